# Optimizing an MI355X kernel written in HIP

```python
import math
import jax
import jax.numpy as jnp
from jax import lax
import numpy as np

D_MODEL = 1024
BATCH = 2
SEQ = 8192
DEPTH = 2

GRID_W = 64
CTX_LEN = 256

HEAD_DIM = 64
N_Q_HEADS = 8
N_KV_HEADS = 2
Q_GROUP = N_Q_HEADS // N_KV_HEADS
ATTN_W = N_Q_HEADS * HEAD_DIM
KV_W = N_KV_HEADS * HEAD_DIM
HYENA_W = 256
S5_W = 256
MIX_W = ATTN_W + HYENA_W + S5_W
Q_OFF = 0
K_OFF = ATTN_W
V_OFF = K_OFF + KV_W
HY_OFF = V_OFF + KV_W
S5_OFF = HY_OFF + 3 * HYENA_W
IN_W = S5_OFF + S5_W

WINDOW = 128
BLOCK = 128
NEG_INF = -1e30
ROPE_BASE = 10000.0
AXIS_DIM = HEAD_DIM // 2

SHORT_K = 3
FILTER_EMB = 33
FILTER_HIDDEN = 64
DECAY_FAST = 0.3
DECAY_SLOW = 1.5
DECAY_TARGET = 1e-2

S5_GROUP = 16
S5_GROUPS = S5_W // S5_GROUP
S5_STATE = 64
DT_MIN = 1e-3
DT_MAX = 1e-1

N_EXPERTS = 256
TOP_K = 8
N_EXPERT_GROUPS = 8
TOPK_GROUPS = 4
EXPERT_FF = 256
SHARED_FF = 256
ROUTED_SCALE = 2.5
MOE_BLOCK = 128

DEEPNORM_ALPHA = (2 * DEPTH) ** 0.25
DEEPNORM_BETA = (8 * DEPTH) ** -0.25
LN_EPS = 1e-5

kernel_name = 'hybrid_hymba_hyena_s5_moe_dit'


def layer_norm(x, g, b):
    xf = x.astype(jnp.float32)
    mu = jnp.mean(xf, axis=-1, keepdims=True)
    var = jnp.mean(jnp.square(xf - mu), axis=-1, keepdims=True)
    y = (xf - mu) * lax.rsqrt(var + LN_EPS)
    return (y * g.astype(jnp.float32) + b.astype(jnp.float32)).astype(x.dtype)


def rms_normalise(x):
    xf = x.astype(jnp.float32)
    return (xf * lax.rsqrt(jnp.mean(jnp.square(xf), axis=-1, keepdims=True) + LN_EPS)).astype(x.dtype)


def modulate(x, shift, scale):
    return x * (1.0 + scale) + shift


def rope_2d(x, row, col):
    inv_freq = ROPE_BASE ** (-jnp.arange(0, AXIS_DIM, 2, dtype=jnp.float32) / AXIS_DIM)
    half = AXIS_DIM // 2

    def rotate(xh, pos):
        ang = pos.astype(jnp.float32)[:, None] * inv_freq[None, :]
        cos = jnp.cos(ang)[None, :, None, :]
        sin = jnp.sin(ang)[None, :, None, :]
        x1, x2 = xh[..., :half], xh[..., half:]
        return jnp.concatenate([x1 * cos - x2 * sin, x1 * sin + x2 * cos], axis=-1)

    xf = x.astype(jnp.float32)
    out = jnp.concatenate([rotate(xf[..., :AXIS_DIM], row), rotate(xf[..., AXIS_DIM:], col)], axis=-1)
    return out.astype(x.dtype)


def sink_softmax(s, sink):
    sk = sink.astype(jnp.float32).reshape(N_KV_HEADS, Q_GROUP, 1, 1)
    m = jnp.maximum(jnp.max(s, axis=-1, keepdims=True), sk)
    e = jnp.exp(s - m)
    return e / (jnp.sum(e, axis=-1, keepdims=True) + jnp.exp(sk - m))


def windowed_attention(q, k, v, k_ctx, v_ctx, sink):
    B, L = q.shape[:2]
    nb = L // BLOCK
    scale = HEAD_DIM ** -0.5
    qb = q.reshape(B, nb, BLOCK, N_KV_HEADS, Q_GROUP, HEAD_DIM)

    def band(t):
        tp = jnp.pad(t, ((0, 0), (BLOCK, BLOCK), (0, 0), (0, 0))).reshape(B, nb + 2, BLOCK, N_KV_HEADS, HEAD_DIM)
        return jnp.concatenate([tp[:, :-2], tp[:, 1:-1], tp[:, 2:]], axis=2)

    kw, vw = band(k), band(v)
    s_win = jnp.einsum('bnqkgd,bnskd->bnkgqs', qb, kw, preferred_element_type=jnp.float32) * scale
    s_ctx = jnp.einsum('bnqkgd,bskd->bnkgqs', qb, k_ctx, preferred_element_type=jnp.float32) * scale
    q_abs = jnp.arange(nb)[:, None, None] * BLOCK + jnp.arange(BLOCK)[None, :, None]
    k_abs = jnp.arange(nb)[:, None, None] * BLOCK + jnp.arange(3 * BLOCK)[None, None, :] - BLOCK
    valid = (jnp.abs(k_abs - q_abs) <= WINDOW) & (k_abs >= 0) & (k_abs < L)
    s_win = jnp.where(valid[None, :, None, None], s_win, NEG_INF)
    p = sink_softmax(jnp.concatenate([s_win, s_ctx], axis=-1), sink)
    p_win, p_ctx = p[..., :3 * BLOCK], p[..., 3 * BLOCK:]
    out = (jnp.einsum('bnkgqs,bnskd->bnqkgd', p_win.astype(v.dtype), vw)
           + jnp.einsum('bnkgqs,bskd->bnqkgd', p_ctx.astype(v.dtype), v_ctx))
    return out.reshape(B, L, ATTN_W)


def context_attention(q_c, k_c, v_c, sink):
    B, C = q_c.shape[:2]
    qg = q_c.reshape(B, C, N_KV_HEADS, Q_GROUP, HEAD_DIM)
    s = jnp.einsum('bqkgd,bskd->bkgqs', qg, k_c, preferred_element_type=jnp.float32) * HEAD_DIM ** -0.5
    p = sink_softmax(s, sink)
    out = jnp.einsum('bkgqs,bskd->bqkgd', p.astype(v_c.dtype), v_c)
    return out.reshape(B, C, ATTN_W)


def short_conv(z, w, b):
    L = z.shape[1]
    pad = SHORT_K // 2
    zp = jnp.pad(z, ((0, 0), (pad, pad), (0, 0)))
    out = b
    for j in range(SHORT_K):
        out = out + zp[:, j:j + L] * w[j]
    return out


def hyena_filter(L, w1, b1, freq, w2, b2, w3):
    t = jnp.linspace(0.0, 1.0, L, dtype=jnp.float32)[:, None]
    bands = (FILTER_EMB - 1) // 2
    w = 2.0 * math.pi * jnp.arange(L, dtype=jnp.float32)[:, None] / L
    f = jnp.linspace(1e-4, bands - 1, bands, dtype=jnp.float32)[None, :]
    z = jnp.concatenate([t, jnp.cos(f * w), -jnp.sin(f * w)], axis=-1)
    fr = freq.astype(jnp.float32)
    h = jnp.sin(fr * (z @ w1.astype(jnp.float32) + b1.astype(jnp.float32)))
    h = jnp.sin(fr * (h @ w2.astype(jnp.float32) + b2.astype(jnp.float32)))
    h = h @ w3.astype(jnp.float32)
    deltas = jnp.abs(jnp.linspace(math.log(DECAY_TARGET) / DECAY_FAST, math.log(DECAY_TARGET) / DECAY_SLOW,
                                  HYENA_W, dtype=jnp.float32))
    decay = jnp.exp(-t * deltas[None, :])
    h_fwd = h[:, :HYENA_W] * decay
    h_bwd = h[:, HYENA_W:] * decay
    k = jnp.concatenate([h_fwd, jnp.zeros((1, HYENA_W), jnp.float32), h_bwd[:0:-1]], axis=0)
    return k / jnp.sum(jnp.abs(k), axis=0, keepdims=True)


def hyena_mix(z, short_w, short_b, w1, b1, freq, w2, b2, w3, d_skip):
    L = z.shape[1]
    zc = short_conv(z, short_w, short_b)
    v, x1, x0 = jnp.split(zc, 3, axis=-1)
    u = (v * x1).astype(jnp.float32)
    k = hyena_filter(L, w1, b1, freq, w2, b2, w3)
    n = 2 * L
    y = jnp.fft.irfft(jnp.fft.rfft(u, n=n, axis=1) * jnp.fft.rfft(k, n=n, axis=0)[None], n=n, axis=1)[:, :L]
    y = y + u * d_skip.astype(jnp.float32)
    return (y * x0.astype(jnp.float32)).astype(z.dtype)


def ssm_combine(e1, e2):
    a1, b1 = e1
    a2, b2 = e2
    return a2 * a1, a2 * b1 + b2


def s5_discretise(a_re, a_im, log_dt, b_re, b_im):
    lam = lax.complex(jnp.minimum(a_re.astype(jnp.float32), -1e-4), a_im.astype(jnp.float32))
    dt = jnp.exp(log_dt.astype(jnp.float32))[:, None]
    lam_bar = jnp.exp(lam * dt)
    b = lax.complex(b_re.astype(jnp.float32), b_im.astype(jnp.float32))
    return lam_bar, ((lam_bar - 1.0) / lam)[..., None] * b


def s5_states(u_g, lam_bar, b_bar, h0, reverse):
    bu = jnp.einsum('blgi,gpi->blgp', u_g.astype(jnp.complex64), b_bar)
    if h0 is not None:
        first = -1 if reverse else 0
        bu = bu.at[:, first].add(lam_bar * h0)
    a = jnp.broadcast_to(lam_bar, bu.shape)
    _, states = lax.associative_scan(ssm_combine, (a, bu), reverse=reverse, axis=1)
    return states


def s5_glu(y, w_glu):
    g = jax.nn.gelu(y)
    return g * jax.nn.sigmoid(g @ w_glu.astype(jnp.float32))


def s5_mix(u_lat, u_ctx, a_re, a_im, log_dt, b_re, b_im, c_re, c_im, d_skip, w_glu, ctx_out):
    B, L = u_lat.shape[:2]
    C = u_ctx.shape[1]
    ul = u_lat.astype(jnp.float32).reshape(B, L, S5_GROUPS, S5_GROUP)
    uc = u_ctx.astype(jnp.float32).reshape(B, C, S5_GROUPS, S5_GROUP)
    dg = d_skip.astype(jnp.float32).reshape(S5_GROUPS, S5_GROUP)
    y_lat = ul * dg
    y_ctx = uc * dg if ctx_out else None
    for direction, reverse in ((0, False), (1, True)):
        lam_bar, b_bar = s5_discretise(a_re[direction], a_im[direction], log_dt[direction],
                                       b_re[direction], b_im[direction])
        c_mat = lax.complex(c_re[direction].astype(jnp.float32), c_im[direction].astype(jnp.float32))
        st_c = s5_states(uc, lam_bar, b_bar, None, reverse)
        h0 = st_c[:, 0] if reverse else st_c[:, -1]
        st_l = s5_states(ul, lam_bar, b_bar, h0, reverse)
        y_lat = y_lat + jnp.einsum('blgp,gip->blgi', st_l, c_mat).real
        if ctx_out:
            y_ctx = y_ctx + jnp.einsum('blgp,gip->blgi', st_c, c_mat).real
    out_lat = s5_glu(y_lat.reshape(B, L, S5_W), w_glu).astype(u_lat.dtype)
    out_ctx = s5_glu(y_ctx.reshape(B, C, S5_W), w_glu).astype(u_ctx.dtype) if ctx_out else None
    return out_lat, out_ctx


def merge_groups(attn, hyena, s5, g):
    return jnp.concatenate([rms_normalise(attn), rms_normalise(hyena), rms_normalise(s5)], axis=-1) * g


def swiglu(h, w_gate, w_up, w_down):
    return (jax.nn.silu(h @ w_gate) * (h @ w_up)) @ w_down


def moe_ffn(xt, w_router, router_bias, w_exp_gate, w_exp_up, w_exp_down, w_sh_gate, w_sh_up, w_sh_down):
    T = xt.shape[0]
    scores = jax.nn.sigmoid((xt @ w_router).astype(jnp.float32))
    biased = scores + router_bias.astype(jnp.float32)
    grp = biased.reshape(T, N_EXPERT_GROUPS, N_EXPERTS // N_EXPERT_GROUPS)
    grp_score = jnp.sum(lax.top_k(grp, 2)[0], axis=-1)
    _, top_g = lax.top_k(grp_score, TOPK_GROUPS)
    keep = jnp.any(top_g[:, :, None] == jnp.arange(N_EXPERT_GROUPS)[None, None, :], axis=1)
    masked = jnp.where(keep[:, :, None], grp, -jnp.inf).reshape(T, N_EXPERTS)
    _, top_e = lax.top_k(masked, TOP_K)
    gate = jnp.take_along_axis(scores, top_e, axis=1)
    gate = gate / jnp.sum(gate, axis=-1, keepdims=True) * ROUTED_SCALE

    tk = T * TOP_K
    flat_e = top_e.reshape(tk)
    flat_tok = jnp.repeat(jnp.arange(T, dtype=jnp.int32), TOP_K)
    flat_w = gate.reshape(tk)
    order = jnp.argsort(flat_e)
    se, stok, sw = flat_e[order], flat_tok[order], flat_w[order]
    counts = jnp.bincount(flat_e, length=N_EXPERTS)
    starts = jnp.cumsum(counts) - counts
    padded = (counts + MOE_BLOCK - 1) // MOE_BLOCK * MOE_BLOCK
    pends = jnp.cumsum(padded)
    pstarts = pends - padded
    dest = pstarts[se] + jnp.arange(tk, dtype=jnp.int32) - starts[se]
    n_blocks = -(-tk // MOE_BLOCK) + N_EXPERTS
    n_rows = n_blocks * MOE_BLOCK
    tok_buf = jnp.zeros((n_rows,), jnp.int32).at[dest].set(stok)
    w_buf = jnp.zeros((n_rows,), jnp.float32).at[dest].set(sw)
    blk_e = jnp.minimum(jnp.searchsorted(pends, jnp.arange(n_blocks, dtype=jnp.int32) * MOE_BLOCK, side='right'),
                        N_EXPERTS - 1)

    def expert_block(y, blk):
        e, toks, wts = blk
        xb = xt[toks]
        h = jax.nn.silu(xb @ w_exp_gate[e]) * (xb @ w_exp_up[e])
        out = (h @ w_exp_down[e]) * wts[:, None].astype(xt.dtype)
        return y.at[toks].add(out.astype(y.dtype)), None

    y, _ = lax.scan(expert_block, jnp.zeros_like(xt),
                    (blk_e, tok_buf.reshape(n_blocks, MOE_BLOCK), w_buf.reshape(n_blocks, MOE_BLOCK)))
    return y + swiglu(xt, w_sh_gate, w_sh_up, w_sh_down)


def hybrid_layer(x, ctx, c, c_ctx, row, col, p, last):
    B, L, D = x.shape
    C = ctx.shape[1]
    mod = jax.nn.silu(c) @ p['w_ada'] + p['b_ada']
    mod_c = jax.nn.silu(c_ctx) @ p['w_ada'] + p['b_ada']
    sh1, sc1, g1, sh2, sc2, g2 = jnp.split(mod[:, None, :], 6, axis=-1)
    sh1c, sc1c, g1c, sh2c, sc2c, g2c = jnp.split(mod_c, 6, axis=-1)
    w_in = p['w_in']
    hy_args = (p['hy_short_w'], p['hy_short_b'], p['hy_w1'], p['hy_b1'], p['hy_freq'],
               p['hy_w2'], p['hy_b2'], p['hy_w3'], p['hy_d'])
    s5_args = (p['s5_a_re'], p['s5_a_im'], p['s5_log_dt'], p['s5_b_re'], p['s5_b_im'],
               p['s5_c_re'], p['s5_c_im'], p['s5_d'], p['s5_w_glu'])
    moe_args = (p['w_router'], p['router_bias'], p['w_exp_gate'], p['w_exp_up'], p['w_exp_down'],
                p['w_sh_gate'], p['w_sh_up'], p['w_sh_down'])

    u = modulate(x, sh1, sc1)
    uc = modulate(ctx, sh1c, sc1c)
    proj = u @ w_in
    q = rope_2d(proj[..., Q_OFF:K_OFF].reshape(B, L, N_Q_HEADS, HEAD_DIM), row, col)
    k = rope_2d(proj[..., K_OFF:V_OFF].reshape(B, L, N_KV_HEADS, HEAD_DIM), row, col)
    v = proj[..., V_OFF:HY_OFF].reshape(B, L, N_KV_HEADS, HEAD_DIM)
    kv_c = uc @ w_in[:, K_OFF:HY_OFF]
    k_c = kv_c[..., :KV_W].reshape(B, C, N_KV_HEADS, HEAD_DIM)
    v_c = kv_c[..., KV_W:].reshape(B, C, N_KV_HEADS, HEAD_DIM)
    s5_in_c = uc @ w_in[:, S5_OFF:]
    attn = windowed_attention(q, k, v, k_c, v_c, p['sink'])
    hyena = hyena_mix(proj[..., HY_OFF:S5_OFF], *hy_args)
    s5_lat, s5_ctx = s5_mix(proj[..., S5_OFF:], s5_in_c, *s5_args, ctx_out=not last)
    mix = merge_groups(attn, hyena, s5_lat, p['mix_g'])
    x = layer_norm(DEEPNORM_ALPHA * x + g1 * (mix @ p['w_out']), p['ln1_g'], p['ln1_b'])
    if not last:
        q_c = (uc @ w_in[:, Q_OFF:K_OFF]).reshape(B, C, N_Q_HEADS, HEAD_DIM)
        attn_c = context_attention(q_c, k_c, v_c, p['sink'])
        hyena_c = hyena_mix(uc @ w_in[:, HY_OFF:S5_OFF], *hy_args)
        mix_c = merge_groups(attn_c, hyena_c, s5_ctx, p['mix_g'])
        ctx = layer_norm(DEEPNORM_ALPHA * ctx + g1c * (mix_c @ p['w_out']), p['ln1_g'], p['ln1_b'])

    u2 = modulate(x, sh2, sc2).reshape(B * L, D)
    if last:
        f = moe_ffn(u2, *moe_args)
    else:
        u2c = modulate(ctx, sh2c, sc2c).reshape(B * C, D)
        f_all = moe_ffn(jnp.concatenate([u2, u2c], axis=0), *moe_args)
        f = f_all[:B * L]
        ctx = layer_norm(DEEPNORM_ALPHA * ctx + g2c * f_all[B * L:].reshape(B, C, D), p['ln2_g'], p['ln2_b'])
    x = layer_norm(DEEPNORM_ALPHA * x + g2 * f.reshape(B, L, D), p['ln2_g'], p['ln2_b'])
    return x, ctx


def setup_inputs(seed: int = 0) -> dict:
    key = jax.random.key(seed)
    keys = iter(jax.random.split(key, 48))

    def normal(shape, std):
        return jax.random.normal(next(keys), shape, jnp.float32) * std

    D = D_MODEL
    x = normal((BATCH, SEQ, D), 1.0)
    c = normal((BATCH, D), 1.0)
    ctx = normal((BATCH, CTX_LEN, D), 1.0)
    c_ctx = normal((D,), 1.0)
    w_ada = normal((DEPTH, D, 6 * D), 0.5 * D ** -0.5)
    b_ada = normal((DEPTH, 6 * D), 0.02)
    w_in = normal((DEPTH, D, IN_W), D ** -0.5)
    w_in = w_in.at[:, :, V_OFF:HY_OFF].multiply(DEEPNORM_BETA)
    w_out = normal((DEPTH, MIX_W, D), DEEPNORM_BETA * MIX_W ** -0.5)
    sink = normal((DEPTH, N_Q_HEADS), 0.5)
    mix_g = 1.0 + normal((DEPTH, MIX_W), 0.02)
    hy_short_w = normal((DEPTH, SHORT_K, 3 * HYENA_W), SHORT_K ** -0.5)
    hy_short_b = normal((DEPTH, 3 * HYENA_W), 0.02)
    hy_w1 = normal((DEPTH, FILTER_EMB, FILTER_HIDDEN), FILTER_EMB ** -0.5)
    hy_b1 = normal((DEPTH, FILTER_HIDDEN), 0.5)
    hy_freq = 1.0 + normal((DEPTH, FILTER_HIDDEN), 0.1)
    hy_w2 = normal((DEPTH, FILTER_HIDDEN, FILTER_HIDDEN), FILTER_HIDDEN ** -0.5)
    hy_b2 = normal((DEPTH, FILTER_HIDDEN), 0.5)
    hy_w3 = normal((DEPTH, FILTER_HIDDEN, 2 * HYENA_W), FILTER_HIDDEN ** -0.5)
    hy_d = normal((DEPTH, HYENA_W), 0.5)
    s5_a_re = -0.5 + normal((DEPTH, 2, S5_GROUPS, S5_STATE), 0.01)
    s5_a_im = math.pi * jnp.arange(S5_STATE, dtype=jnp.float32) + normal((DEPTH, 2, S5_GROUPS, S5_STATE), 0.01)
    s5_log_dt = jax.random.uniform(next(keys), (DEPTH, 2, S5_GROUPS), jnp.float32,
                                   math.log(DT_MIN), math.log(DT_MAX))
    s5_b_re = normal((DEPTH, 2, S5_GROUPS, S5_STATE, S5_GROUP), (2 * S5_GROUP) ** -0.5)
    s5_b_im = normal((DEPTH, 2, S5_GROUPS, S5_STATE, S5_GROUP), (2 * S5_GROUP) ** -0.5)
    s5_c_re = normal((DEPTH, 2, S5_GROUPS, S5_GROUP, S5_STATE), S5_STATE ** -0.5)
    s5_c_im = normal((DEPTH, 2, S5_GROUPS, S5_GROUP, S5_STATE), S5_STATE ** -0.5)
    s5_d = normal((DEPTH, S5_W), 1.0)
    s5_w_glu = normal((DEPTH, S5_W, S5_W), S5_W ** -0.5)
    ln1_g = 1.0 + normal((DEPTH, D), 0.02)
    ln1_b = normal((DEPTH, D), 0.02)
    ln2_g = 1.0 + normal((DEPTH, D), 0.02)
    ln2_b = normal((DEPTH, D), 0.02)
    w_router = normal((DEPTH, D, N_EXPERTS), D ** -0.5)
    router_bias = normal((DEPTH, N_EXPERTS), 0.01)
    w_exp_gate = normal((DEPTH, N_EXPERTS, D, EXPERT_FF), D ** -0.5)
    w_exp_up = normal((DEPTH, N_EXPERTS, D, EXPERT_FF), D ** -0.5)
    w_exp_down = normal((DEPTH, N_EXPERTS, EXPERT_FF, D), DEEPNORM_BETA * EXPERT_FF ** -0.5)
    w_sh_gate = normal((DEPTH, D, SHARED_FF), D ** -0.5)
    w_sh_up = normal((DEPTH, D, SHARED_FF), D ** -0.5)
    w_sh_down = normal((DEPTH, SHARED_FF, D), DEEPNORM_BETA * SHARED_FF ** -0.5)
    return dict(x=x, c=c, ctx=ctx, c_ctx=c_ctx, w_ada=w_ada, b_ada=b_ada, w_in=w_in, w_out=w_out,
                sink=sink, mix_g=mix_g, hy_short_w=hy_short_w, hy_short_b=hy_short_b, hy_w1=hy_w1,
                hy_b1=hy_b1, hy_freq=hy_freq, hy_w2=hy_w2, hy_b2=hy_b2, hy_w3=hy_w3, hy_d=hy_d,
                s5_a_re=s5_a_re, s5_a_im=s5_a_im, s5_log_dt=s5_log_dt, s5_b_re=s5_b_re, s5_b_im=s5_b_im,
                s5_c_re=s5_c_re, s5_c_im=s5_c_im, s5_d=s5_d, s5_w_glu=s5_w_glu, ln1_g=ln1_g, ln1_b=ln1_b,
                ln2_g=ln2_g, ln2_b=ln2_b, w_router=w_router, router_bias=router_bias,
                w_exp_gate=w_exp_gate, w_exp_up=w_exp_up, w_exp_down=w_exp_down,
                w_sh_gate=w_sh_gate, w_sh_up=w_sh_up, w_sh_down=w_sh_down)


def reference(x, c, ctx, c_ctx, w_ada, b_ada, w_in, w_out, sink, mix_g, hy_short_w, hy_short_b, hy_w1,
              hy_b1, hy_freq, hy_w2, hy_b2, hy_w3, hy_d, s5_a_re, s5_a_im, s5_log_dt, s5_b_re, s5_b_im,
              s5_c_re, s5_c_im, s5_d, s5_w_glu, ln1_g, ln1_b, ln2_g, ln2_b, w_router, router_bias,
              w_exp_gate, w_exp_up, w_exp_down, w_sh_gate, w_sh_up, w_sh_down):
    L = x.shape[1]
    ROWS = L // GRID_W
    row = jnp.repeat(jnp.arange(ROWS, dtype=jnp.int32), GRID_W)
    col = jnp.tile(jnp.arange(GRID_W, dtype=jnp.int32), ROWS)
    for l in range(DEPTH):
        p = dict(w_ada=w_ada[l], b_ada=b_ada[l], w_in=w_in[l], w_out=w_out[l], sink=sink[l], mix_g=mix_g[l],
                 hy_short_w=hy_short_w[l], hy_short_b=hy_short_b[l], hy_w1=hy_w1[l], hy_b1=hy_b1[l],
                 hy_freq=hy_freq[l], hy_w2=hy_w2[l], hy_b2=hy_b2[l], hy_w3=hy_w3[l], hy_d=hy_d[l],
                 s5_a_re=s5_a_re[l], s5_a_im=s5_a_im[l], s5_log_dt=s5_log_dt[l], s5_b_re=s5_b_re[l],
                 s5_b_im=s5_b_im[l], s5_c_re=s5_c_re[l], s5_c_im=s5_c_im[l], s5_d=s5_d[l],
                 s5_w_glu=s5_w_glu[l], ln1_g=ln1_g[l], ln1_b=ln1_b[l], ln2_g=ln2_g[l], ln2_b=ln2_b[l],
                 w_router=w_router[l], router_bias=router_bias[l], w_exp_gate=w_exp_gate[l],
                 w_exp_up=w_exp_up[l], w_exp_down=w_exp_down[l], w_sh_gate=w_sh_gate[l],
                 w_sh_up=w_sh_up[l], w_sh_down=w_sh_down[l])
        x, ctx = hybrid_layer(x, ctx, c, c_ctx, row, col, p, l == DEPTH - 1)
    return x
```

```cpp
#ifndef CPU_TEST
#include <hip/hip_runtime.h>
#include <cstring>
#define DEV __device__ __forceinline__
#define DEVM __device__ __forceinline__
#else
#include <cmath>
#include <cstdio>
#include <cstdlib>
#include <cstring>
#define DEV static inline
#define DEVM inline
struct float2 { float x, y; };
static inline float2 make_float2(float a, float b) { float2 r; r.x = a; r.y = b; return r; }
static inline int atomicAdd(int* p, int v) { int o = *p; *p += v; return o; }
#endif

#ifdef SMALL_CFG
#define D_MODEL 64
#define BATCH 2
#define SEQ 256
#define GRID_W 16
#define CTX_LEN 32
#define HEAD_DIM 16
#define N_Q_HEADS 4
#define N_KV_HEADS 2
#define HYENA_W 16
#define S5_W 32
#define WINDOW 32
#define FILTER_HIDDEN 16
#define S5_STATE 8
#define N_EXPERTS 32
#define TOP_K 4
#define EXPERT_FF 16
#define SHARED_FF 16
#define S5_T 32
#else
#define D_MODEL 1024
#define BATCH 2
#define SEQ 8192
#define GRID_W 64
#define CTX_LEN 256
#define HEAD_DIM 64
#define N_Q_HEADS 8
#define N_KV_HEADS 2
#define HYENA_W 256
#define S5_W 256
#define WINDOW 128
#define FILTER_HIDDEN 64
#define S5_STATE 64
#define N_EXPERTS 256
#define TOP_K 8
#define EXPERT_FF 256
#define SHARED_FF 256
#define S5_T 64
#endif
#define DEPTH 2
#define FILTER_EMB 33
#define N_EXPERT_GROUPS 8
#define TOPK_GROUPS 4
#define S5_GROUP 16
#define Q_GROUP (N_Q_HEADS / N_KV_HEADS)
#define ATTN_W (N_Q_HEADS * HEAD_DIM)
#define KV_W (N_KV_HEADS * HEAD_DIM)
#define MIX_W (ATTN_W + HYENA_W + S5_W)
#define Q_OFF 0
#define K_OFF ATTN_W
#define V_OFF (K_OFF + KV_W)
#define HY_OFF (V_OFF + KV_W)
#define S5_OFF (HY_OFF + 3 * HYENA_W)
#define IN_W (S5_OFF + S5_W)
#define AXIS_DIM (HEAD_DIM / 2)
#define ROPE_HALF (AXIS_DIM / 2)
#define S5_GROUPS (S5_W / S5_GROUP)
#define EPG (N_EXPERTS / N_EXPERT_GROUPS)
#define NL (BATCH * SEQ)
#define NC (BATCH * CTX_LEN)
#define NR (NL + NC)
#define NSEQ (CTX_LEN + SEQ)
#define NCH (NSEQ / S5_T)
#define LN_EPS 1e-5f
#define DN_ALPHA 1.4142135623730951f
#define ROUTED_SCALE 2.5f
#define PI_D 3.14159265358979323846

struct P {
  const float *x, *c, *ctx, *c_ctx, *w_ada, *b_ada, *w_in, *w_out, *sink, *mix_g, *hy_short_w, *hy_short_b, *hy_w1,
      *hy_b1, *hy_freq, *hy_w2, *hy_b2, *hy_w3, *hy_d, *s5_a_re, *s5_a_im, *s5_log_dt, *s5_b_re, *s5_b_im, *s5_c_re,
      *s5_c_im, *s5_d, *s5_w_glu, *ln1_g, *ln1_b, *ln2_g, *ln2_b, *w_router, *router_bias, *w_exp_gate, *w_exp_up,
      *w_exp_down, *w_sh_gate, *w_sh_up, *w_sh_down;
  float* out;
  unsigned* bar;
  int* cnt;
  float *mod;
  float *xcur;
  float *ubuf;
  float *proj;
  float *hu, *hx0;
  float *fh1, *fh2;
  float *kraw;
  float *knorm;
  float *fh1c, *fh2c;
  float *krawc;
  float *knormc;
  float *mixb;
  float *tmp;
  float2 *lampow;
  float2 *bbar;
  float *kc;
  float2 *sc, *hc;
  float *ybuf;
  float *rl;
  int *top_e;
  float *gate;
  int *posb;
  int *srow;
  float *hbuf;
  float *hsb;
};

#define FOR_ITEMS(i, N) for (long i = gtid; i < (long)(N); i += gsize)

DEV float siluf(float x) { return x / (1.0f + expf(-x)); }
DEV float sigmoidf_(float x) { return 1.0f / (1.0f + expf(-x)); }
DEV float gelu_tanhf(float x) { return 0.5f * x * (1.0f + tanhf(0.7978845608028654f * (x + 0.044715f * x * x * x))); }
DEV int modrow(long r) { return r < NL ? (int)(r / SEQ) : BATCH; }

DEV void ph_g0(const P& p, long gtid, long gsize) {
  FOR_ITEMS(i, (long)NR * D_MODEL) p.xcur[i] = i < (long)NL * D_MODEL ? p.x[i] : p.ctx[i - (long)NL * D_MODEL];
  FOR_ITEMS(i, DEPTH * (BATCH + 1) * 6 * D_MODEL) {
    int n = (int)(i % (6 * D_MODEL)); int j = (int)((i / (6 * D_MODEL)) % (BATCH + 1)); int l = (int)(i / (6 * D_MODEL * (BATCH + 1)));
    const float* cv = j < BATCH ? p.c + j * D_MODEL : p.c_ctx;
    const float* w = p.w_ada + (long)l * D_MODEL * 6 * D_MODEL;
    float acc = p.b_ada[l * 6 * D_MODEL + n];
    for (int k = 0; k < D_MODEL; ++k) acc += siluf(cv[k]) * w[(long)k * 6 * D_MODEL + n];
    p.mod[i] = acc;
  }
  FOR_ITEMS(i, DEPTH * 2 * S5_GROUPS * S5_STATE) {
    int pp = (int)(i % S5_STATE); int g = (int)((i / S5_STATE) % S5_GROUPS); int ld = (int)(i / (S5_STATE * S5_GROUPS));
    float are = fminf(p.s5_a_re[i], -1e-4f), aim = p.s5_a_im[i];
    float dt = expf(p.s5_log_dt[ld * S5_GROUPS + g]);
    for (int d = 0; d <= S5_T; ++d) {
      float mag = expf(are * dt * d); float ang = aim * dt * d;
      p.lampow[((long)(ld * S5_GROUPS + g) * (S5_T + 1) + d) * S5_STATE + pp] = make_float2(mag * cosf(ang), mag * sinf(ang));
    }
    float mag = expf(are * dt), ang = aim * dt;
    float lr = mag * cosf(ang) - 1.0f, li = mag * sinf(ang);
    float den = are * are + aim * aim;
    float fr = (lr * are + li * aim) / den, fi = (li * are - lr * aim) / den;
    for (int j = 0; j < S5_GROUP; ++j) {
      float br = p.s5_b_re[i * S5_GROUP + j], bi = p.s5_b_im[i * S5_GROUP + j];
      p.bbar[i * S5_GROUP + j] = make_float2(fr * br - fi * bi, fr * bi + fi * br);
    }
  }
}
DEV void hy_f1(const P& p, int l, int Lf, float* h1, long gtid, long gsize) {
  FOR_ITEMS(i, (long)Lf * FILTER_HIDDEN) {
    int j = (int)(i % FILTER_HIDDEN); int t = (int)(i / FILTER_HIDDEN);
    const float* w1 = p.hy_w1 + l * FILTER_EMB * FILTER_HIDDEN;
    float tt = (float)((double)t / (double)(Lf - 1));
    float w = (float)(2.0 * PI_D * (double)t / (double)Lf);
    float acc = p.hy_b1[l * FILTER_HIDDEN + j] + tt * w1[j];
    const int bands = (FILTER_EMB - 1) / 2;
    for (int m = 0; m < bands; ++m) {
      float f = (float)(1e-4 + (double)m * ((double)(bands - 1) - 1e-4) / (double)(bands - 1));
      float a = f * w;
      acc += cosf(a) * w1[(1 + m) * FILTER_HIDDEN + j] - sinf(a) * w1[(1 + bands + m) * FILTER_HIDDEN + j];
    }
    h1[i] = sinf(p.hy_freq[l * FILTER_HIDDEN + j] * acc);
  }
}
DEV void hy_f2(const P& p, int l, int Lf, const float* h1, float* h2, long gtid, long gsize) {
  FOR_ITEMS(i, (long)Lf * FILTER_HIDDEN) {
    int j = (int)(i % FILTER_HIDDEN); int t = (int)(i / FILTER_HIDDEN);
    const float* w2 = p.hy_w2 + l * FILTER_HIDDEN * FILTER_HIDDEN;
    float acc = p.hy_b2[l * FILTER_HIDDEN + j];
    for (int k = 0; k < FILTER_HIDDEN; ++k) acc += h1[t * FILTER_HIDDEN + k] * w2[k * FILTER_HIDDEN + j];
    h2[i] = sinf(p.hy_freq[l * FILTER_HIDDEN + j] * acc);
  }
}
DEV void hy_f3(const P& p, int l, int Lf, const float* h2, float* kraw, long gtid, long gsize) {
  FOR_ITEMS(i, (long)Lf * 2 * HYENA_W) {
    int cc = (int)(i % (2 * HYENA_W)); int t = (int)(i / (2 * HYENA_W)); int ch = cc % HYENA_W;
    const float* w3 = p.hy_w3 + l * FILTER_HIDDEN * 2 * HYENA_W;
    float acc = 0.f;
    for (int k = 0; k < FILTER_HIDDEN; ++k) acc += h2[t * FILTER_HIDDEN + k] * w3[k * 2 * HYENA_W + cc];
    double d0 = log(1e-2) / 0.3, d1 = log(1e-2) / 1.5;
    float delta = fabsf((float)(d0 + (d1 - d0) * (double)ch / (double)(HYENA_W - 1)));
    float tt = (float)((double)t / (double)(Lf - 1));
    kraw[i] = acc * expf(-tt * delta);
  }
}
DEV void hy_f4(int Lf, const float* kraw, float* knorm, long gtid, long gsize) {
  FOR_ITEMS(i, HYENA_W) {
    float s = 0.f;
    for (int t = 0; t < Lf; ++t) {
      s += fabsf(kraw[(long)t * 2 * HYENA_W + i]);
      if (t > 0) s += fabsf(kraw[(long)t * 2 * HYENA_W + HYENA_W + i]);
    }
    knorm[i] = 1.0f / s;
  }
}
DEV void ph_g1(const P& p, long gtid, long gsize) {
  for (int l = 0; l < DEPTH; ++l) hy_f1(p, l, SEQ, p.fh1 + (long)l * SEQ * FILTER_HIDDEN, gtid, gsize);
  hy_f1(p, 0, CTX_LEN, p.fh1c, gtid, gsize);
  FOR_ITEMS(i, (long)DEPTH * 2 * S5_GROUPS * S5_T * S5_GROUP * S5_GROUP) {
    int j = (int)(i % S5_GROUP); int ii = (int)((i / S5_GROUP) % S5_GROUP); int d = (int)((i / (S5_GROUP * S5_GROUP)) % S5_T);
    long ldg = i / (S5_GROUP * S5_GROUP * S5_T);
    float acc = 0.f;
    for (int pp = 0; pp < S5_STATE; ++pp) {
      float cr = p.s5_c_re[(ldg * S5_GROUP + ii) * S5_STATE + pp], ci = p.s5_c_im[(ldg * S5_GROUP + ii) * S5_STATE + pp];
      float2 lp = p.lampow[(ldg * (S5_T + 1) + d) * S5_STATE + pp];
      float2 bb = p.bbar[(ldg * S5_STATE + pp) * S5_GROUP + j];
      float tr = lp.x * bb.x - lp.y * bb.y, ti = lp.x * bb.y + lp.y * bb.x;
      acc += cr * tr - ci * ti;
    }
    p.kc[i] = acc;
  }
}
DEV void ph_g2(const P& p, long gtid, long gsize) {
  for (int l = 0; l < DEPTH; ++l) hy_f2(p, l, SEQ, p.fh1 + (long)l * SEQ * FILTER_HIDDEN, p.fh2 + (long)l * SEQ * FILTER_HIDDEN, gtid, gsize);
  hy_f2(p, 0, CTX_LEN, p.fh1c, p.fh2c, gtid, gsize);
}
DEV void ph_g3(const P& p, long gtid, long gsize) {
  for (int l = 0; l < DEPTH; ++l) hy_f3(p, l, SEQ, p.fh2 + (long)l * SEQ * FILTER_HIDDEN, p.kraw + (long)l * SEQ * 2 * HYENA_W, gtid, gsize);
  hy_f3(p, 0, CTX_LEN, p.fh2c, p.krawc, gtid, gsize);
}
DEV void ph_g4(const P& p, long gtid, long gsize) {
  for (int l = 0; l < DEPTH; ++l) hy_f4(SEQ, p.kraw + (long)l * SEQ * 2 * HYENA_W, p.knorm + l * HYENA_W, gtid, gsize);
  hy_f4(CTX_LEN, p.krawc, p.knormc, gtid, gsize);
}
#define NG 5

DEV void ph_modu(const P& p, int l, int which, long gtid, long gsize) {
  FOR_ITEMS(i, (long)NR * D_MODEL) {
    int k = (int)(i % D_MODEL); long r = i / D_MODEL;
    const float* m = p.mod + ((long)l * (BATCH + 1) + modrow(r)) * 6 * D_MODEL + which * 3 * D_MODEL;
    p.ubuf[i] = p.xcur[i] * (1.0f + m[D_MODEL + k]) + m[k];
  }
}
template <class Epi>
DEV void gemm_naive(const float* A, int lda, const float* B, int ldb, int M, int N, int K, Epi epi, long gtid, long gsize) {
  FOR_ITEMS(i, (long)(M / 4) * N) {
    int n = (int)(i % N); long r0 = (i / N) * 4;
    const float* a0 = A + r0 * lda;
    float c0 = 0.f, c1 = 0.f, c2 = 0.f, c3 = 0.f;
    for (int k = 0; k < K; ++k) {
      float b = B[(long)k * ldb + n];
      c0 += a0[k] * b; c1 += a0[lda + k] * b; c2 += a0[2 * lda + k] * b; c3 += a0[3 * lda + k] * b;
    }
    epi(r0, n, c0); epi(r0 + 1, n, c1); epi(r0 + 2, n, c2); epi(r0 + 3, n, c3);
  }
}
struct EpiStore { float* C; int ldc; DEVM void operator()(long r, int n, float v) const { C[r * ldc + n] = v; } };
DEV void ph_proj(const P& p, int l, long gtid, long gsize) {
  EpiStore e{p.proj, IN_W};
  gemm_naive(p.ubuf, D_MODEL, p.w_in + (long)l * D_MODEL * IN_W, IN_W, NR, IN_W, D_MODEL, e, gtid, gsize);
}
DEV long s5_row(int b, int dir, int n) {
  if (n < CTX_LEN) return (long)NL + b * CTX_LEN + (dir ? CTX_LEN - 1 - n : n);
  int t = n - CTX_LEN; return (long)b * SEQ + (dir ? SEQ - 1 - t : t);
}
DEV void ph_post_proj(const P& p, int l, long gtid, long gsize) {
  FOR_ITEMS(i, (long)NL * (N_Q_HEADS + N_KV_HEADS) * 2 * ROPE_HALF) {
    int ii = (int)(i % ROPE_HALF); int a = (int)((i / ROPE_HALF) % 2); int hs = (int)((i / (2 * ROPE_HALF)) % (N_Q_HEADS + N_KV_HEADS));
    long r = i / (2 * ROPE_HALF * (N_Q_HEADS + N_KV_HEADS));
    int t = (int)(r % SEQ); int pos = a == 0 ? t / GRID_W : t % GRID_W;
    float inv = powf(10000.0f, -(float)(2 * ii) / (float)AXIS_DIM);
    float ang = (float)pos * inv; float cs = cosf(ang), sn = sinf(ang);
    float* q = p.proj + r * IN_W + hs * HEAD_DIM + a * AXIS_DIM + ii;
    float x1 = q[0], x2 = q[ROPE_HALF];
    q[0] = x1 * cs - x2 * sn; q[ROPE_HALF] = x1 * sn + x2 * cs;
  }
  FOR_ITEMS(i, (long)NR * HYENA_W) {
    int ch = (int)(i % HYENA_W); long r = i / HYENA_W;
    int Ls = r < NL ? SEQ : CTX_LEN; long base = r < NL ? (r / SEQ) * SEQ : NL + ((r - NL) / CTX_LEN) * CTX_LEN; int t = (int)(r - base);
    const float* sw = p.hy_short_w + l * 3 * 3 * HYENA_W; const float* sb = p.hy_short_b + l * 3 * HYENA_W;
    float z[3];
#pragma unroll
    for (int part = 0; part < 3; ++part) {
      int cc = part * HYENA_W + ch; float acc = sb[cc];
#pragma unroll
      for (int j = 0; j < 3; ++j) { int tt = t + j - 1; if (tt >= 0 && tt < Ls) acc += p.proj[(base + tt) * IN_W + HY_OFF + cc] * sw[j * 3 * HYENA_W + cc]; }
      z[part] = acc;
    }
    p.hu[i] = z[0] * z[1]; p.hx0[i] = z[2];
  }
  FOR_ITEMS(i, (long)BATCH * 2 * S5_GROUPS * NCH * S5_STATE) {
    int pp = (int)(i % S5_STATE); int c = (int)((i / S5_STATE) % NCH); int g = (int)((i / (S5_STATE * NCH)) % S5_GROUPS);
    int dir = (int)((i / (S5_STATE * NCH * S5_GROUPS)) % 2); int b = (int)(i / (S5_STATE * NCH * S5_GROUPS * 2));
    long ldg = ((long)l * 2 + dir) * S5_GROUPS + g;
    float sr = 0.f, si = 0.f;
    for (int s = 0; s < S5_T; ++s) {
      const float* u = p.proj + s5_row(b, dir, c * S5_T + s) * IN_W + S5_OFF + g * S5_GROUP;
      float br = 0.f, bi = 0.f;
#pragma unroll
      for (int j = 0; j < S5_GROUP; ++j) { float2 bb = p.bbar[(ldg * S5_STATE + pp) * S5_GROUP + j]; br += bb.x * u[j]; bi += bb.y * u[j]; }
      float2 lp = p.lampow[(ldg * (S5_T + 1) + (S5_T - 1 - s)) * S5_STATE + pp];
      sr += lp.x * br - lp.y * bi; si += lp.x * bi + lp.y * br;
    }
    p.sc[i] = make_float2(sr, si);
  }
}
DEV void attn_item(const P& p, int l, long r, int h, float* outp) {
  const float scale = 1.0f / sqrtf((float)HEAD_DIM);
  float q[HEAD_DIM], acc[HEAD_DIM];
  const float* qp = p.proj + r * IN_W + Q_OFF + h * HEAD_DIM;
#pragma unroll
  for (int d = 0; d < HEAD_DIM; ++d) { q[d] = qp[d] * scale; acc[d] = 0.f; }
  int kvh = h / Q_GROUP; int b = r < NL ? (int)(r / SEQ) : (int)((r - NL) / CTX_LEN);
  float m = -1e30f, lsum = 0.f;
  int nwin = 0, t = 0;
  if (r < NL) { t = (int)(r % SEQ); nwin = 2 * WINDOW + 1; }
  for (int j = 0; j < nwin + CTX_LEN; ++j) {
    long kr;
    if (j < nwin) { int tk = t - WINDOW + j; if (tk < 0 || tk >= SEQ) continue; kr = (long)b * SEQ + tk; }
    else kr = (long)NL + b * CTX_LEN + (j - nwin);
    const float* kp = p.proj + kr * IN_W + K_OFF + kvh * HEAD_DIM; const float* vp = p.proj + kr * IN_W + V_OFF + kvh * HEAD_DIM;
    float s = 0.f;
#pragma unroll
    for (int d = 0; d < HEAD_DIM; ++d) s += q[d] * kp[d];
    float mn = fmaxf(m, s); float corr = expf(m - mn); float pe = expf(s - mn);
    lsum = lsum * corr + pe;
#pragma unroll
    for (int d = 0; d < HEAD_DIM; ++d) acc[d] = acc[d] * corr + pe * vp[d];
    m = mn;
  }
  float sk = p.sink[l * N_Q_HEADS + h]; float mf = fmaxf(m, sk); float corr = expf(m - mf);
  float den = lsum * corr + expf(sk - mf); float sc2 = corr / den;
#pragma unroll
  for (int d = 0; d < HEAD_DIM; ++d) outp[d] = acc[d] * sc2;
}
DEV void ph_mix(const P& p, int l, long gtid, long gsize) {
  long nrows_att = l == 0 ? NR : NL;
  FOR_ITEMS(i, nrows_att * N_Q_HEADS) { int h = (int)(i % N_Q_HEADS); long r = i / N_Q_HEADS; attn_item(p, l, r, h, p.mixb + r * MIX_W + h * HEAD_DIM); }
  FOR_ITEMS(i, (long)NL * HYENA_W) {
    int ch = (int)(i % HYENA_W); long r = i / HYENA_W; int t = (int)(r % SEQ); long base = r - t;
    const float* kr = p.kraw + (long)l * SEQ * 2 * HYENA_W;
    float acc = 0.f;
    for (int s = 0; s <= t; ++s) acc += kr[(long)(t - s) * 2 * HYENA_W + ch] * p.hu[(base + s) * HYENA_W + ch];
    for (int s = t + 1; s < SEQ; ++s) acc += kr[(long)(s - t) * 2 * HYENA_W + HYENA_W + ch] * p.hu[(base + s) * HYENA_W + ch];
    float u = p.hu[i];
    p.mixb[r * MIX_W + ATTN_W + ch] = (acc * p.knorm[l * HYENA_W + ch] + u * p.hy_d[l * HYENA_W + ch]) * p.hx0[i];
  }
  if (l == 0) {
    FOR_ITEMS(i, (long)NC * HYENA_W) {
      int ch = (int)(i % HYENA_W); long r = NL + i / HYENA_W; int t = (int)((r - NL) % CTX_LEN); long base = r - t;
      float acc = 0.f;
      for (int s = 0; s <= t; ++s) acc += p.krawc[(long)(t - s) * 2 * HYENA_W + ch] * p.hu[(base + s) * HYENA_W + ch];
      for (int s = t + 1; s < CTX_LEN; ++s) acc += p.krawc[(long)(s - t) * 2 * HYENA_W + HYENA_W + ch] * p.hu[(base + s) * HYENA_W + ch];
      float u = p.hu[r * HYENA_W + ch];
      p.mixb[r * MIX_W + ATTN_W + ch] = (acc * p.knormc[ch] + u * p.hy_d[l * HYENA_W + ch]) * p.hx0[r * HYENA_W + ch];
    }
  }
  FOR_ITEMS(i, (long)BATCH * 2 * S5_GROUPS * S5_STATE) {
    int pp = (int)(i % S5_STATE); int g = (int)((i / S5_STATE) % S5_GROUPS); int dir = (int)((i / (S5_STATE * S5_GROUPS)) % 2); int b = (int)(i / (S5_STATE * S5_GROUPS * 2));
    long ldg = ((long)l * 2 + dir) * S5_GROUPS + g;
    float2 lt = p.lampow[(ldg * (S5_T + 1) + S5_T) * S5_STATE + pp];
    float hr = 0.f, hi = 0.f;
    long base = (((long)b * 2 + dir) * S5_GROUPS + g) * NCH;
    for (int c = 0; c < NCH; ++c) {
      p.hc[(base + c) * S5_STATE + pp] = make_float2(hr, hi);
      float2 s = p.sc[(base + c) * S5_STATE + pp];
      float nr = lt.x * hr - lt.y * hi + s.x, ni = lt.x * hi + lt.y * hr + s.y;
      hr = nr; hi = ni;
    }
  }
}
DEV void ph_s5out(const P& p, int l, long gtid, long gsize) {
  FOR_ITEMS(i, (long)NR * S5_W) {
    int chn = (int)(i % S5_W); long r = i / S5_W; int g = chn / S5_GROUP, ii = chn % S5_GROUP;
    int b, tl; bool isctx = r >= NL;
    if (isctx) { b = (int)((r - NL) / CTX_LEN); tl = (int)((r - NL) % CTX_LEN); } else { b = (int)(r / SEQ); tl = (int)(r % SEQ); }
    float y = p.s5_d[l * S5_W + chn] * p.proj[r * IN_W + S5_OFF + chn];
    for (int dir = 0; dir < 2; ++dir) {
      int n = isctx ? (dir ? CTX_LEN - 1 - tl : tl) : CTX_LEN + (dir ? SEQ - 1 - tl : tl);
      int c = n / S5_T, tau = n % S5_T;
      long ldg = ((long)l * 2 + dir) * S5_GROUPS + g;
      long hb = ((((long)b * 2 + dir) * S5_GROUPS + g) * NCH + c) * S5_STATE;
      for (int pp = 0; pp < S5_STATE; ++pp) {
        float cr = p.s5_c_re[(ldg * S5_GROUP + ii) * S5_STATE + pp], ci = p.s5_c_im[(ldg * S5_GROUP + ii) * S5_STATE + pp];
        float2 lp = p.lampow[(ldg * (S5_T + 1) + tau + 1) * S5_STATE + pp]; float2 h = p.hc[hb + pp];
        float tr = lp.x * h.x - lp.y * h.y, ti = lp.x * h.y + lp.y * h.x;
        y += cr * tr - ci * ti;
      }
      for (int s = 0; s <= tau; ++s) {
        const float* u = p.proj + s5_row(b, dir, c * S5_T + s) * IN_W + S5_OFF + g * S5_GROUP;
        const float* kk = p.kc + ((ldg * S5_T + (tau - s)) * S5_GROUP + ii) * S5_GROUP;
#pragma unroll
        for (int j = 0; j < S5_GROUP; ++j) y += kk[j] * u[j];
      }
    }
    p.ybuf[i] = gelu_tanhf(y);
  }
}
struct EpiGlu { const float* g; float* mixb; DEVM void operator()(long r, int n, float v) const { mixb[r * MIX_W + ATTN_W + HYENA_W + n] = g[r * S5_W + n] * sigmoidf_(v); } };
DEV void ph_glu(const P& p, int l, long gtid, long gsize) {
  EpiGlu e{p.ybuf, p.mixb};
  gemm_naive(p.ybuf, S5_W, p.s5_w_glu + (long)l * S5_W * S5_W, S5_W, NR, S5_W, S5_W, e, gtid, gsize);
}
DEV void ph_rms(const P& p, int l, long gtid, long gsize) {
  FOR_ITEMS(i, (long)NR * 3) {
    int grp = (int)(i % 3); long r = i / 3;
    int off = grp == 0 ? 0 : (grp == 1 ? ATTN_W : ATTN_W + HYENA_W); int w = grp == 0 ? ATTN_W : (grp == 1 ? HYENA_W : S5_W);
    float* v = p.mixb + r * MIX_W + off; float ss = 0.f;
    for (int k = 0; k < w; ++k) ss += v[k] * v[k];
    float rs = 1.0f / sqrtf(ss / (float)w + LN_EPS);
    for (int k = 0; k < w; ++k) v[k] = v[k] * rs * p.mix_g[l * MIX_W + off + k];
  }
}
struct EpiRes { const float* xcur; const float* mod; int l; int goff; float* tmp;
  DEVM void operator()(long r, int n, float v) const { const float* m = mod + ((long)l * (BATCH + 1) + modrow(r)) * 6 * D_MODEL + goff; tmp[r * D_MODEL + n] = DN_ALPHA * xcur[r * D_MODEL + n] + m[n] * v; } };
DEV void ph_outproj(const P& p, int l, long gtid, long gsize) {
  EpiRes e{p.xcur, p.mod, l, 2 * D_MODEL, p.tmp};
  gemm_naive(p.mixb, MIX_W, p.w_out + (long)l * MIX_W * D_MODEL, D_MODEL, NR, D_MODEL, MIX_W, e, gtid, gsize);
}
DEV void ph_ln(const P& p, int l, int which, long gtid, long gsize) {
  const float* gw = (which == 0 ? p.ln1_g : p.ln2_g) + l * D_MODEL; const float* bw = (which == 0 ? p.ln1_b : p.ln2_b) + l * D_MODEL;
  FOR_ITEMS(r, (long)NR) {
    const float* v = p.tmp + r * D_MODEL; float mu = 0.f;
    for (int k = 0; k < D_MODEL; ++k) mu += v[k];
    mu /= (float)D_MODEL; float var = 0.f;
    for (int k = 0; k < D_MODEL; ++k) { float d = v[k] - mu; var += d * d; }
    float rs = 1.0f / sqrtf(var / (float)D_MODEL + LN_EPS);
    const float* m = p.mod + ((long)l * (BATCH + 1) + modrow(r)) * 6 * D_MODEL + 3 * D_MODEL;
    for (int k = 0; k < D_MODEL; ++k) {
      float y = (v[k] - mu) * rs * gw[k] + bw[k];
      p.xcur[r * D_MODEL + k] = y;
      if (which == 0) p.ubuf[r * D_MODEL + k] = y * (1.0f + m[D_MODEL + k]) + m[k];
      if (which == 1 && l == DEPTH - 1 && r < NL) p.out[r * D_MODEL + k] = y;
    }
  }
}
DEV void ph_router(const P& p, int l, long gtid, long gsize) {
  EpiStore e{p.rl, N_EXPERTS};
  gemm_naive(p.ubuf, D_MODEL, p.w_router + (long)l * D_MODEL * N_EXPERTS, N_EXPERTS, NR, N_EXPERTS, D_MODEL, e, gtid, gsize);
}
DEV bool better(float v, int i, float bv, int bi) { return v > bv || (v == bv && i < bi); }
DEV void ph_select(const P& p, int l, long gtid, long gsize) {
  FOR_ITEMS(r, (long)NR) {
    const float* lg = p.rl + r * N_EXPERTS; const float* rb = p.router_bias + l * N_EXPERTS;
    float gs[N_EXPERT_GROUPS];
#pragma unroll
    for (int g = 0; g < N_EXPERT_GROUPS; ++g) {
      float m1 = -1e30f, m2 = -1e30f;
      for (int e = 0; e < EPG; ++e) { float v = sigmoidf_(lg[g * EPG + e]) + rb[g * EPG + e]; if (v > m1) { m2 = m1; m1 = v; } else if (v > m2) m2 = v; }
      gs[g] = m1 + m2;
    }
    unsigned keep = 0;
#pragma unroll
    for (int it = 0; it < TOPK_GROUPS; ++it) {
      float bv = -1e30f; int bi = -1;
#pragma unroll
      for (int g = 0; g < N_EXPERT_GROUPS; ++g) if (!((keep >> g) & 1u) && (bi < 0 || gs[g] > bv)) { bv = gs[g]; bi = g; }
      keep |= 1u << bi;
    }
    float lastv = 1e30f; int lasti = -1; float gsum = 0.f;
    for (int it = 0; it < TOP_K; ++it) {
      float bv = -1e30f; int bi = -1;
      for (int e = 0; e < N_EXPERTS; ++e) {
        if (!((keep >> (e / EPG)) & 1u)) continue;
        float v = sigmoidf_(lg[e]) + rb[e];
        if (!better(lastv, lasti, v, e)) continue;
        if (bi < 0 || better(v, e, bv, bi)) { bv = v; bi = e; }
      }
      lastv = bv; lasti = bi;
      float sc = sigmoidf_(lg[bi]); gsum += sc;
      p.top_e[r * TOP_K + it] = bi; p.gate[r * TOP_K + it] = sc;
      p.posb[r * TOP_K + it] = atomicAdd(&p.cnt[l * N_EXPERTS + bi], 1);
    }
    float inv = ROUTED_SCALE / gsum;
    for (int it = 0; it < TOP_K; ++it) p.gate[r * TOP_K + it] *= inv;
  }
}
DEV void ph_sortrows(const P& p, int l, long gtid, long gsize) {
  FOR_ITEMS(i, (long)NR * TOP_K) {
    int e = p.top_e[i]; int off = 0;
    for (int j = 0; j < e; ++j) off += p.cnt[l * N_EXPERTS + j];
    p.srow[off + p.posb[i]] = (int)i;
  }
}
DEV void ph_expert_up(const P& p, int l, long gtid, long gsize) {
  FOR_ITEMS(i, (long)NR * TOP_K * EXPERT_FF) {
    int cidx = (int)(i % EXPERT_FF); int a = p.srow[i / EXPERT_FF]; int e = p.top_e[a]; long r = a / TOP_K;
    const float* xg = p.ubuf + r * D_MODEL;
    const float* wg = p.w_exp_gate + ((long)l * N_EXPERTS + e) * D_MODEL * EXPERT_FF; const float* wu = p.w_exp_up + ((long)l * N_EXPERTS + e) * D_MODEL * EXPERT_FF;
    float g = 0.f, u = 0.f;
    for (int k = 0; k < D_MODEL; ++k) { float xv = xg[k]; g += xv * wg[(long)k * EXPERT_FF + cidx]; u += xv * wu[(long)k * EXPERT_FF + cidx]; }
    p.hbuf[(long)a * EXPERT_FF + cidx] = siluf(g) * u;
  }
  FOR_ITEMS(i, (long)NR * SHARED_FF) {
    int cidx = (int)(i % SHARED_FF); long r = i / SHARED_FF;
    const float* xg = p.ubuf + r * D_MODEL;
    const float* wg = p.w_sh_gate + (long)l * D_MODEL * SHARED_FF; const float* wu = p.w_sh_up + (long)l * D_MODEL * SHARED_FF;
    float g = 0.f, u = 0.f;
    for (int k = 0; k < D_MODEL; ++k) { float xv = xg[k]; g += xv * wg[(long)k * SHARED_FF + cidx]; u += xv * wu[(long)k * SHARED_FF + cidx]; }
    p.hsb[i] = siluf(g) * u;
  }
}
DEV void ph_expert_down(const P& p, int l, long gtid, long gsize) {
  FOR_ITEMS(i, (long)NR * D_MODEL) {
    int d = (int)(i % D_MODEL); long r = i / D_MODEL;
    float f = 0.f;
    for (int k = 0; k < TOP_K; ++k) {
      int e = p.top_e[r * TOP_K + k]; const float* wd = p.w_exp_down + ((long)l * N_EXPERTS + e) * EXPERT_FF * D_MODEL;
      const float* h = p.hbuf + (r * TOP_K + k) * EXPERT_FF; float acc = 0.f;
      for (int cidx = 0; cidx < EXPERT_FF; ++cidx) acc += h[cidx] * wd[(long)cidx * D_MODEL + d];
      f += acc * p.gate[r * TOP_K + k];
    }
    const float* wsd = p.w_sh_down + (long)l * SHARED_FF * D_MODEL; const float* hs = p.hsb + r * SHARED_FF;
    float acc = 0.f;
    for (int cidx = 0; cidx < SHARED_FF; ++cidx) acc += hs[cidx] * wsd[(long)cidx * D_MODEL + d];
    f += acc;
    const float* m = p.mod + ((long)l * (BATCH + 1) + modrow(r)) * 6 * D_MODEL + 5 * D_MODEL;
    p.tmp[i] = DN_ALPHA * p.xcur[i] + m[d] * f;
  }
}
#define NLP 15

#ifndef CPU_TEST
#define XB_TMO      128
#define XB_XCNT(j)  (256  + 64 * (j))
#define XB_XSUB(j)  (1280 + 64 * (j))
#define XB_XGEN(j)  (2304 + 64 * (j))
#define XB_TOP      3328
#define XB_TOPGEN   3392
#define XCD_BAR_WORDS 3456
#define XB_SPIN_CAP (1u << 18)
#define LAS __attribute__((address_space(3)))
__device__ __forceinline__ unsigned xb_ld(unsigned* p)              { return __hip_atomic_load(p, __ATOMIC_RELAXED, __HIP_MEMORY_SCOPE_AGENT); }
__device__ __forceinline__ unsigned xb_add(unsigned* p, unsigned v) { return __hip_atomic_fetch_add(p, v, __ATOMIC_RELAXED, __HIP_MEMORY_SCOPE_AGENT); }
__device__ __forceinline__ unsigned xb_xcc_id() { return (unsigned)__builtin_amdgcn_s_getreg((3 << 11) | 20) & 0xFu; }
#define XB_SPIN(cond, bar) do { unsigned _sp = 0; while (cond) { __builtin_amdgcn_s_sleep(1); \
    if ((++_sp & 255u) == 0u) { if (xb_ld(&(bar)[XB_TMO])) break; if (_sp > XB_SPIN_CAP) { atomicAdd(&(bar)[XB_TMO], 1u); break; } } } } while (0)
struct XcdBarrier { unsigned* bar; unsigned x; volatile LAS unsigned* st; };
__device__ __forceinline__ XcdBarrier xcd_barrier_post(unsigned* bar, volatile LAS unsigned* st) {
    XcdBarrier b; b.bar = bar; b.x = xb_xcc_id(); b.st = st;
    if (threadIdx.x == 0) (void)xb_add(&bar[XB_XCNT(b.x)], 1u);
    return b;
}
__device__ __forceinline__ void xcd_barrier_complete(unsigned* bar, unsigned x, unsigned& nloc, unsigned& nx) {
    const unsigned G = gridDim.x * gridDim.y * gridDim.z;
    unsigned sum, cnt, mine, sp = 0u;
    for (;;) {
        sum = 0u; cnt = 0u; mine = 0u;
#pragma unroll
        for (unsigned j = 0; j < 16; ++j) { const unsigned c = xb_ld(&bar[XB_XCNT(j)]); sum += c; cnt += (c > 0u) ? 1u : 0u; mine = (j == x) ? c : mine; }
        if (sum == G) break;
        __builtin_amdgcn_s_sleep(1);
        if ((++sp & 255u) == 0u) { if (xb_ld(&bar[XB_TMO])) break; if (sp > XB_SPIN_CAP) { atomicAdd(&bar[XB_TMO], 1u); break; } }
    }
    nloc = mine > 0u ? mine : 1u; nx = cnt > 0u ? cnt : 1u;
}
__device__ __forceinline__ void xcd_barrier(const XcdBarrier& b) {
    asm volatile("s_waitcnt vmcnt(0)" ::: "memory");
    __syncthreads();
    if (threadIdx.x == 0) {
        unsigned* bar = b.bar;
        __builtin_amdgcn_s_waitcnt(0);
        unsigned nloc = b.st[0], nx = b.st[1];
        if (nloc == 0u) { xcd_barrier_complete(bar, b.x, nloc, nx); b.st[0] = nloc; b.st[1] = nx; }
        const unsigned old = xb_add(&bar[XB_XSUB(b.x)], 1u);
        const unsigned gen = old / nloc;
        if (old + 1u == (gen + 1u) * nloc) {
            __builtin_amdgcn_fence(__ATOMIC_RELEASE, "agent");
            asm volatile("s_waitcnt vmcnt(0)" ::: "memory");
            const unsigned og = xb_add(&bar[XB_TOP], 1u);
            const unsigned tg = og / nx;
            if (og + 1u == (tg + 1u) * nx) xb_add(&bar[XB_TOPGEN], 1u);
            else XB_SPIN(xb_ld(&bar[XB_TOPGEN]) == tg, bar);
            __builtin_amdgcn_fence(__ATOMIC_ACQUIRE, "agent");
            xb_add(&bar[XB_XGEN(b.x)], 1u);
            asm volatile("s_waitcnt vmcnt(0)" ::: "memory");
        } else {
            XB_SPIN(xb_ld(&bar[XB_XGEN(b.x)]) == gen, bar);
            __builtin_amdgcn_fence(__ATOMIC_ACQUIRE, "agent");
            asm volatile("s_waitcnt vmcnt(0)" ::: "memory");
        }
    }
    __syncthreads();
}
#define GRID_SYNC() xcd_barrier(xb)
#else
#define GRID_SYNC() do {} while (0)
#endif

#define PHASE(stmt) do { if (SINGLE || ph == only) { stmt; } if (SINGLE) { GRID_SYNC(); } ++ph; } while (0)
#ifndef CPU_TEST
template <bool SINGLE> __device__ __forceinline__ void run_seq(const P& p, long gtid, long gsize, int only, const XcdBarrier& xb)
#else
template <bool SINGLE> static int run_seq(const P& p, long gtid, long gsize, int only)
#endif
{
  int ph = 0;
  PHASE(ph_g0(p, gtid, gsize));
  PHASE(ph_g1(p, gtid, gsize));
  PHASE(ph_g2(p, gtid, gsize));
  PHASE(ph_g3(p, gtid, gsize));
  PHASE(ph_g4(p, gtid, gsize));
  for (int l = 0; l < DEPTH; ++l) {
    PHASE(ph_modu(p, l, 0, gtid, gsize));
    PHASE(ph_proj(p, l, gtid, gsize));
    PHASE(ph_post_proj(p, l, gtid, gsize));
    PHASE(ph_mix(p, l, gtid, gsize));
    PHASE(ph_s5out(p, l, gtid, gsize));
    PHASE(ph_glu(p, l, gtid, gsize));
    PHASE(ph_rms(p, l, gtid, gsize));
    PHASE(ph_outproj(p, l, gtid, gsize));
    PHASE(ph_ln(p, l, 0, gtid, gsize));
    PHASE(ph_router(p, l, gtid, gsize));
    PHASE(ph_select(p, l, gtid, gsize));
    PHASE(ph_sortrows(p, l, gtid, gsize));
    PHASE(ph_expert_up(p, l, gtid, gsize));
    PHASE(ph_expert_down(p, l, gtid, gsize));
    PHASE(ph_ln(p, l, 1, gtid, gsize));
  }
#ifdef CPU_TEST
  return ph;
#endif
}

struct Carver { char* base; size_t off; template <class T> T* take(size_t n) { T* r = (T*)(base + off); off += ((n * sizeof(T) + 255) / 256) * 256; return r; } };
static void carve(P& p, void* ws) {
  Carver c{(char*)ws, 0};
  p.bar = c.take<unsigned>(4096);
  p.cnt = c.take<int>(DEPTH * N_EXPERTS);
  p.mod = c.take<float>((size_t)DEPTH * (BATCH + 1) * 6 * D_MODEL);
  p.xcur = c.take<float>((size_t)NR * D_MODEL);
  p.ubuf = c.take<float>((size_t)NR * D_MODEL);
  p.proj = c.take<float>((size_t)NR * IN_W);
  p.hu = c.take<float>((size_t)NR * HYENA_W);
  p.hx0 = c.take<float>((size_t)NR * HYENA_W);
  p.fh1 = c.take<float>((size_t)DEPTH * SEQ * FILTER_HIDDEN);
  p.fh2 = c.take<float>((size_t)DEPTH * SEQ * FILTER_HIDDEN);
  p.kraw = c.take<float>((size_t)DEPTH * SEQ * 2 * HYENA_W);
  p.knorm = c.take<float>((size_t)DEPTH * HYENA_W);
  p.fh1c = c.take<float>((size_t)CTX_LEN * FILTER_HIDDEN);
  p.fh2c = c.take<float>((size_t)CTX_LEN * FILTER_HIDDEN);
  p.krawc = c.take<float>((size_t)CTX_LEN * 2 * HYENA_W);
  p.knormc = c.take<float>((size_t)HYENA_W);
  p.mixb = c.take<float>((size_t)NR * MIX_W);
  p.tmp = c.take<float>((size_t)NR * D_MODEL);
  p.lampow = c.take<float2>((size_t)DEPTH * 2 * S5_GROUPS * (S5_T + 1) * S5_STATE);
  p.bbar = c.take<float2>((size_t)DEPTH * 2 * S5_GROUPS * S5_STATE * S5_GROUP);
  p.kc = c.take<float>((size_t)DEPTH * 2 * S5_GROUPS * S5_T * S5_GROUP * S5_GROUP);
  p.sc = c.take<float2>((size_t)BATCH * 2 * S5_GROUPS * NCH * S5_STATE);
  p.hc = c.take<float2>((size_t)BATCH * 2 * S5_GROUPS * NCH * S5_STATE);
  p.ybuf = c.take<float>((size_t)NR * S5_W);
  p.rl = c.take<float>((size_t)NR * N_EXPERTS);
  p.top_e = c.take<int>((size_t)NR * TOP_K);
  p.gate = c.take<float>((size_t)NR * TOP_K);
  p.posb = c.take<int>((size_t)NR * TOP_K);
  p.srow = c.take<int>((size_t)NR * TOP_K);
  p.hbuf = c.take<float>((size_t)NR * TOP_K * EXPERT_FF);
  p.hsb = c.take<float>((size_t)NR * SHARED_FF);
}
static void set_inputs(P& p, void* const* d_in) {
  const float** f = (const float**)&p.x;
  for (int i = 0; i < 40; ++i) f[i] = (const float*)d_in[i];
}

#ifndef CPU_TEST
#ifndef MK_SINGLE
#define MK_SINGLE 1
#endif
__global__ void __launch_bounds__(256, 2) mk_single(P p) {
  __shared__ uint4 xb_words;
  if (threadIdx.x == 0) xb_words = make_uint4(0u, 0u, 0u, 0u);
  __syncthreads();
  XcdBarrier xb = xcd_barrier_post(p.bar, (volatile LAS unsigned*)&xb_words);
  run_seq<true>(p, (long)blockIdx.x * blockDim.x + threadIdx.x, (long)gridDim.x * blockDim.x, -1, xb);
}
__global__ void __launch_bounds__(256, 2) mk_phase(P p, int only) {
  XcdBarrier xb; xb.bar = p.bar; xb.x = 0; xb.st = nullptr;
  run_seq<false>(p, (long)blockIdx.x * blockDim.x + threadIdx.x, (long)gridDim.x * blockDim.x, only, xb);
}
extern "C" void kernel_launch(void* const* d_in, const int* in_sizes, int n_in, void* d_out, int out_size, void* d_ws, size_t ws_size, hipStream_t stream) {
  P p; memset(&p, 0, sizeof(p));
  set_inputs(p, d_in); p.out = (float*)d_out; carve(p, d_ws);
  (void)hipMemsetAsync(p.bar, 0, 4096 * sizeof(unsigned) + ((DEPTH * N_EXPERTS * sizeof(int) + 255) / 256) * 256, stream);
#if MK_SINGLE
  static int grid = 0;
  if (!grid) {
    int dev = 0, cus = 0, per_cu = 0; hipGetDevice(&dev);
    hipDeviceGetAttribute(&cus, hipDeviceAttributeMultiprocessorCount, dev);
    hipOccupancyMaxActiveBlocksPerMultiprocessor(&per_cu, mk_single, 256, 0);
    grid = cus * (per_cu < 2 ? per_cu : 2);
  }
  mk_single<<<grid, 256, 0, stream>>>(p);
#else
  for (int ph = 0; ph < NG + DEPTH * NLP; ++ph) mk_phase<<<2048, 256, 0, stream>>>(p, ph);
#endif
}
#endif
```

```cpp
#ifndef CPU_TEST
#include <hip/hip_runtime.h>
#include <cstring>
#define DEV __device__ __forceinline__
#define DEVM __device__ __forceinline__
#else
#include <cmath>
#include <cstdio>
#include <cstdlib>
#include <cstring>
#define DEV static inline
#define DEVM inline
struct float2 { float x, y; };
static inline float2 make_float2(float a, float b) { float2 r; r.x = a; r.y = b; return r; }
static inline int atomicAdd(int* p, int v) { int o = *p; *p += v; return o; }
#endif

#ifdef SMALL_CFG
#define D_MODEL 64
#define BATCH 2
#define SEQ 256
#define GRID_W 16
#define CTX_LEN 32
#define HEAD_DIM 16
#define N_Q_HEADS 4
#define N_KV_HEADS 2
#define HYENA_W 16
#define S5_W 32
#define WINDOW 32
#define FILTER_HIDDEN 16
#define S5_STATE 8
#define N_EXPERTS 32
#define TOP_K 4
#define EXPERT_FF 16
#define SHARED_FF 16
#define S5_T 32
#else
#define D_MODEL 1024
#define BATCH 2
#define SEQ 8192
#define GRID_W 64
#define CTX_LEN 256
#define HEAD_DIM 64
#define N_Q_HEADS 8
#define N_KV_HEADS 2
#define HYENA_W 256
#define S5_W 256
#define WINDOW 128
#define FILTER_HIDDEN 64
#define S5_STATE 64
#define N_EXPERTS 256
#define TOP_K 8
#define EXPERT_FF 256
#define SHARED_FF 256
#define S5_T 64
#endif
#define DEPTH 2
#define FILTER_EMB 33
#define N_EXPERT_GROUPS 8
#define TOPK_GROUPS 4
#define S5_GROUP 16
#define Q_GROUP (N_Q_HEADS / N_KV_HEADS)
#define ATTN_W (N_Q_HEADS * HEAD_DIM)
#define KV_W (N_KV_HEADS * HEAD_DIM)
#define MIX_W (ATTN_W + HYENA_W + S5_W)
#define Q_OFF 0
#define K_OFF ATTN_W
#define V_OFF (K_OFF + KV_W)
#define HY_OFF (V_OFF + KV_W)
#define S5_OFF (HY_OFF + 3 * HYENA_W)
#define IN_W (S5_OFF + S5_W)
#define AXIS_DIM (HEAD_DIM / 2)
#define ROPE_HALF (AXIS_DIM / 2)
#define S5_GROUPS (S5_W / S5_GROUP)
#define EPG (N_EXPERTS / N_EXPERT_GROUPS)
#define NL (BATCH * SEQ)
#define NC (BATCH * CTX_LEN)
#define NR (NL + NC)
#define NSEQ (CTX_LEN + SEQ)
#define NCH (NSEQ / S5_T)
#define LN_EPS 1e-5f
#define DN_ALPHA 1.4142135623730951f
#define ROUTED_SCALE 2.5f
#define PI_D 3.14159265358979323846

struct P {
  const float *x, *c, *ctx, *c_ctx, *w_ada, *b_ada, *w_in, *w_out, *sink, *mix_g, *hy_short_w, *hy_short_b, *hy_w1,
      *hy_b1, *hy_freq, *hy_w2, *hy_b2, *hy_w3, *hy_d, *s5_a_re, *s5_a_im, *s5_log_dt, *s5_b_re, *s5_b_im, *s5_c_re,
      *s5_c_im, *s5_d, *s5_w_glu, *ln1_g, *ln1_b, *ln2_g, *ln2_b, *w_router, *router_bias, *w_exp_gate, *w_exp_up,
      *w_exp_down, *w_sh_gate, *w_sh_up, *w_sh_down;
  float* out;
  unsigned* bar;
  int* cnt;
  float *mod;
  float *xcur;
  float *ubuf;
  float *proj;
  float *hu, *hx0;
  float *fh1, *fh2;
  float *kraw;
  float *knorm;
  float *fh1c, *fh2c;
  float *krawc;
  float *knormc;
  float *mixb;
  float *tmp;
  float2 *lampow;
  float2 *bbar;
  float *kc;
  float2 *sc, *hc;
  float *ybuf;
  float *rl;
  int *top_e;
  float *gate;
  int *posb;
  int *srow;
  float *hbuf;
  float *hsb;
  float *yk;
  unsigned short *ubf;
  unsigned short *ybf;
  unsigned short *mixbf;
  unsigned short *hbf;
  unsigned short *hsbf;
  float *ysh;
};

#define FOR_ITEMS(i, N) for (long i = gtid; i < (long)(N); i += gsize)

DEV unsigned short f2bf16(float f) { unsigned u; memcpy(&u, &f, 4); return (unsigned short)((u + 0x7fffu + ((u >> 16) & 1u)) >> 16); }
DEV float siluf(float x) { return x / (1.0f + expf(-x)); }
DEV float sigmoidf_(float x) { return 1.0f / (1.0f + expf(-x)); }
DEV float gelu_tanhf(float x) { return 0.5f * x * (1.0f + tanhf(0.7978845608028654f * (x + 0.044715f * x * x * x))); }
DEV int modrow(long r) { return r < NL ? (int)(r / SEQ) : BATCH; }

DEV void ph_g0(const P& p, long gtid, long gsize) {
  FOR_ITEMS(i, (long)NR * D_MODEL) p.xcur[i] = i < (long)NL * D_MODEL ? p.x[i] : p.ctx[i - (long)NL * D_MODEL];
  FOR_ITEMS(i, DEPTH * (BATCH + 1) * 6 * D_MODEL) {
    int n = (int)(i % (6 * D_MODEL)); int j = (int)((i / (6 * D_MODEL)) % (BATCH + 1)); int l = (int)(i / (6 * D_MODEL * (BATCH + 1)));
    const float* cv = j < BATCH ? p.c + j * D_MODEL : p.c_ctx;
    const float* w = p.w_ada + (long)l * D_MODEL * 6 * D_MODEL;
    float acc = p.b_ada[l * 6 * D_MODEL + n];
    for (int k = 0; k < D_MODEL; ++k) acc += siluf(cv[k]) * w[(long)k * 6 * D_MODEL + n];
    p.mod[i] = acc;
  }
  FOR_ITEMS(i, DEPTH * 2 * S5_GROUPS * S5_STATE) {
    int pp = (int)(i % S5_STATE); int g = (int)((i / S5_STATE) % S5_GROUPS); int ld = (int)(i / (S5_STATE * S5_GROUPS));
    float are = fminf(p.s5_a_re[i], -1e-4f), aim = p.s5_a_im[i];
    float dt = expf(p.s5_log_dt[ld * S5_GROUPS + g]);
    for (int d = 0; d <= S5_T; ++d) {
      float mag = expf(are * dt * d); float ang = aim * dt * d;
      p.lampow[((long)(ld * S5_GROUPS + g) * (S5_T + 1) + d) * S5_STATE + pp] = make_float2(mag * cosf(ang), mag * sinf(ang));
    }
    float mag = expf(are * dt), ang = aim * dt;
    float lr = mag * cosf(ang) - 1.0f, li = mag * sinf(ang);
    float den = are * are + aim * aim;
    float fr = (lr * are + li * aim) / den, fi = (li * are - lr * aim) / den;
    for (int j = 0; j < S5_GROUP; ++j) {
      float br = p.s5_b_re[i * S5_GROUP + j], bi = p.s5_b_im[i * S5_GROUP + j];
      p.bbar[i * S5_GROUP + j] = make_float2(fr * br - fi * bi, fr * bi + fi * br);
    }
  }
}
DEV void hy_f1(const P& p, int l, int Lf, float* h1, long gtid, long gsize) {
  FOR_ITEMS(i, (long)Lf * FILTER_HIDDEN) {
    int j = (int)(i % FILTER_HIDDEN); int t = (int)(i / FILTER_HIDDEN);
    const float* w1 = p.hy_w1 + l * FILTER_EMB * FILTER_HIDDEN;
    float tt = (float)((double)t / (double)(Lf - 1));
    float w = (float)(2.0 * PI_D * (double)t / (double)Lf);
    float acc = p.hy_b1[l * FILTER_HIDDEN + j] + tt * w1[j];
    const int bands = (FILTER_EMB - 1) / 2;
    for (int m = 0; m < bands; ++m) {
      float f = (float)(1e-4 + (double)m * ((double)(bands - 1) - 1e-4) / (double)(bands - 1));
      float a = f * w;
      acc += cosf(a) * w1[(1 + m) * FILTER_HIDDEN + j] - sinf(a) * w1[(1 + bands + m) * FILTER_HIDDEN + j];
    }
    h1[i] = sinf(p.hy_freq[l * FILTER_HIDDEN + j] * acc);
  }
}
DEV void hy_f2(const P& p, int l, int Lf, const float* h1, float* h2, long gtid, long gsize) {
  FOR_ITEMS(i, (long)Lf * FILTER_HIDDEN) {
    int j = (int)(i % FILTER_HIDDEN); int t = (int)(i / FILTER_HIDDEN);
    const float* w2 = p.hy_w2 + l * FILTER_HIDDEN * FILTER_HIDDEN;
    float acc = p.hy_b2[l * FILTER_HIDDEN + j];
    for (int k = 0; k < FILTER_HIDDEN; ++k) acc += h1[t * FILTER_HIDDEN + k] * w2[k * FILTER_HIDDEN + j];
    h2[i] = sinf(p.hy_freq[l * FILTER_HIDDEN + j] * acc);
  }
}
DEV void hy_f3(const P& p, int l, int Lf, const float* h2, float* kraw, long gtid, long gsize) {
  FOR_ITEMS(i, (long)Lf * 2 * HYENA_W) {
    int cc = (int)(i % (2 * HYENA_W)); int t = (int)(i / (2 * HYENA_W)); int ch = cc % HYENA_W;
    const float* w3 = p.hy_w3 + l * FILTER_HIDDEN * 2 * HYENA_W;
    float acc = 0.f;
    for (int k = 0; k < FILTER_HIDDEN; ++k) acc += h2[t * FILTER_HIDDEN + k] * w3[k * 2 * HYENA_W + cc];
    double d0 = log(1e-2) / 0.3, d1 = log(1e-2) / 1.5;
    float delta = fabsf((float)(d0 + (d1 - d0) * (double)ch / (double)(HYENA_W - 1)));
    float tt = (float)((double)t / (double)(Lf - 1));
    kraw[(long)cc * Lf + t] = acc * expf(-tt * delta);
  }
}
DEV void hy_f4(int Lf, const float* kraw, float* knorm, long gtid, long gsize) {
  FOR_ITEMS(i, HYENA_W) {
    float s = 0.f;
    for (int t = 0; t < Lf; ++t) {
      s += fabsf(kraw[(long)i * Lf + t]);
      if (t > 0) s += fabsf(kraw[(long)(HYENA_W + i) * Lf + t]);
    }
    knorm[i] = 1.0f / s;
  }
}
DEV void ph_g1(const P& p, long gtid, long gsize) {
  for (int l = 0; l < DEPTH; ++l) hy_f1(p, l, SEQ, p.fh1 + (long)l * SEQ * FILTER_HIDDEN, gtid, gsize);
  hy_f1(p, 0, CTX_LEN, p.fh1c, gtid, gsize);
  FOR_ITEMS(i, (long)DEPTH * 2 * S5_GROUPS * S5_T * S5_GROUP * S5_GROUP) {
    int j = (int)(i % S5_GROUP); int ii = (int)((i / S5_GROUP) % S5_GROUP); int d = (int)((i / (S5_GROUP * S5_GROUP)) % S5_T);
    long ldg = i / (S5_GROUP * S5_GROUP * S5_T);
    float acc = 0.f;
    for (int pp = 0; pp < S5_STATE; ++pp) {
      float cr = p.s5_c_re[(ldg * S5_GROUP + ii) * S5_STATE + pp], ci = p.s5_c_im[(ldg * S5_GROUP + ii) * S5_STATE + pp];
      float2 lp = p.lampow[(ldg * (S5_T + 1) + d) * S5_STATE + pp];
      float2 bb = p.bbar[(ldg * S5_STATE + pp) * S5_GROUP + j];
      float tr = lp.x * bb.x - lp.y * bb.y, ti = lp.x * bb.y + lp.y * bb.x;
      acc += cr * tr - ci * ti;
    }
    p.kc[i] = acc;
  }
}
DEV void ph_g2(const P& p, long gtid, long gsize) {
  for (int l = 0; l < DEPTH; ++l) hy_f2(p, l, SEQ, p.fh1 + (long)l * SEQ * FILTER_HIDDEN, p.fh2 + (long)l * SEQ * FILTER_HIDDEN, gtid, gsize);
  hy_f2(p, 0, CTX_LEN, p.fh1c, p.fh2c, gtid, gsize);
}
DEV void ph_g3(const P& p, long gtid, long gsize) {
  for (int l = 0; l < DEPTH; ++l) hy_f3(p, l, SEQ, p.fh2 + (long)l * SEQ * FILTER_HIDDEN, p.kraw + (long)l * SEQ * 2 * HYENA_W, gtid, gsize);
  hy_f3(p, 0, CTX_LEN, p.fh2c, p.krawc, gtid, gsize);
}
DEV void ph_g4(const P& p, long gtid, long gsize) {
  for (int l = 0; l < DEPTH; ++l) hy_f4(SEQ, p.kraw + (long)l * SEQ * 2 * HYENA_W, p.knorm + l * HYENA_W, gtid, gsize);
  hy_f4(CTX_LEN, p.krawc, p.knormc, gtid, gsize);
}
#define NG 5

DEV void ph_modu(const P& p, int l, int which, long gtid, long gsize) {
  FOR_ITEMS(i, (long)NR * D_MODEL) {
    int k = (int)(i % D_MODEL); long r = i / D_MODEL;
    const float* m = p.mod + ((long)l * (BATCH + 1) + modrow(r)) * 6 * D_MODEL + which * 3 * D_MODEL;
    float uv = p.xcur[i] * (1.0f + m[D_MODEL + k]) + m[k];
    p.ubuf[i] = uv; p.ubf[i] = f2bf16(uv);
  }
}
template <class Epi>
DEV void gemm_naive(const float* A, int lda, const float* B, int ldb, int M, int N, int K, Epi epi, long gtid, long gsize) {
  FOR_ITEMS(i, (long)(M / 4) * N) {
    int n = (int)(i % N); long r0 = (i / N) * 4;
    const float* a0 = A + r0 * lda;
    float c0 = 0.f, c1 = 0.f, c2 = 0.f, c3 = 0.f;
    for (int k = 0; k < K; ++k) {
      float b = B[(long)k * ldb + n];
      c0 += a0[k] * b; c1 += a0[lda + k] * b; c2 += a0[2 * lda + k] * b; c3 += a0[3 * lda + k] * b;
    }
    epi(r0, n, c0); epi(r0 + 1, n, c1); epi(r0 + 2, n, c2); epi(r0 + 3, n, c3);
  }
}
struct EpiStore { float* C; int ldc; DEVM void operator()(long r, int n, float v) const { C[r * ldc + n] = v; } };
DEV void ph_proj(const P& p, int l, long gtid, long gsize) {
  EpiStore e{p.proj, IN_W};
  gemm_naive(p.ubuf, D_MODEL, p.w_in + (long)l * D_MODEL * IN_W, IN_W, NR, IN_W, D_MODEL, e, gtid, gsize);
}
DEV long s5_row(int b, int dir, int n) {
  if (n < CTX_LEN) return (long)NL + b * CTX_LEN + (dir ? CTX_LEN - 1 - n : n);
  int t = n - CTX_LEN; return (long)b * SEQ + (dir ? SEQ - 1 - t : t);
}
DEV void ph_post_proj(const P& p, int l, long gtid, long gsize) {
  FOR_ITEMS(i, (long)NL * (N_Q_HEADS + N_KV_HEADS) * 2 * ROPE_HALF) {
    int ii = (int)(i % ROPE_HALF); int a = (int)((i / ROPE_HALF) % 2); int hs = (int)((i / (2 * ROPE_HALF)) % (N_Q_HEADS + N_KV_HEADS));
    long r = i / (2 * ROPE_HALF * (N_Q_HEADS + N_KV_HEADS));
    int t = (int)(r % SEQ); int pos = a == 0 ? t / GRID_W : t % GRID_W;
    float inv = powf(10000.0f, -(float)(2 * ii) / (float)AXIS_DIM);
    float ang = (float)pos * inv; float cs = cosf(ang), sn = sinf(ang);
    float* q = p.proj + r * IN_W + hs * HEAD_DIM + a * AXIS_DIM + ii;
    float x1 = q[0], x2 = q[ROPE_HALF];
    q[0] = x1 * cs - x2 * sn; q[ROPE_HALF] = x1 * sn + x2 * cs;
  }
  FOR_ITEMS(i, (long)NR * HYENA_W) {
    int ch = (int)(i % HYENA_W); long r = i / HYENA_W;
    int Ls = r < NL ? SEQ : CTX_LEN; long base = r < NL ? (r / SEQ) * SEQ : NL + ((r - NL) / CTX_LEN) * CTX_LEN; int t = (int)(r - base);
    const float* sw = p.hy_short_w + l * 3 * 3 * HYENA_W; const float* sb = p.hy_short_b + l * 3 * HYENA_W;
    float z[3];
#pragma unroll
    for (int part = 0; part < 3; ++part) {
      int cc = part * HYENA_W + ch; float acc = sb[cc];
#pragma unroll
      for (int j = 0; j < 3; ++j) { int tt = t + j - 1; if (tt >= 0 && tt < Ls) acc += p.proj[(base + tt) * IN_W + HY_OFF + cc] * sw[j * 3 * HYENA_W + cc]; }
      z[part] = acc;
    }
    long o = r < NL ? ((r / SEQ) * HYENA_W + ch) * SEQ + t : i;
    p.hu[o] = z[0] * z[1]; p.hx0[o] = z[2];
  }
  FOR_ITEMS(i, (long)BATCH * 2 * S5_GROUPS * NCH * S5_STATE) {
    int pp = (int)(i % S5_STATE); int c = (int)((i / S5_STATE) % NCH); int g = (int)((i / (S5_STATE * NCH)) % S5_GROUPS);
    int dir = (int)((i / (S5_STATE * NCH * S5_GROUPS)) % 2); int b = (int)(i / (S5_STATE * NCH * S5_GROUPS * 2));
    long ldg = ((long)l * 2 + dir) * S5_GROUPS + g;
    float sr = 0.f, si = 0.f;
    for (int s = 0; s < S5_T; ++s) {
      const float* u = p.proj + s5_row(b, dir, c * S5_T + s) * IN_W + S5_OFF + g * S5_GROUP;
      float br = 0.f, bi = 0.f;
#pragma unroll
      for (int j = 0; j < S5_GROUP; ++j) { float2 bb = p.bbar[(ldg * S5_STATE + pp) * S5_GROUP + j]; br += bb.x * u[j]; bi += bb.y * u[j]; }
      float2 lp = p.lampow[(ldg * (S5_T + 1) + (S5_T - 1 - s)) * S5_STATE + pp];
      sr += lp.x * br - lp.y * bi; si += lp.x * bi + lp.y * br;
    }
    p.sc[i] = make_float2(sr, si);
  }
}
DEV void attn_item(const P& p, int l, long r, int h, float* outp) {
  const float scale = 1.0f / sqrtf((float)HEAD_DIM);
  float q[HEAD_DIM], acc[HEAD_DIM];
  const float* qp = p.proj + r * IN_W + Q_OFF + h * HEAD_DIM;
#pragma unroll
  for (int d = 0; d < HEAD_DIM; ++d) { q[d] = qp[d] * scale; acc[d] = 0.f; }
  int kvh = h / Q_GROUP; int b = r < NL ? (int)(r / SEQ) : (int)((r - NL) / CTX_LEN);
  float m = -1e30f, lsum = 0.f;
  int nwin = 0, t = 0;
  if (r < NL) { t = (int)(r % SEQ); nwin = 2 * WINDOW + 1; }
  for (int j = 0; j < nwin + CTX_LEN; ++j) {
    long kr;
    if (j < nwin) { int tk = t - WINDOW + j; if (tk < 0 || tk >= SEQ) continue; kr = (long)b * SEQ + tk; }
    else kr = (long)NL + b * CTX_LEN + (j - nwin);
    const float* kp = p.proj + kr * IN_W + K_OFF + kvh * HEAD_DIM; const float* vp = p.proj + kr * IN_W + V_OFF + kvh * HEAD_DIM;
    float s = 0.f;
#pragma unroll
    for (int d = 0; d < HEAD_DIM; ++d) s += q[d] * kp[d];
    float mn = fmaxf(m, s); float corr = expf(m - mn); float pe = expf(s - mn);
    lsum = lsum * corr + pe;
#pragma unroll
    for (int d = 0; d < HEAD_DIM; ++d) acc[d] = acc[d] * corr + pe * vp[d];
    m = mn;
  }
  float sk = p.sink[l * N_Q_HEADS + h]; float mf = fmaxf(m, sk); float corr = expf(m - mf);
  float den = lsum * corr + expf(sk - mf); float sc2 = corr / den;
#pragma unroll
  for (int d = 0; d < HEAD_DIM; ++d) outp[d] = acc[d] * sc2;
}
DEV void ph_mix(const P& p, int l, long gtid, long gsize) {
  long nrows_att = l == 0 ? NR : NL;
  FOR_ITEMS(i, nrows_att * N_Q_HEADS) { int h = (int)(i % N_Q_HEADS); long r = i / N_Q_HEADS; attn_item(p, l, r, h, p.mixb + r * MIX_W + h * HEAD_DIM); }
#ifdef CPU_TEST
  FOR_ITEMS(i, (long)NL * HYENA_W) {
    int ch = (int)(i % HYENA_W); long r = i / HYENA_W; int t = (int)(r % SEQ); int b = (int)(r / SEQ);
    const float* kf = p.kraw + ((long)l * 2 * HYENA_W + ch) * SEQ; const float* kb = p.kraw + ((long)l * 2 * HYENA_W + HYENA_W + ch) * SEQ;
    const float* uu = p.hu + ((long)b * HYENA_W + ch) * SEQ;
    float acc = 0.f;
    for (int s = 0; s <= t; ++s) acc += kf[t - s] * uu[s];
    for (int s = t + 1; s < SEQ; ++s) acc += kb[s - t] * uu[s];
    p.mixb[r * MIX_W + ATTN_W + ch] = (acc * p.knorm[l * HYENA_W + ch] + uu[t] * p.hy_d[l * HYENA_W + ch]) * p.hx0[((long)b * HYENA_W + ch) * SEQ + t];
  }
#endif
  if (l == 0) {
    FOR_ITEMS(i, (long)NC * HYENA_W) {
      int ch = (int)(i % HYENA_W); long r = NL + i / HYENA_W; int t = (int)((r - NL) % CTX_LEN); long base = r - t;
      float acc = 0.f;
      for (int s = 0; s <= t; ++s) acc += p.krawc[(long)ch * CTX_LEN + (t - s)] * p.hu[(base + s) * HYENA_W + ch];
      for (int s = t + 1; s < CTX_LEN; ++s) acc += p.krawc[(long)(HYENA_W + ch) * CTX_LEN + (s - t)] * p.hu[(base + s) * HYENA_W + ch];
      float u = p.hu[r * HYENA_W + ch];
      p.mixb[r * MIX_W + ATTN_W + ch] = (acc * p.knormc[ch] + u * p.hy_d[l * HYENA_W + ch]) * p.hx0[r * HYENA_W + ch];
    }
  }
  FOR_ITEMS(i, (long)BATCH * 2 * S5_GROUPS * S5_STATE) {
    int pp = (int)(i % S5_STATE); int g = (int)((i / S5_STATE) % S5_GROUPS); int dir = (int)((i / (S5_STATE * S5_GROUPS)) % 2); int b = (int)(i / (S5_STATE * S5_GROUPS * 2));
    long ldg = ((long)l * 2 + dir) * S5_GROUPS + g;
    float2 lt = p.lampow[(ldg * (S5_T + 1) + S5_T) * S5_STATE + pp];
    float hr = 0.f, hi = 0.f;
    long base = (((long)b * 2 + dir) * S5_GROUPS + g) * NCH;
    for (int c = 0; c < NCH; ++c) {
      p.hc[(base + c) * S5_STATE + pp] = make_float2(hr, hi);
      float2 s = p.sc[(base + c) * S5_STATE + pp];
      float nr = lt.x * hr - lt.y * hi + s.x, ni = lt.x * hi + lt.y * hr + s.y;
      hr = nr; hi = ni;
    }
  }
}
DEV void ph_s5out(const P& p, int l, long gtid, long gsize) {
  FOR_ITEMS(i, (long)NR * S5_W) {
    int chn = (int)(i % S5_W); long r = i / S5_W; int g = chn / S5_GROUP, ii = chn % S5_GROUP;
    int b, tl; bool isctx = r >= NL;
    if (isctx) { b = (int)((r - NL) / CTX_LEN); tl = (int)((r - NL) % CTX_LEN); } else { b = (int)(r / SEQ); tl = (int)(r % SEQ); }
    float y = p.s5_d[l * S5_W + chn] * p.proj[r * IN_W + S5_OFF + chn];
    for (int dir = 0; dir < 2; ++dir) {
      int n = isctx ? (dir ? CTX_LEN - 1 - tl : tl) : CTX_LEN + (dir ? SEQ - 1 - tl : tl);
      int c = n / S5_T, tau = n % S5_T;
      long ldg = ((long)l * 2 + dir) * S5_GROUPS + g;
      long hb = ((((long)b * 2 + dir) * S5_GROUPS + g) * NCH + c) * S5_STATE;
      for (int pp = 0; pp < S5_STATE; ++pp) {
        float cr = p.s5_c_re[(ldg * S5_GROUP + ii) * S5_STATE + pp], ci = p.s5_c_im[(ldg * S5_GROUP + ii) * S5_STATE + pp];
        float2 lp = p.lampow[(ldg * (S5_T + 1) + tau + 1) * S5_STATE + pp]; float2 h = p.hc[hb + pp];
        float tr = lp.x * h.x - lp.y * h.y, ti = lp.x * h.y + lp.y * h.x;
        y += cr * tr - ci * ti;
      }
      for (int s = 0; s <= tau; ++s) {
        const float* u = p.proj + s5_row(b, dir, c * S5_T + s) * IN_W + S5_OFF + g * S5_GROUP;
        const float* kk = p.kc + ((ldg * S5_T + (tau - s)) * S5_GROUP + ii) * S5_GROUP;
#pragma unroll
        for (int j = 0; j < S5_GROUP; ++j) y += kk[j] * u[j];
      }
    }
    float gy = gelu_tanhf(y); p.ybuf[i] = gy; p.ybf[i] = f2bf16(gy);
  }
}
struct EpiGlu { const float* g; float* mixb; DEVM void operator()(long r, int n, float v) const { mixb[r * MIX_W + ATTN_W + HYENA_W + n] = g[r * S5_W + n] * sigmoidf_(v); } };
DEV void ph_glu(const P& p, int l, long gtid, long gsize) {
  EpiGlu e{p.ybuf, p.mixb};
  gemm_naive(p.ybuf, S5_W, p.s5_w_glu + (long)l * S5_W * S5_W, S5_W, NR, S5_W, S5_W, e, gtid, gsize);
}
DEV void ph_rms(const P& p, int l, long gtid, long gsize) {
  FOR_ITEMS(i, (long)NR * 3) {
    int grp = (int)(i % 3); long r = i / 3;
    int off = grp == 0 ? 0 : (grp == 1 ? ATTN_W : ATTN_W + HYENA_W); int w = grp == 0 ? ATTN_W : (grp == 1 ? HYENA_W : S5_W);
    float* v = p.mixb + r * MIX_W + off; float ss = 0.f;
    for (int k = 0; k < w; ++k) ss += v[k] * v[k];
    float rs = 1.0f / sqrtf(ss / (float)w + LN_EPS);
    for (int k = 0; k < w; ++k) { float nv = v[k] * rs * p.mix_g[l * MIX_W + off + k]; v[k] = nv; p.mixbf[r * MIX_W + off + k] = f2bf16(nv); }
  }
}
struct EpiRes { const float* xcur; const float* mod; int l; int goff; float* tmp;
  DEVM void operator()(long r, int n, float v) const { const float* m = mod + ((long)l * (BATCH + 1) + modrow(r)) * 6 * D_MODEL + goff; tmp[r * D_MODEL + n] = DN_ALPHA * xcur[r * D_MODEL + n] + m[n] * v; } };
DEV void ph_outproj(const P& p, int l, long gtid, long gsize) {
  EpiRes e{p.xcur, p.mod, l, 2 * D_MODEL, p.tmp};
  gemm_naive(p.mixb, MIX_W, p.w_out + (long)l * MIX_W * D_MODEL, D_MODEL, NR, D_MODEL, MIX_W, e, gtid, gsize);
}
DEV void ph_ln(const P& p, int l, int which, long gtid, long gsize) {
  const float* gw = (which == 0 ? p.ln1_g : p.ln2_g) + l * D_MODEL; const float* bw = (which == 0 ? p.ln1_b : p.ln2_b) + l * D_MODEL;
  FOR_ITEMS(r, (long)NR) {
    const float* v = p.tmp + r * D_MODEL; float mu = 0.f;
#pragma unroll 4
    for (int k = 0; k < D_MODEL; ++k) mu += v[k];
    mu /= (float)D_MODEL; float var = 0.f;
#pragma unroll 4
    for (int k = 0; k < D_MODEL; ++k) { float d = v[k] - mu; var += d * d; }
    float rs = 1.0f / sqrtf(var / (float)D_MODEL + LN_EPS);
    const float* m = p.mod + ((long)l * (BATCH + 1) + modrow(r)) * 6 * D_MODEL + 3 * D_MODEL;
#pragma unroll 2
    for (int k = 0; k < D_MODEL; ++k) {
      float y = (v[k] - mu) * rs * gw[k] + bw[k];
      p.xcur[r * D_MODEL + k] = y;
      if (which == 0) { float uv = y * (1.0f + m[D_MODEL + k]) + m[k]; p.ubuf[r * D_MODEL + k] = uv; p.ubf[r * D_MODEL + k] = f2bf16(uv); }
      if (which == 1 && l == DEPTH - 1 && r < NL) p.out[r * D_MODEL + k] = y;
    }
  }
}
DEV void ph_router(const P& p, int l, long gtid, long gsize) {
  EpiStore e{p.rl, N_EXPERTS};
  gemm_naive(p.ubuf, D_MODEL, p.w_router + (long)l * D_MODEL * N_EXPERTS, N_EXPERTS, NR, N_EXPERTS, D_MODEL, e, gtid, gsize);
}
DEV bool better(float v, int i, float bv, int bi) { return v > bv || (v == bv && i < bi); }
DEV void ph_select(const P& p, int l, long gtid, long gsize) {
  FOR_ITEMS(r, (long)NR) {
    const float* lg = p.rl + r * N_EXPERTS; const float* rb = p.router_bias + l * N_EXPERTS;
    float gs[N_EXPERT_GROUPS];
#pragma unroll
    for (int g = 0; g < N_EXPERT_GROUPS; ++g) {
      float m1 = -1e30f, m2 = -1e30f;
      for (int e = 0; e < EPG; ++e) { float v = sigmoidf_(lg[g * EPG + e]) + rb[g * EPG + e]; if (v > m1) { m2 = m1; m1 = v; } else if (v > m2) m2 = v; }
      gs[g] = m1 + m2;
    }
    unsigned keep = 0;
#pragma unroll
    for (int it = 0; it < TOPK_GROUPS; ++it) {
      float bv = -1e30f; int bi = -1;
#pragma unroll
      for (int g = 0; g < N_EXPERT_GROUPS; ++g) if (!((keep >> g) & 1u) && (bi < 0 || gs[g] > bv)) { bv = gs[g]; bi = g; }
      keep |= 1u << bi;
    }
    float lastv = 1e30f; int lasti = -1; float gsum = 0.f;
    for (int it = 0; it < TOP_K; ++it) {
      float bv = -1e30f; int bi = -1;
      for (int e = 0; e < N_EXPERTS; ++e) {
        if (!((keep >> (e / EPG)) & 1u)) continue;
        float v = sigmoidf_(lg[e]) + rb[e];
        if (!better(lastv, lasti, v, e)) continue;
        if (bi < 0 || better(v, e, bv, bi)) { bv = v; bi = e; }
      }
      lastv = bv; lasti = bi;
      float sc = sigmoidf_(lg[bi]); gsum += sc;
      p.top_e[r * TOP_K + it] = bi; p.gate[r * TOP_K + it] = sc;
      p.posb[r * TOP_K + it] = atomicAdd(&p.cnt[l * N_EXPERTS + bi], 1);
    }
    float inv = ROUTED_SCALE / gsum;
    for (int it = 0; it < TOP_K; ++it) p.gate[r * TOP_K + it] *= inv;
  }
}
DEV void ph_sortrows(const P& p, int l, long gtid, long gsize) {
  FOR_ITEMS(i, (long)NR * TOP_K) {
    int e = p.top_e[i]; int off = 0;
    for (int j = 0; j < e; ++j) off += p.cnt[l * N_EXPERTS + j];
    p.srow[off + p.posb[i]] = (int)i;
  }
}
DEV void ph_expert_up(const P& p, int l, long gtid, long gsize) {
  FOR_ITEMS(i, (long)NR * TOP_K * EXPERT_FF) {
    int cidx = (int)(i % EXPERT_FF); int a = p.srow[i / EXPERT_FF]; int e = p.top_e[a]; long r = a / TOP_K;
    const float* xg = p.ubuf + r * D_MODEL;
    const float* wg = p.w_exp_gate + ((long)l * N_EXPERTS + e) * D_MODEL * EXPERT_FF; const float* wu = p.w_exp_up + ((long)l * N_EXPERTS + e) * D_MODEL * EXPERT_FF;
    float g = 0.f, u = 0.f;
    for (int k = 0; k < D_MODEL; ++k) { float xv = xg[k]; g += xv * wg[(long)k * EXPERT_FF + cidx]; u += xv * wu[(long)k * EXPERT_FF + cidx]; }
    p.hbuf[(long)a * EXPERT_FF + cidx] = siluf(g) * u;
  }
  FOR_ITEMS(i, (long)NR * SHARED_FF) {
    int cidx = (int)(i % SHARED_FF); long r = i / SHARED_FF;
    const float* xg = p.ubuf + r * D_MODEL;
    const float* wg = p.w_sh_gate + (long)l * D_MODEL * SHARED_FF; const float* wu = p.w_sh_up + (long)l * D_MODEL * SHARED_FF;
    float g = 0.f, u = 0.f;
    for (int k = 0; k < D_MODEL; ++k) { float xv = xg[k]; g += xv * wg[(long)k * SHARED_FF + cidx]; u += xv * wu[(long)k * SHARED_FF + cidx]; }
    p.hsb[i] = siluf(g) * u;
  }
}
DEV void ph_expert_down(const P& p, int l, long gtid, long gsize) {
  FOR_ITEMS(i, (long)NR * TOP_K * D_MODEL) {
    int d = (int)(i % D_MODEL); long a = i / D_MODEL;
    int e = p.top_e[a]; const float* wd = p.w_exp_down + ((long)l * N_EXPERTS + e) * EXPERT_FF * D_MODEL;
    const float* h = p.hbuf + a * EXPERT_FF; float acc = 0.f;
    for (int cidx = 0; cidx < EXPERT_FF; ++cidx) acc += h[cidx] * wd[(long)cidx * D_MODEL + d];
    p.yk[i] = acc * p.gate[a];
  }
  FOR_ITEMS(i, (long)NR * D_MODEL) {
    int d = (int)(i % D_MODEL); long r = i / D_MODEL;
    const float* wsd = p.w_sh_down + (long)l * SHARED_FF * D_MODEL; const float* hs = p.hsb + r * SHARED_FF;
    float acc = 0.f;
    for (int cidx = 0; cidx < SHARED_FF; ++cidx) acc += hs[cidx] * wsd[(long)cidx * D_MODEL + d];
    p.ysh[i] = acc;
  }
}
DEV void ph_combine(const P& p, int l, long gtid, long gsize) {
#pragma unroll 1
  FOR_ITEMS(i, (long)NR * D_MODEL) {
    int d = (int)(i % D_MODEL); long r = i / D_MODEL;
    float f = p.ysh[i];
#pragma unroll
    for (int k = 0; k < TOP_K; ++k) f += p.yk[(r * TOP_K + k) * D_MODEL + d];
    const float* m = p.mod + ((long)l * (BATCH + 1) + modrow(r)) * 6 * D_MODEL + 5 * D_MODEL;
    p.tmp[i] = DN_ALPHA * p.xcur[i] + m[d] * f;
  }
}
#define NLP 16


#ifndef CPU_TEST
typedef __attribute__((ext_vector_type(8))) short bf16x8;
typedef __attribute__((ext_vector_type(4))) float f32x4;
typedef __attribute__((ext_vector_type(4))) unsigned u32x4;
static_assert(N_EXPERTS == 256 && D_MODEL % 128 == 0 && NR % 128 == 0, "shape assumptions");
#define SM_XB 0
#define SM_A 256
#define SM_B (256 + 16384)
#define SM_MISC (256 + 32768)
#define SMEM_BYTES (256 + 32768 + 2 * 8272 * 2)

DEV int otid() { int t = threadIdx.x; asm volatile("" : "+v"(t)); return t; }
DEV unsigned f2bf(float f) { unsigned u = __float_as_uint(f); return (u + 0x7fffu + ((u >> 16) & 1u)) >> 16; }
DEV unsigned pack2(float a, float b) { return f2bf(a) | (f2bf(b) << 16); }
DEV int tile_off(int row, int chunk) { return row * 128 + ((chunk ^ ((row >> 1) & 7)) << 4); }

DEV void gemm128(const unsigned short* const (&arow)[4], const float* bbase, int ldb, int K, f32x4 (&acc)[4][4], char* smem) {
  const int tid = otid(), lane = tid & 63, wid = tid >> 6, wr = wid >> 1, wc = wid & 1;
  char* As = smem + SM_A; char* Bs = smem + SM_B;
  const int achunk = tid & 7, arow0 = tid >> 3;
  const int kq = tid & 7, nq = tid >> 3;
  u32x4 ra[4]; float4 rb[8];
#pragma unroll
  for (int i = 0; i < 4; ++i) ra[i] = *(const u32x4*)(arow[i]);
#pragma unroll
  for (int i = 0; i < 8; ++i) rb[i] = *(const float4*)(bbase + (long)i * ldb);
  const int nk = K >> 6;
#pragma unroll 1
  for (int kt = 0; kt < nk; ++kt) {
    __syncthreads();
#pragma unroll
    for (int i = 0; i < 4; ++i) *(u32x4*)(As + tile_off(arow0 + 32 * i, achunk)) = ra[i];
    {
      u32x4 v;
      v[0] = pack2(rb[0].x, rb[1].x); v[1] = pack2(rb[2].x, rb[3].x); v[2] = pack2(rb[4].x, rb[5].x); v[3] = pack2(rb[6].x, rb[7].x);
      *(u32x4*)(Bs + tile_off(nq * 4 + 0, kq)) = v;
      v[0] = pack2(rb[0].y, rb[1].y); v[1] = pack2(rb[2].y, rb[3].y); v[2] = pack2(rb[4].y, rb[5].y); v[3] = pack2(rb[6].y, rb[7].y);
      *(u32x4*)(Bs + tile_off(nq * 4 + 1, kq)) = v;
      v[0] = pack2(rb[0].z, rb[1].z); v[1] = pack2(rb[2].z, rb[3].z); v[2] = pack2(rb[4].z, rb[5].z); v[3] = pack2(rb[6].z, rb[7].z);
      *(u32x4*)(Bs + tile_off(nq * 4 + 2, kq)) = v;
      v[0] = pack2(rb[0].w, rb[1].w); v[1] = pack2(rb[2].w, rb[3].w); v[2] = pack2(rb[4].w, rb[5].w); v[3] = pack2(rb[6].w, rb[7].w);
      *(u32x4*)(Bs + tile_off(nq * 4 + 3, kq)) = v;
    }
    __syncthreads();
    if (kt + 1 < nk) {
      const int ko = (kt + 1) << 6;
#pragma unroll
      for (int i = 0; i < 4; ++i) ra[i] = *(const u32x4*)(arow[i] + ko);
#pragma unroll
      for (int i = 0; i < 8; ++i) rb[i] = *(const float4*)(bbase + (long)(ko + i) * ldb);
    }
#pragma unroll
    for (int ks = 0; ks < 2; ++ks) {
      bf16x8 af[4];
      const int ch = ks * 4 + (lane >> 4);
#pragma unroll
      for (int m = 0; m < 4; ++m) af[m] = *(const bf16x8*)(As + tile_off(wr * 64 + m * 16 + (lane & 15), ch));
#pragma unroll
      for (int n = 0; n < 4; ++n) {
        const bf16x8 bfr = *(const bf16x8*)(Bs + tile_off(wc * 64 + n * 16 + (lane & 15), ch));
#pragma unroll
        for (int m = 0; m < 4; ++m) acc[m][n] = __builtin_amdgcn_mfma_f32_16x16x32_bf16(af[m], bfr, acc[m][n], 0, 0, 0);
      }
    }
  }
}
DEV void acc_zero(f32x4 (&acc)[4][4]) {
#pragma unroll
  for (int m = 0; m < 4; ++m)
#pragma unroll
    for (int n = 0; n < 4; ++n) acc[m][n] = (f32x4){0.f, 0.f, 0.f, 0.f};
}
#define EPI_ROW(m, j) (((tid >> 7) & 1) * 64 + (m) * 16 + ((tid & 63) >> 4) * 4 + (j))
#define EPI_COL(n) (((tid >> 6) & 1) * 64 + (n) * 16 + (tid & 15))

template <class Epi>
DEV void gemm_phase_dense(const unsigned short* A, int lda, const float* B, int ldb, int N, int K, Epi epi, char* smem) {
  const int tid = otid(); const int nct = N >> 7; const int nitems = (NR >> 7) * nct;
  for (int it = blockIdx.x; it < nitems; it += gridDim.x) {
    const int rt = it / nct, ct = it - rt * nct;
    const unsigned short* arow[4];
#pragma unroll
    for (int i = 0; i < 4; ++i) arow[i] = A + (long)(rt * 128 + (tid >> 3) + 32 * i) * lda + (tid & 7) * 8;
    const float* bbase = B + (long)((tid & 7) * 8) * ldb + ct * 128 + (tid >> 3) * 4;
    f32x4 acc[4][4]; acc_zero(acc);
    gemm128(arow, bbase, ldb, K, acc, smem);
#pragma unroll
    for (int m = 0; m < 4; ++m)
#pragma unroll
      for (int n = 0; n < 4; ++n)
#pragma unroll
        for (int j = 0; j < 4; ++j) epi((long)rt * 128 + EPI_ROW(m, j), ct * 128 + EPI_COL(n), acc[m][n][j]);
  }
}
DEV void ph_proj_mfma(const P& p, int l, char* smem) {
  EpiStore e{p.proj, IN_W};
  gemm_phase_dense(p.ubf, D_MODEL, p.w_in + (long)l * D_MODEL * IN_W, IN_W, IN_W, D_MODEL, e, smem);
}
DEV void ph_glu_mfma(const P& p, int l, char* smem) {
  EpiGlu e{p.ybuf, p.mixb};
  gemm_phase_dense(p.ybf, S5_W, p.s5_w_glu + (long)l * S5_W * S5_W, S5_W, S5_W, S5_W, e, smem);
}
DEV void ph_outproj_mfma(const P& p, int l, char* smem) {
  EpiRes e{p.xcur, p.mod, l, 2 * D_MODEL, p.tmp};
  gemm_phase_dense(p.mixbf, MIX_W, p.w_out + (long)l * MIX_W * D_MODEL, D_MODEL, D_MODEL, MIX_W, e, smem);
}
DEV void exp_prefix(const P& p, int l, int* toff, int* roff) {
  const int tid = threadIdx.x;
  __syncthreads();
  {
    int t = 0, r = 0;
    for (int e = 0; e < tid; ++e) { int c = p.cnt[l * N_EXPERTS + e]; t += (c + 127) >> 7; r += c; }
    toff[tid] = t; roff[tid] = r;
    if (tid == N_EXPERTS - 1) { int c = p.cnt[l * N_EXPERTS + tid]; toff[N_EXPERTS] = t + ((c + 127) >> 7); roff[N_EXPERTS] = r + c; }
  }
  __syncthreads();
}
DEV int exp_find(const int* toff, int tile) {
  int lo = 0, hi = N_EXPERTS - 1;
  while (lo < hi) { int mid = (lo + hi + 1) >> 1; if (toff[mid] <= tile) lo = mid; else hi = mid - 1; }
  return lo;
}
DEV void ph_expert_up_mfma(const P& p, int l, char* smem) {
  const int tid = otid(), lane = tid & 63, wc = (tid >> 6) & 1;
  int* toff = (int*)(smem + SM_MISC); int* roff = toff + N_EXPERTS + 1;
  exp_prefix(p, l, toff, roff);
  const int ntile = toff[N_EXPERTS];
  const int n_exp_items = ntile * (EXPERT_FF / 64);
  const int n_sh_items = (NR >> 7) * (SHARED_FF / 64);
  const int nq = tid >> 3; const int bwc = nq >> 4, bnt = (nq >> 2) & 3, bc16 = (nq & 3) * 4;
  for (int it = blockIdx.x; it < n_exp_items + n_sh_items; it += gridDim.x) {
    const bool shared = it >= n_exp_items;
    int cq, nrows, rbase = 0, e = 0; const float *wg, *wu;
    if (!shared) {
      const int tile = it / (EXPERT_FF / 64); cq = it - tile * (EXPERT_FF / 64);
      e = exp_find(toff, tile); const int j0 = (tile - toff[e]) * 128;
      nrows = min(128, roff[e + 1] - roff[e] - j0); rbase = roff[e] + j0;
      wg = p.w_exp_gate + ((long)l * N_EXPERTS + e) * D_MODEL * EXPERT_FF; wu = p.w_exp_up + ((long)l * N_EXPERTS + e) * D_MODEL * EXPERT_FF;
    } else {
      const int it2 = it - n_exp_items; const int rt = it2 / (SHARED_FF / 64); cq = it2 - rt * (SHARED_FF / 64);
      nrows = 128; rbase = rt * 128;
      wg = p.w_sh_gate + (long)l * D_MODEL * SHARED_FF; wu = p.w_sh_up + (long)l * D_MODEL * SHARED_FF;
    }
    const unsigned short* arow[4];
#pragma unroll
    for (int i = 0; i < 4; ++i) {
      int rl = min((tid >> 3) + 32 * i, nrows - 1);
      long r = shared ? (long)(rbase + rl) : (long)(p.srow[rbase + rl] / TOP_K);
      arow[i] = p.ubf + r * D_MODEL + (tid & 7) * 8;
    }
    const float* bbase = (bnt < 2 ? wg : wu) + (long)((tid & 7) * 8) * EXPERT_FF + cq * 64 + bwc * 32 + (bnt & 1) * 16 + bc16;
    f32x4 acc[4][4]; acc_zero(acc);
    gemm128(arow, bbase, EXPERT_FF, D_MODEL, acc, smem);
#pragma unroll
    for (int m = 0; m < 4; ++m)
#pragma unroll
      for (int j = 0; j < 4; ++j) {
        const int rl = EPI_ROW(m, j);
        if (rl < nrows) {
          unsigned short* dst = shared ? p.hsbf + (long)(rbase + rl) * SHARED_FF : p.hbf + (long)p.srow[rbase + rl] * EXPERT_FF;
#pragma unroll
          for (int nn = 0; nn < 2; ++nn) dst[cq * 64 + wc * 32 + nn * 16 + (lane & 15)] = (unsigned short)f2bf(siluf(acc[m][nn][j]) * acc[m][nn + 2][j]);
        }
      }
  }
}
DEV void ph_expert_down_mfma(const P& p, int l, char* smem) {
  const int tid = otid();
  int* toff = (int*)(smem + SM_MISC); int* roff = toff + N_EXPERTS + 1;
  exp_prefix(p, l, toff, roff);
  const int ntile = toff[N_EXPERTS];
  const int n_exp_items = ntile * (D_MODEL / 128);
  const int n_sh_items = (NR >> 7) * (D_MODEL / 128);
  for (int it = blockIdx.x; it < n_exp_items + n_sh_items; it += gridDim.x) {
    const bool shared = it >= n_exp_items;
    int ct, nrows, rbase, e = 0; const float* wd;
    if (!shared) {
      const int tile = it / (D_MODEL / 128); ct = it - tile * (D_MODEL / 128);
      e = exp_find(toff, tile); const int j0 = (tile - toff[e]) * 128;
      nrows = min(128, roff[e + 1] - roff[e] - j0); rbase = roff[e] + j0;
      wd = p.w_exp_down + ((long)l * N_EXPERTS + e) * EXPERT_FF * D_MODEL;
    } else {
      const int it2 = it - n_exp_items; const int rt = it2 / (D_MODEL / 128); ct = it2 - rt * (D_MODEL / 128);
      nrows = 128; rbase = rt * 128; wd = p.w_sh_down + (long)l * SHARED_FF * D_MODEL;
    }
    const unsigned short* arow[4];
#pragma unroll
    for (int i = 0; i < 4; ++i) {
      int rl = min((tid >> 3) + 32 * i, nrows - 1);
      arow[i] = shared ? p.hsbf + (long)(rbase + rl) * SHARED_FF + (tid & 7) * 8 : p.hbf + (long)p.srow[rbase + rl] * EXPERT_FF + (tid & 7) * 8;
    }
    const float* bbase = wd + (long)((tid & 7) * 8) * D_MODEL + ct * 128 + (tid >> 3) * 4;
    f32x4 acc[4][4]; acc_zero(acc);
    gemm128(arow, bbase, D_MODEL, EXPERT_FF, acc, smem);
#pragma unroll
    for (int m = 0; m < 4; ++m)
#pragma unroll
      for (int j = 0; j < 4; ++j) {
        const int rl = EPI_ROW(m, j);
        if (rl < nrows) {
          float* dst; float gsc = 1.0f;
          if (shared) dst = p.ysh + (long)(rbase + rl) * D_MODEL; else { int a = p.srow[rbase + rl]; dst = p.yk + (long)a * D_MODEL; gsc = p.gate[a]; }
#pragma unroll
          for (int n = 0; n < 4; ++n) dst[ct * 128 + EPI_COL(n)] = acc[m][n][j] * gsc;
        }
      }
  }
}

typedef __attribute__((ext_vector_type(16))) float f32x16;
#define SM_HR 256
#define UB_STRIDE 8272
#define SM_HU (256 + 32768)
#define SMEM_HY (256 + 32768 + 2 * UB_STRIDE * 2)
static_assert(SEQ == 8192 && HYENA_W == 256, "hyena mfma shape");
DEV void ph_hyena_mfma(const P& p, int l, char* smem) {
  const int tid = otid(), lane = tid & 63, w = tid >> 6;
  unsigned short* R = (unsigned short*)(smem + SM_HR); unsigned short* U = (unsigned short*)(smem + SM_HU);
  for (int ch = blockIdx.x; ch < HYENA_W; ch += gridDim.x) {
    __syncthreads();
    const float* kf = p.kraw + ((long)l * 2 * HYENA_W + ch) * SEQ; const float* kb = p.kraw + ((long)l * 2 * HYENA_W + HYENA_W + ch) * SEQ;
    for (int y = tid; y < 2 * SEQ; y += 256) {
      const int lag = SEQ - y; float v = 0.f;
      if (lag >= 0 && lag < SEQ) v = kf[lag]; else if (lag < 0) v = kb[-lag];
      const int C = y >> 3; R[((C ^ ((C >> 4) & 1)) << 3) + (y & 7)] = (unsigned short)f2bf(v);
    }
    for (int e = tid; e < 2 * UB_STRIDE; e += 256) {
      const int b = e / UB_STRIDE, ee = e - b * UB_STRIDE, t = ee - 16; float v = 0.f;
      if (t >= 0 && t < SEQ) v = p.hu[((long)b * HYENA_W + ch) * SEQ + t];
      U[e] = (unsigned short)f2bf(v);
    }
    __syncthreads();
    f32x16 acc[4];
#pragma unroll
    for (int mi = 0; mi < 4; ++mi)
#pragma unroll
      for (int k = 0; k < 16; ++k) acc[mi][k] = 0.f;
    const int r = lane & 31, h = lane >> 5, sig = lane & 15, bb = (lane >> 4) & 1;
    const unsigned* Ud = (const unsigned*)U + bb * (UB_STRIDE / 2);
    const int ub0 = 8 * h + sig;
    const int cbase = 1022 - 64 * (4 * w) - 2 * r + h;
    const bool odd = sig & 1;
    bf16x8 afn[4]; unsigned dn[5];
    {
#pragma unroll
      for (int mi = 0; mi < 4; ++mi) { const int C = cbase - 64 * mi; afn[mi] = *(const bf16x8*)((const char*)R + ((C ^ ((C >> 4) & 1)) << 4)); }
      const int di = ub0 >> 1;
#pragma unroll
      for (int i = 0; i < 5; ++i) dn[i] = Ud[di + i];
    }
#pragma unroll 1
    for (int q = 0; q <= SEQ / 16; ++q) {
      bf16x8 af[4]; unsigned d[5];
#pragma unroll
      for (int mi = 0; mi < 4; ++mi) af[mi] = afn[mi];
#pragma unroll
      for (int i = 0; i < 5; ++i) d[i] = dn[i];
      {
        const int qn = min(q + 1, SEQ / 16);
#pragma unroll
        for (int mi = 0; mi < 4; ++mi) { const int C = cbase - 64 * mi + 2 * qn; afn[mi] = *(const bf16x8*)((const char*)R + ((C ^ ((C >> 4) & 1)) << 4)); }
        const int di = (16 * qn + ub0) >> 1;
#pragma unroll
        for (int i = 0; i < 5; ++i) dn[i] = Ud[di + i];
      }
      u32x4 bw;
#pragma unroll
      for (int i = 0; i < 4; ++i) bw[i] = odd ? __builtin_amdgcn_alignbit(d[i + 1], d[i], 16) : d[i];
      const bf16x8 bfr = __builtin_bit_cast(bf16x8, bw);
#pragma unroll
      for (int mi = 0; mi < 4; ++mi) acc[mi] = __builtin_amdgcn_mfma_f32_32x32x16_bf16(af[mi], bfr, acc[mi], 0, 0, 0);
    }
    __syncthreads();
    {
      float* Y = (float*)(smem + SM_HR);
      float* yl = Y + bb * SEQ + 16 * (32 * (4 * w) + 4 * h) + sig;
#pragma unroll
      for (int mi = 0; mi < 4; ++mi)
#pragma unroll
        for (int k = 0; k < 16; ++k) yl[16 * (32 * mi + (k & 3) + 8 * (k >> 2))] = acc[mi][k];
    }
    __syncthreads();
    {
      const float* Y = (const float*)(smem + SM_HR);
      const float kn = p.knorm[l * HYENA_W + ch], dsk = p.hy_d[l * HYENA_W + ch];
#pragma unroll 2
      for (int idx = tid; idx < BATCH * SEQ; idx += 256) {
        const int b = idx / SEQ, t = idx - b * SEQ;
        const long o = ((long)b * HYENA_W + ch) * SEQ + t;
        p.mixb[(long)idx * MIX_W + ATTN_W + ch] = (Y[idx] * kn + p.hu[o] * dsk) * p.hx0[o];
      }
    }
  }
}
#endif

#ifndef CPU_TEST
#define XB_TMO      128
#define XB_XCNT(j)  (256  + 64 * (j))
#define XB_XSUB(j)  (1280 + 64 * (j))
#define XB_XGEN(j)  (2304 + 64 * (j))
#define XB_TOP      3328
#define XB_TOPGEN   3392
#define XCD_BAR_WORDS 3456
#define XB_SPIN_CAP (1u << 18)
#define LAS __attribute__((address_space(3)))
__device__ __forceinline__ unsigned xb_ld(unsigned* p)              { return __hip_atomic_load(p, __ATOMIC_RELAXED, __HIP_MEMORY_SCOPE_AGENT); }
__device__ __forceinline__ unsigned xb_add(unsigned* p, unsigned v) { return __hip_atomic_fetch_add(p, v, __ATOMIC_RELAXED, __HIP_MEMORY_SCOPE_AGENT); }
__device__ __forceinline__ unsigned xb_xcc_id() { return (unsigned)__builtin_amdgcn_s_getreg((3 << 11) | 20) & 0xFu; }
#define XB_SPIN(cond, bar) do { unsigned _sp = 0; while (cond) { __builtin_amdgcn_s_sleep(1); \
    if ((++_sp & 255u) == 0u) { if (xb_ld(&(bar)[XB_TMO])) break; if (_sp > XB_SPIN_CAP) { atomicAdd(&(bar)[XB_TMO], 1u); break; } } } } while (0)
struct XcdBarrier { unsigned* bar; unsigned x; volatile LAS unsigned* st; };
__device__ __forceinline__ XcdBarrier xcd_barrier_post(unsigned* bar, volatile LAS unsigned* st) {
    XcdBarrier b; b.bar = bar; b.x = xb_xcc_id(); b.st = st;
    if (threadIdx.x == 0) (void)xb_add(&bar[XB_XCNT(b.x)], 1u);
    return b;
}
__device__ __forceinline__ void xcd_barrier_complete(unsigned* bar, unsigned x, unsigned& nloc, unsigned& nx) {
    const unsigned G = gridDim.x * gridDim.y * gridDim.z;
    unsigned sum, cnt, mine, sp = 0u;
    for (;;) {
        sum = 0u; cnt = 0u; mine = 0u;
#pragma unroll
        for (unsigned j = 0; j < 16; ++j) { const unsigned c = xb_ld(&bar[XB_XCNT(j)]); sum += c; cnt += (c > 0u) ? 1u : 0u; mine = (j == x) ? c : mine; }
        if (sum == G) break;
        __builtin_amdgcn_s_sleep(1);
        if ((++sp & 255u) == 0u) { if (xb_ld(&bar[XB_TMO])) break; if (sp > XB_SPIN_CAP) { atomicAdd(&bar[XB_TMO], 1u); break; } }
    }
    nloc = mine > 0u ? mine : 1u; nx = cnt > 0u ? cnt : 1u;
}
__device__ __forceinline__ void xcd_barrier(const XcdBarrier& b) {
    asm volatile("s_waitcnt vmcnt(0)" ::: "memory");
    __syncthreads();
    if (threadIdx.x == 0) {
        unsigned* bar = b.bar;
        __builtin_amdgcn_s_waitcnt(0);
        unsigned nloc = b.st[0], nx = b.st[1];
        if (nloc == 0u) { xcd_barrier_complete(bar, b.x, nloc, nx); b.st[0] = nloc; b.st[1] = nx; }
        const unsigned old = xb_add(&bar[XB_XSUB(b.x)], 1u);
        const unsigned gen = old / nloc;
        if (old + 1u == (gen + 1u) * nloc) {
            __builtin_amdgcn_fence(__ATOMIC_RELEASE, "agent");
            asm volatile("s_waitcnt vmcnt(0)" ::: "memory");
            const unsigned og = xb_add(&bar[XB_TOP], 1u);
            const unsigned tg = og / nx;
            if (og + 1u == (tg + 1u) * nx) xb_add(&bar[XB_TOPGEN], 1u);
            else XB_SPIN(xb_ld(&bar[XB_TOPGEN]) == tg, bar);
            __builtin_amdgcn_fence(__ATOMIC_ACQUIRE, "agent");
            xb_add(&bar[XB_XGEN(b.x)], 1u);
            asm volatile("s_waitcnt vmcnt(0)" ::: "memory");
        } else {
            XB_SPIN(xb_ld(&bar[XB_XGEN(b.x)]) == gen, bar);
            __builtin_amdgcn_fence(__ATOMIC_ACQUIRE, "agent");
            asm volatile("s_waitcnt vmcnt(0)" ::: "memory");
        }
    }
    __syncthreads();
}
#define GRID_SYNC() xcd_barrier(xb)
#else
#define GRID_SYNC() do {} while (0)
#endif

#ifndef CPU_TEST
#define GPUSEL(a, b) a
#else
#define GPUSEL(a, b) b
#endif
#ifndef CPU_TEST
#define OPAQUE_S(v) asm volatile("" : "+s"(v))
#define OPAQUE_V(v) asm volatile("" : "+v"(v))
#else
#define OPAQUE_S(v) do {} while (0)
#define OPAQUE_V(v) do {} while (0)
#endif
#define LPHASE(stmt) do { int l = lo; OPAQUE_S(l); PHASE(stmt); } while (0)
#define PHASE(stmt) do { if (SINGLE || ph == only) { long gtid = gtid0; OPAQUE_V(gtid); stmt; } if (SINGLE) { GRID_SYNC(); } ++ph; } while (0)
#ifndef CPU_TEST
template <bool SINGLE> __device__ __forceinline__ void run_seq(const P& p, long gtid0, long gsize, int only, const XcdBarrier& xb, char* smem)
#else
template <bool SINGLE> static int run_seq(const P& p, long gtid0, long gsize, int only)
#endif
{
  int ph = 0;
  PHASE(ph_g0(p, gtid, gsize));
  PHASE(ph_g1(p, gtid, gsize));
  PHASE(ph_g2(p, gtid, gsize));
  PHASE(ph_g3(p, gtid, gsize));
  PHASE(ph_g4(p, gtid, gsize));
#pragma unroll 1
  for (int lo = 0; lo < DEPTH; ++lo) {
    LPHASE(ph_modu(p, l, 0, gtid, gsize));
    LPHASE(GPUSEL(ph_proj_mfma(p, l, smem), ph_proj(p, l, gtid, gsize)));
    LPHASE(ph_post_proj(p, l, gtid, gsize));
    LPHASE(ph_mix(p, l, gtid, gsize); GPUSEL(ph_hyena_mfma(p, l, smem), (void)0));
    LPHASE(ph_s5out(p, l, gtid, gsize));
    LPHASE(GPUSEL(ph_glu_mfma(p, l, smem), ph_glu(p, l, gtid, gsize)));
    LPHASE(ph_rms(p, l, gtid, gsize));
    LPHASE(GPUSEL(ph_outproj_mfma(p, l, smem), ph_outproj(p, l, gtid, gsize)));
    LPHASE(ph_ln(p, l, 0, gtid, gsize));
    LPHASE(ph_router(p, l, gtid, gsize));
    LPHASE(ph_select(p, l, gtid, gsize));
    LPHASE(ph_sortrows(p, l, gtid, gsize));
    LPHASE(GPUSEL(ph_expert_up_mfma(p, l, smem), ph_expert_up(p, l, gtid, gsize)));
    LPHASE(GPUSEL(ph_expert_down_mfma(p, l, smem), ph_expert_down(p, l, gtid, gsize)));
    LPHASE(ph_combine(p, l, gtid, gsize));
    LPHASE(ph_ln(p, l, 1, gtid, gsize));
  }
#ifdef CPU_TEST
  return ph;
#endif
}

struct Carver { char* base; size_t off; template <class T> T* take(size_t n) { T* r = (T*)(base + off); off += ((n * sizeof(T) + 255) / 256) * 256; return r; } };
static void carve(P& p, void* ws) {
  Carver c{(char*)ws, 0};
  p.bar = c.take<unsigned>(4096);
  p.cnt = c.take<int>(DEPTH * N_EXPERTS);
  p.mod = c.take<float>((size_t)DEPTH * (BATCH + 1) * 6 * D_MODEL);
  p.xcur = c.take<float>((size_t)NR * D_MODEL);
  p.ubuf = c.take<float>((size_t)NR * D_MODEL);
  p.proj = c.take<float>((size_t)NR * IN_W);
  p.hu = c.take<float>((size_t)NR * HYENA_W);
  p.hx0 = c.take<float>((size_t)NR * HYENA_W);
  p.fh1 = c.take<float>((size_t)DEPTH * SEQ * FILTER_HIDDEN);
  p.fh2 = c.take<float>((size_t)DEPTH * SEQ * FILTER_HIDDEN);
  p.kraw = c.take<float>((size_t)DEPTH * SEQ * 2 * HYENA_W);
  p.knorm = c.take<float>((size_t)DEPTH * HYENA_W);
  p.fh1c = c.take<float>((size_t)CTX_LEN * FILTER_HIDDEN);
  p.fh2c = c.take<float>((size_t)CTX_LEN * FILTER_HIDDEN);
  p.krawc = c.take<float>((size_t)CTX_LEN * 2 * HYENA_W);
  p.knormc = c.take<float>((size_t)HYENA_W);
  p.mixb = c.take<float>((size_t)NR * MIX_W);
  p.tmp = c.take<float>((size_t)NR * D_MODEL);
  p.lampow = c.take<float2>((size_t)DEPTH * 2 * S5_GROUPS * (S5_T + 1) * S5_STATE);
  p.bbar = c.take<float2>((size_t)DEPTH * 2 * S5_GROUPS * S5_STATE * S5_GROUP);
  p.kc = c.take<float>((size_t)DEPTH * 2 * S5_GROUPS * S5_T * S5_GROUP * S5_GROUP);
  p.sc = c.take<float2>((size_t)BATCH * 2 * S5_GROUPS * NCH * S5_STATE);
  p.hc = c.take<float2>((size_t)BATCH * 2 * S5_GROUPS * NCH * S5_STATE);
  p.ybuf = c.take<float>((size_t)NR * S5_W);
  p.rl = c.take<float>((size_t)NR * N_EXPERTS);
  p.top_e = c.take<int>((size_t)NR * TOP_K);
  p.gate = c.take<float>((size_t)NR * TOP_K);
  p.posb = c.take<int>((size_t)NR * TOP_K);
  p.srow = c.take<int>((size_t)NR * TOP_K);
  p.hbuf = c.take<float>((size_t)NR * TOP_K * EXPERT_FF);
  p.hsb = c.take<float>((size_t)NR * SHARED_FF);
  p.yk = c.take<float>((size_t)NR * TOP_K * D_MODEL);
  p.ysh = c.take<float>((size_t)NR * D_MODEL);
  p.ubf = c.take<unsigned short>((size_t)NR * D_MODEL);
  p.ybf = c.take<unsigned short>((size_t)NR * S5_W);
  p.mixbf = c.take<unsigned short>((size_t)NR * MIX_W);
  p.hbf = c.take<unsigned short>((size_t)NR * TOP_K * EXPERT_FF);
  p.hsbf = c.take<unsigned short>((size_t)NR * SHARED_FF);
}
static void set_inputs(P& p, void* const* d_in) {
  const float** f = (const float**)&p.x;
  for (int i = 0; i < 40; ++i) f[i] = (const float*)d_in[i];
}

#ifndef CPU_TEST
#ifndef MK_SINGLE
#define MK_SINGLE 1
#endif
extern __shared__ __attribute__((aligned(16))) char dyn_smem[];
__global__ void __launch_bounds__(256, 2) mk_single(P p) {
  uint4* xbw = (uint4*)(dyn_smem + SM_XB);
  if (threadIdx.x == 0) *xbw = make_uint4(0u, 0u, 0u, 0u);
  __syncthreads();
  XcdBarrier xb = xcd_barrier_post(p.bar, (volatile LAS unsigned*)xbw);
  run_seq<true>(p, (long)blockIdx.x * blockDim.x + threadIdx.x, (long)gridDim.x * blockDim.x, -1, xb, dyn_smem);
}
__global__ void __launch_bounds__(256, 2) mk_phase(P p, int only) {
  XcdBarrier xb; xb.bar = p.bar; xb.x = 0; xb.st = nullptr;
#ifdef DBG_ONLY
  only = DBG_ONLY;
#endif
  run_seq<false>(p, (long)blockIdx.x * blockDim.x + threadIdx.x, (long)gridDim.x * blockDim.x, only, xb, dyn_smem);
}
extern "C" void kernel_launch(void* const* d_in, const int* in_sizes, int n_in, void* d_out, int out_size, void* d_ws, size_t ws_size, hipStream_t stream) {
  P p; memset(&p, 0, sizeof(p));
  set_inputs(p, d_in); p.out = (float*)d_out; carve(p, d_ws);
  (void)hipMemsetAsync(p.bar, 0, 4096 * sizeof(unsigned) + ((DEPTH * N_EXPERTS * sizeof(int) + 255) / 256) * 256, stream);
#if MK_SINGLE
  static int grid = 0;
  if (!grid) {
    int dev = 0, cus = 0, per_cu = 0; (void)hipGetDevice(&dev);
    (void)hipDeviceGetAttribute(&cus, hipDeviceAttributeMultiprocessorCount, dev);
    (void)hipFuncSetAttribute((const void*)mk_single, hipFuncAttributeMaxDynamicSharedMemorySize, SMEM_BYTES);
    (void)hipOccupancyMaxActiveBlocksPerMultiprocessor(&per_cu, mk_single, 256, SMEM_BYTES);
    grid = cus * (per_cu < 2 ? per_cu : 2);
  }
  mk_single<<<grid, 256, SMEM_BYTES, stream>>>(p);
#else
  for (int ph = 0; ph < NG + DEPTH * NLP; ++ph) mk_phase<<<512, 256, SMEM_BYTES, stream>>>(p, ph);
#endif
}
#endif
```

```cpp
#ifndef CPU_TEST
#include <hip/hip_runtime.h>
#include <cstring>
#define DEV __device__ __forceinline__
#define DEVM __device__ __forceinline__
#else
#include <cmath>
#include <cstdio>
#include <cstdlib>
#include <cstring>
#define DEV static inline
#define DEVM inline
struct float2 { float x, y; };
static inline float2 make_float2(float a, float b) { float2 r; r.x = a; r.y = b; return r; }
static inline int atomicAdd(int* p, int v) { int o = *p; *p += v; return o; }
#endif

#ifdef SMALL_CFG
#define D_MODEL 64
#define BATCH 2
#define SEQ 256
#define GRID_W 16
#define CTX_LEN 32
#define HEAD_DIM 16
#define N_Q_HEADS 4
#define N_KV_HEADS 2
#define HYENA_W 16
#define S5_W 32
#define WINDOW 32
#define FILTER_HIDDEN 16
#define S5_STATE 8
#define N_EXPERTS 32
#define TOP_K 4
#define EXPERT_FF 16
#define SHARED_FF 16
#define S5_T 32
#else
#define D_MODEL 1024
#define BATCH 2
#define SEQ 8192
#define GRID_W 64
#define CTX_LEN 256
#define HEAD_DIM 64
#define N_Q_HEADS 8
#define N_KV_HEADS 2
#define HYENA_W 256
#define S5_W 256
#define WINDOW 128
#define FILTER_HIDDEN 64
#define S5_STATE 64
#define N_EXPERTS 256
#define TOP_K 8
#define EXPERT_FF 256
#define SHARED_FF 256
#define S5_T 64
#endif
#define DEPTH 2
#define FILTER_EMB 33
#define N_EXPERT_GROUPS 8
#define TOPK_GROUPS 4
#define S5_GROUP 16
#define Q_GROUP (N_Q_HEADS / N_KV_HEADS)
#define ATTN_W (N_Q_HEADS * HEAD_DIM)
#define KV_W (N_KV_HEADS * HEAD_DIM)
#define MIX_W (ATTN_W + HYENA_W + S5_W)
#define Q_OFF 0
#define K_OFF ATTN_W
#define V_OFF (K_OFF + KV_W)
#define HY_OFF (V_OFF + KV_W)
#define S5_OFF (HY_OFF + 3 * HYENA_W)
#define IN_W (S5_OFF + S5_W)
#define AXIS_DIM (HEAD_DIM / 2)
#define ROPE_HALF (AXIS_DIM / 2)
#define S5_GROUPS (S5_W / S5_GROUP)
#define EPG (N_EXPERTS / N_EXPERT_GROUPS)
#define NL (BATCH * SEQ)
#define NC (BATCH * CTX_LEN)
#define NR (NL + NC)
#define NSEQ (CTX_LEN + SEQ)
#define NCH (NSEQ / S5_T)
#define LN_EPS 1e-5f
#define DN_ALPHA 1.4142135623730951f
#define ROUTED_SCALE 2.5f
#define PI_D 3.14159265358979323846

struct P {
  const float *x, *c, *ctx, *c_ctx, *w_ada, *b_ada, *w_in, *w_out, *sink, *mix_g, *hy_short_w, *hy_short_b, *hy_w1,
      *hy_b1, *hy_freq, *hy_w2, *hy_b2, *hy_w3, *hy_d, *s5_a_re, *s5_a_im, *s5_log_dt, *s5_b_re, *s5_b_im, *s5_c_re,
      *s5_c_im, *s5_d, *s5_w_glu, *ln1_g, *ln1_b, *ln2_g, *ln2_b, *w_router, *router_bias, *w_exp_gate, *w_exp_up,
      *w_exp_down, *w_sh_gate, *w_sh_up, *w_sh_down;
  float* out;
  unsigned* bar;
  int* cnt;
  float *mod;
  float *xcur;
  float *ubuf;
  float *proj;
  float *hu, *hx0;
  float *fh1, *fh2;
  float *kraw;
  float *knorm;
  float *fh1c, *fh2c;
  float *krawc;
  float *knormc;
  float *mixb;
  float *tmp;
  float2 *lampow;
  float2 *bbar;
  float *kc;
  float2 *sc, *hc;
  float *ybuf;
  float *rl;
  int *top_e;
  float *gate;
  int *posb;
  int *srow;
  float *hbuf;
  float *hsb;
  float *yk;
  unsigned short *ubf;
  unsigned short *ybf;
  unsigned short *mixbf;
  unsigned short *hbf;
  unsigned short *hsbf;
  unsigned short *ubl;
  int *elist;
  float *ysh;
};

#define FOR_ITEMS(i, N) for (long i = gtid; i < (long)(N); i += gsize)

DEV unsigned short f2bf16(float f) { unsigned u; memcpy(&u, &f, 4); return (unsigned short)((u + 0x7fffu + ((u >> 16) & 1u)) >> 16); }
DEV float siluf(float x) { return x / (1.0f + expf(-x)); }
DEV float sigmoidf_(float x) { return 1.0f / (1.0f + expf(-x)); }
DEV float gelu_tanhf(float x) { return 0.5f * x * (1.0f + tanhf(0.7978845608028654f * (x + 0.044715f * x * x * x))); }
DEV int modrow(long r) { return r < NL ? (int)(r / SEQ) : BATCH; }

DEV void ph_g0(const P& p, long gtid, long gsize) {
  FOR_ITEMS(i, (long)NR * D_MODEL) p.xcur[i] = i < (long)NL * D_MODEL ? p.x[i] : p.ctx[i - (long)NL * D_MODEL];
  FOR_ITEMS(i, DEPTH * (BATCH + 1) * 6 * D_MODEL) {
    int n = (int)(i % (6 * D_MODEL)); int j = (int)((i / (6 * D_MODEL)) % (BATCH + 1)); int l = (int)(i / (6 * D_MODEL * (BATCH + 1)));
    const float* cv = j < BATCH ? p.c + j * D_MODEL : p.c_ctx;
    const float* w = p.w_ada + (long)l * D_MODEL * 6 * D_MODEL;
    float acc = p.b_ada[l * 6 * D_MODEL + n];
    for (int k = 0; k < D_MODEL; ++k) acc += siluf(cv[k]) * w[(long)k * 6 * D_MODEL + n];
    p.mod[i] = acc;
  }
  FOR_ITEMS(i, DEPTH * 2 * S5_GROUPS * S5_STATE) {
    int pp = (int)(i % S5_STATE); int g = (int)((i / S5_STATE) % S5_GROUPS); int ld = (int)(i / (S5_STATE * S5_GROUPS));
    float are = fminf(p.s5_a_re[i], -1e-4f), aim = p.s5_a_im[i];
    float dt = expf(p.s5_log_dt[ld * S5_GROUPS + g]);
    for (int d = 0; d <= S5_T; ++d) {
      float mag = expf(are * dt * d); float ang = aim * dt * d;
      p.lampow[((long)(ld * S5_GROUPS + g) * (S5_T + 1) + d) * S5_STATE + pp] = make_float2(mag * cosf(ang), mag * sinf(ang));
    }
    float mag = expf(are * dt), ang = aim * dt;
    float lr = mag * cosf(ang) - 1.0f, li = mag * sinf(ang);
    float den = are * are + aim * aim;
    float fr = (lr * are + li * aim) / den, fi = (li * are - lr * aim) / den;
    for (int j = 0; j < S5_GROUP; ++j) {
      float br = p.s5_b_re[i * S5_GROUP + j], bi = p.s5_b_im[i * S5_GROUP + j];
      p.bbar[i * S5_GROUP + j] = make_float2(fr * br - fi * bi, fr * bi + fi * br);
    }
  }
}
DEV void hy_f1(const P& p, int l, int Lf, float* h1, long gtid, long gsize) {
  FOR_ITEMS(i, (long)Lf * FILTER_HIDDEN) {
    int j = (int)(i % FILTER_HIDDEN); int t = (int)(i / FILTER_HIDDEN);
    const float* w1 = p.hy_w1 + l * FILTER_EMB * FILTER_HIDDEN;
    float tt = (float)((double)t / (double)(Lf - 1));
    float w = (float)(2.0 * PI_D * (double)t / (double)Lf);
    float acc = p.hy_b1[l * FILTER_HIDDEN + j] + tt * w1[j];
    const int bands = (FILTER_EMB - 1) / 2;
    for (int m = 0; m < bands; ++m) {
      float f = (float)(1e-4 + (double)m * ((double)(bands - 1) - 1e-4) / (double)(bands - 1));
      float a = f * w;
      acc += cosf(a) * w1[(1 + m) * FILTER_HIDDEN + j] - sinf(a) * w1[(1 + bands + m) * FILTER_HIDDEN + j];
    }
    h1[i] = sinf(p.hy_freq[l * FILTER_HIDDEN + j] * acc);
  }
}
DEV void hy_f2(const P& p, int l, int Lf, const float* h1, float* h2, long gtid, long gsize) {
  FOR_ITEMS(i, (long)Lf * FILTER_HIDDEN) {
    int j = (int)(i % FILTER_HIDDEN); int t = (int)(i / FILTER_HIDDEN);
    const float* w2 = p.hy_w2 + l * FILTER_HIDDEN * FILTER_HIDDEN;
    float acc = p.hy_b2[l * FILTER_HIDDEN + j];
    for (int k = 0; k < FILTER_HIDDEN; ++k) acc += h1[t * FILTER_HIDDEN + k] * w2[k * FILTER_HIDDEN + j];
    h2[i] = sinf(p.hy_freq[l * FILTER_HIDDEN + j] * acc);
  }
}
DEV void hy_f3(const P& p, int l, int Lf, const float* h2, float* kraw, long gtid, long gsize) {
  FOR_ITEMS(i, (long)Lf * 2 * HYENA_W) {
    int cc = (int)(i % (2 * HYENA_W)); int t = (int)(i / (2 * HYENA_W)); int ch = cc % HYENA_W;
    const float* w3 = p.hy_w3 + l * FILTER_HIDDEN * 2 * HYENA_W;
    float acc = 0.f;
    for (int k = 0; k < FILTER_HIDDEN; ++k) acc += h2[t * FILTER_HIDDEN + k] * w3[k * 2 * HYENA_W + cc];
    double d0 = log(1e-2) / 0.3, d1 = log(1e-2) / 1.5;
    float delta = fabsf((float)(d0 + (d1 - d0) * (double)ch / (double)(HYENA_W - 1)));
    float tt = (float)((double)t / (double)(Lf - 1));
    kraw[(long)cc * Lf + t] = acc * expf(-tt * delta);
  }
}
DEV void hy_f4(int Lf, const float* kraw, float* knorm, long gtid, long gsize) {
  FOR_ITEMS(i, HYENA_W) {
    float s = 0.f;
    for (int t = 0; t < Lf; ++t) {
      s += fabsf(kraw[(long)i * Lf + t]);
      if (t > 0) s += fabsf(kraw[(long)(HYENA_W + i) * Lf + t]);
    }
    knorm[i] = 1.0f / s;
  }
}
DEV void ph_g1(const P& p, long gtid, long gsize) {
  for (int l = 0; l < DEPTH; ++l) hy_f1(p, l, SEQ, p.fh1 + (long)l * SEQ * FILTER_HIDDEN, gtid, gsize);
  hy_f1(p, 0, CTX_LEN, p.fh1c, gtid, gsize);
  FOR_ITEMS(i, (long)DEPTH * 2 * S5_GROUPS * S5_T * S5_GROUP * S5_GROUP) {
    int j = (int)(i % S5_GROUP); int ii = (int)((i / S5_GROUP) % S5_GROUP); int d = (int)((i / (S5_GROUP * S5_GROUP)) % S5_T);
    long ldg = i / (S5_GROUP * S5_GROUP * S5_T);
    float acc = 0.f;
    for (int pp = 0; pp < S5_STATE; ++pp) {
      float cr = p.s5_c_re[(ldg * S5_GROUP + ii) * S5_STATE + pp], ci = p.s5_c_im[(ldg * S5_GROUP + ii) * S5_STATE + pp];
      float2 lp = p.lampow[(ldg * (S5_T + 1) + d) * S5_STATE + pp];
      float2 bb = p.bbar[(ldg * S5_STATE + pp) * S5_GROUP + j];
      float tr = lp.x * bb.x - lp.y * bb.y, ti = lp.x * bb.y + lp.y * bb.x;
      acc += cr * tr - ci * ti;
    }
    p.kc[i] = acc;
  }
}
DEV void ph_g2(const P& p, long gtid, long gsize) {
  for (int l = 0; l < DEPTH; ++l) hy_f2(p, l, SEQ, p.fh1 + (long)l * SEQ * FILTER_HIDDEN, p.fh2 + (long)l * SEQ * FILTER_HIDDEN, gtid, gsize);
  hy_f2(p, 0, CTX_LEN, p.fh1c, p.fh2c, gtid, gsize);
}
DEV void ph_g3(const P& p, long gtid, long gsize) {
  for (int l = 0; l < DEPTH; ++l) hy_f3(p, l, SEQ, p.fh2 + (long)l * SEQ * FILTER_HIDDEN, p.kraw + (long)l * SEQ * 2 * HYENA_W, gtid, gsize);
  hy_f3(p, 0, CTX_LEN, p.fh2c, p.krawc, gtid, gsize);
}
DEV void ph_g4(const P& p, long gtid, long gsize) {
  for (int l = 0; l < DEPTH; ++l) hy_f4(SEQ, p.kraw + (long)l * SEQ * 2 * HYENA_W, p.knorm + l * HYENA_W, gtid, gsize);
  hy_f4(CTX_LEN, p.krawc, p.knormc, gtid, gsize);
}
#define NG 5

DEV void ph_modu(const P& p, int l, int which, long gtid, long gsize) {
  FOR_ITEMS(i, (long)NR * D_MODEL) {
    int k = (int)(i % D_MODEL); long r = i / D_MODEL;
    const float* m = p.mod + ((long)l * (BATCH + 1) + modrow(r)) * 6 * D_MODEL + which * 3 * D_MODEL;
    float uv = p.xcur[i] * (1.0f + m[D_MODEL + k]) + m[k];
    p.ubuf[i] = uv; p.ubf[i] = f2bf16(uv);
  }
}
template <class Epi>
DEV void gemm_naive(const float* A, int lda, const float* B, int ldb, int M, int N, int K, Epi epi, long gtid, long gsize) {
  FOR_ITEMS(i, (long)(M / 4) * N) {
    int n = (int)(i % N); long r0 = (i / N) * 4;
    const float* a0 = A + r0 * lda;
    float c0 = 0.f, c1 = 0.f, c2 = 0.f, c3 = 0.f;
    for (int k = 0; k < K; ++k) {
      float b = B[(long)k * ldb + n];
      c0 += a0[k] * b; c1 += a0[lda + k] * b; c2 += a0[2 * lda + k] * b; c3 += a0[3 * lda + k] * b;
    }
    epi(r0, n, c0); epi(r0 + 1, n, c1); epi(r0 + 2, n, c2); epi(r0 + 3, n, c3);
  }
}
struct EpiStore { float* C; int ldc; DEVM void operator()(long r, int n, float v) const { C[r * ldc + n] = v; } };
DEV void ph_proj(const P& p, int l, long gtid, long gsize) {
  EpiStore e{p.proj, IN_W};
  gemm_naive(p.ubuf, D_MODEL, p.w_in + (long)l * D_MODEL * IN_W, IN_W, NR, IN_W, D_MODEL, e, gtid, gsize);
}
DEV long s5_row(int b, int dir, int n) {
  if (n < CTX_LEN) return (long)NL + b * CTX_LEN + (dir ? CTX_LEN - 1 - n : n);
  int t = n - CTX_LEN; return (long)b * SEQ + (dir ? SEQ - 1 - t : t);
}
DEV void ph_post_proj(const P& p, int l, long gtid, long gsize) {
  FOR_ITEMS(i, (long)NL * (N_Q_HEADS + N_KV_HEADS) * 2 * ROPE_HALF) {
    int ii = (int)(i % ROPE_HALF); int a = (int)((i / ROPE_HALF) % 2); int hs = (int)((i / (2 * ROPE_HALF)) % (N_Q_HEADS + N_KV_HEADS));
    long r = i / (2 * ROPE_HALF * (N_Q_HEADS + N_KV_HEADS));
    int t = (int)(r % SEQ); int pos = a == 0 ? t / GRID_W : t % GRID_W;
    float inv = powf(10000.0f, -(float)(2 * ii) / (float)AXIS_DIM);
    float ang = (float)pos * inv; float cs = cosf(ang), sn = sinf(ang);
    float* q = p.proj + r * IN_W + hs * HEAD_DIM + a * AXIS_DIM + ii;
    float x1 = q[0], x2 = q[ROPE_HALF];
    q[0] = x1 * cs - x2 * sn; q[ROPE_HALF] = x1 * sn + x2 * cs;
  }
  FOR_ITEMS(i, (long)NR * HYENA_W) {
    int ch = (int)(i % HYENA_W); long r = i / HYENA_W;
    int Ls = r < NL ? SEQ : CTX_LEN; long base = r < NL ? (r / SEQ) * SEQ : NL + ((r - NL) / CTX_LEN) * CTX_LEN; int t = (int)(r - base);
    const float* sw = p.hy_short_w + l * 3 * 3 * HYENA_W; const float* sb = p.hy_short_b + l * 3 * HYENA_W;
    float z[3];
#pragma unroll
    for (int part = 0; part < 3; ++part) {
      int cc = part * HYENA_W + ch; float acc = sb[cc];
#pragma unroll
      for (int j = 0; j < 3; ++j) { int tt = t + j - 1; if (tt >= 0 && tt < Ls) acc += p.proj[(base + tt) * IN_W + HY_OFF + cc] * sw[j * 3 * HYENA_W + cc]; }
      z[part] = acc;
    }
    long o = r < NL ? ((r / SEQ) * HYENA_W + ch) * SEQ + t : i;
    p.hu[o] = z[0] * z[1]; p.hx0[o] = z[2];
  }
  FOR_ITEMS(i, (long)BATCH * 2 * S5_GROUPS * NCH * S5_STATE) {
    int pp = (int)(i % S5_STATE); int c = (int)((i / S5_STATE) % NCH); int g = (int)((i / (S5_STATE * NCH)) % S5_GROUPS);
    int dir = (int)((i / (S5_STATE * NCH * S5_GROUPS)) % 2); int b = (int)(i / (S5_STATE * NCH * S5_GROUPS * 2));
    long ldg = ((long)l * 2 + dir) * S5_GROUPS + g;
    float sr = 0.f, si = 0.f;
    for (int s = 0; s < S5_T; ++s) {
      const float* u = p.proj + s5_row(b, dir, c * S5_T + s) * IN_W + S5_OFF + g * S5_GROUP;
      float br = 0.f, bi = 0.f;
#pragma unroll
      for (int j = 0; j < S5_GROUP; ++j) { float2 bb = p.bbar[(ldg * S5_STATE + pp) * S5_GROUP + j]; br += bb.x * u[j]; bi += bb.y * u[j]; }
      float2 lp = p.lampow[(ldg * (S5_T + 1) + (S5_T - 1 - s)) * S5_STATE + pp];
      sr += lp.x * br - lp.y * bi; si += lp.x * bi + lp.y * br;
    }
    p.sc[i] = make_float2(sr, si);
  }
}
DEV void attn_item(const P& p, int l, long r, int h, float* outp) {
  const float scale = 1.0f / sqrtf((float)HEAD_DIM);
  float q[HEAD_DIM], acc[HEAD_DIM];
  const float* qp = p.proj + r * IN_W + Q_OFF + h * HEAD_DIM;
#pragma unroll
  for (int d = 0; d < HEAD_DIM; ++d) { q[d] = qp[d] * scale; acc[d] = 0.f; }
  int kvh = h / Q_GROUP; int b = r < NL ? (int)(r / SEQ) : (int)((r - NL) / CTX_LEN);
  float m = -1e30f, lsum = 0.f;
  int nwin = 0, t = 0;
  if (r < NL) { t = (int)(r % SEQ); nwin = 2 * WINDOW + 1; }
  for (int j = 0; j < nwin + CTX_LEN; ++j) {
    long kr;
    if (j < nwin) { int tk = t - WINDOW + j; if (tk < 0 || tk >= SEQ) continue; kr = (long)b * SEQ + tk; }
    else kr = (long)NL + b * CTX_LEN + (j - nwin);
    const float* kp = p.proj + kr * IN_W + K_OFF + kvh * HEAD_DIM; const float* vp = p.proj + kr * IN_W + V_OFF + kvh * HEAD_DIM;
    float s = 0.f;
#pragma unroll
    for (int d = 0; d < HEAD_DIM; ++d) s += q[d] * kp[d];
    float mn = fmaxf(m, s); float corr = expf(m - mn); float pe = expf(s - mn);
    lsum = lsum * corr + pe;
#pragma unroll
    for (int d = 0; d < HEAD_DIM; ++d) acc[d] = acc[d] * corr + pe * vp[d];
    m = mn;
  }
  float sk = p.sink[l * N_Q_HEADS + h]; float mf = fmaxf(m, sk); float corr = expf(m - mf);
  float den = lsum * corr + expf(sk - mf); float sc2 = corr / den;
#pragma unroll
  for (int d = 0; d < HEAD_DIM; ++d) outp[d] = acc[d] * sc2;
}
DEV void ph_mix(const P& p, int l, long gtid, long gsize) {
#ifdef CPU_TEST
  long nrows_att = l == 0 ? NR : NL;
  FOR_ITEMS(i, nrows_att * N_Q_HEADS) { int h = (int)(i % N_Q_HEADS); long r = i / N_Q_HEADS; attn_item(p, l, r, h, p.mixb + r * MIX_W + h * HEAD_DIM); }
#endif
#ifdef CPU_TEST
  FOR_ITEMS(i, (long)NL * HYENA_W) {
    int ch = (int)(i % HYENA_W); long r = i / HYENA_W; int t = (int)(r % SEQ); int b = (int)(r / SEQ);
    const float* kf = p.kraw + ((long)l * 2 * HYENA_W + ch) * SEQ; const float* kb = p.kraw + ((long)l * 2 * HYENA_W + HYENA_W + ch) * SEQ;
    const float* uu = p.hu + ((long)b * HYENA_W + ch) * SEQ;
    float acc = 0.f;
    for (int s = 0; s <= t; ++s) acc += kf[t - s] * uu[s];
    for (int s = t + 1; s < SEQ; ++s) acc += kb[s - t] * uu[s];
    p.mixb[r * MIX_W + ATTN_W + ch] = (acc * p.knorm[l * HYENA_W + ch] + uu[t] * p.hy_d[l * HYENA_W + ch]) * p.hx0[((long)b * HYENA_W + ch) * SEQ + t];
  }
#endif
  if (l == 0) {
    FOR_ITEMS(i, (long)NC * HYENA_W) {
      int ch = (int)(i % HYENA_W); long r = NL + i / HYENA_W; int t = (int)((r - NL) % CTX_LEN); long base = r - t;
      float acc = 0.f;
      for (int s = 0; s <= t; ++s) acc += p.krawc[(long)ch * CTX_LEN + (t - s)] * p.hu[(base + s) * HYENA_W + ch];
      for (int s = t + 1; s < CTX_LEN; ++s) acc += p.krawc[(long)(HYENA_W + ch) * CTX_LEN + (s - t)] * p.hu[(base + s) * HYENA_W + ch];
      float u = p.hu[r * HYENA_W + ch];
      p.mixb[r * MIX_W + ATTN_W + ch] = (acc * p.knormc[ch] + u * p.hy_d[l * HYENA_W + ch]) * p.hx0[r * HYENA_W + ch];
    }
  }
  FOR_ITEMS(i, (long)BATCH * 2 * S5_GROUPS * S5_STATE) {
    int pp = (int)(i % S5_STATE); int g = (int)((i / S5_STATE) % S5_GROUPS); int dir = (int)((i / (S5_STATE * S5_GROUPS)) % 2); int b = (int)(i / (S5_STATE * S5_GROUPS * 2));
    long ldg = ((long)l * 2 + dir) * S5_GROUPS + g;
    float2 lt = p.lampow[(ldg * (S5_T + 1) + S5_T) * S5_STATE + pp];
    float hr = 0.f, hi = 0.f;
    long base = (((long)b * 2 + dir) * S5_GROUPS + g) * NCH;
    for (int c = 0; c < NCH; ++c) {
      p.hc[(base + c) * S5_STATE + pp] = make_float2(hr, hi);
      float2 s = p.sc[(base + c) * S5_STATE + pp];
      float nr = lt.x * hr - lt.y * hi + s.x, ni = lt.x * hi + lt.y * hr + s.y;
      hr = nr; hi = ni;
    }
  }
}
DEV void ph_s5out(const P& p, int l, long gtid, long gsize) {
  FOR_ITEMS(i, (long)NR * S5_W) {
    int chn = (int)(i % S5_W); long r = i / S5_W; int g = chn / S5_GROUP, ii = chn % S5_GROUP;
    int b, tl; bool isctx = r >= NL;
    if (isctx) { b = (int)((r - NL) / CTX_LEN); tl = (int)((r - NL) % CTX_LEN); } else { b = (int)(r / SEQ); tl = (int)(r % SEQ); }
    float y = p.s5_d[l * S5_W + chn] * p.proj[r * IN_W + S5_OFF + chn];
    for (int dir = 0; dir < 2; ++dir) {
      int n = isctx ? (dir ? CTX_LEN - 1 - tl : tl) : CTX_LEN + (dir ? SEQ - 1 - tl : tl);
      int c = n / S5_T, tau = n % S5_T;
      long ldg = ((long)l * 2 + dir) * S5_GROUPS + g;
      long hb = ((((long)b * 2 + dir) * S5_GROUPS + g) * NCH + c) * S5_STATE;
      for (int pp = 0; pp < S5_STATE; ++pp) {
        float cr = p.s5_c_re[(ldg * S5_GROUP + ii) * S5_STATE + pp], ci = p.s5_c_im[(ldg * S5_GROUP + ii) * S5_STATE + pp];
        float2 lp = p.lampow[(ldg * (S5_T + 1) + tau + 1) * S5_STATE + pp]; float2 h = p.hc[hb + pp];
        float tr = lp.x * h.x - lp.y * h.y, ti = lp.x * h.y + lp.y * h.x;
        y += cr * tr - ci * ti;
      }
      for (int s = 0; s <= tau; ++s) {
        const float* u = p.proj + s5_row(b, dir, c * S5_T + s) * IN_W + S5_OFF + g * S5_GROUP;
        const float* kk = p.kc + ((ldg * S5_T + (tau - s)) * S5_GROUP + ii) * S5_GROUP;
#pragma unroll
        for (int j = 0; j < S5_GROUP; ++j) y += kk[j] * u[j];
      }
    }
    float gy = gelu_tanhf(y); p.ybuf[i] = gy; p.ybf[i] = f2bf16(gy);
  }
}
struct EpiGlu { const float* g; float* mixb; DEVM void operator()(long r, int n, float v) const { mixb[r * MIX_W + ATTN_W + HYENA_W + n] = g[r * S5_W + n] * sigmoidf_(v); } };
DEV void ph_glu(const P& p, int l, long gtid, long gsize) {
  EpiGlu e{p.ybuf, p.mixb};
  gemm_naive(p.ybuf, S5_W, p.s5_w_glu + (long)l * S5_W * S5_W, S5_W, NR, S5_W, S5_W, e, gtid, gsize);
}
DEV void ph_rms(const P& p, int l, long gtid, long gsize) {
  FOR_ITEMS(i, (long)NR * 3) {
    int grp = (int)(i % 3); long r = i / 3;
    int off = grp == 0 ? 0 : (grp == 1 ? ATTN_W : ATTN_W + HYENA_W); int w = grp == 0 ? ATTN_W : (grp == 1 ? HYENA_W : S5_W);
    float* v = p.mixb + r * MIX_W + off; float ss = 0.f;
    for (int k = 0; k < w; ++k) ss += v[k] * v[k];
    float rs = 1.0f / sqrtf(ss / (float)w + LN_EPS);
    for (int k = 0; k < w; ++k) { float nv = v[k] * rs * p.mix_g[l * MIX_W + off + k]; v[k] = nv; p.mixbf[r * MIX_W + off + k] = f2bf16(nv); }
  }
}
struct EpiRes { const float* xcur; const float* mod; int l; int goff; float* tmp;
  DEVM void operator()(long r, int n, float v) const { const float* m = mod + ((long)l * (BATCH + 1) + modrow(r)) * 6 * D_MODEL + goff; tmp[r * D_MODEL + n] = DN_ALPHA * xcur[r * D_MODEL + n] + m[n] * v; } };
DEV void ph_outproj(const P& p, int l, long gtid, long gsize) {
  EpiRes e{p.xcur, p.mod, l, 2 * D_MODEL, p.tmp};
  gemm_naive(p.mixb, MIX_W, p.w_out + (long)l * MIX_W * D_MODEL, D_MODEL, NR, D_MODEL, MIX_W, e, gtid, gsize);
}
DEV void ph_ln(const P& p, int l, int which, long gtid, long gsize) {
  const float* gw = (which == 0 ? p.ln1_g : p.ln2_g) + l * D_MODEL; const float* bw = (which == 0 ? p.ln1_b : p.ln2_b) + l * D_MODEL;
  FOR_ITEMS(r, (long)NR) {
    const float* v = p.tmp + r * D_MODEL; float mu = 0.f;
#pragma unroll 4
    for (int k = 0; k < D_MODEL; ++k) mu += v[k];
    mu /= (float)D_MODEL; float var = 0.f;
#pragma unroll 4
    for (int k = 0; k < D_MODEL; ++k) { float d = v[k] - mu; var += d * d; }
    float rs = 1.0f / sqrtf(var / (float)D_MODEL + LN_EPS);
    const float* m = p.mod + ((long)l * (BATCH + 1) + modrow(r)) * 6 * D_MODEL + 3 * D_MODEL;
#pragma unroll 2
    for (int k = 0; k < D_MODEL; ++k) {
      float y = (v[k] - mu) * rs * gw[k] + bw[k];
      p.xcur[r * D_MODEL + k] = y;
      if (which == 0) { float uv = y * (1.0f + m[D_MODEL + k]) + m[k]; p.ubuf[r * D_MODEL + k] = uv; p.ubf[r * D_MODEL + k] = f2bf16(uv); }
      if (which == 1 && l == DEPTH - 1 && r < NL) p.out[r * D_MODEL + k] = y;
    }
  }
}
DEV void ph_router(const P& p, int l, long gtid, long gsize) {
  EpiStore e{p.rl, N_EXPERTS};
  gemm_naive(p.ubuf, D_MODEL, p.w_router + (long)l * D_MODEL * N_EXPERTS, N_EXPERTS, NR, N_EXPERTS, D_MODEL, e, gtid, gsize);
}
DEV bool better(float v, int i, float bv, int bi) { return v > bv || (v == bv && i < bi); }
DEV void ph_select(const P& p, int l, long gtid, long gsize) {
  FOR_ITEMS(r, (long)NR) {
    const float* lg = p.rl + r * N_EXPERTS; const float* rb = p.router_bias + l * N_EXPERTS;
    float gs[N_EXPERT_GROUPS];
#pragma unroll
    for (int g = 0; g < N_EXPERT_GROUPS; ++g) {
      float m1 = -1e30f, m2 = -1e30f;
      for (int e = 0; e < EPG; ++e) { float v = sigmoidf_(lg[g * EPG + e]) + rb[g * EPG + e]; if (v > m1) { m2 = m1; m1 = v; } else if (v > m2) m2 = v; }
      gs[g] = m1 + m2;
    }
    unsigned keep = 0;
#pragma unroll
    for (int it = 0; it < TOPK_GROUPS; ++it) {
      float bv = -1e30f; int bi = -1;
#pragma unroll
      for (int g = 0; g < N_EXPERT_GROUPS; ++g) if (!((keep >> g) & 1u) && (bi < 0 || gs[g] > bv)) { bv = gs[g]; bi = g; }
      keep |= 1u << bi;
    }
    float lastv = 1e30f; int lasti = -1; float gsum = 0.f;
    for (int it = 0; it < TOP_K; ++it) {
      float bv = -1e30f; int bi = -1;
      for (int e = 0; e < N_EXPERTS; ++e) {
        if (!((keep >> (e / EPG)) & 1u)) continue;
        float v = sigmoidf_(lg[e]) + rb[e];
        if (!better(lastv, lasti, v, e)) continue;
        if (bi < 0 || better(v, e, bv, bi)) { bv = v; bi = e; }
      }
      lastv = bv; lasti = bi;
      float sc = sigmoidf_(lg[bi]); gsum += sc;
      p.top_e[r * TOP_K + it] = bi; p.gate[r * TOP_K + it] = sc;
      p.posb[r * TOP_K + it] = atomicAdd(&p.cnt[l * N_EXPERTS + bi], 1);
    }
    float inv = ROUTED_SCALE / gsum;
    for (int it = 0; it < TOP_K; ++it) p.gate[r * TOP_K + it] *= inv;
  }
}
DEV void ph_sortrows(const P& p, int l, long gtid, long gsize) {
  FOR_ITEMS(i, (long)NR * TOP_K) {
    int e = p.top_e[i]; int off = 0;
    for (int j = 0; j < e; ++j) off += p.cnt[l * N_EXPERTS + j];
    p.srow[off + p.posb[i]] = (int)i;
  }
}
DEV void ph_expert_up(const P& p, int l, long gtid, long gsize) {
  FOR_ITEMS(i, (long)NR * TOP_K * EXPERT_FF) {
    int cidx = (int)(i % EXPERT_FF); int a = p.srow[i / EXPERT_FF]; int e = p.top_e[a]; long r = a / TOP_K;
    const float* xg = p.ubuf + r * D_MODEL;
    const float* wg = p.w_exp_gate + ((long)l * N_EXPERTS + e) * D_MODEL * EXPERT_FF; const float* wu = p.w_exp_up + ((long)l * N_EXPERTS + e) * D_MODEL * EXPERT_FF;
    float g = 0.f, u = 0.f;
    for (int k = 0; k < D_MODEL; ++k) { float xv = xg[k]; g += xv * wg[(long)k * EXPERT_FF + cidx]; u += xv * wu[(long)k * EXPERT_FF + cidx]; }
    p.hbuf[(long)a * EXPERT_FF + cidx] = siluf(g) * u;
  }
  FOR_ITEMS(i, (long)NR * SHARED_FF) {
    int cidx = (int)(i % SHARED_FF); long r = i / SHARED_FF;
    const float* xg = p.ubuf + r * D_MODEL;
    const float* wg = p.w_sh_gate + (long)l * D_MODEL * SHARED_FF; const float* wu = p.w_sh_up + (long)l * D_MODEL * SHARED_FF;
    float g = 0.f, u = 0.f;
    for (int k = 0; k < D_MODEL; ++k) { float xv = xg[k]; g += xv * wg[(long)k * SHARED_FF + cidx]; u += xv * wu[(long)k * SHARED_FF + cidx]; }
    p.hsb[i] = siluf(g) * u;
  }
}
DEV void ph_expert_down(const P& p, int l, long gtid, long gsize) {
  FOR_ITEMS(i, (long)NR * TOP_K * D_MODEL) {
    int d = (int)(i % D_MODEL); long a = i / D_MODEL;
    int e = p.top_e[a]; const float* wd = p.w_exp_down + ((long)l * N_EXPERTS + e) * EXPERT_FF * D_MODEL;
    const float* h = p.hbuf + a * EXPERT_FF; float acc = 0.f;
    for (int cidx = 0; cidx < EXPERT_FF; ++cidx) acc += h[cidx] * wd[(long)cidx * D_MODEL + d];
    p.yk[i] = acc * p.gate[a];
  }
  FOR_ITEMS(i, (long)NR * D_MODEL) {
    int d = (int)(i % D_MODEL); long r = i / D_MODEL;
    const float* wsd = p.w_sh_down + (long)l * SHARED_FF * D_MODEL; const float* hs = p.hsb + r * SHARED_FF;
    float acc = 0.f;
    for (int cidx = 0; cidx < SHARED_FF; ++cidx) acc += hs[cidx] * wsd[(long)cidx * D_MODEL + d];
    p.ysh[i] = acc;
  }
}
DEV void ph_combine(const P& p, int l, long gtid, long gsize) {
#pragma unroll 1
  FOR_ITEMS(i, (long)NR * D_MODEL) {
    int d = (int)(i % D_MODEL); long r = i / D_MODEL;
    float f = p.ysh[i];
#pragma unroll
    for (int k = 0; k < TOP_K; ++k) f += p.yk[(r * TOP_K + k) * D_MODEL + d];
    const float* m = p.mod + ((long)l * (BATCH + 1) + modrow(r)) * 6 * D_MODEL + 5 * D_MODEL;
    p.tmp[i] = DN_ALPHA * p.xcur[i] + m[d] * f;
  }
}
#define NLP 16


#ifndef CPU_TEST
typedef __attribute__((ext_vector_type(8))) short bf16x8;
typedef __attribute__((ext_vector_type(4))) float f32x4;
typedef __attribute__((ext_vector_type(4))) unsigned u32x4;
static_assert(N_EXPERTS == 256 && D_MODEL % 128 == 0 && NR % 128 == 0, "shape assumptions");
#define SM_XB 0
#define SM_A 256
#define SM_B (256 + 16384)
#define SM_MISC (256 + 32768)
#define SMEM_BYTES (256 + 32768 + 2 * 8272 * 2)

DEV int otid() { int t = threadIdx.x; asm volatile("" : "+v"(t)); return t; }
DEV unsigned f2bf(float f) { unsigned u = __float_as_uint(f); return (u + 0x7fffu + ((u >> 16) & 1u)) >> 16; }
DEV unsigned pack2(float a, float b) { return f2bf(a) | (f2bf(b) << 16); }
DEV int tile_off(int row, int chunk) { return row * 128 + ((chunk ^ ((row >> 1) & 7)) << 4); }

DEV float bflo(float x) { return x - __uint_as_float(f2bf(x) << 16); }
template <int BMODE>
DEV void gemm128(const unsigned short* const (&arow)[4], const float* bbase, int ldb, int K, f32x4 (&acc)[4][4], char* smem) {
  const int tid = otid(), lane = tid & 63, wid = tid >> 6, wr = wid >> 1, wc = wid & 1;
  char* As = smem + SM_A; char* Bs = smem + SM_B;
  const int achunk = tid & 7, arow0 = tid >> 3;
  const int kq = tid & 7, nq = tid >> 3;
  u32x4 ra[4]; float4 rb[8];
#pragma unroll
  for (int i = 0; i < 4; ++i) ra[i] = *(const u32x4*)(arow[i]);
#pragma unroll
  for (int i = 0; i < 8; ++i) rb[i] = *(const float4*)(bbase + (long)i * ldb);
  const int nk = K >> 6;
#pragma unroll 1
  for (int kt = 0; kt < nk; ++kt) {
    __syncthreads();
#pragma unroll
    for (int i = 0; i < 4; ++i) *(u32x4*)(As + tile_off(arow0 + 32 * i, achunk)) = ra[i];
    if (BMODE == 1) {
#pragma unroll
      for (int i = 0; i < 8; ++i) { rb[i].x = bflo(rb[i].x); rb[i].y = bflo(rb[i].y); rb[i].z = bflo(rb[i].z); rb[i].w = bflo(rb[i].w); }
    }
    {
      u32x4 v;
      v[0] = pack2(rb[0].x, rb[1].x); v[1] = pack2(rb[2].x, rb[3].x); v[2] = pack2(rb[4].x, rb[5].x); v[3] = pack2(rb[6].x, rb[7].x);
      *(u32x4*)(Bs + tile_off(nq * 4 + 0, kq)) = v;
      v[0] = pack2(rb[0].y, rb[1].y); v[1] = pack2(rb[2].y, rb[3].y); v[2] = pack2(rb[4].y, rb[5].y); v[3] = pack2(rb[6].y, rb[7].y);
      *(u32x4*)(Bs + tile_off(nq * 4 + 1, kq)) = v;
      v[0] = pack2(rb[0].z, rb[1].z); v[1] = pack2(rb[2].z, rb[3].z); v[2] = pack2(rb[4].z, rb[5].z); v[3] = pack2(rb[6].z, rb[7].z);
      *(u32x4*)(Bs + tile_off(nq * 4 + 2, kq)) = v;
      v[0] = pack2(rb[0].w, rb[1].w); v[1] = pack2(rb[2].w, rb[3].w); v[2] = pack2(rb[4].w, rb[5].w); v[3] = pack2(rb[6].w, rb[7].w);
      *(u32x4*)(Bs + tile_off(nq * 4 + 3, kq)) = v;
    }
    __syncthreads();
    if (kt + 1 < nk) {
      const int ko = (kt + 1) << 6;
#pragma unroll
      for (int i = 0; i < 4; ++i) ra[i] = *(const u32x4*)(arow[i] + ko);
#pragma unroll
      for (int i = 0; i < 8; ++i) rb[i] = *(const float4*)(bbase + (long)(ko + i) * ldb);
    }
#pragma unroll
    for (int ks = 0; ks < 2; ++ks) {
      bf16x8 af[4];
      const int ch = ks * 4 + (lane >> 4);
#pragma unroll
      for (int m = 0; m < 4; ++m) af[m] = *(const bf16x8*)(As + tile_off(wr * 64 + m * 16 + (lane & 15), ch));
#pragma unroll
      for (int n = 0; n < 4; ++n) {
        const bf16x8 bfr = *(const bf16x8*)(Bs + tile_off(wc * 64 + n * 16 + (lane & 15), ch));
#pragma unroll
        for (int m = 0; m < 4; ++m) acc[m][n] = __builtin_amdgcn_mfma_f32_16x16x32_bf16(af[m], bfr, acc[m][n], 0, 0, 0);
      }
    }
  }
}
DEV void acc_zero(f32x4 (&acc)[4][4]) {
#pragma unroll
  for (int m = 0; m < 4; ++m)
#pragma unroll
    for (int n = 0; n < 4; ++n) acc[m][n] = (f32x4){0.f, 0.f, 0.f, 0.f};
}
#define EPI_ROW(m, j) (((tid >> 7) & 1) * 64 + (m) * 16 + ((tid & 63) >> 4) * 4 + (j))
#define EPI_COL(n) (((tid >> 6) & 1) * 64 + (n) * 16 + (tid & 15))

template <class Epi>
DEV void gemm_phase_dense(const unsigned short* A, int lda, const float* B, int ldb, int N, int K, Epi epi, char* smem) {
  const int tid = otid(); const int nct = N >> 7; const int nitems = (NR >> 7) * nct;
  for (int it = blockIdx.x; it < nitems; it += gridDim.x) {
    const int rt = it / nct, ct = it - rt * nct;
    const unsigned short* arow[4];
#pragma unroll
    for (int i = 0; i < 4; ++i) arow[i] = A + (long)(rt * 128 + (tid >> 3) + 32 * i) * lda + (tid & 7) * 8;
    const float* bbase = B + (long)((tid & 7) * 8) * ldb + ct * 128 + (tid >> 3) * 4;
    f32x4 acc[4][4]; acc_zero(acc);
    gemm128<0>(arow, bbase, ldb, K, acc, smem);
#pragma unroll
    for (int m = 0; m < 4; ++m)
#pragma unroll
      for (int n = 0; n < 4; ++n)
#pragma unroll
        for (int j = 0; j < 4; ++j) epi((long)rt * 128 + EPI_ROW(m, j), ct * 128 + EPI_COL(n), acc[m][n][j]);
  }
}
DEV void ph_proj_mfma(const P& p, int l, char* smem) {
  EpiStore e{p.proj, IN_W};
  gemm_phase_dense(p.ubf, D_MODEL, p.w_in + (long)l * D_MODEL * IN_W, IN_W, IN_W, D_MODEL, e, smem);
}
DEV void ph_glu_mfma(const P& p, int l, char* smem) {
  EpiGlu e{p.ybuf, p.mixb};
  gemm_phase_dense(p.ybf, S5_W, p.s5_w_glu + (long)l * S5_W * S5_W, S5_W, S5_W, S5_W, e, smem);
}
DEV void ph_outproj_mfma(const P& p, int l, char* smem) {
  EpiRes e{p.xcur, p.mod, l, 2 * D_MODEL, p.tmp};
  gemm_phase_dense(p.mixbf, MIX_W, p.w_out + (long)l * MIX_W * D_MODEL, D_MODEL, D_MODEL, MIX_W, e, smem);
}
DEV void exp_prefix(const P& p, int l, int* toff, int* roff) {
  const int tid = otid();
  __syncthreads();
  {
    int t = 0;
    for (int e = 0; e < tid; ++e) { int c = p.cnt[l * N_EXPERTS + e]; t += (c + 127) >> 7; }
    const int c = p.cnt[l * N_EXPERTS + tid];
    toff[tid] = t; roff[tid] = c;
    if (tid == N_EXPERTS - 1) toff[N_EXPERTS] = t + ((c + 127) >> 7);
  }
  __syncthreads();
}
DEV int exp_find(const int* toff, int tile) {
  int lo = 0, hi = N_EXPERTS - 1;
  while (lo < hi) { int mid = (lo + hi + 1) >> 1; if (toff[mid] <= tile) lo = mid; else hi = mid - 1; }
  return lo;
}
DEV void ph_expert_up_mfma(const P& p, int l, char* smem) {
  const int tid = otid(), lane = tid & 63, wc = (tid >> 6) & 1;
  int* toff = (int*)(smem + SM_MISC); int* roff = toff + N_EXPERTS + 1;
  exp_prefix(p, l, toff, roff);
  const int ntile = toff[N_EXPERTS];
  const int n_exp_items = ntile * (EXPERT_FF / 64);
  const int n_sh_items = (NR >> 7) * (SHARED_FF / 64);
  const int nq = tid >> 3; const int bwc = nq >> 4, bnt = (nq >> 2) & 3, bc16 = (nq & 3) * 4;
  for (int it = blockIdx.x; it < n_exp_items + n_sh_items; it += gridDim.x) {
    const bool shared = it >= n_exp_items;
    int cq, nrows, rbase = 0, e = 0; const float *wg, *wu;
    if (!shared) {
      const int tile = it / (EXPERT_FF / 64); cq = it - tile * (EXPERT_FF / 64);
      e = exp_find(toff, tile); const int j0 = (tile - toff[e]) * 128;
      nrows = min(128, roff[e] - j0); rbase = e * NR + j0;
      wg = p.w_exp_gate + ((long)l * N_EXPERTS + e) * D_MODEL * EXPERT_FF; wu = p.w_exp_up + ((long)l * N_EXPERTS + e) * D_MODEL * EXPERT_FF;
    } else {
      const int it2 = it - n_exp_items; const int rt = it2 / (SHARED_FF / 64); cq = it2 - rt * (SHARED_FF / 64);
      nrows = 128; rbase = rt * 128;
      wg = p.w_sh_gate + (long)l * D_MODEL * SHARED_FF; wu = p.w_sh_up + (long)l * D_MODEL * SHARED_FF;
    }
    const unsigned short* arow[4];
#pragma unroll
    for (int i = 0; i < 4; ++i) {
      int rl = min((tid >> 3) + 32 * i, nrows - 1);
      long r = shared ? (long)(rbase + rl) : (long)(p.elist[rbase + rl] / TOP_K);
      arow[i] = p.ubf + r * D_MODEL + (tid & 7) * 8;
    }
    const float* bbase = (bnt < 2 ? wg : wu) + (long)((tid & 7) * 8) * EXPERT_FF + cq * 64 + bwc * 32 + (bnt & 1) * 16 + bc16;
    f32x4 acc[4][4]; acc_zero(acc);
    gemm128<0>(arow, bbase, EXPERT_FF, D_MODEL, acc, smem);
#pragma unroll
    for (int m = 0; m < 4; ++m)
#pragma unroll
      for (int j = 0; j < 4; ++j) {
        const int rl = EPI_ROW(m, j);
        if (rl < nrows) {
          unsigned short* dst = shared ? p.hsbf + (long)(rbase + rl) * SHARED_FF : p.hbf + (long)p.elist[rbase + rl] * EXPERT_FF;
#pragma unroll
          for (int nn = 0; nn < 2; ++nn) dst[cq * 64 + wc * 32 + nn * 16 + (lane & 15)] = (unsigned short)f2bf(siluf(acc[m][nn][j]) * acc[m][nn + 2][j]);
        }
      }
  }
}
DEV void ph_expert_down_mfma(const P& p, int l, char* smem) {
  const int tid = otid();
  int* toff = (int*)(smem + SM_MISC); int* roff = toff + N_EXPERTS + 1;
  exp_prefix(p, l, toff, roff);
  const int ntile = toff[N_EXPERTS];
  const int n_exp_items = ntile * (D_MODEL / 128);
  const int n_sh_items = (NR >> 7) * (D_MODEL / 128);
  for (int it = blockIdx.x; it < n_exp_items + n_sh_items; it += gridDim.x) {
    const bool shared = it >= n_exp_items;
    int ct, nrows, rbase, e = 0; const float* wd;
    if (!shared) {
      const int tile = it / (D_MODEL / 128); ct = it - tile * (D_MODEL / 128);
      e = exp_find(toff, tile); const int j0 = (tile - toff[e]) * 128;
      nrows = min(128, roff[e] - j0); rbase = e * NR + j0;
      wd = p.w_exp_down + ((long)l * N_EXPERTS + e) * EXPERT_FF * D_MODEL;
    } else {
      const int it2 = it - n_exp_items; const int rt = it2 / (D_MODEL / 128); ct = it2 - rt * (D_MODEL / 128);
      nrows = 128; rbase = rt * 128; wd = p.w_sh_down + (long)l * SHARED_FF * D_MODEL;
    }
    const unsigned short* arow[4];
#pragma unroll
    for (int i = 0; i < 4; ++i) {
      int rl = min((tid >> 3) + 32 * i, nrows - 1);
      arow[i] = shared ? p.hsbf + (long)(rbase + rl) * SHARED_FF + (tid & 7) * 8 : p.hbf + (long)p.elist[rbase + rl] * EXPERT_FF + (tid & 7) * 8;
    }
    const float* bbase = wd + (long)((tid & 7) * 8) * D_MODEL + ct * 128 + (tid >> 3) * 4;
    f32x4 acc[4][4]; acc_zero(acc);
    gemm128<0>(arow, bbase, D_MODEL, EXPERT_FF, acc, smem);
#pragma unroll
    for (int m = 0; m < 4; ++m)
#pragma unroll
      for (int j = 0; j < 4; ++j) {
        const int rl = EPI_ROW(m, j);
        if (rl < nrows) {
          float* dst; float gsc = 1.0f;
          if (shared) dst = p.ysh + (long)(rbase + rl) * D_MODEL; else { int a = p.elist[rbase + rl]; dst = p.yk + (long)a * D_MODEL; gsc = p.gate[a]; }
#pragma unroll
          for (int n = 0; n < 4; ++n) dst[ct * 128 + EPI_COL(n)] = acc[m][n][j] * gsc;
        }
      }
  }
}

typedef __attribute__((ext_vector_type(16))) float f32x16;
#define SM_HR 256
#define UB_STRIDE 8272
#define SM_HU (256 + 32768)
#define SMEM_HY (256 + 32768 + 2 * UB_STRIDE * 2)
static_assert(SEQ == 8192 && HYENA_W == 256, "hyena mfma shape");
DEV void ph_hyena_mfma(const P& p, int l, char* smem) {
  const int tid = otid(), lane = tid & 63, w = tid >> 6;
  unsigned short* R = (unsigned short*)(smem + SM_HR); unsigned short* U = (unsigned short*)(smem + SM_HU);
  for (int ch = blockIdx.x; ch < HYENA_W; ch += gridDim.x) {
    __syncthreads();
    const float* kf = p.kraw + ((long)l * 2 * HYENA_W + ch) * SEQ; const float* kb = p.kraw + ((long)l * 2 * HYENA_W + HYENA_W + ch) * SEQ;
    for (int y = tid; y < 2 * SEQ; y += 256) {
      const int lag = SEQ - y; float v = 0.f;
      if (lag >= 0 && lag < SEQ) v = kf[lag]; else if (lag < 0) v = kb[-lag];
      const int C = y >> 3; R[((C ^ ((C >> 4) & 1)) << 3) + (y & 7)] = (unsigned short)f2bf(v);
    }
    for (int e = tid; e < 2 * UB_STRIDE; e += 256) {
      const int b = e / UB_STRIDE, ee = e - b * UB_STRIDE, t = ee - 16; float v = 0.f;
      if (t >= 0 && t < SEQ) v = p.hu[((long)b * HYENA_W + ch) * SEQ + t];
      U[e] = (unsigned short)f2bf(v);
    }
    __syncthreads();
    f32x16 acc[4];
#pragma unroll
    for (int mi = 0; mi < 4; ++mi)
#pragma unroll
      for (int k = 0; k < 16; ++k) acc[mi][k] = 0.f;
    const int r = lane & 31, h = lane >> 5, sig = lane & 15, bb = (lane >> 4) & 1;
    const unsigned* Ud = (const unsigned*)U + bb * (UB_STRIDE / 2);
    const int ub0 = 8 * h + sig;
    const int cbase = 1022 - 64 * (4 * w) - 2 * r + h;
    const bool odd = sig & 1;
    bf16x8 afn[4]; unsigned dn[5];
    {
#pragma unroll
      for (int mi = 0; mi < 4; ++mi) { const int C = cbase - 64 * mi; afn[mi] = *(const bf16x8*)((const char*)R + ((C ^ ((C >> 4) & 1)) << 4)); }
      const int di = ub0 >> 1;
#pragma unroll
      for (int i = 0; i < 5; ++i) dn[i] = Ud[di + i];
    }
#pragma unroll 1
    for (int q = 0; q <= SEQ / 16; ++q) {
      bf16x8 af[4]; unsigned d[5];
#pragma unroll
      for (int mi = 0; mi < 4; ++mi) af[mi] = afn[mi];
#pragma unroll
      for (int i = 0; i < 5; ++i) d[i] = dn[i];
      {
        const int qn = min(q + 1, SEQ / 16);
#pragma unroll
        for (int mi = 0; mi < 4; ++mi) { const int C = cbase - 64 * mi + 2 * qn; afn[mi] = *(const bf16x8*)((const char*)R + ((C ^ ((C >> 4) & 1)) << 4)); }
        const int di = (16 * qn + ub0) >> 1;
#pragma unroll
        for (int i = 0; i < 5; ++i) dn[i] = Ud[di + i];
      }
      u32x4 bw;
#pragma unroll
      for (int i = 0; i < 4; ++i) bw[i] = odd ? __builtin_amdgcn_alignbit(d[i + 1], d[i], 16) : d[i];
      const bf16x8 bfr = __builtin_bit_cast(bf16x8, bw);
#pragma unroll
      for (int mi = 0; mi < 4; ++mi) acc[mi] = __builtin_amdgcn_mfma_f32_32x32x16_bf16(af[mi], bfr, acc[mi], 0, 0, 0);
    }
    __syncthreads();
    {
      float* Y = (float*)(smem + SM_HR);
      float* yl = Y + bb * SEQ + 16 * (32 * (4 * w) + 4 * h) + sig;
#pragma unroll
      for (int mi = 0; mi < 4; ++mi)
#pragma unroll
        for (int k = 0; k < 16; ++k) yl[16 * (32 * mi + (k & 3) + 8 * (k >> 2))] = acc[mi][k];
    }
    __syncthreads();
    {
      const float* Y = (const float*)(smem + SM_HR);
      const float kn = p.knorm[l * HYENA_W + ch], dsk = p.hy_d[l * HYENA_W + ch];
#pragma unroll 2
      for (int idx = tid; idx < BATCH * SEQ; idx += 256) {
        const int b = idx / SEQ, t = idx - b * SEQ;
        const long o = ((long)b * HYENA_W + ch) * SEQ + t;
        p.mixb[(long)idx * MIX_W + ATTN_W + ch] = (Y[idx] * kn + p.hu[o] * dsk) * p.hx0[o];
      }
    }
  }
}

typedef __attribute__((ext_vector_type(2))) unsigned u32x2;
#define SM_K 256
#define SM_V (256 + 8192)
static_assert(HEAD_DIM == 64 && WINDOW == 128 && CTX_LEN == 256 && Q_GROUP == 4, "attention shape");
DEV void ph_attn_mfma(const P& p, int l, char* smem) {
  const int tid = otid(), lane = tid & 63, w = tid >> 6, h = lane >> 5, ql = lane & 31;
  char* Ks = smem + SM_K; char* Vs = smem + SM_V;
  const int n_lat = BATCH * (SEQ / 128) * N_KV_HEADS * Q_GROUP;
  const int n_ctx = (l == 0) ? BATCH * (CTX_LEN / 128) * N_KV_HEADS * Q_GROUP : 0;
  const float QS = 0.125f * 1.4426950408889634f;
  for (int it = blockIdx.x; it < n_lat + n_ctx; it += gridDim.x) {
    const bool isctx = it >= n_lat;
    int b, qb, kvh, g;
    { int x = isctx ? it - n_lat : it; g = x & 3; kvh = (x >> 2) & 1; x >>= 3; if (isctx) { qb = x & 1; b = x >> 1; } else { qb = x & 63; b = x >> 6; } }
    const int hq = kvh * Q_GROUP + g;
    const int tq0 = qb * 128 + 32 * w;
    const long qrow = (isctx ? (long)NL + b * CTX_LEN : (long)b * SEQ) + tq0 + ql;
    bf16x8 qf[4];
    {
      const float* qp = p.proj + qrow * IN_W + Q_OFF + hq * HEAD_DIM + 8 * h;
#pragma unroll
      for (int ks = 0; ks < 4; ++ks) {
        float4 a = *(const float4*)(qp + 16 * ks), c = *(const float4*)(qp + 16 * ks + 4);
        u32x4 v; v[0] = pack2(a.x * QS, a.y * QS); v[1] = pack2(a.z * QS, a.w * QS); v[2] = pack2(c.x * QS, c.y * QS); v[3] = pack2(c.z * QS, c.w * QS);
        qf[ks] = __builtin_bit_cast(bf16x8, v);
      }
    }
    f32x16 o0, o1;
#pragma unroll
    for (int k = 0; k < 16; ++k) { o0[k] = 0.f; o1[k] = 0.f; }
    float m = -1e30f, lsum = 0.f;
    const int nsteps = isctx ? 4 : 10;
    float4 rk[2][2], rv[2][2];
    auto key_row = [&](int step, int key) -> long {
      if (step < 4) return (long)NL + b * CTX_LEN + step * 64 + key;
      const int tk = qb * 128 - 128 + (step - 4) * 64 + key;
      return (tk < 0 || tk >= SEQ) ? -1 : (long)b * SEQ + tk;
    };
    auto step_valid = [&](int step) -> bool { if (step < 4) return true; const int t0 = qb * 128 - 128 + (step - 4) * 64; return t0 >= 0 && t0 < SEQ; };
    auto load_tile = [&](int step) {
#pragma unroll
      for (int i = 0; i < 2; ++i) {
        const int key = (tid >> 3) + 32 * i; const long kr = key_row(step, key);
        const float* kp = p.proj + kr * IN_W + K_OFF + kvh * HEAD_DIM + (tid & 7) * 8; const float* vp = p.proj + kr * IN_W + V_OFF + kvh * HEAD_DIM + (tid & 7) * 8;
        rk[i][0] = *(const float4*)kp; rk[i][1] = *(const float4*)(kp + 4); rv[i][0] = *(const float4*)vp; rv[i][1] = *(const float4*)(vp + 4);
      }
    };
    int step = 0;
    load_tile(0);
    while (step < nsteps) {
      __syncthreads();
#pragma unroll
      for (int i = 0; i < 2; ++i) {
        const int key = (tid >> 3) + 32 * i, ch = tid & 7;
        u32x4 v; v[0] = pack2(rk[i][0].x, rk[i][0].y); v[1] = pack2(rk[i][0].z, rk[i][0].w); v[2] = pack2(rk[i][1].x, rk[i][1].y); v[3] = pack2(rk[i][1].z, rk[i][1].w);
        *(u32x4*)(Ks + tile_off(key, ch)) = v;
        v[0] = pack2(rv[i][0].x, rv[i][0].y); v[1] = pack2(rv[i][0].z, rv[i][0].w); v[2] = pack2(rv[i][1].x, rv[i][1].y); v[3] = pack2(rv[i][1].z, rv[i][1].w);
        *(u32x4*)(Vs + key * 128 + ((ch * 16) ^ (64 * ((key >> 1) & 1)))) = v;
      }
      __syncthreads();
      const int cur = step;
      int nxt = step + 1;
      while (nxt < nsteps && !step_valid(nxt)) ++nxt;
      if (nxt < nsteps) load_tile(nxt);
      step = nxt;
#pragma unroll
      for (int sub = 0; sub < 2; ++sub) {
        const bool win = cur >= 4;
        const int ks0 = win ? qb * 128 - 128 + (cur - 4) * 64 + sub * 32 : 0;
        if (win && (ks0 > tq0 + 31 + WINDOW || ks0 + 31 < tq0 - WINDOW)) continue;
        f32x16 sacc;
#pragma unroll
        for (int k = 0; k < 16; ++k) sacc[k] = 0.f;
#pragma unroll
        for (int ks = 0; ks < 4; ++ks) {
          const bf16x8 kf = *(const bf16x8*)(Ks + tile_off(sub * 32 + ql, 2 * ks + h));
          sacc = __builtin_amdgcn_mfma_f32_32x32x16_bf16(kf, qf[ks], sacc, 0, 0, 0);
        }
        if (win && (ks0 + 31 - tq0 > WINDOW || tq0 + 31 - ks0 > WINDOW)) {
          const int tq = tq0 + ql;
#pragma unroll
          for (int k = 0; k < 16; ++k) { const int d = ks0 + (k & 3) + 8 * (k >> 2) + 4 * h - tq; if (d > WINDOW || d < -WINDOW) sacc[k] = -1e30f; }
        }
        float mx = sacc[0];
#pragma unroll
        for (int k = 1; k < 16; ++k) mx = fmaxf(mx, sacc[k]);
        mx = fmaxf(mx, __shfl_xor(mx, 32));
        const float mn = fmaxf(m, mx); const float alpha = exp2f(m - mn); m = mn;
        float ps = 0.f;
#pragma unroll
        for (int k = 0; k < 16; ++k) { sacc[k] = exp2f(sacc[k] - mn); ps += sacc[k]; }
        lsum = lsum * alpha + ps;
#pragma unroll
        for (int k = 0; k < 16; ++k) { o0[k] *= alpha; o1[k] *= alpha; }
        u32x2 v00, v01, v02, v03, v10, v11, v12, v13;
        {
          const int q4 = (lane & 15) >> 2, p4 = lane & 3, blk = (lane >> 4) & 1, sq = (q4 >> 1) & 1;
          const unsigned lb = (unsigned)(size_t)((__attribute__((address_space(3))) char*)Vs) + (unsigned)((sub * 32 + 4 * h + q4) * 128 + 32 * blk + 8 * p4);
          const unsigned base0 = lb + 64 * sq, base1 = lb + 64 * (1 - sq);
          asm volatile(
              "ds_read_b64_tr_b16 %0, %8\n\t"
              "ds_read_b64_tr_b16 %1, %8 offset:1024\n\t"
              "ds_read_b64_tr_b16 %2, %8 offset:2048\n\t"
              "ds_read_b64_tr_b16 %3, %8 offset:3072\n\t"
              "ds_read_b64_tr_b16 %4, %9\n\t"
              "ds_read_b64_tr_b16 %5, %9 offset:1024\n\t"
              "ds_read_b64_tr_b16 %6, %9 offset:2048\n\t"
              "ds_read_b64_tr_b16 %7, %9 offset:3072\n\t"
              "s_waitcnt lgkmcnt(0)"
              : "=&v"(v00), "=&v"(v01), "=&v"(v02), "=&v"(v03), "=&v"(v10), "=&v"(v11), "=&v"(v12), "=&v"(v13)
              : "v"(base0), "v"(base1) : "memory");
        }
#pragma unroll
        for (int ks2 = 0; ks2 < 2; ++ks2) {
          u32x4 pw;
#pragma unroll
          for (int i = 0; i < 4; ++i) pw[i] = pack2(sacc[8 * ks2 + 2 * i], sacc[8 * ks2 + 2 * i + 1]);
          const bf16x8 pf = __builtin_bit_cast(bf16x8, pw);
          u32x4 a0, a1;
          if (ks2 == 0) { a0[0] = v00[0]; a0[1] = v00[1]; a0[2] = v01[0]; a0[3] = v01[1]; a1[0] = v10[0]; a1[1] = v10[1]; a1[2] = v11[0]; a1[3] = v11[1]; }
          else          { a0[0] = v02[0]; a0[1] = v02[1]; a0[2] = v03[0]; a0[3] = v03[1]; a1[0] = v12[0]; a1[1] = v12[1]; a1[2] = v13[0]; a1[3] = v13[1]; }
          o0 = __builtin_amdgcn_mfma_f32_32x32x16_bf16(__builtin_bit_cast(bf16x8, a0), pf, o0, 0, 0, 0);
          o1 = __builtin_amdgcn_mfma_f32_32x32x16_bf16(__builtin_bit_cast(bf16x8, a1), pf, o1, 0, 0, 0);
        }
      }
    }
    lsum += __shfl_xor(lsum, 32);
    const float sk = p.sink[l * N_Q_HEADS + hq] * 1.4426950408889634f;
    const float mf = fmaxf(m, sk); const float sc = exp2f(m - mf); const float inv = sc / (lsum * sc + exp2f(sk - mf));
    float* op = p.mixb + qrow * MIX_W + hq * HEAD_DIM + 4 * h;
#pragma unroll
    for (int gq = 0; gq < 4; ++gq) {
      *(float4*)(op + 8 * gq) = make_float4(o0[4 * gq] * inv, o0[4 * gq + 1] * inv, o0[4 * gq + 2] * inv, o0[4 * gq + 3] * inv);
      *(float4*)(op + 32 + 8 * gq) = make_float4(o1[4 * gq] * inv, o1[4 * gq + 1] * inv, o1[4 * gq + 2] * inv, o1[4 * gq + 3] * inv);
    }
  }
}

DEV float wave_sum(float v) {
#pragma unroll
  for (int o = 32; o > 0; o >>= 1) v += __shfl_xor(v, o);
  return v;
}
DEV void st_bf4(unsigned short* dst, float a, float b, float c, float d) { u32x2 v; v[0] = pack2(a, b); v[1] = pack2(c, d); *(u32x2*)dst = v; }
DEV void ph_modu0_gpu(const P& p, long gtid, long gsize) {
  FOR_ITEMS(i4, (long)NR * D_MODEL / 4) {
    const long i = i4 * 4; const int k = (int)(i % D_MODEL); const long r = i / D_MODEL;
    const float* m = p.mod + (long)modrow(r) * 6 * D_MODEL;
    const float4 x = *(const float4*)(p.xcur + i); const float4 sh = *(const float4*)(m + k); const float4 sc = *(const float4*)(m + D_MODEL + k);
    st_bf4(p.ubf + i, x.x * (1.f + sc.x) + sh.x, x.y * (1.f + sc.y) + sh.y, x.z * (1.f + sc.z) + sh.z, x.w * (1.f + sc.w) + sh.w);
  }
}
DEV void ph_rms_gpu(const P& p, int l) {
  const int tid_ = otid(); const int lane = tid_ & 63; const int gw = blockIdx.x * 4 + (tid_ >> 6), nw = gridDim.x * 4;
  for (long r = gw; r < NR; r += nw) {
    const float* v = p.mixb + r * MIX_W; float4 a[4]; float ss[4];
#pragma unroll
    for (int i = 0; i < 4; ++i) { a[i] = *(const float4*)(v + (i * 64 + lane) * 4); ss[i] = a[i].x * a[i].x + a[i].y * a[i].y + a[i].z * a[i].z + a[i].w * a[i].w; }
    const float s_att = wave_sum(ss[0] + ss[1]), s_hy = wave_sum(ss[2]), s_s5 = wave_sum(ss[3]);
    float rs[4]; rs[0] = rs[1] = 1.0f / sqrtf(s_att / (float)ATTN_W + LN_EPS); rs[2] = 1.0f / sqrtf(s_hy / (float)HYENA_W + LN_EPS); rs[3] = 1.0f / sqrtf(s_s5 / (float)S5_W + LN_EPS);
#pragma unroll
    for (int i = 0; i < 4; ++i) {
      const int k = (i * 64 + lane) * 4; const float4 g = *(const float4*)(p.mix_g + l * MIX_W + k);
      st_bf4(p.mixbf + r * MIX_W + k, a[i].x * rs[i] * g.x, a[i].y * rs[i] * g.y, a[i].z * rs[i] * g.z, a[i].w * rs[i] * g.w);
    }
  }
}
DEV void ln_rows(float4 (&a)[4], const float* gw, const float* bw, int lane) {
  float s = 0.f;
#pragma unroll
  for (int i = 0; i < 4; ++i) s += a[i].x + a[i].y + a[i].z + a[i].w;
  const float mu = wave_sum(s) / (float)D_MODEL; float q = 0.f;
#pragma unroll
  for (int i = 0; i < 4; ++i) { a[i].x -= mu; a[i].y -= mu; a[i].z -= mu; a[i].w -= mu; q += a[i].x * a[i].x + a[i].y * a[i].y + a[i].z * a[i].z + a[i].w * a[i].w; }
  const float rs = 1.0f / sqrtf(wave_sum(q) / (float)D_MODEL + LN_EPS);
#pragma unroll
  for (int i = 0; i < 4; ++i) {
    const int k = (i * 64 + lane) * 4; const float4 g = *(const float4*)(gw + k), b = *(const float4*)(bw + k);
    a[i].x = a[i].x * rs * g.x + b.x; a[i].y = a[i].y * rs * g.y + b.y; a[i].z = a[i].z * rs * g.z + b.z; a[i].w = a[i].w * rs * g.w + b.w;
  }
}
DEV void ph_ln1_gpu(const P& p, int l) {
  const int tid_ = otid(); const int lane = tid_ & 63; const int gw = blockIdx.x * 4 + (tid_ >> 6), nw = gridDim.x * 4;
  for (long r = gw; r < NR; r += nw) {
    float4 a[4];
#pragma unroll
    for (int i = 0; i < 4; ++i) a[i] = *(const float4*)(p.tmp + r * D_MODEL + (i * 64 + lane) * 4);
    ln_rows(a, p.ln1_g + l * D_MODEL, p.ln1_b + l * D_MODEL, lane);
    const float* m = p.mod + ((long)l * (BATCH + 1) + modrow(r)) * 6 * D_MODEL + 3 * D_MODEL;
#pragma unroll
    for (int i = 0; i < 4; ++i) {
      const int k = (i * 64 + lane) * 4;
      *(float4*)(p.xcur + r * D_MODEL + k) = a[i];
      const float4 sh = *(const float4*)(m + k), sc = *(const float4*)(m + D_MODEL + k);
      const float u0 = a[i].x * (1.f + sc.x) + sh.x, u1 = a[i].y * (1.f + sc.y) + sh.y, u2 = a[i].z * (1.f + sc.z) + sh.z, u3 = a[i].w * (1.f + sc.w) + sh.w;
      st_bf4(p.ubf + r * D_MODEL + k, u0, u1, u2, u3);
      st_bf4(p.ubl + r * D_MODEL + k, bflo(u0), bflo(u1), bflo(u2), bflo(u3));
    }
  }
}
DEV void ph_ln2_gpu(const P& p, int l) {
  const int tid_ = otid(); const int lane = tid_ & 63; const int gw = blockIdx.x * 4 + (tid_ >> 6), nw = gridDim.x * 4;
  for (long r = gw; r < NR; r += nw) {
    float4 a[4];
    const float* m = p.mod + ((long)l * (BATCH + 1) + modrow(r)) * 6 * D_MODEL + 5 * D_MODEL;
#pragma unroll
    for (int i = 0; i < 4; ++i) {
      const int k = (i * 64 + lane) * 4;
      float4 f = *(const float4*)(p.ysh + r * D_MODEL + k);
#pragma unroll
      for (int kk = 0; kk < TOP_K; ++kk) { const float4 y = *(const float4*)(p.yk + (r * TOP_K + kk) * D_MODEL + k); f.x += y.x; f.y += y.y; f.z += y.z; f.w += y.w; }
      const float4 x = *(const float4*)(p.xcur + r * D_MODEL + k), g2 = *(const float4*)(m + k);
      a[i].x = DN_ALPHA * x.x + g2.x * f.x; a[i].y = DN_ALPHA * x.y + g2.y * f.y; a[i].z = DN_ALPHA * x.z + g2.z * f.z; a[i].w = DN_ALPHA * x.w + g2.w * f.w;
    }
    ln_rows(a, p.ln2_g + l * D_MODEL, p.ln2_b + l * D_MODEL, lane);
    const float* mn = p.mod + ((long)(l + 1) * (BATCH + 1) + modrow(r)) * 6 * D_MODEL;
#pragma unroll
    for (int i = 0; i < 4; ++i) {
      const int k = (i * 64 + lane) * 4;
      *(float4*)(p.xcur + r * D_MODEL + k) = a[i];
      if (l + 1 < DEPTH) {
        const float4 sh = *(const float4*)(mn + k), sc = *(const float4*)(mn + D_MODEL + k);
        st_bf4(p.ubf + r * D_MODEL + k, a[i].x * (1.f + sc.x) + sh.x, a[i].y * (1.f + sc.y) + sh.y, a[i].z * (1.f + sc.z) + sh.z, a[i].w * (1.f + sc.w) + sh.w);
      } else if (r < NL) *(float4*)(p.out + r * D_MODEL + k) = a[i];
    }
  }
}
DEV void ph_router_mfma(const P& p, int l, char* smem) {
  const int tid = otid(); const int nct = N_EXPERTS >> 7; const int nitems = (NR >> 7) * nct;
  const float* B = p.w_router + (long)l * D_MODEL * N_EXPERTS;
  for (int it = blockIdx.x; it < nitems; it += gridDim.x) {
    const int rt = it / nct, ct = it - rt * nct;
    const unsigned short *ah[4], *al[4];
#pragma unroll
    for (int i = 0; i < 4; ++i) { const long o = (long)(rt * 128 + (tid >> 3) + 32 * i) * D_MODEL + (tid & 7) * 8; ah[i] = p.ubf + o; al[i] = p.ubl + o; }
    const float* bbase = B + (long)((tid & 7) * 8) * N_EXPERTS + ct * 128 + (tid >> 3) * 4;
    f32x4 acc[4][4]; acc_zero(acc);
    gemm128<0>(ah, bbase, N_EXPERTS, D_MODEL, acc, smem);
    gemm128<1>(ah, bbase, N_EXPERTS, D_MODEL, acc, smem);
    gemm128<0>(al, bbase, N_EXPERTS, D_MODEL, acc, smem);
#pragma unroll
    for (int m = 0; m < 4; ++m)
#pragma unroll
      for (int n = 0; n < 4; ++n)
#pragma unroll
        for (int j = 0; j < 4; ++j) p.rl[((long)rt * 128 + EPI_ROW(m, j)) * N_EXPERTS + ct * 128 + EPI_COL(n)] = acc[m][n][j];
  }
}
static_assert(EPG == 32 && TOP_K == 8 && N_EXPERT_GROUPS == 8 && TOPK_GROUPS == 4, "select shape");
DEV void ph_select_gpu(const P& p, int l) {
  const int tid_ = otid(); const int lane = tid_ & 63; const int gw = blockIdx.x * 4 + (tid_ >> 6), nw = gridDim.x * 4;
  const float4 rb = *(const float4*)(p.router_bias + l * N_EXPERTS + 4 * lane);
  for (long r = gw; r < NR; r += nw) {
    const float4 lg = *(const float4*)(p.rl + r * N_EXPERTS + 4 * lane);
    float sc[4] = {sigmoidf_(lg.x), sigmoidf_(lg.y), sigmoidf_(lg.z), sigmoidf_(lg.w)};
    float bz[4] = {sc[0] + rb.x, sc[1] + rb.y, sc[2] + rb.z, sc[3] + rb.w};
    float m1 = fmaxf(bz[0], bz[1]), m2 = fminf(bz[0], bz[1]);
#pragma unroll
    for (int c = 2; c < 4; ++c) { const float v = bz[c]; m2 = fmaxf(m2, fminf(m1, v)); m1 = fmaxf(m1, v); }
#pragma unroll
    for (int o = 1; o < 8; o <<= 1) { const float b1 = __shfl_xor(m1, o), b2 = __shfl_xor(m2, o); m2 = fmaxf(fminf(m1, b1), fmaxf(m2, b2)); m1 = fmaxf(m1, b1); }
    const float gs = m1 + m2; const int mg = lane >> 3; int rank = 0;
#pragma unroll
    for (int j = 0; j < 8; ++j) { const float gj = __shfl(gs, j * 8); rank += (gj > gs || (gj == gs && j < mg)) ? 1 : 0; }
    if (rank >= TOPK_GROUPS) { bz[0] = bz[1] = bz[2] = bz[3] = -1e30f; }
    int sel_e[TOP_K]; float sel_s[TOP_K]; float gsum = 0.f;
#pragma unroll
    for (int it = 0; it < TOP_K; ++it) {
      float bv = bz[0]; int bc = 0;
#pragma unroll
      for (int c = 1; c < 4; ++c) if (bz[c] > bv) { bv = bz[c]; bc = c; }
      int bi = 4 * lane + bc; float bs = sc[bc];
      const int myi = bi;
#pragma unroll
      for (int o = 1; o < 64; o <<= 1) {
        const float ov = __shfl_xor(bv, o); const int oi = __shfl_xor(bi, o); const float os = __shfl_xor(bs, o);
        if (ov > bv || (ov == bv && oi < bi)) { bv = ov; bi = oi; bs = os; }
      }
      sel_e[it] = bi; sel_s[it] = bs; gsum += bs;
      if (bi == myi) {
#pragma unroll
        for (int c = 0; c < 4; ++c) if (c == bc) bz[c] = -1e30f;
      }
    }
    const float inv = ROUTED_SCALE / gsum;
    int me = sel_e[0]; float ms = sel_s[0];
#pragma unroll
    for (int it = 1; it < TOP_K; ++it) if (lane == it) { me = sel_e[it]; ms = sel_s[it]; }
    if (lane < TOP_K) {
      const long a = r * TOP_K + lane;
      p.top_e[a] = me; p.gate[a] = ms * inv;
      const int pos = atomicAdd(&p.cnt[l * N_EXPERTS + me], 1);
      p.elist[(long)me * NR + pos] = (int)a;
    }
  }
}
#endif

#ifndef CPU_TEST
#define XB_TMO      128
#define XB_XCNT(j)  (256  + 64 * (j))
#define XB_XSUB(j)  (1280 + 64 * (j))
#define XB_XGEN(j)  (2304 + 64 * (j))
#define XB_TOP      3328
#define XB_TOPGEN   3392
#define XCD_BAR_WORDS 3456
#define XB_SPIN_CAP (1u << 18)
#define LAS __attribute__((address_space(3)))
__device__ __forceinline__ unsigned xb_ld(unsigned* p)              { return __hip_atomic_load(p, __ATOMIC_RELAXED, __HIP_MEMORY_SCOPE_AGENT); }
__device__ __forceinline__ unsigned xb_add(unsigned* p, unsigned v) { return __hip_atomic_fetch_add(p, v, __ATOMIC_RELAXED, __HIP_MEMORY_SCOPE_AGENT); }
__device__ __forceinline__ unsigned xb_xcc_id() { return (unsigned)__builtin_amdgcn_s_getreg((3 << 11) | 20) & 0xFu; }
#define XB_SPIN(cond, bar) do { unsigned _sp = 0; while (cond) { __builtin_amdgcn_s_sleep(1); \
    if ((++_sp & 255u) == 0u) { if (xb_ld(&(bar)[XB_TMO])) break; if (_sp > XB_SPIN_CAP) { atomicAdd(&(bar)[XB_TMO], 1u); break; } } } } while (0)
struct XcdBarrier { unsigned* bar; unsigned x; volatile LAS unsigned* st; };
__device__ __forceinline__ XcdBarrier xcd_barrier_post(unsigned* bar, volatile LAS unsigned* st) {
    XcdBarrier b; b.bar = bar; b.x = xb_xcc_id(); b.st = st;
    if (threadIdx.x == 0) (void)xb_add(&bar[XB_XCNT(b.x)], 1u);
    return b;
}
__device__ __forceinline__ void xcd_barrier_complete(unsigned* bar, unsigned x, unsigned& nloc, unsigned& nx) {
    const unsigned G = gridDim.x * gridDim.y * gridDim.z;
    unsigned sum, cnt, mine, sp = 0u;
    for (;;) {
        sum = 0u; cnt = 0u; mine = 0u;
#pragma unroll
        for (unsigned j = 0; j < 16; ++j) { const unsigned c = xb_ld(&bar[XB_XCNT(j)]); sum += c; cnt += (c > 0u) ? 1u : 0u; mine = (j == x) ? c : mine; }
        if (sum == G) break;
        __builtin_amdgcn_s_sleep(1);
        if ((++sp & 255u) == 0u) { if (xb_ld(&bar[XB_TMO])) break; if (sp > XB_SPIN_CAP) { atomicAdd(&bar[XB_TMO], 1u); break; } }
    }
    nloc = mine > 0u ? mine : 1u; nx = cnt > 0u ? cnt : 1u;
}
__device__ __forceinline__ void xcd_barrier(const XcdBarrier& b) {
    asm volatile("s_waitcnt vmcnt(0)" ::: "memory");
    __syncthreads();
    if (threadIdx.x == 0) {
        unsigned* bar = b.bar;
        __builtin_amdgcn_s_waitcnt(0);
        unsigned nloc = b.st[0], nx = b.st[1];
        if (nloc == 0u) { xcd_barrier_complete(bar, b.x, nloc, nx); b.st[0] = nloc; b.st[1] = nx; }
        const unsigned old = xb_add(&bar[XB_XSUB(b.x)], 1u);
        const unsigned gen = old / nloc;
        if (old + 1u == (gen + 1u) * nloc) {
            __builtin_amdgcn_fence(__ATOMIC_RELEASE, "agent");
            asm volatile("s_waitcnt vmcnt(0)" ::: "memory");
            const unsigned og = xb_add(&bar[XB_TOP], 1u);
            const unsigned tg = og / nx;
            if (og + 1u == (tg + 1u) * nx) xb_add(&bar[XB_TOPGEN], 1u);
            else XB_SPIN(xb_ld(&bar[XB_TOPGEN]) == tg, bar);
            __builtin_amdgcn_fence(__ATOMIC_ACQUIRE, "agent");
            xb_add(&bar[XB_XGEN(b.x)], 1u);
            asm volatile("s_waitcnt vmcnt(0)" ::: "memory");
        } else {
            XB_SPIN(xb_ld(&bar[XB_XGEN(b.x)]) == gen, bar);
            __builtin_amdgcn_fence(__ATOMIC_ACQUIRE, "agent");
            asm volatile("s_waitcnt vmcnt(0)" ::: "memory");
        }
    }
    __syncthreads();
}
#define GRID_SYNC() xcd_barrier(xb)
#else
#define GRID_SYNC() do {} while (0)
#endif

#ifndef CPU_TEST
#define GPUSEL(a, b) a
#else
#define GPUSEL(a, b) b
#endif
#ifndef CPU_TEST
#define OPAQUE_S(v) asm volatile("" : "+s"(v))
#define OPAQUE_V(v) asm volatile("" : "+v"(v))
#else
#define OPAQUE_S(v) do {} while (0)
#define OPAQUE_V(v) do {} while (0)
#endif
#ifndef PROBE_MASK
#define PROBE_MASK 0
#endif
#define LPHASE(stmt) do { int l = lo; OPAQUE_S(l); if (SINGLE && ((PROBE_MASK >> (ph - NG - lo * NLP)) & 1)) { long gtid = gtid0; OPAQUE_V(gtid); stmt; GRID_SYNC(); } PHASE(stmt); } while (0)
#define PHASE(stmt) do { if (SINGLE || ph == only) { long gtid = gtid0; OPAQUE_V(gtid); stmt; } if (SINGLE) { GRID_SYNC(); } ++ph; } while (0)
#ifndef CPU_TEST
template <bool SINGLE> __device__ __forceinline__ void run_seq(const P& p, long gtid0, long gsize, int only, const XcdBarrier& xb, char* smem)
#else
template <bool SINGLE> static int run_seq(const P& p, long gtid0, long gsize, int only)
#endif
{
  int ph = 0;
  PHASE(ph_g0(p, gtid, gsize));
  PHASE(ph_g1(p, gtid, gsize));
  PHASE(ph_g2(p, gtid, gsize));
  PHASE(ph_g3(p, gtid, gsize));
  PHASE(ph_g4(p, gtid, gsize));
#pragma unroll 1
  for (int lo = 0; lo < DEPTH; ++lo) {
    LPHASE(ph_modu(p, l, 0, gtid, gsize));
    LPHASE(GPUSEL(ph_proj_mfma(p, l, smem), ph_proj(p, l, gtid, gsize)));
    LPHASE(ph_post_proj(p, l, gtid, gsize));
    LPHASE(ph_mix(p, l, gtid, gsize); GPUSEL((ph_attn_mfma(p, l, smem), ph_hyena_mfma(p, l, smem)), (void)0));
    LPHASE(ph_s5out(p, l, gtid, gsize));
    LPHASE(GPUSEL(ph_glu_mfma(p, l, smem), ph_glu(p, l, gtid, gsize)));
    LPHASE(ph_rms(p, l, gtid, gsize));
    LPHASE(GPUSEL(ph_outproj_mfma(p, l, smem), ph_outproj(p, l, gtid, gsize)));
    LPHASE(ph_ln(p, l, 0, gtid, gsize));
    LPHASE(ph_router(p, l, gtid, gsize));
    LPHASE(ph_select(p, l, gtid, gsize));
    LPHASE(ph_sortrows(p, l, gtid, gsize));
    LPHASE(GPUSEL(ph_expert_up_mfma(p, l, smem), ph_expert_up(p, l, gtid, gsize)));
    LPHASE(GPUSEL(ph_expert_down_mfma(p, l, smem), ph_expert_down(p, l, gtid, gsize)));
    LPHASE(ph_combine(p, l, gtid, gsize));
    LPHASE(ph_ln(p, l, 1, gtid, gsize));
  }
#ifdef CPU_TEST
  return ph;
#endif
}


#ifndef CPU_TEST
#define NG_GPU 5
#define NLP_GPU 13
#ifndef PROBE_MASK_G
#define PROBE_MASK_G 0
#endif
#define GPHASE(stmt) do { if (SINGLE || ph == only) { long gtid = gtid0; OPAQUE_V(gtid); stmt; } if (SINGLE) { GRID_SYNC(); } ++ph; } while (0)
#define GLPHASE(stmt) do { int l = lo; OPAQUE_S(l); if (SINGLE && ((PROBE_MASK_G >> (ph - NG_GPU - lo * NLP_GPU)) & 1)) { long gtid = gtid0; OPAQUE_V(gtid); stmt; GRID_SYNC(); } GPHASE(stmt); } while (0)
template <bool SINGLE> __device__ __forceinline__ void run_seq_gpu(const P& p, long gtid0, long gsize, int only, const XcdBarrier& xb, char* smem) {
  int ph = 0;
  GPHASE(ph_g0(p, gtid, gsize));
  GPHASE(ph_g1(p, gtid, gsize); ph_modu0_gpu(p, gtid, gsize));
  GPHASE(ph_g2(p, gtid, gsize));
  GPHASE(ph_g3(p, gtid, gsize));
  GPHASE(ph_g4(p, gtid, gsize));
#pragma unroll 1
  for (int lo = 0; lo < DEPTH; ++lo) {
    GLPHASE(ph_proj_mfma(p, l, smem));
    GLPHASE(ph_post_proj(p, l, gtid, gsize));
    GLPHASE(ph_mix(p, l, gtid, gsize); ph_attn_mfma(p, l, smem); ph_hyena_mfma(p, l, smem));
    GLPHASE(ph_s5out(p, l, gtid, gsize));
    GLPHASE(ph_glu_mfma(p, l, smem));
    GLPHASE(ph_rms_gpu(p, l));
    GLPHASE(ph_outproj_mfma(p, l, smem));
    GLPHASE(ph_ln1_gpu(p, l));
    GLPHASE(ph_router_mfma(p, l, smem));
    GLPHASE(ph_select_gpu(p, l));
    GLPHASE(ph_expert_up_mfma(p, l, smem));
    GLPHASE(ph_expert_down_mfma(p, l, smem));
    GLPHASE(ph_ln2_gpu(p, l));
  }
}
#endif

struct Carver { char* base; size_t off; template <class T> T* take(size_t n) { T* r = (T*)(base + off); off += ((n * sizeof(T) + 255) / 256) * 256; return r; } };
static void carve(P& p, void* ws) {
  Carver c{(char*)ws, 0};
  p.bar = c.take<unsigned>(4096);
  p.cnt = c.take<int>(DEPTH * N_EXPERTS);
  p.mod = c.take<float>((size_t)DEPTH * (BATCH + 1) * 6 * D_MODEL);
  p.xcur = c.take<float>((size_t)NR * D_MODEL);
  p.ubuf = c.take<float>((size_t)NR * D_MODEL);
  p.proj = c.take<float>((size_t)NR * IN_W);
  p.hu = c.take<float>((size_t)NR * HYENA_W);
  p.hx0 = c.take<float>((size_t)NR * HYENA_W);
  p.fh1 = c.take<float>((size_t)DEPTH * SEQ * FILTER_HIDDEN);
  p.fh2 = c.take<float>((size_t)DEPTH * SEQ * FILTER_HIDDEN);
  p.kraw = c.take<float>((size_t)DEPTH * SEQ * 2 * HYENA_W);
  p.knorm = c.take<float>((size_t)DEPTH * HYENA_W);
  p.fh1c = c.take<float>((size_t)CTX_LEN * FILTER_HIDDEN);
  p.fh2c = c.take<float>((size_t)CTX_LEN * FILTER_HIDDEN);
  p.krawc = c.take<float>((size_t)CTX_LEN * 2 * HYENA_W);
  p.knormc = c.take<float>((size_t)HYENA_W);
  p.mixb = c.take<float>((size_t)NR * MIX_W);
  p.tmp = c.take<float>((size_t)NR * D_MODEL);
  p.lampow = c.take<float2>((size_t)DEPTH * 2 * S5_GROUPS * (S5_T + 1) * S5_STATE);
  p.bbar = c.take<float2>((size_t)DEPTH * 2 * S5_GROUPS * S5_STATE * S5_GROUP);
  p.kc = c.take<float>((size_t)DEPTH * 2 * S5_GROUPS * S5_T * S5_GROUP * S5_GROUP);
  p.sc = c.take<float2>((size_t)BATCH * 2 * S5_GROUPS * NCH * S5_STATE);
  p.hc = c.take<float2>((size_t)BATCH * 2 * S5_GROUPS * NCH * S5_STATE);
  p.ybuf = c.take<float>((size_t)NR * S5_W);
  p.rl = c.take<float>((size_t)NR * N_EXPERTS);
  p.top_e = c.take<int>((size_t)NR * TOP_K);
  p.gate = c.take<float>((size_t)NR * TOP_K);
  p.posb = c.take<int>((size_t)NR * TOP_K);
  p.srow = c.take<int>((size_t)NR * TOP_K);
  p.hbuf = c.take<float>((size_t)NR * TOP_K * EXPERT_FF);
  p.hsb = c.take<float>((size_t)NR * SHARED_FF);
  p.yk = c.take<float>((size_t)NR * TOP_K * D_MODEL);
  p.ysh = c.take<float>((size_t)NR * D_MODEL);
  p.ubf = c.take<unsigned short>((size_t)NR * D_MODEL);
  p.ybf = c.take<unsigned short>((size_t)NR * S5_W);
  p.mixbf = c.take<unsigned short>((size_t)NR * MIX_W);
  p.hbf = c.take<unsigned short>((size_t)NR * TOP_K * EXPERT_FF);
  p.hsbf = c.take<unsigned short>((size_t)NR * SHARED_FF);
  p.ubl = c.take<unsigned short>((size_t)NR * D_MODEL);
  p.elist = c.take<int>((size_t)N_EXPERTS * NR);
}
static void set_inputs(P& p, void* const* d_in) {
  const float** f = (const float**)&p.x;
  for (int i = 0; i < 40; ++i) f[i] = (const float*)d_in[i];
}

#ifndef CPU_TEST
#ifndef MK_SINGLE
#define MK_SINGLE 1
#endif
extern __shared__ __attribute__((aligned(16))) char dyn_smem[];
__global__ void __launch_bounds__(256, 2) mk_single(P p) {
  uint4* xbw = (uint4*)(dyn_smem + SM_XB);
  if (threadIdx.x == 0) *xbw = make_uint4(0u, 0u, 0u, 0u);
  __syncthreads();
  XcdBarrier xb = xcd_barrier_post(p.bar, (volatile LAS unsigned*)xbw);
  run_seq_gpu<true>(p, (long)blockIdx.x * blockDim.x + threadIdx.x, (long)gridDim.x * blockDim.x, -1, xb, dyn_smem);
}
__global__ void __launch_bounds__(256, 2) mk_phase(P p, int only) {
  XcdBarrier xb; xb.bar = p.bar; xb.x = 0; xb.st = nullptr;
#ifdef DBG_ONLY
  only = DBG_ONLY;
#endif
  run_seq_gpu<false>(p, (long)blockIdx.x * blockDim.x + threadIdx.x, (long)gridDim.x * blockDim.x, only, xb, dyn_smem);
}
extern "C" void kernel_launch(void* const* d_in, const int* in_sizes, int n_in, void* d_out, int out_size, void* d_ws, size_t ws_size, hipStream_t stream) {
  P p; memset(&p, 0, sizeof(p));
  set_inputs(p, d_in); p.out = (float*)d_out; carve(p, d_ws);
  (void)hipMemsetAsync(p.bar, 0, 4096 * sizeof(unsigned) + ((DEPTH * N_EXPERTS * sizeof(int) + 255) / 256) * 256, stream);
#if MK_SINGLE
  static int grid = 0;
  if (!grid) {
    int dev = 0, cus = 0, per_cu = 0; (void)hipGetDevice(&dev);
    (void)hipDeviceGetAttribute(&cus, hipDeviceAttributeMultiprocessorCount, dev);
    (void)hipFuncSetAttribute((const void*)mk_single, hipFuncAttributeMaxDynamicSharedMemorySize, SMEM_BYTES);
    (void)hipOccupancyMaxActiveBlocksPerMultiprocessor(&per_cu, mk_single, 256, SMEM_BYTES);
    grid = cus * (per_cu < 2 ? per_cu : 2);
  }
  mk_single<<<grid, 256, SMEM_BYTES, stream>>>(p);
#else
  for (int ph = 0; ph < NG_GPU + DEPTH * NLP_GPU; ++ph) mk_phase<<<512, 256, SMEM_BYTES, stream>>>(p, ph);
#endif
}
#endif
```

```cpp
#ifndef CPU_TEST
#include <hip/hip_runtime.h>
#include <cstring>
#define DEV __device__ __forceinline__
#define DEVM __device__ __forceinline__
#define HDM __host__ __device__ __forceinline__
#else
#include <cmath>
#include <cstdio>
#include <cstdlib>
#include <cstring>
#define DEV static inline
#define DEVM inline
#define HDM inline
struct float2 { float x, y; };
static inline float2 make_float2(float a, float b) { float2 r; r.x = a; r.y = b; return r; }
static inline int atomicAdd(int* p, int v) { int o = *p; *p += v; return o; }
#endif

#ifdef SMALL_CFG
#define D_MODEL 64
#define BATCH 2
#define SEQ 256
#define GRID_W 16
#define CTX_LEN 32
#define HEAD_DIM 16
#define N_Q_HEADS 4
#define N_KV_HEADS 2
#define HYENA_W 16
#define S5_W 32
#define WINDOW 32
#define FILTER_HIDDEN 16
#define S5_STATE 8
#define N_EXPERTS 32
#define TOP_K 4
#define EXPERT_FF 16
#define SHARED_FF 16
#define S5_T 32
#else
#define D_MODEL 1024
#define BATCH 2
#define SEQ 8192
#define GRID_W 64
#define CTX_LEN 256
#define HEAD_DIM 64
#define N_Q_HEADS 8
#define N_KV_HEADS 2
#define HYENA_W 256
#define S5_W 256
#define WINDOW 128
#define FILTER_HIDDEN 64
#define S5_STATE 64
#define N_EXPERTS 256
#define TOP_K 8
#define EXPERT_FF 256
#define SHARED_FF 256
#define S5_T 64
#endif
#define DEPTH 2
#define FILTER_EMB 33
#define N_EXPERT_GROUPS 8
#define TOPK_GROUPS 4
#define S5_GROUP 16
#define Q_GROUP (N_Q_HEADS / N_KV_HEADS)
#define ATTN_W (N_Q_HEADS * HEAD_DIM)
#define KV_W (N_KV_HEADS * HEAD_DIM)
#define MIX_W (ATTN_W + HYENA_W + S5_W)
#define Q_OFF 0
#define K_OFF ATTN_W
#define V_OFF (K_OFF + KV_W)
#define HY_OFF (V_OFF + KV_W)
#define S5_OFF (HY_OFF + 3 * HYENA_W)
#define IN_W (S5_OFF + S5_W)
#define AXIS_DIM (HEAD_DIM / 2)
#define ROPE_HALF (AXIS_DIM / 2)
#define S5_GROUPS (S5_W / S5_GROUP)
#define EPG (N_EXPERTS / N_EXPERT_GROUPS)
#define NL (BATCH * SEQ)
#define NC (BATCH * CTX_LEN)
#define NR (NL + NC)
#define NSEQ (CTX_LEN + SEQ)
#define NCH (NSEQ / S5_T)
#define LN_EPS 1e-5f
#define DN_ALPHA 1.4142135623730951f
#define ROUTED_SCALE 2.5f
#define PI_D 3.14159265358979323846

#define WS_LIST(X) \
  X(unsigned, bar, 4096) \
  X(int, cnt, DEPTH * N_EXPERTS) \
  X(float, mod, (size_t)DEPTH * (BATCH + 1) * 6 * D_MODEL) \
  X(float, xcur, (size_t)NR * D_MODEL) \
  X(float, ubuf, (size_t)NR * D_MODEL) \
  X(float, proj, (size_t)NR * IN_W) \
  X(float, hu, (size_t)NR * HYENA_W) \
  X(float, hx0, (size_t)NR * HYENA_W) \
  X(float, fh1, (size_t)DEPTH * SEQ * FILTER_HIDDEN) \
  X(float, fh2, (size_t)DEPTH * SEQ * FILTER_HIDDEN) \
  X(float, kraw, (size_t)DEPTH * SEQ * 2 * HYENA_W) \
  X(float, knorm, (size_t)DEPTH * HYENA_W) \
  X(float, fh1c, (size_t)CTX_LEN * FILTER_HIDDEN) \
  X(float, fh2c, (size_t)CTX_LEN * FILTER_HIDDEN) \
  X(float, krawc, (size_t)CTX_LEN * 2 * HYENA_W) \
  X(float, knormc, (size_t)HYENA_W) \
  X(float, mixb, (size_t)NR * MIX_W) \
  X(float, tmp, (size_t)NR * D_MODEL) \
  X(float2, lampow, (size_t)DEPTH * 2 * S5_GROUPS * (S5_T + 1) * S5_STATE) \
  X(float2, bbar, (size_t)DEPTH * 2 * S5_GROUPS * S5_STATE * S5_GROUP) \
  X(float, kc, (size_t)DEPTH * 2 * S5_GROUPS * S5_T * S5_GROUP * S5_GROUP) \
  X(float2, sc, (size_t)BATCH * 2 * S5_GROUPS * NCH * S5_STATE) \
  X(float2, hc, (size_t)BATCH * 2 * S5_GROUPS * NCH * S5_STATE) \
  X(float, ybuf, (size_t)NR * S5_W) \
  X(float, rl, (size_t)NR * N_EXPERTS) \
  X(int, top_e, (size_t)NR * TOP_K) \
  X(float, gate, (size_t)NR * TOP_K) \
  X(int, posb, (size_t)NR * TOP_K) \
  X(int, srow, (size_t)NR * TOP_K) \
  X(float, hbuf, (size_t)NR * TOP_K * EXPERT_FF) \
  X(float, hsb, (size_t)NR * SHARED_FF) \
  X(float, yk, (size_t)NR * TOP_K * D_MODEL) \
  X(float, ysh, (size_t)NR * D_MODEL) \
  X(unsigned short, ubf, (size_t)NR * D_MODEL) \
  X(unsigned short, ybf, (size_t)NR * S5_W) \
  X(unsigned short, mixbf, (size_t)NR * MIX_W) \
  X(unsigned short, hbf, (size_t)NR * TOP_K * EXPERT_FF) \
  X(unsigned short, hsbf, (size_t)NR * SHARED_FF) \
  X(unsigned short, ubl, (size_t)NR * D_MODEL) \
  X(int, elist, (size_t)N_EXPERTS * NR) \
  X(unsigned short, s5u, (size_t)NR * S5_W) \
  X(float, bmt, (size_t)DEPTH * 2 * S5_GROUPS * 16 * S5_T * 2 * S5_STATE) \
  X(float, cmt, (size_t)DEPTH * 2 * S5_GROUPS * 16 * S5_T * 2 * S5_STATE) \
  X(unsigned short, hcbf, (size_t)BATCH * 2 * S5_GROUPS * NCH * 2 * S5_STATE) \
  X(float, zT, (size_t)BATCH * 3 * HYENA_W * (SEQ + CTX_LEN)) \
  X(float, modp, (size_t)DEPTH * 16 * (BATCH + 1) * 6 * D_MODEL) \
  X(float, wrlo, (size_t)DEPTH * D_MODEL * N_EXPERTS) \

struct WsOff {
#define X(T, name, n) size_t name;
  WS_LIST(X)
#undef X
  size_t total;
};
constexpr WsOff ws_offsets() {
  WsOff o{}; size_t off = 0;
#define X(T, name, n) o.name = off; off += (((size_t)(n)) * sizeof(T) + 255) / 256 * 256;
  WS_LIST(X)
#undef X
  o.total = off; return o;
}
constexpr WsOff WSO = ws_offsets();
struct P {
  const float *x, *c, *ctx, *c_ctx, *w_ada, *b_ada, *w_in, *w_out, *sink, *mix_g, *hy_short_w, *hy_short_b, *hy_w1,
      *hy_b1, *hy_freq, *hy_w2, *hy_b2, *hy_w3, *hy_d, *s5_a_re, *s5_a_im, *s5_log_dt, *s5_b_re, *s5_b_im, *s5_c_re,
      *s5_c_im, *s5_d, *s5_w_glu, *ln1_g, *ln1_b, *ln2_g, *ln2_b, *w_router, *router_bias, *w_exp_gate, *w_exp_up,
      *w_exp_down, *w_sh_gate, *w_sh_up, *w_sh_down;
  float* out;
  char* ws;
#define X(T, name, n) HDM T* name() const { return (T*)(ws + WSO.name); }
  WS_LIST(X)
#undef X
};

#define FOR_ITEMS(i, N) for (long i = gtid; i < (long)(N); i += gsize)

DEV unsigned short f2bf16(float f) { unsigned u; memcpy(&u, &f, 4); return (unsigned short)((u + 0x7fffu + ((u >> 16) & 1u)) >> 16); }
DEV float siluf(float x) { return x / (1.0f + expf(-x)); }
DEV float sigmoidf_(float x) { return 1.0f / (1.0f + expf(-x)); }
DEV float gelu_tanhf(float x) { return 0.5f * x * (1.0f + tanhf(0.7978845608028654f * (x + 0.044715f * x * x * x))); }
DEV int modrow(long r) { return r < NL ? (int)(r / SEQ) : BATCH; }

DEV void ph_g0(const P& p, long gtid, long gsize) {
  FOR_ITEMS(i, (long)NR * D_MODEL) p.xcur()[i] = i < (long)NL * D_MODEL ? p.x[i] : p.ctx[i - (long)NL * D_MODEL];
#ifdef CPU_TEST
  FOR_ITEMS(i, DEPTH * (BATCH + 1) * 6 * D_MODEL) {
    int n = (int)(i % (6 * D_MODEL)); int j = (int)((i / (6 * D_MODEL)) % (BATCH + 1)); int l = (int)(i / (6 * D_MODEL * (BATCH + 1)));
    const float* cv = j < BATCH ? p.c + j * D_MODEL : p.c_ctx;
    const float* w = p.w_ada + (long)l * D_MODEL * 6 * D_MODEL;
    float acc = p.b_ada[l * 6 * D_MODEL + n];
    for (int k = 0; k < D_MODEL; ++k) acc += siluf(cv[k]) * w[(long)k * 6 * D_MODEL + n];
    p.mod()[i] = acc;
  }
#else
  FOR_ITEMS(i, (long)DEPTH * 16 * 6 * D_MODEL) {
    const int n = (int)(i % (6 * D_MODEL)); const int slab = (int)((i / (6 * D_MODEL)) % 16); const int l = (int)(i / (6 * D_MODEL * 16));
    const float* w = p.w_ada + ((long)l * D_MODEL + slab * 64) * 6 * D_MODEL + n;
    float a0 = 0.f, a1 = 0.f, a2 = 0.f;
#pragma unroll 8
    for (int k = 0; k < 64; ++k) {
      const float wv = w[(long)k * 6 * D_MODEL]; const int kk = slab * 64 + k;
      a0 += siluf(p.c[kk]) * wv; a1 += siluf(p.c[D_MODEL + kk]) * wv; a2 += siluf(p.c_ctx[kk]) * wv;
    }
    float* dst = p.modp() + ((long)(l * 16 + slab) * (BATCH + 1)) * 6 * D_MODEL + n;
    dst[0] = a0; dst[6 * D_MODEL] = a1; dst[2 * 6 * D_MODEL] = a2;
  }
#endif
  FOR_ITEMS(i, DEPTH * 2 * S5_GROUPS * S5_STATE) {
    int pp = (int)(i % S5_STATE); int g = (int)((i / S5_STATE) % S5_GROUPS); int ld = (int)(i / (S5_STATE * S5_GROUPS));
    float are = fminf(p.s5_a_re[i], -1e-4f), aim = p.s5_a_im[i];
    float dt = expf(p.s5_log_dt[ld * S5_GROUPS + g]);
    for (int d = 0; d <= S5_T; ++d) {
      float mag = expf(are * dt * d); float ang = aim * dt * d;
      p.lampow()[((long)(ld * S5_GROUPS + g) * (S5_T + 1) + d) * S5_STATE + pp] = make_float2(mag * cosf(ang), mag * sinf(ang));
    }
    float mag = expf(are * dt), ang = aim * dt;
    float lr = mag * cosf(ang) - 1.0f, li = mag * sinf(ang);
    float den = are * are + aim * aim;
    float fr = (lr * are + li * aim) / den, fi = (li * are - lr * aim) / den;
    for (int j = 0; j < S5_GROUP; ++j) {
      float br = p.s5_b_re[i * S5_GROUP + j], bi = p.s5_b_im[i * S5_GROUP + j];
      p.bbar()[i * S5_GROUP + j] = make_float2(fr * br - fi * bi, fr * bi + fi * br);
    }
  }
}
DEV void hy_f1(const P& p, int l, int Lf, float* h1, long gtid, long gsize) {
  FOR_ITEMS(i, (long)Lf * FILTER_HIDDEN) {
    int j = (int)(i % FILTER_HIDDEN); int t = (int)(i / FILTER_HIDDEN);
    const float* w1 = p.hy_w1 + l * FILTER_EMB * FILTER_HIDDEN;
    float tt = (float)((double)t / (double)(Lf - 1));
    float w = (float)(2.0 * PI_D * (double)t / (double)Lf);
    float acc = p.hy_b1[l * FILTER_HIDDEN + j] + tt * w1[j];
    const int bands = (FILTER_EMB - 1) / 2;
    for (int m = 0; m < bands; ++m) {
      float f = (float)(1e-4 + (double)m * ((double)(bands - 1) - 1e-4) / (double)(bands - 1));
      float a = f * w;
      acc += cosf(a) * w1[(1 + m) * FILTER_HIDDEN + j] - sinf(a) * w1[(1 + bands + m) * FILTER_HIDDEN + j];
    }
    h1[i] = sinf(p.hy_freq[l * FILTER_HIDDEN + j] * acc);
  }
}
DEV void hy_f2(const P& p, int l, int Lf, const float* h1, float* h2, long gtid, long gsize) {
  FOR_ITEMS(i, (long)Lf * FILTER_HIDDEN) {
    int j = (int)(i % FILTER_HIDDEN); int t = (int)(i / FILTER_HIDDEN);
    const float* w2 = p.hy_w2 + l * FILTER_HIDDEN * FILTER_HIDDEN;
    float acc = p.hy_b2[l * FILTER_HIDDEN + j];
    for (int k = 0; k < FILTER_HIDDEN; ++k) acc += h1[t * FILTER_HIDDEN + k] * w2[k * FILTER_HIDDEN + j];
#ifndef CPU_TEST
    h2[(long)j * Lf + t] = sinf(p.hy_freq[l * FILTER_HIDDEN + j] * acc);
#else
    h2[i] = sinf(p.hy_freq[l * FILTER_HIDDEN + j] * acc);
#endif
  }
}
DEV void hy_f3(const P& p, int l, int Lf, const float* h2, float* kraw, long gtid, long gsize) {
  FOR_ITEMS(i, (long)Lf * 2 * HYENA_W) {
    int t = (int)(i % Lf); int cc = (int)(i / Lf); int ch = cc % HYENA_W;
    const float* w3 = p.hy_w3 + l * FILTER_HIDDEN * 2 * HYENA_W;
    float acc = 0.f;
#ifndef CPU_TEST
    for (int k = 0; k < FILTER_HIDDEN; ++k) acc += h2[(long)k * Lf + t] * w3[k * 2 * HYENA_W + cc];
#else
    for (int k = 0; k < FILTER_HIDDEN; ++k) acc += h2[t * FILTER_HIDDEN + k] * w3[k * 2 * HYENA_W + cc];
#endif
    double d0 = log(1e-2) / 0.3, d1 = log(1e-2) / 1.5;
    float delta = fabsf((float)(d0 + (d1 - d0) * (double)ch / (double)(HYENA_W - 1)));
    float tt = (float)((double)t / (double)(Lf - 1));
    kraw[(long)cc * Lf + t] = acc * expf(-tt * delta);
  }
}
DEV void hy_f4(int Lf, const float* kraw, float* knorm, long gtid, long gsize) {
#ifndef CPU_TEST
  const int lane = (int)(gtid & 63); const long gw = gtid >> 6, nw = gsize >> 6;
  for (long i = gw; i < HYENA_W; i += nw) {
    float s = 0.f;
    for (int t = lane; t < Lf; t += 64) { s += fabsf(kraw[i * Lf + t]); if (t > 0) s += fabsf(kraw[(HYENA_W + i) * Lf + t]); }
    for (int o = 32; o > 0; o >>= 1) s += __shfl_xor(s, o);
    if (lane == 0) knorm[i] = 1.0f / s;
  }
#else
  FOR_ITEMS(i, HYENA_W) {
    float s = 0.f;
    for (int t = 0; t < Lf; ++t) {
      s += fabsf(kraw[(long)i * Lf + t]);
      if (t > 0) s += fabsf(kraw[(long)(HYENA_W + i) * Lf + t]);
    }
    knorm[i] = 1.0f / s;
  }
#endif
}
DEV void ph_g1(const P& p, long gtid, long gsize) {
  for (int l = 0; l < DEPTH; ++l) hy_f1(p, l, SEQ, p.fh1() + (long)l * SEQ * FILTER_HIDDEN, gtid, gsize);
  hy_f1(p, 0, CTX_LEN, p.fh1c(), gtid, gsize);
  FOR_ITEMS(i, (long)DEPTH * 2 * S5_GROUPS * S5_T * S5_GROUP * S5_GROUP) {
    int j = (int)(i % S5_GROUP); int ii = (int)((i / S5_GROUP) % S5_GROUP); int d = (int)((i / (S5_GROUP * S5_GROUP)) % S5_T);
    long ldg = i / (S5_GROUP * S5_GROUP * S5_T);
    float acc = 0.f;
    for (int pp = 0; pp < S5_STATE; ++pp) {
      float cr = p.s5_c_re[(ldg * S5_GROUP + ii) * S5_STATE + pp], ci = p.s5_c_im[(ldg * S5_GROUP + ii) * S5_STATE + pp];
      float2 lp = p.lampow()[(ldg * (S5_T + 1) + d) * S5_STATE + pp];
      float2 bb = p.bbar()[(ldg * S5_STATE + pp) * S5_GROUP + j];
      float tr = lp.x * bb.x - lp.y * bb.y, ti = lp.x * bb.y + lp.y * bb.x;
      acc += cr * tr - ci * ti;
    }
    p.kc()[i] = acc;
  }
}
DEV void ph_g2(const P& p, long gtid, long gsize) {
  for (int l = 0; l < DEPTH; ++l) hy_f2(p, l, SEQ, p.fh1() + (long)l * SEQ * FILTER_HIDDEN, p.fh2() + (long)l * SEQ * FILTER_HIDDEN, gtid, gsize);
  hy_f2(p, 0, CTX_LEN, p.fh1c(), p.fh2c(), gtid, gsize);
}
DEV void ph_g3(const P& p, long gtid, long gsize) {
  for (int l = 0; l < DEPTH; ++l) hy_f3(p, l, SEQ, p.fh2() + (long)l * SEQ * FILTER_HIDDEN, p.kraw() + (long)l * SEQ * 2 * HYENA_W, gtid, gsize);
  hy_f3(p, 0, CTX_LEN, p.fh2c(), p.krawc(), gtid, gsize);
}
DEV void ph_g4(const P& p, long gtid, long gsize) {
  for (int l = 0; l < DEPTH; ++l) hy_f4(SEQ, p.kraw() + (long)l * SEQ * 2 * HYENA_W, p.knorm() + l * HYENA_W, gtid, gsize);
  hy_f4(CTX_LEN, p.krawc(), p.knormc(), gtid, gsize);
}
#define NG 5

DEV void ph_modu(const P& p, int l, int which, long gtid, long gsize) {
  FOR_ITEMS(i, (long)NR * D_MODEL) {
    int k = (int)(i % D_MODEL); long r = i / D_MODEL;
    const float* m = p.mod() + ((long)l * (BATCH + 1) + modrow(r)) * 6 * D_MODEL + which * 3 * D_MODEL;
    float uv = p.xcur()[i] * (1.0f + m[D_MODEL + k]) + m[k];
    p.ubuf()[i] = uv; p.ubf()[i] = f2bf16(uv);
  }
}
template <class Epi>
DEV void gemm_naive(const float* A, int lda, const float* B, int ldb, int M, int N, int K, Epi epi, long gtid, long gsize) {
  FOR_ITEMS(i, (long)(M / 4) * N) {
    int n = (int)(i % N); long r0 = (i / N) * 4;
    const float* a0 = A + r0 * lda;
    float c0 = 0.f, c1 = 0.f, c2 = 0.f, c3 = 0.f;
    for (int k = 0; k < K; ++k) {
      float b = B[(long)k * ldb + n];
      c0 += a0[k] * b; c1 += a0[lda + k] * b; c2 += a0[2 * lda + k] * b; c3 += a0[3 * lda + k] * b;
    }
    epi(r0, n, c0); epi(r0 + 1, n, c1); epi(r0 + 2, n, c2); epi(r0 + 3, n, c3);
  }
}
struct EpiStore { float* C; int ldc; DEVM void operator()(long r, int n, float v) const { C[r * ldc + n] = v; } };
DEV void ph_proj(const P& p, int l, long gtid, long gsize) {
  EpiStore e{p.proj(), IN_W};
  gemm_naive(p.ubuf(), D_MODEL, p.w_in + (long)l * D_MODEL * IN_W, IN_W, NR, IN_W, D_MODEL, e, gtid, gsize);
}
DEV long s5_row(int b, int dir, int n) {
  if (n < CTX_LEN) return (long)NL + b * CTX_LEN + (dir ? CTX_LEN - 1 - n : n);
  int t = n - CTX_LEN; return (long)b * SEQ + (dir ? SEQ - 1 - t : t);
}
DEV void ph_post_proj(const P& p, int l, long gtid, long gsize) {
  FOR_ITEMS(i, (long)NL * (N_Q_HEADS + N_KV_HEADS) * 2 * ROPE_HALF) {
    int ii = (int)(i % ROPE_HALF); int a = (int)((i / ROPE_HALF) % 2); int hs = (int)((i / (2 * ROPE_HALF)) % (N_Q_HEADS + N_KV_HEADS));
    long r = i / (2 * ROPE_HALF * (N_Q_HEADS + N_KV_HEADS));
    int t = (int)(r % SEQ); int pos = a == 0 ? t / GRID_W : t % GRID_W;
    float inv = powf(10000.0f, -(float)(2 * ii) / (float)AXIS_DIM);
    float ang = (float)pos * inv; float cs = cosf(ang), sn = sinf(ang);
    float* q = p.proj() + r * IN_W + hs * HEAD_DIM + a * AXIS_DIM + ii;
    float x1 = q[0], x2 = q[ROPE_HALF];
    q[0] = x1 * cs - x2 * sn; q[ROPE_HALF] = x1 * sn + x2 * cs;
  }
#ifdef CPU_TEST
  FOR_ITEMS(i, (long)NR * HYENA_W) {
    int ch = (int)(i % HYENA_W); long r = i / HYENA_W;
    int Ls = r < NL ? SEQ : CTX_LEN; long base = r < NL ? (r / SEQ) * SEQ : NL + ((r - NL) / CTX_LEN) * CTX_LEN; int t = (int)(r - base);
    const float* sw = p.hy_short_w + l * 3 * 3 * HYENA_W; const float* sb = p.hy_short_b + l * 3 * HYENA_W;
    float z[3];
#pragma unroll
    for (int part = 0; part < 3; ++part) {
      int cc = part * HYENA_W + ch; float acc = sb[cc];
#pragma unroll
      for (int j = 0; j < 3; ++j) { int tt = t + j - 1; if (tt >= 0 && tt < Ls) acc += p.proj()[(base + tt) * IN_W + HY_OFF + cc] * sw[j * 3 * HYENA_W + cc]; }
      z[part] = acc;
    }
    long o = r < NL ? ((r / SEQ) * HYENA_W + ch) * SEQ + t : i;
    p.hu()[o] = z[0] * z[1]; p.hx0()[o] = z[2];
  }
#endif
#ifndef CPU_TEST
  FOR_ITEMS(i, (long)NR * S5_W) { long r = i / S5_W; int cc = (int)(i % S5_W); p.s5u()[i] = f2bf16(p.proj()[r * IN_W + S5_OFF + cc]); }
#endif
#ifdef CPU_TEST
  FOR_ITEMS(i, (long)BATCH * 2 * S5_GROUPS * NCH * S5_STATE) {
    int pp = (int)(i % S5_STATE); int c = (int)((i / S5_STATE) % NCH); int g = (int)((i / (S5_STATE * NCH)) % S5_GROUPS);
    int dir = (int)((i / (S5_STATE * NCH * S5_GROUPS)) % 2); int b = (int)(i / (S5_STATE * NCH * S5_GROUPS * 2));
    long ldg = ((long)l * 2 + dir) * S5_GROUPS + g;
    float sr = 0.f, si = 0.f;
    for (int s = 0; s < S5_T; ++s) {
      const float* u = p.proj() + s5_row(b, dir, c * S5_T + s) * IN_W + S5_OFF + g * S5_GROUP;
      float br = 0.f, bi = 0.f;
#pragma unroll
      for (int j = 0; j < S5_GROUP; ++j) { float2 bb = p.bbar()[(ldg * S5_STATE + pp) * S5_GROUP + j]; br += bb.x * u[j]; bi += bb.y * u[j]; }
      float2 lp = p.lampow()[(ldg * (S5_T + 1) + (S5_T - 1 - s)) * S5_STATE + pp];
      sr += lp.x * br - lp.y * bi; si += lp.x * bi + lp.y * br;
    }
    p.sc()[i] = make_float2(sr, si);
  }
#endif
}
DEV void attn_item(const P& p, int l, long r, int h, float* outp) {
  const float scale = 1.0f / sqrtf((float)HEAD_DIM);
  float q[HEAD_DIM], acc[HEAD_DIM];
  const float* qp = p.proj() + r * IN_W + Q_OFF + h * HEAD_DIM;
#pragma unroll
  for (int d = 0; d < HEAD_DIM; ++d) { q[d] = qp[d] * scale; acc[d] = 0.f; }
  int kvh = h / Q_GROUP; int b = r < NL ? (int)(r / SEQ) : (int)((r - NL) / CTX_LEN);
  float m = -1e30f, lsum = 0.f;
  int nwin = 0, t = 0;
  if (r < NL) { t = (int)(r % SEQ); nwin = 2 * WINDOW + 1; }
  for (int j = 0; j < nwin + CTX_LEN; ++j) {
    long kr;
    if (j < nwin) { int tk = t - WINDOW + j; if (tk < 0 || tk >= SEQ) continue; kr = (long)b * SEQ + tk; }
    else kr = (long)NL + b * CTX_LEN + (j - nwin);
    const float* kp = p.proj() + kr * IN_W + K_OFF + kvh * HEAD_DIM; const float* vp = p.proj() + kr * IN_W + V_OFF + kvh * HEAD_DIM;
    float s = 0.f;
#pragma unroll
    for (int d = 0; d < HEAD_DIM; ++d) s += q[d] * kp[d];
    float mn = fmaxf(m, s); float corr = expf(m - mn); float pe = expf(s - mn);
    lsum = lsum * corr + pe;
#pragma unroll
    for (int d = 0; d < HEAD_DIM; ++d) acc[d] = acc[d] * corr + pe * vp[d];
    m = mn;
  }
  float sk = p.sink[l * N_Q_HEADS + h]; float mf = fmaxf(m, sk); float corr = expf(m - mf);
  float den = lsum * corr + expf(sk - mf); float sc2 = corr / den;
#pragma unroll
  for (int d = 0; d < HEAD_DIM; ++d) outp[d] = acc[d] * sc2;
}
DEV void ph_mix(const P& p, int l, long gtid, long gsize) {
#ifdef CPU_TEST
  long nrows_att = l == 0 ? NR : NL;
  FOR_ITEMS(i, nrows_att * N_Q_HEADS) { int h = (int)(i % N_Q_HEADS); long r = i / N_Q_HEADS; attn_item(p, l, r, h, p.mixb() + r * MIX_W + h * HEAD_DIM); }
#endif
#ifdef CPU_TEST
  FOR_ITEMS(i, (long)NL * HYENA_W) {
    int ch = (int)(i % HYENA_W); long r = i / HYENA_W; int t = (int)(r % SEQ); int b = (int)(r / SEQ);
    const float* kf = p.kraw() + ((long)l * 2 * HYENA_W + ch) * SEQ; const float* kb = p.kraw() + ((long)l * 2 * HYENA_W + HYENA_W + ch) * SEQ;
    const float* uu = p.hu() + ((long)b * HYENA_W + ch) * SEQ;
    float acc = 0.f;
    for (int s = 0; s <= t; ++s) acc += kf[t - s] * uu[s];
    for (int s = t + 1; s < SEQ; ++s) acc += kb[s - t] * uu[s];
    p.mixb()[r * MIX_W + ATTN_W + ch] = (acc * p.knorm()[l * HYENA_W + ch] + uu[t] * p.hy_d[l * HYENA_W + ch]) * p.hx0()[((long)b * HYENA_W + ch) * SEQ + t];
  }
#endif
  if (l == 0) {
    FOR_ITEMS(i, (long)NC * HYENA_W) {
      int ch = (int)(i % HYENA_W); long r = NL + i / HYENA_W; int t = (int)((r - NL) % CTX_LEN); long base = r - t;
      float acc = 0.f;
      for (int s = 0; s <= t; ++s) acc += p.krawc()[(long)ch * CTX_LEN + (t - s)] * p.hu()[(base + s) * HYENA_W + ch];
      for (int s = t + 1; s < CTX_LEN; ++s) acc += p.krawc()[(long)(HYENA_W + ch) * CTX_LEN + (s - t)] * p.hu()[(base + s) * HYENA_W + ch];
      float u = p.hu()[r * HYENA_W + ch];
      p.mixb()[r * MIX_W + ATTN_W + ch] = (acc * p.knormc()[ch] + u * p.hy_d[l * HYENA_W + ch]) * p.hx0()[r * HYENA_W + ch];
    }
  }
  FOR_ITEMS(i, (long)BATCH * 2 * S5_GROUPS * S5_STATE) {
    int pp = (int)(i % S5_STATE); int g = (int)((i / S5_STATE) % S5_GROUPS); int dir = (int)((i / (S5_STATE * S5_GROUPS)) % 2); int b = (int)(i / (S5_STATE * S5_GROUPS * 2));
    long ldg = ((long)l * 2 + dir) * S5_GROUPS + g;
    float2 lt = p.lampow()[(ldg * (S5_T + 1) + S5_T) * S5_STATE + pp];
    float hr = 0.f, hi = 0.f;
    long base = (((long)b * 2 + dir) * S5_GROUPS + g) * NCH;
#ifndef CPU_TEST
    static_assert(NCH % 12 == 0, "carry batching");
    for (int c0 = 0; c0 < NCH; c0 += 12) {
      float2 sv[12];
#pragma unroll
      for (int k = 0; k < 12; ++k) sv[k] = p.sc()[(base + c0 + k) * S5_STATE + pp];
#pragma unroll
      for (int k = 0; k < 12; ++k) {
        p.hcbf()[(base + c0 + k) * 2 * S5_STATE + pp] = f2bf16(hr); p.hcbf()[(base + c0 + k) * 2 * S5_STATE + S5_STATE + pp] = f2bf16(hi);
        const float nr = lt.x * hr - lt.y * hi + sv[k].x, ni = lt.x * hi + lt.y * hr + sv[k].y;
        hr = nr; hi = ni;
      }
    }
#else
    for (int c = 0; c < NCH; ++c) {
      p.hc()[(base + c) * S5_STATE + pp] = make_float2(hr, hi);
      float2 s = p.sc()[(base + c) * S5_STATE + pp];
      float nr = lt.x * hr - lt.y * hi + s.x, ni = lt.x * hi + lt.y * hr + s.y;
      hr = nr; hi = ni;
    }
#endif
  }
}
DEV void ph_s5out(const P& p, int l, long gtid, long gsize) {
  FOR_ITEMS(i, (long)NR * S5_W) {
    int chn = (int)(i % S5_W); long r = i / S5_W; int g = chn / S5_GROUP, ii = chn % S5_GROUP;
    int b, tl; bool isctx = r >= NL;
    if (isctx) { b = (int)((r - NL) / CTX_LEN); tl = (int)((r - NL) % CTX_LEN); } else { b = (int)(r / SEQ); tl = (int)(r % SEQ); }
    float y = p.s5_d[l * S5_W + chn] * p.proj()[r * IN_W + S5_OFF + chn];
    for (int dir = 0; dir < 2; ++dir) {
      int n = isctx ? (dir ? CTX_LEN - 1 - tl : tl) : CTX_LEN + (dir ? SEQ - 1 - tl : tl);
      int c = n / S5_T, tau = n % S5_T;
      long ldg = ((long)l * 2 + dir) * S5_GROUPS + g;
      long hb = ((((long)b * 2 + dir) * S5_GROUPS + g) * NCH + c) * S5_STATE;
      for (int pp = 0; pp < S5_STATE; ++pp) {
        float cr = p.s5_c_re[(ldg * S5_GROUP + ii) * S5_STATE + pp], ci = p.s5_c_im[(ldg * S5_GROUP + ii) * S5_STATE + pp];
        float2 lp = p.lampow()[(ldg * (S5_T + 1) + tau + 1) * S5_STATE + pp]; float2 h = p.hc()[hb + pp];
        float tr = lp.x * h.x - lp.y * h.y, ti = lp.x * h.y + lp.y * h.x;
        y += cr * tr - ci * ti;
      }
      for (int s = 0; s <= tau; ++s) {
        const float* u = p.proj() + s5_row(b, dir, c * S5_T + s) * IN_W + S5_OFF + g * S5_GROUP;
        const float* kk = p.kc() + ((ldg * S5_T + (tau - s)) * S5_GROUP + ii) * S5_GROUP;
#pragma unroll
        for (int j = 0; j < S5_GROUP; ++j) y += kk[j] * u[j];
      }
    }
    float gy = gelu_tanhf(y); p.ybuf()[i] = gy; p.ybf()[i] = f2bf16(gy);
  }
}
struct EpiGlu { const float* g; float* mixb; DEVM void operator()(long r, int n, float v) const { mixb[r * MIX_W + ATTN_W + HYENA_W + n] = g[r * S5_W + n] * sigmoidf_(v); } };
DEV void ph_glu(const P& p, int l, long gtid, long gsize) {
  EpiGlu e{p.ybuf(), p.mixb()};
  gemm_naive(p.ybuf(), S5_W, p.s5_w_glu + (long)l * S5_W * S5_W, S5_W, NR, S5_W, S5_W, e, gtid, gsize);
}
DEV void ph_rms(const P& p, int l, long gtid, long gsize) {
  FOR_ITEMS(i, (long)NR * 3) {
    int grp = (int)(i % 3); long r = i / 3;
    int off = grp == 0 ? 0 : (grp == 1 ? ATTN_W : ATTN_W + HYENA_W); int w = grp == 0 ? ATTN_W : (grp == 1 ? HYENA_W : S5_W);
    float* v = p.mixb() + r * MIX_W + off; float ss = 0.f;
    for (int k = 0; k < w; ++k) ss += v[k] * v[k];
    float rs = 1.0f / sqrtf(ss / (float)w + LN_EPS);
    for (int k = 0; k < w; ++k) { float nv = v[k] * rs * p.mix_g[l * MIX_W + off + k]; v[k] = nv; p.mixbf()[r * MIX_W + off + k] = f2bf16(nv); }
  }
}
struct EpiRes { const float* xcur; const float* mod; int l; int goff; float* tmp;
  DEVM void operator()(long r, int n, float v) const { const float* m = mod + ((long)l * (BATCH + 1) + modrow(r)) * 6 * D_MODEL + goff; tmp[r * D_MODEL + n] = DN_ALPHA * xcur[r * D_MODEL + n] + m[n] * v; } };
DEV void ph_outproj(const P& p, int l, long gtid, long gsize) {
  EpiRes e{p.xcur(), p.mod(), l, 2 * D_MODEL, p.tmp()};
  gemm_naive(p.mixb(), MIX_W, p.w_out + (long)l * MIX_W * D_MODEL, D_MODEL, NR, D_MODEL, MIX_W, e, gtid, gsize);
}
DEV void ph_ln(const P& p, int l, int which, long gtid, long gsize) {
  const float* gw = (which == 0 ? p.ln1_g : p.ln2_g) + l * D_MODEL; const float* bw = (which == 0 ? p.ln1_b : p.ln2_b) + l * D_MODEL;
  FOR_ITEMS(r, (long)NR) {
    const float* v = p.tmp() + r * D_MODEL; float mu = 0.f;
#pragma unroll 4
    for (int k = 0; k < D_MODEL; ++k) mu += v[k];
    mu /= (float)D_MODEL; float var = 0.f;
#pragma unroll 4
    for (int k = 0; k < D_MODEL; ++k) { float d = v[k] - mu; var += d * d; }
    float rs = 1.0f / sqrtf(var / (float)D_MODEL + LN_EPS);
    const float* m = p.mod() + ((long)l * (BATCH + 1) + modrow(r)) * 6 * D_MODEL + 3 * D_MODEL;
#pragma unroll 2
    for (int k = 0; k < D_MODEL; ++k) {
      float y = (v[k] - mu) * rs * gw[k] + bw[k];
      p.xcur()[r * D_MODEL + k] = y;
      if (which == 0) { float uv = y * (1.0f + m[D_MODEL + k]) + m[k]; p.ubuf()[r * D_MODEL + k] = uv; p.ubf()[r * D_MODEL + k] = f2bf16(uv); }
      if (which == 1 && l == DEPTH - 1 && r < NL) p.out[r * D_MODEL + k] = y;
    }
  }
}
DEV void ph_router(const P& p, int l, long gtid, long gsize) {
  EpiStore e{p.rl(), N_EXPERTS};
  gemm_naive(p.ubuf(), D_MODEL, p.w_router + (long)l * D_MODEL * N_EXPERTS, N_EXPERTS, NR, N_EXPERTS, D_MODEL, e, gtid, gsize);
}
DEV bool better(float v, int i, float bv, int bi) { return v > bv || (v == bv && i < bi); }
DEV void ph_select(const P& p, int l, long gtid, long gsize) {
  FOR_ITEMS(r, (long)NR) {
    const float* lg = p.rl() + r * N_EXPERTS; const float* rb = p.router_bias + l * N_EXPERTS;
    float gs[N_EXPERT_GROUPS];
#pragma unroll
    for (int g = 0; g < N_EXPERT_GROUPS; ++g) {
      float m1 = -1e30f, m2 = -1e30f;
      for (int e = 0; e < EPG; ++e) { float v = sigmoidf_(lg[g * EPG + e]) + rb[g * EPG + e]; if (v > m1) { m2 = m1; m1 = v; } else if (v > m2) m2 = v; }
      gs[g] = m1 + m2;
    }
    unsigned keep = 0;
#pragma unroll
    for (int it = 0; it < TOPK_GROUPS; ++it) {
      float bv = -1e30f; int bi = -1;
#pragma unroll
      for (int g = 0; g < N_EXPERT_GROUPS; ++g) if (!((keep >> g) & 1u) && (bi < 0 || gs[g] > bv)) { bv = gs[g]; bi = g; }
      keep |= 1u << bi;
    }
    float lastv = 1e30f; int lasti = -1; float gsum = 0.f;
    for (int it = 0; it < TOP_K; ++it) {
      float bv = -1e30f; int bi = -1;
      for (int e = 0; e < N_EXPERTS; ++e) {
        if (!((keep >> (e / EPG)) & 1u)) continue;
        float v = sigmoidf_(lg[e]) + rb[e];
        if (!better(lastv, lasti, v, e)) continue;
        if (bi < 0 || better(v, e, bv, bi)) { bv = v; bi = e; }
      }
      lastv = bv; lasti = bi;
      float sc = sigmoidf_(lg[bi]); gsum += sc;
      p.top_e()[r * TOP_K + it] = bi; p.gate()[r * TOP_K + it] = sc;
      p.posb()[r * TOP_K + it] = atomicAdd(&p.cnt()[l * N_EXPERTS + bi], 1);
    }
    float inv = ROUTED_SCALE / gsum;
    for (int it = 0; it < TOP_K; ++it) p.gate()[r * TOP_K + it] *= inv;
  }
}
DEV void ph_sortrows(const P& p, int l, long gtid, long gsize) {
  FOR_ITEMS(i, (long)NR * TOP_K) {
    int e = p.top_e()[i]; int off = 0;
    for (int j = 0; j < e; ++j) off += p.cnt()[l * N_EXPERTS + j];
    p.srow()[off + p.posb()[i]] = (int)i;
  }
}
DEV void ph_expert_up(const P& p, int l, long gtid, long gsize) {
  FOR_ITEMS(i, (long)NR * TOP_K * EXPERT_FF) {
    int cidx = (int)(i % EXPERT_FF); int a = p.srow()[i / EXPERT_FF]; int e = p.top_e()[a]; long r = a / TOP_K;
    const float* xg = p.ubuf() + r * D_MODEL;
    const float* wg = p.w_exp_gate + ((long)l * N_EXPERTS + e) * D_MODEL * EXPERT_FF; const float* wu = p.w_exp_up + ((long)l * N_EXPERTS + e) * D_MODEL * EXPERT_FF;
    float g = 0.f, u = 0.f;
    for (int k = 0; k < D_MODEL; ++k) { float xv = xg[k]; g += xv * wg[(long)k * EXPERT_FF + cidx]; u += xv * wu[(long)k * EXPERT_FF + cidx]; }
    p.hbuf()[(long)a * EXPERT_FF + cidx] = siluf(g) * u;
  }
  FOR_ITEMS(i, (long)NR * SHARED_FF) {
    int cidx = (int)(i % SHARED_FF); long r = i / SHARED_FF;
    const float* xg = p.ubuf() + r * D_MODEL;
    const float* wg = p.w_sh_gate + (long)l * D_MODEL * SHARED_FF; const float* wu = p.w_sh_up + (long)l * D_MODEL * SHARED_FF;
    float g = 0.f, u = 0.f;
    for (int k = 0; k < D_MODEL; ++k) { float xv = xg[k]; g += xv * wg[(long)k * SHARED_FF + cidx]; u += xv * wu[(long)k * SHARED_FF + cidx]; }
    p.hsb()[i] = siluf(g) * u;
  }
}
DEV void ph_expert_down(const P& p, int l, long gtid, long gsize) {
  FOR_ITEMS(i, (long)NR * TOP_K * D_MODEL) {
    int d = (int)(i % D_MODEL); long a = i / D_MODEL;
    int e = p.top_e()[a]; const float* wd = p.w_exp_down + ((long)l * N_EXPERTS + e) * EXPERT_FF * D_MODEL;
    const float* h = p.hbuf() + a * EXPERT_FF; float acc = 0.f;
    for (int cidx = 0; cidx < EXPERT_FF; ++cidx) acc += h[cidx] * wd[(long)cidx * D_MODEL + d];
    p.yk()[i] = acc * p.gate()[a];
  }
  FOR_ITEMS(i, (long)NR * D_MODEL) {
    int d = (int)(i % D_MODEL); long r = i / D_MODEL;
    const float* wsd = p.w_sh_down + (long)l * SHARED_FF * D_MODEL; const float* hs = p.hsb() + r * SHARED_FF;
    float acc = 0.f;
    for (int cidx = 0; cidx < SHARED_FF; ++cidx) acc += hs[cidx] * wsd[(long)cidx * D_MODEL + d];
    p.ysh()[i] = acc;
  }
}
DEV void ph_combine(const P& p, int l, long gtid, long gsize) {
#pragma unroll 1
  FOR_ITEMS(i, (long)NR * D_MODEL) {
    int d = (int)(i % D_MODEL); long r = i / D_MODEL;
    float f = p.ysh()[i];
#pragma unroll
    for (int k = 0; k < TOP_K; ++k) f += p.yk()[(r * TOP_K + k) * D_MODEL + d];
    const float* m = p.mod() + ((long)l * (BATCH + 1) + modrow(r)) * 6 * D_MODEL + 5 * D_MODEL;
    p.tmp()[i] = DN_ALPHA * p.xcur()[i] + m[d] * f;
  }
}
#define NLP 16


#ifndef CPU_TEST
typedef __attribute__((ext_vector_type(8))) short bf16x8;
typedef __attribute__((ext_vector_type(4))) float f32x4;
typedef __attribute__((ext_vector_type(4))) unsigned u32x4;
typedef __attribute__((ext_vector_type(2))) unsigned u32x2;
static_assert(N_EXPERTS == 256 && D_MODEL % 128 == 0 && NR % 128 == 0, "shape assumptions");
#define SM_XB 0
#define NT 512
#define SM_A 256
#define SM_B (256 + 16384)
#define SM_MISC (256 + 98304)
#define SMEM_BYTES (256 + 98304 + 4096)

DEV int otid() { int t = threadIdx.x; asm volatile("" : "+v"(t)); return t; }
typedef __bf16 bf16x2_t __attribute__((ext_vector_type(2)));
typedef float f32x2_t __attribute__((ext_vector_type(2)));
DEV unsigned pack2(float a, float b) { f32x2_t v = {a, b}; return __builtin_bit_cast(unsigned, __builtin_convertvector(v, bf16x2_t)); }
DEV unsigned f2bf(float f) { return pack2(f, 0.f) & 0xffffu; }
DEV int tile_off(int row, int chunk) { return row * 128 + ((chunk ^ ((row >> 1) & 7)) << 4); }

DEV float bflo(float x) { return x - __uint_as_float(f2bf(x) << 16); }
struct ALRows { const char* base; unsigned off[2]; DEVM const unsigned short* a(int i, int kt) const { return (const unsigned short*)(base + (off[i] + (unsigned)kt * 128u)); } };
struct BLStd { static constexpr bool TR = false; const char* base; unsigned voff; int ldb4; bool valid;
  DEVM void load(float4 (&rb)[8], int kt) const {
#pragma unroll
    for (int i = 0; i < 8; ++i) rb[i] = valid ? *(const float4*)(base + (unsigned)((unsigned)(kt * 64 + i) * (unsigned)ldb4 + voff)) : make_float4(0.f, 0.f, 0.f, 0.f); } };
DEV unsigned bl_voff(int ldb4, int tid) { return (unsigned)((tid & 7) * 8) * (unsigned)ldb4 + (unsigned)((tid >> 3) * 16); }
DEV BLStd mk_bl(const float* B  , int ldb, int tid) {
  BLStd b; b.base = (const char*)B; b.ldb4 = ldb * 4; b.voff = bl_voff(ldb * 4, tid); b.valid = true; return b; }
#define SM_TILE 49152
template <int V = 0, class AL, class BL>
DEV void gemm_t(const AL& al, const BL& bl, int nk, f32x4 (&acc)[4][4], char* smem) {
  const int tid = otid(), lane = tid & 63, wid = tid >> 6, wr = wid >> 2, wc = wid & 3;
  const int l15 = lane & 15, q = lane >> 4, x = l15 >> 1;
  const char* ard0 = smem + SM_A + (wr * 64 + l15) * 128 + ((q ^ x) << 4);
  const char* ard1 = smem + SM_A + (wr * 64 + l15) * 128 + (((4 + q) ^ x) << 4);
  const char* brd0 = smem + SM_B + (wc * 64 + l15) * 128 + ((q ^ x) << 4);
  const char* brd1 = smem + SM_B + (wc * 64 + l15) * 128 + (((4 + q) ^ x) << 4);
  const int kq = tid & 7, nq = tid >> 3;
  char* awr = smem + SM_A + nq * 128 + ((kq ^ ((nq >> 1) & 7)) << 4);
  char* bwr0 = smem + SM_B + (nq * 4) * 128 + ((kq ^ ((2 * nq) & 7)) << 4);
  char* bwr1 = smem + SM_B + (nq * 4 + 2) * 128 + ((kq ^ ((2 * nq + 1) & 7)) << 4);
  if (nk <= 0) return;
  u32x4 ra[2]; float4 rb0[8];
#define GEMM_LOADA(KT) do { _Pragma("unroll") for (int i = 0; i < 2; ++i) ra[i] = *(const u32x4*)(al.a(i, (KT))); } while (0)
#define GEMM_WRITE(rb, PO) do { \
    *(u32x4*)(awr + (PO)) = ra[0]; *(u32x4*)(awr + (PO) + 8192) = ra[1]; \
    if (BL::TR) { u32x4 v; \
      v[0] = pack2(rb[0].x, rb[0].y); v[1] = pack2(rb[0].z, rb[0].w); v[2] = pack2(rb[1].x, rb[1].y); v[3] = pack2(rb[1].z, rb[1].w); *(u32x4*)(bwr0 + (PO)) = v; \
      v[0] = pack2(rb[2].x, rb[2].y); v[1] = pack2(rb[2].z, rb[2].w); v[2] = pack2(rb[3].x, rb[3].y); v[3] = pack2(rb[3].z, rb[3].w); *(u32x4*)(bwr0 + (PO) + 128) = v; \
      v[0] = pack2(rb[4].x, rb[4].y); v[1] = pack2(rb[4].z, rb[4].w); v[2] = pack2(rb[5].x, rb[5].y); v[3] = pack2(rb[5].z, rb[5].w); *(u32x4*)(bwr1 + (PO)) = v; \
      v[0] = pack2(rb[6].x, rb[6].y); v[1] = pack2(rb[6].z, rb[6].w); v[2] = pack2(rb[7].x, rb[7].y); v[3] = pack2(rb[7].z, rb[7].w); *(u32x4*)(bwr1 + (PO) + 128) = v; \
    } else { u32x4 v; \
      v[0] = pack2(rb[0].x, rb[1].x); v[1] = pack2(rb[2].x, rb[3].x); v[2] = pack2(rb[4].x, rb[5].x); v[3] = pack2(rb[6].x, rb[7].x); *(u32x4*)(bwr0 + (PO)) = v; \
      v[0] = pack2(rb[0].y, rb[1].y); v[1] = pack2(rb[2].y, rb[3].y); v[2] = pack2(rb[4].y, rb[5].y); v[3] = pack2(rb[6].y, rb[7].y); *(u32x4*)(bwr0 + (PO) + 128) = v; \
      v[0] = pack2(rb[0].z, rb[1].z); v[1] = pack2(rb[2].z, rb[3].z); v[2] = pack2(rb[4].z, rb[5].z); v[3] = pack2(rb[6].z, rb[7].z); *(u32x4*)(bwr1 + (PO)) = v; \
      v[0] = pack2(rb[0].w, rb[1].w); v[1] = pack2(rb[2].w, rb[3].w); v[2] = pack2(rb[4].w, rb[5].w); v[3] = pack2(rb[6].w, rb[7].w); *(u32x4*)(bwr1 + (PO) + 128) = v; \
    } } while (0)
  GEMM_LOADA(0);
  bl.load(rb0, 0);
  __syncthreads();
  GEMM_WRITE(rb0, 0);
  if (V != 3) { if (nk > 1) { GEMM_LOADA(1); bl.load(rb0, 1); } }
  __syncthreads();
#define GEMM_STEP(rbn, KT) do { \
    const int po = ((KT) & 1) * SM_TILE; \
    if ((KT) + 1 < nk) { \
      GEMM_WRITE(rbn, SM_TILE - po); \
      if (V != 3) { if ((KT) + 2 < nk) { GEMM_LOADA((KT) + 2); bl.load(rbn, (KT) + 2); } } \
    } \
    _Pragma("unroll") for (int ks = 0; ks < 2; ++ks) { \
      bf16x8 fa[4], fb[4]; \
      const char* ard = (ks ? ard1 : ard0) + po; const char* brd = (ks ? brd1 : brd0) + po; \
      _Pragma("unroll") for (int n = 0; n < 4; ++n) fb[n] = *(const bf16x8*)(brd + n * 2048); \
      _Pragma("unroll") for (int m = 0; m < 4; ++m) fa[m] = *(const bf16x8*)(ard + m * 2048); \
      __builtin_amdgcn_sched_barrier(0); \
      if (V != 2) { \
        _Pragma("unroll") for (int m = 0; m < 4; ++m) _Pragma("unroll") for (int n = 0; n < 4; ++n) acc[m][n] = __builtin_amdgcn_mfma_f32_16x16x32_bf16(fa[m], fb[n], acc[m][n], 0, 0, 0); \
      } else { _Pragma("unroll") for (int m = 0; m < 4; ++m) asm volatile("" :: "v"(fa[m]), "v"(fb[m])); } \
    } \
    __syncthreads(); \
  } while (0)
  int kt = 0;
#pragma unroll 1
  for (; kt < nk; ++kt) { GEMM_STEP(rb0, kt); }
#undef GEMM_STEP
#undef GEMM_WRITE
#undef GEMM_LOADA
}
DEV void acc_zero(f32x4 (&acc)[4][4]) {
#pragma unroll
  for (int m = 0; m < 4; ++m)
#pragma unroll
    for (int n = 0; n < 4; ++n) acc[m][n] = (f32x4){0.f, 0.f, 0.f, 0.f};
}
#define EPI_BEGIN const int etid = otid();
#define EPI_ROW(m, j) (((etid >> 8) & 1) * 64 + (m) * 16 + ((etid & 63) >> 4) * 4 + (j))
#define EPI_COL(n) (((etid >> 6) & 3) * 64 + (n) * 16 + (etid & 15))

template <class Epi>
DEV void gemm_phase_dense(const unsigned short* A, int lda, const float* B, int ldb, int N, int K, Epi epi, char* smem) {
  const int tid = otid(); const int nct = N >> 8; const int nitems = (NR >> 7) * nct;
  for (int it = blockIdx.x; it < nitems; it += gridDim.x) {
    const int rt = it / nct, ct = it - rt * nct;
    ALRows al; al.base = (const char*)(A + (long)rt * 128 * lda);
#pragma unroll
    for (int i = 0; i < 2; ++i) al.off[i] = (unsigned)(((tid >> 3) + 64 * i) * lda + (tid & 7) * 8) * 2u;
    const BLStd bl = mk_bl(B + ct * 256, ldb, tid);
    f32x4 acc[4][4]; acc_zero(acc);
    gemm_t(al, bl, K >> 6, acc, smem);
    EPI_BEGIN
#pragma unroll
    for (int m = 0; m < 4; ++m)
#pragma unroll
      for (int n = 0; n < 4; ++n)
#pragma unroll
        for (int j = 0; j < 4; ++j) epi((long)rt * 128 + EPI_ROW(m, j), ct * 256 + EPI_COL(n), acc[m][n][j]);
  }
}
DEV void ph_proj_mfma(const P& p, int l, char* smem) {
  const int tid = otid(); const int nct = IN_W >> 8; const int nitems = (NR >> 7) * nct;
  const float* B = p.w_in + (long)l * D_MODEL * IN_W;
  for (int it = blockIdx.x; it < nitems; it += gridDim.x) {
    const int rt = it / nct, ct = it - rt * nct;
    ALRows al; al.base = (const char*)(p.ubf() + (long)rt * 128 * D_MODEL);
#pragma unroll
    for (int i = 0; i < 2; ++i) al.off[i] = (unsigned)(((tid >> 3) + 64 * i) * D_MODEL + (tid & 7) * 8) * 2u;
    const BLStd bl = mk_bl(B + ct * 256, IN_W, tid);
    f32x4 acc[4][4]; acc_zero(acc);
    gemm_t(al, bl, D_MODEL >> 6, acc, smem);
    EPI_BEGIN
    if (ct >= HY_OFF / 256 && ct < S5_OFF / 256) {
      const bool isctx = rt >= NL / 128;
      const int rloc = (isctx ? (rt - NL / 128) : rt) * 128;
      const int Ls = isctx ? CTX_LEN : SEQ; const int b = rloc / Ls; const int t0 = rloc - b * Ls;
      float* zb = p.zT() + (isctx ? (size_t)BATCH * 3 * HYENA_W * SEQ : (size_t)0) + (size_t)b * 3 * HYENA_W * Ls;
#pragma unroll
      for (int m = 0; m < 4; ++m)
#pragma unroll
        for (int n = 0; n < 4; ++n) {
          const int c = ct * 256 + EPI_COL(n) - HY_OFF; const int t = t0 + EPI_ROW(m, 0);
          *(float4*)(zb + (size_t)c * Ls + t) = make_float4(acc[m][n][0], acc[m][n][1], acc[m][n][2], acc[m][n][3]);
        }
    } else {
#pragma unroll
      for (int m = 0; m < 4; ++m)
#pragma unroll
        for (int n = 0; n < 4; ++n)
#pragma unroll
          for (int j = 0; j < 4; ++j) p.proj()[((long)rt * 128 + EPI_ROW(m, j)) * IN_W + ct * 256 + EPI_COL(n)] = acc[m][n][j];
    }
  }
}
DEV void ph_hyena_pre_gpu(const P& p, int l, long gtid, long gsize) {
  const float* sw = p.hy_short_w + l * 3 * 3 * HYENA_W; const float* sb = p.hy_short_b + l * 3 * HYENA_W;
  FOR_ITEMS(i, (long)BATCH * HYENA_W * (SEQ + CTX_LEN)) {
    const bool isctx = i >= (long)BATCH * HYENA_W * SEQ; const long ii = isctx ? i - (long)BATCH * HYENA_W * SEQ : i;
    const int Ls = isctx ? CTX_LEN : SEQ; const int t = (int)(ii % Ls); const int ch = (int)((ii / Ls) % HYENA_W); const int b = (int)(ii / ((long)Ls * HYENA_W));
    const float* zb = p.zT() + (isctx ? (size_t)BATCH * 3 * HYENA_W * SEQ : (size_t)0) + (size_t)b * 3 * HYENA_W * Ls;
    float z[3];
#pragma unroll
    for (int part = 0; part < 3; ++part) {
      const int cc = part * HYENA_W + ch; const float* zr = zb + (size_t)cc * Ls; float acc = sb[cc];
      if (t > 0) acc += zr[t - 1] * sw[cc];
      acc += zr[t] * sw[3 * HYENA_W + cc];
      if (t + 1 < Ls) acc += zr[t + 1] * sw[2 * 3 * HYENA_W + cc];
      z[part] = acc;
    }
    const long o = isctx ? ((long)NL + b * CTX_LEN + t) * HYENA_W + ch : ((long)b * HYENA_W + ch) * SEQ + t;
    p.hu()[o] = z[0] * z[1]; p.hx0()[o] = z[2];
  }
}
DEV void ph_glu_mfma(const P& p, int l, char* smem) {
  EpiGlu e{p.ybuf(), p.mixb()};
  gemm_phase_dense(p.ybf(), S5_W, p.s5_w_glu + (long)l * S5_W * S5_W, S5_W, S5_W, S5_W, e, smem);
}
DEV void ph_outproj_mfma(const P& p, int l, char* smem) {
  EpiRes e{p.xcur(), p.mod(), l, 2 * D_MODEL, p.tmp()};
  gemm_phase_dense(p.mixbf(), MIX_W, p.w_out + (long)l * MIX_W * D_MODEL, D_MODEL, D_MODEL, MIX_W, e, smem);
}
DEV void exp_prefix(const P& p, int l, int* toff, int* roff) {
  const int tid = otid(), lane = tid & 63, w = tid >> 6;
  __syncthreads();
  int c = 0, tl = 0, incl = 0;
  int* wsum = roff + N_EXPERTS + 8;
  if (tid < N_EXPERTS) {
    c = p.cnt()[l * N_EXPERTS + tid];
    tl = (c + 127) >> 7; incl = tl;
#pragma unroll
    for (int o = 1; o < 64; o <<= 1) { const int v = __shfl_up(incl, o); if (lane >= o) incl += v; }
    if (lane == 63) wsum[w] = incl;
    roff[tid] = c;
  }
  __syncthreads();
  if (tid < N_EXPERTS) {
    int base = 0;
#pragma unroll
    for (int k = 0; k < 4; ++k) if (k < w) base += wsum[k];
    toff[tid] = base + incl - tl;
    if (tid == N_EXPERTS - 1) toff[N_EXPERTS] = base + incl;
  }
  __syncthreads();
}
DEV int exp_find(const int* toff, int tile) {
  int lo = 0, hi = N_EXPERTS - 1;
  while (lo < hi) { int mid = (lo + hi + 1) >> 1; if (toff[mid] <= tile) lo = mid; else hi = mid - 1; }
  return lo;
}
template <int V = 0>
DEV void upgate_tile(const ALRows& al, const float* wg, const float* wu, int cq, f32x4 (&acc)[4][4], char* smem, int tid) {
  const int nq = tid >> 3; const int wsel = __builtin_amdgcn_readfirstlane(tid >> 6) & 1;
  BLStd bl; bl.base = (const char*)((wsel ? wu : wg) + cq * 128); bl.ldb4 = EXPERT_FF * 4; bl.valid = true;
  bl.voff = (unsigned)((tid & 7) * 8) * (unsigned)(EXPERT_FF * 4) + (unsigned)(((nq >> 4) * 32 + (nq & 7) * 4) * 4);
  acc_zero(acc);
  gemm_t<V>(al, bl, D_MODEL >> 6, acc, smem);
}
static_assert(EXPERT_FF == 256 && SHARED_FF == 256, "ff tiling");
template <int V = 0>
DEV void ph_expert_up_mfma(const P& p, int l, char* smem) {
  const int tid = otid(), lane = tid & 63, wc = (tid >> 6) & 3;
  int* toff = (int*)(smem + SM_MISC); int* roff = toff + N_EXPERTS + 1;
  exp_prefix(p, l, toff, roff);
  const int n_items = toff[N_EXPERTS] * 2;
  for (int it = blockIdx.x; it < n_items; it += gridDim.x) {
    const int tile = it >> 1, cq = it & 1;
    const int e = __builtin_amdgcn_readfirstlane(exp_find(toff, tile)); const int j0 = (tile - toff[e]) * 128;
    const int nrows = min(128, roff[e] - j0), rbase = e * NR + j0;
    const float* wg = p.w_exp_gate + ((long)l * N_EXPERTS + e) * D_MODEL * EXPERT_FF; const float* wu = p.w_exp_up + ((long)l * N_EXPERTS + e) * D_MODEL * EXPERT_FF;
    ALRows al; al.base = (const char*)p.ubf();
#pragma unroll
    for (int i = 0; i < 2; ++i) { const int rl = min((tid >> 3) + 64 * i, nrows - 1); al.off[i] = ((unsigned)(p.elist()[rbase + rl] / TOP_K) * D_MODEL + (tid & 7) * 8) * 2u; }
    f32x4 acc[4][4];
    upgate_tile<V>(al, wg, wu, cq, acc, smem, tid);
    EPI_BEGIN
    const int elane = etid & 63, ewc = (etid >> 6) & 3;
#pragma unroll
    for (int m = 0; m < 4; ++m)
#pragma unroll
      for (int j = 0; j < 4; ++j) {
        const int rl = EPI_ROW(m, j);
        if (rl < nrows) {
          { unsigned short* dst = p.hbf() + (long)p.elist()[rbase + rl] * EXPERT_FF + cq * 128 + ewc * 32 + (elane & 15);
            dst[0] = (unsigned short)f2bf(siluf(acc[m][0][j]) * acc[m][2][j]); dst[16] = (unsigned short)f2bf(siluf(acc[m][1][j]) * acc[m][3][j]); }
        }
      }
  }
}
DEV void ph_expert_down_mfma(const P& p, int l, char* smem) {
  const int tid = otid();
  int* toff = (int*)(smem + SM_MISC); int* roff = toff + N_EXPERTS + 1;
  exp_prefix(p, l, toff, roff);
  const int NCT = D_MODEL / 256;
  const int n_exp_items = toff[N_EXPERTS] * NCT;
  const int n_sh_items = (NR >> 7) * NCT;
  for (int it = blockIdx.x; it < n_exp_items + n_sh_items; it += gridDim.x) {
    const bool shared = it >= n_exp_items;
    int ct, nrows, rbase, e = 0; const float* wd;
    if (!shared) {
      const int tile = it / NCT; ct = it - tile * NCT;
      e = __builtin_amdgcn_readfirstlane(exp_find(toff, tile)); const int j0 = (tile - toff[e]) * 128;
      nrows = min(128, roff[e] - j0); rbase = e * NR + j0;
      wd = p.w_exp_down + ((long)l * N_EXPERTS + e) * EXPERT_FF * D_MODEL;
    } else {
      const int it2 = it - n_exp_items; const int rt = it2 / NCT; ct = it2 - rt * NCT;
      nrows = 128; rbase = rt * 128; wd = p.w_sh_down + (long)l * SHARED_FF * D_MODEL;
    }
    ALRows al; al.base = (const char*)(shared ? p.hsbf() : p.hbf());
#pragma unroll
    for (int i = 0; i < 2; ++i) {
      const int rl = min((tid >> 3) + 64 * i, nrows - 1);
      const unsigned a = shared ? (unsigned)(rbase + rl) : (unsigned)p.elist()[rbase + rl];
      al.off[i] = (a * EXPERT_FF + (tid & 7) * 8) * 2u;
    }
    const BLStd bl = mk_bl(wd + ct * 256, D_MODEL, tid);
    f32x4 acc[4][4]; acc_zero(acc);
    gemm_t(al, bl, EXPERT_FF >> 6, acc, smem);
    EPI_BEGIN
#pragma unroll
    for (int m = 0; m < 4; ++m)
#pragma unroll
      for (int j = 0; j < 4; ++j) {
        const int rl = EPI_ROW(m, j);
        if (rl < nrows) {
          float* dst; float gsc = 1.0f;
          if (shared) dst = p.ysh() + (long)(rbase + rl) * D_MODEL; else { const int a = p.elist()[rbase + rl]; dst = p.yk() + (long)a * D_MODEL; gsc = p.gate()[a]; }
#pragma unroll
          for (int n = 0; n < 4; ++n) dst[ct * 256 + EPI_COL(n)] = acc[m][n][j] * gsc;
        }
      }
  }
}

typedef __attribute__((ext_vector_type(16))) float f32x16;
#define SM_HR 256
#define UB_STRIDE 8272
#define SM_HU (256 + 32768)
#define SMEM_HY (256 + 32768 + 2 * UB_STRIDE * 2)
static_assert(SEQ == 8192 && HYENA_W == 256, "hyena mfma shape");
DEV void ph_hyena_mfma(const P& p, int l, char* smem) {
  const int tid = otid(), lane = tid & 63, w = tid >> 6;
  unsigned short* R = (unsigned short*)(smem + SM_HR); unsigned short* U = (unsigned short*)(smem + SM_HU);
  for (int ch = blockIdx.x; ch < HYENA_W; ch += gridDim.x) {
    __syncthreads();
    const float* kf = p.kraw() + ((long)l * 2 * HYENA_W + ch) * SEQ; const float* kb = p.kraw() + ((long)l * 2 * HYENA_W + HYENA_W + ch) * SEQ;
    for (int y = tid; y < 2 * SEQ; y += NT) {
      const int lag = SEQ - y; float v = 0.f;
      if (lag >= 0 && lag < SEQ) v = kf[lag]; else if (lag < 0) v = kb[-lag];
      const int C = y >> 3; R[((C ^ ((C >> 4) & 1)) << 3) + (y & 7)] = (unsigned short)f2bf(v);
    }
    for (int e = tid; e < 2 * UB_STRIDE; e += NT) {
      const int b = e / UB_STRIDE, ee = e - b * UB_STRIDE, t = ee - 16; float v = 0.f;
      if (t >= 0 && t < SEQ) v = p.hu()[((long)b * HYENA_W + ch) * SEQ + t];
      U[e] = (unsigned short)f2bf(v);
    }
    __syncthreads();
    f32x16 acc[2];
#pragma unroll
    for (int mi = 0; mi < 2; ++mi)
#pragma unroll
      for (int k = 0; k < 16; ++k) acc[mi][k] = 0.f;
    const int r = lane & 31, h = lane >> 5, sig = lane & 15, bb = (lane >> 4) & 1;
    const unsigned* Ud = (const unsigned*)U + bb * (UB_STRIDE / 2);
    const int ub0 = 8 * h + sig;
    const int cbase = 1022 - 64 * (2 * w) - 2 * r + h;
    const bool odd = sig & 1;
    bf16x8 afn[2]; unsigned dn[5];
    {
#pragma unroll
      for (int mi = 0; mi < 2; ++mi) { const int C = cbase - 64 * mi; afn[mi] = *(const bf16x8*)((const char*)R + ((C ^ ((C >> 4) & 1)) << 4)); }
      const int di = ub0 >> 1;
#pragma unroll
      for (int i = 0; i < 5; ++i) dn[i] = Ud[di + i];
    }
#pragma unroll 1
    for (int q = 0; q <= SEQ / 16; ++q) {
      bf16x8 af[2]; unsigned d[5];
#pragma unroll
      for (int mi = 0; mi < 2; ++mi) af[mi] = afn[mi];
#pragma unroll
      for (int i = 0; i < 5; ++i) d[i] = dn[i];
      {
        const int qn = min(q + 1, SEQ / 16);
#pragma unroll
        for (int mi = 0; mi < 2; ++mi) { const int C = cbase - 64 * mi + 2 * qn; afn[mi] = *(const bf16x8*)((const char*)R + ((C ^ ((C >> 4) & 1)) << 4)); }
        const int di = (16 * qn + ub0) >> 1;
#pragma unroll
        for (int i = 0; i < 5; ++i) dn[i] = Ud[di + i];
      }
      u32x4 bw;
#pragma unroll
      for (int i = 0; i < 4; ++i) bw[i] = odd ? __builtin_amdgcn_alignbit(d[i + 1], d[i], 16) : d[i];
      const bf16x8 bfr = __builtin_bit_cast(bf16x8, bw);
#pragma unroll
      for (int mi = 0; mi < 2; ++mi) acc[mi] = __builtin_amdgcn_mfma_f32_32x32x16_bf16(af[mi], bfr, acc[mi], 0, 0, 0);
    }
    __syncthreads();
    {
      float* Y = (float*)(smem + SM_HR);
      float* yl = Y + bb * SEQ + 16 * (32 * (2 * w) + 4 * h) + sig;
#pragma unroll
      for (int mi = 0; mi < 2; ++mi)
#pragma unroll
        for (int k = 0; k < 16; ++k) yl[16 * (32 * mi + (k & 3) + 8 * (k >> 2))] = acc[mi][k];
    }
    __syncthreads();
    {
      const float* Y = (const float*)(smem + SM_HR);
      const float kn = p.knorm()[l * HYENA_W + ch], dsk = p.hy_d[l * HYENA_W + ch];
#pragma unroll 2
      for (int idx = tid; idx < BATCH * SEQ; idx += NT) {
        const int b = idx / SEQ, t = idx - b * SEQ;
        const long o = ((long)b * HYENA_W + ch) * SEQ + t;
        p.mixb()[(long)idx * MIX_W + ATTN_W + ch] = (Y[idx] * kn + p.hu()[o] * dsk) * p.hx0()[o];
      }
    }
  }
}
#define SM_K 256
#define SM_V (256 + 8192)
static_assert(HEAD_DIM == 64 && WINDOW == 128 && CTX_LEN == 256 && Q_GROUP == 4, "attention shape");
DEV void ph_attn_mfma(const P& p, int l, char* smem) {
  const int tid = otid(), lane = tid & 63, w = (tid >> 6) & 3, hsel = tid >> 8, h = lane >> 5, ql = lane & 31;
  char* Ks = smem + SM_K; char* Vs = smem + SM_V;
  const int n_lat = BATCH * (SEQ / 128) * N_KV_HEADS * (Q_GROUP / 2);
  const int n_ctx = (l == 0) ? BATCH * (CTX_LEN / 128) * N_KV_HEADS * (Q_GROUP / 2) : 0;
  const float QS = 0.125f * 1.4426950408889634f;
  for (int it = blockIdx.x; it < n_lat + n_ctx; it += gridDim.x) {
    const bool isctx = it >= n_lat;
    int b, qb, kvh, g;
    { int x = isctx ? it - n_lat : it; g = (x & 1) * 2 + hsel; kvh = (x >> 1) & 1; x >>= 2; if (isctx) { qb = x & 1; b = x >> 1; } else { qb = x & 63; b = x >> 6; } }
    const int hq = kvh * Q_GROUP + g;
    const int tq0 = qb * 128 + 32 * w;
    const long qrow = (isctx ? (long)NL + b * CTX_LEN : (long)b * SEQ) + tq0 + ql;
    bf16x8 qf[4];
    {
      const float* qp = p.proj() + qrow * IN_W + Q_OFF + hq * HEAD_DIM + 8 * h;
#pragma unroll
      for (int ks = 0; ks < 4; ++ks) {
        float4 a = *(const float4*)(qp + 16 * ks), c = *(const float4*)(qp + 16 * ks + 4);
        u32x4 v; v[0] = pack2(a.x * QS, a.y * QS); v[1] = pack2(a.z * QS, a.w * QS); v[2] = pack2(c.x * QS, c.y * QS); v[3] = pack2(c.z * QS, c.w * QS);
        qf[ks] = __builtin_bit_cast(bf16x8, v);
      }
    }
    f32x16 o0, o1;
#pragma unroll
    for (int k = 0; k < 16; ++k) { o0[k] = 0.f; o1[k] = 0.f; }
    float m = -1e30f, lsum = 0.f;
    const int nsteps = isctx ? 4 : 10;
    float4 rk[1][2], rv[1][2];
    auto key_row = [&](int step, int key) -> long {
      if (step < 4) return (long)NL + b * CTX_LEN + step * 64 + key;
      const int tk = qb * 128 - 128 + (step - 4) * 64 + key;
      return (tk < 0 || tk >= SEQ) ? -1 : (long)b * SEQ + tk;
    };
    auto step_valid = [&](int step) -> bool { if (step < 4) return true; const int t0 = qb * 128 - 128 + (step - 4) * 64; return t0 >= 0 && t0 < SEQ; };
    auto load_tile = [&](int step) {
#pragma unroll
      for (int i = 0; i < 1; ++i) {
        const int key = (tid >> 3); const long kr = key_row(step, key);
        const float* kp = p.proj() + kr * IN_W + K_OFF + kvh * HEAD_DIM + (tid & 7) * 8; const float* vp = p.proj() + kr * IN_W + V_OFF + kvh * HEAD_DIM + (tid & 7) * 8;
        rk[i][0] = *(const float4*)kp; rk[i][1] = *(const float4*)(kp + 4); rv[i][0] = *(const float4*)vp; rv[i][1] = *(const float4*)(vp + 4);
      }
    };
    int step = 0;
    load_tile(0);
    while (step < nsteps) {
      __syncthreads();
#pragma unroll
      for (int i = 0; i < 1; ++i) {
        const int key = (tid >> 3), ch = tid & 7;
        u32x4 v; v[0] = pack2(rk[i][0].x, rk[i][0].y); v[1] = pack2(rk[i][0].z, rk[i][0].w); v[2] = pack2(rk[i][1].x, rk[i][1].y); v[3] = pack2(rk[i][1].z, rk[i][1].w);
        *(u32x4*)(Ks + tile_off(key, ch)) = v;
        v[0] = pack2(rv[i][0].x, rv[i][0].y); v[1] = pack2(rv[i][0].z, rv[i][0].w); v[2] = pack2(rv[i][1].x, rv[i][1].y); v[3] = pack2(rv[i][1].z, rv[i][1].w);
        *(u32x4*)(Vs + key * 128 + ((ch * 16) ^ (64 * ((key >> 1) & 1)))) = v;
      }
      __syncthreads();
      const int cur = step;
      int nxt = step + 1;
      while (nxt < nsteps && !step_valid(nxt)) ++nxt;
      if (nxt < nsteps) load_tile(nxt);
      step = nxt;
#pragma unroll
      for (int sub = 0; sub < 2; ++sub) {
        const bool win = cur >= 4;
        const int ks0 = win ? qb * 128 - 128 + (cur - 4) * 64 + sub * 32 : 0;
        if (win && (ks0 > tq0 + 31 + WINDOW || ks0 + 31 < tq0 - WINDOW)) continue;
        f32x16 sacc;
#pragma unroll
        for (int k = 0; k < 16; ++k) sacc[k] = 0.f;
#pragma unroll
        for (int ks = 0; ks < 4; ++ks) {
          const bf16x8 kf = *(const bf16x8*)(Ks + tile_off(sub * 32 + ql, 2 * ks + h));
          sacc = __builtin_amdgcn_mfma_f32_32x32x16_bf16(kf, qf[ks], sacc, 0, 0, 0);
        }
        if (win && (ks0 + 31 - tq0 > WINDOW || tq0 + 31 - ks0 > WINDOW)) {
          const int tq = tq0 + ql;
#pragma unroll
          for (int k = 0; k < 16; ++k) { const int d = ks0 + (k & 3) + 8 * (k >> 2) + 4 * h - tq; if (d > WINDOW || d < -WINDOW) sacc[k] = -1e30f; }
        }
        float mx = sacc[0];
#pragma unroll
        for (int k = 1; k < 16; ++k) mx = fmaxf(mx, sacc[k]);
        mx = fmaxf(mx, __shfl_xor(mx, 32));
        const float mn = fmaxf(m, mx); const float alpha = exp2f(m - mn); m = mn;
        float ps = 0.f;
#pragma unroll
        for (int k = 0; k < 16; ++k) { sacc[k] = exp2f(sacc[k] - mn); ps += sacc[k]; }
        lsum = lsum * alpha + ps;
#pragma unroll
        for (int k = 0; k < 16; ++k) { o0[k] *= alpha; o1[k] *= alpha; }
        u32x2 v00, v01, v02, v03, v10, v11, v12, v13;
        {
          const int q4 = (lane & 15) >> 2, p4 = lane & 3, blk = (lane >> 4) & 1, sq = (q4 >> 1) & 1;
          const unsigned lb = (unsigned)(size_t)((__attribute__((address_space(3))) char*)Vs) + (unsigned)((sub * 32 + 4 * h + q4) * 128 + 32 * blk + 8 * p4);
          const unsigned base0 = lb + 64 * sq, base1 = lb + 64 * (1 - sq);
          asm volatile(
              "ds_read_b64_tr_b16 %0, %8\n\t"
              "ds_read_b64_tr_b16 %1, %8 offset:1024\n\t"
              "ds_read_b64_tr_b16 %2, %8 offset:2048\n\t"
              "ds_read_b64_tr_b16 %3, %8 offset:3072\n\t"
              "ds_read_b64_tr_b16 %4, %9\n\t"
              "ds_read_b64_tr_b16 %5, %9 offset:1024\n\t"
              "ds_read_b64_tr_b16 %6, %9 offset:2048\n\t"
              "ds_read_b64_tr_b16 %7, %9 offset:3072\n\t"
              "s_waitcnt lgkmcnt(0)"
              : "=&v"(v00), "=&v"(v01), "=&v"(v02), "=&v"(v03), "=&v"(v10), "=&v"(v11), "=&v"(v12), "=&v"(v13)
              : "v"(base0), "v"(base1) : "memory");
        }
#pragma unroll
        for (int ks2 = 0; ks2 < 2; ++ks2) {
          u32x4 pw;
#pragma unroll
          for (int i = 0; i < 4; ++i) pw[i] = pack2(sacc[8 * ks2 + 2 * i], sacc[8 * ks2 + 2 * i + 1]);
          const bf16x8 pf = __builtin_bit_cast(bf16x8, pw);
          u32x4 a0, a1;
          if (ks2 == 0) { a0[0] = v00[0]; a0[1] = v00[1]; a0[2] = v01[0]; a0[3] = v01[1]; a1[0] = v10[0]; a1[1] = v10[1]; a1[2] = v11[0]; a1[3] = v11[1]; }
          else          { a0[0] = v02[0]; a0[1] = v02[1]; a0[2] = v03[0]; a0[3] = v03[1]; a1[0] = v12[0]; a1[1] = v12[1]; a1[2] = v13[0]; a1[3] = v13[1]; }
          o0 = __builtin_amdgcn_mfma_f32_32x32x16_bf16(__builtin_bit_cast(bf16x8, a0), pf, o0, 0, 0, 0);
          o1 = __builtin_amdgcn_mfma_f32_32x32x16_bf16(__builtin_bit_cast(bf16x8, a1), pf, o1, 0, 0, 0);
        }
      }
    }
    lsum += __shfl_xor(lsum, 32);
    const float sk = p.sink[l * N_Q_HEADS + hq] * 1.4426950408889634f;
    const float mf = fmaxf(m, sk); const float sc = exp2f(m - mf); const float inv = sc / (lsum * sc + exp2f(sk - mf));
    float* op = p.mixb() + qrow * MIX_W + hq * HEAD_DIM + 4 * h;
#pragma unroll
    for (int gq = 0; gq < 4; ++gq) {
      *(float4*)(op + 8 * gq) = make_float4(o0[4 * gq] * inv, o0[4 * gq + 1] * inv, o0[4 * gq + 2] * inv, o0[4 * gq + 3] * inv);
      *(float4*)(op + 32 + 8 * gq) = make_float4(o1[4 * gq] * inv, o1[4 * gq + 1] * inv, o1[4 * gq + 2] * inv, o1[4 * gq + 3] * inv);
    }
  }
}


static_assert(S5_T == 64 && S5_STATE == 64 && S5_GROUP == 16 && S5_GROUPS == 16 && NCH == 132, "s5 mfma shape");
#define S5_COLS (BATCH * NCH)
#define S5_RT 88
DEV void ph_s5tables_gpu(const P& p, long gtid, long gsize) {
  FOR_ITEMS(i, (long)DEPTH * 2 * S5_GROUPS * 1024 * 128) {
    const int n = (int)(i & 127), k = (int)((i >> 7) & 1023); const long ldg = i >> 17;
    const int ri = n >> 6, pp = n & 63, sidx = k >> 4, j = k & 15;
    const float2 lp = p.lampow()[(ldg * (S5_T + 1) + (S5_T - 1 - sidx)) * S5_STATE + pp]; const float2 bb = p.bbar()[(ldg * S5_STATE + pp) * S5_GROUP + j];
    p.bmt()[i] = ri ? lp.x * bb.y + lp.y * bb.x : lp.x * bb.x - lp.y * bb.y;
  }
  FOR_ITEMS(i, (long)DEPTH * 2 * S5_GROUPS * 128 * 1024) {
    const int k = (int)(i & 127), n = (int)((i >> 7) & 1023); const long ldg = i >> 17; const int dir = (int)((ldg >> 4) & 1);
    const int ri = k >> 6, pp = k & 63, tl = n >> 4, ii = n & 15; const int tau = dir ? 63 - tl : tl;
    const float cr = p.s5_c_re[(ldg * S5_GROUP + ii) * S5_STATE + pp], ci = p.s5_c_im[(ldg * S5_GROUP + ii) * S5_STATE + pp];
    const float2 lp = p.lampow()[(ldg * (S5_T + 1) + tau + 1) * S5_STATE + pp];
    p.cmt()[i] = ri ? -(cr * lp.y + ci * lp.x) : cr * lp.x - ci * lp.y;
  }
}
struct ALS5U { const char* base; unsigned off0[2]; int stepb; const char* hbase; unsigned hoff[2]; int nki;
  DEVM void set(int i, int b, int dir, int chunk, int sl, unsigned joff) { off0[i] = (unsigned)s5_row(b, dir, chunk * S5_T + sl) * (unsigned)(S5_W * 2) + joff; }
  DEVM const unsigned short* a(int i, int kt) const {
    if (kt >= nki) return (const unsigned short*)(hbase + (hoff[i] + (unsigned)(kt - nki) * 128u));
    return (const unsigned short*)(base + (off0[i] + (unsigned)(kt * stepb))); } };
struct BLKc { static constexpr bool TR = true; const char* kc; const char* cm; int tl, i0, sj, ss, dir, nki; unsigned cmoff;
  DEVM void load(float4 (&rb)[8], int kt) const {
    if (kt >= nki) {
#pragma unroll
      for (int c = 0; c < 4; ++c) { const char* q = cm + (cmoff + (unsigned)(c * 128 + (kt - nki) * 64) * 4u); rb[2 * c] = *(const float4*)q; rb[2 * c + 1] = *(const float4*)(q + 16); }
      return;
    }
    const int d = (dir ? 63 - tl : tl) - (4 * kt + ss);
    if (d < 0) {
#pragma unroll
      for (int i = 0; i < 8; ++i) rb[i] = make_float4(0.f, 0.f, 0.f, 0.f);
    } else {
#pragma unroll
      for (int c = 0; c < 4; ++c) { const char* q = kc + (unsigned)(((d * 16 + i0 + c) * 16 + sj) * 4); rb[2 * c] = *(const float4*)q; rb[2 * c + 1] = *(const float4*)(q + 16); }
    }
  } };
DEV void ph_s5_sgemm(const P& p, int l, char* smem) {
  const int tid = otid();
  const int nitems = 2 * S5_GROUPS * 3;
  for (int it = blockIdx.x; it < nitems; it += gridDim.x) {
    const int rt = it % 3, g = (it / 3) % S5_GROUPS, dir = it / (3 * S5_GROUPS);
    ALS5U al; al.base = (const char*)(p.s5u() + g * S5_GROUP); al.stepb = (dir ? -4 : 4) * S5_W * 2; al.nki = 1 << 20; al.hbase = al.base; al.hoff[0] = al.hoff[1] = 0;
#pragma unroll
    for (int i = 0; i < 2; ++i) { const int col = rt * S5_RT + min((tid >> 3) + 64 * i, S5_RT - 1); al.set(i, col / NCH, dir, col % NCH, (tid & 7) >> 1, (tid & 1) * 16); }
    BLStd bl = mk_bl(p.bmt() + (((long)l * 2 + dir) * S5_GROUPS + g) * 1024 * 128, 128, tid);
    bl.valid = (tid >> 3) < 32;
    f32x4 acc[4][4]; acc_zero(acc);
    gemm_t(al, bl, 16, acc, smem);
    EPI_BEGIN
    if (((etid >> 6) & 3) < 2) {
#pragma unroll
      for (int m = 0; m < 4; ++m)
#pragma unroll
        for (int j = 0; j < 4; ++j) {
          const int rl = EPI_ROW(m, j);
          if (rl < S5_RT) {
            const int col = rt * S5_RT + rl; const int b = col / NCH, c = col % NCH;
            float* dst = (float*)(p.sc() + ((((long)b * 2 + dir) * S5_GROUPS + g) * NCH + c) * S5_STATE);
#pragma unroll
            for (int n = 0; n < 4; ++n) { const int nn = EPI_COL(n); dst[(nn & 63) * 2 + (nn >> 6)] = acc[m][n][j]; }
          }
        }
    }
  }
}
DEV void ph_s5_ygemm(const P& p, int l, char* smem) {
  const int tid = otid();
  const int nitems = S5_GROUPS * 3 * 4;
  for (int it = blockIdx.x; it < nitems; it += gridDim.x) {
    const int nt = it & 3, rt = (it >> 2) % 3, g = it / 12;
    f32x4 acc[4][4]; acc_zero(acc);
#pragma unroll 1
    for (int dir = 0; dir < 2; ++dir) {
      const long ldg = ((long)l * 2 + dir) * S5_GROUPS + g;
      const int nki = dir ? 16 - 4 * nt : 4 * nt + 4;
      ALS5U al; al.base = (const char*)(p.s5u() + g * S5_GROUP); al.stepb = (dir ? -4 : 4) * S5_W * 2; al.nki = nki; al.hbase = (const char*)p.hcbf();
#pragma unroll
      for (int i = 0; i < 2; ++i) {
        const int col = rt * S5_RT + min((tid >> 3) + 64 * i, S5_RT - 1); const int b = col / NCH, blk = col % NCH;
        const int ch = dir ? (blk < 4 ? 3 - blk : 135 - blk) : blk;
        al.set(i, b, dir, ch, (tid & 7) >> 1, (tid & 1) * 16);
        al.hoff[i] = (unsigned)((((b * 2 + dir) * S5_GROUPS + g) * NCH + ch) * 128 + (tid & 7) * 8) * 2u;
      }
      BLKc bk; bk.kc = (const char*)(p.kc() + ldg * S5_T * 256); bk.tl = 16 * nt + (tid >> 5); bk.i0 = ((tid >> 3) & 3) * 4; bk.sj = (tid & 1) * 8; bk.ss = (tid & 7) >> 1; bk.dir = dir; bk.nki = nki;
      bk.cm = (const char*)(p.cmt() + ldg * 1024 * 128); bk.cmoff = (unsigned)(((16 * nt + (tid >> 5)) * 16 + ((tid >> 3) & 3) * 4) * 128 + (tid & 7) * 8) * 4u;
      gemm_t(al, bk, nki + 2, acc, smem);
    }
    EPI_BEGIN
#pragma unroll
    for (int m = 0; m < 4; ++m)
#pragma unroll
      for (int j = 0; j < 4; ++j) {
        const int rl = EPI_ROW(m, j);
        if (rl < S5_RT) {
          const int col = rt * S5_RT + rl; const int b = col / NCH, blk = col % NCH;
#pragma unroll
          for (int n = 0; n < 4; ++n) {
            const int nn = nt * 256 + EPI_COL(n); const int tl = nn >> 4, chn = g * S5_GROUP + (nn & 15);
            const long row = blk < 4 ? (long)NL + b * CTX_LEN + blk * 64 + tl : (long)b * SEQ + (blk - 4) * 64 + tl;
            const float y = acc[m][n][j] + p.s5_d[l * S5_W + chn] * p.proj()[row * IN_W + S5_OFF + chn];
            const float gy = gelu_tanhf(y);
            p.ybuf()[row * S5_W + chn] = gy; p.ybf()[row * S5_W + chn] = (unsigned short)f2bf(gy);
          }
        }
      }
  }
}

DEV float wave_sum(float v) {
#pragma unroll
  for (int o = 32; o > 0; o >>= 1) v += __shfl_xor(v, o);
  return v;
}
DEV void st_bf4(unsigned short* dst, float a, float b, float c, float d) { u32x2 v; v[0] = pack2(a, b); v[1] = pack2(c, d); *(u32x2*)dst = v; }
static_assert(BATCH == 2, "mod partial layout");
DEV void ph_modsum_gpu(const P& p, long gtid, long gsize) {
  FOR_ITEMS(i, (long)DEPTH * D_MODEL * N_EXPERTS) p.wrlo()[i] = bflo(p.w_router[i]);
  FOR_ITEMS(i, (long)DEPTH * (BATCH + 1) * 6 * D_MODEL) {
    const int n = (int)(i % (6 * D_MODEL)); const int j = (int)((i / (6 * D_MODEL)) % (BATCH + 1)); const int l = (int)(i / (6 * D_MODEL * (BATCH + 1)));
    float acc = p.b_ada[l * 6 * D_MODEL + n];
#pragma unroll
    for (int sl = 0; sl < 16; ++sl) acc += p.modp()[((long)(l * 16 + sl) * (BATCH + 1) + j) * 6 * D_MODEL + n];
    p.mod()[i] = acc;
  }
}
DEV void ph_modu0_gpu(const P& p, long gtid, long gsize) {
  FOR_ITEMS(i4, (long)NR * D_MODEL / 4) {
    const long i = i4 * 4; const int k = (int)(i % D_MODEL); const long r = i / D_MODEL;
    const float* m = p.mod() + (long)modrow(r) * 6 * D_MODEL;
    const float4 x = *(const float4*)(p.xcur() + i); const float4 sh = *(const float4*)(m + k); const float4 sc = *(const float4*)(m + D_MODEL + k);
    st_bf4(p.ubf() + i, x.x * (1.f + sc.x) + sh.x, x.y * (1.f + sc.y) + sh.y, x.z * (1.f + sc.z) + sh.z, x.w * (1.f + sc.w) + sh.w);
  }
}
DEV void ph_rms_gpu(const P& p, int l) {
  const int tid_ = otid(); const int lane = tid_ & 63; const int gw = blockIdx.x * (NT / 64) + (tid_ >> 6), nw = gridDim.x * (NT / 64);
  for (long r = gw; r < NR; r += nw) {
    const float* v = p.mixb() + r * MIX_W; float4 a[4]; float ss[4];
#pragma unroll
    for (int i = 0; i < 4; ++i) { a[i] = *(const float4*)(v + (i * 64 + lane) * 4); ss[i] = a[i].x * a[i].x + a[i].y * a[i].y + a[i].z * a[i].z + a[i].w * a[i].w; }
    const float s_att = wave_sum(ss[0] + ss[1]), s_hy = wave_sum(ss[2]), s_s5 = wave_sum(ss[3]);
    float rs[4]; rs[0] = rs[1] = 1.0f / sqrtf(s_att / (float)ATTN_W + LN_EPS); rs[2] = 1.0f / sqrtf(s_hy / (float)HYENA_W + LN_EPS); rs[3] = 1.0f / sqrtf(s_s5 / (float)S5_W + LN_EPS);
#pragma unroll
    for (int i = 0; i < 4; ++i) {
      const int k = (i * 64 + lane) * 4; const float4 g = *(const float4*)(p.mix_g + l * MIX_W + k);
      st_bf4(p.mixbf() + r * MIX_W + k, a[i].x * rs[i] * g.x, a[i].y * rs[i] * g.y, a[i].z * rs[i] * g.z, a[i].w * rs[i] * g.w);
    }
  }
}
DEV void ln_rows(float4 (&a)[4], const float* gw, const float* bw, int lane) {
  float s = 0.f;
#pragma unroll
  for (int i = 0; i < 4; ++i) s += a[i].x + a[i].y + a[i].z + a[i].w;
  const float mu = wave_sum(s) / (float)D_MODEL; float q = 0.f;
#pragma unroll
  for (int i = 0; i < 4; ++i) { a[i].x -= mu; a[i].y -= mu; a[i].z -= mu; a[i].w -= mu; q += a[i].x * a[i].x + a[i].y * a[i].y + a[i].z * a[i].z + a[i].w * a[i].w; }
  const float rs = 1.0f / sqrtf(wave_sum(q) / (float)D_MODEL + LN_EPS);
#pragma unroll
  for (int i = 0; i < 4; ++i) {
    const int k = (i * 64 + lane) * 4; const float4 g = *(const float4*)(gw + k), b = *(const float4*)(bw + k);
    a[i].x = a[i].x * rs * g.x + b.x; a[i].y = a[i].y * rs * g.y + b.y; a[i].z = a[i].z * rs * g.z + b.z; a[i].w = a[i].w * rs * g.w + b.w;
  }
}
DEV void ph_ln1_gpu(const P& p, int l) {
  const int tid_ = otid(); const int lane = tid_ & 63; const int gw = blockIdx.x * (NT / 64) + (tid_ >> 6), nw = gridDim.x * (NT / 64);
  for (long r = gw; r < NR; r += nw) {
    float4 a[4];
#pragma unroll
    for (int i = 0; i < 4; ++i) a[i] = *(const float4*)(p.tmp() + r * D_MODEL + (i * 64 + lane) * 4);
    ln_rows(a, p.ln1_g + l * D_MODEL, p.ln1_b + l * D_MODEL, lane);
    const float* m = p.mod() + ((long)l * (BATCH + 1) + modrow(r)) * 6 * D_MODEL + 3 * D_MODEL;
#pragma unroll
    for (int i = 0; i < 4; ++i) {
      const int k = (i * 64 + lane) * 4;
      *(float4*)(p.xcur() + r * D_MODEL + k) = a[i];
      const float4 sh = *(const float4*)(m + k), sc = *(const float4*)(m + D_MODEL + k);
      const float u0 = a[i].x * (1.f + sc.x) + sh.x, u1 = a[i].y * (1.f + sc.y) + sh.y, u2 = a[i].z * (1.f + sc.z) + sh.z, u3 = a[i].w * (1.f + sc.w) + sh.w;
      st_bf4(p.ubf() + r * D_MODEL + k, u0, u1, u2, u3);
      st_bf4(p.ubl() + r * D_MODEL + k, bflo(u0), bflo(u1), bflo(u2), bflo(u3));
    }
  }
}
DEV void ph_ln2_gpu(const P& p, int l) {
  const int tid_ = otid(); const int lane = tid_ & 63; const int gw = blockIdx.x * (NT / 64) + (tid_ >> 6), nw = gridDim.x * (NT / 64);
  for (long r = gw; r < NR; r += nw) {
    float4 a[4];
    const float* m = p.mod() + ((long)l * (BATCH + 1) + modrow(r)) * 6 * D_MODEL + 5 * D_MODEL;
#pragma unroll
    for (int i = 0; i < 4; ++i) {
      const int k = (i * 64 + lane) * 4;
      float4 f = *(const float4*)(p.ysh() + r * D_MODEL + k);
#pragma unroll
      for (int kk = 0; kk < TOP_K; ++kk) { const float4 y = *(const float4*)(p.yk() + (r * TOP_K + kk) * D_MODEL + k); f.x += y.x; f.y += y.y; f.z += y.z; f.w += y.w; }
      const float4 x = *(const float4*)(p.xcur() + r * D_MODEL + k), g2 = *(const float4*)(m + k);
      a[i].x = DN_ALPHA * x.x + g2.x * f.x; a[i].y = DN_ALPHA * x.y + g2.y * f.y; a[i].z = DN_ALPHA * x.z + g2.z * f.z; a[i].w = DN_ALPHA * x.w + g2.w * f.w;
    }
    ln_rows(a, p.ln2_g + l * D_MODEL, p.ln2_b + l * D_MODEL, lane);
    const float* mn = p.mod() + ((long)(l + 1) * (BATCH + 1) + modrow(r)) * 6 * D_MODEL;
#pragma unroll
    for (int i = 0; i < 4; ++i) {
      const int k = (i * 64 + lane) * 4;
      *(float4*)(p.xcur() + r * D_MODEL + k) = a[i];
      if (l + 1 < DEPTH) {
        const float4 sh = *(const float4*)(mn + k), sc = *(const float4*)(mn + D_MODEL + k);
        st_bf4(p.ubf() + r * D_MODEL + k, a[i].x * (1.f + sc.x) + sh.x, a[i].y * (1.f + sc.y) + sh.y, a[i].z * (1.f + sc.z) + sh.z, a[i].w * (1.f + sc.w) + sh.w);
      } else if (r < NL) *(float4*)(p.out + r * D_MODEL + k) = a[i];
    }
  }
}
struct ALRouter { const char* hi; const char* lo_; unsigned off[2];
  DEVM const unsigned short* a(int i, int kt) const { return (const unsigned short*)((kt >= 32 ? lo_ : hi) + (off[i] + (unsigned)(kt & 15) * 128u)); } };
struct BLRouter { static constexpr bool TR = false; const char* base; const char* lob; unsigned voff; int ldb4;
  DEVM void load(float4 (&rb)[8], int kt) const {
    const char* bb = (kt >> 4) == 1 ? lob : base;
#pragma unroll
    for (int i = 0; i < 8; ++i) rb[i] = *(const float4*)(bb + (unsigned)((unsigned)((kt & 15) * 64 + i) * (unsigned)ldb4 + voff)); } };
DEV void ph_router_mfma(const P& p, int l, char* smem) {
  const int tid = otid();
  const int n_router = (NR >> 7), n_sh = (NR >> 7) * 2;
  const int nrb = (int)gridDim.x >= 64 ? (int)((gridDim.x * 3) / 5) : 0;
  const bool is_router = nrb == 0 ? false : (int)blockIdx.x < nrb;
  for (int pass = 0; pass < 2; ++pass) {
    const bool do_router = nrb == 0 ? pass == 0 : is_router;
    if (nrb != 0 && pass == 1) break;
    const int first = nrb == 0 ? (int)blockIdx.x : (do_router ? (int)blockIdx.x : (int)blockIdx.x - nrb);
    const int stride = nrb == 0 ? (int)gridDim.x : (do_router ? nrb : (int)gridDim.x - nrb);
    const int nit = do_router ? n_router : n_sh;
    for (int it = first; it < nit; it += stride) {
      const int rt = do_router ? it : (it >> 1), cq = do_router ? 0 : (it & 1);
      ALRouter ar; ar.hi = (const char*)(p.ubf() + (long)rt * 128 * D_MODEL); ar.lo_ = (const char*)(p.ubl() + (long)rt * 128 * D_MODEL);
#pragma unroll
      for (int i = 0; i < 2; ++i) ar.off[i] = (unsigned)(((tid >> 3) + 64 * i) * D_MODEL + (tid & 7) * 8) * 2u;
      BLRouter br; int nk;
      if (do_router) {
        br.base = (const char*)(p.w_router + (long)l * D_MODEL * N_EXPERTS); br.lob = (const char*)(p.wrlo() + (long)l * D_MODEL * N_EXPERTS); br.ldb4 = N_EXPERTS * 4;
        br.voff = bl_voff(N_EXPERTS * 4, tid); nk = 3 * (D_MODEL >> 6);
      } else {
        const int nq = tid >> 3; const int wsel = __builtin_amdgcn_readfirstlane(tid >> 6) & 1;
        const float* wsrc = (wsel ? p.w_sh_up : p.w_sh_gate) + (long)l * D_MODEL * SHARED_FF + cq * 128;
        br.base = (const char*)wsrc; br.lob = br.base; br.ldb4 = SHARED_FF * 4;
        br.voff = (unsigned)((tid & 7) * 8) * (unsigned)(SHARED_FF * 4) + (unsigned)(((nq >> 4) * 32 + (nq & 7) * 4) * 4); nk = D_MODEL >> 6;
      }
      f32x4 acc[4][4]; acc_zero(acc);
      gemm_t(ar, br, nk, acc, smem);
      EPI_BEGIN
      if (do_router) {
#pragma unroll
        for (int m = 0; m < 4; ++m)
#pragma unroll
          for (int n = 0; n < 4; ++n)
#pragma unroll
            for (int j = 0; j < 4; ++j) p.rl()[((long)rt * 128 + EPI_ROW(m, j)) * N_EXPERTS + EPI_COL(n)] = acc[m][n][j];
      } else {
        const int elane = etid & 63, ewc = (etid >> 6) & 3;
#pragma unroll
        for (int m = 0; m < 4; ++m)
#pragma unroll
          for (int j = 0; j < 4; ++j)
          { unsigned short* dst = p.hsbf() + ((long)rt * 128 + EPI_ROW(m, j)) * SHARED_FF + cq * 128 + ewc * 32 + (elane & 15);
            dst[0] = (unsigned short)f2bf(siluf(acc[m][0][j]) * acc[m][2][j]); dst[16] = (unsigned short)f2bf(siluf(acc[m][1][j]) * acc[m][3][j]); }
      }
    }
  }
}
static_assert(EPG == 32 && TOP_K == 8 && N_EXPERT_GROUPS == 8 && TOPK_GROUPS == 4, "select shape");
DEV void ph_select_gpu(const P& p, int l) {
  const int tid_ = otid(); const int lane = tid_ & 63; const int gw = blockIdx.x * (NT / 64) + (tid_ >> 6), nw = gridDim.x * (NT / 64);
  const float4 rb = *(const float4*)(p.router_bias + l * N_EXPERTS + 4 * lane);
  for (long r = gw; r < NR; r += nw) {
    const float4 lg = *(const float4*)(p.rl() + r * N_EXPERTS + 4 * lane);
    float sc[4] = {sigmoidf_(lg.x), sigmoidf_(lg.y), sigmoidf_(lg.z), sigmoidf_(lg.w)};
    float bz[4] = {sc[0] + rb.x, sc[1] + rb.y, sc[2] + rb.z, sc[3] + rb.w};
    float m1 = fmaxf(bz[0], bz[1]), m2 = fminf(bz[0], bz[1]);
#pragma unroll
    for (int c = 2; c < 4; ++c) { const float v = bz[c]; m2 = fmaxf(m2, fminf(m1, v)); m1 = fmaxf(m1, v); }
#pragma unroll
    for (int o = 1; o < 8; o <<= 1) { const float b1 = __shfl_xor(m1, o), b2 = __shfl_xor(m2, o); m2 = fmaxf(fminf(m1, b1), fmaxf(m2, b2)); m1 = fmaxf(m1, b1); }
    const float gs = m1 + m2; const int mg = lane >> 3; int rank = 0;
#pragma unroll
    for (int j = 0; j < 8; ++j) { const float gj = __shfl(gs, j * 8); rank += (gj > gs || (gj == gs && j < mg)) ? 1 : 0; }
    if (rank >= TOPK_GROUPS) { bz[0] = bz[1] = bz[2] = bz[3] = -1e30f; }
    int sel_e[TOP_K]; float sel_s[TOP_K]; float gsum = 0.f;
#pragma unroll
    for (int it = 0; it < TOP_K; ++it) {
      float bv = bz[0]; int bc = 0;
#pragma unroll
      for (int c = 1; c < 4; ++c) if (bz[c] > bv) { bv = bz[c]; bc = c; }
      int bi = 4 * lane + bc; float bs = sc[bc];
      const int myi = bi;
#pragma unroll
      for (int o = 1; o < 64; o <<= 1) {
        const float ov = __shfl_xor(bv, o); const int oi = __shfl_xor(bi, o); const float os = __shfl_xor(bs, o);
        if (ov > bv || (ov == bv && oi < bi)) { bv = ov; bi = oi; bs = os; }
      }
      sel_e[it] = bi; sel_s[it] = bs; gsum += bs;
      if (bi == myi) {
#pragma unroll
        for (int c = 0; c < 4; ++c) if (c == bc) bz[c] = -1e30f;
      }
    }
    const float inv = ROUTED_SCALE / gsum;
    int me = sel_e[0]; float ms = sel_s[0];
#pragma unroll
    for (int it = 1; it < TOP_K; ++it) if (lane == it) { me = sel_e[it]; ms = sel_s[it]; }
    if (lane < TOP_K) {
      const long a = r * TOP_K + lane;
      p.top_e()[a] = me; p.gate()[a] = ms * inv;
      const int pos = atomicAdd(&p.cnt()[l * N_EXPERTS + me], 1);
      p.elist()[(long)me * NR + pos] = (int)a;
    }
  }
}
#endif

#ifndef CPU_TEST
#define XB_TMO      128
#define XB_XCNT(j)  (256  + 64 * (j))
#define XB_XSUB(j)  (1280 + 64 * (j))
#define XB_XGEN(j)  (2304 + 64 * (j))
#define XB_TOP      3328
#define XB_TOPGEN   3392
#define XCD_BAR_WORDS 3456
#define XB_SPIN_CAP (1u << 18)
#define LAS __attribute__((address_space(3)))
__device__ __forceinline__ unsigned xb_ld(unsigned* p)              { return __hip_atomic_load(p, __ATOMIC_RELAXED, __HIP_MEMORY_SCOPE_AGENT); }
__device__ __forceinline__ unsigned xb_add(unsigned* p, unsigned v) { return __hip_atomic_fetch_add(p, v, __ATOMIC_RELAXED, __HIP_MEMORY_SCOPE_AGENT); }
__device__ __forceinline__ unsigned xb_xcc_id() { return (unsigned)__builtin_amdgcn_s_getreg((3 << 11) | 20) & 0xFu; }
#define XB_SPIN(cond, bar) do { unsigned _sp = 0; while (cond) { __builtin_amdgcn_s_sleep(1); \
    if ((++_sp & 255u) == 0u) { if (xb_ld(&(bar)[XB_TMO])) break; if (_sp > XB_SPIN_CAP) { atomicAdd(&(bar)[XB_TMO], 1u); break; } } } } while (0)
struct XcdBarrier { unsigned* bar; unsigned x; volatile LAS unsigned* st; };
__device__ __forceinline__ XcdBarrier xcd_barrier_post(unsigned* bar, volatile LAS unsigned* st) {
    XcdBarrier b; b.bar = bar; b.x = xb_xcc_id(); b.st = st;
    if (threadIdx.x == 0) (void)xb_add(&bar[XB_XCNT(b.x)], 1u);
    return b;
}
__device__ __forceinline__ void xcd_barrier_complete(unsigned* bar, unsigned x, unsigned& nloc, unsigned& nx) {
    const unsigned G = gridDim.x * gridDim.y * gridDim.z;
    unsigned sum, cnt, mine, sp = 0u;
    for (;;) {
        sum = 0u; cnt = 0u; mine = 0u;
#pragma unroll
        for (unsigned j = 0; j < 16; ++j) { const unsigned c = xb_ld(&bar[XB_XCNT(j)]); sum += c; cnt += (c > 0u) ? 1u : 0u; mine = (j == x) ? c : mine; }
        if (sum == G) break;
        __builtin_amdgcn_s_sleep(1);
        if ((++sp & 255u) == 0u) { if (xb_ld(&bar[XB_TMO])) break; if (sp > XB_SPIN_CAP) { atomicAdd(&bar[XB_TMO], 1u); break; } }
    }
    nloc = mine > 0u ? mine : 1u; nx = cnt > 0u ? cnt : 1u;
}
__device__ __forceinline__ void xcd_barrier(const XcdBarrier& b) {
    asm volatile("s_waitcnt vmcnt(0)" ::: "memory");
    __syncthreads();
    if (threadIdx.x == 0) {
        unsigned* bar = b.bar;
        unsigned bx = b.x; asm volatile("" : "+s"(bx));
        __builtin_amdgcn_s_waitcnt(0);
        unsigned nloc = b.st[0], nx = b.st[1];
        if (nloc == 0u) { xcd_barrier_complete(bar, bx, nloc, nx); b.st[0] = nloc; b.st[1] = nx; }
        const unsigned old = xb_add(&bar[XB_XSUB(bx)], 1u);
        const unsigned gen = old / nloc;
        if (old + 1u == (gen + 1u) * nloc) {
            __builtin_amdgcn_fence(__ATOMIC_RELEASE, "agent");
            asm volatile("s_waitcnt vmcnt(0)" ::: "memory");
            const unsigned og = xb_add(&bar[XB_TOP], 1u);
            const unsigned tg = og / nx;
            if (og + 1u == (tg + 1u) * nx) xb_add(&bar[XB_TOPGEN], 1u);
            else XB_SPIN(xb_ld(&bar[XB_TOPGEN]) == tg, bar);
            __builtin_amdgcn_fence(__ATOMIC_ACQUIRE, "agent");
            xb_add(&bar[XB_XGEN(bx)], 1u);
            asm volatile("s_waitcnt vmcnt(0)" ::: "memory");
        } else {
            XB_SPIN(xb_ld(&bar[XB_XGEN(bx)]) == gen, bar);
            __builtin_amdgcn_fence(__ATOMIC_ACQUIRE, "agent");
            asm volatile("s_waitcnt vmcnt(0)" ::: "memory");
        }
    }
    __syncthreads();
}
#define GRID_SYNC() xcd_barrier(xb)
#else
#define GRID_SYNC() do {} while (0)
#endif

#ifndef CPU_TEST
#define GPUSEL(a, b) a
#else
#define GPUSEL(a, b) b
#endif
#ifndef CPU_TEST
#define OPAQUE_S(v) asm volatile("" : "+s"(v))
#define OPAQUE_V(v) asm volatile("" : "+v"(v))
#else
#define OPAQUE_S(v) do {} while (0)
#define OPAQUE_V(v) do {} while (0)
#endif
#ifndef PROBE_MASK
#define PROBE_MASK 0
#endif
#define LPHASE(stmt) do { int l = lo; OPAQUE_S(l); if (SINGLE && ((PROBE_MASK >> (ph - NG - lo * NLP)) & 1)) { long gtid = gtid0; OPAQUE_V(gtid); stmt; GRID_SYNC(); } PHASE(stmt); } while (0)
#define PHASE(stmt) do { if (SINGLE || ph == only) { long gtid = gtid0; OPAQUE_V(gtid); stmt; } if (SINGLE) { GRID_SYNC(); } ++ph; } while (0)
#ifndef CPU_TEST
template <bool SINGLE> __device__ __forceinline__ void run_seq(const P& p, long gtid0, long gsize, int only, const XcdBarrier& xb, char* smem)
#else
template <bool SINGLE> static int run_seq(const P& p, long gtid0, long gsize, int only)
#endif
{
  int ph = 0;
  PHASE(ph_g0(p, gtid, gsize));
  PHASE(ph_g1(p, gtid, gsize));
  PHASE(ph_g2(p, gtid, gsize));
  PHASE(ph_g3(p, gtid, gsize));
  PHASE(ph_g4(p, gtid, gsize));
#pragma unroll 1
  for (int lo = 0; lo < DEPTH; ++lo) {
    LPHASE(ph_modu(p, l, 0, gtid, gsize));
    LPHASE(GPUSEL(ph_proj_mfma(p, l, smem), ph_proj(p, l, gtid, gsize)));
    LPHASE(ph_post_proj(p, l, gtid, gsize));
    LPHASE(ph_mix(p, l, gtid, gsize); GPUSEL((ph_attn_mfma(p, l, smem), ph_hyena_mfma(p, l, smem)), (void)0));
    LPHASE(ph_s5out(p, l, gtid, gsize));
    LPHASE(GPUSEL(ph_glu_mfma(p, l, smem), ph_glu(p, l, gtid, gsize)));
    LPHASE(ph_rms(p, l, gtid, gsize));
    LPHASE(GPUSEL(ph_outproj_mfma(p, l, smem), ph_outproj(p, l, gtid, gsize)));
    LPHASE(ph_ln(p, l, 0, gtid, gsize));
    LPHASE(ph_router(p, l, gtid, gsize));
    LPHASE(ph_select(p, l, gtid, gsize));
    LPHASE(ph_sortrows(p, l, gtid, gsize));
    LPHASE(GPUSEL(ph_expert_up_mfma(p, l, smem), ph_expert_up(p, l, gtid, gsize)));
    LPHASE(GPUSEL(ph_expert_down_mfma(p, l, smem), ph_expert_down(p, l, gtid, gsize)));
    LPHASE(ph_combine(p, l, gtid, gsize));
    LPHASE(ph_ln(p, l, 1, gtid, gsize));
  }
#ifdef CPU_TEST
  return ph;
#endif
}


#ifndef CPU_TEST
#define NG_GPU 5
#define NLP_GPU 14
#ifndef PROBE_MASK_G
#define PROBE_MASK_G 0
#endif
#define GPHASE(stmt) do { if (SINGLE || ph == only) { long gtid = (long)blockIdx.x * NT + otid(); stmt; } if (SINGLE) { GRID_SYNC(); } ++ph; } while (0)
#define GLPHASE(stmt) do { int l = lo; OPAQUE_S(l); if (SINGLE && ((PROBE_MASK_G >> (ph - NG_GPU - lo * NLP_GPU)) & 1)) { long gtid = (long)blockIdx.x * NT + otid(); stmt; GRID_SYNC(); } GPHASE(stmt); } while (0)
template <bool SINGLE> __device__ __forceinline__ void run_seq_gpu(const P& p, long gtid0, long gsize, int only, const XcdBarrier& xb, char* smem) {
  int ph = 0;
#ifdef PROBE_INIT
  if (SINGLE) { long gtid = (long)blockIdx.x * NT + otid(); ph_g0(p, gtid, gsize); GRID_SYNC(); ph_g1(p, gtid, gsize); ph_modsum_gpu(p, gtid, gsize); ph_s5tables_gpu(p, gtid, gsize); GRID_SYNC(); ph_g2(p, gtid, gsize); ph_modu0_gpu(p, gtid, gsize); GRID_SYNC(); ph_g3(p, gtid, gsize); GRID_SYNC(); ph_g4(p, gtid, gsize); GRID_SYNC(); }
#endif
  GPHASE(ph_g0(p, gtid, gsize));
  GPHASE(ph_g1(p, gtid, gsize); ph_modsum_gpu(p, gtid, gsize); ph_s5tables_gpu(p, gtid, gsize));
  GPHASE(ph_g2(p, gtid, gsize); ph_modu0_gpu(p, gtid, gsize));
  GPHASE(ph_g3(p, gtid, gsize));
  GPHASE(ph_g4(p, gtid, gsize));
#pragma unroll 1
  for (int lo = 0; lo < DEPTH; ++lo) {
    GLPHASE(ph_proj_mfma(p, l, smem));
    GLPHASE(ph_post_proj(p, l, gtid, gsize); ph_hyena_pre_gpu(p, l, gtid, gsize));
    GLPHASE(ph_s5_sgemm(p, l, smem));
    GLPHASE(ph_mix(p, l, gtid, gsize); ph_attn_mfma(p, l, smem); ph_hyena_mfma(p, l, smem));
    GLPHASE(ph_s5_ygemm(p, l, smem));
    GLPHASE(ph_glu_mfma(p, l, smem));
    GLPHASE(ph_rms_gpu(p, l));
    GLPHASE(ph_outproj_mfma(p, l, smem));
    GLPHASE(ph_ln1_gpu(p, l));
    GLPHASE(ph_router_mfma(p, l, smem));
    GLPHASE(ph_select_gpu(p, l));
#ifdef UPVAR
    if (SINGLE) { int l = lo; OPAQUE_S(l); ph_expert_up_mfma<UPVAR>(p, l, smem); GRID_SYNC(); }
#endif
    GLPHASE(ph_expert_up_mfma(p, l, smem));
    GLPHASE(ph_expert_down_mfma(p, l, smem));
    GLPHASE(ph_ln2_gpu(p, l));
  }
}
#endif

static void carve(P& p, void* ws) { p.ws = (char*)ws; }
static void set_inputs(P& p, void* const* d_in) {
  const float** f = (const float**)&p.x;
  for (int i = 0; i < 40; ++i) f[i] = (const float*)d_in[i];
}

#ifndef CPU_TEST
#ifndef MK_SINGLE
#define MK_SINGLE 1
#endif
extern __shared__ __attribute__((aligned(16))) char dyn_smem[];
__global__ void __launch_bounds__(NT, 2) mk_single(P p) {
  uint4* xbw = (uint4*)(dyn_smem + SM_XB);
  if (threadIdx.x == 0) *xbw = make_uint4(0u, 0u, 0u, 0u);
  __syncthreads();
  XcdBarrier xb = xcd_barrier_post(p.bar(), (volatile LAS unsigned*)xbw);
  run_seq_gpu<true>(p, (long)blockIdx.x * blockDim.x + threadIdx.x, (long)gridDim.x * blockDim.x, -1, xb, dyn_smem);
}
__global__ void __launch_bounds__(NT, 2) mk_phase(P p, int only) {
  XcdBarrier xb; xb.bar = p.bar(); xb.x = 0; xb.st = nullptr;
#ifdef DBG_ONLY
  only = DBG_ONLY;
#endif
  run_seq_gpu<false>(p, (long)blockIdx.x * blockDim.x + threadIdx.x, (long)gridDim.x * blockDim.x, only, xb, dyn_smem);
}
extern "C" void kernel_launch(void* const* d_in, const int* in_sizes, int n_in, void* d_out, int out_size, void* d_ws, size_t ws_size, hipStream_t stream) {
  P p; memset(&p, 0, sizeof(p));
  set_inputs(p, d_in); p.out = (float*)d_out; carve(p, d_ws);
  (void)hipMemsetAsync(p.bar(), 0, 4096 * sizeof(unsigned) + ((DEPTH * N_EXPERTS * sizeof(int) + 255) / 256) * 256, stream);
#if MK_SINGLE
  static int grid = 0;
  if (!grid) {
    int dev = 0, cus = 0, per_cu = 0; (void)hipGetDevice(&dev);
    (void)hipDeviceGetAttribute(&cus, hipDeviceAttributeMultiprocessorCount, dev);
    (void)hipFuncSetAttribute((const void*)mk_single, hipFuncAttributeMaxDynamicSharedMemorySize, SMEM_BYTES);
    (void)hipOccupancyMaxActiveBlocksPerMultiprocessor(&per_cu, mk_single, NT, SMEM_BYTES);
    grid = cus * (per_cu < 1 ? per_cu : 1);
  }
  mk_single<<<grid, NT, SMEM_BYTES, stream>>>(p);
#else
  for (int ph = 0; ph < NG_GPU + DEPTH * NLP_GPU; ++ph) mk_phase<<<256, NT, SMEM_BYTES, stream>>>(p, ph);
#endif
}
#endif
```

```cpp
#ifndef CPU_TEST
#include <hip/hip_runtime.h>
#include <cstring>
#define DEV __device__ __forceinline__
#define DEVM __device__ __forceinline__
#define HDM __host__ __device__ __forceinline__
#else
#include <cmath>
#include <cstdio>
#include <cstdlib>
#include <cstring>
#define DEV static inline
#define DEVM inline
#define HDM inline
struct float2 { float x, y; };
static inline float2 make_float2(float a, float b) { float2 r; r.x = a; r.y = b; return r; }
static inline int atomicAdd(int* p, int v) { int o = *p; *p += v; return o; }
#endif

#ifdef SMALL_CFG
#define D_MODEL 64
#define BATCH 2
#define SEQ 256
#define GRID_W 16
#define CTX_LEN 32
#define HEAD_DIM 16
#define N_Q_HEADS 4
#define N_KV_HEADS 2
#define HYENA_W 16
#define S5_W 32
#define WINDOW 32
#define FILTER_HIDDEN 16
#define S5_STATE 8
#define N_EXPERTS 32
#define TOP_K 4
#define EXPERT_FF 16
#define SHARED_FF 16
#define S5_T 32
#else
#define D_MODEL 1024
#define BATCH 2
#define SEQ 8192
#define GRID_W 64
#define CTX_LEN 256
#define HEAD_DIM 64
#define N_Q_HEADS 8
#define N_KV_HEADS 2
#define HYENA_W 256
#define S5_W 256
#define WINDOW 128
#define FILTER_HIDDEN 64
#define S5_STATE 64
#define N_EXPERTS 256
#define TOP_K 8
#define EXPERT_FF 256
#define SHARED_FF 256
#define S5_T 64
#endif
#define DEPTH 2
#define FILTER_EMB 33
#define N_EXPERT_GROUPS 8
#define TOPK_GROUPS 4
#define S5_GROUP 16
#define Q_GROUP (N_Q_HEADS / N_KV_HEADS)
#define ATTN_W (N_Q_HEADS * HEAD_DIM)
#define KV_W (N_KV_HEADS * HEAD_DIM)
#define MIX_W (ATTN_W + HYENA_W + S5_W)
#define Q_OFF 0
#define K_OFF ATTN_W
#define V_OFF (K_OFF + KV_W)
#define HY_OFF (V_OFF + KV_W)
#define S5_OFF (HY_OFF + 3 * HYENA_W)
#define IN_W (S5_OFF + S5_W)
#define AXIS_DIM (HEAD_DIM / 2)
#define ROPE_HALF (AXIS_DIM / 2)
#define S5_GROUPS (S5_W / S5_GROUP)
#define EPG (N_EXPERTS / N_EXPERT_GROUPS)
#define NL (BATCH * SEQ)
#define NC (BATCH * CTX_LEN)
#define NR (NL + NC)
#define NSEQ (CTX_LEN + SEQ)
#define NCH (NSEQ / S5_T)
#define LN_EPS 1e-5f
#define DN_ALPHA 1.4142135623730951f
#define ROUTED_SCALE 2.5f
#define PI_D 3.14159265358979323846

#define WS_LIST(X) \
  X(unsigned, bar, 4096) \
  X(int, cnt, DEPTH * N_EXPERTS) \
  X(float, mod, (size_t)DEPTH * (BATCH + 1) * 6 * D_MODEL) \
  X(float, xcur, (size_t)NR * D_MODEL) \
  X(float, ubuf, (size_t)NR * D_MODEL) \
  X(float, proj, (size_t)NR * IN_W) \
  X(float, hu, (size_t)NR * HYENA_W) \
  X(float, hx0, (size_t)NR * HYENA_W) \
  X(float, fh1, (size_t)DEPTH * SEQ * FILTER_HIDDEN) \
  X(float, fh2, (size_t)DEPTH * SEQ * FILTER_HIDDEN) \
  X(float, kraw, (size_t)DEPTH * SEQ * 2 * HYENA_W) \
  X(float, knorm, (size_t)DEPTH * HYENA_W) \
  X(float, fh1c, (size_t)CTX_LEN * FILTER_HIDDEN) \
  X(float, fh2c, (size_t)CTX_LEN * FILTER_HIDDEN) \
  X(float, krawc, (size_t)CTX_LEN * 2 * HYENA_W) \
  X(float, knormc, (size_t)HYENA_W) \
  X(float, mixb, (size_t)NR * MIX_W) \
  X(float, tmp, (size_t)NR * D_MODEL) \
  X(float2, lampow, (size_t)DEPTH * 2 * S5_GROUPS * (S5_T + 1) * S5_STATE) \
  X(float2, bbar, (size_t)DEPTH * 2 * S5_GROUPS * S5_STATE * S5_GROUP) \
  X(float, kc, (size_t)DEPTH * 2 * S5_GROUPS * S5_T * S5_GROUP * S5_GROUP) \
  X(float2, sc, (size_t)BATCH * 2 * S5_GROUPS * NCH * S5_STATE) \
  X(float2, hc, (size_t)BATCH * 2 * S5_GROUPS * NCH * S5_STATE) \
  X(float, ybuf, (size_t)NR * S5_W) \
  X(float, rl, (size_t)NR * N_EXPERTS) \
  X(int, top_e, (size_t)NR * TOP_K) \
  X(float, gate, (size_t)NR * TOP_K) \
  X(int, posb, (size_t)NR * TOP_K) \
  X(int, srow, (size_t)NR * TOP_K) \
  X(float, hbuf, (size_t)NR * TOP_K * EXPERT_FF) \
  X(float, hsb, (size_t)NR * SHARED_FF) \
  X(float, yk, (size_t)NR * TOP_K * D_MODEL) \
  X(float, ysh, (size_t)NR * D_MODEL) \
  X(unsigned short, ykb, (size_t)NR * TOP_K * D_MODEL) \
  X(unsigned short, qkvb, (size_t)NR * HY_OFF) \
  X(float2, ropet, (size_t)128 * ROPE_HALF) \
  X(unsigned short, wt_in, (size_t)DEPTH * IN_W * D_MODEL) \
  X(unsigned short, wt_out, (size_t)DEPTH * D_MODEL * MIX_W) \
  X(unsigned short, wt_glu, (size_t)DEPTH * S5_W * S5_W) \
  X(unsigned short, wt_shg, (size_t)DEPTH * SHARED_FF * D_MODEL) \
  X(unsigned short, wt_shu, (size_t)DEPTH * SHARED_FF * D_MODEL) \
  X(unsigned short, wt_shd, (size_t)DEPTH * D_MODEL * SHARED_FF) \
  X(unsigned short, wt_rh, (size_t)DEPTH * N_EXPERTS * D_MODEL) \
  X(unsigned short, wt_rl, (size_t)DEPTH * N_EXPERTS * D_MODEL) \
  X(unsigned short, ubf, (size_t)NR * D_MODEL) \
  X(unsigned short, ybf, (size_t)NR * S5_W) \
  X(unsigned short, mixbf, (size_t)NR * MIX_W) \
  X(unsigned short, hbf, (size_t)NR * TOP_K * EXPERT_FF) \
  X(unsigned short, hsbf, (size_t)NR * SHARED_FF) \
  X(unsigned short, ubl, (size_t)NR * D_MODEL) \
  X(int, elist, (size_t)N_EXPERTS * NR) \
  X(unsigned short, s5u, (size_t)NR * S5_W) \
  X(float, bmt, (size_t)DEPTH * 2 * S5_GROUPS * 16 * S5_T * 2 * S5_STATE) \
  X(float, cmt, (size_t)DEPTH * 2 * S5_GROUPS * 16 * S5_T * 2 * S5_STATE) \
  X(unsigned short, hcbf, (size_t)BATCH * 2 * S5_GROUPS * NCH * 2 * S5_STATE) \
  X(float, zT, (size_t)BATCH * 3 * HYENA_W * (SEQ + CTX_LEN)) \
  X(float, modp, (size_t)DEPTH * 16 * (BATCH + 1) * 6 * D_MODEL) \
  X(float, wrlo, (size_t)DEPTH * D_MODEL * N_EXPERTS) \

struct WsOff {
#define X(T, name, n) size_t name;
  WS_LIST(X)
#undef X
  size_t total;
};
constexpr WsOff ws_offsets() {
  WsOff o{}; size_t off = 0;
#define X(T, name, n) o.name = off; off += (((size_t)(n)) * sizeof(T) + 255) / 256 * 256;
  WS_LIST(X)
#undef X
  o.total = off; return o;
}
constexpr WsOff WSO = ws_offsets();
struct P {
  const float *x, *c, *ctx, *c_ctx, *w_ada, *b_ada, *w_in, *w_out, *sink, *mix_g, *hy_short_w, *hy_short_b, *hy_w1,
      *hy_b1, *hy_freq, *hy_w2, *hy_b2, *hy_w3, *hy_d, *s5_a_re, *s5_a_im, *s5_log_dt, *s5_b_re, *s5_b_im, *s5_c_re,
      *s5_c_im, *s5_d, *s5_w_glu, *ln1_g, *ln1_b, *ln2_g, *ln2_b, *w_router, *router_bias, *w_exp_gate, *w_exp_up,
      *w_exp_down, *w_sh_gate, *w_sh_up, *w_sh_down;
  float* out;
  char* ws;
#define X(T, name, n) HDM T* name() const { return (T*)(ws + WSO.name); }
  WS_LIST(X)
#undef X
};

#define FOR_ITEMS(i, N) for (long i = gtid; i < (long)(N); i += gsize)
#ifndef CPU_TEST
#define FOR_ITEMS4(i, N) _Pragma("unroll 4") for (long i = gtid; i < (long)(N); i += gsize)
#else
#define FOR_ITEMS4(i, N) FOR_ITEMS(i, N)
#endif

DEV unsigned short f2bf16(float f) { unsigned u; memcpy(&u, &f, 4); return (unsigned short)((u + 0x7fffu + ((u >> 16) & 1u)) >> 16); }
DEV float siluf(float x) { return x / (1.0f + expf(-x)); }
DEV float sigmoidf_(float x) { return 1.0f / (1.0f + expf(-x)); }
DEV float gelu_tanhf(float x) { return 0.5f * x * (1.0f + tanhf(0.7978845608028654f * (x + 0.044715f * x * x * x))); }
DEV int modrow(long r) { return r < NL ? (int)(r / SEQ) : BATCH; }

DEV void ph_g0(const P& p, long gtid, long gsize) {
#ifndef CPU_TEST
  FOR_ITEMS4(i4, (long)NR * D_MODEL / 4) { const long i = i4 * 4; *(float4*)(p.xcur() + i) = i < (long)NL * D_MODEL ? *(const float4*)(p.x + i) : *(const float4*)(p.ctx + (i - (long)NL * D_MODEL)); }
#else
  FOR_ITEMS(i, (long)NR * D_MODEL) p.xcur()[i] = i < (long)NL * D_MODEL ? p.x[i] : p.ctx[i - (long)NL * D_MODEL];
#endif
#ifdef CPU_TEST
  FOR_ITEMS(i, DEPTH * (BATCH + 1) * 6 * D_MODEL) {
    int n = (int)(i % (6 * D_MODEL)); int j = (int)((i / (6 * D_MODEL)) % (BATCH + 1)); int l = (int)(i / (6 * D_MODEL * (BATCH + 1)));
    const float* cv = j < BATCH ? p.c + j * D_MODEL : p.c_ctx;
    const float* w = p.w_ada + (long)l * D_MODEL * 6 * D_MODEL;
    float acc = p.b_ada[l * 6 * D_MODEL + n];
    for (int k = 0; k < D_MODEL; ++k) acc += siluf(cv[k]) * w[(long)k * 6 * D_MODEL + n];
    p.mod()[i] = acc;
  }
#else
  FOR_ITEMS(i, (long)DEPTH * 16 * 6 * D_MODEL) {
    const int n = (int)(i % (6 * D_MODEL)); const int slab = (int)((i / (6 * D_MODEL)) % 16); const int l = (int)(i / (6 * D_MODEL * 16));
    const float* w = p.w_ada + ((long)l * D_MODEL + slab * 64) * 6 * D_MODEL + n;
    float a0 = 0.f, a1 = 0.f, a2 = 0.f;
#pragma unroll 8
    for (int k = 0; k < 64; ++k) {
      const float wv = w[(long)k * 6 * D_MODEL]; const int kk = slab * 64 + k;
      a0 += siluf(p.c[kk]) * wv; a1 += siluf(p.c[D_MODEL + kk]) * wv; a2 += siluf(p.c_ctx[kk]) * wv;
    }
    float* dst = p.modp() + ((long)(l * 16 + slab) * (BATCH + 1)) * 6 * D_MODEL + n;
    dst[0] = a0; dst[6 * D_MODEL] = a1; dst[2 * 6 * D_MODEL] = a2;
  }
#endif
  FOR_ITEMS(i, DEPTH * 2 * S5_GROUPS * S5_STATE) {
    int pp = (int)(i % S5_STATE); int g = (int)((i / S5_STATE) % S5_GROUPS); int ld = (int)(i / (S5_STATE * S5_GROUPS));
    float are = fminf(p.s5_a_re[i], -1e-4f), aim = p.s5_a_im[i];
    float dt = expf(p.s5_log_dt[ld * S5_GROUPS + g]);
#ifdef CPU_TEST
    for (int d = 0; d <= S5_T; ++d) {
      float mag = expf(are * dt * d); float ang = aim * dt * d;
      p.lampow()[((long)(ld * S5_GROUPS + g) * (S5_T + 1) + d) * S5_STATE + pp] = make_float2(mag * cosf(ang), mag * sinf(ang));
    }
#endif
    float mag = expf(are * dt), ang = aim * dt;
    float lr = mag * cosf(ang) - 1.0f, li = mag * sinf(ang);
    float den = are * are + aim * aim;
    float fr = (lr * are + li * aim) / den, fi = (li * are - lr * aim) / den;
    for (int j = 0; j < S5_GROUP; ++j) {
      float br = p.s5_b_re[i * S5_GROUP + j], bi = p.s5_b_im[i * S5_GROUP + j];
      p.bbar()[i * S5_GROUP + j] = make_float2(fr * br - fi * bi, fr * bi + fi * br);
    }
  }
}
#ifndef CPU_TEST
DEV void rope_table_gpu(const P& p, long gtid, long gsize) {
  FOR_ITEMS(i, (long)128 * ROPE_HALF) {
    const int ii = (int)(i % ROPE_HALF), pos = (int)(i / ROPE_HALF);
    const float ang = (float)pos * powf(10000.0f, -(float)(2 * ii) / (float)AXIS_DIM);
    p.ropet()[i] = make_float2(cosf(ang), sinf(ang));
  }
}
DEV void s5_lampow_gpu(const P& p, long gtid, long gsize) {
  FOR_ITEMS4(i, (long)DEPTH * 2 * S5_GROUPS * (S5_T + 1) * S5_STATE) {
    const int pp = (int)(i % S5_STATE); const int d = (int)((i / S5_STATE) % (S5_T + 1)); const long ldg = i / ((long)S5_STATE * (S5_T + 1));
    const long src = ldg * S5_STATE + pp;
    const float are = fminf(p.s5_a_re[src], -1e-4f), aim = p.s5_a_im[src]; const float dt = expf(p.s5_log_dt[ldg]);
    const float mag = expf(are * dt * d); const float ang = aim * dt * d;
    p.lampow()[i] = make_float2(mag * cosf(ang), mag * sinf(ang));
  }
}
#endif
DEV void hy_f1(const P& p, int l, int Lf, float* h1, long gtid, long gsize) {
  FOR_ITEMS(i, (long)Lf * FILTER_HIDDEN) {
    int j = (int)(i % FILTER_HIDDEN); int t = (int)(i / FILTER_HIDDEN);
    const float* w1 = p.hy_w1 + l * FILTER_EMB * FILTER_HIDDEN;
    float tt = (float)((double)t / (double)(Lf - 1));
    float w = (float)(2.0 * PI_D * (double)t / (double)Lf);
    float acc = p.hy_b1[l * FILTER_HIDDEN + j] + tt * w1[j];
    const int bands = (FILTER_EMB - 1) / 2;
    for (int m = 0; m < bands; ++m) {
      float f = (float)(1e-4 + (double)m * ((double)(bands - 1) - 1e-4) / (double)(bands - 1));
      float a = f * w;
      acc += cosf(a) * w1[(1 + m) * FILTER_HIDDEN + j] - sinf(a) * w1[(1 + bands + m) * FILTER_HIDDEN + j];
    }
    h1[i] = sinf(p.hy_freq[l * FILTER_HIDDEN + j] * acc);
  }
}
DEV void hy_f2(const P& p, int l, int Lf, const float* h1, float* h2, long gtid, long gsize) {
  FOR_ITEMS(i, (long)Lf * FILTER_HIDDEN) {
    int j = (int)(i % FILTER_HIDDEN); int t = (int)(i / FILTER_HIDDEN);
    const float* w2 = p.hy_w2 + l * FILTER_HIDDEN * FILTER_HIDDEN;
    float acc = p.hy_b2[l * FILTER_HIDDEN + j];
    for (int k = 0; k < FILTER_HIDDEN; ++k) acc += h1[t * FILTER_HIDDEN + k] * w2[k * FILTER_HIDDEN + j];
#ifndef CPU_TEST
    h2[(long)j * Lf + t] = sinf(p.hy_freq[l * FILTER_HIDDEN + j] * acc);
#else
    h2[i] = sinf(p.hy_freq[l * FILTER_HIDDEN + j] * acc);
#endif
  }
}
DEV void hy_f3(const P& p, int l, int Lf, const float* h2, float* kraw, long gtid, long gsize) {
#ifndef CPU_TEST
  const float* w3 = p.hy_w3 + l * FILTER_HIDDEN * 2 * HYENA_W;
  FOR_ITEMS(i, (long)Lf * (2 * HYENA_W / 8)) {
    const int t = (int)(i % Lf); const int c8 = (int)(i / Lf) * 8;
    float acc[8];
#pragma unroll
    for (int j = 0; j < 8; ++j) acc[j] = 0.f;
#pragma unroll 4
    for (int k = 0; k < FILTER_HIDDEN; ++k) {
      const float hv = h2[(long)k * Lf + t];
      const float4 wa = *(const float4*)(w3 + k * 2 * HYENA_W + c8), wb = *(const float4*)(w3 + k * 2 * HYENA_W + c8 + 4);
      acc[0] += hv * wa.x; acc[1] += hv * wa.y; acc[2] += hv * wa.z; acc[3] += hv * wa.w; acc[4] += hv * wb.x; acc[5] += hv * wb.y; acc[6] += hv * wb.z; acc[7] += hv * wb.w;
    }
    const double d0 = log(1e-2) / 0.3, d1 = log(1e-2) / 1.5;
    const float tt = (float)((double)t / (double)(Lf - 1));
#pragma unroll
    for (int j = 0; j < 8; ++j) {
      const int ch = (c8 + j) % HYENA_W;
      const float delta = fabsf((float)(d0 + (d1 - d0) * (double)ch / (double)(HYENA_W - 1)));
      kraw[(long)(c8 + j) * Lf + t] = acc[j] * expf(-tt * delta);
    }
  }
#else
  FOR_ITEMS(i, (long)Lf * 2 * HYENA_W) {
    int t = (int)(i % Lf); int cc = (int)(i / Lf); int ch = cc % HYENA_W;
    const float* w3 = p.hy_w3 + l * FILTER_HIDDEN * 2 * HYENA_W;
    float acc = 0.f;
    for (int k = 0; k < FILTER_HIDDEN; ++k) acc += h2[t * FILTER_HIDDEN + k] * w3[k * 2 * HYENA_W + cc];
    double d0 = log(1e-2) / 0.3, d1 = log(1e-2) / 1.5;
    float delta = fabsf((float)(d0 + (d1 - d0) * (double)ch / (double)(HYENA_W - 1)));
    float tt = (float)((double)t / (double)(Lf - 1));
    kraw[(long)cc * Lf + t] = acc * expf(-tt * delta);
  }
#endif
}
DEV void hy_f4(int Lf, const float* kraw, float* knorm, long gtid, long gsize) {
#ifndef CPU_TEST
  const int lane = (int)(gtid & 63); const long gw = gtid >> 6, nw = gsize >> 6;
  for (long i = gw; i < HYENA_W; i += nw) {
    float s = 0.f;
    for (int t = lane; t < Lf; t += 64) { s += fabsf(kraw[i * Lf + t]); if (t > 0) s += fabsf(kraw[(HYENA_W + i) * Lf + t]); }
    for (int o = 32; o > 0; o >>= 1) s += __shfl_xor(s, o);
    if (lane == 0) knorm[i] = 1.0f / s;
  }
#else
  FOR_ITEMS(i, HYENA_W) {
    float s = 0.f;
    for (int t = 0; t < Lf; ++t) {
      s += fabsf(kraw[(long)i * Lf + t]);
      if (t > 0) s += fabsf(kraw[(long)(HYENA_W + i) * Lf + t]);
    }
    knorm[i] = 1.0f / s;
  }
#endif
}
DEV void ph_g1(const P& p, long gtid, long gsize) {
  for (int l = 0; l < DEPTH; ++l) hy_f1(p, l, SEQ, p.fh1() + (long)l * SEQ * FILTER_HIDDEN, gtid, gsize);
  hy_f1(p, 0, CTX_LEN, p.fh1c(), gtid, gsize);
  FOR_ITEMS(i, (long)DEPTH * 2 * S5_GROUPS * S5_T * S5_GROUP * S5_GROUP) {
    int j = (int)(i % S5_GROUP); int ii = (int)((i / S5_GROUP) % S5_GROUP); int d = (int)((i / (S5_GROUP * S5_GROUP)) % S5_T);
    long ldg = i / (S5_GROUP * S5_GROUP * S5_T);
    float acc = 0.f;
    for (int pp = 0; pp < S5_STATE; ++pp) {
      float cr = p.s5_c_re[(ldg * S5_GROUP + ii) * S5_STATE + pp], ci = p.s5_c_im[(ldg * S5_GROUP + ii) * S5_STATE + pp];
      float2 lp = p.lampow()[(ldg * (S5_T + 1) + d) * S5_STATE + pp];
      float2 bb = p.bbar()[(ldg * S5_STATE + pp) * S5_GROUP + j];
      float tr = lp.x * bb.x - lp.y * bb.y, ti = lp.x * bb.y + lp.y * bb.x;
      acc += cr * tr - ci * ti;
    }
    p.kc()[i] = acc;
  }
}
DEV void ph_g2(const P& p, long gtid, long gsize) {
  for (int l = 0; l < DEPTH; ++l) hy_f2(p, l, SEQ, p.fh1() + (long)l * SEQ * FILTER_HIDDEN, p.fh2() + (long)l * SEQ * FILTER_HIDDEN, gtid, gsize);
  hy_f2(p, 0, CTX_LEN, p.fh1c(), p.fh2c(), gtid, gsize);
}
DEV void ph_g3(const P& p, long gtid, long gsize) {
  for (int l = 0; l < DEPTH; ++l) hy_f3(p, l, SEQ, p.fh2() + (long)l * SEQ * FILTER_HIDDEN, p.kraw() + (long)l * SEQ * 2 * HYENA_W, gtid, gsize);
  hy_f3(p, 0, CTX_LEN, p.fh2c(), p.krawc(), gtid, gsize);
}
DEV void ph_g4(const P& p, long gtid, long gsize) {
  for (int l = 0; l < DEPTH; ++l) hy_f4(SEQ, p.kraw() + (long)l * SEQ * 2 * HYENA_W, p.knorm() + l * HYENA_W, gtid, gsize);
  hy_f4(CTX_LEN, p.krawc(), p.knormc(), gtid, gsize);
}
#define NG 5

DEV void ph_modu(const P& p, int l, int which, long gtid, long gsize) {
  FOR_ITEMS(i, (long)NR * D_MODEL) {
    int k = (int)(i % D_MODEL); long r = i / D_MODEL;
    const float* m = p.mod() + ((long)l * (BATCH + 1) + modrow(r)) * 6 * D_MODEL + which * 3 * D_MODEL;
    float uv = p.xcur()[i] * (1.0f + m[D_MODEL + k]) + m[k];
    p.ubuf()[i] = uv; p.ubf()[i] = f2bf16(uv);
  }
}
template <class Epi>
DEV void gemm_naive(const float* A, int lda, const float* B, int ldb, int M, int N, int K, Epi epi, long gtid, long gsize) {
  FOR_ITEMS(i, (long)(M / 4) * N) {
    int n = (int)(i % N); long r0 = (i / N) * 4;
    const float* a0 = A + r0 * lda;
    float c0 = 0.f, c1 = 0.f, c2 = 0.f, c3 = 0.f;
    for (int k = 0; k < K; ++k) {
      float b = B[(long)k * ldb + n];
      c0 += a0[k] * b; c1 += a0[lda + k] * b; c2 += a0[2 * lda + k] * b; c3 += a0[3 * lda + k] * b;
    }
    epi(r0, n, c0); epi(r0 + 1, n, c1); epi(r0 + 2, n, c2); epi(r0 + 3, n, c3);
  }
}
struct EpiStore { float* C; int ldc; DEVM void operator()(long r, int n, float v) const { C[r * ldc + n] = v; } };
DEV void ph_proj(const P& p, int l, long gtid, long gsize) {
  EpiStore e{p.proj(), IN_W};
  gemm_naive(p.ubuf(), D_MODEL, p.w_in + (long)l * D_MODEL * IN_W, IN_W, NR, IN_W, D_MODEL, e, gtid, gsize);
}
DEV long s5_row(int b, int dir, int n) {
  if (n < CTX_LEN) return (long)NL + b * CTX_LEN + (dir ? CTX_LEN - 1 - n : n);
  int t = n - CTX_LEN; return (long)b * SEQ + (dir ? SEQ - 1 - t : t);
}
DEV void ph_post_proj(const P& p, int l, long gtid, long gsize) {
  FOR_ITEMS(i, (long)NL * (N_Q_HEADS + N_KV_HEADS) * 2 * ROPE_HALF) {
    int ii = (int)(i % ROPE_HALF); int a = (int)((i / ROPE_HALF) % 2); int hs = (int)((i / (2 * ROPE_HALF)) % (N_Q_HEADS + N_KV_HEADS));
    long r = i / (2 * ROPE_HALF * (N_Q_HEADS + N_KV_HEADS));
    int t = (int)(r % SEQ); int pos = a == 0 ? t / GRID_W : t % GRID_W;
    float inv = powf(10000.0f, -(float)(2 * ii) / (float)AXIS_DIM);
    float ang = (float)pos * inv; float cs = cosf(ang), sn = sinf(ang);
    float* q = p.proj() + r * IN_W + hs * HEAD_DIM + a * AXIS_DIM + ii;
    float x1 = q[0], x2 = q[ROPE_HALF];
    q[0] = x1 * cs - x2 * sn; q[ROPE_HALF] = x1 * sn + x2 * cs;
  }
#ifdef CPU_TEST
  FOR_ITEMS(i, (long)NR * HYENA_W) {
    int ch = (int)(i % HYENA_W); long r = i / HYENA_W;
    int Ls = r < NL ? SEQ : CTX_LEN; long base = r < NL ? (r / SEQ) * SEQ : NL + ((r - NL) / CTX_LEN) * CTX_LEN; int t = (int)(r - base);
    const float* sw = p.hy_short_w + l * 3 * 3 * HYENA_W; const float* sb = p.hy_short_b + l * 3 * HYENA_W;
    float z[3];
#pragma unroll
    for (int part = 0; part < 3; ++part) {
      int cc = part * HYENA_W + ch; float acc = sb[cc];
#pragma unroll
      for (int j = 0; j < 3; ++j) { int tt = t + j - 1; if (tt >= 0 && tt < Ls) acc += p.proj()[(base + tt) * IN_W + HY_OFF + cc] * sw[j * 3 * HYENA_W + cc]; }
      z[part] = acc;
    }
    long o = r < NL ? ((r / SEQ) * HYENA_W + ch) * SEQ + t : i;
    p.hu()[o] = z[0] * z[1]; p.hx0()[o] = z[2];
  }
#endif
#ifndef CPU_TEST
  FOR_ITEMS(i, (long)NR * S5_W) { long r = i / S5_W; int cc = (int)(i % S5_W); p.s5u()[i] = f2bf16(p.proj()[r * IN_W + S5_OFF + cc]); }
#endif
#ifdef CPU_TEST
  FOR_ITEMS(i, (long)BATCH * 2 * S5_GROUPS * NCH * S5_STATE) {
    int pp = (int)(i % S5_STATE); int c = (int)((i / S5_STATE) % NCH); int g = (int)((i / (S5_STATE * NCH)) % S5_GROUPS);
    int dir = (int)((i / (S5_STATE * NCH * S5_GROUPS)) % 2); int b = (int)(i / (S5_STATE * NCH * S5_GROUPS * 2));
    long ldg = ((long)l * 2 + dir) * S5_GROUPS + g;
    float sr = 0.f, si = 0.f;
    for (int s = 0; s < S5_T; ++s) {
      const float* u = p.proj() + s5_row(b, dir, c * S5_T + s) * IN_W + S5_OFF + g * S5_GROUP;
      float br = 0.f, bi = 0.f;
#pragma unroll
      for (int j = 0; j < S5_GROUP; ++j) { float2 bb = p.bbar()[(ldg * S5_STATE + pp) * S5_GROUP + j]; br += bb.x * u[j]; bi += bb.y * u[j]; }
      float2 lp = p.lampow()[(ldg * (S5_T + 1) + (S5_T - 1 - s)) * S5_STATE + pp];
      sr += lp.x * br - lp.y * bi; si += lp.x * bi + lp.y * br;
    }
    p.sc()[i] = make_float2(sr, si);
  }
#endif
}
DEV void attn_item(const P& p, int l, long r, int h, float* outp) {
  const float scale = 1.0f / sqrtf((float)HEAD_DIM);
  float q[HEAD_DIM], acc[HEAD_DIM];
  const float* qp = p.proj() + r * IN_W + Q_OFF + h * HEAD_DIM;
#pragma unroll
  for (int d = 0; d < HEAD_DIM; ++d) { q[d] = qp[d] * scale; acc[d] = 0.f; }
  int kvh = h / Q_GROUP; int b = r < NL ? (int)(r / SEQ) : (int)((r - NL) / CTX_LEN);
  float m = -1e30f, lsum = 0.f;
  int nwin = 0, t = 0;
  if (r < NL) { t = (int)(r % SEQ); nwin = 2 * WINDOW + 1; }
  for (int j = 0; j < nwin + CTX_LEN; ++j) {
    long kr;
    if (j < nwin) { int tk = t - WINDOW + j; if (tk < 0 || tk >= SEQ) continue; kr = (long)b * SEQ + tk; }
    else kr = (long)NL + b * CTX_LEN + (j - nwin);
    const float* kp = p.proj() + kr * IN_W + K_OFF + kvh * HEAD_DIM; const float* vp = p.proj() + kr * IN_W + V_OFF + kvh * HEAD_DIM;
    float s = 0.f;
#pragma unroll
    for (int d = 0; d < HEAD_DIM; ++d) s += q[d] * kp[d];
    float mn = fmaxf(m, s); float corr = expf(m - mn); float pe = expf(s - mn);
    lsum = lsum * corr + pe;
#pragma unroll
    for (int d = 0; d < HEAD_DIM; ++d) acc[d] = acc[d] * corr + pe * vp[d];
    m = mn;
  }
  float sk = p.sink[l * N_Q_HEADS + h]; float mf = fmaxf(m, sk); float corr = expf(m - mf);
  float den = lsum * corr + expf(sk - mf); float sc2 = corr / den;
#pragma unroll
  for (int d = 0; d < HEAD_DIM; ++d) outp[d] = acc[d] * sc2;
}
DEV void ph_mix(const P& p, int l, long gtid, long gsize) {
#ifdef CPU_TEST
  long nrows_att = l == 0 ? NR : NL;
  FOR_ITEMS(i, nrows_att * N_Q_HEADS) { int h = (int)(i % N_Q_HEADS); long r = i / N_Q_HEADS; attn_item(p, l, r, h, p.mixb() + r * MIX_W + h * HEAD_DIM); }
#endif
#ifdef CPU_TEST
  FOR_ITEMS(i, (long)NL * HYENA_W) {
    int ch = (int)(i % HYENA_W); long r = i / HYENA_W; int t = (int)(r % SEQ); int b = (int)(r / SEQ);
    const float* kf = p.kraw() + ((long)l * 2 * HYENA_W + ch) * SEQ; const float* kb = p.kraw() + ((long)l * 2 * HYENA_W + HYENA_W + ch) * SEQ;
    const float* uu = p.hu() + ((long)b * HYENA_W + ch) * SEQ;
    float acc = 0.f;
    for (int s = 0; s <= t; ++s) acc += kf[t - s] * uu[s];
    for (int s = t + 1; s < SEQ; ++s) acc += kb[s - t] * uu[s];
    p.mixb()[r * MIX_W + ATTN_W + ch] = (acc * p.knorm()[l * HYENA_W + ch] + uu[t] * p.hy_d[l * HYENA_W + ch]) * p.hx0()[((long)b * HYENA_W + ch) * SEQ + t];
  }
#endif
  if (l == 0) {
#ifndef CPU_TEST
    FOR_ITEMS(i, (long)NC * HYENA_W) {
      const int t = (int)(i % CTX_LEN); const int ch = (int)((i / CTX_LEN) % HYENA_W); const int b = (int)(i / ((long)CTX_LEN * HYENA_W));
      const long base = (long)NL + (long)b * CTX_LEN; const long r = base + t;
      const float* kf = p.krawc() + (long)ch * CTX_LEN; const float* kb = p.krawc() + (long)(HYENA_W + ch) * CTX_LEN;
      float acc = 0.f;
#pragma unroll 8
      for (int sidx = 0; sidx < CTX_LEN; ++sidx) {
        const int d = t - sidx; const float kv = d >= 0 ? kf[d] : kb[-d];
        acc += kv * p.hu()[(base + sidx) * HYENA_W + ch];
      }
      const float u = p.hu()[r * HYENA_W + ch];
      p.mixb()[r * MIX_W + ATTN_W + ch] = (acc * p.knormc()[ch] + u * p.hy_d[l * HYENA_W + ch]) * p.hx0()[r * HYENA_W + ch];
    }
#else
    FOR_ITEMS(i, (long)NC * HYENA_W) {
      int ch = (int)(i % HYENA_W); long r = NL + i / HYENA_W; int t = (int)((r - NL) % CTX_LEN); long base = r - t;
      float acc = 0.f;
      for (int s = 0; s <= t; ++s) acc += p.krawc()[(long)ch * CTX_LEN + (t - s)] * p.hu()[(base + s) * HYENA_W + ch];
      for (int s = t + 1; s < CTX_LEN; ++s) acc += p.krawc()[(long)(HYENA_W + ch) * CTX_LEN + (s - t)] * p.hu()[(base + s) * HYENA_W + ch];
      float u = p.hu()[r * HYENA_W + ch];
      p.mixb()[r * MIX_W + ATTN_W + ch] = (acc * p.knormc()[ch] + u * p.hy_d[l * HYENA_W + ch]) * p.hx0()[r * HYENA_W + ch];
    }
#endif
  }
#ifdef CPU_TEST
  FOR_ITEMS(i, (long)BATCH * 2 * S5_GROUPS * S5_STATE) {
    int pp = (int)(i % S5_STATE); int g = (int)((i / S5_STATE) % S5_GROUPS); int dir = (int)((i / (S5_STATE * S5_GROUPS)) % 2); int b = (int)(i / (S5_STATE * S5_GROUPS * 2));
    long ldg = ((long)l * 2 + dir) * S5_GROUPS + g;
    float2 lt = p.lampow()[(ldg * (S5_T + 1) + S5_T) * S5_STATE + pp];
    float hr = 0.f, hi = 0.f;
    long base = (((long)b * 2 + dir) * S5_GROUPS + g) * NCH;
#ifndef CPU_TEST
    static_assert(NCH % 12 == 0, "carry batching");
    for (int c0 = 0; c0 < NCH; c0 += 12) {
      float2 sv[12];
#pragma unroll
      for (int k = 0; k < 12; ++k) sv[k] = p.sc()[(base + c0 + k) * S5_STATE + pp];
#pragma unroll
      for (int k = 0; k < 12; ++k) {
        p.hcbf()[(base + c0 + k) * 2 * S5_STATE + pp] = f2bf16(hr); p.hcbf()[(base + c0 + k) * 2 * S5_STATE + S5_STATE + pp] = f2bf16(hi);
        const float nr = lt.x * hr - lt.y * hi + sv[k].x, ni = lt.x * hi + lt.y * hr + sv[k].y;
        hr = nr; hi = ni;
      }
    }
#else
    for (int c = 0; c < NCH; ++c) {
      p.hc()[(base + c) * S5_STATE + pp] = make_float2(hr, hi);
      float2 s = p.sc()[(base + c) * S5_STATE + pp];
      float nr = lt.x * hr - lt.y * hi + s.x, ni = lt.x * hi + lt.y * hr + s.y;
      hr = nr; hi = ni;
    }
#endif
  }
#endif
}
DEV void ph_s5out(const P& p, int l, long gtid, long gsize) {
  FOR_ITEMS(i, (long)NR * S5_W) {
    int chn = (int)(i % S5_W); long r = i / S5_W; int g = chn / S5_GROUP, ii = chn % S5_GROUP;
    int b, tl; bool isctx = r >= NL;
    if (isctx) { b = (int)((r - NL) / CTX_LEN); tl = (int)((r - NL) % CTX_LEN); } else { b = (int)(r / SEQ); tl = (int)(r % SEQ); }
    float y = p.s5_d[l * S5_W + chn] * p.proj()[r * IN_W + S5_OFF + chn];
    for (int dir = 0; dir < 2; ++dir) {
      int n = isctx ? (dir ? CTX_LEN - 1 - tl : tl) : CTX_LEN + (dir ? SEQ - 1 - tl : tl);
      int c = n / S5_T, tau = n % S5_T;
      long ldg = ((long)l * 2 + dir) * S5_GROUPS + g;
      long hb = ((((long)b * 2 + dir) * S5_GROUPS + g) * NCH + c) * S5_STATE;
      for (int pp = 0; pp < S5_STATE; ++pp) {
        float cr = p.s5_c_re[(ldg * S5_GROUP + ii) * S5_STATE + pp], ci = p.s5_c_im[(ldg * S5_GROUP + ii) * S5_STATE + pp];
        float2 lp = p.lampow()[(ldg * (S5_T + 1) + tau + 1) * S5_STATE + pp]; float2 h = p.hc()[hb + pp];
        float tr = lp.x * h.x - lp.y * h.y, ti = lp.x * h.y + lp.y * h.x;
        y += cr * tr - ci * ti;
      }
      for (int s = 0; s <= tau; ++s) {
        const float* u = p.proj() + s5_row(b, dir, c * S5_T + s) * IN_W + S5_OFF + g * S5_GROUP;
        const float* kk = p.kc() + ((ldg * S5_T + (tau - s)) * S5_GROUP + ii) * S5_GROUP;
#pragma unroll
        for (int j = 0; j < S5_GROUP; ++j) y += kk[j] * u[j];
      }
    }
    float gy = gelu_tanhf(y); p.ybuf()[i] = gy; p.ybf()[i] = f2bf16(gy);
  }
}
struct EpiGlu { const float* g; float* mixb; DEVM void operator()(long r, int n, float v) const { mixb[r * MIX_W + ATTN_W + HYENA_W + n] = g[r * S5_W + n] * sigmoidf_(v); } };
DEV void ph_glu(const P& p, int l, long gtid, long gsize) {
  EpiGlu e{p.ybuf(), p.mixb()};
  gemm_naive(p.ybuf(), S5_W, p.s5_w_glu + (long)l * S5_W * S5_W, S5_W, NR, S5_W, S5_W, e, gtid, gsize);
}
DEV void ph_rms(const P& p, int l, long gtid, long gsize) {
  FOR_ITEMS(i, (long)NR * 3) {
    int grp = (int)(i % 3); long r = i / 3;
    int off = grp == 0 ? 0 : (grp == 1 ? ATTN_W : ATTN_W + HYENA_W); int w = grp == 0 ? ATTN_W : (grp == 1 ? HYENA_W : S5_W);
    float* v = p.mixb() + r * MIX_W + off; float ss = 0.f;
    for (int k = 0; k < w; ++k) ss += v[k] * v[k];
    float rs = 1.0f / sqrtf(ss / (float)w + LN_EPS);
    for (int k = 0; k < w; ++k) { float nv = v[k] * rs * p.mix_g[l * MIX_W + off + k]; v[k] = nv; p.mixbf()[r * MIX_W + off + k] = f2bf16(nv); }
  }
}
struct EpiRes { const float* xcur; const float* mod; int l; int goff; float* tmp;
  DEVM void operator()(long r, int n, float v) const { const float* m = mod + ((long)l * (BATCH + 1) + modrow(r)) * 6 * D_MODEL + goff; tmp[r * D_MODEL + n] = DN_ALPHA * xcur[r * D_MODEL + n] + m[n] * v; } };
DEV void ph_outproj(const P& p, int l, long gtid, long gsize) {
  EpiRes e{p.xcur(), p.mod(), l, 2 * D_MODEL, p.tmp()};
  gemm_naive(p.mixb(), MIX_W, p.w_out + (long)l * MIX_W * D_MODEL, D_MODEL, NR, D_MODEL, MIX_W, e, gtid, gsize);
}
DEV void ph_ln(const P& p, int l, int which, long gtid, long gsize) {
  const float* gw = (which == 0 ? p.ln1_g : p.ln2_g) + l * D_MODEL; const float* bw = (which == 0 ? p.ln1_b : p.ln2_b) + l * D_MODEL;
  FOR_ITEMS(r, (long)NR) {
    const float* v = p.tmp() + r * D_MODEL; float mu = 0.f;
#pragma unroll 4
    for (int k = 0; k < D_MODEL; ++k) mu += v[k];
    mu /= (float)D_MODEL; float var = 0.f;
#pragma unroll 4
    for (int k = 0; k < D_MODEL; ++k) { float d = v[k] - mu; var += d * d; }
    float rs = 1.0f / sqrtf(var / (float)D_MODEL + LN_EPS);
    const float* m = p.mod() + ((long)l * (BATCH + 1) + modrow(r)) * 6 * D_MODEL + 3 * D_MODEL;
#pragma unroll 2
    for (int k = 0; k < D_MODEL; ++k) {
      float y = (v[k] - mu) * rs * gw[k] + bw[k];
      p.xcur()[r * D_MODEL + k] = y;
      if (which == 0) { float uv = y * (1.0f + m[D_MODEL + k]) + m[k]; p.ubuf()[r * D_MODEL + k] = uv; p.ubf()[r * D_MODEL + k] = f2bf16(uv); }
      if (which == 1 && l == DEPTH - 1 && r < NL) p.out[r * D_MODEL + k] = y;
    }
  }
}
DEV void ph_router(const P& p, int l, long gtid, long gsize) {
  EpiStore e{p.rl(), N_EXPERTS};
  gemm_naive(p.ubuf(), D_MODEL, p.w_router + (long)l * D_MODEL * N_EXPERTS, N_EXPERTS, NR, N_EXPERTS, D_MODEL, e, gtid, gsize);
}
DEV bool better(float v, int i, float bv, int bi) { return v > bv || (v == bv && i < bi); }
DEV void ph_select(const P& p, int l, long gtid, long gsize) {
  FOR_ITEMS(r, (long)NR) {
    const float* lg = p.rl() + r * N_EXPERTS; const float* rb = p.router_bias + l * N_EXPERTS;
    float gs[N_EXPERT_GROUPS];
#pragma unroll
    for (int g = 0; g < N_EXPERT_GROUPS; ++g) {
      float m1 = -1e30f, m2 = -1e30f;
      for (int e = 0; e < EPG; ++e) { float v = sigmoidf_(lg[g * EPG + e]) + rb[g * EPG + e]; if (v > m1) { m2 = m1; m1 = v; } else if (v > m2) m2 = v; }
      gs[g] = m1 + m2;
    }
    unsigned keep = 0;
#pragma unroll
    for (int it = 0; it < TOPK_GROUPS; ++it) {
      float bv = -1e30f; int bi = -1;
#pragma unroll
      for (int g = 0; g < N_EXPERT_GROUPS; ++g) if (!((keep >> g) & 1u) && (bi < 0 || gs[g] > bv)) { bv = gs[g]; bi = g; }
      keep |= 1u << bi;
    }
    float lastv = 1e30f; int lasti = -1; float gsum = 0.f;
    for (int it = 0; it < TOP_K; ++it) {
      float bv = -1e30f; int bi = -1;
      for (int e = 0; e < N_EXPERTS; ++e) {
        if (!((keep >> (e / EPG)) & 1u)) continue;
        float v = sigmoidf_(lg[e]) + rb[e];
        if (!better(lastv, lasti, v, e)) continue;
        if (bi < 0 || better(v, e, bv, bi)) { bv = v; bi = e; }
      }
      lastv = bv; lasti = bi;
      float sc = sigmoidf_(lg[bi]); gsum += sc;
      p.top_e()[r * TOP_K + it] = bi; p.gate()[r * TOP_K + it] = sc;
      p.posb()[r * TOP_K + it] = atomicAdd(&p.cnt()[l * N_EXPERTS + bi], 1);
    }
    float inv = ROUTED_SCALE / gsum;
    for (int it = 0; it < TOP_K; ++it) p.gate()[r * TOP_K + it] *= inv;
  }
}
DEV void ph_sortrows(const P& p, int l, long gtid, long gsize) {
  FOR_ITEMS(i, (long)NR * TOP_K) {
    int e = p.top_e()[i]; int off = 0;
    for (int j = 0; j < e; ++j) off += p.cnt()[l * N_EXPERTS + j];
    p.srow()[off + p.posb()[i]] = (int)i;
  }
}
DEV void ph_expert_up(const P& p, int l, long gtid, long gsize) {
  FOR_ITEMS(i, (long)NR * TOP_K * EXPERT_FF) {
    int cidx = (int)(i % EXPERT_FF); int a = p.srow()[i / EXPERT_FF]; int e = p.top_e()[a]; long r = a / TOP_K;
    const float* xg = p.ubuf() + r * D_MODEL;
    const float* wg = p.w_exp_gate + ((long)l * N_EXPERTS + e) * D_MODEL * EXPERT_FF; const float* wu = p.w_exp_up + ((long)l * N_EXPERTS + e) * D_MODEL * EXPERT_FF;
    float g = 0.f, u = 0.f;
    for (int k = 0; k < D_MODEL; ++k) { float xv = xg[k]; g += xv * wg[(long)k * EXPERT_FF + cidx]; u += xv * wu[(long)k * EXPERT_FF + cidx]; }
    p.hbuf()[(long)a * EXPERT_FF + cidx] = siluf(g) * u;
  }
  FOR_ITEMS(i, (long)NR * SHARED_FF) {
    int cidx = (int)(i % SHARED_FF); long r = i / SHARED_FF;
    const float* xg = p.ubuf() + r * D_MODEL;
    const float* wg = p.w_sh_gate + (long)l * D_MODEL * SHARED_FF; const float* wu = p.w_sh_up + (long)l * D_MODEL * SHARED_FF;
    float g = 0.f, u = 0.f;
    for (int k = 0; k < D_MODEL; ++k) { float xv = xg[k]; g += xv * wg[(long)k * SHARED_FF + cidx]; u += xv * wu[(long)k * SHARED_FF + cidx]; }
    p.hsb()[i] = siluf(g) * u;
  }
}
DEV void ph_expert_down(const P& p, int l, long gtid, long gsize) {
  FOR_ITEMS(i, (long)NR * TOP_K * D_MODEL) {
    int d = (int)(i % D_MODEL); long a = i / D_MODEL;
    int e = p.top_e()[a]; const float* wd = p.w_exp_down + ((long)l * N_EXPERTS + e) * EXPERT_FF * D_MODEL;
    const float* h = p.hbuf() + a * EXPERT_FF; float acc = 0.f;
    for (int cidx = 0; cidx < EXPERT_FF; ++cidx) acc += h[cidx] * wd[(long)cidx * D_MODEL + d];
    p.yk()[i] = acc * p.gate()[a];
  }
  FOR_ITEMS(i, (long)NR * D_MODEL) {
    int d = (int)(i % D_MODEL); long r = i / D_MODEL;
    const float* wsd = p.w_sh_down + (long)l * SHARED_FF * D_MODEL; const float* hs = p.hsb() + r * SHARED_FF;
    float acc = 0.f;
    for (int cidx = 0; cidx < SHARED_FF; ++cidx) acc += hs[cidx] * wsd[(long)cidx * D_MODEL + d];
    p.ysh()[i] = acc;
  }
}
DEV void ph_combine(const P& p, int l, long gtid, long gsize) {
#pragma unroll 1
  FOR_ITEMS(i, (long)NR * D_MODEL) {
    int d = (int)(i % D_MODEL); long r = i / D_MODEL;
    float f = p.ysh()[i];
#pragma unroll
    for (int k = 0; k < TOP_K; ++k) f += p.yk()[(r * TOP_K + k) * D_MODEL + d];
    const float* m = p.mod() + ((long)l * (BATCH + 1) + modrow(r)) * 6 * D_MODEL + 5 * D_MODEL;
    p.tmp()[i] = DN_ALPHA * p.xcur()[i] + m[d] * f;
  }
}
#define NLP 16


#ifndef CPU_TEST
typedef __attribute__((ext_vector_type(8))) short bf16x8;
typedef __attribute__((ext_vector_type(4))) float f32x4;
typedef __attribute__((ext_vector_type(4))) unsigned u32x4;
typedef __attribute__((ext_vector_type(2))) unsigned u32x2;
static_assert(N_EXPERTS == 256 && D_MODEL % 128 == 0 && NR % 128 == 0, "shape assumptions");
#define SM_XB 0
#define NT 512
#define SM_A 256
#define SM_B (256 + 16384)
#define SM_MISC (256 + 98304)
#define SMEM_BYTES (256 + 98304 + 4096)

DEV int otid() { int t = threadIdx.x; asm volatile("" : "+v"(t)); return t; }
typedef __bf16 bf16x2_t __attribute__((ext_vector_type(2)));
typedef float f32x2_t __attribute__((ext_vector_type(2)));
DEV unsigned pack2(float a, float b) { f32x2_t v = {a, b}; return __builtin_bit_cast(unsigned, __builtin_convertvector(v, bf16x2_t)); }
DEV unsigned f2bf(float f) { return pack2(f, 0.f) & 0xffffu; }
DEV int tile_off(int row, int chunk) { return row * 128 + ((chunk ^ ((row >> 1) & 7)) << 4); }

DEV float bflo(float x) { return x - __uint_as_float(f2bf(x) << 16); }
DEV void wt_convert(const float* W, unsigned short* WT, int K, int N, bool lo, long gtid, long gsize) {
  FOR_ITEMS4(i, (long)N * (K / 8)) {
    const int n = (int)(i % N); const int k8 = (int)(i / N) * 8;
    float v[8];
#pragma unroll
    for (int j = 0; j < 8; ++j) { const float x = W[(long)(k8 + j) * N + n]; v[j] = lo ? bflo(x) : x; }
    u32x4 o; o[0] = pack2(v[0], v[1]); o[1] = pack2(v[2], v[3]); o[2] = pack2(v[4], v[5]); o[3] = pack2(v[6], v[7]);
    *(u32x4*)(WT + (long)n * K + k8) = o;
  }
}
DEV void wt_convert_all(const P& p, long gtid, long gsize) {
  for (int l = 0; l < DEPTH; ++l) {
    wt_convert(p.w_in + (long)l * D_MODEL * IN_W, p.wt_in() + (long)l * IN_W * D_MODEL, D_MODEL, IN_W, false, gtid, gsize);
    wt_convert(p.w_out + (long)l * MIX_W * D_MODEL, p.wt_out() + (long)l * D_MODEL * MIX_W, MIX_W, D_MODEL, false, gtid, gsize);
    wt_convert(p.s5_w_glu + (long)l * S5_W * S5_W, p.wt_glu() + (long)l * S5_W * S5_W, S5_W, S5_W, false, gtid, gsize);
    wt_convert(p.w_sh_gate + (long)l * D_MODEL * SHARED_FF, p.wt_shg() + (long)l * SHARED_FF * D_MODEL, D_MODEL, SHARED_FF, false, gtid, gsize);
    wt_convert(p.w_sh_up + (long)l * D_MODEL * SHARED_FF, p.wt_shu() + (long)l * SHARED_FF * D_MODEL, D_MODEL, SHARED_FF, false, gtid, gsize);
    wt_convert(p.w_sh_down + (long)l * SHARED_FF * D_MODEL, p.wt_shd() + (long)l * D_MODEL * SHARED_FF, SHARED_FF, D_MODEL, false, gtid, gsize);
    wt_convert(p.w_router + (long)l * D_MODEL * N_EXPERTS, p.wt_rh() + (long)l * N_EXPERTS * D_MODEL, D_MODEL, N_EXPERTS, false, gtid, gsize);
    wt_convert(p.w_router + (long)l * D_MODEL * N_EXPERTS, p.wt_rl() + (long)l * N_EXPERTS * D_MODEL, D_MODEL, N_EXPERTS, true, gtid, gsize);
  }
}
struct ALRows { const char* base; unsigned off[2]; DEVM const unsigned short* a(int i, int kt) const { return (const unsigned short*)(base + (off[i] + (unsigned)kt * 128u)); } };
struct BLStd { static constexpr bool TR = false; const char* base; unsigned voff; int ldb4; bool valid;
  DEVM void load(float4 (&rb)[8], int kt) const {
#pragma unroll
    for (int i = 0; i < 8; ++i) rb[i] = valid ? *(const float4*)(base + (unsigned)((unsigned)(kt * 64 + i) * (unsigned)ldb4 + voff)) : make_float4(0.f, 0.f, 0.f, 0.f); } };
DEV unsigned bl_voff(int ldb4, int tid) { return (unsigned)((tid & 7) * 8) * (unsigned)ldb4 + (unsigned)((tid >> 3) * 16); }
DEV BLStd mk_bl(const float* B  , int ldb, int tid) {
  BLStd b; b.base = (const char*)B; b.ldb4 = ldb * 4; b.voff = bl_voff(ldb * 4, tid); b.valid = true; return b; }
#define SM_TILE 49152
template <int V = 0, class AL, class BL>
DEV void gemm_t(const AL& al, const BL& bl, int nk, f32x4 (&acc)[4][4], char* smem) {
  const int tid = otid(), lane = tid & 63, wid = tid >> 6, wr = wid >> 2, wc = wid & 3;
  const int l15 = lane & 15, q = lane >> 4, x = l15 >> 1;
  const char* ard0 = smem + SM_A + (wr * 64 + l15) * 128 + ((q ^ x) << 4);
  const char* ard1 = smem + SM_A + (wr * 64 + l15) * 128 + (((4 + q) ^ x) << 4);
  const char* brd0 = smem + SM_B + (wc * 64 + l15) * 128 + ((q ^ x) << 4);
  const char* brd1 = smem + SM_B + (wc * 64 + l15) * 128 + (((4 + q) ^ x) << 4);
  const int kq = tid & 7, nq = tid >> 3;
  char* awr = smem + SM_A + nq * 128 + ((kq ^ ((nq >> 1) & 7)) << 4);
  char* bwr0 = smem + SM_B + (nq * 4) * 128 + ((kq ^ ((2 * nq) & 7)) << 4);
  char* bwr1 = smem + SM_B + (nq * 4 + 2) * 128 + ((kq ^ ((2 * nq + 1) & 7)) << 4);
  if (nk <= 0) return;
  u32x4 ra[2]; float4 rb0[8];
#define GEMM_LOADA(KT) do { _Pragma("unroll") for (int i = 0; i < 2; ++i) ra[i] = *(const u32x4*)(al.a(i, (KT))); } while (0)
#define GEMM_WRITE(rb, PO) do { \
    *(u32x4*)(awr + (PO)) = ra[0]; *(u32x4*)(awr + (PO) + 8192) = ra[1]; \
    if (BL::TR) { u32x4 v; \
      v[0] = pack2(rb[0].x, rb[0].y); v[1] = pack2(rb[0].z, rb[0].w); v[2] = pack2(rb[1].x, rb[1].y); v[3] = pack2(rb[1].z, rb[1].w); *(u32x4*)(bwr0 + (PO)) = v; \
      v[0] = pack2(rb[2].x, rb[2].y); v[1] = pack2(rb[2].z, rb[2].w); v[2] = pack2(rb[3].x, rb[3].y); v[3] = pack2(rb[3].z, rb[3].w); *(u32x4*)(bwr0 + (PO) + 128) = v; \
      v[0] = pack2(rb[4].x, rb[4].y); v[1] = pack2(rb[4].z, rb[4].w); v[2] = pack2(rb[5].x, rb[5].y); v[3] = pack2(rb[5].z, rb[5].w); *(u32x4*)(bwr1 + (PO)) = v; \
      v[0] = pack2(rb[6].x, rb[6].y); v[1] = pack2(rb[6].z, rb[6].w); v[2] = pack2(rb[7].x, rb[7].y); v[3] = pack2(rb[7].z, rb[7].w); *(u32x4*)(bwr1 + (PO) + 128) = v; \
    } else { u32x4 v; \
      v[0] = pack2(rb[0].x, rb[1].x); v[1] = pack2(rb[2].x, rb[3].x); v[2] = pack2(rb[4].x, rb[5].x); v[3] = pack2(rb[6].x, rb[7].x); *(u32x4*)(bwr0 + (PO)) = v; \
      v[0] = pack2(rb[0].y, rb[1].y); v[1] = pack2(rb[2].y, rb[3].y); v[2] = pack2(rb[4].y, rb[5].y); v[3] = pack2(rb[6].y, rb[7].y); *(u32x4*)(bwr0 + (PO) + 128) = v; \
      v[0] = pack2(rb[0].z, rb[1].z); v[1] = pack2(rb[2].z, rb[3].z); v[2] = pack2(rb[4].z, rb[5].z); v[3] = pack2(rb[6].z, rb[7].z); *(u32x4*)(bwr1 + (PO)) = v; \
      v[0] = pack2(rb[0].w, rb[1].w); v[1] = pack2(rb[2].w, rb[3].w); v[2] = pack2(rb[4].w, rb[5].w); v[3] = pack2(rb[6].w, rb[7].w); *(u32x4*)(bwr1 + (PO) + 128) = v; \
    } } while (0)
  GEMM_LOADA(0);
  bl.load(rb0, 0);
  __syncthreads();
  GEMM_WRITE(rb0, 0);
  if (V != 3) { if (nk > 1) { GEMM_LOADA(1); bl.load(rb0, 1); } }
  __syncthreads();
#define GEMM_STEP(rbn, KT) do { \
    const int po = ((KT) & 1) * SM_TILE; \
    bf16x8 fa0[4], fb0[4], fa1[4], fb1[4]; \
    _Pragma("unroll") for (int n = 0; n < 4; ++n) fb0[n] = *(const bf16x8*)(brd0 + po + n * 2048); \
    _Pragma("unroll") for (int m = 0; m < 4; ++m) fa0[m] = *(const bf16x8*)(ard0 + po + m * 2048); \
    _Pragma("unroll") for (int n = 0; n < 4; ++n) fb1[n] = *(const bf16x8*)(brd1 + po + n * 2048); \
    _Pragma("unroll") for (int m = 0; m < 4; ++m) fa1[m] = *(const bf16x8*)(ard1 + po + m * 2048); \
    __builtin_amdgcn_sched_barrier(0);     \
    if ((KT) + 1 < nk) { \
      GEMM_WRITE(rbn, SM_TILE - po); \
      if (V != 3) { if ((KT) + 2 < nk) { GEMM_LOADA((KT) + 2); bl.load(rbn, (KT) + 2); } } \
    } \
    __builtin_amdgcn_sched_barrier(0); \
    if (V != 2) { \
      _Pragma("unroll") for (int m = 0; m < 4; ++m) _Pragma("unroll") for (int n = 0; n < 4; ++n) acc[m][n] = __builtin_amdgcn_mfma_f32_16x16x32_bf16(fa0[m], fb0[n], acc[m][n], 0, 0, 0); \
      _Pragma("unroll") for (int m = 0; m < 4; ++m) _Pragma("unroll") for (int n = 0; n < 4; ++n) acc[m][n] = __builtin_amdgcn_mfma_f32_16x16x32_bf16(fa1[m], fb1[n], acc[m][n], 0, 0, 0); \
    } else { _Pragma("unroll") for (int m = 0; m < 4; ++m) asm volatile("" :: "v"(fa0[m]), "v"(fb0[m]), "v"(fa1[m]), "v"(fb1[m])); } \
    __syncthreads(); \
  } while (0)
  int kt = 0;
#pragma unroll 1
  for (; kt < nk; ++kt) { GEMM_STEP(rb0, kt); }
#undef GEMM_STEP
#undef GEMM_WRITE
#undef GEMM_LOADA
}

struct BLT { const char* base; unsigned voff; unsigned rowb;
  DEVM void load(u32x4 (&rb)[4], int kt) const {
#pragma unroll
    for (int c = 0; c < 4; ++c) rb[c] = *(const u32x4*)(base + (voff + (unsigned)c * rowb + (unsigned)kt * 128u)); } };
DEV BLT mk_blt(const unsigned short* BT  , int K, int tid) {
  BLT b; b.base = (const char*)BT; b.rowb = (unsigned)K * 2u; b.voff = (unsigned)((tid >> 3) * 4) * b.rowb + (unsigned)((tid & 7) * 16); return b; }
template <class AL, class BL>
DEV void gemm_tb(const AL& al, const BL& bl, int nk, f32x4 (&acc)[4][4], char* smem) {
  const int tid = otid(), lane = tid & 63, wid = tid >> 6, wr = wid >> 2, wc = wid & 3;
  const int l15 = lane & 15, q = lane >> 4, x = l15 >> 1;
  const char* ard0 = smem + SM_A + (wr * 64 + l15) * 128 + ((q ^ x) << 4);
  const char* ard1 = smem + SM_A + (wr * 64 + l15) * 128 + (((4 + q) ^ x) << 4);
  const char* brd0 = smem + SM_B + (wc * 64 + l15) * 128 + ((q ^ x) << 4);
  const char* brd1 = smem + SM_B + (wc * 64 + l15) * 128 + (((4 + q) ^ x) << 4);
  const int kq = tid & 7, nq = tid >> 3;
  char* awr = smem + SM_A + nq * 128 + ((kq ^ ((nq >> 1) & 7)) << 4);
  char* bwr0 = smem + SM_B + (nq * 4) * 128 + ((kq ^ ((2 * nq) & 7)) << 4);
  char* bwr1 = smem + SM_B + (nq * 4 + 2) * 128 + ((kq ^ ((2 * nq + 1) & 7)) << 4);
  if (nk <= 0) return;
  u32x4 ra[2]; u32x4 rb0[4], rb1[4];
#define TB_LOADA(KT) do { _Pragma("unroll") for (int i = 0; i < 2; ++i) ra[i] = *(const u32x4*)(al.a(i, (KT))); } while (0)
#define TB_WRITE(rb, PO) do { \
    *(u32x4*)(awr + (PO)) = ra[0]; *(u32x4*)(awr + (PO) + 8192) = ra[1]; \
    *(u32x4*)(bwr0 + (PO)) = rb[0]; *(u32x4*)(bwr0 + (PO) + 128) = rb[1]; *(u32x4*)(bwr1 + (PO)) = rb[2]; *(u32x4*)(bwr1 + (PO) + 128) = rb[3]; } while (0)
  TB_LOADA(0);
  bl.load(rb0, 0);
  if (nk > 1) bl.load(rb1, 1);
  __syncthreads();
  TB_WRITE(rb0, 0);
  if (nk > 1) TB_LOADA(1);
  if (nk > 2) bl.load(rb0, 2);
  __syncthreads();
#define TB_STEP(rbn, KT) do { \
    const int po = ((KT) & 1) * SM_TILE; \
    bf16x8 fa0[4], fb0[4], fa1[4], fb1[4]; \
    _Pragma("unroll") for (int n = 0; n < 4; ++n) fb0[n] = *(const bf16x8*)(brd0 + po + n * 2048); \
    _Pragma("unroll") for (int m = 0; m < 4; ++m) fa0[m] = *(const bf16x8*)(ard0 + po + m * 2048); \
    _Pragma("unroll") for (int n = 0; n < 4; ++n) fb1[n] = *(const bf16x8*)(brd1 + po + n * 2048); \
    _Pragma("unroll") for (int m = 0; m < 4; ++m) fa1[m] = *(const bf16x8*)(ard1 + po + m * 2048); \
    __builtin_amdgcn_sched_barrier(0); \
    if ((KT) + 1 < nk) { \
      TB_WRITE(rbn, SM_TILE - po); \
      if ((KT) + 2 < nk) TB_LOADA((KT) + 2); \
      if ((KT) + 3 < nk) bl.load(rbn, (KT) + 3); \
    } \
    __builtin_amdgcn_sched_barrier(0); \
    _Pragma("unroll") for (int m = 0; m < 4; ++m) _Pragma("unroll") for (int n = 0; n < 4; ++n) acc[m][n] = __builtin_amdgcn_mfma_f32_16x16x32_bf16(fa0[m], fb0[n], acc[m][n], 0, 0, 0); \
    _Pragma("unroll") for (int m = 0; m < 4; ++m) _Pragma("unroll") for (int n = 0; n < 4; ++n) acc[m][n] = __builtin_amdgcn_mfma_f32_16x16x32_bf16(fa1[m], fb1[n], acc[m][n], 0, 0, 0); \
    __syncthreads(); \
  } while (0)
  int kt = 0;
#pragma unroll 1
  for (; kt + 1 < nk; kt += 2) { TB_STEP(rb1, kt); TB_STEP(rb0, kt + 1); }
  if (kt < nk) TB_STEP(rb1, kt);
#undef TB_STEP
#undef TB_WRITE
#undef TB_LOADA
}
DEV void acc_zero(f32x4 (&acc)[4][4]) {
#pragma unroll
  for (int m = 0; m < 4; ++m)
#pragma unroll
    for (int n = 0; n < 4; ++n) acc[m][n] = (f32x4){0.f, 0.f, 0.f, 0.f};
}
#define EPI_BEGIN const int etid = otid();
#define EPI_ROW(m, j) (((etid >> 8) & 1) * 64 + (m) * 16 + ((etid & 63) >> 4) * 4 + (j))
#define EPI_COL(n) (((etid >> 6) & 3) * 64 + (n) * 16 + (etid & 15))

template <class Epi>
DEV void gemm_phase_dense(const unsigned short* A, int lda, const unsigned short* BT, int N, int K, Epi epi, char* smem) {
  const int tid = otid(); const int nct = N >> 8; const int nitems = (NR >> 7) * nct;
  for (int it = blockIdx.x; it < nitems; it += gridDim.x) {
    const int rt = it / nct, ct = it - rt * nct;
    ALRows al; al.base = (const char*)(A + (long)rt * 128 * lda);
#pragma unroll
    for (int i = 0; i < 2; ++i) al.off[i] = (unsigned)(((tid >> 3) + 64 * i) * lda + (tid & 7) * 8) * 2u;
    const BLT bl = mk_blt(BT + (long)ct * 256 * K, K, tid);
    f32x4 acc[4][4]; acc_zero(acc);
    gemm_tb(al, bl, K >> 6, acc, smem);
    EPI_BEGIN
#pragma unroll
    for (int m = 0; m < 4; ++m)
#pragma unroll
      for (int n = 0; n < 4; ++n)
#pragma unroll
        for (int j = 0; j < 4; ++j) epi((long)rt * 128 + EPI_ROW(m, j), ct * 256 + EPI_COL(n), acc[m][n][j]);
  }
}
DEV void ph_proj_mfma(const P& p, int l, char* smem) {
  const int tid = otid(); const int nct = IN_W >> 8; const int nitems = (NR >> 7) * nct;
  const float* B = p.w_in + (long)l * D_MODEL * IN_W;
  for (int it = blockIdx.x; it < nitems; it += gridDim.x) {
    const int rt = it / nct, ct = it - rt * nct;
    ALRows al; al.base = (const char*)(p.ubf() + (long)rt * 128 * D_MODEL);
#pragma unroll
    for (int i = 0; i < 2; ++i) al.off[i] = (unsigned)(((tid >> 3) + 64 * i) * D_MODEL + (tid & 7) * 8) * 2u;
    const BLT bl = mk_blt(p.wt_in() + ((long)l * IN_W + ct * 256) * D_MODEL, D_MODEL, tid);
    f32x4 acc[4][4]; acc_zero(acc);
    gemm_tb(al, bl, D_MODEL >> 6, acc, smem);
    EPI_BEGIN
    if (ct >= HY_OFF / 256 && ct < S5_OFF / 256) {
      const bool isctx = rt >= NL / 128;
      const int rloc = (isctx ? (rt - NL / 128) : rt) * 128;
      const int Ls = isctx ? CTX_LEN : SEQ; const int b = rloc / Ls; const int t0 = rloc - b * Ls;
      float* zb = p.zT() + (isctx ? (size_t)BATCH * 3 * HYENA_W * SEQ : (size_t)0) + (size_t)b * 3 * HYENA_W * Ls;
#pragma unroll
      for (int m = 0; m < 4; ++m)
#pragma unroll
        for (int n = 0; n < 4; ++n) {
          const int c = ct * 256 + EPI_COL(n) - HY_OFF; const int t = t0 + EPI_ROW(m, 0);
          *(float4*)(zb + (size_t)c * Ls + t) = make_float4(acc[m][n][0], acc[m][n][1], acc[m][n][2], acc[m][n][3]);
        }
    } else if (ct == S5_OFF / 256) {
#pragma unroll
      for (int m = 0; m < 4; ++m)
#pragma unroll
        for (int n = 0; n < 4; ++n)
#pragma unroll
          for (int j = 0; j < 4; ++j) p.s5u()[((long)rt * 128 + EPI_ROW(m, j)) * S5_W + EPI_COL(n)] = (unsigned short)f2bf(acc[m][n][j]);
    } else {
      const int head = ct * 4 + ((etid >> 6) & 3);
      const bool isq = head < N_Q_HEADS, dorope = head < N_Q_HEADS + N_KV_HEADS && rt < NL / 128;
      const float qs = isq ? 0.125f * 1.4426950408889634f : 1.0f;
      const int c16 = etid & 15;
#pragma unroll
      for (int m = 0; m < 4; ++m)
#pragma unroll
        for (int j = 0; j < 4; ++j) {
          const long row = (long)rt * 128 + EPI_ROW(m, j);
          float v0 = acc[m][0][j], v1 = acc[m][1][j], v2 = acc[m][2][j], v3 = acc[m][3][j];
          if (dorope) {
            const int t = (int)(row % SEQ);
            const float2 cr = p.ropet()[(t / GRID_W) * ROPE_HALF + c16], cc = p.ropet()[(t % GRID_W) * ROPE_HALF + c16];
            const float a0 = v0 * cr.x - v1 * cr.y, a1 = v0 * cr.y + v1 * cr.x, a2 = v2 * cc.x - v3 * cc.y, a3 = v2 * cc.y + v3 * cc.x;
            v0 = a0; v1 = a1; v2 = a2; v3 = a3;
          }
          unsigned short* dst = p.qkvb() + row * HY_OFF + head * HEAD_DIM + c16;
          dst[0] = (unsigned short)f2bf(v0 * qs); dst[16] = (unsigned short)f2bf(v1 * qs); dst[32] = (unsigned short)f2bf(v2 * qs); dst[48] = (unsigned short)f2bf(v3 * qs);
        }
    }
  }
}
DEV void ph_hyena_pre_gpu(const P& p, int l, long gtid, long gsize) {
  const float* sw = p.hy_short_w + l * 3 * 3 * HYENA_W; const float* sb = p.hy_short_b + l * 3 * HYENA_W;
  FOR_ITEMS(i, (long)BATCH * HYENA_W * (SEQ + CTX_LEN)) {
    const bool isctx = i >= (long)BATCH * HYENA_W * SEQ; const long ii = isctx ? i - (long)BATCH * HYENA_W * SEQ : i;
    const int Ls = isctx ? CTX_LEN : SEQ; const int t = (int)(ii % Ls); const int ch = (int)((ii / Ls) % HYENA_W); const int b = (int)(ii / ((long)Ls * HYENA_W));
    const float* zb = p.zT() + (isctx ? (size_t)BATCH * 3 * HYENA_W * SEQ : (size_t)0) + (size_t)b * 3 * HYENA_W * Ls;
    float z[3];
#pragma unroll
    for (int part = 0; part < 3; ++part) {
      const int cc = part * HYENA_W + ch; const float* zr = zb + (size_t)cc * Ls; float acc = sb[cc];
      if (t > 0) acc += zr[t - 1] * sw[cc];
      acc += zr[t] * sw[3 * HYENA_W + cc];
      if (t + 1 < Ls) acc += zr[t + 1] * sw[2 * 3 * HYENA_W + cc];
      z[part] = acc;
    }
    const long o = isctx ? ((long)NL + b * CTX_LEN + t) * HYENA_W + ch : ((long)b * HYENA_W + ch) * SEQ + t;
    p.hu()[o] = z[0] * z[1]; p.hx0()[o] = z[2];
  }
}
DEV void rms_rows(const P& p, int l, long r0, long r1, int w0, int nw);
DEV void ph_glu_mfma(const P& p, int l, char* smem) {
  const int tid = otid();
  for (int rt = blockIdx.x; rt < (NR >> 7); rt += gridDim.x) {
    ALRows al; al.base = (const char*)(p.ybf() + (long)rt * 128 * S5_W);
#pragma unroll
    for (int i = 0; i < 2; ++i) al.off[i] = (unsigned)(((tid >> 3) + 64 * i) * S5_W + (tid & 7) * 8) * 2u;
    const BLT bl = mk_blt(p.wt_glu() + (long)l * S5_W * S5_W, S5_W, tid);
    f32x4 acc[4][4]; acc_zero(acc);
    gemm_tb(al, bl, S5_W >> 6, acc, smem);
    EPI_BEGIN
#pragma unroll
    for (int m = 0; m < 4; ++m)
#pragma unroll
      for (int n = 0; n < 4; ++n)
#pragma unroll
        for (int j = 0; j < 4; ++j) {
          const long r = (long)rt * 128 + EPI_ROW(m, j); const int c = EPI_COL(n);
          p.mixb()[r * MIX_W + ATTN_W + HYENA_W + c] = __uint_as_float((unsigned)p.ybf()[r * S5_W + c] << 16) * sigmoidf_(acc[m][n][j]);
        }
    asm volatile("s_waitcnt vmcnt(0)" ::: "memory");
    __syncthreads();
    rms_rows(p, l, (long)rt * 128, (long)rt * 128 + 128, otid() >> 6, NT / 64);
  }
}
DEV void ph_outproj_mfma(const P& p, int l, char* smem) {
  EpiRes e{p.xcur(), p.mod(), l, 2 * D_MODEL, p.tmp()};
  gemm_phase_dense(p.mixbf(), MIX_W, p.wt_out() + (long)l * D_MODEL * MIX_W, D_MODEL, MIX_W, e, smem);
}
DEV void exp_prefix(const P& p, int l, int* toff, int* roff) {
  const int tid = otid(), lane = tid & 63, w = tid >> 6;
  __syncthreads();
  int c = 0, tl = 0, incl = 0;
  int* wsum = roff + N_EXPERTS + 8;
  if (tid < N_EXPERTS) {
    c = p.cnt()[l * N_EXPERTS + tid];
    tl = (c + 127) >> 7; incl = tl;
#pragma unroll
    for (int o = 1; o < 64; o <<= 1) { const int v = __shfl_up(incl, o); if (lane >= o) incl += v; }
    if (lane == 63) wsum[w] = incl;
    roff[tid] = c;
  }
  __syncthreads();
  if (tid < N_EXPERTS) {
    int base = 0;
#pragma unroll
    for (int k = 0; k < 4; ++k) if (k < w) base += wsum[k];
    toff[tid] = base + incl - tl;
    if (tid == N_EXPERTS - 1) toff[N_EXPERTS] = base + incl;
  }
  __syncthreads();
}
DEV int exp_find(const int* toff, int tile) {
  int lo = 0, hi = N_EXPERTS - 1;
  while (lo < hi) { int mid = (lo + hi + 1) >> 1; if (toff[mid] <= tile) lo = mid; else hi = mid - 1; }
  return lo;
}
template <int V = 0>
DEV void upgate_tile(const ALRows& al, const float* wg, const float* wu, int cq, f32x4 (&acc)[4][4], char* smem, int tid) {
  const int nq = tid >> 3; const int wsel = __builtin_amdgcn_readfirstlane(tid >> 6) & 1;
  BLStd bl; bl.base = (const char*)((wsel ? wu : wg) + cq * 128); bl.ldb4 = EXPERT_FF * 4; bl.valid = true;
  bl.voff = (unsigned)((tid & 7) * 8) * (unsigned)(EXPERT_FF * 4) + (unsigned)(((nq >> 4) * 32 + (nq & 7) * 4) * 4);
  acc_zero(acc);
  gemm_t<V>(al, bl, D_MODEL >> 6, acc, smem);
}
static_assert(EXPERT_FF == 256 && SHARED_FF == 256, "ff tiling");
template <int V = 0>
DEV void ph_expert_up_mfma(const P& p, int l, char* smem) {
  const int tid = otid(), lane = tid & 63, wc = (tid >> 6) & 3;
  int* toff = (int*)(smem + SM_MISC); int* roff = toff + N_EXPERTS + 1;
  exp_prefix(p, l, toff, roff);
  const int n_items = toff[N_EXPERTS] * 2;
  for (int it = blockIdx.x; it < n_items; it += gridDim.x) {
    const int tile = it >> 1, cq = it & 1;
    const int e = __builtin_amdgcn_readfirstlane(exp_find(toff, tile)); const int j0 = (tile - toff[e]) * 128;
    const int nrows = min(128, roff[e] - j0), rbase = e * NR + j0;
    const float* wg = p.w_exp_gate + ((long)l * N_EXPERTS + e) * D_MODEL * EXPERT_FF; const float* wu = p.w_exp_up + ((long)l * N_EXPERTS + e) * D_MODEL * EXPERT_FF;
    ALRows al; al.base = (const char*)p.ubf();
#pragma unroll
    for (int i = 0; i < 2; ++i) { const int rl = min((tid >> 3) + 64 * i, nrows - 1); al.off[i] = ((unsigned)(p.elist()[rbase + rl] / TOP_K) * D_MODEL + (tid & 7) * 8) * 2u; }
    f32x4 acc[4][4];
    upgate_tile<V>(al, wg, wu, cq, acc, smem, tid);
    EPI_BEGIN
    const int elane = etid & 63, ewc = (etid >> 6) & 3;
#pragma unroll
    for (int m = 0; m < 4; ++m)
#pragma unroll
      for (int j = 0; j < 4; ++j) {
        const int rl = EPI_ROW(m, j);
        if (rl < nrows) {
          { unsigned short* dst = p.hbf() + (long)p.elist()[rbase + rl] * EXPERT_FF + cq * 128 + ewc * 32 + (elane & 15);
            dst[0] = (unsigned short)f2bf(siluf(acc[m][0][j]) * acc[m][2][j]); dst[16] = (unsigned short)f2bf(siluf(acc[m][1][j]) * acc[m][3][j]); }
        }
      }
  }
}
DEV void ph_expert_down_mfma(const P& p, int l, char* smem) {
  const int tid = otid();
  int* toff = (int*)(smem + SM_MISC); int* roff = toff + N_EXPERTS + 1;
  exp_prefix(p, l, toff, roff);
  const int NCT = D_MODEL / 256;
  const int n_exp_items = toff[N_EXPERTS] * NCT;
  const int n_sh_items = (NR >> 7) * NCT;
  for (int it = blockIdx.x; it < n_exp_items + n_sh_items; it += gridDim.x) {
    const bool shared = it >= n_exp_items;
    int ct, nrows, rbase, e = 0; const float* wd;
    if (!shared) {
      const int tile = it / NCT; ct = it - tile * NCT;
      e = __builtin_amdgcn_readfirstlane(exp_find(toff, tile)); const int j0 = (tile - toff[e]) * 128;
      nrows = min(128, roff[e] - j0); rbase = e * NR + j0;
      wd = p.w_exp_down + ((long)l * N_EXPERTS + e) * EXPERT_FF * D_MODEL;
    } else {
      const int it2 = it - n_exp_items; const int rt = it2 / NCT; ct = it2 - rt * NCT;
      nrows = 128; rbase = rt * 128; wd = p.w_sh_down + (long)l * SHARED_FF * D_MODEL;
    }
    ALRows al; al.base = (const char*)(shared ? p.hsbf() : p.hbf());
#pragma unroll
    for (int i = 0; i < 2; ++i) {
      const int rl = min((tid >> 3) + 64 * i, nrows - 1);
      const unsigned a = shared ? (unsigned)(rbase + rl) : (unsigned)p.elist()[rbase + rl];
      al.off[i] = (a * EXPERT_FF + (tid & 7) * 8) * 2u;
    }
    const BLStd bl = mk_bl(wd + ct * 256, D_MODEL, tid);
    f32x4 acc[4][4]; acc_zero(acc);
    gemm_t(al, bl, EXPERT_FF >> 6, acc, smem);
    EPI_BEGIN
#pragma unroll
    for (int m = 0; m < 4; ++m)
#pragma unroll
      for (int j = 0; j < 4; ++j) {
        const int rl = EPI_ROW(m, j);
        if (rl < nrows) {
          if (shared) {
            float* dst = p.ysh() + (long)(rbase + rl) * D_MODEL;
#pragma unroll
            for (int n = 0; n < 4; ++n) dst[ct * 256 + EPI_COL(n)] = acc[m][n][j];
          } else {
            const int a = p.elist()[rbase + rl]; unsigned short* dst = p.ykb() + (long)a * D_MODEL; const float gsc = p.gate()[a];
#pragma unroll
            for (int n = 0; n < 4; ++n) dst[ct * 256 + EPI_COL(n)] = (unsigned short)f2bf(acc[m][n][j] * gsc);
          }
        }
      }
  }
}

typedef __attribute__((ext_vector_type(16))) float f32x16;
#define SM_HR 256
#define UB_STRIDE 8272
#define SM_HU (256 + 32768)
#define SMEM_HY (256 + 32768 + 2 * UB_STRIDE * 2)
static_assert(SEQ == 8192 && HYENA_W == 256, "hyena mfma shape");
DEV void ph_hyena_mfma(const P& p, int l, char* smem) {
  const int tid = otid(), lane = tid & 63, w = tid >> 6;
  unsigned short* R = (unsigned short*)(smem + SM_HR); unsigned short* U = (unsigned short*)(smem + SM_HU);
  for (int ch = blockIdx.x; ch < HYENA_W; ch += gridDim.x) {
    __syncthreads();
    const float* kf = p.kraw() + ((long)l * 2 * HYENA_W + ch) * SEQ; const float* kb = p.kraw() + ((long)l * 2 * HYENA_W + HYENA_W + ch) * SEQ;
    for (int y = tid; y < 2 * SEQ; y += NT) {
      const int lag = SEQ - y; float v = 0.f;
      if (lag >= 0 && lag < SEQ) v = kf[lag]; else if (lag < 0) v = kb[-lag];
      const int C = y >> 3; R[((C ^ ((C >> 4) & 1)) << 3) + (y & 7)] = (unsigned short)f2bf(v);
    }
    for (int e = tid; e < 2 * UB_STRIDE; e += NT) {
      const int b = e / UB_STRIDE, ee = e - b * UB_STRIDE, t = ee - 16; float v = 0.f;
      if (t >= 0 && t < SEQ) v = p.hu()[((long)b * HYENA_W + ch) * SEQ + t];
      U[e] = (unsigned short)f2bf(v);
    }
    __syncthreads();
    f32x16 acc[2];
#pragma unroll
    for (int mi = 0; mi < 2; ++mi)
#pragma unroll
      for (int k = 0; k < 16; ++k) acc[mi][k] = 0.f;
    const int r = lane & 31, h = lane >> 5, sig = lane & 15, bb = (lane >> 4) & 1;
    const unsigned* Ud = (const unsigned*)U + bb * (UB_STRIDE / 2);
    const int ub0 = 8 * h + sig;
    const int cbase = 1022 - 64 * (2 * w) - 2 * r + h;
    const bool odd = sig & 1;
    bf16x8 afn[2]; unsigned dn[5];
    {
#pragma unroll
      for (int mi = 0; mi < 2; ++mi) { const int C = cbase - 64 * mi; afn[mi] = *(const bf16x8*)((const char*)R + ((C ^ ((C >> 4) & 1)) << 4)); }
      const int di = ub0 >> 1;
#pragma unroll
      for (int i = 0; i < 5; ++i) dn[i] = Ud[di + i];
    }
#pragma unroll 1
    for (int q = 0; q <= SEQ / 16; ++q) {
      bf16x8 af[2]; unsigned d[5];
#pragma unroll
      for (int mi = 0; mi < 2; ++mi) af[mi] = afn[mi];
#pragma unroll
      for (int i = 0; i < 5; ++i) d[i] = dn[i];
      {
        const int qn = min(q + 1, SEQ / 16);
#pragma unroll
        for (int mi = 0; mi < 2; ++mi) { const int C = cbase - 64 * mi + 2 * qn; afn[mi] = *(const bf16x8*)((const char*)R + ((C ^ ((C >> 4) & 1)) << 4)); }
        const int di = (16 * qn + ub0) >> 1;
#pragma unroll
        for (int i = 0; i < 5; ++i) dn[i] = Ud[di + i];
      }
      u32x4 bw;
#pragma unroll
      for (int i = 0; i < 4; ++i) bw[i] = odd ? __builtin_amdgcn_alignbit(d[i + 1], d[i], 16) : d[i];
      const bf16x8 bfr = __builtin_bit_cast(bf16x8, bw);
#pragma unroll
      for (int mi = 0; mi < 2; ++mi) acc[mi] = __builtin_amdgcn_mfma_f32_32x32x16_bf16(af[mi], bfr, acc[mi], 0, 0, 0);
    }
    __syncthreads();
    {
      float* Y = (float*)(smem + SM_HR);
      float* yl = Y + bb * SEQ + 16 * (32 * (2 * w) + 4 * h) + sig;
#pragma unroll
      for (int mi = 0; mi < 2; ++mi)
#pragma unroll
        for (int k = 0; k < 16; ++k) yl[16 * (32 * mi + (k & 3) + 8 * (k >> 2))] = acc[mi][k];
    }
    __syncthreads();
    {
      const float* Y = (const float*)(smem + SM_HR);
      const float kn = p.knorm()[l * HYENA_W + ch], dsk = p.hy_d[l * HYENA_W + ch];
#pragma unroll 2
      for (int idx = tid; idx < BATCH * SEQ; idx += NT) {
        const int b = idx / SEQ, t = idx - b * SEQ;
        const long o = ((long)b * HYENA_W + ch) * SEQ + t;
        p.mixb()[(long)idx * MIX_W + ATTN_W + ch] = (Y[idx] * kn + p.hu()[o] * dsk) * p.hx0()[o];
      }
    }
  }
}
#define SM_K 256
#define SM_V (256 + 8192)
static_assert(HEAD_DIM == 64 && WINDOW == 128 && CTX_LEN == 256 && Q_GROUP == 4, "attention shape");
DEV void ph_attn_mfma(const P& p, int l, char* smem) {
  const int tid = otid(), lane = tid & 63, w = (tid >> 6) & 3, hsel = tid >> 8, h = lane >> 5, ql = lane & 31;
  char* Ks = smem + SM_K; char* Vs = smem + SM_V;
  const int n_lat = BATCH * (SEQ / 128) * N_KV_HEADS * (Q_GROUP / 2);
  const int n_ctx = (l == 0) ? BATCH * (CTX_LEN / 128) * N_KV_HEADS * (Q_GROUP / 2) : 0;
  const float QS = 0.125f * 1.4426950408889634f;
  for (int it = blockIdx.x; it < n_lat + n_ctx; it += gridDim.x) {
    const bool isctx = it >= n_lat;
    int b, qb, kvh, g;
    { int x = isctx ? it - n_lat : it; g = (x & 1) * 2 + hsel; kvh = (x >> 1) & 1; x >>= 2; if (isctx) { qb = x & 1; b = x >> 1; } else { qb = x & 63; b = x >> 6; } }
    const int hq = kvh * Q_GROUP + g;
    const int tq0 = qb * 128 + 32 * w;
    const long qrow = (isctx ? (long)NL + b * CTX_LEN : (long)b * SEQ) + tq0 + ql;
    bf16x8 qf[4];
    {
      const unsigned short* qp = p.qkvb() + qrow * HY_OFF + Q_OFF + hq * HEAD_DIM + 8 * h;
#pragma unroll
      for (int ks = 0; ks < 4; ++ks) qf[ks] = *(const bf16x8*)(qp + 16 * ks);
    }
    f32x16 o0, o1;
#pragma unroll
    for (int k = 0; k < 16; ++k) { o0[k] = 0.f; o1[k] = 0.f; }
    float m = -1e30f, lsum = 0.f;
    const int nsteps = isctx ? 4 : 10;
    u32x4 rk[1], rv[1];
    auto key_row = [&](int step, int key) -> long {
      if (step < 4) return (long)NL + b * CTX_LEN + step * 64 + key;
      const int tk = qb * 128 - 128 + (step - 4) * 64 + key;
      return (tk < 0 || tk >= SEQ) ? -1 : (long)b * SEQ + tk;
    };
    auto step_valid = [&](int step) -> bool { if (step < 4) return true; const int t0 = qb * 128 - 128 + (step - 4) * 64; return t0 >= 0 && t0 < SEQ; };
    auto load_tile = [&](int step) {
#pragma unroll
      for (int i = 0; i < 1; ++i) {
        const int key = (tid >> 3); const long kr = key_row(step, key);
        const unsigned short* kp = p.qkvb() + kr * HY_OFF + K_OFF + kvh * HEAD_DIM + (tid & 7) * 8; const unsigned short* vp = p.qkvb() + kr * HY_OFF + V_OFF + kvh * HEAD_DIM + (tid & 7) * 8;
        rk[i] = *(const u32x4*)kp; rv[i] = *(const u32x4*)vp;
      }
    };
    int step = 0;
    load_tile(0);
    while (step < nsteps) {
      __syncthreads();
#pragma unroll
      for (int i = 0; i < 1; ++i) {
        const int key = (tid >> 3), ch = tid & 7;
        *(u32x4*)(Ks + tile_off(key, ch)) = rk[i];
        *(u32x4*)(Vs + key * 128 + ((ch * 16) ^ (64 * ((key >> 1) & 1)))) = rv[i];
      }
      __syncthreads();
      const int cur = step;
      int nxt = step + 1;
      while (nxt < nsteps && !step_valid(nxt)) ++nxt;
      if (nxt < nsteps) load_tile(nxt);
      step = nxt;
#pragma unroll
      for (int sub = 0; sub < 2; ++sub) {
        const bool win = cur >= 4;
        const int ks0 = win ? qb * 128 - 128 + (cur - 4) * 64 + sub * 32 : 0;
        if (win && (ks0 > tq0 + 31 + WINDOW || ks0 + 31 < tq0 - WINDOW)) continue;
        f32x16 sacc;
#pragma unroll
        for (int k = 0; k < 16; ++k) sacc[k] = 0.f;
#pragma unroll
        for (int ks = 0; ks < 4; ++ks) {
          const bf16x8 kf = *(const bf16x8*)(Ks + tile_off(sub * 32 + ql, 2 * ks + h));
          sacc = __builtin_amdgcn_mfma_f32_32x32x16_bf16(kf, qf[ks], sacc, 0, 0, 0);
        }
        if (win && (ks0 + 31 - tq0 > WINDOW || tq0 + 31 - ks0 > WINDOW)) {
          const int tq = tq0 + ql;
#pragma unroll
          for (int k = 0; k < 16; ++k) { const int d = ks0 + (k & 3) + 8 * (k >> 2) + 4 * h - tq; if (d > WINDOW || d < -WINDOW) sacc[k] = -1e30f; }
        }
        float mx = sacc[0];
#pragma unroll
        for (int k = 1; k < 16; ++k) mx = fmaxf(mx, sacc[k]);
        mx = fmaxf(mx, __shfl_xor(mx, 32));
        const float mn = fmaxf(m, mx); const float alpha = exp2f(m - mn); m = mn;
        float ps = 0.f;
#pragma unroll
        for (int k = 0; k < 16; ++k) { sacc[k] = exp2f(sacc[k] - mn); ps += sacc[k]; }
        lsum = lsum * alpha + ps;
#pragma unroll
        for (int k = 0; k < 16; ++k) { o0[k] *= alpha; o1[k] *= alpha; }
        u32x2 v00, v01, v02, v03, v10, v11, v12, v13;
        {
          const int q4 = (lane & 15) >> 2, p4 = lane & 3, blk = (lane >> 4) & 1, sq = (q4 >> 1) & 1;
          const unsigned lb = (unsigned)(size_t)((__attribute__((address_space(3))) char*)Vs) + (unsigned)((sub * 32 + 4 * h + q4) * 128 + 32 * blk + 8 * p4);
          const unsigned base0 = lb + 64 * sq, base1 = lb + 64 * (1 - sq);
          asm volatile(
              "ds_read_b64_tr_b16 %0, %8\n\t"
              "ds_read_b64_tr_b16 %1, %8 offset:1024\n\t"
              "ds_read_b64_tr_b16 %2, %8 offset:2048\n\t"
              "ds_read_b64_tr_b16 %3, %8 offset:3072\n\t"
              "ds_read_b64_tr_b16 %4, %9\n\t"
              "ds_read_b64_tr_b16 %5, %9 offset:1024\n\t"
              "ds_read_b64_tr_b16 %6, %9 offset:2048\n\t"
              "ds_read_b64_tr_b16 %7, %9 offset:3072\n\t"
              "s_waitcnt lgkmcnt(0)"
              : "=&v"(v00), "=&v"(v01), "=&v"(v02), "=&v"(v03), "=&v"(v10), "=&v"(v11), "=&v"(v12), "=&v"(v13)
              : "v"(base0), "v"(base1) : "memory");
        }
#pragma unroll
        for (int ks2 = 0; ks2 < 2; ++ks2) {
          u32x4 pw;
#pragma unroll
          for (int i = 0; i < 4; ++i) pw[i] = pack2(sacc[8 * ks2 + 2 * i], sacc[8 * ks2 + 2 * i + 1]);
          const bf16x8 pf = __builtin_bit_cast(bf16x8, pw);
          u32x4 a0, a1;
          if (ks2 == 0) { a0[0] = v00[0]; a0[1] = v00[1]; a0[2] = v01[0]; a0[3] = v01[1]; a1[0] = v10[0]; a1[1] = v10[1]; a1[2] = v11[0]; a1[3] = v11[1]; }
          else          { a0[0] = v02[0]; a0[1] = v02[1]; a0[2] = v03[0]; a0[3] = v03[1]; a1[0] = v12[0]; a1[1] = v12[1]; a1[2] = v13[0]; a1[3] = v13[1]; }
          o0 = __builtin_amdgcn_mfma_f32_32x32x16_bf16(__builtin_bit_cast(bf16x8, a0), pf, o0, 0, 0, 0);
          o1 = __builtin_amdgcn_mfma_f32_32x32x16_bf16(__builtin_bit_cast(bf16x8, a1), pf, o1, 0, 0, 0);
        }
      }
    }
    lsum += __shfl_xor(lsum, 32);
    const float sk = p.sink[l * N_Q_HEADS + hq] * 1.4426950408889634f;
    const float mf = fmaxf(m, sk); const float sc = exp2f(m - mf); const float inv = sc / (lsum * sc + exp2f(sk - mf));
    float* op = p.mixb() + qrow * MIX_W + hq * HEAD_DIM + 4 * h;
#pragma unroll
    for (int gq = 0; gq < 4; ++gq) {
      *(float4*)(op + 8 * gq) = make_float4(o0[4 * gq] * inv, o0[4 * gq + 1] * inv, o0[4 * gq + 2] * inv, o0[4 * gq + 3] * inv);
      *(float4*)(op + 32 + 8 * gq) = make_float4(o1[4 * gq] * inv, o1[4 * gq + 1] * inv, o1[4 * gq + 2] * inv, o1[4 * gq + 3] * inv);
    }
  }
}


static_assert(S5_T == 64 && S5_STATE == 64 && S5_GROUP == 16 && S5_GROUPS == 16 && NCH == 132, "s5 mfma shape");
#define S5_COLS (BATCH * NCH)
#define S5_RT 88
DEV void ph_s5tables_gpu(const P& p, long gtid, long gsize) {
  FOR_ITEMS4(i, (long)DEPTH * 2 * S5_GROUPS * 1024 * 128) {
    const int n = (int)(i & 127), k = (int)((i >> 7) & 1023); const long ldg = i >> 17;
    const int ri = n >> 6, pp = n & 63, sidx = k >> 4, j = k & 15;
    const float2 lp = p.lampow()[(ldg * (S5_T + 1) + (S5_T - 1 - sidx)) * S5_STATE + pp]; const float2 bb = p.bbar()[(ldg * S5_STATE + pp) * S5_GROUP + j];
    p.bmt()[i] = ri ? lp.x * bb.y + lp.y * bb.x : lp.x * bb.x - lp.y * bb.y;
  }
  FOR_ITEMS4(i, (long)DEPTH * 2 * S5_GROUPS * 128 * 1024) {
    const int k = (int)(i & 127), n = (int)((i >> 7) & 1023); const long ldg = i >> 17; const int dir = (int)((ldg >> 4) & 1);
    const int ri = k >> 6, pp = k & 63, tl = n >> 4, ii = n & 15; const int tau = dir ? 63 - tl : tl;
    const float cr = p.s5_c_re[(ldg * S5_GROUP + ii) * S5_STATE + pp], ci = p.s5_c_im[(ldg * S5_GROUP + ii) * S5_STATE + pp];
    const float2 lp = p.lampow()[(ldg * (S5_T + 1) + tau + 1) * S5_STATE + pp];
    p.cmt()[i] = ri ? -(cr * lp.y + ci * lp.x) : cr * lp.x - ci * lp.y;
  }
}
struct ALS5U { const char* base; unsigned off0[2]; int stepb; const char* hbase; unsigned hoff[2]; int nki;
  DEVM void set(int i, int b, int dir, int chunk, int sl, unsigned joff) { off0[i] = (unsigned)s5_row(b, dir, chunk * S5_T + sl) * (unsigned)(S5_W * 2) + joff; }
  DEVM const unsigned short* a(int i, int kt) const {
    if (kt >= nki) return (const unsigned short*)(hbase + (hoff[i] + (unsigned)(kt - nki) * 128u));
    return (const unsigned short*)(base + (off0[i] + (unsigned)(kt * stepb))); } };
struct BLKc { static constexpr bool TR = true; const char* kc; const char* cm; int tl, i0, sj, ss, dir, nki; unsigned cmoff;
  DEVM void load(float4 (&rb)[8], int kt) const {
    if (kt >= nki) {
#pragma unroll
      for (int c = 0; c < 4; ++c) { const char* q = cm + (cmoff + (unsigned)(c * 128 + (kt - nki) * 64) * 4u); rb[2 * c] = *(const float4*)q; rb[2 * c + 1] = *(const float4*)(q + 16); }
      return;
    }
    const int d = (dir ? 63 - tl : tl) - (4 * kt + ss);
    if (d < 0) {
#pragma unroll
      for (int i = 0; i < 8; ++i) rb[i] = make_float4(0.f, 0.f, 0.f, 0.f);
    } else {
#pragma unroll
      for (int c = 0; c < 4; ++c) { const char* q = kc + (unsigned)(((d * 16 + i0 + c) * 16 + sj) * 4); rb[2 * c] = *(const float4*)q; rb[2 * c + 1] = *(const float4*)(q + 16); }
    }
  } };
DEV void ph_s5_sgemm(const P& p, int l, char* smem) {
  const int tid = otid();
  const int nitems = 2 * S5_GROUPS * 3;
  for (int it = blockIdx.x; it < nitems; it += gridDim.x) {
    const int rt = it % 3, g = (it / 3) % S5_GROUPS, dir = it / (3 * S5_GROUPS);
    ALS5U al; al.base = (const char*)(p.s5u() + g * S5_GROUP); al.stepb = (dir ? -4 : 4) * S5_W * 2; al.nki = 1 << 20; al.hbase = al.base; al.hoff[0] = al.hoff[1] = 0;
#pragma unroll
    for (int i = 0; i < 2; ++i) { const int col = rt * S5_RT + min((tid >> 3) + 64 * i, S5_RT - 1); al.set(i, col / NCH, dir, col % NCH, (tid & 7) >> 1, (tid & 1) * 16); }
    BLStd bl = mk_bl(p.bmt() + (((long)l * 2 + dir) * S5_GROUPS + g) * 1024 * 128, 128, tid);
    bl.valid = (tid >> 3) < 32;
    f32x4 acc[4][4]; acc_zero(acc);
    gemm_t(al, bl, 16, acc, smem);
    EPI_BEGIN
    if (((etid >> 6) & 3) < 2) {
#pragma unroll
      for (int m = 0; m < 4; ++m)
#pragma unroll
        for (int j = 0; j < 4; ++j) {
          const int rl = EPI_ROW(m, j);
          if (rl < S5_RT) {
            const int col = rt * S5_RT + rl; const int b = col / NCH, c = col % NCH;
            float* dst = (float*)(p.sc() + ((((long)b * 2 + dir) * S5_GROUPS + g) * NCH + c) * S5_STATE);
#pragma unroll
            for (int n = 0; n < 4; ++n) { const int nn = EPI_COL(n); dst[(nn & 63) * 2 + (nn >> 6)] = acc[m][n][j]; }
          }
        }
    }
  }
}

static_assert(NCH == 132, "carry scan grouping");
DEV void ph_s5_carry_gpu(const P& p, int l, char* smem) {
  const int tid = otid();
  float2* E = (float2*)(smem + SM_MISC);
  const int nchains = BATCH * 2 * S5_GROUPS * S5_STATE;
  for (int cb = blockIdx.x * 16; cb < nchains; cb += gridDim.x * 16) {
    const int cl = tid & 15, grp = tid >> 4; const bool act = tid < 176;
    const int chain = cb + cl;
    const int pp = chain % S5_STATE, g = (chain / S5_STATE) % S5_GROUPS, dir = (chain / (S5_STATE * S5_GROUPS)) % 2, b = chain / (S5_STATE * S5_GROUPS * 2);
    const long ldg = ((long)l * 2 + dir) * S5_GROUPS + g;
    const long base = (((long)b * 2 + dir) * S5_GROUPS + g) * NCH + grp * 12;
    float2 lt = make_float2(0.f, 0.f); float2 L[12]; float hr = 0.f, hi = 0.f;
    __syncthreads();
    if (act) {
      lt = p.lampow()[(ldg * (S5_T + 1) + S5_T) * S5_STATE + pp];
      float2 sv[12];
#pragma unroll
      for (int k = 0; k < 12; ++k) sv[k] = p.sc()[(base + k) * S5_STATE + pp];
#pragma unroll
      for (int k = 0; k < 12; ++k) { L[k] = make_float2(hr, hi); const float nr = lt.x * hr - lt.y * hi + sv[k].x, ni = lt.x * hi + lt.y * hr + sv[k].y; hr = nr; hi = ni; }
      E[grp * 16 + cl] = make_float2(hr, hi);
    }
    __syncthreads();
    if (act) {
      float pr = lt.x, pi = lt.y;
#pragma unroll
      for (int k = 1; k < 12; ++k) { const float nr = pr * lt.x - pi * lt.y, ni = pr * lt.y + pi * lt.x; pr = nr; pi = ni; }
      float gr = 0.f, gi = 0.f;
      for (int gp = 0; gp < grp; ++gp) { const float2 e = E[gp * 16 + cl]; const float nr = pr * gr - pi * gi + e.x, ni = pr * gi + pi * gr + e.y; gr = nr; gi = ni; }
#pragma unroll
      for (int k = 0; k < 12; ++k) {
        const float vr = L[k].x + gr, vi = L[k].y + gi;
        p.hcbf()[(base + k) * 2 * S5_STATE + pp] = f2bf16(vr); p.hcbf()[(base + k) * 2 * S5_STATE + S5_STATE + pp] = f2bf16(vi);
        const float nr = lt.x * gr - lt.y * gi, ni = lt.x * gi + lt.y * gr; gr = nr; gi = ni;
      }
    }
  }
}
DEV void ph_s5_ygemm(const P& p, int l, char* smem) {
  const int tid = otid();
  const int nitems = S5_GROUPS * 3 * 4;
  for (int it = blockIdx.x; it < nitems; it += gridDim.x) {
    const int nt = it & 3, rt = (it >> 2) % 3, g = it / 12;
    f32x4 acc[4][4]; acc_zero(acc);
#pragma unroll 1
    for (int dir = 0; dir < 2; ++dir) {
      const long ldg = ((long)l * 2 + dir) * S5_GROUPS + g;
      const int nki = dir ? 16 - 4 * nt : 4 * nt + 4;
      ALS5U al; al.base = (const char*)(p.s5u() + g * S5_GROUP); al.stepb = (dir ? -4 : 4) * S5_W * 2; al.nki = nki; al.hbase = (const char*)p.hcbf();
#pragma unroll
      for (int i = 0; i < 2; ++i) {
        const int col = rt * S5_RT + min((tid >> 3) + 64 * i, S5_RT - 1); const int b = col / NCH, blk = col % NCH;
        const int ch = dir ? (blk < 4 ? 3 - blk : 135 - blk) : blk;
        al.set(i, b, dir, ch, (tid & 7) >> 1, (tid & 1) * 16);
        al.hoff[i] = (unsigned)((((b * 2 + dir) * S5_GROUPS + g) * NCH + ch) * 128 + (tid & 7) * 8) * 2u;
      }
      BLKc bk; bk.kc = (const char*)(p.kc() + ldg * S5_T * 256); bk.tl = 16 * nt + (tid >> 5); bk.i0 = ((tid >> 3) & 3) * 4; bk.sj = (tid & 1) * 8; bk.ss = (tid & 7) >> 1; bk.dir = dir; bk.nki = nki;
      bk.cm = (const char*)(p.cmt() + ldg * 1024 * 128); bk.cmoff = (unsigned)(((16 * nt + (tid >> 5)) * 16 + ((tid >> 3) & 3) * 4) * 128 + (tid & 7) * 8) * 4u;
      gemm_t(al, bk, nki + 2, acc, smem);
    }
    EPI_BEGIN
#pragma unroll
    for (int m = 0; m < 4; ++m)
#pragma unroll
      for (int j = 0; j < 4; ++j) {
        const int rl = EPI_ROW(m, j);
        if (rl < S5_RT) {
          const int col = rt * S5_RT + rl; const int b = col / NCH, blk = col % NCH;
#pragma unroll
          for (int n = 0; n < 4; ++n) {
            const int nn = nt * 256 + EPI_COL(n); const int tl = nn >> 4, chn = g * S5_GROUP + (nn & 15);
            const long row = blk < 4 ? (long)NL + b * CTX_LEN + blk * 64 + tl : (long)b * SEQ + (blk - 4) * 64 + tl;
            const float y = acc[m][n][j] + p.s5_d[l * S5_W + chn] * __uint_as_float((unsigned)p.s5u()[row * S5_W + chn] << 16);
            const float gy = gelu_tanhf(y);
            p.ybuf()[row * S5_W + chn] = gy; p.ybf()[row * S5_W + chn] = (unsigned short)f2bf(gy);
          }
        }
      }
  }
}

DEV float wave_sum(float v) {
#pragma unroll
  for (int o = 32; o > 0; o >>= 1) v += __shfl_xor(v, o);
  return v;
}
DEV void st_bf4(unsigned short* dst, float a, float b, float c, float d) { u32x2 v; v[0] = pack2(a, b); v[1] = pack2(c, d); *(u32x2*)dst = v; }
static_assert(BATCH == 2, "mod partial layout");
DEV void ph_modsum_gpu(const P& p, long gtid, long gsize) {
  FOR_ITEMS4(i, (long)DEPTH * D_MODEL * N_EXPERTS) p.wrlo()[i] = bflo(p.w_router[i]);
  FOR_ITEMS(i, (long)DEPTH * (BATCH + 1) * 6 * D_MODEL) {
    const int n = (int)(i % (6 * D_MODEL)); const int j = (int)((i / (6 * D_MODEL)) % (BATCH + 1)); const int l = (int)(i / (6 * D_MODEL * (BATCH + 1)));
    float acc = p.b_ada[l * 6 * D_MODEL + n];
#pragma unroll
    for (int sl = 0; sl < 16; ++sl) acc += p.modp()[((long)(l * 16 + sl) * (BATCH + 1) + j) * 6 * D_MODEL + n];
    p.mod()[i] = acc;
  }
}
DEV void ph_modu0_gpu(const P& p, long gtid, long gsize) {
  FOR_ITEMS4(i4, (long)NR * D_MODEL / 4) {
    const long i = i4 * 4; const int k = (int)(i % D_MODEL); const long r = i / D_MODEL;
    const float* m = p.mod() + (long)modrow(r) * 6 * D_MODEL;
    const float4 x = *(const float4*)(p.xcur() + i); const float4 sh = *(const float4*)(m + k); const float4 sc = *(const float4*)(m + D_MODEL + k);
    st_bf4(p.ubf() + i, x.x * (1.f + sc.x) + sh.x, x.y * (1.f + sc.y) + sh.y, x.z * (1.f + sc.z) + sh.z, x.w * (1.f + sc.w) + sh.w);
  }
}
DEV void rms_rows(const P& p, int l, long r0, long r1, int w0, int nw) {
  const int lane = otid() & 63;
  for (long r = r0 + w0; r < r1; r += nw) {
    const float* v = p.mixb() + r * MIX_W; float4 a[4]; float ss[4];
#pragma unroll
    for (int i = 0; i < 4; ++i) { a[i] = *(const float4*)(v + (i * 64 + lane) * 4); ss[i] = a[i].x * a[i].x + a[i].y * a[i].y + a[i].z * a[i].z + a[i].w * a[i].w; }
    const float s_att = wave_sum(ss[0] + ss[1]), s_hy = wave_sum(ss[2]), s_s5 = wave_sum(ss[3]);
    float rs[4]; rs[0] = rs[1] = 1.0f / sqrtf(s_att / (float)ATTN_W + LN_EPS); rs[2] = 1.0f / sqrtf(s_hy / (float)HYENA_W + LN_EPS); rs[3] = 1.0f / sqrtf(s_s5 / (float)S5_W + LN_EPS);
#pragma unroll
    for (int i = 0; i < 4; ++i) {
      const int k = (i * 64 + lane) * 4; const float4 g = *(const float4*)(p.mix_g + l * MIX_W + k);
      st_bf4(p.mixbf() + r * MIX_W + k, a[i].x * rs[i] * g.x, a[i].y * rs[i] * g.y, a[i].z * rs[i] * g.z, a[i].w * rs[i] * g.w);
    }
  }
}
DEV void ln_rows(float4 (&a)[4], const float* gw, const float* bw, int lane) {
  float s = 0.f;
#pragma unroll
  for (int i = 0; i < 4; ++i) s += a[i].x + a[i].y + a[i].z + a[i].w;
  const float mu = wave_sum(s) / (float)D_MODEL; float q = 0.f;
#pragma unroll
  for (int i = 0; i < 4; ++i) { a[i].x -= mu; a[i].y -= mu; a[i].z -= mu; a[i].w -= mu; q += a[i].x * a[i].x + a[i].y * a[i].y + a[i].z * a[i].z + a[i].w * a[i].w; }
  const float rs = 1.0f / sqrtf(wave_sum(q) / (float)D_MODEL + LN_EPS);
#pragma unroll
  for (int i = 0; i < 4; ++i) {
    const int k = (i * 64 + lane) * 4; const float4 g = *(const float4*)(gw + k), b = *(const float4*)(bw + k);
    a[i].x = a[i].x * rs * g.x + b.x; a[i].y = a[i].y * rs * g.y + b.y; a[i].z = a[i].z * rs * g.z + b.z; a[i].w = a[i].w * rs * g.w + b.w;
  }
}
DEV void ph_ln1_gpu(const P& p, int l) {
  const int tid_ = otid(); const int lane = tid_ & 63; const int gw = blockIdx.x * (NT / 64) + (tid_ >> 6), nw = gridDim.x * (NT / 64);
  for (long r = gw; r < NR; r += nw) {
    float4 a[4];
#pragma unroll
    for (int i = 0; i < 4; ++i) a[i] = *(const float4*)(p.tmp() + r * D_MODEL + (i * 64 + lane) * 4);
    ln_rows(a, p.ln1_g + l * D_MODEL, p.ln1_b + l * D_MODEL, lane);
    const float* m = p.mod() + ((long)l * (BATCH + 1) + modrow(r)) * 6 * D_MODEL + 3 * D_MODEL;
#pragma unroll
    for (int i = 0; i < 4; ++i) {
      const int k = (i * 64 + lane) * 4;
      *(float4*)(p.xcur() + r * D_MODEL + k) = a[i];
      const float4 sh = *(const float4*)(m + k), sc = *(const float4*)(m + D_MODEL + k);
      const float u0 = a[i].x * (1.f + sc.x) + sh.x, u1 = a[i].y * (1.f + sc.y) + sh.y, u2 = a[i].z * (1.f + sc.z) + sh.z, u3 = a[i].w * (1.f + sc.w) + sh.w;
      st_bf4(p.ubf() + r * D_MODEL + k, u0, u1, u2, u3);
      st_bf4(p.ubl() + r * D_MODEL + k, bflo(u0), bflo(u1), bflo(u2), bflo(u3));
    }
  }
}
DEV void ph_ln2_gpu(const P& p, int l) {
  const int tid_ = otid(); const int lane = tid_ & 63; const int gw = blockIdx.x * (NT / 64) + (tid_ >> 6), nw = gridDim.x * (NT / 64);
  for (long r = gw; r < NR; r += nw) {
    float4 a[4];
    const float* m = p.mod() + ((long)l * (BATCH + 1) + modrow(r)) * 6 * D_MODEL + 5 * D_MODEL;
#pragma unroll
    for (int i = 0; i < 4; ++i) {
      const int k = (i * 64 + lane) * 4;
      float4 f = *(const float4*)(p.ysh() + r * D_MODEL + k);
#pragma unroll
      for (int kk = 0; kk < TOP_K; ++kk) { const u32x2 y = *(const u32x2*)(p.ykb() + (r * TOP_K + kk) * D_MODEL + k); f.x += __uint_as_float(y[0] << 16); f.y += __uint_as_float(y[0] & 0xffff0000u); f.z += __uint_as_float(y[1] << 16); f.w += __uint_as_float(y[1] & 0xffff0000u); }
      const float4 x = *(const float4*)(p.xcur() + r * D_MODEL + k), g2 = *(const float4*)(m + k);
      a[i].x = DN_ALPHA * x.x + g2.x * f.x; a[i].y = DN_ALPHA * x.y + g2.y * f.y; a[i].z = DN_ALPHA * x.z + g2.z * f.z; a[i].w = DN_ALPHA * x.w + g2.w * f.w;
    }
    ln_rows(a, p.ln2_g + l * D_MODEL, p.ln2_b + l * D_MODEL, lane);
    const float* mn = p.mod() + ((long)(l + 1) * (BATCH + 1) + modrow(r)) * 6 * D_MODEL;
#pragma unroll
    for (int i = 0; i < 4; ++i) {
      const int k = (i * 64 + lane) * 4;
      *(float4*)(p.xcur() + r * D_MODEL + k) = a[i];
      if (l + 1 < DEPTH) {
        const float4 sh = *(const float4*)(mn + k), sc = *(const float4*)(mn + D_MODEL + k);
        st_bf4(p.ubf() + r * D_MODEL + k, a[i].x * (1.f + sc.x) + sh.x, a[i].y * (1.f + sc.y) + sh.y, a[i].z * (1.f + sc.z) + sh.z, a[i].w * (1.f + sc.w) + sh.w);
      } else if (r < NL) *(float4*)(p.out + r * D_MODEL + k) = a[i];
    }
  }
}
struct ALRouter { const char* hi; const char* lo_; unsigned off[2];
  DEVM const unsigned short* a(int i, int kt) const { return (const unsigned short*)((kt >= 32 ? lo_ : hi) + (off[i] + (unsigned)(kt & 15) * 128u)); } };
struct BLRouter { const char* base; const char* lob; unsigned voff; unsigned rowb;
  DEVM void load(u32x4 (&rb)[4], int kt) const {
    const char* bb = (kt >> 4) == 1 ? lob : base;
#pragma unroll
    for (int c = 0; c < 4; ++c) rb[c] = *(const u32x4*)(bb + (voff + (unsigned)c * rowb + (unsigned)(kt & 15) * 128u)); } };
DEV void ph_router_mfma(const P& p, int l, char* smem) {
  const int tid = otid();
  const int n_router = (NR >> 7), n_sh = (NR >> 7) * 2;
  const int nrb = (int)gridDim.x >= 64 ? (int)((gridDim.x * 3) / 5) : 0;
  const bool is_router = nrb == 0 ? false : (int)blockIdx.x < nrb;
  for (int pass = 0; pass < 2; ++pass) {
    const bool do_router = nrb == 0 ? pass == 0 : is_router;
    if (nrb != 0 && pass == 1) break;
    const int first = nrb == 0 ? (int)blockIdx.x : (do_router ? (int)blockIdx.x : (int)blockIdx.x - nrb);
    const int stride = nrb == 0 ? (int)gridDim.x : (do_router ? nrb : (int)gridDim.x - nrb);
    const int nit = do_router ? n_router : n_sh;
    for (int it = first; it < nit; it += stride) {
      const int rt = do_router ? it : (it >> 1), cq = do_router ? 0 : (it & 1);
      ALRouter ar; ar.hi = (const char*)(p.ubf() + (long)rt * 128 * D_MODEL); ar.lo_ = (const char*)(p.ubl() + (long)rt * 128 * D_MODEL);
#pragma unroll
      for (int i = 0; i < 2; ++i) ar.off[i] = (unsigned)(((tid >> 3) + 64 * i) * D_MODEL + (tid & 7) * 8) * 2u;
      BLRouter br; int nk;
      if (do_router) {
        br.base = (const char*)(p.wt_rh() + (long)l * N_EXPERTS * D_MODEL); br.lob = (const char*)(p.wt_rl() + (long)l * N_EXPERTS * D_MODEL); br.rowb = D_MODEL * 2;
        br.voff = (unsigned)((tid >> 3) * 4) * br.rowb + (unsigned)((tid & 7) * 16); nk = 3 * (D_MODEL >> 6);
      } else {
        const int nq = tid >> 3; const int wsel = __builtin_amdgcn_readfirstlane(tid >> 6) & 1;
        const unsigned short* wsrc = (wsel ? p.wt_shu() : p.wt_shg()) + (long)l * SHARED_FF * D_MODEL;
        br.base = (const char*)wsrc; br.lob = br.base; br.rowb = D_MODEL * 2;
        br.voff = (unsigned)(cq * 128 + (nq >> 4) * 32 + (nq & 7) * 4) * br.rowb + (unsigned)((tid & 7) * 16); nk = D_MODEL >> 6;
      }
      f32x4 acc[4][4]; acc_zero(acc);
      gemm_tb(ar, br, nk, acc, smem);
      EPI_BEGIN
      if (do_router) {
#pragma unroll
        for (int m = 0; m < 4; ++m)
#pragma unroll
          for (int n = 0; n < 4; ++n)
#pragma unroll
            for (int j = 0; j < 4; ++j) p.rl()[((long)rt * 128 + EPI_ROW(m, j)) * N_EXPERTS + EPI_COL(n)] = acc[m][n][j];
      } else {
        const int elane = etid & 63, ewc = (etid >> 6) & 3;
#pragma unroll
        for (int m = 0; m < 4; ++m)
#pragma unroll
          for (int j = 0; j < 4; ++j)
          { unsigned short* dst = p.hsbf() + ((long)rt * 128 + EPI_ROW(m, j)) * SHARED_FF + cq * 128 + ewc * 32 + (elane & 15);
            dst[0] = (unsigned short)f2bf(siluf(acc[m][0][j]) * acc[m][2][j]); dst[16] = (unsigned short)f2bf(siluf(acc[m][1][j]) * acc[m][3][j]); }
      }
    }
  }
}
static_assert(EPG == 32 && TOP_K == 8 && N_EXPERT_GROUPS == 8 && TOPK_GROUPS == 4, "select shape");
DEV void ph_select_gpu(const P& p, int l) {
  const int tid_ = otid(); const int lane = tid_ & 63; const int gw = blockIdx.x * (NT / 64) + (tid_ >> 6), nw = gridDim.x * (NT / 64);
  const float4 rb = *(const float4*)(p.router_bias + l * N_EXPERTS + 4 * lane);
  for (long r = gw; r < NR; r += nw) {
    const float4 lg = *(const float4*)(p.rl() + r * N_EXPERTS + 4 * lane);
    float sc[4] = {sigmoidf_(lg.x), sigmoidf_(lg.y), sigmoidf_(lg.z), sigmoidf_(lg.w)};
    float bz[4] = {sc[0] + rb.x, sc[1] + rb.y, sc[2] + rb.z, sc[3] + rb.w};
    float m1 = fmaxf(bz[0], bz[1]), m2 = fminf(bz[0], bz[1]);
#pragma unroll
    for (int c = 2; c < 4; ++c) { const float v = bz[c]; m2 = fmaxf(m2, fminf(m1, v)); m1 = fmaxf(m1, v); }
#pragma unroll
    for (int o = 1; o < 8; o <<= 1) { const float b1 = __shfl_xor(m1, o), b2 = __shfl_xor(m2, o); m2 = fmaxf(fminf(m1, b1), fmaxf(m2, b2)); m1 = fmaxf(m1, b1); }
    const float gs = m1 + m2; const int mg = lane >> 3; int rank = 0;
#pragma unroll
    for (int j = 0; j < 8; ++j) { const float gj = __shfl(gs, j * 8); rank += (gj > gs || (gj == gs && j < mg)) ? 1 : 0; }
    if (rank >= TOPK_GROUPS) { bz[0] = bz[1] = bz[2] = bz[3] = -1e30f; }
    int sel_e[TOP_K]; float sel_s[TOP_K]; float gsum = 0.f;
#pragma unroll
    for (int it = 0; it < TOP_K; ++it) {
      float bv = bz[0]; int bc = 0;
#pragma unroll
      for (int c = 1; c < 4; ++c) if (bz[c] > bv) { bv = bz[c]; bc = c; }
      int bi = 4 * lane + bc; float bs = sc[bc];
      const int myi = bi;
#pragma unroll
      for (int o = 1; o < 64; o <<= 1) {
        const float ov = __shfl_xor(bv, o); const int oi = __shfl_xor(bi, o); const float os = __shfl_xor(bs, o);
        if (ov > bv || (ov == bv && oi < bi)) { bv = ov; bi = oi; bs = os; }
      }
      sel_e[it] = bi; sel_s[it] = bs; gsum += bs;
      if (bi == myi) {
#pragma unroll
        for (int c = 0; c < 4; ++c) if (c == bc) bz[c] = -1e30f;
      }
    }
    const float inv = ROUTED_SCALE / gsum;
    int me = sel_e[0]; float ms = sel_s[0];
#pragma unroll
    for (int it = 1; it < TOP_K; ++it) if (lane == it) { me = sel_e[it]; ms = sel_s[it]; }
    if (lane < TOP_K) {
      const long a = r * TOP_K + lane;
      p.top_e()[a] = me; p.gate()[a] = ms * inv;
      const int pos = atomicAdd(&p.cnt()[l * N_EXPERTS + me], 1);
      p.elist()[(long)me * NR + pos] = (int)a;
    }
  }
}
#endif

#ifndef CPU_TEST
#define XB_TMO      128
#define XB_XCNT(j)  (256  + 64 * (j))
#define XB_XSUB(j)  (1280 + 64 * (j))
#define XB_XGEN(j)  (2304 + 64 * (j))
#define XB_TOP      3328
#define XB_TOPGEN   3392
#define XCD_BAR_WORDS 3456
#define XB_SPIN_CAP (1u << 18)
#define LAS __attribute__((address_space(3)))
__device__ __forceinline__ unsigned xb_ld(unsigned* p)              { return __hip_atomic_load(p, __ATOMIC_RELAXED, __HIP_MEMORY_SCOPE_AGENT); }
__device__ __forceinline__ unsigned xb_add(unsigned* p, unsigned v) { return __hip_atomic_fetch_add(p, v, __ATOMIC_RELAXED, __HIP_MEMORY_SCOPE_AGENT); }
__device__ __forceinline__ unsigned xb_xcc_id() { return (unsigned)__builtin_amdgcn_s_getreg((3 << 11) | 20) & 0xFu; }
#define XB_SPIN(cond, bar) do { unsigned _sp = 0; while (cond) { __builtin_amdgcn_s_sleep(1); \
    if ((++_sp & 255u) == 0u) { if (xb_ld(&(bar)[XB_TMO])) break; if (_sp > XB_SPIN_CAP) { atomicAdd(&(bar)[XB_TMO], 1u); break; } } } } while (0)
struct XcdBarrier { unsigned* bar; unsigned x; volatile LAS unsigned* st; };
__device__ __forceinline__ XcdBarrier xcd_barrier_post(unsigned* bar, volatile LAS unsigned* st) {
    XcdBarrier b; b.bar = bar; b.x = xb_xcc_id(); b.st = st;
    if (threadIdx.x == 0) (void)xb_add(&bar[XB_XCNT(b.x)], 1u);
    return b;
}
__device__ __forceinline__ void xcd_barrier_complete(unsigned* bar, unsigned x, unsigned& nloc, unsigned& nx) {
    const unsigned G = gridDim.x * gridDim.y * gridDim.z;
    unsigned sum, cnt, mine, sp = 0u;
    for (;;) {
        sum = 0u; cnt = 0u; mine = 0u;
#pragma unroll
        for (unsigned j = 0; j < 16; ++j) { const unsigned c = xb_ld(&bar[XB_XCNT(j)]); sum += c; cnt += (c > 0u) ? 1u : 0u; mine = (j == x) ? c : mine; }
        if (sum == G) break;
        __builtin_amdgcn_s_sleep(1);
        if ((++sp & 255u) == 0u) { if (xb_ld(&bar[XB_TMO])) break; if (sp > XB_SPIN_CAP) { atomicAdd(&bar[XB_TMO], 1u); break; } }
    }
    nloc = mine > 0u ? mine : 1u; nx = cnt > 0u ? cnt : 1u;
}
__device__ __forceinline__ void xcd_barrier(const XcdBarrier& b) {
    asm volatile("s_waitcnt vmcnt(0)" ::: "memory");
    __syncthreads();
    if (threadIdx.x == 0) {
        unsigned* bar = b.bar;
        unsigned bx = b.x; asm volatile("" : "+s"(bx));
        __builtin_amdgcn_s_waitcnt(0);
        unsigned nloc = b.st[0], nx = b.st[1];
        if (nloc == 0u) { xcd_barrier_complete(bar, bx, nloc, nx); b.st[0] = nloc; b.st[1] = nx; }
        const unsigned old = xb_add(&bar[XB_XSUB(bx)], 1u);
        const unsigned gen = old / nloc;
        if (old + 1u == (gen + 1u) * nloc) {
            __builtin_amdgcn_fence(__ATOMIC_RELEASE, "agent");
            asm volatile("s_waitcnt vmcnt(0)" ::: "memory");
            const unsigned og = xb_add(&bar[XB_TOP], 1u);
            const unsigned tg = og / nx;
            if (og + 1u == (tg + 1u) * nx) xb_add(&bar[XB_TOPGEN], 1u);
            else XB_SPIN(xb_ld(&bar[XB_TOPGEN]) == tg, bar);
            __builtin_amdgcn_fence(__ATOMIC_ACQUIRE, "agent");
            xb_add(&bar[XB_XGEN(bx)], 1u);
            asm volatile("s_waitcnt vmcnt(0)" ::: "memory");
        } else {
            XB_SPIN(xb_ld(&bar[XB_XGEN(bx)]) == gen, bar);
            __builtin_amdgcn_fence(__ATOMIC_ACQUIRE, "agent");
            asm volatile("s_waitcnt vmcnt(0)" ::: "memory");
        }
    }
    __syncthreads();
}
#define GRID_SYNC() xcd_barrier(xb)
#else
#define GRID_SYNC() do {} while (0)
#endif

#ifndef CPU_TEST
#define GPUSEL(a, b) a
#else
#define GPUSEL(a, b) b
#endif
#ifndef CPU_TEST
#define OPAQUE_S(v) asm volatile("" : "+s"(v))
#define OPAQUE_V(v) asm volatile("" : "+v"(v))
#else
#define OPAQUE_S(v) do {} while (0)
#define OPAQUE_V(v) do {} while (0)
#endif
#ifndef PROBE_MASK
#define PROBE_MASK 0
#endif
#define LPHASE(stmt) do { int l = lo; OPAQUE_S(l); if (SINGLE && ((PROBE_MASK >> (ph - NG - lo * NLP)) & 1)) { long gtid = gtid0; OPAQUE_V(gtid); stmt; GRID_SYNC(); } PHASE(stmt); } while (0)
#define PHASE(stmt) do { if (SINGLE || ph == only) { long gtid = gtid0; OPAQUE_V(gtid); stmt; } if (SINGLE) { GRID_SYNC(); } ++ph; } while (0)
#ifndef CPU_TEST
template <bool SINGLE> __device__ __forceinline__ void run_seq(const P& p, long gtid0, long gsize, int only, const XcdBarrier& xb, char* smem)
#else
template <bool SINGLE> static int run_seq(const P& p, long gtid0, long gsize, int only)
#endif
{
  int ph = 0;
  PHASE(ph_g0(p, gtid, gsize));
  PHASE(ph_g1(p, gtid, gsize));
  PHASE(ph_g2(p, gtid, gsize));
  PHASE(ph_g3(p, gtid, gsize));
  PHASE(ph_g4(p, gtid, gsize));
#pragma unroll 1
  for (int lo = 0; lo < DEPTH; ++lo) {
    LPHASE(ph_modu(p, l, 0, gtid, gsize));
    LPHASE(GPUSEL(ph_proj_mfma(p, l, smem), ph_proj(p, l, gtid, gsize)));
    LPHASE(ph_post_proj(p, l, gtid, gsize));
    LPHASE(ph_mix(p, l, gtid, gsize); GPUSEL((ph_attn_mfma(p, l, smem), ph_hyena_mfma(p, l, smem)), (void)0));
    LPHASE(ph_s5out(p, l, gtid, gsize));
    LPHASE(GPUSEL(ph_glu_mfma(p, l, smem), ph_glu(p, l, gtid, gsize)));
    LPHASE(ph_rms(p, l, gtid, gsize));
    LPHASE(GPUSEL(ph_outproj_mfma(p, l, smem), ph_outproj(p, l, gtid, gsize)));
    LPHASE(ph_ln(p, l, 0, gtid, gsize));
    LPHASE(ph_router(p, l, gtid, gsize));
    LPHASE(ph_select(p, l, gtid, gsize));
    LPHASE(ph_sortrows(p, l, gtid, gsize));
    LPHASE(GPUSEL(ph_expert_up_mfma(p, l, smem), ph_expert_up(p, l, gtid, gsize)));
    LPHASE(GPUSEL(ph_expert_down_mfma(p, l, smem), ph_expert_down(p, l, gtid, gsize)));
    LPHASE(ph_combine(p, l, gtid, gsize));
    LPHASE(ph_ln(p, l, 1, gtid, gsize));
  }
#ifdef CPU_TEST
  return ph;
#endif
}


#ifndef CPU_TEST
#define NG_GPU 5
#define NLP_GPU 12
#ifndef PROBE_MASK_G
#define PROBE_MASK_G 0
#endif
#define GPHASE(stmt) do { if (SINGLE || ph == only) { long gtid = (long)blockIdx.x * NT + otid(); stmt; } if (SINGLE) { GRID_SYNC(); } ++ph; } while (0)
#define GLPHASE(stmt) do { int l = lo; OPAQUE_S(l); if (SINGLE && ((PROBE_MASK_G >> (ph - NG_GPU - lo * NLP_GPU)) & 1)) { long gtid = (long)blockIdx.x * NT + otid(); stmt; GRID_SYNC(); } GPHASE(stmt); } while (0)
template <bool SINGLE> __device__ __forceinline__ void run_seq_gpu(const P& p, long gtid0, long gsize, int only, const XcdBarrier& xb, char* smem) {
  int ph = 0;
#ifdef PROBE_INIT
  if (SINGLE) { long gtid = (long)blockIdx.x * NT + otid(); ph_g0(p, gtid, gsize); GRID_SYNC(); ph_g1(p, gtid, gsize); ph_modsum_gpu(p, gtid, gsize); ph_s5tables_gpu(p, gtid, gsize); GRID_SYNC(); ph_g2(p, gtid, gsize); ph_modu0_gpu(p, gtid, gsize); GRID_SYNC(); ph_g3(p, gtid, gsize); GRID_SYNC(); ph_g4(p, gtid, gsize); GRID_SYNC(); }
#endif
  GPHASE(ph_g0(p, gtid, gsize); s5_lampow_gpu(p, gtid, gsize); rope_table_gpu(p, gtid, gsize));
  GPHASE(ph_g1(p, gtid, gsize); ph_modsum_gpu(p, gtid, gsize); ph_s5tables_gpu(p, gtid, gsize); wt_convert_all(p, gtid, gsize));
  GPHASE(ph_g2(p, gtid, gsize); ph_modu0_gpu(p, gtid, gsize));
  GPHASE(ph_g3(p, gtid, gsize));
  GPHASE(ph_g4(p, gtid, gsize));
#pragma unroll 1
  for (int lo = 0; lo < DEPTH; ++lo) {
    GLPHASE(ph_proj_mfma(p, l, smem));
    GLPHASE(ph_s5_sgemm(p, l, smem); ph_hyena_pre_gpu(p, l, gtid, gsize));
    GLPHASE(ph_mix(p, l, gtid, gsize); ph_s5_carry_gpu(p, l, smem); ph_attn_mfma(p, l, smem); ph_hyena_mfma(p, l, smem));
    GLPHASE(ph_s5_ygemm(p, l, smem));
    GLPHASE(ph_glu_mfma(p, l, smem));
    GLPHASE(ph_outproj_mfma(p, l, smem));
    GLPHASE(ph_ln1_gpu(p, l));
    GLPHASE(ph_router_mfma(p, l, smem));
    GLPHASE(ph_select_gpu(p, l));
#ifdef UPVAR
    if (SINGLE) { int l = lo; OPAQUE_S(l); ph_expert_up_mfma<UPVAR>(p, l, smem); GRID_SYNC(); }
#endif
    GLPHASE(ph_expert_up_mfma(p, l, smem));
    GLPHASE(ph_expert_down_mfma(p, l, smem));
    GLPHASE(ph_ln2_gpu(p, l));
  }
}
#endif

static void carve(P& p, void* ws) { p.ws = (char*)ws; }
static void set_inputs(P& p, void* const* d_in) {
  const float** f = (const float**)&p.x;
  for (int i = 0; i < 40; ++i) f[i] = (const float*)d_in[i];
}

#ifndef CPU_TEST
#ifndef MK_SINGLE
#define MK_SINGLE 1
#endif
extern __shared__ __attribute__((aligned(16))) char dyn_smem[];
__global__ void __launch_bounds__(NT, 2) mk_single(P p) {
  uint4* xbw = (uint4*)(dyn_smem + SM_XB);
  if (threadIdx.x == 0) *xbw = make_uint4(0u, 0u, 0u, 0u);
  __syncthreads();
  XcdBarrier xb = xcd_barrier_post(p.bar(), (volatile LAS unsigned*)xbw);
  run_seq_gpu<true>(p, (long)blockIdx.x * blockDim.x + threadIdx.x, (long)gridDim.x * blockDim.x, -1, xb, dyn_smem);
}
__global__ void __launch_bounds__(NT, 2) mk_phase(P p, int only) {
  XcdBarrier xb; xb.bar = p.bar(); xb.x = 0; xb.st = nullptr;
#ifdef DBG_ONLY
  only = DBG_ONLY;
#endif
  run_seq_gpu<false>(p, (long)blockIdx.x * blockDim.x + threadIdx.x, (long)gridDim.x * blockDim.x, only, xb, dyn_smem);
}
extern "C" void kernel_launch(void* const* d_in, const int* in_sizes, int n_in, void* d_out, int out_size, void* d_ws, size_t ws_size, hipStream_t stream) {
  P p; memset(&p, 0, sizeof(p));
  set_inputs(p, d_in); p.out = (float*)d_out; carve(p, d_ws);
  (void)hipMemsetAsync(p.bar(), 0, 4096 * sizeof(unsigned) + ((DEPTH * N_EXPERTS * sizeof(int) + 255) / 256) * 256, stream);
#if MK_SINGLE
  static int grid = 0;
  if (!grid) {
    int dev = 0, cus = 0, per_cu = 0; (void)hipGetDevice(&dev);
    (void)hipDeviceGetAttribute(&cus, hipDeviceAttributeMultiprocessorCount, dev);
    (void)hipFuncSetAttribute((const void*)mk_single, hipFuncAttributeMaxDynamicSharedMemorySize, SMEM_BYTES);
    (void)hipOccupancyMaxActiveBlocksPerMultiprocessor(&per_cu, mk_single, NT, SMEM_BYTES);
    grid = cus * (per_cu < 1 ? per_cu : 1);
  }
  mk_single<<<grid, NT, SMEM_BYTES, stream>>>(p);
#else
  for (int ph = 0; ph < NG_GPU + DEPTH * NLP_GPU; ++ph) mk_phase<<<256, NT, SMEM_BYTES, stream>>>(p, ph);
#endif
}
#endif
```

```cpp
#ifndef CPU_TEST
#include <hip/hip_runtime.h>
#include <cstring>
#define DEV __device__ __forceinline__
#define DEVM __device__ __forceinline__
#define HDM __host__ __device__ __forceinline__
#else
#include <cmath>
#include <cstdio>
#include <cstdlib>
#include <cstring>
#define DEV static inline
#define DEVM inline
#define HDM inline
struct float2 { float x, y; };
static inline float2 make_float2(float a, float b) { float2 r; r.x = a; r.y = b; return r; }
static inline int atomicAdd(int* p, int v) { int o = *p; *p += v; return o; }
#endif

#ifdef SMALL_CFG
#define D_MODEL 64
#define BATCH 2
#define SEQ 256
#define GRID_W 16
#define CTX_LEN 32
#define HEAD_DIM 16
#define N_Q_HEADS 4
#define N_KV_HEADS 2
#define HYENA_W 16
#define S5_W 32
#define WINDOW 32
#define FILTER_HIDDEN 16
#define S5_STATE 8
#define N_EXPERTS 32
#define TOP_K 4
#define EXPERT_FF 16
#define SHARED_FF 16
#define S5_T 32
#else
#define D_MODEL 1024
#define BATCH 2
#define SEQ 8192
#define GRID_W 64
#define CTX_LEN 256
#define HEAD_DIM 64
#define N_Q_HEADS 8
#define N_KV_HEADS 2
#define HYENA_W 256
#define S5_W 256
#define WINDOW 128
#define FILTER_HIDDEN 64
#define S5_STATE 64
#define N_EXPERTS 256
#define TOP_K 8
#define EXPERT_FF 256
#define SHARED_FF 256
#define S5_T 64
#endif
#define DEPTH 2
#define FILTER_EMB 33
#define N_EXPERT_GROUPS 8
#define TOPK_GROUPS 4
#define S5_GROUP 16
#define Q_GROUP (N_Q_HEADS / N_KV_HEADS)
#define ATTN_W (N_Q_HEADS * HEAD_DIM)
#define KV_W (N_KV_HEADS * HEAD_DIM)
#define MIX_W (ATTN_W + HYENA_W + S5_W)
#define Q_OFF 0
#define K_OFF ATTN_W
#define V_OFF (K_OFF + KV_W)
#define HY_OFF (V_OFF + KV_W)
#define S5_OFF (HY_OFF + 3 * HYENA_W)
#define IN_W (S5_OFF + S5_W)
#define AXIS_DIM (HEAD_DIM / 2)
#define ROPE_HALF (AXIS_DIM / 2)
#define S5_GROUPS (S5_W / S5_GROUP)
#define EPG (N_EXPERTS / N_EXPERT_GROUPS)
#define NL (BATCH * SEQ)
#define NC (BATCH * CTX_LEN)
#define NR (NL + NC)
#define NSEQ (CTX_LEN + SEQ)
#define NCH (NSEQ / S5_T)
#define LN_EPS 1e-5f
#define DN_ALPHA 1.4142135623730951f
#define ROUTED_SCALE 2.5f
#define PI_D 3.14159265358979323846

#define WS_LIST(X) \
  X(unsigned, bar, 4096) \
  X(int, cnt, DEPTH * N_EXPERTS) \
  X(float, mod, (size_t)DEPTH * (BATCH + 1) * 6 * D_MODEL) \
  X(float, xcur, (size_t)NR * D_MODEL) \
  X(float, ubuf, (size_t)NR * D_MODEL) \
  X(float, proj, (size_t)NR * IN_W) \
  X(float, hu, (size_t)NR * HYENA_W) \
  X(float, hx0, (size_t)NR * HYENA_W) \
  X(float, fh1, (size_t)DEPTH * SEQ * FILTER_HIDDEN) \
  X(float, fh2, (size_t)DEPTH * SEQ * FILTER_HIDDEN) \
  X(float, kraw, (size_t)DEPTH * SEQ * 2 * HYENA_W) \
  X(float, knorm, (size_t)DEPTH * HYENA_W) \
  X(float, fh1c, (size_t)CTX_LEN * FILTER_HIDDEN) \
  X(float, fh2c, (size_t)CTX_LEN * FILTER_HIDDEN) \
  X(float, krawc, (size_t)CTX_LEN * 2 * HYENA_W) \
  X(float, knormc, (size_t)HYENA_W) \
  X(float, mixb, (size_t)NR * MIX_W) \
  X(float, tmp, (size_t)NR * D_MODEL) \
  X(float2, lampow, (size_t)DEPTH * 2 * S5_GROUPS * (S5_T + 1) * S5_STATE) \
  X(float2, bbar, (size_t)DEPTH * 2 * S5_GROUPS * S5_STATE * S5_GROUP) \
  X(float, kc, (size_t)DEPTH * 2 * S5_GROUPS * S5_T * S5_GROUP * S5_GROUP) \
  X(float2, sc, (size_t)BATCH * 2 * S5_GROUPS * NCH * S5_STATE) \
  X(float2, hc, (size_t)BATCH * 2 * S5_GROUPS * NCH * S5_STATE) \
  X(float, ybuf, (size_t)NR * S5_W) \
  X(float, rl, (size_t)NR * N_EXPERTS) \
  X(int, top_e, (size_t)NR * TOP_K) \
  X(float, gate, (size_t)NR * TOP_K) \
  X(int, posb, (size_t)NR * TOP_K) \
  X(int, srow, (size_t)NR * TOP_K) \
  X(float, hbuf, (size_t)NR * TOP_K * EXPERT_FF) \
  X(float, hsb, (size_t)NR * SHARED_FF) \
  X(float, yk, (size_t)NR * TOP_K * D_MODEL) \
  X(float, ysh, (size_t)NR * D_MODEL) \
  X(unsigned short, ykb, (size_t)NR * TOP_K * D_MODEL) \
  X(unsigned short, qkvb, (size_t)NR * HY_OFF) \
  X(float2, ropet, (size_t)128 * ROPE_HALF) \
  X(unsigned short, bmtb, (size_t)DEPTH * 2 * S5_GROUPS * 128 * 1024) \
  X(unsigned short, cmtb, (size_t)DEPTH * 2 * S5_GROUPS * 1024 * 128) \
  X(unsigned short, kcb, (size_t)DEPTH * 2 * S5_GROUPS * S5_T * 256) \
  X(unsigned short, wt_in, (size_t)DEPTH * IN_W * D_MODEL) \
  X(unsigned short, wt_out, (size_t)DEPTH * D_MODEL * MIX_W) \
  X(unsigned short, wt_glu, (size_t)DEPTH * S5_W * S5_W) \
  X(unsigned short, wt_shg, (size_t)DEPTH * SHARED_FF * D_MODEL) \
  X(unsigned short, wt_shu, (size_t)DEPTH * SHARED_FF * D_MODEL) \
  X(unsigned short, wt_shd, (size_t)DEPTH * D_MODEL * SHARED_FF) \
  X(unsigned short, wt_rh, (size_t)DEPTH * N_EXPERTS * D_MODEL) \
  X(unsigned short, wt_rl, (size_t)DEPTH * N_EXPERTS * D_MODEL) \
  X(unsigned short, ubf, (size_t)NR * D_MODEL) \
  X(unsigned short, ybf, (size_t)NR * S5_W) \
  X(unsigned short, mixbf, (size_t)NR * MIX_W) \
  X(unsigned short, hbf, (size_t)NR * TOP_K * EXPERT_FF) \
  X(unsigned short, hsbf, (size_t)NR * SHARED_FF) \
  X(unsigned short, ubl, (size_t)NR * D_MODEL) \
  X(int, elist, (size_t)N_EXPERTS * NR) \
  X(unsigned short, s5u, (size_t)NR * S5_W) \
  X(float, bmt, (size_t)DEPTH * 2 * S5_GROUPS * 16 * S5_T * 2 * S5_STATE) \
  X(float, cmt, (size_t)DEPTH * 2 * S5_GROUPS * 16 * S5_T * 2 * S5_STATE) \
  X(unsigned short, hcbf, (size_t)BATCH * 2 * S5_GROUPS * NCH * 2 * S5_STATE) \
  X(float, zT, (size_t)BATCH * 3 * HYENA_W * (SEQ + CTX_LEN)) \
  X(float, modp, (size_t)DEPTH * 16 * (BATCH + 1) * 6 * D_MODEL) \
  X(float, wrlo, (size_t)DEPTH * D_MODEL * N_EXPERTS) \

struct WsOff {
#define X(T, name, n) size_t name;
  WS_LIST(X)
#undef X
  size_t total;
};
constexpr WsOff ws_offsets() {
  WsOff o{}; size_t off = 0;
#define X(T, name, n) o.name = off; off += (((size_t)(n)) * sizeof(T) + 255) / 256 * 256;
  WS_LIST(X)
#undef X
  o.total = off; return o;
}
constexpr WsOff WSO = ws_offsets();
struct P {
  const float *x, *c, *ctx, *c_ctx, *w_ada, *b_ada, *w_in, *w_out, *sink, *mix_g, *hy_short_w, *hy_short_b, *hy_w1,
      *hy_b1, *hy_freq, *hy_w2, *hy_b2, *hy_w3, *hy_d, *s5_a_re, *s5_a_im, *s5_log_dt, *s5_b_re, *s5_b_im, *s5_c_re,
      *s5_c_im, *s5_d, *s5_w_glu, *ln1_g, *ln1_b, *ln2_g, *ln2_b, *w_router, *router_bias, *w_exp_gate, *w_exp_up,
      *w_exp_down, *w_sh_gate, *w_sh_up, *w_sh_down;
  float* out;
  char* ws;
#define X(T, name, n) HDM T* name() const { return (T*)(ws + WSO.name); }
  WS_LIST(X)
#undef X
};

#define FOR_ITEMS(i, N) for (long i = gtid; i < (long)(N); i += gsize)
#ifndef CPU_TEST
#define FOR_ITEMS4(i, N) _Pragma("unroll 4") for (long i = gtid; i < (long)(N); i += gsize)
#else
#define FOR_ITEMS4(i, N) FOR_ITEMS(i, N)
#endif

DEV unsigned short f2bf16(float f) { unsigned u; memcpy(&u, &f, 4); return (unsigned short)((u + 0x7fffu + ((u >> 16) & 1u)) >> 16); }
DEV float siluf(float x) { return x / (1.0f + expf(-x)); }
DEV float sigmoidf_(float x) { return 1.0f / (1.0f + expf(-x)); }
DEV float gelu_tanhf(float x) { return 0.5f * x * (1.0f + tanhf(0.7978845608028654f * (x + 0.044715f * x * x * x))); }
DEV int modrow(long r) { return r < NL ? (int)(r / SEQ) : BATCH; }

DEV void ph_g0(const P& p, long gtid, long gsize) {
#ifndef CPU_TEST
  FOR_ITEMS4(i4, (long)NR * D_MODEL / 4) { const long i = i4 * 4; *(float4*)(p.xcur() + i) = i < (long)NL * D_MODEL ? *(const float4*)(p.x + i) : *(const float4*)(p.ctx + (i - (long)NL * D_MODEL)); }
#else
  FOR_ITEMS(i, (long)NR * D_MODEL) p.xcur()[i] = i < (long)NL * D_MODEL ? p.x[i] : p.ctx[i - (long)NL * D_MODEL];
#endif
#ifdef CPU_TEST
  FOR_ITEMS(i, DEPTH * (BATCH + 1) * 6 * D_MODEL) {
    int n = (int)(i % (6 * D_MODEL)); int j = (int)((i / (6 * D_MODEL)) % (BATCH + 1)); int l = (int)(i / (6 * D_MODEL * (BATCH + 1)));
    const float* cv = j < BATCH ? p.c + j * D_MODEL : p.c_ctx;
    const float* w = p.w_ada + (long)l * D_MODEL * 6 * D_MODEL;
    float acc = p.b_ada[l * 6 * D_MODEL + n];
    for (int k = 0; k < D_MODEL; ++k) acc += siluf(cv[k]) * w[(long)k * 6 * D_MODEL + n];
    p.mod()[i] = acc;
  }
#else
  FOR_ITEMS(i, (long)DEPTH * 16 * 6 * D_MODEL) {
    const int n = (int)(i % (6 * D_MODEL)); const int slab = (int)((i / (6 * D_MODEL)) % 16); const int l = (int)(i / (6 * D_MODEL * 16));
    const float* w = p.w_ada + ((long)l * D_MODEL + slab * 64) * 6 * D_MODEL + n;
    float a0 = 0.f, a1 = 0.f, a2 = 0.f;
#pragma unroll 8
    for (int k = 0; k < 64; ++k) {
      const float wv = w[(long)k * 6 * D_MODEL]; const int kk = slab * 64 + k;
      a0 += siluf(p.c[kk]) * wv; a1 += siluf(p.c[D_MODEL + kk]) * wv; a2 += siluf(p.c_ctx[kk]) * wv;
    }
    float* dst = p.modp() + ((long)(l * 16 + slab) * (BATCH + 1)) * 6 * D_MODEL + n;
    dst[0] = a0; dst[6 * D_MODEL] = a1; dst[2 * 6 * D_MODEL] = a2;
  }
#endif
  FOR_ITEMS(i, DEPTH * 2 * S5_GROUPS * S5_STATE) {
    int pp = (int)(i % S5_STATE); int g = (int)((i / S5_STATE) % S5_GROUPS); int ld = (int)(i / (S5_STATE * S5_GROUPS));
    float are = fminf(p.s5_a_re[i], -1e-4f), aim = p.s5_a_im[i];
    float dt = expf(p.s5_log_dt[ld * S5_GROUPS + g]);
#ifdef CPU_TEST
    for (int d = 0; d <= S5_T; ++d) {
      float mag = expf(are * dt * d); float ang = aim * dt * d;
      p.lampow()[((long)(ld * S5_GROUPS + g) * (S5_T + 1) + d) * S5_STATE + pp] = make_float2(mag * cosf(ang), mag * sinf(ang));
    }
#endif
    float mag = expf(are * dt), ang = aim * dt;
    float lr = mag * cosf(ang) - 1.0f, li = mag * sinf(ang);
    float den = are * are + aim * aim;
    float fr = (lr * are + li * aim) / den, fi = (li * are - lr * aim) / den;
    for (int j = 0; j < S5_GROUP; ++j) {
      float br = p.s5_b_re[i * S5_GROUP + j], bi = p.s5_b_im[i * S5_GROUP + j];
      p.bbar()[i * S5_GROUP + j] = make_float2(fr * br - fi * bi, fr * bi + fi * br);
    }
  }
}
#ifndef CPU_TEST
DEV void rope_table_gpu(const P& p, long gtid, long gsize) {
  FOR_ITEMS(i, (long)128 * ROPE_HALF) {
    const int ii = (int)(i % ROPE_HALF), pos = (int)(i / ROPE_HALF);
    const float ang = (float)pos * powf(10000.0f, -(float)(2 * ii) / (float)AXIS_DIM);
    p.ropet()[i] = make_float2(cosf(ang), sinf(ang));
  }
}
DEV void s5_lampow_gpu(const P& p, long gtid, long gsize) {
  FOR_ITEMS4(i, (long)DEPTH * 2 * S5_GROUPS * (S5_T + 1) * S5_STATE) {
    const int pp = (int)(i % S5_STATE); const int d = (int)((i / S5_STATE) % (S5_T + 1)); const long ldg = i / ((long)S5_STATE * (S5_T + 1));
    const long src = ldg * S5_STATE + pp;
    const float are = fminf(p.s5_a_re[src], -1e-4f), aim = p.s5_a_im[src]; const float dt = expf(p.s5_log_dt[ldg]);
    const float mag = expf(are * dt * d); const float ang = aim * dt * d;
    p.lampow()[i] = make_float2(mag * cosf(ang), mag * sinf(ang));
  }
}
#endif
DEV void hy_f1(const P& p, int l, int Lf, float* h1, long gtid, long gsize) {
  FOR_ITEMS(i, (long)Lf * FILTER_HIDDEN) {
    int j = (int)(i % FILTER_HIDDEN); int t = (int)(i / FILTER_HIDDEN);
    const float* w1 = p.hy_w1 + l * FILTER_EMB * FILTER_HIDDEN;
    float tt = (float)((double)t / (double)(Lf - 1));
    float w = (float)(2.0 * PI_D * (double)t / (double)Lf);
    float acc = p.hy_b1[l * FILTER_HIDDEN + j] + tt * w1[j];
    const int bands = (FILTER_EMB - 1) / 2;
    for (int m = 0; m < bands; ++m) {
      float f = (float)(1e-4 + (double)m * ((double)(bands - 1) - 1e-4) / (double)(bands - 1));
      float a = f * w;
      acc += cosf(a) * w1[(1 + m) * FILTER_HIDDEN + j] - sinf(a) * w1[(1 + bands + m) * FILTER_HIDDEN + j];
    }
    h1[i] = sinf(p.hy_freq[l * FILTER_HIDDEN + j] * acc);
  }
}
DEV void hy_f2(const P& p, int l, int Lf, const float* h1, float* h2, long gtid, long gsize) {
  FOR_ITEMS(i, (long)Lf * FILTER_HIDDEN) {
    int j = (int)(i % FILTER_HIDDEN); int t = (int)(i / FILTER_HIDDEN);
    const float* w2 = p.hy_w2 + l * FILTER_HIDDEN * FILTER_HIDDEN;
    float acc = p.hy_b2[l * FILTER_HIDDEN + j];
    for (int k = 0; k < FILTER_HIDDEN; ++k) acc += h1[t * FILTER_HIDDEN + k] * w2[k * FILTER_HIDDEN + j];
#ifndef CPU_TEST
    h2[(long)j * Lf + t] = sinf(p.hy_freq[l * FILTER_HIDDEN + j] * acc);
#else
    h2[i] = sinf(p.hy_freq[l * FILTER_HIDDEN + j] * acc);
#endif
  }
}
DEV void hy_f3(const P& p, int l, int Lf, const float* h2, float* kraw, long gtid, long gsize) {
#ifndef CPU_TEST
  const float* w3 = p.hy_w3 + l * FILTER_HIDDEN * 2 * HYENA_W;
  FOR_ITEMS(i, (long)Lf * (2 * HYENA_W / 8)) {
    const int t = (int)(i % Lf); const int c8 = (int)(i / Lf) * 8;
    float acc[8];
#pragma unroll
    for (int j = 0; j < 8; ++j) acc[j] = 0.f;
#pragma unroll 4
    for (int k = 0; k < FILTER_HIDDEN; ++k) {
      const float hv = h2[(long)k * Lf + t];
      const float4 wa = *(const float4*)(w3 + k * 2 * HYENA_W + c8), wb = *(const float4*)(w3 + k * 2 * HYENA_W + c8 + 4);
      acc[0] += hv * wa.x; acc[1] += hv * wa.y; acc[2] += hv * wa.z; acc[3] += hv * wa.w; acc[4] += hv * wb.x; acc[5] += hv * wb.y; acc[6] += hv * wb.z; acc[7] += hv * wb.w;
    }
    const double d0 = log(1e-2) / 0.3, d1 = log(1e-2) / 1.5;
    const float tt = (float)((double)t / (double)(Lf - 1));
#pragma unroll
    for (int j = 0; j < 8; ++j) {
      const int ch = (c8 + j) % HYENA_W;
      const float delta = fabsf((float)(d0 + (d1 - d0) * (double)ch / (double)(HYENA_W - 1)));
      kraw[(long)(c8 + j) * Lf + t] = acc[j] * expf(-tt * delta);
    }
  }
#else
  FOR_ITEMS(i, (long)Lf * 2 * HYENA_W) {
    int t = (int)(i % Lf); int cc = (int)(i / Lf); int ch = cc % HYENA_W;
    const float* w3 = p.hy_w3 + l * FILTER_HIDDEN * 2 * HYENA_W;
    float acc = 0.f;
    for (int k = 0; k < FILTER_HIDDEN; ++k) acc += h2[t * FILTER_HIDDEN + k] * w3[k * 2 * HYENA_W + cc];
    double d0 = log(1e-2) / 0.3, d1 = log(1e-2) / 1.5;
    float delta = fabsf((float)(d0 + (d1 - d0) * (double)ch / (double)(HYENA_W - 1)));
    float tt = (float)((double)t / (double)(Lf - 1));
    kraw[(long)cc * Lf + t] = acc * expf(-tt * delta);
  }
#endif
}
DEV void hy_f4(int Lf, const float* kraw, float* knorm, long gtid, long gsize) {
#ifndef CPU_TEST
  const int lane = (int)(gtid & 63); const long gw = gtid >> 6, nw = gsize >> 6;
  for (long i = gw; i < HYENA_W; i += nw) {
    float s = 0.f;
    for (int t = lane; t < Lf; t += 64) { s += fabsf(kraw[i * Lf + t]); if (t > 0) s += fabsf(kraw[(HYENA_W + i) * Lf + t]); }
    for (int o = 32; o > 0; o >>= 1) s += __shfl_xor(s, o);
    if (lane == 0) knorm[i] = 1.0f / s;
  }
#else
  FOR_ITEMS(i, HYENA_W) {
    float s = 0.f;
    for (int t = 0; t < Lf; ++t) {
      s += fabsf(kraw[(long)i * Lf + t]);
      if (t > 0) s += fabsf(kraw[(long)(HYENA_W + i) * Lf + t]);
    }
    knorm[i] = 1.0f / s;
  }
#endif
}
DEV void ph_g1(const P& p, long gtid, long gsize) {
  for (int l = 0; l < DEPTH; ++l) hy_f1(p, l, SEQ, p.fh1() + (long)l * SEQ * FILTER_HIDDEN, gtid, gsize);
  hy_f1(p, 0, CTX_LEN, p.fh1c(), gtid, gsize);
  FOR_ITEMS(i, (long)DEPTH * 2 * S5_GROUPS * S5_T * S5_GROUP * S5_GROUP) {
    int j = (int)(i % S5_GROUP); int ii = (int)((i / S5_GROUP) % S5_GROUP); int d = (int)((i / (S5_GROUP * S5_GROUP)) % S5_T);
    long ldg = i / (S5_GROUP * S5_GROUP * S5_T);
    float acc = 0.f;
    for (int pp = 0; pp < S5_STATE; ++pp) {
      float cr = p.s5_c_re[(ldg * S5_GROUP + ii) * S5_STATE + pp], ci = p.s5_c_im[(ldg * S5_GROUP + ii) * S5_STATE + pp];
      float2 lp = p.lampow()[(ldg * (S5_T + 1) + d) * S5_STATE + pp];
      float2 bb = p.bbar()[(ldg * S5_STATE + pp) * S5_GROUP + j];
      float tr = lp.x * bb.x - lp.y * bb.y, ti = lp.x * bb.y + lp.y * bb.x;
      acc += cr * tr - ci * ti;
    }
    p.kc()[i] = acc;
  }
}
DEV void ph_g2(const P& p, long gtid, long gsize) {
  for (int l = 0; l < DEPTH; ++l) hy_f2(p, l, SEQ, p.fh1() + (long)l * SEQ * FILTER_HIDDEN, p.fh2() + (long)l * SEQ * FILTER_HIDDEN, gtid, gsize);
  hy_f2(p, 0, CTX_LEN, p.fh1c(), p.fh2c(), gtid, gsize);
}
DEV void ph_g3(const P& p, long gtid, long gsize) {
  for (int l = 0; l < DEPTH; ++l) hy_f3(p, l, SEQ, p.fh2() + (long)l * SEQ * FILTER_HIDDEN, p.kraw() + (long)l * SEQ * 2 * HYENA_W, gtid, gsize);
  hy_f3(p, 0, CTX_LEN, p.fh2c(), p.krawc(), gtid, gsize);
}
DEV void ph_g4(const P& p, long gtid, long gsize) {
  for (int l = 0; l < DEPTH; ++l) hy_f4(SEQ, p.kraw() + (long)l * SEQ * 2 * HYENA_W, p.knorm() + l * HYENA_W, gtid, gsize);
  hy_f4(CTX_LEN, p.krawc(), p.knormc(), gtid, gsize);
}
#define NG 5

DEV void ph_modu(const P& p, int l, int which, long gtid, long gsize) {
  FOR_ITEMS(i, (long)NR * D_MODEL) {
    int k = (int)(i % D_MODEL); long r = i / D_MODEL;
    const float* m = p.mod() + ((long)l * (BATCH + 1) + modrow(r)) * 6 * D_MODEL + which * 3 * D_MODEL;
    float uv = p.xcur()[i] * (1.0f + m[D_MODEL + k]) + m[k];
    p.ubuf()[i] = uv; p.ubf()[i] = f2bf16(uv);
  }
}
template <class Epi>
DEV void gemm_naive(const float* A, int lda, const float* B, int ldb, int M, int N, int K, Epi epi, long gtid, long gsize) {
  FOR_ITEMS(i, (long)(M / 4) * N) {
    int n = (int)(i % N); long r0 = (i / N) * 4;
    const float* a0 = A + r0 * lda;
    float c0 = 0.f, c1 = 0.f, c2 = 0.f, c3 = 0.f;
    for (int k = 0; k < K; ++k) {
      float b = B[(long)k * ldb + n];
      c0 += a0[k] * b; c1 += a0[lda + k] * b; c2 += a0[2 * lda + k] * b; c3 += a0[3 * lda + k] * b;
    }
    epi(r0, n, c0); epi(r0 + 1, n, c1); epi(r0 + 2, n, c2); epi(r0 + 3, n, c3);
  }
}
struct EpiStore { float* C; int ldc; DEVM void operator()(long r, int n, float v) const { C[r * ldc + n] = v; } };
DEV void ph_proj(const P& p, int l, long gtid, long gsize) {
  EpiStore e{p.proj(), IN_W};
  gemm_naive(p.ubuf(), D_MODEL, p.w_in + (long)l * D_MODEL * IN_W, IN_W, NR, IN_W, D_MODEL, e, gtid, gsize);
}
DEV long s5_row(int b, int dir, int n) {
  if (n < CTX_LEN) return (long)NL + b * CTX_LEN + (dir ? CTX_LEN - 1 - n : n);
  int t = n - CTX_LEN; return (long)b * SEQ + (dir ? SEQ - 1 - t : t);
}
DEV void ph_post_proj(const P& p, int l, long gtid, long gsize) {
  FOR_ITEMS(i, (long)NL * (N_Q_HEADS + N_KV_HEADS) * 2 * ROPE_HALF) {
    int ii = (int)(i % ROPE_HALF); int a = (int)((i / ROPE_HALF) % 2); int hs = (int)((i / (2 * ROPE_HALF)) % (N_Q_HEADS + N_KV_HEADS));
    long r = i / (2 * ROPE_HALF * (N_Q_HEADS + N_KV_HEADS));
    int t = (int)(r % SEQ); int pos = a == 0 ? t / GRID_W : t % GRID_W;
    float inv = powf(10000.0f, -(float)(2 * ii) / (float)AXIS_DIM);
    float ang = (float)pos * inv; float cs = cosf(ang), sn = sinf(ang);
    float* q = p.proj() + r * IN_W + hs * HEAD_DIM + a * AXIS_DIM + ii;
    float x1 = q[0], x2 = q[ROPE_HALF];
    q[0] = x1 * cs - x2 * sn; q[ROPE_HALF] = x1 * sn + x2 * cs;
  }
#ifdef CPU_TEST
  FOR_ITEMS(i, (long)NR * HYENA_W) {
    int ch = (int)(i % HYENA_W); long r = i / HYENA_W;
    int Ls = r < NL ? SEQ : CTX_LEN; long base = r < NL ? (r / SEQ) * SEQ : NL + ((r - NL) / CTX_LEN) * CTX_LEN; int t = (int)(r - base);
    const float* sw = p.hy_short_w + l * 3 * 3 * HYENA_W; const float* sb = p.hy_short_b + l * 3 * HYENA_W;
    float z[3];
#pragma unroll
    for (int part = 0; part < 3; ++part) {
      int cc = part * HYENA_W + ch; float acc = sb[cc];
#pragma unroll
      for (int j = 0; j < 3; ++j) { int tt = t + j - 1; if (tt >= 0 && tt < Ls) acc += p.proj()[(base + tt) * IN_W + HY_OFF + cc] * sw[j * 3 * HYENA_W + cc]; }
      z[part] = acc;
    }
    long o = r < NL ? ((r / SEQ) * HYENA_W + ch) * SEQ + t : i;
    p.hu()[o] = z[0] * z[1]; p.hx0()[o] = z[2];
  }
#endif
#ifndef CPU_TEST
  FOR_ITEMS(i, (long)NR * S5_W) { long r = i / S5_W; int cc = (int)(i % S5_W); p.s5u()[i] = f2bf16(p.proj()[r * IN_W + S5_OFF + cc]); }
#endif
#ifdef CPU_TEST
  FOR_ITEMS(i, (long)BATCH * 2 * S5_GROUPS * NCH * S5_STATE) {
    int pp = (int)(i % S5_STATE); int c = (int)((i / S5_STATE) % NCH); int g = (int)((i / (S5_STATE * NCH)) % S5_GROUPS);
    int dir = (int)((i / (S5_STATE * NCH * S5_GROUPS)) % 2); int b = (int)(i / (S5_STATE * NCH * S5_GROUPS * 2));
    long ldg = ((long)l * 2 + dir) * S5_GROUPS + g;
    float sr = 0.f, si = 0.f;
    for (int s = 0; s < S5_T; ++s) {
      const float* u = p.proj() + s5_row(b, dir, c * S5_T + s) * IN_W + S5_OFF + g * S5_GROUP;
      float br = 0.f, bi = 0.f;
#pragma unroll
      for (int j = 0; j < S5_GROUP; ++j) { float2 bb = p.bbar()[(ldg * S5_STATE + pp) * S5_GROUP + j]; br += bb.x * u[j]; bi += bb.y * u[j]; }
      float2 lp = p.lampow()[(ldg * (S5_T + 1) + (S5_T - 1 - s)) * S5_STATE + pp];
      sr += lp.x * br - lp.y * bi; si += lp.x * bi + lp.y * br;
    }
    p.sc()[i] = make_float2(sr, si);
  }
#endif
}
DEV void attn_item(const P& p, int l, long r, int h, float* outp) {
  const float scale = 1.0f / sqrtf((float)HEAD_DIM);
  float q[HEAD_DIM], acc[HEAD_DIM];
  const float* qp = p.proj() + r * IN_W + Q_OFF + h * HEAD_DIM;
#pragma unroll
  for (int d = 0; d < HEAD_DIM; ++d) { q[d] = qp[d] * scale; acc[d] = 0.f; }
  int kvh = h / Q_GROUP; int b = r < NL ? (int)(r / SEQ) : (int)((r - NL) / CTX_LEN);
  float m = -1e30f, lsum = 0.f;
  int nwin = 0, t = 0;
  if (r < NL) { t = (int)(r % SEQ); nwin = 2 * WINDOW + 1; }
  for (int j = 0; j < nwin + CTX_LEN; ++j) {
    long kr;
    if (j < nwin) { int tk = t - WINDOW + j; if (tk < 0 || tk >= SEQ) continue; kr = (long)b * SEQ + tk; }
    else kr = (long)NL + b * CTX_LEN + (j - nwin);
    const float* kp = p.proj() + kr * IN_W + K_OFF + kvh * HEAD_DIM; const float* vp = p.proj() + kr * IN_W + V_OFF + kvh * HEAD_DIM;
    float s = 0.f;
#pragma unroll
    for (int d = 0; d < HEAD_DIM; ++d) s += q[d] * kp[d];
    float mn = fmaxf(m, s); float corr = expf(m - mn); float pe = expf(s - mn);
    lsum = lsum * corr + pe;
#pragma unroll
    for (int d = 0; d < HEAD_DIM; ++d) acc[d] = acc[d] * corr + pe * vp[d];
    m = mn;
  }
  float sk = p.sink[l * N_Q_HEADS + h]; float mf = fmaxf(m, sk); float corr = expf(m - mf);
  float den = lsum * corr + expf(sk - mf); float sc2 = corr / den;
#pragma unroll
  for (int d = 0; d < HEAD_DIM; ++d) outp[d] = acc[d] * sc2;
}
DEV void ph_mix(const P& p, int l, long gtid, long gsize) {
#ifdef CPU_TEST
  long nrows_att = l == 0 ? NR : NL;
  FOR_ITEMS(i, nrows_att * N_Q_HEADS) { int h = (int)(i % N_Q_HEADS); long r = i / N_Q_HEADS; attn_item(p, l, r, h, p.mixb() + r * MIX_W + h * HEAD_DIM); }
#endif
#ifdef CPU_TEST
  FOR_ITEMS(i, (long)NL * HYENA_W) {
    int ch = (int)(i % HYENA_W); long r = i / HYENA_W; int t = (int)(r % SEQ); int b = (int)(r / SEQ);
    const float* kf = p.kraw() + ((long)l * 2 * HYENA_W + ch) * SEQ; const float* kb = p.kraw() + ((long)l * 2 * HYENA_W + HYENA_W + ch) * SEQ;
    const float* uu = p.hu() + ((long)b * HYENA_W + ch) * SEQ;
    float acc = 0.f;
    for (int s = 0; s <= t; ++s) acc += kf[t - s] * uu[s];
    for (int s = t + 1; s < SEQ; ++s) acc += kb[s - t] * uu[s];
    p.mixb()[r * MIX_W + ATTN_W + ch] = (acc * p.knorm()[l * HYENA_W + ch] + uu[t] * p.hy_d[l * HYENA_W + ch]) * p.hx0()[((long)b * HYENA_W + ch) * SEQ + t];
  }
#endif
  if (l == 0) {
#ifndef CPU_TEST
    FOR_ITEMS(i, (long)NC * HYENA_W) {
      const int t = (int)(i % CTX_LEN); const int ch = (int)((i / CTX_LEN) % HYENA_W); const int b = (int)(i / ((long)CTX_LEN * HYENA_W));
      const long base = (long)NL + (long)b * CTX_LEN; const long r = base + t;
      const float* kf = p.krawc() + (long)ch * CTX_LEN; const float* kb = p.krawc() + (long)(HYENA_W + ch) * CTX_LEN;
      float acc = 0.f;
#pragma unroll 8
      for (int sidx = 0; sidx < CTX_LEN; ++sidx) {
        const int d = t - sidx; const float kv = d >= 0 ? kf[d] : kb[-d];
        acc += kv * p.hu()[(base + sidx) * HYENA_W + ch];
      }
      const float u = p.hu()[r * HYENA_W + ch];
      p.mixb()[r * MIX_W + ATTN_W + ch] = (acc * p.knormc()[ch] + u * p.hy_d[l * HYENA_W + ch]) * p.hx0()[r * HYENA_W + ch];
    }
#else
    FOR_ITEMS(i, (long)NC * HYENA_W) {
      int ch = (int)(i % HYENA_W); long r = NL + i / HYENA_W; int t = (int)((r - NL) % CTX_LEN); long base = r - t;
      float acc = 0.f;
      for (int s = 0; s <= t; ++s) acc += p.krawc()[(long)ch * CTX_LEN + (t - s)] * p.hu()[(base + s) * HYENA_W + ch];
      for (int s = t + 1; s < CTX_LEN; ++s) acc += p.krawc()[(long)(HYENA_W + ch) * CTX_LEN + (s - t)] * p.hu()[(base + s) * HYENA_W + ch];
      float u = p.hu()[r * HYENA_W + ch];
      p.mixb()[r * MIX_W + ATTN_W + ch] = (acc * p.knormc()[ch] + u * p.hy_d[l * HYENA_W + ch]) * p.hx0()[r * HYENA_W + ch];
    }
#endif
  }
#ifdef CPU_TEST
  FOR_ITEMS(i, (long)BATCH * 2 * S5_GROUPS * S5_STATE) {
    int pp = (int)(i % S5_STATE); int g = (int)((i / S5_STATE) % S5_GROUPS); int dir = (int)((i / (S5_STATE * S5_GROUPS)) % 2); int b = (int)(i / (S5_STATE * S5_GROUPS * 2));
    long ldg = ((long)l * 2 + dir) * S5_GROUPS + g;
    float2 lt = p.lampow()[(ldg * (S5_T + 1) + S5_T) * S5_STATE + pp];
    float hr = 0.f, hi = 0.f;
    long base = (((long)b * 2 + dir) * S5_GROUPS + g) * NCH;
#ifndef CPU_TEST
    static_assert(NCH % 12 == 0, "carry batching");
    for (int c0 = 0; c0 < NCH; c0 += 12) {
      float2 sv[12];
#pragma unroll
      for (int k = 0; k < 12; ++k) sv[k] = p.sc()[(base + c0 + k) * S5_STATE + pp];
#pragma unroll
      for (int k = 0; k < 12; ++k) {
        p.hcbf()[(base + c0 + k) * 2 * S5_STATE + pp] = f2bf16(hr); p.hcbf()[(base + c0 + k) * 2 * S5_STATE + S5_STATE + pp] = f2bf16(hi);
        const float nr = lt.x * hr - lt.y * hi + sv[k].x, ni = lt.x * hi + lt.y * hr + sv[k].y;
        hr = nr; hi = ni;
      }
    }
#else
    for (int c = 0; c < NCH; ++c) {
      p.hc()[(base + c) * S5_STATE + pp] = make_float2(hr, hi);
      float2 s = p.sc()[(base + c) * S5_STATE + pp];
      float nr = lt.x * hr - lt.y * hi + s.x, ni = lt.x * hi + lt.y * hr + s.y;
      hr = nr; hi = ni;
    }
#endif
  }
#endif
}
DEV void ph_s5out(const P& p, int l, long gtid, long gsize) {
  FOR_ITEMS(i, (long)NR * S5_W) {
    int chn = (int)(i % S5_W); long r = i / S5_W; int g = chn / S5_GROUP, ii = chn % S5_GROUP;
    int b, tl; bool isctx = r >= NL;
    if (isctx) { b = (int)((r - NL) / CTX_LEN); tl = (int)((r - NL) % CTX_LEN); } else { b = (int)(r / SEQ); tl = (int)(r % SEQ); }
    float y = p.s5_d[l * S5_W + chn] * p.proj()[r * IN_W + S5_OFF + chn];
    for (int dir = 0; dir < 2; ++dir) {
      int n = isctx ? (dir ? CTX_LEN - 1 - tl : tl) : CTX_LEN + (dir ? SEQ - 1 - tl : tl);
      int c = n / S5_T, tau = n % S5_T;
      long ldg = ((long)l * 2 + dir) * S5_GROUPS + g;
      long hb = ((((long)b * 2 + dir) * S5_GROUPS + g) * NCH + c) * S5_STATE;
      for (int pp = 0; pp < S5_STATE; ++pp) {
        float cr = p.s5_c_re[(ldg * S5_GROUP + ii) * S5_STATE + pp], ci = p.s5_c_im[(ldg * S5_GROUP + ii) * S5_STATE + pp];
        float2 lp = p.lampow()[(ldg * (S5_T + 1) + tau + 1) * S5_STATE + pp]; float2 h = p.hc()[hb + pp];
        float tr = lp.x * h.x - lp.y * h.y, ti = lp.x * h.y + lp.y * h.x;
        y += cr * tr - ci * ti;
      }
      for (int s = 0; s <= tau; ++s) {
        const float* u = p.proj() + s5_row(b, dir, c * S5_T + s) * IN_W + S5_OFF + g * S5_GROUP;
        const float* kk = p.kc() + ((ldg * S5_T + (tau - s)) * S5_GROUP + ii) * S5_GROUP;
#pragma unroll
        for (int j = 0; j < S5_GROUP; ++j) y += kk[j] * u[j];
      }
    }
    float gy = gelu_tanhf(y); p.ybuf()[i] = gy; p.ybf()[i] = f2bf16(gy);
  }
}
struct EpiGlu { const float* g; float* mixb; DEVM void operator()(long r, int n, float v) const { mixb[r * MIX_W + ATTN_W + HYENA_W + n] = g[r * S5_W + n] * sigmoidf_(v); } };
DEV void ph_glu(const P& p, int l, long gtid, long gsize) {
  EpiGlu e{p.ybuf(), p.mixb()};
  gemm_naive(p.ybuf(), S5_W, p.s5_w_glu + (long)l * S5_W * S5_W, S5_W, NR, S5_W, S5_W, e, gtid, gsize);
}
DEV void ph_rms(const P& p, int l, long gtid, long gsize) {
  FOR_ITEMS(i, (long)NR * 3) {
    int grp = (int)(i % 3); long r = i / 3;
    int off = grp == 0 ? 0 : (grp == 1 ? ATTN_W : ATTN_W + HYENA_W); int w = grp == 0 ? ATTN_W : (grp == 1 ? HYENA_W : S5_W);
    float* v = p.mixb() + r * MIX_W + off; float ss = 0.f;
    for (int k = 0; k < w; ++k) ss += v[k] * v[k];
    float rs = 1.0f / sqrtf(ss / (float)w + LN_EPS);
    for (int k = 0; k < w; ++k) { float nv = v[k] * rs * p.mix_g[l * MIX_W + off + k]; v[k] = nv; p.mixbf()[r * MIX_W + off + k] = f2bf16(nv); }
  }
}
struct EpiRes { const float* xcur; const float* mod; int l; int goff; float* tmp;
  DEVM void operator()(long r, int n, float v) const { const float* m = mod + ((long)l * (BATCH + 1) + modrow(r)) * 6 * D_MODEL + goff; tmp[r * D_MODEL + n] = DN_ALPHA * xcur[r * D_MODEL + n] + m[n] * v; } };
DEV void ph_outproj(const P& p, int l, long gtid, long gsize) {
  EpiRes e{p.xcur(), p.mod(), l, 2 * D_MODEL, p.tmp()};
  gemm_naive(p.mixb(), MIX_W, p.w_out + (long)l * MIX_W * D_MODEL, D_MODEL, NR, D_MODEL, MIX_W, e, gtid, gsize);
}
DEV void ph_ln(const P& p, int l, int which, long gtid, long gsize) {
  const float* gw = (which == 0 ? p.ln1_g : p.ln2_g) + l * D_MODEL; const float* bw = (which == 0 ? p.ln1_b : p.ln2_b) + l * D_MODEL;
  FOR_ITEMS(r, (long)NR) {
    const float* v = p.tmp() + r * D_MODEL; float mu = 0.f;
#pragma unroll 4
    for (int k = 0; k < D_MODEL; ++k) mu += v[k];
    mu /= (float)D_MODEL; float var = 0.f;
#pragma unroll 4
    for (int k = 0; k < D_MODEL; ++k) { float d = v[k] - mu; var += d * d; }
    float rs = 1.0f / sqrtf(var / (float)D_MODEL + LN_EPS);
    const float* m = p.mod() + ((long)l * (BATCH + 1) + modrow(r)) * 6 * D_MODEL + 3 * D_MODEL;
#pragma unroll 2
    for (int k = 0; k < D_MODEL; ++k) {
      float y = (v[k] - mu) * rs * gw[k] + bw[k];
      p.xcur()[r * D_MODEL + k] = y;
      if (which == 0) { float uv = y * (1.0f + m[D_MODEL + k]) + m[k]; p.ubuf()[r * D_MODEL + k] = uv; p.ubf()[r * D_MODEL + k] = f2bf16(uv); }
      if (which == 1 && l == DEPTH - 1 && r < NL) p.out[r * D_MODEL + k] = y;
    }
  }
}
DEV void ph_router(const P& p, int l, long gtid, long gsize) {
  EpiStore e{p.rl(), N_EXPERTS};
  gemm_naive(p.ubuf(), D_MODEL, p.w_router + (long)l * D_MODEL * N_EXPERTS, N_EXPERTS, NR, N_EXPERTS, D_MODEL, e, gtid, gsize);
}
DEV bool better(float v, int i, float bv, int bi) { return v > bv || (v == bv && i < bi); }
DEV void ph_select(const P& p, int l, long gtid, long gsize) {
  FOR_ITEMS(r, (long)NR) {
    const float* lg = p.rl() + r * N_EXPERTS; const float* rb = p.router_bias + l * N_EXPERTS;
    float gs[N_EXPERT_GROUPS];
#pragma unroll
    for (int g = 0; g < N_EXPERT_GROUPS; ++g) {
      float m1 = -1e30f, m2 = -1e30f;
      for (int e = 0; e < EPG; ++e) { float v = sigmoidf_(lg[g * EPG + e]) + rb[g * EPG + e]; if (v > m1) { m2 = m1; m1 = v; } else if (v > m2) m2 = v; }
      gs[g] = m1 + m2;
    }
    unsigned keep = 0;
#pragma unroll
    for (int it = 0; it < TOPK_GROUPS; ++it) {
      float bv = -1e30f; int bi = -1;
#pragma unroll
      for (int g = 0; g < N_EXPERT_GROUPS; ++g) if (!((keep >> g) & 1u) && (bi < 0 || gs[g] > bv)) { bv = gs[g]; bi = g; }
      keep |= 1u << bi;
    }
    float lastv = 1e30f; int lasti = -1; float gsum = 0.f;
    for (int it = 0; it < TOP_K; ++it) {
      float bv = -1e30f; int bi = -1;
      for (int e = 0; e < N_EXPERTS; ++e) {
        if (!((keep >> (e / EPG)) & 1u)) continue;
        float v = sigmoidf_(lg[e]) + rb[e];
        if (!better(lastv, lasti, v, e)) continue;
        if (bi < 0 || better(v, e, bv, bi)) { bv = v; bi = e; }
      }
      lastv = bv; lasti = bi;
      float sc = sigmoidf_(lg[bi]); gsum += sc;
      p.top_e()[r * TOP_K + it] = bi; p.gate()[r * TOP_K + it] = sc;
      p.posb()[r * TOP_K + it] = atomicAdd(&p.cnt()[l * N_EXPERTS + bi], 1);
    }
    float inv = ROUTED_SCALE / gsum;
    for (int it = 0; it < TOP_K; ++it) p.gate()[r * TOP_K + it] *= inv;
  }
}
DEV void ph_sortrows(const P& p, int l, long gtid, long gsize) {
  FOR_ITEMS(i, (long)NR * TOP_K) {
    int e = p.top_e()[i]; int off = 0;
    for (int j = 0; j < e; ++j) off += p.cnt()[l * N_EXPERTS + j];
    p.srow()[off + p.posb()[i]] = (int)i;
  }
}
DEV void ph_expert_up(const P& p, int l, long gtid, long gsize) {
  FOR_ITEMS(i, (long)NR * TOP_K * EXPERT_FF) {
    int cidx = (int)(i % EXPERT_FF); int a = p.srow()[i / EXPERT_FF]; int e = p.top_e()[a]; long r = a / TOP_K;
    const float* xg = p.ubuf() + r * D_MODEL;
    const float* wg = p.w_exp_gate + ((long)l * N_EXPERTS + e) * D_MODEL * EXPERT_FF; const float* wu = p.w_exp_up + ((long)l * N_EXPERTS + e) * D_MODEL * EXPERT_FF;
    float g = 0.f, u = 0.f;
    for (int k = 0; k < D_MODEL; ++k) { float xv = xg[k]; g += xv * wg[(long)k * EXPERT_FF + cidx]; u += xv * wu[(long)k * EXPERT_FF + cidx]; }
    p.hbuf()[(long)a * EXPERT_FF + cidx] = siluf(g) * u;
  }
  FOR_ITEMS(i, (long)NR * SHARED_FF) {
    int cidx = (int)(i % SHARED_FF); long r = i / SHARED_FF;
    const float* xg = p.ubuf() + r * D_MODEL;
    const float* wg = p.w_sh_gate + (long)l * D_MODEL * SHARED_FF; const float* wu = p.w_sh_up + (long)l * D_MODEL * SHARED_FF;
    float g = 0.f, u = 0.f;
    for (int k = 0; k < D_MODEL; ++k) { float xv = xg[k]; g += xv * wg[(long)k * SHARED_FF + cidx]; u += xv * wu[(long)k * SHARED_FF + cidx]; }
    p.hsb()[i] = siluf(g) * u;
  }
}
DEV void ph_expert_down(const P& p, int l, long gtid, long gsize) {
  FOR_ITEMS(i, (long)NR * TOP_K * D_MODEL) {
    int d = (int)(i % D_MODEL); long a = i / D_MODEL;
    int e = p.top_e()[a]; const float* wd = p.w_exp_down + ((long)l * N_EXPERTS + e) * EXPERT_FF * D_MODEL;
    const float* h = p.hbuf() + a * EXPERT_FF; float acc = 0.f;
    for (int cidx = 0; cidx < EXPERT_FF; ++cidx) acc += h[cidx] * wd[(long)cidx * D_MODEL + d];
    p.yk()[i] = acc * p.gate()[a];
  }
  FOR_ITEMS(i, (long)NR * D_MODEL) {
    int d = (int)(i % D_MODEL); long r = i / D_MODEL;
    const float* wsd = p.w_sh_down + (long)l * SHARED_FF * D_MODEL; const float* hs = p.hsb() + r * SHARED_FF;
    float acc = 0.f;
    for (int cidx = 0; cidx < SHARED_FF; ++cidx) acc += hs[cidx] * wsd[(long)cidx * D_MODEL + d];
    p.ysh()[i] = acc;
  }
}
DEV void ph_combine(const P& p, int l, long gtid, long gsize) {
#pragma unroll 1
  FOR_ITEMS(i, (long)NR * D_MODEL) {
    int d = (int)(i % D_MODEL); long r = i / D_MODEL;
    float f = p.ysh()[i];
#pragma unroll
    for (int k = 0; k < TOP_K; ++k) f += p.yk()[(r * TOP_K + k) * D_MODEL + d];
    const float* m = p.mod() + ((long)l * (BATCH + 1) + modrow(r)) * 6 * D_MODEL + 5 * D_MODEL;
    p.tmp()[i] = DN_ALPHA * p.xcur()[i] + m[d] * f;
  }
}
#define NLP 16


#ifndef CPU_TEST
typedef __attribute__((ext_vector_type(8))) short bf16x8;
typedef __attribute__((ext_vector_type(4))) float f32x4;
typedef __attribute__((ext_vector_type(4))) unsigned u32x4;
typedef __attribute__((ext_vector_type(2))) unsigned u32x2;
static_assert(N_EXPERTS == 256 && D_MODEL % 128 == 0 && NR % 128 == 0, "shape assumptions");
#define SM_XB 0
#define NT 512
#define SM_A 256
#define SM_B (256 + 16384)
#define SM_MISC (256 + 98304)
#define SMEM_BYTES (256 + 98304 + 4096)

DEV int otid() { int t = threadIdx.x; asm volatile("" : "+v"(t)); return t; }
typedef __bf16 bf16x2_t __attribute__((ext_vector_type(2)));
typedef float f32x2_t __attribute__((ext_vector_type(2)));
DEV unsigned pack2(float a, float b) { f32x2_t v = {a, b}; return __builtin_bit_cast(unsigned, __builtin_convertvector(v, bf16x2_t)); }
DEV unsigned f2bf(float f) { return pack2(f, 0.f) & 0xffffu; }
DEV int tile_off(int row, int chunk) { return row * 128 + ((chunk ^ ((row >> 1) & 7)) << 4); }

DEV float bflo(float x) { return x - __uint_as_float(f2bf(x) << 16); }
DEV void wt_convert(const float* W, unsigned short* WT, int K, int N, bool lo, long gtid, long gsize) {
  FOR_ITEMS4(i, (long)N * (K / 8)) {
    const int n = (int)(i % N); const int k8 = (int)(i / N) * 8;
    float v[8];
#pragma unroll
    for (int j = 0; j < 8; ++j) { const float x = W[(long)(k8 + j) * N + n]; v[j] = lo ? bflo(x) : x; }
    u32x4 o; o[0] = pack2(v[0], v[1]); o[1] = pack2(v[2], v[3]); o[2] = pack2(v[4], v[5]); o[3] = pack2(v[6], v[7]);
    *(u32x4*)(WT + (long)n * K + k8) = o;
  }
}
DEV void wt_convert_all(const P& p, long gtid, long gsize) {
  for (int l = 0; l < DEPTH; ++l) {
    wt_convert(p.w_in + (long)l * D_MODEL * IN_W, p.wt_in() + (long)l * IN_W * D_MODEL, D_MODEL, IN_W, false, gtid, gsize);
    wt_convert(p.w_out + (long)l * MIX_W * D_MODEL, p.wt_out() + (long)l * D_MODEL * MIX_W, MIX_W, D_MODEL, false, gtid, gsize);
    wt_convert(p.s5_w_glu + (long)l * S5_W * S5_W, p.wt_glu() + (long)l * S5_W * S5_W, S5_W, S5_W, false, gtid, gsize);
    wt_convert(p.w_sh_gate + (long)l * D_MODEL * SHARED_FF, p.wt_shg() + (long)l * SHARED_FF * D_MODEL, D_MODEL, SHARED_FF, false, gtid, gsize);
    wt_convert(p.w_sh_up + (long)l * D_MODEL * SHARED_FF, p.wt_shu() + (long)l * SHARED_FF * D_MODEL, D_MODEL, SHARED_FF, false, gtid, gsize);
    wt_convert(p.w_sh_down + (long)l * SHARED_FF * D_MODEL, p.wt_shd() + (long)l * D_MODEL * SHARED_FF, SHARED_FF, D_MODEL, false, gtid, gsize);
    wt_convert(p.w_router + (long)l * D_MODEL * N_EXPERTS, p.wt_rh() + (long)l * N_EXPERTS * D_MODEL, D_MODEL, N_EXPERTS, false, gtid, gsize);
    wt_convert(p.w_router + (long)l * D_MODEL * N_EXPERTS, p.wt_rl() + (long)l * N_EXPERTS * D_MODEL, D_MODEL, N_EXPERTS, true, gtid, gsize);
  }
}
struct ALRows { const char* base; unsigned off[2]; DEVM const unsigned short* a(int i, int kt) const { return (const unsigned short*)(base + (off[i] + (unsigned)kt * 128u)); } };
struct BLStd { static constexpr bool TR = false; const char* base; unsigned voff; int ldb4; bool valid;
  DEVM void load(float4 (&rb)[8], int kt) const {
#pragma unroll
    for (int i = 0; i < 8; ++i) rb[i] = valid ? *(const float4*)(base + (unsigned)((unsigned)(kt * 64 + i) * (unsigned)ldb4 + voff)) : make_float4(0.f, 0.f, 0.f, 0.f); } };
DEV unsigned bl_voff(int ldb4, int tid) { return (unsigned)((tid & 7) * 8) * (unsigned)ldb4 + (unsigned)((tid >> 3) * 16); }
DEV BLStd mk_bl(const float* B  , int ldb, int tid) {
  BLStd b; b.base = (const char*)B; b.ldb4 = ldb * 4; b.voff = bl_voff(ldb * 4, tid); b.valid = true; return b; }
#define SM_TILE 49152
template <int V = 0, class AL, class BL>
DEV void gemm_t(const AL& al, const BL& bl, int nk, f32x4 (&acc)[4][4], char* smem) {
  const int tid = otid(), lane = tid & 63, wid = tid >> 6, wr = wid >> 2, wc = wid & 3;
  const int l15 = lane & 15, q = lane >> 4, x = l15 >> 1;
  const char* ard0 = smem + SM_A + (wr * 64 + l15) * 128 + ((q ^ x) << 4);
  const char* ard1 = smem + SM_A + (wr * 64 + l15) * 128 + (((4 + q) ^ x) << 4);
  const char* brd0 = smem + SM_B + (wc * 64 + l15) * 128 + ((q ^ x) << 4);
  const char* brd1 = smem + SM_B + (wc * 64 + l15) * 128 + (((4 + q) ^ x) << 4);
  const int kq = tid & 7, nq = tid >> 3;
  char* awr = smem + SM_A + nq * 128 + ((kq ^ ((nq >> 1) & 7)) << 4);
  char* bwr0 = smem + SM_B + (nq * 4) * 128 + ((kq ^ ((2 * nq) & 7)) << 4);
  char* bwr1 = smem + SM_B + (nq * 4 + 2) * 128 + ((kq ^ ((2 * nq + 1) & 7)) << 4);
  if (nk <= 0) return;
  u32x4 ra[2]; float4 rb0[8];
#define GEMM_LOADA(KT) do { _Pragma("unroll") for (int i = 0; i < 2; ++i) ra[i] = *(const u32x4*)(al.a(i, (KT))); } while (0)
#define GEMM_WRITE(rb, PO) do { \
    *(u32x4*)(awr + (PO)) = ra[0]; *(u32x4*)(awr + (PO) + 8192) = ra[1]; \
    if (BL::TR) { u32x4 v; \
      v[0] = pack2(rb[0].x, rb[0].y); v[1] = pack2(rb[0].z, rb[0].w); v[2] = pack2(rb[1].x, rb[1].y); v[3] = pack2(rb[1].z, rb[1].w); *(u32x4*)(bwr0 + (PO)) = v; \
      v[0] = pack2(rb[2].x, rb[2].y); v[1] = pack2(rb[2].z, rb[2].w); v[2] = pack2(rb[3].x, rb[3].y); v[3] = pack2(rb[3].z, rb[3].w); *(u32x4*)(bwr0 + (PO) + 128) = v; \
      v[0] = pack2(rb[4].x, rb[4].y); v[1] = pack2(rb[4].z, rb[4].w); v[2] = pack2(rb[5].x, rb[5].y); v[3] = pack2(rb[5].z, rb[5].w); *(u32x4*)(bwr1 + (PO)) = v; \
      v[0] = pack2(rb[6].x, rb[6].y); v[1] = pack2(rb[6].z, rb[6].w); v[2] = pack2(rb[7].x, rb[7].y); v[3] = pack2(rb[7].z, rb[7].w); *(u32x4*)(bwr1 + (PO) + 128) = v; \
    } else { u32x4 v; \
      v[0] = pack2(rb[0].x, rb[1].x); v[1] = pack2(rb[2].x, rb[3].x); v[2] = pack2(rb[4].x, rb[5].x); v[3] = pack2(rb[6].x, rb[7].x); *(u32x4*)(bwr0 + (PO)) = v; \
      v[0] = pack2(rb[0].y, rb[1].y); v[1] = pack2(rb[2].y, rb[3].y); v[2] = pack2(rb[4].y, rb[5].y); v[3] = pack2(rb[6].y, rb[7].y); *(u32x4*)(bwr0 + (PO) + 128) = v; \
      v[0] = pack2(rb[0].z, rb[1].z); v[1] = pack2(rb[2].z, rb[3].z); v[2] = pack2(rb[4].z, rb[5].z); v[3] = pack2(rb[6].z, rb[7].z); *(u32x4*)(bwr1 + (PO)) = v; \
      v[0] = pack2(rb[0].w, rb[1].w); v[1] = pack2(rb[2].w, rb[3].w); v[2] = pack2(rb[4].w, rb[5].w); v[3] = pack2(rb[6].w, rb[7].w); *(u32x4*)(bwr1 + (PO) + 128) = v; \
    } } while (0)
  GEMM_LOADA(0);
  bl.load(rb0, 0);
  __syncthreads();
  GEMM_WRITE(rb0, 0);
  if (V != 3) { if (nk > 1) { GEMM_LOADA(1); bl.load(rb0, 1); } }
  __syncthreads();
#define GEMM_STEP(rbn, KT) do { \
    const int po = ((KT) & 1) * SM_TILE; \
    bf16x8 fa0[4], fb0[4], fa1[4], fb1[4]; \
    _Pragma("unroll") for (int n = 0; n < 4; ++n) fb0[n] = *(const bf16x8*)(brd0 + po + n * 2048); \
    _Pragma("unroll") for (int m = 0; m < 4; ++m) fa0[m] = *(const bf16x8*)(ard0 + po + m * 2048); \
    _Pragma("unroll") for (int n = 0; n < 4; ++n) fb1[n] = *(const bf16x8*)(brd1 + po + n * 2048); \
    _Pragma("unroll") for (int m = 0; m < 4; ++m) fa1[m] = *(const bf16x8*)(ard1 + po + m * 2048); \
    __builtin_amdgcn_sched_barrier(0);     \
    if ((KT) + 1 < nk) { \
      GEMM_WRITE(rbn, SM_TILE - po); \
      if (V != 3) { if ((KT) + 2 < nk) { GEMM_LOADA((KT) + 2); bl.load(rbn, (KT) + 2); } } \
    } \
    __builtin_amdgcn_sched_barrier(0); \
    if (V != 2) { \
      _Pragma("unroll") for (int m = 0; m < 4; ++m) _Pragma("unroll") for (int n = 0; n < 4; ++n) acc[m][n] = __builtin_amdgcn_mfma_f32_16x16x32_bf16(fa0[m], fb0[n], acc[m][n], 0, 0, 0); \
      _Pragma("unroll") for (int m = 0; m < 4; ++m) _Pragma("unroll") for (int n = 0; n < 4; ++n) acc[m][n] = __builtin_amdgcn_mfma_f32_16x16x32_bf16(fa1[m], fb1[n], acc[m][n], 0, 0, 0); \
    } else { _Pragma("unroll") for (int m = 0; m < 4; ++m) asm volatile("" :: "v"(fa0[m]), "v"(fb0[m]), "v"(fa1[m]), "v"(fb1[m])); } \
    __syncthreads(); \
  } while (0)
  int kt = 0;
#pragma unroll 1
  for (; kt < nk; ++kt) { GEMM_STEP(rb0, kt); }
#undef GEMM_STEP
#undef GEMM_WRITE
#undef GEMM_LOADA
}

struct BLT { const char* base; unsigned voff; unsigned rowb;
  DEVM void load(u32x4 (&rb)[4], int kt) const {
#pragma unroll
    for (int c = 0; c < 4; ++c) rb[c] = *(const u32x4*)(base + (voff + (unsigned)c * rowb + (unsigned)kt * 128u)); } };
DEV BLT mk_blt(const unsigned short* BT  , int K, int tid) {
  BLT b; b.base = (const char*)BT; b.rowb = (unsigned)K * 2u; b.voff = (unsigned)((tid >> 3) * 4) * b.rowb + (unsigned)((tid & 7) * 16); return b; }
template <class AL, class BL>
DEV void gemm_tb(const AL& al, const BL& bl, int nk, f32x4 (&acc)[4][4], char* smem) {
  const int tid = otid(), lane = tid & 63, wid = tid >> 6, wr = wid >> 2, wc = wid & 3;
  const int l15 = lane & 15, q = lane >> 4, x = l15 >> 1;
  const char* ard0 = smem + SM_A + (wr * 64 + l15) * 128 + ((q ^ x) << 4);
  const char* ard1 = smem + SM_A + (wr * 64 + l15) * 128 + (((4 + q) ^ x) << 4);
  const char* brd0 = smem + SM_B + (wc * 64 + l15) * 128 + ((q ^ x) << 4);
  const char* brd1 = smem + SM_B + (wc * 64 + l15) * 128 + (((4 + q) ^ x) << 4);
  const int kq = tid & 7, nq = tid >> 3;
  char* awr = smem + SM_A + nq * 128 + ((kq ^ ((nq >> 1) & 7)) << 4);
  char* bwr0 = smem + SM_B + (nq * 4) * 128 + ((kq ^ ((2 * nq) & 7)) << 4);
  char* bwr1 = smem + SM_B + (nq * 4 + 2) * 128 + ((kq ^ ((2 * nq + 1) & 7)) << 4);
  if (nk <= 0) return;
  u32x4 ra[2]; u32x4 rb0[4], rb1[4];
#define TB_LOADA(KT) do { _Pragma("unroll") for (int i = 0; i < 2; ++i) ra[i] = *(const u32x4*)(al.a(i, (KT))); } while (0)
#define TB_WRITE(rb, PO) do { \
    *(u32x4*)(awr + (PO)) = ra[0]; *(u32x4*)(awr + (PO) + 8192) = ra[1]; \
    *(u32x4*)(bwr0 + (PO)) = rb[0]; *(u32x4*)(bwr0 + (PO) + 128) = rb[1]; *(u32x4*)(bwr1 + (PO)) = rb[2]; *(u32x4*)(bwr1 + (PO) + 128) = rb[3]; } while (0)
  TB_LOADA(0);
  bl.load(rb0, 0);
  if (nk > 1) bl.load(rb1, 1);
  __syncthreads();
  TB_WRITE(rb0, 0);
  if (nk > 1) TB_LOADA(1);
  if (nk > 2) bl.load(rb0, 2);
  __syncthreads();
#define TB_STEP(rbn, KT) do { \
    const int po = ((KT) & 1) * SM_TILE; \
    bf16x8 fa0[4], fb0[4], fa1[4], fb1[4]; \
    _Pragma("unroll") for (int n = 0; n < 4; ++n) fb0[n] = *(const bf16x8*)(brd0 + po + n * 2048); \
    _Pragma("unroll") for (int m = 0; m < 4; ++m) fa0[m] = *(const bf16x8*)(ard0 + po + m * 2048); \
    _Pragma("unroll") for (int n = 0; n < 4; ++n) fb1[n] = *(const bf16x8*)(brd1 + po + n * 2048); \
    _Pragma("unroll") for (int m = 0; m < 4; ++m) fa1[m] = *(const bf16x8*)(ard1 + po + m * 2048); \
    __builtin_amdgcn_sched_barrier(0); \
    if ((KT) + 1 < nk) { \
      TB_WRITE(rbn, SM_TILE - po); \
      if ((KT) + 2 < nk) TB_LOADA((KT) + 2); \
      if ((KT) + 3 < nk) bl.load(rbn, (KT) + 3); \
    } \
    __builtin_amdgcn_sched_barrier(0); \
    _Pragma("unroll") for (int m = 0; m < 4; ++m) _Pragma("unroll") for (int n = 0; n < 4; ++n) acc[m][n] = __builtin_amdgcn_mfma_f32_16x16x32_bf16(fa0[m], fb0[n], acc[m][n], 0, 0, 0); \
    _Pragma("unroll") for (int m = 0; m < 4; ++m) _Pragma("unroll") for (int n = 0; n < 4; ++n) acc[m][n] = __builtin_amdgcn_mfma_f32_16x16x32_bf16(fa1[m], fb1[n], acc[m][n], 0, 0, 0); \
    __syncthreads(); \
  } while (0)
  int kt = 0;
#pragma unroll 1
  for (; kt + 1 < nk; kt += 2) { TB_STEP(rb1, kt); TB_STEP(rb0, kt + 1); }
  if (kt < nk) TB_STEP(rb1, kt);
#undef TB_STEP
#undef TB_WRITE
#undef TB_LOADA
}
DEV void acc_zero(f32x4 (&acc)[4][4]) {
#pragma unroll
  for (int m = 0; m < 4; ++m)
#pragma unroll
    for (int n = 0; n < 4; ++n) acc[m][n] = (f32x4){0.f, 0.f, 0.f, 0.f};
}
#define EPI_BEGIN const int etid = otid();
#define EPI_ROW(m, j) (((etid >> 8) & 1) * 64 + (m) * 16 + ((etid & 63) >> 4) * 4 + (j))
#define EPI_COL(n) (((etid >> 6) & 3) * 64 + (n) * 16 + (etid & 15))

template <class Epi>
DEV void gemm_phase_dense(const unsigned short* A, int lda, const unsigned short* BT, int N, int K, Epi epi, char* smem) {
  const int tid = otid(); const int nct = N >> 8; const int nitems = (NR >> 7) * nct;
  for (int it = blockIdx.x; it < nitems; it += gridDim.x) {
    const int rt = it / nct, ct = it - rt * nct;
    ALRows al; al.base = (const char*)(A + (long)rt * 128 * lda);
#pragma unroll
    for (int i = 0; i < 2; ++i) al.off[i] = (unsigned)(((tid >> 3) + 64 * i) * lda + (tid & 7) * 8) * 2u;
    const BLT bl = mk_blt(BT + (long)ct * 256 * K, K, tid);
    f32x4 acc[4][4]; acc_zero(acc);
    gemm_tb(al, bl, K >> 6, acc, smem);
    EPI_BEGIN
#pragma unroll
    for (int m = 0; m < 4; ++m)
#pragma unroll
      for (int n = 0; n < 4; ++n)
#pragma unroll
        for (int j = 0; j < 4; ++j) epi((long)rt * 128 + EPI_ROW(m, j), ct * 256 + EPI_COL(n), acc[m][n][j]);
  }
}
DEV void ph_proj_mfma(const P& p, int l, char* smem) {
  const int tid = otid(); const int nct = IN_W >> 8; const int nitems = (NR >> 7) * nct;
  const float* B = p.w_in + (long)l * D_MODEL * IN_W;
  for (int it = blockIdx.x; it < nitems; it += gridDim.x) {
    const int rt = it / nct, ct = it - rt * nct;
    ALRows al; al.base = (const char*)(p.ubf() + (long)rt * 128 * D_MODEL);
#pragma unroll
    for (int i = 0; i < 2; ++i) al.off[i] = (unsigned)(((tid >> 3) + 64 * i) * D_MODEL + (tid & 7) * 8) * 2u;
    const BLT bl = mk_blt(p.wt_in() + ((long)l * IN_W + ct * 256) * D_MODEL, D_MODEL, tid);
    f32x4 acc[4][4]; acc_zero(acc);
    gemm_tb(al, bl, D_MODEL >> 6, acc, smem);
    EPI_BEGIN
    if (ct >= HY_OFF / 256 && ct < S5_OFF / 256) {
      const bool isctx = rt >= NL / 128;
      const int rloc = (isctx ? (rt - NL / 128) : rt) * 128;
      const int Ls = isctx ? CTX_LEN : SEQ; const int b = rloc / Ls; const int t0 = rloc - b * Ls;
      float* zb = p.zT() + (isctx ? (size_t)BATCH * 3 * HYENA_W * SEQ : (size_t)0) + (size_t)b * 3 * HYENA_W * Ls;
#pragma unroll
      for (int m = 0; m < 4; ++m)
#pragma unroll
        for (int n = 0; n < 4; ++n) {
          const int c = ct * 256 + EPI_COL(n) - HY_OFF; const int t = t0 + EPI_ROW(m, 0);
          *(float4*)(zb + (size_t)c * Ls + t) = make_float4(acc[m][n][0], acc[m][n][1], acc[m][n][2], acc[m][n][3]);
        }
    } else if (ct == S5_OFF / 256) {
#pragma unroll
      for (int m = 0; m < 4; ++m)
#pragma unroll
        for (int n = 0; n < 4; ++n)
#pragma unroll
          for (int j = 0; j < 4; ++j) p.s5u()[((long)rt * 128 + EPI_ROW(m, j)) * S5_W + EPI_COL(n)] = (unsigned short)f2bf(acc[m][n][j]);
    } else {
      const int head = ct * 4 + ((etid >> 6) & 3);
      const bool isq = head < N_Q_HEADS, dorope = head < N_Q_HEADS + N_KV_HEADS && rt < NL / 128;
      const float qs = isq ? 0.125f * 1.4426950408889634f : 1.0f;
      const int c16 = etid & 15;
#pragma unroll
      for (int m = 0; m < 4; ++m)
#pragma unroll
        for (int j = 0; j < 4; ++j) {
          const long row = (long)rt * 128 + EPI_ROW(m, j);
          float v0 = acc[m][0][j], v1 = acc[m][1][j], v2 = acc[m][2][j], v3 = acc[m][3][j];
          if (dorope) {
            const int t = (int)(row % SEQ);
            const float2 cr = p.ropet()[(t / GRID_W) * ROPE_HALF + c16], cc = p.ropet()[(t % GRID_W) * ROPE_HALF + c16];
            const float a0 = v0 * cr.x - v1 * cr.y, a1 = v0 * cr.y + v1 * cr.x, a2 = v2 * cc.x - v3 * cc.y, a3 = v2 * cc.y + v3 * cc.x;
            v0 = a0; v1 = a1; v2 = a2; v3 = a3;
          }
          unsigned short* dst = p.qkvb() + row * HY_OFF + head * HEAD_DIM + c16;
          dst[0] = (unsigned short)f2bf(v0 * qs); dst[16] = (unsigned short)f2bf(v1 * qs); dst[32] = (unsigned short)f2bf(v2 * qs); dst[48] = (unsigned short)f2bf(v3 * qs);
        }
    }
  }
}
DEV void ph_hyena_pre_gpu(const P& p, int l, long gtid, long gsize) {
  const float* sw = p.hy_short_w + l * 3 * 3 * HYENA_W; const float* sb = p.hy_short_b + l * 3 * HYENA_W;
  FOR_ITEMS(i, (long)BATCH * HYENA_W * (SEQ + CTX_LEN)) {
    const bool isctx = i >= (long)BATCH * HYENA_W * SEQ; const long ii = isctx ? i - (long)BATCH * HYENA_W * SEQ : i;
    const int Ls = isctx ? CTX_LEN : SEQ; const int t = (int)(ii % Ls); const int ch = (int)((ii / Ls) % HYENA_W); const int b = (int)(ii / ((long)Ls * HYENA_W));
    const float* zb = p.zT() + (isctx ? (size_t)BATCH * 3 * HYENA_W * SEQ : (size_t)0) + (size_t)b * 3 * HYENA_W * Ls;
    float z[3];
#pragma unroll
    for (int part = 0; part < 3; ++part) {
      const int cc = part * HYENA_W + ch; const float* zr = zb + (size_t)cc * Ls; float acc = sb[cc];
      if (t > 0) acc += zr[t - 1] * sw[cc];
      acc += zr[t] * sw[3 * HYENA_W + cc];
      if (t + 1 < Ls) acc += zr[t + 1] * sw[2 * 3 * HYENA_W + cc];
      z[part] = acc;
    }
    const long o = isctx ? ((long)NL + b * CTX_LEN + t) * HYENA_W + ch : ((long)b * HYENA_W + ch) * SEQ + t;
    p.hu()[o] = z[0] * z[1]; p.hx0()[o] = z[2];
  }
}
DEV void rms_rows(const P& p, int l, long r0, long r1, int w0, int nw);
DEV void ph_glu_mfma(const P& p, int l, char* smem) {
  const int tid = otid();
  for (int rt = blockIdx.x; rt < (NR >> 7); rt += gridDim.x) {
    ALRows al; al.base = (const char*)(p.ybf() + (long)rt * 128 * S5_W);
#pragma unroll
    for (int i = 0; i < 2; ++i) al.off[i] = (unsigned)(((tid >> 3) + 64 * i) * S5_W + (tid & 7) * 8) * 2u;
    const BLT bl = mk_blt(p.wt_glu() + (long)l * S5_W * S5_W, S5_W, tid);
    f32x4 acc[4][4]; acc_zero(acc);
    gemm_tb(al, bl, S5_W >> 6, acc, smem);
    EPI_BEGIN
#pragma unroll
    for (int m = 0; m < 4; ++m)
#pragma unroll
      for (int n = 0; n < 4; ++n)
#pragma unroll
        for (int j = 0; j < 4; ++j) {
          const long r = (long)rt * 128 + EPI_ROW(m, j); const int c = EPI_COL(n);
          p.mixb()[r * MIX_W + ATTN_W + HYENA_W + c] = __uint_as_float((unsigned)p.ybf()[r * S5_W + c] << 16) * sigmoidf_(acc[m][n][j]);
        }
    asm volatile("s_waitcnt vmcnt(0)" ::: "memory");
    __syncthreads();
    rms_rows(p, l, (long)rt * 128, (long)rt * 128 + 128, otid() >> 6, NT / 64);
  }
}
DEV void ph_outproj_mfma(const P& p, int l, char* smem) {
  EpiRes e{p.xcur(), p.mod(), l, 2 * D_MODEL, p.tmp()};
  gemm_phase_dense(p.mixbf(), MIX_W, p.wt_out() + (long)l * D_MODEL * MIX_W, D_MODEL, MIX_W, e, smem);
}
DEV void exp_prefix(const P& p, int l, int* toff, int* roff) {
  const int tid = otid(), lane = tid & 63, w = tid >> 6;
  __syncthreads();
  int c = 0, tl = 0, incl = 0;
  int* wsum = roff + N_EXPERTS + 8;
  if (tid < N_EXPERTS) {
    c = p.cnt()[l * N_EXPERTS + tid];
    tl = (c + 127) >> 7; incl = tl;
#pragma unroll
    for (int o = 1; o < 64; o <<= 1) { const int v = __shfl_up(incl, o); if (lane >= o) incl += v; }
    if (lane == 63) wsum[w] = incl;
    roff[tid] = c;
  }
  __syncthreads();
  if (tid < N_EXPERTS) {
    int base = 0;
#pragma unroll
    for (int k = 0; k < 4; ++k) if (k < w) base += wsum[k];
    toff[tid] = base + incl - tl;
    if (tid == N_EXPERTS - 1) toff[N_EXPERTS] = base + incl;
  }
  __syncthreads();
}
DEV int exp_find(const int* toff, int tile) {
  int lo = 0, hi = N_EXPERTS - 1;
  while (lo < hi) { int mid = (lo + hi + 1) >> 1; if (toff[mid] <= tile) lo = mid; else hi = mid - 1; }
  return lo;
}
template <int V = 0>
DEV void upgate_tile(const ALRows& al, const float* wg, const float* wu, int cq, f32x4 (&acc)[4][4], char* smem, int tid) {
  const int nq = tid >> 3; const int wsel = __builtin_amdgcn_readfirstlane(tid >> 6) & 1;
  BLStd bl; bl.base = (const char*)((wsel ? wu : wg) + cq * 128); bl.ldb4 = EXPERT_FF * 4; bl.valid = true;
  bl.voff = (unsigned)((tid & 7) * 8) * (unsigned)(EXPERT_FF * 4) + (unsigned)(((nq >> 4) * 32 + (nq & 7) * 4) * 4);
  acc_zero(acc);
  gemm_t<V>(al, bl, D_MODEL >> 6, acc, smem);
}
static_assert(EXPERT_FF == 256 && SHARED_FF == 256, "ff tiling");
template <int V = 0>
DEV void ph_expert_up_mfma(const P& p, int l, char* smem) {
  const int tid = otid(), lane = tid & 63, wc = (tid >> 6) & 3;
  int* toff = (int*)(smem + SM_MISC); int* roff = toff + N_EXPERTS + 1;
  exp_prefix(p, l, toff, roff);
  const int n_items = toff[N_EXPERTS] * 2;
  for (int it = blockIdx.x; it < n_items; it += gridDim.x) {
    const int tile = it >> 1, cq = it & 1;
    const int e = __builtin_amdgcn_readfirstlane(exp_find(toff, tile)); const int j0 = (tile - toff[e]) * 128;
    const int nrows = min(128, roff[e] - j0), rbase = e * NR + j0;
    const float* wg = p.w_exp_gate + ((long)l * N_EXPERTS + e) * D_MODEL * EXPERT_FF; const float* wu = p.w_exp_up + ((long)l * N_EXPERTS + e) * D_MODEL * EXPERT_FF;
    ALRows al; al.base = (const char*)p.ubf();
#pragma unroll
    for (int i = 0; i < 2; ++i) { const int rl = min((tid >> 3) + 64 * i, nrows - 1); al.off[i] = ((unsigned)(p.elist()[rbase + rl] / TOP_K) * D_MODEL + (tid & 7) * 8) * 2u; }
    f32x4 acc[4][4];
    upgate_tile<V>(al, wg, wu, cq, acc, smem, tid);
    EPI_BEGIN
    const int elane = etid & 63, ewc = (etid >> 6) & 3;
#pragma unroll
    for (int m = 0; m < 4; ++m)
#pragma unroll
      for (int j = 0; j < 4; ++j) {
        const int rl = EPI_ROW(m, j);
        if (rl < nrows) {
          { unsigned short* dst = p.hbf() + (long)p.elist()[rbase + rl] * EXPERT_FF + cq * 128 + ewc * 32 + (elane & 15);
            dst[0] = (unsigned short)f2bf(siluf(acc[m][0][j]) * acc[m][2][j]); dst[16] = (unsigned short)f2bf(siluf(acc[m][1][j]) * acc[m][3][j]); }
        }
      }
  }
}
DEV void ph_expert_down_mfma(const P& p, int l, char* smem) {
  const int tid = otid();
  int* toff = (int*)(smem + SM_MISC); int* roff = toff + N_EXPERTS + 1;
  exp_prefix(p, l, toff, roff);
  const int NCT = D_MODEL / 256;
  const int n_exp_items = toff[N_EXPERTS] * NCT;
  const int n_sh_items = (NR >> 7) * NCT;
  for (int it = blockIdx.x; it < n_exp_items + n_sh_items; it += gridDim.x) {
    const bool shared = it >= n_exp_items;
    int ct, nrows, rbase, e = 0; const float* wd;
    if (!shared) {
      const int tile = it / NCT; ct = it - tile * NCT;
      e = __builtin_amdgcn_readfirstlane(exp_find(toff, tile)); const int j0 = (tile - toff[e]) * 128;
      nrows = min(128, roff[e] - j0); rbase = e * NR + j0;
      wd = p.w_exp_down + ((long)l * N_EXPERTS + e) * EXPERT_FF * D_MODEL;
    } else {
      const int it2 = it - n_exp_items; const int rt = it2 / NCT; ct = it2 - rt * NCT;
      nrows = 128; rbase = rt * 128; wd = p.w_sh_down + (long)l * SHARED_FF * D_MODEL;
    }
    ALRows al; al.base = (const char*)(shared ? p.hsbf() : p.hbf());
#pragma unroll
    for (int i = 0; i < 2; ++i) {
      const int rl = min((tid >> 3) + 64 * i, nrows - 1);
      const unsigned a = shared ? (unsigned)(rbase + rl) : (unsigned)p.elist()[rbase + rl];
      al.off[i] = (a * EXPERT_FF + (tid & 7) * 8) * 2u;
    }
    const BLStd bl = mk_bl(wd + ct * 256, D_MODEL, tid);
    f32x4 acc[4][4]; acc_zero(acc);
    gemm_t(al, bl, EXPERT_FF >> 6, acc, smem);
    EPI_BEGIN
#pragma unroll
    for (int m = 0; m < 4; ++m)
#pragma unroll
      for (int j = 0; j < 4; ++j) {
        const int rl = EPI_ROW(m, j);
        if (rl < nrows) {
          if (shared) {
            float* dst = p.ysh() + (long)(rbase + rl) * D_MODEL;
#pragma unroll
            for (int n = 0; n < 4; ++n) dst[ct * 256 + EPI_COL(n)] = acc[m][n][j];
          } else {
            const int a = p.elist()[rbase + rl]; unsigned short* dst = p.ykb() + (long)a * D_MODEL; const float gsc = p.gate()[a];
#pragma unroll
            for (int n = 0; n < 4; ++n) dst[ct * 256 + EPI_COL(n)] = (unsigned short)f2bf(acc[m][n][j] * gsc);
          }
        }
      }
  }
}

typedef __attribute__((ext_vector_type(16))) float f32x16;
#define SM_HR 256
#define UB_STRIDE 8272
#define SM_HU (256 + 32768)
#define SMEM_HY (256 + 32768 + 2 * UB_STRIDE * 2)
static_assert(SEQ == 8192 && HYENA_W == 256, "hyena mfma shape");
DEV void ph_hyena_mfma(const P& p, int l, char* smem) {
  const int tid = otid(), lane = tid & 63, w = tid >> 6;
  unsigned short* R = (unsigned short*)(smem + SM_HR); unsigned short* U = (unsigned short*)(smem + SM_HU);
  for (int ch = blockIdx.x; ch < HYENA_W; ch += gridDim.x) {
    __syncthreads();
    const float* kf = p.kraw() + ((long)l * 2 * HYENA_W + ch) * SEQ; const float* kb = p.kraw() + ((long)l * 2 * HYENA_W + HYENA_W + ch) * SEQ;
    for (int y = tid; y < 2 * SEQ; y += NT) {
      const int lag = SEQ - y; float v = 0.f;
      if (lag >= 0 && lag < SEQ) v = kf[lag]; else if (lag < 0) v = kb[-lag];
      const int C = y >> 3; R[((C ^ ((C >> 4) & 1)) << 3) + (y & 7)] = (unsigned short)f2bf(v);
    }
    for (int e = tid; e < 2 * UB_STRIDE; e += NT) {
      const int b = e / UB_STRIDE, ee = e - b * UB_STRIDE, t = ee - 16; float v = 0.f;
      if (t >= 0 && t < SEQ) v = p.hu()[((long)b * HYENA_W + ch) * SEQ + t];
      U[e] = (unsigned short)f2bf(v);
    }
    __syncthreads();
    f32x16 acc[2];
#pragma unroll
    for (int mi = 0; mi < 2; ++mi)
#pragma unroll
      for (int k = 0; k < 16; ++k) acc[mi][k] = 0.f;
    const int r = lane & 31, h = lane >> 5, sig = lane & 15, bb = (lane >> 4) & 1;
    const unsigned* Ud = (const unsigned*)U + bb * (UB_STRIDE / 2);
    const int ub0 = 8 * h + sig;
    const int cbase = 1022 - 64 * (2 * w) - 2 * r + h;
    const bool odd = sig & 1;
    bf16x8 afn[2]; unsigned dn[5];
    {
#pragma unroll
      for (int mi = 0; mi < 2; ++mi) { const int C = cbase - 64 * mi; afn[mi] = *(const bf16x8*)((const char*)R + ((C ^ ((C >> 4) & 1)) << 4)); }
      const int di = ub0 >> 1;
#pragma unroll
      for (int i = 0; i < 5; ++i) dn[i] = Ud[di + i];
    }
#pragma unroll 1
    for (int q = 0; q <= SEQ / 16; ++q) {
      bf16x8 af[2]; unsigned d[5];
#pragma unroll
      for (int mi = 0; mi < 2; ++mi) af[mi] = afn[mi];
#pragma unroll
      for (int i = 0; i < 5; ++i) d[i] = dn[i];
      {
        const int qn = min(q + 1, SEQ / 16);
#pragma unroll
        for (int mi = 0; mi < 2; ++mi) { const int C = cbase - 64 * mi + 2 * qn; afn[mi] = *(const bf16x8*)((const char*)R + ((C ^ ((C >> 4) & 1)) << 4)); }
        const int di = (16 * qn + ub0) >> 1;
#pragma unroll
        for (int i = 0; i < 5; ++i) dn[i] = Ud[di + i];
      }
      u32x4 bw;
#pragma unroll
      for (int i = 0; i < 4; ++i) bw[i] = odd ? __builtin_amdgcn_alignbit(d[i + 1], d[i], 16) : d[i];
      const bf16x8 bfr = __builtin_bit_cast(bf16x8, bw);
#pragma unroll
      for (int mi = 0; mi < 2; ++mi) acc[mi] = __builtin_amdgcn_mfma_f32_32x32x16_bf16(af[mi], bfr, acc[mi], 0, 0, 0);
    }
    __syncthreads();
    {
      float* Y = (float*)(smem + SM_HR);
      float* yl = Y + bb * SEQ + 16 * (32 * (2 * w) + 4 * h) + sig;
#pragma unroll
      for (int mi = 0; mi < 2; ++mi)
#pragma unroll
        for (int k = 0; k < 16; ++k) yl[16 * (32 * mi + (k & 3) + 8 * (k >> 2))] = acc[mi][k];
    }
    __syncthreads();
    {
      const float* Y = (const float*)(smem + SM_HR);
      const float kn = p.knorm()[l * HYENA_W + ch], dsk = p.hy_d[l * HYENA_W + ch];
#pragma unroll 2
      for (int idx = tid; idx < BATCH * SEQ; idx += NT) {
        const int b = idx / SEQ, t = idx - b * SEQ;
        const long o = ((long)b * HYENA_W + ch) * SEQ + t;
        p.mixb()[(long)idx * MIX_W + ATTN_W + ch] = (Y[idx] * kn + p.hu()[o] * dsk) * p.hx0()[o];
      }
    }
  }
}
#define SM_K 256
#define SM_V (256 + 8192)
static_assert(HEAD_DIM == 64 && WINDOW == 128 && CTX_LEN == 256 && Q_GROUP == 4, "attention shape");
DEV void ph_attn_mfma(const P& p, int l, char* smem) {
  const int tid = otid(), lane = tid & 63, w = (tid >> 6) & 3, hsel = tid >> 8, h = lane >> 5, ql = lane & 31;
  char* Ks = smem + SM_K; char* Vs = smem + SM_V;
  const int n_lat = BATCH * (SEQ / 128) * N_KV_HEADS * (Q_GROUP / 2);
  const int n_ctx = (l == 0) ? BATCH * (CTX_LEN / 128) * N_KV_HEADS * (Q_GROUP / 2) : 0;
  const float QS = 0.125f * 1.4426950408889634f;
  for (int it = blockIdx.x; it < n_lat + n_ctx; it += gridDim.x) {
    const bool isctx = it >= n_lat;
    int b, qb, kvh, g;
    { int x = isctx ? it - n_lat : it; g = (x & 1) * 2 + hsel; kvh = (x >> 1) & 1; x >>= 2; if (isctx) { qb = x & 1; b = x >> 1; } else { qb = x & 63; b = x >> 6; } }
    const int hq = kvh * Q_GROUP + g;
    const int tq0 = qb * 128 + 32 * w;
    const long qrow = (isctx ? (long)NL + b * CTX_LEN : (long)b * SEQ) + tq0 + ql;
    bf16x8 qf[4];
    {
      const unsigned short* qp = p.qkvb() + qrow * HY_OFF + Q_OFF + hq * HEAD_DIM + 8 * h;
#pragma unroll
      for (int ks = 0; ks < 4; ++ks) qf[ks] = *(const bf16x8*)(qp + 16 * ks);
    }
    f32x16 o0, o1;
#pragma unroll
    for (int k = 0; k < 16; ++k) { o0[k] = 0.f; o1[k] = 0.f; }
    float m = -1e30f, lsum = 0.f;
    const int nsteps = isctx ? 4 : 10;
    u32x4 rk[1], rv[1];
    auto key_row = [&](int step, int key) -> long {
      if (step < 4) return (long)NL + b * CTX_LEN + step * 64 + key;
      const int tk = qb * 128 - 128 + (step - 4) * 64 + key;
      return (tk < 0 || tk >= SEQ) ? -1 : (long)b * SEQ + tk;
    };
    auto step_valid = [&](int step) -> bool { if (step < 4) return true; const int t0 = qb * 128 - 128 + (step - 4) * 64; return t0 >= 0 && t0 < SEQ; };
    auto load_tile = [&](int step) {
#pragma unroll
      for (int i = 0; i < 1; ++i) {
        const int key = (tid >> 3); const long kr = key_row(step, key);
        const unsigned short* kp = p.qkvb() + kr * HY_OFF + K_OFF + kvh * HEAD_DIM + (tid & 7) * 8; const unsigned short* vp = p.qkvb() + kr * HY_OFF + V_OFF + kvh * HEAD_DIM + (tid & 7) * 8;
        rk[i] = *(const u32x4*)kp; rv[i] = *(const u32x4*)vp;
      }
    };
    int step = 0;
    load_tile(0);
    while (step < nsteps) {
      __syncthreads();
#pragma unroll
      for (int i = 0; i < 1; ++i) {
        const int key = (tid >> 3), ch = tid & 7;
        *(u32x4*)(Ks + tile_off(key, ch)) = rk[i];
        *(u32x4*)(Vs + key * 128 + ((ch * 16) ^ (64 * ((key >> 1) & 1)))) = rv[i];
      }
      __syncthreads();
      const int cur = step;
      int nxt = step + 1;
      while (nxt < nsteps && !step_valid(nxt)) ++nxt;
      if (nxt < nsteps) load_tile(nxt);
      step = nxt;
#pragma unroll
      for (int sub = 0; sub < 2; ++sub) {
        const bool win = cur >= 4;
        const int ks0 = win ? qb * 128 - 128 + (cur - 4) * 64 + sub * 32 : 0;
        if (win && (ks0 > tq0 + 31 + WINDOW || ks0 + 31 < tq0 - WINDOW)) continue;
        f32x16 sacc;
#pragma unroll
        for (int k = 0; k < 16; ++k) sacc[k] = 0.f;
#pragma unroll
        for (int ks = 0; ks < 4; ++ks) {
          const bf16x8 kf = *(const bf16x8*)(Ks + tile_off(sub * 32 + ql, 2 * ks + h));
          sacc = __builtin_amdgcn_mfma_f32_32x32x16_bf16(kf, qf[ks], sacc, 0, 0, 0);
        }
        if (win && (ks0 + 31 - tq0 > WINDOW || tq0 + 31 - ks0 > WINDOW)) {
          const int tq = tq0 + ql;
#pragma unroll
          for (int k = 0; k < 16; ++k) { const int d = ks0 + (k & 3) + 8 * (k >> 2) + 4 * h - tq; if (d > WINDOW || d < -WINDOW) sacc[k] = -1e30f; }
        }
        float mx = sacc[0];
#pragma unroll
        for (int k = 1; k < 16; ++k) mx = fmaxf(mx, sacc[k]);
        mx = fmaxf(mx, __shfl_xor(mx, 32));
        const float mn = fmaxf(m, mx); const float alpha = __builtin_amdgcn_exp2f(m - mn); m = mn;
        float ps = 0.f;
#pragma unroll
        for (int k = 0; k < 16; ++k) { sacc[k] = __builtin_amdgcn_exp2f(sacc[k] - mn); ps += sacc[k]; }
        lsum = lsum * alpha + ps;
#pragma unroll
        for (int k = 0; k < 16; ++k) { o0[k] *= alpha; o1[k] *= alpha; }
        u32x2 v00, v01, v02, v03, v10, v11, v12, v13;
        {
          const int q4 = (lane & 15) >> 2, p4 = lane & 3, blk = (lane >> 4) & 1, sq = (q4 >> 1) & 1;
          const unsigned lb = (unsigned)(size_t)((__attribute__((address_space(3))) char*)Vs) + (unsigned)((sub * 32 + 4 * h + q4) * 128 + 32 * blk + 8 * p4);
          const unsigned base0 = lb + 64 * sq, base1 = lb + 64 * (1 - sq);
          asm volatile(
              "ds_read_b64_tr_b16 %0, %8\n\t"
              "ds_read_b64_tr_b16 %1, %8 offset:1024\n\t"
              "ds_read_b64_tr_b16 %2, %8 offset:2048\n\t"
              "ds_read_b64_tr_b16 %3, %8 offset:3072\n\t"
              "ds_read_b64_tr_b16 %4, %9\n\t"
              "ds_read_b64_tr_b16 %5, %9 offset:1024\n\t"
              "ds_read_b64_tr_b16 %6, %9 offset:2048\n\t"
              "ds_read_b64_tr_b16 %7, %9 offset:3072\n\t"
              "s_waitcnt lgkmcnt(0)"
              : "=&v"(v00), "=&v"(v01), "=&v"(v02), "=&v"(v03), "=&v"(v10), "=&v"(v11), "=&v"(v12), "=&v"(v13)
              : "v"(base0), "v"(base1) : "memory");
        }
#pragma unroll
        for (int ks2 = 0; ks2 < 2; ++ks2) {
          u32x4 pw;
#pragma unroll
          for (int i = 0; i < 4; ++i) pw[i] = pack2(sacc[8 * ks2 + 2 * i], sacc[8 * ks2 + 2 * i + 1]);
          const bf16x8 pf = __builtin_bit_cast(bf16x8, pw);
          u32x4 a0, a1;
          if (ks2 == 0) { a0[0] = v00[0]; a0[1] = v00[1]; a0[2] = v01[0]; a0[3] = v01[1]; a1[0] = v10[0]; a1[1] = v10[1]; a1[2] = v11[0]; a1[3] = v11[1]; }
          else          { a0[0] = v02[0]; a0[1] = v02[1]; a0[2] = v03[0]; a0[3] = v03[1]; a1[0] = v12[0]; a1[1] = v12[1]; a1[2] = v13[0]; a1[3] = v13[1]; }
          o0 = __builtin_amdgcn_mfma_f32_32x32x16_bf16(__builtin_bit_cast(bf16x8, a0), pf, o0, 0, 0, 0);
          o1 = __builtin_amdgcn_mfma_f32_32x32x16_bf16(__builtin_bit_cast(bf16x8, a1), pf, o1, 0, 0, 0);
        }
      }
    }
    lsum += __shfl_xor(lsum, 32);
    const float sk = p.sink[l * N_Q_HEADS + hq] * 1.4426950408889634f;
    const float mf = fmaxf(m, sk); const float sc = __builtin_amdgcn_exp2f(m - mf); const float inv = sc / (lsum * sc + __builtin_amdgcn_exp2f(sk - mf));
    float* op = p.mixb() + qrow * MIX_W + hq * HEAD_DIM + 4 * h;
#pragma unroll
    for (int gq = 0; gq < 4; ++gq) {
      *(float4*)(op + 8 * gq) = make_float4(o0[4 * gq] * inv, o0[4 * gq + 1] * inv, o0[4 * gq + 2] * inv, o0[4 * gq + 3] * inv);
      *(float4*)(op + 32 + 8 * gq) = make_float4(o1[4 * gq] * inv, o1[4 * gq + 1] * inv, o1[4 * gq + 2] * inv, o1[4 * gq + 3] * inv);
    }
  }
}


static_assert(S5_T == 64 && S5_STATE == 64 && S5_GROUP == 16 && S5_GROUPS == 16 && NCH == 132, "s5 mfma shape");
#define S5_COLS (BATCH * NCH)
#define S5_RT 88
DEV void ph_s5tables_gpu(const P& p, long gtid, long gsize) {
  FOR_ITEMS4(i, (long)DEPTH * 2 * S5_GROUPS * 128 * 1024) {
    const int k = (int)(i & 1023), n = (int)((i >> 10) & 127); const long ldg = i >> 17;
    const int ri = n >> 6, pp = n & 63, sidx = k >> 4, j = k & 15;
    const float2 lp = p.lampow()[(ldg * (S5_T + 1) + (S5_T - 1 - sidx)) * S5_STATE + pp]; const float2 bb = p.bbar()[(ldg * S5_STATE + pp) * S5_GROUP + j];
    p.bmtb()[i] = (unsigned short)f2bf(ri ? lp.x * bb.y + lp.y * bb.x : lp.x * bb.x - lp.y * bb.y);
  }
  FOR_ITEMS4(i, (long)DEPTH * 2 * S5_GROUPS * 128 * 1024) {
    const int k = (int)(i & 127), n = (int)((i >> 7) & 1023); const long ldg = i >> 17; const int dir = (int)((ldg >> 4) & 1);
    const int ri = k >> 6, pp = k & 63, tl = n >> 4, ii = n & 15; const int tau = dir ? 63 - tl : tl;
    const float cr = p.s5_c_re[(ldg * S5_GROUP + ii) * S5_STATE + pp], ci = p.s5_c_im[(ldg * S5_GROUP + ii) * S5_STATE + pp];
    const float2 lp = p.lampow()[(ldg * (S5_T + 1) + tau + 1) * S5_STATE + pp];
    p.cmtb()[i] = (unsigned short)f2bf(ri ? -(cr * lp.y + ci * lp.x) : cr * lp.x - ci * lp.y);
  }
}
DEV void ph_kcb_gpu(const P& p, long gtid, long gsize) {
  FOR_ITEMS4(i, (long)DEPTH * 2 * S5_GROUPS * S5_T * 256) p.kcb()[i] = (unsigned short)f2bf(p.kc()[i]);
}
struct ALS5U { const char* base; unsigned off0[2]; int stepb; const char* hbase; unsigned hoff[2]; int nki;
  DEVM void set(int i, int b, int dir, int chunk, int sl, unsigned joff) { off0[i] = (unsigned)s5_row(b, dir, chunk * S5_T + sl) * (unsigned)(S5_W * 2) + joff; }
  DEVM const unsigned short* a(int i, int kt) const {
    if (kt >= nki) return (const unsigned short*)(hbase + (hoff[i] + (unsigned)(kt - nki) * 128u));
    return (const unsigned short*)(base + (off0[i] + (unsigned)(kt * stepb))); } };
struct BLKc { const char* kc; const char* cm; int tl, i0, sj, ss, dir, nki; unsigned cmoff;
  DEVM void load(u32x4 (&rb)[4], int kt) const {
    if (kt >= nki) {
#pragma unroll
      for (int c = 0; c < 4; ++c) rb[c] = *(const u32x4*)(cm + (cmoff + (unsigned)(c * 128 + (kt - nki) * 64) * 2u));
      return;
    }
    const int d = (dir ? 63 - tl : tl) - (4 * kt + ss);
    if (d < 0) {
#pragma unroll
      for (int c = 0; c < 4; ++c) rb[c] = (u32x4){0u, 0u, 0u, 0u};
    } else {
#pragma unroll
      for (int c = 0; c < 4; ++c) rb[c] = *(const u32x4*)(kc + (unsigned)(((d * 16 + i0 + c) * 16 + sj) * 2));
    }
  } };
DEV void ph_s5_sgemm(const P& p, int l, char* smem) {
  const int tid = otid();
  const int nitems = 2 * S5_GROUPS * 3;
  for (int it = blockIdx.x; it < nitems; it += gridDim.x) {
    const int rt = it % 3, g = (it / 3) % S5_GROUPS, dir = it / (3 * S5_GROUPS);
    ALS5U al; al.base = (const char*)(p.s5u() + g * S5_GROUP); al.stepb = (dir ? -4 : 4) * S5_W * 2; al.nki = 1 << 20; al.hbase = al.base; al.hoff[0] = al.hoff[1] = 0;
#pragma unroll
    for (int i = 0; i < 2; ++i) { const int col = rt * S5_RT + min((tid >> 3) + 64 * i, S5_RT - 1); al.set(i, col / NCH, dir, col % NCH, (tid & 7) >> 1, (tid & 1) * 16); }
    BLT bl; bl.base = (const char*)(p.bmtb() + (((long)l * 2 + dir) * S5_GROUPS + g) * 128 * 1024); bl.rowb = 1024 * 2;
    bl.voff = (unsigned)((((tid >> 3) & 31) * 4)) * bl.rowb + (unsigned)((tid & 7) * 16);
    f32x4 acc[4][4]; acc_zero(acc);
    gemm_tb(al, bl, 16, acc, smem);
    EPI_BEGIN
    if (((etid >> 6) & 3) < 2) {
#pragma unroll
      for (int m = 0; m < 4; ++m)
#pragma unroll
        for (int j = 0; j < 4; ++j) {
          const int rl = EPI_ROW(m, j);
          if (rl < S5_RT) {
            const int col = rt * S5_RT + rl; const int b = col / NCH, c = col % NCH;
            float* dst = (float*)(p.sc() + ((((long)b * 2 + dir) * S5_GROUPS + g) * NCH + c) * S5_STATE);
#pragma unroll
            for (int n = 0; n < 4; ++n) { const int nn = EPI_COL(n); dst[(nn & 63) * 2 + (nn >> 6)] = acc[m][n][j]; }
          }
        }
    }
  }
}

static_assert(NCH == 132, "carry scan grouping");
DEV void ph_s5_carry_gpu(const P& p, int l, char* smem) {
  const int tid = otid();
  float2* E = (float2*)(smem + SM_MISC);
  const int nchains = BATCH * 2 * S5_GROUPS * S5_STATE;
  for (int cb = blockIdx.x * 16; cb < nchains; cb += gridDim.x * 16) {
    const int cl = tid & 15, grp = tid >> 4; const bool act = tid < 176;
    const int chain = cb + cl;
    const int pp = chain % S5_STATE, g = (chain / S5_STATE) % S5_GROUPS, dir = (chain / (S5_STATE * S5_GROUPS)) % 2, b = chain / (S5_STATE * S5_GROUPS * 2);
    const long ldg = ((long)l * 2 + dir) * S5_GROUPS + g;
    const long base = (((long)b * 2 + dir) * S5_GROUPS + g) * NCH + grp * 12;
    float2 lt = make_float2(0.f, 0.f); float2 L[12]; float hr = 0.f, hi = 0.f;
    __syncthreads();
    if (act) {
      lt = p.lampow()[(ldg * (S5_T + 1) + S5_T) * S5_STATE + pp];
      float2 sv[12];
#pragma unroll
      for (int k = 0; k < 12; ++k) sv[k] = p.sc()[(base + k) * S5_STATE + pp];
#pragma unroll
      for (int k = 0; k < 12; ++k) { L[k] = make_float2(hr, hi); const float nr = lt.x * hr - lt.y * hi + sv[k].x, ni = lt.x * hi + lt.y * hr + sv[k].y; hr = nr; hi = ni; }
      E[grp * 16 + cl] = make_float2(hr, hi);
    }
    __syncthreads();
    if (act) {
      float pr = lt.x, pi = lt.y;
#pragma unroll
      for (int k = 1; k < 12; ++k) { const float nr = pr * lt.x - pi * lt.y, ni = pr * lt.y + pi * lt.x; pr = nr; pi = ni; }
      float gr = 0.f, gi = 0.f;
      for (int gp = 0; gp < grp; ++gp) { const float2 e = E[gp * 16 + cl]; const float nr = pr * gr - pi * gi + e.x, ni = pr * gi + pi * gr + e.y; gr = nr; gi = ni; }
#pragma unroll
      for (int k = 0; k < 12; ++k) {
        const float vr = L[k].x + gr, vi = L[k].y + gi;
        p.hcbf()[(base + k) * 2 * S5_STATE + pp] = f2bf16(vr); p.hcbf()[(base + k) * 2 * S5_STATE + S5_STATE + pp] = f2bf16(vi);
        const float nr = lt.x * gr - lt.y * gi, ni = lt.x * gi + lt.y * gr; gr = nr; gi = ni;
      }
    }
  }
}
DEV void ph_s5_ygemm(const P& p, int l, char* smem) {
  const int tid = otid();
  const int nitems = S5_GROUPS * 3 * 4;
  for (int it = blockIdx.x; it < nitems; it += gridDim.x) {
    const int nt = it & 3, rt = (it >> 2) % 3, g = it / 12;
    f32x4 acc[4][4]; acc_zero(acc);
#pragma unroll 1
    for (int dir = 0; dir < 2; ++dir) {
      const long ldg = ((long)l * 2 + dir) * S5_GROUPS + g;
      const int nki = dir ? 16 - 4 * nt : 4 * nt + 4;
      ALS5U al; al.base = (const char*)(p.s5u() + g * S5_GROUP); al.stepb = (dir ? -4 : 4) * S5_W * 2; al.nki = nki; al.hbase = (const char*)p.hcbf();
#pragma unroll
      for (int i = 0; i < 2; ++i) {
        const int col = rt * S5_RT + min((tid >> 3) + 64 * i, S5_RT - 1); const int b = col / NCH, blk = col % NCH;
        const int ch = dir ? (blk < 4 ? 3 - blk : 135 - blk) : blk;
        al.set(i, b, dir, ch, (tid & 7) >> 1, (tid & 1) * 16);
        al.hoff[i] = (unsigned)((((b * 2 + dir) * S5_GROUPS + g) * NCH + ch) * 128 + (tid & 7) * 8) * 2u;
      }
      BLKc bk; bk.kc = (const char*)(p.kcb() + ldg * S5_T * 256); bk.tl = 16 * nt + (tid >> 5); bk.i0 = ((tid >> 3) & 3) * 4; bk.sj = (tid & 1) * 8; bk.ss = (tid & 7) >> 1; bk.dir = dir; bk.nki = nki;
      bk.cm = (const char*)(p.cmtb() + ldg * 1024 * 128); bk.cmoff = (unsigned)(((16 * nt + (tid >> 5)) * 16 + ((tid >> 3) & 3) * 4) * 128 + (tid & 7) * 8) * 2u;
      gemm_tb(al, bk, nki + 2, acc, smem);
    }
    EPI_BEGIN
#pragma unroll
    for (int m = 0; m < 4; ++m)
#pragma unroll
      for (int j = 0; j < 4; ++j) {
        const int rl = EPI_ROW(m, j);
        if (rl < S5_RT) {
          const int col = rt * S5_RT + rl; const int b = col / NCH, blk = col % NCH;
#pragma unroll
          for (int n = 0; n < 4; ++n) {
            const int nn = nt * 256 + EPI_COL(n); const int tl = nn >> 4, chn = g * S5_GROUP + (nn & 15);
            const long row = blk < 4 ? (long)NL + b * CTX_LEN + blk * 64 + tl : (long)b * SEQ + (blk - 4) * 64 + tl;
            const float y = acc[m][n][j] + p.s5_d[l * S5_W + chn] * __uint_as_float((unsigned)p.s5u()[row * S5_W + chn] << 16);
            const float gy = gelu_tanhf(y);
            p.ybuf()[row * S5_W + chn] = gy; p.ybf()[row * S5_W + chn] = (unsigned short)f2bf(gy);
          }
        }
      }
  }
}

DEV float wave_sum(float v) {
#pragma unroll
  for (int o = 32; o > 0; o >>= 1) v += __shfl_xor(v, o);
  return v;
}
DEV void st_bf4(unsigned short* dst, float a, float b, float c, float d) { u32x2 v; v[0] = pack2(a, b); v[1] = pack2(c, d); *(u32x2*)dst = v; }
static_assert(BATCH == 2, "mod partial layout");
DEV void ph_modsum_gpu(const P& p, long gtid, long gsize) {
  FOR_ITEMS(i, (long)DEPTH * (BATCH + 1) * 6 * D_MODEL) {
    const int n = (int)(i % (6 * D_MODEL)); const int j = (int)((i / (6 * D_MODEL)) % (BATCH + 1)); const int l = (int)(i / (6 * D_MODEL * (BATCH + 1)));
    float acc = p.b_ada[l * 6 * D_MODEL + n];
#pragma unroll
    for (int sl = 0; sl < 16; ++sl) acc += p.modp()[((long)(l * 16 + sl) * (BATCH + 1) + j) * 6 * D_MODEL + n];
    p.mod()[i] = acc;
  }
}
DEV void ph_modu0_gpu(const P& p, long gtid, long gsize) {
  FOR_ITEMS4(i4, (long)NR * D_MODEL / 4) {
    const long i = i4 * 4; const int k = (int)(i % D_MODEL); const long r = i / D_MODEL;
    const float* m = p.mod() + (long)modrow(r) * 6 * D_MODEL;
    const float4 x = *(const float4*)(p.xcur() + i); const float4 sh = *(const float4*)(m + k); const float4 sc = *(const float4*)(m + D_MODEL + k);
    st_bf4(p.ubf() + i, x.x * (1.f + sc.x) + sh.x, x.y * (1.f + sc.y) + sh.y, x.z * (1.f + sc.z) + sh.z, x.w * (1.f + sc.w) + sh.w);
  }
}
DEV void rms_rows(const P& p, int l, long r0, long r1, int w0, int nw) {
  const int lane = otid() & 63;
  for (long r = r0 + w0; r < r1; r += nw) {
    const float* v = p.mixb() + r * MIX_W; float4 a[4]; float ss[4];
#pragma unroll
    for (int i = 0; i < 4; ++i) { a[i] = *(const float4*)(v + (i * 64 + lane) * 4); ss[i] = a[i].x * a[i].x + a[i].y * a[i].y + a[i].z * a[i].z + a[i].w * a[i].w; }
    const float s_att = wave_sum(ss[0] + ss[1]), s_hy = wave_sum(ss[2]), s_s5 = wave_sum(ss[3]);
    float rs[4]; rs[0] = rs[1] = 1.0f / sqrtf(s_att / (float)ATTN_W + LN_EPS); rs[2] = 1.0f / sqrtf(s_hy / (float)HYENA_W + LN_EPS); rs[3] = 1.0f / sqrtf(s_s5 / (float)S5_W + LN_EPS);
#pragma unroll
    for (int i = 0; i < 4; ++i) {
      const int k = (i * 64 + lane) * 4; const float4 g = *(const float4*)(p.mix_g + l * MIX_W + k);
      st_bf4(p.mixbf() + r * MIX_W + k, a[i].x * rs[i] * g.x, a[i].y * rs[i] * g.y, a[i].z * rs[i] * g.z, a[i].w * rs[i] * g.w);
    }
  }
}
DEV void ln_rows(float4 (&a)[4], const float* gw, const float* bw, int lane) {
  float s = 0.f;
#pragma unroll
  for (int i = 0; i < 4; ++i) s += a[i].x + a[i].y + a[i].z + a[i].w;
  const float mu = wave_sum(s) / (float)D_MODEL; float q = 0.f;
#pragma unroll
  for (int i = 0; i < 4; ++i) { a[i].x -= mu; a[i].y -= mu; a[i].z -= mu; a[i].w -= mu; q += a[i].x * a[i].x + a[i].y * a[i].y + a[i].z * a[i].z + a[i].w * a[i].w; }
  const float rs = 1.0f / sqrtf(wave_sum(q) / (float)D_MODEL + LN_EPS);
#pragma unroll
  for (int i = 0; i < 4; ++i) {
    const int k = (i * 64 + lane) * 4; const float4 g = *(const float4*)(gw + k), b = *(const float4*)(bw + k);
    a[i].x = a[i].x * rs * g.x + b.x; a[i].y = a[i].y * rs * g.y + b.y; a[i].z = a[i].z * rs * g.z + b.z; a[i].w = a[i].w * rs * g.w + b.w;
  }
}
DEV void ph_ln1_gpu(const P& p, int l) {
  const int tid_ = otid(); const int lane = tid_ & 63; const int gw = blockIdx.x * (NT / 64) + (tid_ >> 6), nw = gridDim.x * (NT / 64);
  for (long r = gw; r < NR; r += nw) {
    float4 a[4];
#pragma unroll
    for (int i = 0; i < 4; ++i) a[i] = *(const float4*)(p.tmp() + r * D_MODEL + (i * 64 + lane) * 4);
    ln_rows(a, p.ln1_g + l * D_MODEL, p.ln1_b + l * D_MODEL, lane);
    const float* m = p.mod() + ((long)l * (BATCH + 1) + modrow(r)) * 6 * D_MODEL + 3 * D_MODEL;
#pragma unroll
    for (int i = 0; i < 4; ++i) {
      const int k = (i * 64 + lane) * 4;
      *(float4*)(p.xcur() + r * D_MODEL + k) = a[i];
      const float4 sh = *(const float4*)(m + k), sc = *(const float4*)(m + D_MODEL + k);
      const float u0 = a[i].x * (1.f + sc.x) + sh.x, u1 = a[i].y * (1.f + sc.y) + sh.y, u2 = a[i].z * (1.f + sc.z) + sh.z, u3 = a[i].w * (1.f + sc.w) + sh.w;
      st_bf4(p.ubf() + r * D_MODEL + k, u0, u1, u2, u3);
      st_bf4(p.ubl() + r * D_MODEL + k, bflo(u0), bflo(u1), bflo(u2), bflo(u3));
    }
  }
}
DEV void ph_ln2_gpu(const P& p, int l) {
  const int tid_ = otid(); const int lane = tid_ & 63; const int gw = blockIdx.x * (NT / 64) + (tid_ >> 6), nw = gridDim.x * (NT / 64);
  for (long r = gw; r < NR; r += nw) {
    float4 a[4];
    const float* m = p.mod() + ((long)l * (BATCH + 1) + modrow(r)) * 6 * D_MODEL + 5 * D_MODEL;
#pragma unroll
    for (int i = 0; i < 4; ++i) {
      const int k = (i * 64 + lane) * 4;
      float4 f = *(const float4*)(p.ysh() + r * D_MODEL + k);
#pragma unroll
      for (int kk = 0; kk < TOP_K; ++kk) { const u32x2 y = *(const u32x2*)(p.ykb() + (r * TOP_K + kk) * D_MODEL + k); f.x += __uint_as_float(y[0] << 16); f.y += __uint_as_float(y[0] & 0xffff0000u); f.z += __uint_as_float(y[1] << 16); f.w += __uint_as_float(y[1] & 0xffff0000u); }
      const float4 x = *(const float4*)(p.xcur() + r * D_MODEL + k), g2 = *(const float4*)(m + k);
      a[i].x = DN_ALPHA * x.x + g2.x * f.x; a[i].y = DN_ALPHA * x.y + g2.y * f.y; a[i].z = DN_ALPHA * x.z + g2.z * f.z; a[i].w = DN_ALPHA * x.w + g2.w * f.w;
    }
    ln_rows(a, p.ln2_g + l * D_MODEL, p.ln2_b + l * D_MODEL, lane);
    const float* mn = p.mod() + ((long)(l + 1) * (BATCH + 1) + modrow(r)) * 6 * D_MODEL;
#pragma unroll
    for (int i = 0; i < 4; ++i) {
      const int k = (i * 64 + lane) * 4;
      *(float4*)(p.xcur() + r * D_MODEL + k) = a[i];
      if (l + 1 < DEPTH) {
        const float4 sh = *(const float4*)(mn + k), sc = *(const float4*)(mn + D_MODEL + k);
        st_bf4(p.ubf() + r * D_MODEL + k, a[i].x * (1.f + sc.x) + sh.x, a[i].y * (1.f + sc.y) + sh.y, a[i].z * (1.f + sc.z) + sh.z, a[i].w * (1.f + sc.w) + sh.w);
      } else if (r < NL) *(float4*)(p.out + r * D_MODEL + k) = a[i];
    }
  }
}
struct ALRouter { const char* hi; const char* lo_; unsigned off[2];
  DEVM const unsigned short* a(int i, int kt) const { return (const unsigned short*)((kt >= 32 ? lo_ : hi) + (off[i] + (unsigned)(kt & 15) * 128u)); } };
struct BLRouter { const char* base; const char* lob; unsigned voff; unsigned rowb;
  DEVM void load(u32x4 (&rb)[4], int kt) const {
    const char* bb = (kt >> 4) == 1 ? lob : base;
#pragma unroll
    for (int c = 0; c < 4; ++c) rb[c] = *(const u32x4*)(bb + (voff + (unsigned)c * rowb + (unsigned)(kt & 15) * 128u)); } };
DEV void ph_router_mfma(const P& p, int l, char* smem) {
  const int tid = otid();
  const int n_router = (NR >> 7), n_sh = (NR >> 7) * 2;
  const int nrb = (int)gridDim.x >= 64 ? (int)((gridDim.x * 3) / 5) : 0;
  const bool is_router = nrb == 0 ? false : (int)blockIdx.x < nrb;
  for (int pass = 0; pass < 2; ++pass) {
    const bool do_router = nrb == 0 ? pass == 0 : is_router;
    if (nrb != 0 && pass == 1) break;
    const int first = nrb == 0 ? (int)blockIdx.x : (do_router ? (int)blockIdx.x : (int)blockIdx.x - nrb);
    const int stride = nrb == 0 ? (int)gridDim.x : (do_router ? nrb : (int)gridDim.x - nrb);
    const int nit = do_router ? n_router : n_sh;
    for (int it = first; it < nit; it += stride) {
      const int rt = do_router ? it : (it >> 1), cq = do_router ? 0 : (it & 1);
      ALRouter ar; ar.hi = (const char*)(p.ubf() + (long)rt * 128 * D_MODEL); ar.lo_ = (const char*)(p.ubl() + (long)rt * 128 * D_MODEL);
#pragma unroll
      for (int i = 0; i < 2; ++i) ar.off[i] = (unsigned)(((tid >> 3) + 64 * i) * D_MODEL + (tid & 7) * 8) * 2u;
      BLRouter br; int nk;
      if (do_router) {
        br.base = (const char*)(p.wt_rh() + (long)l * N_EXPERTS * D_MODEL); br.lob = (const char*)(p.wt_rl() + (long)l * N_EXPERTS * D_MODEL); br.rowb = D_MODEL * 2;
        br.voff = (unsigned)((tid >> 3) * 4) * br.rowb + (unsigned)((tid & 7) * 16); nk = 3 * (D_MODEL >> 6);
      } else {
        const int nq = tid >> 3; const int wsel = __builtin_amdgcn_readfirstlane(tid >> 6) & 1;
        const unsigned short* wsrc = (wsel ? p.wt_shu() : p.wt_shg()) + (long)l * SHARED_FF * D_MODEL;
        br.base = (const char*)wsrc; br.lob = br.base; br.rowb = D_MODEL * 2;
        br.voff = (unsigned)(cq * 128 + (nq >> 4) * 32 + (nq & 7) * 4) * br.rowb + (unsigned)((tid & 7) * 16); nk = D_MODEL >> 6;
      }
      f32x4 acc[4][4]; acc_zero(acc);
      gemm_tb(ar, br, nk, acc, smem);
      EPI_BEGIN
      if (do_router) {
#pragma unroll
        for (int m = 0; m < 4; ++m)
#pragma unroll
          for (int n = 0; n < 4; ++n)
#pragma unroll
            for (int j = 0; j < 4; ++j) p.rl()[((long)rt * 128 + EPI_ROW(m, j)) * N_EXPERTS + EPI_COL(n)] = acc[m][n][j];
      } else {
        const int elane = etid & 63, ewc = (etid >> 6) & 3;
#pragma unroll
        for (int m = 0; m < 4; ++m)
#pragma unroll
          for (int j = 0; j < 4; ++j)
          { unsigned short* dst = p.hsbf() + ((long)rt * 128 + EPI_ROW(m, j)) * SHARED_FF + cq * 128 + ewc * 32 + (elane & 15);
            dst[0] = (unsigned short)f2bf(siluf(acc[m][0][j]) * acc[m][2][j]); dst[16] = (unsigned short)f2bf(siluf(acc[m][1][j]) * acc[m][3][j]); }
      }
    }
  }
}
static_assert(EPG == 32 && TOP_K == 8 && N_EXPERT_GROUPS == 8 && TOPK_GROUPS == 4, "select shape");
DEV void ph_select_gpu(const P& p, int l) {
  const int tid_ = otid(); const int lane = tid_ & 63; const int gw = blockIdx.x * (NT / 64) + (tid_ >> 6), nw = gridDim.x * (NT / 64);
  const float4 rb = *(const float4*)(p.router_bias + l * N_EXPERTS + 4 * lane);
  for (long r = gw; r < NR; r += nw) {
    const float4 lg = *(const float4*)(p.rl() + r * N_EXPERTS + 4 * lane);
    float sc[4] = {sigmoidf_(lg.x), sigmoidf_(lg.y), sigmoidf_(lg.z), sigmoidf_(lg.w)};
    float bz[4] = {sc[0] + rb.x, sc[1] + rb.y, sc[2] + rb.z, sc[3] + rb.w};
    float m1 = fmaxf(bz[0], bz[1]), m2 = fminf(bz[0], bz[1]);
#pragma unroll
    for (int c = 2; c < 4; ++c) { const float v = bz[c]; m2 = fmaxf(m2, fminf(m1, v)); m1 = fmaxf(m1, v); }
#pragma unroll
    for (int o = 1; o < 8; o <<= 1) { const float b1 = __shfl_xor(m1, o), b2 = __shfl_xor(m2, o); m2 = fmaxf(fminf(m1, b1), fmaxf(m2, b2)); m1 = fmaxf(m1, b1); }
    const float gs = m1 + m2; const int mg = lane >> 3; int rank = 0;
#pragma unroll
    for (int j = 0; j < 8; ++j) { const float gj = __shfl(gs, j * 8); rank += (gj > gs || (gj == gs && j < mg)) ? 1 : 0; }
    if (rank >= TOPK_GROUPS) { bz[0] = bz[1] = bz[2] = bz[3] = -1e30f; }
    int sel_e[TOP_K]; float sel_s[TOP_K]; float gsum = 0.f;
#pragma unroll
    for (int it = 0; it < TOP_K; ++it) {
      float bv = bz[0]; int bc = 0;
#pragma unroll
      for (int c = 1; c < 4; ++c) if (bz[c] > bv) { bv = bz[c]; bc = c; }
      int bi = 4 * lane + bc; float bs = sc[bc];
      const int myi = bi;
#pragma unroll
      for (int o = 1; o < 64; o <<= 1) {
        const float ov = __shfl_xor(bv, o); const int oi = __shfl_xor(bi, o); const float os = __shfl_xor(bs, o);
        if (ov > bv || (ov == bv && oi < bi)) { bv = ov; bi = oi; bs = os; }
      }
      sel_e[it] = bi; sel_s[it] = bs; gsum += bs;
      if (bi == myi) {
#pragma unroll
        for (int c = 0; c < 4; ++c) if (c == bc) bz[c] = -1e30f;
      }
    }
    const float inv = ROUTED_SCALE / gsum;
    int me = sel_e[0]; float ms = sel_s[0];
#pragma unroll
    for (int it = 1; it < TOP_K; ++it) if (lane == it) { me = sel_e[it]; ms = sel_s[it]; }
    if (lane < TOP_K) {
      const long a = r * TOP_K + lane;
      p.top_e()[a] = me; p.gate()[a] = ms * inv;
      const int pos = atomicAdd(&p.cnt()[l * N_EXPERTS + me], 1);
      p.elist()[(long)me * NR + pos] = (int)a;
    }
  }
}
#endif

#ifndef CPU_TEST
#define XB_TMO      128
#define XB_XCNT(j)  (256  + 64 * (j))
#define XB_XSUB(j)  (1280 + 64 * (j))
#define XB_XGEN(j)  (2304 + 64 * (j))
#define XB_TOP      3328
#define XB_TOPGEN   3392
#define XCD_BAR_WORDS 3456
#define XB_SPIN_CAP (1u << 18)
#define LAS __attribute__((address_space(3)))
__device__ __forceinline__ unsigned xb_ld(unsigned* p)              { return __hip_atomic_load(p, __ATOMIC_RELAXED, __HIP_MEMORY_SCOPE_AGENT); }
__device__ __forceinline__ unsigned xb_add(unsigned* p, unsigned v) { return __hip_atomic_fetch_add(p, v, __ATOMIC_RELAXED, __HIP_MEMORY_SCOPE_AGENT); }
__device__ __forceinline__ unsigned xb_xcc_id() { return (unsigned)__builtin_amdgcn_s_getreg((3 << 11) | 20) & 0xFu; }
#define XB_SPIN(cond, bar) do { unsigned _sp = 0; while (cond) { __builtin_amdgcn_s_sleep(1); \
    if ((++_sp & 255u) == 0u) { if (xb_ld(&(bar)[XB_TMO])) break; if (_sp > XB_SPIN_CAP) { atomicAdd(&(bar)[XB_TMO], 1u); break; } } } } while (0)
struct XcdBarrier { unsigned* bar; unsigned x; volatile LAS unsigned* st; };
__device__ __forceinline__ XcdBarrier xcd_barrier_post(unsigned* bar, volatile LAS unsigned* st) {
    XcdBarrier b; b.bar = bar; b.x = xb_xcc_id(); b.st = st;
    if (threadIdx.x == 0) (void)xb_add(&bar[XB_XCNT(b.x)], 1u);
    return b;
}
__device__ __forceinline__ void xcd_barrier_complete(unsigned* bar, unsigned x, unsigned& nloc, unsigned& nx) {
    const unsigned G = gridDim.x * gridDim.y * gridDim.z;
    unsigned sum, cnt, mine, sp = 0u;
    for (;;) {
        sum = 0u; cnt = 0u; mine = 0u;
#pragma unroll
        for (unsigned j = 0; j < 16; ++j) { const unsigned c = xb_ld(&bar[XB_XCNT(j)]); sum += c; cnt += (c > 0u) ? 1u : 0u; mine = (j == x) ? c : mine; }
        if (sum == G) break;
        __builtin_amdgcn_s_sleep(1);
        if ((++sp & 255u) == 0u) { if (xb_ld(&bar[XB_TMO])) break; if (sp > XB_SPIN_CAP) { atomicAdd(&bar[XB_TMO], 1u); break; } }
    }
    nloc = mine > 0u ? mine : 1u; nx = cnt > 0u ? cnt : 1u;
}
__device__ __forceinline__ void xcd_barrier(const XcdBarrier& b) {
    asm volatile("s_waitcnt vmcnt(0)" ::: "memory");
    __syncthreads();
    if (threadIdx.x == 0) {
        unsigned* bar = b.bar;
        unsigned bx = b.x; asm volatile("" : "+s"(bx));
        __builtin_amdgcn_s_waitcnt(0);
        unsigned nloc = b.st[0], nx = b.st[1];
        if (nloc == 0u) { xcd_barrier_complete(bar, bx, nloc, nx); b.st[0] = nloc; b.st[1] = nx; }
        const unsigned old = xb_add(&bar[XB_XSUB(bx)], 1u);
        const unsigned gen = old / nloc;
        if (old + 1u == (gen + 1u) * nloc) {
            __builtin_amdgcn_fence(__ATOMIC_RELEASE, "agent");
            asm volatile("s_waitcnt vmcnt(0)" ::: "memory");
            const unsigned og = xb_add(&bar[XB_TOP], 1u);
            const unsigned tg = og / nx;
            if (og + 1u == (tg + 1u) * nx) xb_add(&bar[XB_TOPGEN], 1u);
            else XB_SPIN(xb_ld(&bar[XB_TOPGEN]) == tg, bar);
            __builtin_amdgcn_fence(__ATOMIC_ACQUIRE, "agent");
            xb_add(&bar[XB_XGEN(bx)], 1u);
            asm volatile("s_waitcnt vmcnt(0)" ::: "memory");
        } else {
            XB_SPIN(xb_ld(&bar[XB_XGEN(bx)]) == gen, bar);
            __builtin_amdgcn_fence(__ATOMIC_ACQUIRE, "agent");
            asm volatile("s_waitcnt vmcnt(0)" ::: "memory");
        }
    }
    __syncthreads();
}
#define GRID_SYNC() xcd_barrier(xb)
#else
#define GRID_SYNC() do {} while (0)
#endif

#ifndef CPU_TEST
#define GPUSEL(a, b) a
#else
#define GPUSEL(a, b) b
#endif
#ifndef CPU_TEST
#define OPAQUE_S(v) asm volatile("" : "+s"(v))
#define OPAQUE_V(v) asm volatile("" : "+v"(v))
#else
#define OPAQUE_S(v) do {} while (0)
#define OPAQUE_V(v) do {} while (0)
#endif
#ifndef PROBE_MASK
#define PROBE_MASK 0
#endif
#define LPHASE(stmt) do { int l = lo; OPAQUE_S(l); if (SINGLE && ((PROBE_MASK >> (ph - NG - lo * NLP)) & 1)) { long gtid = gtid0; OPAQUE_V(gtid); stmt; GRID_SYNC(); } PHASE(stmt); } while (0)
#define PHASE(stmt) do { if (SINGLE || ph == only) { long gtid = gtid0; OPAQUE_V(gtid); stmt; } if (SINGLE) { GRID_SYNC(); } ++ph; } while (0)
#ifndef CPU_TEST
template <bool SINGLE> __device__ __forceinline__ void run_seq(const P& p, long gtid0, long gsize, int only, const XcdBarrier& xb, char* smem)
#else
template <bool SINGLE> static int run_seq(const P& p, long gtid0, long gsize, int only)
#endif
{
  int ph = 0;
  PHASE(ph_g0(p, gtid, gsize));
  PHASE(ph_g1(p, gtid, gsize));
  PHASE(ph_g2(p, gtid, gsize));
  PHASE(ph_g3(p, gtid, gsize));
  PHASE(ph_g4(p, gtid, gsize));
#pragma unroll 1
  for (int lo = 0; lo < DEPTH; ++lo) {
    LPHASE(ph_modu(p, l, 0, gtid, gsize));
    LPHASE(GPUSEL(ph_proj_mfma(p, l, smem), ph_proj(p, l, gtid, gsize)));
    LPHASE(ph_post_proj(p, l, gtid, gsize));
    LPHASE(ph_mix(p, l, gtid, gsize); GPUSEL((ph_attn_mfma(p, l, smem), ph_hyena_mfma(p, l, smem)), (void)0));
    LPHASE(ph_s5out(p, l, gtid, gsize));
    LPHASE(GPUSEL(ph_glu_mfma(p, l, smem), ph_glu(p, l, gtid, gsize)));
    LPHASE(ph_rms(p, l, gtid, gsize));
    LPHASE(GPUSEL(ph_outproj_mfma(p, l, smem), ph_outproj(p, l, gtid, gsize)));
    LPHASE(ph_ln(p, l, 0, gtid, gsize));
    LPHASE(ph_router(p, l, gtid, gsize));
    LPHASE(ph_select(p, l, gtid, gsize));
    LPHASE(ph_sortrows(p, l, gtid, gsize));
    LPHASE(GPUSEL(ph_expert_up_mfma(p, l, smem), ph_expert_up(p, l, gtid, gsize)));
    LPHASE(GPUSEL(ph_expert_down_mfma(p, l, smem), ph_expert_down(p, l, gtid, gsize)));
    LPHASE(ph_combine(p, l, gtid, gsize));
    LPHASE(ph_ln(p, l, 1, gtid, gsize));
  }
#ifdef CPU_TEST
  return ph;
#endif
}


#ifndef CPU_TEST
#define NG_GPU 5
#define NLP_GPU 12
#ifndef PROBE_MASK_G
#define PROBE_MASK_G 0
#endif
#define GPHASE(stmt) do { if (SINGLE || ph == only) { long gtid = (long)blockIdx.x * NT + otid(); stmt; } if (SINGLE) { GRID_SYNC(); } ++ph; } while (0)
#define GLPHASE(stmt) do { int l = lo; OPAQUE_S(l); if (SINGLE && ((PROBE_MASK_G >> (ph - NG_GPU - lo * NLP_GPU)) & 1)) { long gtid = (long)blockIdx.x * NT + otid(); stmt; GRID_SYNC(); } GPHASE(stmt); } while (0)
template <bool SINGLE> __device__ __forceinline__ void run_seq_gpu(const P& p, long gtid0, long gsize, int only, const XcdBarrier& xb, char* smem) {
  int ph = 0;
#ifdef PROBE_INIT
  if (SINGLE) { long gtid = (long)blockIdx.x * NT + otid(); ph_g0(p, gtid, gsize); GRID_SYNC(); ph_g1(p, gtid, gsize); ph_modsum_gpu(p, gtid, gsize); ph_s5tables_gpu(p, gtid, gsize); GRID_SYNC(); ph_g2(p, gtid, gsize); ph_modu0_gpu(p, gtid, gsize); GRID_SYNC(); ph_g3(p, gtid, gsize); GRID_SYNC(); ph_g4(p, gtid, gsize); GRID_SYNC(); }
#endif
  GPHASE(ph_g0(p, gtid, gsize); s5_lampow_gpu(p, gtid, gsize); rope_table_gpu(p, gtid, gsize));
  GPHASE(ph_g1(p, gtid, gsize); ph_modsum_gpu(p, gtid, gsize); ph_s5tables_gpu(p, gtid, gsize); wt_convert_all(p, gtid, gsize));
  GPHASE(ph_g2(p, gtid, gsize); ph_modu0_gpu(p, gtid, gsize); ph_kcb_gpu(p, gtid, gsize));
  GPHASE(ph_g3(p, gtid, gsize));
  GPHASE(ph_g4(p, gtid, gsize));
#pragma unroll 1
  for (int lo = 0; lo < DEPTH; ++lo) {
    GLPHASE(ph_proj_mfma(p, l, smem));
    GLPHASE(ph_s5_sgemm(p, l, smem); ph_hyena_pre_gpu(p, l, gtid, gsize));
    GLPHASE(ph_mix(p, l, gtid, gsize); ph_s5_carry_gpu(p, l, smem); ph_attn_mfma(p, l, smem); ph_hyena_mfma(p, l, smem));
    GLPHASE(ph_s5_ygemm(p, l, smem));
    GLPHASE(ph_glu_mfma(p, l, smem));
    GLPHASE(ph_outproj_mfma(p, l, smem));
    GLPHASE(ph_ln1_gpu(p, l));
    GLPHASE(ph_router_mfma(p, l, smem));
    GLPHASE(ph_select_gpu(p, l));
#ifdef UPVAR
    if (SINGLE) { int l = lo; OPAQUE_S(l); ph_expert_up_mfma<UPVAR>(p, l, smem); GRID_SYNC(); }
#endif
    GLPHASE(ph_expert_up_mfma(p, l, smem));
    GLPHASE(ph_expert_down_mfma(p, l, smem));
    GLPHASE(ph_ln2_gpu(p, l));
  }
}
#endif

static void carve(P& p, void* ws) { p.ws = (char*)ws; }
static void set_inputs(P& p, void* const* d_in) {
  const float** f = (const float**)&p.x;
  for (int i = 0; i < 40; ++i) f[i] = (const float*)d_in[i];
}

#ifndef CPU_TEST
#ifndef MK_SINGLE
#define MK_SINGLE 1
#endif
extern __shared__ __attribute__((aligned(16))) char dyn_smem[];
__global__ void __launch_bounds__(NT, 2) mk_single(P p) {
  uint4* xbw = (uint4*)(dyn_smem + SM_XB);
  if (threadIdx.x == 0) *xbw = make_uint4(0u, 0u, 0u, 0u);
  __syncthreads();
  XcdBarrier xb = xcd_barrier_post(p.bar(), (volatile LAS unsigned*)xbw);
  run_seq_gpu<true>(p, (long)blockIdx.x * blockDim.x + threadIdx.x, (long)gridDim.x * blockDim.x, -1, xb, dyn_smem);
}
__global__ void __launch_bounds__(NT, 2) mk_phase(P p, int only) {
  XcdBarrier xb; xb.bar = p.bar(); xb.x = 0; xb.st = nullptr;
#ifdef DBG_ONLY
  only = DBG_ONLY;
#endif
  run_seq_gpu<false>(p, (long)blockIdx.x * blockDim.x + threadIdx.x, (long)gridDim.x * blockDim.x, only, xb, dyn_smem);
}
extern "C" void kernel_launch(void* const* d_in, const int* in_sizes, int n_in, void* d_out, int out_size, void* d_ws, size_t ws_size, hipStream_t stream) {
  P p; memset(&p, 0, sizeof(p));
  set_inputs(p, d_in); p.out = (float*)d_out; carve(p, d_ws);
  (void)hipMemsetAsync(p.bar(), 0, 4096 * sizeof(unsigned) + ((DEPTH * N_EXPERTS * sizeof(int) + 255) / 256) * 256, stream);
#if MK_SINGLE
  static int grid = 0;
  if (!grid) {
    int dev = 0, cus = 0, per_cu = 0; (void)hipGetDevice(&dev);
    (void)hipDeviceGetAttribute(&cus, hipDeviceAttributeMultiprocessorCount, dev);
    (void)hipFuncSetAttribute((const void*)mk_single, hipFuncAttributeMaxDynamicSharedMemorySize, SMEM_BYTES);
    (void)hipOccupancyMaxActiveBlocksPerMultiprocessor(&per_cu, mk_single, NT, SMEM_BYTES);
    grid = cus * (per_cu < 1 ? per_cu : 1);
  }
  mk_single<<<grid, NT, SMEM_BYTES, stream>>>(p);
#else
  for (int ph = 0; ph < NG_GPU + DEPTH * NLP_GPU; ++ph) mk_phase<<<256, NT, SMEM_BYTES, stream>>>(p, ph);
#endif
}
#endif
```

```cpp
#ifndef CPU_TEST
#include <hip/hip_runtime.h>
#include <cstring>
#define DEV __device__ __forceinline__
#define DEVM __device__ __forceinline__
#define HDM __host__ __device__ __forceinline__
#else
#include <cmath>
#include <cstdio>
#include <cstdlib>
#include <cstring>
#define DEV static inline
#define DEVM inline
#define HDM inline
struct float2 { float x, y; };
static inline float2 make_float2(float a, float b) { float2 r; r.x = a; r.y = b; return r; }
static inline int atomicAdd(int* p, int v) { int o = *p; *p += v; return o; }
#endif

#ifdef SMALL_CFG
#define D_MODEL 64
#define BATCH 2
#define SEQ 256
#define GRID_W 16
#define CTX_LEN 32
#define HEAD_DIM 16
#define N_Q_HEADS 4
#define N_KV_HEADS 2
#define HYENA_W 16
#define S5_W 32
#define WINDOW 32
#define FILTER_HIDDEN 16
#define S5_STATE 8
#define N_EXPERTS 32
#define TOP_K 4
#define EXPERT_FF 16
#define SHARED_FF 16
#define S5_T 32
#else
#define D_MODEL 1024
#define BATCH 2
#define SEQ 8192
#define GRID_W 64
#define CTX_LEN 256
#define HEAD_DIM 64
#define N_Q_HEADS 8
#define N_KV_HEADS 2
#define HYENA_W 256
#define S5_W 256
#define WINDOW 128
#define FILTER_HIDDEN 64
#define S5_STATE 64
#define N_EXPERTS 256
#define TOP_K 8
#define EXPERT_FF 256
#define SHARED_FF 256
#define S5_T 64
#endif
#define DEPTH 2
#define FILTER_EMB 33
#define N_EXPERT_GROUPS 8
#define TOPK_GROUPS 4
#define S5_GROUP 16
#define Q_GROUP (N_Q_HEADS / N_KV_HEADS)
#define ATTN_W (N_Q_HEADS * HEAD_DIM)
#define KV_W (N_KV_HEADS * HEAD_DIM)
#define MIX_W (ATTN_W + HYENA_W + S5_W)
#define Q_OFF 0
#define K_OFF ATTN_W
#define V_OFF (K_OFF + KV_W)
#define HY_OFF (V_OFF + KV_W)
#define S5_OFF (HY_OFF + 3 * HYENA_W)
#define IN_W (S5_OFF + S5_W)
#define AXIS_DIM (HEAD_DIM / 2)
#define ROPE_HALF (AXIS_DIM / 2)
#define S5_GROUPS (S5_W / S5_GROUP)
#define EPG (N_EXPERTS / N_EXPERT_GROUPS)
#define NL (BATCH * SEQ)
#define NC (BATCH * CTX_LEN)
#define NR (NL + NC)
#define NSEQ (CTX_LEN + SEQ)
#define NCH (NSEQ / S5_T)
#define LN_EPS 1e-5f
#define DN_ALPHA 1.4142135623730951f
#define ROUTED_SCALE 2.5f
#define PI_D 3.14159265358979323846

#define WS_LIST(X) \
  X(unsigned, bar, 4096) \
  X(int, cnt, DEPTH * N_EXPERTS) \
  X(float, mod, (size_t)DEPTH * (BATCH + 1) * 6 * D_MODEL) \
  X(float, xcur, (size_t)NR * D_MODEL) \
  X(float, ubuf, (size_t)NR * D_MODEL) \
  X(float, proj, (size_t)NR * IN_W) \
  X(float, hu, (size_t)NR * HYENA_W) \
  X(float, hx0, (size_t)NR * HYENA_W) \
  X(float, fh1, (size_t)DEPTH * SEQ * FILTER_HIDDEN) \
  X(float, fh2, (size_t)DEPTH * SEQ * FILTER_HIDDEN) \
  X(float, kraw, (size_t)DEPTH * SEQ * 2 * HYENA_W) \
  X(float, knorm, (size_t)DEPTH * HYENA_W) \
  X(float, fh1c, (size_t)CTX_LEN * FILTER_HIDDEN) \
  X(float, fh2c, (size_t)CTX_LEN * FILTER_HIDDEN) \
  X(float, krawc, (size_t)CTX_LEN * 2 * HYENA_W) \
  X(float, knormc, (size_t)HYENA_W) \
  X(float, mixb, (size_t)NR * MIX_W) \
  X(float, tmp, (size_t)NR * D_MODEL) \
  X(float2, lampow, (size_t)DEPTH * 2 * S5_GROUPS * (S5_T + 1) * S5_STATE) \
  X(float2, bbar, (size_t)DEPTH * 2 * S5_GROUPS * S5_STATE * S5_GROUP) \
  X(float, kc, (size_t)DEPTH * 2 * S5_GROUPS * S5_T * S5_GROUP * S5_GROUP) \
  X(float2, sc, (size_t)BATCH * 2 * S5_GROUPS * NCH * S5_STATE) \
  X(float2, hc, (size_t)BATCH * 2 * S5_GROUPS * NCH * S5_STATE) \
  X(float, ybuf, (size_t)NR * S5_W) \
  X(float, rl, (size_t)NR * N_EXPERTS) \
  X(int, top_e, (size_t)NR * TOP_K) \
  X(float, gate, (size_t)NR * TOP_K) \
  X(int, posb, (size_t)NR * TOP_K) \
  X(int, srow, (size_t)NR * TOP_K) \
  X(float, hbuf, (size_t)NR * TOP_K * EXPERT_FF) \
  X(float, hsb, (size_t)NR * SHARED_FF) \
  X(float, yk, (size_t)NR * TOP_K * D_MODEL) \
  X(float, ysh, (size_t)NR * D_MODEL) \
  X(unsigned short, ykb, (size_t)NR * TOP_K * D_MODEL) \
  X(unsigned short, qkvb, (size_t)NR * HY_OFF) \
  X(float2, ropet, (size_t)128 * ROPE_HALF) \
  X(unsigned short, bmtb, (size_t)DEPTH * 2 * S5_GROUPS * 128 * 1024) \
  X(unsigned short, cmtb, (size_t)DEPTH * 2 * S5_GROUPS * 1024 * 128) \
  X(unsigned short, kcb, (size_t)DEPTH * 2 * S5_GROUPS * S5_T * 256) \
  X(unsigned short, wt_in, (size_t)DEPTH * IN_W * D_MODEL) \
  X(unsigned short, wt_out, (size_t)DEPTH * D_MODEL * MIX_W) \
  X(unsigned short, wt_glu, (size_t)DEPTH * S5_W * S5_W) \
  X(unsigned short, wt_shg, (size_t)DEPTH * SHARED_FF * D_MODEL) \
  X(unsigned short, wt_shu, (size_t)DEPTH * SHARED_FF * D_MODEL) \
  X(unsigned short, wt_shd, (size_t)DEPTH * D_MODEL * SHARED_FF) \
  X(unsigned short, wt_rh, (size_t)DEPTH * N_EXPERTS * D_MODEL) \
  X(unsigned short, wt_rl, (size_t)DEPTH * N_EXPERTS * D_MODEL) \
  X(unsigned short, ubf, (size_t)NR * D_MODEL) \
  X(unsigned short, ybf, (size_t)NR * S5_W) \
  X(unsigned short, mixbf, (size_t)NR * MIX_W) \
  X(unsigned short, hbf, (size_t)NR * TOP_K * EXPERT_FF) \
  X(unsigned short, hsbf, (size_t)NR * SHARED_FF) \
  X(unsigned short, ubl, (size_t)NR * D_MODEL) \
  X(int, elist, (size_t)N_EXPERTS * NR) \
  X(unsigned short, s5u, (size_t)NR * S5_W) \
  X(float, bmt, (size_t)DEPTH * 2 * S5_GROUPS * 16 * S5_T * 2 * S5_STATE) \
  X(float, cmt, (size_t)DEPTH * 2 * S5_GROUPS * 16 * S5_T * 2 * S5_STATE) \
  X(unsigned short, hcbf, (size_t)BATCH * 2 * S5_GROUPS * NCH * 2 * S5_STATE) \
  X(float, zT, (size_t)BATCH * 3 * HYENA_W * (SEQ + CTX_LEN)) \
  X(float, modp, (size_t)DEPTH * 16 * (BATCH + 1) * 6 * D_MODEL) \
  X(float, wrlo, (size_t)DEPTH * D_MODEL * N_EXPERTS) \

struct WsOff {
#define X(T, name, n) size_t name;
  WS_LIST(X)
#undef X
  size_t total;
};
constexpr WsOff ws_offsets() {
  WsOff o{}; size_t off = 0;
#define X(T, name, n) o.name = off; off += (((size_t)(n)) * sizeof(T) + 255) / 256 * 256;
  WS_LIST(X)
#undef X
  o.total = off; return o;
}
constexpr WsOff WSO = ws_offsets();
struct P {
  const float *x, *c, *ctx, *c_ctx, *w_ada, *b_ada, *w_in, *w_out, *sink, *mix_g, *hy_short_w, *hy_short_b, *hy_w1,
      *hy_b1, *hy_freq, *hy_w2, *hy_b2, *hy_w3, *hy_d, *s5_a_re, *s5_a_im, *s5_log_dt, *s5_b_re, *s5_b_im, *s5_c_re,
      *s5_c_im, *s5_d, *s5_w_glu, *ln1_g, *ln1_b, *ln2_g, *ln2_b, *w_router, *router_bias, *w_exp_gate, *w_exp_up,
      *w_exp_down, *w_sh_gate, *w_sh_up, *w_sh_down;
  float* out;
  char* ws;
#define X(T, name, n) HDM T* name() const { return (T*)(ws + WSO.name); }
  WS_LIST(X)
#undef X
};

#define FOR_ITEMS(i, N) for (long i = gtid; i < (long)(N); i += gsize)
#ifndef CPU_TEST
#define FOR_ITEMS4(i, N) _Pragma("unroll 4") for (long i = gtid; i < (long)(N); i += gsize)
#else
#define FOR_ITEMS4(i, N) FOR_ITEMS(i, N)
#endif

DEV unsigned short f2bf16(float f) { unsigned u; memcpy(&u, &f, 4); return (unsigned short)((u + 0x7fffu + ((u >> 16) & 1u)) >> 16); }
DEV float siluf(float x) { return x / (1.0f + expf(-x)); }
DEV float sigmoidf_(float x) { return 1.0f / (1.0f + expf(-x)); }
DEV float gelu_tanhf(float x) { return 0.5f * x * (1.0f + tanhf(0.7978845608028654f * (x + 0.044715f * x * x * x))); }
DEV int modrow(long r) { return r < NL ? (int)(r / SEQ) : BATCH; }

DEV void ph_g0(const P& p, long gtid, long gsize) {
#ifndef CPU_TEST
  FOR_ITEMS4(i4, (long)NR * D_MODEL / 4) { const long i = i4 * 4; *(float4*)(p.xcur() + i) = i < (long)NL * D_MODEL ? *(const float4*)(p.x + i) : *(const float4*)(p.ctx + (i - (long)NL * D_MODEL)); }
#else
  FOR_ITEMS(i, (long)NR * D_MODEL) p.xcur()[i] = i < (long)NL * D_MODEL ? p.x[i] : p.ctx[i - (long)NL * D_MODEL];
#endif
#ifdef CPU_TEST
  FOR_ITEMS(i, DEPTH * (BATCH + 1) * 6 * D_MODEL) {
    int n = (int)(i % (6 * D_MODEL)); int j = (int)((i / (6 * D_MODEL)) % (BATCH + 1)); int l = (int)(i / (6 * D_MODEL * (BATCH + 1)));
    const float* cv = j < BATCH ? p.c + j * D_MODEL : p.c_ctx;
    const float* w = p.w_ada + (long)l * D_MODEL * 6 * D_MODEL;
    float acc = p.b_ada[l * 6 * D_MODEL + n];
    for (int k = 0; k < D_MODEL; ++k) acc += siluf(cv[k]) * w[(long)k * 6 * D_MODEL + n];
    p.mod()[i] = acc;
  }
#else
  FOR_ITEMS(i, (long)DEPTH * 16 * 6 * D_MODEL) {
    const int n = (int)(i % (6 * D_MODEL)); const int slab = (int)((i / (6 * D_MODEL)) % 16); const int l = (int)(i / (6 * D_MODEL * 16));
    const float* w = p.w_ada + ((long)l * D_MODEL + slab * 64) * 6 * D_MODEL + n;
    float a0 = 0.f, a1 = 0.f, a2 = 0.f;
#pragma unroll 8
    for (int k = 0; k < 64; ++k) {
      const float wv = w[(long)k * 6 * D_MODEL]; const int kk = slab * 64 + k;
      a0 += siluf(p.c[kk]) * wv; a1 += siluf(p.c[D_MODEL + kk]) * wv; a2 += siluf(p.c_ctx[kk]) * wv;
    }
    float* dst = p.modp() + ((long)(l * 16 + slab) * (BATCH + 1)) * 6 * D_MODEL + n;
    dst[0] = a0; dst[6 * D_MODEL] = a1; dst[2 * 6 * D_MODEL] = a2;
  }
#endif
  FOR_ITEMS(i, DEPTH * 2 * S5_GROUPS * S5_STATE) {
    int pp = (int)(i % S5_STATE); int g = (int)((i / S5_STATE) % S5_GROUPS); int ld = (int)(i / (S5_STATE * S5_GROUPS));
    float are = fminf(p.s5_a_re[i], -1e-4f), aim = p.s5_a_im[i];
    float dt = expf(p.s5_log_dt[ld * S5_GROUPS + g]);
#ifdef CPU_TEST
    for (int d = 0; d <= S5_T; ++d) {
      float mag = expf(are * dt * d); float ang = aim * dt * d;
      p.lampow()[((long)(ld * S5_GROUPS + g) * (S5_T + 1) + d) * S5_STATE + pp] = make_float2(mag * cosf(ang), mag * sinf(ang));
    }
#endif
    float mag = expf(are * dt), ang = aim * dt;
    float lr = mag * cosf(ang) - 1.0f, li = mag * sinf(ang);
    float den = are * are + aim * aim;
    float fr = (lr * are + li * aim) / den, fi = (li * are - lr * aim) / den;
    for (int j = 0; j < S5_GROUP; ++j) {
      float br = p.s5_b_re[i * S5_GROUP + j], bi = p.s5_b_im[i * S5_GROUP + j];
      p.bbar()[i * S5_GROUP + j] = make_float2(fr * br - fi * bi, fr * bi + fi * br);
    }
  }
}
#ifndef CPU_TEST
DEV void rope_table_gpu(const P& p, long gtid, long gsize) {
  FOR_ITEMS(i, (long)128 * ROPE_HALF) {
    const int ii = (int)(i % ROPE_HALF), pos = (int)(i / ROPE_HALF);
    const float ang = (float)pos * powf(10000.0f, -(float)(2 * ii) / (float)AXIS_DIM);
    p.ropet()[i] = make_float2(cosf(ang), sinf(ang));
  }
}
DEV void s5_lampow_gpu(const P& p, long gtid, long gsize) {
  FOR_ITEMS4(i, (long)DEPTH * 2 * S5_GROUPS * (S5_T + 1) * S5_STATE) {
    const int pp = (int)(i % S5_STATE); const int d = (int)((i / S5_STATE) % (S5_T + 1)); const long ldg = i / ((long)S5_STATE * (S5_T + 1));
    const long src = ldg * S5_STATE + pp;
    const float are = fminf(p.s5_a_re[src], -1e-4f), aim = p.s5_a_im[src]; const float dt = expf(p.s5_log_dt[ldg]);
    const float mag = expf(are * dt * d); const float ang = aim * dt * d;
    p.lampow()[i] = make_float2(mag * cosf(ang), mag * sinf(ang));
  }
}
#endif
DEV void hy_f1(const P& p, int l, int Lf, float* h1, long gtid, long gsize) {
  FOR_ITEMS(i, (long)Lf * FILTER_HIDDEN) {
    int j = (int)(i % FILTER_HIDDEN); int t = (int)(i / FILTER_HIDDEN);
    const float* w1 = p.hy_w1 + l * FILTER_EMB * FILTER_HIDDEN;
    float tt = (float)((double)t / (double)(Lf - 1));
    float w = (float)(2.0 * PI_D * (double)t / (double)Lf);
    float acc = p.hy_b1[l * FILTER_HIDDEN + j] + tt * w1[j];
    const int bands = (FILTER_EMB - 1) / 2;
    for (int m = 0; m < bands; ++m) {
      float f = (float)(1e-4 + (double)m * ((double)(bands - 1) - 1e-4) / (double)(bands - 1));
      float a = f * w;
      acc += cosf(a) * w1[(1 + m) * FILTER_HIDDEN + j] - sinf(a) * w1[(1 + bands + m) * FILTER_HIDDEN + j];
    }
    h1[i] = sinf(p.hy_freq[l * FILTER_HIDDEN + j] * acc);
  }
}
DEV void hy_f2(const P& p, int l, int Lf, const float* h1, float* h2, long gtid, long gsize) {
  FOR_ITEMS(i, (long)Lf * FILTER_HIDDEN) {
    int j = (int)(i % FILTER_HIDDEN); int t = (int)(i / FILTER_HIDDEN);
    const float* w2 = p.hy_w2 + l * FILTER_HIDDEN * FILTER_HIDDEN;
    float acc = p.hy_b2[l * FILTER_HIDDEN + j];
    for (int k = 0; k < FILTER_HIDDEN; ++k) acc += h1[t * FILTER_HIDDEN + k] * w2[k * FILTER_HIDDEN + j];
#ifndef CPU_TEST
    h2[(long)j * Lf + t] = sinf(p.hy_freq[l * FILTER_HIDDEN + j] * acc);
#else
    h2[i] = sinf(p.hy_freq[l * FILTER_HIDDEN + j] * acc);
#endif
  }
}
DEV void hy_f3(const P& p, int l, int Lf, const float* h2, float* kraw, long gtid, long gsize) {
#ifndef CPU_TEST
  const float* w3 = p.hy_w3 + l * FILTER_HIDDEN * 2 * HYENA_W;
  FOR_ITEMS(i, (long)Lf * (2 * HYENA_W / 8)) {
    const int t = (int)(i % Lf); const int c8 = (int)(i / Lf) * 8;
    float acc[8];
#pragma unroll
    for (int j = 0; j < 8; ++j) acc[j] = 0.f;
#pragma unroll 4
    for (int k = 0; k < FILTER_HIDDEN; ++k) {
      const float hv = h2[(long)k * Lf + t];
      const float4 wa = *(const float4*)(w3 + k * 2 * HYENA_W + c8), wb = *(const float4*)(w3 + k * 2 * HYENA_W + c8 + 4);
      acc[0] += hv * wa.x; acc[1] += hv * wa.y; acc[2] += hv * wa.z; acc[3] += hv * wa.w; acc[4] += hv * wb.x; acc[5] += hv * wb.y; acc[6] += hv * wb.z; acc[7] += hv * wb.w;
    }
    const double d0 = log(1e-2) / 0.3, d1 = log(1e-2) / 1.5;
    const float tt = (float)((double)t / (double)(Lf - 1));
#pragma unroll
    for (int j = 0; j < 8; ++j) {
      const int ch = (c8 + j) % HYENA_W;
      const float delta = fabsf((float)(d0 + (d1 - d0) * (double)ch / (double)(HYENA_W - 1)));
      kraw[(long)(c8 + j) * Lf + t] = acc[j] * expf(-tt * delta);
    }
  }
#else
  FOR_ITEMS(i, (long)Lf * 2 * HYENA_W) {
    int t = (int)(i % Lf); int cc = (int)(i / Lf); int ch = cc % HYENA_W;
    const float* w3 = p.hy_w3 + l * FILTER_HIDDEN * 2 * HYENA_W;
    float acc = 0.f;
    for (int k = 0; k < FILTER_HIDDEN; ++k) acc += h2[t * FILTER_HIDDEN + k] * w3[k * 2 * HYENA_W + cc];
    double d0 = log(1e-2) / 0.3, d1 = log(1e-2) / 1.5;
    float delta = fabsf((float)(d0 + (d1 - d0) * (double)ch / (double)(HYENA_W - 1)));
    float tt = (float)((double)t / (double)(Lf - 1));
    kraw[(long)cc * Lf + t] = acc * expf(-tt * delta);
  }
#endif
}
DEV void hy_f4(int Lf, const float* kraw, float* knorm, long gtid, long gsize) {
#ifndef CPU_TEST
  const int lane = (int)(gtid & 63); const long gw = gtid >> 6, nw = gsize >> 6;
  for (long i = gw; i < HYENA_W; i += nw) {
    float s = 0.f;
    for (int t = lane; t < Lf; t += 64) { s += fabsf(kraw[i * Lf + t]); if (t > 0) s += fabsf(kraw[(HYENA_W + i) * Lf + t]); }
    for (int o = 32; o > 0; o >>= 1) s += __shfl_xor(s, o);
    if (lane == 0) knorm[i] = 1.0f / s;
  }
#else
  FOR_ITEMS(i, HYENA_W) {
    float s = 0.f;
    for (int t = 0; t < Lf; ++t) {
      s += fabsf(kraw[(long)i * Lf + t]);
      if (t > 0) s += fabsf(kraw[(long)(HYENA_W + i) * Lf + t]);
    }
    knorm[i] = 1.0f / s;
  }
#endif
}
DEV void ph_g1(const P& p, long gtid, long gsize) {
  for (int l = 0; l < DEPTH; ++l) hy_f1(p, l, SEQ, p.fh1() + (long)l * SEQ * FILTER_HIDDEN, gtid, gsize);
  hy_f1(p, 0, CTX_LEN, p.fh1c(), gtid, gsize);
  FOR_ITEMS(i, (long)DEPTH * 2 * S5_GROUPS * S5_T * S5_GROUP * S5_GROUP) {
    int j = (int)(i % S5_GROUP); int ii = (int)((i / S5_GROUP) % S5_GROUP); int d = (int)((i / (S5_GROUP * S5_GROUP)) % S5_T);
    long ldg = i / (S5_GROUP * S5_GROUP * S5_T);
    float acc = 0.f;
    for (int pp = 0; pp < S5_STATE; ++pp) {
      float cr = p.s5_c_re[(ldg * S5_GROUP + ii) * S5_STATE + pp], ci = p.s5_c_im[(ldg * S5_GROUP + ii) * S5_STATE + pp];
      float2 lp = p.lampow()[(ldg * (S5_T + 1) + d) * S5_STATE + pp];
      float2 bb = p.bbar()[(ldg * S5_STATE + pp) * S5_GROUP + j];
      float tr = lp.x * bb.x - lp.y * bb.y, ti = lp.x * bb.y + lp.y * bb.x;
      acc += cr * tr - ci * ti;
    }
    p.kc()[i] = acc;
  }
}
DEV void ph_g2(const P& p, long gtid, long gsize) {
  for (int l = 0; l < DEPTH; ++l) hy_f2(p, l, SEQ, p.fh1() + (long)l * SEQ * FILTER_HIDDEN, p.fh2() + (long)l * SEQ * FILTER_HIDDEN, gtid, gsize);
  hy_f2(p, 0, CTX_LEN, p.fh1c(), p.fh2c(), gtid, gsize);
}
DEV void ph_g3(const P& p, long gtid, long gsize) {
  for (int l = 0; l < DEPTH; ++l) hy_f3(p, l, SEQ, p.fh2() + (long)l * SEQ * FILTER_HIDDEN, p.kraw() + (long)l * SEQ * 2 * HYENA_W, gtid, gsize);
  hy_f3(p, 0, CTX_LEN, p.fh2c(), p.krawc(), gtid, gsize);
}
DEV void ph_g4(const P& p, long gtid, long gsize) {
  for (int l = 0; l < DEPTH; ++l) hy_f4(SEQ, p.kraw() + (long)l * SEQ * 2 * HYENA_W, p.knorm() + l * HYENA_W, gtid, gsize);
  hy_f4(CTX_LEN, p.krawc(), p.knormc(), gtid, gsize);
}
#define NG 5

DEV void ph_modu(const P& p, int l, int which, long gtid, long gsize) {
  FOR_ITEMS(i, (long)NR * D_MODEL) {
    int k = (int)(i % D_MODEL); long r = i / D_MODEL;
    const float* m = p.mod() + ((long)l * (BATCH + 1) + modrow(r)) * 6 * D_MODEL + which * 3 * D_MODEL;
    float uv = p.xcur()[i] * (1.0f + m[D_MODEL + k]) + m[k];
    p.ubuf()[i] = uv; p.ubf()[i] = f2bf16(uv);
  }
}
template <class Epi>
DEV void gemm_naive(const float* A, int lda, const float* B, int ldb, int M, int N, int K, Epi epi, long gtid, long gsize) {
  FOR_ITEMS(i, (long)(M / 4) * N) {
    int n = (int)(i % N); long r0 = (i / N) * 4;
    const float* a0 = A + r0 * lda;
    float c0 = 0.f, c1 = 0.f, c2 = 0.f, c3 = 0.f;
    for (int k = 0; k < K; ++k) {
      float b = B[(long)k * ldb + n];
      c0 += a0[k] * b; c1 += a0[lda + k] * b; c2 += a0[2 * lda + k] * b; c3 += a0[3 * lda + k] * b;
    }
    epi(r0, n, c0); epi(r0 + 1, n, c1); epi(r0 + 2, n, c2); epi(r0 + 3, n, c3);
  }
}
struct EpiStore { float* C; int ldc; DEVM void operator()(long r, int n, float v) const { C[r * ldc + n] = v; } };
DEV void ph_proj(const P& p, int l, long gtid, long gsize) {
  EpiStore e{p.proj(), IN_W};
  gemm_naive(p.ubuf(), D_MODEL, p.w_in + (long)l * D_MODEL * IN_W, IN_W, NR, IN_W, D_MODEL, e, gtid, gsize);
}
DEV long s5_row(int b, int dir, int n) {
  if (n < CTX_LEN) return (long)NL + b * CTX_LEN + (dir ? CTX_LEN - 1 - n : n);
  int t = n - CTX_LEN; return (long)b * SEQ + (dir ? SEQ - 1 - t : t);
}
DEV void ph_post_proj(const P& p, int l, long gtid, long gsize) {
  FOR_ITEMS(i, (long)NL * (N_Q_HEADS + N_KV_HEADS) * 2 * ROPE_HALF) {
    int ii = (int)(i % ROPE_HALF); int a = (int)((i / ROPE_HALF) % 2); int hs = (int)((i / (2 * ROPE_HALF)) % (N_Q_HEADS + N_KV_HEADS));
    long r = i / (2 * ROPE_HALF * (N_Q_HEADS + N_KV_HEADS));
    int t = (int)(r % SEQ); int pos = a == 0 ? t / GRID_W : t % GRID_W;
    float inv = powf(10000.0f, -(float)(2 * ii) / (float)AXIS_DIM);
    float ang = (float)pos * inv; float cs = cosf(ang), sn = sinf(ang);
    float* q = p.proj() + r * IN_W + hs * HEAD_DIM + a * AXIS_DIM + ii;
    float x1 = q[0], x2 = q[ROPE_HALF];
    q[0] = x1 * cs - x2 * sn; q[ROPE_HALF] = x1 * sn + x2 * cs;
  }
#ifdef CPU_TEST
  FOR_ITEMS(i, (long)NR * HYENA_W) {
    int ch = (int)(i % HYENA_W); long r = i / HYENA_W;
    int Ls = r < NL ? SEQ : CTX_LEN; long base = r < NL ? (r / SEQ) * SEQ : NL + ((r - NL) / CTX_LEN) * CTX_LEN; int t = (int)(r - base);
    const float* sw = p.hy_short_w + l * 3 * 3 * HYENA_W; const float* sb = p.hy_short_b + l * 3 * HYENA_W;
    float z[3];
#pragma unroll
    for (int part = 0; part < 3; ++part) {
      int cc = part * HYENA_W + ch; float acc = sb[cc];
#pragma unroll
      for (int j = 0; j < 3; ++j) { int tt = t + j - 1; if (tt >= 0 && tt < Ls) acc += p.proj()[(base + tt) * IN_W + HY_OFF + cc] * sw[j * 3 * HYENA_W + cc]; }
      z[part] = acc;
    }
    long o = r < NL ? ((r / SEQ) * HYENA_W + ch) * SEQ + t : i;
    p.hu()[o] = z[0] * z[1]; p.hx0()[o] = z[2];
  }
#endif
#ifndef CPU_TEST
  FOR_ITEMS(i, (long)NR * S5_W) { long r = i / S5_W; int cc = (int)(i % S5_W); p.s5u()[i] = f2bf16(p.proj()[r * IN_W + S5_OFF + cc]); }
#endif
#ifdef CPU_TEST
  FOR_ITEMS(i, (long)BATCH * 2 * S5_GROUPS * NCH * S5_STATE) {
    int pp = (int)(i % S5_STATE); int c = (int)((i / S5_STATE) % NCH); int g = (int)((i / (S5_STATE * NCH)) % S5_GROUPS);
    int dir = (int)((i / (S5_STATE * NCH * S5_GROUPS)) % 2); int b = (int)(i / (S5_STATE * NCH * S5_GROUPS * 2));
    long ldg = ((long)l * 2 + dir) * S5_GROUPS + g;
    float sr = 0.f, si = 0.f;
    for (int s = 0; s < S5_T; ++s) {
      const float* u = p.proj() + s5_row(b, dir, c * S5_T + s) * IN_W + S5_OFF + g * S5_GROUP;
      float br = 0.f, bi = 0.f;
#pragma unroll
      for (int j = 0; j < S5_GROUP; ++j) { float2 bb = p.bbar()[(ldg * S5_STATE + pp) * S5_GROUP + j]; br += bb.x * u[j]; bi += bb.y * u[j]; }
      float2 lp = p.lampow()[(ldg * (S5_T + 1) + (S5_T - 1 - s)) * S5_STATE + pp];
      sr += lp.x * br - lp.y * bi; si += lp.x * bi + lp.y * br;
    }
    p.sc()[i] = make_float2(sr, si);
  }
#endif
}
DEV void attn_item(const P& p, int l, long r, int h, float* outp) {
  const float scale = 1.0f / sqrtf((float)HEAD_DIM);
  float q[HEAD_DIM], acc[HEAD_DIM];
  const float* qp = p.proj() + r * IN_W + Q_OFF + h * HEAD_DIM;
#pragma unroll
  for (int d = 0; d < HEAD_DIM; ++d) { q[d] = qp[d] * scale; acc[d] = 0.f; }
  int kvh = h / Q_GROUP; int b = r < NL ? (int)(r / SEQ) : (int)((r - NL) / CTX_LEN);
  float m = -1e30f, lsum = 0.f;
  int nwin = 0, t = 0;
  if (r < NL) { t = (int)(r % SEQ); nwin = 2 * WINDOW + 1; }
  for (int j = 0; j < nwin + CTX_LEN; ++j) {
    long kr;
    if (j < nwin) { int tk = t - WINDOW + j; if (tk < 0 || tk >= SEQ) continue; kr = (long)b * SEQ + tk; }
    else kr = (long)NL + b * CTX_LEN + (j - nwin);
    const float* kp = p.proj() + kr * IN_W + K_OFF + kvh * HEAD_DIM; const float* vp = p.proj() + kr * IN_W + V_OFF + kvh * HEAD_DIM;
    float s = 0.f;
#pragma unroll
    for (int d = 0; d < HEAD_DIM; ++d) s += q[d] * kp[d];
    float mn = fmaxf(m, s); float corr = expf(m - mn); float pe = expf(s - mn);
    lsum = lsum * corr + pe;
#pragma unroll
    for (int d = 0; d < HEAD_DIM; ++d) acc[d] = acc[d] * corr + pe * vp[d];
    m = mn;
  }
  float sk = p.sink[l * N_Q_HEADS + h]; float mf = fmaxf(m, sk); float corr = expf(m - mf);
  float den = lsum * corr + expf(sk - mf); float sc2 = corr / den;
#pragma unroll
  for (int d = 0; d < HEAD_DIM; ++d) outp[d] = acc[d] * sc2;
}
DEV void ph_mix(const P& p, int l, long gtid, long gsize) {
#ifdef CPU_TEST
  long nrows_att = l == 0 ? NR : NL;
  FOR_ITEMS(i, nrows_att * N_Q_HEADS) { int h = (int)(i % N_Q_HEADS); long r = i / N_Q_HEADS; attn_item(p, l, r, h, p.mixb() + r * MIX_W + h * HEAD_DIM); }
#endif
#ifdef CPU_TEST
  FOR_ITEMS(i, (long)NL * HYENA_W) {
    int ch = (int)(i % HYENA_W); long r = i / HYENA_W; int t = (int)(r % SEQ); int b = (int)(r / SEQ);
    const float* kf = p.kraw() + ((long)l * 2 * HYENA_W + ch) * SEQ; const float* kb = p.kraw() + ((long)l * 2 * HYENA_W + HYENA_W + ch) * SEQ;
    const float* uu = p.hu() + ((long)b * HYENA_W + ch) * SEQ;
    float acc = 0.f;
    for (int s = 0; s <= t; ++s) acc += kf[t - s] * uu[s];
    for (int s = t + 1; s < SEQ; ++s) acc += kb[s - t] * uu[s];
    p.mixb()[r * MIX_W + ATTN_W + ch] = (acc * p.knorm()[l * HYENA_W + ch] + uu[t] * p.hy_d[l * HYENA_W + ch]) * p.hx0()[((long)b * HYENA_W + ch) * SEQ + t];
  }
#endif
  if (l == 0) {
#ifndef CPU_TEST
    FOR_ITEMS(i, (long)NC * HYENA_W) {
      const int t = (int)(i % CTX_LEN); const int ch = (int)((i / CTX_LEN) % HYENA_W); const int b = (int)(i / ((long)CTX_LEN * HYENA_W));
      const long base = (long)NL + (long)b * CTX_LEN; const long r = base + t;
      const float* kf = p.krawc() + (long)ch * CTX_LEN; const float* kb = p.krawc() + (long)(HYENA_W + ch) * CTX_LEN;
      float acc = 0.f;
#pragma unroll 8
      for (int sidx = 0; sidx < CTX_LEN; ++sidx) {
        const int d = t - sidx; const float kv = d >= 0 ? kf[d] : kb[-d];
        acc += kv * p.hu()[(base + sidx) * HYENA_W + ch];
      }
      const float u = p.hu()[r * HYENA_W + ch];
      p.mixb()[r * MIX_W + ATTN_W + ch] = (acc * p.knormc()[ch] + u * p.hy_d[l * HYENA_W + ch]) * p.hx0()[r * HYENA_W + ch];
    }
#else
    FOR_ITEMS(i, (long)NC * HYENA_W) {
      int ch = (int)(i % HYENA_W); long r = NL + i / HYENA_W; int t = (int)((r - NL) % CTX_LEN); long base = r - t;
      float acc = 0.f;
      for (int s = 0; s <= t; ++s) acc += p.krawc()[(long)ch * CTX_LEN + (t - s)] * p.hu()[(base + s) * HYENA_W + ch];
      for (int s = t + 1; s < CTX_LEN; ++s) acc += p.krawc()[(long)(HYENA_W + ch) * CTX_LEN + (s - t)] * p.hu()[(base + s) * HYENA_W + ch];
      float u = p.hu()[r * HYENA_W + ch];
      p.mixb()[r * MIX_W + ATTN_W + ch] = (acc * p.knormc()[ch] + u * p.hy_d[l * HYENA_W + ch]) * p.hx0()[r * HYENA_W + ch];
    }
#endif
  }
#ifdef CPU_TEST
  FOR_ITEMS(i, (long)BATCH * 2 * S5_GROUPS * S5_STATE) {
    int pp = (int)(i % S5_STATE); int g = (int)((i / S5_STATE) % S5_GROUPS); int dir = (int)((i / (S5_STATE * S5_GROUPS)) % 2); int b = (int)(i / (S5_STATE * S5_GROUPS * 2));
    long ldg = ((long)l * 2 + dir) * S5_GROUPS + g;
    float2 lt = p.lampow()[(ldg * (S5_T + 1) + S5_T) * S5_STATE + pp];
    float hr = 0.f, hi = 0.f;
    long base = (((long)b * 2 + dir) * S5_GROUPS + g) * NCH;
#ifndef CPU_TEST
    static_assert(NCH % 12 == 0, "carry batching");
    for (int c0 = 0; c0 < NCH; c0 += 12) {
      float2 sv[12];
#pragma unroll
      for (int k = 0; k < 12; ++k) sv[k] = p.sc()[(base + c0 + k) * S5_STATE + pp];
#pragma unroll
      for (int k = 0; k < 12; ++k) {
        p.hcbf()[(base + c0 + k) * 2 * S5_STATE + pp] = f2bf16(hr); p.hcbf()[(base + c0 + k) * 2 * S5_STATE + S5_STATE + pp] = f2bf16(hi);
        const float nr = lt.x * hr - lt.y * hi + sv[k].x, ni = lt.x * hi + lt.y * hr + sv[k].y;
        hr = nr; hi = ni;
      }
    }
#else
    for (int c = 0; c < NCH; ++c) {
      p.hc()[(base + c) * S5_STATE + pp] = make_float2(hr, hi);
      float2 s = p.sc()[(base + c) * S5_STATE + pp];
      float nr = lt.x * hr - lt.y * hi + s.x, ni = lt.x * hi + lt.y * hr + s.y;
      hr = nr; hi = ni;
    }
#endif
  }
#endif
}
DEV void ph_s5out(const P& p, int l, long gtid, long gsize) {
  FOR_ITEMS(i, (long)NR * S5_W) {
    int chn = (int)(i % S5_W); long r = i / S5_W; int g = chn / S5_GROUP, ii = chn % S5_GROUP;
    int b, tl; bool isctx = r >= NL;
    if (isctx) { b = (int)((r - NL) / CTX_LEN); tl = (int)((r - NL) % CTX_LEN); } else { b = (int)(r / SEQ); tl = (int)(r % SEQ); }
    float y = p.s5_d[l * S5_W + chn] * p.proj()[r * IN_W + S5_OFF + chn];
    for (int dir = 0; dir < 2; ++dir) {
      int n = isctx ? (dir ? CTX_LEN - 1 - tl : tl) : CTX_LEN + (dir ? SEQ - 1 - tl : tl);
      int c = n / S5_T, tau = n % S5_T;
      long ldg = ((long)l * 2 + dir) * S5_GROUPS + g;
      long hb = ((((long)b * 2 + dir) * S5_GROUPS + g) * NCH + c) * S5_STATE;
      for (int pp = 0; pp < S5_STATE; ++pp) {
        float cr = p.s5_c_re[(ldg * S5_GROUP + ii) * S5_STATE + pp], ci = p.s5_c_im[(ldg * S5_GROUP + ii) * S5_STATE + pp];
        float2 lp = p.lampow()[(ldg * (S5_T + 1) + tau + 1) * S5_STATE + pp]; float2 h = p.hc()[hb + pp];
        float tr = lp.x * h.x - lp.y * h.y, ti = lp.x * h.y + lp.y * h.x;
        y += cr * tr - ci * ti;
      }
      for (int s = 0; s <= tau; ++s) {
        const float* u = p.proj() + s5_row(b, dir, c * S5_T + s) * IN_W + S5_OFF + g * S5_GROUP;
        const float* kk = p.kc() + ((ldg * S5_T + (tau - s)) * S5_GROUP + ii) * S5_GROUP;
#pragma unroll
        for (int j = 0; j < S5_GROUP; ++j) y += kk[j] * u[j];
      }
    }
    float gy = gelu_tanhf(y); p.ybuf()[i] = gy; p.ybf()[i] = f2bf16(gy);
  }
}
struct EpiGlu { const float* g; float* mixb; DEVM void operator()(long r, int n, float v) const { mixb[r * MIX_W + ATTN_W + HYENA_W + n] = g[r * S5_W + n] * sigmoidf_(v); } };
DEV void ph_glu(const P& p, int l, long gtid, long gsize) {
  EpiGlu e{p.ybuf(), p.mixb()};
  gemm_naive(p.ybuf(), S5_W, p.s5_w_glu + (long)l * S5_W * S5_W, S5_W, NR, S5_W, S5_W, e, gtid, gsize);
}
DEV void ph_rms(const P& p, int l, long gtid, long gsize) {
  FOR_ITEMS(i, (long)NR * 3) {
    int grp = (int)(i % 3); long r = i / 3;
    int off = grp == 0 ? 0 : (grp == 1 ? ATTN_W : ATTN_W + HYENA_W); int w = grp == 0 ? ATTN_W : (grp == 1 ? HYENA_W : S5_W);
    float* v = p.mixb() + r * MIX_W + off; float ss = 0.f;
    for (int k = 0; k < w; ++k) ss += v[k] * v[k];
    float rs = 1.0f / sqrtf(ss / (float)w + LN_EPS);
    for (int k = 0; k < w; ++k) { float nv = v[k] * rs * p.mix_g[l * MIX_W + off + k]; v[k] = nv; p.mixbf()[r * MIX_W + off + k] = f2bf16(nv); }
  }
}
struct EpiRes { const float* xcur; const float* mod; int l; int goff; float* tmp;
  DEVM void operator()(long r, int n, float v) const { const float* m = mod + ((long)l * (BATCH + 1) + modrow(r)) * 6 * D_MODEL + goff; tmp[r * D_MODEL + n] = DN_ALPHA * xcur[r * D_MODEL + n] + m[n] * v; } };
DEV void ph_outproj(const P& p, int l, long gtid, long gsize) {
  EpiRes e{p.xcur(), p.mod(), l, 2 * D_MODEL, p.tmp()};
  gemm_naive(p.mixb(), MIX_W, p.w_out + (long)l * MIX_W * D_MODEL, D_MODEL, NR, D_MODEL, MIX_W, e, gtid, gsize);
}
DEV void ph_ln(const P& p, int l, int which, long gtid, long gsize) {
  const float* gw = (which == 0 ? p.ln1_g : p.ln2_g) + l * D_MODEL; const float* bw = (which == 0 ? p.ln1_b : p.ln2_b) + l * D_MODEL;
  FOR_ITEMS(r, (long)NR) {
    const float* v = p.tmp() + r * D_MODEL; float mu = 0.f;
#pragma unroll 4
    for (int k = 0; k < D_MODEL; ++k) mu += v[k];
    mu /= (float)D_MODEL; float var = 0.f;
#pragma unroll 4
    for (int k = 0; k < D_MODEL; ++k) { float d = v[k] - mu; var += d * d; }
    float rs = 1.0f / sqrtf(var / (float)D_MODEL + LN_EPS);
    const float* m = p.mod() + ((long)l * (BATCH + 1) + modrow(r)) * 6 * D_MODEL + 3 * D_MODEL;
#pragma unroll 2
    for (int k = 0; k < D_MODEL; ++k) {
      float y = (v[k] - mu) * rs * gw[k] + bw[k];
      p.xcur()[r * D_MODEL + k] = y;
      if (which == 0) { float uv = y * (1.0f + m[D_MODEL + k]) + m[k]; p.ubuf()[r * D_MODEL + k] = uv; p.ubf()[r * D_MODEL + k] = f2bf16(uv); }
      if (which == 1 && l == DEPTH - 1 && r < NL) p.out[r * D_MODEL + k] = y;
    }
  }
}
DEV void ph_router(const P& p, int l, long gtid, long gsize) {
  EpiStore e{p.rl(), N_EXPERTS};
  gemm_naive(p.ubuf(), D_MODEL, p.w_router + (long)l * D_MODEL * N_EXPERTS, N_EXPERTS, NR, N_EXPERTS, D_MODEL, e, gtid, gsize);
}
DEV bool better(float v, int i, float bv, int bi) { return v > bv || (v == bv && i < bi); }
DEV void ph_select(const P& p, int l, long gtid, long gsize) {
  FOR_ITEMS(r, (long)NR) {
    const float* lg = p.rl() + r * N_EXPERTS; const float* rb = p.router_bias + l * N_EXPERTS;
    float gs[N_EXPERT_GROUPS];
#pragma unroll
    for (int g = 0; g < N_EXPERT_GROUPS; ++g) {
      float m1 = -1e30f, m2 = -1e30f;
      for (int e = 0; e < EPG; ++e) { float v = sigmoidf_(lg[g * EPG + e]) + rb[g * EPG + e]; if (v > m1) { m2 = m1; m1 = v; } else if (v > m2) m2 = v; }
      gs[g] = m1 + m2;
    }
    unsigned keep = 0;
#pragma unroll
    for (int it = 0; it < TOPK_GROUPS; ++it) {
      float bv = -1e30f; int bi = -1;
#pragma unroll
      for (int g = 0; g < N_EXPERT_GROUPS; ++g) if (!((keep >> g) & 1u) && (bi < 0 || gs[g] > bv)) { bv = gs[g]; bi = g; }
      keep |= 1u << bi;
    }
    float lastv = 1e30f; int lasti = -1; float gsum = 0.f;
    for (int it = 0; it < TOP_K; ++it) {
      float bv = -1e30f; int bi = -1;
      for (int e = 0; e < N_EXPERTS; ++e) {
        if (!((keep >> (e / EPG)) & 1u)) continue;
        float v = sigmoidf_(lg[e]) + rb[e];
        if (!better(lastv, lasti, v, e)) continue;
        if (bi < 0 || better(v, e, bv, bi)) { bv = v; bi = e; }
      }
      lastv = bv; lasti = bi;
      float sc = sigmoidf_(lg[bi]); gsum += sc;
      p.top_e()[r * TOP_K + it] = bi; p.gate()[r * TOP_K + it] = sc;
      p.posb()[r * TOP_K + it] = atomicAdd(&p.cnt()[l * N_EXPERTS + bi], 1);
    }
    float inv = ROUTED_SCALE / gsum;
    for (int it = 0; it < TOP_K; ++it) p.gate()[r * TOP_K + it] *= inv;
  }
}
DEV void ph_sortrows(const P& p, int l, long gtid, long gsize) {
  FOR_ITEMS(i, (long)NR * TOP_K) {
    int e = p.top_e()[i]; int off = 0;
    for (int j = 0; j < e; ++j) off += p.cnt()[l * N_EXPERTS + j];
    p.srow()[off + p.posb()[i]] = (int)i;
  }
}
DEV void ph_expert_up(const P& p, int l, long gtid, long gsize) {
  FOR_ITEMS(i, (long)NR * TOP_K * EXPERT_FF) {
    int cidx = (int)(i % EXPERT_FF); int a = p.srow()[i / EXPERT_FF]; int e = p.top_e()[a]; long r = a / TOP_K;
    const float* xg = p.ubuf() + r * D_MODEL;
    const float* wg = p.w_exp_gate + ((long)l * N_EXPERTS + e) * D_MODEL * EXPERT_FF; const float* wu = p.w_exp_up + ((long)l * N_EXPERTS + e) * D_MODEL * EXPERT_FF;
    float g = 0.f, u = 0.f;
    for (int k = 0; k < D_MODEL; ++k) { float xv = xg[k]; g += xv * wg[(long)k * EXPERT_FF + cidx]; u += xv * wu[(long)k * EXPERT_FF + cidx]; }
    p.hbuf()[(long)a * EXPERT_FF + cidx] = siluf(g) * u;
  }
  FOR_ITEMS(i, (long)NR * SHARED_FF) {
    int cidx = (int)(i % SHARED_FF); long r = i / SHARED_FF;
    const float* xg = p.ubuf() + r * D_MODEL;
    const float* wg = p.w_sh_gate + (long)l * D_MODEL * SHARED_FF; const float* wu = p.w_sh_up + (long)l * D_MODEL * SHARED_FF;
    float g = 0.f, u = 0.f;
    for (int k = 0; k < D_MODEL; ++k) { float xv = xg[k]; g += xv * wg[(long)k * SHARED_FF + cidx]; u += xv * wu[(long)k * SHARED_FF + cidx]; }
    p.hsb()[i] = siluf(g) * u;
  }
}
DEV void ph_expert_down(const P& p, int l, long gtid, long gsize) {
  FOR_ITEMS(i, (long)NR * TOP_K * D_MODEL) {
    int d = (int)(i % D_MODEL); long a = i / D_MODEL;
    int e = p.top_e()[a]; const float* wd = p.w_exp_down + ((long)l * N_EXPERTS + e) * EXPERT_FF * D_MODEL;
    const float* h = p.hbuf() + a * EXPERT_FF; float acc = 0.f;
    for (int cidx = 0; cidx < EXPERT_FF; ++cidx) acc += h[cidx] * wd[(long)cidx * D_MODEL + d];
    p.yk()[i] = acc * p.gate()[a];
  }
  FOR_ITEMS(i, (long)NR * D_MODEL) {
    int d = (int)(i % D_MODEL); long r = i / D_MODEL;
    const float* wsd = p.w_sh_down + (long)l * SHARED_FF * D_MODEL; const float* hs = p.hsb() + r * SHARED_FF;
    float acc = 0.f;
    for (int cidx = 0; cidx < SHARED_FF; ++cidx) acc += hs[cidx] * wsd[(long)cidx * D_MODEL + d];
    p.ysh()[i] = acc;
  }
}
DEV void ph_combine(const P& p, int l, long gtid, long gsize) {
#pragma unroll 1
  FOR_ITEMS(i, (long)NR * D_MODEL) {
    int d = (int)(i % D_MODEL); long r = i / D_MODEL;
    float f = p.ysh()[i];
#pragma unroll
    for (int k = 0; k < TOP_K; ++k) f += p.yk()[(r * TOP_K + k) * D_MODEL + d];
    const float* m = p.mod() + ((long)l * (BATCH + 1) + modrow(r)) * 6 * D_MODEL + 5 * D_MODEL;
    p.tmp()[i] = DN_ALPHA * p.xcur()[i] + m[d] * f;
  }
}
#define NLP 16


#ifndef CPU_TEST
typedef __attribute__((ext_vector_type(8))) short bf16x8;
typedef __attribute__((ext_vector_type(4))) float f32x4;
typedef __attribute__((ext_vector_type(4))) unsigned u32x4;
typedef __attribute__((ext_vector_type(2))) unsigned u32x2;
static_assert(N_EXPERTS == 256 && D_MODEL % 128 == 0 && NR % 128 == 0, "shape assumptions");
#define SM_XB 0
#define NT 512
#define SM_A 256
#define SM_B (256 + 16384)
#define SM_MISC (256 + 98304)
#define SMEM_BYTES (256 + 98304 + 4096)

DEV int otid() { int t = threadIdx.x; asm volatile("" : "+v"(t)); return t; }
typedef __bf16 bf16x2_t __attribute__((ext_vector_type(2)));
typedef float f32x2_t __attribute__((ext_vector_type(2)));
DEV unsigned pack2(float a, float b) { f32x2_t v = {a, b}; return __builtin_bit_cast(unsigned, __builtin_convertvector(v, bf16x2_t)); }
DEV unsigned f2bf(float f) { return pack2(f, 0.f) & 0xffffu; }
DEV int tile_off(int row, int chunk) { return row * 128 + ((chunk ^ ((row >> 1) & 7)) << 4); }

DEV float bflo(float x) { return x - __uint_as_float(f2bf(x) << 16); }
DEV void wt_convert(const float* W, unsigned short* WT, int K, int N, bool lo, long gtid, long gsize) {
  FOR_ITEMS4(i, (long)N * (K / 8)) {
    const int n = (int)(i % N); const int k8 = (int)(i / N) * 8;
    float v[8];
#pragma unroll
    for (int j = 0; j < 8; ++j) { const float x = W[(long)(k8 + j) * N + n]; v[j] = lo ? bflo(x) : x; }
    u32x4 o; o[0] = pack2(v[0], v[1]); o[1] = pack2(v[2], v[3]); o[2] = pack2(v[4], v[5]); o[3] = pack2(v[6], v[7]);
    *(u32x4*)(WT + (long)n * K + k8) = o;
  }
}
DEV void wt_convert_all(const P& p, long gtid, long gsize) {
  for (int l = 0; l < DEPTH; ++l) {
    wt_convert(p.w_in + (long)l * D_MODEL * IN_W, p.wt_in() + (long)l * IN_W * D_MODEL, D_MODEL, IN_W, false, gtid, gsize);
    wt_convert(p.w_out + (long)l * MIX_W * D_MODEL, p.wt_out() + (long)l * D_MODEL * MIX_W, MIX_W, D_MODEL, false, gtid, gsize);
    wt_convert(p.s5_w_glu + (long)l * S5_W * S5_W, p.wt_glu() + (long)l * S5_W * S5_W, S5_W, S5_W, false, gtid, gsize);
    wt_convert(p.w_sh_gate + (long)l * D_MODEL * SHARED_FF, p.wt_shg() + (long)l * SHARED_FF * D_MODEL, D_MODEL, SHARED_FF, false, gtid, gsize);
    wt_convert(p.w_sh_up + (long)l * D_MODEL * SHARED_FF, p.wt_shu() + (long)l * SHARED_FF * D_MODEL, D_MODEL, SHARED_FF, false, gtid, gsize);
    wt_convert(p.w_sh_down + (long)l * SHARED_FF * D_MODEL, p.wt_shd() + (long)l * D_MODEL * SHARED_FF, SHARED_FF, D_MODEL, false, gtid, gsize);
    wt_convert(p.w_router + (long)l * D_MODEL * N_EXPERTS, p.wt_rh() + (long)l * N_EXPERTS * D_MODEL, D_MODEL, N_EXPERTS, false, gtid, gsize);
    wt_convert(p.w_router + (long)l * D_MODEL * N_EXPERTS, p.wt_rl() + (long)l * N_EXPERTS * D_MODEL, D_MODEL, N_EXPERTS, true, gtid, gsize);
  }
}
struct ALRows { const char* base; unsigned off[2]; DEVM const unsigned short* a(int i, int kt) const { return (const unsigned short*)(base + (off[i] + (unsigned)kt * 128u)); } };
struct BLStd { static constexpr bool TR = false; const char* base; unsigned voff; int ldb4; bool valid;
  DEVM void load(float4 (&rb)[8], int kt) const {
#pragma unroll
    for (int i = 0; i < 8; ++i) rb[i] = valid ? *(const float4*)(base + (unsigned)((unsigned)(kt * 64 + i) * (unsigned)ldb4 + voff)) : make_float4(0.f, 0.f, 0.f, 0.f); } };
DEV unsigned bl_voff(int ldb4, int tid) { return (unsigned)((tid & 7) * 8) * (unsigned)ldb4 + (unsigned)((tid >> 3) * 16); }
DEV BLStd mk_bl(const float* B  , int ldb, int tid) {
  BLStd b; b.base = (const char*)B; b.ldb4 = ldb * 4; b.voff = bl_voff(ldb * 4, tid); b.valid = true; return b; }
#define SM_TILE 49152
template <int V = 0, class AL, class BL>
DEV void gemm_t(const AL& al, const BL& bl, int nk, f32x4 (&acc)[4][4], char* smem) {
  const int tid = otid(), lane = tid & 63, wid = tid >> 6, wr = wid >> 2, wc = wid & 3;
  const int l15 = lane & 15, q = lane >> 4, x = l15 >> 1;
  const char* ard0 = smem + SM_A + (wr * 64 + l15) * 128 + ((q ^ x) << 4);
  const char* ard1 = smem + SM_A + (wr * 64 + l15) * 128 + (((4 + q) ^ x) << 4);
  const char* brd0 = smem + SM_B + (wc * 64 + l15) * 128 + ((q ^ x) << 4);
  const char* brd1 = smem + SM_B + (wc * 64 + l15) * 128 + (((4 + q) ^ x) << 4);
  const int kq = tid & 7, nq = tid >> 3;
  char* awr = smem + SM_A + nq * 128 + ((kq ^ ((nq >> 1) & 7)) << 4);
  char* bwr0 = smem + SM_B + (nq * 4) * 128 + ((kq ^ ((2 * nq) & 7)) << 4);
  char* bwr1 = smem + SM_B + (nq * 4 + 2) * 128 + ((kq ^ ((2 * nq + 1) & 7)) << 4);
  if (nk <= 0) return;
  u32x4 ra[2]; float4 rb0[8];
#define GEMM_LOADA(KT) do { _Pragma("unroll") for (int i = 0; i < 2; ++i) ra[i] = *(const u32x4*)(al.a(i, (KT))); } while (0)
#define GEMM_WRITE(rb, PO) do { \
    *(u32x4*)(awr + (PO)) = ra[0]; *(u32x4*)(awr + (PO) + 8192) = ra[1]; \
    if (BL::TR) { u32x4 v; \
      v[0] = pack2(rb[0].x, rb[0].y); v[1] = pack2(rb[0].z, rb[0].w); v[2] = pack2(rb[1].x, rb[1].y); v[3] = pack2(rb[1].z, rb[1].w); *(u32x4*)(bwr0 + (PO)) = v; \
      v[0] = pack2(rb[2].x, rb[2].y); v[1] = pack2(rb[2].z, rb[2].w); v[2] = pack2(rb[3].x, rb[3].y); v[3] = pack2(rb[3].z, rb[3].w); *(u32x4*)(bwr0 + (PO) + 128) = v; \
      v[0] = pack2(rb[4].x, rb[4].y); v[1] = pack2(rb[4].z, rb[4].w); v[2] = pack2(rb[5].x, rb[5].y); v[3] = pack2(rb[5].z, rb[5].w); *(u32x4*)(bwr1 + (PO)) = v; \
      v[0] = pack2(rb[6].x, rb[6].y); v[1] = pack2(rb[6].z, rb[6].w); v[2] = pack2(rb[7].x, rb[7].y); v[3] = pack2(rb[7].z, rb[7].w); *(u32x4*)(bwr1 + (PO) + 128) = v; \
    } else { u32x4 v; \
      v[0] = pack2(rb[0].x, rb[1].x); v[1] = pack2(rb[2].x, rb[3].x); v[2] = pack2(rb[4].x, rb[5].x); v[3] = pack2(rb[6].x, rb[7].x); *(u32x4*)(bwr0 + (PO)) = v; \
      v[0] = pack2(rb[0].y, rb[1].y); v[1] = pack2(rb[2].y, rb[3].y); v[2] = pack2(rb[4].y, rb[5].y); v[3] = pack2(rb[6].y, rb[7].y); *(u32x4*)(bwr0 + (PO) + 128) = v; \
      v[0] = pack2(rb[0].z, rb[1].z); v[1] = pack2(rb[2].z, rb[3].z); v[2] = pack2(rb[4].z, rb[5].z); v[3] = pack2(rb[6].z, rb[7].z); *(u32x4*)(bwr1 + (PO)) = v; \
      v[0] = pack2(rb[0].w, rb[1].w); v[1] = pack2(rb[2].w, rb[3].w); v[2] = pack2(rb[4].w, rb[5].w); v[3] = pack2(rb[6].w, rb[7].w); *(u32x4*)(bwr1 + (PO) + 128) = v; \
    } } while (0)
  GEMM_LOADA(0);
  bl.load(rb0, 0);
  __syncthreads();
  GEMM_WRITE(rb0, 0);
  if (V != 3) { if (nk > 1) { GEMM_LOADA(1); bl.load(rb0, 1); } }
  __syncthreads();
#define GEMM_STEP(rbn, KT) do { \
    const int po = ((KT) & 1) * SM_TILE; \
    bf16x8 fa0[4], fb0[4], fa1[4], fb1[4]; \
    _Pragma("unroll") for (int n = 0; n < 4; ++n) fb0[n] = *(const bf16x8*)(brd0 + po + n * 2048); \
    _Pragma("unroll") for (int m = 0; m < 4; ++m) fa0[m] = *(const bf16x8*)(ard0 + po + m * 2048); \
    _Pragma("unroll") for (int n = 0; n < 4; ++n) fb1[n] = *(const bf16x8*)(brd1 + po + n * 2048); \
    _Pragma("unroll") for (int m = 0; m < 4; ++m) fa1[m] = *(const bf16x8*)(ard1 + po + m * 2048); \
    __builtin_amdgcn_sched_barrier(0);     \
    if ((KT) + 1 < nk) { \
      GEMM_WRITE(rbn, SM_TILE - po); \
      if (V != 3) { if ((KT) + 2 < nk) { GEMM_LOADA((KT) + 2); bl.load(rbn, (KT) + 2); } } \
    } \
    __builtin_amdgcn_sched_barrier(0); \
    if (V != 2) { \
      _Pragma("unroll") for (int m = 0; m < 4; ++m) _Pragma("unroll") for (int n = 0; n < 4; ++n) acc[m][n] = __builtin_amdgcn_mfma_f32_16x16x32_bf16(fa0[m], fb0[n], acc[m][n], 0, 0, 0); \
      _Pragma("unroll") for (int m = 0; m < 4; ++m) _Pragma("unroll") for (int n = 0; n < 4; ++n) acc[m][n] = __builtin_amdgcn_mfma_f32_16x16x32_bf16(fa1[m], fb1[n], acc[m][n], 0, 0, 0); \
    } else { _Pragma("unroll") for (int m = 0; m < 4; ++m) asm volatile("" :: "v"(fa0[m]), "v"(fb0[m]), "v"(fa1[m]), "v"(fb1[m])); } \
    __syncthreads(); \
  } while (0)
  int kt = 0;
#pragma unroll 1
  for (; kt < nk; ++kt) { GEMM_STEP(rb0, kt); }
#undef GEMM_STEP
#undef GEMM_WRITE
#undef GEMM_LOADA
}

struct BLT { const char* base; unsigned voff; unsigned rowb;
  DEVM void load(u32x4 (&rb)[4], int kt) const {
#pragma unroll
    for (int c = 0; c < 4; ++c) rb[c] = *(const u32x4*)(base + (voff + (unsigned)c * rowb + (unsigned)kt * 128u)); } };
DEV BLT mk_blt(const unsigned short* BT  , int K, int tid) {
  BLT b; b.base = (const char*)BT; b.rowb = (unsigned)K * 2u; b.voff = (unsigned)((tid >> 3) * 4) * b.rowb + (unsigned)((tid & 7) * 16); return b; }
template <class AL, class BL>
DEV void gemm_tb(const AL& al, const BL& bl, int nk, f32x4 (&acc)[4][4], char* smem) {
  const int tid = otid(), lane = tid & 63, wid = tid >> 6, wr = wid >> 2, wc = wid & 3;
  const int l15 = lane & 15, q = lane >> 4, x = l15 >> 1;
  const char* ard0 = smem + SM_A + (wr * 64 + l15) * 128 + ((q ^ x) << 4);
  const char* ard1 = smem + SM_A + (wr * 64 + l15) * 128 + (((4 + q) ^ x) << 4);
  const char* brd0 = smem + SM_B + (wc * 64 + l15) * 128 + ((q ^ x) << 4);
  const char* brd1 = smem + SM_B + (wc * 64 + l15) * 128 + (((4 + q) ^ x) << 4);
  const int kq = tid & 7, nq = tid >> 3;
  char* awr = smem + SM_A + nq * 128 + ((kq ^ ((nq >> 1) & 7)) << 4);
  char* bwr0 = smem + SM_B + (nq * 4) * 128 + ((kq ^ ((2 * nq) & 7)) << 4);
  char* bwr1 = smem + SM_B + (nq * 4 + 2) * 128 + ((kq ^ ((2 * nq + 1) & 7)) << 4);
  if (nk <= 0) return;
  u32x4 ra[2]; u32x4 rb0[4], rb1[4];
#define TB_LOADA(KT) do { _Pragma("unroll") for (int i = 0; i < 2; ++i) ra[i] = *(const u32x4*)(al.a(i, (KT))); } while (0)
#define TB_WRITE(rb, PO) do { \
    *(u32x4*)(awr + (PO)) = ra[0]; *(u32x4*)(awr + (PO) + 8192) = ra[1]; \
    *(u32x4*)(bwr0 + (PO)) = rb[0]; *(u32x4*)(bwr0 + (PO) + 128) = rb[1]; *(u32x4*)(bwr1 + (PO)) = rb[2]; *(u32x4*)(bwr1 + (PO) + 128) = rb[3]; } while (0)
  TB_LOADA(0);
  bl.load(rb0, 0);
  if (nk > 1) bl.load(rb1, 1);
  __syncthreads();
  TB_WRITE(rb0, 0);
  if (nk > 1) TB_LOADA(1);
  if (nk > 2) bl.load(rb0, 2);
  __syncthreads();
#define TB_STEP(rbn, KT) do { \
    const int po = ((KT) & 1) * SM_TILE; \
    bf16x8 fa0[4], fb0[4], fa1[4], fb1[4]; \
    _Pragma("unroll") for (int n = 0; n < 4; ++n) fb0[n] = *(const bf16x8*)(brd0 + po + n * 2048); \
    _Pragma("unroll") for (int m = 0; m < 4; ++m) fa0[m] = *(const bf16x8*)(ard0 + po + m * 2048); \
    _Pragma("unroll") for (int n = 0; n < 4; ++n) fb1[n] = *(const bf16x8*)(brd1 + po + n * 2048); \
    _Pragma("unroll") for (int m = 0; m < 4; ++m) fa1[m] = *(const bf16x8*)(ard1 + po + m * 2048); \
    __builtin_amdgcn_sched_barrier(0); \
    if ((KT) + 1 < nk) { \
      TB_WRITE(rbn, SM_TILE - po); \
      if ((KT) + 2 < nk) TB_LOADA((KT) + 2); \
      if ((KT) + 3 < nk) bl.load(rbn, (KT) + 3); \
    } \
    __builtin_amdgcn_sched_barrier(0); \
    _Pragma("unroll") for (int m = 0; m < 4; ++m) _Pragma("unroll") for (int n = 0; n < 4; ++n) acc[m][n] = __builtin_amdgcn_mfma_f32_16x16x32_bf16(fa0[m], fb0[n], acc[m][n], 0, 0, 0); \
    _Pragma("unroll") for (int m = 0; m < 4; ++m) _Pragma("unroll") for (int n = 0; n < 4; ++n) acc[m][n] = __builtin_amdgcn_mfma_f32_16x16x32_bf16(fa1[m], fb1[n], acc[m][n], 0, 0, 0); \
    __syncthreads(); \
  } while (0)
  int kt = 0;
#pragma unroll 1
  for (; kt + 1 < nk; kt += 2) { TB_STEP(rb1, kt); TB_STEP(rb0, kt + 1); }
  if (kt < nk) TB_STEP(rb1, kt);
#undef TB_STEP
#undef TB_WRITE
#undef TB_LOADA
}
DEV void acc_zero(f32x4 (&acc)[4][4]) {
#pragma unroll
  for (int m = 0; m < 4; ++m)
#pragma unroll
    for (int n = 0; n < 4; ++n) acc[m][n] = (f32x4){0.f, 0.f, 0.f, 0.f};
}
#define EPI_BEGIN const int etid = otid();
#define EPI_ROW(m, j) (((etid >> 8) & 1) * 64 + (m) * 16 + ((etid & 63) >> 4) * 4 + (j))
#define EPI_COL(n) (((etid >> 6) & 3) * 64 + (n) * 16 + (etid & 15))

template <class Epi>
DEV void gemm_phase_dense(const unsigned short* A, int lda, const unsigned short* BT, int N, int K, Epi epi, char* smem) {
  const int tid = otid(); const int nct = N >> 8; const int nitems = (NR >> 7) * nct;
  for (int it = blockIdx.x; it < nitems; it += gridDim.x) {
    const int rt = it / nct, ct = it - rt * nct;
    ALRows al; al.base = (const char*)(A + (long)rt * 128 * lda);
#pragma unroll
    for (int i = 0; i < 2; ++i) al.off[i] = (unsigned)(((tid >> 3) + 64 * i) * lda + (tid & 7) * 8) * 2u;
    const BLT bl = mk_blt(BT + (long)ct * 256 * K, K, tid);
    f32x4 acc[4][4]; acc_zero(acc);
    gemm_tb(al, bl, K >> 6, acc, smem);
    EPI_BEGIN
#pragma unroll
    for (int m = 0; m < 4; ++m)
#pragma unroll
      for (int n = 0; n < 4; ++n)
#pragma unroll
        for (int j = 0; j < 4; ++j) epi((long)rt * 128 + EPI_ROW(m, j), ct * 256 + EPI_COL(n), acc[m][n][j]);
  }
}
DEV void ph_proj_mfma(const P& p, int l, char* smem) {
  const int tid = otid(); const int nct = IN_W >> 8; const int nitems = (NR >> 7) * nct;
  const float* B = p.w_in + (long)l * D_MODEL * IN_W;
  for (int it = blockIdx.x; it < nitems; it += gridDim.x) {
    const int rt = it / nct, ct = it - rt * nct;
    ALRows al; al.base = (const char*)(p.ubf() + (long)rt * 128 * D_MODEL);
#pragma unroll
    for (int i = 0; i < 2; ++i) al.off[i] = (unsigned)(((tid >> 3) + 64 * i) * D_MODEL + (tid & 7) * 8) * 2u;
    const BLT bl = mk_blt(p.wt_in() + ((long)l * IN_W + ct * 256) * D_MODEL, D_MODEL, tid);
    f32x4 acc[4][4]; acc_zero(acc);
    gemm_tb(al, bl, D_MODEL >> 6, acc, smem);
    EPI_BEGIN
    if (ct >= HY_OFF / 256 && ct < S5_OFF / 256) {
      const bool isctx = rt >= NL / 128;
      const int rloc = (isctx ? (rt - NL / 128) : rt) * 128;
      const int Ls = isctx ? CTX_LEN : SEQ; const int b = rloc / Ls; const int t0 = rloc - b * Ls;
      float* zb = p.zT() + (isctx ? (size_t)BATCH * 3 * HYENA_W * SEQ : (size_t)0) + (size_t)b * 3 * HYENA_W * Ls;
#pragma unroll
      for (int m = 0; m < 4; ++m)
#pragma unroll
        for (int n = 0; n < 4; ++n) {
          const int c = ct * 256 + EPI_COL(n) - HY_OFF; const int t = t0 + EPI_ROW(m, 0);
          *(float4*)(zb + (size_t)c * Ls + t) = make_float4(acc[m][n][0], acc[m][n][1], acc[m][n][2], acc[m][n][3]);
        }
    } else if (ct == S5_OFF / 256) {
#pragma unroll
      for (int m = 0; m < 4; ++m)
#pragma unroll
        for (int n = 0; n < 4; ++n)
#pragma unroll
          for (int j = 0; j < 4; ++j) p.s5u()[((long)rt * 128 + EPI_ROW(m, j)) * S5_W + EPI_COL(n)] = (unsigned short)f2bf(acc[m][n][j]);
    } else {
      const int head = ct * 4 + ((etid >> 6) & 3);
      const bool isq = head < N_Q_HEADS, dorope = head < N_Q_HEADS + N_KV_HEADS && rt < NL / 128;
      const float qs = isq ? 0.125f * 1.4426950408889634f : 1.0f;
      const int c16 = etid & 15;
#pragma unroll
      for (int m = 0; m < 4; ++m)
#pragma unroll
        for (int j = 0; j < 4; ++j) {
          const long row = (long)rt * 128 + EPI_ROW(m, j);
          float v0 = acc[m][0][j], v1 = acc[m][1][j], v2 = acc[m][2][j], v3 = acc[m][3][j];
          if (dorope) {
            const int t = (int)(row % SEQ);
            const float2 cr = p.ropet()[(t / GRID_W) * ROPE_HALF + c16], cc = p.ropet()[(t % GRID_W) * ROPE_HALF + c16];
            const float a0 = v0 * cr.x - v1 * cr.y, a1 = v0 * cr.y + v1 * cr.x, a2 = v2 * cc.x - v3 * cc.y, a3 = v2 * cc.y + v3 * cc.x;
            v0 = a0; v1 = a1; v2 = a2; v3 = a3;
          }
          unsigned short* dst = p.qkvb() + row * HY_OFF + head * HEAD_DIM + c16;
          dst[0] = (unsigned short)f2bf(v0 * qs); dst[16] = (unsigned short)f2bf(v1 * qs); dst[32] = (unsigned short)f2bf(v2 * qs); dst[48] = (unsigned short)f2bf(v3 * qs);
        }
    }
  }
}
DEV void ph_hyena_pre_gpu(const P& p, int l, long gtid, long gsize) {
  const float* sw = p.hy_short_w + l * 3 * 3 * HYENA_W; const float* sb = p.hy_short_b + l * 3 * HYENA_W;
  FOR_ITEMS4(i, (long)BATCH * HYENA_W * (SEQ + CTX_LEN)) {
    const bool isctx = i >= (long)BATCH * HYENA_W * SEQ; const long ii = isctx ? i - (long)BATCH * HYENA_W * SEQ : i;
    const int Ls = isctx ? CTX_LEN : SEQ; const int t = (int)(ii % Ls); const int ch = (int)((ii / Ls) % HYENA_W); const int b = (int)(ii / ((long)Ls * HYENA_W));
    const float* zb = p.zT() + (isctx ? (size_t)BATCH * 3 * HYENA_W * SEQ : (size_t)0) + (size_t)b * 3 * HYENA_W * Ls;
    float z[3];
#pragma unroll
    for (int part = 0; part < 3; ++part) {
      const int cc = part * HYENA_W + ch; const float* zr = zb + (size_t)cc * Ls; float acc = sb[cc];
      if (t > 0) acc += zr[t - 1] * sw[cc];
      acc += zr[t] * sw[3 * HYENA_W + cc];
      if (t + 1 < Ls) acc += zr[t + 1] * sw[2 * 3 * HYENA_W + cc];
      z[part] = acc;
    }
    const long o = isctx ? ((long)NL + b * CTX_LEN + t) * HYENA_W + ch : ((long)b * HYENA_W + ch) * SEQ + t;
    p.hu()[o] = z[0] * z[1]; p.hx0()[o] = z[2];
  }
}
DEV void rms_rows(const P& p, int l, long r0, long r1, int w0, int nw);
DEV void ph_glu_mfma(const P& p, int l, char* smem) {
  const int tid = otid();
  for (int rt = blockIdx.x; rt < (NR >> 7); rt += gridDim.x) {
    ALRows al; al.base = (const char*)(p.ybf() + (long)rt * 128 * S5_W);
#pragma unroll
    for (int i = 0; i < 2; ++i) al.off[i] = (unsigned)(((tid >> 3) + 64 * i) * S5_W + (tid & 7) * 8) * 2u;
    const BLT bl = mk_blt(p.wt_glu() + (long)l * S5_W * S5_W, S5_W, tid);
    f32x4 acc[4][4]; acc_zero(acc);
    gemm_tb(al, bl, S5_W >> 6, acc, smem);
    EPI_BEGIN
#pragma unroll
    for (int m = 0; m < 4; ++m)
#pragma unroll
      for (int n = 0; n < 4; ++n)
#pragma unroll
        for (int j = 0; j < 4; ++j) {
          const long r = (long)rt * 128 + EPI_ROW(m, j); const int c = EPI_COL(n);
          p.mixb()[r * MIX_W + ATTN_W + HYENA_W + c] = __uint_as_float((unsigned)p.ybf()[r * S5_W + c] << 16) * sigmoidf_(acc[m][n][j]);
        }
    asm volatile("s_waitcnt vmcnt(0)" ::: "memory");
    __syncthreads();
    rms_rows(p, l, (long)rt * 128, (long)rt * 128 + 128, otid() >> 6, NT / 64);
  }
}
DEV void ph_outproj_mfma(const P& p, int l, char* smem) {
  EpiRes e{p.xcur(), p.mod(), l, 2 * D_MODEL, p.tmp()};
  gemm_phase_dense(p.mixbf(), MIX_W, p.wt_out() + (long)l * D_MODEL * MIX_W, D_MODEL, MIX_W, e, smem);
}
DEV void exp_prefix(const P& p, int l, int* toff, int* roff) {
  const int tid = otid(), lane = tid & 63, w = tid >> 6;
  __syncthreads();
  int c = 0, tl = 0, incl = 0;
  int* wsum = roff + N_EXPERTS + 8;
  if (tid < N_EXPERTS) {
    c = p.cnt()[l * N_EXPERTS + tid];
    tl = (c + 127) >> 7; incl = tl;
#pragma unroll
    for (int o = 1; o < 64; o <<= 1) { const int v = __shfl_up(incl, o); if (lane >= o) incl += v; }
    if (lane == 63) wsum[w] = incl;
    roff[tid] = c;
  }
  __syncthreads();
  if (tid < N_EXPERTS) {
    int base = 0;
#pragma unroll
    for (int k = 0; k < 4; ++k) if (k < w) base += wsum[k];
    toff[tid] = base + incl - tl;
    if (tid == N_EXPERTS - 1) toff[N_EXPERTS] = base + incl;
  }
  __syncthreads();
}
DEV int exp_find(const int* toff, int tile) {
  int lo = 0, hi = N_EXPERTS - 1;
  while (lo < hi) { int mid = (lo + hi + 1) >> 1; if (toff[mid] <= tile) lo = mid; else hi = mid - 1; }
  return lo;
}
template <int V = 0>
DEV void upgate_tile(const ALRows& al, const float* wg, const float* wu, int cq, f32x4 (&acc)[4][4], char* smem, int tid) {
  const int nq = tid >> 3; const int wsel = __builtin_amdgcn_readfirstlane(tid >> 6) & 1;
  BLStd bl; bl.base = (const char*)((wsel ? wu : wg) + cq * 128); bl.ldb4 = EXPERT_FF * 4; bl.valid = true;
  bl.voff = (unsigned)((tid & 7) * 8) * (unsigned)(EXPERT_FF * 4) + (unsigned)(((nq >> 4) * 32 + (nq & 7) * 4) * 4);
  acc_zero(acc);
  gemm_t<V>(al, bl, D_MODEL >> 6, acc, smem);
}
static_assert(EXPERT_FF == 256 && SHARED_FF == 256, "ff tiling");
template <int V = 0>
DEV void ph_expert_up_mfma(const P& p, int l, char* smem) {
  const int tid = otid(), lane = tid & 63, wc = (tid >> 6) & 3;
  int* toff = (int*)(smem + SM_MISC); int* roff = toff + N_EXPERTS + 1;
  exp_prefix(p, l, toff, roff);
  const int n_items = toff[N_EXPERTS] * 2;
  for (int it = blockIdx.x; it < n_items; it += gridDim.x) {
    const int tile = it >> 1, cq = it & 1;
    const int e = __builtin_amdgcn_readfirstlane(exp_find(toff, tile)); const int j0 = (tile - toff[e]) * 128;
    const int nrows = min(128, roff[e] - j0), rbase = e * NR + j0;
    const float* wg = p.w_exp_gate + ((long)l * N_EXPERTS + e) * D_MODEL * EXPERT_FF; const float* wu = p.w_exp_up + ((long)l * N_EXPERTS + e) * D_MODEL * EXPERT_FF;
    ALRows al; al.base = (const char*)p.ubf();
#pragma unroll
    for (int i = 0; i < 2; ++i) { const int rl = min((tid >> 3) + 64 * i, nrows - 1); al.off[i] = ((unsigned)(p.elist()[rbase + rl] / TOP_K) * D_MODEL + (tid & 7) * 8) * 2u; }
    f32x4 acc[4][4];
    upgate_tile<V>(al, wg, wu, cq, acc, smem, tid);
    EPI_BEGIN
    const int elane = etid & 63, ewc = (etid >> 6) & 3;
#pragma unroll
    for (int m = 0; m < 4; ++m)
#pragma unroll
      for (int j = 0; j < 4; ++j) {
        const int rl = EPI_ROW(m, j);
        if (rl < nrows) {
          { unsigned short* dst = p.hbf() + (long)p.elist()[rbase + rl] * EXPERT_FF + cq * 128 + ewc * 32 + (elane & 15);
            dst[0] = (unsigned short)f2bf(siluf(acc[m][0][j]) * acc[m][2][j]); dst[16] = (unsigned short)f2bf(siluf(acc[m][1][j]) * acc[m][3][j]); }
        }
      }
  }
}
DEV void ph_expert_down_mfma(const P& p, int l, char* smem) {
  const int tid = otid();
  int* toff = (int*)(smem + SM_MISC); int* roff = toff + N_EXPERTS + 1;
  exp_prefix(p, l, toff, roff);
  const int NCT = D_MODEL / 256;
  const int n_exp_items = toff[N_EXPERTS] * NCT;
  for (int it = blockIdx.x; it < n_exp_items; it += gridDim.x) {
    const int tile = it / NCT, ct = it - tile * NCT;
    const int e = __builtin_amdgcn_readfirstlane(exp_find(toff, tile)); const int j0 = (tile - toff[e]) * 128;
    const int nrows = min(128, roff[e] - j0), rbase = e * NR + j0;
    const float* wd = p.w_exp_down + ((long)l * N_EXPERTS + e) * EXPERT_FF * D_MODEL;
    ALRows al; al.base = (const char*)p.hbf();
#pragma unroll
    for (int i = 0; i < 2; ++i) { const int rl = min((tid >> 3) + 64 * i, nrows - 1); al.off[i] = ((unsigned)p.elist()[rbase + rl] * EXPERT_FF + (tid & 7) * 8) * 2u; }
    const BLStd bl = mk_bl(wd + ct * 256, D_MODEL, tid);
    f32x4 acc[4][4]; acc_zero(acc);
    gemm_t(al, bl, EXPERT_FF >> 6, acc, smem);
    EPI_BEGIN
#pragma unroll
    for (int m = 0; m < 4; ++m)
#pragma unroll
      for (int j = 0; j < 4; ++j) {
        const int rl = EPI_ROW(m, j);
        if (rl < nrows) {
          const int a = p.elist()[rbase + rl]; unsigned short* dst = p.ykb() + (long)a * D_MODEL; const float gsc = p.gate()[a];
#pragma unroll
          for (int n = 0; n < 4; ++n) dst[ct * 256 + EPI_COL(n)] = (unsigned short)f2bf(acc[m][n][j] * gsc);
        }
      }
  }
  const int n_sh_items = (NR >> 7) * NCT;
  for (int it = (int)gridDim.x - 1 - (int)blockIdx.x; it < n_sh_items; it += gridDim.x) {
    const int rt = it / NCT, ct = it - rt * NCT;
    ALRows al; al.base = (const char*)(p.hsbf() + (long)rt * 128 * SHARED_FF);
#pragma unroll
    for (int i = 0; i < 2; ++i) al.off[i] = (unsigned)(((tid >> 3) + 64 * i) * SHARED_FF + (tid & 7) * 8) * 2u;
    const BLT bl = mk_blt(p.wt_shd() + ((long)l * D_MODEL + ct * 256) * SHARED_FF, SHARED_FF, tid);
    f32x4 acc[4][4]; acc_zero(acc);
    gemm_tb(al, bl, SHARED_FF >> 6, acc, smem);
    EPI_BEGIN
#pragma unroll
    for (int m = 0; m < 4; ++m)
#pragma unroll
      for (int n = 0; n < 4; ++n)
#pragma unroll
        for (int j = 0; j < 4; ++j) p.ysh()[((long)rt * 128 + EPI_ROW(m, j)) * D_MODEL + ct * 256 + EPI_COL(n)] = acc[m][n][j];
  }
}

typedef __attribute__((ext_vector_type(16))) float f32x16;
#define SM_HR 256
#define UB_STRIDE 8272
#define SM_HU (256 + 32768)
#define SMEM_HY (256 + 32768 + 2 * UB_STRIDE * 2)
static_assert(SEQ == 8192 && HYENA_W == 256, "hyena mfma shape");
DEV void ph_hyena_mfma(const P& p, int l, char* smem) {
  const int tid = otid(), lane = tid & 63, w = tid >> 6;
  unsigned short* R = (unsigned short*)(smem + SM_HR); unsigned short* U = (unsigned short*)(smem + SM_HU);
  for (int ch = blockIdx.x; ch < HYENA_W; ch += gridDim.x) {
    __syncthreads();
    const float* kf = p.kraw() + ((long)l * 2 * HYENA_W + ch) * SEQ; const float* kb = p.kraw() + ((long)l * 2 * HYENA_W + HYENA_W + ch) * SEQ;
    for (int y = tid; y < 2 * SEQ; y += NT) {
      const int lag = SEQ - y; float v = 0.f;
      if (lag >= 0 && lag < SEQ) v = kf[lag]; else if (lag < 0) v = kb[-lag];
      const int C = y >> 3; R[((C ^ ((C >> 4) & 1)) << 3) + (y & 7)] = (unsigned short)f2bf(v);
    }
    for (int e = tid; e < 2 * UB_STRIDE; e += NT) {
      const int b = e / UB_STRIDE, ee = e - b * UB_STRIDE, t = ee - 16; float v = 0.f;
      if (t >= 0 && t < SEQ) v = p.hu()[((long)b * HYENA_W + ch) * SEQ + t];
      U[e] = (unsigned short)f2bf(v);
    }
    __syncthreads();
    f32x16 acc[2];
#pragma unroll
    for (int mi = 0; mi < 2; ++mi)
#pragma unroll
      for (int k = 0; k < 16; ++k) acc[mi][k] = 0.f;
    const int r = lane & 31, h = lane >> 5, sig = lane & 15, bb = (lane >> 4) & 1;
    const unsigned* Ud = (const unsigned*)U + bb * (UB_STRIDE / 2);
    const int ub0 = 8 * h + sig;
    const int cbase = 1022 - 64 * (2 * w) - 2 * r + h;
    const bool odd = sig & 1;
    bf16x8 afn[2]; unsigned dn[5];
    {
#pragma unroll
      for (int mi = 0; mi < 2; ++mi) { const int C = cbase - 64 * mi; afn[mi] = *(const bf16x8*)((const char*)R + ((C ^ ((C >> 4) & 1)) << 4)); }
      const int di = ub0 >> 1;
#pragma unroll
      for (int i = 0; i < 5; ++i) dn[i] = Ud[di + i];
    }
#pragma unroll 1
    for (int q = 0; q <= SEQ / 16; ++q) {
      bf16x8 af[2]; unsigned d[5];
#pragma unroll
      for (int mi = 0; mi < 2; ++mi) af[mi] = afn[mi];
#pragma unroll
      for (int i = 0; i < 5; ++i) d[i] = dn[i];
      {
        const int qn = min(q + 1, SEQ / 16);
#pragma unroll
        for (int mi = 0; mi < 2; ++mi) { const int C = cbase - 64 * mi + 2 * qn; afn[mi] = *(const bf16x8*)((const char*)R + ((C ^ ((C >> 4) & 1)) << 4)); }
        const int di = (16 * qn + ub0) >> 1;
#pragma unroll
        for (int i = 0; i < 5; ++i) dn[i] = Ud[di + i];
      }
      u32x4 bw;
#pragma unroll
      for (int i = 0; i < 4; ++i) bw[i] = odd ? __builtin_amdgcn_alignbit(d[i + 1], d[i], 16) : d[i];
      const bf16x8 bfr = __builtin_bit_cast(bf16x8, bw);
#pragma unroll
      for (int mi = 0; mi < 2; ++mi) acc[mi] = __builtin_amdgcn_mfma_f32_32x32x16_bf16(af[mi], bfr, acc[mi], 0, 0, 0);
    }
    __syncthreads();
    {
      float* Y = (float*)(smem + SM_HR);
      float* yl = Y + bb * SEQ + 16 * (32 * (2 * w) + 4 * h) + sig;
#pragma unroll
      for (int mi = 0; mi < 2; ++mi)
#pragma unroll
        for (int k = 0; k < 16; ++k) yl[16 * (32 * mi + (k & 3) + 8 * (k >> 2))] = acc[mi][k];
    }
    __syncthreads();
    {
      const float* Y = (const float*)(smem + SM_HR);
      const float kn = p.knorm()[l * HYENA_W + ch], dsk = p.hy_d[l * HYENA_W + ch];
#pragma unroll 2
      for (int idx = tid; idx < BATCH * SEQ; idx += NT) {
        const int b = idx / SEQ, t = idx - b * SEQ;
        const long o = ((long)b * HYENA_W + ch) * SEQ + t;
        p.mixb()[(long)idx * MIX_W + ATTN_W + ch] = (Y[idx] * kn + p.hu()[o] * dsk) * p.hx0()[o];
      }
    }
  }
}
#define SM_K 256
#define SM_V (256 + 8192)
static_assert(HEAD_DIM == 64 && WINDOW == 128 && CTX_LEN == 256 && Q_GROUP == 4, "attention shape");
DEV void ph_attn_mfma(const P& p, int l, char* smem) {
  const int tid = otid(), lane = tid & 63, w = (tid >> 6) & 3, hsel = tid >> 8, h = lane >> 5, ql = lane & 31;
  char* Ks = smem + SM_K; char* Vs = smem + SM_V;
  const int n_lat = BATCH * (SEQ / 128) * N_KV_HEADS * (Q_GROUP / 2);
  const int n_ctx = (l == 0) ? BATCH * (CTX_LEN / 128) * N_KV_HEADS * (Q_GROUP / 2) : 0;
  const float QS = 0.125f * 1.4426950408889634f;
  for (int it = blockIdx.x; it < n_lat + n_ctx; it += gridDim.x) {
    const bool isctx = it >= n_lat;
    int b, qb, kvh, g;
    { int x = isctx ? it - n_lat : it; g = (x & 1) * 2 + hsel; kvh = (x >> 1) & 1; x >>= 2; if (isctx) { qb = x & 1; b = x >> 1; } else { qb = x & 63; b = x >> 6; } }
    const int hq = kvh * Q_GROUP + g;
    const int tq0 = qb * 128 + 32 * w;
    const long qrow = (isctx ? (long)NL + b * CTX_LEN : (long)b * SEQ) + tq0 + ql;
    bf16x8 qf[4];
    {
      const unsigned short* qp = p.qkvb() + qrow * HY_OFF + Q_OFF + hq * HEAD_DIM + 8 * h;
#pragma unroll
      for (int ks = 0; ks < 4; ++ks) qf[ks] = *(const bf16x8*)(qp + 16 * ks);
    }
    f32x16 o0, o1;
#pragma unroll
    for (int k = 0; k < 16; ++k) { o0[k] = 0.f; o1[k] = 0.f; }
    float m = -1e30f, lsum = 0.f;
    const int nsteps = isctx ? 4 : 10;
    u32x4 rk[1], rv[1];
    auto key_row = [&](int step, int key) -> long {
      if (step < 4) return (long)NL + b * CTX_LEN + step * 64 + key;
      const int tk = qb * 128 - 128 + (step - 4) * 64 + key;
      return (tk < 0 || tk >= SEQ) ? -1 : (long)b * SEQ + tk;
    };
    auto step_valid = [&](int step) -> bool { if (step < 4) return true; const int t0 = qb * 128 - 128 + (step - 4) * 64; return t0 >= 0 && t0 < SEQ; };
    auto load_tile = [&](int step) {
#pragma unroll
      for (int i = 0; i < 1; ++i) {
        const int key = (tid >> 3); const long kr = key_row(step, key);
        const unsigned short* kp = p.qkvb() + kr * HY_OFF + K_OFF + kvh * HEAD_DIM + (tid & 7) * 8; const unsigned short* vp = p.qkvb() + kr * HY_OFF + V_OFF + kvh * HEAD_DIM + (tid & 7) * 8;
        rk[i] = *(const u32x4*)kp; rv[i] = *(const u32x4*)vp;
      }
    };
    int step = 0;
    load_tile(0);
    while (step < nsteps) {
      __syncthreads();
#pragma unroll
      for (int i = 0; i < 1; ++i) {
        const int key = (tid >> 3), ch = tid & 7;
        *(u32x4*)(Ks + tile_off(key, ch)) = rk[i];
        *(u32x4*)(Vs + key * 128 + ((ch * 16) ^ (64 * ((key >> 1) & 1)))) = rv[i];
      }
      __syncthreads();
      const int cur = step;
      int nxt = step + 1;
      while (nxt < nsteps && !step_valid(nxt)) ++nxt;
      if (nxt < nsteps) load_tile(nxt);
      step = nxt;
#pragma unroll
      for (int sub = 0; sub < 2; ++sub) {
        const bool win = cur >= 4;
        const int ks0 = win ? qb * 128 - 128 + (cur - 4) * 64 + sub * 32 : 0;
        if (win && (ks0 > tq0 + 31 + WINDOW || ks0 + 31 < tq0 - WINDOW)) continue;
        f32x16 sacc;
#pragma unroll
        for (int k = 0; k < 16; ++k) sacc[k] = 0.f;
#pragma unroll
        for (int ks = 0; ks < 4; ++ks) {
          const bf16x8 kf = *(const bf16x8*)(Ks + tile_off(sub * 32 + ql, 2 * ks + h));
          sacc = __builtin_amdgcn_mfma_f32_32x32x16_bf16(kf, qf[ks], sacc, 0, 0, 0);
        }
        if (win && (ks0 + 31 - tq0 > WINDOW || tq0 + 31 - ks0 > WINDOW)) {
          const int tq = tq0 + ql;
#pragma unroll
          for (int k = 0; k < 16; ++k) { const int d = ks0 + (k & 3) + 8 * (k >> 2) + 4 * h - tq; if (d > WINDOW || d < -WINDOW) sacc[k] = -1e30f; }
        }
        float mx = sacc[0];
#pragma unroll
        for (int k = 1; k < 16; ++k) mx = fmaxf(mx, sacc[k]);
        mx = fmaxf(mx, __shfl_xor(mx, 32));
        const float mn = fmaxf(m, mx); const float alpha = __builtin_amdgcn_exp2f(m - mn); m = mn;
        float ps = 0.f;
#pragma unroll
        for (int k = 0; k < 16; ++k) { sacc[k] = __builtin_amdgcn_exp2f(sacc[k] - mn); ps += sacc[k]; }
        lsum = lsum * alpha + ps;
#pragma unroll
        for (int k = 0; k < 16; ++k) { o0[k] *= alpha; o1[k] *= alpha; }
        u32x2 v00, v01, v02, v03, v10, v11, v12, v13;
        {
          const int q4 = (lane & 15) >> 2, p4 = lane & 3, blk = (lane >> 4) & 1, sq = (q4 >> 1) & 1;
          const unsigned lb = (unsigned)(size_t)((__attribute__((address_space(3))) char*)Vs) + (unsigned)((sub * 32 + 4 * h + q4) * 128 + 32 * blk + 8 * p4);
          const unsigned base0 = lb + 64 * sq, base1 = lb + 64 * (1 - sq);
          asm volatile(
              "ds_read_b64_tr_b16 %0, %8\n\t"
              "ds_read_b64_tr_b16 %1, %8 offset:1024\n\t"
              "ds_read_b64_tr_b16 %2, %8 offset:2048\n\t"
              "ds_read_b64_tr_b16 %3, %8 offset:3072\n\t"
              "ds_read_b64_tr_b16 %4, %9\n\t"
              "ds_read_b64_tr_b16 %5, %9 offset:1024\n\t"
              "ds_read_b64_tr_b16 %6, %9 offset:2048\n\t"
              "ds_read_b64_tr_b16 %7, %9 offset:3072\n\t"
              "s_waitcnt lgkmcnt(0)"
              : "=&v"(v00), "=&v"(v01), "=&v"(v02), "=&v"(v03), "=&v"(v10), "=&v"(v11), "=&v"(v12), "=&v"(v13)
              : "v"(base0), "v"(base1) : "memory");
        }
#pragma unroll
        for (int ks2 = 0; ks2 < 2; ++ks2) {
          u32x4 pw;
#pragma unroll
          for (int i = 0; i < 4; ++i) pw[i] = pack2(sacc[8 * ks2 + 2 * i], sacc[8 * ks2 + 2 * i + 1]);
          const bf16x8 pf = __builtin_bit_cast(bf16x8, pw);
          u32x4 a0, a1;
          if (ks2 == 0) { a0[0] = v00[0]; a0[1] = v00[1]; a0[2] = v01[0]; a0[3] = v01[1]; a1[0] = v10[0]; a1[1] = v10[1]; a1[2] = v11[0]; a1[3] = v11[1]; }
          else          { a0[0] = v02[0]; a0[1] = v02[1]; a0[2] = v03[0]; a0[3] = v03[1]; a1[0] = v12[0]; a1[1] = v12[1]; a1[2] = v13[0]; a1[3] = v13[1]; }
          o0 = __builtin_amdgcn_mfma_f32_32x32x16_bf16(__builtin_bit_cast(bf16x8, a0), pf, o0, 0, 0, 0);
          o1 = __builtin_amdgcn_mfma_f32_32x32x16_bf16(__builtin_bit_cast(bf16x8, a1), pf, o1, 0, 0, 0);
        }
      }
    }
    lsum += __shfl_xor(lsum, 32);
    const float sk = p.sink[l * N_Q_HEADS + hq] * 1.4426950408889634f;
    const float mf = fmaxf(m, sk); const float sc = __builtin_amdgcn_exp2f(m - mf); const float inv = sc / (lsum * sc + __builtin_amdgcn_exp2f(sk - mf));
    float* op = p.mixb() + qrow * MIX_W + hq * HEAD_DIM + 4 * h;
#pragma unroll
    for (int gq = 0; gq < 4; ++gq) {
      *(float4*)(op + 8 * gq) = make_float4(o0[4 * gq] * inv, o0[4 * gq + 1] * inv, o0[4 * gq + 2] * inv, o0[4 * gq + 3] * inv);
      *(float4*)(op + 32 + 8 * gq) = make_float4(o1[4 * gq] * inv, o1[4 * gq + 1] * inv, o1[4 * gq + 2] * inv, o1[4 * gq + 3] * inv);
    }
  }
}


static_assert(S5_T == 64 && S5_STATE == 64 && S5_GROUP == 16 && S5_GROUPS == 16 && NCH == 132, "s5 mfma shape");
#define S5_COLS (BATCH * NCH)
#define S5_RT 88
DEV void ph_s5tables_gpu(const P& p, long gtid, long gsize) {
  FOR_ITEMS4(i, (long)DEPTH * 2 * S5_GROUPS * 128 * 1024) {
    const int k = (int)(i & 1023), n = (int)((i >> 10) & 127); const long ldg = i >> 17;
    const int ri = n >> 6, pp = n & 63, sidx = k >> 4, j = k & 15;
    const float2 lp = p.lampow()[(ldg * (S5_T + 1) + (S5_T - 1 - sidx)) * S5_STATE + pp]; const float2 bb = p.bbar()[(ldg * S5_STATE + pp) * S5_GROUP + j];
    p.bmtb()[i] = (unsigned short)f2bf(ri ? lp.x * bb.y + lp.y * bb.x : lp.x * bb.x - lp.y * bb.y);
  }
  FOR_ITEMS4(i, (long)DEPTH * 2 * S5_GROUPS * 128 * 1024) {
    const int k = (int)(i & 127), n = (int)((i >> 7) & 1023); const long ldg = i >> 17; const int dir = (int)((ldg >> 4) & 1);
    const int ri = k >> 6, pp = k & 63, tl = n >> 4, ii = n & 15; const int tau = dir ? 63 - tl : tl;
    const float cr = p.s5_c_re[(ldg * S5_GROUP + ii) * S5_STATE + pp], ci = p.s5_c_im[(ldg * S5_GROUP + ii) * S5_STATE + pp];
    const float2 lp = p.lampow()[(ldg * (S5_T + 1) + tau + 1) * S5_STATE + pp];
    p.cmtb()[i] = (unsigned short)f2bf(ri ? -(cr * lp.y + ci * lp.x) : cr * lp.x - ci * lp.y);
  }
}
DEV void ph_kcb_gpu(const P& p, long gtid, long gsize) {
  FOR_ITEMS4(i, (long)DEPTH * 2 * S5_GROUPS * S5_T * 256) p.kcb()[i] = (unsigned short)f2bf(p.kc()[i]);
}
struct ALS5U { const char* base; unsigned off0[2]; int stepb; const char* hbase; unsigned hoff[2]; int nki;
  DEVM void set(int i, int b, int dir, int chunk, int sl, unsigned joff) { off0[i] = (unsigned)s5_row(b, dir, chunk * S5_T + sl) * (unsigned)(S5_W * 2) + joff; }
  DEVM const unsigned short* a(int i, int kt) const {
    if (kt >= nki) return (const unsigned short*)(hbase + (hoff[i] + (unsigned)(kt - nki) * 128u));
    return (const unsigned short*)(base + (off0[i] + (unsigned)(kt * stepb))); } };
struct BLKc { const char* kc; const char* cm; int tl, i0, sj, ss, dir, nki; unsigned cmoff;
  DEVM void load(u32x4 (&rb)[4], int kt) const {
    if (kt >= nki) {
#pragma unroll
      for (int c = 0; c < 4; ++c) rb[c] = *(const u32x4*)(cm + (cmoff + (unsigned)(c * 128 + (kt - nki) * 64) * 2u));
      return;
    }
    const int d = (dir ? 63 - tl : tl) - (4 * kt + ss);
    if (d < 0) {
#pragma unroll
      for (int c = 0; c < 4; ++c) rb[c] = (u32x4){0u, 0u, 0u, 0u};
    } else {
#pragma unroll
      for (int c = 0; c < 4; ++c) rb[c] = *(const u32x4*)(kc + (unsigned)(((d * 16 + i0 + c) * 16 + sj) * 2));
    }
  } };
DEV void ph_s5_sgemm(const P& p, int l, char* smem) {
  const int tid = otid();
  const int nitems = 2 * S5_GROUPS * 3;
  for (int it = blockIdx.x; it < nitems; it += gridDim.x) {
    const int rt = it % 3, g = (it / 3) % S5_GROUPS, dir = it / (3 * S5_GROUPS);
    ALS5U al; al.base = (const char*)(p.s5u() + g * S5_GROUP); al.stepb = (dir ? -4 : 4) * S5_W * 2; al.nki = 1 << 20; al.hbase = al.base; al.hoff[0] = al.hoff[1] = 0;
#pragma unroll
    for (int i = 0; i < 2; ++i) { const int col = rt * S5_RT + min((tid >> 3) + 64 * i, S5_RT - 1); al.set(i, col / NCH, dir, col % NCH, (tid & 7) >> 1, (tid & 1) * 16); }
    BLT bl; bl.base = (const char*)(p.bmtb() + (((long)l * 2 + dir) * S5_GROUPS + g) * 128 * 1024); bl.rowb = 1024 * 2;
    bl.voff = (unsigned)((((tid >> 3) & 31) * 4)) * bl.rowb + (unsigned)((tid & 7) * 16);
    f32x4 acc[4][4]; acc_zero(acc);
    gemm_tb(al, bl, 16, acc, smem);
    EPI_BEGIN
    if (((etid >> 6) & 3) < 2) {
#pragma unroll
      for (int m = 0; m < 4; ++m)
#pragma unroll
        for (int j = 0; j < 4; ++j) {
          const int rl = EPI_ROW(m, j);
          if (rl < S5_RT) {
            const int col = rt * S5_RT + rl; const int b = col / NCH, c = col % NCH;
            float* dst = (float*)(p.sc() + ((((long)b * 2 + dir) * S5_GROUPS + g) * NCH + c) * S5_STATE);
#pragma unroll
            for (int n = 0; n < 4; ++n) { const int nn = EPI_COL(n); dst[(nn & 63) * 2 + (nn >> 6)] = acc[m][n][j]; }
          }
        }
    }
  }
}

static_assert(NCH == 132, "carry scan grouping");
DEV void ph_s5_carry_gpu(const P& p, int l, char* smem) {
  const int tid = otid();
  float2* E = (float2*)(smem + SM_MISC);
  const int nchains = BATCH * 2 * S5_GROUPS * S5_STATE;
  for (int cb = blockIdx.x * 16; cb < nchains; cb += gridDim.x * 16) {
    const int cl = tid & 15, grp = tid >> 4; const bool act = tid < 176;
    const int chain = cb + cl;
    const int pp = chain % S5_STATE, g = (chain / S5_STATE) % S5_GROUPS, dir = (chain / (S5_STATE * S5_GROUPS)) % 2, b = chain / (S5_STATE * S5_GROUPS * 2);
    const long ldg = ((long)l * 2 + dir) * S5_GROUPS + g;
    const long base = (((long)b * 2 + dir) * S5_GROUPS + g) * NCH + grp * 12;
    float2 lt = make_float2(0.f, 0.f); float2 L[12]; float hr = 0.f, hi = 0.f;
    __syncthreads();
    if (act) {
      lt = p.lampow()[(ldg * (S5_T + 1) + S5_T) * S5_STATE + pp];
      float2 sv[12];
#pragma unroll
      for (int k = 0; k < 12; ++k) sv[k] = p.sc()[(base + k) * S5_STATE + pp];
#pragma unroll
      for (int k = 0; k < 12; ++k) { L[k] = make_float2(hr, hi); const float nr = lt.x * hr - lt.y * hi + sv[k].x, ni = lt.x * hi + lt.y * hr + sv[k].y; hr = nr; hi = ni; }
      E[grp * 16 + cl] = make_float2(hr, hi);
    }
    __syncthreads();
    if (act) {
      float pr = lt.x, pi = lt.y;
#pragma unroll
      for (int k = 1; k < 12; ++k) { const float nr = pr * lt.x - pi * lt.y, ni = pr * lt.y + pi * lt.x; pr = nr; pi = ni; }
      float gr = 0.f, gi = 0.f;
      for (int gp = 0; gp < grp; ++gp) { const float2 e = E[gp * 16 + cl]; const float nr = pr * gr - pi * gi + e.x, ni = pr * gi + pi * gr + e.y; gr = nr; gi = ni; }
#pragma unroll
      for (int k = 0; k < 12; ++k) {
        const float vr = L[k].x + gr, vi = L[k].y + gi;
        p.hcbf()[(base + k) * 2 * S5_STATE + pp] = f2bf16(vr); p.hcbf()[(base + k) * 2 * S5_STATE + S5_STATE + pp] = f2bf16(vi);
        const float nr = lt.x * gr - lt.y * gi, ni = lt.x * gi + lt.y * gr; gr = nr; gi = ni;
      }
    }
  }
}
DEV void ph_s5_ygemm(const P& p, int l, char* smem) {
  const int tid = otid();
  const int nitems = S5_GROUPS * 3 * 4;
  for (int it = blockIdx.x; it < nitems; it += gridDim.x) {
    const int nt = it & 3, rt = (it >> 2) % 3, g = it / 12;
    f32x4 acc[4][4]; acc_zero(acc);
#pragma unroll 1
    for (int dir = 0; dir < 2; ++dir) {
      const long ldg = ((long)l * 2 + dir) * S5_GROUPS + g;
      const int nki = dir ? 16 - 4 * nt : 4 * nt + 4;
      ALS5U al; al.base = (const char*)(p.s5u() + g * S5_GROUP); al.stepb = (dir ? -4 : 4) * S5_W * 2; al.nki = nki; al.hbase = (const char*)p.hcbf();
#pragma unroll
      for (int i = 0; i < 2; ++i) {
        const int col = rt * S5_RT + min((tid >> 3) + 64 * i, S5_RT - 1); const int b = col / NCH, blk = col % NCH;
        const int ch = dir ? (blk < 4 ? 3 - blk : 135 - blk) : blk;
        al.set(i, b, dir, ch, (tid & 7) >> 1, (tid & 1) * 16);
        al.hoff[i] = (unsigned)((((b * 2 + dir) * S5_GROUPS + g) * NCH + ch) * 128 + (tid & 7) * 8) * 2u;
      }
      BLKc bk; bk.kc = (const char*)(p.kcb() + ldg * S5_T * 256); bk.tl = 16 * nt + (tid >> 5); bk.i0 = ((tid >> 3) & 3) * 4; bk.sj = (tid & 1) * 8; bk.ss = (tid & 7) >> 1; bk.dir = dir; bk.nki = nki;
      bk.cm = (const char*)(p.cmtb() + ldg * 1024 * 128); bk.cmoff = (unsigned)(((16 * nt + (tid >> 5)) * 16 + ((tid >> 3) & 3) * 4) * 128 + (tid & 7) * 8) * 2u;
      gemm_tb(al, bk, nki + 2, acc, smem);
    }
    EPI_BEGIN
#pragma unroll
    for (int m = 0; m < 4; ++m)
#pragma unroll
      for (int j = 0; j < 4; ++j) {
        const int rl = EPI_ROW(m, j);
        if (rl < S5_RT) {
          const int col = rt * S5_RT + rl; const int b = col / NCH, blk = col % NCH;
#pragma unroll
          for (int n = 0; n < 4; ++n) {
            const int nn = nt * 256 + EPI_COL(n); const int tl = nn >> 4, chn = g * S5_GROUP + (nn & 15);
            const long row = blk < 4 ? (long)NL + b * CTX_LEN + blk * 64 + tl : (long)b * SEQ + (blk - 4) * 64 + tl;
            const float y = acc[m][n][j] + p.s5_d[l * S5_W + chn] * __uint_as_float((unsigned)p.s5u()[row * S5_W + chn] << 16);
            const float gy = gelu_tanhf(y);
            p.ybuf()[row * S5_W + chn] = gy; p.ybf()[row * S5_W + chn] = (unsigned short)f2bf(gy);
          }
        }
      }
  }
}

DEV float wave_sum(float v) {
#pragma unroll
  for (int o = 32; o > 0; o >>= 1) v += __shfl_xor(v, o);
  return v;
}
DEV void st_bf4(unsigned short* dst, float a, float b, float c, float d) { u32x2 v; v[0] = pack2(a, b); v[1] = pack2(c, d); *(u32x2*)dst = v; }
static_assert(BATCH == 2, "mod partial layout");
DEV void ph_modsum_gpu(const P& p, long gtid, long gsize) {
  FOR_ITEMS(i, (long)DEPTH * (BATCH + 1) * 6 * D_MODEL) {
    const int n = (int)(i % (6 * D_MODEL)); const int j = (int)((i / (6 * D_MODEL)) % (BATCH + 1)); const int l = (int)(i / (6 * D_MODEL * (BATCH + 1)));
    float acc = p.b_ada[l * 6 * D_MODEL + n];
#pragma unroll
    for (int sl = 0; sl < 16; ++sl) acc += p.modp()[((long)(l * 16 + sl) * (BATCH + 1) + j) * 6 * D_MODEL + n];
    p.mod()[i] = acc;
  }
}
DEV void ph_modu0_gpu(const P& p, long gtid, long gsize) {
  FOR_ITEMS4(i4, (long)NR * D_MODEL / 4) {
    const long i = i4 * 4; const int k = (int)(i % D_MODEL); const long r = i / D_MODEL;
    const float* m = p.mod() + (long)modrow(r) * 6 * D_MODEL;
    const float4 x = *(const float4*)(p.xcur() + i); const float4 sh = *(const float4*)(m + k); const float4 sc = *(const float4*)(m + D_MODEL + k);
    st_bf4(p.ubf() + i, x.x * (1.f + sc.x) + sh.x, x.y * (1.f + sc.y) + sh.y, x.z * (1.f + sc.z) + sh.z, x.w * (1.f + sc.w) + sh.w);
  }
}
DEV void rms_rows(const P& p, int l, long r0, long r1, int w0, int nw) {
  const int lane = otid() & 63;
  for (long r = r0 + w0; r < r1; r += nw) {
    const float* v = p.mixb() + r * MIX_W; float4 a[4]; float ss[4];
#pragma unroll
    for (int i = 0; i < 4; ++i) { a[i] = *(const float4*)(v + (i * 64 + lane) * 4); ss[i] = a[i].x * a[i].x + a[i].y * a[i].y + a[i].z * a[i].z + a[i].w * a[i].w; }
    const float s_att = wave_sum(ss[0] + ss[1]), s_hy = wave_sum(ss[2]), s_s5 = wave_sum(ss[3]);
    float rs[4]; rs[0] = rs[1] = 1.0f / sqrtf(s_att / (float)ATTN_W + LN_EPS); rs[2] = 1.0f / sqrtf(s_hy / (float)HYENA_W + LN_EPS); rs[3] = 1.0f / sqrtf(s_s5 / (float)S5_W + LN_EPS);
#pragma unroll
    for (int i = 0; i < 4; ++i) {
      const int k = (i * 64 + lane) * 4; const float4 g = *(const float4*)(p.mix_g + l * MIX_W + k);
      st_bf4(p.mixbf() + r * MIX_W + k, a[i].x * rs[i] * g.x, a[i].y * rs[i] * g.y, a[i].z * rs[i] * g.z, a[i].w * rs[i] * g.w);
    }
  }
}
DEV void ln_rows(float4 (&a)[4], const float* gw, const float* bw, int lane) {
  float s = 0.f;
#pragma unroll
  for (int i = 0; i < 4; ++i) s += a[i].x + a[i].y + a[i].z + a[i].w;
  const float mu = wave_sum(s) / (float)D_MODEL; float q = 0.f;
#pragma unroll
  for (int i = 0; i < 4; ++i) { a[i].x -= mu; a[i].y -= mu; a[i].z -= mu; a[i].w -= mu; q += a[i].x * a[i].x + a[i].y * a[i].y + a[i].z * a[i].z + a[i].w * a[i].w; }
  const float rs = 1.0f / sqrtf(wave_sum(q) / (float)D_MODEL + LN_EPS);
#pragma unroll
  for (int i = 0; i < 4; ++i) {
    const int k = (i * 64 + lane) * 4; const float4 g = *(const float4*)(gw + k), b = *(const float4*)(bw + k);
    a[i].x = a[i].x * rs * g.x + b.x; a[i].y = a[i].y * rs * g.y + b.y; a[i].z = a[i].z * rs * g.z + b.z; a[i].w = a[i].w * rs * g.w + b.w;
  }
}
DEV void ph_ln1_gpu(const P& p, int l) {
  const int tid_ = otid(); const int lane = tid_ & 63; const int gw = blockIdx.x * (NT / 64) + (tid_ >> 6), nw = gridDim.x * (NT / 64);
  for (long r = gw; r < NR; r += nw) {
    float4 a[4];
#pragma unroll
    for (int i = 0; i < 4; ++i) a[i] = *(const float4*)(p.tmp() + r * D_MODEL + (i * 64 + lane) * 4);
    ln_rows(a, p.ln1_g + l * D_MODEL, p.ln1_b + l * D_MODEL, lane);
    const float* m = p.mod() + ((long)l * (BATCH + 1) + modrow(r)) * 6 * D_MODEL + 3 * D_MODEL;
#pragma unroll
    for (int i = 0; i < 4; ++i) {
      const int k = (i * 64 + lane) * 4;
      *(float4*)(p.xcur() + r * D_MODEL + k) = a[i];
      const float4 sh = *(const float4*)(m + k), sc = *(const float4*)(m + D_MODEL + k);
      const float u0 = a[i].x * (1.f + sc.x) + sh.x, u1 = a[i].y * (1.f + sc.y) + sh.y, u2 = a[i].z * (1.f + sc.z) + sh.z, u3 = a[i].w * (1.f + sc.w) + sh.w;
      st_bf4(p.ubf() + r * D_MODEL + k, u0, u1, u2, u3);
      st_bf4(p.ubl() + r * D_MODEL + k, bflo(u0), bflo(u1), bflo(u2), bflo(u3));
    }
  }
}
DEV void ph_ln2_gpu(const P& p, int l) {
  const int tid_ = otid(); const int lane = tid_ & 63; const int gw = blockIdx.x * (NT / 64) + (tid_ >> 6), nw = gridDim.x * (NT / 64);
  for (long r = gw; r < NR; r += nw) {
    float4 a[4];
    const float* m = p.mod() + ((long)l * (BATCH + 1) + modrow(r)) * 6 * D_MODEL + 5 * D_MODEL;
#pragma unroll
    for (int i = 0; i < 4; ++i) {
      const int k = (i * 64 + lane) * 4;
      float4 f = *(const float4*)(p.ysh() + r * D_MODEL + k);
#pragma unroll
      for (int kk = 0; kk < TOP_K; ++kk) { const u32x2 y = *(const u32x2*)(p.ykb() + (r * TOP_K + kk) * D_MODEL + k); f.x += __uint_as_float(y[0] << 16); f.y += __uint_as_float(y[0] & 0xffff0000u); f.z += __uint_as_float(y[1] << 16); f.w += __uint_as_float(y[1] & 0xffff0000u); }
      const float4 x = *(const float4*)(p.xcur() + r * D_MODEL + k), g2 = *(const float4*)(m + k);
      a[i].x = DN_ALPHA * x.x + g2.x * f.x; a[i].y = DN_ALPHA * x.y + g2.y * f.y; a[i].z = DN_ALPHA * x.z + g2.z * f.z; a[i].w = DN_ALPHA * x.w + g2.w * f.w;
    }
    ln_rows(a, p.ln2_g + l * D_MODEL, p.ln2_b + l * D_MODEL, lane);
    const float* mn = p.mod() + ((long)(l + 1) * (BATCH + 1) + modrow(r)) * 6 * D_MODEL;
#pragma unroll
    for (int i = 0; i < 4; ++i) {
      const int k = (i * 64 + lane) * 4;
      *(float4*)(p.xcur() + r * D_MODEL + k) = a[i];
      if (l + 1 < DEPTH) {
        const float4 sh = *(const float4*)(mn + k), sc = *(const float4*)(mn + D_MODEL + k);
        st_bf4(p.ubf() + r * D_MODEL + k, a[i].x * (1.f + sc.x) + sh.x, a[i].y * (1.f + sc.y) + sh.y, a[i].z * (1.f + sc.z) + sh.z, a[i].w * (1.f + sc.w) + sh.w);
      } else if (r < NL) *(float4*)(p.out + r * D_MODEL + k) = a[i];
    }
  }
}
struct ALRouter { const char* hi; const char* lo_; unsigned off[2];
  DEVM const unsigned short* a(int i, int kt) const { return (const unsigned short*)((kt >= 32 ? lo_ : hi) + (off[i] + (unsigned)(kt & 15) * 128u)); } };
struct BLRouter { const char* base; const char* lob; unsigned voff; unsigned rowb;
  DEVM void load(u32x4 (&rb)[4], int kt) const {
    const char* bb = (kt >> 4) == 1 ? lob : base;
#pragma unroll
    for (int c = 0; c < 4; ++c) rb[c] = *(const u32x4*)(bb + (voff + (unsigned)c * rowb + (unsigned)(kt & 15) * 128u)); } };
DEV void ph_router_mfma(const P& p, int l, char* smem) {
  const int tid = otid();
  const int n_router = (NR >> 7), n_sh = (NR >> 7) * 2;
  const int nrb = (int)gridDim.x >= 64 ? (int)((gridDim.x * 3) / 5) : 0;
  const bool is_router = nrb == 0 ? false : (int)blockIdx.x < nrb;
  for (int pass = 0; pass < 2; ++pass) {
    const bool do_router = nrb == 0 ? pass == 0 : is_router;
    if (nrb != 0 && pass == 1) break;
    const int first = nrb == 0 ? (int)blockIdx.x : (do_router ? (int)blockIdx.x : (int)blockIdx.x - nrb);
    const int stride = nrb == 0 ? (int)gridDim.x : (do_router ? nrb : (int)gridDim.x - nrb);
    const int nit = do_router ? n_router : n_sh;
    for (int it = first; it < nit; it += stride) {
      const int rt = do_router ? it : (it >> 1), cq = do_router ? 0 : (it & 1);
      ALRouter ar; ar.hi = (const char*)(p.ubf() + (long)rt * 128 * D_MODEL); ar.lo_ = (const char*)(p.ubl() + (long)rt * 128 * D_MODEL);
#pragma unroll
      for (int i = 0; i < 2; ++i) ar.off[i] = (unsigned)(((tid >> 3) + 64 * i) * D_MODEL + (tid & 7) * 8) * 2u;
      BLRouter br; int nk;
      if (do_router) {
        br.base = (const char*)(p.wt_rh() + (long)l * N_EXPERTS * D_MODEL); br.lob = (const char*)(p.wt_rl() + (long)l * N_EXPERTS * D_MODEL); br.rowb = D_MODEL * 2;
        br.voff = (unsigned)((tid >> 3) * 4) * br.rowb + (unsigned)((tid & 7) * 16); nk = 3 * (D_MODEL >> 6);
      } else {
        const int nq = tid >> 3; const int wsel = __builtin_amdgcn_readfirstlane(tid >> 6) & 1;
        const unsigned short* wsrc = (wsel ? p.wt_shu() : p.wt_shg()) + (long)l * SHARED_FF * D_MODEL;
        br.base = (const char*)wsrc; br.lob = br.base; br.rowb = D_MODEL * 2;
        br.voff = (unsigned)(cq * 128 + (nq >> 4) * 32 + (nq & 7) * 4) * br.rowb + (unsigned)((tid & 7) * 16); nk = D_MODEL >> 6;
      }
      f32x4 acc[4][4]; acc_zero(acc);
      gemm_tb(ar, br, nk, acc, smem);
      EPI_BEGIN
      if (do_router) {
#pragma unroll
        for (int m = 0; m < 4; ++m)
#pragma unroll
          for (int n = 0; n < 4; ++n)
#pragma unroll
            for (int j = 0; j < 4; ++j) p.rl()[((long)rt * 128 + EPI_ROW(m, j)) * N_EXPERTS + EPI_COL(n)] = acc[m][n][j];
      } else {
        const int elane = etid & 63, ewc = (etid >> 6) & 3;
#pragma unroll
        for (int m = 0; m < 4; ++m)
#pragma unroll
          for (int j = 0; j < 4; ++j)
          { unsigned short* dst = p.hsbf() + ((long)rt * 128 + EPI_ROW(m, j)) * SHARED_FF + cq * 128 + ewc * 32 + (elane & 15);
            dst[0] = (unsigned short)f2bf(siluf(acc[m][0][j]) * acc[m][2][j]); dst[16] = (unsigned short)f2bf(siluf(acc[m][1][j]) * acc[m][3][j]); }
      }
    }
  }
}
static_assert(EPG == 32 && TOP_K == 8 && N_EXPERT_GROUPS == 8 && TOPK_GROUPS == 4, "select shape");
DEV void ph_select_gpu(const P& p, int l) {
  const int tid_ = otid(); const int lane = tid_ & 63; const int gw = blockIdx.x * (NT / 64) + (tid_ >> 6), nw = gridDim.x * (NT / 64);
  const float4 rb = *(const float4*)(p.router_bias + l * N_EXPERTS + 4 * lane);
  for (long r = gw; r < NR; r += nw) {
    const float4 lg = *(const float4*)(p.rl() + r * N_EXPERTS + 4 * lane);
    float sc[4] = {sigmoidf_(lg.x), sigmoidf_(lg.y), sigmoidf_(lg.z), sigmoidf_(lg.w)};
    float bz[4] = {sc[0] + rb.x, sc[1] + rb.y, sc[2] + rb.z, sc[3] + rb.w};
    float m1 = fmaxf(bz[0], bz[1]), m2 = fminf(bz[0], bz[1]);
#pragma unroll
    for (int c = 2; c < 4; ++c) { const float v = bz[c]; m2 = fmaxf(m2, fminf(m1, v)); m1 = fmaxf(m1, v); }
#pragma unroll
    for (int o = 1; o < 8; o <<= 1) { const float b1 = __shfl_xor(m1, o), b2 = __shfl_xor(m2, o); m2 = fmaxf(fminf(m1, b1), fmaxf(m2, b2)); m1 = fmaxf(m1, b1); }
    const float gs = m1 + m2; const int mg = lane >> 3; int rank = 0;
#pragma unroll
    for (int j = 0; j < 8; ++j) { const float gj = __shfl(gs, j * 8); rank += (gj > gs || (gj == gs && j < mg)) ? 1 : 0; }
    if (rank >= TOPK_GROUPS) { bz[0] = bz[1] = bz[2] = bz[3] = -1e30f; }
    int sel_e[TOP_K]; float sel_s[TOP_K]; float gsum = 0.f;
#pragma unroll
    for (int it = 0; it < TOP_K; ++it) {
      float bv = bz[0]; int bc = 0;
#pragma unroll
      for (int c = 1; c < 4; ++c) if (bz[c] > bv) { bv = bz[c]; bc = c; }
      int bi = 4 * lane + bc; float bs = sc[bc];
      const int myi = bi;
#pragma unroll
      for (int o = 1; o < 64; o <<= 1) {
        const float ov = __shfl_xor(bv, o); const int oi = __shfl_xor(bi, o); const float os = __shfl_xor(bs, o);
        if (ov > bv || (ov == bv && oi < bi)) { bv = ov; bi = oi; bs = os; }
      }
      sel_e[it] = bi; sel_s[it] = bs; gsum += bs;
      if (bi == myi) {
#pragma unroll
        for (int c = 0; c < 4; ++c) if (c == bc) bz[c] = -1e30f;
      }
    }
    const float inv = ROUTED_SCALE / gsum;
    int me = sel_e[0]; float ms = sel_s[0];
#pragma unroll
    for (int it = 1; it < TOP_K; ++it) if (lane == it) { me = sel_e[it]; ms = sel_s[it]; }
    if (lane < TOP_K) {
      const long a = r * TOP_K + lane;
      p.top_e()[a] = me; p.gate()[a] = ms * inv;
      const int pos = atomicAdd(&p.cnt()[l * N_EXPERTS + me], 1);
      p.elist()[(long)me * NR + pos] = (int)a;
    }
  }
}
#endif

#ifndef CPU_TEST
#define XB_TMO      128
#define XB_XCNT(j)  (256  + 64 * (j))
#define XB_XSUB(j)  (1280 + 64 * (j))
#define XB_XGEN(j)  (2304 + 64 * (j))
#define XB_TOP      3328
#define XB_TOPGEN   3392
#define XCD_BAR_WORDS 3456
#define XB_SPIN_CAP (1u << 18)
#define LAS __attribute__((address_space(3)))
__device__ __forceinline__ unsigned xb_ld(unsigned* p)              { return __hip_atomic_load(p, __ATOMIC_RELAXED, __HIP_MEMORY_SCOPE_AGENT); }
__device__ __forceinline__ unsigned xb_add(unsigned* p, unsigned v) { return __hip_atomic_fetch_add(p, v, __ATOMIC_RELAXED, __HIP_MEMORY_SCOPE_AGENT); }
__device__ __forceinline__ unsigned xb_xcc_id() { return (unsigned)__builtin_amdgcn_s_getreg((3 << 11) | 20) & 0xFu; }
#define XB_SPIN(cond, bar) do { unsigned _sp = 0; while (cond) { __builtin_amdgcn_s_sleep(1); \
    if ((++_sp & 255u) == 0u) { if (xb_ld(&(bar)[XB_TMO])) break; if (_sp > XB_SPIN_CAP) { atomicAdd(&(bar)[XB_TMO], 1u); break; } } } } while (0)
struct XcdBarrier { unsigned* bar; unsigned x; volatile LAS unsigned* st; };
__device__ __forceinline__ XcdBarrier xcd_barrier_post(unsigned* bar, volatile LAS unsigned* st) {
    XcdBarrier b; b.bar = bar; b.x = xb_xcc_id(); b.st = st;
    if (threadIdx.x == 0) (void)xb_add(&bar[XB_XCNT(b.x)], 1u);
    return b;
}
__device__ __forceinline__ void xcd_barrier_complete(unsigned* bar, unsigned x, unsigned& nloc, unsigned& nx) {
    const unsigned G = gridDim.x * gridDim.y * gridDim.z;
    unsigned sum, cnt, mine, sp = 0u;
    for (;;) {
        sum = 0u; cnt = 0u; mine = 0u;
#pragma unroll
        for (unsigned j = 0; j < 16; ++j) { const unsigned c = xb_ld(&bar[XB_XCNT(j)]); sum += c; cnt += (c > 0u) ? 1u : 0u; mine = (j == x) ? c : mine; }
        if (sum == G) break;
        __builtin_amdgcn_s_sleep(1);
        if ((++sp & 255u) == 0u) { if (xb_ld(&bar[XB_TMO])) break; if (sp > XB_SPIN_CAP) { atomicAdd(&bar[XB_TMO], 1u); break; } }
    }
    nloc = mine > 0u ? mine : 1u; nx = cnt > 0u ? cnt : 1u;
}
__device__ __forceinline__ void xcd_barrier(const XcdBarrier& b) {
    asm volatile("s_waitcnt vmcnt(0)" ::: "memory");
    __syncthreads();
    if (threadIdx.x == 0) {
        unsigned* bar = b.bar;
        unsigned bx = b.x; asm volatile("" : "+s"(bx));
        __builtin_amdgcn_s_waitcnt(0);
        unsigned nloc = b.st[0], nx = b.st[1];
        if (nloc == 0u) { xcd_barrier_complete(bar, bx, nloc, nx); b.st[0] = nloc; b.st[1] = nx; }
        const unsigned old = xb_add(&bar[XB_XSUB(bx)], 1u);
        const unsigned gen = old / nloc;
        if (old + 1u == (gen + 1u) * nloc) {
            __builtin_amdgcn_fence(__ATOMIC_RELEASE, "agent");
            asm volatile("s_waitcnt vmcnt(0)" ::: "memory");
            const unsigned og = xb_add(&bar[XB_TOP], 1u);
            const unsigned tg = og / nx;
            if (og + 1u == (tg + 1u) * nx) xb_add(&bar[XB_TOPGEN], 1u);
            else XB_SPIN(xb_ld(&bar[XB_TOPGEN]) == tg, bar);
            __builtin_amdgcn_fence(__ATOMIC_ACQUIRE, "agent");
            xb_add(&bar[XB_XGEN(bx)], 1u);
            asm volatile("s_waitcnt vmcnt(0)" ::: "memory");
        } else {
            XB_SPIN(xb_ld(&bar[XB_XGEN(bx)]) == gen, bar);
            __builtin_amdgcn_fence(__ATOMIC_ACQUIRE, "agent");
            asm volatile("s_waitcnt vmcnt(0)" ::: "memory");
        }
    }
    __syncthreads();
}
#define GRID_SYNC() xcd_barrier(xb)
#else
#define GRID_SYNC() do {} while (0)
#endif

#ifndef CPU_TEST
#define GPUSEL(a, b) a
#else
#define GPUSEL(a, b) b
#endif
#ifndef CPU_TEST
#define OPAQUE_S(v) asm volatile("" : "+s"(v))
#define OPAQUE_V(v) asm volatile("" : "+v"(v))
#else
#define OPAQUE_S(v) do {} while (0)
#define OPAQUE_V(v) do {} while (0)
#endif
#ifndef PROBE_MASK
#define PROBE_MASK 0
#endif
#define LPHASE(stmt) do { int l = lo; OPAQUE_S(l); if (SINGLE && ((PROBE_MASK >> (ph - NG - lo * NLP)) & 1)) { long gtid = gtid0; OPAQUE_V(gtid); stmt; GRID_SYNC(); } PHASE(stmt); } while (0)
#define PHASE(stmt) do { if (SINGLE || ph == only) { long gtid = gtid0; OPAQUE_V(gtid); stmt; } if (SINGLE) { GRID_SYNC(); } ++ph; } while (0)
#ifndef CPU_TEST
template <bool SINGLE> __device__ __forceinline__ void run_seq(const P& p, long gtid0, long gsize, int only, const XcdBarrier& xb, char* smem)
#else
template <bool SINGLE> static int run_seq(const P& p, long gtid0, long gsize, int only)
#endif
{
  int ph = 0;
  PHASE(ph_g0(p, gtid, gsize));
  PHASE(ph_g1(p, gtid, gsize));
  PHASE(ph_g2(p, gtid, gsize));
  PHASE(ph_g3(p, gtid, gsize));
  PHASE(ph_g4(p, gtid, gsize));
#pragma unroll 1
  for (int lo = 0; lo < DEPTH; ++lo) {
    LPHASE(ph_modu(p, l, 0, gtid, gsize));
    LPHASE(GPUSEL(ph_proj_mfma(p, l, smem), ph_proj(p, l, gtid, gsize)));
    LPHASE(ph_post_proj(p, l, gtid, gsize));
    LPHASE(ph_mix(p, l, gtid, gsize); GPUSEL((ph_attn_mfma(p, l, smem), ph_hyena_mfma(p, l, smem)), (void)0));
    LPHASE(ph_s5out(p, l, gtid, gsize));
    LPHASE(GPUSEL(ph_glu_mfma(p, l, smem), ph_glu(p, l, gtid, gsize)));
    LPHASE(ph_rms(p, l, gtid, gsize));
    LPHASE(GPUSEL(ph_outproj_mfma(p, l, smem), ph_outproj(p, l, gtid, gsize)));
    LPHASE(ph_ln(p, l, 0, gtid, gsize));
    LPHASE(ph_router(p, l, gtid, gsize));
    LPHASE(ph_select(p, l, gtid, gsize));
    LPHASE(ph_sortrows(p, l, gtid, gsize));
    LPHASE(GPUSEL(ph_expert_up_mfma(p, l, smem), ph_expert_up(p, l, gtid, gsize)));
    LPHASE(GPUSEL(ph_expert_down_mfma(p, l, smem), ph_expert_down(p, l, gtid, gsize)));
    LPHASE(ph_combine(p, l, gtid, gsize));
    LPHASE(ph_ln(p, l, 1, gtid, gsize));
  }
#ifdef CPU_TEST
  return ph;
#endif
}


#ifndef CPU_TEST
#define NG_GPU 5
#define NLP_GPU 12
#ifndef PROBE_MASK_G
#define PROBE_MASK_G 0
#endif
#define GPHASE(stmt) do { if (SINGLE || ph == only) { long gtid = (long)blockIdx.x * NT + otid(); stmt; } if (SINGLE) { GRID_SYNC(); } ++ph; } while (0)
#define GLPHASE(stmt) do { int l = lo; OPAQUE_S(l); if (SINGLE && ((PROBE_MASK_G >> (ph - NG_GPU - lo * NLP_GPU)) & 1)) { long gtid = (long)blockIdx.x * NT + otid(); stmt; GRID_SYNC(); } GPHASE(stmt); } while (0)
template <bool SINGLE> __device__ __forceinline__ void run_seq_gpu(const P& p, long gtid0, long gsize, int only, const XcdBarrier& xb, char* smem) {
  int ph = 0;
#ifdef PROBE_INIT
  if (SINGLE) { long gtid = (long)blockIdx.x * NT + otid(); ph_g0(p, gtid, gsize); GRID_SYNC(); ph_g1(p, gtid, gsize); ph_modsum_gpu(p, gtid, gsize); ph_s5tables_gpu(p, gtid, gsize); GRID_SYNC(); ph_g2(p, gtid, gsize); ph_modu0_gpu(p, gtid, gsize); GRID_SYNC(); ph_g3(p, gtid, gsize); GRID_SYNC(); ph_g4(p, gtid, gsize); GRID_SYNC(); }
#endif
  GPHASE(ph_g0(p, gtid, gsize); s5_lampow_gpu(p, gtid, gsize); rope_table_gpu(p, gtid, gsize));
  GPHASE(ph_g1(p, gtid, gsize); ph_modsum_gpu(p, gtid, gsize); ph_s5tables_gpu(p, gtid, gsize); wt_convert_all(p, gtid, gsize));
  GPHASE(ph_g2(p, gtid, gsize); ph_modu0_gpu(p, gtid, gsize); ph_kcb_gpu(p, gtid, gsize));
  GPHASE(ph_g3(p, gtid, gsize));
  GPHASE(ph_g4(p, gtid, gsize));
#pragma unroll 1
  for (int lo = 0; lo < DEPTH; ++lo) {
    GLPHASE(ph_proj_mfma(p, l, smem));
    GLPHASE(ph_s5_sgemm(p, l, smem); ph_hyena_pre_gpu(p, l, gtid, gsize));
    GLPHASE(ph_mix(p, l, gtid, gsize); ph_s5_carry_gpu(p, l, smem); ph_attn_mfma(p, l, smem); ph_hyena_mfma(p, l, smem));
    GLPHASE(ph_s5_ygemm(p, l, smem));
    GLPHASE(ph_glu_mfma(p, l, smem));
    GLPHASE(ph_outproj_mfma(p, l, smem));
    GLPHASE(ph_ln1_gpu(p, l));
    GLPHASE(ph_router_mfma(p, l, smem));
    GLPHASE(ph_select_gpu(p, l));
#ifdef UPVAR
    if (SINGLE) { int l = lo; OPAQUE_S(l); ph_expert_up_mfma<UPVAR>(p, l, smem); GRID_SYNC(); }
#endif
    GLPHASE(ph_expert_up_mfma(p, l, smem));
    GLPHASE(ph_expert_down_mfma(p, l, smem));
    GLPHASE(ph_ln2_gpu(p, l));
  }
}
#endif

static void carve(P& p, void* ws) { p.ws = (char*)ws; }
static void set_inputs(P& p, void* const* d_in) {
  const float** f = (const float**)&p.x;
  for (int i = 0; i < 40; ++i) f[i] = (const float*)d_in[i];
}

#ifndef CPU_TEST
#ifndef MK_SINGLE
#define MK_SINGLE 1
#endif
extern __shared__ __attribute__((aligned(16))) char dyn_smem[];
__global__ void __launch_bounds__(NT, 2) mk_single(P p) {
  uint4* xbw = (uint4*)(dyn_smem + SM_XB);
  if (threadIdx.x == 0) *xbw = make_uint4(0u, 0u, 0u, 0u);
  __syncthreads();
  XcdBarrier xb = xcd_barrier_post(p.bar(), (volatile LAS unsigned*)xbw);
  run_seq_gpu<true>(p, (long)blockIdx.x * blockDim.x + threadIdx.x, (long)gridDim.x * blockDim.x, -1, xb, dyn_smem);
}
__global__ void __launch_bounds__(NT, 2) mk_phase(P p, int only) {
  XcdBarrier xb; xb.bar = p.bar(); xb.x = 0; xb.st = nullptr;
#ifdef DBG_ONLY
  only = DBG_ONLY;
#endif
  run_seq_gpu<false>(p, (long)blockIdx.x * blockDim.x + threadIdx.x, (long)gridDim.x * blockDim.x, only, xb, dyn_smem);
}
extern "C" void kernel_launch(void* const* d_in, const int* in_sizes, int n_in, void* d_out, int out_size, void* d_ws, size_t ws_size, hipStream_t stream) {
  P p; memset(&p, 0, sizeof(p));
  set_inputs(p, d_in); p.out = (float*)d_out; carve(p, d_ws);
  (void)hipMemsetAsync(p.bar(), 0, 4096 * sizeof(unsigned) + ((DEPTH * N_EXPERTS * sizeof(int) + 255) / 256) * 256, stream);
#if MK_SINGLE
  static int grid = 0;
  if (!grid) {
    int dev = 0, cus = 0, per_cu = 0; (void)hipGetDevice(&dev);
    (void)hipDeviceGetAttribute(&cus, hipDeviceAttributeMultiprocessorCount, dev);
    (void)hipFuncSetAttribute((const void*)mk_single, hipFuncAttributeMaxDynamicSharedMemorySize, SMEM_BYTES);
    (void)hipOccupancyMaxActiveBlocksPerMultiprocessor(&per_cu, mk_single, NT, SMEM_BYTES);
    grid = cus * (per_cu < 1 ? per_cu : 1);
  }
  mk_single<<<grid, NT, SMEM_BYTES, stream>>>(p);
#else
  for (int ph = 0; ph < NG_GPU + DEPTH * NLP_GPU; ++ph) mk_phase<<<256, NT, SMEM_BYTES, stream>>>(p, ph);
#endif
}
#endif
```

```cpp
#ifndef CPU_TEST
#include <hip/hip_runtime.h>
#include <cstring>
#define DEV __device__ __forceinline__
#define DEVM __device__ __forceinline__
#define HDM __host__ __device__ __forceinline__
#else
#include <cmath>
#include <cstdio>
#include <cstdlib>
#include <cstring>
#define DEV static inline
#define DEVM inline
#define HDM inline
struct float2 { float x, y; };
static inline float2 make_float2(float a, float b) { float2 r; r.x = a; r.y = b; return r; }
static inline int atomicAdd(int* p, int v) { int o = *p; *p += v; return o; }
#endif

#ifdef SMALL_CFG
#define D_MODEL 64
#define BATCH 2
#define SEQ 256
#define GRID_W 16
#define CTX_LEN 32
#define HEAD_DIM 16
#define N_Q_HEADS 4
#define N_KV_HEADS 2
#define HYENA_W 16
#define S5_W 32
#define WINDOW 32
#define FILTER_HIDDEN 16
#define S5_STATE 8
#define N_EXPERTS 32
#define TOP_K 4
#define EXPERT_FF 16
#define SHARED_FF 16
#define S5_T 32
#else
#define D_MODEL 1024
#define BATCH 2
#define SEQ 8192
#define GRID_W 64
#define CTX_LEN 256
#define HEAD_DIM 64
#define N_Q_HEADS 8
#define N_KV_HEADS 2
#define HYENA_W 256
#define S5_W 256
#define WINDOW 128
#define FILTER_HIDDEN 64
#define S5_STATE 64
#define N_EXPERTS 256
#define TOP_K 8
#define EXPERT_FF 256
#define SHARED_FF 256
#define S5_T 64
#endif
#define DEPTH 2
#define FILTER_EMB 33
#define N_EXPERT_GROUPS 8
#define TOPK_GROUPS 4
#define S5_GROUP 16
#define Q_GROUP (N_Q_HEADS / N_KV_HEADS)
#define ATTN_W (N_Q_HEADS * HEAD_DIM)
#define KV_W (N_KV_HEADS * HEAD_DIM)
#define MIX_W (ATTN_W + HYENA_W + S5_W)
#define Q_OFF 0
#define K_OFF ATTN_W
#define V_OFF (K_OFF + KV_W)
#define HY_OFF (V_OFF + KV_W)
#define S5_OFF (HY_OFF + 3 * HYENA_W)
#define IN_W (S5_OFF + S5_W)
#define AXIS_DIM (HEAD_DIM / 2)
#define ROPE_HALF (AXIS_DIM / 2)
#define S5_GROUPS (S5_W / S5_GROUP)
#define EPG (N_EXPERTS / N_EXPERT_GROUPS)
#define NL (BATCH * SEQ)
#define NC (BATCH * CTX_LEN)
#define NR (NL + NC)
#define NSEQ (CTX_LEN + SEQ)
#define NCH (NSEQ / S5_T)
#define LN_EPS 1e-5f
#define DN_ALPHA 1.4142135623730951f
#define ROUTED_SCALE 2.5f
#define PI_D 3.14159265358979323846

#define WS_LIST(X) \
  X(unsigned, bar, 4096) \
  X(int, cnt, DEPTH * N_EXPERTS) \
  X(float, mod, (size_t)DEPTH * (BATCH + 1) * 6 * D_MODEL) \
  X(float, xcur, (size_t)NR * D_MODEL) \
  X(float, ubuf, (size_t)NR * D_MODEL) \
  X(float, proj, (size_t)NR * IN_W) \
  X(float, hu, (size_t)NR * HYENA_W) \
  X(float, hx0, (size_t)NR * HYENA_W) \
  X(float, fh1, (size_t)DEPTH * SEQ * FILTER_HIDDEN) \
  X(float, fh2, (size_t)DEPTH * SEQ * FILTER_HIDDEN) \
  X(float, kraw, (size_t)DEPTH * SEQ * 2 * HYENA_W) \
  X(float, knorm, (size_t)DEPTH * HYENA_W) \
  X(float, fh1c, (size_t)CTX_LEN * FILTER_HIDDEN) \
  X(float, fh2c, (size_t)CTX_LEN * FILTER_HIDDEN) \
  X(float, krawc, (size_t)CTX_LEN * 2 * HYENA_W) \
  X(float, knormc, (size_t)HYENA_W) \
  X(float, mixb, (size_t)NR * MIX_W) \
  X(float, tmp, (size_t)NR * D_MODEL) \
  X(float2, lampow, (size_t)DEPTH * 2 * S5_GROUPS * (S5_T + 1) * S5_STATE) \
  X(float2, bbar, (size_t)DEPTH * 2 * S5_GROUPS * S5_STATE * S5_GROUP) \
  X(float, kc, (size_t)DEPTH * 2 * S5_GROUPS * S5_T * S5_GROUP * S5_GROUP) \
  X(float2, sc, (size_t)BATCH * 2 * S5_GROUPS * NCH * S5_STATE) \
  X(float2, hc, (size_t)BATCH * 2 * S5_GROUPS * NCH * S5_STATE) \
  X(float, ybuf, (size_t)NR * S5_W) \
  X(float, rl, (size_t)NR * N_EXPERTS) \
  X(int, top_e, (size_t)NR * TOP_K) \
  X(float, gate, (size_t)NR * TOP_K) \
  X(int, posb, (size_t)NR * TOP_K) \
  X(int, srow, (size_t)NR * TOP_K) \
  X(float, hbuf, (size_t)NR * TOP_K * EXPERT_FF) \
  X(float, hsb, (size_t)NR * SHARED_FF) \
  X(float, yk, (size_t)NR * TOP_K * D_MODEL) \
  X(float, ysh, (size_t)NR * D_MODEL) \
  X(unsigned short, ykb, (size_t)NR * TOP_K * D_MODEL) \
  X(unsigned short, qkvb, (size_t)NR * HY_OFF) \
  X(float2, ropet, (size_t)128 * ROPE_HALF) \
  X(unsigned short, bmtb, (size_t)DEPTH * 2 * S5_GROUPS * 128 * 1024) \
  X(unsigned short, cmtb, (size_t)DEPTH * 2 * S5_GROUPS * 1024 * 128) \
  X(unsigned short, kcb, (size_t)DEPTH * 2 * S5_GROUPS * S5_T * 256) \
  X(unsigned short, wt_in, (size_t)DEPTH * IN_W * D_MODEL) \
  X(unsigned short, wt_out, (size_t)DEPTH * D_MODEL * MIX_W) \
  X(unsigned short, wt_glu, (size_t)DEPTH * S5_W * S5_W) \
  X(unsigned short, wt_shg, (size_t)DEPTH * SHARED_FF * D_MODEL) \
  X(unsigned short, wt_shu, (size_t)DEPTH * SHARED_FF * D_MODEL) \
  X(unsigned short, wt_shd, (size_t)DEPTH * D_MODEL * SHARED_FF) \
  X(unsigned short, wt_rh, (size_t)DEPTH * N_EXPERTS * D_MODEL) \
  X(unsigned short, wt_rl, (size_t)DEPTH * N_EXPERTS * D_MODEL) \
  X(unsigned short, ubf, (size_t)NR * D_MODEL) \
  X(unsigned short, ybf, (size_t)NR * S5_W) \
  X(unsigned short, mixbf, (size_t)NR * MIX_W) \
  X(unsigned short, hbf, (size_t)NR * TOP_K * EXPERT_FF) \
  X(unsigned short, hsbf, (size_t)NR * SHARED_FF) \
  X(unsigned short, ubl, (size_t)NR * D_MODEL) \
  X(int, elist, (size_t)N_EXPERTS * NR) \
  X(unsigned short, s5u, (size_t)NR * S5_W) \
  X(float, bmt, (size_t)DEPTH * 2 * S5_GROUPS * 16 * S5_T * 2 * S5_STATE) \
  X(float, cmt, (size_t)DEPTH * 2 * S5_GROUPS * 16 * S5_T * 2 * S5_STATE) \
  X(unsigned short, hcbf, (size_t)BATCH * 2 * S5_GROUPS * NCH * 2 * S5_STATE) \
  X(float, zT, (size_t)BATCH * 3 * HYENA_W * (SEQ + CTX_LEN)) \
  X(float, modp, (size_t)DEPTH * 16 * (BATCH + 1) * 6 * D_MODEL) \
  X(float, wrlo, (size_t)DEPTH * D_MODEL * N_EXPERTS) \

struct WsOff {
#define X(T, name, n) size_t name;
  WS_LIST(X)
#undef X
  size_t total;
};
constexpr WsOff ws_offsets() {
  WsOff o{}; size_t off = 0;
#define X(T, name, n) o.name = off; off += (((size_t)(n)) * sizeof(T) + 255) / 256 * 256;
  WS_LIST(X)
#undef X
  o.total = off; return o;
}
constexpr WsOff WSO = ws_offsets();
struct P {
  const float *x, *c, *ctx, *c_ctx, *w_ada, *b_ada, *w_in, *w_out, *sink, *mix_g, *hy_short_w, *hy_short_b, *hy_w1,
      *hy_b1, *hy_freq, *hy_w2, *hy_b2, *hy_w3, *hy_d, *s5_a_re, *s5_a_im, *s5_log_dt, *s5_b_re, *s5_b_im, *s5_c_re,
      *s5_c_im, *s5_d, *s5_w_glu, *ln1_g, *ln1_b, *ln2_g, *ln2_b, *w_router, *router_bias, *w_exp_gate, *w_exp_up,
      *w_exp_down, *w_sh_gate, *w_sh_up, *w_sh_down;
  float* out;
  char* ws;
#define X(T, name, n) HDM T* name() const { return (T*)(ws + WSO.name); }
  WS_LIST(X)
#undef X
};

#define FOR_ITEMS(i, N) for (long i = gtid; i < (long)(N); i += gsize)
#ifndef CPU_TEST
#define FOR_ITEMS4(i, N) _Pragma("unroll 4") for (long i = gtid; i < (long)(N); i += gsize)
#else
#define FOR_ITEMS4(i, N) FOR_ITEMS(i, N)
#endif

DEV unsigned short f2bf16(float f) { unsigned u; memcpy(&u, &f, 4); return (unsigned short)((u + 0x7fffu + ((u >> 16) & 1u)) >> 16); }
DEV float siluf(float x) { return x / (1.0f + expf(-x)); }
DEV float sigmoidf_(float x) { return 1.0f / (1.0f + expf(-x)); }
DEV float gelu_tanhf(float x) { return 0.5f * x * (1.0f + tanhf(0.7978845608028654f * (x + 0.044715f * x * x * x))); }
DEV int modrow(long r) { return r < NL ? (int)(r / SEQ) : BATCH; }

DEV void ph_g0(const P& p, long gtid, long gsize) {
#ifndef CPU_TEST
  FOR_ITEMS4(i4, (long)NR * D_MODEL / 4) { const long i = i4 * 4; *(float4*)(p.xcur() + i) = i < (long)NL * D_MODEL ? *(const float4*)(p.x + i) : *(const float4*)(p.ctx + (i - (long)NL * D_MODEL)); }
#else
  FOR_ITEMS(i, (long)NR * D_MODEL) p.xcur()[i] = i < (long)NL * D_MODEL ? p.x[i] : p.ctx[i - (long)NL * D_MODEL];
#endif
#ifdef CPU_TEST
  FOR_ITEMS(i, DEPTH * (BATCH + 1) * 6 * D_MODEL) {
    int n = (int)(i % (6 * D_MODEL)); int j = (int)((i / (6 * D_MODEL)) % (BATCH + 1)); int l = (int)(i / (6 * D_MODEL * (BATCH + 1)));
    const float* cv = j < BATCH ? p.c + j * D_MODEL : p.c_ctx;
    const float* w = p.w_ada + (long)l * D_MODEL * 6 * D_MODEL;
    float acc = p.b_ada[l * 6 * D_MODEL + n];
    for (int k = 0; k < D_MODEL; ++k) acc += siluf(cv[k]) * w[(long)k * 6 * D_MODEL + n];
    p.mod()[i] = acc;
  }
#else
  FOR_ITEMS(i, (long)DEPTH * 16 * 6 * D_MODEL) {
    const int n = (int)(i % (6 * D_MODEL)); const int slab = (int)((i / (6 * D_MODEL)) % 16); const int l = (int)(i / (6 * D_MODEL * 16));
    const float* w = p.w_ada + ((long)l * D_MODEL + slab * 64) * 6 * D_MODEL + n;
    float a0 = 0.f, a1 = 0.f, a2 = 0.f;
#pragma unroll 8
    for (int k = 0; k < 64; ++k) {
      const float wv = w[(long)k * 6 * D_MODEL]; const int kk = slab * 64 + k;
      a0 += siluf(p.c[kk]) * wv; a1 += siluf(p.c[D_MODEL + kk]) * wv; a2 += siluf(p.c_ctx[kk]) * wv;
    }
    float* dst = p.modp() + ((long)(l * 16 + slab) * (BATCH + 1)) * 6 * D_MODEL + n;
    dst[0] = a0; dst[6 * D_MODEL] = a1; dst[2 * 6 * D_MODEL] = a2;
  }
#endif
  FOR_ITEMS(i, DEPTH * 2 * S5_GROUPS * S5_STATE) {
    int pp = (int)(i % S5_STATE); int g = (int)((i / S5_STATE) % S5_GROUPS); int ld = (int)(i / (S5_STATE * S5_GROUPS));
    float are = fminf(p.s5_a_re[i], -1e-4f), aim = p.s5_a_im[i];
    float dt = expf(p.s5_log_dt[ld * S5_GROUPS + g]);
#ifdef CPU_TEST
    for (int d = 0; d <= S5_T; ++d) {
      float mag = expf(are * dt * d); float ang = aim * dt * d;
      p.lampow()[((long)(ld * S5_GROUPS + g) * (S5_T + 1) + d) * S5_STATE + pp] = make_float2(mag * cosf(ang), mag * sinf(ang));
    }
#endif
    float mag = expf(are * dt), ang = aim * dt;
    float lr = mag * cosf(ang) - 1.0f, li = mag * sinf(ang);
    float den = are * are + aim * aim;
    float fr = (lr * are + li * aim) / den, fi = (li * are - lr * aim) / den;
    for (int j = 0; j < S5_GROUP; ++j) {
      float br = p.s5_b_re[i * S5_GROUP + j], bi = p.s5_b_im[i * S5_GROUP + j];
      p.bbar()[i * S5_GROUP + j] = make_float2(fr * br - fi * bi, fr * bi + fi * br);
    }
  }
}
#ifndef CPU_TEST
DEV void rope_table_gpu(const P& p, long gtid, long gsize) {
  FOR_ITEMS(i, (long)128 * ROPE_HALF) {
    const int ii = (int)(i % ROPE_HALF), pos = (int)(i / ROPE_HALF);
    const float ang = (float)pos * powf(10000.0f, -(float)(2 * ii) / (float)AXIS_DIM);
    p.ropet()[i] = make_float2(cosf(ang), sinf(ang));
  }
}
DEV void s5_lampow_gpu(const P& p, long gtid, long gsize) {
  FOR_ITEMS4(i, (long)DEPTH * 2 * S5_GROUPS * (S5_T + 1) * S5_STATE) {
    const int pp = (int)(i % S5_STATE); const int d = (int)((i / S5_STATE) % (S5_T + 1)); const long ldg = i / ((long)S5_STATE * (S5_T + 1));
    const long src = ldg * S5_STATE + pp;
    const float are = fminf(p.s5_a_re[src], -1e-4f), aim = p.s5_a_im[src]; const float dt = expf(p.s5_log_dt[ldg]);
    const float mag = expf(are * dt * d); const float ang = aim * dt * d;
    p.lampow()[i] = make_float2(mag * cosf(ang), mag * sinf(ang));
  }
}
#endif
DEV void hy_f1(const P& p, int l, int Lf, float* h1, long gtid, long gsize) {
  FOR_ITEMS(i, (long)Lf * FILTER_HIDDEN) {
    int j = (int)(i % FILTER_HIDDEN); int t = (int)(i / FILTER_HIDDEN);
    const float* w1 = p.hy_w1 + l * FILTER_EMB * FILTER_HIDDEN;
    float tt = (float)((double)t / (double)(Lf - 1));
    float w = (float)(2.0 * PI_D * (double)t / (double)Lf);
    float acc = p.hy_b1[l * FILTER_HIDDEN + j] + tt * w1[j];
    const int bands = (FILTER_EMB - 1) / 2;
    for (int m = 0; m < bands; ++m) {
      float f = (float)(1e-4 + (double)m * ((double)(bands - 1) - 1e-4) / (double)(bands - 1));
      float a = f * w;
      acc += cosf(a) * w1[(1 + m) * FILTER_HIDDEN + j] - sinf(a) * w1[(1 + bands + m) * FILTER_HIDDEN + j];
    }
    h1[i] = sinf(p.hy_freq[l * FILTER_HIDDEN + j] * acc);
  }
}
DEV void hy_f2(const P& p, int l, int Lf, const float* h1, float* h2, long gtid, long gsize) {
  FOR_ITEMS(i, (long)Lf * FILTER_HIDDEN) {
    int j = (int)(i % FILTER_HIDDEN); int t = (int)(i / FILTER_HIDDEN);
    const float* w2 = p.hy_w2 + l * FILTER_HIDDEN * FILTER_HIDDEN;
    float acc = p.hy_b2[l * FILTER_HIDDEN + j];
    for (int k = 0; k < FILTER_HIDDEN; ++k) acc += h1[t * FILTER_HIDDEN + k] * w2[k * FILTER_HIDDEN + j];
#ifndef CPU_TEST
    h2[(long)j * Lf + t] = sinf(p.hy_freq[l * FILTER_HIDDEN + j] * acc);
#else
    h2[i] = sinf(p.hy_freq[l * FILTER_HIDDEN + j] * acc);
#endif
  }
}
DEV void hy_f3(const P& p, int l, int Lf, const float* h2, float* kraw, long gtid, long gsize) {
#ifndef CPU_TEST
  const float* w3 = p.hy_w3 + l * FILTER_HIDDEN * 2 * HYENA_W;
  FOR_ITEMS(i, (long)Lf * (2 * HYENA_W / 8)) {
    const int t = (int)(i % Lf); const int c8 = (int)(i / Lf) * 8;
    float acc[8];
#pragma unroll
    for (int j = 0; j < 8; ++j) acc[j] = 0.f;
#pragma unroll 4
    for (int k = 0; k < FILTER_HIDDEN; ++k) {
      const float hv = h2[(long)k * Lf + t];
      const float4 wa = *(const float4*)(w3 + k * 2 * HYENA_W + c8), wb = *(const float4*)(w3 + k * 2 * HYENA_W + c8 + 4);
      acc[0] += hv * wa.x; acc[1] += hv * wa.y; acc[2] += hv * wa.z; acc[3] += hv * wa.w; acc[4] += hv * wb.x; acc[5] += hv * wb.y; acc[6] += hv * wb.z; acc[7] += hv * wb.w;
    }
    const double d0 = log(1e-2) / 0.3, d1 = log(1e-2) / 1.5;
    const float tt = (float)((double)t / (double)(Lf - 1));
#pragma unroll
    for (int j = 0; j < 8; ++j) {
      const int ch = (c8 + j) % HYENA_W;
      const float delta = fabsf((float)(d0 + (d1 - d0) * (double)ch / (double)(HYENA_W - 1)));
      kraw[(long)(c8 + j) * Lf + t] = acc[j] * expf(-tt * delta);
    }
  }
#else
  FOR_ITEMS(i, (long)Lf * 2 * HYENA_W) {
    int t = (int)(i % Lf); int cc = (int)(i / Lf); int ch = cc % HYENA_W;
    const float* w3 = p.hy_w3 + l * FILTER_HIDDEN * 2 * HYENA_W;
    float acc = 0.f;
    for (int k = 0; k < FILTER_HIDDEN; ++k) acc += h2[t * FILTER_HIDDEN + k] * w3[k * 2 * HYENA_W + cc];
    double d0 = log(1e-2) / 0.3, d1 = log(1e-2) / 1.5;
    float delta = fabsf((float)(d0 + (d1 - d0) * (double)ch / (double)(HYENA_W - 1)));
    float tt = (float)((double)t / (double)(Lf - 1));
    kraw[(long)cc * Lf + t] = acc * expf(-tt * delta);
  }
#endif
}
DEV void hy_f4(int Lf, const float* kraw, float* knorm, long gtid, long gsize) {
#ifndef CPU_TEST
  const int lane = (int)(gtid & 63); const long gw = gtid >> 6, nw = gsize >> 6;
  for (long i = gw; i < HYENA_W; i += nw) {
    float s = 0.f;
    for (int t = lane; t < Lf; t += 64) { s += fabsf(kraw[i * Lf + t]); if (t > 0) s += fabsf(kraw[(HYENA_W + i) * Lf + t]); }
    for (int o = 32; o > 0; o >>= 1) s += __shfl_xor(s, o);
    if (lane == 0) knorm[i] = 1.0f / s;
  }
#else
  FOR_ITEMS(i, HYENA_W) {
    float s = 0.f;
    for (int t = 0; t < Lf; ++t) {
      s += fabsf(kraw[(long)i * Lf + t]);
      if (t > 0) s += fabsf(kraw[(long)(HYENA_W + i) * Lf + t]);
    }
    knorm[i] = 1.0f / s;
  }
#endif
}
DEV void ph_g1(const P& p, long gtid, long gsize) {
  for (int l = 0; l < DEPTH; ++l) hy_f1(p, l, SEQ, p.fh1() + (long)l * SEQ * FILTER_HIDDEN, gtid, gsize);
  hy_f1(p, 0, CTX_LEN, p.fh1c(), gtid, gsize);
  FOR_ITEMS(i, (long)DEPTH * 2 * S5_GROUPS * S5_T * S5_GROUP * S5_GROUP) {
    int j = (int)(i % S5_GROUP); int ii = (int)((i / S5_GROUP) % S5_GROUP); int d = (int)((i / (S5_GROUP * S5_GROUP)) % S5_T);
    long ldg = i / (S5_GROUP * S5_GROUP * S5_T);
    float acc = 0.f;
    for (int pp = 0; pp < S5_STATE; ++pp) {
      float cr = p.s5_c_re[(ldg * S5_GROUP + ii) * S5_STATE + pp], ci = p.s5_c_im[(ldg * S5_GROUP + ii) * S5_STATE + pp];
      float2 lp = p.lampow()[(ldg * (S5_T + 1) + d) * S5_STATE + pp];
      float2 bb = p.bbar()[(ldg * S5_STATE + pp) * S5_GROUP + j];
      float tr = lp.x * bb.x - lp.y * bb.y, ti = lp.x * bb.y + lp.y * bb.x;
      acc += cr * tr - ci * ti;
    }
    p.kc()[i] = acc;
  }
}
DEV void ph_g2(const P& p, long gtid, long gsize) {
  for (int l = 0; l < DEPTH; ++l) hy_f2(p, l, SEQ, p.fh1() + (long)l * SEQ * FILTER_HIDDEN, p.fh2() + (long)l * SEQ * FILTER_HIDDEN, gtid, gsize);
  hy_f2(p, 0, CTX_LEN, p.fh1c(), p.fh2c(), gtid, gsize);
}
DEV void ph_g3(const P& p, long gtid, long gsize) {
  for (int l = 0; l < DEPTH; ++l) hy_f3(p, l, SEQ, p.fh2() + (long)l * SEQ * FILTER_HIDDEN, p.kraw() + (long)l * SEQ * 2 * HYENA_W, gtid, gsize);
  hy_f3(p, 0, CTX_LEN, p.fh2c(), p.krawc(), gtid, gsize);
}
DEV void ph_g4(const P& p, long gtid, long gsize) {
  for (int l = 0; l < DEPTH; ++l) hy_f4(SEQ, p.kraw() + (long)l * SEQ * 2 * HYENA_W, p.knorm() + l * HYENA_W, gtid, gsize);
  hy_f4(CTX_LEN, p.krawc(), p.knormc(), gtid, gsize);
}
#define NG 5

DEV void ph_modu(const P& p, int l, int which, long gtid, long gsize) {
  FOR_ITEMS(i, (long)NR * D_MODEL) {
    int k = (int)(i % D_MODEL); long r = i / D_MODEL;
    const float* m = p.mod() + ((long)l * (BATCH + 1) + modrow(r)) * 6 * D_MODEL + which * 3 * D_MODEL;
    float uv = p.xcur()[i] * (1.0f + m[D_MODEL + k]) + m[k];
    p.ubuf()[i] = uv; p.ubf()[i] = f2bf16(uv);
  }
}
template <class Epi>
DEV void gemm_naive(const float* A, int lda, const float* B, int ldb, int M, int N, int K, Epi epi, long gtid, long gsize) {
  FOR_ITEMS(i, (long)(M / 4) * N) {
    int n = (int)(i % N); long r0 = (i / N) * 4;
    const float* a0 = A + r0 * lda;
    float c0 = 0.f, c1 = 0.f, c2 = 0.f, c3 = 0.f;
    for (int k = 0; k < K; ++k) {
      float b = B[(long)k * ldb + n];
      c0 += a0[k] * b; c1 += a0[lda + k] * b; c2 += a0[2 * lda + k] * b; c3 += a0[3 * lda + k] * b;
    }
    epi(r0, n, c0); epi(r0 + 1, n, c1); epi(r0 + 2, n, c2); epi(r0 + 3, n, c3);
  }
}
struct EpiStore { float* C; int ldc; DEVM void operator()(long r, int n, float v) const { C[r * ldc + n] = v; } };
DEV void ph_proj(const P& p, int l, long gtid, long gsize) {
  EpiStore e{p.proj(), IN_W};
  gemm_naive(p.ubuf(), D_MODEL, p.w_in + (long)l * D_MODEL * IN_W, IN_W, NR, IN_W, D_MODEL, e, gtid, gsize);
}
DEV long s5_row(int b, int dir, int n) {
  if (n < CTX_LEN) return (long)NL + b * CTX_LEN + (dir ? CTX_LEN - 1 - n : n);
  int t = n - CTX_LEN; return (long)b * SEQ + (dir ? SEQ - 1 - t : t);
}
DEV void ph_post_proj(const P& p, int l, long gtid, long gsize) {
  FOR_ITEMS(i, (long)NL * (N_Q_HEADS + N_KV_HEADS) * 2 * ROPE_HALF) {
    int ii = (int)(i % ROPE_HALF); int a = (int)((i / ROPE_HALF) % 2); int hs = (int)((i / (2 * ROPE_HALF)) % (N_Q_HEADS + N_KV_HEADS));
    long r = i / (2 * ROPE_HALF * (N_Q_HEADS + N_KV_HEADS));
    int t = (int)(r % SEQ); int pos = a == 0 ? t / GRID_W : t % GRID_W;
    float inv = powf(10000.0f, -(float)(2 * ii) / (float)AXIS_DIM);
    float ang = (float)pos * inv; float cs = cosf(ang), sn = sinf(ang);
    float* q = p.proj() + r * IN_W + hs * HEAD_DIM + a * AXIS_DIM + ii;
    float x1 = q[0], x2 = q[ROPE_HALF];
    q[0] = x1 * cs - x2 * sn; q[ROPE_HALF] = x1 * sn + x2 * cs;
  }
#ifdef CPU_TEST
  FOR_ITEMS(i, (long)NR * HYENA_W) {
    int ch = (int)(i % HYENA_W); long r = i / HYENA_W;
    int Ls = r < NL ? SEQ : CTX_LEN; long base = r < NL ? (r / SEQ) * SEQ : NL + ((r - NL) / CTX_LEN) * CTX_LEN; int t = (int)(r - base);
    const float* sw = p.hy_short_w + l * 3 * 3 * HYENA_W; const float* sb = p.hy_short_b + l * 3 * HYENA_W;
    float z[3];
#pragma unroll
    for (int part = 0; part < 3; ++part) {
      int cc = part * HYENA_W + ch; float acc = sb[cc];
#pragma unroll
      for (int j = 0; j < 3; ++j) { int tt = t + j - 1; if (tt >= 0 && tt < Ls) acc += p.proj()[(base + tt) * IN_W + HY_OFF + cc] * sw[j * 3 * HYENA_W + cc]; }
      z[part] = acc;
    }
    long o = r < NL ? ((r / SEQ) * HYENA_W + ch) * SEQ + t : i;
    p.hu()[o] = z[0] * z[1]; p.hx0()[o] = z[2];
  }
#endif
#ifndef CPU_TEST
  FOR_ITEMS(i, (long)NR * S5_W) { long r = i / S5_W; int cc = (int)(i % S5_W); p.s5u()[i] = f2bf16(p.proj()[r * IN_W + S5_OFF + cc]); }
#endif
#ifdef CPU_TEST
  FOR_ITEMS(i, (long)BATCH * 2 * S5_GROUPS * NCH * S5_STATE) {
    int pp = (int)(i % S5_STATE); int c = (int)((i / S5_STATE) % NCH); int g = (int)((i / (S5_STATE * NCH)) % S5_GROUPS);
    int dir = (int)((i / (S5_STATE * NCH * S5_GROUPS)) % 2); int b = (int)(i / (S5_STATE * NCH * S5_GROUPS * 2));
    long ldg = ((long)l * 2 + dir) * S5_GROUPS + g;
    float sr = 0.f, si = 0.f;
    for (int s = 0; s < S5_T; ++s) {
      const float* u = p.proj() + s5_row(b, dir, c * S5_T + s) * IN_W + S5_OFF + g * S5_GROUP;
      float br = 0.f, bi = 0.f;
#pragma unroll
      for (int j = 0; j < S5_GROUP; ++j) { float2 bb = p.bbar()[(ldg * S5_STATE + pp) * S5_GROUP + j]; br += bb.x * u[j]; bi += bb.y * u[j]; }
      float2 lp = p.lampow()[(ldg * (S5_T + 1) + (S5_T - 1 - s)) * S5_STATE + pp];
      sr += lp.x * br - lp.y * bi; si += lp.x * bi + lp.y * br;
    }
    p.sc()[i] = make_float2(sr, si);
  }
#endif
}
DEV void attn_item(const P& p, int l, long r, int h, float* outp) {
  const float scale = 1.0f / sqrtf((float)HEAD_DIM);
  float q[HEAD_DIM], acc[HEAD_DIM];
  const float* qp = p.proj() + r * IN_W + Q_OFF + h * HEAD_DIM;
#pragma unroll
  for (int d = 0; d < HEAD_DIM; ++d) { q[d] = qp[d] * scale; acc[d] = 0.f; }
  int kvh = h / Q_GROUP; int b = r < NL ? (int)(r / SEQ) : (int)((r - NL) / CTX_LEN);
  float m = -1e30f, lsum = 0.f;
  int nwin = 0, t = 0;
  if (r < NL) { t = (int)(r % SEQ); nwin = 2 * WINDOW + 1; }
  for (int j = 0; j < nwin + CTX_LEN; ++j) {
    long kr;
    if (j < nwin) { int tk = t - WINDOW + j; if (tk < 0 || tk >= SEQ) continue; kr = (long)b * SEQ + tk; }
    else kr = (long)NL + b * CTX_LEN + (j - nwin);
    const float* kp = p.proj() + kr * IN_W + K_OFF + kvh * HEAD_DIM; const float* vp = p.proj() + kr * IN_W + V_OFF + kvh * HEAD_DIM;
    float s = 0.f;
#pragma unroll
    for (int d = 0; d < HEAD_DIM; ++d) s += q[d] * kp[d];
    float mn = fmaxf(m, s); float corr = expf(m - mn); float pe = expf(s - mn);
    lsum = lsum * corr + pe;
#pragma unroll
    for (int d = 0; d < HEAD_DIM; ++d) acc[d] = acc[d] * corr + pe * vp[d];
    m = mn;
  }
  float sk = p.sink[l * N_Q_HEADS + h]; float mf = fmaxf(m, sk); float corr = expf(m - mf);
  float den = lsum * corr + expf(sk - mf); float sc2 = corr / den;
#pragma unroll
  for (int d = 0; d < HEAD_DIM; ++d) outp[d] = acc[d] * sc2;
}
DEV void ph_mix(const P& p, int l, long gtid, long gsize) {
#ifdef CPU_TEST
  long nrows_att = l == 0 ? NR : NL;
  FOR_ITEMS(i, nrows_att * N_Q_HEADS) { int h = (int)(i % N_Q_HEADS); long r = i / N_Q_HEADS; attn_item(p, l, r, h, p.mixb() + r * MIX_W + h * HEAD_DIM); }
#endif
#ifdef CPU_TEST
  FOR_ITEMS(i, (long)NL * HYENA_W) {
    int ch = (int)(i % HYENA_W); long r = i / HYENA_W; int t = (int)(r % SEQ); int b = (int)(r / SEQ);
    const float* kf = p.kraw() + ((long)l * 2 * HYENA_W + ch) * SEQ; const float* kb = p.kraw() + ((long)l * 2 * HYENA_W + HYENA_W + ch) * SEQ;
    const float* uu = p.hu() + ((long)b * HYENA_W + ch) * SEQ;
    float acc = 0.f;
    for (int s = 0; s <= t; ++s) acc += kf[t - s] * uu[s];
    for (int s = t + 1; s < SEQ; ++s) acc += kb[s - t] * uu[s];
    p.mixb()[r * MIX_W + ATTN_W + ch] = (acc * p.knorm()[l * HYENA_W + ch] + uu[t] * p.hy_d[l * HYENA_W + ch]) * p.hx0()[((long)b * HYENA_W + ch) * SEQ + t];
  }
#endif
  if (l == 0) {
#ifndef CPU_TEST
    FOR_ITEMS(i, (long)NC * HYENA_W) {
      const int t = (int)(i % CTX_LEN); const int ch = (int)((i / CTX_LEN) % HYENA_W); const int b = (int)(i / ((long)CTX_LEN * HYENA_W));
      const long base = (long)NL + (long)b * CTX_LEN; const long r = base + t;
      const float* kf = p.krawc() + (long)ch * CTX_LEN; const float* kb = p.krawc() + (long)(HYENA_W + ch) * CTX_LEN;
      float acc = 0.f;
#pragma unroll 8
      for (int sidx = 0; sidx < CTX_LEN; ++sidx) {
        const int d = t - sidx; const float kv = d >= 0 ? kf[d] : kb[-d];
        acc += kv * p.hu()[(base + sidx) * HYENA_W + ch];
      }
      const float u = p.hu()[r * HYENA_W + ch];
      p.mixb()[r * MIX_W + ATTN_W + ch] = (acc * p.knormc()[ch] + u * p.hy_d[l * HYENA_W + ch]) * p.hx0()[r * HYENA_W + ch];
    }
#else
    FOR_ITEMS(i, (long)NC * HYENA_W) {
      int ch = (int)(i % HYENA_W); long r = NL + i / HYENA_W; int t = (int)((r - NL) % CTX_LEN); long base = r - t;
      float acc = 0.f;
      for (int s = 0; s <= t; ++s) acc += p.krawc()[(long)ch * CTX_LEN + (t - s)] * p.hu()[(base + s) * HYENA_W + ch];
      for (int s = t + 1; s < CTX_LEN; ++s) acc += p.krawc()[(long)(HYENA_W + ch) * CTX_LEN + (s - t)] * p.hu()[(base + s) * HYENA_W + ch];
      float u = p.hu()[r * HYENA_W + ch];
      p.mixb()[r * MIX_W + ATTN_W + ch] = (acc * p.knormc()[ch] + u * p.hy_d[l * HYENA_W + ch]) * p.hx0()[r * HYENA_W + ch];
    }
#endif
  }
#ifdef CPU_TEST
  FOR_ITEMS(i, (long)BATCH * 2 * S5_GROUPS * S5_STATE) {
    int pp = (int)(i % S5_STATE); int g = (int)((i / S5_STATE) % S5_GROUPS); int dir = (int)((i / (S5_STATE * S5_GROUPS)) % 2); int b = (int)(i / (S5_STATE * S5_GROUPS * 2));
    long ldg = ((long)l * 2 + dir) * S5_GROUPS + g;
    float2 lt = p.lampow()[(ldg * (S5_T + 1) + S5_T) * S5_STATE + pp];
    float hr = 0.f, hi = 0.f;
    long base = (((long)b * 2 + dir) * S5_GROUPS + g) * NCH;
#ifndef CPU_TEST
    static_assert(NCH % 12 == 0, "carry batching");
    for (int c0 = 0; c0 < NCH; c0 += 12) {
      float2 sv[12];
#pragma unroll
      for (int k = 0; k < 12; ++k) sv[k] = p.sc()[(base + c0 + k) * S5_STATE + pp];
#pragma unroll
      for (int k = 0; k < 12; ++k) {
        p.hcbf()[(base + c0 + k) * 2 * S5_STATE + pp] = f2bf16(hr); p.hcbf()[(base + c0 + k) * 2 * S5_STATE + S5_STATE + pp] = f2bf16(hi);
        const float nr = lt.x * hr - lt.y * hi + sv[k].x, ni = lt.x * hi + lt.y * hr + sv[k].y;
        hr = nr; hi = ni;
      }
    }
#else
    for (int c = 0; c < NCH; ++c) {
      p.hc()[(base + c) * S5_STATE + pp] = make_float2(hr, hi);
      float2 s = p.sc()[(base + c) * S5_STATE + pp];
      float nr = lt.x * hr - lt.y * hi + s.x, ni = lt.x * hi + lt.y * hr + s.y;
      hr = nr; hi = ni;
    }
#endif
  }
#endif
}
DEV void ph_s5out(const P& p, int l, long gtid, long gsize) {
  FOR_ITEMS(i, (long)NR * S5_W) {
    int chn = (int)(i % S5_W); long r = i / S5_W; int g = chn / S5_GROUP, ii = chn % S5_GROUP;
    int b, tl; bool isctx = r >= NL;
    if (isctx) { b = (int)((r - NL) / CTX_LEN); tl = (int)((r - NL) % CTX_LEN); } else { b = (int)(r / SEQ); tl = (int)(r % SEQ); }
    float y = p.s5_d[l * S5_W + chn] * p.proj()[r * IN_W + S5_OFF + chn];
    for (int dir = 0; dir < 2; ++dir) {
      int n = isctx ? (dir ? CTX_LEN - 1 - tl : tl) : CTX_LEN + (dir ? SEQ - 1 - tl : tl);
      int c = n / S5_T, tau = n % S5_T;
      long ldg = ((long)l * 2 + dir) * S5_GROUPS + g;
      long hb = ((((long)b * 2 + dir) * S5_GROUPS + g) * NCH + c) * S5_STATE;
      for (int pp = 0; pp < S5_STATE; ++pp) {
        float cr = p.s5_c_re[(ldg * S5_GROUP + ii) * S5_STATE + pp], ci = p.s5_c_im[(ldg * S5_GROUP + ii) * S5_STATE + pp];
        float2 lp = p.lampow()[(ldg * (S5_T + 1) + tau + 1) * S5_STATE + pp]; float2 h = p.hc()[hb + pp];
        float tr = lp.x * h.x - lp.y * h.y, ti = lp.x * h.y + lp.y * h.x;
        y += cr * tr - ci * ti;
      }
      for (int s = 0; s <= tau; ++s) {
        const float* u = p.proj() + s5_row(b, dir, c * S5_T + s) * IN_W + S5_OFF + g * S5_GROUP;
        const float* kk = p.kc() + ((ldg * S5_T + (tau - s)) * S5_GROUP + ii) * S5_GROUP;
#pragma unroll
        for (int j = 0; j < S5_GROUP; ++j) y += kk[j] * u[j];
      }
    }
    float gy = gelu_tanhf(y); p.ybuf()[i] = gy; p.ybf()[i] = f2bf16(gy);
  }
}
struct EpiGlu { const float* g; float* mixb; DEVM void operator()(long r, int n, float v) const { mixb[r * MIX_W + ATTN_W + HYENA_W + n] = g[r * S5_W + n] * sigmoidf_(v); } };
DEV void ph_glu(const P& p, int l, long gtid, long gsize) {
  EpiGlu e{p.ybuf(), p.mixb()};
  gemm_naive(p.ybuf(), S5_W, p.s5_w_glu + (long)l * S5_W * S5_W, S5_W, NR, S5_W, S5_W, e, gtid, gsize);
}
DEV void ph_rms(const P& p, int l, long gtid, long gsize) {
  FOR_ITEMS(i, (long)NR * 3) {
    int grp = (int)(i % 3); long r = i / 3;
    int off = grp == 0 ? 0 : (grp == 1 ? ATTN_W : ATTN_W + HYENA_W); int w = grp == 0 ? ATTN_W : (grp == 1 ? HYENA_W : S5_W);
    float* v = p.mixb() + r * MIX_W + off; float ss = 0.f;
    for (int k = 0; k < w; ++k) ss += v[k] * v[k];
    float rs = 1.0f / sqrtf(ss / (float)w + LN_EPS);
    for (int k = 0; k < w; ++k) { float nv = v[k] * rs * p.mix_g[l * MIX_W + off + k]; v[k] = nv; p.mixbf()[r * MIX_W + off + k] = f2bf16(nv); }
  }
}
struct EpiRes { const float* xcur; const float* mod; int l; int goff; float* tmp;
  DEVM void operator()(long r, int n, float v) const { const float* m = mod + ((long)l * (BATCH + 1) + modrow(r)) * 6 * D_MODEL + goff; tmp[r * D_MODEL + n] = DN_ALPHA * xcur[r * D_MODEL + n] + m[n] * v; } };
DEV void ph_outproj(const P& p, int l, long gtid, long gsize) {
  EpiRes e{p.xcur(), p.mod(), l, 2 * D_MODEL, p.tmp()};
  gemm_naive(p.mixb(), MIX_W, p.w_out + (long)l * MIX_W * D_MODEL, D_MODEL, NR, D_MODEL, MIX_W, e, gtid, gsize);
}
DEV void ph_ln(const P& p, int l, int which, long gtid, long gsize) {
  const float* gw = (which == 0 ? p.ln1_g : p.ln2_g) + l * D_MODEL; const float* bw = (which == 0 ? p.ln1_b : p.ln2_b) + l * D_MODEL;
  FOR_ITEMS(r, (long)NR) {
    const float* v = p.tmp() + r * D_MODEL; float mu = 0.f;
#pragma unroll 4
    for (int k = 0; k < D_MODEL; ++k) mu += v[k];
    mu /= (float)D_MODEL; float var = 0.f;
#pragma unroll 4
    for (int k = 0; k < D_MODEL; ++k) { float d = v[k] - mu; var += d * d; }
    float rs = 1.0f / sqrtf(var / (float)D_MODEL + LN_EPS);
    const float* m = p.mod() + ((long)l * (BATCH + 1) + modrow(r)) * 6 * D_MODEL + 3 * D_MODEL;
#pragma unroll 2
    for (int k = 0; k < D_MODEL; ++k) {
      float y = (v[k] - mu) * rs * gw[k] + bw[k];
      p.xcur()[r * D_MODEL + k] = y;
      if (which == 0) { float uv = y * (1.0f + m[D_MODEL + k]) + m[k]; p.ubuf()[r * D_MODEL + k] = uv; p.ubf()[r * D_MODEL + k] = f2bf16(uv); }
      if (which == 1 && l == DEPTH - 1 && r < NL) p.out[r * D_MODEL + k] = y;
    }
  }
}
DEV void ph_router(const P& p, int l, long gtid, long gsize) {
  EpiStore e{p.rl(), N_EXPERTS};
  gemm_naive(p.ubuf(), D_MODEL, p.w_router + (long)l * D_MODEL * N_EXPERTS, N_EXPERTS, NR, N_EXPERTS, D_MODEL, e, gtid, gsize);
}
DEV bool better(float v, int i, float bv, int bi) { return v > bv || (v == bv && i < bi); }
DEV void ph_select(const P& p, int l, long gtid, long gsize) {
  FOR_ITEMS(r, (long)NR) {
    const float* lg = p.rl() + r * N_EXPERTS; const float* rb = p.router_bias + l * N_EXPERTS;
    float gs[N_EXPERT_GROUPS];
#pragma unroll
    for (int g = 0; g < N_EXPERT_GROUPS; ++g) {
      float m1 = -1e30f, m2 = -1e30f;
      for (int e = 0; e < EPG; ++e) { float v = sigmoidf_(lg[g * EPG + e]) + rb[g * EPG + e]; if (v > m1) { m2 = m1; m1 = v; } else if (v > m2) m2 = v; }
      gs[g] = m1 + m2;
    }
    unsigned keep = 0;
#pragma unroll
    for (int it = 0; it < TOPK_GROUPS; ++it) {
      float bv = -1e30f; int bi = -1;
#pragma unroll
      for (int g = 0; g < N_EXPERT_GROUPS; ++g) if (!((keep >> g) & 1u) && (bi < 0 || gs[g] > bv)) { bv = gs[g]; bi = g; }
      keep |= 1u << bi;
    }
    float lastv = 1e30f; int lasti = -1; float gsum = 0.f;
    for (int it = 0; it < TOP_K; ++it) {
      float bv = -1e30f; int bi = -1;
      for (int e = 0; e < N_EXPERTS; ++e) {
        if (!((keep >> (e / EPG)) & 1u)) continue;
        float v = sigmoidf_(lg[e]) + rb[e];
        if (!better(lastv, lasti, v, e)) continue;
        if (bi < 0 || better(v, e, bv, bi)) { bv = v; bi = e; }
      }
      lastv = bv; lasti = bi;
      float sc = sigmoidf_(lg[bi]); gsum += sc;
      p.top_e()[r * TOP_K + it] = bi; p.gate()[r * TOP_K + it] = sc;
      p.posb()[r * TOP_K + it] = atomicAdd(&p.cnt()[l * N_EXPERTS + bi], 1);
    }
    float inv = ROUTED_SCALE / gsum;
    for (int it = 0; it < TOP_K; ++it) p.gate()[r * TOP_K + it] *= inv;
  }
}
DEV void ph_sortrows(const P& p, int l, long gtid, long gsize) {
  FOR_ITEMS(i, (long)NR * TOP_K) {
    int e = p.top_e()[i]; int off = 0;
    for (int j = 0; j < e; ++j) off += p.cnt()[l * N_EXPERTS + j];
    p.srow()[off + p.posb()[i]] = (int)i;
  }
}
DEV void ph_expert_up(const P& p, int l, long gtid, long gsize) {
  FOR_ITEMS(i, (long)NR * TOP_K * EXPERT_FF) {
    int cidx = (int)(i % EXPERT_FF); int a = p.srow()[i / EXPERT_FF]; int e = p.top_e()[a]; long r = a / TOP_K;
    const float* xg = p.ubuf() + r * D_MODEL;
    const float* wg = p.w_exp_gate + ((long)l * N_EXPERTS + e) * D_MODEL * EXPERT_FF; const float* wu = p.w_exp_up + ((long)l * N_EXPERTS + e) * D_MODEL * EXPERT_FF;
    float g = 0.f, u = 0.f;
    for (int k = 0; k < D_MODEL; ++k) { float xv = xg[k]; g += xv * wg[(long)k * EXPERT_FF + cidx]; u += xv * wu[(long)k * EXPERT_FF + cidx]; }
    p.hbuf()[(long)a * EXPERT_FF + cidx] = siluf(g) * u;
  }
  FOR_ITEMS(i, (long)NR * SHARED_FF) {
    int cidx = (int)(i % SHARED_FF); long r = i / SHARED_FF;
    const float* xg = p.ubuf() + r * D_MODEL;
    const float* wg = p.w_sh_gate + (long)l * D_MODEL * SHARED_FF; const float* wu = p.w_sh_up + (long)l * D_MODEL * SHARED_FF;
    float g = 0.f, u = 0.f;
    for (int k = 0; k < D_MODEL; ++k) { float xv = xg[k]; g += xv * wg[(long)k * SHARED_FF + cidx]; u += xv * wu[(long)k * SHARED_FF + cidx]; }
    p.hsb()[i] = siluf(g) * u;
  }
}
DEV void ph_expert_down(const P& p, int l, long gtid, long gsize) {
  FOR_ITEMS(i, (long)NR * TOP_K * D_MODEL) {
    int d = (int)(i % D_MODEL); long a = i / D_MODEL;
    int e = p.top_e()[a]; const float* wd = p.w_exp_down + ((long)l * N_EXPERTS + e) * EXPERT_FF * D_MODEL;
    const float* h = p.hbuf() + a * EXPERT_FF; float acc = 0.f;
    for (int cidx = 0; cidx < EXPERT_FF; ++cidx) acc += h[cidx] * wd[(long)cidx * D_MODEL + d];
    p.yk()[i] = acc * p.gate()[a];
  }
  FOR_ITEMS(i, (long)NR * D_MODEL) {
    int d = (int)(i % D_MODEL); long r = i / D_MODEL;
    const float* wsd = p.w_sh_down + (long)l * SHARED_FF * D_MODEL; const float* hs = p.hsb() + r * SHARED_FF;
    float acc = 0.f;
    for (int cidx = 0; cidx < SHARED_FF; ++cidx) acc += hs[cidx] * wsd[(long)cidx * D_MODEL + d];
    p.ysh()[i] = acc;
  }
}
DEV void ph_combine(const P& p, int l, long gtid, long gsize) {
#pragma unroll 1
  FOR_ITEMS(i, (long)NR * D_MODEL) {
    int d = (int)(i % D_MODEL); long r = i / D_MODEL;
    float f = p.ysh()[i];
#pragma unroll
    for (int k = 0; k < TOP_K; ++k) f += p.yk()[(r * TOP_K + k) * D_MODEL + d];
    const float* m = p.mod() + ((long)l * (BATCH + 1) + modrow(r)) * 6 * D_MODEL + 5 * D_MODEL;
    p.tmp()[i] = DN_ALPHA * p.xcur()[i] + m[d] * f;
  }
}
#define NLP 16


#ifndef CPU_TEST
typedef __attribute__((ext_vector_type(8))) short bf16x8;
typedef __attribute__((ext_vector_type(4))) float f32x4;
typedef __attribute__((ext_vector_type(4))) unsigned u32x4;
typedef __attribute__((ext_vector_type(2))) unsigned u32x2;
static_assert(N_EXPERTS == 256 && D_MODEL % 128 == 0 && NR % 128 == 0, "shape assumptions");
#define SM_XB 0
#define NT 512
#define SM_A 256
#define SM_B (256 + 16384)
#define SM_MISC (256 + 98304)
#define SMEM_BYTES (256 + 98304 + 4096)

DEV int otid() { int t = threadIdx.x; asm volatile("" : "+v"(t)); return t; }
typedef __bf16 bf16x2_t __attribute__((ext_vector_type(2)));
typedef float f32x2_t __attribute__((ext_vector_type(2)));
DEV unsigned pack2(float a, float b) { f32x2_t v = {a, b}; return __builtin_bit_cast(unsigned, __builtin_convertvector(v, bf16x2_t)); }
DEV unsigned f2bf(float f) { return pack2(f, 0.f) & 0xffffu; }
DEV int tile_off(int row, int chunk) { return row * 128 + ((chunk ^ ((row >> 1) & 7)) << 4); }

DEV float bflo(float x) { return x - __uint_as_float(f2bf(x) << 16); }
DEV void wt_convert(const float* W, unsigned short* WT, int K, int N, bool lo, long gtid, long gsize) {
  FOR_ITEMS4(i, (long)N * (K / 8)) {
    const int n = (int)(i % N); const int k8 = (int)(i / N) * 8;
    float v[8];
#pragma unroll
    for (int j = 0; j < 8; ++j) { const float x = W[(long)(k8 + j) * N + n]; v[j] = lo ? bflo(x) : x; }
    u32x4 o; o[0] = pack2(v[0], v[1]); o[1] = pack2(v[2], v[3]); o[2] = pack2(v[4], v[5]); o[3] = pack2(v[6], v[7]);
    *(u32x4*)(WT + (long)n * K + k8) = o;
  }
}
DEV void wt_convert_all(const P& p, long gtid, long gsize) {
  for (int l = 0; l < DEPTH; ++l) {
    wt_convert(p.w_in + (long)l * D_MODEL * IN_W, p.wt_in() + (long)l * IN_W * D_MODEL, D_MODEL, IN_W, false, gtid, gsize);
    wt_convert(p.w_out + (long)l * MIX_W * D_MODEL, p.wt_out() + (long)l * D_MODEL * MIX_W, MIX_W, D_MODEL, false, gtid, gsize);
    wt_convert(p.s5_w_glu + (long)l * S5_W * S5_W, p.wt_glu() + (long)l * S5_W * S5_W, S5_W, S5_W, false, gtid, gsize);
    wt_convert(p.w_sh_gate + (long)l * D_MODEL * SHARED_FF, p.wt_shg() + (long)l * SHARED_FF * D_MODEL, D_MODEL, SHARED_FF, false, gtid, gsize);
    wt_convert(p.w_sh_up + (long)l * D_MODEL * SHARED_FF, p.wt_shu() + (long)l * SHARED_FF * D_MODEL, D_MODEL, SHARED_FF, false, gtid, gsize);
    wt_convert(p.w_sh_down + (long)l * SHARED_FF * D_MODEL, p.wt_shd() + (long)l * D_MODEL * SHARED_FF, SHARED_FF, D_MODEL, false, gtid, gsize);
    wt_convert(p.w_router + (long)l * D_MODEL * N_EXPERTS, p.wt_rh() + (long)l * N_EXPERTS * D_MODEL, D_MODEL, N_EXPERTS, false, gtid, gsize);
    wt_convert(p.w_router + (long)l * D_MODEL * N_EXPERTS, p.wt_rl() + (long)l * N_EXPERTS * D_MODEL, D_MODEL, N_EXPERTS, true, gtid, gsize);
  }
}
struct ALRows { const char* base; unsigned off[2]; DEVM const unsigned short* a(int i, int kt) const { return (const unsigned short*)(base + (off[i] + (unsigned)kt * 128u)); } };
struct BLStd { static constexpr bool TR = false; const char* base; unsigned voff; int ldb4; bool valid;
  DEVM void load(float4 (&rb)[8], int kt) const {
#pragma unroll
    for (int i = 0; i < 8; ++i) rb[i] = valid ? *(const float4*)(base + (unsigned)((unsigned)(kt * 64 + i) * (unsigned)ldb4 + voff)) : make_float4(0.f, 0.f, 0.f, 0.f); } };
DEV unsigned bl_voff(int ldb4, int tid) { return (unsigned)((tid & 7) * 8) * (unsigned)ldb4 + (unsigned)((tid >> 3) * 16); }
DEV BLStd mk_bl(const float* B  , int ldb, int tid) {
  BLStd b; b.base = (const char*)B; b.ldb4 = ldb * 4; b.voff = bl_voff(ldb * 4, tid); b.valid = true; return b; }
#define SM_TILE 49152
template <int V = 0, class AL, class BL>
DEV void gemm_t(const AL& al, const BL& bl, int nk, f32x4 (&acc)[4][4], char* smem) {
  const int tid = otid(), lane = tid & 63, wid = tid >> 6, wr = wid >> 2, wc = wid & 3;
  const int l15 = lane & 15, q = lane >> 4, x = l15 >> 1;
  const char* ard0 = smem + SM_A + (wr * 64 + l15) * 128 + ((q ^ x) << 4);
  const char* ard1 = smem + SM_A + (wr * 64 + l15) * 128 + (((4 + q) ^ x) << 4);
  const char* brd0 = smem + SM_B + (wc * 64 + l15) * 128 + ((q ^ x) << 4);
  const char* brd1 = smem + SM_B + (wc * 64 + l15) * 128 + (((4 + q) ^ x) << 4);
  const int kq = tid & 7, nq = tid >> 3;
  char* awr = smem + SM_A + nq * 128 + ((kq ^ ((nq >> 1) & 7)) << 4);
  char* bwr0 = smem + SM_B + (nq * 4) * 128 + ((kq ^ ((2 * nq) & 7)) << 4);
  char* bwr1 = smem + SM_B + (nq * 4 + 2) * 128 + ((kq ^ ((2 * nq + 1) & 7)) << 4);
  if (nk <= 0) return;
  u32x4 ra[2]; float4 rb0[8];
#define GEMM_LOADA(KT) do { _Pragma("unroll") for (int i = 0; i < 2; ++i) ra[i] = *(const u32x4*)(al.a(i, (KT))); } while (0)
#define GEMM_WRITE(rb, PO) do { \
    *(u32x4*)(awr + (PO)) = ra[0]; *(u32x4*)(awr + (PO) + 8192) = ra[1]; \
    if (BL::TR) { u32x4 v; \
      v[0] = pack2(rb[0].x, rb[0].y); v[1] = pack2(rb[0].z, rb[0].w); v[2] = pack2(rb[1].x, rb[1].y); v[3] = pack2(rb[1].z, rb[1].w); *(u32x4*)(bwr0 + (PO)) = v; \
      v[0] = pack2(rb[2].x, rb[2].y); v[1] = pack2(rb[2].z, rb[2].w); v[2] = pack2(rb[3].x, rb[3].y); v[3] = pack2(rb[3].z, rb[3].w); *(u32x4*)(bwr0 + (PO) + 128) = v; \
      v[0] = pack2(rb[4].x, rb[4].y); v[1] = pack2(rb[4].z, rb[4].w); v[2] = pack2(rb[5].x, rb[5].y); v[3] = pack2(rb[5].z, rb[5].w); *(u32x4*)(bwr1 + (PO)) = v; \
      v[0] = pack2(rb[6].x, rb[6].y); v[1] = pack2(rb[6].z, rb[6].w); v[2] = pack2(rb[7].x, rb[7].y); v[3] = pack2(rb[7].z, rb[7].w); *(u32x4*)(bwr1 + (PO) + 128) = v; \
    } else { u32x4 v; \
      v[0] = pack2(rb[0].x, rb[1].x); v[1] = pack2(rb[2].x, rb[3].x); v[2] = pack2(rb[4].x, rb[5].x); v[3] = pack2(rb[6].x, rb[7].x); *(u32x4*)(bwr0 + (PO)) = v; \
      v[0] = pack2(rb[0].y, rb[1].y); v[1] = pack2(rb[2].y, rb[3].y); v[2] = pack2(rb[4].y, rb[5].y); v[3] = pack2(rb[6].y, rb[7].y); *(u32x4*)(bwr0 + (PO) + 128) = v; \
      v[0] = pack2(rb[0].z, rb[1].z); v[1] = pack2(rb[2].z, rb[3].z); v[2] = pack2(rb[4].z, rb[5].z); v[3] = pack2(rb[6].z, rb[7].z); *(u32x4*)(bwr1 + (PO)) = v; \
      v[0] = pack2(rb[0].w, rb[1].w); v[1] = pack2(rb[2].w, rb[3].w); v[2] = pack2(rb[4].w, rb[5].w); v[3] = pack2(rb[6].w, rb[7].w); *(u32x4*)(bwr1 + (PO) + 128) = v; \
    } } while (0)
  GEMM_LOADA(0);
  bl.load(rb0, 0);
  __syncthreads();
  GEMM_WRITE(rb0, 0);
  if (V != 3) { if (nk > 1) { GEMM_LOADA(1); bl.load(rb0, 1); } }
  __syncthreads();
#define GEMM_STEP(rbn, KT) do { \
    const int po = ((KT) & 1) * SM_TILE; \
    bf16x8 fa0[4], fb0[4], fa1[4], fb1[4]; \
    _Pragma("unroll") for (int n = 0; n < 4; ++n) fb0[n] = *(const bf16x8*)(brd0 + po + n * 2048); \
    _Pragma("unroll") for (int m = 0; m < 4; ++m) fa0[m] = *(const bf16x8*)(ard0 + po + m * 2048); \
    _Pragma("unroll") for (int n = 0; n < 4; ++n) fb1[n] = *(const bf16x8*)(brd1 + po + n * 2048); \
    _Pragma("unroll") for (int m = 0; m < 4; ++m) fa1[m] = *(const bf16x8*)(ard1 + po + m * 2048); \
    __builtin_amdgcn_sched_barrier(0);     \
    if ((KT) + 1 < nk) { \
      GEMM_WRITE(rbn, SM_TILE - po); \
      if (V != 3) { if ((KT) + 2 < nk) { GEMM_LOADA((KT) + 2); bl.load(rbn, (KT) + 2); } } \
    } \
    __builtin_amdgcn_sched_barrier(0); \
    if (V != 2) { \
      _Pragma("unroll") for (int m = 0; m < 4; ++m) _Pragma("unroll") for (int n = 0; n < 4; ++n) acc[m][n] = __builtin_amdgcn_mfma_f32_16x16x32_bf16(fa0[m], fb0[n], acc[m][n], 0, 0, 0); \
      _Pragma("unroll") for (int m = 0; m < 4; ++m) _Pragma("unroll") for (int n = 0; n < 4; ++n) acc[m][n] = __builtin_amdgcn_mfma_f32_16x16x32_bf16(fa1[m], fb1[n], acc[m][n], 0, 0, 0); \
    } else { _Pragma("unroll") for (int m = 0; m < 4; ++m) asm volatile("" :: "v"(fa0[m]), "v"(fb0[m]), "v"(fa1[m]), "v"(fb1[m])); } \
    __syncthreads(); \
  } while (0)
  int kt = 0;
#pragma unroll 1
  for (; kt < nk; ++kt) { GEMM_STEP(rb0, kt); }
#undef GEMM_STEP
#undef GEMM_WRITE
#undef GEMM_LOADA
}

struct BLT { const char* base; unsigned voff; unsigned rowb;
  DEVM void load(u32x4 (&rb)[4], int kt) const {
#pragma unroll
    for (int c = 0; c < 4; ++c) rb[c] = *(const u32x4*)(base + (voff + (unsigned)c * rowb + (unsigned)kt * 128u)); } };
DEV BLT mk_blt(const unsigned short* BT  , int K, int tid) {
  BLT b; b.base = (const char*)BT; b.rowb = (unsigned)K * 2u; b.voff = (unsigned)((tid >> 3) * 4) * b.rowb + (unsigned)((tid & 7) * 16); return b; }
template <class AL, class BL>
DEV void gemm_tb(const AL& al, const BL& bl, int nk, f32x4 (&acc)[4][4], char* smem) {
  const int tid = otid(), lane = tid & 63, wid = tid >> 6, wr = wid >> 2, wc = wid & 3;
  const int l15 = lane & 15, q = lane >> 4, x = l15 >> 1;
  const char* ard0 = smem + SM_A + (wr * 64 + l15) * 128 + ((q ^ x) << 4);
  const char* ard1 = smem + SM_A + (wr * 64 + l15) * 128 + (((4 + q) ^ x) << 4);
  const char* brd0 = smem + SM_B + (wc * 64 + l15) * 128 + ((q ^ x) << 4);
  const char* brd1 = smem + SM_B + (wc * 64 + l15) * 128 + (((4 + q) ^ x) << 4);
  const int kq = tid & 7, nq = tid >> 3;
  char* awr = smem + SM_A + nq * 128 + ((kq ^ ((nq >> 1) & 7)) << 4);
  char* bwr0 = smem + SM_B + (nq * 4) * 128 + ((kq ^ ((2 * nq) & 7)) << 4);
  char* bwr1 = smem + SM_B + (nq * 4 + 2) * 128 + ((kq ^ ((2 * nq + 1) & 7)) << 4);
  if (nk <= 0) return;
  u32x4 ra[2]; u32x4 rb0[4], rb1[4];
#define TB_LOADA(KT) do { _Pragma("unroll") for (int i = 0; i < 2; ++i) ra[i] = *(const u32x4*)(al.a(i, (KT))); } while (0)
#define TB_WRITE(rb, PO) do { \
    *(u32x4*)(awr + (PO)) = ra[0]; *(u32x4*)(awr + (PO) + 8192) = ra[1]; \
    *(u32x4*)(bwr0 + (PO)) = rb[0]; *(u32x4*)(bwr0 + (PO) + 128) = rb[1]; *(u32x4*)(bwr1 + (PO)) = rb[2]; *(u32x4*)(bwr1 + (PO) + 128) = rb[3]; } while (0)
  TB_LOADA(0);
  bl.load(rb0, 0);
  if (nk > 1) bl.load(rb1, 1);
  __syncthreads();
  TB_WRITE(rb0, 0);
  if (nk > 1) TB_LOADA(1);
  if (nk > 2) bl.load(rb0, 2);
  __syncthreads();
#define TB_STEP(rbn, KT) do { \
    const int po = ((KT) & 1) * SM_TILE; \
    bf16x8 fa0[4], fb0[4], fa1[4], fb1[4]; \
    _Pragma("unroll") for (int n = 0; n < 4; ++n) fb0[n] = *(const bf16x8*)(brd0 + po + n * 2048); \
    _Pragma("unroll") for (int m = 0; m < 4; ++m) fa0[m] = *(const bf16x8*)(ard0 + po + m * 2048); \
    _Pragma("unroll") for (int n = 0; n < 4; ++n) fb1[n] = *(const bf16x8*)(brd1 + po + n * 2048); \
    _Pragma("unroll") for (int m = 0; m < 4; ++m) fa1[m] = *(const bf16x8*)(ard1 + po + m * 2048); \
    __builtin_amdgcn_sched_barrier(0); \
    if ((KT) + 1 < nk) { \
      TB_WRITE(rbn, SM_TILE - po); \
      if ((KT) + 2 < nk) TB_LOADA((KT) + 2); \
      if ((KT) + 3 < nk) bl.load(rbn, (KT) + 3); \
    } \
    __builtin_amdgcn_sched_barrier(0); \
    _Pragma("unroll") for (int m = 0; m < 4; ++m) _Pragma("unroll") for (int n = 0; n < 4; ++n) acc[m][n] = __builtin_amdgcn_mfma_f32_16x16x32_bf16(fa0[m], fb0[n], acc[m][n], 0, 0, 0); \
    _Pragma("unroll") for (int m = 0; m < 4; ++m) _Pragma("unroll") for (int n = 0; n < 4; ++n) acc[m][n] = __builtin_amdgcn_mfma_f32_16x16x32_bf16(fa1[m], fb1[n], acc[m][n], 0, 0, 0); \
    __syncthreads(); \
  } while (0)
  int kt = 0;
#pragma unroll 1
  for (; kt + 1 < nk; kt += 2) { TB_STEP(rb1, kt); TB_STEP(rb0, kt + 1); }
  if (kt < nk) TB_STEP(rb1, kt);
#undef TB_STEP
#undef TB_WRITE
#undef TB_LOADA
}
DEV void acc_zero(f32x4 (&acc)[4][4]) {
#pragma unroll
  for (int m = 0; m < 4; ++m)
#pragma unroll
    for (int n = 0; n < 4; ++n) acc[m][n] = (f32x4){0.f, 0.f, 0.f, 0.f};
}
#define EPI_BEGIN const int etid = otid();
#define EPI_ROW(m, j) (((etid >> 8) & 1) * 64 + (m) * 16 + ((etid & 63) >> 4) * 4 + (j))
#define EPI_COL(n) (((etid >> 6) & 3) * 64 + (n) * 16 + (etid & 15))

template <class Epi>
DEV void gemm_phase_dense(const unsigned short* A, int lda, const unsigned short* BT, int N, int K, Epi epi, char* smem) {
  const int tid = otid(); const int nct = N >> 8; const int nitems = (NR >> 7) * nct;
  for (int it = blockIdx.x; it < nitems; it += gridDim.x) {
    const int rt = it / nct, ct = it - rt * nct;
    ALRows al; al.base = (const char*)(A + (long)rt * 128 * lda);
#pragma unroll
    for (int i = 0; i < 2; ++i) al.off[i] = (unsigned)(((tid >> 3) + 64 * i) * lda + (tid & 7) * 8) * 2u;
    const BLT bl = mk_blt(BT + (long)ct * 256 * K, K, tid);
    f32x4 acc[4][4]; acc_zero(acc);
    gemm_tb(al, bl, K >> 6, acc, smem);
    EPI_BEGIN
#pragma unroll
    for (int m = 0; m < 4; ++m)
#pragma unroll
      for (int n = 0; n < 4; ++n)
#pragma unroll
        for (int j = 0; j < 4; ++j) epi((long)rt * 128 + EPI_ROW(m, j), ct * 256 + EPI_COL(n), acc[m][n][j]);
  }
}
DEV void ph_proj_mfma(const P& p, int l, char* smem) {
  const int tid = otid(); const int nct = IN_W >> 8; const int nitems = (NR >> 7) * nct;
  const float* B = p.w_in + (long)l * D_MODEL * IN_W;
  for (int it = blockIdx.x; it < nitems; it += gridDim.x) {
    const int rt = it / nct, ct = it - rt * nct;
    ALRows al; al.base = (const char*)(p.ubf() + (long)rt * 128 * D_MODEL);
#pragma unroll
    for (int i = 0; i < 2; ++i) al.off[i] = (unsigned)(((tid >> 3) + 64 * i) * D_MODEL + (tid & 7) * 8) * 2u;
    const BLT bl = mk_blt(p.wt_in() + ((long)l * IN_W + ct * 256) * D_MODEL, D_MODEL, tid);
    f32x4 acc[4][4]; acc_zero(acc);
    gemm_tb(al, bl, D_MODEL >> 6, acc, smem);
    EPI_BEGIN
    if (ct >= HY_OFF / 256 && ct < S5_OFF / 256) {
      const bool isctx = rt >= NL / 128;
      const int rloc = (isctx ? (rt - NL / 128) : rt) * 128;
      const int Ls = isctx ? CTX_LEN : SEQ; const int b = rloc / Ls; const int t0 = rloc - b * Ls;
      float* zb = p.zT() + (isctx ? (size_t)BATCH * 3 * HYENA_W * SEQ : (size_t)0) + (size_t)b * 3 * HYENA_W * Ls;
#pragma unroll
      for (int m = 0; m < 4; ++m)
#pragma unroll
        for (int n = 0; n < 4; ++n) {
          const int c = ct * 256 + EPI_COL(n) - HY_OFF; const int t = t0 + EPI_ROW(m, 0);
          *(float4*)(zb + (size_t)c * Ls + t) = make_float4(acc[m][n][0], acc[m][n][1], acc[m][n][2], acc[m][n][3]);
        }
    } else if (ct == S5_OFF / 256) {
#pragma unroll
      for (int m = 0; m < 4; ++m)
#pragma unroll
        for (int n = 0; n < 4; ++n)
#pragma unroll
          for (int j = 0; j < 4; ++j) p.s5u()[((long)rt * 128 + EPI_ROW(m, j)) * S5_W + EPI_COL(n)] = (unsigned short)f2bf(acc[m][n][j]);
    } else {
      const int head = ct * 4 + ((etid >> 6) & 3);
      const bool isq = head < N_Q_HEADS, dorope = head < N_Q_HEADS + N_KV_HEADS && rt < NL / 128;
      const float qs = isq ? 0.125f * 1.4426950408889634f : 1.0f;
      const int c16 = etid & 15;
#pragma unroll
      for (int m = 0; m < 4; ++m)
#pragma unroll
        for (int j = 0; j < 4; ++j) {
          const long row = (long)rt * 128 + EPI_ROW(m, j);
          float v0 = acc[m][0][j], v1 = acc[m][1][j], v2 = acc[m][2][j], v3 = acc[m][3][j];
          if (dorope) {
            const int t = (int)(row % SEQ);
            const float2 cr = p.ropet()[(t / GRID_W) * ROPE_HALF + c16], cc = p.ropet()[(t % GRID_W) * ROPE_HALF + c16];
            const float a0 = v0 * cr.x - v1 * cr.y, a1 = v0 * cr.y + v1 * cr.x, a2 = v2 * cc.x - v3 * cc.y, a3 = v2 * cc.y + v3 * cc.x;
            v0 = a0; v1 = a1; v2 = a2; v3 = a3;
          }
          unsigned short* dst = p.qkvb() + row * HY_OFF + head * HEAD_DIM + c16;
          dst[0] = (unsigned short)f2bf(v0 * qs); dst[16] = (unsigned short)f2bf(v1 * qs); dst[32] = (unsigned short)f2bf(v2 * qs); dst[48] = (unsigned short)f2bf(v3 * qs);
        }
    }
  }
}
DEV void ph_hyena_pre_gpu(const P& p, int l, long gtid, long gsize) {
  const float* sw = p.hy_short_w + l * 3 * 3 * HYENA_W; const float* sb = p.hy_short_b + l * 3 * HYENA_W;
  FOR_ITEMS4(i, (long)BATCH * HYENA_W * (SEQ + CTX_LEN)) {
    const bool isctx = i >= (long)BATCH * HYENA_W * SEQ; const long ii = isctx ? i - (long)BATCH * HYENA_W * SEQ : i;
    const int Ls = isctx ? CTX_LEN : SEQ; const int t = (int)(ii % Ls); const int ch = (int)((ii / Ls) % HYENA_W); const int b = (int)(ii / ((long)Ls * HYENA_W));
    const float* zb = p.zT() + (isctx ? (size_t)BATCH * 3 * HYENA_W * SEQ : (size_t)0) + (size_t)b * 3 * HYENA_W * Ls;
    float z[3];
#pragma unroll
    for (int part = 0; part < 3; ++part) {
      const int cc = part * HYENA_W + ch; const float* zr = zb + (size_t)cc * Ls; float acc = sb[cc];
      if (t > 0) acc += zr[t - 1] * sw[cc];
      acc += zr[t] * sw[3 * HYENA_W + cc];
      if (t + 1 < Ls) acc += zr[t + 1] * sw[2 * 3 * HYENA_W + cc];
      z[part] = acc;
    }
    const long o = isctx ? ((long)NL + b * CTX_LEN + t) * HYENA_W + ch : ((long)b * HYENA_W + ch) * SEQ + t;
    p.hu()[o] = z[0] * z[1]; p.hx0()[o] = z[2];
  }
}
DEV void rms_rows(const P& p, int l, long r0, long r1, int w0, int nw);
DEV void ph_glu_mfma(const P& p, int l, char* smem) {
  const int tid = otid();
  for (int rt = blockIdx.x; rt < (NR >> 7); rt += gridDim.x) {
    ALRows al; al.base = (const char*)(p.ybf() + (long)rt * 128 * S5_W);
#pragma unroll
    for (int i = 0; i < 2; ++i) al.off[i] = (unsigned)(((tid >> 3) + 64 * i) * S5_W + (tid & 7) * 8) * 2u;
    const BLT bl = mk_blt(p.wt_glu() + (long)l * S5_W * S5_W, S5_W, tid);
    f32x4 acc[4][4]; acc_zero(acc);
    gemm_tb(al, bl, S5_W >> 6, acc, smem);
    EPI_BEGIN
#pragma unroll
    for (int m = 0; m < 4; ++m)
#pragma unroll
      for (int n = 0; n < 4; ++n)
#pragma unroll
        for (int j = 0; j < 4; ++j) {
          const long r = (long)rt * 128 + EPI_ROW(m, j); const int c = EPI_COL(n);
          p.mixb()[r * MIX_W + ATTN_W + HYENA_W + c] = __uint_as_float((unsigned)p.ybf()[r * S5_W + c] << 16) * sigmoidf_(acc[m][n][j]);
        }
    asm volatile("s_waitcnt vmcnt(0)" ::: "memory");
    __syncthreads();
    rms_rows(p, l, (long)rt * 128, (long)rt * 128 + 128, otid() >> 6, NT / 64);
  }
}
DEV void ph_outproj_mfma(const P& p, int l, char* smem) {
  EpiRes e{p.xcur(), p.mod(), l, 2 * D_MODEL, p.tmp()};
  gemm_phase_dense(p.mixbf(), MIX_W, p.wt_out() + (long)l * D_MODEL * MIX_W, D_MODEL, MIX_W, e, smem);
}

struct ALRows4 { const char* base; unsigned off[4]; DEVM const unsigned short* a(int i, int kt) const { return (const unsigned short*)(base + (off[i] + (unsigned)kt * 128u)); } };
struct BLStd4 { const char* base; unsigned voff; int ldb4;
  DEVM void load(float4 (&rb)[4], int kt) const {
    unsigned vo = voff; asm volatile("" : "+v"(vo));
#pragma unroll
    for (int i = 0; i < 4; ++i) rb[i] = *(const float4*)(base + (unsigned)((unsigned)(kt * 64 + i) * (unsigned)ldb4 + vo)); } };
#define SM_B2 (SM_A + 32768)
template <class AL, class BL>
DEV void gemm_m2(const AL& al, const BL& bl, int nk, f32x4 (&acc)[4][4], char* smem) {
  const int tid = otid(), lane = tid & 63, wid = tid >> 6, wr = wid >> 1, wc = wid & 1;
  const int l15 = lane & 15, q = lane >> 4, x = l15 >> 1;
  const char* ard0 = smem + SM_A + (wr * 64 + l15) * 128 + ((q ^ x) << 4);
  const char* ard1 = smem + SM_A + (wr * 64 + l15) * 128 + (((4 + q) ^ x) << 4);
  const char* brd0 = smem + SM_B2 + (wc * 64 + l15) * 128 + ((q ^ x) << 4);
  const char* brd1 = smem + SM_B2 + (wc * 64 + l15) * 128 + (((4 + q) ^ x) << 4);
  const int kq = tid & 7, ar = tid >> 3, nq = (tid >> 3) & 31, kh = tid >> 8;
  char* awr = smem + SM_A + ar * 128 + ((kq ^ ((ar >> 1) & 7)) << 4);
  char* bwr0 = smem + SM_B2 + (nq * 4) * 128 + ((kq ^ ((2 * nq) & 7)) << 4) + kh * 8;
  char* bwr1 = smem + SM_B2 + (nq * 4 + 2) * 128 + ((kq ^ ((2 * nq + 1) & 7)) << 4) + kh * 8;
  if (nk <= 0) return;
  u32x4 ra[4]; float4 rb0[4], rb1[4];
#define M2_LOADA(KT) do { _Pragma("unroll") for (int i = 0; i < 4; ++i) ra[i] = *(const u32x4*)(al.a(i, (KT))); } while (0)
#define M2_WRITE(rb, PO) do { \
    _Pragma("unroll") for (int i = 0; i < 4; ++i) *(u32x4*)(awr + (PO) + 8192 * i) = ra[i]; \
    { u32x2 v; \
      v[0] = pack2(rb[0].x, rb[1].x); v[1] = pack2(rb[2].x, rb[3].x); *(u32x2*)(bwr0 + (PO)) = v; \
      v[0] = pack2(rb[0].y, rb[1].y); v[1] = pack2(rb[2].y, rb[3].y); *(u32x2*)(bwr0 + (PO) + 128) = v; \
      v[0] = pack2(rb[0].z, rb[1].z); v[1] = pack2(rb[2].z, rb[3].z); *(u32x2*)(bwr1 + (PO)) = v; \
      v[0] = pack2(rb[0].w, rb[1].w); v[1] = pack2(rb[2].w, rb[3].w); *(u32x2*)(bwr1 + (PO) + 128) = v; } } while (0)
  M2_LOADA(0);
  bl.load(rb0, 0);
  if (nk > 1) bl.load(rb1, 1);
  __syncthreads();
  M2_WRITE(rb0, 0);
  if (nk > 1) M2_LOADA(1);
  if (nk > 2) bl.load(rb0, 2);
  __syncthreads();
#define M2_STEP(rbn, KT) do { \
    const int po = ((KT) & 1) * SM_TILE; \
    bf16x8 fa0[4], fb0[4], fa1[4], fb1[4]; \
    _Pragma("unroll") for (int n = 0; n < 4; ++n) fb0[n] = *(const bf16x8*)(brd0 + po + n * 2048); \
    _Pragma("unroll") for (int m = 0; m < 4; ++m) fa0[m] = *(const bf16x8*)(ard0 + po + m * 2048); \
    _Pragma("unroll") for (int n = 0; n < 4; ++n) fb1[n] = *(const bf16x8*)(brd1 + po + n * 2048); \
    _Pragma("unroll") for (int m = 0; m < 4; ++m) fa1[m] = *(const bf16x8*)(ard1 + po + m * 2048); \
    __builtin_amdgcn_sched_barrier(0); \
    if ((KT) + 1 < nk) { \
      M2_WRITE(rbn, SM_TILE - po); \
      if ((KT) + 2 < nk) M2_LOADA((KT) + 2); \
      if ((KT) + 3 < nk) bl.load(rbn, (KT) + 3); \
    } \
    __builtin_amdgcn_sched_barrier(0); \
    _Pragma("unroll") for (int m = 0; m < 4; ++m) _Pragma("unroll") for (int n = 0; n < 4; ++n) acc[m][n] = __builtin_amdgcn_mfma_f32_16x16x32_bf16(fa0[m], fb0[n], acc[m][n], 0, 0, 0); \
    _Pragma("unroll") for (int m = 0; m < 4; ++m) _Pragma("unroll") for (int n = 0; n < 4; ++n) acc[m][n] = __builtin_amdgcn_mfma_f32_16x16x32_bf16(fa1[m], fb1[n], acc[m][n], 0, 0, 0); \
    __syncthreads(); \
  } while (0)
  int kt = 0;
#pragma unroll 1
  for (; kt + 1 < nk; kt += 2) { M2_STEP(rb1, kt); M2_STEP(rb0, kt + 1); }
  if (kt < nk) M2_STEP(rb1, kt);
#undef M2_STEP
#undef M2_WRITE
#undef M2_LOADA
}
#define EPI2_ROW(m, j) (((etid >> 7) & 3) * 64 + (m) * 16 + ((etid & 63) >> 4) * 4 + (j))
#define EPI2_COL(n) (((etid >> 6) & 1) * 64 + (n) * 16 + (etid & 15))
DEV void exp_prefix(const P& p, int l, int* toff, int* roff) {
  const int tid = otid(), lane = tid & 63, w = tid >> 6;
  __syncthreads();
  int c = 0, tl = 0, incl = 0;
  int* wsum = roff + N_EXPERTS + 8;
  if (tid < N_EXPERTS) {
    c = p.cnt()[l * N_EXPERTS + tid];
    tl = (c + 255) >> 8; incl = tl;
#pragma unroll
    for (int o = 1; o < 64; o <<= 1) { const int v = __shfl_up(incl, o); if (lane >= o) incl += v; }
    if (lane == 63) wsum[w] = incl;
    roff[tid] = c;
  }
  __syncthreads();
  if (tid < N_EXPERTS) {
    int base = 0;
#pragma unroll
    for (int k = 0; k < 4; ++k) if (k < w) base += wsum[k];
    toff[tid] = base + incl - tl;
    if (tid == N_EXPERTS - 1) toff[N_EXPERTS] = base + incl;
  }
  __syncthreads();
}
DEV int exp_find(const int* toff, int tile) {
  int lo = 0, hi = N_EXPERTS - 1;
  while (lo < hi) { int mid = (lo + hi + 1) >> 1; if (toff[mid] <= tile) lo = mid; else hi = mid - 1; }
  return lo;
}
template <int V = 0>
DEV void upgate_tile(const ALRows& al, const float* wg, const float* wu, int cq, f32x4 (&acc)[4][4], char* smem, int tid) {
  const int nq = tid >> 3; const int wsel = __builtin_amdgcn_readfirstlane(tid >> 6) & 1;
  BLStd bl; bl.base = (const char*)((wsel ? wu : wg) + cq * 128); bl.ldb4 = EXPERT_FF * 4; bl.valid = true;
  bl.voff = (unsigned)((tid & 7) * 8) * (unsigned)(EXPERT_FF * 4) + (unsigned)(((nq >> 4) * 32 + (nq & 7) * 4) * 4);
  acc_zero(acc);
  gemm_t<V>(al, bl, D_MODEL >> 6, acc, smem);
}
static_assert(EXPERT_FF == 256 && SHARED_FF == 256, "ff tiling");
template <int V = 0>
DEV void ph_expert_up_mfma(const P& p, int l, char* smem) {
  const int tid = otid();
  int* toff = (int*)(smem + SM_MISC); int* roff = toff + N_EXPERTS + 1;
  exp_prefix(p, l, toff, roff);
  const int n_items = toff[N_EXPERTS] * 4;
  for (int it = blockIdx.x; it < n_items; it += gridDim.x) {
    const int tile = it >> 2, cq = it & 3;
    const int e = __builtin_amdgcn_readfirstlane(exp_find(toff, tile)); const int j0 = (tile - toff[e]) * 256;
    const int nrows = min(256, roff[e] - j0), rbase = e * NR + j0;
    const float* wg = p.w_exp_gate + ((long)l * N_EXPERTS + e) * D_MODEL * EXPERT_FF; const float* wu = p.w_exp_up + ((long)l * N_EXPERTS + e) * D_MODEL * EXPERT_FF;
    ALRows4 al; al.base = (const char*)p.ubf();
#pragma unroll
    for (int i = 0; i < 4; ++i) { const int rl = min((tid >> 3) + 64 * i, nrows - 1); al.off[i] = ((unsigned)(p.elist()[rbase + rl] / TOP_K) * D_MODEL + (tid & 7) * 8) * 2u; }
    const int nq = (tid >> 3) & 31; const int wsel = __builtin_amdgcn_readfirstlane(tid >> 6) & 1;
    BLStd4 bl; bl.base = (const char*)((wsel ? wu : wg) + cq * 64); bl.ldb4 = EXPERT_FF * 4;
    bl.voff = (unsigned)((tid & 7) * 8 + (tid >> 8) * 4) * (unsigned)(EXPERT_FF * 4) + (unsigned)(((nq >> 4) * 32 + (nq & 7) * 4) * 4);
    f32x4 acc[4][4]; acc_zero(acc);
    gemm_m2(al, bl, D_MODEL >> 6, acc, smem);
    EPI_BEGIN
    const int ewc = (etid >> 6) & 1, ec = etid & 15;
#pragma unroll
    for (int m = 0; m < 4; ++m)
#pragma unroll
      for (int j = 0; j < 4; ++j) {
        const int rl = EPI2_ROW(m, j);
        if (rl < nrows) {
          unsigned short* dst = p.hbf() + (long)p.elist()[rbase + rl] * EXPERT_FF + cq * 64 + ewc * 32 + ec;
          dst[0] = (unsigned short)f2bf(siluf(acc[m][0][j]) * acc[m][2][j]); dst[16] = (unsigned short)f2bf(siluf(acc[m][1][j]) * acc[m][3][j]);
        }
      }
  }
}
DEV void ph_expert_down_mfma(const P& p, int l, char* smem) {
  const int tid = otid();
  int* toff = (int*)(smem + SM_MISC); int* roff = toff + N_EXPERTS + 1;
  exp_prefix(p, l, toff, roff);
  const int NC8 = D_MODEL / 128;
  const int n_exp_items = toff[N_EXPERTS] * NC8;
  for (int it = blockIdx.x; it < n_exp_items; it += gridDim.x) {
    const int tile = it / NC8, ct = it - tile * NC8;
    const int e = __builtin_amdgcn_readfirstlane(exp_find(toff, tile)); const int j0 = (tile - toff[e]) * 256;
    const int nrows = min(256, roff[e] - j0), rbase = e * NR + j0;
    const float* wd = p.w_exp_down + ((long)l * N_EXPERTS + e) * EXPERT_FF * D_MODEL;
    ALRows4 al; al.base = (const char*)p.hbf();
#pragma unroll
    for (int i = 0; i < 4; ++i) { const int rl = min((tid >> 3) + 64 * i, nrows - 1); al.off[i] = ((unsigned)p.elist()[rbase + rl] * EXPERT_FF + (tid & 7) * 8) * 2u; }
    BLStd4 bl; bl.base = (const char*)(wd + ct * 128); bl.ldb4 = D_MODEL * 4;
    bl.voff = (unsigned)((tid & 7) * 8 + (tid >> 8) * 4) * (unsigned)(D_MODEL * 4) + (unsigned)(((tid >> 3) & 31) * 16);
    f32x4 acc[4][4]; acc_zero(acc);
    gemm_m2(al, bl, EXPERT_FF >> 6, acc, smem);
    EPI_BEGIN
#pragma unroll
    for (int m = 0; m < 4; ++m)
#pragma unroll
      for (int j = 0; j < 4; ++j) {
        const int rl = EPI2_ROW(m, j);
        if (rl < nrows) {
          const int a = p.elist()[rbase + rl]; unsigned short* dst = p.ykb() + (long)a * D_MODEL + ct * 128; const float gsc = p.gate()[a];
#pragma unroll
          for (int n = 0; n < 4; ++n) dst[EPI2_COL(n)] = (unsigned short)f2bf(acc[m][n][j] * gsc);
        }
      }
  }
  const int NCT = D_MODEL / 256;
  const int n_sh_items = (NR >> 7) * NCT;
  for (int it = (int)gridDim.x - 1 - (int)blockIdx.x; it < n_sh_items; it += gridDim.x) {
    const int rt = it / NCT, ct = it - rt * NCT;
    ALRows al; al.base = (const char*)(p.hsbf() + (long)rt * 128 * SHARED_FF);
#pragma unroll
    for (int i = 0; i < 2; ++i) al.off[i] = (unsigned)(((tid >> 3) + 64 * i) * SHARED_FF + (tid & 7) * 8) * 2u;
    const BLT bl = mk_blt(p.wt_shd() + ((long)l * D_MODEL + ct * 256) * SHARED_FF, SHARED_FF, tid);
    f32x4 acc[4][4]; acc_zero(acc);
    gemm_tb(al, bl, SHARED_FF >> 6, acc, smem);
    EPI_BEGIN
#pragma unroll
    for (int m = 0; m < 4; ++m)
#pragma unroll
      for (int n = 0; n < 4; ++n)
#pragma unroll
        for (int j = 0; j < 4; ++j) p.ysh()[((long)rt * 128 + EPI_ROW(m, j)) * D_MODEL + ct * 256 + EPI_COL(n)] = acc[m][n][j];
  }
}

typedef __attribute__((ext_vector_type(16))) float f32x16;
#define SM_HR 256
#define UB_STRIDE 8272
#define SM_HU (256 + 32768)
#define SMEM_HY (256 + 32768 + 2 * UB_STRIDE * 2)
static_assert(SEQ == 8192 && HYENA_W == 256, "hyena mfma shape");
DEV void ph_hyena_mfma(const P& p, int l, char* smem) {
  const int tid = otid(), lane = tid & 63, w = tid >> 6;
  unsigned short* R = (unsigned short*)(smem + SM_HR); unsigned short* U = (unsigned short*)(smem + SM_HU);
  for (int ch = blockIdx.x; ch < HYENA_W; ch += gridDim.x) {
    __syncthreads();
    const float* kf = p.kraw() + ((long)l * 2 * HYENA_W + ch) * SEQ; const float* kb = p.kraw() + ((long)l * 2 * HYENA_W + HYENA_W + ch) * SEQ;
    for (int y = tid; y < 2 * SEQ; y += NT) {
      const int lag = SEQ - y; float v = 0.f;
      if (lag >= 0 && lag < SEQ) v = kf[lag]; else if (lag < 0) v = kb[-lag];
      const int C = y >> 3; R[((C ^ ((C >> 4) & 1)) << 3) + (y & 7)] = (unsigned short)f2bf(v);
    }
    for (int e = tid; e < 2 * UB_STRIDE; e += NT) {
      const int b = e / UB_STRIDE, ee = e - b * UB_STRIDE, t = ee - 16; float v = 0.f;
      if (t >= 0 && t < SEQ) v = p.hu()[((long)b * HYENA_W + ch) * SEQ + t];
      U[e] = (unsigned short)f2bf(v);
    }
    __syncthreads();
    f32x16 acc[2];
#pragma unroll
    for (int mi = 0; mi < 2; ++mi)
#pragma unroll
      for (int k = 0; k < 16; ++k) acc[mi][k] = 0.f;
    const int r = lane & 31, h = lane >> 5, sig = lane & 15, bb = (lane >> 4) & 1;
    const unsigned* Ud = (const unsigned*)U + bb * (UB_STRIDE / 2);
    const int ub0 = 8 * h + sig;
    const int cbase = 1022 - 64 * (2 * w) - 2 * r + h;
    const bool odd = sig & 1;
    bf16x8 afn[2]; unsigned dn[5];
    {
#pragma unroll
      for (int mi = 0; mi < 2; ++mi) { const int C = cbase - 64 * mi; afn[mi] = *(const bf16x8*)((const char*)R + ((C ^ ((C >> 4) & 1)) << 4)); }
      const int di = ub0 >> 1;
#pragma unroll
      for (int i = 0; i < 5; ++i) dn[i] = Ud[di + i];
    }
#pragma unroll 1
    for (int q = 0; q <= SEQ / 16; ++q) {
      bf16x8 af[2]; unsigned d[5];
#pragma unroll
      for (int mi = 0; mi < 2; ++mi) af[mi] = afn[mi];
#pragma unroll
      for (int i = 0; i < 5; ++i) d[i] = dn[i];
      {
        const int qn = min(q + 1, SEQ / 16);
#pragma unroll
        for (int mi = 0; mi < 2; ++mi) { const int C = cbase - 64 * mi + 2 * qn; afn[mi] = *(const bf16x8*)((const char*)R + ((C ^ ((C >> 4) & 1)) << 4)); }
        const int di = (16 * qn + ub0) >> 1;
#pragma unroll
        for (int i = 0; i < 5; ++i) dn[i] = Ud[di + i];
      }
      u32x4 bw;
#pragma unroll
      for (int i = 0; i < 4; ++i) bw[i] = odd ? __builtin_amdgcn_alignbit(d[i + 1], d[i], 16) : d[i];
      const bf16x8 bfr = __builtin_bit_cast(bf16x8, bw);
#pragma unroll
      for (int mi = 0; mi < 2; ++mi) acc[mi] = __builtin_amdgcn_mfma_f32_32x32x16_bf16(af[mi], bfr, acc[mi], 0, 0, 0);
    }
    __syncthreads();
    {
      float* Y = (float*)(smem + SM_HR);
      float* yl = Y + bb * SEQ + 16 * (32 * (2 * w) + 4 * h) + sig;
#pragma unroll
      for (int mi = 0; mi < 2; ++mi)
#pragma unroll
        for (int k = 0; k < 16; ++k) yl[16 * (32 * mi + (k & 3) + 8 * (k >> 2))] = acc[mi][k];
    }
    __syncthreads();
    {
      const float* Y = (const float*)(smem + SM_HR);
      const float kn = p.knorm()[l * HYENA_W + ch], dsk = p.hy_d[l * HYENA_W + ch];
#pragma unroll 2
      for (int idx = tid; idx < BATCH * SEQ; idx += NT) {
        const int b = idx / SEQ, t = idx - b * SEQ;
        const long o = ((long)b * HYENA_W + ch) * SEQ + t;
        p.mixb()[(long)idx * MIX_W + ATTN_W + ch] = (Y[idx] * kn + p.hu()[o] * dsk) * p.hx0()[o];
      }
    }
  }
}
#define SM_K 256
#define SM_V (256 + 8192)
static_assert(HEAD_DIM == 64 && WINDOW == 128 && CTX_LEN == 256 && Q_GROUP == 4, "attention shape");
DEV void ph_attn_mfma(const P& p, int l, char* smem) {
  const int tid = otid(), lane = tid & 63, w = (tid >> 6) & 3, hsel = tid >> 8, h = lane >> 5, ql = lane & 31;
  char* Ks = smem + SM_K; char* Vs = smem + SM_V;
  const int n_lat = BATCH * (SEQ / 128) * N_KV_HEADS * (Q_GROUP / 2);
  const int n_ctx = (l == 0) ? BATCH * (CTX_LEN / 128) * N_KV_HEADS * (Q_GROUP / 2) : 0;
  const float QS = 0.125f * 1.4426950408889634f;
  for (int it = blockIdx.x; it < n_lat + n_ctx; it += gridDim.x) {
    const bool isctx = it >= n_lat;
    int b, qb, kvh, g;
    { int x = isctx ? it - n_lat : it; g = (x & 1) * 2 + hsel; kvh = (x >> 1) & 1; x >>= 2; if (isctx) { qb = x & 1; b = x >> 1; } else { qb = x & 63; b = x >> 6; } }
    const int hq = kvh * Q_GROUP + g;
    const int tq0 = qb * 128 + 32 * w;
    const long qrow = (isctx ? (long)NL + b * CTX_LEN : (long)b * SEQ) + tq0 + ql;
    bf16x8 qf[4];
    {
      const unsigned short* qp = p.qkvb() + qrow * HY_OFF + Q_OFF + hq * HEAD_DIM + 8 * h;
#pragma unroll
      for (int ks = 0; ks < 4; ++ks) qf[ks] = *(const bf16x8*)(qp + 16 * ks);
    }
    f32x16 o0, o1;
#pragma unroll
    for (int k = 0; k < 16; ++k) { o0[k] = 0.f; o1[k] = 0.f; }
    float m = -1e30f, lsum = 0.f;
    const int nsteps = isctx ? 4 : 10;
    u32x4 rk[1], rv[1];
    auto key_row = [&](int step, int key) -> long {
      if (step < 4) return (long)NL + b * CTX_LEN + step * 64 + key;
      const int tk = qb * 128 - 128 + (step - 4) * 64 + key;
      return (tk < 0 || tk >= SEQ) ? -1 : (long)b * SEQ + tk;
    };
    auto step_valid = [&](int step) -> bool { if (step < 4) return true; const int t0 = qb * 128 - 128 + (step - 4) * 64; return t0 >= 0 && t0 < SEQ; };
    auto load_tile = [&](int step) {
#pragma unroll
      for (int i = 0; i < 1; ++i) {
        const int key = (tid >> 3); const long kr = key_row(step, key);
        const unsigned short* kp = p.qkvb() + kr * HY_OFF + K_OFF + kvh * HEAD_DIM + (tid & 7) * 8; const unsigned short* vp = p.qkvb() + kr * HY_OFF + V_OFF + kvh * HEAD_DIM + (tid & 7) * 8;
        rk[i] = *(const u32x4*)kp; rv[i] = *(const u32x4*)vp;
      }
    };
    int step = 0;
    load_tile(0);
    while (step < nsteps) {
      __syncthreads();
#pragma unroll
      for (int i = 0; i < 1; ++i) {
        const int key = (tid >> 3), ch = tid & 7;
        *(u32x4*)(Ks + tile_off(key, ch)) = rk[i];
        *(u32x4*)(Vs + key * 128 + ((ch * 16) ^ (64 * ((key >> 1) & 1)))) = rv[i];
      }
      __syncthreads();
      const int cur = step;
      int nxt = step + 1;
      while (nxt < nsteps && !step_valid(nxt)) ++nxt;
      if (nxt < nsteps) load_tile(nxt);
      step = nxt;
#pragma unroll
      for (int sub = 0; sub < 2; ++sub) {
        const bool win = cur >= 4;
        const int ks0 = win ? qb * 128 - 128 + (cur - 4) * 64 + sub * 32 : 0;
        if (win && (ks0 > tq0 + 31 + WINDOW || ks0 + 31 < tq0 - WINDOW)) continue;
        f32x16 sacc;
#pragma unroll
        for (int k = 0; k < 16; ++k) sacc[k] = 0.f;
#pragma unroll
        for (int ks = 0; ks < 4; ++ks) {
          const bf16x8 kf = *(const bf16x8*)(Ks + tile_off(sub * 32 + ql, 2 * ks + h));
          sacc = __builtin_amdgcn_mfma_f32_32x32x16_bf16(kf, qf[ks], sacc, 0, 0, 0);
        }
        if (win && (ks0 + 31 - tq0 > WINDOW || tq0 + 31 - ks0 > WINDOW)) {
          const int tq = tq0 + ql;
#pragma unroll
          for (int k = 0; k < 16; ++k) { const int d = ks0 + (k & 3) + 8 * (k >> 2) + 4 * h - tq; if (d > WINDOW || d < -WINDOW) sacc[k] = -1e30f; }
        }
        float mx = sacc[0];
#pragma unroll
        for (int k = 1; k < 16; ++k) mx = fmaxf(mx, sacc[k]);
        mx = fmaxf(mx, __shfl_xor(mx, 32));
        const float mn = fmaxf(m, mx); const float alpha = __builtin_amdgcn_exp2f(m - mn); m = mn;
        float ps = 0.f;
#pragma unroll
        for (int k = 0; k < 16; ++k) { sacc[k] = __builtin_amdgcn_exp2f(sacc[k] - mn); ps += sacc[k]; }
        lsum = lsum * alpha + ps;
#pragma unroll
        for (int k = 0; k < 16; ++k) { o0[k] *= alpha; o1[k] *= alpha; }
        u32x2 v00, v01, v02, v03, v10, v11, v12, v13;
        {
          const int q4 = (lane & 15) >> 2, p4 = lane & 3, blk = (lane >> 4) & 1, sq = (q4 >> 1) & 1;
          const unsigned lb = (unsigned)(size_t)((__attribute__((address_space(3))) char*)Vs) + (unsigned)((sub * 32 + 4 * h + q4) * 128 + 32 * blk + 8 * p4);
          const unsigned base0 = lb + 64 * sq, base1 = lb + 64 * (1 - sq);
          asm volatile(
              "ds_read_b64_tr_b16 %0, %8\n\t"
              "ds_read_b64_tr_b16 %1, %8 offset:1024\n\t"
              "ds_read_b64_tr_b16 %2, %8 offset:2048\n\t"
              "ds_read_b64_tr_b16 %3, %8 offset:3072\n\t"
              "ds_read_b64_tr_b16 %4, %9\n\t"
              "ds_read_b64_tr_b16 %5, %9 offset:1024\n\t"
              "ds_read_b64_tr_b16 %6, %9 offset:2048\n\t"
              "ds_read_b64_tr_b16 %7, %9 offset:3072\n\t"
              "s_waitcnt lgkmcnt(0)"
              : "=&v"(v00), "=&v"(v01), "=&v"(v02), "=&v"(v03), "=&v"(v10), "=&v"(v11), "=&v"(v12), "=&v"(v13)
              : "v"(base0), "v"(base1) : "memory");
        }
#pragma unroll
        for (int ks2 = 0; ks2 < 2; ++ks2) {
          u32x4 pw;
#pragma unroll
          for (int i = 0; i < 4; ++i) pw[i] = pack2(sacc[8 * ks2 + 2 * i], sacc[8 * ks2 + 2 * i + 1]);
          const bf16x8 pf = __builtin_bit_cast(bf16x8, pw);
          u32x4 a0, a1;
          if (ks2 == 0) { a0[0] = v00[0]; a0[1] = v00[1]; a0[2] = v01[0]; a0[3] = v01[1]; a1[0] = v10[0]; a1[1] = v10[1]; a1[2] = v11[0]; a1[3] = v11[1]; }
          else          { a0[0] = v02[0]; a0[1] = v02[1]; a0[2] = v03[0]; a0[3] = v03[1]; a1[0] = v12[0]; a1[1] = v12[1]; a1[2] = v13[0]; a1[3] = v13[1]; }
          o0 = __builtin_amdgcn_mfma_f32_32x32x16_bf16(__builtin_bit_cast(bf16x8, a0), pf, o0, 0, 0, 0);
          o1 = __builtin_amdgcn_mfma_f32_32x32x16_bf16(__builtin_bit_cast(bf16x8, a1), pf, o1, 0, 0, 0);
        }
      }
    }
    lsum += __shfl_xor(lsum, 32);
    const float sk = p.sink[l * N_Q_HEADS + hq] * 1.4426950408889634f;
    const float mf = fmaxf(m, sk); const float sc = __builtin_amdgcn_exp2f(m - mf); const float inv = sc / (lsum * sc + __builtin_amdgcn_exp2f(sk - mf));
    float* op = p.mixb() + qrow * MIX_W + hq * HEAD_DIM + 4 * h;
#pragma unroll
    for (int gq = 0; gq < 4; ++gq) {
      *(float4*)(op + 8 * gq) = make_float4(o0[4 * gq] * inv, o0[4 * gq + 1] * inv, o0[4 * gq + 2] * inv, o0[4 * gq + 3] * inv);
      *(float4*)(op + 32 + 8 * gq) = make_float4(o1[4 * gq] * inv, o1[4 * gq + 1] * inv, o1[4 * gq + 2] * inv, o1[4 * gq + 3] * inv);
    }
  }
}


static_assert(S5_T == 64 && S5_STATE == 64 && S5_GROUP == 16 && S5_GROUPS == 16 && NCH == 132, "s5 mfma shape");
#define S5_COLS (BATCH * NCH)
#define S5_RT 88
DEV void ph_s5tables_gpu(const P& p, long gtid, long gsize) {
  FOR_ITEMS4(i, (long)DEPTH * 2 * S5_GROUPS * 128 * 1024) {
    const int k = (int)(i & 1023), n = (int)((i >> 10) & 127); const long ldg = i >> 17;
    const int ri = n >> 6, pp = n & 63, sidx = k >> 4, j = k & 15;
    const float2 lp = p.lampow()[(ldg * (S5_T + 1) + (S5_T - 1 - sidx)) * S5_STATE + pp]; const float2 bb = p.bbar()[(ldg * S5_STATE + pp) * S5_GROUP + j];
    p.bmtb()[i] = (unsigned short)f2bf(ri ? lp.x * bb.y + lp.y * bb.x : lp.x * bb.x - lp.y * bb.y);
  }
  FOR_ITEMS4(i, (long)DEPTH * 2 * S5_GROUPS * 128 * 1024) {
    const int k = (int)(i & 127), n = (int)((i >> 7) & 1023); const long ldg = i >> 17; const int dir = (int)((ldg >> 4) & 1);
    const int ri = k >> 6, pp = k & 63, tl = n >> 4, ii = n & 15; const int tau = dir ? 63 - tl : tl;
    const float cr = p.s5_c_re[(ldg * S5_GROUP + ii) * S5_STATE + pp], ci = p.s5_c_im[(ldg * S5_GROUP + ii) * S5_STATE + pp];
    const float2 lp = p.lampow()[(ldg * (S5_T + 1) + tau + 1) * S5_STATE + pp];
    p.cmtb()[i] = (unsigned short)f2bf(ri ? -(cr * lp.y + ci * lp.x) : cr * lp.x - ci * lp.y);
  }
}
DEV void ph_kcb_gpu(const P& p, long gtid, long gsize) {
  FOR_ITEMS4(i, (long)DEPTH * 2 * S5_GROUPS * S5_T * 256) p.kcb()[i] = (unsigned short)f2bf(p.kc()[i]);
}
struct ALS5U { const char* base; unsigned off0[2]; int stepb; const char* hbase; unsigned hoff[2]; int nki;
  DEVM void set(int i, int b, int dir, int chunk, int sl, unsigned joff) { off0[i] = (unsigned)s5_row(b, dir, chunk * S5_T + sl) * (unsigned)(S5_W * 2) + joff; }
  DEVM const unsigned short* a(int i, int kt) const {
    if (kt >= nki) return (const unsigned short*)(hbase + (hoff[i] + (unsigned)(kt - nki) * 128u));
    return (const unsigned short*)(base + (off0[i] + (unsigned)(kt * stepb))); } };
struct BLKc { const char* kc; const char* cm; int tl, i0, sj, ss, dir, nki; unsigned cmoff;
  DEVM void load(u32x4 (&rb)[4], int kt) const {
    if (kt >= nki) {
#pragma unroll
      for (int c = 0; c < 4; ++c) rb[c] = *(const u32x4*)(cm + (cmoff + (unsigned)(c * 128 + (kt - nki) * 64) * 2u));
      return;
    }
    const int d = (dir ? 63 - tl : tl) - (4 * kt + ss);
    if (d < 0) {
#pragma unroll
      for (int c = 0; c < 4; ++c) rb[c] = (u32x4){0u, 0u, 0u, 0u};
    } else {
#pragma unroll
      for (int c = 0; c < 4; ++c) rb[c] = *(const u32x4*)(kc + (unsigned)(((d * 16 + i0 + c) * 16 + sj) * 2));
    }
  } };
DEV void ph_s5_sgemm(const P& p, int l, char* smem) {
  const int tid = otid();
  const int nitems = 2 * S5_GROUPS * 3;
  for (int it = blockIdx.x; it < nitems; it += gridDim.x) {
    const int rt = it % 3, g = (it / 3) % S5_GROUPS, dir = it / (3 * S5_GROUPS);
    ALS5U al; al.base = (const char*)(p.s5u() + g * S5_GROUP); al.stepb = (dir ? -4 : 4) * S5_W * 2; al.nki = 1 << 20; al.hbase = al.base; al.hoff[0] = al.hoff[1] = 0;
#pragma unroll
    for (int i = 0; i < 2; ++i) { const int col = rt * S5_RT + min((tid >> 3) + 64 * i, S5_RT - 1); al.set(i, col / NCH, dir, col % NCH, (tid & 7) >> 1, (tid & 1) * 16); }
    BLT bl; bl.base = (const char*)(p.bmtb() + (((long)l * 2 + dir) * S5_GROUPS + g) * 128 * 1024); bl.rowb = 1024 * 2;
    bl.voff = (unsigned)((((tid >> 3) & 31) * 4)) * bl.rowb + (unsigned)((tid & 7) * 16);
    f32x4 acc[4][4]; acc_zero(acc);
    gemm_tb(al, bl, 16, acc, smem);
    EPI_BEGIN
    if (((etid >> 6) & 3) < 2) {
#pragma unroll
      for (int m = 0; m < 4; ++m)
#pragma unroll
        for (int j = 0; j < 4; ++j) {
          const int rl = EPI_ROW(m, j);
          if (rl < S5_RT) {
            const int col = rt * S5_RT + rl; const int b = col / NCH, c = col % NCH;
            float* dst = (float*)(p.sc() + ((((long)b * 2 + dir) * S5_GROUPS + g) * NCH + c) * S5_STATE);
#pragma unroll
            for (int n = 0; n < 4; ++n) { const int nn = EPI_COL(n); dst[(nn & 63) * 2 + (nn >> 6)] = acc[m][n][j]; }
          }
        }
    }
  }
}

static_assert(NCH == 132, "carry scan grouping");
DEV void ph_s5_carry_gpu(const P& p, int l, char* smem) {
  const int tid = otid();
  float2* E = (float2*)(smem + SM_MISC);
  const int nchains = BATCH * 2 * S5_GROUPS * S5_STATE;
  for (int cb = blockIdx.x * 16; cb < nchains; cb += gridDim.x * 16) {
    const int cl = tid & 15, grp = tid >> 4; const bool act = tid < 176;
    const int chain = cb + cl;
    const int pp = chain % S5_STATE, g = (chain / S5_STATE) % S5_GROUPS, dir = (chain / (S5_STATE * S5_GROUPS)) % 2, b = chain / (S5_STATE * S5_GROUPS * 2);
    const long ldg = ((long)l * 2 + dir) * S5_GROUPS + g;
    const long base = (((long)b * 2 + dir) * S5_GROUPS + g) * NCH + grp * 12;
    float2 lt = make_float2(0.f, 0.f); float2 L[12]; float hr = 0.f, hi = 0.f;
    __syncthreads();
    if (act) {
      lt = p.lampow()[(ldg * (S5_T + 1) + S5_T) * S5_STATE + pp];
      float2 sv[12];
#pragma unroll
      for (int k = 0; k < 12; ++k) sv[k] = p.sc()[(base + k) * S5_STATE + pp];
#pragma unroll
      for (int k = 0; k < 12; ++k) { L[k] = make_float2(hr, hi); const float nr = lt.x * hr - lt.y * hi + sv[k].x, ni = lt.x * hi + lt.y * hr + sv[k].y; hr = nr; hi = ni; }
      E[grp * 16 + cl] = make_float2(hr, hi);
    }
    __syncthreads();
    if (act) {
      float pr = lt.x, pi = lt.y;
#pragma unroll
      for (int k = 1; k < 12; ++k) { const float nr = pr * lt.x - pi * lt.y, ni = pr * lt.y + pi * lt.x; pr = nr; pi = ni; }
      float gr = 0.f, gi = 0.f;
      for (int gp = 0; gp < grp; ++gp) { const float2 e = E[gp * 16 + cl]; const float nr = pr * gr - pi * gi + e.x, ni = pr * gi + pi * gr + e.y; gr = nr; gi = ni; }
#pragma unroll
      for (int k = 0; k < 12; ++k) {
        const float vr = L[k].x + gr, vi = L[k].y + gi;
        p.hcbf()[(base + k) * 2 * S5_STATE + pp] = f2bf16(vr); p.hcbf()[(base + k) * 2 * S5_STATE + S5_STATE + pp] = f2bf16(vi);
        const float nr = lt.x * gr - lt.y * gi, ni = lt.x * gi + lt.y * gr; gr = nr; gi = ni;
      }
    }
  }
}
DEV void ph_s5_ygemm(const P& p, int l, char* smem) {
  const int tid = otid();
  const int nitems = S5_GROUPS * 3 * 4;
  for (int it = blockIdx.x; it < nitems; it += gridDim.x) {
    const int nt = it & 3, rt = (it >> 2) % 3, g = it / 12;
    f32x4 acc[4][4]; acc_zero(acc);
#pragma unroll 1
    for (int dir = 0; dir < 2; ++dir) {
      const long ldg = ((long)l * 2 + dir) * S5_GROUPS + g;
      const int nki = dir ? 16 - 4 * nt : 4 * nt + 4;
      ALS5U al; al.base = (const char*)(p.s5u() + g * S5_GROUP); al.stepb = (dir ? -4 : 4) * S5_W * 2; al.nki = nki; al.hbase = (const char*)p.hcbf();
#pragma unroll
      for (int i = 0; i < 2; ++i) {
        const int col = rt * S5_RT + min((tid >> 3) + 64 * i, S5_RT - 1); const int b = col / NCH, blk = col % NCH;
        const int ch = dir ? (blk < 4 ? 3 - blk : 135 - blk) : blk;
        al.set(i, b, dir, ch, (tid & 7) >> 1, (tid & 1) * 16);
        al.hoff[i] = (unsigned)((((b * 2 + dir) * S5_GROUPS + g) * NCH + ch) * 128 + (tid & 7) * 8) * 2u;
      }
      BLKc bk; bk.kc = (const char*)(p.kcb() + ldg * S5_T * 256); bk.tl = 16 * nt + (tid >> 5); bk.i0 = ((tid >> 3) & 3) * 4; bk.sj = (tid & 1) * 8; bk.ss = (tid & 7) >> 1; bk.dir = dir; bk.nki = nki;
      bk.cm = (const char*)(p.cmtb() + ldg * 1024 * 128); bk.cmoff = (unsigned)(((16 * nt + (tid >> 5)) * 16 + ((tid >> 3) & 3) * 4) * 128 + (tid & 7) * 8) * 2u;
      gemm_tb(al, bk, nki + 2, acc, smem);
    }
    EPI_BEGIN
#pragma unroll
    for (int m = 0; m < 4; ++m)
#pragma unroll
      for (int j = 0; j < 4; ++j) {
        const int rl = EPI_ROW(m, j);
        if (rl < S5_RT) {
          const int col = rt * S5_RT + rl; const int b = col / NCH, blk = col % NCH;
#pragma unroll
          for (int n = 0; n < 4; ++n) {
            const int nn = nt * 256 + EPI_COL(n); const int tl = nn >> 4, chn = g * S5_GROUP + (nn & 15);
            const long row = blk < 4 ? (long)NL + b * CTX_LEN + blk * 64 + tl : (long)b * SEQ + (blk - 4) * 64 + tl;
            const float y = acc[m][n][j] + p.s5_d[l * S5_W + chn] * __uint_as_float((unsigned)p.s5u()[row * S5_W + chn] << 16);
            const float gy = gelu_tanhf(y);
            p.ybuf()[row * S5_W + chn] = gy; p.ybf()[row * S5_W + chn] = (unsigned short)f2bf(gy);
          }
        }
      }
  }
}

DEV float wave_sum(float v) {
#pragma unroll
  for (int o = 32; o > 0; o >>= 1) v += __shfl_xor(v, o);
  return v;
}
DEV void st_bf4(unsigned short* dst, float a, float b, float c, float d) { u32x2 v; v[0] = pack2(a, b); v[1] = pack2(c, d); *(u32x2*)dst = v; }
static_assert(BATCH == 2, "mod partial layout");
DEV void ph_modsum_gpu(const P& p, long gtid, long gsize) {
  FOR_ITEMS(i, (long)DEPTH * (BATCH + 1) * 6 * D_MODEL) {
    const int n = (int)(i % (6 * D_MODEL)); const int j = (int)((i / (6 * D_MODEL)) % (BATCH + 1)); const int l = (int)(i / (6 * D_MODEL * (BATCH + 1)));
    float acc = p.b_ada[l * 6 * D_MODEL + n];
#pragma unroll
    for (int sl = 0; sl < 16; ++sl) acc += p.modp()[((long)(l * 16 + sl) * (BATCH + 1) + j) * 6 * D_MODEL + n];
    p.mod()[i] = acc;
  }
}
DEV void ph_modu0_gpu(const P& p, long gtid, long gsize) {
  FOR_ITEMS4(i4, (long)NR * D_MODEL / 4) {
    const long i = i4 * 4; const int k = (int)(i % D_MODEL); const long r = i / D_MODEL;
    const float* m = p.mod() + (long)modrow(r) * 6 * D_MODEL;
    const float4 x = *(const float4*)(p.xcur() + i); const float4 sh = *(const float4*)(m + k); const float4 sc = *(const float4*)(m + D_MODEL + k);
    st_bf4(p.ubf() + i, x.x * (1.f + sc.x) + sh.x, x.y * (1.f + sc.y) + sh.y, x.z * (1.f + sc.z) + sh.z, x.w * (1.f + sc.w) + sh.w);
  }
}
DEV void rms_rows(const P& p, int l, long r0, long r1, int w0, int nw) {
  const int lane = otid() & 63;
  for (long r = r0 + w0; r < r1; r += nw) {
    const float* v = p.mixb() + r * MIX_W; float4 a[4]; float ss[4];
#pragma unroll
    for (int i = 0; i < 4; ++i) { a[i] = *(const float4*)(v + (i * 64 + lane) * 4); ss[i] = a[i].x * a[i].x + a[i].y * a[i].y + a[i].z * a[i].z + a[i].w * a[i].w; }
    const float s_att = wave_sum(ss[0] + ss[1]), s_hy = wave_sum(ss[2]), s_s5 = wave_sum(ss[3]);
    float rs[4]; rs[0] = rs[1] = 1.0f / sqrtf(s_att / (float)ATTN_W + LN_EPS); rs[2] = 1.0f / sqrtf(s_hy / (float)HYENA_W + LN_EPS); rs[3] = 1.0f / sqrtf(s_s5 / (float)S5_W + LN_EPS);
#pragma unroll
    for (int i = 0; i < 4; ++i) {
      const int k = (i * 64 + lane) * 4; const float4 g = *(const float4*)(p.mix_g + l * MIX_W + k);
      st_bf4(p.mixbf() + r * MIX_W + k, a[i].x * rs[i] * g.x, a[i].y * rs[i] * g.y, a[i].z * rs[i] * g.z, a[i].w * rs[i] * g.w);
    }
  }
}
DEV void ln_rows(float4 (&a)[4], const float* gw, const float* bw, int lane) {
  float s = 0.f;
#pragma unroll
  for (int i = 0; i < 4; ++i) s += a[i].x + a[i].y + a[i].z + a[i].w;
  const float mu = wave_sum(s) / (float)D_MODEL; float q = 0.f;
#pragma unroll
  for (int i = 0; i < 4; ++i) { a[i].x -= mu; a[i].y -= mu; a[i].z -= mu; a[i].w -= mu; q += a[i].x * a[i].x + a[i].y * a[i].y + a[i].z * a[i].z + a[i].w * a[i].w; }
  const float rs = 1.0f / sqrtf(wave_sum(q) / (float)D_MODEL + LN_EPS);
#pragma unroll
  for (int i = 0; i < 4; ++i) {
    const int k = (i * 64 + lane) * 4; const float4 g = *(const float4*)(gw + k), b = *(const float4*)(bw + k);
    a[i].x = a[i].x * rs * g.x + b.x; a[i].y = a[i].y * rs * g.y + b.y; a[i].z = a[i].z * rs * g.z + b.z; a[i].w = a[i].w * rs * g.w + b.w;
  }
}
DEV void ph_ln1_gpu(const P& p, int l) {
  const int tid_ = otid(); const int lane = tid_ & 63; const int gw = blockIdx.x * (NT / 64) + (tid_ >> 6), nw = gridDim.x * (NT / 64);
  for (long r = gw; r < NR; r += nw) {
    float4 a[4];
#pragma unroll
    for (int i = 0; i < 4; ++i) a[i] = *(const float4*)(p.tmp() + r * D_MODEL + (i * 64 + lane) * 4);
    ln_rows(a, p.ln1_g + l * D_MODEL, p.ln1_b + l * D_MODEL, lane);
    const float* m = p.mod() + ((long)l * (BATCH + 1) + modrow(r)) * 6 * D_MODEL + 3 * D_MODEL;
#pragma unroll
    for (int i = 0; i < 4; ++i) {
      const int k = (i * 64 + lane) * 4;
      *(float4*)(p.xcur() + r * D_MODEL + k) = a[i];
      const float4 sh = *(const float4*)(m + k), sc = *(const float4*)(m + D_MODEL + k);
      const float u0 = a[i].x * (1.f + sc.x) + sh.x, u1 = a[i].y * (1.f + sc.y) + sh.y, u2 = a[i].z * (1.f + sc.z) + sh.z, u3 = a[i].w * (1.f + sc.w) + sh.w;
      st_bf4(p.ubf() + r * D_MODEL + k, u0, u1, u2, u3);
      st_bf4(p.ubl() + r * D_MODEL + k, bflo(u0), bflo(u1), bflo(u2), bflo(u3));
    }
  }
}
DEV void ph_ln2_gpu(const P& p, int l) {
  const int tid_ = otid(); const int lane = tid_ & 63; const int gw = blockIdx.x * (NT / 64) + (tid_ >> 6), nw = gridDim.x * (NT / 64);
  for (long r = gw; r < NR; r += nw) {
    float4 a[4];
    const float* m = p.mod() + ((long)l * (BATCH + 1) + modrow(r)) * 6 * D_MODEL + 5 * D_MODEL;
#pragma unroll
    for (int i = 0; i < 4; ++i) {
      const int k = (i * 64 + lane) * 4;
      float4 f = *(const float4*)(p.ysh() + r * D_MODEL + k);
#pragma unroll
      for (int kk = 0; kk < TOP_K; ++kk) { const u32x2 y = *(const u32x2*)(p.ykb() + (r * TOP_K + kk) * D_MODEL + k); f.x += __uint_as_float(y[0] << 16); f.y += __uint_as_float(y[0] & 0xffff0000u); f.z += __uint_as_float(y[1] << 16); f.w += __uint_as_float(y[1] & 0xffff0000u); }
      const float4 x = *(const float4*)(p.xcur() + r * D_MODEL + k), g2 = *(const float4*)(m + k);
      a[i].x = DN_ALPHA * x.x + g2.x * f.x; a[i].y = DN_ALPHA * x.y + g2.y * f.y; a[i].z = DN_ALPHA * x.z + g2.z * f.z; a[i].w = DN_ALPHA * x.w + g2.w * f.w;
    }
    ln_rows(a, p.ln2_g + l * D_MODEL, p.ln2_b + l * D_MODEL, lane);
    const float* mn = p.mod() + ((long)(l + 1) * (BATCH + 1) + modrow(r)) * 6 * D_MODEL;
#pragma unroll
    for (int i = 0; i < 4; ++i) {
      const int k = (i * 64 + lane) * 4;
      *(float4*)(p.xcur() + r * D_MODEL + k) = a[i];
      if (l + 1 < DEPTH) {
        const float4 sh = *(const float4*)(mn + k), sc = *(const float4*)(mn + D_MODEL + k);
        st_bf4(p.ubf() + r * D_MODEL + k, a[i].x * (1.f + sc.x) + sh.x, a[i].y * (1.f + sc.y) + sh.y, a[i].z * (1.f + sc.z) + sh.z, a[i].w * (1.f + sc.w) + sh.w);
      } else if (r < NL) *(float4*)(p.out + r * D_MODEL + k) = a[i];
    }
  }
}
struct ALRouter { const char* hi; const char* lo_; unsigned off[2];
  DEVM const unsigned short* a(int i, int kt) const { return (const unsigned short*)((kt >= 32 ? lo_ : hi) + (off[i] + (unsigned)(kt & 15) * 128u)); } };
struct BLRouter { const char* base; const char* lob; unsigned voff; unsigned rowb;
  DEVM void load(u32x4 (&rb)[4], int kt) const {
    const char* bb = (kt >> 4) == 1 ? lob : base;
#pragma unroll
    for (int c = 0; c < 4; ++c) rb[c] = *(const u32x4*)(bb + (voff + (unsigned)c * rowb + (unsigned)(kt & 15) * 128u)); } };
DEV void ph_router_mfma(const P& p, int l, char* smem) {
  const int tid = otid();
  const int n_router = (NR >> 7), n_sh = (NR >> 7) * 2;
  const int nrb = (int)gridDim.x >= 64 ? (int)((gridDim.x * 3) / 5) : 0;
  const bool is_router = nrb == 0 ? false : (int)blockIdx.x < nrb;
  for (int pass = 0; pass < 2; ++pass) {
    const bool do_router = nrb == 0 ? pass == 0 : is_router;
    if (nrb != 0 && pass == 1) break;
    const int first = nrb == 0 ? (int)blockIdx.x : (do_router ? (int)blockIdx.x : (int)blockIdx.x - nrb);
    const int stride = nrb == 0 ? (int)gridDim.x : (do_router ? nrb : (int)gridDim.x - nrb);
    const int nit = do_router ? n_router : n_sh;
    for (int it = first; it < nit; it += stride) {
      const int rt = do_router ? it : (it >> 1), cq = do_router ? 0 : (it & 1);
      ALRouter ar; ar.hi = (const char*)(p.ubf() + (long)rt * 128 * D_MODEL); ar.lo_ = (const char*)(p.ubl() + (long)rt * 128 * D_MODEL);
#pragma unroll
      for (int i = 0; i < 2; ++i) ar.off[i] = (unsigned)(((tid >> 3) + 64 * i) * D_MODEL + (tid & 7) * 8) * 2u;
      BLRouter br; int nk;
      if (do_router) {
        br.base = (const char*)(p.wt_rh() + (long)l * N_EXPERTS * D_MODEL); br.lob = (const char*)(p.wt_rl() + (long)l * N_EXPERTS * D_MODEL); br.rowb = D_MODEL * 2;
        br.voff = (unsigned)((tid >> 3) * 4) * br.rowb + (unsigned)((tid & 7) * 16); nk = 3 * (D_MODEL >> 6);
      } else {
        const int nq = tid >> 3; const int wsel = __builtin_amdgcn_readfirstlane(tid >> 6) & 1;
        const unsigned short* wsrc = (wsel ? p.wt_shu() : p.wt_shg()) + (long)l * SHARED_FF * D_MODEL;
        br.base = (const char*)wsrc; br.lob = br.base; br.rowb = D_MODEL * 2;
        br.voff = (unsigned)(cq * 128 + (nq >> 4) * 32 + (nq & 7) * 4) * br.rowb + (unsigned)((tid & 7) * 16); nk = D_MODEL >> 6;
      }
      f32x4 acc[4][4]; acc_zero(acc);
      gemm_tb(ar, br, nk, acc, smem);
      EPI_BEGIN
      if (do_router) {
#pragma unroll
        for (int m = 0; m < 4; ++m)
#pragma unroll
          for (int n = 0; n < 4; ++n)
#pragma unroll
            for (int j = 0; j < 4; ++j) p.rl()[((long)rt * 128 + EPI_ROW(m, j)) * N_EXPERTS + EPI_COL(n)] = acc[m][n][j];
      } else {
        const int elane = etid & 63, ewc = (etid >> 6) & 3;
#pragma unroll
        for (int m = 0; m < 4; ++m)
#pragma unroll
          for (int j = 0; j < 4; ++j)
          { unsigned short* dst = p.hsbf() + ((long)rt * 128 + EPI_ROW(m, j)) * SHARED_FF + cq * 128 + ewc * 32 + (elane & 15);
            dst[0] = (unsigned short)f2bf(siluf(acc[m][0][j]) * acc[m][2][j]); dst[16] = (unsigned short)f2bf(siluf(acc[m][1][j]) * acc[m][3][j]); }
      }
    }
  }
}
static_assert(EPG == 32 && TOP_K == 8 && N_EXPERT_GROUPS == 8 && TOPK_GROUPS == 4, "select shape");
DEV void ph_select_gpu(const P& p, int l) {
  const int tid_ = otid(); const int lane = tid_ & 63; const int gw = blockIdx.x * (NT / 64) + (tid_ >> 6), nw = gridDim.x * (NT / 64);
  const float4 rb = *(const float4*)(p.router_bias + l * N_EXPERTS + 4 * lane);
  for (long r = gw; r < NR; r += nw) {
    const float4 lg = *(const float4*)(p.rl() + r * N_EXPERTS + 4 * lane);
    float sc[4] = {sigmoidf_(lg.x), sigmoidf_(lg.y), sigmoidf_(lg.z), sigmoidf_(lg.w)};
    float bz[4] = {sc[0] + rb.x, sc[1] + rb.y, sc[2] + rb.z, sc[3] + rb.w};
    float m1 = fmaxf(bz[0], bz[1]), m2 = fminf(bz[0], bz[1]);
#pragma unroll
    for (int c = 2; c < 4; ++c) { const float v = bz[c]; m2 = fmaxf(m2, fminf(m1, v)); m1 = fmaxf(m1, v); }
#pragma unroll
    for (int o = 1; o < 8; o <<= 1) { const float b1 = __shfl_xor(m1, o), b2 = __shfl_xor(m2, o); m2 = fmaxf(fminf(m1, b1), fmaxf(m2, b2)); m1 = fmaxf(m1, b1); }
    const float gs = m1 + m2; const int mg = lane >> 3; int rank = 0;
#pragma unroll
    for (int j = 0; j < 8; ++j) { const float gj = __shfl(gs, j * 8); rank += (gj > gs || (gj == gs && j < mg)) ? 1 : 0; }
    if (rank >= TOPK_GROUPS) { bz[0] = bz[1] = bz[2] = bz[3] = -1e30f; }
    int sel_e[TOP_K]; float sel_s[TOP_K]; float gsum = 0.f;
#pragma unroll
    for (int it = 0; it < TOP_K; ++it) {
      float bv = bz[0]; int bc = 0;
#pragma unroll
      for (int c = 1; c < 4; ++c) if (bz[c] > bv) { bv = bz[c]; bc = c; }
      int bi = 4 * lane + bc; float bs = sc[bc];
      const int myi = bi;
#pragma unroll
      for (int o = 1; o < 64; o <<= 1) {
        const float ov = __shfl_xor(bv, o); const int oi = __shfl_xor(bi, o); const float os = __shfl_xor(bs, o);
        if (ov > bv || (ov == bv && oi < bi)) { bv = ov; bi = oi; bs = os; }
      }
      sel_e[it] = bi; sel_s[it] = bs; gsum += bs;
      if (bi == myi) {
#pragma unroll
        for (int c = 0; c < 4; ++c) if (c == bc) bz[c] = -1e30f;
      }
    }
    const float inv = ROUTED_SCALE / gsum;
    int me = sel_e[0]; float ms = sel_s[0];
#pragma unroll
    for (int it = 1; it < TOP_K; ++it) if (lane == it) { me = sel_e[it]; ms = sel_s[it]; }
    if (lane < TOP_K) {
      const long a = r * TOP_K + lane;
      p.top_e()[a] = me; p.gate()[a] = ms * inv;
      const int pos = atomicAdd(&p.cnt()[l * N_EXPERTS + me], 1);
      p.elist()[(long)me * NR + pos] = (int)a;
    }
  }
}
#endif

#ifndef CPU_TEST
#define XB_TMO      128
#define XB_XCNT(j)  (256  + 64 * (j))
#define XB_XSUB(j)  (1280 + 64 * (j))
#define XB_XGEN(j)  (2304 + 64 * (j))
#define XB_TOP      3328
#define XB_TOPGEN   3392
#define XCD_BAR_WORDS 3456
#define XB_SPIN_CAP (1u << 18)
#define LAS __attribute__((address_space(3)))
__device__ __forceinline__ unsigned xb_ld(unsigned* p)              { return __hip_atomic_load(p, __ATOMIC_RELAXED, __HIP_MEMORY_SCOPE_AGENT); }
__device__ __forceinline__ unsigned xb_add(unsigned* p, unsigned v) { return __hip_atomic_fetch_add(p, v, __ATOMIC_RELAXED, __HIP_MEMORY_SCOPE_AGENT); }
__device__ __forceinline__ unsigned xb_xcc_id() { return (unsigned)__builtin_amdgcn_s_getreg((3 << 11) | 20) & 0xFu; }
#define XB_SPIN(cond, bar) do { unsigned _sp = 0; while (cond) { __builtin_amdgcn_s_sleep(1); \
    if ((++_sp & 255u) == 0u) { if (xb_ld(&(bar)[XB_TMO])) break; if (_sp > XB_SPIN_CAP) { atomicAdd(&(bar)[XB_TMO], 1u); break; } } } } while (0)
struct XcdBarrier { unsigned* bar; unsigned x; volatile LAS unsigned* st; };
__device__ __forceinline__ XcdBarrier xcd_barrier_post(unsigned* bar, volatile LAS unsigned* st) {
    XcdBarrier b; b.bar = bar; b.x = xb_xcc_id(); b.st = st;
    if (threadIdx.x == 0) (void)xb_add(&bar[XB_XCNT(b.x)], 1u);
    return b;
}
__device__ __forceinline__ void xcd_barrier_complete(unsigned* bar, unsigned x, unsigned& nloc, unsigned& nx) {
    const unsigned G = gridDim.x * gridDim.y * gridDim.z;
    unsigned sum, cnt, mine, sp = 0u;
    for (;;) {
        sum = 0u; cnt = 0u; mine = 0u;
#pragma unroll
        for (unsigned j = 0; j < 16; ++j) { const unsigned c = xb_ld(&bar[XB_XCNT(j)]); sum += c; cnt += (c > 0u) ? 1u : 0u; mine = (j == x) ? c : mine; }
        if (sum == G) break;
        __builtin_amdgcn_s_sleep(1);
        if ((++sp & 255u) == 0u) { if (xb_ld(&bar[XB_TMO])) break; if (sp > XB_SPIN_CAP) { atomicAdd(&bar[XB_TMO], 1u); break; } }
    }
    nloc = mine > 0u ? mine : 1u; nx = cnt > 0u ? cnt : 1u;
}
__device__ __forceinline__ void xcd_barrier(const XcdBarrier& b) {
    asm volatile("s_waitcnt vmcnt(0)" ::: "memory");
    __syncthreads();
    if (threadIdx.x == 0) {
        unsigned* bar = b.bar;
        unsigned bx = b.x; asm volatile("" : "+s"(bx));
        __builtin_amdgcn_s_waitcnt(0);
        unsigned nloc = b.st[0], nx = b.st[1];
        if (nloc == 0u) { xcd_barrier_complete(bar, bx, nloc, nx); b.st[0] = nloc; b.st[1] = nx; }
        const unsigned old = xb_add(&bar[XB_XSUB(bx)], 1u);
        const unsigned gen = old / nloc;
        if (old + 1u == (gen + 1u) * nloc) {
            __builtin_amdgcn_fence(__ATOMIC_RELEASE, "agent");
            asm volatile("s_waitcnt vmcnt(0)" ::: "memory");
            const unsigned og = xb_add(&bar[XB_TOP], 1u);
            const unsigned tg = og / nx;
            if (og + 1u == (tg + 1u) * nx) xb_add(&bar[XB_TOPGEN], 1u);
            else XB_SPIN(xb_ld(&bar[XB_TOPGEN]) == tg, bar);
            __builtin_amdgcn_fence(__ATOMIC_ACQUIRE, "agent");
            xb_add(&bar[XB_XGEN(bx)], 1u);
            asm volatile("s_waitcnt vmcnt(0)" ::: "memory");
        } else {
            XB_SPIN(xb_ld(&bar[XB_XGEN(bx)]) == gen, bar);
            __builtin_amdgcn_fence(__ATOMIC_ACQUIRE, "agent");
            asm volatile("s_waitcnt vmcnt(0)" ::: "memory");
        }
    }
    __syncthreads();
}
#define GRID_SYNC() xcd_barrier(xb)
#else
#define GRID_SYNC() do {} while (0)
#endif

#ifndef CPU_TEST
#define GPUSEL(a, b) a
#else
#define GPUSEL(a, b) b
#endif
#ifndef CPU_TEST
#define OPAQUE_S(v) asm volatile("" : "+s"(v))
#define OPAQUE_V(v) asm volatile("" : "+v"(v))
#else
#define OPAQUE_S(v) do {} while (0)
#define OPAQUE_V(v) do {} while (0)
#endif
#ifndef PROBE_MASK
#define PROBE_MASK 0
#endif
#define LPHASE(stmt) do { int l = lo; OPAQUE_S(l); if (SINGLE && ((PROBE_MASK >> (ph - NG - lo * NLP)) & 1)) { long gtid = gtid0; OPAQUE_V(gtid); stmt; GRID_SYNC(); } PHASE(stmt); } while (0)
#define PHASE(stmt) do { if (SINGLE || ph == only) { long gtid = gtid0; OPAQUE_V(gtid); stmt; } if (SINGLE) { GRID_SYNC(); } ++ph; } while (0)
#ifndef CPU_TEST
template <bool SINGLE> __device__ __forceinline__ void run_seq(const P& p, long gtid0, long gsize, int only, const XcdBarrier& xb, char* smem)
#else
template <bool SINGLE> static int run_seq(const P& p, long gtid0, long gsize, int only)
#endif
{
  int ph = 0;
  PHASE(ph_g0(p, gtid, gsize));
  PHASE(ph_g1(p, gtid, gsize));
  PHASE(ph_g2(p, gtid, gsize));
  PHASE(ph_g3(p, gtid, gsize));
  PHASE(ph_g4(p, gtid, gsize));
#pragma unroll 1
  for (int lo = 0; lo < DEPTH; ++lo) {
    LPHASE(ph_modu(p, l, 0, gtid, gsize));
    LPHASE(GPUSEL(ph_proj_mfma(p, l, smem), ph_proj(p, l, gtid, gsize)));
    LPHASE(ph_post_proj(p, l, gtid, gsize));
    LPHASE(ph_mix(p, l, gtid, gsize); GPUSEL((ph_attn_mfma(p, l, smem), ph_hyena_mfma(p, l, smem)), (void)0));
    LPHASE(ph_s5out(p, l, gtid, gsize));
    LPHASE(GPUSEL(ph_glu_mfma(p, l, smem), ph_glu(p, l, gtid, gsize)));
    LPHASE(ph_rms(p, l, gtid, gsize));
    LPHASE(GPUSEL(ph_outproj_mfma(p, l, smem), ph_outproj(p, l, gtid, gsize)));
    LPHASE(ph_ln(p, l, 0, gtid, gsize));
    LPHASE(ph_router(p, l, gtid, gsize));
    LPHASE(ph_select(p, l, gtid, gsize));
    LPHASE(ph_sortrows(p, l, gtid, gsize));
    LPHASE(GPUSEL(ph_expert_up_mfma(p, l, smem), ph_expert_up(p, l, gtid, gsize)));
    LPHASE(GPUSEL(ph_expert_down_mfma(p, l, smem), ph_expert_down(p, l, gtid, gsize)));
    LPHASE(ph_combine(p, l, gtid, gsize));
    LPHASE(ph_ln(p, l, 1, gtid, gsize));
  }
#ifdef CPU_TEST
  return ph;
#endif
}


#ifndef CPU_TEST
#define NG_GPU 5
#define NLP_GPU 12
#ifndef PROBE_MASK_G
#define PROBE_MASK_G 0
#endif
#define GPHASE(stmt) do { if (SINGLE || ph == only) { long gtid = (long)blockIdx.x * NT + otid(); stmt; } if (SINGLE) { GRID_SYNC(); } ++ph; } while (0)
#define GLPHASE(stmt) do { int l = lo; OPAQUE_S(l); if (SINGLE && ((PROBE_MASK_G >> (ph - NG_GPU - lo * NLP_GPU)) & 1)) { long gtid = (long)blockIdx.x * NT + otid(); stmt; GRID_SYNC(); } GPHASE(stmt); } while (0)
template <bool SINGLE> __device__ __forceinline__ void run_seq_gpu(const P& p, long gtid0, long gsize, int only, const XcdBarrier& xb, char* smem) {
  int ph = 0;
#ifdef PROBE_INIT
  if (SINGLE) { long gtid = (long)blockIdx.x * NT + otid(); ph_g0(p, gtid, gsize); GRID_SYNC(); ph_g1(p, gtid, gsize); ph_modsum_gpu(p, gtid, gsize); ph_s5tables_gpu(p, gtid, gsize); GRID_SYNC(); ph_g2(p, gtid, gsize); ph_modu0_gpu(p, gtid, gsize); GRID_SYNC(); ph_g3(p, gtid, gsize); GRID_SYNC(); ph_g4(p, gtid, gsize); GRID_SYNC(); }
#endif
  GPHASE(ph_g0(p, gtid, gsize); s5_lampow_gpu(p, gtid, gsize); rope_table_gpu(p, gtid, gsize));
  GPHASE(ph_g1(p, gtid, gsize); ph_modsum_gpu(p, gtid, gsize); ph_s5tables_gpu(p, gtid, gsize); wt_convert_all(p, gtid, gsize));
  GPHASE(ph_g2(p, gtid, gsize); ph_modu0_gpu(p, gtid, gsize); ph_kcb_gpu(p, gtid, gsize));
  GPHASE(ph_g3(p, gtid, gsize));
  GPHASE(ph_g4(p, gtid, gsize));
#pragma unroll 1
  for (int lo = 0; lo < DEPTH; ++lo) {
    GLPHASE(ph_proj_mfma(p, l, smem));
    GLPHASE(ph_s5_sgemm(p, l, smem); ph_hyena_pre_gpu(p, l, gtid, gsize));
    GLPHASE(ph_mix(p, l, gtid, gsize); ph_s5_carry_gpu(p, l, smem); ph_attn_mfma(p, l, smem); ph_hyena_mfma(p, l, smem));
    GLPHASE(ph_s5_ygemm(p, l, smem));
    GLPHASE(ph_glu_mfma(p, l, smem));
    GLPHASE(ph_outproj_mfma(p, l, smem));
    GLPHASE(ph_ln1_gpu(p, l));
    GLPHASE(ph_router_mfma(p, l, smem));
    GLPHASE(ph_select_gpu(p, l));
#ifdef UPVAR
    if (SINGLE) { int l = lo; OPAQUE_S(l); ph_expert_up_mfma<UPVAR>(p, l, smem); GRID_SYNC(); }
#endif
    GLPHASE(ph_expert_up_mfma(p, l, smem));
    GLPHASE(ph_expert_down_mfma(p, l, smem));
    GLPHASE(ph_ln2_gpu(p, l));
  }
}
#endif

static void carve(P& p, void* ws) { p.ws = (char*)ws; }
static void set_inputs(P& p, void* const* d_in) {
  const float** f = (const float**)&p.x;
  for (int i = 0; i < 40; ++i) f[i] = (const float*)d_in[i];
}

#ifndef CPU_TEST
#ifndef MK_SINGLE
#define MK_SINGLE 1
#endif
extern __shared__ __attribute__((aligned(16))) char dyn_smem[];
__global__ void __launch_bounds__(NT, 2) mk_single(P p) {
  uint4* xbw = (uint4*)(dyn_smem + SM_XB);
  if (threadIdx.x == 0) *xbw = make_uint4(0u, 0u, 0u, 0u);
  __syncthreads();
  XcdBarrier xb = xcd_barrier_post(p.bar(), (volatile LAS unsigned*)xbw);
  run_seq_gpu<true>(p, (long)blockIdx.x * blockDim.x + threadIdx.x, (long)gridDim.x * blockDim.x, -1, xb, dyn_smem);
}
__global__ void __launch_bounds__(NT, 2) mk_phase(P p, int only) {
  XcdBarrier xb; xb.bar = p.bar(); xb.x = 0; xb.st = nullptr;
#ifdef DBG_ONLY
  only = DBG_ONLY;
#endif
  run_seq_gpu<false>(p, (long)blockIdx.x * blockDim.x + threadIdx.x, (long)gridDim.x * blockDim.x, only, xb, dyn_smem);
}
extern "C" void kernel_launch(void* const* d_in, const int* in_sizes, int n_in, void* d_out, int out_size, void* d_ws, size_t ws_size, hipStream_t stream) {
  P p; memset(&p, 0, sizeof(p));
  set_inputs(p, d_in); p.out = (float*)d_out; carve(p, d_ws);
  (void)hipMemsetAsync(p.bar(), 0, 4096 * sizeof(unsigned) + ((DEPTH * N_EXPERTS * sizeof(int) + 255) / 256) * 256, stream);
#if MK_SINGLE
  static int grid = 0;
  if (!grid) {
    int dev = 0, cus = 0, per_cu = 0; (void)hipGetDevice(&dev);
    (void)hipDeviceGetAttribute(&cus, hipDeviceAttributeMultiprocessorCount, dev);
    (void)hipFuncSetAttribute((const void*)mk_single, hipFuncAttributeMaxDynamicSharedMemorySize, SMEM_BYTES);
    (void)hipOccupancyMaxActiveBlocksPerMultiprocessor(&per_cu, mk_single, NT, SMEM_BYTES);
    grid = cus * (per_cu < 1 ? per_cu : 1);
  }
  mk_single<<<grid, NT, SMEM_BYTES, stream>>>(p);
#else
  for (int ph = 0; ph < NG_GPU + DEPTH * NLP_GPU; ++ph) mk_phase<<<256, NT, SMEM_BYTES, stream>>>(p, ph);
#endif
}
#endif
```

```cpp
#ifndef CPU_TEST
#include <hip/hip_runtime.h>
#include <cstring>
#define DEV __device__ __forceinline__
#define DEVM __device__ __forceinline__
#define HDM __host__ __device__ __forceinline__
#else
#include <cmath>
#include <cstdio>
#include <cstdlib>
#include <cstring>
#define DEV static inline
#define DEVM inline
#define HDM inline
struct float2 { float x, y; };
static inline float2 make_float2(float a, float b) { float2 r; r.x = a; r.y = b; return r; }
static inline int atomicAdd(int* p, int v) { int o = *p; *p += v; return o; }
#endif

#ifdef SMALL_CFG
#define D_MODEL 64
#define BATCH 2
#define SEQ 256
#define GRID_W 16
#define CTX_LEN 32
#define HEAD_DIM 16
#define N_Q_HEADS 4
#define N_KV_HEADS 2
#define HYENA_W 16
#define S5_W 32
#define WINDOW 32
#define FILTER_HIDDEN 16
#define S5_STATE 8
#define N_EXPERTS 32
#define TOP_K 4
#define EXPERT_FF 16
#define SHARED_FF 16
#define S5_T 32
#else
#define D_MODEL 1024
#define BATCH 2
#define SEQ 8192
#define GRID_W 64
#define CTX_LEN 256
#define HEAD_DIM 64
#define N_Q_HEADS 8
#define N_KV_HEADS 2
#define HYENA_W 256
#define S5_W 256
#define WINDOW 128
#define FILTER_HIDDEN 64
#define S5_STATE 64
#define N_EXPERTS 256
#define TOP_K 8
#define EXPERT_FF 256
#define SHARED_FF 256
#define S5_T 64
#endif
#define DEPTH 2
#define FILTER_EMB 33
#define N_EXPERT_GROUPS 8
#define TOPK_GROUPS 4
#define S5_GROUP 16
#define Q_GROUP (N_Q_HEADS / N_KV_HEADS)
#define ATTN_W (N_Q_HEADS * HEAD_DIM)
#define KV_W (N_KV_HEADS * HEAD_DIM)
#define MIX_W (ATTN_W + HYENA_W + S5_W)
#define Q_OFF 0
#define K_OFF ATTN_W
#define V_OFF (K_OFF + KV_W)
#define HY_OFF (V_OFF + KV_W)
#define S5_OFF (HY_OFF + 3 * HYENA_W)
#define IN_W (S5_OFF + S5_W)
#define AXIS_DIM (HEAD_DIM / 2)
#define ROPE_HALF (AXIS_DIM / 2)
#define S5_GROUPS (S5_W / S5_GROUP)
#define EPG (N_EXPERTS / N_EXPERT_GROUPS)
#define NL (BATCH * SEQ)
#define NC (BATCH * CTX_LEN)
#define NR (NL + NC)
#define NSEQ (CTX_LEN + SEQ)
#define NCH (NSEQ / S5_T)
#define LN_EPS 1e-5f
#define DN_ALPHA 1.4142135623730951f
#define ROUTED_SCALE 2.5f
#define PI_D 3.14159265358979323846

#define WS_LIST(X) \
  X(unsigned, bar, 4096) \
  X(int, cnt, DEPTH * N_EXPERTS) \
  X(float, mod, (size_t)DEPTH * (BATCH + 1) * 6 * D_MODEL) \
  X(float, xcur, (size_t)NR * D_MODEL) \
  X(float, ubuf, (size_t)NR * D_MODEL) \
  X(float, proj, (size_t)NR * IN_W) \
  X(float, hu, (size_t)NR * HYENA_W) \
  X(float, hx0, (size_t)NR * HYENA_W) \
  X(float, fh1, (size_t)DEPTH * SEQ * FILTER_HIDDEN) \
  X(float, fh2, (size_t)DEPTH * SEQ * FILTER_HIDDEN) \
  X(float, kraw, (size_t)DEPTH * SEQ * 2 * HYENA_W) \
  X(float, knorm, (size_t)DEPTH * HYENA_W) \
  X(float, fh1c, (size_t)CTX_LEN * FILTER_HIDDEN) \
  X(float, fh2c, (size_t)CTX_LEN * FILTER_HIDDEN) \
  X(float, krawc, (size_t)CTX_LEN * 2 * HYENA_W) \
  X(float, knormc, (size_t)HYENA_W) \
  X(float, mixb, (size_t)NR * MIX_W) \
  X(float, tmp, (size_t)NR * D_MODEL) \
  X(float2, lampow, (size_t)DEPTH * 2 * S5_GROUPS * (S5_T + 1) * S5_STATE) \
  X(float2, bbar, (size_t)DEPTH * 2 * S5_GROUPS * S5_STATE * S5_GROUP) \
  X(float, kc, (size_t)DEPTH * 2 * S5_GROUPS * S5_T * S5_GROUP * S5_GROUP) \
  X(float2, sc, (size_t)BATCH * 2 * S5_GROUPS * NCH * S5_STATE) \
  X(float2, hc, (size_t)BATCH * 2 * S5_GROUPS * NCH * S5_STATE) \
  X(float, ybuf, (size_t)NR * S5_W) \
  X(float, rl, (size_t)NR * N_EXPERTS) \
  X(int, top_e, (size_t)NR * TOP_K) \
  X(float, gate, (size_t)NR * TOP_K) \
  X(int, posb, (size_t)NR * TOP_K) \
  X(int, srow, (size_t)NR * TOP_K) \
  X(float, hbuf, (size_t)NR * TOP_K * EXPERT_FF) \
  X(float, hsb, (size_t)NR * SHARED_FF) \
  X(float, yk, (size_t)NR * TOP_K * D_MODEL) \
  X(float, ysh, (size_t)NR * D_MODEL) \
  X(unsigned short, ykb, (size_t)NR * TOP_K * D_MODEL) \
  X(unsigned short, qkvb, (size_t)NR * HY_OFF) \
  X(float2, ropet, (size_t)128 * ROPE_HALF) \
  X(unsigned short, bmtb, (size_t)DEPTH * 2 * S5_GROUPS * 128 * 1024) \
  X(unsigned short, cmtb, (size_t)DEPTH * 2 * S5_GROUPS * 1024 * 128) \
  X(unsigned short, kcb, (size_t)DEPTH * 2 * S5_GROUPS * S5_T * 256) \
  X(unsigned short, wt_in, (size_t)DEPTH * IN_W * D_MODEL) \
  X(unsigned short, wt_out, (size_t)DEPTH * D_MODEL * MIX_W) \
  X(unsigned short, wt_glu, (size_t)DEPTH * S5_W * S5_W) \
  X(unsigned short, wt_shg, (size_t)DEPTH * SHARED_FF * D_MODEL) \
  X(unsigned short, wt_shu, (size_t)DEPTH * SHARED_FF * D_MODEL) \
  X(unsigned short, wt_shd, (size_t)DEPTH * D_MODEL * SHARED_FF) \
  X(unsigned short, wt_rh, (size_t)DEPTH * N_EXPERTS * D_MODEL) \
  X(unsigned short, wt_rl, (size_t)DEPTH * N_EXPERTS * D_MODEL) \
  X(unsigned short, ubf, (size_t)NR * D_MODEL) \
  X(unsigned short, ybf, (size_t)NR * S5_W) \
  X(unsigned short, mixbf, (size_t)NR * MIX_W) \
  X(unsigned short, hbf, (size_t)NR * TOP_K * EXPERT_FF) \
  X(unsigned short, hsbf, (size_t)NR * SHARED_FF) \
  X(unsigned short, ubl, (size_t)NR * D_MODEL) \
  X(int, elist, (size_t)N_EXPERTS * NR) \
  X(float, egate, (size_t)N_EXPERTS * NR) \
  X(unsigned short, s5u, (size_t)NR * S5_W) \
  X(float, bmt, (size_t)DEPTH * 2 * S5_GROUPS * 16 * S5_T * 2 * S5_STATE) \
  X(float, cmt, (size_t)DEPTH * 2 * S5_GROUPS * 16 * S5_T * 2 * S5_STATE) \
  X(unsigned short, hcbf, (size_t)BATCH * 2 * S5_GROUPS * NCH * 2 * S5_STATE) \
  X(float, zT, (size_t)BATCH * 3 * HYENA_W * (SEQ + CTX_LEN)) \
  X(float, modp, (size_t)DEPTH * 16 * (BATCH + 1) * 6 * D_MODEL) \
  X(float, wrlo, (size_t)DEPTH * D_MODEL * N_EXPERTS) \

struct WsOff {
#define X(T, name, n) size_t name;
  WS_LIST(X)
#undef X
  size_t total;
};
constexpr WsOff ws_offsets() {
  WsOff o{}; size_t off = 0;
#define X(T, name, n) o.name = off; off += (((size_t)(n)) * sizeof(T) + 255) / 256 * 256;
  WS_LIST(X)
#undef X
  o.total = off; return o;
}
constexpr WsOff WSO = ws_offsets();
struct P {
  const float *x, *c, *ctx, *c_ctx, *w_ada, *b_ada, *w_in, *w_out, *sink, *mix_g, *hy_short_w, *hy_short_b, *hy_w1,
      *hy_b1, *hy_freq, *hy_w2, *hy_b2, *hy_w3, *hy_d, *s5_a_re, *s5_a_im, *s5_log_dt, *s5_b_re, *s5_b_im, *s5_c_re,
      *s5_c_im, *s5_d, *s5_w_glu, *ln1_g, *ln1_b, *ln2_g, *ln2_b, *w_router, *router_bias, *w_exp_gate, *w_exp_up,
      *w_exp_down, *w_sh_gate, *w_sh_up, *w_sh_down;
  float* out;
  char* ws;
#define X(T, name, n) HDM T* name() const { return (T*)(ws + WSO.name); }
  WS_LIST(X)
#undef X
};

#define FOR_ITEMS(i, N) for (long i = gtid; i < (long)(N); i += gsize)
#ifndef CPU_TEST
#define FOR_ITEMS4(i, N) _Pragma("unroll 4") for (long i = gtid; i < (long)(N); i += gsize)
#else
#define FOR_ITEMS4(i, N) FOR_ITEMS(i, N)
#endif

DEV unsigned short f2bf16(float f) { unsigned u; memcpy(&u, &f, 4); return (unsigned short)((u + 0x7fffu + ((u >> 16) & 1u)) >> 16); }
DEV float siluf(float x) { return x / (1.0f + expf(-x)); }
DEV float sigmoidf_(float x) { return 1.0f / (1.0f + expf(-x)); }
DEV float gelu_tanhf(float x) { return 0.5f * x * (1.0f + tanhf(0.7978845608028654f * (x + 0.044715f * x * x * x))); }
DEV int modrow(long r) { return r < NL ? (int)(r / SEQ) : BATCH; }

DEV void ph_g0(const P& p, long gtid, long gsize) {
#ifndef CPU_TEST
  FOR_ITEMS4(i4, (long)NR * D_MODEL / 4) { const long i = i4 * 4; *(float4*)(p.xcur() + i) = i < (long)NL * D_MODEL ? *(const float4*)(p.x + i) : *(const float4*)(p.ctx + (i - (long)NL * D_MODEL)); }
#else
  FOR_ITEMS(i, (long)NR * D_MODEL) p.xcur()[i] = i < (long)NL * D_MODEL ? p.x[i] : p.ctx[i - (long)NL * D_MODEL];
#endif
#ifdef CPU_TEST
  FOR_ITEMS(i, DEPTH * (BATCH + 1) * 6 * D_MODEL) {
    int n = (int)(i % (6 * D_MODEL)); int j = (int)((i / (6 * D_MODEL)) % (BATCH + 1)); int l = (int)(i / (6 * D_MODEL * (BATCH + 1)));
    const float* cv = j < BATCH ? p.c + j * D_MODEL : p.c_ctx;
    const float* w = p.w_ada + (long)l * D_MODEL * 6 * D_MODEL;
    float acc = p.b_ada[l * 6 * D_MODEL + n];
    for (int k = 0; k < D_MODEL; ++k) acc += siluf(cv[k]) * w[(long)k * 6 * D_MODEL + n];
    p.mod()[i] = acc;
  }
#else
  FOR_ITEMS(i, (long)DEPTH * 16 * 6 * D_MODEL) {
    const int n = (int)(i % (6 * D_MODEL)); const int slab = (int)((i / (6 * D_MODEL)) % 16); const int l = (int)(i / (6 * D_MODEL * 16));
    const float* w = p.w_ada + ((long)l * D_MODEL + slab * 64) * 6 * D_MODEL + n;
    float a0 = 0.f, a1 = 0.f, a2 = 0.f;
#pragma unroll 8
    for (int k = 0; k < 64; ++k) {
      const float wv = w[(long)k * 6 * D_MODEL]; const int kk = slab * 64 + k;
      a0 += siluf(p.c[kk]) * wv; a1 += siluf(p.c[D_MODEL + kk]) * wv; a2 += siluf(p.c_ctx[kk]) * wv;
    }
    float* dst = p.modp() + ((long)(l * 16 + slab) * (BATCH + 1)) * 6 * D_MODEL + n;
    dst[0] = a0; dst[6 * D_MODEL] = a1; dst[2 * 6 * D_MODEL] = a2;
  }
#endif
  FOR_ITEMS(i, DEPTH * 2 * S5_GROUPS * S5_STATE) {
    int pp = (int)(i % S5_STATE); int g = (int)((i / S5_STATE) % S5_GROUPS); int ld = (int)(i / (S5_STATE * S5_GROUPS));
    float are = fminf(p.s5_a_re[i], -1e-4f), aim = p.s5_a_im[i];
    float dt = expf(p.s5_log_dt[ld * S5_GROUPS + g]);
#ifdef CPU_TEST
    for (int d = 0; d <= S5_T; ++d) {
      float mag = expf(are * dt * d); float ang = aim * dt * d;
      p.lampow()[((long)(ld * S5_GROUPS + g) * (S5_T + 1) + d) * S5_STATE + pp] = make_float2(mag * cosf(ang), mag * sinf(ang));
    }
#endif
    float mag = expf(are * dt), ang = aim * dt;
    float lr = mag * cosf(ang) - 1.0f, li = mag * sinf(ang);
    float den = are * are + aim * aim;
    float fr = (lr * are + li * aim) / den, fi = (li * are - lr * aim) / den;
    for (int j = 0; j < S5_GROUP; ++j) {
      float br = p.s5_b_re[i * S5_GROUP + j], bi = p.s5_b_im[i * S5_GROUP + j];
      p.bbar()[i * S5_GROUP + j] = make_float2(fr * br - fi * bi, fr * bi + fi * br);
    }
  }
}
#ifndef CPU_TEST
DEV void rope_table_gpu(const P& p, long gtid, long gsize) {
  FOR_ITEMS(i, (long)128 * ROPE_HALF) {
    const int ii = (int)(i % ROPE_HALF), pos = (int)(i / ROPE_HALF);
    const float ang = (float)pos * powf(10000.0f, -(float)(2 * ii) / (float)AXIS_DIM);
    p.ropet()[i] = make_float2(cosf(ang), sinf(ang));
  }
}
DEV void s5_lampow_gpu(const P& p, long gtid, long gsize) {
  FOR_ITEMS4(i, (long)DEPTH * 2 * S5_GROUPS * (S5_T + 1) * S5_STATE) {
    const int pp = (int)(i % S5_STATE); const int d = (int)((i / S5_STATE) % (S5_T + 1)); const long ldg = i / ((long)S5_STATE * (S5_T + 1));
    const long src = ldg * S5_STATE + pp;
    const float are = fminf(p.s5_a_re[src], -1e-4f), aim = p.s5_a_im[src]; const float dt = expf(p.s5_log_dt[ldg]);
    const float mag = expf(are * dt * d); const float ang = aim * dt * d;
    p.lampow()[i] = make_float2(mag * cosf(ang), mag * sinf(ang));
  }
}
#endif
DEV void hy_f1(const P& p, int l, int Lf, float* h1, long gtid, long gsize) {
  FOR_ITEMS(i, (long)Lf * FILTER_HIDDEN) {
    int j = (int)(i % FILTER_HIDDEN); int t = (int)(i / FILTER_HIDDEN);
    const float* w1 = p.hy_w1 + l * FILTER_EMB * FILTER_HIDDEN;
    float tt = (float)((double)t / (double)(Lf - 1));
    float w = (float)(2.0 * PI_D * (double)t / (double)Lf);
    float acc = p.hy_b1[l * FILTER_HIDDEN + j] + tt * w1[j];
    const int bands = (FILTER_EMB - 1) / 2;
    for (int m = 0; m < bands; ++m) {
      float f = (float)(1e-4 + (double)m * ((double)(bands - 1) - 1e-4) / (double)(bands - 1));
      float a = f * w;
      acc += cosf(a) * w1[(1 + m) * FILTER_HIDDEN + j] - sinf(a) * w1[(1 + bands + m) * FILTER_HIDDEN + j];
    }
    h1[i] = sinf(p.hy_freq[l * FILTER_HIDDEN + j] * acc);
  }
}
DEV void hy_f2(const P& p, int l, int Lf, const float* h1, float* h2, long gtid, long gsize) {
  FOR_ITEMS(i, (long)Lf * FILTER_HIDDEN) {
    int j = (int)(i % FILTER_HIDDEN); int t = (int)(i / FILTER_HIDDEN);
    const float* w2 = p.hy_w2 + l * FILTER_HIDDEN * FILTER_HIDDEN;
    float acc = p.hy_b2[l * FILTER_HIDDEN + j];
    for (int k = 0; k < FILTER_HIDDEN; ++k) acc += h1[t * FILTER_HIDDEN + k] * w2[k * FILTER_HIDDEN + j];
#ifndef CPU_TEST
    h2[(long)j * Lf + t] = sinf(p.hy_freq[l * FILTER_HIDDEN + j] * acc);
#else
    h2[i] = sinf(p.hy_freq[l * FILTER_HIDDEN + j] * acc);
#endif
  }
}
DEV void hy_f3(const P& p, int l, int Lf, const float* h2, float* kraw, long gtid, long gsize) {
#ifndef CPU_TEST
  const float* w3 = p.hy_w3 + l * FILTER_HIDDEN * 2 * HYENA_W;
  FOR_ITEMS(i, (long)Lf * (2 * HYENA_W / 8)) {
    const int t = (int)(i % Lf); const int c8 = (int)(i / Lf) * 8;
    float acc[8];
#pragma unroll
    for (int j = 0; j < 8; ++j) acc[j] = 0.f;
#pragma unroll 4
    for (int k = 0; k < FILTER_HIDDEN; ++k) {
      const float hv = h2[(long)k * Lf + t];
      const float4 wa = *(const float4*)(w3 + k * 2 * HYENA_W + c8), wb = *(const float4*)(w3 + k * 2 * HYENA_W + c8 + 4);
      acc[0] += hv * wa.x; acc[1] += hv * wa.y; acc[2] += hv * wa.z; acc[3] += hv * wa.w; acc[4] += hv * wb.x; acc[5] += hv * wb.y; acc[6] += hv * wb.z; acc[7] += hv * wb.w;
    }
    const double d0 = log(1e-2) / 0.3, d1 = log(1e-2) / 1.5;
    const float tt = (float)((double)t / (double)(Lf - 1));
#pragma unroll
    for (int j = 0; j < 8; ++j) {
      const int ch = (c8 + j) % HYENA_W;
      const float delta = fabsf((float)(d0 + (d1 - d0) * (double)ch / (double)(HYENA_W - 1)));
      kraw[(long)(c8 + j) * Lf + t] = acc[j] * expf(-tt * delta);
    }
  }
#else
  FOR_ITEMS(i, (long)Lf * 2 * HYENA_W) {
    int t = (int)(i % Lf); int cc = (int)(i / Lf); int ch = cc % HYENA_W;
    const float* w3 = p.hy_w3 + l * FILTER_HIDDEN * 2 * HYENA_W;
    float acc = 0.f;
    for (int k = 0; k < FILTER_HIDDEN; ++k) acc += h2[t * FILTER_HIDDEN + k] * w3[k * 2 * HYENA_W + cc];
    double d0 = log(1e-2) / 0.3, d1 = log(1e-2) / 1.5;
    float delta = fabsf((float)(d0 + (d1 - d0) * (double)ch / (double)(HYENA_W - 1)));
    float tt = (float)((double)t / (double)(Lf - 1));
    kraw[(long)cc * Lf + t] = acc * expf(-tt * delta);
  }
#endif
}
DEV void hy_f4(int Lf, const float* kraw, float* knorm, long gtid, long gsize) {
#ifndef CPU_TEST
  const int lane = (int)(gtid & 63); const long gw = gtid >> 6, nw = gsize >> 6;
  for (long i = gw; i < HYENA_W; i += nw) {
    float s = 0.f;
    for (int t = lane; t < Lf; t += 64) { s += fabsf(kraw[i * Lf + t]); if (t > 0) s += fabsf(kraw[(HYENA_W + i) * Lf + t]); }
    for (int o = 32; o > 0; o >>= 1) s += __shfl_xor(s, o);
    if (lane == 0) knorm[i] = 1.0f / s;
  }
#else
  FOR_ITEMS(i, HYENA_W) {
    float s = 0.f;
    for (int t = 0; t < Lf; ++t) {
      s += fabsf(kraw[(long)i * Lf + t]);
      if (t > 0) s += fabsf(kraw[(long)(HYENA_W + i) * Lf + t]);
    }
    knorm[i] = 1.0f / s;
  }
#endif
}
DEV void ph_g1(const P& p, long gtid, long gsize) {
  for (int l = 0; l < DEPTH; ++l) hy_f1(p, l, SEQ, p.fh1() + (long)l * SEQ * FILTER_HIDDEN, gtid, gsize);
  hy_f1(p, 0, CTX_LEN, p.fh1c(), gtid, gsize);
  FOR_ITEMS(i, (long)DEPTH * 2 * S5_GROUPS * S5_T * S5_GROUP * S5_GROUP) {
    int j = (int)(i % S5_GROUP); int ii = (int)((i / S5_GROUP) % S5_GROUP); int d = (int)((i / (S5_GROUP * S5_GROUP)) % S5_T);
    long ldg = i / (S5_GROUP * S5_GROUP * S5_T);
    float acc = 0.f;
    for (int pp = 0; pp < S5_STATE; ++pp) {
      float cr = p.s5_c_re[(ldg * S5_GROUP + ii) * S5_STATE + pp], ci = p.s5_c_im[(ldg * S5_GROUP + ii) * S5_STATE + pp];
      float2 lp = p.lampow()[(ldg * (S5_T + 1) + d) * S5_STATE + pp];
      float2 bb = p.bbar()[(ldg * S5_STATE + pp) * S5_GROUP + j];
      float tr = lp.x * bb.x - lp.y * bb.y, ti = lp.x * bb.y + lp.y * bb.x;
      acc += cr * tr - ci * ti;
    }
    p.kc()[i] = acc;
  }
}
DEV void ph_g2(const P& p, long gtid, long gsize) {
  for (int l = 0; l < DEPTH; ++l) hy_f2(p, l, SEQ, p.fh1() + (long)l * SEQ * FILTER_HIDDEN, p.fh2() + (long)l * SEQ * FILTER_HIDDEN, gtid, gsize);
  hy_f2(p, 0, CTX_LEN, p.fh1c(), p.fh2c(), gtid, gsize);
}
DEV void ph_g3(const P& p, long gtid, long gsize) {
  for (int l = 0; l < DEPTH; ++l) hy_f3(p, l, SEQ, p.fh2() + (long)l * SEQ * FILTER_HIDDEN, p.kraw() + (long)l * SEQ * 2 * HYENA_W, gtid, gsize);
  hy_f3(p, 0, CTX_LEN, p.fh2c(), p.krawc(), gtid, gsize);
}
DEV void ph_g4(const P& p, long gtid, long gsize) {
  for (int l = 0; l < DEPTH; ++l) hy_f4(SEQ, p.kraw() + (long)l * SEQ * 2 * HYENA_W, p.knorm() + l * HYENA_W, gtid, gsize);
  hy_f4(CTX_LEN, p.krawc(), p.knormc(), gtid, gsize);
}
#define NG 5

DEV void ph_modu(const P& p, int l, int which, long gtid, long gsize) {
  FOR_ITEMS(i, (long)NR * D_MODEL) {
    int k = (int)(i % D_MODEL); long r = i / D_MODEL;
    const float* m = p.mod() + ((long)l * (BATCH + 1) + modrow(r)) * 6 * D_MODEL + which * 3 * D_MODEL;
    float uv = p.xcur()[i] * (1.0f + m[D_MODEL + k]) + m[k];
    p.ubuf()[i] = uv; p.ubf()[i] = f2bf16(uv);
  }
}
template <class Epi>
DEV void gemm_naive(const float* A, int lda, const float* B, int ldb, int M, int N, int K, Epi epi, long gtid, long gsize) {
  FOR_ITEMS(i, (long)(M / 4) * N) {
    int n = (int)(i % N); long r0 = (i / N) * 4;
    const float* a0 = A + r0 * lda;
    float c0 = 0.f, c1 = 0.f, c2 = 0.f, c3 = 0.f;
    for (int k = 0; k < K; ++k) {
      float b = B[(long)k * ldb + n];
      c0 += a0[k] * b; c1 += a0[lda + k] * b; c2 += a0[2 * lda + k] * b; c3 += a0[3 * lda + k] * b;
    }
    epi(r0, n, c0); epi(r0 + 1, n, c1); epi(r0 + 2, n, c2); epi(r0 + 3, n, c3);
  }
}
struct EpiStore { float* C; int ldc; DEVM void operator()(long r, int n, float v) const { C[r * ldc + n] = v; } };
DEV void ph_proj(const P& p, int l, long gtid, long gsize) {
  EpiStore e{p.proj(), IN_W};
  gemm_naive(p.ubuf(), D_MODEL, p.w_in + (long)l * D_MODEL * IN_W, IN_W, NR, IN_W, D_MODEL, e, gtid, gsize);
}
DEV long s5_row(int b, int dir, int n) {
  if (n < CTX_LEN) return (long)NL + b * CTX_LEN + (dir ? CTX_LEN - 1 - n : n);
  int t = n - CTX_LEN; return (long)b * SEQ + (dir ? SEQ - 1 - t : t);
}
DEV void ph_post_proj(const P& p, int l, long gtid, long gsize) {
  FOR_ITEMS(i, (long)NL * (N_Q_HEADS + N_KV_HEADS) * 2 * ROPE_HALF) {
    int ii = (int)(i % ROPE_HALF); int a = (int)((i / ROPE_HALF) % 2); int hs = (int)((i / (2 * ROPE_HALF)) % (N_Q_HEADS + N_KV_HEADS));
    long r = i / (2 * ROPE_HALF * (N_Q_HEADS + N_KV_HEADS));
    int t = (int)(r % SEQ); int pos = a == 0 ? t / GRID_W : t % GRID_W;
    float inv = powf(10000.0f, -(float)(2 * ii) / (float)AXIS_DIM);
    float ang = (float)pos * inv; float cs = cosf(ang), sn = sinf(ang);
    float* q = p.proj() + r * IN_W + hs * HEAD_DIM + a * AXIS_DIM + ii;
    float x1 = q[0], x2 = q[ROPE_HALF];
    q[0] = x1 * cs - x2 * sn; q[ROPE_HALF] = x1 * sn + x2 * cs;
  }
#ifdef CPU_TEST
  FOR_ITEMS(i, (long)NR * HYENA_W) {
    int ch = (int)(i % HYENA_W); long r = i / HYENA_W;
    int Ls = r < NL ? SEQ : CTX_LEN; long base = r < NL ? (r / SEQ) * SEQ : NL + ((r - NL) / CTX_LEN) * CTX_LEN; int t = (int)(r - base);
    const float* sw = p.hy_short_w + l * 3 * 3 * HYENA_W; const float* sb = p.hy_short_b + l * 3 * HYENA_W;
    float z[3];
#pragma unroll
    for (int part = 0; part < 3; ++part) {
      int cc = part * HYENA_W + ch; float acc = sb[cc];
#pragma unroll
      for (int j = 0; j < 3; ++j) { int tt = t + j - 1; if (tt >= 0 && tt < Ls) acc += p.proj()[(base + tt) * IN_W + HY_OFF + cc] * sw[j * 3 * HYENA_W + cc]; }
      z[part] = acc;
    }
    long o = r < NL ? ((r / SEQ) * HYENA_W + ch) * SEQ + t : i;
    p.hu()[o] = z[0] * z[1]; p.hx0()[o] = z[2];
  }
#endif
#ifndef CPU_TEST
  FOR_ITEMS(i, (long)NR * S5_W) { long r = i / S5_W; int cc = (int)(i % S5_W); p.s5u()[i] = f2bf16(p.proj()[r * IN_W + S5_OFF + cc]); }
#endif
#ifdef CPU_TEST
  FOR_ITEMS(i, (long)BATCH * 2 * S5_GROUPS * NCH * S5_STATE) {
    int pp = (int)(i % S5_STATE); int c = (int)((i / S5_STATE) % NCH); int g = (int)((i / (S5_STATE * NCH)) % S5_GROUPS);
    int dir = (int)((i / (S5_STATE * NCH * S5_GROUPS)) % 2); int b = (int)(i / (S5_STATE * NCH * S5_GROUPS * 2));
    long ldg = ((long)l * 2 + dir) * S5_GROUPS + g;
    float sr = 0.f, si = 0.f;
    for (int s = 0; s < S5_T; ++s) {
      const float* u = p.proj() + s5_row(b, dir, c * S5_T + s) * IN_W + S5_OFF + g * S5_GROUP;
      float br = 0.f, bi = 0.f;
#pragma unroll
      for (int j = 0; j < S5_GROUP; ++j) { float2 bb = p.bbar()[(ldg * S5_STATE + pp) * S5_GROUP + j]; br += bb.x * u[j]; bi += bb.y * u[j]; }
      float2 lp = p.lampow()[(ldg * (S5_T + 1) + (S5_T - 1 - s)) * S5_STATE + pp];
      sr += lp.x * br - lp.y * bi; si += lp.x * bi + lp.y * br;
    }
    p.sc()[i] = make_float2(sr, si);
  }
#endif
}
DEV void attn_item(const P& p, int l, long r, int h, float* outp) {
  const float scale = 1.0f / sqrtf((float)HEAD_DIM);
  float q[HEAD_DIM], acc[HEAD_DIM];
  const float* qp = p.proj() + r * IN_W + Q_OFF + h * HEAD_DIM;
#pragma unroll
  for (int d = 0; d < HEAD_DIM; ++d) { q[d] = qp[d] * scale; acc[d] = 0.f; }
  int kvh = h / Q_GROUP; int b = r < NL ? (int)(r / SEQ) : (int)((r - NL) / CTX_LEN);
  float m = -1e30f, lsum = 0.f;
  int nwin = 0, t = 0;
  if (r < NL) { t = (int)(r % SEQ); nwin = 2 * WINDOW + 1; }
  for (int j = 0; j < nwin + CTX_LEN; ++j) {
    long kr;
    if (j < nwin) { int tk = t - WINDOW + j; if (tk < 0 || tk >= SEQ) continue; kr = (long)b * SEQ + tk; }
    else kr = (long)NL + b * CTX_LEN + (j - nwin);
    const float* kp = p.proj() + kr * IN_W + K_OFF + kvh * HEAD_DIM; const float* vp = p.proj() + kr * IN_W + V_OFF + kvh * HEAD_DIM;
    float s = 0.f;
#pragma unroll
    for (int d = 0; d < HEAD_DIM; ++d) s += q[d] * kp[d];
    float mn = fmaxf(m, s); float corr = expf(m - mn); float pe = expf(s - mn);
    lsum = lsum * corr + pe;
#pragma unroll
    for (int d = 0; d < HEAD_DIM; ++d) acc[d] = acc[d] * corr + pe * vp[d];
    m = mn;
  }
  float sk = p.sink[l * N_Q_HEADS + h]; float mf = fmaxf(m, sk); float corr = expf(m - mf);
  float den = lsum * corr + expf(sk - mf); float sc2 = corr / den;
#pragma unroll
  for (int d = 0; d < HEAD_DIM; ++d) outp[d] = acc[d] * sc2;
}
DEV void ph_mix(const P& p, int l, long gtid, long gsize) {
#ifdef CPU_TEST
  long nrows_att = l == 0 ? NR : NL;
  FOR_ITEMS(i, nrows_att * N_Q_HEADS) { int h = (int)(i % N_Q_HEADS); long r = i / N_Q_HEADS; attn_item(p, l, r, h, p.mixb() + r * MIX_W + h * HEAD_DIM); }
#endif
#ifdef CPU_TEST
  FOR_ITEMS(i, (long)NL * HYENA_W) {
    int ch = (int)(i % HYENA_W); long r = i / HYENA_W; int t = (int)(r % SEQ); int b = (int)(r / SEQ);
    const float* kf = p.kraw() + ((long)l * 2 * HYENA_W + ch) * SEQ; const float* kb = p.kraw() + ((long)l * 2 * HYENA_W + HYENA_W + ch) * SEQ;
    const float* uu = p.hu() + ((long)b * HYENA_W + ch) * SEQ;
    float acc = 0.f;
    for (int s = 0; s <= t; ++s) acc += kf[t - s] * uu[s];
    for (int s = t + 1; s < SEQ; ++s) acc += kb[s - t] * uu[s];
    p.mixb()[r * MIX_W + ATTN_W + ch] = (acc * p.knorm()[l * HYENA_W + ch] + uu[t] * p.hy_d[l * HYENA_W + ch]) * p.hx0()[((long)b * HYENA_W + ch) * SEQ + t];
  }
#endif
  if (l == 0) {
#ifndef CPU_TEST
    FOR_ITEMS(i, (long)NC * HYENA_W) {
      const int t = (int)(i % CTX_LEN); const int ch = (int)((i / CTX_LEN) % HYENA_W); const int b = (int)(i / ((long)CTX_LEN * HYENA_W));
      const long base = (long)NL + (long)b * CTX_LEN; const long r = base + t;
      const float* kf = p.krawc() + (long)ch * CTX_LEN; const float* kb = p.krawc() + (long)(HYENA_W + ch) * CTX_LEN;
      float acc = 0.f;
#pragma unroll 8
      for (int sidx = 0; sidx < CTX_LEN; ++sidx) {
        const int d = t - sidx; const float kv = d >= 0 ? kf[d] : kb[-d];
        acc += kv * p.hu()[(base + sidx) * HYENA_W + ch];
      }
      const float u = p.hu()[r * HYENA_W + ch];
      p.mixb()[r * MIX_W + ATTN_W + ch] = (acc * p.knormc()[ch] + u * p.hy_d[l * HYENA_W + ch]) * p.hx0()[r * HYENA_W + ch];
    }
#else
    FOR_ITEMS(i, (long)NC * HYENA_W) {
      int ch = (int)(i % HYENA_W); long r = NL + i / HYENA_W; int t = (int)((r - NL) % CTX_LEN); long base = r - t;
      float acc = 0.f;
      for (int s = 0; s <= t; ++s) acc += p.krawc()[(long)ch * CTX_LEN + (t - s)] * p.hu()[(base + s) * HYENA_W + ch];
      for (int s = t + 1; s < CTX_LEN; ++s) acc += p.krawc()[(long)(HYENA_W + ch) * CTX_LEN + (s - t)] * p.hu()[(base + s) * HYENA_W + ch];
      float u = p.hu()[r * HYENA_W + ch];
      p.mixb()[r * MIX_W + ATTN_W + ch] = (acc * p.knormc()[ch] + u * p.hy_d[l * HYENA_W + ch]) * p.hx0()[r * HYENA_W + ch];
    }
#endif
  }
#ifdef CPU_TEST
  FOR_ITEMS(i, (long)BATCH * 2 * S5_GROUPS * S5_STATE) {
    int pp = (int)(i % S5_STATE); int g = (int)((i / S5_STATE) % S5_GROUPS); int dir = (int)((i / (S5_STATE * S5_GROUPS)) % 2); int b = (int)(i / (S5_STATE * S5_GROUPS * 2));
    long ldg = ((long)l * 2 + dir) * S5_GROUPS + g;
    float2 lt = p.lampow()[(ldg * (S5_T + 1) + S5_T) * S5_STATE + pp];
    float hr = 0.f, hi = 0.f;
    long base = (((long)b * 2 + dir) * S5_GROUPS + g) * NCH;
#ifndef CPU_TEST
    static_assert(NCH % 12 == 0, "carry batching");
    for (int c0 = 0; c0 < NCH; c0 += 12) {
      float2 sv[12];
#pragma unroll
      for (int k = 0; k < 12; ++k) sv[k] = p.sc()[(base + c0 + k) * S5_STATE + pp];
#pragma unroll
      for (int k = 0; k < 12; ++k) {
        p.hcbf()[(base + c0 + k) * 2 * S5_STATE + pp] = f2bf16(hr); p.hcbf()[(base + c0 + k) * 2 * S5_STATE + S5_STATE + pp] = f2bf16(hi);
        const float nr = lt.x * hr - lt.y * hi + sv[k].x, ni = lt.x * hi + lt.y * hr + sv[k].y;
        hr = nr; hi = ni;
      }
    }
#else
    for (int c = 0; c < NCH; ++c) {
      p.hc()[(base + c) * S5_STATE + pp] = make_float2(hr, hi);
      float2 s = p.sc()[(base + c) * S5_STATE + pp];
      float nr = lt.x * hr - lt.y * hi + s.x, ni = lt.x * hi + lt.y * hr + s.y;
      hr = nr; hi = ni;
    }
#endif
  }
#endif
}
DEV void ph_s5out(const P& p, int l, long gtid, long gsize) {
  FOR_ITEMS(i, (long)NR * S5_W) {
    int chn = (int)(i % S5_W); long r = i / S5_W; int g = chn / S5_GROUP, ii = chn % S5_GROUP;
    int b, tl; bool isctx = r >= NL;
    if (isctx) { b = (int)((r - NL) / CTX_LEN); tl = (int)((r - NL) % CTX_LEN); } else { b = (int)(r / SEQ); tl = (int)(r % SEQ); }
    float y = p.s5_d[l * S5_W + chn] * p.proj()[r * IN_W + S5_OFF + chn];
    for (int dir = 0; dir < 2; ++dir) {
      int n = isctx ? (dir ? CTX_LEN - 1 - tl : tl) : CTX_LEN + (dir ? SEQ - 1 - tl : tl);
      int c = n / S5_T, tau = n % S5_T;
      long ldg = ((long)l * 2 + dir) * S5_GROUPS + g;
      long hb = ((((long)b * 2 + dir) * S5_GROUPS + g) * NCH + c) * S5_STATE;
      for (int pp = 0; pp < S5_STATE; ++pp) {
        float cr = p.s5_c_re[(ldg * S5_GROUP + ii) * S5_STATE + pp], ci = p.s5_c_im[(ldg * S5_GROUP + ii) * S5_STATE + pp];
        float2 lp = p.lampow()[(ldg * (S5_T + 1) + tau + 1) * S5_STATE + pp]; float2 h = p.hc()[hb + pp];
        float tr = lp.x * h.x - lp.y * h.y, ti = lp.x * h.y + lp.y * h.x;
        y += cr * tr - ci * ti;
      }
      for (int s = 0; s <= tau; ++s) {
        const float* u = p.proj() + s5_row(b, dir, c * S5_T + s) * IN_W + S5_OFF + g * S5_GROUP;
        const float* kk = p.kc() + ((ldg * S5_T + (tau - s)) * S5_GROUP + ii) * S5_GROUP;
#pragma unroll
        for (int j = 0; j < S5_GROUP; ++j) y += kk[j] * u[j];
      }
    }
    float gy = gelu_tanhf(y); p.ybuf()[i] = gy; p.ybf()[i] = f2bf16(gy);
  }
}
struct EpiGlu { const float* g; float* mixb; DEVM void operator()(long r, int n, float v) const { mixb[r * MIX_W + ATTN_W + HYENA_W + n] = g[r * S5_W + n] * sigmoidf_(v); } };
DEV void ph_glu(const P& p, int l, long gtid, long gsize) {
  EpiGlu e{p.ybuf(), p.mixb()};
  gemm_naive(p.ybuf(), S5_W, p.s5_w_glu + (long)l * S5_W * S5_W, S5_W, NR, S5_W, S5_W, e, gtid, gsize);
}
DEV void ph_rms(const P& p, int l, long gtid, long gsize) {
  FOR_ITEMS(i, (long)NR * 3) {
    int grp = (int)(i % 3); long r = i / 3;
    int off = grp == 0 ? 0 : (grp == 1 ? ATTN_W : ATTN_W + HYENA_W); int w = grp == 0 ? ATTN_W : (grp == 1 ? HYENA_W : S5_W);
    float* v = p.mixb() + r * MIX_W + off; float ss = 0.f;
    for (int k = 0; k < w; ++k) ss += v[k] * v[k];
    float rs = 1.0f / sqrtf(ss / (float)w + LN_EPS);
    for (int k = 0; k < w; ++k) { float nv = v[k] * rs * p.mix_g[l * MIX_W + off + k]; v[k] = nv; p.mixbf()[r * MIX_W + off + k] = f2bf16(nv); }
  }
}
struct EpiRes { const float* xcur; const float* mod; int l; int goff; float* tmp;
  DEVM void operator()(long r, int n, float v) const { const float* m = mod + ((long)l * (BATCH + 1) + modrow(r)) * 6 * D_MODEL + goff; tmp[r * D_MODEL + n] = DN_ALPHA * xcur[r * D_MODEL + n] + m[n] * v; } };
DEV void ph_outproj(const P& p, int l, long gtid, long gsize) {
  EpiRes e{p.xcur(), p.mod(), l, 2 * D_MODEL, p.tmp()};
  gemm_naive(p.mixb(), MIX_W, p.w_out + (long)l * MIX_W * D_MODEL, D_MODEL, NR, D_MODEL, MIX_W, e, gtid, gsize);
}
DEV void ph_ln(const P& p, int l, int which, long gtid, long gsize) {
  const float* gw = (which == 0 ? p.ln1_g : p.ln2_g) + l * D_MODEL; const float* bw = (which == 0 ? p.ln1_b : p.ln2_b) + l * D_MODEL;
  FOR_ITEMS(r, (long)NR) {
    const float* v = p.tmp() + r * D_MODEL; float mu = 0.f;
#pragma unroll 4
    for (int k = 0; k < D_MODEL; ++k) mu += v[k];
    mu /= (float)D_MODEL; float var = 0.f;
#pragma unroll 4
    for (int k = 0; k < D_MODEL; ++k) { float d = v[k] - mu; var += d * d; }
    float rs = 1.0f / sqrtf(var / (float)D_MODEL + LN_EPS);
    const float* m = p.mod() + ((long)l * (BATCH + 1) + modrow(r)) * 6 * D_MODEL + 3 * D_MODEL;
#pragma unroll 2
    for (int k = 0; k < D_MODEL; ++k) {
      float y = (v[k] - mu) * rs * gw[k] + bw[k];
      p.xcur()[r * D_MODEL + k] = y;
      if (which == 0) { float uv = y * (1.0f + m[D_MODEL + k]) + m[k]; p.ubuf()[r * D_MODEL + k] = uv; p.ubf()[r * D_MODEL + k] = f2bf16(uv); }
      if (which == 1 && l == DEPTH - 1 && r < NL) p.out[r * D_MODEL + k] = y;
    }
  }
}
DEV void ph_router(const P& p, int l, long gtid, long gsize) {
  EpiStore e{p.rl(), N_EXPERTS};
  gemm_naive(p.ubuf(), D_MODEL, p.w_router + (long)l * D_MODEL * N_EXPERTS, N_EXPERTS, NR, N_EXPERTS, D_MODEL, e, gtid, gsize);
}
DEV bool better(float v, int i, float bv, int bi) { return v > bv || (v == bv && i < bi); }
DEV void ph_select(const P& p, int l, long gtid, long gsize) {
  FOR_ITEMS(r, (long)NR) {
    const float* lg = p.rl() + r * N_EXPERTS; const float* rb = p.router_bias + l * N_EXPERTS;
    float gs[N_EXPERT_GROUPS];
#pragma unroll
    for (int g = 0; g < N_EXPERT_GROUPS; ++g) {
      float m1 = -1e30f, m2 = -1e30f;
      for (int e = 0; e < EPG; ++e) { float v = sigmoidf_(lg[g * EPG + e]) + rb[g * EPG + e]; if (v > m1) { m2 = m1; m1 = v; } else if (v > m2) m2 = v; }
      gs[g] = m1 + m2;
    }
    unsigned keep = 0;
#pragma unroll
    for (int it = 0; it < TOPK_GROUPS; ++it) {
      float bv = -1e30f; int bi = -1;
#pragma unroll
      for (int g = 0; g < N_EXPERT_GROUPS; ++g) if (!((keep >> g) & 1u) && (bi < 0 || gs[g] > bv)) { bv = gs[g]; bi = g; }
      keep |= 1u << bi;
    }
    float lastv = 1e30f; int lasti = -1; float gsum = 0.f;
    for (int it = 0; it < TOP_K; ++it) {
      float bv = -1e30f; int bi = -1;
      for (int e = 0; e < N_EXPERTS; ++e) {
        if (!((keep >> (e / EPG)) & 1u)) continue;
        float v = sigmoidf_(lg[e]) + rb[e];
        if (!better(lastv, lasti, v, e)) continue;
        if (bi < 0 || better(v, e, bv, bi)) { bv = v; bi = e; }
      }
      lastv = bv; lasti = bi;
      float sc = sigmoidf_(lg[bi]); gsum += sc;
      p.top_e()[r * TOP_K + it] = bi; p.gate()[r * TOP_K + it] = sc;
      p.posb()[r * TOP_K + it] = atomicAdd(&p.cnt()[l * N_EXPERTS + bi], 1);
    }
    float inv = ROUTED_SCALE / gsum;
    for (int it = 0; it < TOP_K; ++it) p.gate()[r * TOP_K + it] *= inv;
  }
}
DEV void ph_sortrows(const P& p, int l, long gtid, long gsize) {
  FOR_ITEMS(i, (long)NR * TOP_K) {
    int e = p.top_e()[i]; int off = 0;
    for (int j = 0; j < e; ++j) off += p.cnt()[l * N_EXPERTS + j];
    p.srow()[off + p.posb()[i]] = (int)i;
  }
}
DEV void ph_expert_up(const P& p, int l, long gtid, long gsize) {
  FOR_ITEMS(i, (long)NR * TOP_K * EXPERT_FF) {
    int cidx = (int)(i % EXPERT_FF); int a = p.srow()[i / EXPERT_FF]; int e = p.top_e()[a]; long r = a / TOP_K;
    const float* xg = p.ubuf() + r * D_MODEL;
    const float* wg = p.w_exp_gate + ((long)l * N_EXPERTS + e) * D_MODEL * EXPERT_FF; const float* wu = p.w_exp_up + ((long)l * N_EXPERTS + e) * D_MODEL * EXPERT_FF;
    float g = 0.f, u = 0.f;
    for (int k = 0; k < D_MODEL; ++k) { float xv = xg[k]; g += xv * wg[(long)k * EXPERT_FF + cidx]; u += xv * wu[(long)k * EXPERT_FF + cidx]; }
    p.hbuf()[(long)a * EXPERT_FF + cidx] = siluf(g) * u;
  }
  FOR_ITEMS(i, (long)NR * SHARED_FF) {
    int cidx = (int)(i % SHARED_FF); long r = i / SHARED_FF;
    const float* xg = p.ubuf() + r * D_MODEL;
    const float* wg = p.w_sh_gate + (long)l * D_MODEL * SHARED_FF; const float* wu = p.w_sh_up + (long)l * D_MODEL * SHARED_FF;
    float g = 0.f, u = 0.f;
    for (int k = 0; k < D_MODEL; ++k) { float xv = xg[k]; g += xv * wg[(long)k * SHARED_FF + cidx]; u += xv * wu[(long)k * SHARED_FF + cidx]; }
    p.hsb()[i] = siluf(g) * u;
  }
}
DEV void ph_expert_down(const P& p, int l, long gtid, long gsize) {
  FOR_ITEMS(i, (long)NR * TOP_K * D_MODEL) {
    int d = (int)(i % D_MODEL); long a = i / D_MODEL;
    int e = p.top_e()[a]; const float* wd = p.w_exp_down + ((long)l * N_EXPERTS + e) * EXPERT_FF * D_MODEL;
    const float* h = p.hbuf() + a * EXPERT_FF; float acc = 0.f;
    for (int cidx = 0; cidx < EXPERT_FF; ++cidx) acc += h[cidx] * wd[(long)cidx * D_MODEL + d];
    p.yk()[i] = acc * p.gate()[a];
  }
  FOR_ITEMS(i, (long)NR * D_MODEL) {
    int d = (int)(i % D_MODEL); long r = i / D_MODEL;
    const float* wsd = p.w_sh_down + (long)l * SHARED_FF * D_MODEL; const float* hs = p.hsb() + r * SHARED_FF;
    float acc = 0.f;
    for (int cidx = 0; cidx < SHARED_FF; ++cidx) acc += hs[cidx] * wsd[(long)cidx * D_MODEL + d];
    p.ysh()[i] = acc;
  }
}
DEV void ph_combine(const P& p, int l, long gtid, long gsize) {
#pragma unroll 1
  FOR_ITEMS(i, (long)NR * D_MODEL) {
    int d = (int)(i % D_MODEL); long r = i / D_MODEL;
    float f = p.ysh()[i];
#pragma unroll
    for (int k = 0; k < TOP_K; ++k) f += p.yk()[(r * TOP_K + k) * D_MODEL + d];
    const float* m = p.mod() + ((long)l * (BATCH + 1) + modrow(r)) * 6 * D_MODEL + 5 * D_MODEL;
    p.tmp()[i] = DN_ALPHA * p.xcur()[i] + m[d] * f;
  }
}
#define NLP 16


#ifndef CPU_TEST
typedef __attribute__((ext_vector_type(8))) short bf16x8;
typedef __attribute__((ext_vector_type(4))) float f32x4;
typedef __attribute__((ext_vector_type(4))) unsigned u32x4;
typedef __attribute__((ext_vector_type(2))) unsigned u32x2;
static_assert(N_EXPERTS == 256 && D_MODEL % 128 == 0 && NR % 128 == 0, "shape assumptions");
#define SM_XB 0
#define NT 512
#define SM_A 256
#define SM_B (256 + 16384)
#define SM_MISC (256 + 98304)
#define SMEM_BYTES (256 + 98304 + 4096)

DEV int otid() { int t = threadIdx.x; asm volatile("" : "+v"(t)); return t; }
typedef __bf16 bf16x2_t __attribute__((ext_vector_type(2)));
typedef float f32x2_t __attribute__((ext_vector_type(2)));
DEV unsigned pack2(float a, float b) { f32x2_t v = {a, b}; return __builtin_bit_cast(unsigned, __builtin_convertvector(v, bf16x2_t)); }
DEV unsigned f2bf(float f) { return pack2(f, 0.f) & 0xffffu; }
DEV int tile_off(int row, int chunk) { return row * 128 + ((chunk ^ ((row >> 1) & 7)) << 4); }

DEV float bflo(float x) { return x - __uint_as_float(f2bf(x) << 16); }
DEV void wt_convert(const float* W, unsigned short* WT, int K, int N, bool lo, long gtid, long gsize) {
  FOR_ITEMS4(i, (long)N * (K / 8)) {
    const int n = (int)(i % N); const int k8 = (int)(i / N) * 8;
    float v[8];
#pragma unroll
    for (int j = 0; j < 8; ++j) { const float x = W[(long)(k8 + j) * N + n]; v[j] = lo ? bflo(x) : x; }
    u32x4 o; o[0] = pack2(v[0], v[1]); o[1] = pack2(v[2], v[3]); o[2] = pack2(v[4], v[5]); o[3] = pack2(v[6], v[7]);
    *(u32x4*)(WT + (long)n * K + k8) = o;
  }
}
DEV void wt_convert_all(const P& p, long gtid, long gsize) {
  for (int l = 0; l < DEPTH; ++l) {
    wt_convert(p.w_in + (long)l * D_MODEL * IN_W, p.wt_in() + (long)l * IN_W * D_MODEL, D_MODEL, IN_W, false, gtid, gsize);
    wt_convert(p.w_out + (long)l * MIX_W * D_MODEL, p.wt_out() + (long)l * D_MODEL * MIX_W, MIX_W, D_MODEL, false, gtid, gsize);
    wt_convert(p.s5_w_glu + (long)l * S5_W * S5_W, p.wt_glu() + (long)l * S5_W * S5_W, S5_W, S5_W, false, gtid, gsize);
    wt_convert(p.w_sh_gate + (long)l * D_MODEL * SHARED_FF, p.wt_shg() + (long)l * SHARED_FF * D_MODEL, D_MODEL, SHARED_FF, false, gtid, gsize);
    wt_convert(p.w_sh_up + (long)l * D_MODEL * SHARED_FF, p.wt_shu() + (long)l * SHARED_FF * D_MODEL, D_MODEL, SHARED_FF, false, gtid, gsize);
    wt_convert(p.w_sh_down + (long)l * SHARED_FF * D_MODEL, p.wt_shd() + (long)l * D_MODEL * SHARED_FF, SHARED_FF, D_MODEL, false, gtid, gsize);
    wt_convert(p.w_router + (long)l * D_MODEL * N_EXPERTS, p.wt_rh() + (long)l * N_EXPERTS * D_MODEL, D_MODEL, N_EXPERTS, false, gtid, gsize);
    wt_convert(p.w_router + (long)l * D_MODEL * N_EXPERTS, p.wt_rl() + (long)l * N_EXPERTS * D_MODEL, D_MODEL, N_EXPERTS, true, gtid, gsize);
  }
}
struct ALRows { const char* base; unsigned off[2]; DEVM const unsigned short* a(int i, int kt) const { return (const unsigned short*)(base + (off[i] + (unsigned)kt * 128u)); } };
struct BLStd { static constexpr bool TR = false; const char* base; unsigned voff; int ldb4; bool valid;
  DEVM void load(float4 (&rb)[8], int kt) const {
#pragma unroll
    for (int i = 0; i < 8; ++i) rb[i] = valid ? *(const float4*)(base + (unsigned)((unsigned)(kt * 64 + i) * (unsigned)ldb4 + voff)) : make_float4(0.f, 0.f, 0.f, 0.f); } };
DEV unsigned bl_voff(int ldb4, int tid) { return (unsigned)((tid & 7) * 8) * (unsigned)ldb4 + (unsigned)((tid >> 3) * 16); }
DEV BLStd mk_bl(const float* B  , int ldb, int tid) {
  BLStd b; b.base = (const char*)B; b.ldb4 = ldb * 4; b.voff = bl_voff(ldb * 4, tid); b.valid = true; return b; }
#define SM_TILE 49152
template <int V = 0, class AL, class BL>
DEV void gemm_t(const AL& al, const BL& bl, int nk, f32x4 (&acc)[4][4], char* smem) {
  const int tid = otid(), lane = tid & 63, wid = tid >> 6, wr = wid >> 2, wc = wid & 3;
  const int l15 = lane & 15, q = lane >> 4, x = l15 >> 1;
  const char* ard0 = smem + SM_A + (wr * 64 + l15) * 128 + ((q ^ x) << 4);
  const char* ard1 = smem + SM_A + (wr * 64 + l15) * 128 + (((4 + q) ^ x) << 4);
  const char* brd0 = smem + SM_B + (wc * 64 + l15) * 128 + ((q ^ x) << 4);
  const char* brd1 = smem + SM_B + (wc * 64 + l15) * 128 + (((4 + q) ^ x) << 4);
  const int kq = tid & 7, nq = tid >> 3;
  char* awr = smem + SM_A + nq * 128 + ((kq ^ ((nq >> 1) & 7)) << 4);
  char* bwr0 = smem + SM_B + (nq * 4) * 128 + ((kq ^ ((2 * nq) & 7)) << 4);
  char* bwr1 = smem + SM_B + (nq * 4 + 2) * 128 + ((kq ^ ((2 * nq + 1) & 7)) << 4);
  if (nk <= 0) return;
  u32x4 ra[2]; float4 rb0[8];
#define GEMM_LOADA(KT) do { _Pragma("unroll") for (int i = 0; i < 2; ++i) ra[i] = *(const u32x4*)(al.a(i, (KT))); } while (0)
#define GEMM_WRITE(rb, PO) do { \
    *(u32x4*)(awr + (PO)) = ra[0]; *(u32x4*)(awr + (PO) + 8192) = ra[1]; \
    if (BL::TR) { u32x4 v; \
      v[0] = pack2(rb[0].x, rb[0].y); v[1] = pack2(rb[0].z, rb[0].w); v[2] = pack2(rb[1].x, rb[1].y); v[3] = pack2(rb[1].z, rb[1].w); *(u32x4*)(bwr0 + (PO)) = v; \
      v[0] = pack2(rb[2].x, rb[2].y); v[1] = pack2(rb[2].z, rb[2].w); v[2] = pack2(rb[3].x, rb[3].y); v[3] = pack2(rb[3].z, rb[3].w); *(u32x4*)(bwr0 + (PO) + 128) = v; \
      v[0] = pack2(rb[4].x, rb[4].y); v[1] = pack2(rb[4].z, rb[4].w); v[2] = pack2(rb[5].x, rb[5].y); v[3] = pack2(rb[5].z, rb[5].w); *(u32x4*)(bwr1 + (PO)) = v; \
      v[0] = pack2(rb[6].x, rb[6].y); v[1] = pack2(rb[6].z, rb[6].w); v[2] = pack2(rb[7].x, rb[7].y); v[3] = pack2(rb[7].z, rb[7].w); *(u32x4*)(bwr1 + (PO) + 128) = v; \
    } else { u32x4 v; \
      v[0] = pack2(rb[0].x, rb[1].x); v[1] = pack2(rb[2].x, rb[3].x); v[2] = pack2(rb[4].x, rb[5].x); v[3] = pack2(rb[6].x, rb[7].x); *(u32x4*)(bwr0 + (PO)) = v; \
      v[0] = pack2(rb[0].y, rb[1].y); v[1] = pack2(rb[2].y, rb[3].y); v[2] = pack2(rb[4].y, rb[5].y); v[3] = pack2(rb[6].y, rb[7].y); *(u32x4*)(bwr0 + (PO) + 128) = v; \
      v[0] = pack2(rb[0].z, rb[1].z); v[1] = pack2(rb[2].z, rb[3].z); v[2] = pack2(rb[4].z, rb[5].z); v[3] = pack2(rb[6].z, rb[7].z); *(u32x4*)(bwr1 + (PO)) = v; \
      v[0] = pack2(rb[0].w, rb[1].w); v[1] = pack2(rb[2].w, rb[3].w); v[2] = pack2(rb[4].w, rb[5].w); v[3] = pack2(rb[6].w, rb[7].w); *(u32x4*)(bwr1 + (PO) + 128) = v; \
    } } while (0)
  GEMM_LOADA(0);
  bl.load(rb0, 0);
  __syncthreads();
  GEMM_WRITE(rb0, 0);
  if (V != 3) { if (nk > 1) { GEMM_LOADA(1); bl.load(rb0, 1); } }
  __syncthreads();
#define GEMM_STEP(rbn, KT) do { \
    const int po = ((KT) & 1) * SM_TILE; \
    bf16x8 fa0[4], fb0[4], fa1[4], fb1[4]; \
    _Pragma("unroll") for (int n = 0; n < 4; ++n) fb0[n] = *(const bf16x8*)(brd0 + po + n * 2048); \
    _Pragma("unroll") for (int m = 0; m < 4; ++m) fa0[m] = *(const bf16x8*)(ard0 + po + m * 2048); \
    _Pragma("unroll") for (int n = 0; n < 4; ++n) fb1[n] = *(const bf16x8*)(brd1 + po + n * 2048); \
    _Pragma("unroll") for (int m = 0; m < 4; ++m) fa1[m] = *(const bf16x8*)(ard1 + po + m * 2048); \
    __builtin_amdgcn_sched_barrier(0);     \
    if ((KT) + 1 < nk) { \
      GEMM_WRITE(rbn, SM_TILE - po); \
      if (V != 3) { if ((KT) + 2 < nk) { GEMM_LOADA((KT) + 2); bl.load(rbn, (KT) + 2); } } \
    } \
    __builtin_amdgcn_sched_barrier(0); \
    if (V != 2) { \
      _Pragma("unroll") for (int m = 0; m < 4; ++m) _Pragma("unroll") for (int n = 0; n < 4; ++n) acc[m][n] = __builtin_amdgcn_mfma_f32_16x16x32_bf16(fa0[m], fb0[n], acc[m][n], 0, 0, 0); \
      _Pragma("unroll") for (int m = 0; m < 4; ++m) _Pragma("unroll") for (int n = 0; n < 4; ++n) acc[m][n] = __builtin_amdgcn_mfma_f32_16x16x32_bf16(fa1[m], fb1[n], acc[m][n], 0, 0, 0); \
    } else { _Pragma("unroll") for (int m = 0; m < 4; ++m) asm volatile("" :: "v"(fa0[m]), "v"(fb0[m]), "v"(fa1[m]), "v"(fb1[m])); } \
    __syncthreads(); \
  } while (0)
  int kt = 0;
#pragma unroll 1
  for (; kt < nk; ++kt) { GEMM_STEP(rb0, kt); }
#undef GEMM_STEP
#undef GEMM_WRITE
#undef GEMM_LOADA
}

struct BLT { const char* base; unsigned voff; unsigned rowb;
  DEVM void load(u32x4 (&rb)[4], int kt) const {
#pragma unroll
    for (int c = 0; c < 4; ++c) rb[c] = *(const u32x4*)(base + (voff + (unsigned)c * rowb + (unsigned)kt * 128u)); } };
DEV BLT mk_blt(const unsigned short* BT  , int K, int tid) {
  BLT b; b.base = (const char*)BT; b.rowb = (unsigned)K * 2u; b.voff = (unsigned)((tid >> 3) * 4) * b.rowb + (unsigned)((tid & 7) * 16); return b; }
template <class AL, class BL>
DEV void gemm_tb(const AL& al, const BL& bl, int nk, f32x4 (&acc)[4][4], char* smem) {
  const int tid = otid(), lane = tid & 63, wid = tid >> 6, wr = wid >> 2, wc = wid & 3;
  const int l15 = lane & 15, q = lane >> 4, x = l15 >> 1;
  const char* ard0 = smem + SM_A + (wr * 64 + l15) * 128 + ((q ^ x) << 4);
  const char* ard1 = smem + SM_A + (wr * 64 + l15) * 128 + (((4 + q) ^ x) << 4);
  const char* brd0 = smem + SM_B + (wc * 64 + l15) * 128 + ((q ^ x) << 4);
  const char* brd1 = smem + SM_B + (wc * 64 + l15) * 128 + (((4 + q) ^ x) << 4);
  const int kq = tid & 7, nq = tid >> 3;
  char* awr = smem + SM_A + nq * 128 + ((kq ^ ((nq >> 1) & 7)) << 4);
  char* bwr0 = smem + SM_B + (nq * 4) * 128 + ((kq ^ ((2 * nq) & 7)) << 4);
  char* bwr1 = smem + SM_B + (nq * 4 + 2) * 128 + ((kq ^ ((2 * nq + 1) & 7)) << 4);
  if (nk <= 0) return;
  u32x4 ra[2]; u32x4 rb0[4], rb1[4];
#define TB_LOADA(KT) do { _Pragma("unroll") for (int i = 0; i < 2; ++i) ra[i] = *(const u32x4*)(al.a(i, (KT))); } while (0)
#define TB_WRITE(rb, PO) do { \
    *(u32x4*)(awr + (PO)) = ra[0]; *(u32x4*)(awr + (PO) + 8192) = ra[1]; \
    *(u32x4*)(bwr0 + (PO)) = rb[0]; *(u32x4*)(bwr0 + (PO) + 128) = rb[1]; *(u32x4*)(bwr1 + (PO)) = rb[2]; *(u32x4*)(bwr1 + (PO) + 128) = rb[3]; } while (0)
  TB_LOADA(0);
  bl.load(rb0, 0);
  if (nk > 1) bl.load(rb1, 1);
  __syncthreads();
  TB_WRITE(rb0, 0);
  if (nk > 1) TB_LOADA(1);
  if (nk > 2) bl.load(rb0, 2);
  __syncthreads();
#define TB_STEP(rbn, KT) do { \
    const int po = ((KT) & 1) * SM_TILE; \
    bf16x8 fa0[4], fb0[4], fa1[4], fb1[4]; \
    _Pragma("unroll") for (int n = 0; n < 4; ++n) fb0[n] = *(const bf16x8*)(brd0 + po + n * 2048); \
    _Pragma("unroll") for (int m = 0; m < 4; ++m) fa0[m] = *(const bf16x8*)(ard0 + po + m * 2048); \
    _Pragma("unroll") for (int n = 0; n < 4; ++n) fb1[n] = *(const bf16x8*)(brd1 + po + n * 2048); \
    _Pragma("unroll") for (int m = 0; m < 4; ++m) fa1[m] = *(const bf16x8*)(ard1 + po + m * 2048); \
    __builtin_amdgcn_sched_barrier(0); \
    if ((KT) + 1 < nk) { \
      TB_WRITE(rbn, SM_TILE - po); \
      if ((KT) + 2 < nk) TB_LOADA((KT) + 2); \
      if ((KT) + 3 < nk) bl.load(rbn, (KT) + 3); \
    } \
    __builtin_amdgcn_sched_barrier(0); \
    _Pragma("unroll") for (int m = 0; m < 4; ++m) _Pragma("unroll") for (int n = 0; n < 4; ++n) acc[m][n] = __builtin_amdgcn_mfma_f32_16x16x32_bf16(fa0[m], fb0[n], acc[m][n], 0, 0, 0); \
    _Pragma("unroll") for (int m = 0; m < 4; ++m) _Pragma("unroll") for (int n = 0; n < 4; ++n) acc[m][n] = __builtin_amdgcn_mfma_f32_16x16x32_bf16(fa1[m], fb1[n], acc[m][n], 0, 0, 0); \
    __syncthreads(); \
  } while (0)
  int kt = 0;
#pragma unroll 1
  for (; kt + 1 < nk; kt += 2) { TB_STEP(rb1, kt); TB_STEP(rb0, kt + 1); }
  if (kt < nk) TB_STEP(rb1, kt);
#undef TB_STEP
#undef TB_WRITE
#undef TB_LOADA
}
DEV void acc_zero(f32x4 (&acc)[4][4]) {
#pragma unroll
  for (int m = 0; m < 4; ++m)
#pragma unroll
    for (int n = 0; n < 4; ++n) acc[m][n] = (f32x4){0.f, 0.f, 0.f, 0.f};
}
#define EPI_BEGIN const int etid = otid();
#define EPI_ROW(m, j) (((etid >> 8) & 1) * 64 + (m) * 16 + ((etid & 63) >> 4) * 4 + (j))
#define EPI_COL(n) (((etid >> 6) & 3) * 64 + (n) * 16 + (etid & 15))

template <class Epi>
DEV void gemm_phase_dense(const unsigned short* A, int lda, const unsigned short* BT, int N, int K, Epi epi, char* smem) {
  const int tid = otid(); const int nct = N >> 8; const int nitems = (NR >> 7) * nct;
  for (int it = blockIdx.x; it < nitems; it += gridDim.x) {
    const int rt = it / nct, ct = it - rt * nct;
    ALRows al; al.base = (const char*)(A + (long)rt * 128 * lda);
#pragma unroll
    for (int i = 0; i < 2; ++i) al.off[i] = (unsigned)(((tid >> 3) + 64 * i) * lda + (tid & 7) * 8) * 2u;
    const BLT bl = mk_blt(BT + (long)ct * 256 * K, K, tid);
    f32x4 acc[4][4]; acc_zero(acc);
    gemm_tb(al, bl, K >> 6, acc, smem);
    EPI_BEGIN
#pragma unroll
    for (int m = 0; m < 4; ++m)
#pragma unroll
      for (int n = 0; n < 4; ++n)
#pragma unroll
        for (int j = 0; j < 4; ++j) epi((long)rt * 128 + EPI_ROW(m, j), ct * 256 + EPI_COL(n), acc[m][n][j]);
  }
}
DEV void ph_proj_mfma(const P& p, int l, char* smem) {
  const int tid = otid(); const int nct = IN_W >> 8; const int nitems = (NR >> 7) * nct;
  const float* B = p.w_in + (long)l * D_MODEL * IN_W;
  for (int it = blockIdx.x; it < nitems; it += gridDim.x) {
    const int rt = it / nct, ct = it - rt * nct;
    ALRows al; al.base = (const char*)(p.ubf() + (long)rt * 128 * D_MODEL);
#pragma unroll
    for (int i = 0; i < 2; ++i) al.off[i] = (unsigned)(((tid >> 3) + 64 * i) * D_MODEL + (tid & 7) * 8) * 2u;
    const BLT bl = mk_blt(p.wt_in() + ((long)l * IN_W + ct * 256) * D_MODEL, D_MODEL, tid);
    f32x4 acc[4][4]; acc_zero(acc);
    gemm_tb(al, bl, D_MODEL >> 6, acc, smem);
    EPI_BEGIN
    if (ct >= HY_OFF / 256 && ct < S5_OFF / 256) {
      const bool isctx = rt >= NL / 128;
      const int rloc = (isctx ? (rt - NL / 128) : rt) * 128;
      const int Ls = isctx ? CTX_LEN : SEQ; const int b = rloc / Ls; const int t0 = rloc - b * Ls;
      float* zb = p.zT() + (isctx ? (size_t)BATCH * 3 * HYENA_W * SEQ : (size_t)0) + (size_t)b * 3 * HYENA_W * Ls;
#pragma unroll
      for (int m = 0; m < 4; ++m)
#pragma unroll
        for (int n = 0; n < 4; ++n) {
          const int c = ct * 256 + EPI_COL(n) - HY_OFF; const int t = t0 + EPI_ROW(m, 0);
          *(float4*)(zb + (size_t)c * Ls + t) = make_float4(acc[m][n][0], acc[m][n][1], acc[m][n][2], acc[m][n][3]);
        }
    } else if (ct == S5_OFF / 256) {
#pragma unroll
      for (int m = 0; m < 4; ++m)
#pragma unroll
        for (int n = 0; n < 4; ++n)
#pragma unroll
          for (int j = 0; j < 4; ++j) p.s5u()[((long)rt * 128 + EPI_ROW(m, j)) * S5_W + EPI_COL(n)] = (unsigned short)f2bf(acc[m][n][j]);
    } else {
      const int head = ct * 4 + ((etid >> 6) & 3);
      const bool isq = head < N_Q_HEADS, dorope = head < N_Q_HEADS + N_KV_HEADS && rt < NL / 128;
      const float qs = isq ? 0.125f * 1.4426950408889634f : 1.0f;
      const int c16 = etid & 15;
#pragma unroll
      for (int m = 0; m < 4; ++m)
#pragma unroll
        for (int j = 0; j < 4; ++j) {
          const long row = (long)rt * 128 + EPI_ROW(m, j);
          float v0 = acc[m][0][j], v1 = acc[m][1][j], v2 = acc[m][2][j], v3 = acc[m][3][j];
          if (dorope) {
            const int t = (int)(row % SEQ);
            const float2 cr = p.ropet()[(t / GRID_W) * ROPE_HALF + c16], cc = p.ropet()[(t % GRID_W) * ROPE_HALF + c16];
            const float a0 = v0 * cr.x - v1 * cr.y, a1 = v0 * cr.y + v1 * cr.x, a2 = v2 * cc.x - v3 * cc.y, a3 = v2 * cc.y + v3 * cc.x;
            v0 = a0; v1 = a1; v2 = a2; v3 = a3;
          }
          unsigned short* dst = p.qkvb() + row * HY_OFF + head * HEAD_DIM + c16;
          dst[0] = (unsigned short)f2bf(v0 * qs); dst[16] = (unsigned short)f2bf(v1 * qs); dst[32] = (unsigned short)f2bf(v2 * qs); dst[48] = (unsigned short)f2bf(v3 * qs);
        }
    }
  }
}
DEV void ph_hyena_pre_gpu(const P& p, int l, long gtid, long gsize) {
  const float* sw = p.hy_short_w + l * 3 * 3 * HYENA_W; const float* sb = p.hy_short_b + l * 3 * HYENA_W;
  FOR_ITEMS4(i, (long)BATCH * HYENA_W * (SEQ + CTX_LEN)) {
    const bool isctx = i >= (long)BATCH * HYENA_W * SEQ; const long ii = isctx ? i - (long)BATCH * HYENA_W * SEQ : i;
    const int Ls = isctx ? CTX_LEN : SEQ; const int t = (int)(ii % Ls); const int ch = (int)((ii / Ls) % HYENA_W); const int b = (int)(ii / ((long)Ls * HYENA_W));
    const float* zb = p.zT() + (isctx ? (size_t)BATCH * 3 * HYENA_W * SEQ : (size_t)0) + (size_t)b * 3 * HYENA_W * Ls;
    float z[3];
#pragma unroll
    for (int part = 0; part < 3; ++part) {
      const int cc = part * HYENA_W + ch; const float* zr = zb + (size_t)cc * Ls; float acc = sb[cc];
      if (t > 0) acc += zr[t - 1] * sw[cc];
      acc += zr[t] * sw[3 * HYENA_W + cc];
      if (t + 1 < Ls) acc += zr[t + 1] * sw[2 * 3 * HYENA_W + cc];
      z[part] = acc;
    }
    const long o = isctx ? ((long)NL + b * CTX_LEN + t) * HYENA_W + ch : ((long)b * HYENA_W + ch) * SEQ + t;
    p.hu()[o] = z[0] * z[1]; p.hx0()[o] = z[2];
  }
}
DEV void rms_rows(const P& p, int l, long r0, long r1, int w0, int nw);
DEV void ph_glu_mfma(const P& p, int l, char* smem) {
  const int tid = otid();
  for (int rt = blockIdx.x; rt < (NR >> 7); rt += gridDim.x) {
    ALRows al; al.base = (const char*)(p.ybf() + (long)rt * 128 * S5_W);
#pragma unroll
    for (int i = 0; i < 2; ++i) al.off[i] = (unsigned)(((tid >> 3) + 64 * i) * S5_W + (tid & 7) * 8) * 2u;
    const BLT bl = mk_blt(p.wt_glu() + (long)l * S5_W * S5_W, S5_W, tid);
    f32x4 acc[4][4]; acc_zero(acc);
    gemm_tb(al, bl, S5_W >> 6, acc, smem);
    EPI_BEGIN
#pragma unroll
    for (int m = 0; m < 4; ++m)
#pragma unroll
      for (int n = 0; n < 4; ++n)
#pragma unroll
        for (int j = 0; j < 4; ++j) {
          const long r = (long)rt * 128 + EPI_ROW(m, j); const int c = EPI_COL(n);
          p.mixb()[r * MIX_W + ATTN_W + HYENA_W + c] = __uint_as_float((unsigned)p.ybf()[r * S5_W + c] << 16) * sigmoidf_(acc[m][n][j]);
        }
    asm volatile("s_waitcnt vmcnt(0)" ::: "memory");
    __syncthreads();
    rms_rows(p, l, (long)rt * 128, (long)rt * 128 + 128, otid() >> 6, NT / 64);
  }
}
DEV void ph_outproj_mfma(const P& p, int l, char* smem) {
  EpiRes e{p.xcur(), p.mod(), l, 2 * D_MODEL, p.tmp()};
  gemm_phase_dense(p.mixbf(), MIX_W, p.wt_out() + (long)l * D_MODEL * MIX_W, D_MODEL, MIX_W, e, smem);
}

struct ALRows4 { const char* base; unsigned off[4]; DEVM const unsigned short* a(int i, int kt) const { return (const unsigned short*)(base + (off[i] + (unsigned)kt * 128u)); } };
struct BLStd4 { const char* base; unsigned voff; int ldb4;
  DEVM void load(float4 (&rb)[4], int kt) const {
    unsigned vo = voff; asm volatile("" : "+v"(vo));
#pragma unroll
    for (int i = 0; i < 4; ++i) rb[i] = *(const float4*)(base + (unsigned)((unsigned)(kt * 64 + i) * (unsigned)ldb4 + vo)); } };
#define SM_B2 (SM_A + 32768)
template <class AL, class BL>
DEV void gemm_m2(const AL& al, const BL& bl, int nk, f32x4 (&acc)[4][4], char* smem) {
  const int tid = otid(), lane = tid & 63, wid = tid >> 6, wr = wid >> 1, wc = wid & 1;
  const int l15 = lane & 15, q = lane >> 4, x = l15 >> 1;
  const char* ard0 = smem + SM_A + (wr * 64 + l15) * 128 + ((q ^ x) << 4);
  const char* ard1 = smem + SM_A + (wr * 64 + l15) * 128 + (((4 + q) ^ x) << 4);
  const char* brd0 = smem + SM_B2 + (wc * 64 + l15) * 128 + ((q ^ x) << 4);
  const char* brd1 = smem + SM_B2 + (wc * 64 + l15) * 128 + (((4 + q) ^ x) << 4);
  const int kq = tid & 7, ar = tid >> 3, nq = (tid >> 3) & 31, kh = tid >> 8;
  char* awr = smem + SM_A + ar * 128 + ((kq ^ ((ar >> 1) & 7)) << 4);
  char* bwr0 = smem + SM_B2 + (nq * 4) * 128 + ((kq ^ ((2 * nq) & 7)) << 4) + kh * 8;
  char* bwr1 = smem + SM_B2 + (nq * 4 + 2) * 128 + ((kq ^ ((2 * nq + 1) & 7)) << 4) + kh * 8;
  if (nk <= 0) return;
  u32x4 ra[4]; float4 rb0[4], rb1[4];
#define M2_LOADA(KT) do { _Pragma("unroll") for (int i = 0; i < 4; ++i) ra[i] = *(const u32x4*)(al.a(i, (KT))); } while (0)
#define M2_WRITE(rb, PO) do { \
    _Pragma("unroll") for (int i = 0; i < 4; ++i) *(u32x4*)(awr + (PO) + 8192 * i) = ra[i]; \
    { u32x2 v; \
      v[0] = pack2(rb[0].x, rb[1].x); v[1] = pack2(rb[2].x, rb[3].x); *(u32x2*)(bwr0 + (PO)) = v; \
      v[0] = pack2(rb[0].y, rb[1].y); v[1] = pack2(rb[2].y, rb[3].y); *(u32x2*)(bwr0 + (PO) + 128) = v; \
      v[0] = pack2(rb[0].z, rb[1].z); v[1] = pack2(rb[2].z, rb[3].z); *(u32x2*)(bwr1 + (PO)) = v; \
      v[0] = pack2(rb[0].w, rb[1].w); v[1] = pack2(rb[2].w, rb[3].w); *(u32x2*)(bwr1 + (PO) + 128) = v; } } while (0)
  M2_LOADA(0);
  bl.load(rb0, 0);
  if (nk > 1) bl.load(rb1, 1);
  __syncthreads();
  M2_WRITE(rb0, 0);
  if (nk > 1) M2_LOADA(1);
  if (nk > 2) bl.load(rb0, 2);
  __syncthreads();
#define M2_STEP(rbn, KT) do { \
    const int po = ((KT) & 1) * SM_TILE; \
    bf16x8 fa0[4], fb0[4], fa1[4], fb1[4]; \
    _Pragma("unroll") for (int n = 0; n < 4; ++n) fb0[n] = *(const bf16x8*)(brd0 + po + n * 2048); \
    _Pragma("unroll") for (int m = 0; m < 4; ++m) fa0[m] = *(const bf16x8*)(ard0 + po + m * 2048); \
    _Pragma("unroll") for (int n = 0; n < 4; ++n) fb1[n] = *(const bf16x8*)(brd1 + po + n * 2048); \
    _Pragma("unroll") for (int m = 0; m < 4; ++m) fa1[m] = *(const bf16x8*)(ard1 + po + m * 2048); \
    __builtin_amdgcn_sched_barrier(0); \
    if ((KT) + 1 < nk) { \
      M2_WRITE(rbn, SM_TILE - po); \
      if ((KT) + 2 < nk) M2_LOADA((KT) + 2); \
      if ((KT) + 3 < nk) bl.load(rbn, (KT) + 3); \
    } \
    __builtin_amdgcn_sched_barrier(0); \
    _Pragma("unroll") for (int m = 0; m < 4; ++m) _Pragma("unroll") for (int n = 0; n < 4; ++n) acc[m][n] = __builtin_amdgcn_mfma_f32_16x16x32_bf16(fa0[m], fb0[n], acc[m][n], 0, 0, 0); \
    _Pragma("unroll") for (int m = 0; m < 4; ++m) _Pragma("unroll") for (int n = 0; n < 4; ++n) acc[m][n] = __builtin_amdgcn_mfma_f32_16x16x32_bf16(fa1[m], fb1[n], acc[m][n], 0, 0, 0); \
    __syncthreads(); \
  } while (0)
  int kt = 0;
#pragma unroll 1
  for (; kt + 1 < nk; kt += 2) { M2_STEP(rb1, kt); M2_STEP(rb0, kt + 1); }
  if (kt < nk) M2_STEP(rb1, kt);
#undef M2_STEP
#undef M2_WRITE
#undef M2_LOADA
}
#define EPI2_ROW(m, j) (((etid >> 7) & 3) * 64 + (m) * 16 + ((etid & 63) >> 4) * 4 + (j))
#define EPI2_COL(n) (((etid >> 6) & 1) * 64 + (n) * 16 + (etid & 15))
DEV void exp_prefix(const P& p, int l, int* toff, int* roff, int* rowo) {
  const int tid = otid(), lane = tid & 63, w = tid >> 6;
  __syncthreads();
  int c = 0, tl = 0, incl = 0, rinc = 0;
  int* wsum = roff + N_EXPERTS + 8;
  if (tid < N_EXPERTS) {
    c = p.cnt()[l * N_EXPERTS + tid];
    tl = (c + 255) >> 8; incl = tl; rinc = c;
#pragma unroll
    for (int o = 1; o < 64; o <<= 1) { const int v = __shfl_up(incl, o), v2 = __shfl_up(rinc, o); if (lane >= o) { incl += v; rinc += v2; } }
    if (lane == 63) { wsum[w] = incl; wsum[4 + w] = rinc; }
    roff[tid] = c;
  }
  __syncthreads();
  if (tid < N_EXPERTS) {
    int base = 0, rb = 0;
#pragma unroll
    for (int k = 0; k < 4; ++k) if (k < w) { base += wsum[k]; rb += wsum[4 + k]; }
    toff[tid] = base + incl - tl;
    rowo[tid] = rb + rinc - c;
    if (tid == N_EXPERTS - 1) toff[N_EXPERTS] = base + incl;
  }
  __syncthreads();
}
#define EXP_TABLES int* toff = (int*)(smem + SM_MISC); int* roff = toff + N_EXPERTS + 1; int* rowo = roff + N_EXPERTS + 16;
DEV int exp_find(const int* toff, int tile) {
  int lo = 0, hi = N_EXPERTS - 1;
  while (lo < hi) { int mid = (lo + hi + 1) >> 1; if (toff[mid] <= tile) lo = mid; else hi = mid - 1; }
  return lo;
}
template <int V = 0>
DEV void upgate_tile(const ALRows& al, const float* wg, const float* wu, int cq, f32x4 (&acc)[4][4], char* smem, int tid) {
  const int nq = tid >> 3; const int wsel = __builtin_amdgcn_readfirstlane(tid >> 6) & 1;
  BLStd bl; bl.base = (const char*)((wsel ? wu : wg) + cq * 128); bl.ldb4 = EXPERT_FF * 4; bl.valid = true;
  bl.voff = (unsigned)((tid & 7) * 8) * (unsigned)(EXPERT_FF * 4) + (unsigned)(((nq >> 4) * 32 + (nq & 7) * 4) * 4);
  acc_zero(acc);
  gemm_t<V>(al, bl, D_MODEL >> 6, acc, smem);
}
static_assert(EXPERT_FF == 256 && SHARED_FF == 256, "ff tiling");
template <int V = 0>
DEV void ph_expert_up_mfma(const P& p, int l, char* smem) {
  const int tid = otid();
  EXP_TABLES
  exp_prefix(p, l, toff, roff, rowo);
  const int n_items = toff[N_EXPERTS] * 4;
  for (int it = blockIdx.x; it < n_items; it += gridDim.x) {
    const int tile = it >> 2, cq = it & 3;
    const int e = __builtin_amdgcn_readfirstlane(exp_find(toff, tile)); const int j0 = (tile - toff[e]) * 256;
    const int nrows = min(256, roff[e] - j0), rbase = e * NR + j0, crow0 = rowo[e] + j0;
    const float* wg = p.w_exp_gate + ((long)l * N_EXPERTS + e) * D_MODEL * EXPERT_FF; const float* wu = p.w_exp_up + ((long)l * N_EXPERTS + e) * D_MODEL * EXPERT_FF;
    ALRows4 al; al.base = (const char*)p.ubf();
#pragma unroll
    for (int i = 0; i < 4; ++i) { const int rl = min((tid >> 3) + 64 * i, nrows - 1); al.off[i] = ((unsigned)(p.elist()[rbase + rl] / TOP_K) * D_MODEL + (tid & 7) * 8) * 2u; }
    const int nq = (tid >> 3) & 31; const int wsel = __builtin_amdgcn_readfirstlane(tid >> 6) & 1;
    BLStd4 bl; bl.base = (const char*)((wsel ? wu : wg) + cq * 64); bl.ldb4 = EXPERT_FF * 4;
    bl.voff = (unsigned)((tid & 7) * 8 + (tid >> 8) * 4) * (unsigned)(EXPERT_FF * 4) + (unsigned)(((nq >> 4) * 32 + (nq & 7) * 4) * 4);
    f32x4 acc[4][4]; acc_zero(acc);
    gemm_m2(al, bl, D_MODEL >> 6, acc, smem);
    EPI_BEGIN
    const int ewc = (etid >> 6) & 1, ec = etid & 15;
#pragma unroll
    for (int m = 0; m < 4; ++m)
#pragma unroll
      for (int j = 0; j < 4; ++j) {
        const int rl = EPI2_ROW(m, j);
        if (rl < nrows) {
          const float gsc = p.egate()[rbase + rl];
          unsigned short* dst = p.hbf() + (long)(crow0 + rl) * EXPERT_FF + cq * 64 + ewc * 32 + ec;
          dst[0] = (unsigned short)f2bf(siluf(acc[m][0][j]) * acc[m][2][j] * gsc); dst[16] = (unsigned short)f2bf(siluf(acc[m][1][j]) * acc[m][3][j] * gsc);
        }
      }
  }
}
DEV void ph_expert_down_mfma(const P& p, int l, char* smem) {
  const int tid = otid();
  EXP_TABLES
  exp_prefix(p, l, toff, roff, rowo);
  const int NC8 = D_MODEL / 128;
  const int n_exp_items = toff[N_EXPERTS] * NC8;
  for (int it = blockIdx.x; it < n_exp_items; it += gridDim.x) {
    const int tile = it / NC8, ct = it - tile * NC8;
    const int e = __builtin_amdgcn_readfirstlane(exp_find(toff, tile)); const int j0 = (tile - toff[e]) * 256;
    const int nrows = min(256, roff[e] - j0), crow0 = rowo[e] + j0;
    const float* wd = p.w_exp_down + ((long)l * N_EXPERTS + e) * EXPERT_FF * D_MODEL;
    ALRows4 al; al.base = (const char*)p.hbf();
#pragma unroll
    for (int i = 0; i < 4; ++i) { const int rl = min((tid >> 3) + 64 * i, nrows - 1); al.off[i] = ((unsigned)(crow0 + rl) * EXPERT_FF + (tid & 7) * 8) * 2u; }
    BLStd4 bl; bl.base = (const char*)(wd + ct * 128); bl.ldb4 = D_MODEL * 4;
    bl.voff = (unsigned)((tid & 7) * 8 + (tid >> 8) * 4) * (unsigned)(D_MODEL * 4) + (unsigned)(((tid >> 3) & 31) * 16);
    f32x4 acc[4][4]; acc_zero(acc);
    gemm_m2(al, bl, EXPERT_FF >> 6, acc, smem);
    EPI_BEGIN
#pragma unroll
    for (int m = 0; m < 4; ++m)
#pragma unroll
      for (int j = 0; j < 4; ++j) {
        const int rl = EPI2_ROW(m, j);
        if (rl < nrows) {
          unsigned short* dst = p.ykb() + (long)(crow0 + rl) * D_MODEL + ct * 128;
#pragma unroll
          for (int n = 0; n < 4; ++n) dst[EPI2_COL(n)] = (unsigned short)f2bf(acc[m][n][j]);
        }
      }
  }
  const int NCT = D_MODEL / 256;
  const int n_sh_items = (NR >> 7) * NCT;
  for (int it = (int)gridDim.x - 1 - (int)blockIdx.x; it < n_sh_items; it += gridDim.x) {
    const int rt = it / NCT, ct = it - rt * NCT;
    ALRows al; al.base = (const char*)(p.hsbf() + (long)rt * 128 * SHARED_FF);
#pragma unroll
    for (int i = 0; i < 2; ++i) al.off[i] = (unsigned)(((tid >> 3) + 64 * i) * SHARED_FF + (tid & 7) * 8) * 2u;
    const BLT bl = mk_blt(p.wt_shd() + ((long)l * D_MODEL + ct * 256) * SHARED_FF, SHARED_FF, tid);
    f32x4 acc[4][4]; acc_zero(acc);
    gemm_tb(al, bl, SHARED_FF >> 6, acc, smem);
    EPI_BEGIN
#pragma unroll
    for (int m = 0; m < 4; ++m)
#pragma unroll
      for (int n = 0; n < 4; ++n)
#pragma unroll
        for (int j = 0; j < 4; ++j) p.ysh()[((long)rt * 128 + EPI_ROW(m, j)) * D_MODEL + ct * 256 + EPI_COL(n)] = acc[m][n][j];
  }
}

typedef __attribute__((ext_vector_type(16))) float f32x16;
#define SM_HR 256
#define UB_STRIDE 8272
#define SM_HU (256 + 32768)
#define SMEM_HY (256 + 32768 + 2 * UB_STRIDE * 2)
static_assert(SEQ == 8192 && HYENA_W == 256, "hyena mfma shape");
DEV void ph_hyena_mfma(const P& p, int l, char* smem) {
  const int tid = otid(), lane = tid & 63, w = tid >> 6;
  unsigned short* R = (unsigned short*)(smem + SM_HR); unsigned short* U = (unsigned short*)(smem + SM_HU);
  for (int ch = blockIdx.x; ch < HYENA_W; ch += gridDim.x) {
    __syncthreads();
    const float* kf = p.kraw() + ((long)l * 2 * HYENA_W + ch) * SEQ; const float* kb = p.kraw() + ((long)l * 2 * HYENA_W + HYENA_W + ch) * SEQ;
    for (int y = tid; y < 2 * SEQ; y += NT) {
      const int lag = SEQ - y; float v = 0.f;
      if (lag >= 0 && lag < SEQ) v = kf[lag]; else if (lag < 0) v = kb[-lag];
      const int C = y >> 3; R[((C ^ ((C >> 4) & 1)) << 3) + (y & 7)] = (unsigned short)f2bf(v);
    }
    for (int e = tid; e < 2 * UB_STRIDE; e += NT) {
      const int b = e / UB_STRIDE, ee = e - b * UB_STRIDE, t = ee - 16; float v = 0.f;
      if (t >= 0 && t < SEQ) v = p.hu()[((long)b * HYENA_W + ch) * SEQ + t];
      U[e] = (unsigned short)f2bf(v);
    }
    __syncthreads();
    f32x16 acc[2];
#pragma unroll
    for (int mi = 0; mi < 2; ++mi)
#pragma unroll
      for (int k = 0; k < 16; ++k) acc[mi][k] = 0.f;
    const int r = lane & 31, h = lane >> 5, sig = lane & 15, bb = (lane >> 4) & 1;
    const unsigned* Ud = (const unsigned*)U + bb * (UB_STRIDE / 2);
    const int ub0 = 8 * h + sig;
    const int cbase = 1022 - 64 * (2 * w) - 2 * r + h;
    const bool odd = sig & 1;
    bf16x8 afn[2]; unsigned dn[5];
    {
#pragma unroll
      for (int mi = 0; mi < 2; ++mi) { const int C = cbase - 64 * mi; afn[mi] = *(const bf16x8*)((const char*)R + ((C ^ ((C >> 4) & 1)) << 4)); }
      const int di = ub0 >> 1;
#pragma unroll
      for (int i = 0; i < 5; ++i) dn[i] = Ud[di + i];
    }
#pragma unroll 1
    for (int q = 0; q <= SEQ / 16; ++q) {
      bf16x8 af[2]; unsigned d[5];
#pragma unroll
      for (int mi = 0; mi < 2; ++mi) af[mi] = afn[mi];
#pragma unroll
      for (int i = 0; i < 5; ++i) d[i] = dn[i];
      {
        const int qn = min(q + 1, SEQ / 16);
#pragma unroll
        for (int mi = 0; mi < 2; ++mi) { const int C = cbase - 64 * mi + 2 * qn; afn[mi] = *(const bf16x8*)((const char*)R + ((C ^ ((C >> 4) & 1)) << 4)); }
        const int di = (16 * qn + ub0) >> 1;
#pragma unroll
        for (int i = 0; i < 5; ++i) dn[i] = Ud[di + i];
      }
      u32x4 bw;
#pragma unroll
      for (int i = 0; i < 4; ++i) bw[i] = odd ? __builtin_amdgcn_alignbit(d[i + 1], d[i], 16) : d[i];
      const bf16x8 bfr = __builtin_bit_cast(bf16x8, bw);
#pragma unroll
      for (int mi = 0; mi < 2; ++mi) acc[mi] = __builtin_amdgcn_mfma_f32_32x32x16_bf16(af[mi], bfr, acc[mi], 0, 0, 0);
    }
    __syncthreads();
    {
      float* Y = (float*)(smem + SM_HR);
      float* yl = Y + bb * SEQ + 16 * (32 * (2 * w) + 4 * h) + sig;
#pragma unroll
      for (int mi = 0; mi < 2; ++mi)
#pragma unroll
        for (int k = 0; k < 16; ++k) yl[16 * (32 * mi + (k & 3) + 8 * (k >> 2))] = acc[mi][k];
    }
    __syncthreads();
    {
      const float* Y = (const float*)(smem + SM_HR);
      const float kn = p.knorm()[l * HYENA_W + ch], dsk = p.hy_d[l * HYENA_W + ch];
#pragma unroll 2
      for (int idx = tid; idx < BATCH * SEQ; idx += NT) {
        const int b = idx / SEQ, t = idx - b * SEQ;
        const long o = ((long)b * HYENA_W + ch) * SEQ + t;
        p.mixb()[(long)idx * MIX_W + ATTN_W + ch] = (Y[idx] * kn + p.hu()[o] * dsk) * p.hx0()[o];
      }
    }
  }
}
#define SM_K 256
#define SM_V (256 + 8192)
static_assert(HEAD_DIM == 64 && WINDOW == 128 && CTX_LEN == 256 && Q_GROUP == 4, "attention shape");
DEV void ph_attn_mfma(const P& p, int l, char* smem) {
  const int tid = otid(), lane = tid & 63, w = (tid >> 6) & 3, hsel = tid >> 8, h = lane >> 5, ql = lane & 31;
  char* Ks = smem + SM_K; char* Vs = smem + SM_V;
  const int n_lat = BATCH * (SEQ / 128) * N_KV_HEADS * (Q_GROUP / 2);
  const int n_ctx = (l == 0) ? BATCH * (CTX_LEN / 128) * N_KV_HEADS * (Q_GROUP / 2) : 0;
  const float QS = 0.125f * 1.4426950408889634f;
  for (int it = blockIdx.x; it < n_lat + n_ctx; it += gridDim.x) {
    const bool isctx = it >= n_lat;
    int b, qb, kvh, g;
    { int x = isctx ? it - n_lat : it; g = (x & 1) * 2 + hsel; kvh = (x >> 1) & 1; x >>= 2; if (isctx) { qb = x & 1; b = x >> 1; } else { qb = x & 63; b = x >> 6; } }
    const int hq = kvh * Q_GROUP + g;
    const int tq0 = qb * 128 + 32 * w;
    const long qrow = (isctx ? (long)NL + b * CTX_LEN : (long)b * SEQ) + tq0 + ql;
    bf16x8 qf[4];
    {
      const unsigned short* qp = p.qkvb() + qrow * HY_OFF + Q_OFF + hq * HEAD_DIM + 8 * h;
#pragma unroll
      for (int ks = 0; ks < 4; ++ks) qf[ks] = *(const bf16x8*)(qp + 16 * ks);
    }
    f32x16 o0, o1;
#pragma unroll
    for (int k = 0; k < 16; ++k) { o0[k] = 0.f; o1[k] = 0.f; }
    float m = -1e30f, lsum = 0.f;
    const int nsteps = isctx ? 4 : 10;
    u32x4 rk[1], rv[1];
    auto key_row = [&](int step, int key) -> long {
      if (step < 4) return (long)NL + b * CTX_LEN + step * 64 + key;
      const int tk = qb * 128 - 128 + (step - 4) * 64 + key;
      return (tk < 0 || tk >= SEQ) ? -1 : (long)b * SEQ + tk;
    };
    auto step_valid = [&](int step) -> bool { if (step < 4) return true; const int t0 = qb * 128 - 128 + (step - 4) * 64; return t0 >= 0 && t0 < SEQ; };
    auto load_tile = [&](int step) {
#pragma unroll
      for (int i = 0; i < 1; ++i) {
        const int key = (tid >> 3); const long kr = key_row(step, key);
        const unsigned short* kp = p.qkvb() + kr * HY_OFF + K_OFF + kvh * HEAD_DIM + (tid & 7) * 8; const unsigned short* vp = p.qkvb() + kr * HY_OFF + V_OFF + kvh * HEAD_DIM + (tid & 7) * 8;
        rk[i] = *(const u32x4*)kp; rv[i] = *(const u32x4*)vp;
      }
    };
    int step = 0;
    load_tile(0);
    while (step < nsteps) {
      __syncthreads();
#pragma unroll
      for (int i = 0; i < 1; ++i) {
        const int key = (tid >> 3), ch = tid & 7;
        *(u32x4*)(Ks + tile_off(key, ch)) = rk[i];
        *(u32x4*)(Vs + key * 128 + ((ch * 16) ^ (64 * ((key >> 1) & 1)))) = rv[i];
      }
      __syncthreads();
      const int cur = step;
      int nxt = step + 1;
      while (nxt < nsteps && !step_valid(nxt)) ++nxt;
      if (nxt < nsteps) load_tile(nxt);
      step = nxt;
#pragma unroll
      for (int sub = 0; sub < 2; ++sub) {
        const bool win = cur >= 4;
        const int ks0 = win ? qb * 128 - 128 + (cur - 4) * 64 + sub * 32 : 0;
        if (win && (ks0 > tq0 + 31 + WINDOW || ks0 + 31 < tq0 - WINDOW)) continue;
        f32x16 sacc;
#pragma unroll
        for (int k = 0; k < 16; ++k) sacc[k] = 0.f;
#pragma unroll
        for (int ks = 0; ks < 4; ++ks) {
          const bf16x8 kf = *(const bf16x8*)(Ks + tile_off(sub * 32 + ql, 2 * ks + h));
          sacc = __builtin_amdgcn_mfma_f32_32x32x16_bf16(kf, qf[ks], sacc, 0, 0, 0);
        }
        if (win && (ks0 + 31 - tq0 > WINDOW || tq0 + 31 - ks0 > WINDOW)) {
          const int tq = tq0 + ql;
#pragma unroll
          for (int k = 0; k < 16; ++k) { const int d = ks0 + (k & 3) + 8 * (k >> 2) + 4 * h - tq; if (d > WINDOW || d < -WINDOW) sacc[k] = -1e30f; }
        }
        float mx = sacc[0];
#pragma unroll
        for (int k = 1; k < 16; ++k) mx = fmaxf(mx, sacc[k]);
        mx = fmaxf(mx, __shfl_xor(mx, 32));
        const float mn = fmaxf(m, mx); const float alpha = __builtin_amdgcn_exp2f(m - mn); m = mn;
        float ps = 0.f;
#pragma unroll
        for (int k = 0; k < 16; ++k) { sacc[k] = __builtin_amdgcn_exp2f(sacc[k] - mn); ps += sacc[k]; }
        lsum = lsum * alpha + ps;
#pragma unroll
        for (int k = 0; k < 16; ++k) { o0[k] *= alpha; o1[k] *= alpha; }
        u32x2 v00, v01, v02, v03, v10, v11, v12, v13;
        {
          const int q4 = (lane & 15) >> 2, p4 = lane & 3, blk = (lane >> 4) & 1, sq = (q4 >> 1) & 1;
          const unsigned lb = (unsigned)(size_t)((__attribute__((address_space(3))) char*)Vs) + (unsigned)((sub * 32 + 4 * h + q4) * 128 + 32 * blk + 8 * p4);
          const unsigned base0 = lb + 64 * sq, base1 = lb + 64 * (1 - sq);
          asm volatile(
              "ds_read_b64_tr_b16 %0, %8\n\t"
              "ds_read_b64_tr_b16 %1, %8 offset:1024\n\t"
              "ds_read_b64_tr_b16 %2, %8 offset:2048\n\t"
              "ds_read_b64_tr_b16 %3, %8 offset:3072\n\t"
              "ds_read_b64_tr_b16 %4, %9\n\t"
              "ds_read_b64_tr_b16 %5, %9 offset:1024\n\t"
              "ds_read_b64_tr_b16 %6, %9 offset:2048\n\t"
              "ds_read_b64_tr_b16 %7, %9 offset:3072\n\t"
              "s_waitcnt lgkmcnt(0)"
              : "=&v"(v00), "=&v"(v01), "=&v"(v02), "=&v"(v03), "=&v"(v10), "=&v"(v11), "=&v"(v12), "=&v"(v13)
              : "v"(base0), "v"(base1) : "memory");
        }
#pragma unroll
        for (int ks2 = 0; ks2 < 2; ++ks2) {
          u32x4 pw;
#pragma unroll
          for (int i = 0; i < 4; ++i) pw[i] = pack2(sacc[8 * ks2 + 2 * i], sacc[8 * ks2 + 2 * i + 1]);
          const bf16x8 pf = __builtin_bit_cast(bf16x8, pw);
          u32x4 a0, a1;
          if (ks2 == 0) { a0[0] = v00[0]; a0[1] = v00[1]; a0[2] = v01[0]; a0[3] = v01[1]; a1[0] = v10[0]; a1[1] = v10[1]; a1[2] = v11[0]; a1[3] = v11[1]; }
          else          { a0[0] = v02[0]; a0[1] = v02[1]; a0[2] = v03[0]; a0[3] = v03[1]; a1[0] = v12[0]; a1[1] = v12[1]; a1[2] = v13[0]; a1[3] = v13[1]; }
          o0 = __builtin_amdgcn_mfma_f32_32x32x16_bf16(__builtin_bit_cast(bf16x8, a0), pf, o0, 0, 0, 0);
          o1 = __builtin_amdgcn_mfma_f32_32x32x16_bf16(__builtin_bit_cast(bf16x8, a1), pf, o1, 0, 0, 0);
        }
      }
    }
    lsum += __shfl_xor(lsum, 32);
    const float sk = p.sink[l * N_Q_HEADS + hq] * 1.4426950408889634f;
    const float mf = fmaxf(m, sk); const float sc = __builtin_amdgcn_exp2f(m - mf); const float inv = sc / (lsum * sc + __builtin_amdgcn_exp2f(sk - mf));
    float* op = p.mixb() + qrow * MIX_W + hq * HEAD_DIM + 4 * h;
#pragma unroll
    for (int gq = 0; gq < 4; ++gq) {
      *(float4*)(op + 8 * gq) = make_float4(o0[4 * gq] * inv, o0[4 * gq + 1] * inv, o0[4 * gq + 2] * inv, o0[4 * gq + 3] * inv);
      *(float4*)(op + 32 + 8 * gq) = make_float4(o1[4 * gq] * inv, o1[4 * gq + 1] * inv, o1[4 * gq + 2] * inv, o1[4 * gq + 3] * inv);
    }
  }
}


static_assert(S5_T == 64 && S5_STATE == 64 && S5_GROUP == 16 && S5_GROUPS == 16 && NCH == 132, "s5 mfma shape");
#define S5_COLS (BATCH * NCH)
#define S5_RT 88
DEV void ph_s5tables_gpu(const P& p, long gtid, long gsize) {
  FOR_ITEMS4(i, (long)DEPTH * 2 * S5_GROUPS * 128 * 1024) {
    const int k = (int)(i & 1023), n = (int)((i >> 10) & 127); const long ldg = i >> 17;
    const int ri = n >> 6, pp = n & 63, sidx = k >> 4, j = k & 15;
    const float2 lp = p.lampow()[(ldg * (S5_T + 1) + (S5_T - 1 - sidx)) * S5_STATE + pp]; const float2 bb = p.bbar()[(ldg * S5_STATE + pp) * S5_GROUP + j];
    p.bmtb()[i] = (unsigned short)f2bf(ri ? lp.x * bb.y + lp.y * bb.x : lp.x * bb.x - lp.y * bb.y);
  }
  FOR_ITEMS4(i, (long)DEPTH * 2 * S5_GROUPS * 128 * 1024) {
    const int k = (int)(i & 127), n = (int)((i >> 7) & 1023); const long ldg = i >> 17; const int dir = (int)((ldg >> 4) & 1);
    const int ri = k >> 6, pp = k & 63, tl = n >> 4, ii = n & 15; const int tau = dir ? 63 - tl : tl;
    const float cr = p.s5_c_re[(ldg * S5_GROUP + ii) * S5_STATE + pp], ci = p.s5_c_im[(ldg * S5_GROUP + ii) * S5_STATE + pp];
    const float2 lp = p.lampow()[(ldg * (S5_T + 1) + tau + 1) * S5_STATE + pp];
    p.cmtb()[i] = (unsigned short)f2bf(ri ? -(cr * lp.y + ci * lp.x) : cr * lp.x - ci * lp.y);
  }
}
DEV void ph_kcb_gpu(const P& p, long gtid, long gsize) {
  FOR_ITEMS4(i, (long)DEPTH * 2 * S5_GROUPS * S5_T * 256) p.kcb()[i] = (unsigned short)f2bf(p.kc()[i]);
}
struct ALS5U { const char* base; unsigned off0[2]; int stepb; const char* hbase; unsigned hoff[2]; int nki;
  DEVM void set(int i, int b, int dir, int chunk, int sl, unsigned joff) { off0[i] = (unsigned)s5_row(b, dir, chunk * S5_T + sl) * (unsigned)(S5_W * 2) + joff; }
  DEVM const unsigned short* a(int i, int kt) const {
    if (kt >= nki) return (const unsigned short*)(hbase + (hoff[i] + (unsigned)(kt - nki) * 128u));
    return (const unsigned short*)(base + (off0[i] + (unsigned)(kt * stepb))); } };
struct BLKc { const char* kc; const char* cm; int tl, i0, sj, ss, dir, nki; unsigned cmoff;
  DEVM void load(u32x4 (&rb)[4], int kt) const {
    if (kt >= nki) {
#pragma unroll
      for (int c = 0; c < 4; ++c) rb[c] = *(const u32x4*)(cm + (cmoff + (unsigned)(c * 128 + (kt - nki) * 64) * 2u));
      return;
    }
    const int d = (dir ? 63 - tl : tl) - (4 * kt + ss);
    if (d < 0) {
#pragma unroll
      for (int c = 0; c < 4; ++c) rb[c] = (u32x4){0u, 0u, 0u, 0u};
    } else {
#pragma unroll
      for (int c = 0; c < 4; ++c) rb[c] = *(const u32x4*)(kc + (unsigned)(((d * 16 + i0 + c) * 16 + sj) * 2));
    }
  } };
DEV void ph_s5_sgemm(const P& p, int l, char* smem) {
  const int tid = otid();
  const int nitems = 2 * S5_GROUPS * 3;
  for (int it = blockIdx.x; it < nitems; it += gridDim.x) {
    const int rt = it % 3, g = (it / 3) % S5_GROUPS, dir = it / (3 * S5_GROUPS);
    ALS5U al; al.base = (const char*)(p.s5u() + g * S5_GROUP); al.stepb = (dir ? -4 : 4) * S5_W * 2; al.nki = 1 << 20; al.hbase = al.base; al.hoff[0] = al.hoff[1] = 0;
#pragma unroll
    for (int i = 0; i < 2; ++i) { const int col = rt * S5_RT + min((tid >> 3) + 64 * i, S5_RT - 1); al.set(i, col / NCH, dir, col % NCH, (tid & 7) >> 1, (tid & 1) * 16); }
    BLT bl; bl.base = (const char*)(p.bmtb() + (((long)l * 2 + dir) * S5_GROUPS + g) * 128 * 1024); bl.rowb = 1024 * 2;
    bl.voff = (unsigned)((((tid >> 3) & 31) * 4)) * bl.rowb + (unsigned)((tid & 7) * 16);
    f32x4 acc[4][4]; acc_zero(acc);
    gemm_tb(al, bl, 16, acc, smem);
    EPI_BEGIN
    if (((etid >> 6) & 3) < 2) {
#pragma unroll
      for (int m = 0; m < 4; ++m)
#pragma unroll
        for (int j = 0; j < 4; ++j) {
          const int rl = EPI_ROW(m, j);
          if (rl < S5_RT) {
            const int col = rt * S5_RT + rl; const int b = col / NCH, c = col % NCH;
            float* dst = (float*)(p.sc() + ((((long)b * 2 + dir) * S5_GROUPS + g) * NCH + c) * S5_STATE);
#pragma unroll
            for (int n = 0; n < 4; ++n) { const int nn = EPI_COL(n); dst[(nn & 63) * 2 + (nn >> 6)] = acc[m][n][j]; }
          }
        }
    }
  }
}

static_assert(NCH == 132, "carry scan grouping");
DEV void ph_s5_carry_gpu(const P& p, int l, char* smem) {
  const int tid = otid();
  float2* E = (float2*)(smem + SM_MISC);
  const int nchains = BATCH * 2 * S5_GROUPS * S5_STATE;
  for (int cb = blockIdx.x * 16; cb < nchains; cb += gridDim.x * 16) {
    const int cl = tid & 15, grp = tid >> 4; const bool act = tid < 176;
    const int chain = cb + cl;
    const int pp = chain % S5_STATE, g = (chain / S5_STATE) % S5_GROUPS, dir = (chain / (S5_STATE * S5_GROUPS)) % 2, b = chain / (S5_STATE * S5_GROUPS * 2);
    const long ldg = ((long)l * 2 + dir) * S5_GROUPS + g;
    const long base = (((long)b * 2 + dir) * S5_GROUPS + g) * NCH + grp * 12;
    float2 lt = make_float2(0.f, 0.f); float2 L[12]; float hr = 0.f, hi = 0.f;
    __syncthreads();
    if (act) {
      lt = p.lampow()[(ldg * (S5_T + 1) + S5_T) * S5_STATE + pp];
      float2 sv[12];
#pragma unroll
      for (int k = 0; k < 12; ++k) sv[k] = p.sc()[(base + k) * S5_STATE + pp];
#pragma unroll
      for (int k = 0; k < 12; ++k) { L[k] = make_float2(hr, hi); const float nr = lt.x * hr - lt.y * hi + sv[k].x, ni = lt.x * hi + lt.y * hr + sv[k].y; hr = nr; hi = ni; }
      E[grp * 16 + cl] = make_float2(hr, hi);
    }
    __syncthreads();
    if (act) {
      float pr = lt.x, pi = lt.y;
#pragma unroll
      for (int k = 1; k < 12; ++k) { const float nr = pr * lt.x - pi * lt.y, ni = pr * lt.y + pi * lt.x; pr = nr; pi = ni; }
      float gr = 0.f, gi = 0.f;
      for (int gp = 0; gp < grp; ++gp) { const float2 e = E[gp * 16 + cl]; const float nr = pr * gr - pi * gi + e.x, ni = pr * gi + pi * gr + e.y; gr = nr; gi = ni; }
#pragma unroll
      for (int k = 0; k < 12; ++k) {
        const float vr = L[k].x + gr, vi = L[k].y + gi;
        p.hcbf()[(base + k) * 2 * S5_STATE + pp] = f2bf16(vr); p.hcbf()[(base + k) * 2 * S5_STATE + S5_STATE + pp] = f2bf16(vi);
        const float nr = lt.x * gr - lt.y * gi, ni = lt.x * gi + lt.y * gr; gr = nr; gi = ni;
      }
    }
  }
}
DEV void ph_s5_ygemm(const P& p, int l, char* smem) {
  const int tid = otid();
  const int nitems = S5_GROUPS * 3 * 4;
  for (int it = blockIdx.x; it < nitems; it += gridDim.x) {
    const int nt = it & 3, rt = (it >> 2) % 3, g = it / 12;
    f32x4 acc[4][4]; acc_zero(acc);
#pragma unroll 1
    for (int dir = 0; dir < 2; ++dir) {
      const long ldg = ((long)l * 2 + dir) * S5_GROUPS + g;
      const int nki = dir ? 16 - 4 * nt : 4 * nt + 4;
      ALS5U al; al.base = (const char*)(p.s5u() + g * S5_GROUP); al.stepb = (dir ? -4 : 4) * S5_W * 2; al.nki = nki; al.hbase = (const char*)p.hcbf();
#pragma unroll
      for (int i = 0; i < 2; ++i) {
        const int col = rt * S5_RT + min((tid >> 3) + 64 * i, S5_RT - 1); const int b = col / NCH, blk = col % NCH;
        const int ch = dir ? (blk < 4 ? 3 - blk : 135 - blk) : blk;
        al.set(i, b, dir, ch, (tid & 7) >> 1, (tid & 1) * 16);
        al.hoff[i] = (unsigned)((((b * 2 + dir) * S5_GROUPS + g) * NCH + ch) * 128 + (tid & 7) * 8) * 2u;
      }
      BLKc bk; bk.kc = (const char*)(p.kcb() + ldg * S5_T * 256); bk.tl = 16 * nt + (tid >> 5); bk.i0 = ((tid >> 3) & 3) * 4; bk.sj = (tid & 1) * 8; bk.ss = (tid & 7) >> 1; bk.dir = dir; bk.nki = nki;
      bk.cm = (const char*)(p.cmtb() + ldg * 1024 * 128); bk.cmoff = (unsigned)(((16 * nt + (tid >> 5)) * 16 + ((tid >> 3) & 3) * 4) * 128 + (tid & 7) * 8) * 2u;
      gemm_tb(al, bk, nki + 2, acc, smem);
    }
    EPI_BEGIN
#pragma unroll
    for (int m = 0; m < 4; ++m)
#pragma unroll
      for (int j = 0; j < 4; ++j) {
        const int rl = EPI_ROW(m, j);
        if (rl < S5_RT) {
          const int col = rt * S5_RT + rl; const int b = col / NCH, blk = col % NCH;
#pragma unroll
          for (int n = 0; n < 4; ++n) {
            const int nn = nt * 256 + EPI_COL(n); const int tl = nn >> 4, chn = g * S5_GROUP + (nn & 15);
            const long row = blk < 4 ? (long)NL + b * CTX_LEN + blk * 64 + tl : (long)b * SEQ + (blk - 4) * 64 + tl;
            const float y = acc[m][n][j] + p.s5_d[l * S5_W + chn] * __uint_as_float((unsigned)p.s5u()[row * S5_W + chn] << 16);
            const float gy = gelu_tanhf(y);
            p.ybuf()[row * S5_W + chn] = gy; p.ybf()[row * S5_W + chn] = (unsigned short)f2bf(gy);
          }
        }
      }
  }
}

DEV float wave_sum(float v) {
#pragma unroll
  for (int o = 32; o > 0; o >>= 1) v += __shfl_xor(v, o);
  return v;
}
DEV void st_bf4(unsigned short* dst, float a, float b, float c, float d) { u32x2 v; v[0] = pack2(a, b); v[1] = pack2(c, d); *(u32x2*)dst = v; }
static_assert(BATCH == 2, "mod partial layout");
DEV void ph_modsum_gpu(const P& p, long gtid, long gsize) {
  FOR_ITEMS(i, (long)DEPTH * (BATCH + 1) * 6 * D_MODEL) {
    const int n = (int)(i % (6 * D_MODEL)); const int j = (int)((i / (6 * D_MODEL)) % (BATCH + 1)); const int l = (int)(i / (6 * D_MODEL * (BATCH + 1)));
    float acc = p.b_ada[l * 6 * D_MODEL + n];
#pragma unroll
    for (int sl = 0; sl < 16; ++sl) acc += p.modp()[((long)(l * 16 + sl) * (BATCH + 1) + j) * 6 * D_MODEL + n];
    p.mod()[i] = acc;
  }
}
DEV void ph_modu0_gpu(const P& p, long gtid, long gsize) {
  FOR_ITEMS4(i4, (long)NR * D_MODEL / 4) {
    const long i = i4 * 4; const int k = (int)(i % D_MODEL); const long r = i / D_MODEL;
    const float* m = p.mod() + (long)modrow(r) * 6 * D_MODEL;
    const float4 x = *(const float4*)(p.xcur() + i); const float4 sh = *(const float4*)(m + k); const float4 sc = *(const float4*)(m + D_MODEL + k);
    st_bf4(p.ubf() + i, x.x * (1.f + sc.x) + sh.x, x.y * (1.f + sc.y) + sh.y, x.z * (1.f + sc.z) + sh.z, x.w * (1.f + sc.w) + sh.w);
  }
}
DEV void rms_rows(const P& p, int l, long r0, long r1, int w0, int nw) {
  const int lane = otid() & 63;
  for (long r = r0 + w0; r < r1; r += nw) {
    const float* v = p.mixb() + r * MIX_W; float4 a[4]; float ss[4];
#pragma unroll
    for (int i = 0; i < 4; ++i) { a[i] = *(const float4*)(v + (i * 64 + lane) * 4); ss[i] = a[i].x * a[i].x + a[i].y * a[i].y + a[i].z * a[i].z + a[i].w * a[i].w; }
    const float s_att = wave_sum(ss[0] + ss[1]), s_hy = wave_sum(ss[2]), s_s5 = wave_sum(ss[3]);
    float rs[4]; rs[0] = rs[1] = 1.0f / sqrtf(s_att / (float)ATTN_W + LN_EPS); rs[2] = 1.0f / sqrtf(s_hy / (float)HYENA_W + LN_EPS); rs[3] = 1.0f / sqrtf(s_s5 / (float)S5_W + LN_EPS);
#pragma unroll
    for (int i = 0; i < 4; ++i) {
      const int k = (i * 64 + lane) * 4; const float4 g = *(const float4*)(p.mix_g + l * MIX_W + k);
      st_bf4(p.mixbf() + r * MIX_W + k, a[i].x * rs[i] * g.x, a[i].y * rs[i] * g.y, a[i].z * rs[i] * g.z, a[i].w * rs[i] * g.w);
    }
  }
}
DEV void ln_rows(float4 (&a)[4], const float* gw, const float* bw, int lane) {
  float s = 0.f;
#pragma unroll
  for (int i = 0; i < 4; ++i) s += a[i].x + a[i].y + a[i].z + a[i].w;
  const float mu = wave_sum(s) / (float)D_MODEL; float q = 0.f;
#pragma unroll
  for (int i = 0; i < 4; ++i) { a[i].x -= mu; a[i].y -= mu; a[i].z -= mu; a[i].w -= mu; q += a[i].x * a[i].x + a[i].y * a[i].y + a[i].z * a[i].z + a[i].w * a[i].w; }
  const float rs = 1.0f / sqrtf(wave_sum(q) / (float)D_MODEL + LN_EPS);
#pragma unroll
  for (int i = 0; i < 4; ++i) {
    const int k = (i * 64 + lane) * 4; const float4 g = *(const float4*)(gw + k), b = *(const float4*)(bw + k);
    a[i].x = a[i].x * rs * g.x + b.x; a[i].y = a[i].y * rs * g.y + b.y; a[i].z = a[i].z * rs * g.z + b.z; a[i].w = a[i].w * rs * g.w + b.w;
  }
}
DEV void ph_ln1_gpu(const P& p, int l) {
  const int tid_ = otid(); const int lane = tid_ & 63; const int gw = blockIdx.x * (NT / 64) + (tid_ >> 6), nw = gridDim.x * (NT / 64);
  for (long r = gw; r < NR; r += nw) {
    float4 a[4];
#pragma unroll
    for (int i = 0; i < 4; ++i) a[i] = *(const float4*)(p.tmp() + r * D_MODEL + (i * 64 + lane) * 4);
    ln_rows(a, p.ln1_g + l * D_MODEL, p.ln1_b + l * D_MODEL, lane);
    const float* m = p.mod() + ((long)l * (BATCH + 1) + modrow(r)) * 6 * D_MODEL + 3 * D_MODEL;
#pragma unroll
    for (int i = 0; i < 4; ++i) {
      const int k = (i * 64 + lane) * 4;
      *(float4*)(p.xcur() + r * D_MODEL + k) = a[i];
      const float4 sh = *(const float4*)(m + k), sc = *(const float4*)(m + D_MODEL + k);
      const float u0 = a[i].x * (1.f + sc.x) + sh.x, u1 = a[i].y * (1.f + sc.y) + sh.y, u2 = a[i].z * (1.f + sc.z) + sh.z, u3 = a[i].w * (1.f + sc.w) + sh.w;
      st_bf4(p.ubf() + r * D_MODEL + k, u0, u1, u2, u3);
      st_bf4(p.ubl() + r * D_MODEL + k, bflo(u0), bflo(u1), bflo(u2), bflo(u3));
    }
  }
}
DEV void exp_prefix(const P& p, int l, int* toff, int* roff, int* rowo);
DEV void ph_ln2_gpu(const P& p, int l, char* smem) {
  const int tid_ = otid(); const int lane = tid_ & 63; const int gw = blockIdx.x * (NT / 64) + (tid_ >> 6), nw = gridDim.x * (NT / 64);
  int* toff = (int*)(smem + SM_MISC); int* roff = toff + N_EXPERTS + 1; int* rowo = roff + N_EXPERTS + 16;
  exp_prefix(p, l, toff, roff, rowo);
  int e_n = 0, s_n = 0;
  if (gw < NR && lane < TOP_K) { e_n = p.top_e()[(long)gw * TOP_K + lane]; s_n = p.posb()[(long)gw * TOP_K + lane]; }
  for (long r = gw; r < NR; r += nw) {
    const int myrow = rowo[e_n] + s_n;
    if (r + nw < NR && lane < TOP_K) { e_n = p.top_e()[(r + nw) * TOP_K + lane]; s_n = p.posb()[(r + nw) * TOP_K + lane]; }
    float4 a[4];
    const float* m = p.mod() + ((long)l * (BATCH + 1) + modrow(r)) * 6 * D_MODEL + 5 * D_MODEL;
#pragma unroll
    for (int i = 0; i < 4; ++i) {
      const int k = (i * 64 + lane) * 4;
      float4 f = *(const float4*)(p.ysh() + r * D_MODEL + k);
#pragma unroll
      for (int kk = 0; kk < TOP_K; ++kk) { const u32x2 y = *(const u32x2*)(p.ykb() + (long)__builtin_amdgcn_readlane(myrow, kk) * D_MODEL + k); f.x += __uint_as_float(y[0] << 16); f.y += __uint_as_float(y[0] & 0xffff0000u); f.z += __uint_as_float(y[1] << 16); f.w += __uint_as_float(y[1] & 0xffff0000u); }
      const float4 x = *(const float4*)(p.xcur() + r * D_MODEL + k), g2 = *(const float4*)(m + k);
      a[i].x = DN_ALPHA * x.x + g2.x * f.x; a[i].y = DN_ALPHA * x.y + g2.y * f.y; a[i].z = DN_ALPHA * x.z + g2.z * f.z; a[i].w = DN_ALPHA * x.w + g2.w * f.w;
    }
    ln_rows(a, p.ln2_g + l * D_MODEL, p.ln2_b + l * D_MODEL, lane);
    const float* mn = p.mod() + ((long)(l + 1) * (BATCH + 1) + modrow(r)) * 6 * D_MODEL;
#pragma unroll
    for (int i = 0; i < 4; ++i) {
      const int k = (i * 64 + lane) * 4;
      *(float4*)(p.xcur() + r * D_MODEL + k) = a[i];
      if (l + 1 < DEPTH) {
        const float4 sh = *(const float4*)(mn + k), sc = *(const float4*)(mn + D_MODEL + k);
        st_bf4(p.ubf() + r * D_MODEL + k, a[i].x * (1.f + sc.x) + sh.x, a[i].y * (1.f + sc.y) + sh.y, a[i].z * (1.f + sc.z) + sh.z, a[i].w * (1.f + sc.w) + sh.w);
      } else if (r < NL) *(float4*)(p.out + r * D_MODEL + k) = a[i];
    }
  }
}
struct ALRouter { const char* hi; const char* lo_; unsigned off[2];
  DEVM const unsigned short* a(int i, int kt) const { return (const unsigned short*)((kt >= 32 ? lo_ : hi) + (off[i] + (unsigned)(kt & 15) * 128u)); } };
struct BLRouter { const char* base; const char* lob; unsigned voff; unsigned rowb;
  DEVM void load(u32x4 (&rb)[4], int kt) const {
    const char* bb = (kt >> 4) == 1 ? lob : base;
#pragma unroll
    for (int c = 0; c < 4; ++c) rb[c] = *(const u32x4*)(bb + (voff + (unsigned)c * rowb + (unsigned)(kt & 15) * 128u)); } };
DEV void ph_router_mfma(const P& p, int l, char* smem) {
  const int tid = otid();
  const int n_router = (NR >> 7), n_sh = (NR >> 7) * 2;
  const int nrb = (int)gridDim.x >= 64 ? (int)((gridDim.x * 3) / 5) : 0;
  const bool is_router = nrb == 0 ? false : (int)blockIdx.x < nrb;
  for (int pass = 0; pass < 2; ++pass) {
    const bool do_router = nrb == 0 ? pass == 0 : is_router;
    if (nrb != 0 && pass == 1) break;
    const int first = nrb == 0 ? (int)blockIdx.x : (do_router ? (int)blockIdx.x : (int)blockIdx.x - nrb);
    const int stride = nrb == 0 ? (int)gridDim.x : (do_router ? nrb : (int)gridDim.x - nrb);
    const int nit = do_router ? n_router : n_sh;
    for (int it = first; it < nit; it += stride) {
      const int rt = do_router ? it : (it >> 1), cq = do_router ? 0 : (it & 1);
      ALRouter ar; ar.hi = (const char*)(p.ubf() + (long)rt * 128 * D_MODEL); ar.lo_ = (const char*)(p.ubl() + (long)rt * 128 * D_MODEL);
#pragma unroll
      for (int i = 0; i < 2; ++i) ar.off[i] = (unsigned)(((tid >> 3) + 64 * i) * D_MODEL + (tid & 7) * 8) * 2u;
      BLRouter br; int nk;
      if (do_router) {
        br.base = (const char*)(p.wt_rh() + (long)l * N_EXPERTS * D_MODEL); br.lob = (const char*)(p.wt_rl() + (long)l * N_EXPERTS * D_MODEL); br.rowb = D_MODEL * 2;
        br.voff = (unsigned)((tid >> 3) * 4) * br.rowb + (unsigned)((tid & 7) * 16); nk = 3 * (D_MODEL >> 6);
      } else {
        const int nq = tid >> 3; const int wsel = __builtin_amdgcn_readfirstlane(tid >> 6) & 1;
        const unsigned short* wsrc = (wsel ? p.wt_shu() : p.wt_shg()) + (long)l * SHARED_FF * D_MODEL;
        br.base = (const char*)wsrc; br.lob = br.base; br.rowb = D_MODEL * 2;
        br.voff = (unsigned)(cq * 128 + (nq >> 4) * 32 + (nq & 7) * 4) * br.rowb + (unsigned)((tid & 7) * 16); nk = D_MODEL >> 6;
      }
      f32x4 acc[4][4]; acc_zero(acc);
      gemm_tb(ar, br, nk, acc, smem);
      EPI_BEGIN
      if (do_router) {
#pragma unroll
        for (int m = 0; m < 4; ++m)
#pragma unroll
          for (int n = 0; n < 4; ++n)
#pragma unroll
            for (int j = 0; j < 4; ++j) p.rl()[((long)rt * 128 + EPI_ROW(m, j)) * N_EXPERTS + EPI_COL(n)] = acc[m][n][j];
      } else {
        const int elane = etid & 63, ewc = (etid >> 6) & 3;
#pragma unroll
        for (int m = 0; m < 4; ++m)
#pragma unroll
          for (int j = 0; j < 4; ++j)
          { unsigned short* dst = p.hsbf() + ((long)rt * 128 + EPI_ROW(m, j)) * SHARED_FF + cq * 128 + ewc * 32 + (elane & 15);
            dst[0] = (unsigned short)f2bf(siluf(acc[m][0][j]) * acc[m][2][j]); dst[16] = (unsigned short)f2bf(siluf(acc[m][1][j]) * acc[m][3][j]); }
      }
    }
  }
}
static_assert(EPG == 32 && TOP_K == 8 && N_EXPERT_GROUPS == 8 && TOPK_GROUPS == 4, "select shape");
DEV void ph_select_gpu(const P& p, int l) {
  const int tid_ = otid(); const int lane = tid_ & 63; const int gw = blockIdx.x * (NT / 64) + (tid_ >> 6), nw = gridDim.x * (NT / 64);
  const float4 rb = *(const float4*)(p.router_bias + l * N_EXPERTS + 4 * lane);
  for (long r = gw; r < NR; r += nw) {
    const float4 lg = *(const float4*)(p.rl() + r * N_EXPERTS + 4 * lane);
    float sc[4] = {sigmoidf_(lg.x), sigmoidf_(lg.y), sigmoidf_(lg.z), sigmoidf_(lg.w)};
    float bz[4] = {sc[0] + rb.x, sc[1] + rb.y, sc[2] + rb.z, sc[3] + rb.w};
    float m1 = fmaxf(bz[0], bz[1]), m2 = fminf(bz[0], bz[1]);
#pragma unroll
    for (int c = 2; c < 4; ++c) { const float v = bz[c]; m2 = fmaxf(m2, fminf(m1, v)); m1 = fmaxf(m1, v); }
#pragma unroll
    for (int o = 1; o < 8; o <<= 1) { const float b1 = __shfl_xor(m1, o), b2 = __shfl_xor(m2, o); m2 = fmaxf(fminf(m1, b1), fmaxf(m2, b2)); m1 = fmaxf(m1, b1); }
    const float gs = m1 + m2; const int mg = lane >> 3; int rank = 0;
#pragma unroll
    for (int j = 0; j < 8; ++j) { const float gj = __shfl(gs, j * 8); rank += (gj > gs || (gj == gs && j < mg)) ? 1 : 0; }
    if (rank >= TOPK_GROUPS) { bz[0] = bz[1] = bz[2] = bz[3] = -1e30f; }
    int sel_e[TOP_K]; float sel_s[TOP_K]; float gsum = 0.f;
#pragma unroll
    for (int it = 0; it < TOP_K; ++it) {
      float bv = bz[0]; int bc = 0;
#pragma unroll
      for (int c = 1; c < 4; ++c) if (bz[c] > bv) { bv = bz[c]; bc = c; }
      int bi = 4 * lane + bc; float bs = sc[bc];
      const int myi = bi;
#pragma unroll
      for (int o = 1; o < 64; o <<= 1) {
        const float ov = __shfl_xor(bv, o); const int oi = __shfl_xor(bi, o); const float os = __shfl_xor(bs, o);
        if (ov > bv || (ov == bv && oi < bi)) { bv = ov; bi = oi; bs = os; }
      }
      sel_e[it] = bi; sel_s[it] = bs; gsum += bs;
      if (bi == myi) {
#pragma unroll
        for (int c = 0; c < 4; ++c) if (c == bc) bz[c] = -1e30f;
      }
    }
    const float inv = ROUTED_SCALE / gsum;
    int me = sel_e[0]; float ms = sel_s[0];
#pragma unroll
    for (int it = 1; it < TOP_K; ++it) if (lane == it) { me = sel_e[it]; ms = sel_s[it]; }
    if (lane < TOP_K) {
      const long a = r * TOP_K + lane;
      p.top_e()[a] = me; p.gate()[a] = ms * inv;
      const int pos = atomicAdd(&p.cnt()[l * N_EXPERTS + me], 1);
      p.elist()[(long)me * NR + pos] = (int)a; p.egate()[(long)me * NR + pos] = ms * inv; p.posb()[a] = pos;
    }
  }
}
#endif

#ifndef CPU_TEST
#define XB_TMO      128
#define XB_XCNT(j)  (256  + 64 * (j))
#define XB_XSUB(j)  (1280 + 64 * (j))
#define XB_XGEN(j)  (2304 + 64 * (j))
#define XB_TOP      3328
#define XB_TOPGEN   3392
#define XCD_BAR_WORDS 3456
#define XB_SPIN_CAP (1u << 18)
#define LAS __attribute__((address_space(3)))
__device__ __forceinline__ unsigned xb_ld(unsigned* p)              { return __hip_atomic_load(p, __ATOMIC_RELAXED, __HIP_MEMORY_SCOPE_AGENT); }
__device__ __forceinline__ unsigned xb_add(unsigned* p, unsigned v) { return __hip_atomic_fetch_add(p, v, __ATOMIC_RELAXED, __HIP_MEMORY_SCOPE_AGENT); }
__device__ __forceinline__ unsigned xb_xcc_id() { return (unsigned)__builtin_amdgcn_s_getreg((3 << 11) | 20) & 0xFu; }
#define XB_SPIN(cond, bar) do { unsigned _sp = 0; while (cond) { __builtin_amdgcn_s_sleep(1); \
    if ((++_sp & 255u) == 0u) { if (xb_ld(&(bar)[XB_TMO])) break; if (_sp > XB_SPIN_CAP) { atomicAdd(&(bar)[XB_TMO], 1u); break; } } } } while (0)
struct XcdBarrier { unsigned* bar; unsigned x; volatile LAS unsigned* st; };
__device__ __forceinline__ XcdBarrier xcd_barrier_post(unsigned* bar, volatile LAS unsigned* st) {
    XcdBarrier b; b.bar = bar; b.x = xb_xcc_id(); b.st = st;
    if (threadIdx.x == 0) (void)xb_add(&bar[XB_XCNT(b.x)], 1u);
    return b;
}
__device__ __forceinline__ void xcd_barrier_complete(unsigned* bar, unsigned x, unsigned& nloc, unsigned& nx) {
    const unsigned G = gridDim.x * gridDim.y * gridDim.z;
    unsigned sum, cnt, mine, sp = 0u;
    for (;;) {
        sum = 0u; cnt = 0u; mine = 0u;
#pragma unroll
        for (unsigned j = 0; j < 16; ++j) { const unsigned c = xb_ld(&bar[XB_XCNT(j)]); sum += c; cnt += (c > 0u) ? 1u : 0u; mine = (j == x) ? c : mine; }
        if (sum == G) break;
        __builtin_amdgcn_s_sleep(1);
        if ((++sp & 255u) == 0u) { if (xb_ld(&bar[XB_TMO])) break; if (sp > XB_SPIN_CAP) { atomicAdd(&bar[XB_TMO], 1u); break; } }
    }
    nloc = mine > 0u ? mine : 1u; nx = cnt > 0u ? cnt : 1u;
}
__device__ __forceinline__ void xcd_barrier(const XcdBarrier& b) {
    asm volatile("s_waitcnt vmcnt(0)" ::: "memory");
    __syncthreads();
    if (threadIdx.x == 0) {
        unsigned* bar = b.bar;
        unsigned bx = b.x; asm volatile("" : "+s"(bx));
        __builtin_amdgcn_s_waitcnt(0);
        unsigned nloc = b.st[0], nx = b.st[1];
        if (nloc == 0u) { xcd_barrier_complete(bar, bx, nloc, nx); b.st[0] = nloc; b.st[1] = nx; }
        const unsigned old = xb_add(&bar[XB_XSUB(bx)], 1u);
        const unsigned gen = old / nloc;
        if (old + 1u == (gen + 1u) * nloc) {
            __builtin_amdgcn_fence(__ATOMIC_RELEASE, "agent");
            asm volatile("s_waitcnt vmcnt(0)" ::: "memory");
            const unsigned og = xb_add(&bar[XB_TOP], 1u);
            const unsigned tg = og / nx;
            if (og + 1u == (tg + 1u) * nx) xb_add(&bar[XB_TOPGEN], 1u);
            else XB_SPIN(xb_ld(&bar[XB_TOPGEN]) == tg, bar);
            __builtin_amdgcn_fence(__ATOMIC_ACQUIRE, "agent");
            xb_add(&bar[XB_XGEN(bx)], 1u);
            asm volatile("s_waitcnt vmcnt(0)" ::: "memory");
        } else {
            XB_SPIN(xb_ld(&bar[XB_XGEN(bx)]) == gen, bar);
            __builtin_amdgcn_fence(__ATOMIC_ACQUIRE, "agent");
            asm volatile("s_waitcnt vmcnt(0)" ::: "memory");
        }
    }
    __syncthreads();
}
#define GRID_SYNC() xcd_barrier(xb)
#else
#define GRID_SYNC() do {} while (0)
#endif

#ifndef CPU_TEST
#define GPUSEL(a, b) a
#else
#define GPUSEL(a, b) b
#endif
#ifndef CPU_TEST
#define OPAQUE_S(v) asm volatile("" : "+s"(v))
#define OPAQUE_V(v) asm volatile("" : "+v"(v))
#else
#define OPAQUE_S(v) do {} while (0)
#define OPAQUE_V(v) do {} while (0)
#endif
#ifndef PROBE_MASK
#define PROBE_MASK 0
#endif
#define LPHASE(stmt) do { int l = lo; OPAQUE_S(l); if (SINGLE && ((PROBE_MASK >> (ph - NG - lo * NLP)) & 1)) { long gtid = gtid0; OPAQUE_V(gtid); stmt; GRID_SYNC(); } PHASE(stmt); } while (0)
#define PHASE(stmt) do { if (SINGLE || ph == only) { long gtid = gtid0; OPAQUE_V(gtid); stmt; } if (SINGLE) { GRID_SYNC(); } ++ph; } while (0)
#ifndef CPU_TEST
template <bool SINGLE> __device__ __forceinline__ void run_seq(const P& p, long gtid0, long gsize, int only, const XcdBarrier& xb, char* smem)
#else
template <bool SINGLE> static int run_seq(const P& p, long gtid0, long gsize, int only)
#endif
{
  int ph = 0;
  PHASE(ph_g0(p, gtid, gsize));
  PHASE(ph_g1(p, gtid, gsize));
  PHASE(ph_g2(p, gtid, gsize));
  PHASE(ph_g3(p, gtid, gsize));
  PHASE(ph_g4(p, gtid, gsize));
#pragma unroll 1
  for (int lo = 0; lo < DEPTH; ++lo) {
    LPHASE(ph_modu(p, l, 0, gtid, gsize));
    LPHASE(GPUSEL(ph_proj_mfma(p, l, smem), ph_proj(p, l, gtid, gsize)));
    LPHASE(ph_post_proj(p, l, gtid, gsize));
    LPHASE(ph_mix(p, l, gtid, gsize); GPUSEL((ph_attn_mfma(p, l, smem), ph_hyena_mfma(p, l, smem)), (void)0));
    LPHASE(ph_s5out(p, l, gtid, gsize));
    LPHASE(GPUSEL(ph_glu_mfma(p, l, smem), ph_glu(p, l, gtid, gsize)));
    LPHASE(ph_rms(p, l, gtid, gsize));
    LPHASE(GPUSEL(ph_outproj_mfma(p, l, smem), ph_outproj(p, l, gtid, gsize)));
    LPHASE(ph_ln(p, l, 0, gtid, gsize));
    LPHASE(ph_router(p, l, gtid, gsize));
    LPHASE(ph_select(p, l, gtid, gsize));
    LPHASE(ph_sortrows(p, l, gtid, gsize));
    LPHASE(GPUSEL(ph_expert_up_mfma(p, l, smem), ph_expert_up(p, l, gtid, gsize)));
    LPHASE(GPUSEL(ph_expert_down_mfma(p, l, smem), ph_expert_down(p, l, gtid, gsize)));
    LPHASE(ph_combine(p, l, gtid, gsize));
    LPHASE(ph_ln(p, l, 1, gtid, gsize));
  }
#ifdef CPU_TEST
  return ph;
#endif
}


#ifndef CPU_TEST
#define NG_GPU 5
#define NLP_GPU 12
#ifndef PROBE_MASK_G
#define PROBE_MASK_G 0
#endif
#define GPHASE(stmt) do { if (SINGLE || ph == only) { long gtid = (long)blockIdx.x * NT + otid(); stmt; } if (SINGLE) { GRID_SYNC(); } ++ph; } while (0)
#define GLPHASE(stmt) do { int l = lo; OPAQUE_S(l); if (SINGLE && ((PROBE_MASK_G >> (ph - NG_GPU - lo * NLP_GPU)) & 1)) { long gtid = (long)blockIdx.x * NT + otid(); stmt; GRID_SYNC(); } GPHASE(stmt); } while (0)
template <bool SINGLE> __device__ __forceinline__ void run_seq_gpu(const P& p, long gtid0, long gsize, int only, const XcdBarrier& xb, char* smem) {
  int ph = 0;
#ifdef PROBE_INIT
  if (SINGLE) { long gtid = (long)blockIdx.x * NT + otid(); ph_g0(p, gtid, gsize); GRID_SYNC(); ph_g1(p, gtid, gsize); ph_modsum_gpu(p, gtid, gsize); ph_s5tables_gpu(p, gtid, gsize); GRID_SYNC(); ph_g2(p, gtid, gsize); ph_modu0_gpu(p, gtid, gsize); GRID_SYNC(); ph_g3(p, gtid, gsize); GRID_SYNC(); ph_g4(p, gtid, gsize); GRID_SYNC(); }
#endif
  GPHASE(ph_g0(p, gtid, gsize); s5_lampow_gpu(p, gtid, gsize); rope_table_gpu(p, gtid, gsize));
  GPHASE(ph_g1(p, gtid, gsize); ph_modsum_gpu(p, gtid, gsize); ph_s5tables_gpu(p, gtid, gsize); wt_convert_all(p, gtid, gsize));
  GPHASE(ph_g2(p, gtid, gsize); ph_modu0_gpu(p, gtid, gsize); ph_kcb_gpu(p, gtid, gsize));
  GPHASE(ph_g3(p, gtid, gsize));
  GPHASE(ph_g4(p, gtid, gsize));
#pragma unroll 1
  for (int lo = 0; lo < DEPTH; ++lo) {
    GLPHASE(ph_proj_mfma(p, l, smem));
    GLPHASE(ph_s5_sgemm(p, l, smem); ph_hyena_pre_gpu(p, l, gtid, gsize));
    GLPHASE(ph_mix(p, l, gtid, gsize); ph_s5_carry_gpu(p, l, smem); ph_attn_mfma(p, l, smem); ph_hyena_mfma(p, l, smem));
    GLPHASE(ph_s5_ygemm(p, l, smem));
    GLPHASE(ph_glu_mfma(p, l, smem));
    GLPHASE(ph_outproj_mfma(p, l, smem));
    GLPHASE(ph_ln1_gpu(p, l));
    GLPHASE(ph_router_mfma(p, l, smem));
    GLPHASE(ph_select_gpu(p, l));
#ifdef UPVAR
    if (SINGLE) { int l = lo; OPAQUE_S(l); ph_expert_up_mfma<UPVAR>(p, l, smem); GRID_SYNC(); }
#endif
    GLPHASE(ph_expert_up_mfma(p, l, smem));
    GLPHASE(ph_expert_down_mfma(p, l, smem));
    GLPHASE(ph_ln2_gpu(p, l, smem));
  }
}
#endif

static void carve(P& p, void* ws) { p.ws = (char*)ws; }
static void set_inputs(P& p, void* const* d_in) {
  const float** f = (const float**)&p.x;
  for (int i = 0; i < 40; ++i) f[i] = (const float*)d_in[i];
}

#ifndef CPU_TEST
#ifndef MK_SINGLE
#define MK_SINGLE 1
#endif
extern __shared__ __attribute__((aligned(16))) char dyn_smem[];
__global__ void __launch_bounds__(NT, 2) mk_single(P p) {
  uint4* xbw = (uint4*)(dyn_smem + SM_XB);
  if (threadIdx.x == 0) *xbw = make_uint4(0u, 0u, 0u, 0u);
  __syncthreads();
  XcdBarrier xb = xcd_barrier_post(p.bar(), (volatile LAS unsigned*)xbw);
  run_seq_gpu<true>(p, (long)blockIdx.x * blockDim.x + threadIdx.x, (long)gridDim.x * blockDim.x, -1, xb, dyn_smem);
}
__global__ void __launch_bounds__(NT, 2) mk_phase(P p, int only) {
  XcdBarrier xb; xb.bar = p.bar(); xb.x = 0; xb.st = nullptr;
#ifdef DBG_ONLY
  only = DBG_ONLY;
#endif
  run_seq_gpu<false>(p, (long)blockIdx.x * blockDim.x + threadIdx.x, (long)gridDim.x * blockDim.x, only, xb, dyn_smem);
}
extern "C" void kernel_launch(void* const* d_in, const int* in_sizes, int n_in, void* d_out, int out_size, void* d_ws, size_t ws_size, hipStream_t stream) {
  P p; memset(&p, 0, sizeof(p));
  set_inputs(p, d_in); p.out = (float*)d_out; carve(p, d_ws);
  (void)hipMemsetAsync(p.bar(), 0, 4096 * sizeof(unsigned) + ((DEPTH * N_EXPERTS * sizeof(int) + 255) / 256) * 256, stream);
#if MK_SINGLE
  static int grid = 0;
  if (!grid) {
    int dev = 0, cus = 0, per_cu = 0; (void)hipGetDevice(&dev);
    (void)hipDeviceGetAttribute(&cus, hipDeviceAttributeMultiprocessorCount, dev);
    (void)hipFuncSetAttribute((const void*)mk_single, hipFuncAttributeMaxDynamicSharedMemorySize, SMEM_BYTES);
    (void)hipOccupancyMaxActiveBlocksPerMultiprocessor(&per_cu, mk_single, NT, SMEM_BYTES);
    grid = cus * (per_cu < 1 ? per_cu : 1);
  }
  mk_single<<<grid, NT, SMEM_BYTES, stream>>>(p);
#else
  for (int ph = 0; ph < NG_GPU + DEPTH * NLP_GPU; ++ph) mk_phase<<<256, NT, SMEM_BYTES, stream>>>(p, ph);
#endif
}
#endif
```

```cpp
#ifndef CPU_TEST
#include <hip/hip_runtime.h>
#include <cstring>
#define DEV __device__ __forceinline__
#define DEVM __device__ __forceinline__
#define HDM __host__ __device__ __forceinline__
#else
#include <cmath>
#include <cstdio>
#include <cstdlib>
#include <cstring>
#define DEV static inline
#define DEVM inline
#define HDM inline
struct float2 { float x, y; };
static inline float2 make_float2(float a, float b) { float2 r; r.x = a; r.y = b; return r; }
static inline int atomicAdd(int* p, int v) { int o = *p; *p += v; return o; }
#endif

#ifdef SMALL_CFG
#define D_MODEL 64
#define BATCH 2
#define SEQ 256
#define GRID_W 16
#define CTX_LEN 32
#define HEAD_DIM 16
#define N_Q_HEADS 4
#define N_KV_HEADS 2
#define HYENA_W 16
#define S5_W 32
#define WINDOW 32
#define FILTER_HIDDEN 16
#define S5_STATE 8
#define N_EXPERTS 32
#define TOP_K 4
#define EXPERT_FF 16
#define SHARED_FF 16
#define S5_T 32
#else
#define D_MODEL 1024
#define BATCH 2
#define SEQ 8192
#define GRID_W 64
#define CTX_LEN 256
#define HEAD_DIM 64
#define N_Q_HEADS 8
#define N_KV_HEADS 2
#define HYENA_W 256
#define S5_W 256
#define WINDOW 128
#define FILTER_HIDDEN 64
#define S5_STATE 64
#define N_EXPERTS 256
#define TOP_K 8
#define EXPERT_FF 256
#define SHARED_FF 256
#define S5_T 64
#endif
#define DEPTH 2
#define FILTER_EMB 33
#define N_EXPERT_GROUPS 8
#define TOPK_GROUPS 4
#define S5_GROUP 16
#define Q_GROUP (N_Q_HEADS / N_KV_HEADS)
#define ATTN_W (N_Q_HEADS * HEAD_DIM)
#define KV_W (N_KV_HEADS * HEAD_DIM)
#define MIX_W (ATTN_W + HYENA_W + S5_W)
#define Q_OFF 0
#define K_OFF ATTN_W
#define V_OFF (K_OFF + KV_W)
#define HY_OFF (V_OFF + KV_W)
#define S5_OFF (HY_OFF + 3 * HYENA_W)
#define IN_W (S5_OFF + S5_W)
#define AXIS_DIM (HEAD_DIM / 2)
#define ROPE_HALF (AXIS_DIM / 2)
#define S5_GROUPS (S5_W / S5_GROUP)
#define EPG (N_EXPERTS / N_EXPERT_GROUPS)
#define NL (BATCH * SEQ)
#define NC (BATCH * CTX_LEN)
#define NR (NL + NC)
#define NSEQ (CTX_LEN + SEQ)
#define NCH (NSEQ / S5_T)
#define LN_EPS 1e-5f
#define DN_ALPHA 1.4142135623730951f
#define ROUTED_SCALE 2.5f
#define PI_D 3.14159265358979323846

#define WS_LIST(X) \
  X(unsigned, bar, 4096) \
  X(int, cnt, DEPTH * N_EXPERTS) \
  X(float, mod, (size_t)DEPTH * (BATCH + 1) * 6 * D_MODEL) \
  X(float, xcur, (size_t)NR * D_MODEL) \
  X(float, ubuf, (size_t)NR * D_MODEL) \
  X(float, proj, (size_t)NR * IN_W) \
  X(float, hu, (size_t)NR * HYENA_W) \
  X(float, hx0, (size_t)NR * HYENA_W) \
  X(float, fh1, (size_t)DEPTH * SEQ * FILTER_HIDDEN) \
  X(float, fh2, (size_t)DEPTH * SEQ * FILTER_HIDDEN) \
  X(float, kraw, (size_t)DEPTH * SEQ * 2 * HYENA_W) \
  X(float, knorm, (size_t)DEPTH * HYENA_W) \
  X(float, fh1c, (size_t)CTX_LEN * FILTER_HIDDEN) \
  X(float, fh2c, (size_t)CTX_LEN * FILTER_HIDDEN) \
  X(float, krawc, (size_t)CTX_LEN * 2 * HYENA_W) \
  X(float, knormc, (size_t)HYENA_W) \
  X(float, mixb, (size_t)NR * MIX_W) \
  X(float, tmp, (size_t)NR * D_MODEL) \
  X(float2, lampow, (size_t)DEPTH * 2 * S5_GROUPS * (S5_T + 1) * S5_STATE) \
  X(float2, bbar, (size_t)DEPTH * 2 * S5_GROUPS * S5_STATE * S5_GROUP) \
  X(float, kc, (size_t)DEPTH * 2 * S5_GROUPS * S5_T * S5_GROUP * S5_GROUP) \
  X(float2, sc, (size_t)BATCH * 2 * S5_GROUPS * NCH * S5_STATE) \
  X(float2, hc, (size_t)BATCH * 2 * S5_GROUPS * NCH * S5_STATE) \
  X(float, ybuf, (size_t)NR * S5_W) \
  X(float, rl, (size_t)NR * N_EXPERTS) \
  X(int, top_e, (size_t)NR * TOP_K) \
  X(float, gate, (size_t)NR * TOP_K) \
  X(int, posb, (size_t)NR * TOP_K) \
  X(int, srow, (size_t)NR * TOP_K) \
  X(float, hbuf, (size_t)NR * TOP_K * EXPERT_FF) \
  X(float, hsb, (size_t)NR * SHARED_FF) \
  X(float, yk, (size_t)NR * TOP_K * D_MODEL) \
  X(float, ysh, (size_t)NR * D_MODEL) \
  X(unsigned short, ykb, (size_t)NR * TOP_K * D_MODEL) \
  X(unsigned short, qkvb, (size_t)NR * HY_OFF) \
  X(float2, ropet, (size_t)128 * ROPE_HALF) \
  X(unsigned short, bmtb, (size_t)DEPTH * 2 * S5_GROUPS * 128 * 1024) \
  X(unsigned short, cmtb, (size_t)DEPTH * 2 * S5_GROUPS * 1024 * 128) \
  X(unsigned short, kcb, (size_t)DEPTH * 2 * S5_GROUPS * S5_T * 256) \
  X(unsigned short, wt_in, (size_t)DEPTH * IN_W * D_MODEL) \
  X(unsigned short, wt_out, (size_t)DEPTH * D_MODEL * MIX_W) \
  X(unsigned short, wt_glu, (size_t)DEPTH * S5_W * S5_W) \
  X(unsigned short, wt_shg, (size_t)DEPTH * SHARED_FF * D_MODEL) \
  X(unsigned short, wt_shu, (size_t)DEPTH * SHARED_FF * D_MODEL) \
  X(unsigned short, wt_shd, (size_t)DEPTH * D_MODEL * SHARED_FF) \
  X(unsigned short, wt_rh, (size_t)DEPTH * N_EXPERTS * D_MODEL) \
  X(unsigned short, wt_rl, (size_t)DEPTH * N_EXPERTS * D_MODEL) \
  X(unsigned short, ubf, (size_t)NR * D_MODEL) \
  X(unsigned short, ybf, (size_t)NR * S5_W) \
  X(unsigned short, mixbf, (size_t)NR * MIX_W) \
  X(unsigned short, hbf, (size_t)NR * TOP_K * EXPERT_FF) \
  X(unsigned short, hsbf, (size_t)NR * SHARED_FF) \
  X(unsigned short, ubl, (size_t)NR * D_MODEL) \
  X(int, elist, (size_t)N_EXPERTS * NR) \
  X(float, egate, (size_t)N_EXPERTS * NR) \
  X(unsigned short, s5u, (size_t)NR * S5_W) \
  X(float, bmt, (size_t)DEPTH * 2 * S5_GROUPS * 16 * S5_T * 2 * S5_STATE) \
  X(float, cmt, (size_t)DEPTH * 2 * S5_GROUPS * 16 * S5_T * 2 * S5_STATE) \
  X(unsigned short, hcbf, (size_t)BATCH * 2 * S5_GROUPS * NCH * 2 * S5_STATE) \
  X(float, zT, (size_t)BATCH * 3 * HYENA_W * (SEQ + CTX_LEN)) \
  X(float, modp, (size_t)DEPTH * 16 * (BATCH + 1) * 6 * D_MODEL) \
  X(float, wrlo, (size_t)DEPTH * D_MODEL * N_EXPERTS) \

struct WsOff {
#define X(T, name, n) size_t name;
  WS_LIST(X)
#undef X
  size_t total;
};
constexpr WsOff ws_offsets() {
  WsOff o{}; size_t off = 0;
#define X(T, name, n) o.name = off; off += (((size_t)(n)) * sizeof(T) + 255) / 256 * 256;
  WS_LIST(X)
#undef X
  o.total = off; return o;
}
constexpr WsOff WSO = ws_offsets();
struct P {
  const float *x, *c, *ctx, *c_ctx, *w_ada, *b_ada, *w_in, *w_out, *sink, *mix_g, *hy_short_w, *hy_short_b, *hy_w1,
      *hy_b1, *hy_freq, *hy_w2, *hy_b2, *hy_w3, *hy_d, *s5_a_re, *s5_a_im, *s5_log_dt, *s5_b_re, *s5_b_im, *s5_c_re,
      *s5_c_im, *s5_d, *s5_w_glu, *ln1_g, *ln1_b, *ln2_g, *ln2_b, *w_router, *router_bias, *w_exp_gate, *w_exp_up,
      *w_exp_down, *w_sh_gate, *w_sh_up, *w_sh_down;
  float* out;
  char* ws;
#define X(T, name, n) HDM T* name() const { return (T*)(ws + WSO.name); }
  WS_LIST(X)
#undef X
};

#define FOR_ITEMS(i, N) for (long i = gtid; i < (long)(N); i += gsize)
#ifndef CPU_TEST
#define FOR_ITEMS4(i, N) _Pragma("unroll 4") for (long i = gtid; i < (long)(N); i += gsize)
#else
#define FOR_ITEMS4(i, N) FOR_ITEMS(i, N)
#endif

DEV unsigned short f2bf16(float f) { unsigned u; memcpy(&u, &f, 4); return (unsigned short)((u + 0x7fffu + ((u >> 16) & 1u)) >> 16); }
DEV float siluf(float x) { return x / (1.0f + expf(-x)); }
DEV float sigmoidf_(float x) { return 1.0f / (1.0f + expf(-x)); }
DEV float gelu_tanhf(float x) { return 0.5f * x * (1.0f + tanhf(0.7978845608028654f * (x + 0.044715f * x * x * x))); }
DEV int modrow(long r) { return r < NL ? (int)(r / SEQ) : BATCH; }

DEV void ph_g0(const P& p, long gtid, long gsize) {
#ifndef CPU_TEST
  FOR_ITEMS4(i4, (long)NR * D_MODEL / 4) { const long i = i4 * 4; *(float4*)(p.xcur() + i) = i < (long)NL * D_MODEL ? *(const float4*)(p.x + i) : *(const float4*)(p.ctx + (i - (long)NL * D_MODEL)); }
#else
  FOR_ITEMS(i, (long)NR * D_MODEL) p.xcur()[i] = i < (long)NL * D_MODEL ? p.x[i] : p.ctx[i - (long)NL * D_MODEL];
#endif
#ifdef CPU_TEST
  FOR_ITEMS(i, DEPTH * (BATCH + 1) * 6 * D_MODEL) {
    int n = (int)(i % (6 * D_MODEL)); int j = (int)((i / (6 * D_MODEL)) % (BATCH + 1)); int l = (int)(i / (6 * D_MODEL * (BATCH + 1)));
    const float* cv = j < BATCH ? p.c + j * D_MODEL : p.c_ctx;
    const float* w = p.w_ada + (long)l * D_MODEL * 6 * D_MODEL;
    float acc = p.b_ada[l * 6 * D_MODEL + n];
    for (int k = 0; k < D_MODEL; ++k) acc += siluf(cv[k]) * w[(long)k * 6 * D_MODEL + n];
    p.mod()[i] = acc;
  }
#else
  FOR_ITEMS(i, (long)DEPTH * 16 * 6 * D_MODEL) {
    const int n = (int)(i % (6 * D_MODEL)); const int slab = (int)((i / (6 * D_MODEL)) % 16); const int l = (int)(i / (6 * D_MODEL * 16));
    const float* w = p.w_ada + ((long)l * D_MODEL + slab * 64) * 6 * D_MODEL + n;
    float a0 = 0.f, a1 = 0.f, a2 = 0.f;
#pragma unroll 8
    for (int k = 0; k < 64; ++k) {
      const float wv = w[(long)k * 6 * D_MODEL]; const int kk = slab * 64 + k;
      a0 += siluf(p.c[kk]) * wv; a1 += siluf(p.c[D_MODEL + kk]) * wv; a2 += siluf(p.c_ctx[kk]) * wv;
    }
    float* dst = p.modp() + ((long)(l * 16 + slab) * (BATCH + 1)) * 6 * D_MODEL + n;
    dst[0] = a0; dst[6 * D_MODEL] = a1; dst[2 * 6 * D_MODEL] = a2;
  }
#endif
  FOR_ITEMS(i, DEPTH * 2 * S5_GROUPS * S5_STATE) {
    int pp = (int)(i % S5_STATE); int g = (int)((i / S5_STATE) % S5_GROUPS); int ld = (int)(i / (S5_STATE * S5_GROUPS));
    float are = fminf(p.s5_a_re[i], -1e-4f), aim = p.s5_a_im[i];
    float dt = expf(p.s5_log_dt[ld * S5_GROUPS + g]);
#ifdef CPU_TEST
    for (int d = 0; d <= S5_T; ++d) {
      float mag = expf(are * dt * d); float ang = aim * dt * d;
      p.lampow()[((long)(ld * S5_GROUPS + g) * (S5_T + 1) + d) * S5_STATE + pp] = make_float2(mag * cosf(ang), mag * sinf(ang));
    }
#endif
    float mag = expf(are * dt), ang = aim * dt;
    float lr = mag * cosf(ang) - 1.0f, li = mag * sinf(ang);
    float den = are * are + aim * aim;
    float fr = (lr * are + li * aim) / den, fi = (li * are - lr * aim) / den;
    for (int j = 0; j < S5_GROUP; ++j) {
      float br = p.s5_b_re[i * S5_GROUP + j], bi = p.s5_b_im[i * S5_GROUP + j];
      p.bbar()[i * S5_GROUP + j] = make_float2(fr * br - fi * bi, fr * bi + fi * br);
    }
  }
}
#ifndef CPU_TEST
DEV void rope_table_gpu(const P& p, long gtid, long gsize) {
  FOR_ITEMS(i, (long)128 * ROPE_HALF) {
    const int ii = (int)(i % ROPE_HALF), pos = (int)(i / ROPE_HALF);
    const float ang = (float)pos * powf(10000.0f, -(float)(2 * ii) / (float)AXIS_DIM);
    p.ropet()[i] = make_float2(cosf(ang), sinf(ang));
  }
}
DEV void s5_lampow_gpu(const P& p, long gtid, long gsize) {
  FOR_ITEMS4(i, (long)DEPTH * 2 * S5_GROUPS * (S5_T + 1) * S5_STATE) {
    const int pp = (int)(i % S5_STATE); const int d = (int)((i / S5_STATE) % (S5_T + 1)); const long ldg = i / ((long)S5_STATE * (S5_T + 1));
    const long src = ldg * S5_STATE + pp;
    const float are = fminf(p.s5_a_re[src], -1e-4f), aim = p.s5_a_im[src]; const float dt = expf(p.s5_log_dt[ldg]);
    const float mag = expf(are * dt * d); const float ang = aim * dt * d;
    p.lampow()[i] = make_float2(mag * cosf(ang), mag * sinf(ang));
  }
}
#endif
DEV void hy_f1(const P& p, int l, int Lf, float* h1, long gtid, long gsize) {
  FOR_ITEMS(i, (long)Lf * FILTER_HIDDEN) {
    int j = (int)(i % FILTER_HIDDEN); int t = (int)(i / FILTER_HIDDEN);
    const float* w1 = p.hy_w1 + l * FILTER_EMB * FILTER_HIDDEN;
    float tt = (float)((double)t / (double)(Lf - 1));
    float w = (float)(2.0 * PI_D * (double)t / (double)Lf);
    float acc = p.hy_b1[l * FILTER_HIDDEN + j] + tt * w1[j];
    const int bands = (FILTER_EMB - 1) / 2;
    for (int m = 0; m < bands; ++m) {
      float f = (float)(1e-4 + (double)m * ((double)(bands - 1) - 1e-4) / (double)(bands - 1));
      float a = f * w;
      acc += cosf(a) * w1[(1 + m) * FILTER_HIDDEN + j] - sinf(a) * w1[(1 + bands + m) * FILTER_HIDDEN + j];
    }
    h1[i] = sinf(p.hy_freq[l * FILTER_HIDDEN + j] * acc);
  }
}
DEV void hy_f2(const P& p, int l, int Lf, const float* h1, float* h2, long gtid, long gsize) {
  FOR_ITEMS(i, (long)Lf * FILTER_HIDDEN) {
    int j = (int)(i % FILTER_HIDDEN); int t = (int)(i / FILTER_HIDDEN);
    const float* w2 = p.hy_w2 + l * FILTER_HIDDEN * FILTER_HIDDEN;
    float acc = p.hy_b2[l * FILTER_HIDDEN + j];
    for (int k = 0; k < FILTER_HIDDEN; ++k) acc += h1[t * FILTER_HIDDEN + k] * w2[k * FILTER_HIDDEN + j];
#ifndef CPU_TEST
    h2[(long)j * Lf + t] = sinf(p.hy_freq[l * FILTER_HIDDEN + j] * acc);
#else
    h2[i] = sinf(p.hy_freq[l * FILTER_HIDDEN + j] * acc);
#endif
  }
}
DEV void hy_f3(const P& p, int l, int Lf, const float* h2, float* kraw, long gtid, long gsize) {
#ifndef CPU_TEST
  const float* w3 = p.hy_w3 + l * FILTER_HIDDEN * 2 * HYENA_W;
  FOR_ITEMS(i, (long)Lf * (2 * HYENA_W / 8)) {
    const int t = (int)(i % Lf); const int c8 = (int)(i / Lf) * 8;
    float acc[8];
#pragma unroll
    for (int j = 0; j < 8; ++j) acc[j] = 0.f;
#pragma unroll 4
    for (int k = 0; k < FILTER_HIDDEN; ++k) {
      const float hv = h2[(long)k * Lf + t];
      const float4 wa = *(const float4*)(w3 + k * 2 * HYENA_W + c8), wb = *(const float4*)(w3 + k * 2 * HYENA_W + c8 + 4);
      acc[0] += hv * wa.x; acc[1] += hv * wa.y; acc[2] += hv * wa.z; acc[3] += hv * wa.w; acc[4] += hv * wb.x; acc[5] += hv * wb.y; acc[6] += hv * wb.z; acc[7] += hv * wb.w;
    }
    const double d0 = log(1e-2) / 0.3, d1 = log(1e-2) / 1.5;
    const float tt = (float)((double)t / (double)(Lf - 1));
#pragma unroll
    for (int j = 0; j < 8; ++j) {
      const int ch = (c8 + j) % HYENA_W;
      const float delta = fabsf((float)(d0 + (d1 - d0) * (double)ch / (double)(HYENA_W - 1)));
      kraw[(long)(c8 + j) * Lf + t] = acc[j] * expf(-tt * delta);
    }
  }
#else
  FOR_ITEMS(i, (long)Lf * 2 * HYENA_W) {
    int t = (int)(i % Lf); int cc = (int)(i / Lf); int ch = cc % HYENA_W;
    const float* w3 = p.hy_w3 + l * FILTER_HIDDEN * 2 * HYENA_W;
    float acc = 0.f;
    for (int k = 0; k < FILTER_HIDDEN; ++k) acc += h2[t * FILTER_HIDDEN + k] * w3[k * 2 * HYENA_W + cc];
    double d0 = log(1e-2) / 0.3, d1 = log(1e-2) / 1.5;
    float delta = fabsf((float)(d0 + (d1 - d0) * (double)ch / (double)(HYENA_W - 1)));
    float tt = (float)((double)t / (double)(Lf - 1));
    kraw[(long)cc * Lf + t] = acc * expf(-tt * delta);
  }
#endif
}
DEV void hy_f4(int Lf, const float* kraw, float* knorm, long gtid, long gsize) {
#ifndef CPU_TEST
  const int lane = (int)(gtid & 63); const long gw = gtid >> 6, nw = gsize >> 6;
  for (long i = gw; i < HYENA_W; i += nw) {
    float s = 0.f;
    for (int t = lane; t < Lf; t += 64) { s += fabsf(kraw[i * Lf + t]); if (t > 0) s += fabsf(kraw[(HYENA_W + i) * Lf + t]); }
    for (int o = 32; o > 0; o >>= 1) s += __shfl_xor(s, o);
    if (lane == 0) knorm[i] = 1.0f / s;
  }
#else
  FOR_ITEMS(i, HYENA_W) {
    float s = 0.f;
    for (int t = 0; t < Lf; ++t) {
      s += fabsf(kraw[(long)i * Lf + t]);
      if (t > 0) s += fabsf(kraw[(long)(HYENA_W + i) * Lf + t]);
    }
    knorm[i] = 1.0f / s;
  }
#endif
}
#ifndef CPU_TEST
DEV float rl_f(float v, int srcl) { return __int_as_float(__builtin_amdgcn_readlane(__float_as_int(v), srcl)); }
DEV void hy_f1g(const P& p, int l, int Lf, float* h1, long gtid, long gsize) {
  const int lane = (int)(gtid & 63);
  const float* w1 = p.hy_w1 + l * FILTER_EMB * FILTER_HIDDEN;
  const int bands = (FILTER_EMB - 1) / 2;
  static_assert(FILTER_HIDDEN == 64 && (FILTER_EMB - 1) / 2 == 16, "filter shape");
  FOR_ITEMS(i, (long)Lf * FILTER_HIDDEN) {
    const int j = lane; const int t = (int)(i / FILTER_HIDDEN);
    const float tt = (float)((double)t / (double)(Lf - 1));
    const float w = (float)(2.0 * PI_D * (double)t / (double)Lf);
    const int mm = lane & 15;
    const float f = (float)(1e-4 + (double)mm * ((double)(bands - 1) - 1e-4) / (double)(bands - 1));
    const float a = f * w; const float ca = cosf(a), sa = sinf(a);
    float acc = p.hy_b1[l * FILTER_HIDDEN + j] + tt * w1[j];
#pragma unroll
    for (int m = 0; m < 16; ++m) acc += rl_f(ca, m) * w1[(1 + m) * FILTER_HIDDEN + j] - rl_f(sa, m) * w1[(1 + bands + m) * FILTER_HIDDEN + j];
    h1[i] = sinf(p.hy_freq[l * FILTER_HIDDEN + j] * acc);
  }
}
DEV void hy_f2g(const P& p, int l, int Lf, const float* h1, float* h2, long gtid, long gsize) {
  const int j = (int)(gtid & 63);
  const float* w2 = p.hy_w2 + l * FILTER_HIDDEN * FILTER_HIDDEN;
  float wc[FILTER_HIDDEN];
#pragma unroll
  for (int k = 0; k < FILTER_HIDDEN; ++k) wc[k] = w2[k * FILTER_HIDDEN + j];
  const float b2 = p.hy_b2[l * FILTER_HIDDEN + j], fq = p.hy_freq[l * FILTER_HIDDEN + j];
  FOR_ITEMS(i, (long)Lf * FILTER_HIDDEN) {
    const int t = __builtin_amdgcn_readfirstlane((int)(i / FILTER_HIDDEN));
    const float4* hr = (const float4*)(h1 + (long)t * FILTER_HIDDEN);
    float acc = b2;
#pragma unroll
    for (int k4 = 0; k4 < FILTER_HIDDEN / 4; ++k4) { const float4 h = hr[k4]; acc += h.x * wc[4 * k4] ; acc += h.y * wc[4 * k4 + 1]; acc += h.z * wc[4 * k4 + 2]; acc += h.w * wc[4 * k4 + 3]; }
    h2[(long)j * Lf + t] = sinf(fq * acc);
  }
}
DEV void hy_f3g(const P& p, int l, int Lf, const float* h2, float* kraw, float* psum, long gtid, long gsize) {
  const float* w3 = p.hy_w3 + l * FILTER_HIDDEN * 2 * HYENA_W;
  const int nblk = Lf >> 8; const int lane = (int)(gtid & 63);
  FOR_ITEMS(i, (long)(2 * HYENA_W / 8) * nblk * 64) {
    const int wi = __builtin_amdgcn_readfirstlane((int)(i >> 6));
    const int c8 = (wi / nblk) * 8, tb = wi % nblk, t0 = tb * 256 + lane;
    float acc[4][8];
#pragma unroll
    for (int q = 0; q < 4; ++q)
#pragma unroll
      for (int j = 0; j < 8; ++j) acc[q][j] = 0.f;
#pragma unroll 2
    for (int k = 0; k < FILTER_HIDDEN; ++k) {
      const float4 wa = *(const float4*)(w3 + k * 2 * HYENA_W + c8), wb = *(const float4*)(w3 + k * 2 * HYENA_W + c8 + 4);
#pragma unroll
      for (int q = 0; q < 4; ++q) {
        const float hv = h2[(long)k * Lf + t0 + 64 * q];
        acc[q][0] += hv * wa.x; acc[q][1] += hv * wa.y; acc[q][2] += hv * wa.z; acc[q][3] += hv * wa.w; acc[q][4] += hv * wb.x; acc[q][5] += hv * wb.y; acc[q][6] += hv * wb.z; acc[q][7] += hv * wb.w;
      }
    }
    const double d0 = log(1e-2) / 0.3, d1 = log(1e-2) / 1.5;
    float ps[8];
#pragma unroll
    for (int j = 0; j < 8; ++j) ps[j] = 0.f;
#pragma unroll
    for (int j = 0; j < 8; ++j) {
      const int ch = (c8 + j) % HYENA_W;
      const float delta = fabsf((float)(d0 + (d1 - d0) * (double)ch / (double)(HYENA_W - 1)));
#pragma unroll
      for (int q = 0; q < 4; ++q) {
        const int t = t0 + 64 * q; const float tt = (float)((double)t / (double)(Lf - 1));
        const float v = acc[q][j] * expf(-tt * delta);
        kraw[(long)(c8 + j) * Lf + t] = v;
        ps[j] += (c8 >= HYENA_W && t == 0) ? 0.f : fabsf(v);
      }
    }
#pragma unroll
    for (int j = 0; j < 8; ++j) {
      float v = ps[j];
#pragma unroll
      for (int o = 32; o > 0; o >>= 1) v += __shfl_xor(v, o);
      if (lane == 0) psum[(long)(c8 + j) * nblk + tb] = v;
    }
  }
}
DEV void hy_f4g(int Lf, const float* psum, float* knorm, long gtid, long gsize) {
  const int lane = (int)(gtid & 63); const long gw = gtid >> 6, nw = gsize >> 6; const int nblk = Lf >> 8;
  for (long i = gw; i < HYENA_W; i += nw) {
    float s = 0.f;
    for (int q = lane; q < nblk; q += 64) s += psum[i * nblk + q] + psum[(HYENA_W + i) * nblk + q];
#pragma unroll
    for (int o = 32; o > 0; o >>= 1) s += __shfl_xor(s, o);
    if (lane == 0) knorm[i] = 1.0f / s;
  }
}
#define HY_PSUM(f) (p.tmp() + (long)(f) * 2 * HYENA_W * (SEQ >> 8))
#endif
DEV void ph_g1(const P& p, long gtid, long gsize) {
#ifndef CPU_TEST
  for (int l = 0; l < DEPTH; ++l) hy_f1g(p, l, SEQ, p.fh1() + (long)l * SEQ * FILTER_HIDDEN, gtid, gsize);
  hy_f1g(p, 0, CTX_LEN, p.fh1c(), gtid, gsize);
#else
  for (int l = 0; l < DEPTH; ++l) hy_f1(p, l, SEQ, p.fh1() + (long)l * SEQ * FILTER_HIDDEN, gtid, gsize);
  hy_f1(p, 0, CTX_LEN, p.fh1c(), gtid, gsize);
#endif
  FOR_ITEMS(i, (long)DEPTH * 2 * S5_GROUPS * S5_T * S5_GROUP * S5_GROUP) {
    int j = (int)(i % S5_GROUP); int ii = (int)((i / S5_GROUP) % S5_GROUP); int d = (int)((i / (S5_GROUP * S5_GROUP)) % S5_T);
    long ldg = i / (S5_GROUP * S5_GROUP * S5_T);
    float acc = 0.f;
    for (int pp = 0; pp < S5_STATE; ++pp) {
      float cr = p.s5_c_re[(ldg * S5_GROUP + ii) * S5_STATE + pp], ci = p.s5_c_im[(ldg * S5_GROUP + ii) * S5_STATE + pp];
      float2 lp = p.lampow()[(ldg * (S5_T + 1) + d) * S5_STATE + pp];
      float2 bb = p.bbar()[(ldg * S5_STATE + pp) * S5_GROUP + j];
      float tr = lp.x * bb.x - lp.y * bb.y, ti = lp.x * bb.y + lp.y * bb.x;
      acc += cr * tr - ci * ti;
    }
    p.kc()[i] = acc;
  }
}
#ifndef CPU_TEST
DEV void ph_g2(const P& p, long gtid, long gsize) {
  for (int l = 0; l < DEPTH; ++l) hy_f2g(p, l, SEQ, p.fh1() + (long)l * SEQ * FILTER_HIDDEN, p.fh2() + (long)l * SEQ * FILTER_HIDDEN, gtid, gsize);
  hy_f2g(p, 0, CTX_LEN, p.fh1c(), p.fh2c(), gtid, gsize);
}
DEV void ph_g3(const P& p, long gtid, long gsize) {
  for (int l = 0; l < DEPTH; ++l) hy_f3g(p, l, SEQ, p.fh2() + (long)l * SEQ * FILTER_HIDDEN, p.kraw() + (long)l * SEQ * 2 * HYENA_W, HY_PSUM(l), gtid, gsize);
  hy_f3g(p, 0, CTX_LEN, p.fh2c(), p.krawc(), HY_PSUM(DEPTH), gtid, gsize);
}
DEV void ph_g4(const P& p, long gtid, long gsize) {
  for (int l = 0; l < DEPTH; ++l) hy_f4g(SEQ, HY_PSUM(l), p.knorm() + l * HYENA_W, gtid, gsize);
  hy_f4g(CTX_LEN, HY_PSUM(DEPTH), p.knormc(), gtid, gsize);
}
#else
DEV void ph_g2(const P& p, long gtid, long gsize) {
  for (int l = 0; l < DEPTH; ++l) hy_f2(p, l, SEQ, p.fh1() + (long)l * SEQ * FILTER_HIDDEN, p.fh2() + (long)l * SEQ * FILTER_HIDDEN, gtid, gsize);
  hy_f2(p, 0, CTX_LEN, p.fh1c(), p.fh2c(), gtid, gsize);
}
DEV void ph_g3(const P& p, long gtid, long gsize) {
  for (int l = 0; l < DEPTH; ++l) hy_f3(p, l, SEQ, p.fh2() + (long)l * SEQ * FILTER_HIDDEN, p.kraw() + (long)l * SEQ * 2 * HYENA_W, gtid, gsize);
  hy_f3(p, 0, CTX_LEN, p.fh2c(), p.krawc(), gtid, gsize);
}
DEV void ph_g4(const P& p, long gtid, long gsize) {
  for (int l = 0; l < DEPTH; ++l) hy_f4(SEQ, p.kraw() + (long)l * SEQ * 2 * HYENA_W, p.knorm() + l * HYENA_W, gtid, gsize);
  hy_f4(CTX_LEN, p.krawc(), p.knormc(), gtid, gsize);
}
#endif
#define NG 5

DEV void ph_modu(const P& p, int l, int which, long gtid, long gsize) {
  FOR_ITEMS(i, (long)NR * D_MODEL) {
    int k = (int)(i % D_MODEL); long r = i / D_MODEL;
    const float* m = p.mod() + ((long)l * (BATCH + 1) + modrow(r)) * 6 * D_MODEL + which * 3 * D_MODEL;
    float uv = p.xcur()[i] * (1.0f + m[D_MODEL + k]) + m[k];
    p.ubuf()[i] = uv; p.ubf()[i] = f2bf16(uv);
  }
}
template <class Epi>
DEV void gemm_naive(const float* A, int lda, const float* B, int ldb, int M, int N, int K, Epi epi, long gtid, long gsize) {
  FOR_ITEMS(i, (long)(M / 4) * N) {
    int n = (int)(i % N); long r0 = (i / N) * 4;
    const float* a0 = A + r0 * lda;
    float c0 = 0.f, c1 = 0.f, c2 = 0.f, c3 = 0.f;
    for (int k = 0; k < K; ++k) {
      float b = B[(long)k * ldb + n];
      c0 += a0[k] * b; c1 += a0[lda + k] * b; c2 += a0[2 * lda + k] * b; c3 += a0[3 * lda + k] * b;
    }
    epi(r0, n, c0); epi(r0 + 1, n, c1); epi(r0 + 2, n, c2); epi(r0 + 3, n, c3);
  }
}
struct EpiStore { float* C; int ldc; DEVM void operator()(long r, int n, float v) const { C[r * ldc + n] = v; } };
DEV void ph_proj(const P& p, int l, long gtid, long gsize) {
  EpiStore e{p.proj(), IN_W};
  gemm_naive(p.ubuf(), D_MODEL, p.w_in + (long)l * D_MODEL * IN_W, IN_W, NR, IN_W, D_MODEL, e, gtid, gsize);
}
DEV long s5_row(int b, int dir, int n) {
  if (n < CTX_LEN) return (long)NL + b * CTX_LEN + (dir ? CTX_LEN - 1 - n : n);
  int t = n - CTX_LEN; return (long)b * SEQ + (dir ? SEQ - 1 - t : t);
}
DEV void ph_post_proj(const P& p, int l, long gtid, long gsize) {
  FOR_ITEMS(i, (long)NL * (N_Q_HEADS + N_KV_HEADS) * 2 * ROPE_HALF) {
    int ii = (int)(i % ROPE_HALF); int a = (int)((i / ROPE_HALF) % 2); int hs = (int)((i / (2 * ROPE_HALF)) % (N_Q_HEADS + N_KV_HEADS));
    long r = i / (2 * ROPE_HALF * (N_Q_HEADS + N_KV_HEADS));
    int t = (int)(r % SEQ); int pos = a == 0 ? t / GRID_W : t % GRID_W;
    float inv = powf(10000.0f, -(float)(2 * ii) / (float)AXIS_DIM);
    float ang = (float)pos * inv; float cs = cosf(ang), sn = sinf(ang);
    float* q = p.proj() + r * IN_W + hs * HEAD_DIM + a * AXIS_DIM + ii;
    float x1 = q[0], x2 = q[ROPE_HALF];
    q[0] = x1 * cs - x2 * sn; q[ROPE_HALF] = x1 * sn + x2 * cs;
  }
#ifdef CPU_TEST
  FOR_ITEMS(i, (long)NR * HYENA_W) {
    int ch = (int)(i % HYENA_W); long r = i / HYENA_W;
    int Ls = r < NL ? SEQ : CTX_LEN; long base = r < NL ? (r / SEQ) * SEQ : NL + ((r - NL) / CTX_LEN) * CTX_LEN; int t = (int)(r - base);
    const float* sw = p.hy_short_w + l * 3 * 3 * HYENA_W; const float* sb = p.hy_short_b + l * 3 * HYENA_W;
    float z[3];
#pragma unroll
    for (int part = 0; part < 3; ++part) {
      int cc = part * HYENA_W + ch; float acc = sb[cc];
#pragma unroll
      for (int j = 0; j < 3; ++j) { int tt = t + j - 1; if (tt >= 0 && tt < Ls) acc += p.proj()[(base + tt) * IN_W + HY_OFF + cc] * sw[j * 3 * HYENA_W + cc]; }
      z[part] = acc;
    }
    long o = r < NL ? ((r / SEQ) * HYENA_W + ch) * SEQ + t : i;
    p.hu()[o] = z[0] * z[1]; p.hx0()[o] = z[2];
  }
#endif
#ifndef CPU_TEST
  FOR_ITEMS(i, (long)NR * S5_W) { long r = i / S5_W; int cc = (int)(i % S5_W); p.s5u()[i] = f2bf16(p.proj()[r * IN_W + S5_OFF + cc]); }
#endif
#ifdef CPU_TEST
  FOR_ITEMS(i, (long)BATCH * 2 * S5_GROUPS * NCH * S5_STATE) {
    int pp = (int)(i % S5_STATE); int c = (int)((i / S5_STATE) % NCH); int g = (int)((i / (S5_STATE * NCH)) % S5_GROUPS);
    int dir = (int)((i / (S5_STATE * NCH * S5_GROUPS)) % 2); int b = (int)(i / (S5_STATE * NCH * S5_GROUPS * 2));
    long ldg = ((long)l * 2 + dir) * S5_GROUPS + g;
    float sr = 0.f, si = 0.f;
    for (int s = 0; s < S5_T; ++s) {
      const float* u = p.proj() + s5_row(b, dir, c * S5_T + s) * IN_W + S5_OFF + g * S5_GROUP;
      float br = 0.f, bi = 0.f;
#pragma unroll
      for (int j = 0; j < S5_GROUP; ++j) { float2 bb = p.bbar()[(ldg * S5_STATE + pp) * S5_GROUP + j]; br += bb.x * u[j]; bi += bb.y * u[j]; }
      float2 lp = p.lampow()[(ldg * (S5_T + 1) + (S5_T - 1 - s)) * S5_STATE + pp];
      sr += lp.x * br - lp.y * bi; si += lp.x * bi + lp.y * br;
    }
    p.sc()[i] = make_float2(sr, si);
  }
#endif
}
DEV void attn_item(const P& p, int l, long r, int h, float* outp) {
  const float scale = 1.0f / sqrtf((float)HEAD_DIM);
  float q[HEAD_DIM], acc[HEAD_DIM];
  const float* qp = p.proj() + r * IN_W + Q_OFF + h * HEAD_DIM;
#pragma unroll
  for (int d = 0; d < HEAD_DIM; ++d) { q[d] = qp[d] * scale; acc[d] = 0.f; }
  int kvh = h / Q_GROUP; int b = r < NL ? (int)(r / SEQ) : (int)((r - NL) / CTX_LEN);
  float m = -1e30f, lsum = 0.f;
  int nwin = 0, t = 0;
  if (r < NL) { t = (int)(r % SEQ); nwin = 2 * WINDOW + 1; }
  for (int j = 0; j < nwin + CTX_LEN; ++j) {
    long kr;
    if (j < nwin) { int tk = t - WINDOW + j; if (tk < 0 || tk >= SEQ) continue; kr = (long)b * SEQ + tk; }
    else kr = (long)NL + b * CTX_LEN + (j - nwin);
    const float* kp = p.proj() + kr * IN_W + K_OFF + kvh * HEAD_DIM; const float* vp = p.proj() + kr * IN_W + V_OFF + kvh * HEAD_DIM;
    float s = 0.f;
#pragma unroll
    for (int d = 0; d < HEAD_DIM; ++d) s += q[d] * kp[d];
    float mn = fmaxf(m, s); float corr = expf(m - mn); float pe = expf(s - mn);
    lsum = lsum * corr + pe;
#pragma unroll
    for (int d = 0; d < HEAD_DIM; ++d) acc[d] = acc[d] * corr + pe * vp[d];
    m = mn;
  }
  float sk = p.sink[l * N_Q_HEADS + h]; float mf = fmaxf(m, sk); float corr = expf(m - mf);
  float den = lsum * corr + expf(sk - mf); float sc2 = corr / den;
#pragma unroll
  for (int d = 0; d < HEAD_DIM; ++d) outp[d] = acc[d] * sc2;
}
DEV void ph_mix(const P& p, int l, long gtid, long gsize) {
#ifdef CPU_TEST
  long nrows_att = l == 0 ? NR : NL;
  FOR_ITEMS(i, nrows_att * N_Q_HEADS) { int h = (int)(i % N_Q_HEADS); long r = i / N_Q_HEADS; attn_item(p, l, r, h, p.mixb() + r * MIX_W + h * HEAD_DIM); }
#endif
#ifdef CPU_TEST
  FOR_ITEMS(i, (long)NL * HYENA_W) {
    int ch = (int)(i % HYENA_W); long r = i / HYENA_W; int t = (int)(r % SEQ); int b = (int)(r / SEQ);
    const float* kf = p.kraw() + ((long)l * 2 * HYENA_W + ch) * SEQ; const float* kb = p.kraw() + ((long)l * 2 * HYENA_W + HYENA_W + ch) * SEQ;
    const float* uu = p.hu() + ((long)b * HYENA_W + ch) * SEQ;
    float acc = 0.f;
    for (int s = 0; s <= t; ++s) acc += kf[t - s] * uu[s];
    for (int s = t + 1; s < SEQ; ++s) acc += kb[s - t] * uu[s];
    p.mixb()[r * MIX_W + ATTN_W + ch] = (acc * p.knorm()[l * HYENA_W + ch] + uu[t] * p.hy_d[l * HYENA_W + ch]) * p.hx0()[((long)b * HYENA_W + ch) * SEQ + t];
  }
#endif
  if (l == 0) {
#ifndef CPU_TEST
    FOR_ITEMS(i, (long)NC * HYENA_W) {
      const int t = (int)(i % CTX_LEN); const int ch = (int)((i / CTX_LEN) % HYENA_W); const int b = (int)(i / ((long)CTX_LEN * HYENA_W));
      const long base = (long)NL + (long)b * CTX_LEN; const long r = base + t;
      const float* kf = p.krawc() + (long)ch * CTX_LEN; const float* kb = p.krawc() + (long)(HYENA_W + ch) * CTX_LEN;
      float acc = 0.f;
#pragma unroll 8
      for (int sidx = 0; sidx < CTX_LEN; ++sidx) {
        const int d = t - sidx; const float kv = d >= 0 ? kf[d] : kb[-d];
        acc += kv * p.hu()[(base + sidx) * HYENA_W + ch];
      }
      const float u = p.hu()[r * HYENA_W + ch];
      p.mixb()[r * MIX_W + ATTN_W + ch] = (acc * p.knormc()[ch] + u * p.hy_d[l * HYENA_W + ch]) * p.hx0()[r * HYENA_W + ch];
    }
#else
    FOR_ITEMS(i, (long)NC * HYENA_W) {
      int ch = (int)(i % HYENA_W); long r = NL + i / HYENA_W; int t = (int)((r - NL) % CTX_LEN); long base = r - t;
      float acc = 0.f;
      for (int s = 0; s <= t; ++s) acc += p.krawc()[(long)ch * CTX_LEN + (t - s)] * p.hu()[(base + s) * HYENA_W + ch];
      for (int s = t + 1; s < CTX_LEN; ++s) acc += p.krawc()[(long)(HYENA_W + ch) * CTX_LEN + (s - t)] * p.hu()[(base + s) * HYENA_W + ch];
      float u = p.hu()[r * HYENA_W + ch];
      p.mixb()[r * MIX_W + ATTN_W + ch] = (acc * p.knormc()[ch] + u * p.hy_d[l * HYENA_W + ch]) * p.hx0()[r * HYENA_W + ch];
    }
#endif
  }
#ifdef CPU_TEST
  FOR_ITEMS(i, (long)BATCH * 2 * S5_GROUPS * S5_STATE) {
    int pp = (int)(i % S5_STATE); int g = (int)((i / S5_STATE) % S5_GROUPS); int dir = (int)((i / (S5_STATE * S5_GROUPS)) % 2); int b = (int)(i / (S5_STATE * S5_GROUPS * 2));
    long ldg = ((long)l * 2 + dir) * S5_GROUPS + g;
    float2 lt = p.lampow()[(ldg * (S5_T + 1) + S5_T) * S5_STATE + pp];
    float hr = 0.f, hi = 0.f;
    long base = (((long)b * 2 + dir) * S5_GROUPS + g) * NCH;
#ifndef CPU_TEST
    static_assert(NCH % 12 == 0, "carry batching");
    for (int c0 = 0; c0 < NCH; c0 += 12) {
      float2 sv[12];
#pragma unroll
      for (int k = 0; k < 12; ++k) sv[k] = p.sc()[(base + c0 + k) * S5_STATE + pp];
#pragma unroll
      for (int k = 0; k < 12; ++k) {
        p.hcbf()[(base + c0 + k) * 2 * S5_STATE + pp] = f2bf16(hr); p.hcbf()[(base + c0 + k) * 2 * S5_STATE + S5_STATE + pp] = f2bf16(hi);
        const float nr = lt.x * hr - lt.y * hi + sv[k].x, ni = lt.x * hi + lt.y * hr + sv[k].y;
        hr = nr; hi = ni;
      }
    }
#else
    for (int c = 0; c < NCH; ++c) {
      p.hc()[(base + c) * S5_STATE + pp] = make_float2(hr, hi);
      float2 s = p.sc()[(base + c) * S5_STATE + pp];
      float nr = lt.x * hr - lt.y * hi + s.x, ni = lt.x * hi + lt.y * hr + s.y;
      hr = nr; hi = ni;
    }
#endif
  }
#endif
}
DEV void ph_s5out(const P& p, int l, long gtid, long gsize) {
  FOR_ITEMS(i, (long)NR * S5_W) {
    int chn = (int)(i % S5_W); long r = i / S5_W; int g = chn / S5_GROUP, ii = chn % S5_GROUP;
    int b, tl; bool isctx = r >= NL;
    if (isctx) { b = (int)((r - NL) / CTX_LEN); tl = (int)((r - NL) % CTX_LEN); } else { b = (int)(r / SEQ); tl = (int)(r % SEQ); }
    float y = p.s5_d[l * S5_W + chn] * p.proj()[r * IN_W + S5_OFF + chn];
    for (int dir = 0; dir < 2; ++dir) {
      int n = isctx ? (dir ? CTX_LEN - 1 - tl : tl) : CTX_LEN + (dir ? SEQ - 1 - tl : tl);
      int c = n / S5_T, tau = n % S5_T;
      long ldg = ((long)l * 2 + dir) * S5_GROUPS + g;
      long hb = ((((long)b * 2 + dir) * S5_GROUPS + g) * NCH + c) * S5_STATE;
      for (int pp = 0; pp < S5_STATE; ++pp) {
        float cr = p.s5_c_re[(ldg * S5_GROUP + ii) * S5_STATE + pp], ci = p.s5_c_im[(ldg * S5_GROUP + ii) * S5_STATE + pp];
        float2 lp = p.lampow()[(ldg * (S5_T + 1) + tau + 1) * S5_STATE + pp]; float2 h = p.hc()[hb + pp];
        float tr = lp.x * h.x - lp.y * h.y, ti = lp.x * h.y + lp.y * h.x;
        y += cr * tr - ci * ti;
      }
      for (int s = 0; s <= tau; ++s) {
        const float* u = p.proj() + s5_row(b, dir, c * S5_T + s) * IN_W + S5_OFF + g * S5_GROUP;
        const float* kk = p.kc() + ((ldg * S5_T + (tau - s)) * S5_GROUP + ii) * S5_GROUP;
#pragma unroll
        for (int j = 0; j < S5_GROUP; ++j) y += kk[j] * u[j];
      }
    }
    float gy = gelu_tanhf(y); p.ybuf()[i] = gy; p.ybf()[i] = f2bf16(gy);
  }
}
struct EpiGlu { const float* g; float* mixb; DEVM void operator()(long r, int n, float v) const { mixb[r * MIX_W + ATTN_W + HYENA_W + n] = g[r * S5_W + n] * sigmoidf_(v); } };
DEV void ph_glu(const P& p, int l, long gtid, long gsize) {
  EpiGlu e{p.ybuf(), p.mixb()};
  gemm_naive(p.ybuf(), S5_W, p.s5_w_glu + (long)l * S5_W * S5_W, S5_W, NR, S5_W, S5_W, e, gtid, gsize);
}
DEV void ph_rms(const P& p, int l, long gtid, long gsize) {
  FOR_ITEMS(i, (long)NR * 3) {
    int grp = (int)(i % 3); long r = i / 3;
    int off = grp == 0 ? 0 : (grp == 1 ? ATTN_W : ATTN_W + HYENA_W); int w = grp == 0 ? ATTN_W : (grp == 1 ? HYENA_W : S5_W);
    float* v = p.mixb() + r * MIX_W + off; float ss = 0.f;
    for (int k = 0; k < w; ++k) ss += v[k] * v[k];
    float rs = 1.0f / sqrtf(ss / (float)w + LN_EPS);
    for (int k = 0; k < w; ++k) { float nv = v[k] * rs * p.mix_g[l * MIX_W + off + k]; v[k] = nv; p.mixbf()[r * MIX_W + off + k] = f2bf16(nv); }
  }
}
struct EpiRes { const float* xcur; const float* mod; int l; int goff; float* tmp;
  DEVM void operator()(long r, int n, float v) const { const float* m = mod + ((long)l * (BATCH + 1) + modrow(r)) * 6 * D_MODEL + goff; tmp[r * D_MODEL + n] = DN_ALPHA * xcur[r * D_MODEL + n] + m[n] * v; } };
DEV void ph_outproj(const P& p, int l, long gtid, long gsize) {
  EpiRes e{p.xcur(), p.mod(), l, 2 * D_MODEL, p.tmp()};
  gemm_naive(p.mixb(), MIX_W, p.w_out + (long)l * MIX_W * D_MODEL, D_MODEL, NR, D_MODEL, MIX_W, e, gtid, gsize);
}
DEV void ph_ln(const P& p, int l, int which, long gtid, long gsize) {
  const float* gw = (which == 0 ? p.ln1_g : p.ln2_g) + l * D_MODEL; const float* bw = (which == 0 ? p.ln1_b : p.ln2_b) + l * D_MODEL;
  FOR_ITEMS(r, (long)NR) {
    const float* v = p.tmp() + r * D_MODEL; float mu = 0.f;
#pragma unroll 4
    for (int k = 0; k < D_MODEL; ++k) mu += v[k];
    mu /= (float)D_MODEL; float var = 0.f;
#pragma unroll 4
    for (int k = 0; k < D_MODEL; ++k) { float d = v[k] - mu; var += d * d; }
    float rs = 1.0f / sqrtf(var / (float)D_MODEL + LN_EPS);
    const float* m = p.mod() + ((long)l * (BATCH + 1) + modrow(r)) * 6 * D_MODEL + 3 * D_MODEL;
#pragma unroll 2
    for (int k = 0; k < D_MODEL; ++k) {
      float y = (v[k] - mu) * rs * gw[k] + bw[k];
      p.xcur()[r * D_MODEL + k] = y;
      if (which == 0) { float uv = y * (1.0f + m[D_MODEL + k]) + m[k]; p.ubuf()[r * D_MODEL + k] = uv; p.ubf()[r * D_MODEL + k] = f2bf16(uv); }
      if (which == 1 && l == DEPTH - 1 && r < NL) p.out[r * D_MODEL + k] = y;
    }
  }
}
DEV void ph_router(const P& p, int l, long gtid, long gsize) {
  EpiStore e{p.rl(), N_EXPERTS};
  gemm_naive(p.ubuf(), D_MODEL, p.w_router + (long)l * D_MODEL * N_EXPERTS, N_EXPERTS, NR, N_EXPERTS, D_MODEL, e, gtid, gsize);
}
DEV bool better(float v, int i, float bv, int bi) { return v > bv || (v == bv && i < bi); }
DEV void ph_select(const P& p, int l, long gtid, long gsize) {
  FOR_ITEMS(r, (long)NR) {
    const float* lg = p.rl() + r * N_EXPERTS; const float* rb = p.router_bias + l * N_EXPERTS;
    float gs[N_EXPERT_GROUPS];
#pragma unroll
    for (int g = 0; g < N_EXPERT_GROUPS; ++g) {
      float m1 = -1e30f, m2 = -1e30f;
      for (int e = 0; e < EPG; ++e) { float v = sigmoidf_(lg[g * EPG + e]) + rb[g * EPG + e]; if (v > m1) { m2 = m1; m1 = v; } else if (v > m2) m2 = v; }
      gs[g] = m1 + m2;
    }
    unsigned keep = 0;
#pragma unroll
    for (int it = 0; it < TOPK_GROUPS; ++it) {
      float bv = -1e30f; int bi = -1;
#pragma unroll
      for (int g = 0; g < N_EXPERT_GROUPS; ++g) if (!((keep >> g) & 1u) && (bi < 0 || gs[g] > bv)) { bv = gs[g]; bi = g; }
      keep |= 1u << bi;
    }
    float lastv = 1e30f; int lasti = -1; float gsum = 0.f;
    for (int it = 0; it < TOP_K; ++it) {
      float bv = -1e30f; int bi = -1;
      for (int e = 0; e < N_EXPERTS; ++e) {
        if (!((keep >> (e / EPG)) & 1u)) continue;
        float v = sigmoidf_(lg[e]) + rb[e];
        if (!better(lastv, lasti, v, e)) continue;
        if (bi < 0 || better(v, e, bv, bi)) { bv = v; bi = e; }
      }
      lastv = bv; lasti = bi;
      float sc = sigmoidf_(lg[bi]); gsum += sc;
      p.top_e()[r * TOP_K + it] = bi; p.gate()[r * TOP_K + it] = sc;
      p.posb()[r * TOP_K + it] = atomicAdd(&p.cnt()[l * N_EXPERTS + bi], 1);
    }
    float inv = ROUTED_SCALE / gsum;
    for (int it = 0; it < TOP_K; ++it) p.gate()[r * TOP_K + it] *= inv;
  }
}
DEV void ph_sortrows(const P& p, int l, long gtid, long gsize) {
  FOR_ITEMS(i, (long)NR * TOP_K) {
    int e = p.top_e()[i]; int off = 0;
    for (int j = 0; j < e; ++j) off += p.cnt()[l * N_EXPERTS + j];
    p.srow()[off + p.posb()[i]] = (int)i;
  }
}
DEV void ph_expert_up(const P& p, int l, long gtid, long gsize) {
  FOR_ITEMS(i, (long)NR * TOP_K * EXPERT_FF) {
    int cidx = (int)(i % EXPERT_FF); int a = p.srow()[i / EXPERT_FF]; int e = p.top_e()[a]; long r = a / TOP_K;
    const float* xg = p.ubuf() + r * D_MODEL;
    const float* wg = p.w_exp_gate + ((long)l * N_EXPERTS + e) * D_MODEL * EXPERT_FF; const float* wu = p.w_exp_up + ((long)l * N_EXPERTS + e) * D_MODEL * EXPERT_FF;
    float g = 0.f, u = 0.f;
    for (int k = 0; k < D_MODEL; ++k) { float xv = xg[k]; g += xv * wg[(long)k * EXPERT_FF + cidx]; u += xv * wu[(long)k * EXPERT_FF + cidx]; }
    p.hbuf()[(long)a * EXPERT_FF + cidx] = siluf(g) * u;
  }
  FOR_ITEMS(i, (long)NR * SHARED_FF) {
    int cidx = (int)(i % SHARED_FF); long r = i / SHARED_FF;
    const float* xg = p.ubuf() + r * D_MODEL;
    const float* wg = p.w_sh_gate + (long)l * D_MODEL * SHARED_FF; const float* wu = p.w_sh_up + (long)l * D_MODEL * SHARED_FF;
    float g = 0.f, u = 0.f;
    for (int k = 0; k < D_MODEL; ++k) { float xv = xg[k]; g += xv * wg[(long)k * SHARED_FF + cidx]; u += xv * wu[(long)k * SHARED_FF + cidx]; }
    p.hsb()[i] = siluf(g) * u;
  }
}
DEV void ph_expert_down(const P& p, int l, long gtid, long gsize) {
  FOR_ITEMS(i, (long)NR * TOP_K * D_MODEL) {
    int d = (int)(i % D_MODEL); long a = i / D_MODEL;
    int e = p.top_e()[a]; const float* wd = p.w_exp_down + ((long)l * N_EXPERTS + e) * EXPERT_FF * D_MODEL;
    const float* h = p.hbuf() + a * EXPERT_FF; float acc = 0.f;
    for (int cidx = 0; cidx < EXPERT_FF; ++cidx) acc += h[cidx] * wd[(long)cidx * D_MODEL + d];
    p.yk()[i] = acc * p.gate()[a];
  }
  FOR_ITEMS(i, (long)NR * D_MODEL) {
    int d = (int)(i % D_MODEL); long r = i / D_MODEL;
    const float* wsd = p.w_sh_down + (long)l * SHARED_FF * D_MODEL; const float* hs = p.hsb() + r * SHARED_FF;
    float acc = 0.f;
    for (int cidx = 0; cidx < SHARED_FF; ++cidx) acc += hs[cidx] * wsd[(long)cidx * D_MODEL + d];
    p.ysh()[i] = acc;
  }
}
DEV void ph_combine(const P& p, int l, long gtid, long gsize) {
#pragma unroll 1
  FOR_ITEMS(i, (long)NR * D_MODEL) {
    int d = (int)(i % D_MODEL); long r = i / D_MODEL;
    float f = p.ysh()[i];
#pragma unroll
    for (int k = 0; k < TOP_K; ++k) f += p.yk()[(r * TOP_K + k) * D_MODEL + d];
    const float* m = p.mod() + ((long)l * (BATCH + 1) + modrow(r)) * 6 * D_MODEL + 5 * D_MODEL;
    p.tmp()[i] = DN_ALPHA * p.xcur()[i] + m[d] * f;
  }
}
#define NLP 16


#ifndef CPU_TEST
typedef __attribute__((ext_vector_type(8))) short bf16x8;
typedef __attribute__((ext_vector_type(4))) float f32x4;
typedef __attribute__((ext_vector_type(4))) unsigned u32x4;
typedef __attribute__((ext_vector_type(2))) unsigned u32x2;
static_assert(N_EXPERTS == 256 && D_MODEL % 128 == 0 && NR % 128 == 0, "shape assumptions");
#define SM_XB 0
#define NT 512
#define SM_A 256
#define SM_B (256 + 16384)
#define SM_MISC (256 + 98304)
#define SMEM_BYTES (256 + 98304 + 4096)

DEV int otid() { int t = threadIdx.x; asm volatile("" : "+v"(t)); return t; }
typedef __bf16 bf16x2_t __attribute__((ext_vector_type(2)));
typedef float f32x2_t __attribute__((ext_vector_type(2)));
DEV unsigned pack2(float a, float b) { f32x2_t v = {a, b}; return __builtin_bit_cast(unsigned, __builtin_convertvector(v, bf16x2_t)); }
DEV unsigned f2bf(float f) { return pack2(f, 0.f) & 0xffffu; }
DEV int tile_off(int row, int chunk) { return row * 128 + ((chunk ^ ((row >> 1) & 7)) << 4); }

DEV float bflo(float x) { return x - __uint_as_float(f2bf(x) << 16); }
DEV void wt_convert(const float* W, unsigned short* WT, int K, int N, bool lo, long gtid, long gsize) {
  FOR_ITEMS4(i, (long)N * (K / 8)) {
    const int n = (int)(i % N); const int k8 = (int)(i / N) * 8;
    float v[8];
#pragma unroll
    for (int j = 0; j < 8; ++j) { const float x = W[(long)(k8 + j) * N + n]; v[j] = lo ? bflo(x) : x; }
    u32x4 o; o[0] = pack2(v[0], v[1]); o[1] = pack2(v[2], v[3]); o[2] = pack2(v[4], v[5]); o[3] = pack2(v[6], v[7]);
    *(u32x4*)(WT + (long)n * K + k8) = o;
  }
}
DEV void wt_convert_all(const P& p, long gtid, long gsize) {
  for (int l = 0; l < DEPTH; ++l) {
    wt_convert(p.w_in + (long)l * D_MODEL * IN_W, p.wt_in() + (long)l * IN_W * D_MODEL, D_MODEL, IN_W, false, gtid, gsize);
    wt_convert(p.w_out + (long)l * MIX_W * D_MODEL, p.wt_out() + (long)l * D_MODEL * MIX_W, MIX_W, D_MODEL, false, gtid, gsize);
    wt_convert(p.s5_w_glu + (long)l * S5_W * S5_W, p.wt_glu() + (long)l * S5_W * S5_W, S5_W, S5_W, false, gtid, gsize);
    wt_convert(p.w_sh_gate + (long)l * D_MODEL * SHARED_FF, p.wt_shg() + (long)l * SHARED_FF * D_MODEL, D_MODEL, SHARED_FF, false, gtid, gsize);
    wt_convert(p.w_sh_up + (long)l * D_MODEL * SHARED_FF, p.wt_shu() + (long)l * SHARED_FF * D_MODEL, D_MODEL, SHARED_FF, false, gtid, gsize);
    wt_convert(p.w_sh_down + (long)l * SHARED_FF * D_MODEL, p.wt_shd() + (long)l * D_MODEL * SHARED_FF, SHARED_FF, D_MODEL, false, gtid, gsize);
    wt_convert(p.w_router + (long)l * D_MODEL * N_EXPERTS, p.wt_rh() + (long)l * N_EXPERTS * D_MODEL, D_MODEL, N_EXPERTS, false, gtid, gsize);
    wt_convert(p.w_router + (long)l * D_MODEL * N_EXPERTS, p.wt_rl() + (long)l * N_EXPERTS * D_MODEL, D_MODEL, N_EXPERTS, true, gtid, gsize);
  }
}
struct ALRows { const char* base; unsigned off[2]; DEVM const unsigned short* a(int i, int kt) const { return (const unsigned short*)(base + (off[i] + (unsigned)kt * 128u)); } };
struct BLStd { static constexpr bool TR = false; const char* base; unsigned voff; int ldb4; bool valid;
  DEVM void load(float4 (&rb)[8], int kt) const {
#pragma unroll
    for (int i = 0; i < 8; ++i) rb[i] = valid ? *(const float4*)(base + (unsigned)((unsigned)(kt * 64 + i) * (unsigned)ldb4 + voff)) : make_float4(0.f, 0.f, 0.f, 0.f); } };
DEV unsigned bl_voff(int ldb4, int tid) { return (unsigned)((tid & 7) * 8) * (unsigned)ldb4 + (unsigned)((tid >> 3) * 16); }
DEV BLStd mk_bl(const float* B  , int ldb, int tid) {
  BLStd b; b.base = (const char*)B; b.ldb4 = ldb * 4; b.voff = bl_voff(ldb * 4, tid); b.valid = true; return b; }
#define SM_TILE 49152
template <int V = 0, class AL, class BL>
DEV void gemm_t(const AL& al, const BL& bl, int nk, f32x4 (&acc)[4][4], char* smem) {
  const int tid = otid(), lane = tid & 63, wid = tid >> 6, wr = wid >> 2, wc = wid & 3;
  const int l15 = lane & 15, q = lane >> 4, x = l15 >> 1;
  const char* ard0 = smem + SM_A + (wr * 64 + l15) * 128 + ((q ^ x) << 4);
  const char* ard1 = smem + SM_A + (wr * 64 + l15) * 128 + (((4 + q) ^ x) << 4);
  const char* brd0 = smem + SM_B + (wc * 64 + l15) * 128 + ((q ^ x) << 4);
  const char* brd1 = smem + SM_B + (wc * 64 + l15) * 128 + (((4 + q) ^ x) << 4);
  const int kq = tid & 7, nq = tid >> 3;
  char* awr = smem + SM_A + nq * 128 + ((kq ^ ((nq >> 1) & 7)) << 4);
  char* bwr0 = smem + SM_B + (nq * 4) * 128 + ((kq ^ ((2 * nq) & 7)) << 4);
  char* bwr1 = smem + SM_B + (nq * 4 + 2) * 128 + ((kq ^ ((2 * nq + 1) & 7)) << 4);
  if (nk <= 0) return;
  u32x4 ra[2]; float4 rb0[8];
#define GEMM_LOADA(KT) do { _Pragma("unroll") for (int i = 0; i < 2; ++i) ra[i] = *(const u32x4*)(al.a(i, (KT))); } while (0)
#define GEMM_WRITE(rb, PO) do { \
    *(u32x4*)(awr + (PO)) = ra[0]; *(u32x4*)(awr + (PO) + 8192) = ra[1]; \
    if (BL::TR) { u32x4 v; \
      v[0] = pack2(rb[0].x, rb[0].y); v[1] = pack2(rb[0].z, rb[0].w); v[2] = pack2(rb[1].x, rb[1].y); v[3] = pack2(rb[1].z, rb[1].w); *(u32x4*)(bwr0 + (PO)) = v; \
      v[0] = pack2(rb[2].x, rb[2].y); v[1] = pack2(rb[2].z, rb[2].w); v[2] = pack2(rb[3].x, rb[3].y); v[3] = pack2(rb[3].z, rb[3].w); *(u32x4*)(bwr0 + (PO) + 128) = v; \
      v[0] = pack2(rb[4].x, rb[4].y); v[1] = pack2(rb[4].z, rb[4].w); v[2] = pack2(rb[5].x, rb[5].y); v[3] = pack2(rb[5].z, rb[5].w); *(u32x4*)(bwr1 + (PO)) = v; \
      v[0] = pack2(rb[6].x, rb[6].y); v[1] = pack2(rb[6].z, rb[6].w); v[2] = pack2(rb[7].x, rb[7].y); v[3] = pack2(rb[7].z, rb[7].w); *(u32x4*)(bwr1 + (PO) + 128) = v; \
    } else { u32x4 v; \
      v[0] = pack2(rb[0].x, rb[1].x); v[1] = pack2(rb[2].x, rb[3].x); v[2] = pack2(rb[4].x, rb[5].x); v[3] = pack2(rb[6].x, rb[7].x); *(u32x4*)(bwr0 + (PO)) = v; \
      v[0] = pack2(rb[0].y, rb[1].y); v[1] = pack2(rb[2].y, rb[3].y); v[2] = pack2(rb[4].y, rb[5].y); v[3] = pack2(rb[6].y, rb[7].y); *(u32x4*)(bwr0 + (PO) + 128) = v; \
      v[0] = pack2(rb[0].z, rb[1].z); v[1] = pack2(rb[2].z, rb[3].z); v[2] = pack2(rb[4].z, rb[5].z); v[3] = pack2(rb[6].z, rb[7].z); *(u32x4*)(bwr1 + (PO)) = v; \
      v[0] = pack2(rb[0].w, rb[1].w); v[1] = pack2(rb[2].w, rb[3].w); v[2] = pack2(rb[4].w, rb[5].w); v[3] = pack2(rb[6].w, rb[7].w); *(u32x4*)(bwr1 + (PO) + 128) = v; \
    } } while (0)
  GEMM_LOADA(0);
  bl.load(rb0, 0);
  __syncthreads();
  GEMM_WRITE(rb0, 0);
  if (V != 3) { if (nk > 1) { GEMM_LOADA(1); bl.load(rb0, 1); } }
  __syncthreads();
#define GEMM_STEP(rbn, KT) do { \
    const int po = ((KT) & 1) * SM_TILE; \
    bf16x8 fa0[4], fb0[4], fa1[4], fb1[4]; \
    _Pragma("unroll") for (int n = 0; n < 4; ++n) fb0[n] = *(const bf16x8*)(brd0 + po + n * 2048); \
    _Pragma("unroll") for (int m = 0; m < 4; ++m) fa0[m] = *(const bf16x8*)(ard0 + po + m * 2048); \
    _Pragma("unroll") for (int n = 0; n < 4; ++n) fb1[n] = *(const bf16x8*)(brd1 + po + n * 2048); \
    _Pragma("unroll") for (int m = 0; m < 4; ++m) fa1[m] = *(const bf16x8*)(ard1 + po + m * 2048); \
    __builtin_amdgcn_sched_barrier(0);     \
    if ((KT) + 1 < nk) { \
      GEMM_WRITE(rbn, SM_TILE - po); \
      if (V != 3) { if ((KT) + 2 < nk) { GEMM_LOADA((KT) + 2); bl.load(rbn, (KT) + 2); } } \
    } \
    __builtin_amdgcn_sched_barrier(0); \
    if (V != 2) { \
      _Pragma("unroll") for (int m = 0; m < 4; ++m) _Pragma("unroll") for (int n = 0; n < 4; ++n) acc[m][n] = __builtin_amdgcn_mfma_f32_16x16x32_bf16(fa0[m], fb0[n], acc[m][n], 0, 0, 0); \
      _Pragma("unroll") for (int m = 0; m < 4; ++m) _Pragma("unroll") for (int n = 0; n < 4; ++n) acc[m][n] = __builtin_amdgcn_mfma_f32_16x16x32_bf16(fa1[m], fb1[n], acc[m][n], 0, 0, 0); \
    } else { _Pragma("unroll") for (int m = 0; m < 4; ++m) asm volatile("" :: "v"(fa0[m]), "v"(fb0[m]), "v"(fa1[m]), "v"(fb1[m])); } \
    __syncthreads(); \
  } while (0)
  int kt = 0;
#pragma unroll 1
  for (; kt < nk; ++kt) { GEMM_STEP(rb0, kt); }
#undef GEMM_STEP
#undef GEMM_WRITE
#undef GEMM_LOADA
}

struct BLT { const char* base; unsigned voff; unsigned rowb;
  DEVM void load(u32x4 (&rb)[4], int kt) const {
#pragma unroll
    for (int c = 0; c < 4; ++c) rb[c] = *(const u32x4*)(base + (voff + (unsigned)c * rowb + (unsigned)kt * 128u)); } };
DEV BLT mk_blt(const unsigned short* BT  , int K, int tid) {
  BLT b; b.base = (const char*)BT; b.rowb = (unsigned)K * 2u; b.voff = (unsigned)((tid >> 3) * 4) * b.rowb + (unsigned)((tid & 7) * 16); return b; }
template <class AL, class BL>
DEV void gemm_tb(const AL& al, const BL& bl, int nk, f32x4 (&acc)[4][4], char* smem) {
  const int tid = otid(), lane = tid & 63, wid = tid >> 6, wr = wid >> 2, wc = wid & 3;
  const int l15 = lane & 15, q = lane >> 4, x = l15 >> 1;
  const char* ard0 = smem + SM_A + (wr * 64 + l15) * 128 + ((q ^ x) << 4);
  const char* ard1 = smem + SM_A + (wr * 64 + l15) * 128 + (((4 + q) ^ x) << 4);
  const char* brd0 = smem + SM_B + (wc * 64 + l15) * 128 + ((q ^ x) << 4);
  const char* brd1 = smem + SM_B + (wc * 64 + l15) * 128 + (((4 + q) ^ x) << 4);
  const int kq = tid & 7, nq = tid >> 3;
  char* awr = smem + SM_A + nq * 128 + ((kq ^ ((nq >> 1) & 7)) << 4);
  char* bwr0 = smem + SM_B + (nq * 4) * 128 + ((kq ^ ((2 * nq) & 7)) << 4);
  char* bwr1 = smem + SM_B + (nq * 4 + 2) * 128 + ((kq ^ ((2 * nq + 1) & 7)) << 4);
  if (nk <= 0) return;
  u32x4 ra[2]; u32x4 rb0[4], rb1[4];
#define TB_LOADA(KT) do { _Pragma("unroll") for (int i = 0; i < 2; ++i) ra[i] = *(const u32x4*)(al.a(i, (KT))); } while (0)
#define TB_WRITE(rb, PO) do { \
    *(u32x4*)(awr + (PO)) = ra[0]; *(u32x4*)(awr + (PO) + 8192) = ra[1]; \
    *(u32x4*)(bwr0 + (PO)) = rb[0]; *(u32x4*)(bwr0 + (PO) + 128) = rb[1]; *(u32x4*)(bwr1 + (PO)) = rb[2]; *(u32x4*)(bwr1 + (PO) + 128) = rb[3]; } while (0)
  TB_LOADA(0);
  bl.load(rb0, 0);
  if (nk > 1) bl.load(rb1, 1);
  __syncthreads();
  TB_WRITE(rb0, 0);
  if (nk > 1) TB_LOADA(1);
  if (nk > 2) bl.load(rb0, 2);
  __syncthreads();
#define TB_STEP(rbn, KT) do { \
    const int po = ((KT) & 1) * SM_TILE; \
    bf16x8 fa0[4], fb0[4], fa1[4], fb1[4]; \
    _Pragma("unroll") for (int n = 0; n < 4; ++n) fb0[n] = *(const bf16x8*)(brd0 + po + n * 2048); \
    _Pragma("unroll") for (int m = 0; m < 4; ++m) fa0[m] = *(const bf16x8*)(ard0 + po + m * 2048); \
    _Pragma("unroll") for (int n = 0; n < 4; ++n) fb1[n] = *(const bf16x8*)(brd1 + po + n * 2048); \
    _Pragma("unroll") for (int m = 0; m < 4; ++m) fa1[m] = *(const bf16x8*)(ard1 + po + m * 2048); \
    __builtin_amdgcn_sched_barrier(0); \
    if ((KT) + 1 < nk) { \
      TB_WRITE(rbn, SM_TILE - po); \
      if ((KT) + 2 < nk) TB_LOADA((KT) + 2); \
      if ((KT) + 3 < nk) bl.load(rbn, (KT) + 3); \
    } \
    __builtin_amdgcn_sched_barrier(0); \
    _Pragma("unroll") for (int m = 0; m < 4; ++m) _Pragma("unroll") for (int n = 0; n < 4; ++n) acc[m][n] = __builtin_amdgcn_mfma_f32_16x16x32_bf16(fa0[m], fb0[n], acc[m][n], 0, 0, 0); \
    _Pragma("unroll") for (int m = 0; m < 4; ++m) _Pragma("unroll") for (int n = 0; n < 4; ++n) acc[m][n] = __builtin_amdgcn_mfma_f32_16x16x32_bf16(fa1[m], fb1[n], acc[m][n], 0, 0, 0); \
    __syncthreads(); \
  } while (0)
  int kt = 0;
#pragma unroll 1
  for (; kt + 1 < nk; kt += 2) { TB_STEP(rb1, kt); TB_STEP(rb0, kt + 1); }
  if (kt < nk) TB_STEP(rb1, kt);
#undef TB_STEP
#undef TB_WRITE
#undef TB_LOADA
}
DEV void acc_zero(f32x4 (&acc)[4][4]) {
#pragma unroll
  for (int m = 0; m < 4; ++m)
#pragma unroll
    for (int n = 0; n < 4; ++n) acc[m][n] = (f32x4){0.f, 0.f, 0.f, 0.f};
}
#define EPI_BEGIN const int etid = otid();
#define EPI_ROW(m, j) (((etid >> 8) & 1) * 64 + (m) * 16 + ((etid & 63) >> 4) * 4 + (j))
#define EPI_COL(n) (((etid >> 6) & 3) * 64 + (n) * 16 + (etid & 15))

template <class Epi>
DEV void gemm_phase_dense(const unsigned short* A, int lda, const unsigned short* BT, int N, int K, Epi epi, char* smem) {
  const int tid = otid(); const int nct = N >> 8; const int nitems = (NR >> 7) * nct;
  for (int it = blockIdx.x; it < nitems; it += gridDim.x) {
    const int rt = it / nct, ct = it - rt * nct;
    ALRows al; al.base = (const char*)(A + (long)rt * 128 * lda);
#pragma unroll
    for (int i = 0; i < 2; ++i) al.off[i] = (unsigned)(((tid >> 3) + 64 * i) * lda + (tid & 7) * 8) * 2u;
    const BLT bl = mk_blt(BT + (long)ct * 256 * K, K, tid);
    f32x4 acc[4][4]; acc_zero(acc);
    gemm_tb(al, bl, K >> 6, acc, smem);
    EPI_BEGIN
#pragma unroll
    for (int m = 0; m < 4; ++m)
#pragma unroll
      for (int n = 0; n < 4; ++n)
#pragma unroll
        for (int j = 0; j < 4; ++j) epi((long)rt * 128 + EPI_ROW(m, j), ct * 256 + EPI_COL(n), acc[m][n][j]);
  }
}
DEV void ph_proj_mfma(const P& p, int l, char* smem) {
  const int tid = otid(); const int nct = IN_W >> 8; const int nitems = (NR >> 7) * nct;
  const float* B = p.w_in + (long)l * D_MODEL * IN_W;
  for (int it = blockIdx.x; it < nitems; it += gridDim.x) {
    const int rt = it / nct, ct = it - rt * nct;
    ALRows al; al.base = (const char*)(p.ubf() + (long)rt * 128 * D_MODEL);
#pragma unroll
    for (int i = 0; i < 2; ++i) al.off[i] = (unsigned)(((tid >> 3) + 64 * i) * D_MODEL + (tid & 7) * 8) * 2u;
    const BLT bl = mk_blt(p.wt_in() + ((long)l * IN_W + ct * 256) * D_MODEL, D_MODEL, tid);
    f32x4 acc[4][4]; acc_zero(acc);
    gemm_tb(al, bl, D_MODEL >> 6, acc, smem);
    EPI_BEGIN
    if (ct >= HY_OFF / 256 && ct < S5_OFF / 256) {
      const bool isctx = rt >= NL / 128;
      const int rloc = (isctx ? (rt - NL / 128) : rt) * 128;
      const int Ls = isctx ? CTX_LEN : SEQ; const int b = rloc / Ls; const int t0 = rloc - b * Ls;
      float* zb = p.zT() + (isctx ? (size_t)BATCH * 3 * HYENA_W * SEQ : (size_t)0) + (size_t)b * 3 * HYENA_W * Ls;
#pragma unroll
      for (int m = 0; m < 4; ++m)
#pragma unroll
        for (int n = 0; n < 4; ++n) {
          const int c = ct * 256 + EPI_COL(n) - HY_OFF; const int t = t0 + EPI_ROW(m, 0);
          *(float4*)(zb + (size_t)c * Ls + t) = make_float4(acc[m][n][0], acc[m][n][1], acc[m][n][2], acc[m][n][3]);
        }
    } else if (ct == S5_OFF / 256) {
#pragma unroll
      for (int m = 0; m < 4; ++m)
#pragma unroll
        for (int n = 0; n < 4; ++n)
#pragma unroll
          for (int j = 0; j < 4; ++j) p.s5u()[((long)rt * 128 + EPI_ROW(m, j)) * S5_W + EPI_COL(n)] = (unsigned short)f2bf(acc[m][n][j]);
    } else {
      const int head = ct * 4 + ((etid >> 6) & 3);
      const bool isq = head < N_Q_HEADS, dorope = head < N_Q_HEADS + N_KV_HEADS && rt < NL / 128;
      const float qs = isq ? 0.125f * 1.4426950408889634f : 1.0f;
      const int c16 = etid & 15;
#pragma unroll
      for (int m = 0; m < 4; ++m)
#pragma unroll
        for (int j = 0; j < 4; ++j) {
          const long row = (long)rt * 128 + EPI_ROW(m, j);
          float v0 = acc[m][0][j], v1 = acc[m][1][j], v2 = acc[m][2][j], v3 = acc[m][3][j];
          if (dorope) {
            const int t = (int)(row % SEQ);
            const float2 cr = p.ropet()[(t / GRID_W) * ROPE_HALF + c16], cc = p.ropet()[(t % GRID_W) * ROPE_HALF + c16];
            const float a0 = v0 * cr.x - v1 * cr.y, a1 = v0 * cr.y + v1 * cr.x, a2 = v2 * cc.x - v3 * cc.y, a3 = v2 * cc.y + v3 * cc.x;
            v0 = a0; v1 = a1; v2 = a2; v3 = a3;
          }
          unsigned short* dst = p.qkvb() + row * HY_OFF + head * HEAD_DIM + c16;
          dst[0] = (unsigned short)f2bf(v0 * qs); dst[16] = (unsigned short)f2bf(v1 * qs); dst[32] = (unsigned short)f2bf(v2 * qs); dst[48] = (unsigned short)f2bf(v3 * qs);
        }
    }
  }
}
DEV void ph_hyena_pre_gpu(const P& p, int l, long gtid, long gsize) {
  const float* sw = p.hy_short_w + l * 3 * 3 * HYENA_W; const float* sb = p.hy_short_b + l * 3 * HYENA_W;
  FOR_ITEMS4(i, (long)BATCH * HYENA_W * (SEQ + CTX_LEN)) {
    const bool isctx = i >= (long)BATCH * HYENA_W * SEQ; const long ii = isctx ? i - (long)BATCH * HYENA_W * SEQ : i;
    const int Ls = isctx ? CTX_LEN : SEQ; const int t = (int)(ii % Ls); const int ch = (int)((ii / Ls) % HYENA_W); const int b = (int)(ii / ((long)Ls * HYENA_W));
    const float* zb = p.zT() + (isctx ? (size_t)BATCH * 3 * HYENA_W * SEQ : (size_t)0) + (size_t)b * 3 * HYENA_W * Ls;
    float z[3];
#pragma unroll
    for (int part = 0; part < 3; ++part) {
      const int cc = part * HYENA_W + ch; const float* zr = zb + (size_t)cc * Ls; float acc = sb[cc];
      if (t > 0) acc += zr[t - 1] * sw[cc];
      acc += zr[t] * sw[3 * HYENA_W + cc];
      if (t + 1 < Ls) acc += zr[t + 1] * sw[2 * 3 * HYENA_W + cc];
      z[part] = acc;
    }
    const long o = isctx ? ((long)NL + b * CTX_LEN + t) * HYENA_W + ch : ((long)b * HYENA_W + ch) * SEQ + t;
    p.hu()[o] = z[0] * z[1]; p.hx0()[o] = z[2];
  }
}
DEV void rms_rows(const P& p, int l, long r0, long r1, int w0, int nw);
DEV void ph_glu_mfma(const P& p, int l, char* smem) {
  const int tid = otid();
  for (int rt = blockIdx.x; rt < (NR >> 7); rt += gridDim.x) {
    ALRows al; al.base = (const char*)(p.ybf() + (long)rt * 128 * S5_W);
#pragma unroll
    for (int i = 0; i < 2; ++i) al.off[i] = (unsigned)(((tid >> 3) + 64 * i) * S5_W + (tid & 7) * 8) * 2u;
    const BLT bl = mk_blt(p.wt_glu() + (long)l * S5_W * S5_W, S5_W, tid);
    f32x4 acc[4][4]; acc_zero(acc);
    gemm_tb(al, bl, S5_W >> 6, acc, smem);
    EPI_BEGIN
#pragma unroll
    for (int m = 0; m < 4; ++m)
#pragma unroll
      for (int n = 0; n < 4; ++n)
#pragma unroll
        for (int j = 0; j < 4; ++j) {
          const long r = (long)rt * 128 + EPI_ROW(m, j); const int c = EPI_COL(n);
          p.mixb()[r * MIX_W + ATTN_W + HYENA_W + c] = __uint_as_float((unsigned)p.ybf()[r * S5_W + c] << 16) * sigmoidf_(acc[m][n][j]);
        }
    asm volatile("s_waitcnt vmcnt(0)" ::: "memory");
    __syncthreads();
    rms_rows(p, l, (long)rt * 128, (long)rt * 128 + 128, otid() >> 6, NT / 64);
  }
}
DEV void ph_outproj_mfma(const P& p, int l, char* smem) {
  EpiRes e{p.xcur(), p.mod(), l, 2 * D_MODEL, p.tmp()};
  gemm_phase_dense(p.mixbf(), MIX_W, p.wt_out() + (long)l * D_MODEL * MIX_W, D_MODEL, MIX_W, e, smem);
}

struct ALRows4 { const char* base; unsigned off[4]; DEVM const unsigned short* a(int i, int kt) const { return (const unsigned short*)(base + (off[i] + (unsigned)kt * 128u)); } };
struct BLStd4 { const char* base; unsigned voff; int ldb4;
  DEVM void load(float4 (&rb)[4], int kt) const {
    unsigned vo = voff; asm volatile("" : "+v"(vo));
#pragma unroll
    for (int i = 0; i < 4; ++i) rb[i] = *(const float4*)(base + (unsigned)((unsigned)(kt * 64 + i) * (unsigned)ldb4 + vo)); } };
#define SM_B2 (SM_A + 32768)
template <class AL, class BL>
DEV void gemm_m2(const AL& al, const BL& bl, int nk, f32x4 (&acc)[4][4], char* smem) {
  const int tid = otid(), lane = tid & 63, wid = tid >> 6, wr = wid >> 1, wc = wid & 1;
  const int l15 = lane & 15, q = lane >> 4, x = l15 >> 1;
  const char* ard0 = smem + SM_A + (wr * 64 + l15) * 128 + ((q ^ x) << 4);
  const char* ard1 = smem + SM_A + (wr * 64 + l15) * 128 + (((4 + q) ^ x) << 4);
  const char* brd0 = smem + SM_B2 + (wc * 64 + l15) * 128 + ((q ^ x) << 4);
  const char* brd1 = smem + SM_B2 + (wc * 64 + l15) * 128 + (((4 + q) ^ x) << 4);
  const int kq = tid & 7, ar = tid >> 3, nq = (tid >> 3) & 31, kh = tid >> 8;
  char* awr = smem + SM_A + ar * 128 + ((kq ^ ((ar >> 1) & 7)) << 4);
  char* bwr0 = smem + SM_B2 + (nq * 4) * 128 + ((kq ^ ((2 * nq) & 7)) << 4) + kh * 8;
  char* bwr1 = smem + SM_B2 + (nq * 4 + 2) * 128 + ((kq ^ ((2 * nq + 1) & 7)) << 4) + kh * 8;
  if (nk <= 0) return;
  u32x4 ra[4]; float4 rb0[4], rb1[4];
#define M2_LOADA(KT) do { _Pragma("unroll") for (int i = 0; i < 4; ++i) ra[i] = *(const u32x4*)(al.a(i, (KT))); } while (0)
#define M2_WRITE(rb, PO) do { \
    _Pragma("unroll") for (int i = 0; i < 4; ++i) *(u32x4*)(awr + (PO) + 8192 * i) = ra[i]; \
    { u32x2 v; \
      v[0] = pack2(rb[0].x, rb[1].x); v[1] = pack2(rb[2].x, rb[3].x); *(u32x2*)(bwr0 + (PO)) = v; \
      v[0] = pack2(rb[0].y, rb[1].y); v[1] = pack2(rb[2].y, rb[3].y); *(u32x2*)(bwr0 + (PO) + 128) = v; \
      v[0] = pack2(rb[0].z, rb[1].z); v[1] = pack2(rb[2].z, rb[3].z); *(u32x2*)(bwr1 + (PO)) = v; \
      v[0] = pack2(rb[0].w, rb[1].w); v[1] = pack2(rb[2].w, rb[3].w); *(u32x2*)(bwr1 + (PO) + 128) = v; } } while (0)
  M2_LOADA(0);
  bl.load(rb0, 0);
  if (nk > 1) bl.load(rb1, 1);
  __syncthreads();
  M2_WRITE(rb0, 0);
  if (nk > 1) M2_LOADA(1);
  if (nk > 2) bl.load(rb0, 2);
  __syncthreads();
#define M2_STEP(rbn, KT) do { \
    const int po = ((KT) & 1) * SM_TILE; \
    bf16x8 fa0[4], fb0[4], fa1[4], fb1[4]; \
    _Pragma("unroll") for (int n = 0; n < 4; ++n) fb0[n] = *(const bf16x8*)(brd0 + po + n * 2048); \
    _Pragma("unroll") for (int m = 0; m < 4; ++m) fa0[m] = *(const bf16x8*)(ard0 + po + m * 2048); \
    _Pragma("unroll") for (int n = 0; n < 4; ++n) fb1[n] = *(const bf16x8*)(brd1 + po + n * 2048); \
    _Pragma("unroll") for (int m = 0; m < 4; ++m) fa1[m] = *(const bf16x8*)(ard1 + po + m * 2048); \
    __builtin_amdgcn_sched_barrier(0); \
    if ((KT) + 1 < nk) { \
      M2_WRITE(rbn, SM_TILE - po); \
      if ((KT) + 2 < nk) M2_LOADA((KT) + 2); \
      if ((KT) + 3 < nk) bl.load(rbn, (KT) + 3); \
    } \
    __builtin_amdgcn_sched_barrier(0); \
    _Pragma("unroll") for (int m = 0; m < 4; ++m) _Pragma("unroll") for (int n = 0; n < 4; ++n) acc[m][n] = __builtin_amdgcn_mfma_f32_16x16x32_bf16(fa0[m], fb0[n], acc[m][n], 0, 0, 0); \
    _Pragma("unroll") for (int m = 0; m < 4; ++m) _Pragma("unroll") for (int n = 0; n < 4; ++n) acc[m][n] = __builtin_amdgcn_mfma_f32_16x16x32_bf16(fa1[m], fb1[n], acc[m][n], 0, 0, 0); \
    __syncthreads(); \
  } while (0)
  int kt = 0;
#pragma unroll 1
  for (; kt + 1 < nk; kt += 2) { M2_STEP(rb1, kt); M2_STEP(rb0, kt + 1); }
  if (kt < nk) M2_STEP(rb1, kt);
#undef M2_STEP
#undef M2_WRITE
#undef M2_LOADA
}
#define EPI2_ROW(m, j) (((etid >> 7) & 3) * 64 + (m) * 16 + ((etid & 63) >> 4) * 4 + (j))
#define EPI2_COL(n) (((etid >> 6) & 1) * 64 + (n) * 16 + (etid & 15))
DEV void exp_prefix(const P& p, int l, int* toff, int* roff, int* rowo) {
  const int tid = otid(), lane = tid & 63, w = tid >> 6;
  __syncthreads();
  int c = 0, tl = 0, incl = 0, rinc = 0;
  int* wsum = roff + N_EXPERTS + 8;
  if (tid < N_EXPERTS) {
    c = p.cnt()[l * N_EXPERTS + tid];
    tl = (c + 255) >> 8; incl = tl; rinc = c;
#pragma unroll
    for (int o = 1; o < 64; o <<= 1) { const int v = __shfl_up(incl, o), v2 = __shfl_up(rinc, o); if (lane >= o) { incl += v; rinc += v2; } }
    if (lane == 63) { wsum[w] = incl; wsum[4 + w] = rinc; }
    roff[tid] = c;
  }
  __syncthreads();
  if (tid < N_EXPERTS) {
    int base = 0, rb = 0;
#pragma unroll
    for (int k = 0; k < 4; ++k) if (k < w) { base += wsum[k]; rb += wsum[4 + k]; }
    toff[tid] = base + incl - tl;
    rowo[tid] = rb + rinc - c;
    if (tid == N_EXPERTS - 1) toff[N_EXPERTS] = base + incl;
  }
  __syncthreads();
}
#define EXP_TABLES int* toff = (int*)(smem + SM_MISC); int* roff = toff + N_EXPERTS + 1; int* rowo = roff + N_EXPERTS + 16;
DEV int exp_find(const int* toff, int tile) {
  int lo = 0, hi = N_EXPERTS - 1;
  while (lo < hi) { int mid = (lo + hi + 1) >> 1; if (toff[mid] <= tile) lo = mid; else hi = mid - 1; }
  return lo;
}
template <int V = 0>
DEV void upgate_tile(const ALRows& al, const float* wg, const float* wu, int cq, f32x4 (&acc)[4][4], char* smem, int tid) {
  const int nq = tid >> 3; const int wsel = __builtin_amdgcn_readfirstlane(tid >> 6) & 1;
  BLStd bl; bl.base = (const char*)((wsel ? wu : wg) + cq * 128); bl.ldb4 = EXPERT_FF * 4; bl.valid = true;
  bl.voff = (unsigned)((tid & 7) * 8) * (unsigned)(EXPERT_FF * 4) + (unsigned)(((nq >> 4) * 32 + (nq & 7) * 4) * 4);
  acc_zero(acc);
  gemm_t<V>(al, bl, D_MODEL >> 6, acc, smem);
}
static_assert(EXPERT_FF == 256 && SHARED_FF == 256, "ff tiling");
template <int V = 0>
DEV void ph_expert_up_mfma(const P& p, int l, char* smem) {
  const int tid = otid();
  EXP_TABLES
  exp_prefix(p, l, toff, roff, rowo);
  const int n_items = toff[N_EXPERTS] * 4;
  for (int it = blockIdx.x; it < n_items; it += gridDim.x) {
    const int tile = it >> 2, cq = it & 3;
    const int e = __builtin_amdgcn_readfirstlane(exp_find(toff, tile)); const int j0 = (tile - toff[e]) * 256;
    const int nrows = min(256, roff[e] - j0), rbase = e * NR + j0, crow0 = rowo[e] + j0;
    const float* wg = p.w_exp_gate + ((long)l * N_EXPERTS + e) * D_MODEL * EXPERT_FF; const float* wu = p.w_exp_up + ((long)l * N_EXPERTS + e) * D_MODEL * EXPERT_FF;
    ALRows4 al; al.base = (const char*)p.ubf();
#pragma unroll
    for (int i = 0; i < 4; ++i) { const int rl = min((tid >> 3) + 64 * i, nrows - 1); al.off[i] = ((unsigned)(p.elist()[rbase + rl] / TOP_K) * D_MODEL + (tid & 7) * 8) * 2u; }
    const int nq = (tid >> 3) & 31; const int wsel = __builtin_amdgcn_readfirstlane(tid >> 6) & 1;
    BLStd4 bl; bl.base = (const char*)((wsel ? wu : wg) + cq * 64); bl.ldb4 = EXPERT_FF * 4;
    bl.voff = (unsigned)((tid & 7) * 8 + (tid >> 8) * 4) * (unsigned)(EXPERT_FF * 4) + (unsigned)(((nq >> 4) * 32 + (nq & 7) * 4) * 4);
    f32x4 acc[4][4]; acc_zero(acc);
    gemm_m2(al, bl, D_MODEL >> 6, acc, smem);
    EPI_BEGIN
    const int ewc = (etid >> 6) & 1, ec = etid & 15;
#pragma unroll
    for (int m = 0; m < 4; ++m)
#pragma unroll
      for (int j = 0; j < 4; ++j) {
        const int rl = EPI2_ROW(m, j);
        if (rl < nrows) {
          const float gsc = p.egate()[rbase + rl];
          unsigned short* dst = p.hbf() + (long)(crow0 + rl) * EXPERT_FF + cq * 64 + ewc * 32 + ec;
          dst[0] = (unsigned short)f2bf(siluf(acc[m][0][j]) * acc[m][2][j] * gsc); dst[16] = (unsigned short)f2bf(siluf(acc[m][1][j]) * acc[m][3][j] * gsc);
        }
      }
  }
}
DEV void ph_expert_down_mfma(const P& p, int l, char* smem) {
  const int tid = otid();
  EXP_TABLES
  exp_prefix(p, l, toff, roff, rowo);
  const int NC8 = D_MODEL / 128;
  const int n_exp_items = toff[N_EXPERTS] * NC8;
  for (int it = blockIdx.x; it < n_exp_items; it += gridDim.x) {
    const int tile = it / NC8, ct = it - tile * NC8;
    const int e = __builtin_amdgcn_readfirstlane(exp_find(toff, tile)); const int j0 = (tile - toff[e]) * 256;
    const int nrows = min(256, roff[e] - j0), crow0 = rowo[e] + j0;
    const float* wd = p.w_exp_down + ((long)l * N_EXPERTS + e) * EXPERT_FF * D_MODEL;
    ALRows4 al; al.base = (const char*)p.hbf();
#pragma unroll
    for (int i = 0; i < 4; ++i) { const int rl = min((tid >> 3) + 64 * i, nrows - 1); al.off[i] = ((unsigned)(crow0 + rl) * EXPERT_FF + (tid & 7) * 8) * 2u; }
    BLStd4 bl; bl.base = (const char*)(wd + ct * 128); bl.ldb4 = D_MODEL * 4;
    bl.voff = (unsigned)((tid & 7) * 8 + (tid >> 8) * 4) * (unsigned)(D_MODEL * 4) + (unsigned)(((tid >> 3) & 31) * 16);
    f32x4 acc[4][4]; acc_zero(acc);
    gemm_m2(al, bl, EXPERT_FF >> 6, acc, smem);
    EPI_BEGIN
#pragma unroll
    for (int m = 0; m < 4; ++m)
#pragma unroll
      for (int j = 0; j < 4; ++j) {
        const int rl = EPI2_ROW(m, j);
        if (rl < nrows) {
          unsigned short* dst = p.ykb() + (long)(crow0 + rl) * D_MODEL + ct * 128;
#pragma unroll
          for (int n = 0; n < 4; ++n) dst[EPI2_COL(n)] = (unsigned short)f2bf(acc[m][n][j]);
        }
      }
  }
  const int NCT = D_MODEL / 256;
  const int n_sh_items = (NR >> 7) * NCT;
  for (int it = (int)gridDim.x - 1 - (int)blockIdx.x; it < n_sh_items; it += gridDim.x) {
    const int rt = it / NCT, ct = it - rt * NCT;
    ALRows al; al.base = (const char*)(p.hsbf() + (long)rt * 128 * SHARED_FF);
#pragma unroll
    for (int i = 0; i < 2; ++i) al.off[i] = (unsigned)(((tid >> 3) + 64 * i) * SHARED_FF + (tid & 7) * 8) * 2u;
    const BLT bl = mk_blt(p.wt_shd() + ((long)l * D_MODEL + ct * 256) * SHARED_FF, SHARED_FF, tid);
    f32x4 acc[4][4]; acc_zero(acc);
    gemm_tb(al, bl, SHARED_FF >> 6, acc, smem);
    EPI_BEGIN
#pragma unroll
    for (int m = 0; m < 4; ++m)
#pragma unroll
      for (int n = 0; n < 4; ++n)
#pragma unroll
        for (int j = 0; j < 4; ++j) p.ysh()[((long)rt * 128 + EPI_ROW(m, j)) * D_MODEL + ct * 256 + EPI_COL(n)] = acc[m][n][j];
  }
}

typedef __attribute__((ext_vector_type(16))) float f32x16;
#define SM_HR 256
#define UB_STRIDE 8272
#define SM_HU (256 + 32768)
#define SMEM_HY (256 + 32768 + 2 * UB_STRIDE * 2)
static_assert(SEQ == 8192 && HYENA_W == 256, "hyena mfma shape");
DEV void ph_hyena_mfma(const P& p, int l, char* smem) {
  const int tid = otid(), lane = tid & 63, w = tid >> 6;
  unsigned short* R = (unsigned short*)(smem + SM_HR); unsigned short* U = (unsigned short*)(smem + SM_HU);
  for (int ch = blockIdx.x; ch < HYENA_W; ch += gridDim.x) {
    __syncthreads();
    const float* kf = p.kraw() + ((long)l * 2 * HYENA_W + ch) * SEQ; const float* kb = p.kraw() + ((long)l * 2 * HYENA_W + HYENA_W + ch) * SEQ;
    for (int y = tid; y < 2 * SEQ; y += NT) {
      const int lag = SEQ - y; float v = 0.f;
      if (lag >= 0 && lag < SEQ) v = kf[lag]; else if (lag < 0) v = kb[-lag];
      const int C = y >> 3; R[((C ^ ((C >> 4) & 1)) << 3) + (y & 7)] = (unsigned short)f2bf(v);
    }
    for (int e = tid; e < 2 * UB_STRIDE; e += NT) {
      const int b = e / UB_STRIDE, ee = e - b * UB_STRIDE, t = ee - 16; float v = 0.f;
      if (t >= 0 && t < SEQ) v = p.hu()[((long)b * HYENA_W + ch) * SEQ + t];
      U[e] = (unsigned short)f2bf(v);
    }
    __syncthreads();
    f32x16 acc[2];
#pragma unroll
    for (int mi = 0; mi < 2; ++mi)
#pragma unroll
      for (int k = 0; k < 16; ++k) acc[mi][k] = 0.f;
    const int r = lane & 31, h = lane >> 5, sig = lane & 15, bb = (lane >> 4) & 1;
    const unsigned* Ud = (const unsigned*)U + bb * (UB_STRIDE / 2);
    const int ub0 = 8 * h + sig;
    const int cbase = 1022 - 64 * (2 * w) - 2 * r + h;
    const bool odd = sig & 1;
    bf16x8 afn[2]; unsigned dn[5];
    {
#pragma unroll
      for (int mi = 0; mi < 2; ++mi) { const int C = cbase - 64 * mi; afn[mi] = *(const bf16x8*)((const char*)R + ((C ^ ((C >> 4) & 1)) << 4)); }
      const int di = ub0 >> 1;
#pragma unroll
      for (int i = 0; i < 5; ++i) dn[i] = Ud[di + i];
    }
#pragma unroll 1
    for (int q = 0; q <= SEQ / 16; ++q) {
      bf16x8 af[2]; unsigned d[5];
#pragma unroll
      for (int mi = 0; mi < 2; ++mi) af[mi] = afn[mi];
#pragma unroll
      for (int i = 0; i < 5; ++i) d[i] = dn[i];
      {
        const int qn = min(q + 1, SEQ / 16);
#pragma unroll
        for (int mi = 0; mi < 2; ++mi) { const int C = cbase - 64 * mi + 2 * qn; afn[mi] = *(const bf16x8*)((const char*)R + ((C ^ ((C >> 4) & 1)) << 4)); }
        const int di = (16 * qn + ub0) >> 1;
#pragma unroll
        for (int i = 0; i < 5; ++i) dn[i] = Ud[di + i];
      }
      u32x4 bw;
#pragma unroll
      for (int i = 0; i < 4; ++i) bw[i] = odd ? __builtin_amdgcn_alignbit(d[i + 1], d[i], 16) : d[i];
      const bf16x8 bfr = __builtin_bit_cast(bf16x8, bw);
#pragma unroll
      for (int mi = 0; mi < 2; ++mi) acc[mi] = __builtin_amdgcn_mfma_f32_32x32x16_bf16(af[mi], bfr, acc[mi], 0, 0, 0);
    }
    __syncthreads();
    {
      float* Y = (float*)(smem + SM_HR);
      float* yl = Y + bb * SEQ + 16 * (32 * (2 * w) + 4 * h) + sig;
#pragma unroll
      for (int mi = 0; mi < 2; ++mi)
#pragma unroll
        for (int k = 0; k < 16; ++k) yl[16 * (32 * mi + (k & 3) + 8 * (k >> 2))] = acc[mi][k];
    }
    __syncthreads();
    {
      const float* Y = (const float*)(smem + SM_HR);
      const float kn = p.knorm()[l * HYENA_W + ch], dsk = p.hy_d[l * HYENA_W + ch];
#pragma unroll 2
      for (int idx = tid; idx < BATCH * SEQ; idx += NT) {
        const int b = idx / SEQ, t = idx - b * SEQ;
        const long o = ((long)b * HYENA_W + ch) * SEQ + t;
        p.mixb()[(long)idx * MIX_W + ATTN_W + ch] = (Y[idx] * kn + p.hu()[o] * dsk) * p.hx0()[o];
      }
    }
  }
}
#define SM_K 256
#define SM_V (256 + 8192)
static_assert(HEAD_DIM == 64 && WINDOW == 128 && CTX_LEN == 256 && Q_GROUP == 4, "attention shape");
DEV void ph_attn_mfma(const P& p, int l, char* smem) {
  const int tid = otid(), lane = tid & 63, w = (tid >> 6) & 3, hsel = tid >> 8, h = lane >> 5, ql = lane & 31;
  char* Ks = smem + SM_K; char* Vs = smem + SM_V;
  const int n_lat = BATCH * (SEQ / 128) * N_KV_HEADS * (Q_GROUP / 2);
  const int n_ctx = (l == 0) ? BATCH * (CTX_LEN / 128) * N_KV_HEADS * (Q_GROUP / 2) : 0;
  const float QS = 0.125f * 1.4426950408889634f;
  for (int it = blockIdx.x; it < n_lat + n_ctx; it += gridDim.x) {
    const bool isctx = it >= n_lat;
    int b, qb, kvh, g;
    { int x = isctx ? it - n_lat : it; g = (x & 1) * 2 + hsel; kvh = (x >> 1) & 1; x >>= 2; if (isctx) { qb = x & 1; b = x >> 1; } else { qb = x & 63; b = x >> 6; } }
    const int hq = kvh * Q_GROUP + g;
    const int tq0 = qb * 128 + 32 * w;
    const long qrow = (isctx ? (long)NL + b * CTX_LEN : (long)b * SEQ) + tq0 + ql;
    bf16x8 qf[4];
    {
      const unsigned short* qp = p.qkvb() + qrow * HY_OFF + Q_OFF + hq * HEAD_DIM + 8 * h;
#pragma unroll
      for (int ks = 0; ks < 4; ++ks) qf[ks] = *(const bf16x8*)(qp + 16 * ks);
    }
    f32x16 o0, o1;
#pragma unroll
    for (int k = 0; k < 16; ++k) { o0[k] = 0.f; o1[k] = 0.f; }
    float m = -1e30f, lsum = 0.f;
    const int nsteps = isctx ? 4 : 10;
    u32x4 rk[1], rv[1];
    auto key_row = [&](int step, int key) -> long {
      if (step < 4) return (long)NL + b * CTX_LEN + step * 64 + key;
      const int tk = qb * 128 - 128 + (step - 4) * 64 + key;
      return (tk < 0 || tk >= SEQ) ? -1 : (long)b * SEQ + tk;
    };
    auto step_valid = [&](int step) -> bool { if (step < 4) return true; const int t0 = qb * 128 - 128 + (step - 4) * 64; return t0 >= 0 && t0 < SEQ; };
    auto load_tile = [&](int step) {
#pragma unroll
      for (int i = 0; i < 1; ++i) {
        const int key = (tid >> 3); const long kr = key_row(step, key);
        const unsigned short* kp = p.qkvb() + kr * HY_OFF + K_OFF + kvh * HEAD_DIM + (tid & 7) * 8; const unsigned short* vp = p.qkvb() + kr * HY_OFF + V_OFF + kvh * HEAD_DIM + (tid & 7) * 8;
        rk[i] = *(const u32x4*)kp; rv[i] = *(const u32x4*)vp;
      }
    };
    int step = 0;
    load_tile(0);
    while (step < nsteps) {
      __syncthreads();
#pragma unroll
      for (int i = 0; i < 1; ++i) {
        const int key = (tid >> 3), ch = tid & 7;
        *(u32x4*)(Ks + tile_off(key, ch)) = rk[i];
        *(u32x4*)(Vs + key * 128 + ((ch * 16) ^ (64 * ((key >> 1) & 1)))) = rv[i];
      }
      __syncthreads();
      const int cur = step;
      int nxt = step + 1;
      while (nxt < nsteps && !step_valid(nxt)) ++nxt;
      if (nxt < nsteps) load_tile(nxt);
      step = nxt;
#pragma unroll
      for (int sub = 0; sub < 2; ++sub) {
        const bool win = cur >= 4;
        const int ks0 = win ? qb * 128 - 128 + (cur - 4) * 64 + sub * 32 : 0;
        if (win && (ks0 > tq0 + 31 + WINDOW || ks0 + 31 < tq0 - WINDOW)) continue;
        f32x16 sacc;
#pragma unroll
        for (int k = 0; k < 16; ++k) sacc[k] = 0.f;
#pragma unroll
        for (int ks = 0; ks < 4; ++ks) {
          const bf16x8 kf = *(const bf16x8*)(Ks + tile_off(sub * 32 + ql, 2 * ks + h));
          sacc = __builtin_amdgcn_mfma_f32_32x32x16_bf16(kf, qf[ks], sacc, 0, 0, 0);
        }
        if (win && (ks0 + 31 - tq0 > WINDOW || tq0 + 31 - ks0 > WINDOW)) {
          const int tq = tq0 + ql;
#pragma unroll
          for (int k = 0; k < 16; ++k) { const int d = ks0 + (k & 3) + 8 * (k >> 2) + 4 * h - tq; if (d > WINDOW || d < -WINDOW) sacc[k] = -1e30f; }
        }
        float mx = sacc[0];
#pragma unroll
        for (int k = 1; k < 16; ++k) mx = fmaxf(mx, sacc[k]);
        mx = fmaxf(mx, __shfl_xor(mx, 32));
        const float mn = fmaxf(m, mx); const float alpha = __builtin_amdgcn_exp2f(m - mn); m = mn;
        float ps = 0.f;
#pragma unroll
        for (int k = 0; k < 16; ++k) { sacc[k] = __builtin_amdgcn_exp2f(sacc[k] - mn); ps += sacc[k]; }
        lsum = lsum * alpha + ps;
#pragma unroll
        for (int k = 0; k < 16; ++k) { o0[k] *= alpha; o1[k] *= alpha; }
        u32x2 v00, v01, v02, v03, v10, v11, v12, v13;
        {
          const int q4 = (lane & 15) >> 2, p4 = lane & 3, blk = (lane >> 4) & 1, sq = (q4 >> 1) & 1;
          const unsigned lb = (unsigned)(size_t)((__attribute__((address_space(3))) char*)Vs) + (unsigned)((sub * 32 + 4 * h + q4) * 128 + 32 * blk + 8 * p4);
          const unsigned base0 = lb + 64 * sq, base1 = lb + 64 * (1 - sq);
          asm volatile(
              "ds_read_b64_tr_b16 %0, %8\n\t"
              "ds_read_b64_tr_b16 %1, %8 offset:1024\n\t"
              "ds_read_b64_tr_b16 %2, %8 offset:2048\n\t"
              "ds_read_b64_tr_b16 %3, %8 offset:3072\n\t"
              "ds_read_b64_tr_b16 %4, %9\n\t"
              "ds_read_b64_tr_b16 %5, %9 offset:1024\n\t"
              "ds_read_b64_tr_b16 %6, %9 offset:2048\n\t"
              "ds_read_b64_tr_b16 %7, %9 offset:3072\n\t"
              "s_waitcnt lgkmcnt(0)"
              : "=&v"(v00), "=&v"(v01), "=&v"(v02), "=&v"(v03), "=&v"(v10), "=&v"(v11), "=&v"(v12), "=&v"(v13)
              : "v"(base0), "v"(base1) : "memory");
        }
#pragma unroll
        for (int ks2 = 0; ks2 < 2; ++ks2) {
          u32x4 pw;
#pragma unroll
          for (int i = 0; i < 4; ++i) pw[i] = pack2(sacc[8 * ks2 + 2 * i], sacc[8 * ks2 + 2 * i + 1]);
          const bf16x8 pf = __builtin_bit_cast(bf16x8, pw);
          u32x4 a0, a1;
          if (ks2 == 0) { a0[0] = v00[0]; a0[1] = v00[1]; a0[2] = v01[0]; a0[3] = v01[1]; a1[0] = v10[0]; a1[1] = v10[1]; a1[2] = v11[0]; a1[3] = v11[1]; }
          else          { a0[0] = v02[0]; a0[1] = v02[1]; a0[2] = v03[0]; a0[3] = v03[1]; a1[0] = v12[0]; a1[1] = v12[1]; a1[2] = v13[0]; a1[3] = v13[1]; }
          o0 = __builtin_amdgcn_mfma_f32_32x32x16_bf16(__builtin_bit_cast(bf16x8, a0), pf, o0, 0, 0, 0);
          o1 = __builtin_amdgcn_mfma_f32_32x32x16_bf16(__builtin_bit_cast(bf16x8, a1), pf, o1, 0, 0, 0);
        }
      }
    }
    lsum += __shfl_xor(lsum, 32);
    const float sk = p.sink[l * N_Q_HEADS + hq] * 1.4426950408889634f;
    const float mf = fmaxf(m, sk); const float sc = __builtin_amdgcn_exp2f(m - mf); const float inv = sc / (lsum * sc + __builtin_amdgcn_exp2f(sk - mf));
    float* op = p.mixb() + qrow * MIX_W + hq * HEAD_DIM + 4 * h;
#pragma unroll
    for (int gq = 0; gq < 4; ++gq) {
      *(float4*)(op + 8 * gq) = make_float4(o0[4 * gq] * inv, o0[4 * gq + 1] * inv, o0[4 * gq + 2] * inv, o0[4 * gq + 3] * inv);
      *(float4*)(op + 32 + 8 * gq) = make_float4(o1[4 * gq] * inv, o1[4 * gq + 1] * inv, o1[4 * gq + 2] * inv, o1[4 * gq + 3] * inv);
    }
  }
}


static_assert(S5_T == 64 && S5_STATE == 64 && S5_GROUP == 16 && S5_GROUPS == 16 && NCH == 132, "s5 mfma shape");
#define S5_COLS (BATCH * NCH)
#define S5_RT 88
DEV void ph_s5tables_gpu(const P& p, long gtid, long gsize) {
  FOR_ITEMS4(i, (long)DEPTH * 2 * S5_GROUPS * 128 * 1024) {
    const int k = (int)(i & 1023), n = (int)((i >> 10) & 127); const long ldg = i >> 17;
    const int ri = n >> 6, pp = n & 63, sidx = k >> 4, j = k & 15;
    const float2 lp = p.lampow()[(ldg * (S5_T + 1) + (S5_T - 1 - sidx)) * S5_STATE + pp]; const float2 bb = p.bbar()[(ldg * S5_STATE + pp) * S5_GROUP + j];
    p.bmtb()[i] = (unsigned short)f2bf(ri ? lp.x * bb.y + lp.y * bb.x : lp.x * bb.x - lp.y * bb.y);
  }
  FOR_ITEMS4(i, (long)DEPTH * 2 * S5_GROUPS * 128 * 1024) {
    const int k = (int)(i & 127), n = (int)((i >> 7) & 1023); const long ldg = i >> 17; const int dir = (int)((ldg >> 4) & 1);
    const int ri = k >> 6, pp = k & 63, tl = n >> 4, ii = n & 15; const int tau = dir ? 63 - tl : tl;
    const float cr = p.s5_c_re[(ldg * S5_GROUP + ii) * S5_STATE + pp], ci = p.s5_c_im[(ldg * S5_GROUP + ii) * S5_STATE + pp];
    const float2 lp = p.lampow()[(ldg * (S5_T + 1) + tau + 1) * S5_STATE + pp];
    p.cmtb()[i] = (unsigned short)f2bf(ri ? -(cr * lp.y + ci * lp.x) : cr * lp.x - ci * lp.y);
  }
}
DEV void ph_kcb_gpu(const P& p, long gtid, long gsize) {
  FOR_ITEMS4(i, (long)DEPTH * 2 * S5_GROUPS * S5_T * 256) p.kcb()[i] = (unsigned short)f2bf(p.kc()[i]);
}
struct ALS5U { const char* base; unsigned off0[2]; int stepb; const char* hbase; unsigned hoff[2]; int nki;
  DEVM void set(int i, int b, int dir, int chunk, int sl, unsigned joff) { off0[i] = (unsigned)s5_row(b, dir, chunk * S5_T + sl) * (unsigned)(S5_W * 2) + joff; }
  DEVM const unsigned short* a(int i, int kt) const {
    if (kt >= nki) return (const unsigned short*)(hbase + (hoff[i] + (unsigned)(kt - nki) * 128u));
    return (const unsigned short*)(base + (off0[i] + (unsigned)(kt * stepb))); } };
struct BLKc { const char* kc; const char* cm; int tl, i0, sj, ss, dir, nki; unsigned cmoff;
  DEVM void load(u32x4 (&rb)[4], int kt) const {
    if (kt >= nki) {
#pragma unroll
      for (int c = 0; c < 4; ++c) rb[c] = *(const u32x4*)(cm + (cmoff + (unsigned)(c * 128 + (kt - nki) * 64) * 2u));
      return;
    }
    const int d = (dir ? 63 - tl : tl) - (4 * kt + ss);
    if (d < 0) {
#pragma unroll
      for (int c = 0; c < 4; ++c) rb[c] = (u32x4){0u, 0u, 0u, 0u};
    } else {
#pragma unroll
      for (int c = 0; c < 4; ++c) rb[c] = *(const u32x4*)(kc + (unsigned)(((d * 16 + i0 + c) * 16 + sj) * 2));
    }
  } };
DEV void ph_s5_sgemm(const P& p, int l, char* smem) {
  const int tid = otid();
  const int nitems = 2 * S5_GROUPS * 3;
  for (int it = blockIdx.x; it < nitems; it += gridDim.x) {
    const int rt = it % 3, g = (it / 3) % S5_GROUPS, dir = it / (3 * S5_GROUPS);
    ALS5U al; al.base = (const char*)(p.s5u() + g * S5_GROUP); al.stepb = (dir ? -4 : 4) * S5_W * 2; al.nki = 1 << 20; al.hbase = al.base; al.hoff[0] = al.hoff[1] = 0;
#pragma unroll
    for (int i = 0; i < 2; ++i) { const int col = rt * S5_RT + min((tid >> 3) + 64 * i, S5_RT - 1); al.set(i, col / NCH, dir, col % NCH, (tid & 7) >> 1, (tid & 1) * 16); }
    BLT bl; bl.base = (const char*)(p.bmtb() + (((long)l * 2 + dir) * S5_GROUPS + g) * 128 * 1024); bl.rowb = 1024 * 2;
    bl.voff = (unsigned)((((tid >> 3) & 31) * 4)) * bl.rowb + (unsigned)((tid & 7) * 16);
    f32x4 acc[4][4]; acc_zero(acc);
    gemm_tb(al, bl, 16, acc, smem);
    EPI_BEGIN
    if (((etid >> 6) & 3) < 2) {
#pragma unroll
      for (int m = 0; m < 4; ++m)
#pragma unroll
        for (int j = 0; j < 4; ++j) {
          const int rl = EPI_ROW(m, j);
          if (rl < S5_RT) {
            const int col = rt * S5_RT + rl; const int b = col / NCH, c = col % NCH;
            float* dst = (float*)(p.sc() + ((((long)b * 2 + dir) * S5_GROUPS + g) * NCH + c) * S5_STATE);
#pragma unroll
            for (int n = 0; n < 4; ++n) { const int nn = EPI_COL(n); dst[(nn & 63) * 2 + (nn >> 6)] = acc[m][n][j]; }
          }
        }
    }
  }
}

static_assert(NCH == 132, "carry scan grouping");
DEV void ph_s5_carry_gpu(const P& p, int l, char* smem) {
  const int tid = otid();
  float2* E = (float2*)(smem + SM_MISC);
  const int nchains = BATCH * 2 * S5_GROUPS * S5_STATE;
  for (int cb = blockIdx.x * 16; cb < nchains; cb += gridDim.x * 16) {
    const int cl = tid & 15, grp = tid >> 4; const bool act = tid < 176;
    const int chain = cb + cl;
    const int pp = chain % S5_STATE, g = (chain / S5_STATE) % S5_GROUPS, dir = (chain / (S5_STATE * S5_GROUPS)) % 2, b = chain / (S5_STATE * S5_GROUPS * 2);
    const long ldg = ((long)l * 2 + dir) * S5_GROUPS + g;
    const long base = (((long)b * 2 + dir) * S5_GROUPS + g) * NCH + grp * 12;
    float2 lt = make_float2(0.f, 0.f); float2 L[12]; float hr = 0.f, hi = 0.f;
    __syncthreads();
    if (act) {
      lt = p.lampow()[(ldg * (S5_T + 1) + S5_T) * S5_STATE + pp];
      float2 sv[12];
#pragma unroll
      for (int k = 0; k < 12; ++k) sv[k] = p.sc()[(base + k) * S5_STATE + pp];
#pragma unroll
      for (int k = 0; k < 12; ++k) { L[k] = make_float2(hr, hi); const float nr = lt.x * hr - lt.y * hi + sv[k].x, ni = lt.x * hi + lt.y * hr + sv[k].y; hr = nr; hi = ni; }
      E[grp * 16 + cl] = make_float2(hr, hi);
    }
    __syncthreads();
    if (act) {
      float pr = lt.x, pi = lt.y;
#pragma unroll
      for (int k = 1; k < 12; ++k) { const float nr = pr * lt.x - pi * lt.y, ni = pr * lt.y + pi * lt.x; pr = nr; pi = ni; }
      float gr = 0.f, gi = 0.f;
      for (int gp = 0; gp < grp; ++gp) { const float2 e = E[gp * 16 + cl]; const float nr = pr * gr - pi * gi + e.x, ni = pr * gi + pi * gr + e.y; gr = nr; gi = ni; }
#pragma unroll
      for (int k = 0; k < 12; ++k) {
        const float vr = L[k].x + gr, vi = L[k].y + gi;
        p.hcbf()[(base + k) * 2 * S5_STATE + pp] = f2bf16(vr); p.hcbf()[(base + k) * 2 * S5_STATE + S5_STATE + pp] = f2bf16(vi);
        const float nr = lt.x * gr - lt.y * gi, ni = lt.x * gi + lt.y * gr; gr = nr; gi = ni;
      }
    }
  }
}
DEV void ph_s5_ygemm(const P& p, int l, char* smem) {
  const int tid = otid();
  const int nitems = S5_GROUPS * 3 * 4;
  for (int it = blockIdx.x; it < nitems; it += gridDim.x) {
    const int nt = it & 3, rt = (it >> 2) % 3, g = it / 12;
    f32x4 acc[4][4]; acc_zero(acc);
#pragma unroll 1
    for (int dir = 0; dir < 2; ++dir) {
      const long ldg = ((long)l * 2 + dir) * S5_GROUPS + g;
      const int nki = dir ? 16 - 4 * nt : 4 * nt + 4;
      ALS5U al; al.base = (const char*)(p.s5u() + g * S5_GROUP); al.stepb = (dir ? -4 : 4) * S5_W * 2; al.nki = nki; al.hbase = (const char*)p.hcbf();
#pragma unroll
      for (int i = 0; i < 2; ++i) {
        const int col = rt * S5_RT + min((tid >> 3) + 64 * i, S5_RT - 1); const int b = col / NCH, blk = col % NCH;
        const int ch = dir ? (blk < 4 ? 3 - blk : 135 - blk) : blk;
        al.set(i, b, dir, ch, (tid & 7) >> 1, (tid & 1) * 16);
        al.hoff[i] = (unsigned)((((b * 2 + dir) * S5_GROUPS + g) * NCH + ch) * 128 + (tid & 7) * 8) * 2u;
      }
      BLKc bk; bk.kc = (const char*)(p.kcb() + ldg * S5_T * 256); bk.tl = 16 * nt + (tid >> 5); bk.i0 = ((tid >> 3) & 3) * 4; bk.sj = (tid & 1) * 8; bk.ss = (tid & 7) >> 1; bk.dir = dir; bk.nki = nki;
      bk.cm = (const char*)(p.cmtb() + ldg * 1024 * 128); bk.cmoff = (unsigned)(((16 * nt + (tid >> 5)) * 16 + ((tid >> 3) & 3) * 4) * 128 + (tid & 7) * 8) * 2u;
      gemm_tb(al, bk, nki + 2, acc, smem);
    }
    EPI_BEGIN
#pragma unroll
    for (int m = 0; m < 4; ++m)
#pragma unroll
      for (int j = 0; j < 4; ++j) {
        const int rl = EPI_ROW(m, j);
        if (rl < S5_RT) {
          const int col = rt * S5_RT + rl; const int b = col / NCH, blk = col % NCH;
#pragma unroll
          for (int n = 0; n < 4; ++n) {
            const int nn = nt * 256 + EPI_COL(n); const int tl = nn >> 4, chn = g * S5_GROUP + (nn & 15);
            const long row = blk < 4 ? (long)NL + b * CTX_LEN + blk * 64 + tl : (long)b * SEQ + (blk - 4) * 64 + tl;
            const float y = acc[m][n][j] + p.s5_d[l * S5_W + chn] * __uint_as_float((unsigned)p.s5u()[row * S5_W + chn] << 16);
            const float gy = gelu_tanhf(y);
            p.ybuf()[row * S5_W + chn] = gy; p.ybf()[row * S5_W + chn] = (unsigned short)f2bf(gy);
          }
        }
      }
  }
}

DEV float wave_sum(float v) {
#pragma unroll
  for (int o = 32; o > 0; o >>= 1) v += __shfl_xor(v, o);
  return v;
}
DEV void st_bf4(unsigned short* dst, float a, float b, float c, float d) { u32x2 v; v[0] = pack2(a, b); v[1] = pack2(c, d); *(u32x2*)dst = v; }
static_assert(BATCH == 2, "mod partial layout");
DEV void ph_modsum_gpu(const P& p, long gtid, long gsize) {
  FOR_ITEMS(i, (long)DEPTH * (BATCH + 1) * 6 * D_MODEL) {
    const int n = (int)(i % (6 * D_MODEL)); const int j = (int)((i / (6 * D_MODEL)) % (BATCH + 1)); const int l = (int)(i / (6 * D_MODEL * (BATCH + 1)));
    float acc = p.b_ada[l * 6 * D_MODEL + n];
#pragma unroll
    for (int sl = 0; sl < 16; ++sl) acc += p.modp()[((long)(l * 16 + sl) * (BATCH + 1) + j) * 6 * D_MODEL + n];
    p.mod()[i] = acc;
  }
}
DEV void ph_modu0_gpu(const P& p, long gtid, long gsize) {
  FOR_ITEMS4(i4, (long)NR * D_MODEL / 4) {
    const long i = i4 * 4; const int k = (int)(i % D_MODEL); const long r = i / D_MODEL;
    const float* m = p.mod() + (long)modrow(r) * 6 * D_MODEL;
    const float4 x = *(const float4*)(p.xcur() + i); const float4 sh = *(const float4*)(m + k); const float4 sc = *(const float4*)(m + D_MODEL + k);
    st_bf4(p.ubf() + i, x.x * (1.f + sc.x) + sh.x, x.y * (1.f + sc.y) + sh.y, x.z * (1.f + sc.z) + sh.z, x.w * (1.f + sc.w) + sh.w);
  }
}
DEV void rms_rows(const P& p, int l, long r0, long r1, int w0, int nw) {
  const int lane = otid() & 63;
  for (long r = r0 + w0; r < r1; r += nw) {
    const float* v = p.mixb() + r * MIX_W; float4 a[4]; float ss[4];
#pragma unroll
    for (int i = 0; i < 4; ++i) { a[i] = *(const float4*)(v + (i * 64 + lane) * 4); ss[i] = a[i].x * a[i].x + a[i].y * a[i].y + a[i].z * a[i].z + a[i].w * a[i].w; }
    const float s_att = wave_sum(ss[0] + ss[1]), s_hy = wave_sum(ss[2]), s_s5 = wave_sum(ss[3]);
    float rs[4]; rs[0] = rs[1] = 1.0f / sqrtf(s_att / (float)ATTN_W + LN_EPS); rs[2] = 1.0f / sqrtf(s_hy / (float)HYENA_W + LN_EPS); rs[3] = 1.0f / sqrtf(s_s5 / (float)S5_W + LN_EPS);
#pragma unroll
    for (int i = 0; i < 4; ++i) {
      const int k = (i * 64 + lane) * 4; const float4 g = *(const float4*)(p.mix_g + l * MIX_W + k);
      st_bf4(p.mixbf() + r * MIX_W + k, a[i].x * rs[i] * g.x, a[i].y * rs[i] * g.y, a[i].z * rs[i] * g.z, a[i].w * rs[i] * g.w);
    }
  }
}
DEV void ln_rows(float4 (&a)[4], const float* gw, const float* bw, int lane) {
  float s = 0.f;
#pragma unroll
  for (int i = 0; i < 4; ++i) s += a[i].x + a[i].y + a[i].z + a[i].w;
  const float mu = wave_sum(s) / (float)D_MODEL; float q = 0.f;
#pragma unroll
  for (int i = 0; i < 4; ++i) { a[i].x -= mu; a[i].y -= mu; a[i].z -= mu; a[i].w -= mu; q += a[i].x * a[i].x + a[i].y * a[i].y + a[i].z * a[i].z + a[i].w * a[i].w; }
  const float rs = 1.0f / sqrtf(wave_sum(q) / (float)D_MODEL + LN_EPS);
#pragma unroll
  for (int i = 0; i < 4; ++i) {
    const int k = (i * 64 + lane) * 4; const float4 g = *(const float4*)(gw + k), b = *(const float4*)(bw + k);
    a[i].x = a[i].x * rs * g.x + b.x; a[i].y = a[i].y * rs * g.y + b.y; a[i].z = a[i].z * rs * g.z + b.z; a[i].w = a[i].w * rs * g.w + b.w;
  }
}
DEV void ph_ln1_gpu(const P& p, int l) {
  const int tid_ = otid(); const int lane = tid_ & 63; const int gw = blockIdx.x * (NT / 64) + (tid_ >> 6), nw = gridDim.x * (NT / 64);
  for (long r = gw; r < NR; r += nw) {
    float4 a[4];
#pragma unroll
    for (int i = 0; i < 4; ++i) a[i] = *(const float4*)(p.tmp() + r * D_MODEL + (i * 64 + lane) * 4);
    ln_rows(a, p.ln1_g + l * D_MODEL, p.ln1_b + l * D_MODEL, lane);
    const float* m = p.mod() + ((long)l * (BATCH + 1) + modrow(r)) * 6 * D_MODEL + 3 * D_MODEL;
#pragma unroll
    for (int i = 0; i < 4; ++i) {
      const int k = (i * 64 + lane) * 4;
      *(float4*)(p.xcur() + r * D_MODEL + k) = a[i];
      const float4 sh = *(const float4*)(m + k), sc = *(const float4*)(m + D_MODEL + k);
      const float u0 = a[i].x * (1.f + sc.x) + sh.x, u1 = a[i].y * (1.f + sc.y) + sh.y, u2 = a[i].z * (1.f + sc.z) + sh.z, u3 = a[i].w * (1.f + sc.w) + sh.w;
      st_bf4(p.ubf() + r * D_MODEL + k, u0, u1, u2, u3);
      st_bf4(p.ubl() + r * D_MODEL + k, bflo(u0), bflo(u1), bflo(u2), bflo(u3));
    }
  }
}
DEV void exp_prefix(const P& p, int l, int* toff, int* roff, int* rowo);
DEV void ph_ln2_gpu(const P& p, int l, char* smem) {
  const int tid_ = otid(); const int lane = tid_ & 63; const int gw = blockIdx.x * (NT / 64) + (tid_ >> 6), nw = gridDim.x * (NT / 64);
  int* toff = (int*)(smem + SM_MISC); int* roff = toff + N_EXPERTS + 1; int* rowo = roff + N_EXPERTS + 16;
  exp_prefix(p, l, toff, roff, rowo);
  int e_n = 0, s_n = 0;
  if (gw < NR && lane < TOP_K) { e_n = p.top_e()[(long)gw * TOP_K + lane]; s_n = p.posb()[(long)gw * TOP_K + lane]; }
  for (long r = gw; r < NR; r += nw) {
    const int myrow = rowo[e_n] + s_n;
    if (r + nw < NR && lane < TOP_K) { e_n = p.top_e()[(r + nw) * TOP_K + lane]; s_n = p.posb()[(r + nw) * TOP_K + lane]; }
    float4 a[4];
    const float* m = p.mod() + ((long)l * (BATCH + 1) + modrow(r)) * 6 * D_MODEL + 5 * D_MODEL;
#pragma unroll
    for (int i = 0; i < 4; ++i) {
      const int k = (i * 64 + lane) * 4;
      float4 f = *(const float4*)(p.ysh() + r * D_MODEL + k);
#pragma unroll
      for (int kk = 0; kk < TOP_K; ++kk) { const u32x2 y = *(const u32x2*)(p.ykb() + (long)__builtin_amdgcn_readlane(myrow, kk) * D_MODEL + k); f.x += __uint_as_float(y[0] << 16); f.y += __uint_as_float(y[0] & 0xffff0000u); f.z += __uint_as_float(y[1] << 16); f.w += __uint_as_float(y[1] & 0xffff0000u); }
      const float4 x = *(const float4*)(p.xcur() + r * D_MODEL + k), g2 = *(const float4*)(m + k);
      a[i].x = DN_ALPHA * x.x + g2.x * f.x; a[i].y = DN_ALPHA * x.y + g2.y * f.y; a[i].z = DN_ALPHA * x.z + g2.z * f.z; a[i].w = DN_ALPHA * x.w + g2.w * f.w;
    }
    ln_rows(a, p.ln2_g + l * D_MODEL, p.ln2_b + l * D_MODEL, lane);
    const float* mn = p.mod() + ((long)(l + 1) * (BATCH + 1) + modrow(r)) * 6 * D_MODEL;
#pragma unroll
    for (int i = 0; i < 4; ++i) {
      const int k = (i * 64 + lane) * 4;
      *(float4*)(p.xcur() + r * D_MODEL + k) = a[i];
      if (l + 1 < DEPTH) {
        const float4 sh = *(const float4*)(mn + k), sc = *(const float4*)(mn + D_MODEL + k);
        st_bf4(p.ubf() + r * D_MODEL + k, a[i].x * (1.f + sc.x) + sh.x, a[i].y * (1.f + sc.y) + sh.y, a[i].z * (1.f + sc.z) + sh.z, a[i].w * (1.f + sc.w) + sh.w);
      } else if (r < NL) *(float4*)(p.out + r * D_MODEL + k) = a[i];
    }
  }
}
struct ALRouter { const char* hi; const char* lo_; unsigned off[2];
  DEVM const unsigned short* a(int i, int kt) const { return (const unsigned short*)((kt >= 32 ? lo_ : hi) + (off[i] + (unsigned)(kt & 15) * 128u)); } };
struct BLRouter { const char* base; const char* lob; unsigned voff; unsigned rowb;
  DEVM void load(u32x4 (&rb)[4], int kt) const {
    const char* bb = (kt >> 4) == 1 ? lob : base;
#pragma unroll
    for (int c = 0; c < 4; ++c) rb[c] = *(const u32x4*)(bb + (voff + (unsigned)c * rowb + (unsigned)(kt & 15) * 128u)); } };
DEV void ph_router_mfma(const P& p, int l, char* smem) {
  const int tid = otid();
  const int n_router = (NR >> 7), n_sh = (NR >> 7) * 2;
  const int nrb = (int)gridDim.x >= 64 ? (int)((gridDim.x * 3) / 5) : 0;
  const bool is_router = nrb == 0 ? false : (int)blockIdx.x < nrb;
  for (int pass = 0; pass < 2; ++pass) {
    const bool do_router = nrb == 0 ? pass == 0 : is_router;
    if (nrb != 0 && pass == 1) break;
    const int first = nrb == 0 ? (int)blockIdx.x : (do_router ? (int)blockIdx.x : (int)blockIdx.x - nrb);
    const int stride = nrb == 0 ? (int)gridDim.x : (do_router ? nrb : (int)gridDim.x - nrb);
    const int nit = do_router ? n_router : n_sh;
    for (int it = first; it < nit; it += stride) {
      const int rt = do_router ? it : (it >> 1), cq = do_router ? 0 : (it & 1);
      ALRouter ar; ar.hi = (const char*)(p.ubf() + (long)rt * 128 * D_MODEL); ar.lo_ = (const char*)(p.ubl() + (long)rt * 128 * D_MODEL);
#pragma unroll
      for (int i = 0; i < 2; ++i) ar.off[i] = (unsigned)(((tid >> 3) + 64 * i) * D_MODEL + (tid & 7) * 8) * 2u;
      BLRouter br; int nk;
      if (do_router) {
        br.base = (const char*)(p.wt_rh() + (long)l * N_EXPERTS * D_MODEL); br.lob = (const char*)(p.wt_rl() + (long)l * N_EXPERTS * D_MODEL); br.rowb = D_MODEL * 2;
        br.voff = (unsigned)((tid >> 3) * 4) * br.rowb + (unsigned)((tid & 7) * 16); nk = 3 * (D_MODEL >> 6);
      } else {
        const int nq = tid >> 3; const int wsel = __builtin_amdgcn_readfirstlane(tid >> 6) & 1;
        const unsigned short* wsrc = (wsel ? p.wt_shu() : p.wt_shg()) + (long)l * SHARED_FF * D_MODEL;
        br.base = (const char*)wsrc; br.lob = br.base; br.rowb = D_MODEL * 2;
        br.voff = (unsigned)(cq * 128 + (nq >> 4) * 32 + (nq & 7) * 4) * br.rowb + (unsigned)((tid & 7) * 16); nk = D_MODEL >> 6;
      }
      f32x4 acc[4][4]; acc_zero(acc);
      gemm_tb(ar, br, nk, acc, smem);
      EPI_BEGIN
      if (do_router) {
#pragma unroll
        for (int m = 0; m < 4; ++m)
#pragma unroll
          for (int n = 0; n < 4; ++n)
#pragma unroll
            for (int j = 0; j < 4; ++j) p.rl()[((long)rt * 128 + EPI_ROW(m, j)) * N_EXPERTS + EPI_COL(n)] = acc[m][n][j];
      } else {
        const int elane = etid & 63, ewc = (etid >> 6) & 3;
#pragma unroll
        for (int m = 0; m < 4; ++m)
#pragma unroll
          for (int j = 0; j < 4; ++j)
          { unsigned short* dst = p.hsbf() + ((long)rt * 128 + EPI_ROW(m, j)) * SHARED_FF + cq * 128 + ewc * 32 + (elane & 15);
            dst[0] = (unsigned short)f2bf(siluf(acc[m][0][j]) * acc[m][2][j]); dst[16] = (unsigned short)f2bf(siluf(acc[m][1][j]) * acc[m][3][j]); }
      }
    }
  }
}
static_assert(EPG == 32 && TOP_K == 8 && N_EXPERT_GROUPS == 8 && TOPK_GROUPS == 4, "select shape");
DEV void ph_select_gpu(const P& p, int l) {
  const int tid_ = otid(); const int lane = tid_ & 63; const int gw = blockIdx.x * (NT / 64) + (tid_ >> 6), nw = gridDim.x * (NT / 64);
  const float4 rb = *(const float4*)(p.router_bias + l * N_EXPERTS + 4 * lane);
  for (long r = gw; r < NR; r += nw) {
    const float4 lg = *(const float4*)(p.rl() + r * N_EXPERTS + 4 * lane);
    float sc[4] = {sigmoidf_(lg.x), sigmoidf_(lg.y), sigmoidf_(lg.z), sigmoidf_(lg.w)};
    float bz[4] = {sc[0] + rb.x, sc[1] + rb.y, sc[2] + rb.z, sc[3] + rb.w};
    float m1 = fmaxf(bz[0], bz[1]), m2 = fminf(bz[0], bz[1]);
#pragma unroll
    for (int c = 2; c < 4; ++c) { const float v = bz[c]; m2 = fmaxf(m2, fminf(m1, v)); m1 = fmaxf(m1, v); }
#pragma unroll
    for (int o = 1; o < 8; o <<= 1) { const float b1 = __shfl_xor(m1, o), b2 = __shfl_xor(m2, o); m2 = fmaxf(fminf(m1, b1), fmaxf(m2, b2)); m1 = fmaxf(m1, b1); }
    const float gs = m1 + m2; const int mg = lane >> 3; int rank = 0;
#pragma unroll
    for (int j = 0; j < 8; ++j) { const float gj = __shfl(gs, j * 8); rank += (gj > gs || (gj == gs && j < mg)) ? 1 : 0; }
    if (rank >= TOPK_GROUPS) { bz[0] = bz[1] = bz[2] = bz[3] = -1e30f; }
    int sel_e[TOP_K]; float sel_s[TOP_K]; float gsum = 0.f;
#pragma unroll
    for (int it = 0; it < TOP_K; ++it) {
      float bv = bz[0]; int bc = 0;
#pragma unroll
      for (int c = 1; c < 4; ++c) if (bz[c] > bv) { bv = bz[c]; bc = c; }
      int bi = 4 * lane + bc; float bs = sc[bc];
      const int myi = bi;
#pragma unroll
      for (int o = 1; o < 64; o <<= 1) {
        const float ov = __shfl_xor(bv, o); const int oi = __shfl_xor(bi, o); const float os = __shfl_xor(bs, o);
        if (ov > bv || (ov == bv && oi < bi)) { bv = ov; bi = oi; bs = os; }
      }
      sel_e[it] = bi; sel_s[it] = bs; gsum += bs;
      if (bi == myi) {
#pragma unroll
        for (int c = 0; c < 4; ++c) if (c == bc) bz[c] = -1e30f;
      }
    }
    const float inv = ROUTED_SCALE / gsum;
    int me = sel_e[0]; float ms = sel_s[0];
#pragma unroll
    for (int it = 1; it < TOP_K; ++it) if (lane == it) { me = sel_e[it]; ms = sel_s[it]; }
    if (lane < TOP_K) {
      const long a = r * TOP_K + lane;
      p.top_e()[a] = me; p.gate()[a] = ms * inv;
      const int pos = atomicAdd(&p.cnt()[l * N_EXPERTS + me], 1);
      p.elist()[(long)me * NR + pos] = (int)a; p.egate()[(long)me * NR + pos] = ms * inv; p.posb()[a] = pos;
    }
  }
}
#endif

#ifndef CPU_TEST
#define XB_TMO      128
#define XB_XCNT(j)  (256  + 64 * (j))
#define XB_XSUB(j)  (1280 + 64 * (j))
#define XB_XGEN(j)  (2304 + 64 * (j))
#define XB_TOP      3328
#define XB_TOPGEN   3392
#define XCD_BAR_WORDS 3456
#define XB_SPIN_CAP (1u << 18)
#define LAS __attribute__((address_space(3)))
__device__ __forceinline__ unsigned xb_ld(unsigned* p)              { return __hip_atomic_load(p, __ATOMIC_RELAXED, __HIP_MEMORY_SCOPE_AGENT); }
__device__ __forceinline__ unsigned xb_add(unsigned* p, unsigned v) { return __hip_atomic_fetch_add(p, v, __ATOMIC_RELAXED, __HIP_MEMORY_SCOPE_AGENT); }
__device__ __forceinline__ unsigned xb_xcc_id() { return (unsigned)__builtin_amdgcn_s_getreg((3 << 11) | 20) & 0xFu; }
#define XB_SPIN(cond, bar) do { unsigned _sp = 0; while (cond) { __builtin_amdgcn_s_sleep(1); \
    if ((++_sp & 255u) == 0u) { if (xb_ld(&(bar)[XB_TMO])) break; if (_sp > XB_SPIN_CAP) { atomicAdd(&(bar)[XB_TMO], 1u); break; } } } } while (0)
struct XcdBarrier { unsigned* bar; unsigned x; volatile LAS unsigned* st; };
__device__ __forceinline__ XcdBarrier xcd_barrier_post(unsigned* bar, volatile LAS unsigned* st) {
    XcdBarrier b; b.bar = bar; b.x = xb_xcc_id(); b.st = st;
    if (threadIdx.x == 0) (void)xb_add(&bar[XB_XCNT(b.x)], 1u);
    return b;
}
__device__ __forceinline__ void xcd_barrier_complete(unsigned* bar, unsigned x, unsigned& nloc, unsigned& nx) {
    const unsigned G = gridDim.x * gridDim.y * gridDim.z;
    unsigned sum, cnt, mine, sp = 0u;
    for (;;) {
        sum = 0u; cnt = 0u; mine = 0u;
#pragma unroll
        for (unsigned j = 0; j < 16; ++j) { const unsigned c = xb_ld(&bar[XB_XCNT(j)]); sum += c; cnt += (c > 0u) ? 1u : 0u; mine = (j == x) ? c : mine; }
        if (sum == G) break;
        __builtin_amdgcn_s_sleep(1);
        if ((++sp & 255u) == 0u) { if (xb_ld(&bar[XB_TMO])) break; if (sp > XB_SPIN_CAP) { atomicAdd(&bar[XB_TMO], 1u); break; } }
    }
    nloc = mine > 0u ? mine : 1u; nx = cnt > 0u ? cnt : 1u;
}
__device__ __forceinline__ void xcd_barrier(const XcdBarrier& b) {
    asm volatile("s_waitcnt vmcnt(0)" ::: "memory");
    __syncthreads();
    if (threadIdx.x == 0) {
        unsigned* bar = b.bar;
        unsigned bx = b.x; asm volatile("" : "+s"(bx));
        __builtin_amdgcn_s_waitcnt(0);
        unsigned nloc = b.st[0], nx = b.st[1];
        if (nloc == 0u) { xcd_barrier_complete(bar, bx, nloc, nx); b.st[0] = nloc; b.st[1] = nx; }
        const unsigned old = xb_add(&bar[XB_XSUB(bx)], 1u);
        const unsigned gen = old / nloc;
        if (old + 1u == (gen + 1u) * nloc) {
            __builtin_amdgcn_fence(__ATOMIC_RELEASE, "agent");
            asm volatile("s_waitcnt vmcnt(0)" ::: "memory");
            const unsigned og = xb_add(&bar[XB_TOP], 1u);
            const unsigned tg = og / nx;
            if (og + 1u == (tg + 1u) * nx) xb_add(&bar[XB_TOPGEN], 1u);
            else XB_SPIN(xb_ld(&bar[XB_TOPGEN]) == tg, bar);
            __builtin_amdgcn_fence(__ATOMIC_ACQUIRE, "agent");
            xb_add(&bar[XB_XGEN(bx)], 1u);
            asm volatile("s_waitcnt vmcnt(0)" ::: "memory");
        } else {
            XB_SPIN(xb_ld(&bar[XB_XGEN(bx)]) == gen, bar);
            __builtin_amdgcn_fence(__ATOMIC_ACQUIRE, "agent");
            asm volatile("s_waitcnt vmcnt(0)" ::: "memory");
        }
    }
    __syncthreads();
}
#define GRID_SYNC() xcd_barrier(xb)
#else
#define GRID_SYNC() do {} while (0)
#endif

#ifndef CPU_TEST
#define GPUSEL(a, b) a
#else
#define GPUSEL(a, b) b
#endif
#ifndef CPU_TEST
#define OPAQUE_S(v) asm volatile("" : "+s"(v))
#define OPAQUE_V(v) asm volatile("" : "+v"(v))
#else
#define OPAQUE_S(v) do {} while (0)
#define OPAQUE_V(v) do {} while (0)
#endif
#ifndef PROBE_MASK
#define PROBE_MASK 0
#endif
#define LPHASE(stmt) do { int l = lo; OPAQUE_S(l); if (SINGLE && ((PROBE_MASK >> (ph - NG - lo * NLP)) & 1)) { long gtid = gtid0; OPAQUE_V(gtid); stmt; GRID_SYNC(); } PHASE(stmt); } while (0)
#define PHASE(stmt) do { if (SINGLE || ph == only) { long gtid = gtid0; OPAQUE_V(gtid); stmt; } if (SINGLE) { GRID_SYNC(); } ++ph; } while (0)
#ifndef CPU_TEST
template <bool SINGLE> __device__ __forceinline__ void run_seq(const P& p, long gtid0, long gsize, int only, const XcdBarrier& xb, char* smem)
#else
template <bool SINGLE> static int run_seq(const P& p, long gtid0, long gsize, int only)
#endif
{
  int ph = 0;
  PHASE(ph_g0(p, gtid, gsize));
  PHASE(ph_g1(p, gtid, gsize));
  PHASE(ph_g2(p, gtid, gsize));
  PHASE(ph_g3(p, gtid, gsize));
  PHASE(ph_g4(p, gtid, gsize));
#pragma unroll 1
  for (int lo = 0; lo < DEPTH; ++lo) {
    LPHASE(ph_modu(p, l, 0, gtid, gsize));
    LPHASE(GPUSEL(ph_proj_mfma(p, l, smem), ph_proj(p, l, gtid, gsize)));
    LPHASE(ph_post_proj(p, l, gtid, gsize));
    LPHASE(ph_mix(p, l, gtid, gsize); GPUSEL((ph_attn_mfma(p, l, smem), ph_hyena_mfma(p, l, smem)), (void)0));
    LPHASE(ph_s5out(p, l, gtid, gsize));
    LPHASE(GPUSEL(ph_glu_mfma(p, l, smem), ph_glu(p, l, gtid, gsize)));
    LPHASE(ph_rms(p, l, gtid, gsize));
    LPHASE(GPUSEL(ph_outproj_mfma(p, l, smem), ph_outproj(p, l, gtid, gsize)));
    LPHASE(ph_ln(p, l, 0, gtid, gsize));
    LPHASE(ph_router(p, l, gtid, gsize));
    LPHASE(ph_select(p, l, gtid, gsize));
    LPHASE(ph_sortrows(p, l, gtid, gsize));
    LPHASE(GPUSEL(ph_expert_up_mfma(p, l, smem), ph_expert_up(p, l, gtid, gsize)));
    LPHASE(GPUSEL(ph_expert_down_mfma(p, l, smem), ph_expert_down(p, l, gtid, gsize)));
    LPHASE(ph_combine(p, l, gtid, gsize));
    LPHASE(ph_ln(p, l, 1, gtid, gsize));
  }
#ifdef CPU_TEST
  return ph;
#endif
}


#ifndef CPU_TEST
#define NG_GPU 5
#define NLP_GPU 12
#ifndef PROBE_MASK_G
#define PROBE_MASK_G 0
#endif
#define GPHASE(stmt) do { if (SINGLE || ph == only) { long gtid = (long)blockIdx.x * NT + otid(); stmt; } if (SINGLE) { GRID_SYNC(); } ++ph; } while (0)
#define GLPHASE(stmt) do { int l = lo; OPAQUE_S(l); if (SINGLE && ((PROBE_MASK_G >> (ph - NG_GPU - lo * NLP_GPU)) & 1)) { long gtid = (long)blockIdx.x * NT + otid(); stmt; GRID_SYNC(); } GPHASE(stmt); } while (0)
template <bool SINGLE> __device__ __forceinline__ void run_seq_gpu(const P& p, long gtid0, long gsize, int only, const XcdBarrier& xb, char* smem) {
  int ph = 0;
#ifdef PROBE_INIT
  if (SINGLE) { long gtid = (long)blockIdx.x * NT + otid(); ph_g0(p, gtid, gsize); GRID_SYNC(); ph_g1(p, gtid, gsize); ph_modsum_gpu(p, gtid, gsize); ph_s5tables_gpu(p, gtid, gsize); GRID_SYNC(); ph_g2(p, gtid, gsize); ph_modu0_gpu(p, gtid, gsize); GRID_SYNC(); ph_g3(p, gtid, gsize); GRID_SYNC(); ph_g4(p, gtid, gsize); GRID_SYNC(); }
#endif
  GPHASE(ph_g0(p, gtid, gsize); s5_lampow_gpu(p, gtid, gsize); rope_table_gpu(p, gtid, gsize));
  GPHASE(ph_g1(p, gtid, gsize); ph_modsum_gpu(p, gtid, gsize); ph_s5tables_gpu(p, gtid, gsize); wt_convert_all(p, gtid, gsize));
  GPHASE(ph_g2(p, gtid, gsize); ph_modu0_gpu(p, gtid, gsize); ph_kcb_gpu(p, gtid, gsize));
  GPHASE(ph_g3(p, gtid, gsize));
  GPHASE(ph_g4(p, gtid, gsize));
#pragma unroll 1
  for (int lo = 0; lo < DEPTH; ++lo) {
    GLPHASE(ph_proj_mfma(p, l, smem));
    GLPHASE(ph_s5_sgemm(p, l, smem); ph_hyena_pre_gpu(p, l, gtid, gsize));
    GLPHASE(ph_mix(p, l, gtid, gsize); ph_s5_carry_gpu(p, l, smem); ph_attn_mfma(p, l, smem); ph_hyena_mfma(p, l, smem));
    GLPHASE(ph_s5_ygemm(p, l, smem));
    GLPHASE(ph_glu_mfma(p, l, smem));
    GLPHASE(ph_outproj_mfma(p, l, smem));
    GLPHASE(ph_ln1_gpu(p, l));
    GLPHASE(ph_router_mfma(p, l, smem));
    GLPHASE(ph_select_gpu(p, l));
#ifdef UPVAR
    if (SINGLE) { int l = lo; OPAQUE_S(l); ph_expert_up_mfma<UPVAR>(p, l, smem); GRID_SYNC(); }
#endif
    GLPHASE(ph_expert_up_mfma(p, l, smem));
    GLPHASE(ph_expert_down_mfma(p, l, smem));
    GLPHASE(ph_ln2_gpu(p, l, smem));
  }
}
#endif

static void carve(P& p, void* ws) { p.ws = (char*)ws; }
static void set_inputs(P& p, void* const* d_in) {
  const float** f = (const float**)&p.x;
  for (int i = 0; i < 40; ++i) f[i] = (const float*)d_in[i];
}

#ifndef CPU_TEST
#ifndef MK_SINGLE
#define MK_SINGLE 1
#endif
extern __shared__ __attribute__((aligned(16))) char dyn_smem[];
__global__ void __launch_bounds__(NT, 2) mk_single(P p) {
  uint4* xbw = (uint4*)(dyn_smem + SM_XB);
  if (threadIdx.x == 0) *xbw = make_uint4(0u, 0u, 0u, 0u);
  __syncthreads();
  XcdBarrier xb = xcd_barrier_post(p.bar(), (volatile LAS unsigned*)xbw);
  run_seq_gpu<true>(p, (long)blockIdx.x * blockDim.x + threadIdx.x, (long)gridDim.x * blockDim.x, -1, xb, dyn_smem);
}
__global__ void __launch_bounds__(NT, 2) mk_phase(P p, int only) {
  XcdBarrier xb; xb.bar = p.bar(); xb.x = 0; xb.st = nullptr;
#ifdef DBG_ONLY
  only = DBG_ONLY;
#endif
  run_seq_gpu<false>(p, (long)blockIdx.x * blockDim.x + threadIdx.x, (long)gridDim.x * blockDim.x, only, xb, dyn_smem);
}
extern "C" void kernel_launch(void* const* d_in, const int* in_sizes, int n_in, void* d_out, int out_size, void* d_ws, size_t ws_size, hipStream_t stream) {
  P p; memset(&p, 0, sizeof(p));
  set_inputs(p, d_in); p.out = (float*)d_out; carve(p, d_ws);
  (void)hipMemsetAsync(p.bar(), 0, 4096 * sizeof(unsigned) + ((DEPTH * N_EXPERTS * sizeof(int) + 255) / 256) * 256, stream);
#if MK_SINGLE
  static int grid = 0;
  if (!grid) {
    int dev = 0, cus = 0, per_cu = 0; (void)hipGetDevice(&dev);
    (void)hipDeviceGetAttribute(&cus, hipDeviceAttributeMultiprocessorCount, dev);
    (void)hipFuncSetAttribute((const void*)mk_single, hipFuncAttributeMaxDynamicSharedMemorySize, SMEM_BYTES);
    (void)hipOccupancyMaxActiveBlocksPerMultiprocessor(&per_cu, mk_single, NT, SMEM_BYTES);
    grid = cus * (per_cu < 1 ? per_cu : 1);
  }
  mk_single<<<grid, NT, SMEM_BYTES, stream>>>(p);
#else
  for (int ph = 0; ph < NG_GPU + DEPTH * NLP_GPU; ++ph) mk_phase<<<256, NT, SMEM_BYTES, stream>>>(p, ph);
#endif
}
#endif
```

```cpp
#ifndef CPU_TEST
#include <hip/hip_runtime.h>
#include <cstring>
#define DEV __device__ __forceinline__
#define DEVM __device__ __forceinline__
#define HDM __host__ __device__ __forceinline__
#else
#include <cmath>
#include <cstdio>
#include <cstdlib>
#include <cstring>
#define DEV static inline
#define DEVM inline
#define HDM inline
struct float2 { float x, y; };
static inline float2 make_float2(float a, float b) { float2 r; r.x = a; r.y = b; return r; }
static inline int atomicAdd(int* p, int v) { int o = *p; *p += v; return o; }
#endif

#ifdef SMALL_CFG
#define D_MODEL 64
#define BATCH 2
#define SEQ 256
#define GRID_W 16
#define CTX_LEN 32
#define HEAD_DIM 16
#define N_Q_HEADS 4
#define N_KV_HEADS 2
#define HYENA_W 16
#define S5_W 32
#define WINDOW 32
#define FILTER_HIDDEN 16
#define S5_STATE 8
#define N_EXPERTS 32
#define TOP_K 4
#define EXPERT_FF 16
#define SHARED_FF 16
#define S5_T 32
#else
#define D_MODEL 1024
#define BATCH 2
#define SEQ 8192
#define GRID_W 64
#define CTX_LEN 256
#define HEAD_DIM 64
#define N_Q_HEADS 8
#define N_KV_HEADS 2
#define HYENA_W 256
#define S5_W 256
#define WINDOW 128
#define FILTER_HIDDEN 64
#define S5_STATE 64
#define N_EXPERTS 256
#define TOP_K 8
#define EXPERT_FF 256
#define SHARED_FF 256
#define S5_T 64
#endif
#define DEPTH 2
#define FILTER_EMB 33
#define N_EXPERT_GROUPS 8
#define TOPK_GROUPS 4
#define S5_GROUP 16
#define Q_GROUP (N_Q_HEADS / N_KV_HEADS)
#define ATTN_W (N_Q_HEADS * HEAD_DIM)
#define KV_W (N_KV_HEADS * HEAD_DIM)
#define MIX_W (ATTN_W + HYENA_W + S5_W)
#define Q_OFF 0
#define K_OFF ATTN_W
#define V_OFF (K_OFF + KV_W)
#define HY_OFF (V_OFF + KV_W)
#define S5_OFF (HY_OFF + 3 * HYENA_W)
#define IN_W (S5_OFF + S5_W)
#define AXIS_DIM (HEAD_DIM / 2)
#define ROPE_HALF (AXIS_DIM / 2)
#define S5_GROUPS (S5_W / S5_GROUP)
#define EPG (N_EXPERTS / N_EXPERT_GROUPS)
#define NL (BATCH * SEQ)
#define NC (BATCH * CTX_LEN)
#define NR (NL + NC)
#define NSEQ (CTX_LEN + SEQ)
#define NCH (NSEQ / S5_T)
#define LN_EPS 1e-5f
#define DN_ALPHA 1.4142135623730951f
#define ROUTED_SCALE 2.5f
#define PI_D 3.14159265358979323846

#define WS_LIST(X) \
  X(unsigned, bar, 4096) \
  X(int, cnt, DEPTH * N_EXPERTS) \
  X(float, mod, (size_t)DEPTH * (BATCH + 1) * 6 * D_MODEL) \
  X(float, xcur, (size_t)NR * D_MODEL) \
  X(float, ubuf, (size_t)NR * D_MODEL) \
  X(float, proj, (size_t)NR * IN_W) \
  X(float, hu, (size_t)NR * HYENA_W) \
  X(float, hx0, (size_t)NR * HYENA_W) \
  X(float, fh1, (size_t)DEPTH * SEQ * FILTER_HIDDEN) \
  X(float, fh2, (size_t)DEPTH * SEQ * FILTER_HIDDEN) \
  X(float, kraw, (size_t)DEPTH * SEQ * 2 * HYENA_W) \
  X(float, knorm, (size_t)DEPTH * HYENA_W) \
  X(float, fh1c, (size_t)CTX_LEN * FILTER_HIDDEN) \
  X(float, fh2c, (size_t)CTX_LEN * FILTER_HIDDEN) \
  X(float, krawc, (size_t)CTX_LEN * 2 * HYENA_W) \
  X(float, knormc, (size_t)HYENA_W) \
  X(float, mixb, (size_t)NR * MIX_W) \
  X(float, tmp, (size_t)NR * D_MODEL) \
  X(float2, lampow, (size_t)DEPTH * 2 * S5_GROUPS * (S5_T + 1) * S5_STATE) \
  X(float2, bbar, (size_t)DEPTH * 2 * S5_GROUPS * S5_STATE * S5_GROUP) \
  X(float, kc, (size_t)DEPTH * 2 * S5_GROUPS * S5_T * S5_GROUP * S5_GROUP) \
  X(float2, sc, (size_t)BATCH * 2 * S5_GROUPS * NCH * S5_STATE) \
  X(float2, hc, (size_t)BATCH * 2 * S5_GROUPS * NCH * S5_STATE) \
  X(float, ybuf, (size_t)NR * S5_W) \
  X(float, rl, (size_t)NR * N_EXPERTS) \
  X(int, top_e, (size_t)NR * TOP_K) \
  X(float, gate, (size_t)NR * TOP_K) \
  X(int, posb, (size_t)NR * TOP_K) \
  X(int, srow, (size_t)NR * TOP_K) \
  X(float, hbuf, (size_t)NR * TOP_K * EXPERT_FF) \
  X(float, hsb, (size_t)NR * SHARED_FF) \
  X(float, yk, (size_t)NR * TOP_K * D_MODEL) \
  X(float, ysh, (size_t)NR * D_MODEL) \
  X(unsigned short, ykb, (size_t)NR * TOP_K * D_MODEL) \
  X(unsigned short, qkvb, (size_t)NR * HY_OFF) \
  X(float2, ropet, (size_t)128 * ROPE_HALF) \
  X(unsigned short, bmtb, (size_t)DEPTH * 2 * S5_GROUPS * 128 * 1024) \
  X(unsigned short, cmtb, (size_t)DEPTH * 2 * S5_GROUPS * 1024 * 128) \
  X(unsigned short, kcb, (size_t)DEPTH * 2 * S5_GROUPS * S5_T * 256) \
  X(unsigned short, wt_in, (size_t)DEPTH * IN_W * D_MODEL) \
  X(unsigned short, wt_out, (size_t)DEPTH * D_MODEL * MIX_W) \
  X(unsigned short, wt_glu, (size_t)DEPTH * S5_W * S5_W) \
  X(unsigned short, wt_shg, (size_t)DEPTH * SHARED_FF * D_MODEL) \
  X(unsigned short, wt_shu, (size_t)DEPTH * SHARED_FF * D_MODEL) \
  X(unsigned short, wt_shd, (size_t)DEPTH * D_MODEL * SHARED_FF) \
  X(unsigned short, wt_rh, (size_t)DEPTH * N_EXPERTS * D_MODEL) \
  X(unsigned short, wt_rl, (size_t)DEPTH * N_EXPERTS * D_MODEL) \
  X(unsigned short, ubf, (size_t)NR * D_MODEL) \
  X(unsigned short, ybf, (size_t)NR * S5_W) \
  X(unsigned short, mixbf, (size_t)NR * MIX_W) \
  X(unsigned short, hbf, (size_t)NR * TOP_K * EXPERT_FF) \
  X(unsigned short, hsbf, (size_t)NR * SHARED_FF) \
  X(unsigned short, ubl, (size_t)NR * D_MODEL) \
  X(int, elist, (size_t)N_EXPERTS * NR) \
  X(float, egate, (size_t)N_EXPERTS * NR) \
  X(unsigned short, s5u, (size_t)NR * S5_W) \
  X(float, bmt, (size_t)DEPTH * 2 * S5_GROUPS * 16 * S5_T * 2 * S5_STATE) \
  X(float, cmt, (size_t)DEPTH * 2 * S5_GROUPS * 16 * S5_T * 2 * S5_STATE) \
  X(unsigned short, hcbf, (size_t)BATCH * 2 * S5_GROUPS * NCH * 2 * S5_STATE) \
  X(float, zT, (size_t)BATCH * 3 * HYENA_W * (SEQ + CTX_LEN)) \
  X(float, modp, (size_t)DEPTH * 16 * (BATCH + 1) * 6 * D_MODEL) \
  X(float, wrlo, (size_t)DEPTH * D_MODEL * N_EXPERTS) \

struct WsOff {
#define X(T, name, n) size_t name;
  WS_LIST(X)
#undef X
  size_t total;
};
constexpr WsOff ws_offsets() {
  WsOff o{}; size_t off = 0;
#define X(T, name, n) o.name = off; off += (((size_t)(n)) * sizeof(T) + 255) / 256 * 256;
  WS_LIST(X)
#undef X
  o.total = off; return o;
}
constexpr WsOff WSO = ws_offsets();
struct P {
  const float *x, *c, *ctx, *c_ctx, *w_ada, *b_ada, *w_in, *w_out, *sink, *mix_g, *hy_short_w, *hy_short_b, *hy_w1,
      *hy_b1, *hy_freq, *hy_w2, *hy_b2, *hy_w3, *hy_d, *s5_a_re, *s5_a_im, *s5_log_dt, *s5_b_re, *s5_b_im, *s5_c_re,
      *s5_c_im, *s5_d, *s5_w_glu, *ln1_g, *ln1_b, *ln2_g, *ln2_b, *w_router, *router_bias, *w_exp_gate, *w_exp_up,
      *w_exp_down, *w_sh_gate, *w_sh_up, *w_sh_down;
  float* out;
  char* ws;
#define X(T, name, n) HDM T* name() const { return (T*)(ws + WSO.name); }
  WS_LIST(X)
#undef X
};

#define FOR_ITEMS(i, N) for (long i = gtid; i < (long)(N); i += gsize)
#ifndef CPU_TEST
#define FOR_ITEMS4(i, N) _Pragma("unroll 4") for (long i = gtid; i < (long)(N); i += gsize)
#else
#define FOR_ITEMS4(i, N) FOR_ITEMS(i, N)
#endif

DEV unsigned short f2bf16(float f) { unsigned u; memcpy(&u, &f, 4); return (unsigned short)((u + 0x7fffu + ((u >> 16) & 1u)) >> 16); }
DEV float siluf(float x) { return x / (1.0f + expf(-x)); }
DEV float sigmoidf_(float x) { return 1.0f / (1.0f + expf(-x)); }
#ifndef CPU_TEST
DEV float rl_f(float v, int srcl) { return __int_as_float(__builtin_amdgcn_readlane(__float_as_int(v), srcl)); }
DEV float siluq(float x) { return x * __builtin_amdgcn_rcpf(1.0f + __builtin_amdgcn_exp2f(-1.4426950408889634f * x)); }
#endif
DEV float gelu_tanhf(float x) { return 0.5f * x * (1.0f + tanhf(0.7978845608028654f * (x + 0.044715f * x * x * x))); }
DEV int modrow(long r) { return r < NL ? (int)(r / SEQ) : BATCH; }

DEV void ph_g0(const P& p, long gtid, long gsize) {
#ifndef CPU_TEST
  FOR_ITEMS4(i4, (long)NR * D_MODEL / 4) { const long i = i4 * 4; *(float4*)(p.xcur() + i) = i < (long)NL * D_MODEL ? *(const float4*)(p.x + i) : *(const float4*)(p.ctx + (i - (long)NL * D_MODEL)); }
#else
  FOR_ITEMS(i, (long)NR * D_MODEL) p.xcur()[i] = i < (long)NL * D_MODEL ? p.x[i] : p.ctx[i - (long)NL * D_MODEL];
#endif
#ifdef CPU_TEST
  FOR_ITEMS(i, DEPTH * (BATCH + 1) * 6 * D_MODEL) {
    int n = (int)(i % (6 * D_MODEL)); int j = (int)((i / (6 * D_MODEL)) % (BATCH + 1)); int l = (int)(i / (6 * D_MODEL * (BATCH + 1)));
    const float* cv = j < BATCH ? p.c + j * D_MODEL : p.c_ctx;
    const float* w = p.w_ada + (long)l * D_MODEL * 6 * D_MODEL;
    float acc = p.b_ada[l * 6 * D_MODEL + n];
    for (int k = 0; k < D_MODEL; ++k) acc += siluf(cv[k]) * w[(long)k * 6 * D_MODEL + n];
    p.mod()[i] = acc;
  }
#else
  FOR_ITEMS(i, (long)DEPTH * 16 * 6 * D_MODEL) {
    const int n = (int)(i % (6 * D_MODEL)); const int slab = (int)((i / (6 * D_MODEL)) % 16); const int l = (int)(i / (6 * D_MODEL * 16));
    const float* w = p.w_ada + ((long)l * D_MODEL + slab * 64) * 6 * D_MODEL + n;
    float a0 = 0.f, a1 = 0.f, a2 = 0.f;
    const int kl = slab * 64 + (int)(gtid & 63);
    const float s0 = siluf(p.c[kl]), s1 = siluf(p.c[D_MODEL + kl]), s2 = siluf(p.c_ctx[kl]);
#pragma unroll
    for (int k = 0; k < 64; ++k) {
      const float wv = w[(long)k * 6 * D_MODEL];
      a0 += rl_f(s0, k) * wv; a1 += rl_f(s1, k) * wv; a2 += rl_f(s2, k) * wv;
    }
    float* dst = p.modp() + ((long)(l * 16 + slab) * (BATCH + 1)) * 6 * D_MODEL + n;
    dst[0] = a0; dst[6 * D_MODEL] = a1; dst[2 * 6 * D_MODEL] = a2;
  }
#endif
  FOR_ITEMS(i, DEPTH * 2 * S5_GROUPS * S5_STATE) {
    int pp = (int)(i % S5_STATE); int g = (int)((i / S5_STATE) % S5_GROUPS); int ld = (int)(i / (S5_STATE * S5_GROUPS));
    float are = fminf(p.s5_a_re[i], -1e-4f), aim = p.s5_a_im[i];
    float dt = expf(p.s5_log_dt[ld * S5_GROUPS + g]);
#ifdef CPU_TEST
    for (int d = 0; d <= S5_T; ++d) {
      float mag = expf(are * dt * d); float ang = aim * dt * d;
      p.lampow()[((long)(ld * S5_GROUPS + g) * (S5_T + 1) + d) * S5_STATE + pp] = make_float2(mag * cosf(ang), mag * sinf(ang));
    }
#endif
    float mag = expf(are * dt), ang = aim * dt;
    float lr = mag * cosf(ang) - 1.0f, li = mag * sinf(ang);
    float den = are * are + aim * aim;
    float fr = (lr * are + li * aim) / den, fi = (li * are - lr * aim) / den;
    for (int j = 0; j < S5_GROUP; ++j) {
      float br = p.s5_b_re[i * S5_GROUP + j], bi = p.s5_b_im[i * S5_GROUP + j];
      p.bbar()[i * S5_GROUP + j] = make_float2(fr * br - fi * bi, fr * bi + fi * br);
    }
  }
}
#ifndef CPU_TEST
DEV void rope_table_gpu(const P& p, long gtid, long gsize) {
  FOR_ITEMS(i, (long)128 * ROPE_HALF) {
    const int ii = (int)(i % ROPE_HALF), pos = (int)(i / ROPE_HALF);
    const float ang = (float)pos * powf(10000.0f, -(float)(2 * ii) / (float)AXIS_DIM);
    p.ropet()[i] = make_float2(cosf(ang), sinf(ang));
  }
}
DEV void s5_lampow_gpu(const P& p, long gtid, long gsize) {
  FOR_ITEMS4(i, (long)DEPTH * 2 * S5_GROUPS * (S5_T + 1) * S5_STATE) {
    const int pp = (int)(i % S5_STATE); const int d = (int)((i / S5_STATE) % (S5_T + 1)); const long ldg = i / ((long)S5_STATE * (S5_T + 1));
    const long src = ldg * S5_STATE + pp;
    const float are = fminf(p.s5_a_re[src], -1e-4f), aim = p.s5_a_im[src]; const float dt = expf(p.s5_log_dt[ldg]);
    const float mag = expf(are * dt * d); const float ang = aim * dt * d;
    p.lampow()[i] = make_float2(mag * cosf(ang), mag * sinf(ang));
  }
}
#endif
DEV void hy_f1(const P& p, int l, int Lf, float* h1, long gtid, long gsize) {
  FOR_ITEMS(i, (long)Lf * FILTER_HIDDEN) {
    int j = (int)(i % FILTER_HIDDEN); int t = (int)(i / FILTER_HIDDEN);
    const float* w1 = p.hy_w1 + l * FILTER_EMB * FILTER_HIDDEN;
    float tt = (float)((double)t / (double)(Lf - 1));
    float w = (float)(2.0 * PI_D * (double)t / (double)Lf);
    float acc = p.hy_b1[l * FILTER_HIDDEN + j] + tt * w1[j];
    const int bands = (FILTER_EMB - 1) / 2;
    for (int m = 0; m < bands; ++m) {
      float f = (float)(1e-4 + (double)m * ((double)(bands - 1) - 1e-4) / (double)(bands - 1));
      float a = f * w;
      acc += cosf(a) * w1[(1 + m) * FILTER_HIDDEN + j] - sinf(a) * w1[(1 + bands + m) * FILTER_HIDDEN + j];
    }
    h1[i] = sinf(p.hy_freq[l * FILTER_HIDDEN + j] * acc);
  }
}
DEV void hy_f2(const P& p, int l, int Lf, const float* h1, float* h2, long gtid, long gsize) {
  FOR_ITEMS(i, (long)Lf * FILTER_HIDDEN) {
    int j = (int)(i % FILTER_HIDDEN); int t = (int)(i / FILTER_HIDDEN);
    const float* w2 = p.hy_w2 + l * FILTER_HIDDEN * FILTER_HIDDEN;
    float acc = p.hy_b2[l * FILTER_HIDDEN + j];
    for (int k = 0; k < FILTER_HIDDEN; ++k) acc += h1[t * FILTER_HIDDEN + k] * w2[k * FILTER_HIDDEN + j];
#ifndef CPU_TEST
    h2[(long)j * Lf + t] = sinf(p.hy_freq[l * FILTER_HIDDEN + j] * acc);
#else
    h2[i] = sinf(p.hy_freq[l * FILTER_HIDDEN + j] * acc);
#endif
  }
}
DEV void hy_f3(const P& p, int l, int Lf, const float* h2, float* kraw, long gtid, long gsize) {
#ifndef CPU_TEST
  const float* w3 = p.hy_w3 + l * FILTER_HIDDEN * 2 * HYENA_W;
  FOR_ITEMS(i, (long)Lf * (2 * HYENA_W / 8)) {
    const int t = (int)(i % Lf); const int c8 = (int)(i / Lf) * 8;
    float acc[8];
#pragma unroll
    for (int j = 0; j < 8; ++j) acc[j] = 0.f;
#pragma unroll 4
    for (int k = 0; k < FILTER_HIDDEN; ++k) {
      const float hv = h2[(long)k * Lf + t];
      const float4 wa = *(const float4*)(w3 + k * 2 * HYENA_W + c8), wb = *(const float4*)(w3 + k * 2 * HYENA_W + c8 + 4);
      acc[0] += hv * wa.x; acc[1] += hv * wa.y; acc[2] += hv * wa.z; acc[3] += hv * wa.w; acc[4] += hv * wb.x; acc[5] += hv * wb.y; acc[6] += hv * wb.z; acc[7] += hv * wb.w;
    }
    const double d0 = log(1e-2) / 0.3, d1 = log(1e-2) / 1.5;
    const float tt = (float)((double)t / (double)(Lf - 1));
#pragma unroll
    for (int j = 0; j < 8; ++j) {
      const int ch = (c8 + j) % HYENA_W;
      const float delta = fabsf((float)(d0 + (d1 - d0) * (double)ch / (double)(HYENA_W - 1)));
      kraw[(long)(c8 + j) * Lf + t] = acc[j] * expf(-tt * delta);
    }
  }
#else
  FOR_ITEMS(i, (long)Lf * 2 * HYENA_W) {
    int t = (int)(i % Lf); int cc = (int)(i / Lf); int ch = cc % HYENA_W;
    const float* w3 = p.hy_w3 + l * FILTER_HIDDEN * 2 * HYENA_W;
    float acc = 0.f;
    for (int k = 0; k < FILTER_HIDDEN; ++k) acc += h2[t * FILTER_HIDDEN + k] * w3[k * 2 * HYENA_W + cc];
    double d0 = log(1e-2) / 0.3, d1 = log(1e-2) / 1.5;
    float delta = fabsf((float)(d0 + (d1 - d0) * (double)ch / (double)(HYENA_W - 1)));
    float tt = (float)((double)t / (double)(Lf - 1));
    kraw[(long)cc * Lf + t] = acc * expf(-tt * delta);
  }
#endif
}
DEV void hy_f4(int Lf, const float* kraw, float* knorm, long gtid, long gsize) {
#ifndef CPU_TEST
  const int lane = (int)(gtid & 63); const long gw = gtid >> 6, nw = gsize >> 6;
  for (long i = gw; i < HYENA_W; i += nw) {
    float s = 0.f;
    for (int t = lane; t < Lf; t += 64) { s += fabsf(kraw[i * Lf + t]); if (t > 0) s += fabsf(kraw[(HYENA_W + i) * Lf + t]); }
    for (int o = 32; o > 0; o >>= 1) s += __shfl_xor(s, o);
    if (lane == 0) knorm[i] = 1.0f / s;
  }
#else
  FOR_ITEMS(i, HYENA_W) {
    float s = 0.f;
    for (int t = 0; t < Lf; ++t) {
      s += fabsf(kraw[(long)i * Lf + t]);
      if (t > 0) s += fabsf(kraw[(long)(HYENA_W + i) * Lf + t]);
    }
    knorm[i] = 1.0f / s;
  }
#endif
}
#ifndef CPU_TEST
DEV void hy_f1g(const P& p, int l, int Lf, float* h1, long gtid, long gsize) {
  const int lane = (int)(gtid & 63);
  const float* w1 = p.hy_w1 + l * FILTER_EMB * FILTER_HIDDEN;
  const int bands = (FILTER_EMB - 1) / 2;
  static_assert(FILTER_HIDDEN == 64 && (FILTER_EMB - 1) / 2 == 16, "filter shape");
  FOR_ITEMS(i, (long)Lf * FILTER_HIDDEN) {
    const int j = lane; const int t = (int)(i / FILTER_HIDDEN);
    const float tt = (float)((double)t / (double)(Lf - 1));
    const float w = (float)(2.0 * PI_D * (double)t / (double)Lf);
    const int mm = lane & 15;
    const float f = (float)(1e-4 + (double)mm * ((double)(bands - 1) - 1e-4) / (double)(bands - 1));
    const float a = f * w; const float ca = cosf(a), sa = sinf(a);
    float acc = p.hy_b1[l * FILTER_HIDDEN + j] + tt * w1[j];
#pragma unroll
    for (int m = 0; m < 16; ++m) acc += rl_f(ca, m) * w1[(1 + m) * FILTER_HIDDEN + j] - rl_f(sa, m) * w1[(1 + bands + m) * FILTER_HIDDEN + j];
    h1[i] = sinf(p.hy_freq[l * FILTER_HIDDEN + j] * acc);
  }
}
DEV void hy_f2g(const P& p, long gtid, long gsize) {
  const long n_main = (long)DEPTH * 8 * SEQ, n_all = n_main + 8 * CTX_LEN;
  FOR_ITEMS(i, n_all) {
    const bool isc = __builtin_amdgcn_readfirstlane((int)(i >= n_main)) != 0;
    const long ii = isc ? i - n_main : i; const int Lf = isc ? CTX_LEN : SEQ;
    const int t = (int)(ii % Lf); const int gq = __builtin_amdgcn_readfirstlane((int)(ii / Lf)); const int j8 = (gq & 7) * 8, l = isc ? 0 : (gq >> 3);
    const float* h1 = isc ? p.fh1c() : p.fh1() + (long)l * SEQ * FILTER_HIDDEN; float* h2 = isc ? p.fh2c() : p.fh2() + (long)l * SEQ * FILTER_HIDDEN;
    const float* w2 = p.hy_w2 + l * FILTER_HIDDEN * FILTER_HIDDEN + j8;
    const float4* hr = (const float4*)(h1 + (long)t * FILTER_HIDDEN);
    float acc[8];
#pragma unroll
    for (int jj = 0; jj < 8; ++jj) acc[jj] = p.hy_b2[l * FILTER_HIDDEN + j8 + jj];
#pragma unroll 4
    for (int k4 = 0; k4 < FILTER_HIDDEN / 4; ++k4) {
      const float4 h = hr[k4]; const float hv[4] = {h.x, h.y, h.z, h.w};
#pragma unroll
      for (int e = 0; e < 4; ++e) {
        const float4 wa = *(const float4*)(w2 + (4 * k4 + e) * FILTER_HIDDEN), wb = *(const float4*)(w2 + (4 * k4 + e) * FILTER_HIDDEN + 4);
        acc[0] += hv[e] * wa.x; acc[1] += hv[e] * wa.y; acc[2] += hv[e] * wa.z; acc[3] += hv[e] * wa.w; acc[4] += hv[e] * wb.x; acc[5] += hv[e] * wb.y; acc[6] += hv[e] * wb.z; acc[7] += hv[e] * wb.w;
      }
    }
#pragma unroll
    for (int jj = 0; jj < 8; ++jj) h2[(long)(j8 + jj) * Lf + t] = sinf(p.hy_freq[l * FILTER_HIDDEN + j8 + jj] * acc[jj]);
  }
}
DEV void hy_f3g(const P& p, int l, int Lf, const float* h2, float* kraw, float* psum, long gtid, long gsize) {
  const float* w3 = p.hy_w3 + l * FILTER_HIDDEN * 2 * HYENA_W;
  const int nblk = Lf >> 8; const int lane = (int)(gtid & 63);
  FOR_ITEMS(i, (long)(2 * HYENA_W / 8) * nblk * 64) {
    const int wi = __builtin_amdgcn_readfirstlane((int)(i >> 6));
    const int c8 = (wi / nblk) * 8, tb = wi % nblk, t0 = tb * 256 + lane;
    float acc[4][8];
#pragma unroll
    for (int q = 0; q < 4; ++q)
#pragma unroll
      for (int j = 0; j < 8; ++j) acc[q][j] = 0.f;
#pragma unroll 4
    for (int k = 0; k < FILTER_HIDDEN; ++k) {
      const float4 wa = *(const float4*)(w3 + k * 2 * HYENA_W + c8), wb = *(const float4*)(w3 + k * 2 * HYENA_W + c8 + 4);
#pragma unroll
      for (int q = 0; q < 4; ++q) {
        const float hv = h2[(long)k * Lf + t0 + 64 * q];
        acc[q][0] += hv * wa.x; acc[q][1] += hv * wa.y; acc[q][2] += hv * wa.z; acc[q][3] += hv * wa.w; acc[q][4] += hv * wb.x; acc[q][5] += hv * wb.y; acc[q][6] += hv * wb.z; acc[q][7] += hv * wb.w;
      }
    }
    const double d0 = log(1e-2) / 0.3, d1 = log(1e-2) / 1.5;
    float ps[8];
#pragma unroll
    for (int j = 0; j < 8; ++j) ps[j] = 0.f;
#pragma unroll
    for (int j = 0; j < 8; ++j) {
      const int ch = (c8 + j) % HYENA_W;
      const float delta = fabsf((float)(d0 + (d1 - d0) * (double)ch / (double)(HYENA_W - 1)));
#pragma unroll
      for (int q = 0; q < 4; ++q) {
        const int t = t0 + 64 * q; const float tt = (float)((double)t / (double)(Lf - 1));
        const float v = acc[q][j] * expf(-tt * delta);
        kraw[(long)(c8 + j) * Lf + t] = v;
        ps[j] += (c8 >= HYENA_W && t == 0) ? 0.f : fabsf(v);
      }
    }
#pragma unroll
    for (int j = 0; j < 8; ++j) {
      float v = ps[j];
#pragma unroll
      for (int o = 32; o > 0; o >>= 1) v += __shfl_xor(v, o);
      if (lane == 0) psum[(long)(c8 + j) * nblk + tb] = v;
    }
  }
}
DEV void hy_f4g(int Lf, const float* psum, float* knorm, long gtid, long gsize) {
  const int lane = (int)(gtid & 63); const long gw = gtid >> 6, nw = gsize >> 6; const int nblk = Lf >> 8;
  for (long i = gw; i < HYENA_W; i += nw) {
    float s = 0.f;
    for (int q = lane; q < nblk; q += 64) s += psum[i * nblk + q] + psum[(HYENA_W + i) * nblk + q];
#pragma unroll
    for (int o = 32; o > 0; o >>= 1) s += __shfl_xor(s, o);
    if (lane == 0) knorm[i] = 1.0f / s;
  }
}
#define HY_PSUM(f) (p.tmp() + (long)(f) * 2 * HYENA_W * (SEQ >> 8))
#endif
DEV void ph_g1(const P& p, long gtid, long gsize) {
#ifndef CPU_TEST
  for (int l = 0; l < DEPTH; ++l) hy_f1g(p, l, SEQ, p.fh1() + (long)l * SEQ * FILTER_HIDDEN, gtid, gsize);
  hy_f1g(p, 0, CTX_LEN, p.fh1c(), gtid, gsize);
#else
  for (int l = 0; l < DEPTH; ++l) hy_f1(p, l, SEQ, p.fh1() + (long)l * SEQ * FILTER_HIDDEN, gtid, gsize);
  hy_f1(p, 0, CTX_LEN, p.fh1c(), gtid, gsize);
#endif
  FOR_ITEMS(i, (long)DEPTH * 2 * S5_GROUPS * S5_T * S5_GROUP * S5_GROUP) {
    int j = (int)(i % S5_GROUP); int ii = (int)((i / S5_GROUP) % S5_GROUP); int d = (int)((i / (S5_GROUP * S5_GROUP)) % S5_T);
    long ldg = i / (S5_GROUP * S5_GROUP * S5_T);
    float acc = 0.f;
    for (int pp = 0; pp < S5_STATE; ++pp) {
      float cr = p.s5_c_re[(ldg * S5_GROUP + ii) * S5_STATE + pp], ci = p.s5_c_im[(ldg * S5_GROUP + ii) * S5_STATE + pp];
      float2 lp = p.lampow()[(ldg * (S5_T + 1) + d) * S5_STATE + pp];
      float2 bb = p.bbar()[(ldg * S5_STATE + pp) * S5_GROUP + j];
      float tr = lp.x * bb.x - lp.y * bb.y, ti = lp.x * bb.y + lp.y * bb.x;
      acc += cr * tr - ci * ti;
    }
    p.kc()[i] = acc;
  }
}
#ifndef CPU_TEST
DEV void ph_g2(const P& p, long gtid, long gsize) {
  hy_f2g(p, gtid, gsize);
}
DEV void ph_g3(const P& p, long gtid, long gsize) {
  for (int l = 0; l < DEPTH; ++l) hy_f3g(p, l, SEQ, p.fh2() + (long)l * SEQ * FILTER_HIDDEN, p.kraw() + (long)l * SEQ * 2 * HYENA_W, HY_PSUM(l), gtid, gsize);
  hy_f3g(p, 0, CTX_LEN, p.fh2c(), p.krawc(), HY_PSUM(DEPTH), gtid, gsize);
}
DEV void ph_g4(const P& p, long gtid, long gsize) {
  for (int l = 0; l < DEPTH; ++l) hy_f4g(SEQ, HY_PSUM(l), p.knorm() + l * HYENA_W, gtid, gsize);
  hy_f4g(CTX_LEN, HY_PSUM(DEPTH), p.knormc(), gtid, gsize);
}
#else
DEV void ph_g2(const P& p, long gtid, long gsize) {
  for (int l = 0; l < DEPTH; ++l) hy_f2(p, l, SEQ, p.fh1() + (long)l * SEQ * FILTER_HIDDEN, p.fh2() + (long)l * SEQ * FILTER_HIDDEN, gtid, gsize);
  hy_f2(p, 0, CTX_LEN, p.fh1c(), p.fh2c(), gtid, gsize);
}
DEV void ph_g3(const P& p, long gtid, long gsize) {
  for (int l = 0; l < DEPTH; ++l) hy_f3(p, l, SEQ, p.fh2() + (long)l * SEQ * FILTER_HIDDEN, p.kraw() + (long)l * SEQ * 2 * HYENA_W, gtid, gsize);
  hy_f3(p, 0, CTX_LEN, p.fh2c(), p.krawc(), gtid, gsize);
}
DEV void ph_g4(const P& p, long gtid, long gsize) {
  for (int l = 0; l < DEPTH; ++l) hy_f4(SEQ, p.kraw() + (long)l * SEQ * 2 * HYENA_W, p.knorm() + l * HYENA_W, gtid, gsize);
  hy_f4(CTX_LEN, p.krawc(), p.knormc(), gtid, gsize);
}
#endif
#define NG 5

DEV void ph_modu(const P& p, int l, int which, long gtid, long gsize) {
  FOR_ITEMS(i, (long)NR * D_MODEL) {
    int k = (int)(i % D_MODEL); long r = i / D_MODEL;
    const float* m = p.mod() + ((long)l * (BATCH + 1) + modrow(r)) * 6 * D_MODEL + which * 3 * D_MODEL;
    float uv = p.xcur()[i] * (1.0f + m[D_MODEL + k]) + m[k];
    p.ubuf()[i] = uv; p.ubf()[i] = f2bf16(uv);
  }
}
template <class Epi>
DEV void gemm_naive(const float* A, int lda, const float* B, int ldb, int M, int N, int K, Epi epi, long gtid, long gsize) {
  FOR_ITEMS(i, (long)(M / 4) * N) {
    int n = (int)(i % N); long r0 = (i / N) * 4;
    const float* a0 = A + r0 * lda;
    float c0 = 0.f, c1 = 0.f, c2 = 0.f, c3 = 0.f;
    for (int k = 0; k < K; ++k) {
      float b = B[(long)k * ldb + n];
      c0 += a0[k] * b; c1 += a0[lda + k] * b; c2 += a0[2 * lda + k] * b; c3 += a0[3 * lda + k] * b;
    }
    epi(r0, n, c0); epi(r0 + 1, n, c1); epi(r0 + 2, n, c2); epi(r0 + 3, n, c3);
  }
}
struct EpiStore { float* C; int ldc; DEVM void operator()(long r, int n, float v) const { C[r * ldc + n] = v; } };
DEV void ph_proj(const P& p, int l, long gtid, long gsize) {
  EpiStore e{p.proj(), IN_W};
  gemm_naive(p.ubuf(), D_MODEL, p.w_in + (long)l * D_MODEL * IN_W, IN_W, NR, IN_W, D_MODEL, e, gtid, gsize);
}
DEV long s5_row(int b, int dir, int n) {
  if (n < CTX_LEN) return (long)NL + b * CTX_LEN + (dir ? CTX_LEN - 1 - n : n);
  int t = n - CTX_LEN; return (long)b * SEQ + (dir ? SEQ - 1 - t : t);
}
DEV void ph_post_proj(const P& p, int l, long gtid, long gsize) {
  FOR_ITEMS(i, (long)NL * (N_Q_HEADS + N_KV_HEADS) * 2 * ROPE_HALF) {
    int ii = (int)(i % ROPE_HALF); int a = (int)((i / ROPE_HALF) % 2); int hs = (int)((i / (2 * ROPE_HALF)) % (N_Q_HEADS + N_KV_HEADS));
    long r = i / (2 * ROPE_HALF * (N_Q_HEADS + N_KV_HEADS));
    int t = (int)(r % SEQ); int pos = a == 0 ? t / GRID_W : t % GRID_W;
    float inv = powf(10000.0f, -(float)(2 * ii) / (float)AXIS_DIM);
    float ang = (float)pos * inv; float cs = cosf(ang), sn = sinf(ang);
    float* q = p.proj() + r * IN_W + hs * HEAD_DIM + a * AXIS_DIM + ii;
    float x1 = q[0], x2 = q[ROPE_HALF];
    q[0] = x1 * cs - x2 * sn; q[ROPE_HALF] = x1 * sn + x2 * cs;
  }
#ifdef CPU_TEST
  FOR_ITEMS(i, (long)NR * HYENA_W) {
    int ch = (int)(i % HYENA_W); long r = i / HYENA_W;
    int Ls = r < NL ? SEQ : CTX_LEN; long base = r < NL ? (r / SEQ) * SEQ : NL + ((r - NL) / CTX_LEN) * CTX_LEN; int t = (int)(r - base);
    const float* sw = p.hy_short_w + l * 3 * 3 * HYENA_W; const float* sb = p.hy_short_b + l * 3 * HYENA_W;
    float z[3];
#pragma unroll
    for (int part = 0; part < 3; ++part) {
      int cc = part * HYENA_W + ch; float acc = sb[cc];
#pragma unroll
      for (int j = 0; j < 3; ++j) { int tt = t + j - 1; if (tt >= 0 && tt < Ls) acc += p.proj()[(base + tt) * IN_W + HY_OFF + cc] * sw[j * 3 * HYENA_W + cc]; }
      z[part] = acc;
    }
    long o = r < NL ? ((r / SEQ) * HYENA_W + ch) * SEQ + t : i;
    p.hu()[o] = z[0] * z[1]; p.hx0()[o] = z[2];
  }
#endif
#ifndef CPU_TEST
  FOR_ITEMS(i, (long)NR * S5_W) { long r = i / S5_W; int cc = (int)(i % S5_W); p.s5u()[i] = f2bf16(p.proj()[r * IN_W + S5_OFF + cc]); }
#endif
#ifdef CPU_TEST
  FOR_ITEMS(i, (long)BATCH * 2 * S5_GROUPS * NCH * S5_STATE) {
    int pp = (int)(i % S5_STATE); int c = (int)((i / S5_STATE) % NCH); int g = (int)((i / (S5_STATE * NCH)) % S5_GROUPS);
    int dir = (int)((i / (S5_STATE * NCH * S5_GROUPS)) % 2); int b = (int)(i / (S5_STATE * NCH * S5_GROUPS * 2));
    long ldg = ((long)l * 2 + dir) * S5_GROUPS + g;
    float sr = 0.f, si = 0.f;
    for (int s = 0; s < S5_T; ++s) {
      const float* u = p.proj() + s5_row(b, dir, c * S5_T + s) * IN_W + S5_OFF + g * S5_GROUP;
      float br = 0.f, bi = 0.f;
#pragma unroll
      for (int j = 0; j < S5_GROUP; ++j) { float2 bb = p.bbar()[(ldg * S5_STATE + pp) * S5_GROUP + j]; br += bb.x * u[j]; bi += bb.y * u[j]; }
      float2 lp = p.lampow()[(ldg * (S5_T + 1) + (S5_T - 1 - s)) * S5_STATE + pp];
      sr += lp.x * br - lp.y * bi; si += lp.x * bi + lp.y * br;
    }
    p.sc()[i] = make_float2(sr, si);
  }
#endif
}
DEV void attn_item(const P& p, int l, long r, int h, float* outp) {
  const float scale = 1.0f / sqrtf((float)HEAD_DIM);
  float q[HEAD_DIM], acc[HEAD_DIM];
  const float* qp = p.proj() + r * IN_W + Q_OFF + h * HEAD_DIM;
#pragma unroll
  for (int d = 0; d < HEAD_DIM; ++d) { q[d] = qp[d] * scale; acc[d] = 0.f; }
  int kvh = h / Q_GROUP; int b = r < NL ? (int)(r / SEQ) : (int)((r - NL) / CTX_LEN);
  float m = -1e30f, lsum = 0.f;
  int nwin = 0, t = 0;
  if (r < NL) { t = (int)(r % SEQ); nwin = 2 * WINDOW + 1; }
  for (int j = 0; j < nwin + CTX_LEN; ++j) {
    long kr;
    if (j < nwin) { int tk = t - WINDOW + j; if (tk < 0 || tk >= SEQ) continue; kr = (long)b * SEQ + tk; }
    else kr = (long)NL + b * CTX_LEN + (j - nwin);
    const float* kp = p.proj() + kr * IN_W + K_OFF + kvh * HEAD_DIM; const float* vp = p.proj() + kr * IN_W + V_OFF + kvh * HEAD_DIM;
    float s = 0.f;
#pragma unroll
    for (int d = 0; d < HEAD_DIM; ++d) s += q[d] * kp[d];
    float mn = fmaxf(m, s); float corr = expf(m - mn); float pe = expf(s - mn);
    lsum = lsum * corr + pe;
#pragma unroll
    for (int d = 0; d < HEAD_DIM; ++d) acc[d] = acc[d] * corr + pe * vp[d];
    m = mn;
  }
  float sk = p.sink[l * N_Q_HEADS + h]; float mf = fmaxf(m, sk); float corr = expf(m - mf);
  float den = lsum * corr + expf(sk - mf); float sc2 = corr / den;
#pragma unroll
  for (int d = 0; d < HEAD_DIM; ++d) outp[d] = acc[d] * sc2;
}
DEV void ph_mix(const P& p, int l, long gtid, long gsize) {
#ifdef CPU_TEST
  long nrows_att = l == 0 ? NR : NL;
  FOR_ITEMS(i, nrows_att * N_Q_HEADS) { int h = (int)(i % N_Q_HEADS); long r = i / N_Q_HEADS; attn_item(p, l, r, h, p.mixb() + r * MIX_W + h * HEAD_DIM); }
#endif
#ifdef CPU_TEST
  FOR_ITEMS(i, (long)NL * HYENA_W) {
    int ch = (int)(i % HYENA_W); long r = i / HYENA_W; int t = (int)(r % SEQ); int b = (int)(r / SEQ);
    const float* kf = p.kraw() + ((long)l * 2 * HYENA_W + ch) * SEQ; const float* kb = p.kraw() + ((long)l * 2 * HYENA_W + HYENA_W + ch) * SEQ;
    const float* uu = p.hu() + ((long)b * HYENA_W + ch) * SEQ;
    float acc = 0.f;
    for (int s = 0; s <= t; ++s) acc += kf[t - s] * uu[s];
    for (int s = t + 1; s < SEQ; ++s) acc += kb[s - t] * uu[s];
    p.mixb()[r * MIX_W + ATTN_W + ch] = (acc * p.knorm()[l * HYENA_W + ch] + uu[t] * p.hy_d[l * HYENA_W + ch]) * p.hx0()[((long)b * HYENA_W + ch) * SEQ + t];
  }
#endif
  if (l == 0) {
#ifndef CPU_TEST
    FOR_ITEMS(i, (long)NC * HYENA_W) {
      const int t = (int)(i % CTX_LEN); const int ch = (int)((i / CTX_LEN) % HYENA_W); const int b = (int)(i / ((long)CTX_LEN * HYENA_W));
      const long base = (long)NL + (long)b * CTX_LEN; const long r = base + t;
      const float* kf = p.krawc() + (long)ch * CTX_LEN; const float* kb = p.krawc() + (long)(HYENA_W + ch) * CTX_LEN;
      float acc = 0.f;
#pragma unroll 8
      for (int sidx = 0; sidx < CTX_LEN; ++sidx) {
        const int d = t - sidx; const float kv = d >= 0 ? kf[d] : kb[-d];
        acc += kv * p.hu()[(base + sidx) * HYENA_W + ch];
      }
      const float u = p.hu()[r * HYENA_W + ch];
      p.mixb()[r * MIX_W + ATTN_W + ch] = (acc * p.knormc()[ch] + u * p.hy_d[l * HYENA_W + ch]) * p.hx0()[r * HYENA_W + ch];
    }
#else
    FOR_ITEMS(i, (long)NC * HYENA_W) {
      int ch = (int)(i % HYENA_W); long r = NL + i / HYENA_W; int t = (int)((r - NL) % CTX_LEN); long base = r - t;
      float acc = 0.f;
      for (int s = 0; s <= t; ++s) acc += p.krawc()[(long)ch * CTX_LEN + (t - s)] * p.hu()[(base + s) * HYENA_W + ch];
      for (int s = t + 1; s < CTX_LEN; ++s) acc += p.krawc()[(long)(HYENA_W + ch) * CTX_LEN + (s - t)] * p.hu()[(base + s) * HYENA_W + ch];
      float u = p.hu()[r * HYENA_W + ch];
      p.mixb()[r * MIX_W + ATTN_W + ch] = (acc * p.knormc()[ch] + u * p.hy_d[l * HYENA_W + ch]) * p.hx0()[r * HYENA_W + ch];
    }
#endif
  }
#ifdef CPU_TEST
  FOR_ITEMS(i, (long)BATCH * 2 * S5_GROUPS * S5_STATE) {
    int pp = (int)(i % S5_STATE); int g = (int)((i / S5_STATE) % S5_GROUPS); int dir = (int)((i / (S5_STATE * S5_GROUPS)) % 2); int b = (int)(i / (S5_STATE * S5_GROUPS * 2));
    long ldg = ((long)l * 2 + dir) * S5_GROUPS + g;
    float2 lt = p.lampow()[(ldg * (S5_T + 1) + S5_T) * S5_STATE + pp];
    float hr = 0.f, hi = 0.f;
    long base = (((long)b * 2 + dir) * S5_GROUPS + g) * NCH;
#ifndef CPU_TEST
    static_assert(NCH % 12 == 0, "carry batching");
    for (int c0 = 0; c0 < NCH; c0 += 12) {
      float2 sv[12];
#pragma unroll
      for (int k = 0; k < 12; ++k) sv[k] = p.sc()[(base + c0 + k) * S5_STATE + pp];
#pragma unroll
      for (int k = 0; k < 12; ++k) {
        p.hcbf()[(base + c0 + k) * 2 * S5_STATE + pp] = f2bf16(hr); p.hcbf()[(base + c0 + k) * 2 * S5_STATE + S5_STATE + pp] = f2bf16(hi);
        const float nr = lt.x * hr - lt.y * hi + sv[k].x, ni = lt.x * hi + lt.y * hr + sv[k].y;
        hr = nr; hi = ni;
      }
    }
#else
    for (int c = 0; c < NCH; ++c) {
      p.hc()[(base + c) * S5_STATE + pp] = make_float2(hr, hi);
      float2 s = p.sc()[(base + c) * S5_STATE + pp];
      float nr = lt.x * hr - lt.y * hi + s.x, ni = lt.x * hi + lt.y * hr + s.y;
      hr = nr; hi = ni;
    }
#endif
  }
#endif
}
DEV void ph_s5out(const P& p, int l, long gtid, long gsize) {
  FOR_ITEMS(i, (long)NR * S5_W) {
    int chn = (int)(i % S5_W); long r = i / S5_W; int g = chn / S5_GROUP, ii = chn % S5_GROUP;
    int b, tl; bool isctx = r >= NL;
    if (isctx) { b = (int)((r - NL) / CTX_LEN); tl = (int)((r - NL) % CTX_LEN); } else { b = (int)(r / SEQ); tl = (int)(r % SEQ); }
    float y = p.s5_d[l * S5_W + chn] * p.proj()[r * IN_W + S5_OFF + chn];
    for (int dir = 0; dir < 2; ++dir) {
      int n = isctx ? (dir ? CTX_LEN - 1 - tl : tl) : CTX_LEN + (dir ? SEQ - 1 - tl : tl);
      int c = n / S5_T, tau = n % S5_T;
      long ldg = ((long)l * 2 + dir) * S5_GROUPS + g;
      long hb = ((((long)b * 2 + dir) * S5_GROUPS + g) * NCH + c) * S5_STATE;
      for (int pp = 0; pp < S5_STATE; ++pp) {
        float cr = p.s5_c_re[(ldg * S5_GROUP + ii) * S5_STATE + pp], ci = p.s5_c_im[(ldg * S5_GROUP + ii) * S5_STATE + pp];
        float2 lp = p.lampow()[(ldg * (S5_T + 1) + tau + 1) * S5_STATE + pp]; float2 h = p.hc()[hb + pp];
        float tr = lp.x * h.x - lp.y * h.y, ti = lp.x * h.y + lp.y * h.x;
        y += cr * tr - ci * ti;
      }
      for (int s = 0; s <= tau; ++s) {
        const float* u = p.proj() + s5_row(b, dir, c * S5_T + s) * IN_W + S5_OFF + g * S5_GROUP;
        const float* kk = p.kc() + ((ldg * S5_T + (tau - s)) * S5_GROUP + ii) * S5_GROUP;
#pragma unroll
        for (int j = 0; j < S5_GROUP; ++j) y += kk[j] * u[j];
      }
    }
    float gy = gelu_tanhf(y); p.ybuf()[i] = gy; p.ybf()[i] = f2bf16(gy);
  }
}
struct EpiGlu { const float* g; float* mixb; DEVM void operator()(long r, int n, float v) const { mixb[r * MIX_W + ATTN_W + HYENA_W + n] = g[r * S5_W + n] * sigmoidf_(v); } };
DEV void ph_glu(const P& p, int l, long gtid, long gsize) {
  EpiGlu e{p.ybuf(), p.mixb()};
  gemm_naive(p.ybuf(), S5_W, p.s5_w_glu + (long)l * S5_W * S5_W, S5_W, NR, S5_W, S5_W, e, gtid, gsize);
}
DEV void ph_rms(const P& p, int l, long gtid, long gsize) {
  FOR_ITEMS(i, (long)NR * 3) {
    int grp = (int)(i % 3); long r = i / 3;
    int off = grp == 0 ? 0 : (grp == 1 ? ATTN_W : ATTN_W + HYENA_W); int w = grp == 0 ? ATTN_W : (grp == 1 ? HYENA_W : S5_W);
    float* v = p.mixb() + r * MIX_W + off; float ss = 0.f;
    for (int k = 0; k < w; ++k) ss += v[k] * v[k];
    float rs = 1.0f / sqrtf(ss / (float)w + LN_EPS);
    for (int k = 0; k < w; ++k) { float nv = v[k] * rs * p.mix_g[l * MIX_W + off + k]; v[k] = nv; p.mixbf()[r * MIX_W + off + k] = f2bf16(nv); }
  }
}
struct EpiRes { const float* xcur; const float* mod; int l; int goff; float* tmp;
  DEVM void operator()(long r, int n, float v) const { const float* m = mod + ((long)l * (BATCH + 1) + modrow(r)) * 6 * D_MODEL + goff; tmp[r * D_MODEL + n] = DN_ALPHA * xcur[r * D_MODEL + n] + m[n] * v; } };
DEV void ph_outproj(const P& p, int l, long gtid, long gsize) {
  EpiRes e{p.xcur(), p.mod(), l, 2 * D_MODEL, p.tmp()};
  gemm_naive(p.mixb(), MIX_W, p.w_out + (long)l * MIX_W * D_MODEL, D_MODEL, NR, D_MODEL, MIX_W, e, gtid, gsize);
}
DEV void ph_ln(const P& p, int l, int which, long gtid, long gsize) {
  const float* gw = (which == 0 ? p.ln1_g : p.ln2_g) + l * D_MODEL; const float* bw = (which == 0 ? p.ln1_b : p.ln2_b) + l * D_MODEL;
  FOR_ITEMS(r, (long)NR) {
    const float* v = p.tmp() + r * D_MODEL; float mu = 0.f;
#pragma unroll 4
    for (int k = 0; k < D_MODEL; ++k) mu += v[k];
    mu /= (float)D_MODEL; float var = 0.f;
#pragma unroll 4
    for (int k = 0; k < D_MODEL; ++k) { float d = v[k] - mu; var += d * d; }
    float rs = 1.0f / sqrtf(var / (float)D_MODEL + LN_EPS);
    const float* m = p.mod() + ((long)l * (BATCH + 1) + modrow(r)) * 6 * D_MODEL + 3 * D_MODEL;
#pragma unroll 2
    for (int k = 0; k < D_MODEL; ++k) {
      float y = (v[k] - mu) * rs * gw[k] + bw[k];
      p.xcur()[r * D_MODEL + k] = y;
      if (which == 0) { float uv = y * (1.0f + m[D_MODEL + k]) + m[k]; p.ubuf()[r * D_MODEL + k] = uv; p.ubf()[r * D_MODEL + k] = f2bf16(uv); }
      if (which == 1 && l == DEPTH - 1 && r < NL) p.out[r * D_MODEL + k] = y;
    }
  }
}
DEV void ph_router(const P& p, int l, long gtid, long gsize) {
  EpiStore e{p.rl(), N_EXPERTS};
  gemm_naive(p.ubuf(), D_MODEL, p.w_router + (long)l * D_MODEL * N_EXPERTS, N_EXPERTS, NR, N_EXPERTS, D_MODEL, e, gtid, gsize);
}
DEV bool better(float v, int i, float bv, int bi) { return v > bv || (v == bv && i < bi); }
DEV void ph_select(const P& p, int l, long gtid, long gsize) {
  FOR_ITEMS(r, (long)NR) {
    const float* lg = p.rl() + r * N_EXPERTS; const float* rb = p.router_bias + l * N_EXPERTS;
    float gs[N_EXPERT_GROUPS];
#pragma unroll
    for (int g = 0; g < N_EXPERT_GROUPS; ++g) {
      float m1 = -1e30f, m2 = -1e30f;
      for (int e = 0; e < EPG; ++e) { float v = sigmoidf_(lg[g * EPG + e]) + rb[g * EPG + e]; if (v > m1) { m2 = m1; m1 = v; } else if (v > m2) m2 = v; }
      gs[g] = m1 + m2;
    }
    unsigned keep = 0;
#pragma unroll
    for (int it = 0; it < TOPK_GROUPS; ++it) {
      float bv = -1e30f; int bi = -1;
#pragma unroll
      for (int g = 0; g < N_EXPERT_GROUPS; ++g) if (!((keep >> g) & 1u) && (bi < 0 || gs[g] > bv)) { bv = gs[g]; bi = g; }
      keep |= 1u << bi;
    }
    float lastv = 1e30f; int lasti = -1; float gsum = 0.f;
    for (int it = 0; it < TOP_K; ++it) {
      float bv = -1e30f; int bi = -1;
      for (int e = 0; e < N_EXPERTS; ++e) {
        if (!((keep >> (e / EPG)) & 1u)) continue;
        float v = sigmoidf_(lg[e]) + rb[e];
        if (!better(lastv, lasti, v, e)) continue;
        if (bi < 0 || better(v, e, bv, bi)) { bv = v; bi = e; }
      }
      lastv = bv; lasti = bi;
      float sc = sigmoidf_(lg[bi]); gsum += sc;
      p.top_e()[r * TOP_K + it] = bi; p.gate()[r * TOP_K + it] = sc;
      p.posb()[r * TOP_K + it] = atomicAdd(&p.cnt()[l * N_EXPERTS + bi], 1);
    }
    float inv = ROUTED_SCALE / gsum;
    for (int it = 0; it < TOP_K; ++it) p.gate()[r * TOP_K + it] *= inv;
  }
}
DEV void ph_sortrows(const P& p, int l, long gtid, long gsize) {
  FOR_ITEMS(i, (long)NR * TOP_K) {
    int e = p.top_e()[i]; int off = 0;
    for (int j = 0; j < e; ++j) off += p.cnt()[l * N_EXPERTS + j];
    p.srow()[off + p.posb()[i]] = (int)i;
  }
}
DEV void ph_expert_up(const P& p, int l, long gtid, long gsize) {
  FOR_ITEMS(i, (long)NR * TOP_K * EXPERT_FF) {
    int cidx = (int)(i % EXPERT_FF); int a = p.srow()[i / EXPERT_FF]; int e = p.top_e()[a]; long r = a / TOP_K;
    const float* xg = p.ubuf() + r * D_MODEL;
    const float* wg = p.w_exp_gate + ((long)l * N_EXPERTS + e) * D_MODEL * EXPERT_FF; const float* wu = p.w_exp_up + ((long)l * N_EXPERTS + e) * D_MODEL * EXPERT_FF;
    float g = 0.f, u = 0.f;
    for (int k = 0; k < D_MODEL; ++k) { float xv = xg[k]; g += xv * wg[(long)k * EXPERT_FF + cidx]; u += xv * wu[(long)k * EXPERT_FF + cidx]; }
    p.hbuf()[(long)a * EXPERT_FF + cidx] = siluf(g) * u;
  }
  FOR_ITEMS(i, (long)NR * SHARED_FF) {
    int cidx = (int)(i % SHARED_FF); long r = i / SHARED_FF;
    const float* xg = p.ubuf() + r * D_MODEL;
    const float* wg = p.w_sh_gate + (long)l * D_MODEL * SHARED_FF; const float* wu = p.w_sh_up + (long)l * D_MODEL * SHARED_FF;
    float g = 0.f, u = 0.f;
    for (int k = 0; k < D_MODEL; ++k) { float xv = xg[k]; g += xv * wg[(long)k * SHARED_FF + cidx]; u += xv * wu[(long)k * SHARED_FF + cidx]; }
    p.hsb()[i] = siluf(g) * u;
  }
}
DEV void ph_expert_down(const P& p, int l, long gtid, long gsize) {
  FOR_ITEMS(i, (long)NR * TOP_K * D_MODEL) {
    int d = (int)(i % D_MODEL); long a = i / D_MODEL;
    int e = p.top_e()[a]; const float* wd = p.w_exp_down + ((long)l * N_EXPERTS + e) * EXPERT_FF * D_MODEL;
    const float* h = p.hbuf() + a * EXPERT_FF; float acc = 0.f;
    for (int cidx = 0; cidx < EXPERT_FF; ++cidx) acc += h[cidx] * wd[(long)cidx * D_MODEL + d];
    p.yk()[i] = acc * p.gate()[a];
  }
  FOR_ITEMS(i, (long)NR * D_MODEL) {
    int d = (int)(i % D_MODEL); long r = i / D_MODEL;
    const float* wsd = p.w_sh_down + (long)l * SHARED_FF * D_MODEL; const float* hs = p.hsb() + r * SHARED_FF;
    float acc = 0.f;
    for (int cidx = 0; cidx < SHARED_FF; ++cidx) acc += hs[cidx] * wsd[(long)cidx * D_MODEL + d];
    p.ysh()[i] = acc;
  }
}
DEV void ph_combine(const P& p, int l, long gtid, long gsize) {
#pragma unroll 1
  FOR_ITEMS(i, (long)NR * D_MODEL) {
    int d = (int)(i % D_MODEL); long r = i / D_MODEL;
    float f = p.ysh()[i];
#pragma unroll
    for (int k = 0; k < TOP_K; ++k) f += p.yk()[(r * TOP_K + k) * D_MODEL + d];
    const float* m = p.mod() + ((long)l * (BATCH + 1) + modrow(r)) * 6 * D_MODEL + 5 * D_MODEL;
    p.tmp()[i] = DN_ALPHA * p.xcur()[i] + m[d] * f;
  }
}
#define NLP 16


#ifndef CPU_TEST
typedef __attribute__((ext_vector_type(8))) short bf16x8;
typedef __attribute__((ext_vector_type(4))) float f32x4;
typedef __attribute__((ext_vector_type(4))) unsigned u32x4;
typedef __attribute__((ext_vector_type(2))) unsigned u32x2;
static_assert(N_EXPERTS == 256 && D_MODEL % 128 == 0 && NR % 128 == 0, "shape assumptions");
#define SM_XB 0
#define NT 512
#define SM_A 256
#define SM_B (256 + 16384)
#define SM_MISC (256 + 98304)
#define SMEM_BYTES (256 + 98304 + 4096)

DEV int otid() { int t = threadIdx.x; asm volatile("" : "+v"(t)); return t; }
typedef __bf16 bf16x2_t __attribute__((ext_vector_type(2)));
typedef float f32x2_t __attribute__((ext_vector_type(2)));
DEV unsigned pack2(float a, float b) { f32x2_t v = {a, b}; return __builtin_bit_cast(unsigned, __builtin_convertvector(v, bf16x2_t)); }
DEV unsigned f2bf(float f) { return pack2(f, 0.f) & 0xffffu; }
DEV int tile_off(int row, int chunk) { return row * 128 + ((chunk ^ ((row >> 1) & 7)) << 4); }

DEV float bflo(float x) { return x - __uint_as_float(f2bf(x) << 16); }
DEV void wt_convert(const float* W, unsigned short* WT, int K, int N, bool lo, long gtid, long gsize) {
  FOR_ITEMS4(i, (long)N * (K / 8)) {
    const int n = (int)(i % N); const int k8 = (int)(i / N) * 8;
    float v[8];
#pragma unroll
    for (int j = 0; j < 8; ++j) { const float x = W[(long)(k8 + j) * N + n]; v[j] = lo ? bflo(x) : x; }
    u32x4 o; o[0] = pack2(v[0], v[1]); o[1] = pack2(v[2], v[3]); o[2] = pack2(v[4], v[5]); o[3] = pack2(v[6], v[7]);
    *(u32x4*)(WT + (long)n * K + k8) = o;
  }
}
DEV void wt_convert_all(const P& p, long gtid, long gsize) {
  for (int l = 0; l < DEPTH; ++l) {
    wt_convert(p.w_in + (long)l * D_MODEL * IN_W, p.wt_in() + (long)l * IN_W * D_MODEL, D_MODEL, IN_W, false, gtid, gsize);
    wt_convert(p.w_out + (long)l * MIX_W * D_MODEL, p.wt_out() + (long)l * D_MODEL * MIX_W, MIX_W, D_MODEL, false, gtid, gsize);
    wt_convert(p.s5_w_glu + (long)l * S5_W * S5_W, p.wt_glu() + (long)l * S5_W * S5_W, S5_W, S5_W, false, gtid, gsize);
    wt_convert(p.w_sh_gate + (long)l * D_MODEL * SHARED_FF, p.wt_shg() + (long)l * SHARED_FF * D_MODEL, D_MODEL, SHARED_FF, false, gtid, gsize);
    wt_convert(p.w_sh_up + (long)l * D_MODEL * SHARED_FF, p.wt_shu() + (long)l * SHARED_FF * D_MODEL, D_MODEL, SHARED_FF, false, gtid, gsize);
    wt_convert(p.w_sh_down + (long)l * SHARED_FF * D_MODEL, p.wt_shd() + (long)l * D_MODEL * SHARED_FF, SHARED_FF, D_MODEL, false, gtid, gsize);
    wt_convert(p.w_router + (long)l * D_MODEL * N_EXPERTS, p.wt_rh() + (long)l * N_EXPERTS * D_MODEL, D_MODEL, N_EXPERTS, false, gtid, gsize);
    wt_convert(p.w_router + (long)l * D_MODEL * N_EXPERTS, p.wt_rl() + (long)l * N_EXPERTS * D_MODEL, D_MODEL, N_EXPERTS, true, gtid, gsize);
  }
}
struct ALRows { const char* base; unsigned off[2]; DEVM const unsigned short* a(int i, int kt) const { return (const unsigned short*)(base + (off[i] + (unsigned)kt * 128u)); } };
struct BLStd { static constexpr bool TR = false; const char* base; unsigned voff; int ldb4; bool valid;
  DEVM void load(float4 (&rb)[8], int kt) const {
#pragma unroll
    for (int i = 0; i < 8; ++i) rb[i] = valid ? *(const float4*)(base + (unsigned)((unsigned)(kt * 64 + i) * (unsigned)ldb4 + voff)) : make_float4(0.f, 0.f, 0.f, 0.f); } };
DEV unsigned bl_voff(int ldb4, int tid) { return (unsigned)((tid & 7) * 8) * (unsigned)ldb4 + (unsigned)((tid >> 3) * 16); }
DEV BLStd mk_bl(const float* B  , int ldb, int tid) {
  BLStd b; b.base = (const char*)B; b.ldb4 = ldb * 4; b.voff = bl_voff(ldb * 4, tid); b.valid = true; return b; }
#define SM_TILE 49152
template <int V = 0, class AL, class BL>
DEV void gemm_t(const AL& al, const BL& bl, int nk, f32x4 (&acc)[4][4], char* smem) {
  const int tid = otid(), lane = tid & 63, wid = tid >> 6, wr = wid >> 2, wc = wid & 3;
  const int l15 = lane & 15, q = lane >> 4, x = l15 >> 1;
  const char* ard0 = smem + SM_A + (wr * 64 + l15) * 128 + ((q ^ x) << 4);
  const char* ard1 = smem + SM_A + (wr * 64 + l15) * 128 + (((4 + q) ^ x) << 4);
  const char* brd0 = smem + SM_B + (wc * 64 + l15) * 128 + ((q ^ x) << 4);
  const char* brd1 = smem + SM_B + (wc * 64 + l15) * 128 + (((4 + q) ^ x) << 4);
  const int kq = tid & 7, nq = tid >> 3;
  char* awr = smem + SM_A + nq * 128 + ((kq ^ ((nq >> 1) & 7)) << 4);
  char* bwr0 = smem + SM_B + (nq * 4) * 128 + ((kq ^ ((2 * nq) & 7)) << 4);
  char* bwr1 = smem + SM_B + (nq * 4 + 2) * 128 + ((kq ^ ((2 * nq + 1) & 7)) << 4);
  if (nk <= 0) return;
  u32x4 ra[2]; float4 rb0[8];
#define GEMM_LOADA(KT) do { _Pragma("unroll") for (int i = 0; i < 2; ++i) ra[i] = *(const u32x4*)(al.a(i, (KT))); } while (0)
#define GEMM_WRITE(rb, PO) do { \
    *(u32x4*)(awr + (PO)) = ra[0]; *(u32x4*)(awr + (PO) + 8192) = ra[1]; \
    if (BL::TR) { u32x4 v; \
      v[0] = pack2(rb[0].x, rb[0].y); v[1] = pack2(rb[0].z, rb[0].w); v[2] = pack2(rb[1].x, rb[1].y); v[3] = pack2(rb[1].z, rb[1].w); *(u32x4*)(bwr0 + (PO)) = v; \
      v[0] = pack2(rb[2].x, rb[2].y); v[1] = pack2(rb[2].z, rb[2].w); v[2] = pack2(rb[3].x, rb[3].y); v[3] = pack2(rb[3].z, rb[3].w); *(u32x4*)(bwr0 + (PO) + 128) = v; \
      v[0] = pack2(rb[4].x, rb[4].y); v[1] = pack2(rb[4].z, rb[4].w); v[2] = pack2(rb[5].x, rb[5].y); v[3] = pack2(rb[5].z, rb[5].w); *(u32x4*)(bwr1 + (PO)) = v; \
      v[0] = pack2(rb[6].x, rb[6].y); v[1] = pack2(rb[6].z, rb[6].w); v[2] = pack2(rb[7].x, rb[7].y); v[3] = pack2(rb[7].z, rb[7].w); *(u32x4*)(bwr1 + (PO) + 128) = v; \
    } else { u32x4 v; \
      v[0] = pack2(rb[0].x, rb[1].x); v[1] = pack2(rb[2].x, rb[3].x); v[2] = pack2(rb[4].x, rb[5].x); v[3] = pack2(rb[6].x, rb[7].x); *(u32x4*)(bwr0 + (PO)) = v; \
      v[0] = pack2(rb[0].y, rb[1].y); v[1] = pack2(rb[2].y, rb[3].y); v[2] = pack2(rb[4].y, rb[5].y); v[3] = pack2(rb[6].y, rb[7].y); *(u32x4*)(bwr0 + (PO) + 128) = v; \
      v[0] = pack2(rb[0].z, rb[1].z); v[1] = pack2(rb[2].z, rb[3].z); v[2] = pack2(rb[4].z, rb[5].z); v[3] = pack2(rb[6].z, rb[7].z); *(u32x4*)(bwr1 + (PO)) = v; \
      v[0] = pack2(rb[0].w, rb[1].w); v[1] = pack2(rb[2].w, rb[3].w); v[2] = pack2(rb[4].w, rb[5].w); v[3] = pack2(rb[6].w, rb[7].w); *(u32x4*)(bwr1 + (PO) + 128) = v; \
    } } while (0)
  GEMM_LOADA(0);
  bl.load(rb0, 0);
  __syncthreads();
  GEMM_WRITE(rb0, 0);
  if (V != 3) { if (nk > 1) { GEMM_LOADA(1); bl.load(rb0, 1); } }
  __syncthreads();
#define GEMM_STEP(rbn, KT) do { \
    const int po = ((KT) & 1) * SM_TILE; \
    bf16x8 fa0[4], fb0[4], fa1[4], fb1[4]; \
    _Pragma("unroll") for (int n = 0; n < 4; ++n) fb0[n] = *(const bf16x8*)(brd0 + po + n * 2048); \
    _Pragma("unroll") for (int m = 0; m < 4; ++m) fa0[m] = *(const bf16x8*)(ard0 + po + m * 2048); \
    _Pragma("unroll") for (int n = 0; n < 4; ++n) fb1[n] = *(const bf16x8*)(brd1 + po + n * 2048); \
    _Pragma("unroll") for (int m = 0; m < 4; ++m) fa1[m] = *(const bf16x8*)(ard1 + po + m * 2048); \
    __builtin_amdgcn_sched_barrier(0);     \
    if ((KT) + 1 < nk) { \
      GEMM_WRITE(rbn, SM_TILE - po); \
      if (V != 3) { if ((KT) + 2 < nk) { GEMM_LOADA((KT) + 2); bl.load(rbn, (KT) + 2); } } \
    } \
    __builtin_amdgcn_sched_barrier(0); \
    if (V != 2) { \
      _Pragma("unroll") for (int m = 0; m < 4; ++m) _Pragma("unroll") for (int n = 0; n < 4; ++n) acc[m][n] = __builtin_amdgcn_mfma_f32_16x16x32_bf16(fa0[m], fb0[n], acc[m][n], 0, 0, 0); \
      _Pragma("unroll") for (int m = 0; m < 4; ++m) _Pragma("unroll") for (int n = 0; n < 4; ++n) acc[m][n] = __builtin_amdgcn_mfma_f32_16x16x32_bf16(fa1[m], fb1[n], acc[m][n], 0, 0, 0); \
    } else { _Pragma("unroll") for (int m = 0; m < 4; ++m) asm volatile("" :: "v"(fa0[m]), "v"(fb0[m]), "v"(fa1[m]), "v"(fb1[m])); } \
    __syncthreads(); \
  } while (0)
  int kt = 0;
#pragma unroll 1
  for (; kt < nk; ++kt) { GEMM_STEP(rb0, kt); }
#undef GEMM_STEP
#undef GEMM_WRITE
#undef GEMM_LOADA
}

struct BLT { const char* base; unsigned voff; unsigned rowb;
  DEVM void load(u32x4 (&rb)[4], int kt) const {
#pragma unroll
    for (int c = 0; c < 4; ++c) rb[c] = *(const u32x4*)(base + (voff + (unsigned)c * rowb + (unsigned)kt * 128u)); } };
DEV BLT mk_blt(const unsigned short* BT  , int K, int tid) {
  BLT b; b.base = (const char*)BT; b.rowb = (unsigned)K * 2u; b.voff = (unsigned)((tid >> 3) * 4) * b.rowb + (unsigned)((tid & 7) * 16); return b; }
template <class AL, class BL>
DEV void gemm_tb(const AL& al, const BL& bl, int nk, f32x4 (&acc)[4][4], char* smem) {
  const int tid = otid(), lane = tid & 63, wid = tid >> 6, wr = wid >> 2, wc = wid & 3;
  const int l15 = lane & 15, q = lane >> 4, x = l15 >> 1;
  const char* ard0 = smem + SM_A + (wr * 64 + l15) * 128 + ((q ^ x) << 4);
  const char* ard1 = smem + SM_A + (wr * 64 + l15) * 128 + (((4 + q) ^ x) << 4);
  const char* brd0 = smem + SM_B + (wc * 64 + l15) * 128 + ((q ^ x) << 4);
  const char* brd1 = smem + SM_B + (wc * 64 + l15) * 128 + (((4 + q) ^ x) << 4);
  const int kq = tid & 7, nq = tid >> 3;
  char* awr = smem + SM_A + nq * 128 + ((kq ^ ((nq >> 1) & 7)) << 4);
  char* bwr0 = smem + SM_B + (nq * 4) * 128 + ((kq ^ ((2 * nq) & 7)) << 4);
  char* bwr1 = smem + SM_B + (nq * 4 + 2) * 128 + ((kq ^ ((2 * nq + 1) & 7)) << 4);
  if (nk <= 0) return;
  u32x4 ra[2]; u32x4 rb0[4], rb1[4];
#define TB_LOADA(KT) do { _Pragma("unroll") for (int i = 0; i < 2; ++i) ra[i] = *(const u32x4*)(al.a(i, (KT))); } while (0)
#define TB_WRITE(rb, PO) do { \
    *(u32x4*)(awr + (PO)) = ra[0]; *(u32x4*)(awr + (PO) + 8192) = ra[1]; \
    *(u32x4*)(bwr0 + (PO)) = rb[0]; *(u32x4*)(bwr0 + (PO) + 128) = rb[1]; *(u32x4*)(bwr1 + (PO)) = rb[2]; *(u32x4*)(bwr1 + (PO) + 128) = rb[3]; } while (0)
  TB_LOADA(0);
  bl.load(rb0, 0);
  if (nk > 1) bl.load(rb1, 1);
  __syncthreads();
  TB_WRITE(rb0, 0);
  if (nk > 1) TB_LOADA(1);
  if (nk > 2) bl.load(rb0, 2);
  __syncthreads();
#define TB_STEP(rbn, KT) do { \
    const int po = ((KT) & 1) * SM_TILE; \
    bf16x8 fa0[4], fb0[4], fa1[4], fb1[4]; \
    _Pragma("unroll") for (int n = 0; n < 4; ++n) fb0[n] = *(const bf16x8*)(brd0 + po + n * 2048); \
    _Pragma("unroll") for (int m = 0; m < 4; ++m) fa0[m] = *(const bf16x8*)(ard0 + po + m * 2048); \
    _Pragma("unroll") for (int n = 0; n < 4; ++n) fb1[n] = *(const bf16x8*)(brd1 + po + n * 2048); \
    _Pragma("unroll") for (int m = 0; m < 4; ++m) fa1[m] = *(const bf16x8*)(ard1 + po + m * 2048); \
    __builtin_amdgcn_sched_barrier(0); \
    if ((KT) + 1 < nk) { \
      TB_WRITE(rbn, SM_TILE - po); \
      if ((KT) + 2 < nk) TB_LOADA((KT) + 2); \
      if ((KT) + 3 < nk) bl.load(rbn, (KT) + 3); \
    } \
    __builtin_amdgcn_sched_barrier(0); \
    _Pragma("unroll") for (int m = 0; m < 4; ++m) _Pragma("unroll") for (int n = 0; n < 4; ++n) acc[m][n] = __builtin_amdgcn_mfma_f32_16x16x32_bf16(fa0[m], fb0[n], acc[m][n], 0, 0, 0); \
    _Pragma("unroll") for (int m = 0; m < 4; ++m) _Pragma("unroll") for (int n = 0; n < 4; ++n) acc[m][n] = __builtin_amdgcn_mfma_f32_16x16x32_bf16(fa1[m], fb1[n], acc[m][n], 0, 0, 0); \
    __syncthreads(); \
  } while (0)
  int kt = 0;
#pragma unroll 1
  for (; kt + 1 < nk; kt += 2) { TB_STEP(rb1, kt); TB_STEP(rb0, kt + 1); }
  if (kt < nk) TB_STEP(rb1, kt);
#undef TB_STEP
#undef TB_WRITE
#undef TB_LOADA
}
DEV void acc_zero(f32x4 (&acc)[4][4]) {
#pragma unroll
  for (int m = 0; m < 4; ++m)
#pragma unroll
    for (int n = 0; n < 4; ++n) acc[m][n] = (f32x4){0.f, 0.f, 0.f, 0.f};
}
#define EPI_BEGIN const int etid = otid();
#define EPI_ROW(m, j) (((etid >> 8) & 1) * 64 + (m) * 16 + ((etid & 63) >> 4) * 4 + (j))
#define EPI_COL(n) (((etid >> 6) & 3) * 64 + (n) * 16 + (etid & 15))

template <class Epi>
DEV void gemm_phase_dense(const unsigned short* A, int lda, const unsigned short* BT, int N, int K, Epi epi, char* smem) {
  const int tid = otid(); const int nct = N >> 8; const int nitems = (NR >> 7) * nct;
  for (int it = blockIdx.x; it < nitems; it += gridDim.x) {
    const int rt = it / nct, ct = it - rt * nct;
    ALRows al; al.base = (const char*)(A + (long)rt * 128 * lda);
#pragma unroll
    for (int i = 0; i < 2; ++i) al.off[i] = (unsigned)(((tid >> 3) + 64 * i) * lda + (tid & 7) * 8) * 2u;
    const BLT bl = mk_blt(BT + (long)ct * 256 * K, K, tid);
    f32x4 acc[4][4]; acc_zero(acc);
    gemm_tb(al, bl, K >> 6, acc, smem);
    EPI_BEGIN
#pragma unroll
    for (int m = 0; m < 4; ++m)
#pragma unroll
      for (int n = 0; n < 4; ++n)
#pragma unroll
        for (int j = 0; j < 4; ++j) epi((long)rt * 128 + EPI_ROW(m, j), ct * 256 + EPI_COL(n), acc[m][n][j]);
  }
}
DEV void ph_proj_mfma(const P& p, int l, char* smem) {
  const int tid = otid(); const int nct = IN_W >> 8; const int nitems = (NR >> 7) * nct;
  const float* B = p.w_in + (long)l * D_MODEL * IN_W;
  for (int it = blockIdx.x; it < nitems; it += gridDim.x) {
    const int rt = it / nct, ct = it - rt * nct;
    ALRows al; al.base = (const char*)(p.ubf() + (long)rt * 128 * D_MODEL);
#pragma unroll
    for (int i = 0; i < 2; ++i) al.off[i] = (unsigned)(((tid >> 3) + 64 * i) * D_MODEL + (tid & 7) * 8) * 2u;
    const BLT bl = mk_blt(p.wt_in() + ((long)l * IN_W + ct * 256) * D_MODEL, D_MODEL, tid);
    f32x4 acc[4][4]; acc_zero(acc);
    gemm_tb(al, bl, D_MODEL >> 6, acc, smem);
    EPI_BEGIN
    if (ct >= HY_OFF / 256 && ct < S5_OFF / 256) {
      const bool isctx = rt >= NL / 128;
      const int rloc = (isctx ? (rt - NL / 128) : rt) * 128;
      const int Ls = isctx ? CTX_LEN : SEQ; const int b = rloc / Ls; const int t0 = rloc - b * Ls;
      float* zb = p.zT() + (isctx ? (size_t)BATCH * 3 * HYENA_W * SEQ : (size_t)0) + (size_t)b * 3 * HYENA_W * Ls;
#pragma unroll
      for (int m = 0; m < 4; ++m)
#pragma unroll
        for (int n = 0; n < 4; ++n) {
          const int c = ct * 256 + EPI_COL(n) - HY_OFF; const int t = t0 + EPI_ROW(m, 0);
          *(float4*)(zb + (size_t)c * Ls + t) = make_float4(acc[m][n][0], acc[m][n][1], acc[m][n][2], acc[m][n][3]);
        }
    } else if (ct == S5_OFF / 256) {
#pragma unroll
      for (int m = 0; m < 4; ++m)
#pragma unroll
        for (int n = 0; n < 4; ++n)
#pragma unroll
          for (int j = 0; j < 4; ++j) p.s5u()[((long)rt * 128 + EPI_ROW(m, j)) * S5_W + EPI_COL(n)] = (unsigned short)f2bf(acc[m][n][j]);
    } else {
      const int head = ct * 4 + ((etid >> 6) & 3);
      const bool isq = head < N_Q_HEADS, dorope = head < N_Q_HEADS + N_KV_HEADS && rt < NL / 128;
      const float qs = isq ? 0.125f * 1.4426950408889634f : 1.0f;
      const int c16 = etid & 15;
#pragma unroll
      for (int m = 0; m < 4; ++m)
#pragma unroll
        for (int j = 0; j < 4; ++j) {
          const long row = (long)rt * 128 + EPI_ROW(m, j);
          float v0 = acc[m][0][j], v1 = acc[m][1][j], v2 = acc[m][2][j], v3 = acc[m][3][j];
          if (dorope) {
            const int t = (int)(row % SEQ);
            const float2 cr = p.ropet()[(t / GRID_W) * ROPE_HALF + c16], cc = p.ropet()[(t % GRID_W) * ROPE_HALF + c16];
            const float a0 = v0 * cr.x - v1 * cr.y, a1 = v0 * cr.y + v1 * cr.x, a2 = v2 * cc.x - v3 * cc.y, a3 = v2 * cc.y + v3 * cc.x;
            v0 = a0; v1 = a1; v2 = a2; v3 = a3;
          }
          unsigned short* dst = p.qkvb() + row * HY_OFF + head * HEAD_DIM + c16;
          dst[0] = (unsigned short)f2bf(v0 * qs); dst[16] = (unsigned short)f2bf(v1 * qs); dst[32] = (unsigned short)f2bf(v2 * qs); dst[48] = (unsigned short)f2bf(v3 * qs);
        }
    }
  }
}
DEV void ph_hyena_pre_gpu(const P& p, int l, long gtid, long gsize) {
  const float* sw = p.hy_short_w + l * 3 * 3 * HYENA_W; const float* sb = p.hy_short_b + l * 3 * HYENA_W;
  FOR_ITEMS4(i, (long)BATCH * HYENA_W * (SEQ + CTX_LEN)) {
    const bool isctx = i >= (long)BATCH * HYENA_W * SEQ; const long ii = isctx ? i - (long)BATCH * HYENA_W * SEQ : i;
    const int Ls = isctx ? CTX_LEN : SEQ; const int t = (int)(ii % Ls); const int ch = (int)((ii / Ls) % HYENA_W); const int b = (int)(ii / ((long)Ls * HYENA_W));
    const float* zb = p.zT() + (isctx ? (size_t)BATCH * 3 * HYENA_W * SEQ : (size_t)0) + (size_t)b * 3 * HYENA_W * Ls;
    float z[3];
#pragma unroll
    for (int part = 0; part < 3; ++part) {
      const int cc = part * HYENA_W + ch; const float* zr = zb + (size_t)cc * Ls; float acc = sb[cc];
      if (t > 0) acc += zr[t - 1] * sw[cc];
      acc += zr[t] * sw[3 * HYENA_W + cc];
      if (t + 1 < Ls) acc += zr[t + 1] * sw[2 * 3 * HYENA_W + cc];
      z[part] = acc;
    }
    const long o = isctx ? ((long)NL + b * CTX_LEN + t) * HYENA_W + ch : ((long)b * HYENA_W + ch) * SEQ + t;
    p.hu()[o] = z[0] * z[1]; p.hx0()[o] = z[2];
  }
}
DEV void rms_rows(const P& p, int l, long r0, long r1, int w0, int nw);
DEV void ph_glu_mfma(const P& p, int l, char* smem) {
  const int tid = otid();
  for (int rt = blockIdx.x; rt < (NR >> 7); rt += gridDim.x) {
    ALRows al; al.base = (const char*)(p.ybf() + (long)rt * 128 * S5_W);
#pragma unroll
    for (int i = 0; i < 2; ++i) al.off[i] = (unsigned)(((tid >> 3) + 64 * i) * S5_W + (tid & 7) * 8) * 2u;
    const BLT bl = mk_blt(p.wt_glu() + (long)l * S5_W * S5_W, S5_W, tid);
    f32x4 acc[4][4]; acc_zero(acc);
    gemm_tb(al, bl, S5_W >> 6, acc, smem);
    EPI_BEGIN
#pragma unroll
    for (int m = 0; m < 4; ++m)
#pragma unroll
      for (int n = 0; n < 4; ++n)
#pragma unroll
        for (int j = 0; j < 4; ++j) {
          const long r = (long)rt * 128 + EPI_ROW(m, j); const int c = EPI_COL(n);
          p.mixb()[r * MIX_W + ATTN_W + HYENA_W + c] = __uint_as_float((unsigned)p.ybf()[r * S5_W + c] << 16) * sigmoidf_(acc[m][n][j]);
        }
    asm volatile("s_waitcnt vmcnt(0)" ::: "memory");
    __syncthreads();
    rms_rows(p, l, (long)rt * 128, (long)rt * 128 + 128, otid() >> 6, NT / 64);
  }
}
DEV void ph_outproj_mfma(const P& p, int l, char* smem) {
  EpiRes e{p.xcur(), p.mod(), l, 2 * D_MODEL, p.tmp()};
  gemm_phase_dense(p.mixbf(), MIX_W, p.wt_out() + (long)l * D_MODEL * MIX_W, D_MODEL, MIX_W, e, smem);
}

struct ALRows4 { const char* base; unsigned off[4]; DEVM const unsigned short* a(int i, int kt) const { return (const unsigned short*)(base + (off[i] + (unsigned)kt * 128u)); } };
struct BLStd4 { const char* base; unsigned voff; int ldb4;
  DEVM void load(float4 (&rb)[4], int kt) const {
    unsigned vo = voff; asm volatile("" : "+v"(vo));
#pragma unroll
    for (int i = 0; i < 4; ++i) rb[i] = *(const float4*)(base + (unsigned)((unsigned)(kt * 64 + i) * (unsigned)ldb4 + vo)); } };
#define SM_B2 (SM_A + 32768)
template <class AL, class BL>
DEV void gemm_m2(const AL& al, const BL& bl, int nk, f32x4 (&acc)[4][4], char* smem) {
  const int tid = otid(), lane = tid & 63, wid = tid >> 6, wr = wid >> 1, wc = wid & 1;
  const int l15 = lane & 15, q = lane >> 4, x = l15 >> 1;
  const char* ard0 = smem + SM_A + (wr * 64 + l15) * 128 + ((q ^ x) << 4);
  const char* ard1 = smem + SM_A + (wr * 64 + l15) * 128 + (((4 + q) ^ x) << 4);
  const char* brd0 = smem + SM_B2 + (wc * 64 + l15) * 128 + ((q ^ x) << 4);
  const char* brd1 = smem + SM_B2 + (wc * 64 + l15) * 128 + (((4 + q) ^ x) << 4);
  const int kq = tid & 7, ar = tid >> 3, nq = (tid >> 3) & 31, kh = tid >> 8;
  char* awr = smem + SM_A + ar * 128 + ((kq ^ ((ar >> 1) & 7)) << 4);
  char* bwr0 = smem + SM_B2 + (nq * 4) * 128 + ((kq ^ ((2 * nq) & 7)) << 4) + kh * 8;
  char* bwr1 = smem + SM_B2 + (nq * 4 + 2) * 128 + ((kq ^ ((2 * nq + 1) & 7)) << 4) + kh * 8;
  if (nk <= 0) return;
  u32x4 ra[4]; float4 rb0[4], rb1[4];
#define M2_LOADA(KT) do { _Pragma("unroll") for (int i = 0; i < 4; ++i) ra[i] = *(const u32x4*)(al.a(i, (KT))); } while (0)
#define M2_WRITE(rb, PO) do { \
    _Pragma("unroll") for (int i = 0; i < 4; ++i) *(u32x4*)(awr + (PO) + 8192 * i) = ra[i]; \
    { u32x2 v; \
      v[0] = pack2(rb[0].x, rb[1].x); v[1] = pack2(rb[2].x, rb[3].x); *(u32x2*)(bwr0 + (PO)) = v; \
      v[0] = pack2(rb[0].y, rb[1].y); v[1] = pack2(rb[2].y, rb[3].y); *(u32x2*)(bwr0 + (PO) + 128) = v; \
      v[0] = pack2(rb[0].z, rb[1].z); v[1] = pack2(rb[2].z, rb[3].z); *(u32x2*)(bwr1 + (PO)) = v; \
      v[0] = pack2(rb[0].w, rb[1].w); v[1] = pack2(rb[2].w, rb[3].w); *(u32x2*)(bwr1 + (PO) + 128) = v; } } while (0)
  M2_LOADA(0);
  bl.load(rb0, 0);
  if (nk > 1) bl.load(rb1, 1);
  __syncthreads();
  M2_WRITE(rb0, 0);
  if (nk > 1) M2_LOADA(1);
  if (nk > 2) bl.load(rb0, 2);
  __syncthreads();
#define M2_STEP(rbn, KT) do { \
    const int po = ((KT) & 1) * SM_TILE; \
    bf16x8 fa0[4], fb0[4], fa1[4], fb1[4]; \
    _Pragma("unroll") for (int n = 0; n < 4; ++n) fb0[n] = *(const bf16x8*)(brd0 + po + n * 2048); \
    _Pragma("unroll") for (int m = 0; m < 4; ++m) fa0[m] = *(const bf16x8*)(ard0 + po + m * 2048); \
    _Pragma("unroll") for (int n = 0; n < 4; ++n) fb1[n] = *(const bf16x8*)(brd1 + po + n * 2048); \
    _Pragma("unroll") for (int m = 0; m < 4; ++m) fa1[m] = *(const bf16x8*)(ard1 + po + m * 2048); \
    __builtin_amdgcn_sched_barrier(0); \
    if ((KT) + 1 < nk) { \
      M2_WRITE(rbn, SM_TILE - po); \
      if ((KT) + 2 < nk) M2_LOADA((KT) + 2); \
      if ((KT) + 3 < nk) bl.load(rbn, (KT) + 3); \
    } \
    __builtin_amdgcn_sched_barrier(0); \
    _Pragma("unroll") for (int m = 0; m < 4; ++m) _Pragma("unroll") for (int n = 0; n < 4; ++n) acc[m][n] = __builtin_amdgcn_mfma_f32_16x16x32_bf16(fa0[m], fb0[n], acc[m][n], 0, 0, 0); \
    _Pragma("unroll") for (int m = 0; m < 4; ++m) _Pragma("unroll") for (int n = 0; n < 4; ++n) acc[m][n] = __builtin_amdgcn_mfma_f32_16x16x32_bf16(fa1[m], fb1[n], acc[m][n], 0, 0, 0); \
    __syncthreads(); \
  } while (0)
  int kt = 0;
#pragma unroll 1
  for (; kt + 1 < nk; kt += 2) { M2_STEP(rb1, kt); M2_STEP(rb0, kt + 1); }
  if (kt < nk) M2_STEP(rb1, kt);
#undef M2_STEP
#undef M2_WRITE
#undef M2_LOADA
}
#define EPI2_ROW(m, j) (((etid >> 7) & 3) * 64 + (m) * 16 + ((etid & 63) >> 4) * 4 + (j))
#define EPI2_COL(n) (((etid >> 6) & 1) * 64 + (n) * 16 + (etid & 15))
DEV void exp_prefix(const P& p, int l, int* toff, int* roff, int* rowo) {
  const int tid = otid(), lane = tid & 63, w = tid >> 6;
  __syncthreads();
  int c = 0, tl = 0, incl = 0, rinc = 0;
  int* wsum = roff + N_EXPERTS + 8;
  if (tid < N_EXPERTS) {
    c = p.cnt()[l * N_EXPERTS + tid];
    tl = (c + 255) >> 8; incl = tl; rinc = c;
#pragma unroll
    for (int o = 1; o < 64; o <<= 1) { const int v = __shfl_up(incl, o), v2 = __shfl_up(rinc, o); if (lane >= o) { incl += v; rinc += v2; } }
    if (lane == 63) { wsum[w] = incl; wsum[4 + w] = rinc; }
    roff[tid] = c;
  }
  __syncthreads();
  if (tid < N_EXPERTS) {
    int base = 0, rb = 0;
#pragma unroll
    for (int k = 0; k < 4; ++k) if (k < w) { base += wsum[k]; rb += wsum[4 + k]; }
    toff[tid] = base + incl - tl;
    rowo[tid] = rb + rinc - c;
    if (tid == N_EXPERTS - 1) toff[N_EXPERTS] = base + incl;
  }
  __syncthreads();
}
#define EXP_TABLES int* toff = (int*)(smem + SM_MISC); int* roff = toff + N_EXPERTS + 1; int* rowo = roff + N_EXPERTS + 16;
DEV int exp_find(const int* toff, int tile) {
  int lo = 0, hi = N_EXPERTS - 1;
  while (lo < hi) { int mid = (lo + hi + 1) >> 1; if (toff[mid] <= tile) lo = mid; else hi = mid - 1; }
  return lo;
}
template <int V = 0>
DEV void upgate_tile(const ALRows& al, const float* wg, const float* wu, int cq, f32x4 (&acc)[4][4], char* smem, int tid) {
  const int nq = tid >> 3; const int wsel = __builtin_amdgcn_readfirstlane(tid >> 6) & 1;
  BLStd bl; bl.base = (const char*)((wsel ? wu : wg) + cq * 128); bl.ldb4 = EXPERT_FF * 4; bl.valid = true;
  bl.voff = (unsigned)((tid & 7) * 8) * (unsigned)(EXPERT_FF * 4) + (unsigned)(((nq >> 4) * 32 + (nq & 7) * 4) * 4);
  acc_zero(acc);
  gemm_t<V>(al, bl, D_MODEL >> 6, acc, smem);
}
static_assert(EXPERT_FF == 256 && SHARED_FF == 256, "ff tiling");
template <int V = 0>
DEV void ph_expert_up_mfma(const P& p, int l, char* smem) {
  const int tid = otid();
  EXP_TABLES
  exp_prefix(p, l, toff, roff, rowo);
  const int n_items = toff[N_EXPERTS] * 4;
  for (int it = blockIdx.x; it < n_items; it += gridDim.x) {
    const int tile = it >> 2, cq = it & 3;
    const int e = __builtin_amdgcn_readfirstlane(exp_find(toff, tile)); const int j0 = (tile - toff[e]) * 256;
    const int nrows = min(256, roff[e] - j0), rbase = e * NR + j0, crow0 = rowo[e] + j0;
    const float* wg = p.w_exp_gate + ((long)l * N_EXPERTS + e) * D_MODEL * EXPERT_FF; const float* wu = p.w_exp_up + ((long)l * N_EXPERTS + e) * D_MODEL * EXPERT_FF;
    ALRows4 al; al.base = (const char*)p.ubf();
#pragma unroll
    for (int i = 0; i < 4; ++i) { const int rl = min((tid >> 3) + 64 * i, nrows - 1); al.off[i] = ((unsigned)(p.elist()[rbase + rl] / TOP_K) * D_MODEL + (tid & 7) * 8) * 2u; }
    const int nq = (tid >> 3) & 31; const int wsel = __builtin_amdgcn_readfirstlane(tid >> 6) & 1;
    BLStd4 bl; bl.base = (const char*)((wsel ? wu : wg) + cq * 64); bl.ldb4 = EXPERT_FF * 4;
    bl.voff = (unsigned)((tid & 7) * 8 + (tid >> 8) * 4) * (unsigned)(EXPERT_FF * 4) + (unsigned)(((nq >> 4) * 32 + (nq & 7) * 4) * 4);
    f32x4 acc[4][4]; acc_zero(acc);
    gemm_m2(al, bl, D_MODEL >> 6, acc, smem);
    EPI_BEGIN
    const int ewc = (etid >> 6) & 1, ec = etid & 15;
#pragma unroll
    for (int m = 0; m < 4; ++m)
#pragma unroll
      for (int j = 0; j < 4; ++j) {
        const int rl = EPI2_ROW(m, j);
        if (rl < nrows) {
          const float gsc = p.egate()[rbase + rl];
          unsigned short* dst = p.hbf() + (long)(crow0 + rl) * EXPERT_FF + cq * 64 + ewc * 32 + ec;
          dst[0] = (unsigned short)f2bf(siluq(acc[m][0][j]) * acc[m][2][j] * gsc); dst[16] = (unsigned short)f2bf(siluq(acc[m][1][j]) * acc[m][3][j] * gsc);
        }
      }
  }
}
DEV void ph_expert_down_mfma(const P& p, int l, char* smem) {
  const int tid = otid();
  EXP_TABLES
  exp_prefix(p, l, toff, roff, rowo);
  const int NC8 = D_MODEL / 128;
  const int n_exp_items = toff[N_EXPERTS] * NC8;
  for (int it = blockIdx.x; it < n_exp_items; it += gridDim.x) {
    const int tile = it / NC8, ct = it - tile * NC8;
    const int e = __builtin_amdgcn_readfirstlane(exp_find(toff, tile)); const int j0 = (tile - toff[e]) * 256;
    const int nrows = min(256, roff[e] - j0), crow0 = rowo[e] + j0;
    const float* wd = p.w_exp_down + ((long)l * N_EXPERTS + e) * EXPERT_FF * D_MODEL;
    ALRows4 al; al.base = (const char*)p.hbf();
#pragma unroll
    for (int i = 0; i < 4; ++i) { const int rl = min((tid >> 3) + 64 * i, nrows - 1); al.off[i] = ((unsigned)(crow0 + rl) * EXPERT_FF + (tid & 7) * 8) * 2u; }
    BLStd4 bl; bl.base = (const char*)(wd + ct * 128); bl.ldb4 = D_MODEL * 4;
    bl.voff = (unsigned)((tid & 7) * 8 + (tid >> 8) * 4) * (unsigned)(D_MODEL * 4) + (unsigned)(((tid >> 3) & 31) * 16);
    f32x4 acc[4][4]; acc_zero(acc);
    gemm_m2(al, bl, EXPERT_FF >> 6, acc, smem);
    EPI_BEGIN
#pragma unroll
    for (int m = 0; m < 4; ++m)
#pragma unroll
      for (int j = 0; j < 4; ++j) {
        const int rl = EPI2_ROW(m, j);
        if (rl < nrows) {
          unsigned short* dst = p.ykb() + (long)(crow0 + rl) * D_MODEL + ct * 128;
#pragma unroll
          for (int n = 0; n < 4; ++n) dst[EPI2_COL(n)] = (unsigned short)f2bf(acc[m][n][j]);
        }
      }
  }
  const int NCT = D_MODEL / 256;
  const int n_sh_items = (NR >> 7) * NCT;
  for (int it = (int)gridDim.x - 1 - (int)blockIdx.x; it < n_sh_items; it += gridDim.x) {
    const int rt = it / NCT, ct = it - rt * NCT;
    ALRows al; al.base = (const char*)(p.hsbf() + (long)rt * 128 * SHARED_FF);
#pragma unroll
    for (int i = 0; i < 2; ++i) al.off[i] = (unsigned)(((tid >> 3) + 64 * i) * SHARED_FF + (tid & 7) * 8) * 2u;
    const BLT bl = mk_blt(p.wt_shd() + ((long)l * D_MODEL + ct * 256) * SHARED_FF, SHARED_FF, tid);
    f32x4 acc[4][4]; acc_zero(acc);
    gemm_tb(al, bl, SHARED_FF >> 6, acc, smem);
    EPI_BEGIN
#pragma unroll
    for (int m = 0; m < 4; ++m)
#pragma unroll
      for (int n = 0; n < 4; ++n)
#pragma unroll
        for (int j = 0; j < 4; ++j) p.ysh()[((long)rt * 128 + EPI_ROW(m, j)) * D_MODEL + ct * 256 + EPI_COL(n)] = acc[m][n][j];
  }
}

typedef __attribute__((ext_vector_type(16))) float f32x16;
#define SM_HR 256
#define UB_STRIDE 8272
#define SM_HU (256 + 32768)
#define SMEM_HY (256 + 32768 + 2 * UB_STRIDE * 2)
static_assert(SEQ == 8192 && HYENA_W == 256, "hyena mfma shape");
DEV void ph_hyena_mfma(const P& p, int l, char* smem) {
  const int tid = otid(), lane = tid & 63, w = tid >> 6;
  unsigned short* R = (unsigned short*)(smem + SM_HR); unsigned short* U = (unsigned short*)(smem + SM_HU);
  for (int ch = blockIdx.x; ch < HYENA_W; ch += gridDim.x) {
    __syncthreads();
    const float* kf = p.kraw() + ((long)l * 2 * HYENA_W + ch) * SEQ; const float* kb = p.kraw() + ((long)l * 2 * HYENA_W + HYENA_W + ch) * SEQ;
    for (int y = tid; y < 2 * SEQ; y += NT) {
      const int lag = SEQ - y; float v = 0.f;
      if (lag >= 0 && lag < SEQ) v = kf[lag]; else if (lag < 0) v = kb[-lag];
      const int C = y >> 3; R[((C ^ ((C >> 4) & 1)) << 3) + (y & 7)] = (unsigned short)f2bf(v);
    }
    for (int e = tid; e < 2 * UB_STRIDE; e += NT) {
      const int b = e / UB_STRIDE, ee = e - b * UB_STRIDE, t = ee - 16; float v = 0.f;
      if (t >= 0 && t < SEQ) v = p.hu()[((long)b * HYENA_W + ch) * SEQ + t];
      U[e] = (unsigned short)f2bf(v);
    }
    __syncthreads();
    f32x16 acc[2];
#pragma unroll
    for (int mi = 0; mi < 2; ++mi)
#pragma unroll
      for (int k = 0; k < 16; ++k) acc[mi][k] = 0.f;
    const int r = lane & 31, h = lane >> 5, sig = lane & 15, bb = (lane >> 4) & 1;
    const unsigned* Ud = (const unsigned*)U + bb * (UB_STRIDE / 2);
    const int ub0 = 8 * h + sig;
    const int cbase = 1022 - 64 * (2 * w) - 2 * r + h;
    const bool odd = sig & 1;
    bf16x8 afn[2]; unsigned dn[5];
    {
#pragma unroll
      for (int mi = 0; mi < 2; ++mi) { const int C = cbase - 64 * mi; afn[mi] = *(const bf16x8*)((const char*)R + ((C ^ ((C >> 4) & 1)) << 4)); }
      const int di = ub0 >> 1;
#pragma unroll
      for (int i = 0; i < 5; ++i) dn[i] = Ud[di + i];
    }
#pragma unroll 1
    for (int q = 0; q <= SEQ / 16; ++q) {
      bf16x8 af[2]; unsigned d[5];
#pragma unroll
      for (int mi = 0; mi < 2; ++mi) af[mi] = afn[mi];
#pragma unroll
      for (int i = 0; i < 5; ++i) d[i] = dn[i];
      {
        const int qn = min(q + 1, SEQ / 16);
#pragma unroll
        for (int mi = 0; mi < 2; ++mi) { const int C = cbase - 64 * mi + 2 * qn; afn[mi] = *(const bf16x8*)((const char*)R + ((C ^ ((C >> 4) & 1)) << 4)); }
        const int di = (16 * qn + ub0) >> 1;
#pragma unroll
        for (int i = 0; i < 5; ++i) dn[i] = Ud[di + i];
      }
      u32x4 bw;
#pragma unroll
      for (int i = 0; i < 4; ++i) bw[i] = odd ? __builtin_amdgcn_alignbit(d[i + 1], d[i], 16) : d[i];
      const bf16x8 bfr = __builtin_bit_cast(bf16x8, bw);
#pragma unroll
      for (int mi = 0; mi < 2; ++mi) acc[mi] = __builtin_amdgcn_mfma_f32_32x32x16_bf16(af[mi], bfr, acc[mi], 0, 0, 0);
    }
    __syncthreads();
    {
      float* Y = (float*)(smem + SM_HR);
      float* yl = Y + bb * SEQ + 16 * (32 * (2 * w) + 4 * h) + sig;
#pragma unroll
      for (int mi = 0; mi < 2; ++mi)
#pragma unroll
        for (int k = 0; k < 16; ++k) yl[16 * (32 * mi + (k & 3) + 8 * (k >> 2))] = acc[mi][k];
    }
    __syncthreads();
    {
      const float* Y = (const float*)(smem + SM_HR);
      const float kn = p.knorm()[l * HYENA_W + ch], dsk = p.hy_d[l * HYENA_W + ch];
#pragma unroll 2
      for (int idx = tid; idx < BATCH * SEQ; idx += NT) {
        const int b = idx / SEQ, t = idx - b * SEQ;
        const long o = ((long)b * HYENA_W + ch) * SEQ + t;
        p.mixb()[(long)idx * MIX_W + ATTN_W + ch] = (Y[idx] * kn + p.hu()[o] * dsk) * p.hx0()[o];
      }
    }
  }
}
#define SM_K 256
#define SM_V (256 + 8192)
static_assert(HEAD_DIM == 64 && WINDOW == 128 && CTX_LEN == 256 && Q_GROUP == 4, "attention shape");
DEV void ph_attn_mfma(const P& p, int l, char* smem) {
  const int tid = otid(), lane = tid & 63, w = (tid >> 6) & 3, hsel = tid >> 8, h = lane >> 5, ql = lane & 31;
  char* Ks = smem + SM_K; char* Vs = smem + SM_V;
  const int n_lat = BATCH * (SEQ / 128) * N_KV_HEADS * (Q_GROUP / 2);
  const int n_ctx = (l == 0) ? BATCH * (CTX_LEN / 128) * N_KV_HEADS * (Q_GROUP / 2) : 0;
  const float QS = 0.125f * 1.4426950408889634f;
  for (int it = blockIdx.x; it < n_lat + n_ctx; it += gridDim.x) {
    const bool isctx = it >= n_lat;
    int b, qb, kvh, g;
    { int x = isctx ? it - n_lat : it; g = (x & 1) * 2 + hsel; kvh = (x >> 1) & 1; x >>= 2; if (isctx) { qb = x & 1; b = x >> 1; } else { qb = x & 63; b = x >> 6; } }
    const int hq = kvh * Q_GROUP + g;
    const int tq0 = qb * 128 + 32 * w;
    const long qrow = (isctx ? (long)NL + b * CTX_LEN : (long)b * SEQ) + tq0 + ql;
    bf16x8 qf[4];
    {
      const unsigned short* qp = p.qkvb() + qrow * HY_OFF + Q_OFF + hq * HEAD_DIM + 8 * h;
#pragma unroll
      for (int ks = 0; ks < 4; ++ks) qf[ks] = *(const bf16x8*)(qp + 16 * ks);
    }
    f32x16 o0, o1;
#pragma unroll
    for (int k = 0; k < 16; ++k) { o0[k] = 0.f; o1[k] = 0.f; }
    float m = -1e30f, lsum = 0.f;
    const int nsteps = isctx ? 4 : 10;
    u32x4 rk[1], rv[1];
    auto key_row = [&](int step, int key) -> long {
      if (step < 4) return (long)NL + b * CTX_LEN + step * 64 + key;
      const int tk = qb * 128 - 128 + (step - 4) * 64 + key;
      return (tk < 0 || tk >= SEQ) ? -1 : (long)b * SEQ + tk;
    };
    auto step_valid = [&](int step) -> bool { if (step < 4) return true; const int t0 = qb * 128 - 128 + (step - 4) * 64; return t0 >= 0 && t0 < SEQ; };
    auto load_tile = [&](int step) {
#pragma unroll
      for (int i = 0; i < 1; ++i) {
        const int key = (tid >> 3); const long kr = key_row(step, key);
        const unsigned short* kp = p.qkvb() + kr * HY_OFF + K_OFF + kvh * HEAD_DIM + (tid & 7) * 8; const unsigned short* vp = p.qkvb() + kr * HY_OFF + V_OFF + kvh * HEAD_DIM + (tid & 7) * 8;
        rk[i] = *(const u32x4*)kp; rv[i] = *(const u32x4*)vp;
      }
    };
    int step = 0;
    load_tile(0);
    while (step < nsteps) {
      __syncthreads();
#pragma unroll
      for (int i = 0; i < 1; ++i) {
        const int key = (tid >> 3), ch = tid & 7;
        *(u32x4*)(Ks + tile_off(key, ch)) = rk[i];
        *(u32x4*)(Vs + key * 128 + ((ch * 16) ^ (64 * ((key >> 1) & 1)))) = rv[i];
      }
      __syncthreads();
      const int cur = step;
      int nxt = step + 1;
      while (nxt < nsteps && !step_valid(nxt)) ++nxt;
      if (nxt < nsteps) load_tile(nxt);
      step = nxt;
#pragma unroll
      for (int sub = 0; sub < 2; ++sub) {
        const bool win = cur >= 4;
        const int ks0 = win ? qb * 128 - 128 + (cur - 4) * 64 + sub * 32 : 0;
        if (win && (ks0 > tq0 + 31 + WINDOW || ks0 + 31 < tq0 - WINDOW)) continue;
        f32x16 sacc;
#pragma unroll
        for (int k = 0; k < 16; ++k) sacc[k] = 0.f;
#pragma unroll
        for (int ks = 0; ks < 4; ++ks) {
          const bf16x8 kf = *(const bf16x8*)(Ks + tile_off(sub * 32 + ql, 2 * ks + h));
          sacc = __builtin_amdgcn_mfma_f32_32x32x16_bf16(kf, qf[ks], sacc, 0, 0, 0);
        }
        if (win && (ks0 + 31 - tq0 > WINDOW || tq0 + 31 - ks0 > WINDOW)) {
          const int tq = tq0 + ql;
#pragma unroll
          for (int k = 0; k < 16; ++k) { const int d = ks0 + (k & 3) + 8 * (k >> 2) + 4 * h - tq; if (d > WINDOW || d < -WINDOW) sacc[k] = -1e30f; }
        }
        float mx = sacc[0];
#pragma unroll
        for (int k = 1; k < 16; ++k) mx = fmaxf(mx, sacc[k]);
        mx = fmaxf(mx, __shfl_xor(mx, 32));
        const float mn = fmaxf(m, mx); const float alpha = __builtin_amdgcn_exp2f(m - mn); m = mn;
        float ps = 0.f;
#pragma unroll
        for (int k = 0; k < 16; ++k) { sacc[k] = __builtin_amdgcn_exp2f(sacc[k] - mn); ps += sacc[k]; }
        lsum = lsum * alpha + ps;
#pragma unroll
        for (int k = 0; k < 16; ++k) { o0[k] *= alpha; o1[k] *= alpha; }
        u32x2 v00, v01, v02, v03, v10, v11, v12, v13;
        {
          const int q4 = (lane & 15) >> 2, p4 = lane & 3, blk = (lane >> 4) & 1, sq = (q4 >> 1) & 1;
          const unsigned lb = (unsigned)(size_t)((__attribute__((address_space(3))) char*)Vs) + (unsigned)((sub * 32 + 4 * h + q4) * 128 + 32 * blk + 8 * p4);
          const unsigned base0 = lb + 64 * sq, base1 = lb + 64 * (1 - sq);
          asm volatile(
              "ds_read_b64_tr_b16 %0, %8\n\t"
              "ds_read_b64_tr_b16 %1, %8 offset:1024\n\t"
              "ds_read_b64_tr_b16 %2, %8 offset:2048\n\t"
              "ds_read_b64_tr_b16 %3, %8 offset:3072\n\t"
              "ds_read_b64_tr_b16 %4, %9\n\t"
              "ds_read_b64_tr_b16 %5, %9 offset:1024\n\t"
              "ds_read_b64_tr_b16 %6, %9 offset:2048\n\t"
              "ds_read_b64_tr_b16 %7, %9 offset:3072\n\t"
              "s_waitcnt lgkmcnt(0)"
              : "=&v"(v00), "=&v"(v01), "=&v"(v02), "=&v"(v03), "=&v"(v10), "=&v"(v11), "=&v"(v12), "=&v"(v13)
              : "v"(base0), "v"(base1) : "memory");
        }
#pragma unroll
        for (int ks2 = 0; ks2 < 2; ++ks2) {
          u32x4 pw;
#pragma unroll
          for (int i = 0; i < 4; ++i) pw[i] = pack2(sacc[8 * ks2 + 2 * i], sacc[8 * ks2 + 2 * i + 1]);
          const bf16x8 pf = __builtin_bit_cast(bf16x8, pw);
          u32x4 a0, a1;
          if (ks2 == 0) { a0[0] = v00[0]; a0[1] = v00[1]; a0[2] = v01[0]; a0[3] = v01[1]; a1[0] = v10[0]; a1[1] = v10[1]; a1[2] = v11[0]; a1[3] = v11[1]; }
          else          { a0[0] = v02[0]; a0[1] = v02[1]; a0[2] = v03[0]; a0[3] = v03[1]; a1[0] = v12[0]; a1[1] = v12[1]; a1[2] = v13[0]; a1[3] = v13[1]; }
          o0 = __builtin_amdgcn_mfma_f32_32x32x16_bf16(__builtin_bit_cast(bf16x8, a0), pf, o0, 0, 0, 0);
          o1 = __builtin_amdgcn_mfma_f32_32x32x16_bf16(__builtin_bit_cast(bf16x8, a1), pf, o1, 0, 0, 0);
        }
      }
    }
    lsum += __shfl_xor(lsum, 32);
    const float sk = p.sink[l * N_Q_HEADS + hq] * 1.4426950408889634f;
    const float mf = fmaxf(m, sk); const float sc = __builtin_amdgcn_exp2f(m - mf); const float inv = sc / (lsum * sc + __builtin_amdgcn_exp2f(sk - mf));
    float* op = p.mixb() + qrow * MIX_W + hq * HEAD_DIM + 4 * h;
#pragma unroll
    for (int gq = 0; gq < 4; ++gq) {
      *(float4*)(op + 8 * gq) = make_float4(o0[4 * gq] * inv, o0[4 * gq + 1] * inv, o0[4 * gq + 2] * inv, o0[4 * gq + 3] * inv);
      *(float4*)(op + 32 + 8 * gq) = make_float4(o1[4 * gq] * inv, o1[4 * gq + 1] * inv, o1[4 * gq + 2] * inv, o1[4 * gq + 3] * inv);
    }
  }
}


static_assert(S5_T == 64 && S5_STATE == 64 && S5_GROUP == 16 && S5_GROUPS == 16 && NCH == 132, "s5 mfma shape");
#define S5_COLS (BATCH * NCH)
#define S5_RT 88
DEV void ph_s5tables_gpu(const P& p, long gtid, long gsize) {
  FOR_ITEMS4(i, (long)DEPTH * 2 * S5_GROUPS * 128 * 1024) {
    const int k = (int)(i & 1023), n = (int)((i >> 10) & 127); const long ldg = i >> 17;
    const int ri = n >> 6, pp = n & 63, sidx = k >> 4, j = k & 15;
    const float2 lp = p.lampow()[(ldg * (S5_T + 1) + (S5_T - 1 - sidx)) * S5_STATE + pp]; const float2 bb = p.bbar()[(ldg * S5_STATE + pp) * S5_GROUP + j];
    p.bmtb()[i] = (unsigned short)f2bf(ri ? lp.x * bb.y + lp.y * bb.x : lp.x * bb.x - lp.y * bb.y);
  }
  FOR_ITEMS4(i, (long)DEPTH * 2 * S5_GROUPS * 128 * 1024) {
    const int k = (int)(i & 127), n = (int)((i >> 7) & 1023); const long ldg = i >> 17; const int dir = (int)((ldg >> 4) & 1);
    const int ri = k >> 6, pp = k & 63, tl = n >> 4, ii = n & 15; const int tau = dir ? 63 - tl : tl;
    const float cr = p.s5_c_re[(ldg * S5_GROUP + ii) * S5_STATE + pp], ci = p.s5_c_im[(ldg * S5_GROUP + ii) * S5_STATE + pp];
    const float2 lp = p.lampow()[(ldg * (S5_T + 1) + tau + 1) * S5_STATE + pp];
    p.cmtb()[i] = (unsigned short)f2bf(ri ? -(cr * lp.y + ci * lp.x) : cr * lp.x - ci * lp.y);
  }
}
DEV void ph_kcb_gpu(const P& p, long gtid, long gsize) {
  FOR_ITEMS4(i, (long)DEPTH * 2 * S5_GROUPS * S5_T * 256) p.kcb()[i] = (unsigned short)f2bf(p.kc()[i]);
}
struct ALS5U { const char* base; unsigned off0[2]; int stepb; const char* hbase; unsigned hoff[2]; int nki;
  DEVM void set(int i, int b, int dir, int chunk, int sl, unsigned joff) { off0[i] = (unsigned)s5_row(b, dir, chunk * S5_T + sl) * (unsigned)(S5_W * 2) + joff; }
  DEVM const unsigned short* a(int i, int kt) const {
    if (kt >= nki) return (const unsigned short*)(hbase + (hoff[i] + (unsigned)(kt - nki) * 128u));
    return (const unsigned short*)(base + (off0[i] + (unsigned)(kt * stepb))); } };
struct BLKc { const char* kc; const char* cm; int tl, i0, sj, ss, dir, nki; unsigned cmoff;
  DEVM void load(u32x4 (&rb)[4], int kt) const {
    if (kt >= nki) {
#pragma unroll
      for (int c = 0; c < 4; ++c) rb[c] = *(const u32x4*)(cm + (cmoff + (unsigned)(c * 128 + (kt - nki) * 64) * 2u));
      return;
    }
    const int d = (dir ? 63 - tl : tl) - (4 * kt + ss);
    if (d < 0) {
#pragma unroll
      for (int c = 0; c < 4; ++c) rb[c] = (u32x4){0u, 0u, 0u, 0u};
    } else {
#pragma unroll
      for (int c = 0; c < 4; ++c) rb[c] = *(const u32x4*)(kc + (unsigned)(((d * 16 + i0 + c) * 16 + sj) * 2));
    }
  } };
DEV void ph_s5_sgemm(const P& p, int l, char* smem) {
  const int tid = otid();
  const int nitems = 2 * S5_GROUPS * 3;
  for (int it = blockIdx.x; it < nitems; it += gridDim.x) {
    const int rt = it % 3, g = (it / 3) % S5_GROUPS, dir = it / (3 * S5_GROUPS);
    ALS5U al; al.base = (const char*)(p.s5u() + g * S5_GROUP); al.stepb = (dir ? -4 : 4) * S5_W * 2; al.nki = 1 << 20; al.hbase = al.base; al.hoff[0] = al.hoff[1] = 0;
#pragma unroll
    for (int i = 0; i < 2; ++i) { const int col = rt * S5_RT + min((tid >> 3) + 64 * i, S5_RT - 1); al.set(i, col / NCH, dir, col % NCH, (tid & 7) >> 1, (tid & 1) * 16); }
    BLT bl; bl.base = (const char*)(p.bmtb() + (((long)l * 2 + dir) * S5_GROUPS + g) * 128 * 1024); bl.rowb = 1024 * 2;
    bl.voff = (unsigned)((((tid >> 3) & 31) * 4)) * bl.rowb + (unsigned)((tid & 7) * 16);
    f32x4 acc[4][4]; acc_zero(acc);
    gemm_tb(al, bl, 16, acc, smem);
    EPI_BEGIN
    if (((etid >> 6) & 3) < 2) {
#pragma unroll
      for (int m = 0; m < 4; ++m)
#pragma unroll
        for (int j = 0; j < 4; ++j) {
          const int rl = EPI_ROW(m, j);
          if (rl < S5_RT) {
            const int col = rt * S5_RT + rl; const int b = col / NCH, c = col % NCH;
            float* dst = (float*)(p.sc() + ((((long)b * 2 + dir) * S5_GROUPS + g) * NCH + c) * S5_STATE);
#pragma unroll
            for (int n = 0; n < 4; ++n) { const int nn = EPI_COL(n); dst[(nn & 63) * 2 + (nn >> 6)] = acc[m][n][j]; }
          }
        }
    }
  }
}

static_assert(NCH == 132, "carry scan grouping");
DEV void ph_s5_carry_gpu(const P& p, int l, char* smem) {
  const int tid = otid();
  float2* E = (float2*)(smem + SM_MISC);
  const int nchains = BATCH * 2 * S5_GROUPS * S5_STATE;
  for (int cb = blockIdx.x * 16; cb < nchains; cb += gridDim.x * 16) {
    const int cl = tid & 15, grp = tid >> 4; const bool act = tid < 176;
    const int chain = cb + cl;
    const int pp = chain % S5_STATE, g = (chain / S5_STATE) % S5_GROUPS, dir = (chain / (S5_STATE * S5_GROUPS)) % 2, b = chain / (S5_STATE * S5_GROUPS * 2);
    const long ldg = ((long)l * 2 + dir) * S5_GROUPS + g;
    const long base = (((long)b * 2 + dir) * S5_GROUPS + g) * NCH + grp * 12;
    float2 lt = make_float2(0.f, 0.f); float2 L[12]; float hr = 0.f, hi = 0.f;
    __syncthreads();
    if (act) {
      lt = p.lampow()[(ldg * (S5_T + 1) + S5_T) * S5_STATE + pp];
      float2 sv[12];
#pragma unroll
      for (int k = 0; k < 12; ++k) sv[k] = p.sc()[(base + k) * S5_STATE + pp];
#pragma unroll
      for (int k = 0; k < 12; ++k) { L[k] = make_float2(hr, hi); const float nr = lt.x * hr - lt.y * hi + sv[k].x, ni = lt.x * hi + lt.y * hr + sv[k].y; hr = nr; hi = ni; }
      E[grp * 16 + cl] = make_float2(hr, hi);
    }
    __syncthreads();
    if (act) {
      float pr = lt.x, pi = lt.y;
#pragma unroll
      for (int k = 1; k < 12; ++k) { const float nr = pr * lt.x - pi * lt.y, ni = pr * lt.y + pi * lt.x; pr = nr; pi = ni; }
      float gr = 0.f, gi = 0.f;
      for (int gp = 0; gp < grp; ++gp) { const float2 e = E[gp * 16 + cl]; const float nr = pr * gr - pi * gi + e.x, ni = pr * gi + pi * gr + e.y; gr = nr; gi = ni; }
#pragma unroll
      for (int k = 0; k < 12; ++k) {
        const float vr = L[k].x + gr, vi = L[k].y + gi;
        p.hcbf()[(base + k) * 2 * S5_STATE + pp] = f2bf16(vr); p.hcbf()[(base + k) * 2 * S5_STATE + S5_STATE + pp] = f2bf16(vi);
        const float nr = lt.x * gr - lt.y * gi, ni = lt.x * gi + lt.y * gr; gr = nr; gi = ni;
      }
    }
  }
}
DEV void ph_s5_ygemm(const P& p, int l, char* smem) {
  const int tid = otid();
  const int nitems = S5_GROUPS * 3 * 4;
  for (int it = blockIdx.x; it < nitems; it += gridDim.x) {
    const int nt = it & 3, rt = (it >> 2) % 3, g = it / 12;
    f32x4 acc[4][4]; acc_zero(acc);
#pragma unroll 1
    for (int dir = 0; dir < 2; ++dir) {
      const long ldg = ((long)l * 2 + dir) * S5_GROUPS + g;
      const int nki = dir ? 16 - 4 * nt : 4 * nt + 4;
      ALS5U al; al.base = (const char*)(p.s5u() + g * S5_GROUP); al.stepb = (dir ? -4 : 4) * S5_W * 2; al.nki = nki; al.hbase = (const char*)p.hcbf();
#pragma unroll
      for (int i = 0; i < 2; ++i) {
        const int col = rt * S5_RT + min((tid >> 3) + 64 * i, S5_RT - 1); const int b = col / NCH, blk = col % NCH;
        const int ch = dir ? (blk < 4 ? 3 - blk : 135 - blk) : blk;
        al.set(i, b, dir, ch, (tid & 7) >> 1, (tid & 1) * 16);
        al.hoff[i] = (unsigned)((((b * 2 + dir) * S5_GROUPS + g) * NCH + ch) * 128 + (tid & 7) * 8) * 2u;
      }
      BLKc bk; bk.kc = (const char*)(p.kcb() + ldg * S5_T * 256); bk.tl = 16 * nt + (tid >> 5); bk.i0 = ((tid >> 3) & 3) * 4; bk.sj = (tid & 1) * 8; bk.ss = (tid & 7) >> 1; bk.dir = dir; bk.nki = nki;
      bk.cm = (const char*)(p.cmtb() + ldg * 1024 * 128); bk.cmoff = (unsigned)(((16 * nt + (tid >> 5)) * 16 + ((tid >> 3) & 3) * 4) * 128 + (tid & 7) * 8) * 2u;
      gemm_tb(al, bk, nki + 2, acc, smem);
    }
    EPI_BEGIN
#pragma unroll
    for (int m = 0; m < 4; ++m)
#pragma unroll
      for (int j = 0; j < 4; ++j) {
        const int rl = EPI_ROW(m, j);
        if (rl < S5_RT) {
          const int col = rt * S5_RT + rl; const int b = col / NCH, blk = col % NCH;
#pragma unroll
          for (int n = 0; n < 4; ++n) {
            const int nn = nt * 256 + EPI_COL(n); const int tl = nn >> 4, chn = g * S5_GROUP + (nn & 15);
            const long row = blk < 4 ? (long)NL + b * CTX_LEN + blk * 64 + tl : (long)b * SEQ + (blk - 4) * 64 + tl;
            const float y = acc[m][n][j] + p.s5_d[l * S5_W + chn] * __uint_as_float((unsigned)p.s5u()[row * S5_W + chn] << 16);
            const float gy = gelu_tanhf(y);
            p.ybuf()[row * S5_W + chn] = gy; p.ybf()[row * S5_W + chn] = (unsigned short)f2bf(gy);
          }
        }
      }
  }
}

DEV float wave_sum(float v) {
#pragma unroll
  for (int o = 32; o > 0; o >>= 1) v += __shfl_xor(v, o);
  return v;
}
DEV void st_bf4(unsigned short* dst, float a, float b, float c, float d) { u32x2 v; v[0] = pack2(a, b); v[1] = pack2(c, d); *(u32x2*)dst = v; }
static_assert(BATCH == 2, "mod partial layout");
DEV void ph_modsum_gpu(const P& p, long gtid, long gsize) {
  FOR_ITEMS(i, (long)DEPTH * (BATCH + 1) * 6 * D_MODEL) {
    const int n = (int)(i % (6 * D_MODEL)); const int j = (int)((i / (6 * D_MODEL)) % (BATCH + 1)); const int l = (int)(i / (6 * D_MODEL * (BATCH + 1)));
    float acc = p.b_ada[l * 6 * D_MODEL + n];
#pragma unroll
    for (int sl = 0; sl < 16; ++sl) acc += p.modp()[((long)(l * 16 + sl) * (BATCH + 1) + j) * 6 * D_MODEL + n];
    p.mod()[i] = acc;
  }
}
DEV void ph_modu0_gpu(const P& p, long gtid, long gsize) {
  FOR_ITEMS4(i4, (long)NR * D_MODEL / 4) {
    const long i = i4 * 4; const int k = (int)(i % D_MODEL); const long r = i / D_MODEL;
    const float* m = p.mod() + (long)modrow(r) * 6 * D_MODEL;
    const float4 x = *(const float4*)(p.xcur() + i); const float4 sh = *(const float4*)(m + k); const float4 sc = *(const float4*)(m + D_MODEL + k);
    st_bf4(p.ubf() + i, x.x * (1.f + sc.x) + sh.x, x.y * (1.f + sc.y) + sh.y, x.z * (1.f + sc.z) + sh.z, x.w * (1.f + sc.w) + sh.w);
  }
}
DEV void rms_rows(const P& p, int l, long r0, long r1, int w0, int nw) {
  const int lane = otid() & 63;
  for (long r = r0 + w0; r < r1; r += nw) {
    const float* v = p.mixb() + r * MIX_W; float4 a[4]; float ss[4];
#pragma unroll
    for (int i = 0; i < 4; ++i) { a[i] = *(const float4*)(v + (i * 64 + lane) * 4); ss[i] = a[i].x * a[i].x + a[i].y * a[i].y + a[i].z * a[i].z + a[i].w * a[i].w; }
    const float s_att = wave_sum(ss[0] + ss[1]), s_hy = wave_sum(ss[2]), s_s5 = wave_sum(ss[3]);
    float rs[4]; rs[0] = rs[1] = 1.0f / sqrtf(s_att / (float)ATTN_W + LN_EPS); rs[2] = 1.0f / sqrtf(s_hy / (float)HYENA_W + LN_EPS); rs[3] = 1.0f / sqrtf(s_s5 / (float)S5_W + LN_EPS);
#pragma unroll
    for (int i = 0; i < 4; ++i) {
      const int k = (i * 64 + lane) * 4; const float4 g = *(const float4*)(p.mix_g + l * MIX_W + k);
      st_bf4(p.mixbf() + r * MIX_W + k, a[i].x * rs[i] * g.x, a[i].y * rs[i] * g.y, a[i].z * rs[i] * g.z, a[i].w * rs[i] * g.w);
    }
  }
}
DEV void ln_rows(float4 (&a)[4], const float* gw, const float* bw, int lane) {
  float s = 0.f;
#pragma unroll
  for (int i = 0; i < 4; ++i) s += a[i].x + a[i].y + a[i].z + a[i].w;
  const float mu = wave_sum(s) / (float)D_MODEL; float q = 0.f;
#pragma unroll
  for (int i = 0; i < 4; ++i) { a[i].x -= mu; a[i].y -= mu; a[i].z -= mu; a[i].w -= mu; q += a[i].x * a[i].x + a[i].y * a[i].y + a[i].z * a[i].z + a[i].w * a[i].w; }
  const float rs = 1.0f / sqrtf(wave_sum(q) / (float)D_MODEL + LN_EPS);
#pragma unroll
  for (int i = 0; i < 4; ++i) {
    const int k = (i * 64 + lane) * 4; const float4 g = *(const float4*)(gw + k), b = *(const float4*)(bw + k);
    a[i].x = a[i].x * rs * g.x + b.x; a[i].y = a[i].y * rs * g.y + b.y; a[i].z = a[i].z * rs * g.z + b.z; a[i].w = a[i].w * rs * g.w + b.w;
  }
}
DEV void ph_ln1_gpu(const P& p, int l) {
  const int tid_ = otid(); const int lane = tid_ & 63; const int gw = blockIdx.x * (NT / 64) + (tid_ >> 6), nw = gridDim.x * (NT / 64);
  for (long r = gw; r < NR; r += nw) {
    float4 a[4];
#pragma unroll
    for (int i = 0; i < 4; ++i) a[i] = *(const float4*)(p.tmp() + r * D_MODEL + (i * 64 + lane) * 4);
    ln_rows(a, p.ln1_g + l * D_MODEL, p.ln1_b + l * D_MODEL, lane);
    const float* m = p.mod() + ((long)l * (BATCH + 1) + modrow(r)) * 6 * D_MODEL + 3 * D_MODEL;
#pragma unroll
    for (int i = 0; i < 4; ++i) {
      const int k = (i * 64 + lane) * 4;
      *(float4*)(p.xcur() + r * D_MODEL + k) = a[i];
      const float4 sh = *(const float4*)(m + k), sc = *(const float4*)(m + D_MODEL + k);
      const float u0 = a[i].x * (1.f + sc.x) + sh.x, u1 = a[i].y * (1.f + sc.y) + sh.y, u2 = a[i].z * (1.f + sc.z) + sh.z, u3 = a[i].w * (1.f + sc.w) + sh.w;
      st_bf4(p.ubf() + r * D_MODEL + k, u0, u1, u2, u3);
      st_bf4(p.ubl() + r * D_MODEL + k, bflo(u0), bflo(u1), bflo(u2), bflo(u3));
    }
  }
}
DEV void exp_prefix(const P& p, int l, int* toff, int* roff, int* rowo);
DEV void ph_ln2_gpu(const P& p, int l, char* smem) {
  const int tid_ = otid(); const int lane = tid_ & 63; const int gw = blockIdx.x * (NT / 64) + (tid_ >> 6), nw = gridDim.x * (NT / 64);
  int* toff = (int*)(smem + SM_MISC); int* roff = toff + N_EXPERTS + 1; int* rowo = roff + N_EXPERTS + 16;
  exp_prefix(p, l, toff, roff, rowo);
  int e_n = 0, s_n = 0;
  if (gw < NR && lane < TOP_K) { e_n = p.top_e()[(long)gw * TOP_K + lane]; s_n = p.posb()[(long)gw * TOP_K + lane]; }
  for (long r = gw; r < NR; r += nw) {
    const int myrow = rowo[e_n] + s_n;
    if (r + nw < NR && lane < TOP_K) { e_n = p.top_e()[(r + nw) * TOP_K + lane]; s_n = p.posb()[(r + nw) * TOP_K + lane]; }
    float4 a[4];
    const float* m = p.mod() + ((long)l * (BATCH + 1) + modrow(r)) * 6 * D_MODEL + 5 * D_MODEL;
#pragma unroll
    for (int i = 0; i < 4; ++i) {
      const int k = (i * 64 + lane) * 4;
      float4 f = *(const float4*)(p.ysh() + r * D_MODEL + k);
#pragma unroll
      for (int kk = 0; kk < TOP_K; ++kk) { const u32x2 y = *(const u32x2*)(p.ykb() + (long)__builtin_amdgcn_readlane(myrow, kk) * D_MODEL + k); f.x += __uint_as_float(y[0] << 16); f.y += __uint_as_float(y[0] & 0xffff0000u); f.z += __uint_as_float(y[1] << 16); f.w += __uint_as_float(y[1] & 0xffff0000u); }
      const float4 x = *(const float4*)(p.xcur() + r * D_MODEL + k), g2 = *(const float4*)(m + k);
      a[i].x = DN_ALPHA * x.x + g2.x * f.x; a[i].y = DN_ALPHA * x.y + g2.y * f.y; a[i].z = DN_ALPHA * x.z + g2.z * f.z; a[i].w = DN_ALPHA * x.w + g2.w * f.w;
    }
    ln_rows(a, p.ln2_g + l * D_MODEL, p.ln2_b + l * D_MODEL, lane);
    const float* mn = p.mod() + ((long)(l + 1) * (BATCH + 1) + modrow(r)) * 6 * D_MODEL;
#pragma unroll
    for (int i = 0; i < 4; ++i) {
      const int k = (i * 64 + lane) * 4;
      *(float4*)(p.xcur() + r * D_MODEL + k) = a[i];
      if (l + 1 < DEPTH) {
        const float4 sh = *(const float4*)(mn + k), sc = *(const float4*)(mn + D_MODEL + k);
        st_bf4(p.ubf() + r * D_MODEL + k, a[i].x * (1.f + sc.x) + sh.x, a[i].y * (1.f + sc.y) + sh.y, a[i].z * (1.f + sc.z) + sh.z, a[i].w * (1.f + sc.w) + sh.w);
      } else if (r < NL) *(float4*)(p.out + r * D_MODEL + k) = a[i];
    }
  }
}
struct ALRouter { const char* hi; const char* lo_; unsigned off[2];
  DEVM const unsigned short* a(int i, int kt) const { return (const unsigned short*)((kt >= 32 ? lo_ : hi) + (off[i] + (unsigned)(kt & 15) * 128u)); } };
struct BLRouter { const char* base; const char* lob; unsigned voff; unsigned rowb;
  DEVM void load(u32x4 (&rb)[4], int kt) const {
    const char* bb = (kt >> 4) == 1 ? lob : base;
#pragma unroll
    for (int c = 0; c < 4; ++c) rb[c] = *(const u32x4*)(bb + (voff + (unsigned)c * rowb + (unsigned)(kt & 15) * 128u)); } };
DEV void ph_router_mfma(const P& p, int l, char* smem) {
  const int tid = otid();
  const int n_router = (NR >> 7), n_sh = (NR >> 7) * 2;
  const int nrb = (int)gridDim.x >= 64 ? (int)((gridDim.x * 3) / 5) : 0;
  const bool is_router = nrb == 0 ? false : (int)blockIdx.x < nrb;
  for (int pass = 0; pass < 2; ++pass) {
    const bool do_router = nrb == 0 ? pass == 0 : is_router;
    if (nrb != 0 && pass == 1) break;
    const int first = nrb == 0 ? (int)blockIdx.x : (do_router ? (int)blockIdx.x : (int)blockIdx.x - nrb);
    const int stride = nrb == 0 ? (int)gridDim.x : (do_router ? nrb : (int)gridDim.x - nrb);
    const int nit = do_router ? n_router : n_sh;
    for (int it = first; it < nit; it += stride) {
      const int rt = do_router ? it : (it >> 1), cq = do_router ? 0 : (it & 1);
      ALRouter ar; ar.hi = (const char*)(p.ubf() + (long)rt * 128 * D_MODEL); ar.lo_ = (const char*)(p.ubl() + (long)rt * 128 * D_MODEL);
#pragma unroll
      for (int i = 0; i < 2; ++i) ar.off[i] = (unsigned)(((tid >> 3) + 64 * i) * D_MODEL + (tid & 7) * 8) * 2u;
      BLRouter br; int nk;
      if (do_router) {
        br.base = (const char*)(p.wt_rh() + (long)l * N_EXPERTS * D_MODEL); br.lob = (const char*)(p.wt_rl() + (long)l * N_EXPERTS * D_MODEL); br.rowb = D_MODEL * 2;
        br.voff = (unsigned)((tid >> 3) * 4) * br.rowb + (unsigned)((tid & 7) * 16); nk = 3 * (D_MODEL >> 6);
      } else {
        const int nq = tid >> 3; const int wsel = __builtin_amdgcn_readfirstlane(tid >> 6) & 1;
        const unsigned short* wsrc = (wsel ? p.wt_shu() : p.wt_shg()) + (long)l * SHARED_FF * D_MODEL;
        br.base = (const char*)wsrc; br.lob = br.base; br.rowb = D_MODEL * 2;
        br.voff = (unsigned)(cq * 128 + (nq >> 4) * 32 + (nq & 7) * 4) * br.rowb + (unsigned)((tid & 7) * 16); nk = D_MODEL >> 6;
      }
      f32x4 acc[4][4]; acc_zero(acc);
      gemm_tb(ar, br, nk, acc, smem);
      EPI_BEGIN
      if (do_router) {
#pragma unroll
        for (int m = 0; m < 4; ++m)
#pragma unroll
          for (int n = 0; n < 4; ++n)
#pragma unroll
            for (int j = 0; j < 4; ++j) p.rl()[((long)rt * 128 + EPI_ROW(m, j)) * N_EXPERTS + EPI_COL(n)] = acc[m][n][j];
      } else {
        const int elane = etid & 63, ewc = (etid >> 6) & 3;
#pragma unroll
        for (int m = 0; m < 4; ++m)
#pragma unroll
          for (int j = 0; j < 4; ++j)
          { unsigned short* dst = p.hsbf() + ((long)rt * 128 + EPI_ROW(m, j)) * SHARED_FF + cq * 128 + ewc * 32 + (elane & 15);
            dst[0] = (unsigned short)f2bf(siluq(acc[m][0][j]) * acc[m][2][j]); dst[16] = (unsigned short)f2bf(siluq(acc[m][1][j]) * acc[m][3][j]); }
      }
    }
  }
}
static_assert(EPG == 32 && TOP_K == 8 && N_EXPERT_GROUPS == 8 && TOPK_GROUPS == 4, "select shape");
DEV void ph_select_gpu(const P& p, int l) {
  const int tid_ = otid(); const int lane = tid_ & 63; const int gw = blockIdx.x * (NT / 64) + (tid_ >> 6), nw = gridDim.x * (NT / 64);
  const float4 rb = *(const float4*)(p.router_bias + l * N_EXPERTS + 4 * lane);
  for (long r = gw; r < NR; r += nw) {
    const float4 lg = *(const float4*)(p.rl() + r * N_EXPERTS + 4 * lane);
    float sc[4] = {sigmoidf_(lg.x), sigmoidf_(lg.y), sigmoidf_(lg.z), sigmoidf_(lg.w)};
    float bz[4] = {sc[0] + rb.x, sc[1] + rb.y, sc[2] + rb.z, sc[3] + rb.w};
    float m1 = fmaxf(bz[0], bz[1]), m2 = fminf(bz[0], bz[1]);
#pragma unroll
    for (int c = 2; c < 4; ++c) { const float v = bz[c]; m2 = fmaxf(m2, fminf(m1, v)); m1 = fmaxf(m1, v); }
#pragma unroll
    for (int o = 1; o < 8; o <<= 1) { const float b1 = __shfl_xor(m1, o), b2 = __shfl_xor(m2, o); m2 = fmaxf(fminf(m1, b1), fmaxf(m2, b2)); m1 = fmaxf(m1, b1); }
    const float gs = m1 + m2; const int mg = lane >> 3; int rank = 0;
#pragma unroll
    for (int j = 0; j < 8; ++j) { const float gj = __shfl(gs, j * 8); rank += (gj > gs || (gj == gs && j < mg)) ? 1 : 0; }
    if (rank >= TOPK_GROUPS) { bz[0] = bz[1] = bz[2] = bz[3] = -1e30f; }
    int sel_e[TOP_K]; float sel_s[TOP_K]; float gsum = 0.f;
#pragma unroll
    for (int it = 0; it < TOP_K; ++it) {
      float bv = bz[0]; int bc = 0;
#pragma unroll
      for (int c = 1; c < 4; ++c) if (bz[c] > bv) { bv = bz[c]; bc = c; }
      int bi = 4 * lane + bc; float bs = sc[bc];
      const int myi = bi;
#pragma unroll
      for (int o = 1; o < 64; o <<= 1) {
        const float ov = __shfl_xor(bv, o); const int oi = __shfl_xor(bi, o); const float os = __shfl_xor(bs, o);
        if (ov > bv || (ov == bv && oi < bi)) { bv = ov; bi = oi; bs = os; }
      }
      sel_e[it] = bi; sel_s[it] = bs; gsum += bs;
      if (bi == myi) {
#pragma unroll
        for (int c = 0; c < 4; ++c) if (c == bc) bz[c] = -1e30f;
      }
    }
    const float inv = ROUTED_SCALE / gsum;
    int me = sel_e[0]; float ms = sel_s[0];
#pragma unroll
    for (int it = 1; it < TOP_K; ++it) if (lane == it) { me = sel_e[it]; ms = sel_s[it]; }
    if (lane < TOP_K) {
      const long a = r * TOP_K + lane;
      p.top_e()[a] = me; p.gate()[a] = ms * inv;
      const int pos = atomicAdd(&p.cnt()[l * N_EXPERTS + me], 1);
      p.elist()[(long)me * NR + pos] = (int)a; p.egate()[(long)me * NR + pos] = ms * inv; p.posb()[a] = pos;
    }
  }
}
#endif

#ifndef CPU_TEST
#define XB_TMO      128
#define XB_XCNT(j)  (256  + 64 * (j))
#define XB_XSUB(j)  (1280 + 64 * (j))
#define XB_XGEN(j)  (2304 + 64 * (j))
#define XB_TOP      3328
#define XB_TOPGEN   3392
#define XCD_BAR_WORDS 3456
#define XB_SPIN_CAP (1u << 18)
#define LAS __attribute__((address_space(3)))
__device__ __forceinline__ unsigned xb_ld(unsigned* p)              { return __hip_atomic_load(p, __ATOMIC_RELAXED, __HIP_MEMORY_SCOPE_AGENT); }
__device__ __forceinline__ unsigned xb_add(unsigned* p, unsigned v) { return __hip_atomic_fetch_add(p, v, __ATOMIC_RELAXED, __HIP_MEMORY_SCOPE_AGENT); }
__device__ __forceinline__ unsigned xb_xcc_id() { return (unsigned)__builtin_amdgcn_s_getreg((3 << 11) | 20) & 0xFu; }
#define XB_SPIN(cond, bar) do { unsigned _sp = 0; while (cond) { __builtin_amdgcn_s_sleep(1); \
    if ((++_sp & 255u) == 0u) { if (xb_ld(&(bar)[XB_TMO])) break; if (_sp > XB_SPIN_CAP) { atomicAdd(&(bar)[XB_TMO], 1u); break; } } } } while (0)
struct XcdBarrier { unsigned* bar; unsigned x; volatile LAS unsigned* st; };
__device__ __forceinline__ XcdBarrier xcd_barrier_post(unsigned* bar, volatile LAS unsigned* st) {
    XcdBarrier b; b.bar = bar; b.x = xb_xcc_id(); b.st = st;
    if (threadIdx.x == 0) (void)xb_add(&bar[XB_XCNT(b.x)], 1u);
    return b;
}
__device__ __forceinline__ void xcd_barrier_complete(unsigned* bar, unsigned x, unsigned& nloc, unsigned& nx) {
    const unsigned G = gridDim.x * gridDim.y * gridDim.z;
    unsigned sum, cnt, mine, sp = 0u;
    for (;;) {
        sum = 0u; cnt = 0u; mine = 0u;
#pragma unroll
        for (unsigned j = 0; j < 16; ++j) { const unsigned c = xb_ld(&bar[XB_XCNT(j)]); sum += c; cnt += (c > 0u) ? 1u : 0u; mine = (j == x) ? c : mine; }
        if (sum == G) break;
        __builtin_amdgcn_s_sleep(1);
        if ((++sp & 255u) == 0u) { if (xb_ld(&bar[XB_TMO])) break; if (sp > XB_SPIN_CAP) { atomicAdd(&bar[XB_TMO], 1u); break; } }
    }
    nloc = mine > 0u ? mine : 1u; nx = cnt > 0u ? cnt : 1u;
}
__device__ __forceinline__ void xcd_barrier(const XcdBarrier& b) {
    asm volatile("s_waitcnt vmcnt(0)" ::: "memory");
    __syncthreads();
    if (threadIdx.x == 0) {
        unsigned* bar = b.bar;
        unsigned bx = b.x; asm volatile("" : "+s"(bx));
        __builtin_amdgcn_s_waitcnt(0);
        unsigned nloc = b.st[0], nx = b.st[1];
        if (nloc == 0u) { xcd_barrier_complete(bar, bx, nloc, nx); b.st[0] = nloc; b.st[1] = nx; }
        const unsigned old = xb_add(&bar[XB_XSUB(bx)], 1u);
        const unsigned gen = old / nloc;
        if (old + 1u == (gen + 1u) * nloc) {
            __builtin_amdgcn_fence(__ATOMIC_RELEASE, "agent");
            asm volatile("s_waitcnt vmcnt(0)" ::: "memory");
            const unsigned og = xb_add(&bar[XB_TOP], 1u);
            const unsigned tg = og / nx;
            if (og + 1u == (tg + 1u) * nx) xb_add(&bar[XB_TOPGEN], 1u);
            else XB_SPIN(xb_ld(&bar[XB_TOPGEN]) == tg, bar);
            __builtin_amdgcn_fence(__ATOMIC_ACQUIRE, "agent");
            xb_add(&bar[XB_XGEN(bx)], 1u);
            asm volatile("s_waitcnt vmcnt(0)" ::: "memory");
        } else {
            XB_SPIN(xb_ld(&bar[XB_XGEN(bx)]) == gen, bar);
            __builtin_amdgcn_fence(__ATOMIC_ACQUIRE, "agent");
            asm volatile("s_waitcnt vmcnt(0)" ::: "memory");
        }
    }
    __syncthreads();
}
#define GRID_SYNC() xcd_barrier(xb)
#else
#define GRID_SYNC() do {} while (0)
#endif

#ifndef CPU_TEST
#define GPUSEL(a, b) a
#else
#define GPUSEL(a, b) b
#endif
#ifndef CPU_TEST
#define OPAQUE_S(v) asm volatile("" : "+s"(v))
#define OPAQUE_V(v) asm volatile("" : "+v"(v))
#else
#define OPAQUE_S(v) do {} while (0)
#define OPAQUE_V(v) do {} while (0)
#endif
#ifndef PROBE_MASK
#define PROBE_MASK 0
#endif
#define LPHASE(stmt) do { int l = lo; OPAQUE_S(l); if (SINGLE && ((PROBE_MASK >> (ph - NG - lo * NLP)) & 1)) { long gtid = gtid0; OPAQUE_V(gtid); stmt; GRID_SYNC(); } PHASE(stmt); } while (0)
#define PHASE(stmt) do { if (SINGLE || ph == only) { long gtid = gtid0; OPAQUE_V(gtid); stmt; } if (SINGLE) { GRID_SYNC(); } ++ph; } while (0)
#ifndef CPU_TEST
template <bool SINGLE> __device__ __forceinline__ void run_seq(const P& p, long gtid0, long gsize, int only, const XcdBarrier& xb, char* smem)
#else
template <bool SINGLE> static int run_seq(const P& p, long gtid0, long gsize, int only)
#endif
{
  int ph = 0;
  PHASE(ph_g0(p, gtid, gsize));
  PHASE(ph_g1(p, gtid, gsize));
  PHASE(ph_g2(p, gtid, gsize));
  PHASE(ph_g3(p, gtid, gsize));
  PHASE(ph_g4(p, gtid, gsize));
#pragma unroll 1
  for (int lo = 0; lo < DEPTH; ++lo) {
    LPHASE(ph_modu(p, l, 0, gtid, gsize));
    LPHASE(GPUSEL(ph_proj_mfma(p, l, smem), ph_proj(p, l, gtid, gsize)));
    LPHASE(ph_post_proj(p, l, gtid, gsize));
    LPHASE(ph_mix(p, l, gtid, gsize); GPUSEL((ph_attn_mfma(p, l, smem), ph_hyena_mfma(p, l, smem)), (void)0));
    LPHASE(ph_s5out(p, l, gtid, gsize));
    LPHASE(GPUSEL(ph_glu_mfma(p, l, smem), ph_glu(p, l, gtid, gsize)));
    LPHASE(ph_rms(p, l, gtid, gsize));
    LPHASE(GPUSEL(ph_outproj_mfma(p, l, smem), ph_outproj(p, l, gtid, gsize)));
    LPHASE(ph_ln(p, l, 0, gtid, gsize));
    LPHASE(ph_router(p, l, gtid, gsize));
    LPHASE(ph_select(p, l, gtid, gsize));
    LPHASE(ph_sortrows(p, l, gtid, gsize));
    LPHASE(GPUSEL(ph_expert_up_mfma(p, l, smem), ph_expert_up(p, l, gtid, gsize)));
    LPHASE(GPUSEL(ph_expert_down_mfma(p, l, smem), ph_expert_down(p, l, gtid, gsize)));
    LPHASE(ph_combine(p, l, gtid, gsize));
    LPHASE(ph_ln(p, l, 1, gtid, gsize));
  }
#ifdef CPU_TEST
  return ph;
#endif
}


#ifndef CPU_TEST
#define NG_GPU 4
#define NLP_GPU 12
#ifndef PROBE_MASK_G
#define PROBE_MASK_G 0
#endif
#define GPHASE(stmt) do { if (SINGLE || ph == only) { long gtid = (long)blockIdx.x * NT + otid(); stmt; } if (SINGLE) { GRID_SYNC(); } ++ph; } while (0)
#define GLPHASE(stmt) do { int l = lo; OPAQUE_S(l); if (SINGLE && ((PROBE_MASK_G >> (ph - NG_GPU - lo * NLP_GPU)) & 1)) { long gtid = (long)blockIdx.x * NT + otid(); stmt; GRID_SYNC(); } GPHASE(stmt); } while (0)
template <bool SINGLE> __device__ __forceinline__ void run_seq_gpu(const P& p, long gtid0, long gsize, int only, const XcdBarrier& xb, char* smem) {
  int ph = 0;
#ifdef PROBE_INIT
  if (SINGLE) { long gtid = (long)blockIdx.x * NT + otid(); ph_g0(p, gtid, gsize); GRID_SYNC(); ph_g1(p, gtid, gsize); ph_modsum_gpu(p, gtid, gsize); ph_s5tables_gpu(p, gtid, gsize); GRID_SYNC(); ph_g2(p, gtid, gsize); ph_modu0_gpu(p, gtid, gsize); GRID_SYNC(); ph_g3(p, gtid, gsize); GRID_SYNC(); ph_g4(p, gtid, gsize); GRID_SYNC(); }
#endif
  GPHASE(ph_g0(p, gtid, gsize); s5_lampow_gpu(p, gtid, gsize); rope_table_gpu(p, gtid, gsize));
  GPHASE(ph_g1(p, gtid, gsize); ph_modsum_gpu(p, gtid, gsize); ph_s5tables_gpu(p, gtid, gsize); wt_convert_all(p, gtid, gsize));
  GPHASE(ph_g2(p, gtid, gsize); ph_modu0_gpu(p, gtid, gsize); ph_kcb_gpu(p, gtid, gsize));
  GPHASE(ph_g3(p, gtid, gsize));
#pragma unroll 1
  for (int lo = 0; lo < DEPTH; ++lo) {
    GLPHASE(if (l == 0) ph_g4(p, gtid, gsize); ph_proj_mfma(p, l, smem));
    GLPHASE(ph_s5_sgemm(p, l, smem); ph_hyena_pre_gpu(p, l, gtid, gsize));
    GLPHASE(ph_mix(p, l, gtid, gsize); ph_s5_carry_gpu(p, l, smem); ph_attn_mfma(p, l, smem); ph_hyena_mfma(p, l, smem));
    GLPHASE(ph_s5_ygemm(p, l, smem));
    GLPHASE(ph_glu_mfma(p, l, smem));
    GLPHASE(ph_outproj_mfma(p, l, smem));
    GLPHASE(ph_ln1_gpu(p, l));
    GLPHASE(ph_router_mfma(p, l, smem));
    GLPHASE(ph_select_gpu(p, l));
#ifdef UPVAR
    if (SINGLE) { int l = lo; OPAQUE_S(l); ph_expert_up_mfma<UPVAR>(p, l, smem); GRID_SYNC(); }
#endif
    GLPHASE(ph_expert_up_mfma(p, l, smem));
    GLPHASE(ph_expert_down_mfma(p, l, smem));
    GLPHASE(ph_ln2_gpu(p, l, smem));
  }
}
#endif

static void carve(P& p, void* ws) { p.ws = (char*)ws; }
static void set_inputs(P& p, void* const* d_in) {
  const float** f = (const float**)&p.x;
  for (int i = 0; i < 40; ++i) f[i] = (const float*)d_in[i];
}

#ifndef CPU_TEST
#ifndef MK_SINGLE
#define MK_SINGLE 1
#endif
extern __shared__ __attribute__((aligned(16))) char dyn_smem[];
__global__ void __launch_bounds__(NT, 2) mk_single(P p) {
  uint4* xbw = (uint4*)(dyn_smem + SM_XB);
  if (threadIdx.x == 0) *xbw = make_uint4(0u, 0u, 0u, 0u);
  __syncthreads();
  XcdBarrier xb = xcd_barrier_post(p.bar(), (volatile LAS unsigned*)xbw);
  run_seq_gpu<true>(p, (long)blockIdx.x * blockDim.x + threadIdx.x, (long)gridDim.x * blockDim.x, -1, xb, dyn_smem);
}
__global__ void __launch_bounds__(NT, 2) mk_phase(P p, int only) {
  XcdBarrier xb; xb.bar = p.bar(); xb.x = 0; xb.st = nullptr;
#ifdef DBG_ONLY
  only = DBG_ONLY;
#endif
  run_seq_gpu<false>(p, (long)blockIdx.x * blockDim.x + threadIdx.x, (long)gridDim.x * blockDim.x, only, xb, dyn_smem);
}
extern "C" void kernel_launch(void* const* d_in, const int* in_sizes, int n_in, void* d_out, int out_size, void* d_ws, size_t ws_size, hipStream_t stream) {
  P p; memset(&p, 0, sizeof(p));
  set_inputs(p, d_in); p.out = (float*)d_out; carve(p, d_ws);
  (void)hipMemsetAsync(p.bar(), 0, 4096 * sizeof(unsigned) + ((DEPTH * N_EXPERTS * sizeof(int) + 255) / 256) * 256, stream);
#if MK_SINGLE
  static int grid = 0;
  if (!grid) {
    int dev = 0, cus = 0, per_cu = 0; (void)hipGetDevice(&dev);
    (void)hipDeviceGetAttribute(&cus, hipDeviceAttributeMultiprocessorCount, dev);
    (void)hipFuncSetAttribute((const void*)mk_single, hipFuncAttributeMaxDynamicSharedMemorySize, SMEM_BYTES);
    (void)hipOccupancyMaxActiveBlocksPerMultiprocessor(&per_cu, mk_single, NT, SMEM_BYTES);
    grid = cus * (per_cu < 1 ? per_cu : 1);
  }
  mk_single<<<grid, NT, SMEM_BYTES, stream>>>(p);
#else
  for (int ph = 0; ph < NG_GPU + DEPTH * NLP_GPU; ++ph) mk_phase<<<256, NT, SMEM_BYTES, stream>>>(p, ph);
#endif
}
#endif
```

```cpp
#ifndef CPU_TEST
#include <hip/hip_runtime.h>
#include <cstring>
#define DEV __device__ __forceinline__
#define DEVM __device__ __forceinline__
#define HDM __host__ __device__ __forceinline__
#else
#include <cmath>
#include <cstdio>
#include <cstdlib>
#include <cstring>
#define DEV static inline
#define DEVM inline
#define HDM inline
struct float2 { float x, y; };
static inline float2 make_float2(float a, float b) { float2 r; r.x = a; r.y = b; return r; }
static inline int atomicAdd(int* p, int v) { int o = *p; *p += v; return o; }
#endif

#ifdef SMALL_CFG
#define D_MODEL 64
#define BATCH 2
#define SEQ 256
#define GRID_W 16
#define CTX_LEN 32
#define HEAD_DIM 16
#define N_Q_HEADS 4
#define N_KV_HEADS 2
#define HYENA_W 16
#define S5_W 32
#define WINDOW 32
#define FILTER_HIDDEN 16
#define S5_STATE 8
#define N_EXPERTS 32
#define TOP_K 4
#define EXPERT_FF 16
#define SHARED_FF 16
#define S5_T 32
#else
#define D_MODEL 1024
#define BATCH 2
#define SEQ 8192
#define GRID_W 64
#define CTX_LEN 256
#define HEAD_DIM 64
#define N_Q_HEADS 8
#define N_KV_HEADS 2
#define HYENA_W 256
#define S5_W 256
#define WINDOW 128
#define FILTER_HIDDEN 64
#define S5_STATE 64
#define N_EXPERTS 256
#define TOP_K 8
#define EXPERT_FF 256
#define SHARED_FF 256
#define S5_T 64
#endif
#define DEPTH 2
#define FILTER_EMB 33
#define N_EXPERT_GROUPS 8
#define TOPK_GROUPS 4
#define S5_GROUP 16
#define Q_GROUP (N_Q_HEADS / N_KV_HEADS)
#define ATTN_W (N_Q_HEADS * HEAD_DIM)
#define KV_W (N_KV_HEADS * HEAD_DIM)
#define MIX_W (ATTN_W + HYENA_W + S5_W)
#define Q_OFF 0
#define K_OFF ATTN_W
#define V_OFF (K_OFF + KV_W)
#define HY_OFF (V_OFF + KV_W)
#define S5_OFF (HY_OFF + 3 * HYENA_W)
#define IN_W (S5_OFF + S5_W)
#define AXIS_DIM (HEAD_DIM / 2)
#define ROPE_HALF (AXIS_DIM / 2)
#define S5_GROUPS (S5_W / S5_GROUP)
#define EPG (N_EXPERTS / N_EXPERT_GROUPS)
#define NL (BATCH * SEQ)
#define NC (BATCH * CTX_LEN)
#define NR (NL + NC)
#define NSEQ (CTX_LEN + SEQ)
#define NCH (NSEQ / S5_T)
#define LN_EPS 1e-5f
#define DN_ALPHA 1.4142135623730951f
#define ROUTED_SCALE 2.5f
#define PI_D 3.14159265358979323846

#define WS_LIST(X) \
  X(unsigned, bar, 4096) \
  X(int, cnt, DEPTH * N_EXPERTS) \
  X(float, mod, (size_t)DEPTH * (BATCH + 1) * 6 * D_MODEL) \
  X(float, xcur, (size_t)NR * D_MODEL) \
  X(float, ubuf, (size_t)NR * D_MODEL) \
  X(float, proj, (size_t)NR * IN_W) \
  X(float, hu, (size_t)NR * HYENA_W) \
  X(float, hx0, (size_t)NR * HYENA_W) \
  X(float, fh1, (size_t)DEPTH * SEQ * FILTER_HIDDEN) \
  X(float, fh2, (size_t)DEPTH * SEQ * FILTER_HIDDEN) \
  X(float, kraw, (size_t)DEPTH * SEQ * 2 * HYENA_W) \
  X(float, knorm, (size_t)DEPTH * HYENA_W) \
  X(float, fh1c, (size_t)CTX_LEN * FILTER_HIDDEN) \
  X(float, fh2c, (size_t)CTX_LEN * FILTER_HIDDEN) \
  X(float, krawc, (size_t)CTX_LEN * 2 * HYENA_W) \
  X(float, knormc, (size_t)HYENA_W) \
  X(float, mixb, (size_t)NR * MIX_W) \
  X(float, tmp, (size_t)NR * D_MODEL) \
  X(float2, lampow, (size_t)DEPTH * 2 * S5_GROUPS * (S5_T + 1) * S5_STATE) \
  X(float2, bbar, (size_t)DEPTH * 2 * S5_GROUPS * S5_STATE * S5_GROUP) \
  X(float, kc, (size_t)DEPTH * 2 * S5_GROUPS * S5_T * S5_GROUP * S5_GROUP) \
  X(float2, sc, (size_t)BATCH * 2 * S5_GROUPS * NCH * S5_STATE) \
  X(float2, hc, (size_t)BATCH * 2 * S5_GROUPS * NCH * S5_STATE) \
  X(float, ybuf, (size_t)NR * S5_W) \
  X(float, rl, (size_t)NR * N_EXPERTS) \
  X(int, top_e, (size_t)NR * TOP_K) \
  X(float, gate, (size_t)NR * TOP_K) \
  X(int, posb, (size_t)NR * TOP_K) \
  X(int, srow, (size_t)NR * TOP_K) \
  X(float, hbuf, (size_t)NR * TOP_K * EXPERT_FF) \
  X(float, hsb, (size_t)NR * SHARED_FF) \
  X(float, yk, (size_t)NR * TOP_K * D_MODEL) \
  X(float, ysh, (size_t)NR * D_MODEL) \
  X(unsigned short, ykb, (size_t)NR * TOP_K * D_MODEL) \
  X(unsigned short, qkvb, (size_t)NR * HY_OFF) \
  X(float2, ropet, (size_t)128 * ROPE_HALF) \
  X(unsigned short, bmtb, (size_t)DEPTH * 2 * S5_GROUPS * 128 * 1024) \
  X(unsigned short, cmtb, (size_t)DEPTH * 2 * S5_GROUPS * 1024 * 128) \
  X(unsigned short, kcb, (size_t)DEPTH * 2 * S5_GROUPS * S5_T * 256) \
  X(unsigned short, wt_in, (size_t)DEPTH * IN_W * D_MODEL) \
  X(unsigned short, wt_out, (size_t)DEPTH * D_MODEL * MIX_W) \
  X(unsigned short, wt_glu, (size_t)DEPTH * S5_W * S5_W) \
  X(unsigned short, wt_shg, (size_t)DEPTH * SHARED_FF * D_MODEL) \
  X(unsigned short, wt_shu, (size_t)DEPTH * SHARED_FF * D_MODEL) \
  X(unsigned short, wt_shd, (size_t)DEPTH * D_MODEL * SHARED_FF) \
  X(unsigned short, wt_rh, (size_t)DEPTH * N_EXPERTS * D_MODEL) \
  X(unsigned short, wt_rl, (size_t)DEPTH * N_EXPERTS * D_MODEL) \
  X(unsigned short, ubf, (size_t)NR * D_MODEL) \
  X(unsigned short, ybf, (size_t)NR * S5_W) \
  X(unsigned short, mixbf, (size_t)NR * MIX_W) \
  X(unsigned short, hbf, (size_t)NR * TOP_K * EXPERT_FF) \
  X(unsigned short, hsbf, (size_t)NR * SHARED_FF) \
  X(unsigned short, ubl, (size_t)NR * D_MODEL) \
  X(int, elist, (size_t)N_EXPERTS * NR) \
  X(float, egate, (size_t)N_EXPERTS * NR) \
  X(unsigned short, s5u, (size_t)NR * S5_W) \
  X(float, bmt, (size_t)DEPTH * 2 * S5_GROUPS * 16 * S5_T * 2 * S5_STATE) \
  X(float, cmt, (size_t)DEPTH * 2 * S5_GROUPS * 16 * S5_T * 2 * S5_STATE) \
  X(unsigned short, hcbf, (size_t)BATCH * 2 * S5_GROUPS * NCH * 2 * S5_STATE) \
  X(float, zT, (size_t)BATCH * 3 * HYENA_W * (SEQ + CTX_LEN)) \
  X(float, modp, (size_t)DEPTH * 16 * (BATCH + 1) * 6 * D_MODEL) \
  X(float, wrlo, (size_t)DEPTH * D_MODEL * N_EXPERTS) \

struct WsOff {
#define X(T, name, n) size_t name;
  WS_LIST(X)
#undef X
  size_t total;
};
constexpr WsOff ws_offsets() {
  WsOff o{}; size_t off = 0;
#define X(T, name, n) o.name = off; off += (((size_t)(n)) * sizeof(T) + 255) / 256 * 256;
  WS_LIST(X)
#undef X
  o.total = off; return o;
}
constexpr WsOff WSO = ws_offsets();
struct P {
  const float *x, *c, *ctx, *c_ctx, *w_ada, *b_ada, *w_in, *w_out, *sink, *mix_g, *hy_short_w, *hy_short_b, *hy_w1,
      *hy_b1, *hy_freq, *hy_w2, *hy_b2, *hy_w3, *hy_d, *s5_a_re, *s5_a_im, *s5_log_dt, *s5_b_re, *s5_b_im, *s5_c_re,
      *s5_c_im, *s5_d, *s5_w_glu, *ln1_g, *ln1_b, *ln2_g, *ln2_b, *w_router, *router_bias, *w_exp_gate, *w_exp_up,
      *w_exp_down, *w_sh_gate, *w_sh_up, *w_sh_down;
  float* out;
  char* ws;
#define X(T, name, n) HDM T* name() const { return (T*)(ws + WSO.name); }
  WS_LIST(X)
#undef X
};

#define FOR_ITEMS(i, N) for (long i = gtid; i < (long)(N); i += gsize)
#ifndef CPU_TEST
#define FOR_ITEMS4(i, N) _Pragma("unroll 4") for (long i = gtid; i < (long)(N); i += gsize)
#else
#define FOR_ITEMS4(i, N) FOR_ITEMS(i, N)
#endif

DEV unsigned short f2bf16(float f) { unsigned u; memcpy(&u, &f, 4); return (unsigned short)((u + 0x7fffu + ((u >> 16) & 1u)) >> 16); }
DEV float siluf(float x) { return x / (1.0f + expf(-x)); }
DEV float sigmoidf_(float x) { return 1.0f / (1.0f + expf(-x)); }
#ifndef CPU_TEST
DEV float rl_f(float v, int srcl) { return __int_as_float(__builtin_amdgcn_readlane(__float_as_int(v), srcl)); }
DEV float siluq(float x) { return x * __builtin_amdgcn_rcpf(1.0f + __builtin_amdgcn_exp2f(-1.4426950408889634f * x)); }
#endif
DEV float gelu_tanhf(float x) { return 0.5f * x * (1.0f + tanhf(0.7978845608028654f * (x + 0.044715f * x * x * x))); }
DEV int modrow(long r) { return r < NL ? (int)(r / SEQ) : BATCH; }

DEV void ph_g0(const P& p, long gtid, long gsize) {
#ifndef CPU_TEST
  FOR_ITEMS4(i4, (long)NR * D_MODEL / 4) { const long i = i4 * 4; *(float4*)(p.xcur() + i) = i < (long)NL * D_MODEL ? *(const float4*)(p.x + i) : *(const float4*)(p.ctx + (i - (long)NL * D_MODEL)); }
#else
  FOR_ITEMS(i, (long)NR * D_MODEL) p.xcur()[i] = i < (long)NL * D_MODEL ? p.x[i] : p.ctx[i - (long)NL * D_MODEL];
#endif
#ifdef CPU_TEST
  FOR_ITEMS(i, DEPTH * (BATCH + 1) * 6 * D_MODEL) {
    int n = (int)(i % (6 * D_MODEL)); int j = (int)((i / (6 * D_MODEL)) % (BATCH + 1)); int l = (int)(i / (6 * D_MODEL * (BATCH + 1)));
    const float* cv = j < BATCH ? p.c + j * D_MODEL : p.c_ctx;
    const float* w = p.w_ada + (long)l * D_MODEL * 6 * D_MODEL;
    float acc = p.b_ada[l * 6 * D_MODEL + n];
    for (int k = 0; k < D_MODEL; ++k) acc += siluf(cv[k]) * w[(long)k * 6 * D_MODEL + n];
    p.mod()[i] = acc;
  }
#else
  FOR_ITEMS(i, (long)DEPTH * 16 * 6 * D_MODEL) {
    const int n = (int)(i % (6 * D_MODEL)); const int slab = (int)((i / (6 * D_MODEL)) % 16); const int l = (int)(i / (6 * D_MODEL * 16));
    const float* w = p.w_ada + ((long)l * D_MODEL + slab * 64) * 6 * D_MODEL + n;
    float a0 = 0.f, a1 = 0.f, a2 = 0.f;
    const int kl = slab * 64 + (int)(gtid & 63);
    const float s0 = siluf(p.c[kl]), s1 = siluf(p.c[D_MODEL + kl]), s2 = siluf(p.c_ctx[kl]);
#pragma unroll
    for (int k = 0; k < 64; ++k) {
      const float wv = w[(long)k * 6 * D_MODEL];
      a0 += rl_f(s0, k) * wv; a1 += rl_f(s1, k) * wv; a2 += rl_f(s2, k) * wv;
    }
    float* dst = p.modp() + ((long)(l * 16 + slab) * (BATCH + 1)) * 6 * D_MODEL + n;
    dst[0] = a0; dst[6 * D_MODEL] = a1; dst[2 * 6 * D_MODEL] = a2;
  }
#endif
  FOR_ITEMS(i, DEPTH * 2 * S5_GROUPS * S5_STATE) {
    int pp = (int)(i % S5_STATE); int g = (int)((i / S5_STATE) % S5_GROUPS); int ld = (int)(i / (S5_STATE * S5_GROUPS));
    float are = fminf(p.s5_a_re[i], -1e-4f), aim = p.s5_a_im[i];
    float dt = expf(p.s5_log_dt[ld * S5_GROUPS + g]);
#ifdef CPU_TEST
    for (int d = 0; d <= S5_T; ++d) {
      float mag = expf(are * dt * d); float ang = aim * dt * d;
      p.lampow()[((long)(ld * S5_GROUPS + g) * (S5_T + 1) + d) * S5_STATE + pp] = make_float2(mag * cosf(ang), mag * sinf(ang));
    }
#endif
    float mag = expf(are * dt), ang = aim * dt;
    float lr = mag * cosf(ang) - 1.0f, li = mag * sinf(ang);
    float den = are * are + aim * aim;
    float fr = (lr * are + li * aim) / den, fi = (li * are - lr * aim) / den;
    for (int j = 0; j < S5_GROUP; ++j) {
      float br = p.s5_b_re[i * S5_GROUP + j], bi = p.s5_b_im[i * S5_GROUP + j];
      p.bbar()[i * S5_GROUP + j] = make_float2(fr * br - fi * bi, fr * bi + fi * br);
    }
  }
}
#ifndef CPU_TEST
DEV void rope_table_gpu(const P& p, long gtid, long gsize) {
  FOR_ITEMS(i, (long)128 * ROPE_HALF) {
    const int ii = (int)(i % ROPE_HALF), pos = (int)(i / ROPE_HALF);
    const float ang = (float)pos * powf(10000.0f, -(float)(2 * ii) / (float)AXIS_DIM);
    p.ropet()[i] = make_float2(cosf(ang), sinf(ang));
  }
}
DEV void s5_lampow_gpu(const P& p, long gtid, long gsize) {
  FOR_ITEMS4(i, (long)DEPTH * 2 * S5_GROUPS * (S5_T + 1) * S5_STATE) {
    const int pp = (int)(i % S5_STATE); const int d = (int)((i / S5_STATE) % (S5_T + 1)); const long ldg = i / ((long)S5_STATE * (S5_T + 1));
    const long src = ldg * S5_STATE + pp;
    const float are = fminf(p.s5_a_re[src], -1e-4f), aim = p.s5_a_im[src]; const float dt = expf(p.s5_log_dt[ldg]);
    const float mag = expf(are * dt * d); const float ang = aim * dt * d;
    p.lampow()[i] = make_float2(mag * cosf(ang), mag * sinf(ang));
  }
}
#endif
DEV void hy_f1(const P& p, int l, int Lf, float* h1, long gtid, long gsize) {
  FOR_ITEMS(i, (long)Lf * FILTER_HIDDEN) {
    int j = (int)(i % FILTER_HIDDEN); int t = (int)(i / FILTER_HIDDEN);
    const float* w1 = p.hy_w1 + l * FILTER_EMB * FILTER_HIDDEN;
    float tt = (float)((double)t / (double)(Lf - 1));
    float w = (float)(2.0 * PI_D * (double)t / (double)Lf);
    float acc = p.hy_b1[l * FILTER_HIDDEN + j] + tt * w1[j];
    const int bands = (FILTER_EMB - 1) / 2;
    for (int m = 0; m < bands; ++m) {
      float f = (float)(1e-4 + (double)m * ((double)(bands - 1) - 1e-4) / (double)(bands - 1));
      float a = f * w;
      acc += cosf(a) * w1[(1 + m) * FILTER_HIDDEN + j] - sinf(a) * w1[(1 + bands + m) * FILTER_HIDDEN + j];
    }
    h1[i] = sinf(p.hy_freq[l * FILTER_HIDDEN + j] * acc);
  }
}
DEV void hy_f2(const P& p, int l, int Lf, const float* h1, float* h2, long gtid, long gsize) {
  FOR_ITEMS(i, (long)Lf * FILTER_HIDDEN) {
    int j = (int)(i % FILTER_HIDDEN); int t = (int)(i / FILTER_HIDDEN);
    const float* w2 = p.hy_w2 + l * FILTER_HIDDEN * FILTER_HIDDEN;
    float acc = p.hy_b2[l * FILTER_HIDDEN + j];
    for (int k = 0; k < FILTER_HIDDEN; ++k) acc += h1[t * FILTER_HIDDEN + k] * w2[k * FILTER_HIDDEN + j];
#ifndef CPU_TEST
    h2[(long)j * Lf + t] = sinf(p.hy_freq[l * FILTER_HIDDEN + j] * acc);
#else
    h2[i] = sinf(p.hy_freq[l * FILTER_HIDDEN + j] * acc);
#endif
  }
}
DEV void hy_f3(const P& p, int l, int Lf, const float* h2, float* kraw, long gtid, long gsize) {
#ifndef CPU_TEST
  const float* w3 = p.hy_w3 + l * FILTER_HIDDEN * 2 * HYENA_W;
  FOR_ITEMS(i, (long)Lf * (2 * HYENA_W / 8)) {
    const int t = (int)(i % Lf); const int c8 = (int)(i / Lf) * 8;
    float acc[8];
#pragma unroll
    for (int j = 0; j < 8; ++j) acc[j] = 0.f;
#pragma unroll 4
    for (int k = 0; k < FILTER_HIDDEN; ++k) {
      const float hv = h2[(long)k * Lf + t];
      const float4 wa = *(const float4*)(w3 + k * 2 * HYENA_W + c8), wb = *(const float4*)(w3 + k * 2 * HYENA_W + c8 + 4);
      acc[0] += hv * wa.x; acc[1] += hv * wa.y; acc[2] += hv * wa.z; acc[3] += hv * wa.w; acc[4] += hv * wb.x; acc[5] += hv * wb.y; acc[6] += hv * wb.z; acc[7] += hv * wb.w;
    }
    const double d0 = log(1e-2) / 0.3, d1 = log(1e-2) / 1.5;
    const float tt = (float)((double)t / (double)(Lf - 1));
#pragma unroll
    for (int j = 0; j < 8; ++j) {
      const int ch = (c8 + j) % HYENA_W;
      const float delta = fabsf((float)(d0 + (d1 - d0) * (double)ch / (double)(HYENA_W - 1)));
      kraw[(long)(c8 + j) * Lf + t] = acc[j] * expf(-tt * delta);
    }
  }
#else
  FOR_ITEMS(i, (long)Lf * 2 * HYENA_W) {
    int t = (int)(i % Lf); int cc = (int)(i / Lf); int ch = cc % HYENA_W;
    const float* w3 = p.hy_w3 + l * FILTER_HIDDEN * 2 * HYENA_W;
    float acc = 0.f;
    for (int k = 0; k < FILTER_HIDDEN; ++k) acc += h2[t * FILTER_HIDDEN + k] * w3[k * 2 * HYENA_W + cc];
    double d0 = log(1e-2) / 0.3, d1 = log(1e-2) / 1.5;
    float delta = fabsf((float)(d0 + (d1 - d0) * (double)ch / (double)(HYENA_W - 1)));
    float tt = (float)((double)t / (double)(Lf - 1));
    kraw[(long)cc * Lf + t] = acc * expf(-tt * delta);
  }
#endif
}
DEV void hy_f4(int Lf, const float* kraw, float* knorm, long gtid, long gsize) {
#ifndef CPU_TEST
  const int lane = (int)(gtid & 63); const long gw = gtid >> 6, nw = gsize >> 6;
  for (long i = gw; i < HYENA_W; i += nw) {
    float s = 0.f;
    for (int t = lane; t < Lf; t += 64) { s += fabsf(kraw[i * Lf + t]); if (t > 0) s += fabsf(kraw[(HYENA_W + i) * Lf + t]); }
    for (int o = 32; o > 0; o >>= 1) s += __shfl_xor(s, o);
    if (lane == 0) knorm[i] = 1.0f / s;
  }
#else
  FOR_ITEMS(i, HYENA_W) {
    float s = 0.f;
    for (int t = 0; t < Lf; ++t) {
      s += fabsf(kraw[(long)i * Lf + t]);
      if (t > 0) s += fabsf(kraw[(long)(HYENA_W + i) * Lf + t]);
    }
    knorm[i] = 1.0f / s;
  }
#endif
}
#ifndef CPU_TEST
DEV void hy_f1g(const P& p, int l, int Lf, float* h1, long gtid, long gsize) {
  const int lane = (int)(gtid & 63);
  const float* w1 = p.hy_w1 + l * FILTER_EMB * FILTER_HIDDEN;
  const int bands = (FILTER_EMB - 1) / 2;
  static_assert(FILTER_HIDDEN == 64 && (FILTER_EMB - 1) / 2 == 16, "filter shape");
  FOR_ITEMS(i, (long)Lf * FILTER_HIDDEN) {
    const int j = lane; const int t = (int)(i / FILTER_HIDDEN);
    const float tt = (float)((double)t / (double)(Lf - 1));
    const float w = (float)(2.0 * PI_D * (double)t / (double)Lf);
    const int mm = lane & 15;
    const float f = (float)(1e-4 + (double)mm * ((double)(bands - 1) - 1e-4) / (double)(bands - 1));
    const float a = f * w; const float ca = cosf(a), sa = sinf(a);
    float acc = p.hy_b1[l * FILTER_HIDDEN + j] + tt * w1[j];
#pragma unroll
    for (int m = 0; m < 16; ++m) acc += rl_f(ca, m) * w1[(1 + m) * FILTER_HIDDEN + j] - rl_f(sa, m) * w1[(1 + bands + m) * FILTER_HIDDEN + j];
    h1[i] = sinf(p.hy_freq[l * FILTER_HIDDEN + j] * acc);
  }
}
DEV void hy_f2g(const P& p, long gtid, long gsize) {
  const long n_main = (long)DEPTH * 8 * SEQ, n_all = n_main + 8 * CTX_LEN;
  FOR_ITEMS(i, n_all) {
    const bool isc = __builtin_amdgcn_readfirstlane((int)(i >= n_main)) != 0;
    const long ii = isc ? i - n_main : i; const int Lf = isc ? CTX_LEN : SEQ;
    const int t = (int)(ii % Lf); const int gq = __builtin_amdgcn_readfirstlane((int)(ii / Lf)); const int j8 = (gq & 7) * 8, l = isc ? 0 : (gq >> 3);
    const float* h1 = isc ? p.fh1c() : p.fh1() + (long)l * SEQ * FILTER_HIDDEN; float* h2 = isc ? p.fh2c() : p.fh2() + (long)l * SEQ * FILTER_HIDDEN;
    const float* w2 = p.hy_w2 + l * FILTER_HIDDEN * FILTER_HIDDEN + j8;
    const float4* hr = (const float4*)(h1 + (long)t * FILTER_HIDDEN);
    float acc[8];
#pragma unroll
    for (int jj = 0; jj < 8; ++jj) acc[jj] = p.hy_b2[l * FILTER_HIDDEN + j8 + jj];
#pragma unroll 4
    for (int k4 = 0; k4 < FILTER_HIDDEN / 4; ++k4) {
      const float4 h = hr[k4]; const float hv[4] = {h.x, h.y, h.z, h.w};
#pragma unroll
      for (int e = 0; e < 4; ++e) {
        const float4 wa = *(const float4*)(w2 + (4 * k4 + e) * FILTER_HIDDEN), wb = *(const float4*)(w2 + (4 * k4 + e) * FILTER_HIDDEN + 4);
        acc[0] += hv[e] * wa.x; acc[1] += hv[e] * wa.y; acc[2] += hv[e] * wa.z; acc[3] += hv[e] * wa.w; acc[4] += hv[e] * wb.x; acc[5] += hv[e] * wb.y; acc[6] += hv[e] * wb.z; acc[7] += hv[e] * wb.w;
      }
    }
#pragma unroll
    for (int jj = 0; jj < 8; ++jj) h2[(long)(j8 + jj) * Lf + t] = sinf(p.hy_freq[l * FILTER_HIDDEN + j8 + jj] * acc[jj]);
  }
}
DEV void hy_f3g(const P& p, int l, int Lf, const float* h2, float* kraw, float* psum, long gtid, long gsize) {
  const float* w3 = p.hy_w3 + l * FILTER_HIDDEN * 2 * HYENA_W;
  const int nblk = Lf >> 8; const int lane = (int)(gtid & 63);
  FOR_ITEMS(i, (long)(2 * HYENA_W / 8) * nblk * 64) {
    const int wi = __builtin_amdgcn_readfirstlane((int)(i >> 6));
    const int c8 = (wi / nblk) * 8, tb = wi % nblk, t0 = tb * 256 + lane;
    float acc[4][8];
#pragma unroll
    for (int q = 0; q < 4; ++q)
#pragma unroll
      for (int j = 0; j < 8; ++j) acc[q][j] = 0.f;
#pragma unroll 4
    for (int k = 0; k < FILTER_HIDDEN; ++k) {
      const float4 wa = *(const float4*)(w3 + k * 2 * HYENA_W + c8), wb = *(const float4*)(w3 + k * 2 * HYENA_W + c8 + 4);
#pragma unroll
      for (int q = 0; q < 4; ++q) {
        const float hv = h2[(long)k * Lf + t0 + 64 * q];
        acc[q][0] += hv * wa.x; acc[q][1] += hv * wa.y; acc[q][2] += hv * wa.z; acc[q][3] += hv * wa.w; acc[q][4] += hv * wb.x; acc[q][5] += hv * wb.y; acc[q][6] += hv * wb.z; acc[q][7] += hv * wb.w;
      }
    }
    const double d0 = log(1e-2) / 0.3, d1 = log(1e-2) / 1.5;
    float ps[8];
#pragma unroll
    for (int j = 0; j < 8; ++j) ps[j] = 0.f;
#pragma unroll
    for (int j = 0; j < 8; ++j) {
      const int ch = (c8 + j) % HYENA_W;
      const float delta = fabsf((float)(d0 + (d1 - d0) * (double)ch / (double)(HYENA_W - 1)));
#pragma unroll
      for (int q = 0; q < 4; ++q) {
        const int t = t0 + 64 * q; const float tt = (float)((double)t / (double)(Lf - 1));
        const float v = acc[q][j] * expf(-tt * delta);
        kraw[(long)(c8 + j) * Lf + t] = v;
        ps[j] += (c8 >= HYENA_W && t == 0) ? 0.f : fabsf(v);
      }
    }
#pragma unroll
    for (int j = 0; j < 8; ++j) {
      float v = ps[j];
#pragma unroll
      for (int o = 32; o > 0; o >>= 1) v += __shfl_xor(v, o);
      if (lane == 0) psum[(long)(c8 + j) * nblk + tb] = v;
    }
  }
}
DEV void hy_f4g(int Lf, const float* psum, float* knorm, long gtid, long gsize) {
  const int lane = (int)(gtid & 63); const long gw = gtid >> 6, nw = gsize >> 6; const int nblk = Lf >> 8;
  for (long i = gw; i < HYENA_W; i += nw) {
    float s = 0.f;
    for (int q = lane; q < nblk; q += 64) s += psum[i * nblk + q] + psum[(HYENA_W + i) * nblk + q];
#pragma unroll
    for (int o = 32; o > 0; o >>= 1) s += __shfl_xor(s, o);
    if (lane == 0) knorm[i] = 1.0f / s;
  }
}
#define HY_PSUM(f) (p.tmp() + (long)(f) * 2 * HYENA_W * (SEQ >> 8))
#endif
DEV void ph_g1(const P& p, long gtid, long gsize) {
#ifndef CPU_TEST
  for (int l = 0; l < DEPTH; ++l) hy_f1g(p, l, SEQ, p.fh1() + (long)l * SEQ * FILTER_HIDDEN, gtid, gsize);
  hy_f1g(p, 0, CTX_LEN, p.fh1c(), gtid, gsize);
#else
  for (int l = 0; l < DEPTH; ++l) hy_f1(p, l, SEQ, p.fh1() + (long)l * SEQ * FILTER_HIDDEN, gtid, gsize);
  hy_f1(p, 0, CTX_LEN, p.fh1c(), gtid, gsize);
#endif
  FOR_ITEMS(i, (long)DEPTH * 2 * S5_GROUPS * S5_T * S5_GROUP * S5_GROUP) {
    int j = (int)(i % S5_GROUP); int ii = (int)((i / S5_GROUP) % S5_GROUP); int d = (int)((i / (S5_GROUP * S5_GROUP)) % S5_T);
    long ldg = i / (S5_GROUP * S5_GROUP * S5_T);
    float acc = 0.f;
    for (int pp = 0; pp < S5_STATE; ++pp) {
      float cr = p.s5_c_re[(ldg * S5_GROUP + ii) * S5_STATE + pp], ci = p.s5_c_im[(ldg * S5_GROUP + ii) * S5_STATE + pp];
      float2 lp = p.lampow()[(ldg * (S5_T + 1) + d) * S5_STATE + pp];
      float2 bb = p.bbar()[(ldg * S5_STATE + pp) * S5_GROUP + j];
      float tr = lp.x * bb.x - lp.y * bb.y, ti = lp.x * bb.y + lp.y * bb.x;
      acc += cr * tr - ci * ti;
    }
    p.kc()[i] = acc;
  }
}
#ifndef CPU_TEST
DEV void ph_g2(const P& p, long gtid, long gsize) {
  hy_f2g(p, gtid, gsize);
}
DEV void ph_g3(const P& p, long gtid, long gsize) {
  for (int l = 0; l < DEPTH; ++l) hy_f3g(p, l, SEQ, p.fh2() + (long)l * SEQ * FILTER_HIDDEN, p.kraw() + (long)l * SEQ * 2 * HYENA_W, HY_PSUM(l), gtid, gsize);
  hy_f3g(p, 0, CTX_LEN, p.fh2c(), p.krawc(), HY_PSUM(DEPTH), gtid, gsize);
}
DEV void ph_g4(const P& p, long gtid, long gsize) {
  for (int l = 0; l < DEPTH; ++l) hy_f4g(SEQ, HY_PSUM(l), p.knorm() + l * HYENA_W, gtid, gsize);
  hy_f4g(CTX_LEN, HY_PSUM(DEPTH), p.knormc(), gtid, gsize);
}
#else
DEV void ph_g2(const P& p, long gtid, long gsize) {
  for (int l = 0; l < DEPTH; ++l) hy_f2(p, l, SEQ, p.fh1() + (long)l * SEQ * FILTER_HIDDEN, p.fh2() + (long)l * SEQ * FILTER_HIDDEN, gtid, gsize);
  hy_f2(p, 0, CTX_LEN, p.fh1c(), p.fh2c(), gtid, gsize);
}
DEV void ph_g3(const P& p, long gtid, long gsize) {
  for (int l = 0; l < DEPTH; ++l) hy_f3(p, l, SEQ, p.fh2() + (long)l * SEQ * FILTER_HIDDEN, p.kraw() + (long)l * SEQ * 2 * HYENA_W, gtid, gsize);
  hy_f3(p, 0, CTX_LEN, p.fh2c(), p.krawc(), gtid, gsize);
}
DEV void ph_g4(const P& p, long gtid, long gsize) {
  for (int l = 0; l < DEPTH; ++l) hy_f4(SEQ, p.kraw() + (long)l * SEQ * 2 * HYENA_W, p.knorm() + l * HYENA_W, gtid, gsize);
  hy_f4(CTX_LEN, p.krawc(), p.knormc(), gtid, gsize);
}
#endif
#define NG 5

DEV void ph_modu(const P& p, int l, int which, long gtid, long gsize) {
  FOR_ITEMS(i, (long)NR * D_MODEL) {
    int k = (int)(i % D_MODEL); long r = i / D_MODEL;
    const float* m = p.mod() + ((long)l * (BATCH + 1) + modrow(r)) * 6 * D_MODEL + which * 3 * D_MODEL;
    float uv = p.xcur()[i] * (1.0f + m[D_MODEL + k]) + m[k];
    p.ubuf()[i] = uv; p.ubf()[i] = f2bf16(uv);
  }
}
template <class Epi>
DEV void gemm_naive(const float* A, int lda, const float* B, int ldb, int M, int N, int K, Epi epi, long gtid, long gsize) {
  FOR_ITEMS(i, (long)(M / 4) * N) {
    int n = (int)(i % N); long r0 = (i / N) * 4;
    const float* a0 = A + r0 * lda;
    float c0 = 0.f, c1 = 0.f, c2 = 0.f, c3 = 0.f;
    for (int k = 0; k < K; ++k) {
      float b = B[(long)k * ldb + n];
      c0 += a0[k] * b; c1 += a0[lda + k] * b; c2 += a0[2 * lda + k] * b; c3 += a0[3 * lda + k] * b;
    }
    epi(r0, n, c0); epi(r0 + 1, n, c1); epi(r0 + 2, n, c2); epi(r0 + 3, n, c3);
  }
}
struct EpiStore { float* C; int ldc; DEVM void operator()(long r, int n, float v) const { C[r * ldc + n] = v; } };
DEV void ph_proj(const P& p, int l, long gtid, long gsize) {
  EpiStore e{p.proj(), IN_W};
  gemm_naive(p.ubuf(), D_MODEL, p.w_in + (long)l * D_MODEL * IN_W, IN_W, NR, IN_W, D_MODEL, e, gtid, gsize);
}
DEV long s5_row(int b, int dir, int n) {
  if (n < CTX_LEN) return (long)NL + b * CTX_LEN + (dir ? CTX_LEN - 1 - n : n);
  int t = n - CTX_LEN; return (long)b * SEQ + (dir ? SEQ - 1 - t : t);
}
DEV void ph_post_proj(const P& p, int l, long gtid, long gsize) {
  FOR_ITEMS(i, (long)NL * (N_Q_HEADS + N_KV_HEADS) * 2 * ROPE_HALF) {
    int ii = (int)(i % ROPE_HALF); int a = (int)((i / ROPE_HALF) % 2); int hs = (int)((i / (2 * ROPE_HALF)) % (N_Q_HEADS + N_KV_HEADS));
    long r = i / (2 * ROPE_HALF * (N_Q_HEADS + N_KV_HEADS));
    int t = (int)(r % SEQ); int pos = a == 0 ? t / GRID_W : t % GRID_W;
    float inv = powf(10000.0f, -(float)(2 * ii) / (float)AXIS_DIM);
    float ang = (float)pos * inv; float cs = cosf(ang), sn = sinf(ang);
    float* q = p.proj() + r * IN_W + hs * HEAD_DIM + a * AXIS_DIM + ii;
    float x1 = q[0], x2 = q[ROPE_HALF];
    q[0] = x1 * cs - x2 * sn; q[ROPE_HALF] = x1 * sn + x2 * cs;
  }
#ifdef CPU_TEST
  FOR_ITEMS(i, (long)NR * HYENA_W) {
    int ch = (int)(i % HYENA_W); long r = i / HYENA_W;
    int Ls = r < NL ? SEQ : CTX_LEN; long base = r < NL ? (r / SEQ) * SEQ : NL + ((r - NL) / CTX_LEN) * CTX_LEN; int t = (int)(r - base);
    const float* sw = p.hy_short_w + l * 3 * 3 * HYENA_W; const float* sb = p.hy_short_b + l * 3 * HYENA_W;
    float z[3];
#pragma unroll
    for (int part = 0; part < 3; ++part) {
      int cc = part * HYENA_W + ch; float acc = sb[cc];
#pragma unroll
      for (int j = 0; j < 3; ++j) { int tt = t + j - 1; if (tt >= 0 && tt < Ls) acc += p.proj()[(base + tt) * IN_W + HY_OFF + cc] * sw[j * 3 * HYENA_W + cc]; }
      z[part] = acc;
    }
    long o = r < NL ? ((r / SEQ) * HYENA_W + ch) * SEQ + t : i;
    p.hu()[o] = z[0] * z[1]; p.hx0()[o] = z[2];
  }
#endif
#ifndef CPU_TEST
  FOR_ITEMS(i, (long)NR * S5_W) { long r = i / S5_W; int cc = (int)(i % S5_W); p.s5u()[i] = f2bf16(p.proj()[r * IN_W + S5_OFF + cc]); }
#endif
#ifdef CPU_TEST
  FOR_ITEMS(i, (long)BATCH * 2 * S5_GROUPS * NCH * S5_STATE) {
    int pp = (int)(i % S5_STATE); int c = (int)((i / S5_STATE) % NCH); int g = (int)((i / (S5_STATE * NCH)) % S5_GROUPS);
    int dir = (int)((i / (S5_STATE * NCH * S5_GROUPS)) % 2); int b = (int)(i / (S5_STATE * NCH * S5_GROUPS * 2));
    long ldg = ((long)l * 2 + dir) * S5_GROUPS + g;
    float sr = 0.f, si = 0.f;
    for (int s = 0; s < S5_T; ++s) {
      const float* u = p.proj() + s5_row(b, dir, c * S5_T + s) * IN_W + S5_OFF + g * S5_GROUP;
      float br = 0.f, bi = 0.f;
#pragma unroll
      for (int j = 0; j < S5_GROUP; ++j) { float2 bb = p.bbar()[(ldg * S5_STATE + pp) * S5_GROUP + j]; br += bb.x * u[j]; bi += bb.y * u[j]; }
      float2 lp = p.lampow()[(ldg * (S5_T + 1) + (S5_T - 1 - s)) * S5_STATE + pp];
      sr += lp.x * br - lp.y * bi; si += lp.x * bi + lp.y * br;
    }
    p.sc()[i] = make_float2(sr, si);
  }
#endif
}
DEV void attn_item(const P& p, int l, long r, int h, float* outp) {
  const float scale = 1.0f / sqrtf((float)HEAD_DIM);
  float q[HEAD_DIM], acc[HEAD_DIM];
  const float* qp = p.proj() + r * IN_W + Q_OFF + h * HEAD_DIM;
#pragma unroll
  for (int d = 0; d < HEAD_DIM; ++d) { q[d] = qp[d] * scale; acc[d] = 0.f; }
  int kvh = h / Q_GROUP; int b = r < NL ? (int)(r / SEQ) : (int)((r - NL) / CTX_LEN);
  float m = -1e30f, lsum = 0.f;
  int nwin = 0, t = 0;
  if (r < NL) { t = (int)(r % SEQ); nwin = 2 * WINDOW + 1; }
  for (int j = 0; j < nwin + CTX_LEN; ++j) {
    long kr;
    if (j < nwin) { int tk = t - WINDOW + j; if (tk < 0 || tk >= SEQ) continue; kr = (long)b * SEQ + tk; }
    else kr = (long)NL + b * CTX_LEN + (j - nwin);
    const float* kp = p.proj() + kr * IN_W + K_OFF + kvh * HEAD_DIM; const float* vp = p.proj() + kr * IN_W + V_OFF + kvh * HEAD_DIM;
    float s = 0.f;
#pragma unroll
    for (int d = 0; d < HEAD_DIM; ++d) s += q[d] * kp[d];
    float mn = fmaxf(m, s); float corr = expf(m - mn); float pe = expf(s - mn);
    lsum = lsum * corr + pe;
#pragma unroll
    for (int d = 0; d < HEAD_DIM; ++d) acc[d] = acc[d] * corr + pe * vp[d];
    m = mn;
  }
  float sk = p.sink[l * N_Q_HEADS + h]; float mf = fmaxf(m, sk); float corr = expf(m - mf);
  float den = lsum * corr + expf(sk - mf); float sc2 = corr / den;
#pragma unroll
  for (int d = 0; d < HEAD_DIM; ++d) outp[d] = acc[d] * sc2;
}
DEV void ph_mix(const P& p, int l, long gtid, long gsize) {
#ifdef CPU_TEST
  long nrows_att = l == 0 ? NR : NL;
  FOR_ITEMS(i, nrows_att * N_Q_HEADS) { int h = (int)(i % N_Q_HEADS); long r = i / N_Q_HEADS; attn_item(p, l, r, h, p.mixb() + r * MIX_W + h * HEAD_DIM); }
#endif
#ifdef CPU_TEST
  FOR_ITEMS(i, (long)NL * HYENA_W) {
    int ch = (int)(i % HYENA_W); long r = i / HYENA_W; int t = (int)(r % SEQ); int b = (int)(r / SEQ);
    const float* kf = p.kraw() + ((long)l * 2 * HYENA_W + ch) * SEQ; const float* kb = p.kraw() + ((long)l * 2 * HYENA_W + HYENA_W + ch) * SEQ;
    const float* uu = p.hu() + ((long)b * HYENA_W + ch) * SEQ;
    float acc = 0.f;
    for (int s = 0; s <= t; ++s) acc += kf[t - s] * uu[s];
    for (int s = t + 1; s < SEQ; ++s) acc += kb[s - t] * uu[s];
    p.mixb()[r * MIX_W + ATTN_W + ch] = (acc * p.knorm()[l * HYENA_W + ch] + uu[t] * p.hy_d[l * HYENA_W + ch]) * p.hx0()[((long)b * HYENA_W + ch) * SEQ + t];
  }
#endif
  if (l == 0) {
#ifndef CPU_TEST
    FOR_ITEMS(i, (long)NC * HYENA_W) {
      const int t = (int)(i % CTX_LEN); const int ch = (int)((i / CTX_LEN) % HYENA_W); const int b = (int)(i / ((long)CTX_LEN * HYENA_W));
      const long base = (long)NL + (long)b * CTX_LEN; const long r = base + t;
      const float* kf = p.krawc() + (long)ch * CTX_LEN; const float* kb = p.krawc() + (long)(HYENA_W + ch) * CTX_LEN;
      float acc = 0.f;
#pragma unroll 8
      for (int sidx = 0; sidx < CTX_LEN; ++sidx) {
        const int d = t - sidx; const float kv = d >= 0 ? kf[d] : kb[-d];
        acc += kv * p.hu()[(base + sidx) * HYENA_W + ch];
      }
      const float u = p.hu()[r * HYENA_W + ch];
      p.mixb()[r * MIX_W + ATTN_W + ch] = (acc * p.knormc()[ch] + u * p.hy_d[l * HYENA_W + ch]) * p.hx0()[r * HYENA_W + ch];
    }
#else
    FOR_ITEMS(i, (long)NC * HYENA_W) {
      int ch = (int)(i % HYENA_W); long r = NL + i / HYENA_W; int t = (int)((r - NL) % CTX_LEN); long base = r - t;
      float acc = 0.f;
      for (int s = 0; s <= t; ++s) acc += p.krawc()[(long)ch * CTX_LEN + (t - s)] * p.hu()[(base + s) * HYENA_W + ch];
      for (int s = t + 1; s < CTX_LEN; ++s) acc += p.krawc()[(long)(HYENA_W + ch) * CTX_LEN + (s - t)] * p.hu()[(base + s) * HYENA_W + ch];
      float u = p.hu()[r * HYENA_W + ch];
      p.mixb()[r * MIX_W + ATTN_W + ch] = (acc * p.knormc()[ch] + u * p.hy_d[l * HYENA_W + ch]) * p.hx0()[r * HYENA_W + ch];
    }
#endif
  }
#ifdef CPU_TEST
  FOR_ITEMS(i, (long)BATCH * 2 * S5_GROUPS * S5_STATE) {
    int pp = (int)(i % S5_STATE); int g = (int)((i / S5_STATE) % S5_GROUPS); int dir = (int)((i / (S5_STATE * S5_GROUPS)) % 2); int b = (int)(i / (S5_STATE * S5_GROUPS * 2));
    long ldg = ((long)l * 2 + dir) * S5_GROUPS + g;
    float2 lt = p.lampow()[(ldg * (S5_T + 1) + S5_T) * S5_STATE + pp];
    float hr = 0.f, hi = 0.f;
    long base = (((long)b * 2 + dir) * S5_GROUPS + g) * NCH;
#ifndef CPU_TEST
    static_assert(NCH % 12 == 0, "carry batching");
    for (int c0 = 0; c0 < NCH; c0 += 12) {
      float2 sv[12];
#pragma unroll
      for (int k = 0; k < 12; ++k) sv[k] = p.sc()[(base + c0 + k) * S5_STATE + pp];
#pragma unroll
      for (int k = 0; k < 12; ++k) {
        p.hcbf()[(base + c0 + k) * 2 * S5_STATE + pp] = f2bf16(hr); p.hcbf()[(base + c0 + k) * 2 * S5_STATE + S5_STATE + pp] = f2bf16(hi);
        const float nr = lt.x * hr - lt.y * hi + sv[k].x, ni = lt.x * hi + lt.y * hr + sv[k].y;
        hr = nr; hi = ni;
      }
    }
#else
    for (int c = 0; c < NCH; ++c) {
      p.hc()[(base + c) * S5_STATE + pp] = make_float2(hr, hi);
      float2 s = p.sc()[(base + c) * S5_STATE + pp];
      float nr = lt.x * hr - lt.y * hi + s.x, ni = lt.x * hi + lt.y * hr + s.y;
      hr = nr; hi = ni;
    }
#endif
  }
#endif
}
DEV void ph_s5out(const P& p, int l, long gtid, long gsize) {
  FOR_ITEMS(i, (long)NR * S5_W) {
    int chn = (int)(i % S5_W); long r = i / S5_W; int g = chn / S5_GROUP, ii = chn % S5_GROUP;
    int b, tl; bool isctx = r >= NL;
    if (isctx) { b = (int)((r - NL) / CTX_LEN); tl = (int)((r - NL) % CTX_LEN); } else { b = (int)(r / SEQ); tl = (int)(r % SEQ); }
    float y = p.s5_d[l * S5_W + chn] * p.proj()[r * IN_W + S5_OFF + chn];
    for (int dir = 0; dir < 2; ++dir) {
      int n = isctx ? (dir ? CTX_LEN - 1 - tl : tl) : CTX_LEN + (dir ? SEQ - 1 - tl : tl);
      int c = n / S5_T, tau = n % S5_T;
      long ldg = ((long)l * 2 + dir) * S5_GROUPS + g;
      long hb = ((((long)b * 2 + dir) * S5_GROUPS + g) * NCH + c) * S5_STATE;
      for (int pp = 0; pp < S5_STATE; ++pp) {
        float cr = p.s5_c_re[(ldg * S5_GROUP + ii) * S5_STATE + pp], ci = p.s5_c_im[(ldg * S5_GROUP + ii) * S5_STATE + pp];
        float2 lp = p.lampow()[(ldg * (S5_T + 1) + tau + 1) * S5_STATE + pp]; float2 h = p.hc()[hb + pp];
        float tr = lp.x * h.x - lp.y * h.y, ti = lp.x * h.y + lp.y * h.x;
        y += cr * tr - ci * ti;
      }
      for (int s = 0; s <= tau; ++s) {
        const float* u = p.proj() + s5_row(b, dir, c * S5_T + s) * IN_W + S5_OFF + g * S5_GROUP;
        const float* kk = p.kc() + ((ldg * S5_T + (tau - s)) * S5_GROUP + ii) * S5_GROUP;
#pragma unroll
        for (int j = 0; j < S5_GROUP; ++j) y += kk[j] * u[j];
      }
    }
    float gy = gelu_tanhf(y); p.ybuf()[i] = gy; p.ybf()[i] = f2bf16(gy);
  }
}
struct EpiGlu { const float* g; float* mixb; DEVM void operator()(long r, int n, float v) const { mixb[r * MIX_W + ATTN_W + HYENA_W + n] = g[r * S5_W + n] * sigmoidf_(v); } };
DEV void ph_glu(const P& p, int l, long gtid, long gsize) {
  EpiGlu e{p.ybuf(), p.mixb()};
  gemm_naive(p.ybuf(), S5_W, p.s5_w_glu + (long)l * S5_W * S5_W, S5_W, NR, S5_W, S5_W, e, gtid, gsize);
}
DEV void ph_rms(const P& p, int l, long gtid, long gsize) {
  FOR_ITEMS(i, (long)NR * 3) {
    int grp = (int)(i % 3); long r = i / 3;
    int off = grp == 0 ? 0 : (grp == 1 ? ATTN_W : ATTN_W + HYENA_W); int w = grp == 0 ? ATTN_W : (grp == 1 ? HYENA_W : S5_W);
    float* v = p.mixb() + r * MIX_W + off; float ss = 0.f;
    for (int k = 0; k < w; ++k) ss += v[k] * v[k];
    float rs = 1.0f / sqrtf(ss / (float)w + LN_EPS);
    for (int k = 0; k < w; ++k) { float nv = v[k] * rs * p.mix_g[l * MIX_W + off + k]; v[k] = nv; p.mixbf()[r * MIX_W + off + k] = f2bf16(nv); }
  }
}
struct EpiRes { const float* xcur; const float* mod; int l; int goff; float* tmp;
  DEVM void operator()(long r, int n, float v) const { const float* m = mod + ((long)l * (BATCH + 1) + modrow(r)) * 6 * D_MODEL + goff; tmp[r * D_MODEL + n] = DN_ALPHA * xcur[r * D_MODEL + n] + m[n] * v; } };
DEV void ph_outproj(const P& p, int l, long gtid, long gsize) {
  EpiRes e{p.xcur(), p.mod(), l, 2 * D_MODEL, p.tmp()};
  gemm_naive(p.mixb(), MIX_W, p.w_out + (long)l * MIX_W * D_MODEL, D_MODEL, NR, D_MODEL, MIX_W, e, gtid, gsize);
}
DEV void ph_ln(const P& p, int l, int which, long gtid, long gsize) {
  const float* gw = (which == 0 ? p.ln1_g : p.ln2_g) + l * D_MODEL; const float* bw = (which == 0 ? p.ln1_b : p.ln2_b) + l * D_MODEL;
  FOR_ITEMS(r, (long)NR) {
    const float* v = p.tmp() + r * D_MODEL; float mu = 0.f;
#pragma unroll 4
    for (int k = 0; k < D_MODEL; ++k) mu += v[k];
    mu /= (float)D_MODEL; float var = 0.f;
#pragma unroll 4
    for (int k = 0; k < D_MODEL; ++k) { float d = v[k] - mu; var += d * d; }
    float rs = 1.0f / sqrtf(var / (float)D_MODEL + LN_EPS);
    const float* m = p.mod() + ((long)l * (BATCH + 1) + modrow(r)) * 6 * D_MODEL + 3 * D_MODEL;
#pragma unroll 2
    for (int k = 0; k < D_MODEL; ++k) {
      float y = (v[k] - mu) * rs * gw[k] + bw[k];
      p.xcur()[r * D_MODEL + k] = y;
      if (which == 0) { float uv = y * (1.0f + m[D_MODEL + k]) + m[k]; p.ubuf()[r * D_MODEL + k] = uv; p.ubf()[r * D_MODEL + k] = f2bf16(uv); }
      if (which == 1 && l == DEPTH - 1 && r < NL) p.out[r * D_MODEL + k] = y;
    }
  }
}
DEV void ph_router(const P& p, int l, long gtid, long gsize) {
  EpiStore e{p.rl(), N_EXPERTS};
  gemm_naive(p.ubuf(), D_MODEL, p.w_router + (long)l * D_MODEL * N_EXPERTS, N_EXPERTS, NR, N_EXPERTS, D_MODEL, e, gtid, gsize);
}
DEV bool better(float v, int i, float bv, int bi) { return v > bv || (v == bv && i < bi); }
DEV void ph_select(const P& p, int l, long gtid, long gsize) {
  FOR_ITEMS(r, (long)NR) {
    const float* lg = p.rl() + r * N_EXPERTS; const float* rb = p.router_bias + l * N_EXPERTS;
    float gs[N_EXPERT_GROUPS];
#pragma unroll
    for (int g = 0; g < N_EXPERT_GROUPS; ++g) {
      float m1 = -1e30f, m2 = -1e30f;
      for (int e = 0; e < EPG; ++e) { float v = sigmoidf_(lg[g * EPG + e]) + rb[g * EPG + e]; if (v > m1) { m2 = m1; m1 = v; } else if (v > m2) m2 = v; }
      gs[g] = m1 + m2;
    }
    unsigned keep = 0;
#pragma unroll
    for (int it = 0; it < TOPK_GROUPS; ++it) {
      float bv = -1e30f; int bi = -1;
#pragma unroll
      for (int g = 0; g < N_EXPERT_GROUPS; ++g) if (!((keep >> g) & 1u) && (bi < 0 || gs[g] > bv)) { bv = gs[g]; bi = g; }
      keep |= 1u << bi;
    }
    float lastv = 1e30f; int lasti = -1; float gsum = 0.f;
    for (int it = 0; it < TOP_K; ++it) {
      float bv = -1e30f; int bi = -1;
      for (int e = 0; e < N_EXPERTS; ++e) {
        if (!((keep >> (e / EPG)) & 1u)) continue;
        float v = sigmoidf_(lg[e]) + rb[e];
        if (!better(lastv, lasti, v, e)) continue;
        if (bi < 0 || better(v, e, bv, bi)) { bv = v; bi = e; }
      }
      lastv = bv; lasti = bi;
      float sc = sigmoidf_(lg[bi]); gsum += sc;
      p.top_e()[r * TOP_K + it] = bi; p.gate()[r * TOP_K + it] = sc;
      p.posb()[r * TOP_K + it] = atomicAdd(&p.cnt()[l * N_EXPERTS + bi], 1);
    }
    float inv = ROUTED_SCALE / gsum;
    for (int it = 0; it < TOP_K; ++it) p.gate()[r * TOP_K + it] *= inv;
  }
}
DEV void ph_sortrows(const P& p, int l, long gtid, long gsize) {
  FOR_ITEMS(i, (long)NR * TOP_K) {
    int e = p.top_e()[i]; int off = 0;
    for (int j = 0; j < e; ++j) off += p.cnt()[l * N_EXPERTS + j];
    p.srow()[off + p.posb()[i]] = (int)i;
  }
}
DEV void ph_expert_up(const P& p, int l, long gtid, long gsize) {
  FOR_ITEMS(i, (long)NR * TOP_K * EXPERT_FF) {
    int cidx = (int)(i % EXPERT_FF); int a = p.srow()[i / EXPERT_FF]; int e = p.top_e()[a]; long r = a / TOP_K;
    const float* xg = p.ubuf() + r * D_MODEL;
    const float* wg = p.w_exp_gate + ((long)l * N_EXPERTS + e) * D_MODEL * EXPERT_FF; const float* wu = p.w_exp_up + ((long)l * N_EXPERTS + e) * D_MODEL * EXPERT_FF;
    float g = 0.f, u = 0.f;
    for (int k = 0; k < D_MODEL; ++k) { float xv = xg[k]; g += xv * wg[(long)k * EXPERT_FF + cidx]; u += xv * wu[(long)k * EXPERT_FF + cidx]; }
    p.hbuf()[(long)a * EXPERT_FF + cidx] = siluf(g) * u;
  }
  FOR_ITEMS(i, (long)NR * SHARED_FF) {
    int cidx = (int)(i % SHARED_FF); long r = i / SHARED_FF;
    const float* xg = p.ubuf() + r * D_MODEL;
    const float* wg = p.w_sh_gate + (long)l * D_MODEL * SHARED_FF; const float* wu = p.w_sh_up + (long)l * D_MODEL * SHARED_FF;
    float g = 0.f, u = 0.f;
    for (int k = 0; k < D_MODEL; ++k) { float xv = xg[k]; g += xv * wg[(long)k * SHARED_FF + cidx]; u += xv * wu[(long)k * SHARED_FF + cidx]; }
    p.hsb()[i] = siluf(g) * u;
  }
}
DEV void ph_expert_down(const P& p, int l, long gtid, long gsize) {
  FOR_ITEMS(i, (long)NR * TOP_K * D_MODEL) {
    int d = (int)(i % D_MODEL); long a = i / D_MODEL;
    int e = p.top_e()[a]; const float* wd = p.w_exp_down + ((long)l * N_EXPERTS + e) * EXPERT_FF * D_MODEL;
    const float* h = p.hbuf() + a * EXPERT_FF; float acc = 0.f;
    for (int cidx = 0; cidx < EXPERT_FF; ++cidx) acc += h[cidx] * wd[(long)cidx * D_MODEL + d];
    p.yk()[i] = acc * p.gate()[a];
  }
  FOR_ITEMS(i, (long)NR * D_MODEL) {
    int d = (int)(i % D_MODEL); long r = i / D_MODEL;
    const float* wsd = p.w_sh_down + (long)l * SHARED_FF * D_MODEL; const float* hs = p.hsb() + r * SHARED_FF;
    float acc = 0.f;
    for (int cidx = 0; cidx < SHARED_FF; ++cidx) acc += hs[cidx] * wsd[(long)cidx * D_MODEL + d];
    p.ysh()[i] = acc;
  }
}
DEV void ph_combine(const P& p, int l, long gtid, long gsize) {
#pragma unroll 1
  FOR_ITEMS(i, (long)NR * D_MODEL) {
    int d = (int)(i % D_MODEL); long r = i / D_MODEL;
    float f = p.ysh()[i];
#pragma unroll
    for (int k = 0; k < TOP_K; ++k) f += p.yk()[(r * TOP_K + k) * D_MODEL + d];
    const float* m = p.mod() + ((long)l * (BATCH + 1) + modrow(r)) * 6 * D_MODEL + 5 * D_MODEL;
    p.tmp()[i] = DN_ALPHA * p.xcur()[i] + m[d] * f;
  }
}
#define NLP 16


#ifndef CPU_TEST
typedef __attribute__((ext_vector_type(8))) short bf16x8;
typedef __attribute__((ext_vector_type(4))) float f32x4;
typedef __attribute__((ext_vector_type(4))) unsigned u32x4;
typedef __attribute__((ext_vector_type(2))) unsigned u32x2;
static_assert(N_EXPERTS == 256 && D_MODEL % 128 == 0 && NR % 128 == 0, "shape assumptions");
#define SM_XB 0
#define NT 512
#define SM_A 256
#define SM_B (256 + 16384)
#define SM_MISC (256 + 98304)
#define SMEM_BYTES (256 + 98304 + 4096)

DEV int otid() { int t = threadIdx.x; asm volatile("" : "+v"(t)); return t; }
typedef __bf16 bf16x2_t __attribute__((ext_vector_type(2)));
typedef float f32x2_t __attribute__((ext_vector_type(2)));
DEV unsigned pack2(float a, float b) { f32x2_t v = {a, b}; return __builtin_bit_cast(unsigned, __builtin_convertvector(v, bf16x2_t)); }
DEV unsigned f2bf(float f) { return pack2(f, 0.f) & 0xffffu; }
DEV int tile_off(int row, int chunk) { return row * 128 + ((chunk ^ ((row >> 1) & 7)) << 4); }

DEV float bflo(float x) { return x - __uint_as_float(f2bf(x) << 16); }
DEV void wt_convert(const float* W, unsigned short* WT, int K, int N, bool lo, long gtid, long gsize) {
  FOR_ITEMS4(i, (long)N * (K / 8)) {
    const int n = (int)(i % N); const int k8 = (int)(i / N) * 8;
    float v[8];
#pragma unroll
    for (int j = 0; j < 8; ++j) { const float x = W[(long)(k8 + j) * N + n]; v[j] = lo ? bflo(x) : x; }
    u32x4 o; o[0] = pack2(v[0], v[1]); o[1] = pack2(v[2], v[3]); o[2] = pack2(v[4], v[5]); o[3] = pack2(v[6], v[7]);
    *(u32x4*)(WT + (long)n * K + k8) = o;
  }
}
DEV void wt_convert_all(const P& p, long gtid, long gsize) {
  for (int l = 0; l < DEPTH; ++l) {
    wt_convert(p.w_in + (long)l * D_MODEL * IN_W, p.wt_in() + (long)l * IN_W * D_MODEL, D_MODEL, IN_W, false, gtid, gsize);
    wt_convert(p.w_out + (long)l * MIX_W * D_MODEL, p.wt_out() + (long)l * D_MODEL * MIX_W, MIX_W, D_MODEL, false, gtid, gsize);
    wt_convert(p.s5_w_glu + (long)l * S5_W * S5_W, p.wt_glu() + (long)l * S5_W * S5_W, S5_W, S5_W, false, gtid, gsize);
    wt_convert(p.w_sh_gate + (long)l * D_MODEL * SHARED_FF, p.wt_shg() + (long)l * SHARED_FF * D_MODEL, D_MODEL, SHARED_FF, false, gtid, gsize);
    wt_convert(p.w_sh_up + (long)l * D_MODEL * SHARED_FF, p.wt_shu() + (long)l * SHARED_FF * D_MODEL, D_MODEL, SHARED_FF, false, gtid, gsize);
    wt_convert(p.w_sh_down + (long)l * SHARED_FF * D_MODEL, p.wt_shd() + (long)l * D_MODEL * SHARED_FF, SHARED_FF, D_MODEL, false, gtid, gsize);
    wt_convert(p.w_router + (long)l * D_MODEL * N_EXPERTS, p.wt_rh() + (long)l * N_EXPERTS * D_MODEL, D_MODEL, N_EXPERTS, false, gtid, gsize);
    wt_convert(p.w_router + (long)l * D_MODEL * N_EXPERTS, p.wt_rl() + (long)l * N_EXPERTS * D_MODEL, D_MODEL, N_EXPERTS, true, gtid, gsize);
  }
}
struct ALRows { const char* base; unsigned off[2]; DEVM const unsigned short* a(int i, int kt) const { return (const unsigned short*)(base + (off[i] + (unsigned)kt * 128u)); } };
struct BLStd { static constexpr bool TR = false; const char* base; unsigned voff; int ldb4; bool valid;
  DEVM void load(float4 (&rb)[8], int kt) const {
#pragma unroll
    for (int i = 0; i < 8; ++i) rb[i] = valid ? *(const float4*)(base + (unsigned)((unsigned)(kt * 64 + i) * (unsigned)ldb4 + voff)) : make_float4(0.f, 0.f, 0.f, 0.f); } };
DEV unsigned bl_voff(int ldb4, int tid) { return (unsigned)((tid & 7) * 8) * (unsigned)ldb4 + (unsigned)((tid >> 3) * 16); }
DEV BLStd mk_bl(const float* B  , int ldb, int tid) {
  BLStd b; b.base = (const char*)B; b.ldb4 = ldb * 4; b.voff = bl_voff(ldb * 4, tid); b.valid = true; return b; }
#define SM_TILE 49152
template <int V = 0, class AL, class BL>
DEV void gemm_t(const AL& al, const BL& bl, int nk, f32x4 (&acc)[4][4], char* smem) {
  const int tid = otid(), lane = tid & 63, wid = tid >> 6, wr = wid >> 2, wc = wid & 3;
  const int l15 = lane & 15, q = lane >> 4, x = l15 >> 1;
  const char* ard0 = smem + SM_A + (wr * 64 + l15) * 128 + ((q ^ x) << 4);
  const char* ard1 = smem + SM_A + (wr * 64 + l15) * 128 + (((4 + q) ^ x) << 4);
  const char* brd0 = smem + SM_B + (wc * 64 + l15) * 128 + ((q ^ x) << 4);
  const char* brd1 = smem + SM_B + (wc * 64 + l15) * 128 + (((4 + q) ^ x) << 4);
  const int kq = tid & 7, nq = tid >> 3;
  char* awr = smem + SM_A + nq * 128 + ((kq ^ ((nq >> 1) & 7)) << 4);
  char* bwr0 = smem + SM_B + (nq * 4) * 128 + ((kq ^ ((2 * nq) & 7)) << 4);
  char* bwr1 = smem + SM_B + (nq * 4 + 2) * 128 + ((kq ^ ((2 * nq + 1) & 7)) << 4);
  if (nk <= 0) return;
  u32x4 ra[2]; float4 rb0[8];
#define GEMM_LOADA(KT) do { _Pragma("unroll") for (int i = 0; i < 2; ++i) ra[i] = *(const u32x4*)(al.a(i, (KT))); } while (0)
#define GEMM_WRITE(rb, PO) do { \
    *(u32x4*)(awr + (PO)) = ra[0]; *(u32x4*)(awr + (PO) + 8192) = ra[1]; \
    if (BL::TR) { u32x4 v; \
      v[0] = pack2(rb[0].x, rb[0].y); v[1] = pack2(rb[0].z, rb[0].w); v[2] = pack2(rb[1].x, rb[1].y); v[3] = pack2(rb[1].z, rb[1].w); *(u32x4*)(bwr0 + (PO)) = v; \
      v[0] = pack2(rb[2].x, rb[2].y); v[1] = pack2(rb[2].z, rb[2].w); v[2] = pack2(rb[3].x, rb[3].y); v[3] = pack2(rb[3].z, rb[3].w); *(u32x4*)(bwr0 + (PO) + 128) = v; \
      v[0] = pack2(rb[4].x, rb[4].y); v[1] = pack2(rb[4].z, rb[4].w); v[2] = pack2(rb[5].x, rb[5].y); v[3] = pack2(rb[5].z, rb[5].w); *(u32x4*)(bwr1 + (PO)) = v; \
      v[0] = pack2(rb[6].x, rb[6].y); v[1] = pack2(rb[6].z, rb[6].w); v[2] = pack2(rb[7].x, rb[7].y); v[3] = pack2(rb[7].z, rb[7].w); *(u32x4*)(bwr1 + (PO) + 128) = v; \
    } else { u32x4 v; \
      v[0] = pack2(rb[0].x, rb[1].x); v[1] = pack2(rb[2].x, rb[3].x); v[2] = pack2(rb[4].x, rb[5].x); v[3] = pack2(rb[6].x, rb[7].x); *(u32x4*)(bwr0 + (PO)) = v; \
      v[0] = pack2(rb[0].y, rb[1].y); v[1] = pack2(rb[2].y, rb[3].y); v[2] = pack2(rb[4].y, rb[5].y); v[3] = pack2(rb[6].y, rb[7].y); *(u32x4*)(bwr0 + (PO) + 128) = v; \
      v[0] = pack2(rb[0].z, rb[1].z); v[1] = pack2(rb[2].z, rb[3].z); v[2] = pack2(rb[4].z, rb[5].z); v[3] = pack2(rb[6].z, rb[7].z); *(u32x4*)(bwr1 + (PO)) = v; \
      v[0] = pack2(rb[0].w, rb[1].w); v[1] = pack2(rb[2].w, rb[3].w); v[2] = pack2(rb[4].w, rb[5].w); v[3] = pack2(rb[6].w, rb[7].w); *(u32x4*)(bwr1 + (PO) + 128) = v; \
    } } while (0)
  GEMM_LOADA(0);
  bl.load(rb0, 0);
  __syncthreads();
  GEMM_WRITE(rb0, 0);
  if (V != 3) { if (nk > 1) { GEMM_LOADA(1); bl.load(rb0, 1); } }
  __syncthreads();
#define GEMM_STEP(rbn, KT) do { \
    const int po = ((KT) & 1) * SM_TILE; \
    bf16x8 fa0[4], fb0[4], fa1[4], fb1[4]; \
    _Pragma("unroll") for (int n = 0; n < 4; ++n) fb0[n] = *(const bf16x8*)(brd0 + po + n * 2048); \
    _Pragma("unroll") for (int m = 0; m < 4; ++m) fa0[m] = *(const bf16x8*)(ard0 + po + m * 2048); \
    _Pragma("unroll") for (int n = 0; n < 4; ++n) fb1[n] = *(const bf16x8*)(brd1 + po + n * 2048); \
    _Pragma("unroll") for (int m = 0; m < 4; ++m) fa1[m] = *(const bf16x8*)(ard1 + po + m * 2048); \
    __builtin_amdgcn_sched_barrier(0);     \
    if ((KT) + 1 < nk) { \
      GEMM_WRITE(rbn, SM_TILE - po); \
      if (V != 3) { if ((KT) + 2 < nk) { GEMM_LOADA((KT) + 2); bl.load(rbn, (KT) + 2); } } \
    } \
    __builtin_amdgcn_sched_barrier(0); \
    if (V != 2) { \
      _Pragma("unroll") for (int m = 0; m < 4; ++m) _Pragma("unroll") for (int n = 0; n < 4; ++n) acc[m][n] = __builtin_amdgcn_mfma_f32_16x16x32_bf16(fa0[m], fb0[n], acc[m][n], 0, 0, 0); \
      _Pragma("unroll") for (int m = 0; m < 4; ++m) _Pragma("unroll") for (int n = 0; n < 4; ++n) acc[m][n] = __builtin_amdgcn_mfma_f32_16x16x32_bf16(fa1[m], fb1[n], acc[m][n], 0, 0, 0); \
    } else { _Pragma("unroll") for (int m = 0; m < 4; ++m) asm volatile("" :: "v"(fa0[m]), "v"(fb0[m]), "v"(fa1[m]), "v"(fb1[m])); } \
    __syncthreads(); \
  } while (0)
  int kt = 0;
#pragma unroll 1
  for (; kt < nk; ++kt) { GEMM_STEP(rb0, kt); }
#undef GEMM_STEP
#undef GEMM_WRITE
#undef GEMM_LOADA
}

struct BLT { const char* base; unsigned voff; unsigned rowb;
  DEVM void load(u32x4 (&rb)[4], int kt) const {
#pragma unroll
    for (int c = 0; c < 4; ++c) rb[c] = *(const u32x4*)(base + (voff + (unsigned)c * rowb + (unsigned)kt * 128u)); } };
DEV BLT mk_blt(const unsigned short* BT  , int K, int tid) {
  BLT b; b.base = (const char*)BT; b.rowb = (unsigned)K * 2u; b.voff = (unsigned)((tid >> 3) * 4) * b.rowb + (unsigned)((tid & 7) * 16); return b; }
template <class AL, class BL>
DEV void gemm_tb(const AL& al, const BL& bl, int nk, f32x4 (&acc)[4][4], char* smem) {
  const int tid = otid(), lane = tid & 63, wid = tid >> 6, wr = wid >> 2, wc = wid & 3;
  const int l15 = lane & 15, q = lane >> 4, x = l15 >> 1;
  const char* ard0 = smem + SM_A + (wr * 64 + l15) * 128 + ((q ^ x) << 4);
  const char* ard1 = smem + SM_A + (wr * 64 + l15) * 128 + (((4 + q) ^ x) << 4);
  const char* brd0 = smem + SM_B + (wc * 64 + l15) * 128 + ((q ^ x) << 4);
  const char* brd1 = smem + SM_B + (wc * 64 + l15) * 128 + (((4 + q) ^ x) << 4);
  const int kq = tid & 7, nq = tid >> 3;
  char* awr = smem + SM_A + nq * 128 + ((kq ^ ((nq >> 1) & 7)) << 4);
  char* bwr0 = smem + SM_B + (nq * 4) * 128 + ((kq ^ ((2 * nq) & 7)) << 4);
  char* bwr1 = smem + SM_B + (nq * 4 + 2) * 128 + ((kq ^ ((2 * nq + 1) & 7)) << 4);
  if (nk <= 0) return;
  u32x4 ra[2]; u32x4 rb0[4], rb1[4];
#define TB_LOADA(KT) do { _Pragma("unroll") for (int i = 0; i < 2; ++i) ra[i] = *(const u32x4*)(al.a(i, (KT))); } while (0)
#define TB_WRITE(rb, PO) do { \
    *(u32x4*)(awr + (PO)) = ra[0]; *(u32x4*)(awr + (PO) + 8192) = ra[1]; \
    *(u32x4*)(bwr0 + (PO)) = rb[0]; *(u32x4*)(bwr0 + (PO) + 128) = rb[1]; *(u32x4*)(bwr1 + (PO)) = rb[2]; *(u32x4*)(bwr1 + (PO) + 128) = rb[3]; } while (0)
  TB_LOADA(0);
  bl.load(rb0, 0);
  if (nk > 1) bl.load(rb1, 1);
  __syncthreads();
  TB_WRITE(rb0, 0);
  if (nk > 1) TB_LOADA(1);
  if (nk > 2) bl.load(rb0, 2);
  __syncthreads();
#define TB_STEP(rbn, KT) do { \
    const int po = ((KT) & 1) * SM_TILE; \
    bf16x8 fa0[4], fb0[4], fa1[4], fb1[4]; \
    _Pragma("unroll") for (int n = 0; n < 4; ++n) fb0[n] = *(const bf16x8*)(brd0 + po + n * 2048); \
    _Pragma("unroll") for (int m = 0; m < 4; ++m) fa0[m] = *(const bf16x8*)(ard0 + po + m * 2048); \
    _Pragma("unroll") for (int n = 0; n < 4; ++n) fb1[n] = *(const bf16x8*)(brd1 + po + n * 2048); \
    _Pragma("unroll") for (int m = 0; m < 4; ++m) fa1[m] = *(const bf16x8*)(ard1 + po + m * 2048); \
    __builtin_amdgcn_sched_barrier(0); \
    if ((KT) + 1 < nk) { \
      TB_WRITE(rbn, SM_TILE - po); \
      if ((KT) + 2 < nk) TB_LOADA((KT) + 2); \
      if ((KT) + 3 < nk) bl.load(rbn, (KT) + 3); \
    } \
    __builtin_amdgcn_sched_barrier(0); \
    _Pragma("unroll") for (int m = 0; m < 4; ++m) _Pragma("unroll") for (int n = 0; n < 4; ++n) acc[m][n] = __builtin_amdgcn_mfma_f32_16x16x32_bf16(fa0[m], fb0[n], acc[m][n], 0, 0, 0); \
    _Pragma("unroll") for (int m = 0; m < 4; ++m) _Pragma("unroll") for (int n = 0; n < 4; ++n) acc[m][n] = __builtin_amdgcn_mfma_f32_16x16x32_bf16(fa1[m], fb1[n], acc[m][n], 0, 0, 0); \
    __syncthreads(); \
  } while (0)
  int kt = 0;
#pragma unroll 1
  for (; kt + 1 < nk; kt += 2) { TB_STEP(rb1, kt); TB_STEP(rb0, kt + 1); }
  if (kt < nk) TB_STEP(rb1, kt);
#undef TB_STEP
#undef TB_WRITE
#undef TB_LOADA
}
DEV void acc_zero(f32x4 (&acc)[4][4]) {
#pragma unroll
  for (int m = 0; m < 4; ++m)
#pragma unroll
    for (int n = 0; n < 4; ++n) acc[m][n] = (f32x4){0.f, 0.f, 0.f, 0.f};
}
#define EPI_BEGIN const int etid = otid();
#define EPI_ROW(m, j) (((etid >> 8) & 1) * 64 + (m) * 16 + ((etid & 63) >> 4) * 4 + (j))
#define EPI_COL(n) (((etid >> 6) & 3) * 64 + (n) * 16 + (etid & 15))

template <class Epi>
DEV void gemm_phase_dense(const unsigned short* A, int lda, const unsigned short* BT, int N, int K, Epi epi, char* smem) {
  const int tid = otid(); const int nct = N >> 8; const int nitems = (NR >> 7) * nct;
  for (int it = blockIdx.x; it < nitems; it += gridDim.x) {
    const int rt = it / nct, ct = it - rt * nct;
    ALRows al; al.base = (const char*)(A + (long)rt * 128 * lda);
#pragma unroll
    for (int i = 0; i < 2; ++i) al.off[i] = (unsigned)(((tid >> 3) + 64 * i) * lda + (tid & 7) * 8) * 2u;
    const BLT bl = mk_blt(BT + (long)ct * 256 * K, K, tid);
    f32x4 acc[4][4]; acc_zero(acc);
    gemm_tb(al, bl, K >> 6, acc, smem);
    EPI_BEGIN
#pragma unroll
    for (int m = 0; m < 4; ++m)
#pragma unroll
      for (int n = 0; n < 4; ++n)
#pragma unroll
        for (int j = 0; j < 4; ++j) epi((long)rt * 128 + EPI_ROW(m, j), ct * 256 + EPI_COL(n), acc[m][n][j]);
  }
}
DEV void ph_proj_mfma(const P& p, int l, char* smem) {
  const int tid = otid(); const int nct = IN_W >> 8; const int nitems = (NR >> 7) * nct;
  const float* B = p.w_in + (long)l * D_MODEL * IN_W;
  for (int it = blockIdx.x; it < nitems; it += gridDim.x) {
    const int rt = it / nct, ct = it - rt * nct;
    ALRows al; al.base = (const char*)(p.ubf() + (long)rt * 128 * D_MODEL);
#pragma unroll
    for (int i = 0; i < 2; ++i) al.off[i] = (unsigned)(((tid >> 3) + 64 * i) * D_MODEL + (tid & 7) * 8) * 2u;
    const BLT bl = mk_blt(p.wt_in() + ((long)l * IN_W + ct * 256) * D_MODEL, D_MODEL, tid);
    f32x4 acc[4][4]; acc_zero(acc);
    gemm_tb(al, bl, D_MODEL >> 6, acc, smem);
    EPI_BEGIN
    if (ct >= HY_OFF / 256 && ct < S5_OFF / 256) {
      const bool isctx = rt >= NL / 128;
      const int rloc = (isctx ? (rt - NL / 128) : rt) * 128;
      const int Ls = isctx ? CTX_LEN : SEQ; const int b = rloc / Ls; const int t0 = rloc - b * Ls;
      float* zb = p.zT() + (isctx ? (size_t)BATCH * 3 * HYENA_W * SEQ : (size_t)0) + (size_t)b * 3 * HYENA_W * Ls;
#pragma unroll
      for (int m = 0; m < 4; ++m)
#pragma unroll
        for (int n = 0; n < 4; ++n) {
          const int c = ct * 256 + EPI_COL(n) - HY_OFF; const int t = t0 + EPI_ROW(m, 0);
          *(float4*)(zb + (size_t)c * Ls + t) = make_float4(acc[m][n][0], acc[m][n][1], acc[m][n][2], acc[m][n][3]);
        }
    } else if (ct == S5_OFF / 256) {
#pragma unroll
      for (int m = 0; m < 4; ++m)
#pragma unroll
        for (int n = 0; n < 4; ++n)
#pragma unroll
          for (int j = 0; j < 4; ++j) p.s5u()[((long)rt * 128 + EPI_ROW(m, j)) * S5_W + EPI_COL(n)] = (unsigned short)f2bf(acc[m][n][j]);
    } else {
      const int head = ct * 4 + ((etid >> 6) & 3);
      const bool isq = head < N_Q_HEADS, dorope = head < N_Q_HEADS + N_KV_HEADS && rt < NL / 128;
      const float qs = isq ? 0.125f * 1.4426950408889634f : 1.0f;
      const int c16 = etid & 15;
#pragma unroll
      for (int m = 0; m < 4; ++m)
#pragma unroll
        for (int j = 0; j < 4; ++j) {
          const long row = (long)rt * 128 + EPI_ROW(m, j);
          float v0 = acc[m][0][j], v1 = acc[m][1][j], v2 = acc[m][2][j], v3 = acc[m][3][j];
          if (dorope) {
            const int t = (int)(row % SEQ);
            const float2 cr = p.ropet()[(t / GRID_W) * ROPE_HALF + c16], cc = p.ropet()[(t % GRID_W) * ROPE_HALF + c16];
            const float a0 = v0 * cr.x - v1 * cr.y, a1 = v0 * cr.y + v1 * cr.x, a2 = v2 * cc.x - v3 * cc.y, a3 = v2 * cc.y + v3 * cc.x;
            v0 = a0; v1 = a1; v2 = a2; v3 = a3;
          }
          unsigned short* dst = p.qkvb() + row * HY_OFF + head * HEAD_DIM + c16;
          dst[0] = (unsigned short)f2bf(v0 * qs); dst[16] = (unsigned short)f2bf(v1 * qs); dst[32] = (unsigned short)f2bf(v2 * qs); dst[48] = (unsigned short)f2bf(v3 * qs);
        }
    }
  }
}
DEV void ph_hyena_pre_gpu(const P& p, int l, long gtid, long gsize) {
  const float* sw = p.hy_short_w + l * 3 * 3 * HYENA_W; const float* sb = p.hy_short_b + l * 3 * HYENA_W;
  FOR_ITEMS4(i, (long)BATCH * HYENA_W * (SEQ + CTX_LEN)) {
    const bool isctx = i >= (long)BATCH * HYENA_W * SEQ; const long ii = isctx ? i - (long)BATCH * HYENA_W * SEQ : i;
    const int Ls = isctx ? CTX_LEN : SEQ; const int t = (int)(ii % Ls); const int ch = (int)((ii / Ls) % HYENA_W); const int b = (int)(ii / ((long)Ls * HYENA_W));
    const float* zb = p.zT() + (isctx ? (size_t)BATCH * 3 * HYENA_W * SEQ : (size_t)0) + (size_t)b * 3 * HYENA_W * Ls;
    float z[3];
#pragma unroll
    for (int part = 0; part < 3; ++part) {
      const int cc = part * HYENA_W + ch; const float* zr = zb + (size_t)cc * Ls; float acc = sb[cc];
      if (t > 0) acc += zr[t - 1] * sw[cc];
      acc += zr[t] * sw[3 * HYENA_W + cc];
      if (t + 1 < Ls) acc += zr[t + 1] * sw[2 * 3 * HYENA_W + cc];
      z[part] = acc;
    }
    const long o = isctx ? ((long)NL + b * CTX_LEN + t) * HYENA_W + ch : ((long)b * HYENA_W + ch) * SEQ + t;
    p.hu()[o] = z[0] * z[1]; p.hx0()[o] = z[2];
  }
}
DEV void rms_rows(const P& p, int l, long r0, long r1, int w0, int nw);
DEV void ph_glu_mfma(const P& p, int l, char* smem) {
  const int tid = otid();
  for (int rt = blockIdx.x; rt < (NR >> 7); rt += gridDim.x) {
    ALRows al; al.base = (const char*)(p.ybf() + (long)rt * 128 * S5_W);
#pragma unroll
    for (int i = 0; i < 2; ++i) al.off[i] = (unsigned)(((tid >> 3) + 64 * i) * S5_W + (tid & 7) * 8) * 2u;
    const BLT bl = mk_blt(p.wt_glu() + (long)l * S5_W * S5_W, S5_W, tid);
    f32x4 acc[4][4]; acc_zero(acc);
    gemm_tb(al, bl, S5_W >> 6, acc, smem);
    EPI_BEGIN
#pragma unroll
    for (int m = 0; m < 4; ++m)
#pragma unroll
      for (int n = 0; n < 4; ++n)
#pragma unroll
        for (int j = 0; j < 4; ++j) {
          const long r = (long)rt * 128 + EPI_ROW(m, j); const int c = EPI_COL(n);
          p.mixb()[r * MIX_W + ATTN_W + HYENA_W + c] = __uint_as_float((unsigned)p.ybf()[r * S5_W + c] << 16) * sigmoidf_(acc[m][n][j]);
        }
    asm volatile("s_waitcnt vmcnt(0)" ::: "memory");
    __syncthreads();
    rms_rows(p, l, (long)rt * 128, (long)rt * 128 + 128, otid() >> 6, NT / 64);
  }
}
DEV void ph_outproj_mfma(const P& p, int l, char* smem) {
  EpiRes e{p.xcur(), p.mod(), l, 2 * D_MODEL, p.tmp()};
  gemm_phase_dense(p.mixbf(), MIX_W, p.wt_out() + (long)l * D_MODEL * MIX_W, D_MODEL, MIX_W, e, smem);
}

struct ALRows4 { const char* base; unsigned off[4]; DEVM const unsigned short* a(int i, int kt) const { return (const unsigned short*)(base + (off[i] + (unsigned)kt * 128u)); } };
struct BLStd4 { const char* base; unsigned voff; int ldb4;
  DEVM void load(float4 (&rb)[4], int kt) const {
    unsigned vo = voff; asm volatile("" : "+v"(vo));
#pragma unroll
    for (int i = 0; i < 4; ++i) rb[i] = *(const float4*)(base + (unsigned)((unsigned)(kt * 64 + i) * (unsigned)ldb4 + vo)); } };
#define SM_B2 (SM_A + 32768)
template <class AL, class BL>
DEV void gemm_m2(const AL& al, const BL& bl, int nk, f32x4 (&acc)[4][4], char* smem) {
  const int tid = otid(), lane = tid & 63, wid = tid >> 6, wr = wid >> 1, wc = wid & 1;
  const int l15 = lane & 15, q = lane >> 4, x = l15 >> 1;
  const char* ard0 = smem + SM_A + (wr * 64 + l15) * 128 + ((q ^ x) << 4);
  const char* ard1 = smem + SM_A + (wr * 64 + l15) * 128 + (((4 + q) ^ x) << 4);
  const char* brd0 = smem + SM_B2 + (wc * 64 + l15) * 128 + ((q ^ x) << 4);
  const char* brd1 = smem + SM_B2 + (wc * 64 + l15) * 128 + (((4 + q) ^ x) << 4);
  const int kq = tid & 7, ar = tid >> 3, nq = (tid >> 3) & 31, kh = tid >> 8;
  char* awr = smem + SM_A + ar * 128 + ((kq ^ ((ar >> 1) & 7)) << 4);
  char* bwr0 = smem + SM_B2 + (nq * 4) * 128 + ((kq ^ ((2 * nq) & 7)) << 4) + kh * 8;
  char* bwr1 = smem + SM_B2 + (nq * 4 + 2) * 128 + ((kq ^ ((2 * nq + 1) & 7)) << 4) + kh * 8;
  if (nk <= 0) return;
  u32x4 ra[4]; float4 rb0[4], rb1[4];
#define M2_LOADA(KT) do { _Pragma("unroll") for (int i = 0; i < 4; ++i) ra[i] = *(const u32x4*)(al.a(i, (KT))); } while (0)
#define M2_WRITE(rb, PO) do { \
    _Pragma("unroll") for (int i = 0; i < 4; ++i) *(u32x4*)(awr + (PO) + 8192 * i) = ra[i]; \
    { u32x2 v; \
      v[0] = pack2(rb[0].x, rb[1].x); v[1] = pack2(rb[2].x, rb[3].x); *(u32x2*)(bwr0 + (PO)) = v; \
      v[0] = pack2(rb[0].y, rb[1].y); v[1] = pack2(rb[2].y, rb[3].y); *(u32x2*)(bwr0 + (PO) + 128) = v; \
      v[0] = pack2(rb[0].z, rb[1].z); v[1] = pack2(rb[2].z, rb[3].z); *(u32x2*)(bwr1 + (PO)) = v; \
      v[0] = pack2(rb[0].w, rb[1].w); v[1] = pack2(rb[2].w, rb[3].w); *(u32x2*)(bwr1 + (PO) + 128) = v; } } while (0)
  M2_LOADA(0);
  bl.load(rb0, 0);
  if (nk > 1) bl.load(rb1, 1);
  __syncthreads();
  M2_WRITE(rb0, 0);
  if (nk > 1) M2_LOADA(1);
  if (nk > 2) bl.load(rb0, 2);
  __syncthreads();
#define M2_STEP(rbn, KT) do { \
    const int po = ((KT) & 1) * SM_TILE; \
    bf16x8 fa0[4], fb0[4], fa1[4], fb1[4]; \
    _Pragma("unroll") for (int n = 0; n < 4; ++n) fb0[n] = *(const bf16x8*)(brd0 + po + n * 2048); \
    _Pragma("unroll") for (int m = 0; m < 4; ++m) fa0[m] = *(const bf16x8*)(ard0 + po + m * 2048); \
    _Pragma("unroll") for (int n = 0; n < 4; ++n) fb1[n] = *(const bf16x8*)(brd1 + po + n * 2048); \
    _Pragma("unroll") for (int m = 0; m < 4; ++m) fa1[m] = *(const bf16x8*)(ard1 + po + m * 2048); \
    __builtin_amdgcn_sched_barrier(0); \
    if ((KT) + 1 < nk) { \
      M2_WRITE(rbn, SM_TILE - po); \
      if ((KT) + 2 < nk) M2_LOADA((KT) + 2); \
      if ((KT) + 3 < nk) bl.load(rbn, (KT) + 3); \
    } \
    __builtin_amdgcn_sched_barrier(0); \
    _Pragma("unroll") for (int m = 0; m < 4; ++m) _Pragma("unroll") for (int n = 0; n < 4; ++n) acc[m][n] = __builtin_amdgcn_mfma_f32_16x16x32_bf16(fa0[m], fb0[n], acc[m][n], 0, 0, 0); \
    _Pragma("unroll") for (int m = 0; m < 4; ++m) _Pragma("unroll") for (int n = 0; n < 4; ++n) acc[m][n] = __builtin_amdgcn_mfma_f32_16x16x32_bf16(fa1[m], fb1[n], acc[m][n], 0, 0, 0); \
    __syncthreads(); \
  } while (0)
  int kt = 0;
#pragma unroll 1
  for (; kt + 1 < nk; kt += 2) { M2_STEP(rb1, kt); M2_STEP(rb0, kt + 1); }
  if (kt < nk) M2_STEP(rb1, kt);
#undef M2_STEP
#undef M2_WRITE
#undef M2_LOADA
}
#define EPI2_ROW(m, j) (((etid >> 7) & 3) * 64 + (m) * 16 + ((etid & 63) >> 4) * 4 + (j))
#define EPI2_COL(n) (((etid >> 6) & 1) * 64 + (n) * 16 + (etid & 15))
DEV void exp_prefix(const P& p, int l, int* toff, int* roff, int* rowo) {
  const int tid = otid(), lane = tid & 63, w = tid >> 6;
  __syncthreads();
  int c = 0, tl = 0, incl = 0, rinc = 0;
  int* wsum = roff + N_EXPERTS + 8;
  if (tid < N_EXPERTS) {
    c = p.cnt()[l * N_EXPERTS + tid];
    tl = (c + 255) >> 8; incl = tl; rinc = c;
#pragma unroll
    for (int o = 1; o < 64; o <<= 1) { const int v = __shfl_up(incl, o), v2 = __shfl_up(rinc, o); if (lane >= o) { incl += v; rinc += v2; } }
    if (lane == 63) { wsum[w] = incl; wsum[4 + w] = rinc; }
    roff[tid] = c;
  }
  __syncthreads();
  if (tid < N_EXPERTS) {
    int base = 0, rb = 0;
#pragma unroll
    for (int k = 0; k < 4; ++k) if (k < w) { base += wsum[k]; rb += wsum[4 + k]; }
    toff[tid] = base + incl - tl;
    rowo[tid] = rb + rinc - c;
    if (tid == N_EXPERTS - 1) toff[N_EXPERTS] = base + incl;
  }
  __syncthreads();
}
#define EXP_TABLES int* toff = (int*)(smem + SM_MISC); int* roff = toff + N_EXPERTS + 1; int* rowo = roff + N_EXPERTS + 16;
DEV int exp_find(const int* toff, int tile) {
  int lo = 0, hi = N_EXPERTS - 1;
  while (lo < hi) { int mid = (lo + hi + 1) >> 1; if (toff[mid] <= tile) lo = mid; else hi = mid - 1; }
  return lo;
}
template <int V = 0>
DEV void upgate_tile(const ALRows& al, const float* wg, const float* wu, int cq, f32x4 (&acc)[4][4], char* smem, int tid) {
  const int nq = tid >> 3; const int wsel = __builtin_amdgcn_readfirstlane(tid >> 6) & 1;
  BLStd bl; bl.base = (const char*)((wsel ? wu : wg) + cq * 128); bl.ldb4 = EXPERT_FF * 4; bl.valid = true;
  bl.voff = (unsigned)((tid & 7) * 8) * (unsigned)(EXPERT_FF * 4) + (unsigned)(((nq >> 4) * 32 + (nq & 7) * 4) * 4);
  acc_zero(acc);
  gemm_t<V>(al, bl, D_MODEL >> 6, acc, smem);
}
static_assert(EXPERT_FF == 256 && SHARED_FF == 256, "ff tiling");
template <int V = 0>
DEV void ph_expert_up_mfma(const P& p, int l, char* smem) {
  const int tid = otid();
  EXP_TABLES
  exp_prefix(p, l, toff, roff, rowo);
  const int n_items = toff[N_EXPERTS] * 4;
  for (int it = blockIdx.x; it < n_items; it += gridDim.x) {
    const int tile = it >> 2, cq = it & 3;
    const int e = __builtin_amdgcn_readfirstlane(exp_find(toff, tile)); const int j0 = (tile - toff[e]) * 256;
    const int nrows = min(256, roff[e] - j0), rbase = e * NR + j0, crow0 = rowo[e] + j0;
    const float* wg = p.w_exp_gate + ((long)l * N_EXPERTS + e) * D_MODEL * EXPERT_FF; const float* wu = p.w_exp_up + ((long)l * N_EXPERTS + e) * D_MODEL * EXPERT_FF;
    ALRows4 al; al.base = (const char*)p.ubf();
#pragma unroll
    for (int i = 0; i < 4; ++i) { const int rl = min((tid >> 3) + 64 * i, nrows - 1); al.off[i] = ((unsigned)(p.elist()[rbase + rl] / TOP_K) * D_MODEL + (tid & 7) * 8) * 2u; }
    const int nq = (tid >> 3) & 31; const int wsel = __builtin_amdgcn_readfirstlane(tid >> 6) & 1;
    BLStd4 bl; bl.base = (const char*)((wsel ? wu : wg) + cq * 64); bl.ldb4 = EXPERT_FF * 4;
    bl.voff = (unsigned)((tid & 7) * 8 + (tid >> 8) * 4) * (unsigned)(EXPERT_FF * 4) + (unsigned)(((nq >> 4) * 32 + (nq & 7) * 4) * 4);
    f32x4 acc[4][4]; acc_zero(acc);
    gemm_m2(al, bl, D_MODEL >> 6, acc, smem);
    EPI_BEGIN
    const int ewc = (etid >> 6) & 1, ec = etid & 15;
#pragma unroll
    for (int m = 0; m < 4; ++m)
#pragma unroll
      for (int j = 0; j < 4; ++j) {
        const int rl = EPI2_ROW(m, j);
        if (rl < nrows) {
          const float gsc = p.egate()[rbase + rl];
          unsigned short* dst = p.hbf() + (long)(crow0 + rl) * EXPERT_FF + cq * 64 + ewc * 32 + ec;
          dst[0] = (unsigned short)f2bf(siluq(acc[m][0][j]) * acc[m][2][j] * gsc); dst[16] = (unsigned short)f2bf(siluq(acc[m][1][j]) * acc[m][3][j] * gsc);
        }
      }
  }
}
DEV void ph_expert_down_mfma(const P& p, int l, char* smem) {
  const int tid = otid();
  EXP_TABLES
  exp_prefix(p, l, toff, roff, rowo);
  const int NC8 = D_MODEL / 128;
  const int n_exp_items = toff[N_EXPERTS] * NC8;
  for (int it = blockIdx.x; it < n_exp_items; it += gridDim.x) {
    const int tile = it / NC8, ct = it - tile * NC8;
    const int e = __builtin_amdgcn_readfirstlane(exp_find(toff, tile)); const int j0 = (tile - toff[e]) * 256;
    const int nrows = min(256, roff[e] - j0), crow0 = rowo[e] + j0;
    const float* wd = p.w_exp_down + ((long)l * N_EXPERTS + e) * EXPERT_FF * D_MODEL;
    ALRows4 al; al.base = (const char*)p.hbf();
#pragma unroll
    for (int i = 0; i < 4; ++i) { const int rl = min((tid >> 3) + 64 * i, nrows - 1); al.off[i] = ((unsigned)(crow0 + rl) * EXPERT_FF + (tid & 7) * 8) * 2u; }
    BLStd4 bl; bl.base = (const char*)(wd + ct * 128); bl.ldb4 = D_MODEL * 4;
    bl.voff = (unsigned)((tid & 7) * 8 + (tid >> 8) * 4) * (unsigned)(D_MODEL * 4) + (unsigned)(((tid >> 3) & 31) * 16);
    f32x4 acc[4][4]; acc_zero(acc);
    gemm_m2(al, bl, EXPERT_FF >> 6, acc, smem);
    EPI_BEGIN
#pragma unroll
    for (int m = 0; m < 4; ++m)
#pragma unroll
      for (int j = 0; j < 4; ++j) {
        const int rl = EPI2_ROW(m, j);
        if (rl < nrows) {
          unsigned short* dst = p.ykb() + (long)(crow0 + rl) * D_MODEL + ct * 128;
#pragma unroll
          for (int n = 0; n < 4; ++n) dst[EPI2_COL(n)] = (unsigned short)f2bf(acc[m][n][j]);
        }
      }
  }
  const int NCT = D_MODEL / 256;
  const int n_sh_items = (NR >> 7) * NCT;
  for (int it = (int)gridDim.x - 1 - (int)blockIdx.x; it < n_sh_items; it += gridDim.x) {
    const int rt = it / NCT, ct = it - rt * NCT;
    ALRows al; al.base = (const char*)(p.hsbf() + (long)rt * 128 * SHARED_FF);
#pragma unroll
    for (int i = 0; i < 2; ++i) al.off[i] = (unsigned)(((tid >> 3) + 64 * i) * SHARED_FF + (tid & 7) * 8) * 2u;
    const BLT bl = mk_blt(p.wt_shd() + ((long)l * D_MODEL + ct * 256) * SHARED_FF, SHARED_FF, tid);
    f32x4 acc[4][4]; acc_zero(acc);
    gemm_tb(al, bl, SHARED_FF >> 6, acc, smem);
    EPI_BEGIN
#pragma unroll
    for (int m = 0; m < 4; ++m)
#pragma unroll
      for (int n = 0; n < 4; ++n)
#pragma unroll
        for (int j = 0; j < 4; ++j) p.ysh()[((long)rt * 128 + EPI_ROW(m, j)) * D_MODEL + ct * 256 + EPI_COL(n)] = acc[m][n][j];
  }
}

typedef __attribute__((ext_vector_type(16))) float f32x16;
#define SM_HR 256
#define UB_STRIDE 8272
#define SM_HU (256 + 32768)
#define SMEM_HY (256 + 32768 + 2 * UB_STRIDE * 2)
static_assert(SEQ == 8192 && HYENA_W == 256, "hyena mfma shape");
DEV void ph_hyena_mfma(const P& p, int l, char* smem) {
  const int tid = otid(), lane = tid & 63, w = tid >> 6;
  unsigned short* R = (unsigned short*)(smem + SM_HR); unsigned short* U = (unsigned short*)(smem + SM_HU);
  for (int ch = blockIdx.x; ch < HYENA_W; ch += gridDim.x) {
    __syncthreads();
    const float* kf = p.kraw() + ((long)l * 2 * HYENA_W + ch) * SEQ; const float* kb = p.kraw() + ((long)l * 2 * HYENA_W + HYENA_W + ch) * SEQ;
    {
      float4 fa[2][2]; float fx[2]; float4 ba[2][2];
#pragma unroll
      for (int i = 0; i < 2; ++i) {
        const int base = 8 * (1024 - (tid + 512 * i));
        fa[i][0] = *(const float4*)(kf + base - 8); fa[i][1] = *(const float4*)(kf + base - 4); fx[i] = base < SEQ ? kf[base] : 0.f;
      }
#pragma unroll
      for (int i = 0; i < 2; ++i) {
        const int o = 8 * (tid + 512 * i);
        ba[i][0] = *(const float4*)(kb + o); ba[i][1] = *(const float4*)(kb + o + 4);
      }
      const float kf0 = kf[0];
#pragma unroll
      for (int i = 0; i < 2; ++i) {
        const int C = tid + 512 * i; u32x4 v;
        v[0] = pack2(fx[i], fa[i][1].w); v[1] = pack2(fa[i][1].z, fa[i][1].y); v[2] = pack2(fa[i][1].x, fa[i][0].w); v[3] = pack2(fa[i][0].z, fa[i][0].y);
        *(u32x4*)((char*)R + ((C ^ ((C >> 4) & 1)) << 4)) = v;
      }
#pragma unroll
      for (int i = 0; i < 2; ++i) {
        const int C = 1024 + tid + 512 * i; u32x4 v;
        v[0] = pack2((i == 0 && tid == 0) ? kf0 : ba[i][0].x, ba[i][0].y); v[1] = pack2(ba[i][0].z, ba[i][0].w); v[2] = pack2(ba[i][1].x, ba[i][1].y); v[3] = pack2(ba[i][1].z, ba[i][1].w);
        *(u32x4*)((char*)R + ((C ^ ((C >> 4) & 1)) << 4)) = v;
      }
      __builtin_amdgcn_sched_barrier(0);
      float4 ua[5][2];
#pragma unroll
      for (int i = 0; i < 5; ++i) {
        const int cc = tid + 512 * i; const int b = cc >= (UB_STRIDE / 8) ? 1 : 0; const int c = cc - b * (UB_STRIDE / 8);
        const bool ok = cc < 2 * (UB_STRIDE / 8) && c >= 2 && c < 2 + SEQ / 8;
        const float* src = p.hu() + ((long)b * HYENA_W + ch) * SEQ + (ok ? 8 * c - 16 : 0);
        ua[i][0] = ok ? *(const float4*)src : make_float4(0.f, 0.f, 0.f, 0.f); ua[i][1] = ok ? *(const float4*)(src + 4) : make_float4(0.f, 0.f, 0.f, 0.f);
      }
#pragma unroll
      for (int i = 0; i < 5; ++i) {
        const int cc = tid + 512 * i;
        if (cc < 2 * (UB_STRIDE / 8)) {
          u32x4 v; v[0] = pack2(ua[i][0].x, ua[i][0].y); v[1] = pack2(ua[i][0].z, ua[i][0].w); v[2] = pack2(ua[i][1].x, ua[i][1].y); v[3] = pack2(ua[i][1].z, ua[i][1].w);
          *(u32x4*)((char*)U + cc * 16) = v;
        }
      }
    }
    __syncthreads();
    f32x16 acc[2];
#pragma unroll
    for (int mi = 0; mi < 2; ++mi)
#pragma unroll
      for (int k = 0; k < 16; ++k) acc[mi][k] = 0.f;
    const int r = lane & 31, h = lane >> 5, sig = lane & 15, bb = (lane >> 4) & 1;
    const unsigned* Ud = (const unsigned*)U + bb * (UB_STRIDE / 2);
    const int ub0 = 8 * h + sig;
    const int cbase = 1022 - 64 * (2 * w) - 2 * r + h;
    const bool odd = sig & 1;
#define HY_LOAD(AF, D, Q) do { const int qq_ = (Q); \
      _Pragma("unroll") for (int mi = 0; mi < 2; ++mi) { const int C = cbase - 64 * mi + 2 * qq_; AF[mi] = *(const bf16x8*)((const char*)R + ((C ^ ((C >> 4) & 1)) << 4)); } \
      const int di_ = (16 * qq_ + ub0) >> 1; \
      _Pragma("unroll") for (int i = 0; i < 5; ++i) D[i] = Ud[di_ + i]; } while (0)
#define HY_MMA(AF, D) do { u32x4 bw_; \
      _Pragma("unroll") for (int i = 0; i < 4; ++i) bw_[i] = odd ? __builtin_amdgcn_alignbit(D[i + 1], D[i], 16) : D[i]; \
      const bf16x8 bfr_ = __builtin_bit_cast(bf16x8, bw_); \
      _Pragma("unroll") for (int mi = 0; mi < 2; ++mi) acc[mi] = __builtin_amdgcn_mfma_f32_32x32x16_bf16(AF[mi], bfr_, acc[mi], 0, 0, 0); } while (0)
    bf16x8 a0[2], a1[2], a2[2], a3[2]; unsigned d0[5], d1[5], d2[5], d3[5];
    HY_LOAD(a0, d0, 0); HY_LOAD(a1, d1, 1); HY_LOAD(a2, d2, 2); HY_LOAD(a3, d3, 3);
    static_assert((SEQ / 16) % 4 == 0, "hyena k-tiles");
#pragma unroll 1
    for (int q = 0; q < SEQ / 16; q += 4) {
      HY_MMA(a0, d0); HY_LOAD(a0, d0, min(q + 4, SEQ / 16));
      HY_MMA(a1, d1); HY_LOAD(a1, d1, min(q + 5, SEQ / 16));
      HY_MMA(a2, d2); HY_LOAD(a2, d2, min(q + 6, SEQ / 16));
      HY_MMA(a3, d3); HY_LOAD(a3, d3, min(q + 7, SEQ / 16));
    }
    HY_MMA(a0, d0);
#undef HY_LOAD
#undef HY_MMA
    __syncthreads();
    {
      float* Y = (float*)(smem + SM_HR);
      float* yl = Y + bb * SEQ + 16 * (32 * (2 * w) + 4 * h) + sig;
#pragma unroll
      for (int mi = 0; mi < 2; ++mi)
#pragma unroll
        for (int k = 0; k < 16; ++k) yl[16 * (32 * mi + (k & 3) + 8 * (k >> 2))] = acc[mi][k];
    }
    __syncthreads();
    {
      const float* Y = (const float*)(smem + SM_HR);
      const float kn = p.knorm()[l * HYENA_W + ch], dsk = p.hy_d[l * HYENA_W + ch];
      static_assert(BATCH * SEQ == NT * 32, "hyena epilogue shape");
#pragma unroll 1
      for (int hh = 0; hh < 2; ++hh) {
        float4 uu[4], xx[4], yy[4];
#pragma unroll
        for (int i = 0; i < 4; ++i) {
          const int idx = 4 * (tid + NT * (4 * hh + i)); const int b = idx / SEQ, t = idx - b * SEQ;
          const long o = ((long)b * HYENA_W + ch) * SEQ + t;
          uu[i] = *(const float4*)(p.hu() + o); xx[i] = *(const float4*)(p.hx0() + o); yy[i] = *(const float4*)(Y + idx);
        }
#pragma unroll
        for (int i = 0; i < 4; ++i) {
          const int idx = 4 * (tid + NT * (4 * hh + i));
          float* dst = p.mixb() + (long)idx * MIX_W + ATTN_W + ch;
          dst[0] = (yy[i].x * kn + uu[i].x * dsk) * xx[i].x; dst[MIX_W] = (yy[i].y * kn + uu[i].y * dsk) * xx[i].y;
          dst[2 * MIX_W] = (yy[i].z * kn + uu[i].z * dsk) * xx[i].z; dst[3 * MIX_W] = (yy[i].w * kn + uu[i].w * dsk) * xx[i].w;
        }
      }
    }
  }
}
#define SM_K 256
#define SM_V (256 + 8192)
static_assert(HEAD_DIM == 64 && WINDOW == 128 && CTX_LEN == 256 && Q_GROUP == 4, "attention shape");
DEV void ph_attn_mfma(const P& p, int l, char* smem) {
  const int tid = otid(), lane = tid & 63, w = (tid >> 6) & 3, hsel = tid >> 8, h = lane >> 5, ql = lane & 31;
  char* Ks = smem + SM_K; char* Vs = smem + SM_V;
  const int n_lat = BATCH * (SEQ / 128) * N_KV_HEADS * (Q_GROUP / 2);
  const int n_ctx = (l == 0) ? BATCH * (CTX_LEN / 128) * N_KV_HEADS * (Q_GROUP / 2) : 0;
  const float QS = 0.125f * 1.4426950408889634f;
  for (int it = blockIdx.x; it < n_lat + n_ctx; it += gridDim.x) {
    const bool isctx = it >= n_lat;
    int b, qb, kvh, g;
    { int x = isctx ? it - n_lat : it; g = (x & 1) * 2 + hsel; kvh = (x >> 1) & 1; x >>= 2; if (isctx) { qb = x & 1; b = x >> 1; } else { qb = x & 63; b = x >> 6; } }
    const int hq = kvh * Q_GROUP + g;
    const int tq0 = qb * 128 + 32 * w;
    const long qrow = (isctx ? (long)NL + b * CTX_LEN : (long)b * SEQ) + tq0 + ql;
    bf16x8 qf[4];
    {
      const unsigned short* qp = p.qkvb() + qrow * HY_OFF + Q_OFF + hq * HEAD_DIM + 8 * h;
#pragma unroll
      for (int ks = 0; ks < 4; ++ks) qf[ks] = *(const bf16x8*)(qp + 16 * ks);
    }
    f32x16 o0, o1;
#pragma unroll
    for (int k = 0; k < 16; ++k) { o0[k] = 0.f; o1[k] = 0.f; }
    float m = -1e30f, lsum = 0.f;
    const int nsteps = isctx ? 4 : 10;
    u32x4 rk[1], rv[1];
    auto key_row = [&](int step, int key) -> long {
      if (step < 4) return (long)NL + b * CTX_LEN + step * 64 + key;
      const int tk = qb * 128 - 128 + (step - 4) * 64 + key;
      return (tk < 0 || tk >= SEQ) ? -1 : (long)b * SEQ + tk;
    };
    auto step_valid = [&](int step) -> bool { if (step < 4) return true; const int t0 = qb * 128 - 128 + (step - 4) * 64; return t0 >= 0 && t0 < SEQ; };
    auto load_tile = [&](int step) {
#pragma unroll
      for (int i = 0; i < 1; ++i) {
        const int key = (tid >> 3); const long kr = key_row(step, key);
        const unsigned short* kp = p.qkvb() + kr * HY_OFF + K_OFF + kvh * HEAD_DIM + (tid & 7) * 8; const unsigned short* vp = p.qkvb() + kr * HY_OFF + V_OFF + kvh * HEAD_DIM + (tid & 7) * 8;
        rk[i] = *(const u32x4*)kp; rv[i] = *(const u32x4*)vp;
      }
    };
    int step = 0;
    load_tile(0);
    while (step < nsteps) {
      __syncthreads();
#pragma unroll
      for (int i = 0; i < 1; ++i) {
        const int key = (tid >> 3), ch = tid & 7;
        *(u32x4*)(Ks + tile_off(key, ch)) = rk[i];
        *(u32x4*)(Vs + key * 128 + ((ch * 16) ^ (64 * ((key >> 1) & 1)))) = rv[i];
      }
      __syncthreads();
      const int cur = step;
      int nxt = step + 1;
      while (nxt < nsteps && !step_valid(nxt)) ++nxt;
      if (nxt < nsteps) load_tile(nxt);
      step = nxt;
#pragma unroll
      for (int sub = 0; sub < 2; ++sub) {
        const bool win = cur >= 4;
        const int ks0 = win ? qb * 128 - 128 + (cur - 4) * 64 + sub * 32 : 0;
        if (win && (ks0 > tq0 + 31 + WINDOW || ks0 + 31 < tq0 - WINDOW)) continue;
        f32x16 sacc;
#pragma unroll
        for (int k = 0; k < 16; ++k) sacc[k] = 0.f;
#pragma unroll
        for (int ks = 0; ks < 4; ++ks) {
          const bf16x8 kf = *(const bf16x8*)(Ks + tile_off(sub * 32 + ql, 2 * ks + h));
          sacc = __builtin_amdgcn_mfma_f32_32x32x16_bf16(kf, qf[ks], sacc, 0, 0, 0);
        }
        if (win && (ks0 + 31 - tq0 > WINDOW || tq0 + 31 - ks0 > WINDOW)) {
          const int tq = tq0 + ql;
#pragma unroll
          for (int k = 0; k < 16; ++k) { const int d = ks0 + (k & 3) + 8 * (k >> 2) + 4 * h - tq; if (d > WINDOW || d < -WINDOW) sacc[k] = -1e30f; }
        }
        float mx = sacc[0];
#pragma unroll
        for (int k = 1; k < 16; ++k) mx = fmaxf(mx, sacc[k]);
        mx = fmaxf(mx, __shfl_xor(mx, 32));
        const float mn = fmaxf(m, mx); const float alpha = __builtin_amdgcn_exp2f(m - mn); m = mn;
        float ps = 0.f;
#pragma unroll
        for (int k = 0; k < 16; ++k) { sacc[k] = __builtin_amdgcn_exp2f(sacc[k] - mn); ps += sacc[k]; }
        lsum = lsum * alpha + ps;
#pragma unroll
        for (int k = 0; k < 16; ++k) { o0[k] *= alpha; o1[k] *= alpha; }
        u32x2 v00, v01, v02, v03, v10, v11, v12, v13;
        {
          const int q4 = (lane & 15) >> 2, p4 = lane & 3, blk = (lane >> 4) & 1, sq = (q4 >> 1) & 1;
          const unsigned lb = (unsigned)(size_t)((__attribute__((address_space(3))) char*)Vs) + (unsigned)((sub * 32 + 4 * h + q4) * 128 + 32 * blk + 8 * p4);
          const unsigned base0 = lb + 64 * sq, base1 = lb + 64 * (1 - sq);
          asm volatile(
              "ds_read_b64_tr_b16 %0, %8\n\t"
              "ds_read_b64_tr_b16 %1, %8 offset:1024\n\t"
              "ds_read_b64_tr_b16 %2, %8 offset:2048\n\t"
              "ds_read_b64_tr_b16 %3, %8 offset:3072\n\t"
              "ds_read_b64_tr_b16 %4, %9\n\t"
              "ds_read_b64_tr_b16 %5, %9 offset:1024\n\t"
              "ds_read_b64_tr_b16 %6, %9 offset:2048\n\t"
              "ds_read_b64_tr_b16 %7, %9 offset:3072\n\t"
              "s_waitcnt lgkmcnt(0)"
              : "=&v"(v00), "=&v"(v01), "=&v"(v02), "=&v"(v03), "=&v"(v10), "=&v"(v11), "=&v"(v12), "=&v"(v13)
              : "v"(base0), "v"(base1) : "memory");
        }
#pragma unroll
        for (int ks2 = 0; ks2 < 2; ++ks2) {
          u32x4 pw;
#pragma unroll
          for (int i = 0; i < 4; ++i) pw[i] = pack2(sacc[8 * ks2 + 2 * i], sacc[8 * ks2 + 2 * i + 1]);
          const bf16x8 pf = __builtin_bit_cast(bf16x8, pw);
          u32x4 a0, a1;
          if (ks2 == 0) { a0[0] = v00[0]; a0[1] = v00[1]; a0[2] = v01[0]; a0[3] = v01[1]; a1[0] = v10[0]; a1[1] = v10[1]; a1[2] = v11[0]; a1[3] = v11[1]; }
          else          { a0[0] = v02[0]; a0[1] = v02[1]; a0[2] = v03[0]; a0[3] = v03[1]; a1[0] = v12[0]; a1[1] = v12[1]; a1[2] = v13[0]; a1[3] = v13[1]; }
          o0 = __builtin_amdgcn_mfma_f32_32x32x16_bf16(__builtin_bit_cast(bf16x8, a0), pf, o0, 0, 0, 0);
          o1 = __builtin_amdgcn_mfma_f32_32x32x16_bf16(__builtin_bit_cast(bf16x8, a1), pf, o1, 0, 0, 0);
        }
      }
    }
    lsum += __shfl_xor(lsum, 32);
    const float sk = p.sink[l * N_Q_HEADS + hq] * 1.4426950408889634f;
    const float mf = fmaxf(m, sk); const float sc = __builtin_amdgcn_exp2f(m - mf); const float inv = sc / (lsum * sc + __builtin_amdgcn_exp2f(sk - mf));
    float* op = p.mixb() + qrow * MIX_W + hq * HEAD_DIM + 4 * h;
#pragma unroll
    for (int gq = 0; gq < 4; ++gq) {
      *(float4*)(op + 8 * gq) = make_float4(o0[4 * gq] * inv, o0[4 * gq + 1] * inv, o0[4 * gq + 2] * inv, o0[4 * gq + 3] * inv);
      *(float4*)(op + 32 + 8 * gq) = make_float4(o1[4 * gq] * inv, o1[4 * gq + 1] * inv, o1[4 * gq + 2] * inv, o1[4 * gq + 3] * inv);
    }
  }
}


static_assert(S5_T == 64 && S5_STATE == 64 && S5_GROUP == 16 && S5_GROUPS == 16 && NCH == 132, "s5 mfma shape");
#define S5_COLS (BATCH * NCH)
#define S5_RT 88
DEV void ph_s5tables_gpu(const P& p, long gtid, long gsize) {
  FOR_ITEMS4(i, (long)DEPTH * 2 * S5_GROUPS * 128 * 1024) {
    const int k = (int)(i & 1023), n = (int)((i >> 10) & 127); const long ldg = i >> 17;
    const int ri = n >> 6, pp = n & 63, sidx = k >> 4, j = k & 15;
    const float2 lp = p.lampow()[(ldg * (S5_T + 1) + (S5_T - 1 - sidx)) * S5_STATE + pp]; const float2 bb = p.bbar()[(ldg * S5_STATE + pp) * S5_GROUP + j];
    p.bmtb()[i] = (unsigned short)f2bf(ri ? lp.x * bb.y + lp.y * bb.x : lp.x * bb.x - lp.y * bb.y);
  }
  FOR_ITEMS4(i, (long)DEPTH * 2 * S5_GROUPS * 128 * 1024) {
    const int k = (int)(i & 127), n = (int)((i >> 7) & 1023); const long ldg = i >> 17; const int dir = (int)((ldg >> 4) & 1);
    const int ri = k >> 6, pp = k & 63, tl = n >> 4, ii = n & 15; const int tau = dir ? 63 - tl : tl;
    const float cr = p.s5_c_re[(ldg * S5_GROUP + ii) * S5_STATE + pp], ci = p.s5_c_im[(ldg * S5_GROUP + ii) * S5_STATE + pp];
    const float2 lp = p.lampow()[(ldg * (S5_T + 1) + tau + 1) * S5_STATE + pp];
    p.cmtb()[i] = (unsigned short)f2bf(ri ? -(cr * lp.y + ci * lp.x) : cr * lp.x - ci * lp.y);
  }
}
DEV void ph_kcb_gpu(const P& p, long gtid, long gsize) {
  FOR_ITEMS4(i, (long)DEPTH * 2 * S5_GROUPS * S5_T * 256) p.kcb()[i] = (unsigned short)f2bf(p.kc()[i]);
}
struct ALS5U { const char* base; unsigned off0[2]; int stepb; const char* hbase; unsigned hoff[2]; int nki;
  DEVM void set(int i, int b, int dir, int chunk, int sl, unsigned joff) { off0[i] = (unsigned)s5_row(b, dir, chunk * S5_T + sl) * (unsigned)(S5_W * 2) + joff; }
  DEVM const unsigned short* a(int i, int kt) const {
    if (kt >= nki) return (const unsigned short*)(hbase + (hoff[i] + (unsigned)(kt - nki) * 128u));
    return (const unsigned short*)(base + (off0[i] + (unsigned)(kt * stepb))); } };
struct BLKc { const char* kc; const char* cm; int tl, i0, sj, ss, dir, nki; unsigned cmoff;
  DEVM void load(u32x4 (&rb)[4], int kt) const {
    if (kt >= nki) {
#pragma unroll
      for (int c = 0; c < 4; ++c) rb[c] = *(const u32x4*)(cm + (cmoff + (unsigned)(c * 128 + (kt - nki) * 64) * 2u));
      return;
    }
    const int d = (dir ? 63 - tl : tl) - (4 * kt + ss);
    if (d < 0) {
#pragma unroll
      for (int c = 0; c < 4; ++c) rb[c] = (u32x4){0u, 0u, 0u, 0u};
    } else {
#pragma unroll
      for (int c = 0; c < 4; ++c) rb[c] = *(const u32x4*)(kc + (unsigned)(((d * 16 + i0 + c) * 16 + sj) * 2));
    }
  } };
DEV void ph_s5_sgemm(const P& p, int l, char* smem) {
  const int tid = otid();
  const int nitems = 2 * S5_GROUPS * 3;
  for (int it = blockIdx.x; it < nitems; it += gridDim.x) {
    const int rt = it % 3, g = (it / 3) % S5_GROUPS, dir = it / (3 * S5_GROUPS);
    ALS5U al; al.base = (const char*)(p.s5u() + g * S5_GROUP); al.stepb = (dir ? -4 : 4) * S5_W * 2; al.nki = 1 << 20; al.hbase = al.base; al.hoff[0] = al.hoff[1] = 0;
#pragma unroll
    for (int i = 0; i < 2; ++i) { const int col = rt * S5_RT + min((tid >> 3) + 64 * i, S5_RT - 1); al.set(i, col / NCH, dir, col % NCH, (tid & 7) >> 1, (tid & 1) * 16); }
    BLT bl; bl.base = (const char*)(p.bmtb() + (((long)l * 2 + dir) * S5_GROUPS + g) * 128 * 1024); bl.rowb = 1024 * 2;
    bl.voff = (unsigned)((((tid >> 3) & 31) * 4)) * bl.rowb + (unsigned)((tid & 7) * 16);
    f32x4 acc[4][4]; acc_zero(acc);
    gemm_tb(al, bl, 16, acc, smem);
    EPI_BEGIN
    if (((etid >> 6) & 3) < 2) {
#pragma unroll
      for (int m = 0; m < 4; ++m)
#pragma unroll
        for (int j = 0; j < 4; ++j) {
          const int rl = EPI_ROW(m, j);
          if (rl < S5_RT) {
            const int col = rt * S5_RT + rl; const int b = col / NCH, c = col % NCH;
            float* dst = (float*)(p.sc() + ((((long)b * 2 + dir) * S5_GROUPS + g) * NCH + c) * S5_STATE);
#pragma unroll
            for (int n = 0; n < 4; ++n) { const int nn = EPI_COL(n); dst[(nn & 63) * 2 + (nn >> 6)] = acc[m][n][j]; }
          }
        }
    }
  }
}

static_assert(NCH == 132, "carry scan grouping");
DEV void ph_s5_carry_gpu(const P& p, int l, char* smem) {
  const int tid = otid();
  float2* E = (float2*)(smem + SM_MISC);
  const int nchains = BATCH * 2 * S5_GROUPS * S5_STATE;
  for (int cb = blockIdx.x * 16; cb < nchains; cb += gridDim.x * 16) {
    const int cl = tid & 15, grp = tid >> 4; const bool act = tid < 176;
    const int chain = cb + cl;
    const int pp = chain % S5_STATE, g = (chain / S5_STATE) % S5_GROUPS, dir = (chain / (S5_STATE * S5_GROUPS)) % 2, b = chain / (S5_STATE * S5_GROUPS * 2);
    const long ldg = ((long)l * 2 + dir) * S5_GROUPS + g;
    const long base = (((long)b * 2 + dir) * S5_GROUPS + g) * NCH + grp * 12;
    float2 lt = make_float2(0.f, 0.f); float2 L[12]; float hr = 0.f, hi = 0.f;
    __syncthreads();
    if (act) {
      lt = p.lampow()[(ldg * (S5_T + 1) + S5_T) * S5_STATE + pp];
      float2 sv[12];
#pragma unroll
      for (int k = 0; k < 12; ++k) sv[k] = p.sc()[(base + k) * S5_STATE + pp];
#pragma unroll
      for (int k = 0; k < 12; ++k) { L[k] = make_float2(hr, hi); const float nr = lt.x * hr - lt.y * hi + sv[k].x, ni = lt.x * hi + lt.y * hr + sv[k].y; hr = nr; hi = ni; }
      E[grp * 16 + cl] = make_float2(hr, hi);
    }
    __syncthreads();
    if (act) {
      float pr = lt.x, pi = lt.y;
#pragma unroll
      for (int k = 1; k < 12; ++k) { const float nr = pr * lt.x - pi * lt.y, ni = pr * lt.y + pi * lt.x; pr = nr; pi = ni; }
      float gr = 0.f, gi = 0.f;
      for (int gp = 0; gp < grp; ++gp) { const float2 e = E[gp * 16 + cl]; const float nr = pr * gr - pi * gi + e.x, ni = pr * gi + pi * gr + e.y; gr = nr; gi = ni; }
#pragma unroll
      for (int k = 0; k < 12; ++k) {
        const float vr = L[k].x + gr, vi = L[k].y + gi;
        p.hcbf()[(base + k) * 2 * S5_STATE + pp] = f2bf16(vr); p.hcbf()[(base + k) * 2 * S5_STATE + S5_STATE + pp] = f2bf16(vi);
        const float nr = lt.x * gr - lt.y * gi, ni = lt.x * gi + lt.y * gr; gr = nr; gi = ni;
      }
    }
  }
}
DEV void ph_s5_ygemm(const P& p, int l, char* smem) {
  const int tid = otid();
  const int nitems = S5_GROUPS * 3 * 4;
  for (int it = blockIdx.x; it < nitems; it += gridDim.x) {
    const int nt = it & 3, rt = (it >> 2) % 3, g = it / 12;
    f32x4 acc[4][4]; acc_zero(acc);
#pragma unroll 1
    for (int dir = 0; dir < 2; ++dir) {
      const long ldg = ((long)l * 2 + dir) * S5_GROUPS + g;
      const int nki = dir ? 16 - 4 * nt : 4 * nt + 4;
      ALS5U al; al.base = (const char*)(p.s5u() + g * S5_GROUP); al.stepb = (dir ? -4 : 4) * S5_W * 2; al.nki = nki; al.hbase = (const char*)p.hcbf();
#pragma unroll
      for (int i = 0; i < 2; ++i) {
        const int col = rt * S5_RT + min((tid >> 3) + 64 * i, S5_RT - 1); const int b = col / NCH, blk = col % NCH;
        const int ch = dir ? (blk < 4 ? 3 - blk : 135 - blk) : blk;
        al.set(i, b, dir, ch, (tid & 7) >> 1, (tid & 1) * 16);
        al.hoff[i] = (unsigned)((((b * 2 + dir) * S5_GROUPS + g) * NCH + ch) * 128 + (tid & 7) * 8) * 2u;
      }
      BLKc bk; bk.kc = (const char*)(p.kcb() + ldg * S5_T * 256); bk.tl = 16 * nt + (tid >> 5); bk.i0 = ((tid >> 3) & 3) * 4; bk.sj = (tid & 1) * 8; bk.ss = (tid & 7) >> 1; bk.dir = dir; bk.nki = nki;
      bk.cm = (const char*)(p.cmtb() + ldg * 1024 * 128); bk.cmoff = (unsigned)(((16 * nt + (tid >> 5)) * 16 + ((tid >> 3) & 3) * 4) * 128 + (tid & 7) * 8) * 2u;
      gemm_tb(al, bk, nki + 2, acc, smem);
    }
    EPI_BEGIN
#pragma unroll
    for (int m = 0; m < 4; ++m)
#pragma unroll
      for (int j = 0; j < 4; ++j) {
        const int rl = EPI_ROW(m, j);
        if (rl < S5_RT) {
          const int col = rt * S5_RT + rl; const int b = col / NCH, blk = col % NCH;
#pragma unroll
          for (int n = 0; n < 4; ++n) {
            const int nn = nt * 256 + EPI_COL(n); const int tl = nn >> 4, chn = g * S5_GROUP + (nn & 15);
            const long row = blk < 4 ? (long)NL + b * CTX_LEN + blk * 64 + tl : (long)b * SEQ + (blk - 4) * 64 + tl;
            const float y = acc[m][n][j] + p.s5_d[l * S5_W + chn] * __uint_as_float((unsigned)p.s5u()[row * S5_W + chn] << 16);
            const float gy = gelu_tanhf(y);
            p.ybuf()[row * S5_W + chn] = gy; p.ybf()[row * S5_W + chn] = (unsigned short)f2bf(gy);
          }
        }
      }
  }
}

DEV float wave_sum(float v) {
#pragma unroll
  for (int o = 32; o > 0; o >>= 1) v += __shfl_xor(v, o);
  return v;
}
DEV void st_bf4(unsigned short* dst, float a, float b, float c, float d) { u32x2 v; v[0] = pack2(a, b); v[1] = pack2(c, d); *(u32x2*)dst = v; }
static_assert(BATCH == 2, "mod partial layout");
DEV void ph_modsum_gpu(const P& p, long gtid, long gsize) {
  FOR_ITEMS(i, (long)DEPTH * (BATCH + 1) * 6 * D_MODEL) {
    const int n = (int)(i % (6 * D_MODEL)); const int j = (int)((i / (6 * D_MODEL)) % (BATCH + 1)); const int l = (int)(i / (6 * D_MODEL * (BATCH + 1)));
    float acc = p.b_ada[l * 6 * D_MODEL + n];
#pragma unroll
    for (int sl = 0; sl < 16; ++sl) acc += p.modp()[((long)(l * 16 + sl) * (BATCH + 1) + j) * 6 * D_MODEL + n];
    p.mod()[i] = acc;
  }
}
DEV void ph_modu0_gpu(const P& p, long gtid, long gsize) {
  FOR_ITEMS4(i4, (long)NR * D_MODEL / 4) {
    const long i = i4 * 4; const int k = (int)(i % D_MODEL); const long r = i / D_MODEL;
    const float* m = p.mod() + (long)modrow(r) * 6 * D_MODEL;
    const float4 x = *(const float4*)(p.xcur() + i); const float4 sh = *(const float4*)(m + k); const float4 sc = *(const float4*)(m + D_MODEL + k);
    st_bf4(p.ubf() + i, x.x * (1.f + sc.x) + sh.x, x.y * (1.f + sc.y) + sh.y, x.z * (1.f + sc.z) + sh.z, x.w * (1.f + sc.w) + sh.w);
  }
}
DEV void rms_rows(const P& p, int l, long r0, long r1, int w0, int nw) {
  const int lane = otid() & 63;
  for (long r = r0 + w0; r < r1; r += nw) {
    const float* v = p.mixb() + r * MIX_W; float4 a[4]; float ss[4];
#pragma unroll
    for (int i = 0; i < 4; ++i) { a[i] = *(const float4*)(v + (i * 64 + lane) * 4); ss[i] = a[i].x * a[i].x + a[i].y * a[i].y + a[i].z * a[i].z + a[i].w * a[i].w; }
    const float s_att = wave_sum(ss[0] + ss[1]), s_hy = wave_sum(ss[2]), s_s5 = wave_sum(ss[3]);
    float rs[4]; rs[0] = rs[1] = 1.0f / sqrtf(s_att / (float)ATTN_W + LN_EPS); rs[2] = 1.0f / sqrtf(s_hy / (float)HYENA_W + LN_EPS); rs[3] = 1.0f / sqrtf(s_s5 / (float)S5_W + LN_EPS);
#pragma unroll
    for (int i = 0; i < 4; ++i) {
      const int k = (i * 64 + lane) * 4; const float4 g = *(const float4*)(p.mix_g + l * MIX_W + k);
      st_bf4(p.mixbf() + r * MIX_W + k, a[i].x * rs[i] * g.x, a[i].y * rs[i] * g.y, a[i].z * rs[i] * g.z, a[i].w * rs[i] * g.w);
    }
  }
}
DEV void ln_rows(float4 (&a)[4], const float* gw, const float* bw, int lane) {
  float s = 0.f;
#pragma unroll
  for (int i = 0; i < 4; ++i) s += a[i].x + a[i].y + a[i].z + a[i].w;
  const float mu = wave_sum(s) / (float)D_MODEL; float q = 0.f;
#pragma unroll
  for (int i = 0; i < 4; ++i) { a[i].x -= mu; a[i].y -= mu; a[i].z -= mu; a[i].w -= mu; q += a[i].x * a[i].x + a[i].y * a[i].y + a[i].z * a[i].z + a[i].w * a[i].w; }
  const float rs = 1.0f / sqrtf(wave_sum(q) / (float)D_MODEL + LN_EPS);
#pragma unroll
  for (int i = 0; i < 4; ++i) {
    const int k = (i * 64 + lane) * 4; const float4 g = *(const float4*)(gw + k), b = *(const float4*)(bw + k);
    a[i].x = a[i].x * rs * g.x + b.x; a[i].y = a[i].y * rs * g.y + b.y; a[i].z = a[i].z * rs * g.z + b.z; a[i].w = a[i].w * rs * g.w + b.w;
  }
}
DEV void ph_ln1_gpu(const P& p, int l) {
  const int tid_ = otid(); const int lane = tid_ & 63; const int gw = blockIdx.x * (NT / 64) + (tid_ >> 6), nw = gridDim.x * (NT / 64);
  for (long r = gw; r < NR; r += nw) {
    float4 a[4];
#pragma unroll
    for (int i = 0; i < 4; ++i) a[i] = *(const float4*)(p.tmp() + r * D_MODEL + (i * 64 + lane) * 4);
    ln_rows(a, p.ln1_g + l * D_MODEL, p.ln1_b + l * D_MODEL, lane);
    const float* m = p.mod() + ((long)l * (BATCH + 1) + modrow(r)) * 6 * D_MODEL + 3 * D_MODEL;
#pragma unroll
    for (int i = 0; i < 4; ++i) {
      const int k = (i * 64 + lane) * 4;
      *(float4*)(p.xcur() + r * D_MODEL + k) = a[i];
      const float4 sh = *(const float4*)(m + k), sc = *(const float4*)(m + D_MODEL + k);
      const float u0 = a[i].x * (1.f + sc.x) + sh.x, u1 = a[i].y * (1.f + sc.y) + sh.y, u2 = a[i].z * (1.f + sc.z) + sh.z, u3 = a[i].w * (1.f + sc.w) + sh.w;
      st_bf4(p.ubf() + r * D_MODEL + k, u0, u1, u2, u3);
      st_bf4(p.ubl() + r * D_MODEL + k, bflo(u0), bflo(u1), bflo(u2), bflo(u3));
    }
  }
}
DEV void exp_prefix(const P& p, int l, int* toff, int* roff, int* rowo);
DEV void ph_ln2_gpu(const P& p, int l, char* smem) {
  const int tid_ = otid(); const int lane = tid_ & 63; const int gw = blockIdx.x * (NT / 64) + (tid_ >> 6), nw = gridDim.x * (NT / 64);
  int* toff = (int*)(smem + SM_MISC); int* roff = toff + N_EXPERTS + 1; int* rowo = roff + N_EXPERTS + 16;
  exp_prefix(p, l, toff, roff, rowo);
  int e_n = 0, s_n = 0;
  if (gw < NR && lane < TOP_K) { e_n = p.top_e()[(long)gw * TOP_K + lane]; s_n = p.posb()[(long)gw * TOP_K + lane]; }
  for (long r = gw; r < NR; r += nw) {
    const int myrow = rowo[e_n] + s_n;
    if (r + nw < NR && lane < TOP_K) { e_n = p.top_e()[(r + nw) * TOP_K + lane]; s_n = p.posb()[(r + nw) * TOP_K + lane]; }
    float4 a[4];
    const float* m = p.mod() + ((long)l * (BATCH + 1) + modrow(r)) * 6 * D_MODEL + 5 * D_MODEL;
#pragma unroll
    for (int i = 0; i < 4; ++i) {
      const int k = (i * 64 + lane) * 4;
      float4 f = *(const float4*)(p.ysh() + r * D_MODEL + k);
#pragma unroll
      for (int kk = 0; kk < TOP_K; ++kk) { const u32x2 y = *(const u32x2*)(p.ykb() + (long)__builtin_amdgcn_readlane(myrow, kk) * D_MODEL + k); f.x += __uint_as_float(y[0] << 16); f.y += __uint_as_float(y[0] & 0xffff0000u); f.z += __uint_as_float(y[1] << 16); f.w += __uint_as_float(y[1] & 0xffff0000u); }
      const float4 x = *(const float4*)(p.xcur() + r * D_MODEL + k), g2 = *(const float4*)(m + k);
      a[i].x = DN_ALPHA * x.x + g2.x * f.x; a[i].y = DN_ALPHA * x.y + g2.y * f.y; a[i].z = DN_ALPHA * x.z + g2.z * f.z; a[i].w = DN_ALPHA * x.w + g2.w * f.w;
    }
    ln_rows(a, p.ln2_g + l * D_MODEL, p.ln2_b + l * D_MODEL, lane);
    const float* mn = p.mod() + ((long)(l + 1) * (BATCH + 1) + modrow(r)) * 6 * D_MODEL;
#pragma unroll
    for (int i = 0; i < 4; ++i) {
      const int k = (i * 64 + lane) * 4;
      *(float4*)(p.xcur() + r * D_MODEL + k) = a[i];
      if (l + 1 < DEPTH) {
        const float4 sh = *(const float4*)(mn + k), sc = *(const float4*)(mn + D_MODEL + k);
        st_bf4(p.ubf() + r * D_MODEL + k, a[i].x * (1.f + sc.x) + sh.x, a[i].y * (1.f + sc.y) + sh.y, a[i].z * (1.f + sc.z) + sh.z, a[i].w * (1.f + sc.w) + sh.w);
      } else if (r < NL) *(float4*)(p.out + r * D_MODEL + k) = a[i];
    }
  }
}
struct ALRouter { const char* hi; const char* lo_; unsigned off[2];
  DEVM const unsigned short* a(int i, int kt) const { return (const unsigned short*)((kt >= 32 ? lo_ : hi) + (off[i] + (unsigned)(kt & 15) * 128u)); } };
struct BLRouter { const char* base; const char* lob; unsigned voff; unsigned rowb;
  DEVM void load(u32x4 (&rb)[4], int kt) const {
    const char* bb = (kt >> 4) == 1 ? lob : base;
#pragma unroll
    for (int c = 0; c < 4; ++c) rb[c] = *(const u32x4*)(bb + (voff + (unsigned)c * rowb + (unsigned)(kt & 15) * 128u)); } };
DEV void ph_router_mfma(const P& p, int l, char* smem) {
  const int tid = otid();
  const int n_router = (NR >> 7), n_sh = (NR >> 7) * 2;
  const int nrb = (int)gridDim.x >= 64 ? (int)((gridDim.x * 3) / 5) : 0;
  const bool is_router = nrb == 0 ? false : (int)blockIdx.x < nrb;
  for (int pass = 0; pass < 2; ++pass) {
    const bool do_router = nrb == 0 ? pass == 0 : is_router;
    if (nrb != 0 && pass == 1) break;
    const int first = nrb == 0 ? (int)blockIdx.x : (do_router ? (int)blockIdx.x : (int)blockIdx.x - nrb);
    const int stride = nrb == 0 ? (int)gridDim.x : (do_router ? nrb : (int)gridDim.x - nrb);
    const int nit = do_router ? n_router : n_sh;
    for (int it = first; it < nit; it += stride) {
      const int rt = do_router ? it : (it >> 1), cq = do_router ? 0 : (it & 1);
      ALRouter ar; ar.hi = (const char*)(p.ubf() + (long)rt * 128 * D_MODEL); ar.lo_ = (const char*)(p.ubl() + (long)rt * 128 * D_MODEL);
#pragma unroll
      for (int i = 0; i < 2; ++i) ar.off[i] = (unsigned)(((tid >> 3) + 64 * i) * D_MODEL + (tid & 7) * 8) * 2u;
      BLRouter br; int nk;
      if (do_router) {
        br.base = (const char*)(p.wt_rh() + (long)l * N_EXPERTS * D_MODEL); br.lob = (const char*)(p.wt_rl() + (long)l * N_EXPERTS * D_MODEL); br.rowb = D_MODEL * 2;
        br.voff = (unsigned)((tid >> 3) * 4) * br.rowb + (unsigned)((tid & 7) * 16); nk = 3 * (D_MODEL >> 6);
      } else {
        const int nq = tid >> 3; const int wsel = __builtin_amdgcn_readfirstlane(tid >> 6) & 1;
        const unsigned short* wsrc = (wsel ? p.wt_shu() : p.wt_shg()) + (long)l * SHARED_FF * D_MODEL;
        br.base = (const char*)wsrc; br.lob = br.base; br.rowb = D_MODEL * 2;
        br.voff = (unsigned)(cq * 128 + (nq >> 4) * 32 + (nq & 7) * 4) * br.rowb + (unsigned)((tid & 7) * 16); nk = D_MODEL >> 6;
      }
      f32x4 acc[4][4]; acc_zero(acc);
      gemm_tb(ar, br, nk, acc, smem);
      EPI_BEGIN
      if (do_router) {
#pragma unroll
        for (int m = 0; m < 4; ++m)
#pragma unroll
          for (int n = 0; n < 4; ++n)
#pragma unroll
            for (int j = 0; j < 4; ++j) p.rl()[((long)rt * 128 + EPI_ROW(m, j)) * N_EXPERTS + EPI_COL(n)] = acc[m][n][j];
      } else {
        const int elane = etid & 63, ewc = (etid >> 6) & 3;
#pragma unroll
        for (int m = 0; m < 4; ++m)
#pragma unroll
          for (int j = 0; j < 4; ++j)
          { unsigned short* dst = p.hsbf() + ((long)rt * 128 + EPI_ROW(m, j)) * SHARED_FF + cq * 128 + ewc * 32 + (elane & 15);
            dst[0] = (unsigned short)f2bf(siluq(acc[m][0][j]) * acc[m][2][j]); dst[16] = (unsigned short)f2bf(siluq(acc[m][1][j]) * acc[m][3][j]); }
      }
    }
  }
}
static_assert(EPG == 32 && TOP_K == 8 && N_EXPERT_GROUPS == 8 && TOPK_GROUPS == 4, "select shape");
DEV void ph_select_gpu(const P& p, int l) {
  const int tid_ = otid(); const int lane = tid_ & 63; const int gw = blockIdx.x * (NT / 64) + (tid_ >> 6), nw = gridDim.x * (NT / 64);
  const float4 rb = *(const float4*)(p.router_bias + l * N_EXPERTS + 4 * lane);
  for (long r = gw; r < NR; r += nw) {
    const float4 lg = *(const float4*)(p.rl() + r * N_EXPERTS + 4 * lane);
    float sc[4] = {sigmoidf_(lg.x), sigmoidf_(lg.y), sigmoidf_(lg.z), sigmoidf_(lg.w)};
    float bz[4] = {sc[0] + rb.x, sc[1] + rb.y, sc[2] + rb.z, sc[3] + rb.w};
    float m1 = fmaxf(bz[0], bz[1]), m2 = fminf(bz[0], bz[1]);
#pragma unroll
    for (int c = 2; c < 4; ++c) { const float v = bz[c]; m2 = fmaxf(m2, fminf(m1, v)); m1 = fmaxf(m1, v); }
#pragma unroll
    for (int o = 1; o < 8; o <<= 1) { const float b1 = __shfl_xor(m1, o), b2 = __shfl_xor(m2, o); m2 = fmaxf(fminf(m1, b1), fmaxf(m2, b2)); m1 = fmaxf(m1, b1); }
    const float gs = m1 + m2; const int mg = lane >> 3; int rank = 0;
#pragma unroll
    for (int j = 0; j < 8; ++j) { const float gj = __shfl(gs, j * 8); rank += (gj > gs || (gj == gs && j < mg)) ? 1 : 0; }
    if (rank >= TOPK_GROUPS) { bz[0] = bz[1] = bz[2] = bz[3] = -1e30f; }
    int sel_e[TOP_K]; float sel_s[TOP_K]; float gsum = 0.f;
#pragma unroll
    for (int it = 0; it < TOP_K; ++it) {
      float bv = bz[0]; int bc = 0;
#pragma unroll
      for (int c = 1; c < 4; ++c) if (bz[c] > bv) { bv = bz[c]; bc = c; }
      int bi = 4 * lane + bc; float bs = sc[bc];
      const int myi = bi;
#pragma unroll
      for (int o = 1; o < 64; o <<= 1) {
        const float ov = __shfl_xor(bv, o); const int oi = __shfl_xor(bi, o); const float os = __shfl_xor(bs, o);
        if (ov > bv || (ov == bv && oi < bi)) { bv = ov; bi = oi; bs = os; }
      }
      sel_e[it] = bi; sel_s[it] = bs; gsum += bs;
      if (bi == myi) {
#pragma unroll
        for (int c = 0; c < 4; ++c) if (c == bc) bz[c] = -1e30f;
      }
    }
    const float inv = ROUTED_SCALE / gsum;
    int me = sel_e[0]; float ms = sel_s[0];
#pragma unroll
    for (int it = 1; it < TOP_K; ++it) if (lane == it) { me = sel_e[it]; ms = sel_s[it]; }
    if (lane < TOP_K) {
      const long a = r * TOP_K + lane;
      p.top_e()[a] = me; p.gate()[a] = ms * inv;
      const int pos = atomicAdd(&p.cnt()[l * N_EXPERTS + me], 1);
      p.elist()[(long)me * NR + pos] = (int)a; p.egate()[(long)me * NR + pos] = ms * inv; p.posb()[a] = pos;
    }
  }
}
#endif

#ifndef CPU_TEST
#define XB_TMO      128
#define XB_XCNT(j)  (256  + 64 * (j))
#define XB_XSUB(j)  (1280 + 64 * (j))
#define XB_XGEN(j)  (2304 + 64 * (j))
#define XB_TOP      3328
#define XB_TOPGEN   3392
#define XCD_BAR_WORDS 3456
#define XB_SPIN_CAP (1u << 18)
#define LAS __attribute__((address_space(3)))
__device__ __forceinline__ unsigned xb_ld(unsigned* p)              { return __hip_atomic_load(p, __ATOMIC_RELAXED, __HIP_MEMORY_SCOPE_AGENT); }
__device__ __forceinline__ unsigned xb_add(unsigned* p, unsigned v) { return __hip_atomic_fetch_add(p, v, __ATOMIC_RELAXED, __HIP_MEMORY_SCOPE_AGENT); }
__device__ __forceinline__ unsigned xb_xcc_id() { return (unsigned)__builtin_amdgcn_s_getreg((3 << 11) | 20) & 0xFu; }
#define XB_SPIN(cond, bar) do { unsigned _sp = 0; while (cond) { __builtin_amdgcn_s_sleep(1); \
    if ((++_sp & 255u) == 0u) { if (xb_ld(&(bar)[XB_TMO])) break; if (_sp > XB_SPIN_CAP) { atomicAdd(&(bar)[XB_TMO], 1u); break; } } } } while (0)
struct XcdBarrier { unsigned* bar; unsigned x; volatile LAS unsigned* st; };
__device__ __forceinline__ XcdBarrier xcd_barrier_post(unsigned* bar, volatile LAS unsigned* st) {
    XcdBarrier b; b.bar = bar; b.x = xb_xcc_id(); b.st = st;
    if (threadIdx.x == 0) (void)xb_add(&bar[XB_XCNT(b.x)], 1u);
    return b;
}
__device__ __forceinline__ void xcd_barrier_complete(unsigned* bar, unsigned x, unsigned& nloc, unsigned& nx) {
    const unsigned G = gridDim.x * gridDim.y * gridDim.z;
    unsigned sum, cnt, mine, sp = 0u;
    for (;;) {
        sum = 0u; cnt = 0u; mine = 0u;
#pragma unroll
        for (unsigned j = 0; j < 16; ++j) { const unsigned c = xb_ld(&bar[XB_XCNT(j)]); sum += c; cnt += (c > 0u) ? 1u : 0u; mine = (j == x) ? c : mine; }
        if (sum == G) break;
        __builtin_amdgcn_s_sleep(1);
        if ((++sp & 255u) == 0u) { if (xb_ld(&bar[XB_TMO])) break; if (sp > XB_SPIN_CAP) { atomicAdd(&bar[XB_TMO], 1u); break; } }
    }
    nloc = mine > 0u ? mine : 1u; nx = cnt > 0u ? cnt : 1u;
}
__device__ __forceinline__ void xcd_barrier(const XcdBarrier& b) {
    asm volatile("s_waitcnt vmcnt(0)" ::: "memory");
    __syncthreads();
    if (threadIdx.x == 0) {
        unsigned* bar = b.bar;
        unsigned bx = b.x; asm volatile("" : "+s"(bx));
        __builtin_amdgcn_s_waitcnt(0);
        unsigned nloc = b.st[0], nx = b.st[1];
        if (nloc == 0u) { xcd_barrier_complete(bar, bx, nloc, nx); b.st[0] = nloc; b.st[1] = nx; }
        const unsigned old = xb_add(&bar[XB_XSUB(bx)], 1u);
        const unsigned gen = old / nloc;
        if (old + 1u == (gen + 1u) * nloc) {
            __builtin_amdgcn_fence(__ATOMIC_RELEASE, "agent");
            asm volatile("s_waitcnt vmcnt(0)" ::: "memory");
            const unsigned og = xb_add(&bar[XB_TOP], 1u);
            const unsigned tg = og / nx;
            if (og + 1u == (tg + 1u) * nx) xb_add(&bar[XB_TOPGEN], 1u);
            else XB_SPIN(xb_ld(&bar[XB_TOPGEN]) == tg, bar);
            __builtin_amdgcn_fence(__ATOMIC_ACQUIRE, "agent");
            xb_add(&bar[XB_XGEN(bx)], 1u);
            asm volatile("s_waitcnt vmcnt(0)" ::: "memory");
        } else {
            XB_SPIN(xb_ld(&bar[XB_XGEN(bx)]) == gen, bar);
            __builtin_amdgcn_fence(__ATOMIC_ACQUIRE, "agent");
            asm volatile("s_waitcnt vmcnt(0)" ::: "memory");
        }
    }
    __syncthreads();
}
#define GRID_SYNC() xcd_barrier(xb)
#else
#define GRID_SYNC() do {} while (0)
#endif

#ifndef CPU_TEST
#define GPUSEL(a, b) a
#else
#define GPUSEL(a, b) b
#endif
#ifndef CPU_TEST
#define OPAQUE_S(v) asm volatile("" : "+s"(v))
#define OPAQUE_V(v) asm volatile("" : "+v"(v))
#else
#define OPAQUE_S(v) do {} while (0)
#define OPAQUE_V(v) do {} while (0)
#endif
#ifndef PROBE_MASK
#define PROBE_MASK 0
#endif
#define LPHASE(stmt) do { int l = lo; OPAQUE_S(l); if (SINGLE && ((PROBE_MASK >> (ph - NG - lo * NLP)) & 1)) { long gtid = gtid0; OPAQUE_V(gtid); stmt; GRID_SYNC(); } PHASE(stmt); } while (0)
#define PHASE(stmt) do { if (SINGLE || ph == only) { long gtid = gtid0; OPAQUE_V(gtid); stmt; } if (SINGLE) { GRID_SYNC(); } ++ph; } while (0)
#ifndef CPU_TEST
template <bool SINGLE> __device__ __forceinline__ void run_seq(const P& p, long gtid0, long gsize, int only, const XcdBarrier& xb, char* smem)
#else
template <bool SINGLE> static int run_seq(const P& p, long gtid0, long gsize, int only)
#endif
{
  int ph = 0;
  PHASE(ph_g0(p, gtid, gsize));
  PHASE(ph_g1(p, gtid, gsize));
  PHASE(ph_g2(p, gtid, gsize));
  PHASE(ph_g3(p, gtid, gsize));
  PHASE(ph_g4(p, gtid, gsize));
#pragma unroll 1
  for (int lo = 0; lo < DEPTH; ++lo) {
    LPHASE(ph_modu(p, l, 0, gtid, gsize));
    LPHASE(GPUSEL(ph_proj_mfma(p, l, smem), ph_proj(p, l, gtid, gsize)));
    LPHASE(ph_post_proj(p, l, gtid, gsize));
    LPHASE(ph_mix(p, l, gtid, gsize); GPUSEL((ph_attn_mfma(p, l, smem), ph_hyena_mfma(p, l, smem)), (void)0));
    LPHASE(ph_s5out(p, l, gtid, gsize));
    LPHASE(GPUSEL(ph_glu_mfma(p, l, smem), ph_glu(p, l, gtid, gsize)));
    LPHASE(ph_rms(p, l, gtid, gsize));
    LPHASE(GPUSEL(ph_outproj_mfma(p, l, smem), ph_outproj(p, l, gtid, gsize)));
    LPHASE(ph_ln(p, l, 0, gtid, gsize));
    LPHASE(ph_router(p, l, gtid, gsize));
    LPHASE(ph_select(p, l, gtid, gsize));
    LPHASE(ph_sortrows(p, l, gtid, gsize));
    LPHASE(GPUSEL(ph_expert_up_mfma(p, l, smem), ph_expert_up(p, l, gtid, gsize)));
    LPHASE(GPUSEL(ph_expert_down_mfma(p, l, smem), ph_expert_down(p, l, gtid, gsize)));
    LPHASE(ph_combine(p, l, gtid, gsize));
    LPHASE(ph_ln(p, l, 1, gtid, gsize));
  }
#ifdef CPU_TEST
  return ph;
#endif
}


#ifndef CPU_TEST
#define NG_GPU 4
#define NLP_GPU 12
#ifndef PROBE_MASK_G
#define PROBE_MASK_G 0
#endif
#define GPHASE(stmt) do { if (SINGLE || ph == only) { long gtid = (long)blockIdx.x * NT + otid(); long gsize = gsize0; asm volatile("" : "+s"(gsize)); stmt; } if (SINGLE) { GRID_SYNC(); } ++ph; } while (0)
#define GLPHASE(stmt) do { int l = lo; OPAQUE_S(l); if (SINGLE && ((PROBE_MASK_G >> (ph - NG_GPU - lo * NLP_GPU)) & 1)) { long gtid = (long)blockIdx.x * NT + otid(); stmt; GRID_SYNC(); } GPHASE(stmt); } while (0)
template <bool SINGLE> __device__ __forceinline__ void run_seq_gpu(const P& p, long gtid0, long gsize0, int only, const XcdBarrier& xb, char* smem) {
  int ph = 0;
  const long gsize = gsize0;
#ifdef PROBE_INIT
  if (SINGLE) { long gtid = (long)blockIdx.x * NT + otid(); ph_g0(p, gtid, gsize); GRID_SYNC(); ph_g1(p, gtid, gsize); ph_modsum_gpu(p, gtid, gsize); ph_s5tables_gpu(p, gtid, gsize); GRID_SYNC(); ph_g2(p, gtid, gsize); ph_modu0_gpu(p, gtid, gsize); GRID_SYNC(); ph_g3(p, gtid, gsize); GRID_SYNC(); ph_g4(p, gtid, gsize); GRID_SYNC(); }
#endif
  GPHASE(ph_g0(p, gtid, gsize); s5_lampow_gpu(p, gtid, gsize); rope_table_gpu(p, gtid, gsize));
  GPHASE(ph_g1(p, gtid, gsize); ph_modsum_gpu(p, gtid, gsize); ph_s5tables_gpu(p, gtid, gsize); wt_convert_all(p, gtid, gsize));
  GPHASE(ph_g2(p, gtid, gsize); ph_modu0_gpu(p, gtid, gsize); ph_kcb_gpu(p, gtid, gsize));
  GPHASE(ph_g3(p, gtid, gsize));
#pragma unroll 1
  for (int lo = 0; lo < DEPTH; ++lo) {
    GLPHASE(if (l == 0) ph_g4(p, gtid, gsize); ph_proj_mfma(p, l, smem));
    GLPHASE(ph_s5_sgemm(p, l, smem); ph_hyena_pre_gpu(p, l, gtid, gsize));
    GLPHASE(ph_mix(p, l, gtid, gsize); ph_s5_carry_gpu(p, l, smem); ph_attn_mfma(p, l, smem); ph_hyena_mfma(p, l, smem));
    GLPHASE(ph_s5_ygemm(p, l, smem));
    GLPHASE(ph_glu_mfma(p, l, smem));
    GLPHASE(ph_outproj_mfma(p, l, smem));
    GLPHASE(ph_ln1_gpu(p, l));
    GLPHASE(ph_router_mfma(p, l, smem));
    GLPHASE(ph_select_gpu(p, l));
#ifdef UPVAR
    if (SINGLE) { int l = lo; OPAQUE_S(l); ph_expert_up_mfma<UPVAR>(p, l, smem); GRID_SYNC(); }
#endif
    GLPHASE(ph_expert_up_mfma(p, l, smem));
    GLPHASE(ph_expert_down_mfma(p, l, smem));
    GLPHASE(ph_ln2_gpu(p, l, smem));
  }
}
#endif

static void carve(P& p, void* ws) { p.ws = (char*)ws; }
static void set_inputs(P& p, void* const* d_in) {
  const float** f = (const float**)&p.x;
  for (int i = 0; i < 40; ++i) f[i] = (const float*)d_in[i];
}

#ifndef CPU_TEST
#ifndef MK_SINGLE
#define MK_SINGLE 1
#endif
extern __shared__ __attribute__((aligned(16))) char dyn_smem[];
__global__ void __launch_bounds__(NT, 2) mk_single(P p) {
  uint4* xbw = (uint4*)(dyn_smem + SM_XB);
  if (threadIdx.x == 0) *xbw = make_uint4(0u, 0u, 0u, 0u);
  __syncthreads();
  XcdBarrier xb = xcd_barrier_post(p.bar(), (volatile LAS unsigned*)xbw);
  run_seq_gpu<true>(p, (long)blockIdx.x * blockDim.x + threadIdx.x, (long)gridDim.x * blockDim.x, -1, xb, dyn_smem);
}
__global__ void __launch_bounds__(NT, 2) mk_phase(P p, int only) {
  XcdBarrier xb; xb.bar = p.bar(); xb.x = 0; xb.st = nullptr;
#ifdef DBG_ONLY
  only = DBG_ONLY;
#endif
  run_seq_gpu<false>(p, (long)blockIdx.x * blockDim.x + threadIdx.x, (long)gridDim.x * blockDim.x, only, xb, dyn_smem);
}
extern "C" void kernel_launch(void* const* d_in, const int* in_sizes, int n_in, void* d_out, int out_size, void* d_ws, size_t ws_size, hipStream_t stream) {
  P p; memset(&p, 0, sizeof(p));
  set_inputs(p, d_in); p.out = (float*)d_out; carve(p, d_ws);
  (void)hipMemsetAsync(p.bar(), 0, 4096 * sizeof(unsigned) + ((DEPTH * N_EXPERTS * sizeof(int) + 255) / 256) * 256, stream);
#if MK_SINGLE
  static int grid = 0;
  if (!grid) {
    int dev = 0, cus = 0, per_cu = 0; (void)hipGetDevice(&dev);
    (void)hipDeviceGetAttribute(&cus, hipDeviceAttributeMultiprocessorCount, dev);
    (void)hipFuncSetAttribute((const void*)mk_single, hipFuncAttributeMaxDynamicSharedMemorySize, SMEM_BYTES);
    (void)hipOccupancyMaxActiveBlocksPerMultiprocessor(&per_cu, mk_single, NT, SMEM_BYTES);
    grid = cus * (per_cu < 1 ? per_cu : 1);
  }
  mk_single<<<grid, NT, SMEM_BYTES, stream>>>(p);
#else
  for (int ph = 0; ph < NG_GPU + DEPTH * NLP_GPU; ++ph) mk_phase<<<256, NT, SMEM_BYTES, stream>>>(p, ph);
#endif
}
#endif
```

```cpp
#ifndef CPU_TEST
#include <hip/hip_runtime.h>
#include <cstring>
#define DEV __device__ __forceinline__
#define DEVM __device__ __forceinline__
#define HDM __host__ __device__ __forceinline__
#else
#include <cmath>
#include <cstdio>
#include <cstdlib>
#include <cstring>
#define DEV static inline
#define DEVM inline
#define HDM inline
struct float2 { float x, y; };
static inline float2 make_float2(float a, float b) { float2 r; r.x = a; r.y = b; return r; }
static inline int atomicAdd(int* p, int v) { int o = *p; *p += v; return o; }
#endif

#ifdef SMALL_CFG
#define D_MODEL 64
#define BATCH 2
#define SEQ 256
#define GRID_W 16
#define CTX_LEN 32
#define HEAD_DIM 16
#define N_Q_HEADS 4
#define N_KV_HEADS 2
#define HYENA_W 16
#define S5_W 32
#define WINDOW 32
#define FILTER_HIDDEN 16
#define S5_STATE 8
#define N_EXPERTS 32
#define TOP_K 4
#define EXPERT_FF 16
#define SHARED_FF 16
#define S5_T 32
#else
#define D_MODEL 1024
#define BATCH 2
#define SEQ 8192
#define GRID_W 64
#define CTX_LEN 256
#define HEAD_DIM 64
#define N_Q_HEADS 8
#define N_KV_HEADS 2
#define HYENA_W 256
#define S5_W 256
#define WINDOW 128
#define FILTER_HIDDEN 64
#define S5_STATE 64
#define N_EXPERTS 256
#define TOP_K 8
#define EXPERT_FF 256
#define SHARED_FF 256
#define S5_T 64
#endif
#define DEPTH 2
#define FILTER_EMB 33
#define N_EXPERT_GROUPS 8
#define TOPK_GROUPS 4
#define S5_GROUP 16
#define Q_GROUP (N_Q_HEADS / N_KV_HEADS)
#define ATTN_W (N_Q_HEADS * HEAD_DIM)
#define KV_W (N_KV_HEADS * HEAD_DIM)
#define MIX_W (ATTN_W + HYENA_W + S5_W)
#define Q_OFF 0
#define K_OFF ATTN_W
#define V_OFF (K_OFF + KV_W)
#define HY_OFF (V_OFF + KV_W)
#define S5_OFF (HY_OFF + 3 * HYENA_W)
#define IN_W (S5_OFF + S5_W)
#define AXIS_DIM (HEAD_DIM / 2)
#define ROPE_HALF (AXIS_DIM / 2)
#define S5_GROUPS (S5_W / S5_GROUP)
#define EPG (N_EXPERTS / N_EXPERT_GROUPS)
#define NL (BATCH * SEQ)
#define NC (BATCH * CTX_LEN)
#define NR (NL + NC)
#define NSEQ (CTX_LEN + SEQ)
#define NCH (NSEQ / S5_T)
#define LN_EPS 1e-5f
#define DN_ALPHA 1.4142135623730951f
#define ROUTED_SCALE 2.5f
#define PI_D 3.14159265358979323846

#define WS_LIST(X) \
  X(unsigned, bar, 4096) \
  X(int, cnt, DEPTH * N_EXPERTS) \
  X(float, mod, (size_t)DEPTH * (BATCH + 1) * 6 * D_MODEL) \
  X(float, xcur, (size_t)NR * D_MODEL) \
  X(float, ubuf, (size_t)NR * D_MODEL) \
  X(float, proj, (size_t)NR * IN_W) \
  X(float, hu, (size_t)NR * HYENA_W) \
  X(float, hx0, (size_t)NR * HYENA_W) \
  X(float, fh1, (size_t)DEPTH * SEQ * FILTER_HIDDEN) \
  X(float, fh2, (size_t)DEPTH * SEQ * FILTER_HIDDEN) \
  X(float, kraw, (size_t)DEPTH * SEQ * 2 * HYENA_W) \
  X(float, knorm, (size_t)DEPTH * HYENA_W) \
  X(float, fh1c, (size_t)CTX_LEN * FILTER_HIDDEN) \
  X(float, fh2c, (size_t)CTX_LEN * FILTER_HIDDEN) \
  X(float, krawc, (size_t)CTX_LEN * 2 * HYENA_W) \
  X(float, knormc, (size_t)HYENA_W) \
  X(float, mixb, (size_t)NR * MIX_W) \
  X(float, tmp, (size_t)NR * D_MODEL) \
  X(float2, lampow, (size_t)DEPTH * 2 * S5_GROUPS * (S5_T + 1) * S5_STATE) \
  X(float2, bbar, (size_t)DEPTH * 2 * S5_GROUPS * S5_STATE * S5_GROUP) \
  X(float, kc, (size_t)DEPTH * 2 * S5_GROUPS * S5_T * S5_GROUP * S5_GROUP) \
  X(float2, sc, (size_t)BATCH * 2 * S5_GROUPS * NCH * S5_STATE) \
  X(float2, hc, (size_t)BATCH * 2 * S5_GROUPS * NCH * S5_STATE) \
  X(float, ybuf, (size_t)NR * S5_W) \
  X(float, rl, (size_t)NR * N_EXPERTS) \
  X(int, top_e, (size_t)NR * TOP_K) \
  X(float, gate, (size_t)NR * TOP_K) \
  X(int, posb, (size_t)NR * TOP_K) \
  X(int, srow, (size_t)NR * TOP_K) \
  X(float, hbuf, (size_t)NR * TOP_K * EXPERT_FF) \
  X(float, hsb, (size_t)NR * SHARED_FF) \
  X(float, yk, (size_t)NR * TOP_K * D_MODEL) \
  X(float, ysh, (size_t)NR * D_MODEL) \
  X(unsigned short, ykb, (size_t)NR * TOP_K * D_MODEL) \
  X(unsigned short, qkvb, (size_t)NR * HY_OFF) \
  X(float2, ropet, (size_t)128 * ROPE_HALF) \
  X(unsigned short, bmtb, (size_t)DEPTH * 2 * S5_GROUPS * 128 * 1024) \
  X(unsigned short, cmtb, (size_t)DEPTH * 2 * S5_GROUPS * 1024 * 128) \
  X(unsigned short, kcb, (size_t)DEPTH * 2 * S5_GROUPS * S5_T * 256) \
  X(unsigned short, wt_in, (size_t)DEPTH * IN_W * D_MODEL) \
  X(unsigned short, wt_out, (size_t)DEPTH * D_MODEL * MIX_W) \
  X(unsigned short, wt_glu, (size_t)DEPTH * S5_W * S5_W) \
  X(unsigned short, wt_shg, (size_t)DEPTH * SHARED_FF * D_MODEL) \
  X(unsigned short, wt_shu, (size_t)DEPTH * SHARED_FF * D_MODEL) \
  X(unsigned short, wt_shd, (size_t)DEPTH * D_MODEL * SHARED_FF) \
  X(unsigned short, wt_rh, (size_t)DEPTH * N_EXPERTS * D_MODEL) \
  X(unsigned short, wt_rl, (size_t)DEPTH * N_EXPERTS * D_MODEL) \
  X(unsigned short, ubf, (size_t)NR * D_MODEL) \
  X(unsigned short, ybf, (size_t)NR * S5_W) \
  X(unsigned short, mixbf, (size_t)NR * MIX_W) \
  X(unsigned short, hbf, (size_t)NR * TOP_K * EXPERT_FF) \
  X(unsigned short, hsbf, (size_t)NR * SHARED_FF) \
  X(unsigned short, ubl, (size_t)NR * D_MODEL) \
  X(int, elist, (size_t)N_EXPERTS * NR) \
  X(float, egate, (size_t)N_EXPERTS * NR) \
  X(unsigned short, s5u, (size_t)NR * S5_W) \
  X(float, bmt, (size_t)DEPTH * 2 * S5_GROUPS * 16 * S5_T * 2 * S5_STATE) \
  X(float, cmt, (size_t)DEPTH * 2 * S5_GROUPS * 16 * S5_T * 2 * S5_STATE) \
  X(unsigned short, hcbf, (size_t)BATCH * 2 * S5_GROUPS * NCH * 2 * S5_STATE) \
  X(float, zT, (size_t)BATCH * 3 * HYENA_W * (SEQ + CTX_LEN)) \
  X(float, modp, (size_t)DEPTH * 16 * (BATCH + 1) * 6 * D_MODEL) \
  X(float, wrlo, (size_t)DEPTH * D_MODEL * N_EXPERTS) \

struct WsOff {
#define X(T, name, n) size_t name;
  WS_LIST(X)
#undef X
  size_t total;
};
constexpr WsOff ws_offsets() {
  WsOff o{}; size_t off = 0;
#define X(T, name, n) o.name = off; off += (((size_t)(n)) * sizeof(T) + 255) / 256 * 256;
  WS_LIST(X)
#undef X
  o.total = off; return o;
}
constexpr WsOff WSO = ws_offsets();
struct P {
  const float *x, *c, *ctx, *c_ctx, *w_ada, *b_ada, *w_in, *w_out, *sink, *mix_g, *hy_short_w, *hy_short_b, *hy_w1,
      *hy_b1, *hy_freq, *hy_w2, *hy_b2, *hy_w3, *hy_d, *s5_a_re, *s5_a_im, *s5_log_dt, *s5_b_re, *s5_b_im, *s5_c_re,
      *s5_c_im, *s5_d, *s5_w_glu, *ln1_g, *ln1_b, *ln2_g, *ln2_b, *w_router, *router_bias, *w_exp_gate, *w_exp_up,
      *w_exp_down, *w_sh_gate, *w_sh_up, *w_sh_down;
  float* out;
  char* ws;
#define X(T, name, n) HDM T* name() const { return (T*)(ws + WSO.name); }
  WS_LIST(X)
#undef X
};

#define FOR_ITEMS(i, N) for (long i = gtid; i < (long)(N); i += gsize)
#ifndef CPU_TEST
#define FOR_ITEMS4(i, N) _Pragma("unroll 4") for (long i = gtid; i < (long)(N); i += gsize)
#else
#define FOR_ITEMS4(i, N) FOR_ITEMS(i, N)
#endif

DEV unsigned short f2bf16(float f) { unsigned u; memcpy(&u, &f, 4); return (unsigned short)((u + 0x7fffu + ((u >> 16) & 1u)) >> 16); }
DEV float siluf(float x) { return x / (1.0f + expf(-x)); }
DEV float sigmoidf_(float x) { return 1.0f / (1.0f + expf(-x)); }
#ifndef CPU_TEST
DEV float rl_f(float v, int srcl) { return __int_as_float(__builtin_amdgcn_readlane(__float_as_int(v), srcl)); }
DEV float siluq(float x) { return x * __builtin_amdgcn_rcpf(1.0f + __builtin_amdgcn_exp2f(-1.4426950408889634f * x)); }
#endif
DEV float gelu_tanhf(float x) { return 0.5f * x * (1.0f + tanhf(0.7978845608028654f * (x + 0.044715f * x * x * x))); }
DEV int modrow(long r) { return r < NL ? (int)(r / SEQ) : BATCH; }

DEV void ph_g0(const P& p, long gtid, long gsize) {
#ifndef CPU_TEST
  FOR_ITEMS4(i4, (long)NR * D_MODEL / 4) { const long i = i4 * 4; *(float4*)(p.xcur() + i) = i < (long)NL * D_MODEL ? *(const float4*)(p.x + i) : *(const float4*)(p.ctx + (i - (long)NL * D_MODEL)); }
#else
  FOR_ITEMS(i, (long)NR * D_MODEL) p.xcur()[i] = i < (long)NL * D_MODEL ? p.x[i] : p.ctx[i - (long)NL * D_MODEL];
#endif
#ifdef CPU_TEST
  FOR_ITEMS(i, DEPTH * (BATCH + 1) * 6 * D_MODEL) {
    int n = (int)(i % (6 * D_MODEL)); int j = (int)((i / (6 * D_MODEL)) % (BATCH + 1)); int l = (int)(i / (6 * D_MODEL * (BATCH + 1)));
    const float* cv = j < BATCH ? p.c + j * D_MODEL : p.c_ctx;
    const float* w = p.w_ada + (long)l * D_MODEL * 6 * D_MODEL;
    float acc = p.b_ada[l * 6 * D_MODEL + n];
    for (int k = 0; k < D_MODEL; ++k) acc += siluf(cv[k]) * w[(long)k * 6 * D_MODEL + n];
    p.mod()[i] = acc;
  }
#else
  FOR_ITEMS(i, (long)DEPTH * 16 * 6 * D_MODEL) {
    const int n = (int)(i % (6 * D_MODEL)); const int slab = (int)((i / (6 * D_MODEL)) % 16); const int l = (int)(i / (6 * D_MODEL * 16));
    const float* w = p.w_ada + ((long)l * D_MODEL + slab * 64) * 6 * D_MODEL + n;
    float a0 = 0.f, a1 = 0.f, a2 = 0.f;
    const int kl = slab * 64 + (int)(gtid & 63);
    const float s0 = siluf(p.c[kl]), s1 = siluf(p.c[D_MODEL + kl]), s2 = siluf(p.c_ctx[kl]);
#pragma unroll
    for (int k = 0; k < 64; ++k) {
      const float wv = w[(long)k * 6 * D_MODEL];
      a0 += rl_f(s0, k) * wv; a1 += rl_f(s1, k) * wv; a2 += rl_f(s2, k) * wv;
    }
    float* dst = p.modp() + ((long)(l * 16 + slab) * (BATCH + 1)) * 6 * D_MODEL + n;
    dst[0] = a0; dst[6 * D_MODEL] = a1; dst[2 * 6 * D_MODEL] = a2;
  }
#endif
  FOR_ITEMS(i, DEPTH * 2 * S5_GROUPS * S5_STATE) {
    int pp = (int)(i % S5_STATE); int g = (int)((i / S5_STATE) % S5_GROUPS); int ld = (int)(i / (S5_STATE * S5_GROUPS));
    float are = fminf(p.s5_a_re[i], -1e-4f), aim = p.s5_a_im[i];
    float dt = expf(p.s5_log_dt[ld * S5_GROUPS + g]);
#ifdef CPU_TEST
    for (int d = 0; d <= S5_T; ++d) {
      float mag = expf(are * dt * d); float ang = aim * dt * d;
      p.lampow()[((long)(ld * S5_GROUPS + g) * (S5_T + 1) + d) * S5_STATE + pp] = make_float2(mag * cosf(ang), mag * sinf(ang));
    }
#endif
    float mag = expf(are * dt), ang = aim * dt;
    float lr = mag * cosf(ang) - 1.0f, li = mag * sinf(ang);
    float den = are * are + aim * aim;
    float fr = (lr * are + li * aim) / den, fi = (li * are - lr * aim) / den;
    for (int j = 0; j < S5_GROUP; ++j) {
      float br = p.s5_b_re[i * S5_GROUP + j], bi = p.s5_b_im[i * S5_GROUP + j];
      p.bbar()[i * S5_GROUP + j] = make_float2(fr * br - fi * bi, fr * bi + fi * br);
    }
  }
}
#ifndef CPU_TEST
DEV void rope_table_gpu(const P& p, long gtid, long gsize) {
  FOR_ITEMS(i, (long)128 * ROPE_HALF) {
    const int ii = (int)(i % ROPE_HALF), pos = (int)(i / ROPE_HALF);
    const float ang = (float)pos * powf(10000.0f, -(float)(2 * ii) / (float)AXIS_DIM);
    p.ropet()[i] = make_float2(cosf(ang), sinf(ang));
  }
}
DEV void s5_lampow_gpu(const P& p, long gtid, long gsize) {
  FOR_ITEMS4(i, (long)DEPTH * 2 * S5_GROUPS * (S5_T + 1) * S5_STATE) {
    const int pp = (int)(i % S5_STATE); const int d = (int)((i / S5_STATE) % (S5_T + 1)); const long ldg = i / ((long)S5_STATE * (S5_T + 1));
    const long src = ldg * S5_STATE + pp;
    const float are = fminf(p.s5_a_re[src], -1e-4f), aim = p.s5_a_im[src]; const float dt = expf(p.s5_log_dt[ldg]);
    const float mag = expf(are * dt * d); const float ang = aim * dt * d;
    p.lampow()[i] = make_float2(mag * cosf(ang), mag * sinf(ang));
  }
}
#endif
DEV void hy_f1(const P& p, int l, int Lf, float* h1, long gtid, long gsize) {
  FOR_ITEMS(i, (long)Lf * FILTER_HIDDEN) {
    int j = (int)(i % FILTER_HIDDEN); int t = (int)(i / FILTER_HIDDEN);
    const float* w1 = p.hy_w1 + l * FILTER_EMB * FILTER_HIDDEN;
    float tt = (float)((double)t / (double)(Lf - 1));
    float w = (float)(2.0 * PI_D * (double)t / (double)Lf);
    float acc = p.hy_b1[l * FILTER_HIDDEN + j] + tt * w1[j];
    const int bands = (FILTER_EMB - 1) / 2;
    for (int m = 0; m < bands; ++m) {
      float f = (float)(1e-4 + (double)m * ((double)(bands - 1) - 1e-4) / (double)(bands - 1));
      float a = f * w;
      acc += cosf(a) * w1[(1 + m) * FILTER_HIDDEN + j] - sinf(a) * w1[(1 + bands + m) * FILTER_HIDDEN + j];
    }
    h1[i] = sinf(p.hy_freq[l * FILTER_HIDDEN + j] * acc);
  }
}
DEV void hy_f2(const P& p, int l, int Lf, const float* h1, float* h2, long gtid, long gsize) {
  FOR_ITEMS(i, (long)Lf * FILTER_HIDDEN) {
    int j = (int)(i % FILTER_HIDDEN); int t = (int)(i / FILTER_HIDDEN);
    const float* w2 = p.hy_w2 + l * FILTER_HIDDEN * FILTER_HIDDEN;
    float acc = p.hy_b2[l * FILTER_HIDDEN + j];
    for (int k = 0; k < FILTER_HIDDEN; ++k) acc += h1[t * FILTER_HIDDEN + k] * w2[k * FILTER_HIDDEN + j];
#ifndef CPU_TEST
    h2[(long)j * Lf + t] = sinf(p.hy_freq[l * FILTER_HIDDEN + j] * acc);
#else
    h2[i] = sinf(p.hy_freq[l * FILTER_HIDDEN + j] * acc);
#endif
  }
}
DEV void hy_f3(const P& p, int l, int Lf, const float* h2, float* kraw, long gtid, long gsize) {
#ifndef CPU_TEST
  const float* w3 = p.hy_w3 + l * FILTER_HIDDEN * 2 * HYENA_W;
  FOR_ITEMS(i, (long)Lf * (2 * HYENA_W / 8)) {
    const int t = (int)(i % Lf); const int c8 = (int)(i / Lf) * 8;
    float acc[8];
#pragma unroll
    for (int j = 0; j < 8; ++j) acc[j] = 0.f;
#pragma unroll 4
    for (int k = 0; k < FILTER_HIDDEN; ++k) {
      const float hv = h2[(long)k * Lf + t];
      const float4 wa = *(const float4*)(w3 + k * 2 * HYENA_W + c8), wb = *(const float4*)(w3 + k * 2 * HYENA_W + c8 + 4);
      acc[0] += hv * wa.x; acc[1] += hv * wa.y; acc[2] += hv * wa.z; acc[3] += hv * wa.w; acc[4] += hv * wb.x; acc[5] += hv * wb.y; acc[6] += hv * wb.z; acc[7] += hv * wb.w;
    }
    const double d0 = log(1e-2) / 0.3, d1 = log(1e-2) / 1.5;
    const float tt = (float)((double)t / (double)(Lf - 1));
#pragma unroll
    for (int j = 0; j < 8; ++j) {
      const int ch = (c8 + j) % HYENA_W;
      const float delta = fabsf((float)(d0 + (d1 - d0) * (double)ch / (double)(HYENA_W - 1)));
      kraw[(long)(c8 + j) * Lf + t] = acc[j] * expf(-tt * delta);
    }
  }
#else
  FOR_ITEMS(i, (long)Lf * 2 * HYENA_W) {
    int t = (int)(i % Lf); int cc = (int)(i / Lf); int ch = cc % HYENA_W;
    const float* w3 = p.hy_w3 + l * FILTER_HIDDEN * 2 * HYENA_W;
    float acc = 0.f;
    for (int k = 0; k < FILTER_HIDDEN; ++k) acc += h2[t * FILTER_HIDDEN + k] * w3[k * 2 * HYENA_W + cc];
    double d0 = log(1e-2) / 0.3, d1 = log(1e-2) / 1.5;
    float delta = fabsf((float)(d0 + (d1 - d0) * (double)ch / (double)(HYENA_W - 1)));
    float tt = (float)((double)t / (double)(Lf - 1));
    kraw[(long)cc * Lf + t] = acc * expf(-tt * delta);
  }
#endif
}
DEV void hy_f4(int Lf, const float* kraw, float* knorm, long gtid, long gsize) {
#ifndef CPU_TEST
  const int lane = (int)(gtid & 63); const long gw = gtid >> 6, nw = gsize >> 6;
  for (long i = gw; i < HYENA_W; i += nw) {
    float s = 0.f;
    for (int t = lane; t < Lf; t += 64) { s += fabsf(kraw[i * Lf + t]); if (t > 0) s += fabsf(kraw[(HYENA_W + i) * Lf + t]); }
    for (int o = 32; o > 0; o >>= 1) s += __shfl_xor(s, o);
    if (lane == 0) knorm[i] = 1.0f / s;
  }
#else
  FOR_ITEMS(i, HYENA_W) {
    float s = 0.f;
    for (int t = 0; t < Lf; ++t) {
      s += fabsf(kraw[(long)i * Lf + t]);
      if (t > 0) s += fabsf(kraw[(long)(HYENA_W + i) * Lf + t]);
    }
    knorm[i] = 1.0f / s;
  }
#endif
}
#ifndef CPU_TEST
DEV void hy_f1g(const P& p, int l, int Lf, float* h1, long gtid, long gsize) {
  const int lane = (int)(gtid & 63);
  const float* w1 = p.hy_w1 + l * FILTER_EMB * FILTER_HIDDEN;
  const int bands = (FILTER_EMB - 1) / 2;
  static_assert(FILTER_HIDDEN == 64 && (FILTER_EMB - 1) / 2 == 16, "filter shape");
  FOR_ITEMS(i, (long)Lf * FILTER_HIDDEN) {
    const int j = lane; const int t = (int)(i / FILTER_HIDDEN);
    const float tt = (float)((double)t / (double)(Lf - 1));
    const float w = (float)(2.0 * PI_D * (double)t / (double)Lf);
    const int mm = lane & 15;
    const float f = (float)(1e-4 + (double)mm * ((double)(bands - 1) - 1e-4) / (double)(bands - 1));
    const float a = f * w; const float ca = cosf(a), sa = sinf(a);
    float acc = p.hy_b1[l * FILTER_HIDDEN + j] + tt * w1[j];
#pragma unroll
    for (int m = 0; m < 16; ++m) acc += rl_f(ca, m) * w1[(1 + m) * FILTER_HIDDEN + j] - rl_f(sa, m) * w1[(1 + bands + m) * FILTER_HIDDEN + j];
    h1[i] = sinf(p.hy_freq[l * FILTER_HIDDEN + j] * acc);
  }
}
DEV void hy_f2g(const P& p, long gtid, long gsize) {
  const long n_main = (long)DEPTH * 8 * SEQ, n_all = n_main + 8 * CTX_LEN;
  FOR_ITEMS(i, n_all) {
    const bool isc = __builtin_amdgcn_readfirstlane((int)(i >= n_main)) != 0;
    const long ii = isc ? i - n_main : i; const int Lf = isc ? CTX_LEN : SEQ;
    const int t = (int)(ii % Lf); const int gq = __builtin_amdgcn_readfirstlane((int)(ii / Lf)); const int j8 = (gq & 7) * 8, l = isc ? 0 : (gq >> 3);
    const float* h1 = isc ? p.fh1c() : p.fh1() + (long)l * SEQ * FILTER_HIDDEN; float* h2 = isc ? p.fh2c() : p.fh2() + (long)l * SEQ * FILTER_HIDDEN;
    const float* w2 = p.hy_w2 + l * FILTER_HIDDEN * FILTER_HIDDEN + j8;
    const float4* hr = (const float4*)(h1 + (long)t * FILTER_HIDDEN);
    float acc[8];
#pragma unroll
    for (int jj = 0; jj < 8; ++jj) acc[jj] = p.hy_b2[l * FILTER_HIDDEN + j8 + jj];
#pragma unroll 4
    for (int k4 = 0; k4 < FILTER_HIDDEN / 4; ++k4) {
      const float4 h = hr[k4]; const float hv[4] = {h.x, h.y, h.z, h.w};
#pragma unroll
      for (int e = 0; e < 4; ++e) {
        const float4 wa = *(const float4*)(w2 + (4 * k4 + e) * FILTER_HIDDEN), wb = *(const float4*)(w2 + (4 * k4 + e) * FILTER_HIDDEN + 4);
        acc[0] += hv[e] * wa.x; acc[1] += hv[e] * wa.y; acc[2] += hv[e] * wa.z; acc[3] += hv[e] * wa.w; acc[4] += hv[e] * wb.x; acc[5] += hv[e] * wb.y; acc[6] += hv[e] * wb.z; acc[7] += hv[e] * wb.w;
      }
    }
#pragma unroll
    for (int jj = 0; jj < 8; ++jj) h2[(long)(j8 + jj) * Lf + t] = sinf(p.hy_freq[l * FILTER_HIDDEN + j8 + jj] * acc[jj]);
  }
}
DEV void hy_f3g(const P& p, int l, int Lf, const float* h2, float* kraw, float* psum, long gtid, long gsize) {
  const float* w3 = p.hy_w3 + l * FILTER_HIDDEN * 2 * HYENA_W;
  const int nblk = Lf >> 8; const int lane = (int)(gtid & 63);
  FOR_ITEMS(i, (long)(2 * HYENA_W / 8) * nblk * 64) {
    const int wi = __builtin_amdgcn_readfirstlane((int)(i >> 6));
    const int c8 = (wi / nblk) * 8, tb = wi % nblk, t0 = tb * 256 + lane;
    float acc[4][8];
#pragma unroll
    for (int q = 0; q < 4; ++q)
#pragma unroll
      for (int j = 0; j < 8; ++j) acc[q][j] = 0.f;
#pragma unroll 4
    for (int k = 0; k < FILTER_HIDDEN; ++k) {
      const float4 wa = *(const float4*)(w3 + k * 2 * HYENA_W + c8), wb = *(const float4*)(w3 + k * 2 * HYENA_W + c8 + 4);
#pragma unroll
      for (int q = 0; q < 4; ++q) {
        const float hv = h2[(long)k * Lf + t0 + 64 * q];
        acc[q][0] += hv * wa.x; acc[q][1] += hv * wa.y; acc[q][2] += hv * wa.z; acc[q][3] += hv * wa.w; acc[q][4] += hv * wb.x; acc[q][5] += hv * wb.y; acc[q][6] += hv * wb.z; acc[q][7] += hv * wb.w;
      }
    }
    const double d0 = log(1e-2) / 0.3, d1 = log(1e-2) / 1.5;
    float ps[8];
#pragma unroll
    for (int j = 0; j < 8; ++j) ps[j] = 0.f;
#pragma unroll
    for (int j = 0; j < 8; ++j) {
      const int ch = (c8 + j) % HYENA_W;
      const float delta = fabsf((float)(d0 + (d1 - d0) * (double)ch / (double)(HYENA_W - 1)));
#pragma unroll
      for (int q = 0; q < 4; ++q) {
        const int t = t0 + 64 * q; const float tt = (float)((double)t / (double)(Lf - 1));
        const float v = acc[q][j] * expf(-tt * delta);
        kraw[(long)(c8 + j) * Lf + t] = v;
        ps[j] += (c8 >= HYENA_W && t == 0) ? 0.f : fabsf(v);
      }
    }
#pragma unroll
    for (int j = 0; j < 8; ++j) {
      float v = ps[j];
#pragma unroll
      for (int o = 32; o > 0; o >>= 1) v += __shfl_xor(v, o);
      if (lane == 0) psum[(long)(c8 + j) * nblk + tb] = v;
    }
  }
}
DEV void hy_f4g(int Lf, const float* psum, float* knorm, long gtid, long gsize) {
  const int lane = (int)(gtid & 63); const long gw = gtid >> 6, nw = gsize >> 6; const int nblk = Lf >> 8;
  for (long i = gw; i < HYENA_W; i += nw) {
    float s = 0.f;
    for (int q = lane; q < nblk; q += 64) s += psum[i * nblk + q] + psum[(HYENA_W + i) * nblk + q];
#pragma unroll
    for (int o = 32; o > 0; o >>= 1) s += __shfl_xor(s, o);
    if (lane == 0) knorm[i] = 1.0f / s;
  }
}
#define HY_PSUM(f) (p.tmp() + (long)(f) * 2 * HYENA_W * (SEQ >> 8))
#endif
DEV void ph_g1(const P& p, long gtid, long gsize) {
#ifndef CPU_TEST
  for (int l = 0; l < DEPTH; ++l) hy_f1g(p, l, SEQ, p.fh1() + (long)l * SEQ * FILTER_HIDDEN, gtid, gsize);
  hy_f1g(p, 0, CTX_LEN, p.fh1c(), gtid, gsize);
#else
  for (int l = 0; l < DEPTH; ++l) hy_f1(p, l, SEQ, p.fh1() + (long)l * SEQ * FILTER_HIDDEN, gtid, gsize);
  hy_f1(p, 0, CTX_LEN, p.fh1c(), gtid, gsize);
#endif
  FOR_ITEMS(i, (long)DEPTH * 2 * S5_GROUPS * S5_T * S5_GROUP * S5_GROUP) {
    int j = (int)(i % S5_GROUP); int ii = (int)((i / S5_GROUP) % S5_GROUP); int d = (int)((i / (S5_GROUP * S5_GROUP)) % S5_T);
    long ldg = i / (S5_GROUP * S5_GROUP * S5_T);
    float acc = 0.f;
    for (int pp = 0; pp < S5_STATE; ++pp) {
      float cr = p.s5_c_re[(ldg * S5_GROUP + ii) * S5_STATE + pp], ci = p.s5_c_im[(ldg * S5_GROUP + ii) * S5_STATE + pp];
      float2 lp = p.lampow()[(ldg * (S5_T + 1) + d) * S5_STATE + pp];
      float2 bb = p.bbar()[(ldg * S5_STATE + pp) * S5_GROUP + j];
      float tr = lp.x * bb.x - lp.y * bb.y, ti = lp.x * bb.y + lp.y * bb.x;
      acc += cr * tr - ci * ti;
    }
    p.kc()[i] = acc;
  }
}
#ifndef CPU_TEST
DEV void ph_g2(const P& p, long gtid, long gsize) {
  hy_f2g(p, gtid, gsize);
}
DEV void ph_g3(const P& p, long gtid, long gsize) {
  for (int l = 0; l < DEPTH; ++l) hy_f3g(p, l, SEQ, p.fh2() + (long)l * SEQ * FILTER_HIDDEN, p.kraw() + (long)l * SEQ * 2 * HYENA_W, HY_PSUM(l), gtid, gsize);
  hy_f3g(p, 0, CTX_LEN, p.fh2c(), p.krawc(), HY_PSUM(DEPTH), gtid, gsize);
}
DEV void ph_g4(const P& p, long gtid, long gsize) {
  for (int l = 0; l < DEPTH; ++l) hy_f4g(SEQ, HY_PSUM(l), p.knorm() + l * HYENA_W, gtid, gsize);
  hy_f4g(CTX_LEN, HY_PSUM(DEPTH), p.knormc(), gtid, gsize);
}
#else
DEV void ph_g2(const P& p, long gtid, long gsize) {
  for (int l = 0; l < DEPTH; ++l) hy_f2(p, l, SEQ, p.fh1() + (long)l * SEQ * FILTER_HIDDEN, p.fh2() + (long)l * SEQ * FILTER_HIDDEN, gtid, gsize);
  hy_f2(p, 0, CTX_LEN, p.fh1c(), p.fh2c(), gtid, gsize);
}
DEV void ph_g3(const P& p, long gtid, long gsize) {
  for (int l = 0; l < DEPTH; ++l) hy_f3(p, l, SEQ, p.fh2() + (long)l * SEQ * FILTER_HIDDEN, p.kraw() + (long)l * SEQ * 2 * HYENA_W, gtid, gsize);
  hy_f3(p, 0, CTX_LEN, p.fh2c(), p.krawc(), gtid, gsize);
}
DEV void ph_g4(const P& p, long gtid, long gsize) {
  for (int l = 0; l < DEPTH; ++l) hy_f4(SEQ, p.kraw() + (long)l * SEQ * 2 * HYENA_W, p.knorm() + l * HYENA_W, gtid, gsize);
  hy_f4(CTX_LEN, p.krawc(), p.knormc(), gtid, gsize);
}
#endif
#define NG 5

DEV void ph_modu(const P& p, int l, int which, long gtid, long gsize) {
  FOR_ITEMS(i, (long)NR * D_MODEL) {
    int k = (int)(i % D_MODEL); long r = i / D_MODEL;
    const float* m = p.mod() + ((long)l * (BATCH + 1) + modrow(r)) * 6 * D_MODEL + which * 3 * D_MODEL;
    float uv = p.xcur()[i] * (1.0f + m[D_MODEL + k]) + m[k];
    p.ubuf()[i] = uv; p.ubf()[i] = f2bf16(uv);
  }
}
template <class Epi>
DEV void gemm_naive(const float* A, int lda, const float* B, int ldb, int M, int N, int K, Epi epi, long gtid, long gsize) {
  FOR_ITEMS(i, (long)(M / 4) * N) {
    int n = (int)(i % N); long r0 = (i / N) * 4;
    const float* a0 = A + r0 * lda;
    float c0 = 0.f, c1 = 0.f, c2 = 0.f, c3 = 0.f;
    for (int k = 0; k < K; ++k) {
      float b = B[(long)k * ldb + n];
      c0 += a0[k] * b; c1 += a0[lda + k] * b; c2 += a0[2 * lda + k] * b; c3 += a0[3 * lda + k] * b;
    }
    epi(r0, n, c0); epi(r0 + 1, n, c1); epi(r0 + 2, n, c2); epi(r0 + 3, n, c3);
  }
}
struct EpiStore { float* C; int ldc; DEVM void operator()(long r, int n, float v) const { C[r * ldc + n] = v; } };
DEV void ph_proj(const P& p, int l, long gtid, long gsize) {
  EpiStore e{p.proj(), IN_W};
  gemm_naive(p.ubuf(), D_MODEL, p.w_in + (long)l * D_MODEL * IN_W, IN_W, NR, IN_W, D_MODEL, e, gtid, gsize);
}
DEV long s5_row(int b, int dir, int n) {
  if (n < CTX_LEN) return (long)NL + b * CTX_LEN + (dir ? CTX_LEN - 1 - n : n);
  int t = n - CTX_LEN; return (long)b * SEQ + (dir ? SEQ - 1 - t : t);
}
DEV void ph_post_proj(const P& p, int l, long gtid, long gsize) {
  FOR_ITEMS(i, (long)NL * (N_Q_HEADS + N_KV_HEADS) * 2 * ROPE_HALF) {
    int ii = (int)(i % ROPE_HALF); int a = (int)((i / ROPE_HALF) % 2); int hs = (int)((i / (2 * ROPE_HALF)) % (N_Q_HEADS + N_KV_HEADS));
    long r = i / (2 * ROPE_HALF * (N_Q_HEADS + N_KV_HEADS));
    int t = (int)(r % SEQ); int pos = a == 0 ? t / GRID_W : t % GRID_W;
    float inv = powf(10000.0f, -(float)(2 * ii) / (float)AXIS_DIM);
    float ang = (float)pos * inv; float cs = cosf(ang), sn = sinf(ang);
    float* q = p.proj() + r * IN_W + hs * HEAD_DIM + a * AXIS_DIM + ii;
    float x1 = q[0], x2 = q[ROPE_HALF];
    q[0] = x1 * cs - x2 * sn; q[ROPE_HALF] = x1 * sn + x2 * cs;
  }
#ifdef CPU_TEST
  FOR_ITEMS(i, (long)NR * HYENA_W) {
    int ch = (int)(i % HYENA_W); long r = i / HYENA_W;
    int Ls = r < NL ? SEQ : CTX_LEN; long base = r < NL ? (r / SEQ) * SEQ : NL + ((r - NL) / CTX_LEN) * CTX_LEN; int t = (int)(r - base);
    const float* sw = p.hy_short_w + l * 3 * 3 * HYENA_W; const float* sb = p.hy_short_b + l * 3 * HYENA_W;
    float z[3];
#pragma unroll
    for (int part = 0; part < 3; ++part) {
      int cc = part * HYENA_W + ch; float acc = sb[cc];
#pragma unroll
      for (int j = 0; j < 3; ++j) { int tt = t + j - 1; if (tt >= 0 && tt < Ls) acc += p.proj()[(base + tt) * IN_W + HY_OFF + cc] * sw[j * 3 * HYENA_W + cc]; }
      z[part] = acc;
    }
    long o = r < NL ? ((r / SEQ) * HYENA_W + ch) * SEQ + t : i;
    p.hu()[o] = z[0] * z[1]; p.hx0()[o] = z[2];
  }
#endif
#ifndef CPU_TEST
  FOR_ITEMS(i, (long)NR * S5_W) { long r = i / S5_W; int cc = (int)(i % S5_W); p.s5u()[i] = f2bf16(p.proj()[r * IN_W + S5_OFF + cc]); }
#endif
#ifdef CPU_TEST
  FOR_ITEMS(i, (long)BATCH * 2 * S5_GROUPS * NCH * S5_STATE) {
    int pp = (int)(i % S5_STATE); int c = (int)((i / S5_STATE) % NCH); int g = (int)((i / (S5_STATE * NCH)) % S5_GROUPS);
    int dir = (int)((i / (S5_STATE * NCH * S5_GROUPS)) % 2); int b = (int)(i / (S5_STATE * NCH * S5_GROUPS * 2));
    long ldg = ((long)l * 2 + dir) * S5_GROUPS + g;
    float sr = 0.f, si = 0.f;
    for (int s = 0; s < S5_T; ++s) {
      const float* u = p.proj() + s5_row(b, dir, c * S5_T + s) * IN_W + S5_OFF + g * S5_GROUP;
      float br = 0.f, bi = 0.f;
#pragma unroll
      for (int j = 0; j < S5_GROUP; ++j) { float2 bb = p.bbar()[(ldg * S5_STATE + pp) * S5_GROUP + j]; br += bb.x * u[j]; bi += bb.y * u[j]; }
      float2 lp = p.lampow()[(ldg * (S5_T + 1) + (S5_T - 1 - s)) * S5_STATE + pp];
      sr += lp.x * br - lp.y * bi; si += lp.x * bi + lp.y * br;
    }
    p.sc()[i] = make_float2(sr, si);
  }
#endif
}
DEV void attn_item(const P& p, int l, long r, int h, float* outp) {
  const float scale = 1.0f / sqrtf((float)HEAD_DIM);
  float q[HEAD_DIM], acc[HEAD_DIM];
  const float* qp = p.proj() + r * IN_W + Q_OFF + h * HEAD_DIM;
#pragma unroll
  for (int d = 0; d < HEAD_DIM; ++d) { q[d] = qp[d] * scale; acc[d] = 0.f; }
  int kvh = h / Q_GROUP; int b = r < NL ? (int)(r / SEQ) : (int)((r - NL) / CTX_LEN);
  float m = -1e30f, lsum = 0.f;
  int nwin = 0, t = 0;
  if (r < NL) { t = (int)(r % SEQ); nwin = 2 * WINDOW + 1; }
  for (int j = 0; j < nwin + CTX_LEN; ++j) {
    long kr;
    if (j < nwin) { int tk = t - WINDOW + j; if (tk < 0 || tk >= SEQ) continue; kr = (long)b * SEQ + tk; }
    else kr = (long)NL + b * CTX_LEN + (j - nwin);
    const float* kp = p.proj() + kr * IN_W + K_OFF + kvh * HEAD_DIM; const float* vp = p.proj() + kr * IN_W + V_OFF + kvh * HEAD_DIM;
    float s = 0.f;
#pragma unroll
    for (int d = 0; d < HEAD_DIM; ++d) s += q[d] * kp[d];
    float mn = fmaxf(m, s); float corr = expf(m - mn); float pe = expf(s - mn);
    lsum = lsum * corr + pe;
#pragma unroll
    for (int d = 0; d < HEAD_DIM; ++d) acc[d] = acc[d] * corr + pe * vp[d];
    m = mn;
  }
  float sk = p.sink[l * N_Q_HEADS + h]; float mf = fmaxf(m, sk); float corr = expf(m - mf);
  float den = lsum * corr + expf(sk - mf); float sc2 = corr / den;
#pragma unroll
  for (int d = 0; d < HEAD_DIM; ++d) outp[d] = acc[d] * sc2;
}
DEV void ph_mix(const P& p, int l, long gtid, long gsize) {
#ifdef CPU_TEST
  long nrows_att = l == 0 ? NR : NL;
  FOR_ITEMS(i, nrows_att * N_Q_HEADS) { int h = (int)(i % N_Q_HEADS); long r = i / N_Q_HEADS; attn_item(p, l, r, h, p.mixb() + r * MIX_W + h * HEAD_DIM); }
#endif
#ifdef CPU_TEST
  FOR_ITEMS(i, (long)NL * HYENA_W) {
    int ch = (int)(i % HYENA_W); long r = i / HYENA_W; int t = (int)(r % SEQ); int b = (int)(r / SEQ);
    const float* kf = p.kraw() + ((long)l * 2 * HYENA_W + ch) * SEQ; const float* kb = p.kraw() + ((long)l * 2 * HYENA_W + HYENA_W + ch) * SEQ;
    const float* uu = p.hu() + ((long)b * HYENA_W + ch) * SEQ;
    float acc = 0.f;
    for (int s = 0; s <= t; ++s) acc += kf[t - s] * uu[s];
    for (int s = t + 1; s < SEQ; ++s) acc += kb[s - t] * uu[s];
    p.mixb()[r * MIX_W + ATTN_W + ch] = (acc * p.knorm()[l * HYENA_W + ch] + uu[t] * p.hy_d[l * HYENA_W + ch]) * p.hx0()[((long)b * HYENA_W + ch) * SEQ + t];
  }
#endif
  if (l == 0) {
#ifndef CPU_TEST
    FOR_ITEMS(i, (long)NC * HYENA_W) {
      const int t = (int)(i % CTX_LEN); const int ch = (int)((i / CTX_LEN) % HYENA_W); const int b = (int)(i / ((long)CTX_LEN * HYENA_W));
      const long base = (long)NL + (long)b * CTX_LEN; const long r = base + t;
      const float* kf = p.krawc() + (long)ch * CTX_LEN; const float* kb = p.krawc() + (long)(HYENA_W + ch) * CTX_LEN;
      float acc = 0.f;
#pragma unroll 8
      for (int sidx = 0; sidx < CTX_LEN; ++sidx) {
        const int d = t - sidx; const float kv = d >= 0 ? kf[d] : kb[-d];
        acc += kv * p.hu()[(base + sidx) * HYENA_W + ch];
      }
      const float u = p.hu()[r * HYENA_W + ch];
      p.mixb()[r * MIX_W + ATTN_W + ch] = (acc * p.knormc()[ch] + u * p.hy_d[l * HYENA_W + ch]) * p.hx0()[r * HYENA_W + ch];
    }
#else
    FOR_ITEMS(i, (long)NC * HYENA_W) {
      int ch = (int)(i % HYENA_W); long r = NL + i / HYENA_W; int t = (int)((r - NL) % CTX_LEN); long base = r - t;
      float acc = 0.f;
      for (int s = 0; s <= t; ++s) acc += p.krawc()[(long)ch * CTX_LEN + (t - s)] * p.hu()[(base + s) * HYENA_W + ch];
      for (int s = t + 1; s < CTX_LEN; ++s) acc += p.krawc()[(long)(HYENA_W + ch) * CTX_LEN + (s - t)] * p.hu()[(base + s) * HYENA_W + ch];
      float u = p.hu()[r * HYENA_W + ch];
      p.mixb()[r * MIX_W + ATTN_W + ch] = (acc * p.knormc()[ch] + u * p.hy_d[l * HYENA_W + ch]) * p.hx0()[r * HYENA_W + ch];
    }
#endif
  }
#ifdef CPU_TEST
  FOR_ITEMS(i, (long)BATCH * 2 * S5_GROUPS * S5_STATE) {
    int pp = (int)(i % S5_STATE); int g = (int)((i / S5_STATE) % S5_GROUPS); int dir = (int)((i / (S5_STATE * S5_GROUPS)) % 2); int b = (int)(i / (S5_STATE * S5_GROUPS * 2));
    long ldg = ((long)l * 2 + dir) * S5_GROUPS + g;
    float2 lt = p.lampow()[(ldg * (S5_T + 1) + S5_T) * S5_STATE + pp];
    float hr = 0.f, hi = 0.f;
    long base = (((long)b * 2 + dir) * S5_GROUPS + g) * NCH;
#ifndef CPU_TEST
    static_assert(NCH % 12 == 0, "carry batching");
    for (int c0 = 0; c0 < NCH; c0 += 12) {
      float2 sv[12];
#pragma unroll
      for (int k = 0; k < 12; ++k) sv[k] = p.sc()[(base + c0 + k) * S5_STATE + pp];
#pragma unroll
      for (int k = 0; k < 12; ++k) {
        p.hcbf()[(base + c0 + k) * 2 * S5_STATE + pp] = f2bf16(hr); p.hcbf()[(base + c0 + k) * 2 * S5_STATE + S5_STATE + pp] = f2bf16(hi);
        const float nr = lt.x * hr - lt.y * hi + sv[k].x, ni = lt.x * hi + lt.y * hr + sv[k].y;
        hr = nr; hi = ni;
      }
    }
#else
    for (int c = 0; c < NCH; ++c) {
      p.hc()[(base + c) * S5_STATE + pp] = make_float2(hr, hi);
      float2 s = p.sc()[(base + c) * S5_STATE + pp];
      float nr = lt.x * hr - lt.y * hi + s.x, ni = lt.x * hi + lt.y * hr + s.y;
      hr = nr; hi = ni;
    }
#endif
  }
#endif
}
DEV void ph_s5out(const P& p, int l, long gtid, long gsize) {
  FOR_ITEMS(i, (long)NR * S5_W) {
    int chn = (int)(i % S5_W); long r = i / S5_W; int g = chn / S5_GROUP, ii = chn % S5_GROUP;
    int b, tl; bool isctx = r >= NL;
    if (isctx) { b = (int)((r - NL) / CTX_LEN); tl = (int)((r - NL) % CTX_LEN); } else { b = (int)(r / SEQ); tl = (int)(r % SEQ); }
    float y = p.s5_d[l * S5_W + chn] * p.proj()[r * IN_W + S5_OFF + chn];
    for (int dir = 0; dir < 2; ++dir) {
      int n = isctx ? (dir ? CTX_LEN - 1 - tl : tl) : CTX_LEN + (dir ? SEQ - 1 - tl : tl);
      int c = n / S5_T, tau = n % S5_T;
      long ldg = ((long)l * 2 + dir) * S5_GROUPS + g;
      long hb = ((((long)b * 2 + dir) * S5_GROUPS + g) * NCH + c) * S5_STATE;
      for (int pp = 0; pp < S5_STATE; ++pp) {
        float cr = p.s5_c_re[(ldg * S5_GROUP + ii) * S5_STATE + pp], ci = p.s5_c_im[(ldg * S5_GROUP + ii) * S5_STATE + pp];
        float2 lp = p.lampow()[(ldg * (S5_T + 1) + tau + 1) * S5_STATE + pp]; float2 h = p.hc()[hb + pp];
        float tr = lp.x * h.x - lp.y * h.y, ti = lp.x * h.y + lp.y * h.x;
        y += cr * tr - ci * ti;
      }
      for (int s = 0; s <= tau; ++s) {
        const float* u = p.proj() + s5_row(b, dir, c * S5_T + s) * IN_W + S5_OFF + g * S5_GROUP;
        const float* kk = p.kc() + ((ldg * S5_T + (tau - s)) * S5_GROUP + ii) * S5_GROUP;
#pragma unroll
        for (int j = 0; j < S5_GROUP; ++j) y += kk[j] * u[j];
      }
    }
    float gy = gelu_tanhf(y); p.ybuf()[i] = gy; p.ybf()[i] = f2bf16(gy);
  }
}
struct EpiGlu { const float* g; float* mixb; DEVM void operator()(long r, int n, float v) const { mixb[r * MIX_W + ATTN_W + HYENA_W + n] = g[r * S5_W + n] * sigmoidf_(v); } };
DEV void ph_glu(const P& p, int l, long gtid, long gsize) {
  EpiGlu e{p.ybuf(), p.mixb()};
  gemm_naive(p.ybuf(), S5_W, p.s5_w_glu + (long)l * S5_W * S5_W, S5_W, NR, S5_W, S5_W, e, gtid, gsize);
}
DEV void ph_rms(const P& p, int l, long gtid, long gsize) {
  FOR_ITEMS(i, (long)NR * 3) {
    int grp = (int)(i % 3); long r = i / 3;
    int off = grp == 0 ? 0 : (grp == 1 ? ATTN_W : ATTN_W + HYENA_W); int w = grp == 0 ? ATTN_W : (grp == 1 ? HYENA_W : S5_W);
    float* v = p.mixb() + r * MIX_W + off; float ss = 0.f;
    for (int k = 0; k < w; ++k) ss += v[k] * v[k];
    float rs = 1.0f / sqrtf(ss / (float)w + LN_EPS);
    for (int k = 0; k < w; ++k) { float nv = v[k] * rs * p.mix_g[l * MIX_W + off + k]; v[k] = nv; p.mixbf()[r * MIX_W + off + k] = f2bf16(nv); }
  }
}
struct EpiRes { const float* xcur; const float* mod; int l; int goff; float* tmp;
  DEVM void operator()(long r, int n, float v) const { const float* m = mod + ((long)l * (BATCH + 1) + modrow(r)) * 6 * D_MODEL + goff; tmp[r * D_MODEL + n] = DN_ALPHA * xcur[r * D_MODEL + n] + m[n] * v; } };
DEV void ph_outproj(const P& p, int l, long gtid, long gsize) {
  EpiRes e{p.xcur(), p.mod(), l, 2 * D_MODEL, p.tmp()};
  gemm_naive(p.mixb(), MIX_W, p.w_out + (long)l * MIX_W * D_MODEL, D_MODEL, NR, D_MODEL, MIX_W, e, gtid, gsize);
}
DEV void ph_ln(const P& p, int l, int which, long gtid, long gsize) {
  const float* gw = (which == 0 ? p.ln1_g : p.ln2_g) + l * D_MODEL; const float* bw = (which == 0 ? p.ln1_b : p.ln2_b) + l * D_MODEL;
  FOR_ITEMS(r, (long)NR) {
    const float* v = p.tmp() + r * D_MODEL; float mu = 0.f;
#pragma unroll 4
    for (int k = 0; k < D_MODEL; ++k) mu += v[k];
    mu /= (float)D_MODEL; float var = 0.f;
#pragma unroll 4
    for (int k = 0; k < D_MODEL; ++k) { float d = v[k] - mu; var += d * d; }
    float rs = 1.0f / sqrtf(var / (float)D_MODEL + LN_EPS);
    const float* m = p.mod() + ((long)l * (BATCH + 1) + modrow(r)) * 6 * D_MODEL + 3 * D_MODEL;
#pragma unroll 2
    for (int k = 0; k < D_MODEL; ++k) {
      float y = (v[k] - mu) * rs * gw[k] + bw[k];
      p.xcur()[r * D_MODEL + k] = y;
      if (which == 0) { float uv = y * (1.0f + m[D_MODEL + k]) + m[k]; p.ubuf()[r * D_MODEL + k] = uv; p.ubf()[r * D_MODEL + k] = f2bf16(uv); }
      if (which == 1 && l == DEPTH - 1 && r < NL) p.out[r * D_MODEL + k] = y;
    }
  }
}
DEV void ph_router(const P& p, int l, long gtid, long gsize) {
  EpiStore e{p.rl(), N_EXPERTS};
  gemm_naive(p.ubuf(), D_MODEL, p.w_router + (long)l * D_MODEL * N_EXPERTS, N_EXPERTS, NR, N_EXPERTS, D_MODEL, e, gtid, gsize);
}
DEV bool better(float v, int i, float bv, int bi) { return v > bv || (v == bv && i < bi); }
DEV void ph_select(const P& p, int l, long gtid, long gsize) {
  FOR_ITEMS(r, (long)NR) {
    const float* lg = p.rl() + r * N_EXPERTS; const float* rb = p.router_bias + l * N_EXPERTS;
    float gs[N_EXPERT_GROUPS];
#pragma unroll
    for (int g = 0; g < N_EXPERT_GROUPS; ++g) {
      float m1 = -1e30f, m2 = -1e30f;
      for (int e = 0; e < EPG; ++e) { float v = sigmoidf_(lg[g * EPG + e]) + rb[g * EPG + e]; if (v > m1) { m2 = m1; m1 = v; } else if (v > m2) m2 = v; }
      gs[g] = m1 + m2;
    }
    unsigned keep = 0;
#pragma unroll
    for (int it = 0; it < TOPK_GROUPS; ++it) {
      float bv = -1e30f; int bi = -1;
#pragma unroll
      for (int g = 0; g < N_EXPERT_GROUPS; ++g) if (!((keep >> g) & 1u) && (bi < 0 || gs[g] > bv)) { bv = gs[g]; bi = g; }
      keep |= 1u << bi;
    }
    float lastv = 1e30f; int lasti = -1; float gsum = 0.f;
    for (int it = 0; it < TOP_K; ++it) {
      float bv = -1e30f; int bi = -1;
      for (int e = 0; e < N_EXPERTS; ++e) {
        if (!((keep >> (e / EPG)) & 1u)) continue;
        float v = sigmoidf_(lg[e]) + rb[e];
        if (!better(lastv, lasti, v, e)) continue;
        if (bi < 0 || better(v, e, bv, bi)) { bv = v; bi = e; }
      }
      lastv = bv; lasti = bi;
      float sc = sigmoidf_(lg[bi]); gsum += sc;
      p.top_e()[r * TOP_K + it] = bi; p.gate()[r * TOP_K + it] = sc;
      p.posb()[r * TOP_K + it] = atomicAdd(&p.cnt()[l * N_EXPERTS + bi], 1);
    }
    float inv = ROUTED_SCALE / gsum;
    for (int it = 0; it < TOP_K; ++it) p.gate()[r * TOP_K + it] *= inv;
  }
}
DEV void ph_sortrows(const P& p, int l, long gtid, long gsize) {
  FOR_ITEMS(i, (long)NR * TOP_K) {
    int e = p.top_e()[i]; int off = 0;
    for (int j = 0; j < e; ++j) off += p.cnt()[l * N_EXPERTS + j];
    p.srow()[off + p.posb()[i]] = (int)i;
  }
}
DEV void ph_expert_up(const P& p, int l, long gtid, long gsize) {
  FOR_ITEMS(i, (long)NR * TOP_K * EXPERT_FF) {
    int cidx = (int)(i % EXPERT_FF); int a = p.srow()[i / EXPERT_FF]; int e = p.top_e()[a]; long r = a / TOP_K;
    const float* xg = p.ubuf() + r * D_MODEL;
    const float* wg = p.w_exp_gate + ((long)l * N_EXPERTS + e) * D_MODEL * EXPERT_FF; const float* wu = p.w_exp_up + ((long)l * N_EXPERTS + e) * D_MODEL * EXPERT_FF;
    float g = 0.f, u = 0.f;
    for (int k = 0; k < D_MODEL; ++k) { float xv = xg[k]; g += xv * wg[(long)k * EXPERT_FF + cidx]; u += xv * wu[(long)k * EXPERT_FF + cidx]; }
    p.hbuf()[(long)a * EXPERT_FF + cidx] = siluf(g) * u;
  }
  FOR_ITEMS(i, (long)NR * SHARED_FF) {
    int cidx = (int)(i % SHARED_FF); long r = i / SHARED_FF;
    const float* xg = p.ubuf() + r * D_MODEL;
    const float* wg = p.w_sh_gate + (long)l * D_MODEL * SHARED_FF; const float* wu = p.w_sh_up + (long)l * D_MODEL * SHARED_FF;
    float g = 0.f, u = 0.f;
    for (int k = 0; k < D_MODEL; ++k) { float xv = xg[k]; g += xv * wg[(long)k * SHARED_FF + cidx]; u += xv * wu[(long)k * SHARED_FF + cidx]; }
    p.hsb()[i] = siluf(g) * u;
  }
}
DEV void ph_expert_down(const P& p, int l, long gtid, long gsize) {
  FOR_ITEMS(i, (long)NR * TOP_K * D_MODEL) {
    int d = (int)(i % D_MODEL); long a = i / D_MODEL;
    int e = p.top_e()[a]; const float* wd = p.w_exp_down + ((long)l * N_EXPERTS + e) * EXPERT_FF * D_MODEL;
    const float* h = p.hbuf() + a * EXPERT_FF; float acc = 0.f;
    for (int cidx = 0; cidx < EXPERT_FF; ++cidx) acc += h[cidx] * wd[(long)cidx * D_MODEL + d];
    p.yk()[i] = acc * p.gate()[a];
  }
  FOR_ITEMS(i, (long)NR * D_MODEL) {
    int d = (int)(i % D_MODEL); long r = i / D_MODEL;
    const float* wsd = p.w_sh_down + (long)l * SHARED_FF * D_MODEL; const float* hs = p.hsb() + r * SHARED_FF;
    float acc = 0.f;
    for (int cidx = 0; cidx < SHARED_FF; ++cidx) acc += hs[cidx] * wsd[(long)cidx * D_MODEL + d];
    p.ysh()[i] = acc;
  }
}
DEV void ph_combine(const P& p, int l, long gtid, long gsize) {
#pragma unroll 1
  FOR_ITEMS(i, (long)NR * D_MODEL) {
    int d = (int)(i % D_MODEL); long r = i / D_MODEL;
    float f = p.ysh()[i];
#pragma unroll
    for (int k = 0; k < TOP_K; ++k) f += p.yk()[(r * TOP_K + k) * D_MODEL + d];
    const float* m = p.mod() + ((long)l * (BATCH + 1) + modrow(r)) * 6 * D_MODEL + 5 * D_MODEL;
    p.tmp()[i] = DN_ALPHA * p.xcur()[i] + m[d] * f;
  }
}
#define NLP 16


#ifndef CPU_TEST
typedef __attribute__((ext_vector_type(8))) short bf16x8;
typedef __attribute__((ext_vector_type(4))) float f32x4;
typedef __attribute__((ext_vector_type(4))) unsigned u32x4;
typedef __attribute__((ext_vector_type(2))) unsigned u32x2;
static_assert(N_EXPERTS == 256 && D_MODEL % 128 == 0 && NR % 128 == 0, "shape assumptions");
#define SM_XB 0
#define NT 512
#define SM_A 256
#define SM_B (256 + 16384)
#define SM_MISC (256 + 114688)
#define SMEM_BYTES (256 + 114688 + 4096)

DEV int otid() { int t = threadIdx.x; asm volatile("" : "+v"(t)); return t; }
typedef __bf16 bf16x2_t __attribute__((ext_vector_type(2)));
typedef float f32x2_t __attribute__((ext_vector_type(2)));
DEV unsigned pack2(float a, float b) { f32x2_t v = {a, b}; return __builtin_bit_cast(unsigned, __builtin_convertvector(v, bf16x2_t)); }
DEV unsigned f2bf(float f) { return pack2(f, 0.f) & 0xffffu; }
DEV int tile_off(int row, int chunk) { return row * 128 + ((chunk ^ ((row >> 1) & 7)) << 4); }

DEV float bflo(float x) { return x - __uint_as_float(f2bf(x) << 16); }
DEV void wt_convert(const float* W, unsigned short* WT, int K, int N, bool lo, long gtid, long gsize) {
  FOR_ITEMS4(i, (long)N * (K / 8)) {
    const int n = (int)(i % N); const int k8 = (int)(i / N) * 8;
    float v[8];
#pragma unroll
    for (int j = 0; j < 8; ++j) { const float x = W[(long)(k8 + j) * N + n]; v[j] = lo ? bflo(x) : x; }
    u32x4 o; o[0] = pack2(v[0], v[1]); o[1] = pack2(v[2], v[3]); o[2] = pack2(v[4], v[5]); o[3] = pack2(v[6], v[7]);
    *(u32x4*)(WT + (long)n * K + k8) = o;
  }
}
DEV void wt_convert_all(const P& p, long gtid, long gsize) {
  for (int l = 0; l < DEPTH; ++l) {
    wt_convert(p.w_in + (long)l * D_MODEL * IN_W, p.wt_in() + (long)l * IN_W * D_MODEL, D_MODEL, IN_W, false, gtid, gsize);
    wt_convert(p.w_out + (long)l * MIX_W * D_MODEL, p.wt_out() + (long)l * D_MODEL * MIX_W, MIX_W, D_MODEL, false, gtid, gsize);
    wt_convert(p.s5_w_glu + (long)l * S5_W * S5_W, p.wt_glu() + (long)l * S5_W * S5_W, S5_W, S5_W, false, gtid, gsize);
    wt_convert(p.w_sh_gate + (long)l * D_MODEL * SHARED_FF, p.wt_shg() + (long)l * SHARED_FF * D_MODEL, D_MODEL, SHARED_FF, false, gtid, gsize);
    wt_convert(p.w_sh_up + (long)l * D_MODEL * SHARED_FF, p.wt_shu() + (long)l * SHARED_FF * D_MODEL, D_MODEL, SHARED_FF, false, gtid, gsize);
    wt_convert(p.w_sh_down + (long)l * SHARED_FF * D_MODEL, p.wt_shd() + (long)l * D_MODEL * SHARED_FF, SHARED_FF, D_MODEL, false, gtid, gsize);
    wt_convert(p.w_router + (long)l * D_MODEL * N_EXPERTS, p.wt_rh() + (long)l * N_EXPERTS * D_MODEL, D_MODEL, N_EXPERTS, false, gtid, gsize);
    wt_convert(p.w_router + (long)l * D_MODEL * N_EXPERTS, p.wt_rl() + (long)l * N_EXPERTS * D_MODEL, D_MODEL, N_EXPERTS, true, gtid, gsize);
  }
}
struct ALRows { const char* base; unsigned off[2]; DEVM const unsigned short* a(int i, int kt) const { return (const unsigned short*)(base + (off[i] + (unsigned)kt * 128u)); } };
struct BLStd { static constexpr bool TR = false; const char* base; unsigned voff; int ldb4; bool valid;
  DEVM void load(float4 (&rb)[8], int kt) const {
#pragma unroll
    for (int i = 0; i < 8; ++i) rb[i] = valid ? *(const float4*)(base + (unsigned)((unsigned)(kt * 64 + i) * (unsigned)ldb4 + voff)) : make_float4(0.f, 0.f, 0.f, 0.f); } };
DEV unsigned bl_voff(int ldb4, int tid) { return (unsigned)((tid & 7) * 8) * (unsigned)ldb4 + (unsigned)((tid >> 3) * 16); }
DEV BLStd mk_bl(const float* B  , int ldb, int tid) {
  BLStd b; b.base = (const char*)B; b.ldb4 = ldb * 4; b.voff = bl_voff(ldb * 4, tid); b.valid = true; return b; }
#define SM_TILE 49152
template <int V = 0, class AL, class BL>
DEV void gemm_t(const AL& al, const BL& bl, int nk, f32x4 (&acc)[4][4], char* smem) {
  const int tid = otid(), lane = tid & 63, wid = tid >> 6, wr = wid >> 2, wc = wid & 3;
  const int l15 = lane & 15, q = lane >> 4, x = l15 >> 1;
  const char* ard0 = smem + SM_A + (wr * 64 + l15) * 128 + ((q ^ x) << 4);
  const char* ard1 = smem + SM_A + (wr * 64 + l15) * 128 + (((4 + q) ^ x) << 4);
  const char* brd0 = smem + SM_B + (wc * 64 + l15) * 128 + ((q ^ x) << 4);
  const char* brd1 = smem + SM_B + (wc * 64 + l15) * 128 + (((4 + q) ^ x) << 4);
  const int kq = tid & 7, nq = tid >> 3;
  char* awr = smem + SM_A + nq * 128 + ((kq ^ ((nq >> 1) & 7)) << 4);
  char* bwr0 = smem + SM_B + (nq * 4) * 128 + ((kq ^ ((2 * nq) & 7)) << 4);
  char* bwr1 = smem + SM_B + (nq * 4 + 2) * 128 + ((kq ^ ((2 * nq + 1) & 7)) << 4);
  if (nk <= 0) return;
  u32x4 ra[2]; float4 rb0[8];
#define GEMM_LOADA(KT) do { _Pragma("unroll") for (int i = 0; i < 2; ++i) ra[i] = *(const u32x4*)(al.a(i, (KT))); } while (0)
#define GEMM_WRITE(rb, PO) do { \
    *(u32x4*)(awr + (PO)) = ra[0]; *(u32x4*)(awr + (PO) + 8192) = ra[1]; \
    if (BL::TR) { u32x4 v; \
      v[0] = pack2(rb[0].x, rb[0].y); v[1] = pack2(rb[0].z, rb[0].w); v[2] = pack2(rb[1].x, rb[1].y); v[3] = pack2(rb[1].z, rb[1].w); *(u32x4*)(bwr0 + (PO)) = v; \
      v[0] = pack2(rb[2].x, rb[2].y); v[1] = pack2(rb[2].z, rb[2].w); v[2] = pack2(rb[3].x, rb[3].y); v[3] = pack2(rb[3].z, rb[3].w); *(u32x4*)(bwr0 + (PO) + 128) = v; \
      v[0] = pack2(rb[4].x, rb[4].y); v[1] = pack2(rb[4].z, rb[4].w); v[2] = pack2(rb[5].x, rb[5].y); v[3] = pack2(rb[5].z, rb[5].w); *(u32x4*)(bwr1 + (PO)) = v; \
      v[0] = pack2(rb[6].x, rb[6].y); v[1] = pack2(rb[6].z, rb[6].w); v[2] = pack2(rb[7].x, rb[7].y); v[3] = pack2(rb[7].z, rb[7].w); *(u32x4*)(bwr1 + (PO) + 128) = v; \
    } else { u32x4 v; \
      v[0] = pack2(rb[0].x, rb[1].x); v[1] = pack2(rb[2].x, rb[3].x); v[2] = pack2(rb[4].x, rb[5].x); v[3] = pack2(rb[6].x, rb[7].x); *(u32x4*)(bwr0 + (PO)) = v; \
      v[0] = pack2(rb[0].y, rb[1].y); v[1] = pack2(rb[2].y, rb[3].y); v[2] = pack2(rb[4].y, rb[5].y); v[3] = pack2(rb[6].y, rb[7].y); *(u32x4*)(bwr0 + (PO) + 128) = v; \
      v[0] = pack2(rb[0].z, rb[1].z); v[1] = pack2(rb[2].z, rb[3].z); v[2] = pack2(rb[4].z, rb[5].z); v[3] = pack2(rb[6].z, rb[7].z); *(u32x4*)(bwr1 + (PO)) = v; \
      v[0] = pack2(rb[0].w, rb[1].w); v[1] = pack2(rb[2].w, rb[3].w); v[2] = pack2(rb[4].w, rb[5].w); v[3] = pack2(rb[6].w, rb[7].w); *(u32x4*)(bwr1 + (PO) + 128) = v; \
    } } while (0)
  GEMM_LOADA(0);
  bl.load(rb0, 0);
  __syncthreads();
  GEMM_WRITE(rb0, 0);
  if (V != 3) { if (nk > 1) { GEMM_LOADA(1); bl.load(rb0, 1); } }
  __syncthreads();
#define GEMM_STEP(rbn, KT) do { \
    const int po = ((KT) & 1) * SM_TILE; \
    bf16x8 fa0[4], fb0[4], fa1[4], fb1[4]; \
    _Pragma("unroll") for (int n = 0; n < 4; ++n) fb0[n] = *(const bf16x8*)(brd0 + po + n * 2048); \
    _Pragma("unroll") for (int m = 0; m < 4; ++m) fa0[m] = *(const bf16x8*)(ard0 + po + m * 2048); \
    _Pragma("unroll") for (int n = 0; n < 4; ++n) fb1[n] = *(const bf16x8*)(brd1 + po + n * 2048); \
    _Pragma("unroll") for (int m = 0; m < 4; ++m) fa1[m] = *(const bf16x8*)(ard1 + po + m * 2048); \
    __builtin_amdgcn_sched_barrier(0);     \
    if ((KT) + 1 < nk) { \
      GEMM_WRITE(rbn, SM_TILE - po); \
      if (V != 3) { if ((KT) + 2 < nk) { GEMM_LOADA((KT) + 2); bl.load(rbn, (KT) + 2); } } \
    } \
    __builtin_amdgcn_sched_barrier(0); \
    if (V != 2) { \
      _Pragma("unroll") for (int m = 0; m < 4; ++m) _Pragma("unroll") for (int n = 0; n < 4; ++n) acc[m][n] = __builtin_amdgcn_mfma_f32_16x16x32_bf16(fa0[m], fb0[n], acc[m][n], 0, 0, 0); \
      _Pragma("unroll") for (int m = 0; m < 4; ++m) _Pragma("unroll") for (int n = 0; n < 4; ++n) acc[m][n] = __builtin_amdgcn_mfma_f32_16x16x32_bf16(fa1[m], fb1[n], acc[m][n], 0, 0, 0); \
    } else { _Pragma("unroll") for (int m = 0; m < 4; ++m) asm volatile("" :: "v"(fa0[m]), "v"(fb0[m]), "v"(fa1[m]), "v"(fb1[m])); } \
    __syncthreads(); \
  } while (0)
  int kt = 0;
#pragma unroll 1
  for (; kt < nk; ++kt) { GEMM_STEP(rb0, kt); }
#undef GEMM_STEP
#undef GEMM_WRITE
#undef GEMM_LOADA
}

struct BLT { const char* base; unsigned voff; unsigned rowb;
  DEVM void load(u32x4 (&rb)[4], int kt) const {
#pragma unroll
    for (int c = 0; c < 4; ++c) rb[c] = *(const u32x4*)(base + (voff + (unsigned)c * rowb + (unsigned)kt * 128u)); } };
DEV BLT mk_blt(const unsigned short* BT  , int K, int tid) {
  BLT b; b.base = (const char*)BT; b.rowb = (unsigned)K * 2u; b.voff = (unsigned)((tid >> 3) * 4) * b.rowb + (unsigned)((tid & 7) * 16); return b; }
template <class AL, class BL>
DEV void gemm_tb(const AL& al, const BL& bl, int nk, f32x4 (&acc)[4][4], char* smem) {
  const int tid = otid(), lane = tid & 63, wid = tid >> 6, wr = wid >> 2, wc = wid & 3;
  const int l15 = lane & 15, q = lane >> 4, x = l15 >> 1;
  const char* ard0 = smem + SM_A + (wr * 64 + l15) * 128 + ((q ^ x) << 4);
  const char* ard1 = smem + SM_A + (wr * 64 + l15) * 128 + (((4 + q) ^ x) << 4);
  const char* brd0 = smem + SM_B + (wc * 64 + l15) * 128 + ((q ^ x) << 4);
  const char* brd1 = smem + SM_B + (wc * 64 + l15) * 128 + (((4 + q) ^ x) << 4);
  const int kq = tid & 7, nq = tid >> 3;
  char* awr = smem + SM_A + nq * 128 + ((kq ^ ((nq >> 1) & 7)) << 4);
  char* bwr0 = smem + SM_B + (nq * 4) * 128 + ((kq ^ ((2 * nq) & 7)) << 4);
  char* bwr1 = smem + SM_B + (nq * 4 + 2) * 128 + ((kq ^ ((2 * nq + 1) & 7)) << 4);
  if (nk <= 0) return;
  u32x4 ra[2]; u32x4 rb0[4], rb1[4];
#define TB_LOADA(KT) do { _Pragma("unroll") for (int i = 0; i < 2; ++i) ra[i] = *(const u32x4*)(al.a(i, (KT))); } while (0)
#define TB_WRITE(rb, PO) do { \
    *(u32x4*)(awr + (PO)) = ra[0]; *(u32x4*)(awr + (PO) + 8192) = ra[1]; \
    *(u32x4*)(bwr0 + (PO)) = rb[0]; *(u32x4*)(bwr0 + (PO) + 128) = rb[1]; *(u32x4*)(bwr1 + (PO)) = rb[2]; *(u32x4*)(bwr1 + (PO) + 128) = rb[3]; } while (0)
  TB_LOADA(0);
  bl.load(rb0, 0);
  if (nk > 1) bl.load(rb1, 1);
  __syncthreads();
  TB_WRITE(rb0, 0);
  if (nk > 1) TB_LOADA(1);
  if (nk > 2) bl.load(rb0, 2);
  __syncthreads();
#define TB_STEP(rbn, KT) do { \
    const int po = ((KT) & 1) * SM_TILE; \
    bf16x8 fa0[4], fb0[4], fa1[4], fb1[4]; \
    _Pragma("unroll") for (int n = 0; n < 4; ++n) fb0[n] = *(const bf16x8*)(brd0 + po + n * 2048); \
    _Pragma("unroll") for (int m = 0; m < 4; ++m) fa0[m] = *(const bf16x8*)(ard0 + po + m * 2048); \
    _Pragma("unroll") for (int n = 0; n < 4; ++n) fb1[n] = *(const bf16x8*)(brd1 + po + n * 2048); \
    _Pragma("unroll") for (int m = 0; m < 4; ++m) fa1[m] = *(const bf16x8*)(ard1 + po + m * 2048); \
    __builtin_amdgcn_sched_barrier(0); \
    if ((KT) + 1 < nk) { \
      TB_WRITE(rbn, SM_TILE - po); \
      if ((KT) + 2 < nk) TB_LOADA((KT) + 2); \
      if ((KT) + 3 < nk) bl.load(rbn, (KT) + 3); \
    } \
    __builtin_amdgcn_sched_barrier(0); \
    _Pragma("unroll") for (int m = 0; m < 4; ++m) _Pragma("unroll") for (int n = 0; n < 4; ++n) acc[m][n] = __builtin_amdgcn_mfma_f32_16x16x32_bf16(fa0[m], fb0[n], acc[m][n], 0, 0, 0); \
    _Pragma("unroll") for (int m = 0; m < 4; ++m) _Pragma("unroll") for (int n = 0; n < 4; ++n) acc[m][n] = __builtin_amdgcn_mfma_f32_16x16x32_bf16(fa1[m], fb1[n], acc[m][n], 0, 0, 0); \
    __syncthreads(); \
  } while (0)
  int kt = 0;
#pragma unroll 1
  for (; kt + 1 < nk; kt += 2) { TB_STEP(rb1, kt); TB_STEP(rb0, kt + 1); }
  if (kt < nk) TB_STEP(rb1, kt);
#undef TB_STEP
#undef TB_WRITE
#undef TB_LOADA
}
DEV void acc_zero(f32x4 (&acc)[4][4]) {
#pragma unroll
  for (int m = 0; m < 4; ++m)
#pragma unroll
    for (int n = 0; n < 4; ++n) acc[m][n] = (f32x4){0.f, 0.f, 0.f, 0.f};
}
#define EPI_BEGIN const int etid = otid();
#define EPI_ROW(m, j) (((etid >> 8) & 1) * 64 + (m) * 16 + ((etid & 63) >> 4) * 4 + (j))
#define EPI_COL(n) (((etid >> 6) & 3) * 64 + (n) * 16 + (etid & 15))

template <class Epi>
DEV void gemm_phase_dense(const unsigned short* A, int lda, const unsigned short* BT, int N, int K, Epi epi, char* smem) {
  const int tid = otid(); const int nct = N >> 8; const int nitems = (NR >> 7) * nct;
  for (int it = blockIdx.x; it < nitems; it += gridDim.x) {
    const int rt = it / nct, ct = it - rt * nct;
    ALRows al; al.base = (const char*)(A + (long)rt * 128 * lda);
#pragma unroll
    for (int i = 0; i < 2; ++i) al.off[i] = (unsigned)(((tid >> 3) + 64 * i) * lda + (tid & 7) * 8) * 2u;
    const BLT bl = mk_blt(BT + (long)ct * 256 * K, K, tid);
    f32x4 acc[4][4]; acc_zero(acc);
    gemm_tb(al, bl, K >> 6, acc, smem);
    EPI_BEGIN
#pragma unroll
    for (int m = 0; m < 4; ++m)
#pragma unroll
      for (int n = 0; n < 4; ++n)
#pragma unroll
        for (int j = 0; j < 4; ++j) epi((long)rt * 128 + EPI_ROW(m, j), ct * 256 + EPI_COL(n), acc[m][n][j]);
  }
}
DEV void ph_proj_mfma(const P& p, int l, char* smem) {
  const int tid = otid(); const int nct = IN_W >> 8; const int nitems = (NR >> 7) * nct;
  const float* B = p.w_in + (long)l * D_MODEL * IN_W;
  for (int it = blockIdx.x; it < nitems; it += gridDim.x) {
    const int rt = it / nct, ct = it - rt * nct;
    ALRows al; al.base = (const char*)(p.ubf() + (long)rt * 128 * D_MODEL);
#pragma unroll
    for (int i = 0; i < 2; ++i) al.off[i] = (unsigned)(((tid >> 3) + 64 * i) * D_MODEL + (tid & 7) * 8) * 2u;
    const BLT bl = mk_blt(p.wt_in() + ((long)l * IN_W + ct * 256) * D_MODEL, D_MODEL, tid);
    f32x4 acc[4][4]; acc_zero(acc);
    gemm_tb(al, bl, D_MODEL >> 6, acc, smem);
    EPI_BEGIN
    if (ct >= HY_OFF / 256 && ct < S5_OFF / 256) {
      const bool isctx = rt >= NL / 128;
      const int rloc = (isctx ? (rt - NL / 128) : rt) * 128;
      const int Ls = isctx ? CTX_LEN : SEQ; const int b = rloc / Ls; const int t0 = rloc - b * Ls;
      float* zb = p.zT() + (isctx ? (size_t)BATCH * 3 * HYENA_W * SEQ : (size_t)0) + (size_t)b * 3 * HYENA_W * Ls;
#pragma unroll
      for (int m = 0; m < 4; ++m)
#pragma unroll
        for (int n = 0; n < 4; ++n) {
          const int c = ct * 256 + EPI_COL(n) - HY_OFF; const int t = t0 + EPI_ROW(m, 0);
          *(float4*)(zb + (size_t)c * Ls + t) = make_float4(acc[m][n][0], acc[m][n][1], acc[m][n][2], acc[m][n][3]);
        }
    } else if (ct == S5_OFF / 256) {
#pragma unroll
      for (int m = 0; m < 4; ++m)
#pragma unroll
        for (int n = 0; n < 4; ++n)
#pragma unroll
          for (int j = 0; j < 4; ++j) p.s5u()[((long)rt * 128 + EPI_ROW(m, j)) * S5_W + EPI_COL(n)] = (unsigned short)f2bf(acc[m][n][j]);
    } else {
      const int head = ct * 4 + ((etid >> 6) & 3);
      const bool isq = head < N_Q_HEADS, dorope = head < N_Q_HEADS + N_KV_HEADS && rt < NL / 128;
      const float qs = isq ? 0.125f * 1.4426950408889634f : 1.0f;
      const int c16 = etid & 15;
#pragma unroll
      for (int m = 0; m < 4; ++m)
#pragma unroll
        for (int j = 0; j < 4; ++j) {
          const long row = (long)rt * 128 + EPI_ROW(m, j);
          float v0 = acc[m][0][j], v1 = acc[m][1][j], v2 = acc[m][2][j], v3 = acc[m][3][j];
          if (dorope) {
            const int t = (int)(row % SEQ);
            const float2 cr = p.ropet()[(t / GRID_W) * ROPE_HALF + c16], cc = p.ropet()[(t % GRID_W) * ROPE_HALF + c16];
            const float a0 = v0 * cr.x - v1 * cr.y, a1 = v0 * cr.y + v1 * cr.x, a2 = v2 * cc.x - v3 * cc.y, a3 = v2 * cc.y + v3 * cc.x;
            v0 = a0; v1 = a1; v2 = a2; v3 = a3;
          }
          unsigned short* dst = p.qkvb() + row * HY_OFF + head * HEAD_DIM + c16;
          dst[0] = (unsigned short)f2bf(v0 * qs); dst[16] = (unsigned short)f2bf(v1 * qs); dst[32] = (unsigned short)f2bf(v2 * qs); dst[48] = (unsigned short)f2bf(v3 * qs);
        }
    }
  }
}
DEV void ph_hyena_pre_gpu(const P& p, int l, long gtid, long gsize) {
  const float* sw = p.hy_short_w + l * 3 * 3 * HYENA_W; const float* sb = p.hy_short_b + l * 3 * HYENA_W;
  FOR_ITEMS4(i, (long)BATCH * HYENA_W * (SEQ + CTX_LEN)) {
    const bool isctx = i >= (long)BATCH * HYENA_W * SEQ; const long ii = isctx ? i - (long)BATCH * HYENA_W * SEQ : i;
    const int Ls = isctx ? CTX_LEN : SEQ; const int t = (int)(ii % Ls); const int ch = (int)((ii / Ls) % HYENA_W); const int b = (int)(ii / ((long)Ls * HYENA_W));
    const float* zb = p.zT() + (isctx ? (size_t)BATCH * 3 * HYENA_W * SEQ : (size_t)0) + (size_t)b * 3 * HYENA_W * Ls;
    float z[3];
#pragma unroll
    for (int part = 0; part < 3; ++part) {
      const int cc = part * HYENA_W + ch; const float* zr = zb + (size_t)cc * Ls; float acc = sb[cc];
      if (t > 0) acc += zr[t - 1] * sw[cc];
      acc += zr[t] * sw[3 * HYENA_W + cc];
      if (t + 1 < Ls) acc += zr[t + 1] * sw[2 * 3 * HYENA_W + cc];
      z[part] = acc;
    }
    const long o = isctx ? ((long)NL + b * CTX_LEN + t) * HYENA_W + ch : ((long)b * HYENA_W + ch) * SEQ + t;
    p.hu()[o] = z[0] * z[1]; p.hx0()[o] = z[2];
  }
}
DEV void rms_rows(const P& p, int l, long r0, long r1, int w0, int nw);
DEV void ph_glu_mfma(const P& p, int l, char* smem) {
  const int tid = otid();
  for (int rt = blockIdx.x; rt < (NR >> 7); rt += gridDim.x) {
    ALRows al; al.base = (const char*)(p.ybf() + (long)rt * 128 * S5_W);
#pragma unroll
    for (int i = 0; i < 2; ++i) al.off[i] = (unsigned)(((tid >> 3) + 64 * i) * S5_W + (tid & 7) * 8) * 2u;
    const BLT bl = mk_blt(p.wt_glu() + (long)l * S5_W * S5_W, S5_W, tid);
    f32x4 acc[4][4]; acc_zero(acc);
    gemm_tb(al, bl, S5_W >> 6, acc, smem);
    EPI_BEGIN
#pragma unroll
    for (int m = 0; m < 4; ++m)
#pragma unroll
      for (int n = 0; n < 4; ++n)
#pragma unroll
        for (int j = 0; j < 4; ++j) {
          const long r = (long)rt * 128 + EPI_ROW(m, j); const int c = EPI_COL(n);
          p.mixb()[r * MIX_W + ATTN_W + HYENA_W + c] = __uint_as_float((unsigned)p.ybf()[r * S5_W + c] << 16) * sigmoidf_(acc[m][n][j]);
        }
    asm volatile("s_waitcnt vmcnt(0)" ::: "memory");
    __syncthreads();
    rms_rows(p, l, (long)rt * 128, (long)rt * 128 + 128, otid() >> 6, NT / 64);
  }
}
DEV void ph_outproj_mfma(const P& p, int l, char* smem) {
  EpiRes e{p.xcur(), p.mod(), l, 2 * D_MODEL, p.tmp()};
  gemm_phase_dense(p.mixbf(), MIX_W, p.wt_out() + (long)l * D_MODEL * MIX_W, D_MODEL, MIX_W, e, smem);
}

#define M3_ROWS 320
struct ALRows5 { const char* base; unsigned off[5]; DEVM const unsigned short* a(int i, int kt) const { return (const unsigned short*)(base + (off[i] + (unsigned)kt * 128u)); } };
struct BLStd4 { const char* base; unsigned voff; int ldb4;
  DEVM void load(float4 (&rb)[4], int kt) const {
    unsigned vo = voff; asm volatile("" : "+v"(vo));
#pragma unroll
    for (int i = 0; i < 4; ++i) rb[i] = *(const float4*)(base + (unsigned)((unsigned)(kt * 64 + i) * (unsigned)ldb4 + vo)); } };
#define SM_B3 (SM_A + 40960)
#define SM_TILE3 57344
template <class AL, class BL>
DEV void gemm_m3(const AL& al, const BL& bl, int nk, int nrows, f32x4 (&acc)[5][4], char* smem) {
  const int tid = otid(), lane = tid & 63, wid = tid >> 6, wr = wid >> 1, wc = wid & 1;
  const int l15 = lane & 15, q = lane >> 4, x = l15 >> 1;
  const bool has5 = __builtin_amdgcn_readfirstlane((int)(nrows > 256 + 16 * wr)) != 0;
  const char* ard0 = smem + SM_A + (wr * 16 + l15) * 128 + ((q ^ x) << 4);
  const char* ard1 = smem + SM_A + (wr * 16 + l15) * 128 + (((4 + q) ^ x) << 4);
  const char* brd0 = smem + SM_B3 + (wc * 64 + l15) * 128 + ((q ^ x) << 4);
  const char* brd1 = smem + SM_B3 + (wc * 64 + l15) * 128 + (((4 + q) ^ x) << 4);
  const int kq = tid & 7, ar = tid >> 3, nq = (tid >> 3) & 31, kh = tid >> 8;
  char* awr = smem + SM_A + ar * 128 + ((kq ^ ((ar >> 1) & 7)) << 4);
  char* bwr0 = smem + SM_B3 + (nq * 4) * 128 + ((kq ^ ((2 * nq) & 7)) << 4) + kh * 8;
  char* bwr1 = smem + SM_B3 + (nq * 4 + 2) * 128 + ((kq ^ ((2 * nq + 1) & 7)) << 4) + kh * 8;
  if (nk <= 0) return;
  u32x4 ra[5]; float4 rb0[4];
#define M3_LOADA(KT) do { _Pragma("unroll") for (int i = 0; i < 5; ++i) ra[i] = *(const u32x4*)(al.a(i, (KT))); } while (0)
#define M3_WRITE(rb, PO) do { \
    _Pragma("unroll") for (int i = 0; i < 5; ++i) *(u32x4*)(awr + (PO) + 8192 * i) = ra[i]; \
    { u32x2 v; \
      v[0] = pack2(rb[0].x, rb[1].x); v[1] = pack2(rb[2].x, rb[3].x); *(u32x2*)(bwr0 + (PO)) = v; \
      v[0] = pack2(rb[0].y, rb[1].y); v[1] = pack2(rb[2].y, rb[3].y); *(u32x2*)(bwr0 + (PO) + 128) = v; \
      v[0] = pack2(rb[0].z, rb[1].z); v[1] = pack2(rb[2].z, rb[3].z); *(u32x2*)(bwr1 + (PO)) = v; \
      v[0] = pack2(rb[0].w, rb[1].w); v[1] = pack2(rb[2].w, rb[3].w); *(u32x2*)(bwr1 + (PO) + 128) = v; } } while (0)
  M3_LOADA(0);
  bl.load(rb0, 0);
  __syncthreads();
  M3_WRITE(rb0, 0);
  if (nk > 1) { M3_LOADA(1); bl.load(rb0, 1); }
  __syncthreads();
#define M3_MMA(fa, fb) do { \
    _Pragma("unroll") for (int m = 0; m < 4; ++m) _Pragma("unroll") for (int n = 0; n < 4; ++n) acc[m][n] = __builtin_amdgcn_mfma_f32_16x16x32_bf16(fa[m], fb[n], acc[m][n], 0, 0, 0); \
    if (has5) { _Pragma("unroll") for (int n = 0; n < 4; ++n) acc[4][n] = __builtin_amdgcn_mfma_f32_16x16x32_bf16(fa[4], fb[n], acc[4][n], 0, 0, 0); } } while (0)
#define M3_STEP(rbn, KT) do { \
    const int po = ((KT) & 1) * SM_TILE3; \
    bf16x8 fa0[5], fb0[4], fa1[5], fb1[4]; \
    _Pragma("unroll") for (int n = 0; n < 4; ++n) fb0[n] = *(const bf16x8*)(brd0 + po + n * 2048); \
    _Pragma("unroll") for (int m = 0; m < 5; ++m) fa0[m] = *(const bf16x8*)(ard0 + po + m * 8192); \
    __builtin_amdgcn_sched_barrier(0); \
    if ((KT) + 1 < nk) { \
      M3_WRITE(rbn, SM_TILE3 - po); \
      if ((KT) + 2 < nk) { M3_LOADA((KT) + 2); bl.load(rbn, (KT) + 2); } \
    } \
    __builtin_amdgcn_sched_barrier(0); \
    _Pragma("unroll") for (int n = 0; n < 4; ++n) fb1[n] = *(const bf16x8*)(brd1 + po + n * 2048); \
    _Pragma("unroll") for (int m = 0; m < 5; ++m) fa1[m] = *(const bf16x8*)(ard1 + po + m * 8192); \
    M3_MMA(fa0, fb0); \
    M3_MMA(fa1, fb1); \
    __syncthreads(); \
  } while (0)
  int kt = 0;
#pragma unroll 1
  for (; kt + 1 < nk; kt += 2) { M3_STEP(rb0, kt); M3_STEP(rb0, kt + 1); }
  if (kt < nk) M3_STEP(rb0, kt);
#undef M3_STEP
#undef M3_MMA
#undef M3_WRITE
#undef M3_LOADA
}
#define EPI3_ROW(m, j) ((((etid >> 7) & 3) + 4 * (m)) * 16 + ((etid & 63) >> 4) * 4 + (j))
#define EPI2_COL(n) (((etid >> 6) & 1) * 64 + (n) * 16 + (etid & 15))
#define EXP_ITEM(tile) \
    const int e = __builtin_amdgcn_readfirstlane(exp_find(toff, (tile))); const int tle_ = toff[e + 1] - toff[e]; \
    const int rpt_ = (((roff[e] + tle_ - 1) / tle_) + 15) & ~15; const int j0 = ((tile) - toff[e]) * rpt_; \
    const int nrows = min(rpt_, roff[e] - j0); \
    if (nrows <= 0) continue;
DEV void exp_prefix(const P& p, int l, int* toff, int* roff, int* rowo) {
  const int tid = otid(), lane = tid & 63, w = tid >> 6;
  __syncthreads();
  int c = 0, tl = 0, incl = 0, rinc = 0;
  int* wsum = roff + N_EXPERTS + 8;
  if (tid < N_EXPERTS) {
    c = p.cnt()[l * N_EXPERTS + tid];
    tl = (c + M3_ROWS - 1) / M3_ROWS; incl = tl; rinc = c;
#pragma unroll
    for (int o = 1; o < 64; o <<= 1) { const int v = __shfl_up(incl, o), v2 = __shfl_up(rinc, o); if (lane >= o) { incl += v; rinc += v2; } }
    if (lane == 63) { wsum[w] = incl; wsum[4 + w] = rinc; }
    roff[tid] = c;
  }
  __syncthreads();
  if (tid < N_EXPERTS) {
    int base = 0, rb = 0;
#pragma unroll
    for (int k = 0; k < 4; ++k) if (k < w) { base += wsum[k]; rb += wsum[4 + k]; }
    toff[tid] = base + incl - tl;
    rowo[tid] = rb + rinc - c;
    if (tid == N_EXPERTS - 1) toff[N_EXPERTS] = base + incl;
  }
  __syncthreads();
}
#define EXP_TABLES int* toff = (int*)(smem + SM_MISC); int* roff = toff + N_EXPERTS + 1; int* rowo = roff + N_EXPERTS + 16;
DEV int exp_find(const int* toff, int tile) {
  int lo = 0, hi = N_EXPERTS - 1;
  while (lo < hi) { int mid = (lo + hi + 1) >> 1; if (toff[mid] <= tile) lo = mid; else hi = mid - 1; }
  return lo;
}
template <int V = 0>
DEV void upgate_tile(const ALRows& al, const float* wg, const float* wu, int cq, f32x4 (&acc)[4][4], char* smem, int tid) {
  const int nq = tid >> 3; const int wsel = __builtin_amdgcn_readfirstlane(tid >> 6) & 1;
  BLStd bl; bl.base = (const char*)((wsel ? wu : wg) + cq * 128); bl.ldb4 = EXPERT_FF * 4; bl.valid = true;
  bl.voff = (unsigned)((tid & 7) * 8) * (unsigned)(EXPERT_FF * 4) + (unsigned)(((nq >> 4) * 32 + (nq & 7) * 4) * 4);
  acc_zero(acc);
  gemm_t<V>(al, bl, D_MODEL >> 6, acc, smem);
}
static_assert(EXPERT_FF == 256 && SHARED_FF == 256, "ff tiling");
template <int V = 0>
DEV void ph_expert_up_mfma(const P& p, int l, char* smem) {
  const int tid = otid();
  EXP_TABLES
  exp_prefix(p, l, toff, roff, rowo);
  const int n_items = toff[N_EXPERTS] * 4;
  for (int it = blockIdx.x; it < n_items; it += gridDim.x) {
    const int tile = it >> 2, cq = it & 3;
    EXP_ITEM(tile)
    const int rbase = e * NR + j0, crow0 = rowo[e] + j0;
    const float* wg = p.w_exp_gate + ((long)l * N_EXPERTS + e) * D_MODEL * EXPERT_FF; const float* wu = p.w_exp_up + ((long)l * N_EXPERTS + e) * D_MODEL * EXPERT_FF;
    ALRows5 al; al.base = (const char*)p.ubf();
#pragma unroll
    for (int i = 0; i < 5; ++i) { const int rl = min((tid >> 3) + 64 * i, nrows - 1); al.off[i] = ((unsigned)(p.elist()[rbase + rl] / TOP_K) * D_MODEL + (tid & 7) * 8) * 2u; }
    const int nq = (tid >> 3) & 31; const int wsel = __builtin_amdgcn_readfirstlane(tid >> 6) & 1;
    BLStd4 bl; bl.base = (const char*)((wsel ? wu : wg) + cq * 64); bl.ldb4 = EXPERT_FF * 4;
    bl.voff = (unsigned)((tid & 7) * 8 + (tid >> 8) * 4) * (unsigned)(EXPERT_FF * 4) + (unsigned)(((nq >> 4) * 32 + (nq & 7) * 4) * 4);
    f32x4 acc[5][4];
#pragma unroll
    for (int m = 0; m < 5; ++m)
#pragma unroll
      for (int n = 0; n < 4; ++n) acc[m][n] = f32x4{0.f, 0.f, 0.f, 0.f};
    gemm_m3(al, bl, D_MODEL >> 6, nrows, acc, smem);
    EPI_BEGIN
    const int ewc = (etid >> 6) & 1, ec = etid & 15;
#pragma unroll
    for (int m = 0; m < 5; ++m)
#pragma unroll
      for (int j = 0; j < 4; ++j) {
        const int rl = EPI3_ROW(m, j);
        if (rl < nrows) {
          const float gsc = p.egate()[rbase + rl];
          unsigned short* dst = p.hbf() + (long)(crow0 + rl) * EXPERT_FF + cq * 64 + ewc * 32 + ec;
          dst[0] = (unsigned short)f2bf(siluq(acc[m][0][j]) * acc[m][2][j] * gsc); dst[16] = (unsigned short)f2bf(siluq(acc[m][1][j]) * acc[m][3][j] * gsc);
        }
      }
  }
}
DEV void ph_expert_down_mfma(const P& p, int l, char* smem) {
  const int tid = otid();
  EXP_TABLES
  exp_prefix(p, l, toff, roff, rowo);
  const int NC8 = D_MODEL / 128;
  const int n_exp_items = toff[N_EXPERTS] * NC8;
  for (int it = blockIdx.x; it < n_exp_items; it += gridDim.x) {
    const int tile = it / NC8, ct = it - tile * NC8;
    EXP_ITEM(tile)
    const int crow0 = rowo[e] + j0;
    const float* wd = p.w_exp_down + ((long)l * N_EXPERTS + e) * EXPERT_FF * D_MODEL;
    ALRows5 al; al.base = (const char*)p.hbf();
#pragma unroll
    for (int i = 0; i < 5; ++i) { const int rl = min((tid >> 3) + 64 * i, nrows - 1); al.off[i] = ((unsigned)(crow0 + rl) * EXPERT_FF + (tid & 7) * 8) * 2u; }
    BLStd4 bl; bl.base = (const char*)(wd + ct * 128); bl.ldb4 = D_MODEL * 4;
    bl.voff = (unsigned)((tid & 7) * 8 + (tid >> 8) * 4) * (unsigned)(D_MODEL * 4) + (unsigned)(((tid >> 3) & 31) * 16);
    f32x4 acc[5][4];
#pragma unroll
    for (int m = 0; m < 5; ++m)
#pragma unroll
      for (int n = 0; n < 4; ++n) acc[m][n] = f32x4{0.f, 0.f, 0.f, 0.f};
    gemm_m3(al, bl, EXPERT_FF >> 6, nrows, acc, smem);
    EPI_BEGIN
#pragma unroll
    for (int m = 0; m < 5; ++m)
#pragma unroll
      for (int j = 0; j < 4; ++j) {
        const int rl = EPI3_ROW(m, j);
        if (rl < nrows) {
          unsigned short* dst = p.ykb() + (long)(crow0 + rl) * D_MODEL + ct * 128;
#pragma unroll
          for (int n = 0; n < 4; ++n) dst[EPI2_COL(n)] = (unsigned short)f2bf(acc[m][n][j]);
        }
      }
  }
  const int NCT = D_MODEL / 256;
  const int n_sh_items = (NR >> 7) * NCT;
  for (int it = (int)gridDim.x - 1 - (int)blockIdx.x; it < n_sh_items; it += gridDim.x) {
    const int rt = it / NCT, ct = it - rt * NCT;
    ALRows al; al.base = (const char*)(p.hsbf() + (long)rt * 128 * SHARED_FF);
#pragma unroll
    for (int i = 0; i < 2; ++i) al.off[i] = (unsigned)(((tid >> 3) + 64 * i) * SHARED_FF + (tid & 7) * 8) * 2u;
    const BLT bl = mk_blt(p.wt_shd() + ((long)l * D_MODEL + ct * 256) * SHARED_FF, SHARED_FF, tid);
    f32x4 acc[4][4]; acc_zero(acc);
    gemm_tb(al, bl, SHARED_FF >> 6, acc, smem);
    EPI_BEGIN
#pragma unroll
    for (int m = 0; m < 4; ++m)
#pragma unroll
      for (int n = 0; n < 4; ++n)
#pragma unroll
        for (int j = 0; j < 4; ++j) p.ysh()[((long)rt * 128 + EPI_ROW(m, j)) * D_MODEL + ct * 256 + EPI_COL(n)] = acc[m][n][j];
  }
}

typedef __attribute__((ext_vector_type(16))) float f32x16;
#define SM_HR 256
#define UB_STRIDE 8272
#define SM_HU (256 + 32768)
#define SMEM_HY (256 + 32768 + 2 * UB_STRIDE * 2)
static_assert(SEQ == 8192 && HYENA_W == 256, "hyena mfma shape");
DEV void ph_hyena_mfma(const P& p, int l, char* smem) {
  const int tid = otid(), lane = tid & 63, w = tid >> 6;
  unsigned short* R = (unsigned short*)(smem + SM_HR); unsigned short* U = (unsigned short*)(smem + SM_HU);
  for (int ch = blockIdx.x; ch < HYENA_W; ch += gridDim.x) {
    __syncthreads();
    const float* kf = p.kraw() + ((long)l * 2 * HYENA_W + ch) * SEQ; const float* kb = p.kraw() + ((long)l * 2 * HYENA_W + HYENA_W + ch) * SEQ;
    {
      float4 fa[2][2]; float fx[2]; float4 ba[2][2];
#pragma unroll
      for (int i = 0; i < 2; ++i) {
        const int base = 8 * (1024 - (tid + 512 * i));
        fa[i][0] = *(const float4*)(kf + base - 8); fa[i][1] = *(const float4*)(kf + base - 4); fx[i] = base < SEQ ? kf[base] : 0.f;
      }
#pragma unroll
      for (int i = 0; i < 2; ++i) {
        const int o = 8 * (tid + 512 * i);
        ba[i][0] = *(const float4*)(kb + o); ba[i][1] = *(const float4*)(kb + o + 4);
      }
      const float kf0 = kf[0];
#pragma unroll
      for (int i = 0; i < 2; ++i) {
        const int C = tid + 512 * i; u32x4 v;
        v[0] = pack2(fx[i], fa[i][1].w); v[1] = pack2(fa[i][1].z, fa[i][1].y); v[2] = pack2(fa[i][1].x, fa[i][0].w); v[3] = pack2(fa[i][0].z, fa[i][0].y);
        *(u32x4*)((char*)R + ((C ^ ((C >> 4) & 1)) << 4)) = v;
      }
#pragma unroll
      for (int i = 0; i < 2; ++i) {
        const int C = 1024 + tid + 512 * i; u32x4 v;
        v[0] = pack2((i == 0 && tid == 0) ? kf0 : ba[i][0].x, ba[i][0].y); v[1] = pack2(ba[i][0].z, ba[i][0].w); v[2] = pack2(ba[i][1].x, ba[i][1].y); v[3] = pack2(ba[i][1].z, ba[i][1].w);
        *(u32x4*)((char*)R + ((C ^ ((C >> 4) & 1)) << 4)) = v;
      }
      __builtin_amdgcn_sched_barrier(0);
      float4 ua[5][2];
#pragma unroll
      for (int i = 0; i < 5; ++i) {
        const int cc = tid + 512 * i; const int b = cc >= (UB_STRIDE / 8) ? 1 : 0; const int c = cc - b * (UB_STRIDE / 8);
        const bool ok = cc < 2 * (UB_STRIDE / 8) && c >= 2 && c < 2 + SEQ / 8;
        const float* src = p.hu() + ((long)b * HYENA_W + ch) * SEQ + (ok ? 8 * c - 16 : 0);
        ua[i][0] = ok ? *(const float4*)src : make_float4(0.f, 0.f, 0.f, 0.f); ua[i][1] = ok ? *(const float4*)(src + 4) : make_float4(0.f, 0.f, 0.f, 0.f);
      }
#pragma unroll
      for (int i = 0; i < 5; ++i) {
        const int cc = tid + 512 * i;
        if (cc < 2 * (UB_STRIDE / 8)) {
          u32x4 v; v[0] = pack2(ua[i][0].x, ua[i][0].y); v[1] = pack2(ua[i][0].z, ua[i][0].w); v[2] = pack2(ua[i][1].x, ua[i][1].y); v[3] = pack2(ua[i][1].z, ua[i][1].w);
          *(u32x4*)((char*)U + cc * 16) = v;
        }
      }
    }
    __syncthreads();
    f32x16 acc[2];
#pragma unroll
    for (int mi = 0; mi < 2; ++mi)
#pragma unroll
      for (int k = 0; k < 16; ++k) acc[mi][k] = 0.f;
    const int r = lane & 31, h = lane >> 5, sig = lane & 15, bb = (lane >> 4) & 1;
    const unsigned* Ud = (const unsigned*)U + bb * (UB_STRIDE / 2);
    const int ub0 = 8 * h + sig;
    const int cbase = 1022 - 64 * (2 * w) - 2 * r + h;
    const bool odd = sig & 1;
#define HY_LOAD(AF, D, Q) do { const int qq_ = (Q); \
      _Pragma("unroll") for (int mi = 0; mi < 2; ++mi) { const int C = cbase - 64 * mi + 2 * qq_; AF[mi] = *(const bf16x8*)((const char*)R + ((C ^ ((C >> 4) & 1)) << 4)); } \
      const int di_ = (16 * qq_ + ub0) >> 1; \
      _Pragma("unroll") for (int i = 0; i < 5; ++i) D[i] = Ud[di_ + i]; } while (0)
#define HY_MMA(AF, D) do { u32x4 bw_; \
      _Pragma("unroll") for (int i = 0; i < 4; ++i) bw_[i] = odd ? __builtin_amdgcn_alignbit(D[i + 1], D[i], 16) : D[i]; \
      const bf16x8 bfr_ = __builtin_bit_cast(bf16x8, bw_); \
      _Pragma("unroll") for (int mi = 0; mi < 2; ++mi) acc[mi] = __builtin_amdgcn_mfma_f32_32x32x16_bf16(AF[mi], bfr_, acc[mi], 0, 0, 0); } while (0)
    bf16x8 a0[2], a1[2], a2[2], a3[2]; unsigned d0[5], d1[5], d2[5], d3[5];
    HY_LOAD(a0, d0, 0); HY_LOAD(a1, d1, 1); HY_LOAD(a2, d2, 2); HY_LOAD(a3, d3, 3);
    static_assert((SEQ / 16) % 4 == 0, "hyena k-tiles");
#pragma unroll 1
    for (int q = 0; q < SEQ / 16; q += 4) {
      HY_MMA(a0, d0); HY_LOAD(a0, d0, min(q + 4, SEQ / 16));
      HY_MMA(a1, d1); HY_LOAD(a1, d1, min(q + 5, SEQ / 16));
      HY_MMA(a2, d2); HY_LOAD(a2, d2, min(q + 6, SEQ / 16));
      HY_MMA(a3, d3); HY_LOAD(a3, d3, min(q + 7, SEQ / 16));
    }
    HY_MMA(a0, d0);
#undef HY_LOAD
#undef HY_MMA
    __syncthreads();
    {
      float* Y = (float*)(smem + SM_HR);
      float* yl = Y + bb * SEQ + 16 * (32 * (2 * w) + 4 * h) + sig;
#pragma unroll
      for (int mi = 0; mi < 2; ++mi)
#pragma unroll
        for (int k = 0; k < 16; ++k) yl[16 * (32 * mi + (k & 3) + 8 * (k >> 2))] = acc[mi][k];
    }
    __syncthreads();
    {
      const float* Y = (const float*)(smem + SM_HR);
      const float kn = p.knorm()[l * HYENA_W + ch], dsk = p.hy_d[l * HYENA_W + ch];
      static_assert(BATCH * SEQ == NT * 32, "hyena epilogue shape");
#pragma unroll 1
      for (int hh = 0; hh < 2; ++hh) {
        float4 uu[4], xx[4], yy[4];
#pragma unroll
        for (int i = 0; i < 4; ++i) {
          const int idx = 4 * (tid + NT * (4 * hh + i)); const int b = idx / SEQ, t = idx - b * SEQ;
          const long o = ((long)b * HYENA_W + ch) * SEQ + t;
          uu[i] = *(const float4*)(p.hu() + o); xx[i] = *(const float4*)(p.hx0() + o); yy[i] = *(const float4*)(Y + idx);
        }
#pragma unroll
        for (int i = 0; i < 4; ++i) {
          const int idx = 4 * (tid + NT * (4 * hh + i));
          float* dst = p.mixb() + (long)idx * MIX_W + ATTN_W + ch;
          dst[0] = (yy[i].x * kn + uu[i].x * dsk) * xx[i].x; dst[MIX_W] = (yy[i].y * kn + uu[i].y * dsk) * xx[i].y;
          dst[2 * MIX_W] = (yy[i].z * kn + uu[i].z * dsk) * xx[i].z; dst[3 * MIX_W] = (yy[i].w * kn + uu[i].w * dsk) * xx[i].w;
        }
      }
    }
  }
}
#define SM_K 256
#define SM_V (256 + 8192)
static_assert(HEAD_DIM == 64 && WINDOW == 128 && CTX_LEN == 256 && Q_GROUP == 4, "attention shape");
DEV void ph_attn_mfma(const P& p, int l, char* smem) {
  const int tid = otid(), lane = tid & 63, w = (tid >> 6) & 3, hsel = tid >> 8, h = lane >> 5, ql = lane & 31;
  char* Ks = smem + SM_K; char* Vs = smem + SM_V;
  const int n_lat = BATCH * (SEQ / 128) * N_KV_HEADS * (Q_GROUP / 2);
  const int n_ctx = (l == 0) ? BATCH * (CTX_LEN / 128) * N_KV_HEADS * (Q_GROUP / 2) : 0;
  const float QS = 0.125f * 1.4426950408889634f;
  for (int it = blockIdx.x; it < n_lat + n_ctx; it += gridDim.x) {
    const bool isctx = it >= n_lat;
    int b, qb, kvh, g;
    { int x = isctx ? it - n_lat : it; g = (x & 1) * 2 + hsel; kvh = (x >> 1) & 1; x >>= 2; if (isctx) { qb = x & 1; b = x >> 1; } else { qb = x & 63; b = x >> 6; } }
    const int hq = kvh * Q_GROUP + g;
    const int tq0 = qb * 128 + 32 * w;
    const long qrow = (isctx ? (long)NL + b * CTX_LEN : (long)b * SEQ) + tq0 + ql;
    bf16x8 qf[4];
    {
      const unsigned short* qp = p.qkvb() + qrow * HY_OFF + Q_OFF + hq * HEAD_DIM + 8 * h;
#pragma unroll
      for (int ks = 0; ks < 4; ++ks) qf[ks] = *(const bf16x8*)(qp + 16 * ks);
    }
    f32x16 o0, o1;
#pragma unroll
    for (int k = 0; k < 16; ++k) { o0[k] = 0.f; o1[k] = 0.f; }
    float m = -1e30f, lsum = 0.f;
    const int nsteps = isctx ? 4 : 10;
    u32x4 rk[1], rv[1];
    auto key_row = [&](int step, int key) -> long {
      if (step < 4) return (long)NL + b * CTX_LEN + step * 64 + key;
      const int tk = qb * 128 - 128 + (step - 4) * 64 + key;
      return (tk < 0 || tk >= SEQ) ? -1 : (long)b * SEQ + tk;
    };
    auto step_valid = [&](int step) -> bool { if (step < 4) return true; const int t0 = qb * 128 - 128 + (step - 4) * 64; return t0 >= 0 && t0 < SEQ; };
    auto load_tile = [&](int step) {
#pragma unroll
      for (int i = 0; i < 1; ++i) {
        const int key = (tid >> 3); const long kr = key_row(step, key);
        const unsigned short* kp = p.qkvb() + kr * HY_OFF + K_OFF + kvh * HEAD_DIM + (tid & 7) * 8; const unsigned short* vp = p.qkvb() + kr * HY_OFF + V_OFF + kvh * HEAD_DIM + (tid & 7) * 8;
        rk[i] = *(const u32x4*)kp; rv[i] = *(const u32x4*)vp;
      }
    };
    int step = 0;
    load_tile(0);
    while (step < nsteps) {
      __syncthreads();
#pragma unroll
      for (int i = 0; i < 1; ++i) {
        const int key = (tid >> 3), ch = tid & 7;
        *(u32x4*)(Ks + tile_off(key, ch)) = rk[i];
        *(u32x4*)(Vs + key * 128 + ((ch * 16) ^ (64 * ((key >> 1) & 1)))) = rv[i];
      }
      __syncthreads();
      const int cur = step;
      int nxt = step + 1;
      while (nxt < nsteps && !step_valid(nxt)) ++nxt;
      if (nxt < nsteps) load_tile(nxt);
      step = nxt;
#pragma unroll
      for (int sub = 0; sub < 2; ++sub) {
        const bool win = cur >= 4;
        const int ks0 = win ? qb * 128 - 128 + (cur - 4) * 64 + sub * 32 : 0;
        if (win && (ks0 > tq0 + 31 + WINDOW || ks0 + 31 < tq0 - WINDOW)) continue;
        f32x16 sacc;
#pragma unroll
        for (int k = 0; k < 16; ++k) sacc[k] = 0.f;
#pragma unroll
        for (int ks = 0; ks < 4; ++ks) {
          const bf16x8 kf = *(const bf16x8*)(Ks + tile_off(sub * 32 + ql, 2 * ks + h));
          sacc = __builtin_amdgcn_mfma_f32_32x32x16_bf16(kf, qf[ks], sacc, 0, 0, 0);
        }
        if (win && (ks0 + 31 - tq0 > WINDOW || tq0 + 31 - ks0 > WINDOW)) {
          const int tq = tq0 + ql;
#pragma unroll
          for (int k = 0; k < 16; ++k) { const int d = ks0 + (k & 3) + 8 * (k >> 2) + 4 * h - tq; if (d > WINDOW || d < -WINDOW) sacc[k] = -1e30f; }
        }
        float mx = sacc[0];
#pragma unroll
        for (int k = 1; k < 16; ++k) mx = fmaxf(mx, sacc[k]);
        mx = fmaxf(mx, __shfl_xor(mx, 32));
        const float mn = fmaxf(m, mx); const float alpha = __builtin_amdgcn_exp2f(m - mn); m = mn;
        float ps = 0.f;
#pragma unroll
        for (int k = 0; k < 16; ++k) { sacc[k] = __builtin_amdgcn_exp2f(sacc[k] - mn); ps += sacc[k]; }
        lsum = lsum * alpha + ps;
#pragma unroll
        for (int k = 0; k < 16; ++k) { o0[k] *= alpha; o1[k] *= alpha; }
        u32x2 v00, v01, v02, v03, v10, v11, v12, v13;
        {
          const int q4 = (lane & 15) >> 2, p4 = lane & 3, blk = (lane >> 4) & 1, sq = (q4 >> 1) & 1;
          const unsigned lb = (unsigned)(size_t)((__attribute__((address_space(3))) char*)Vs) + (unsigned)((sub * 32 + 4 * h + q4) * 128 + 32 * blk + 8 * p4);
          const unsigned base0 = lb + 64 * sq, base1 = lb + 64 * (1 - sq);
          asm volatile(
              "ds_read_b64_tr_b16 %0, %8\n\t"
              "ds_read_b64_tr_b16 %1, %8 offset:1024\n\t"
              "ds_read_b64_tr_b16 %2, %8 offset:2048\n\t"
              "ds_read_b64_tr_b16 %3, %8 offset:3072\n\t"
              "ds_read_b64_tr_b16 %4, %9\n\t"
              "ds_read_b64_tr_b16 %5, %9 offset:1024\n\t"
              "ds_read_b64_tr_b16 %6, %9 offset:2048\n\t"
              "ds_read_b64_tr_b16 %7, %9 offset:3072\n\t"
              "s_waitcnt lgkmcnt(0)"
              : "=&v"(v00), "=&v"(v01), "=&v"(v02), "=&v"(v03), "=&v"(v10), "=&v"(v11), "=&v"(v12), "=&v"(v13)
              : "v"(base0), "v"(base1) : "memory");
        }
#pragma unroll
        for (int ks2 = 0; ks2 < 2; ++ks2) {
          u32x4 pw;
#pragma unroll
          for (int i = 0; i < 4; ++i) pw[i] = pack2(sacc[8 * ks2 + 2 * i], sacc[8 * ks2 + 2 * i + 1]);
          const bf16x8 pf = __builtin_bit_cast(bf16x8, pw);
          u32x4 a0, a1;
          if (ks2 == 0) { a0[0] = v00[0]; a0[1] = v00[1]; a0[2] = v01[0]; a0[3] = v01[1]; a1[0] = v10[0]; a1[1] = v10[1]; a1[2] = v11[0]; a1[3] = v11[1]; }
          else          { a0[0] = v02[0]; a0[1] = v02[1]; a0[2] = v03[0]; a0[3] = v03[1]; a1[0] = v12[0]; a1[1] = v12[1]; a1[2] = v13[0]; a1[3] = v13[1]; }
          o0 = __builtin_amdgcn_mfma_f32_32x32x16_bf16(__builtin_bit_cast(bf16x8, a0), pf, o0, 0, 0, 0);
          o1 = __builtin_amdgcn_mfma_f32_32x32x16_bf16(__builtin_bit_cast(bf16x8, a1), pf, o1, 0, 0, 0);
        }
      }
    }
    lsum += __shfl_xor(lsum, 32);
    const float sk = p.sink[l * N_Q_HEADS + hq] * 1.4426950408889634f;
    const float mf = fmaxf(m, sk); const float sc = __builtin_amdgcn_exp2f(m - mf); const float inv = sc / (lsum * sc + __builtin_amdgcn_exp2f(sk - mf));
    float* op = p.mixb() + qrow * MIX_W + hq * HEAD_DIM + 4 * h;
#pragma unroll
    for (int gq = 0; gq < 4; ++gq) {
      *(float4*)(op + 8 * gq) = make_float4(o0[4 * gq] * inv, o0[4 * gq + 1] * inv, o0[4 * gq + 2] * inv, o0[4 * gq + 3] * inv);
      *(float4*)(op + 32 + 8 * gq) = make_float4(o1[4 * gq] * inv, o1[4 * gq + 1] * inv, o1[4 * gq + 2] * inv, o1[4 * gq + 3] * inv);
    }
  }
}


static_assert(S5_T == 64 && S5_STATE == 64 && S5_GROUP == 16 && S5_GROUPS == 16 && NCH == 132, "s5 mfma shape");
#define S5_COLS (BATCH * NCH)
#define S5_RT 88
DEV void ph_s5tables_gpu(const P& p, long gtid, long gsize) {
  FOR_ITEMS4(i, (long)DEPTH * 2 * S5_GROUPS * 128 * 1024) {
    const int k = (int)(i & 1023), n = (int)((i >> 10) & 127); const long ldg = i >> 17;
    const int ri = n >> 6, pp = n & 63, sidx = k >> 4, j = k & 15;
    const float2 lp = p.lampow()[(ldg * (S5_T + 1) + (S5_T - 1 - sidx)) * S5_STATE + pp]; const float2 bb = p.bbar()[(ldg * S5_STATE + pp) * S5_GROUP + j];
    p.bmtb()[i] = (unsigned short)f2bf(ri ? lp.x * bb.y + lp.y * bb.x : lp.x * bb.x - lp.y * bb.y);
  }
  FOR_ITEMS4(i, (long)DEPTH * 2 * S5_GROUPS * 128 * 1024) {
    const int k = (int)(i & 127), n = (int)((i >> 7) & 1023); const long ldg = i >> 17; const int dir = (int)((ldg >> 4) & 1);
    const int ri = k >> 6, pp = k & 63, tl = n >> 4, ii = n & 15; const int tau = dir ? 63 - tl : tl;
    const float cr = p.s5_c_re[(ldg * S5_GROUP + ii) * S5_STATE + pp], ci = p.s5_c_im[(ldg * S5_GROUP + ii) * S5_STATE + pp];
    const float2 lp = p.lampow()[(ldg * (S5_T + 1) + tau + 1) * S5_STATE + pp];
    p.cmtb()[i] = (unsigned short)f2bf(ri ? -(cr * lp.y + ci * lp.x) : cr * lp.x - ci * lp.y);
  }
}
DEV void ph_kcb_gpu(const P& p, long gtid, long gsize) {
  FOR_ITEMS4(i, (long)DEPTH * 2 * S5_GROUPS * S5_T * 256) p.kcb()[i] = (unsigned short)f2bf(p.kc()[i]);
}
struct ALS5U { const char* base; unsigned off0[2]; int stepb; const char* hbase; unsigned hoff[2]; int nki;
  DEVM void set(int i, int b, int dir, int chunk, int sl, unsigned joff) { off0[i] = (unsigned)s5_row(b, dir, chunk * S5_T + sl) * (unsigned)(S5_W * 2) + joff; }
  DEVM const unsigned short* a(int i, int kt) const {
    if (kt >= nki) return (const unsigned short*)(hbase + (hoff[i] + (unsigned)(kt - nki) * 128u));
    return (const unsigned short*)(base + (off0[i] + (unsigned)(kt * stepb))); } };
struct BLKc { const char* kc; const char* cm; int tl, i0, sj, ss, dir, nki; unsigned cmoff;
  DEVM void load(u32x4 (&rb)[4], int kt) const {
    if (kt >= nki) {
#pragma unroll
      for (int c = 0; c < 4; ++c) rb[c] = *(const u32x4*)(cm + (cmoff + (unsigned)(c * 128 + (kt - nki) * 64) * 2u));
      return;
    }
    const int d = (dir ? 63 - tl : tl) - (4 * kt + ss);
    if (d < 0) {
#pragma unroll
      for (int c = 0; c < 4; ++c) rb[c] = (u32x4){0u, 0u, 0u, 0u};
    } else {
#pragma unroll
      for (int c = 0; c < 4; ++c) rb[c] = *(const u32x4*)(kc + (unsigned)(((d * 16 + i0 + c) * 16 + sj) * 2));
    }
  } };
DEV void ph_s5_sgemm(const P& p, int l, char* smem) {
  const int tid = otid();
  const int nitems = 2 * S5_GROUPS * 3;
  for (int it = blockIdx.x; it < nitems; it += gridDim.x) {
    const int rt = it % 3, g = (it / 3) % S5_GROUPS, dir = it / (3 * S5_GROUPS);
    ALS5U al; al.base = (const char*)(p.s5u() + g * S5_GROUP); al.stepb = (dir ? -4 : 4) * S5_W * 2; al.nki = 1 << 20; al.hbase = al.base; al.hoff[0] = al.hoff[1] = 0;
#pragma unroll
    for (int i = 0; i < 2; ++i) { const int col = rt * S5_RT + min((tid >> 3) + 64 * i, S5_RT - 1); al.set(i, col / NCH, dir, col % NCH, (tid & 7) >> 1, (tid & 1) * 16); }
    BLT bl; bl.base = (const char*)(p.bmtb() + (((long)l * 2 + dir) * S5_GROUPS + g) * 128 * 1024); bl.rowb = 1024 * 2;
    bl.voff = (unsigned)((((tid >> 3) & 31) * 4)) * bl.rowb + (unsigned)((tid & 7) * 16);
    f32x4 acc[4][4]; acc_zero(acc);
    gemm_tb(al, bl, 16, acc, smem);
    EPI_BEGIN
    if (((etid >> 6) & 3) < 2) {
#pragma unroll
      for (int m = 0; m < 4; ++m)
#pragma unroll
        for (int j = 0; j < 4; ++j) {
          const int rl = EPI_ROW(m, j);
          if (rl < S5_RT) {
            const int col = rt * S5_RT + rl; const int b = col / NCH, c = col % NCH;
            float* dst = (float*)(p.sc() + ((((long)b * 2 + dir) * S5_GROUPS + g) * NCH + c) * S5_STATE);
#pragma unroll
            for (int n = 0; n < 4; ++n) { const int nn = EPI_COL(n); dst[(nn & 63) * 2 + (nn >> 6)] = acc[m][n][j]; }
          }
        }
    }
  }
}

static_assert(NCH == 132, "carry scan grouping");
DEV void ph_s5_carry_gpu(const P& p, int l, char* smem) {
  const int tid = otid();
  float2* E = (float2*)(smem + SM_MISC);
  const int nchains = BATCH * 2 * S5_GROUPS * S5_STATE;
  for (int cb = blockIdx.x * 16; cb < nchains; cb += gridDim.x * 16) {
    const int cl = tid & 15, grp = tid >> 4; const bool act = tid < 176;
    const int chain = cb + cl;
    const int pp = chain % S5_STATE, g = (chain / S5_STATE) % S5_GROUPS, dir = (chain / (S5_STATE * S5_GROUPS)) % 2, b = chain / (S5_STATE * S5_GROUPS * 2);
    const long ldg = ((long)l * 2 + dir) * S5_GROUPS + g;
    const long base = (((long)b * 2 + dir) * S5_GROUPS + g) * NCH + grp * 12;
    float2 lt = make_float2(0.f, 0.f); float2 L[12]; float hr = 0.f, hi = 0.f;
    __syncthreads();
    if (act) {
      lt = p.lampow()[(ldg * (S5_T + 1) + S5_T) * S5_STATE + pp];
      float2 sv[12];
#pragma unroll
      for (int k = 0; k < 12; ++k) sv[k] = p.sc()[(base + k) * S5_STATE + pp];
#pragma unroll
      for (int k = 0; k < 12; ++k) { L[k] = make_float2(hr, hi); const float nr = lt.x * hr - lt.y * hi + sv[k].x, ni = lt.x * hi + lt.y * hr + sv[k].y; hr = nr; hi = ni; }
      E[grp * 16 + cl] = make_float2(hr, hi);
    }
    __syncthreads();
    if (act) {
      float pr = lt.x, pi = lt.y;
#pragma unroll
      for (int k = 1; k < 12; ++k) { const float nr = pr * lt.x - pi * lt.y, ni = pr * lt.y + pi * lt.x; pr = nr; pi = ni; }
      float gr = 0.f, gi = 0.f;
      for (int gp = 0; gp < grp; ++gp) { const float2 e = E[gp * 16 + cl]; const float nr = pr * gr - pi * gi + e.x, ni = pr * gi + pi * gr + e.y; gr = nr; gi = ni; }
#pragma unroll
      for (int k = 0; k < 12; ++k) {
        const float vr = L[k].x + gr, vi = L[k].y + gi;
        p.hcbf()[(base + k) * 2 * S5_STATE + pp] = f2bf16(vr); p.hcbf()[(base + k) * 2 * S5_STATE + S5_STATE + pp] = f2bf16(vi);
        const float nr = lt.x * gr - lt.y * gi, ni = lt.x * gi + lt.y * gr; gr = nr; gi = ni;
      }
    }
  }
}
DEV void ph_s5_ygemm(const P& p, int l, char* smem) {
  const int tid = otid();
  const int nitems = S5_GROUPS * 3 * 4;
  for (int it = blockIdx.x; it < nitems; it += gridDim.x) {
    const int nt = it & 3, rt = (it >> 2) % 3, g = it / 12;
    f32x4 acc[4][4]; acc_zero(acc);
#pragma unroll 1
    for (int dir = 0; dir < 2; ++dir) {
      const long ldg = ((long)l * 2 + dir) * S5_GROUPS + g;
      const int nki = dir ? 16 - 4 * nt : 4 * nt + 4;
      ALS5U al; al.base = (const char*)(p.s5u() + g * S5_GROUP); al.stepb = (dir ? -4 : 4) * S5_W * 2; al.nki = nki; al.hbase = (const char*)p.hcbf();
#pragma unroll
      for (int i = 0; i < 2; ++i) {
        const int col = rt * S5_RT + min((tid >> 3) + 64 * i, S5_RT - 1); const int b = col / NCH, blk = col % NCH;
        const int ch = dir ? (blk < 4 ? 3 - blk : 135 - blk) : blk;
        al.set(i, b, dir, ch, (tid & 7) >> 1, (tid & 1) * 16);
        al.hoff[i] = (unsigned)((((b * 2 + dir) * S5_GROUPS + g) * NCH + ch) * 128 + (tid & 7) * 8) * 2u;
      }
      BLKc bk; bk.kc = (const char*)(p.kcb() + ldg * S5_T * 256); bk.tl = 16 * nt + (tid >> 5); bk.i0 = ((tid >> 3) & 3) * 4; bk.sj = (tid & 1) * 8; bk.ss = (tid & 7) >> 1; bk.dir = dir; bk.nki = nki;
      bk.cm = (const char*)(p.cmtb() + ldg * 1024 * 128); bk.cmoff = (unsigned)(((16 * nt + (tid >> 5)) * 16 + ((tid >> 3) & 3) * 4) * 128 + (tid & 7) * 8) * 2u;
      gemm_tb(al, bk, nki + 2, acc, smem);
    }
    EPI_BEGIN
#pragma unroll
    for (int m = 0; m < 4; ++m)
#pragma unroll
      for (int j = 0; j < 4; ++j) {
        const int rl = EPI_ROW(m, j);
        if (rl < S5_RT) {
          const int col = rt * S5_RT + rl; const int b = col / NCH, blk = col % NCH;
#pragma unroll
          for (int n = 0; n < 4; ++n) {
            const int nn = nt * 256 + EPI_COL(n); const int tl = nn >> 4, chn = g * S5_GROUP + (nn & 15);
            const long row = blk < 4 ? (long)NL + b * CTX_LEN + blk * 64 + tl : (long)b * SEQ + (blk - 4) * 64 + tl;
            const float y = acc[m][n][j] + p.s5_d[l * S5_W + chn] * __uint_as_float((unsigned)p.s5u()[row * S5_W + chn] << 16);
            const float gy = gelu_tanhf(y);
            p.ybuf()[row * S5_W + chn] = gy; p.ybf()[row * S5_W + chn] = (unsigned short)f2bf(gy);
          }
        }
      }
  }
}

DEV float wave_sum(float v) {
#pragma unroll
  for (int o = 32; o > 0; o >>= 1) v += __shfl_xor(v, o);
  return v;
}
DEV void st_bf4(unsigned short* dst, float a, float b, float c, float d) { u32x2 v; v[0] = pack2(a, b); v[1] = pack2(c, d); *(u32x2*)dst = v; }
static_assert(BATCH == 2, "mod partial layout");
DEV void ph_modsum_gpu(const P& p, long gtid, long gsize) {
  FOR_ITEMS(i, (long)DEPTH * (BATCH + 1) * 6 * D_MODEL) {
    const int n = (int)(i % (6 * D_MODEL)); const int j = (int)((i / (6 * D_MODEL)) % (BATCH + 1)); const int l = (int)(i / (6 * D_MODEL * (BATCH + 1)));
    float acc = p.b_ada[l * 6 * D_MODEL + n];
#pragma unroll
    for (int sl = 0; sl < 16; ++sl) acc += p.modp()[((long)(l * 16 + sl) * (BATCH + 1) + j) * 6 * D_MODEL + n];
    p.mod()[i] = acc;
  }
}
DEV void ph_modu0_gpu(const P& p, long gtid, long gsize) {
  FOR_ITEMS4(i4, (long)NR * D_MODEL / 4) {
    const long i = i4 * 4; const int k = (int)(i % D_MODEL); const long r = i / D_MODEL;
    const float* m = p.mod() + (long)modrow(r) * 6 * D_MODEL;
    const float4 x = *(const float4*)(p.xcur() + i); const float4 sh = *(const float4*)(m + k); const float4 sc = *(const float4*)(m + D_MODEL + k);
    st_bf4(p.ubf() + i, x.x * (1.f + sc.x) + sh.x, x.y * (1.f + sc.y) + sh.y, x.z * (1.f + sc.z) + sh.z, x.w * (1.f + sc.w) + sh.w);
  }
}
DEV void rms_rows(const P& p, int l, long r0, long r1, int w0, int nw) {
  const int lane = otid() & 63;
  for (long r = r0 + w0; r < r1; r += nw) {
    const float* v = p.mixb() + r * MIX_W; float4 a[4]; float ss[4];
#pragma unroll
    for (int i = 0; i < 4; ++i) { a[i] = *(const float4*)(v + (i * 64 + lane) * 4); ss[i] = a[i].x * a[i].x + a[i].y * a[i].y + a[i].z * a[i].z + a[i].w * a[i].w; }
    const float s_att = wave_sum(ss[0] + ss[1]), s_hy = wave_sum(ss[2]), s_s5 = wave_sum(ss[3]);
    float rs[4]; rs[0] = rs[1] = 1.0f / sqrtf(s_att / (float)ATTN_W + LN_EPS); rs[2] = 1.0f / sqrtf(s_hy / (float)HYENA_W + LN_EPS); rs[3] = 1.0f / sqrtf(s_s5 / (float)S5_W + LN_EPS);
#pragma unroll
    for (int i = 0; i < 4; ++i) {
      const int k = (i * 64 + lane) * 4; const float4 g = *(const float4*)(p.mix_g + l * MIX_W + k);
      st_bf4(p.mixbf() + r * MIX_W + k, a[i].x * rs[i] * g.x, a[i].y * rs[i] * g.y, a[i].z * rs[i] * g.z, a[i].w * rs[i] * g.w);
    }
  }
}
DEV void ln_rows(float4 (&a)[4], const float* gw, const float* bw, int lane) {
  float s = 0.f;
#pragma unroll
  for (int i = 0; i < 4; ++i) s += a[i].x + a[i].y + a[i].z + a[i].w;
  const float mu = wave_sum(s) / (float)D_MODEL; float q = 0.f;
#pragma unroll
  for (int i = 0; i < 4; ++i) { a[i].x -= mu; a[i].y -= mu; a[i].z -= mu; a[i].w -= mu; q += a[i].x * a[i].x + a[i].y * a[i].y + a[i].z * a[i].z + a[i].w * a[i].w; }
  const float rs = 1.0f / sqrtf(wave_sum(q) / (float)D_MODEL + LN_EPS);
#pragma unroll
  for (int i = 0; i < 4; ++i) {
    const int k = (i * 64 + lane) * 4; const float4 g = *(const float4*)(gw + k), b = *(const float4*)(bw + k);
    a[i].x = a[i].x * rs * g.x + b.x; a[i].y = a[i].y * rs * g.y + b.y; a[i].z = a[i].z * rs * g.z + b.z; a[i].w = a[i].w * rs * g.w + b.w;
  }
}
DEV void ph_ln1_gpu(const P& p, int l) {
  const int tid_ = otid(); const int lane = tid_ & 63; const int gw = blockIdx.x * (NT / 64) + (tid_ >> 6), nw = gridDim.x * (NT / 64);
  for (long r = gw; r < NR; r += nw) {
    float4 a[4];
#pragma unroll
    for (int i = 0; i < 4; ++i) a[i] = *(const float4*)(p.tmp() + r * D_MODEL + (i * 64 + lane) * 4);
    ln_rows(a, p.ln1_g + l * D_MODEL, p.ln1_b + l * D_MODEL, lane);
    const float* m = p.mod() + ((long)l * (BATCH + 1) + modrow(r)) * 6 * D_MODEL + 3 * D_MODEL;
#pragma unroll
    for (int i = 0; i < 4; ++i) {
      const int k = (i * 64 + lane) * 4;
      *(float4*)(p.xcur() + r * D_MODEL + k) = a[i];
      const float4 sh = *(const float4*)(m + k), sc = *(const float4*)(m + D_MODEL + k);
      const float u0 = a[i].x * (1.f + sc.x) + sh.x, u1 = a[i].y * (1.f + sc.y) + sh.y, u2 = a[i].z * (1.f + sc.z) + sh.z, u3 = a[i].w * (1.f + sc.w) + sh.w;
      st_bf4(p.ubf() + r * D_MODEL + k, u0, u1, u2, u3);
      st_bf4(p.ubl() + r * D_MODEL + k, bflo(u0), bflo(u1), bflo(u2), bflo(u3));
    }
  }
}
DEV void exp_prefix(const P& p, int l, int* toff, int* roff, int* rowo);
DEV void ph_ln2_gpu(const P& p, int l, char* smem) {
  const int tid_ = otid(); const int lane = tid_ & 63; const int gw = blockIdx.x * (NT / 64) + (tid_ >> 6), nw = gridDim.x * (NT / 64);
  int* toff = (int*)(smem + SM_MISC); int* roff = toff + N_EXPERTS + 1; int* rowo = roff + N_EXPERTS + 16;
  exp_prefix(p, l, toff, roff, rowo);
  int e_n = 0, s_n = 0;
  if (gw < NR && lane < TOP_K) { e_n = p.top_e()[(long)gw * TOP_K + lane]; s_n = p.posb()[(long)gw * TOP_K + lane]; }
  for (long r = gw; r < NR; r += nw) {
    const int myrow = rowo[e_n] + s_n;
    if (r + nw < NR && lane < TOP_K) { e_n = p.top_e()[(r + nw) * TOP_K + lane]; s_n = p.posb()[(r + nw) * TOP_K + lane]; }
    float4 a[4];
    const float* m = p.mod() + ((long)l * (BATCH + 1) + modrow(r)) * 6 * D_MODEL + 5 * D_MODEL;
#pragma unroll
    for (int i = 0; i < 4; ++i) {
      const int k = (i * 64 + lane) * 4;
      float4 f = *(const float4*)(p.ysh() + r * D_MODEL + k);
#pragma unroll
      for (int kk = 0; kk < TOP_K; ++kk) { const u32x2 y = *(const u32x2*)(p.ykb() + (long)__builtin_amdgcn_readlane(myrow, kk) * D_MODEL + k); f.x += __uint_as_float(y[0] << 16); f.y += __uint_as_float(y[0] & 0xffff0000u); f.z += __uint_as_float(y[1] << 16); f.w += __uint_as_float(y[1] & 0xffff0000u); }
      const float4 x = *(const float4*)(p.xcur() + r * D_MODEL + k), g2 = *(const float4*)(m + k);
      a[i].x = DN_ALPHA * x.x + g2.x * f.x; a[i].y = DN_ALPHA * x.y + g2.y * f.y; a[i].z = DN_ALPHA * x.z + g2.z * f.z; a[i].w = DN_ALPHA * x.w + g2.w * f.w;
    }
    ln_rows(a, p.ln2_g + l * D_MODEL, p.ln2_b + l * D_MODEL, lane);
    const float* mn = p.mod() + ((long)(l + 1) * (BATCH + 1) + modrow(r)) * 6 * D_MODEL;
#pragma unroll
    for (int i = 0; i < 4; ++i) {
      const int k = (i * 64 + lane) * 4;
      *(float4*)(p.xcur() + r * D_MODEL + k) = a[i];
      if (l + 1 < DEPTH) {
        const float4 sh = *(const float4*)(mn + k), sc = *(const float4*)(mn + D_MODEL + k);
        st_bf4(p.ubf() + r * D_MODEL + k, a[i].x * (1.f + sc.x) + sh.x, a[i].y * (1.f + sc.y) + sh.y, a[i].z * (1.f + sc.z) + sh.z, a[i].w * (1.f + sc.w) + sh.w);
      } else if (r < NL) *(float4*)(p.out + r * D_MODEL + k) = a[i];
    }
  }
}
struct ALRouter { const char* hi; const char* lo_; unsigned off[2];
  DEVM const unsigned short* a(int i, int kt) const { return (const unsigned short*)((kt >= 32 ? lo_ : hi) + (off[i] + (unsigned)(kt & 15) * 128u)); } };
struct BLRouter { const char* base; const char* lob; unsigned voff; unsigned rowb;
  DEVM void load(u32x4 (&rb)[4], int kt) const {
    const char* bb = (kt >> 4) == 1 ? lob : base;
#pragma unroll
    for (int c = 0; c < 4; ++c) rb[c] = *(const u32x4*)(bb + (voff + (unsigned)c * rowb + (unsigned)(kt & 15) * 128u)); } };
DEV void ph_router_mfma(const P& p, int l, char* smem) {
  const int tid = otid();
  const int n_router = (NR >> 7), n_sh = (NR >> 7) * 2;
  const int nrb = (int)gridDim.x >= 64 ? (int)((gridDim.x * 3) / 5) : 0;
  const bool is_router = nrb == 0 ? false : (int)blockIdx.x < nrb;
  for (int pass = 0; pass < 2; ++pass) {
    const bool do_router = nrb == 0 ? pass == 0 : is_router;
    if (nrb != 0 && pass == 1) break;
    const int first = nrb == 0 ? (int)blockIdx.x : (do_router ? (int)blockIdx.x : (int)blockIdx.x - nrb);
    const int stride = nrb == 0 ? (int)gridDim.x : (do_router ? nrb : (int)gridDim.x - nrb);
    const int nit = do_router ? n_router : n_sh;
    for (int it = first; it < nit; it += stride) {
      const int rt = do_router ? it : (it >> 1), cq = do_router ? 0 : (it & 1);
      ALRouter ar; ar.hi = (const char*)(p.ubf() + (long)rt * 128 * D_MODEL); ar.lo_ = (const char*)(p.ubl() + (long)rt * 128 * D_MODEL);
#pragma unroll
      for (int i = 0; i < 2; ++i) ar.off[i] = (unsigned)(((tid >> 3) + 64 * i) * D_MODEL + (tid & 7) * 8) * 2u;
      BLRouter br; int nk;
      if (do_router) {
        br.base = (const char*)(p.wt_rh() + (long)l * N_EXPERTS * D_MODEL); br.lob = (const char*)(p.wt_rl() + (long)l * N_EXPERTS * D_MODEL); br.rowb = D_MODEL * 2;
        br.voff = (unsigned)((tid >> 3) * 4) * br.rowb + (unsigned)((tid & 7) * 16); nk = 3 * (D_MODEL >> 6);
      } else {
        const int nq = tid >> 3; const int wsel = __builtin_amdgcn_readfirstlane(tid >> 6) & 1;
        const unsigned short* wsrc = (wsel ? p.wt_shu() : p.wt_shg()) + (long)l * SHARED_FF * D_MODEL;
        br.base = (const char*)wsrc; br.lob = br.base; br.rowb = D_MODEL * 2;
        br.voff = (unsigned)(cq * 128 + (nq >> 4) * 32 + (nq & 7) * 4) * br.rowb + (unsigned)((tid & 7) * 16); nk = D_MODEL >> 6;
      }
      f32x4 acc[4][4]; acc_zero(acc);
      gemm_tb(ar, br, nk, acc, smem);
      EPI_BEGIN
      if (do_router) {
#pragma unroll
        for (int m = 0; m < 4; ++m)
#pragma unroll
          for (int n = 0; n < 4; ++n)
#pragma unroll
            for (int j = 0; j < 4; ++j) p.rl()[((long)rt * 128 + EPI_ROW(m, j)) * N_EXPERTS + EPI_COL(n)] = acc[m][n][j];
      } else {
        const int elane = etid & 63, ewc = (etid >> 6) & 3;
#pragma unroll
        for (int m = 0; m < 4; ++m)
#pragma unroll
          for (int j = 0; j < 4; ++j)
          { unsigned short* dst = p.hsbf() + ((long)rt * 128 + EPI_ROW(m, j)) * SHARED_FF + cq * 128 + ewc * 32 + (elane & 15);
            dst[0] = (unsigned short)f2bf(siluq(acc[m][0][j]) * acc[m][2][j]); dst[16] = (unsigned short)f2bf(siluq(acc[m][1][j]) * acc[m][3][j]); }
      }
    }
  }
}
static_assert(EPG == 32 && TOP_K == 8 && N_EXPERT_GROUPS == 8 && TOPK_GROUPS == 4, "select shape");
DEV void ph_select_gpu(const P& p, int l) {
  const int tid_ = otid(); const int lane = tid_ & 63; const int gw = blockIdx.x * (NT / 64) + (tid_ >> 6), nw = gridDim.x * (NT / 64);
  const float4 rb = *(const float4*)(p.router_bias + l * N_EXPERTS + 4 * lane);
  for (long r = gw; r < NR; r += nw) {
    const float4 lg = *(const float4*)(p.rl() + r * N_EXPERTS + 4 * lane);
    float sc[4] = {sigmoidf_(lg.x), sigmoidf_(lg.y), sigmoidf_(lg.z), sigmoidf_(lg.w)};
    float bz[4] = {sc[0] + rb.x, sc[1] + rb.y, sc[2] + rb.z, sc[3] + rb.w};
    float m1 = fmaxf(bz[0], bz[1]), m2 = fminf(bz[0], bz[1]);
#pragma unroll
    for (int c = 2; c < 4; ++c) { const float v = bz[c]; m2 = fmaxf(m2, fminf(m1, v)); m1 = fmaxf(m1, v); }
#pragma unroll
    for (int o = 1; o < 8; o <<= 1) { const float b1 = __shfl_xor(m1, o), b2 = __shfl_xor(m2, o); m2 = fmaxf(fminf(m1, b1), fmaxf(m2, b2)); m1 = fmaxf(m1, b1); }
    const float gs = m1 + m2; const int mg = lane >> 3; int rank = 0;
#pragma unroll
    for (int j = 0; j < 8; ++j) { const float gj = __shfl(gs, j * 8); rank += (gj > gs || (gj == gs && j < mg)) ? 1 : 0; }
    if (rank >= TOPK_GROUPS) { bz[0] = bz[1] = bz[2] = bz[3] = -1e30f; }
    int sel_e[TOP_K]; float sel_s[TOP_K]; float gsum = 0.f;
#pragma unroll
    for (int it = 0; it < TOP_K; ++it) {
      float bv = bz[0]; int bc = 0;
#pragma unroll
      for (int c = 1; c < 4; ++c) if (bz[c] > bv) { bv = bz[c]; bc = c; }
      int bi = 4 * lane + bc; float bs = sc[bc];
      const int myi = bi;
#pragma unroll
      for (int o = 1; o < 64; o <<= 1) {
        const float ov = __shfl_xor(bv, o); const int oi = __shfl_xor(bi, o); const float os = __shfl_xor(bs, o);
        if (ov > bv || (ov == bv && oi < bi)) { bv = ov; bi = oi; bs = os; }
      }
      sel_e[it] = bi; sel_s[it] = bs; gsum += bs;
      if (bi == myi) {
#pragma unroll
        for (int c = 0; c < 4; ++c) if (c == bc) bz[c] = -1e30f;
      }
    }
    const float inv = ROUTED_SCALE / gsum;
    int me = sel_e[0]; float ms = sel_s[0];
#pragma unroll
    for (int it = 1; it < TOP_K; ++it) if (lane == it) { me = sel_e[it]; ms = sel_s[it]; }
    if (lane < TOP_K) {
      const long a = r * TOP_K + lane;
      p.top_e()[a] = me; p.gate()[a] = ms * inv;
      const int pos = atomicAdd(&p.cnt()[l * N_EXPERTS + me], 1);
      p.elist()[(long)me * NR + pos] = (int)a; p.egate()[(long)me * NR + pos] = ms * inv; p.posb()[a] = pos;
    }
  }
}
#endif

#ifndef CPU_TEST
#define XB_TMO      128
#define XB_XCNT(j)  (256  + 64 * (j))
#define XB_XSUB(j)  (1280 + 64 * (j))
#define XB_XGEN(j)  (2304 + 64 * (j))
#define XB_TOP      3328
#define XB_TOPGEN   3392
#define XCD_BAR_WORDS 3456
#define XB_SPIN_CAP (1u << 18)
#define LAS __attribute__((address_space(3)))
__device__ __forceinline__ unsigned xb_ld(unsigned* p)              { return __hip_atomic_load(p, __ATOMIC_RELAXED, __HIP_MEMORY_SCOPE_AGENT); }
__device__ __forceinline__ unsigned xb_add(unsigned* p, unsigned v) { return __hip_atomic_fetch_add(p, v, __ATOMIC_RELAXED, __HIP_MEMORY_SCOPE_AGENT); }
__device__ __forceinline__ unsigned xb_xcc_id() { return (unsigned)__builtin_amdgcn_s_getreg((3 << 11) | 20) & 0xFu; }
#define XB_SPIN(cond, bar) do { unsigned _sp = 0; while (cond) { __builtin_amdgcn_s_sleep(1); \
    if ((++_sp & 255u) == 0u) { if (xb_ld(&(bar)[XB_TMO])) break; if (_sp > XB_SPIN_CAP) { atomicAdd(&(bar)[XB_TMO], 1u); break; } } } } while (0)
struct XcdBarrier { unsigned* bar; unsigned x; volatile LAS unsigned* st; };
__device__ __forceinline__ XcdBarrier xcd_barrier_post(unsigned* bar, volatile LAS unsigned* st) {
    XcdBarrier b; b.bar = bar; b.x = xb_xcc_id(); b.st = st;
    if (threadIdx.x == 0) (void)xb_add(&bar[XB_XCNT(b.x)], 1u);
    return b;
}
__device__ __forceinline__ void xcd_barrier_complete(unsigned* bar, unsigned x, unsigned& nloc, unsigned& nx) {
    const unsigned G = gridDim.x * gridDim.y * gridDim.z;
    unsigned sum, cnt, mine, sp = 0u;
    for (;;) {
        sum = 0u; cnt = 0u; mine = 0u;
#pragma unroll
        for (unsigned j = 0; j < 16; ++j) { const unsigned c = xb_ld(&bar[XB_XCNT(j)]); sum += c; cnt += (c > 0u) ? 1u : 0u; mine = (j == x) ? c : mine; }
        if (sum == G) break;
        __builtin_amdgcn_s_sleep(1);
        if ((++sp & 255u) == 0u) { if (xb_ld(&bar[XB_TMO])) break; if (sp > XB_SPIN_CAP) { atomicAdd(&bar[XB_TMO], 1u); break; } }
    }
    nloc = mine > 0u ? mine : 1u; nx = cnt > 0u ? cnt : 1u;
}
__device__ __forceinline__ void xcd_barrier(const XcdBarrier& b) {
    asm volatile("s_waitcnt vmcnt(0)" ::: "memory");
    __syncthreads();
    if (threadIdx.x == 0) {
        unsigned* bar = b.bar;
        unsigned bx = b.x; asm volatile("" : "+s"(bx));
        __builtin_amdgcn_s_waitcnt(0);
        unsigned nloc = b.st[0], nx = b.st[1];
        if (nloc == 0u) { xcd_barrier_complete(bar, bx, nloc, nx); b.st[0] = nloc; b.st[1] = nx; }
        const unsigned old = xb_add(&bar[XB_XSUB(bx)], 1u);
        const unsigned gen = old / nloc;
        if (old + 1u == (gen + 1u) * nloc) {
            __builtin_amdgcn_fence(__ATOMIC_RELEASE, "agent");
            asm volatile("s_waitcnt vmcnt(0)" ::: "memory");
            const unsigned og = xb_add(&bar[XB_TOP], 1u);
            const unsigned tg = og / nx;
            if (og + 1u == (tg + 1u) * nx) xb_add(&bar[XB_TOPGEN], 1u);
            else XB_SPIN(xb_ld(&bar[XB_TOPGEN]) == tg, bar);
            __builtin_amdgcn_fence(__ATOMIC_ACQUIRE, "agent");
            xb_add(&bar[XB_XGEN(bx)], 1u);
            asm volatile("s_waitcnt vmcnt(0)" ::: "memory");
        } else {
            XB_SPIN(xb_ld(&bar[XB_XGEN(bx)]) == gen, bar);
            __builtin_amdgcn_fence(__ATOMIC_ACQUIRE, "agent");
            asm volatile("s_waitcnt vmcnt(0)" ::: "memory");
        }
    }
    __syncthreads();
}
#define GRID_SYNC() xcd_barrier(xb)
#else
#define GRID_SYNC() do {} while (0)
#endif

#ifndef CPU_TEST
#define GPUSEL(a, b) a
#else
#define GPUSEL(a, b) b
#endif
#ifndef CPU_TEST
#define OPAQUE_S(v) asm volatile("" : "+s"(v))
#define OPAQUE_V(v) asm volatile("" : "+v"(v))
#else
#define OPAQUE_S(v) do {} while (0)
#define OPAQUE_V(v) do {} while (0)
#endif
#ifndef PROBE_MASK
#define PROBE_MASK 0
#endif
#define LPHASE(stmt) do { int l = lo; OPAQUE_S(l); if (SINGLE && ((PROBE_MASK >> (ph - NG - lo * NLP)) & 1)) { long gtid = gtid0; OPAQUE_V(gtid); stmt; GRID_SYNC(); } PHASE(stmt); } while (0)
#define PHASE(stmt) do { if (SINGLE || ph == only) { long gtid = gtid0; OPAQUE_V(gtid); stmt; } if (SINGLE) { GRID_SYNC(); } ++ph; } while (0)
#ifndef CPU_TEST
template <bool SINGLE> __device__ __forceinline__ void run_seq(const P& p, long gtid0, long gsize, int only, const XcdBarrier& xb, char* smem)
#else
template <bool SINGLE> static int run_seq(const P& p, long gtid0, long gsize, int only)
#endif
{
  int ph = 0;
  PHASE(ph_g0(p, gtid, gsize));
  PHASE(ph_g1(p, gtid, gsize));
  PHASE(ph_g2(p, gtid, gsize));
  PHASE(ph_g3(p, gtid, gsize));
  PHASE(ph_g4(p, gtid, gsize));
#pragma unroll 1
  for (int lo = 0; lo < DEPTH; ++lo) {
    LPHASE(ph_modu(p, l, 0, gtid, gsize));
    LPHASE(GPUSEL(ph_proj_mfma(p, l, smem), ph_proj(p, l, gtid, gsize)));
    LPHASE(ph_post_proj(p, l, gtid, gsize));
    LPHASE(ph_mix(p, l, gtid, gsize); GPUSEL((ph_attn_mfma(p, l, smem), ph_hyena_mfma(p, l, smem)), (void)0));
    LPHASE(ph_s5out(p, l, gtid, gsize));
    LPHASE(GPUSEL(ph_glu_mfma(p, l, smem), ph_glu(p, l, gtid, gsize)));
    LPHASE(ph_rms(p, l, gtid, gsize));
    LPHASE(GPUSEL(ph_outproj_mfma(p, l, smem), ph_outproj(p, l, gtid, gsize)));
    LPHASE(ph_ln(p, l, 0, gtid, gsize));
    LPHASE(ph_router(p, l, gtid, gsize));
    LPHASE(ph_select(p, l, gtid, gsize));
    LPHASE(ph_sortrows(p, l, gtid, gsize));
    LPHASE(GPUSEL(ph_expert_up_mfma(p, l, smem), ph_expert_up(p, l, gtid, gsize)));
    LPHASE(GPUSEL(ph_expert_down_mfma(p, l, smem), ph_expert_down(p, l, gtid, gsize)));
    LPHASE(ph_combine(p, l, gtid, gsize));
    LPHASE(ph_ln(p, l, 1, gtid, gsize));
  }
#ifdef CPU_TEST
  return ph;
#endif
}


#ifndef CPU_TEST
#define NG_GPU 4
#define NLP_GPU 12
#ifndef PROBE_MASK_G
#define PROBE_MASK_G 0
#endif
#define GPHASE(stmt) do { if (SINGLE || ph == only) { long gtid = (long)blockIdx.x * NT + otid(); long gsize = gsize0; asm volatile("" : "+s"(gsize)); stmt; } if (SINGLE) { GRID_SYNC(); } ++ph; } while (0)
#define GLPHASE(stmt) do { int l = lo; OPAQUE_S(l); if (SINGLE && ((PROBE_MASK_G >> (ph - NG_GPU - lo * NLP_GPU)) & 1)) { long gtid = (long)blockIdx.x * NT + otid(); stmt; GRID_SYNC(); } GPHASE(stmt); } while (0)
template <bool SINGLE> __device__ __forceinline__ void run_seq_gpu(const P& p, long gtid0, long gsize0, int only, const XcdBarrier& xb, char* smem) {
  int ph = 0;
  const long gsize = gsize0;
#ifdef PROBE_INIT
  if (SINGLE) { long gtid = (long)blockIdx.x * NT + otid(); ph_g0(p, gtid, gsize); GRID_SYNC(); ph_g1(p, gtid, gsize); ph_modsum_gpu(p, gtid, gsize); ph_s5tables_gpu(p, gtid, gsize); GRID_SYNC(); ph_g2(p, gtid, gsize); ph_modu0_gpu(p, gtid, gsize); GRID_SYNC(); ph_g3(p, gtid, gsize); GRID_SYNC(); ph_g4(p, gtid, gsize); GRID_SYNC(); }
#endif
  GPHASE(ph_g0(p, gtid, gsize); s5_lampow_gpu(p, gtid, gsize); rope_table_gpu(p, gtid, gsize));
  GPHASE(ph_g1(p, gtid, gsize); ph_modsum_gpu(p, gtid, gsize); ph_s5tables_gpu(p, gtid, gsize); wt_convert_all(p, gtid, gsize));
  GPHASE(ph_g2(p, gtid, gsize); ph_modu0_gpu(p, gtid, gsize); ph_kcb_gpu(p, gtid, gsize));
  GPHASE(ph_g3(p, gtid, gsize));
#pragma unroll 1
  for (int lo = 0; lo < DEPTH; ++lo) {
    GLPHASE(if (l == 0) ph_g4(p, gtid, gsize); ph_proj_mfma(p, l, smem));
    GLPHASE(ph_s5_sgemm(p, l, smem); ph_hyena_pre_gpu(p, l, gtid, gsize));
    GLPHASE(ph_mix(p, l, gtid, gsize); ph_s5_carry_gpu(p, l, smem); ph_attn_mfma(p, l, smem); ph_hyena_mfma(p, l, smem));
    GLPHASE(ph_s5_ygemm(p, l, smem));
    GLPHASE(ph_glu_mfma(p, l, smem));
    GLPHASE(ph_outproj_mfma(p, l, smem));
    GLPHASE(ph_ln1_gpu(p, l));
    GLPHASE(ph_router_mfma(p, l, smem));
    GLPHASE(ph_select_gpu(p, l));
#ifdef UPVAR
    if (SINGLE) { int l = lo; OPAQUE_S(l); ph_expert_up_mfma<UPVAR>(p, l, smem); GRID_SYNC(); }
#endif
    GLPHASE(ph_expert_up_mfma(p, l, smem));
    GLPHASE(ph_expert_down_mfma(p, l, smem));
    GLPHASE(ph_ln2_gpu(p, l, smem));
  }
}
#endif

static void carve(P& p, void* ws) { p.ws = (char*)ws; }
static void set_inputs(P& p, void* const* d_in) {
  const float** f = (const float**)&p.x;
  for (int i = 0; i < 40; ++i) f[i] = (const float*)d_in[i];
}

#ifndef CPU_TEST
#ifndef MK_SINGLE
#define MK_SINGLE 1
#endif
extern __shared__ __attribute__((aligned(16))) char dyn_smem[];
__global__ void __launch_bounds__(NT, 2) mk_single(P p) {
  uint4* xbw = (uint4*)(dyn_smem + SM_XB);
  if (threadIdx.x == 0) *xbw = make_uint4(0u, 0u, 0u, 0u);
  __syncthreads();
  XcdBarrier xb = xcd_barrier_post(p.bar(), (volatile LAS unsigned*)xbw);
  run_seq_gpu<true>(p, (long)blockIdx.x * blockDim.x + threadIdx.x, (long)gridDim.x * blockDim.x, -1, xb, dyn_smem);
}
#if !MK_SINGLE
__global__ void __launch_bounds__(NT, 2) mk_phase(P p, int only) {
  XcdBarrier xb; xb.bar = p.bar(); xb.x = 0; xb.st = nullptr;
#ifdef DBG_ONLY
  only = DBG_ONLY;
#endif
  run_seq_gpu<false>(p, (long)blockIdx.x * blockDim.x + threadIdx.x, (long)gridDim.x * blockDim.x, only, xb, dyn_smem);
}
#endif
extern "C" void kernel_launch(void* const* d_in, const int* in_sizes, int n_in, void* d_out, int out_size, void* d_ws, size_t ws_size, hipStream_t stream) {
  P p; memset(&p, 0, sizeof(p));
  set_inputs(p, d_in); p.out = (float*)d_out; carve(p, d_ws);
  (void)hipMemsetAsync(p.bar(), 0, 4096 * sizeof(unsigned) + ((DEPTH * N_EXPERTS * sizeof(int) + 255) / 256) * 256, stream);
#if MK_SINGLE
  static int grid = 0;
  if (!grid) {
    int dev = 0, cus = 0, per_cu = 0; (void)hipGetDevice(&dev);
    (void)hipDeviceGetAttribute(&cus, hipDeviceAttributeMultiprocessorCount, dev);
    (void)hipFuncSetAttribute((const void*)mk_single, hipFuncAttributeMaxDynamicSharedMemorySize, SMEM_BYTES);
    (void)hipOccupancyMaxActiveBlocksPerMultiprocessor(&per_cu, mk_single, NT, SMEM_BYTES);
    grid = cus * (per_cu < 1 ? per_cu : 1);
  }
  mk_single<<<grid, NT, SMEM_BYTES, stream>>>(p);
#else
  for (int ph = 0; ph < NG_GPU + DEPTH * NLP_GPU; ++ph) mk_phase<<<256, NT, SMEM_BYTES, stream>>>(p, ph);
#endif
}
#endif
```

```cpp
#ifndef CPU_TEST
#include <hip/hip_runtime.h>
#include <cstring>
#define DEV __device__ __forceinline__
#define DEVM __device__ __forceinline__
#define HDM __host__ __device__ __forceinline__
#else
#include <cmath>
#include <cstdio>
#include <cstdlib>
#include <cstring>
#define DEV static inline
#define DEVM inline
#define HDM inline
struct float2 { float x, y; };
static inline float2 make_float2(float a, float b) { float2 r; r.x = a; r.y = b; return r; }
static inline int atomicAdd(int* p, int v) { int o = *p; *p += v; return o; }
#endif

#ifdef SMALL_CFG
#define D_MODEL 64
#define BATCH 2
#define SEQ 256
#define GRID_W 16
#define CTX_LEN 32
#define HEAD_DIM 16
#define N_Q_HEADS 4
#define N_KV_HEADS 2
#define HYENA_W 16
#define S5_W 32
#define WINDOW 32
#define FILTER_HIDDEN 16
#define S5_STATE 8
#define N_EXPERTS 32
#define TOP_K 4
#define EXPERT_FF 16
#define SHARED_FF 16
#define S5_T 32
#else
#define D_MODEL 1024
#define BATCH 2
#define SEQ 8192
#define GRID_W 64
#define CTX_LEN 256
#define HEAD_DIM 64
#define N_Q_HEADS 8
#define N_KV_HEADS 2
#define HYENA_W 256
#define S5_W 256
#define WINDOW 128
#define FILTER_HIDDEN 64
#define S5_STATE 64
#define N_EXPERTS 256
#define TOP_K 8
#define EXPERT_FF 256
#define SHARED_FF 256
#define S5_T 64
#endif
#define DEPTH 2
#define FILTER_EMB 33
#define N_EXPERT_GROUPS 8
#define TOPK_GROUPS 4
#define S5_GROUP 16
#define Q_GROUP (N_Q_HEADS / N_KV_HEADS)
#define ATTN_W (N_Q_HEADS * HEAD_DIM)
#define KV_W (N_KV_HEADS * HEAD_DIM)
#define MIX_W (ATTN_W + HYENA_W + S5_W)
#define Q_OFF 0
#define K_OFF ATTN_W
#define V_OFF (K_OFF + KV_W)
#define HY_OFF (V_OFF + KV_W)
#define S5_OFF (HY_OFF + 3 * HYENA_W)
#define IN_W (S5_OFF + S5_W)
#define AXIS_DIM (HEAD_DIM / 2)
#define ROPE_HALF (AXIS_DIM / 2)
#define S5_GROUPS (S5_W / S5_GROUP)
#define EPG (N_EXPERTS / N_EXPERT_GROUPS)
#define NL (BATCH * SEQ)
#define NC (BATCH * CTX_LEN)
#define NR (NL + NC)
#define NSEQ (CTX_LEN + SEQ)
#define NCH (NSEQ / S5_T)
#define LN_EPS 1e-5f
#define DN_ALPHA 1.4142135623730951f
#define ROUTED_SCALE 2.5f
#define PI_D 3.14159265358979323846

#define WS_LIST(X) \
  X(unsigned, bar, 4096) \
  X(int, cnt, DEPTH * N_EXPERTS) \
  X(float, mod, (size_t)DEPTH * (BATCH + 1) * 6 * D_MODEL) \
  X(float, xcur, (size_t)NR * D_MODEL) \
  X(float, ubuf, (size_t)NR * D_MODEL) \
  X(float, proj, (size_t)NR * IN_W) \
  X(float, hu, (size_t)NR * HYENA_W) \
  X(float, hx0, (size_t)NR * HYENA_W) \
  X(float, fh1, (size_t)DEPTH * SEQ * FILTER_HIDDEN) \
  X(float, fh2, (size_t)DEPTH * SEQ * FILTER_HIDDEN) \
  X(float, kraw, (size_t)DEPTH * SEQ * 2 * HYENA_W) \
  X(float, knorm, (size_t)DEPTH * HYENA_W) \
  X(float, fh1c, (size_t)CTX_LEN * FILTER_HIDDEN) \
  X(float, fh2c, (size_t)CTX_LEN * FILTER_HIDDEN) \
  X(float, krawc, (size_t)CTX_LEN * 2 * HYENA_W) \
  X(float, knormc, (size_t)HYENA_W) \
  X(float, mixb, (size_t)NR * MIX_W) \
  X(float, tmp, (size_t)NR * D_MODEL) \
  X(float2, lampow, (size_t)DEPTH * 2 * S5_GROUPS * (S5_T + 1) * S5_STATE) \
  X(float2, bbar, (size_t)DEPTH * 2 * S5_GROUPS * S5_STATE * S5_GROUP) \
  X(float, kc, (size_t)DEPTH * 2 * S5_GROUPS * S5_T * S5_GROUP * S5_GROUP) \
  X(float2, sc, (size_t)BATCH * 2 * S5_GROUPS * NCH * S5_STATE) \
  X(float2, hc, (size_t)BATCH * 2 * S5_GROUPS * NCH * S5_STATE) \
  X(float, ybuf, (size_t)NR * S5_W) \
  X(float, rl, (size_t)NR * N_EXPERTS) \
  X(int, top_e, (size_t)NR * TOP_K) \
  X(float, gate, (size_t)NR * TOP_K) \
  X(int, posb, (size_t)NR * TOP_K) \
  X(int, srow, (size_t)NR * TOP_K) \
  X(float, hbuf, (size_t)NR * TOP_K * EXPERT_FF) \
  X(float, hsb, (size_t)NR * SHARED_FF) \
  X(float, yk, (size_t)NR * TOP_K * D_MODEL) \
  X(float, ysh, (size_t)NR * D_MODEL) \
  X(unsigned short, ykb, (size_t)NR * TOP_K * D_MODEL) \
  X(unsigned short, qkvb, (size_t)NR * HY_OFF) \
  X(float2, ropet, (size_t)128 * ROPE_HALF) \
  X(unsigned short, bmtb, (size_t)DEPTH * 2 * S5_GROUPS * 128 * 1024) \
  X(unsigned short, cmtb, (size_t)DEPTH * 2 * S5_GROUPS * 1024 * 128) \
  X(unsigned short, kcb, (size_t)DEPTH * 2 * S5_GROUPS * S5_T * 256) \
  X(unsigned short, wt_in, (size_t)DEPTH * IN_W * D_MODEL) \
  X(unsigned short, wt_out, (size_t)DEPTH * D_MODEL * MIX_W) \
  X(unsigned short, wt_glu, (size_t)DEPTH * S5_W * S5_W) \
  X(unsigned short, wt_shg, (size_t)DEPTH * SHARED_FF * D_MODEL) \
  X(unsigned short, wt_shu, (size_t)DEPTH * SHARED_FF * D_MODEL) \
  X(unsigned short, wt_shd, (size_t)DEPTH * D_MODEL * SHARED_FF) \
  X(unsigned short, wt_rh, (size_t)DEPTH * N_EXPERTS * D_MODEL) \
  X(unsigned short, wt_rl, (size_t)DEPTH * N_EXPERTS * D_MODEL) \
  X(unsigned short, ubf, (size_t)NR * D_MODEL) \
  X(unsigned short, ybf, (size_t)NR * S5_W) \
  X(unsigned short, mixbf, (size_t)NR * MIX_W) \
  X(unsigned short, hbf, (size_t)NR * TOP_K * EXPERT_FF) \
  X(unsigned short, hsbf, (size_t)NR * SHARED_FF) \
  X(unsigned short, ubl, (size_t)NR * D_MODEL) \
  X(int, elist, (size_t)N_EXPERTS * NR) \
  X(float, egate, (size_t)N_EXPERTS * NR) \
  X(unsigned short, s5u, (size_t)NR * S5_W) \
  X(float, bmt, (size_t)DEPTH * 2 * S5_GROUPS * 16 * S5_T * 2 * S5_STATE) \
  X(float, cmt, (size_t)DEPTH * 2 * S5_GROUPS * 16 * S5_T * 2 * S5_STATE) \
  X(unsigned short, hcbf, (size_t)BATCH * 2 * S5_GROUPS * NCH * 2 * S5_STATE) \
  X(float, zT, (size_t)BATCH * 3 * HYENA_W * (SEQ + CTX_LEN)) \
  X(float, modp, (size_t)DEPTH * 16 * (BATCH + 1) * 6 * D_MODEL) \
  X(float, wrlo, (size_t)DEPTH * D_MODEL * N_EXPERTS) \

struct WsOff {
#define X(T, name, n) size_t name;
  WS_LIST(X)
#undef X
  size_t total;
};
constexpr WsOff ws_offsets() {
  WsOff o{}; size_t off = 0;
#define X(T, name, n) o.name = off; off += (((size_t)(n)) * sizeof(T) + 255) / 256 * 256;
  WS_LIST(X)
#undef X
  o.total = off; return o;
}
constexpr WsOff WSO = ws_offsets();
struct P {
  const float *x, *c, *ctx, *c_ctx, *w_ada, *b_ada, *w_in, *w_out, *sink, *mix_g, *hy_short_w, *hy_short_b, *hy_w1,
      *hy_b1, *hy_freq, *hy_w2, *hy_b2, *hy_w3, *hy_d, *s5_a_re, *s5_a_im, *s5_log_dt, *s5_b_re, *s5_b_im, *s5_c_re,
      *s5_c_im, *s5_d, *s5_w_glu, *ln1_g, *ln1_b, *ln2_g, *ln2_b, *w_router, *router_bias, *w_exp_gate, *w_exp_up,
      *w_exp_down, *w_sh_gate, *w_sh_up, *w_sh_down;
  float* out;
  char* ws;
#define X(T, name, n) HDM T* name() const { return (T*)(ws + WSO.name); }
  WS_LIST(X)
#undef X
};

#define FOR_ITEMS(i, N) for (long i = gtid; i < (long)(N); i += gsize)
#ifndef CPU_TEST
#define FOR_ITEMS4(i, N) _Pragma("unroll 4") for (long i = gtid; i < (long)(N); i += gsize)
#else
#define FOR_ITEMS4(i, N) FOR_ITEMS(i, N)
#endif

DEV unsigned short f2bf16(float f) { unsigned u; memcpy(&u, &f, 4); return (unsigned short)((u + 0x7fffu + ((u >> 16) & 1u)) >> 16); }
DEV float siluf(float x) { return x / (1.0f + expf(-x)); }
DEV float sigmoidf_(float x) { return 1.0f / (1.0f + expf(-x)); }
#ifndef CPU_TEST
DEV float rl_f(float v, int srcl) { return __int_as_float(__builtin_amdgcn_readlane(__float_as_int(v), srcl)); }
DEV float siluq(float x) { return x * __builtin_amdgcn_rcpf(1.0f + __builtin_amdgcn_exp2f(-1.4426950408889634f * x)); }
#endif
DEV float gelu_tanhf(float x) { return 0.5f * x * (1.0f + tanhf(0.7978845608028654f * (x + 0.044715f * x * x * x))); }
DEV int modrow(long r) { return r < NL ? (int)(r / SEQ) : BATCH; }

DEV void ph_g0(const P& p, long gtid, long gsize) {
#ifndef CPU_TEST
  FOR_ITEMS4(i4, (long)NR * D_MODEL / 4) { const long i = i4 * 4; *(float4*)(p.xcur() + i) = i < (long)NL * D_MODEL ? *(const float4*)(p.x + i) : *(const float4*)(p.ctx + (i - (long)NL * D_MODEL)); }
#else
  FOR_ITEMS(i, (long)NR * D_MODEL) p.xcur()[i] = i < (long)NL * D_MODEL ? p.x[i] : p.ctx[i - (long)NL * D_MODEL];
#endif
#ifdef CPU_TEST
  FOR_ITEMS(i, DEPTH * (BATCH + 1) * 6 * D_MODEL) {
    int n = (int)(i % (6 * D_MODEL)); int j = (int)((i / (6 * D_MODEL)) % (BATCH + 1)); int l = (int)(i / (6 * D_MODEL * (BATCH + 1)));
    const float* cv = j < BATCH ? p.c + j * D_MODEL : p.c_ctx;
    const float* w = p.w_ada + (long)l * D_MODEL * 6 * D_MODEL;
    float acc = p.b_ada[l * 6 * D_MODEL + n];
    for (int k = 0; k < D_MODEL; ++k) acc += siluf(cv[k]) * w[(long)k * 6 * D_MODEL + n];
    p.mod()[i] = acc;
  }
#else
  FOR_ITEMS(i, (long)DEPTH * 16 * 6 * D_MODEL) {
    const int n = (int)(i % (6 * D_MODEL)); const int slab = (int)((i / (6 * D_MODEL)) % 16); const int l = (int)(i / (6 * D_MODEL * 16));
    const float* w = p.w_ada + ((long)l * D_MODEL + slab * 64) * 6 * D_MODEL + n;
    float a0 = 0.f, a1 = 0.f, a2 = 0.f;
    const int kl = slab * 64 + (int)(gtid & 63);
    const float s0 = siluf(p.c[kl]), s1 = siluf(p.c[D_MODEL + kl]), s2 = siluf(p.c_ctx[kl]);
#pragma unroll
    for (int k = 0; k < 64; ++k) {
      const float wv = w[(long)k * 6 * D_MODEL];
      a0 += rl_f(s0, k) * wv; a1 += rl_f(s1, k) * wv; a2 += rl_f(s2, k) * wv;
    }
    float* dst = p.modp() + ((long)(l * 16 + slab) * (BATCH + 1)) * 6 * D_MODEL + n;
    dst[0] = a0; dst[6 * D_MODEL] = a1; dst[2 * 6 * D_MODEL] = a2;
  }
#endif
  FOR_ITEMS(i, DEPTH * 2 * S5_GROUPS * S5_STATE) {
    int pp = (int)(i % S5_STATE); int g = (int)((i / S5_STATE) % S5_GROUPS); int ld = (int)(i / (S5_STATE * S5_GROUPS));
    float are = fminf(p.s5_a_re[i], -1e-4f), aim = p.s5_a_im[i];
    float dt = expf(p.s5_log_dt[ld * S5_GROUPS + g]);
#ifdef CPU_TEST
    for (int d = 0; d <= S5_T; ++d) {
      float mag = expf(are * dt * d); float ang = aim * dt * d;
      p.lampow()[((long)(ld * S5_GROUPS + g) * (S5_T + 1) + d) * S5_STATE + pp] = make_float2(mag * cosf(ang), mag * sinf(ang));
    }
#endif
    float mag = expf(are * dt), ang = aim * dt;
    float lr = mag * cosf(ang) - 1.0f, li = mag * sinf(ang);
    float den = are * are + aim * aim;
    float fr = (lr * are + li * aim) / den, fi = (li * are - lr * aim) / den;
    for (int j = 0; j < S5_GROUP; ++j) {
      float br = p.s5_b_re[i * S5_GROUP + j], bi = p.s5_b_im[i * S5_GROUP + j];
      p.bbar()[i * S5_GROUP + j] = make_float2(fr * br - fi * bi, fr * bi + fi * br);
    }
  }
}
#ifndef CPU_TEST
DEV void rope_table_gpu(const P& p, long gtid, long gsize) {
  FOR_ITEMS(i, (long)128 * ROPE_HALF) {
    const int ii = (int)(i % ROPE_HALF), pos = (int)(i / ROPE_HALF);
    const float ang = (float)pos * powf(10000.0f, -(float)(2 * ii) / (float)AXIS_DIM);
    p.ropet()[i] = make_float2(cosf(ang), sinf(ang));
  }
}
DEV void s5_lampow_gpu(const P& p, long gtid, long gsize) {
  FOR_ITEMS4(i, (long)DEPTH * 2 * S5_GROUPS * (S5_T + 1) * S5_STATE) {
    const int pp = (int)(i % S5_STATE); const int d = (int)((i / S5_STATE) % (S5_T + 1)); const long ldg = i / ((long)S5_STATE * (S5_T + 1));
    const long src = ldg * S5_STATE + pp;
    const float are = fminf(p.s5_a_re[src], -1e-4f), aim = p.s5_a_im[src]; const float dt = expf(p.s5_log_dt[ldg]);
    const float mag = expf(are * dt * d); const float ang = aim * dt * d;
    p.lampow()[i] = make_float2(mag * cosf(ang), mag * sinf(ang));
  }
}
#endif
DEV void hy_f1(const P& p, int l, int Lf, float* h1, long gtid, long gsize) {
  FOR_ITEMS(i, (long)Lf * FILTER_HIDDEN) {
    int j = (int)(i % FILTER_HIDDEN); int t = (int)(i / FILTER_HIDDEN);
    const float* w1 = p.hy_w1 + l * FILTER_EMB * FILTER_HIDDEN;
    float tt = (float)((double)t / (double)(Lf - 1));
    float w = (float)(2.0 * PI_D * (double)t / (double)Lf);
    float acc = p.hy_b1[l * FILTER_HIDDEN + j] + tt * w1[j];
    const int bands = (FILTER_EMB - 1) / 2;
    for (int m = 0; m < bands; ++m) {
      float f = (float)(1e-4 + (double)m * ((double)(bands - 1) - 1e-4) / (double)(bands - 1));
      float a = f * w;
      acc += cosf(a) * w1[(1 + m) * FILTER_HIDDEN + j] - sinf(a) * w1[(1 + bands + m) * FILTER_HIDDEN + j];
    }
    h1[i] = sinf(p.hy_freq[l * FILTER_HIDDEN + j] * acc);
  }
}
DEV void hy_f2(const P& p, int l, int Lf, const float* h1, float* h2, long gtid, long gsize) {
  FOR_ITEMS(i, (long)Lf * FILTER_HIDDEN) {
    int j = (int)(i % FILTER_HIDDEN); int t = (int)(i / FILTER_HIDDEN);
    const float* w2 = p.hy_w2 + l * FILTER_HIDDEN * FILTER_HIDDEN;
    float acc = p.hy_b2[l * FILTER_HIDDEN + j];
    for (int k = 0; k < FILTER_HIDDEN; ++k) acc += h1[t * FILTER_HIDDEN + k] * w2[k * FILTER_HIDDEN + j];
#ifndef CPU_TEST
    h2[(long)j * Lf + t] = sinf(p.hy_freq[l * FILTER_HIDDEN + j] * acc);
#else
    h2[i] = sinf(p.hy_freq[l * FILTER_HIDDEN + j] * acc);
#endif
  }
}
DEV void hy_f3(const P& p, int l, int Lf, const float* h2, float* kraw, long gtid, long gsize) {
#ifndef CPU_TEST
  const float* w3 = p.hy_w3 + l * FILTER_HIDDEN * 2 * HYENA_W;
  FOR_ITEMS(i, (long)Lf * (2 * HYENA_W / 8)) {
    const int t = (int)(i % Lf); const int c8 = (int)(i / Lf) * 8;
    float acc[8];
#pragma unroll
    for (int j = 0; j < 8; ++j) acc[j] = 0.f;
#pragma unroll 4
    for (int k = 0; k < FILTER_HIDDEN; ++k) {
      const float hv = h2[(long)k * Lf + t];
      const float4 wa = *(const float4*)(w3 + k * 2 * HYENA_W + c8), wb = *(const float4*)(w3 + k * 2 * HYENA_W + c8 + 4);
      acc[0] += hv * wa.x; acc[1] += hv * wa.y; acc[2] += hv * wa.z; acc[3] += hv * wa.w; acc[4] += hv * wb.x; acc[5] += hv * wb.y; acc[6] += hv * wb.z; acc[7] += hv * wb.w;
    }
    const double d0 = log(1e-2) / 0.3, d1 = log(1e-2) / 1.5;
    const float tt = (float)((double)t / (double)(Lf - 1));
#pragma unroll
    for (int j = 0; j < 8; ++j) {
      const int ch = (c8 + j) % HYENA_W;
      const float delta = fabsf((float)(d0 + (d1 - d0) * (double)ch / (double)(HYENA_W - 1)));
      kraw[(long)(c8 + j) * Lf + t] = acc[j] * expf(-tt * delta);
    }
  }
#else
  FOR_ITEMS(i, (long)Lf * 2 * HYENA_W) {
    int t = (int)(i % Lf); int cc = (int)(i / Lf); int ch = cc % HYENA_W;
    const float* w3 = p.hy_w3 + l * FILTER_HIDDEN * 2 * HYENA_W;
    float acc = 0.f;
    for (int k = 0; k < FILTER_HIDDEN; ++k) acc += h2[t * FILTER_HIDDEN + k] * w3[k * 2 * HYENA_W + cc];
    double d0 = log(1e-2) / 0.3, d1 = log(1e-2) / 1.5;
    float delta = fabsf((float)(d0 + (d1 - d0) * (double)ch / (double)(HYENA_W - 1)));
    float tt = (float)((double)t / (double)(Lf - 1));
    kraw[(long)cc * Lf + t] = acc * expf(-tt * delta);
  }
#endif
}
DEV void hy_f4(int Lf, const float* kraw, float* knorm, long gtid, long gsize) {
#ifndef CPU_TEST
  const int lane = (int)(gtid & 63); const long gw = gtid >> 6, nw = gsize >> 6;
  for (long i = gw; i < HYENA_W; i += nw) {
    float s = 0.f;
    for (int t = lane; t < Lf; t += 64) { s += fabsf(kraw[i * Lf + t]); if (t > 0) s += fabsf(kraw[(HYENA_W + i) * Lf + t]); }
    for (int o = 32; o > 0; o >>= 1) s += __shfl_xor(s, o);
    if (lane == 0) knorm[i] = 1.0f / s;
  }
#else
  FOR_ITEMS(i, HYENA_W) {
    float s = 0.f;
    for (int t = 0; t < Lf; ++t) {
      s += fabsf(kraw[(long)i * Lf + t]);
      if (t > 0) s += fabsf(kraw[(long)(HYENA_W + i) * Lf + t]);
    }
    knorm[i] = 1.0f / s;
  }
#endif
}
#ifndef CPU_TEST
DEV void hy_f1g(const P& p, int l, int Lf, float* h1, long gtid, long gsize) {
  const int lane = (int)(gtid & 63);
  const float* w1 = p.hy_w1 + l * FILTER_EMB * FILTER_HIDDEN;
  const int bands = (FILTER_EMB - 1) / 2;
  static_assert(FILTER_HIDDEN == 64 && (FILTER_EMB - 1) / 2 == 16, "filter shape");
  FOR_ITEMS(i, (long)Lf * FILTER_HIDDEN) {
    const int j = lane; const int t = (int)(i / FILTER_HIDDEN);
    const float tt = (float)((double)t / (double)(Lf - 1));
    const float w = (float)(2.0 * PI_D * (double)t / (double)Lf);
    const int mm = lane & 15;
    const float f = (float)(1e-4 + (double)mm * ((double)(bands - 1) - 1e-4) / (double)(bands - 1));
    const float a = f * w; const float ca = cosf(a), sa = sinf(a);
    float acc = p.hy_b1[l * FILTER_HIDDEN + j] + tt * w1[j];
#pragma unroll
    for (int m = 0; m < 16; ++m) acc += rl_f(ca, m) * w1[(1 + m) * FILTER_HIDDEN + j] - rl_f(sa, m) * w1[(1 + bands + m) * FILTER_HIDDEN + j];
    h1[i] = sinf(p.hy_freq[l * FILTER_HIDDEN + j] * acc);
  }
}
DEV void hy_f2g(const P& p, long gtid, long gsize) {
  const long n_main = (long)DEPTH * 8 * SEQ, n_all = n_main + 8 * CTX_LEN;
  FOR_ITEMS(i, n_all) {
    const bool isc = __builtin_amdgcn_readfirstlane((int)(i >= n_main)) != 0;
    const long ii = isc ? i - n_main : i; const int Lf = isc ? CTX_LEN : SEQ;
    const int t = (int)(ii % Lf); const int gq = __builtin_amdgcn_readfirstlane((int)(ii / Lf)); const int j8 = (gq & 7) * 8, l = isc ? 0 : (gq >> 3);
    const float* h1 = isc ? p.fh1c() : p.fh1() + (long)l * SEQ * FILTER_HIDDEN; float* h2 = isc ? p.fh2c() : p.fh2() + (long)l * SEQ * FILTER_HIDDEN;
    const float* w2 = p.hy_w2 + l * FILTER_HIDDEN * FILTER_HIDDEN + j8;
    const float4* hr = (const float4*)(h1 + (long)t * FILTER_HIDDEN);
    float acc[8];
#pragma unroll
    for (int jj = 0; jj < 8; ++jj) acc[jj] = p.hy_b2[l * FILTER_HIDDEN + j8 + jj];
#pragma unroll 4
    for (int k4 = 0; k4 < FILTER_HIDDEN / 4; ++k4) {
      const float4 h = hr[k4]; const float hv[4] = {h.x, h.y, h.z, h.w};
#pragma unroll
      for (int e = 0; e < 4; ++e) {
        const float4 wa = *(const float4*)(w2 + (4 * k4 + e) * FILTER_HIDDEN), wb = *(const float4*)(w2 + (4 * k4 + e) * FILTER_HIDDEN + 4);
        acc[0] += hv[e] * wa.x; acc[1] += hv[e] * wa.y; acc[2] += hv[e] * wa.z; acc[3] += hv[e] * wa.w; acc[4] += hv[e] * wb.x; acc[5] += hv[e] * wb.y; acc[6] += hv[e] * wb.z; acc[7] += hv[e] * wb.w;
      }
    }
#pragma unroll
    for (int jj = 0; jj < 8; ++jj) h2[(long)(j8 + jj) * Lf + t] = sinf(p.hy_freq[l * FILTER_HIDDEN + j8 + jj] * acc[jj]);
  }
}
DEV void hy_f3g(const P& p, int l, int Lf, const float* h2, float* kraw, float* psum, long gtid, long gsize) {
  const float* w3 = p.hy_w3 + l * FILTER_HIDDEN * 2 * HYENA_W;
  const int nblk = Lf >> 8; const int lane = (int)(gtid & 63);
  FOR_ITEMS(i, (long)(2 * HYENA_W / 8) * nblk * 64) {
    const int wi = __builtin_amdgcn_readfirstlane((int)(i >> 6));
    const int c8 = (wi / nblk) * 8, tb = wi % nblk, t0 = tb * 256 + lane;
    float acc[4][8];
#pragma unroll
    for (int q = 0; q < 4; ++q)
#pragma unroll
      for (int j = 0; j < 8; ++j) acc[q][j] = 0.f;
#pragma unroll 4
    for (int k = 0; k < FILTER_HIDDEN; ++k) {
      const float4 wa = *(const float4*)(w3 + k * 2 * HYENA_W + c8), wb = *(const float4*)(w3 + k * 2 * HYENA_W + c8 + 4);
#pragma unroll
      for (int q = 0; q < 4; ++q) {
        const float hv = h2[(long)k * Lf + t0 + 64 * q];
        acc[q][0] += hv * wa.x; acc[q][1] += hv * wa.y; acc[q][2] += hv * wa.z; acc[q][3] += hv * wa.w; acc[q][4] += hv * wb.x; acc[q][5] += hv * wb.y; acc[q][6] += hv * wb.z; acc[q][7] += hv * wb.w;
      }
    }
    const double d0 = log(1e-2) / 0.3, d1 = log(1e-2) / 1.5;
    float ps[8];
#pragma unroll
    for (int j = 0; j < 8; ++j) ps[j] = 0.f;
#pragma unroll
    for (int j = 0; j < 8; ++j) {
      const int ch = (c8 + j) % HYENA_W;
      const float delta = fabsf((float)(d0 + (d1 - d0) * (double)ch / (double)(HYENA_W - 1)));
#pragma unroll
      for (int q = 0; q < 4; ++q) {
        const int t = t0 + 64 * q; const float tt = (float)((double)t / (double)(Lf - 1));
        const float v = acc[q][j] * expf(-tt * delta);
        kraw[(long)(c8 + j) * Lf + t] = v;
        ps[j] += (c8 >= HYENA_W && t == 0) ? 0.f : fabsf(v);
      }
    }
#pragma unroll
    for (int j = 0; j < 8; ++j) {
      float v = ps[j];
#pragma unroll
      for (int o = 32; o > 0; o >>= 1) v += __shfl_xor(v, o);
      if (lane == 0) psum[(long)(c8 + j) * nblk + tb] = v;
    }
  }
}
DEV void hy_f4g(int Lf, const float* psum, float* knorm, long gtid, long gsize) {
  const int lane = (int)(gtid & 63); const long gw = gtid >> 6, nw = gsize >> 6; const int nblk = Lf >> 8;
  for (long i = gw; i < HYENA_W; i += nw) {
    float s = 0.f;
    for (int q = lane; q < nblk; q += 64) s += psum[i * nblk + q] + psum[(HYENA_W + i) * nblk + q];
#pragma unroll
    for (int o = 32; o > 0; o >>= 1) s += __shfl_xor(s, o);
    if (lane == 0) knorm[i] = 1.0f / s;
  }
}
#define HY_PSUM(f) (p.tmp() + (long)(f) * 2 * HYENA_W * (SEQ >> 8))
#endif
DEV void ph_g1(const P& p, long gtid, long gsize) {
#ifndef CPU_TEST
  for (int l = 0; l < DEPTH; ++l) hy_f1g(p, l, SEQ, p.fh1() + (long)l * SEQ * FILTER_HIDDEN, gtid, gsize);
  hy_f1g(p, 0, CTX_LEN, p.fh1c(), gtid, gsize);
#else
  for (int l = 0; l < DEPTH; ++l) hy_f1(p, l, SEQ, p.fh1() + (long)l * SEQ * FILTER_HIDDEN, gtid, gsize);
  hy_f1(p, 0, CTX_LEN, p.fh1c(), gtid, gsize);
#endif
  FOR_ITEMS(i, (long)DEPTH * 2 * S5_GROUPS * S5_T * S5_GROUP * S5_GROUP) {
    int j = (int)(i % S5_GROUP); int ii = (int)((i / S5_GROUP) % S5_GROUP); int d = (int)((i / (S5_GROUP * S5_GROUP)) % S5_T);
    long ldg = i / (S5_GROUP * S5_GROUP * S5_T);
    float acc = 0.f;
    for (int pp = 0; pp < S5_STATE; ++pp) {
      float cr = p.s5_c_re[(ldg * S5_GROUP + ii) * S5_STATE + pp], ci = p.s5_c_im[(ldg * S5_GROUP + ii) * S5_STATE + pp];
      float2 lp = p.lampow()[(ldg * (S5_T + 1) + d) * S5_STATE + pp];
      float2 bb = p.bbar()[(ldg * S5_STATE + pp) * S5_GROUP + j];
      float tr = lp.x * bb.x - lp.y * bb.y, ti = lp.x * bb.y + lp.y * bb.x;
      acc += cr * tr - ci * ti;
    }
    p.kc()[i] = acc;
  }
}
#ifndef CPU_TEST
DEV void ph_g2(const P& p, long gtid, long gsize) {
  hy_f2g(p, gtid, gsize);
}
DEV void ph_g3(const P& p, long gtid, long gsize) {
  for (int l = 0; l < DEPTH; ++l) hy_f3g(p, l, SEQ, p.fh2() + (long)l * SEQ * FILTER_HIDDEN, p.kraw() + (long)l * SEQ * 2 * HYENA_W, HY_PSUM(l), gtid, gsize);
  hy_f3g(p, 0, CTX_LEN, p.fh2c(), p.krawc(), HY_PSUM(DEPTH), gtid, gsize);
}
DEV void ph_g4(const P& p, long gtid, long gsize) {
  for (int l = 0; l < DEPTH; ++l) hy_f4g(SEQ, HY_PSUM(l), p.knorm() + l * HYENA_W, gtid, gsize);
  hy_f4g(CTX_LEN, HY_PSUM(DEPTH), p.knormc(), gtid, gsize);
}
#else
DEV void ph_g2(const P& p, long gtid, long gsize) {
  for (int l = 0; l < DEPTH; ++l) hy_f2(p, l, SEQ, p.fh1() + (long)l * SEQ * FILTER_HIDDEN, p.fh2() + (long)l * SEQ * FILTER_HIDDEN, gtid, gsize);
  hy_f2(p, 0, CTX_LEN, p.fh1c(), p.fh2c(), gtid, gsize);
}
DEV void ph_g3(const P& p, long gtid, long gsize) {
  for (int l = 0; l < DEPTH; ++l) hy_f3(p, l, SEQ, p.fh2() + (long)l * SEQ * FILTER_HIDDEN, p.kraw() + (long)l * SEQ * 2 * HYENA_W, gtid, gsize);
  hy_f3(p, 0, CTX_LEN, p.fh2c(), p.krawc(), gtid, gsize);
}
DEV void ph_g4(const P& p, long gtid, long gsize) {
  for (int l = 0; l < DEPTH; ++l) hy_f4(SEQ, p.kraw() + (long)l * SEQ * 2 * HYENA_W, p.knorm() + l * HYENA_W, gtid, gsize);
  hy_f4(CTX_LEN, p.krawc(), p.knormc(), gtid, gsize);
}
#endif
#define NG 5

DEV void ph_modu(const P& p, int l, int which, long gtid, long gsize) {
  FOR_ITEMS(i, (long)NR * D_MODEL) {
    int k = (int)(i % D_MODEL); long r = i / D_MODEL;
    const float* m = p.mod() + ((long)l * (BATCH + 1) + modrow(r)) * 6 * D_MODEL + which * 3 * D_MODEL;
    float uv = p.xcur()[i] * (1.0f + m[D_MODEL + k]) + m[k];
    p.ubuf()[i] = uv; p.ubf()[i] = f2bf16(uv);
  }
}
template <class Epi>
DEV void gemm_naive(const float* A, int lda, const float* B, int ldb, int M, int N, int K, Epi epi, long gtid, long gsize) {
  FOR_ITEMS(i, (long)(M / 4) * N) {
    int n = (int)(i % N); long r0 = (i / N) * 4;
    const float* a0 = A + r0 * lda;
    float c0 = 0.f, c1 = 0.f, c2 = 0.f, c3 = 0.f;
    for (int k = 0; k < K; ++k) {
      float b = B[(long)k * ldb + n];
      c0 += a0[k] * b; c1 += a0[lda + k] * b; c2 += a0[2 * lda + k] * b; c3 += a0[3 * lda + k] * b;
    }
    epi(r0, n, c0); epi(r0 + 1, n, c1); epi(r0 + 2, n, c2); epi(r0 + 3, n, c3);
  }
}
struct EpiStore { float* C; int ldc; DEVM void operator()(long r, int n, float v) const { C[r * ldc + n] = v; } };
DEV void ph_proj(const P& p, int l, long gtid, long gsize) {
  EpiStore e{p.proj(), IN_W};
  gemm_naive(p.ubuf(), D_MODEL, p.w_in + (long)l * D_MODEL * IN_W, IN_W, NR, IN_W, D_MODEL, e, gtid, gsize);
}
DEV long s5_row(int b, int dir, int n) {
  if (n < CTX_LEN) return (long)NL + b * CTX_LEN + (dir ? CTX_LEN - 1 - n : n);
  int t = n - CTX_LEN; return (long)b * SEQ + (dir ? SEQ - 1 - t : t);
}
DEV void ph_post_proj(const P& p, int l, long gtid, long gsize) {
  FOR_ITEMS(i, (long)NL * (N_Q_HEADS + N_KV_HEADS) * 2 * ROPE_HALF) {
    int ii = (int)(i % ROPE_HALF); int a = (int)((i / ROPE_HALF) % 2); int hs = (int)((i / (2 * ROPE_HALF)) % (N_Q_HEADS + N_KV_HEADS));
    long r = i / (2 * ROPE_HALF * (N_Q_HEADS + N_KV_HEADS));
    int t = (int)(r % SEQ); int pos = a == 0 ? t / GRID_W : t % GRID_W;
    float inv = powf(10000.0f, -(float)(2 * ii) / (float)AXIS_DIM);
    float ang = (float)pos * inv; float cs = cosf(ang), sn = sinf(ang);
    float* q = p.proj() + r * IN_W + hs * HEAD_DIM + a * AXIS_DIM + ii;
    float x1 = q[0], x2 = q[ROPE_HALF];
    q[0] = x1 * cs - x2 * sn; q[ROPE_HALF] = x1 * sn + x2 * cs;
  }
#ifdef CPU_TEST
  FOR_ITEMS(i, (long)NR * HYENA_W) {
    int ch = (int)(i % HYENA_W); long r = i / HYENA_W;
    int Ls = r < NL ? SEQ : CTX_LEN; long base = r < NL ? (r / SEQ) * SEQ : NL + ((r - NL) / CTX_LEN) * CTX_LEN; int t = (int)(r - base);
    const float* sw = p.hy_short_w + l * 3 * 3 * HYENA_W; const float* sb = p.hy_short_b + l * 3 * HYENA_W;
    float z[3];
#pragma unroll
    for (int part = 0; part < 3; ++part) {
      int cc = part * HYENA_W + ch; float acc = sb[cc];
#pragma unroll
      for (int j = 0; j < 3; ++j) { int tt = t + j - 1; if (tt >= 0 && tt < Ls) acc += p.proj()[(base + tt) * IN_W + HY_OFF + cc] * sw[j * 3 * HYENA_W + cc]; }
      z[part] = acc;
    }
    long o = r < NL ? ((r / SEQ) * HYENA_W + ch) * SEQ + t : i;
    p.hu()[o] = z[0] * z[1]; p.hx0()[o] = z[2];
  }
#endif
#ifndef CPU_TEST
  FOR_ITEMS(i, (long)NR * S5_W) { long r = i / S5_W; int cc = (int)(i % S5_W); p.s5u()[i] = f2bf16(p.proj()[r * IN_W + S5_OFF + cc]); }
#endif
#ifdef CPU_TEST
  FOR_ITEMS(i, (long)BATCH * 2 * S5_GROUPS * NCH * S5_STATE) {
    int pp = (int)(i % S5_STATE); int c = (int)((i / S5_STATE) % NCH); int g = (int)((i / (S5_STATE * NCH)) % S5_GROUPS);
    int dir = (int)((i / (S5_STATE * NCH * S5_GROUPS)) % 2); int b = (int)(i / (S5_STATE * NCH * S5_GROUPS * 2));
    long ldg = ((long)l * 2 + dir) * S5_GROUPS + g;
    float sr = 0.f, si = 0.f;
    for (int s = 0; s < S5_T; ++s) {
      const float* u = p.proj() + s5_row(b, dir, c * S5_T + s) * IN_W + S5_OFF + g * S5_GROUP;
      float br = 0.f, bi = 0.f;
#pragma unroll
      for (int j = 0; j < S5_GROUP; ++j) { float2 bb = p.bbar()[(ldg * S5_STATE + pp) * S5_GROUP + j]; br += bb.x * u[j]; bi += bb.y * u[j]; }
      float2 lp = p.lampow()[(ldg * (S5_T + 1) + (S5_T - 1 - s)) * S5_STATE + pp];
      sr += lp.x * br - lp.y * bi; si += lp.x * bi + lp.y * br;
    }
    p.sc()[i] = make_float2(sr, si);
  }
#endif
}
DEV void attn_item(const P& p, int l, long r, int h, float* outp) {
  const float scale = 1.0f / sqrtf((float)HEAD_DIM);
  float q[HEAD_DIM], acc[HEAD_DIM];
  const float* qp = p.proj() + r * IN_W + Q_OFF + h * HEAD_DIM;
#pragma unroll
  for (int d = 0; d < HEAD_DIM; ++d) { q[d] = qp[d] * scale; acc[d] = 0.f; }
  int kvh = h / Q_GROUP; int b = r < NL ? (int)(r / SEQ) : (int)((r - NL) / CTX_LEN);
  float m = -1e30f, lsum = 0.f;
  int nwin = 0, t = 0;
  if (r < NL) { t = (int)(r % SEQ); nwin = 2 * WINDOW + 1; }
  for (int j = 0; j < nwin + CTX_LEN; ++j) {
    long kr;
    if (j < nwin) { int tk = t - WINDOW + j; if (tk < 0 || tk >= SEQ) continue; kr = (long)b * SEQ + tk; }
    else kr = (long)NL + b * CTX_LEN + (j - nwin);
    const float* kp = p.proj() + kr * IN_W + K_OFF + kvh * HEAD_DIM; const float* vp = p.proj() + kr * IN_W + V_OFF + kvh * HEAD_DIM;
    float s = 0.f;
#pragma unroll
    for (int d = 0; d < HEAD_DIM; ++d) s += q[d] * kp[d];
    float mn = fmaxf(m, s); float corr = expf(m - mn); float pe = expf(s - mn);
    lsum = lsum * corr + pe;
#pragma unroll
    for (int d = 0; d < HEAD_DIM; ++d) acc[d] = acc[d] * corr + pe * vp[d];
    m = mn;
  }
  float sk = p.sink[l * N_Q_HEADS + h]; float mf = fmaxf(m, sk); float corr = expf(m - mf);
  float den = lsum * corr + expf(sk - mf); float sc2 = corr / den;
#pragma unroll
  for (int d = 0; d < HEAD_DIM; ++d) outp[d] = acc[d] * sc2;
}
DEV void ph_mix(const P& p, int l, long gtid, long gsize) {
#ifdef CPU_TEST
  long nrows_att = l == 0 ? NR : NL;
  FOR_ITEMS(i, nrows_att * N_Q_HEADS) { int h = (int)(i % N_Q_HEADS); long r = i / N_Q_HEADS; attn_item(p, l, r, h, p.mixb() + r * MIX_W + h * HEAD_DIM); }
#endif
#ifdef CPU_TEST
  FOR_ITEMS(i, (long)NL * HYENA_W) {
    int ch = (int)(i % HYENA_W); long r = i / HYENA_W; int t = (int)(r % SEQ); int b = (int)(r / SEQ);
    const float* kf = p.kraw() + ((long)l * 2 * HYENA_W + ch) * SEQ; const float* kb = p.kraw() + ((long)l * 2 * HYENA_W + HYENA_W + ch) * SEQ;
    const float* uu = p.hu() + ((long)b * HYENA_W + ch) * SEQ;
    float acc = 0.f;
    for (int s = 0; s <= t; ++s) acc += kf[t - s] * uu[s];
    for (int s = t + 1; s < SEQ; ++s) acc += kb[s - t] * uu[s];
    p.mixb()[r * MIX_W + ATTN_W + ch] = (acc * p.knorm()[l * HYENA_W + ch] + uu[t] * p.hy_d[l * HYENA_W + ch]) * p.hx0()[((long)b * HYENA_W + ch) * SEQ + t];
  }
#endif
  if (l == 0) {
#ifndef CPU_TEST
    FOR_ITEMS(i, (long)NC * HYENA_W) {
      const int t = (int)(i % CTX_LEN); const int ch = (int)((i / CTX_LEN) % HYENA_W); const int b = (int)(i / ((long)CTX_LEN * HYENA_W));
      const long base = (long)NL + (long)b * CTX_LEN; const long r = base + t;
      const float* kf = p.krawc() + (long)ch * CTX_LEN; const float* kb = p.krawc() + (long)(HYENA_W + ch) * CTX_LEN;
      float acc = 0.f;
#pragma unroll 8
      for (int sidx = 0; sidx < CTX_LEN; ++sidx) {
        const int d = t - sidx; const float kv = d >= 0 ? kf[d] : kb[-d];
        acc += kv * p.hu()[(base + sidx) * HYENA_W + ch];
      }
      const float u = p.hu()[r * HYENA_W + ch];
      p.mixb()[r * MIX_W + ATTN_W + ch] = (acc * p.knormc()[ch] + u * p.hy_d[l * HYENA_W + ch]) * p.hx0()[r * HYENA_W + ch];
    }
#else
    FOR_ITEMS(i, (long)NC * HYENA_W) {
      int ch = (int)(i % HYENA_W); long r = NL + i / HYENA_W; int t = (int)((r - NL) % CTX_LEN); long base = r - t;
      float acc = 0.f;
      for (int s = 0; s <= t; ++s) acc += p.krawc()[(long)ch * CTX_LEN + (t - s)] * p.hu()[(base + s) * HYENA_W + ch];
      for (int s = t + 1; s < CTX_LEN; ++s) acc += p.krawc()[(long)(HYENA_W + ch) * CTX_LEN + (s - t)] * p.hu()[(base + s) * HYENA_W + ch];
      float u = p.hu()[r * HYENA_W + ch];
      p.mixb()[r * MIX_W + ATTN_W + ch] = (acc * p.knormc()[ch] + u * p.hy_d[l * HYENA_W + ch]) * p.hx0()[r * HYENA_W + ch];
    }
#endif
  }
#ifdef CPU_TEST
  FOR_ITEMS(i, (long)BATCH * 2 * S5_GROUPS * S5_STATE) {
    int pp = (int)(i % S5_STATE); int g = (int)((i / S5_STATE) % S5_GROUPS); int dir = (int)((i / (S5_STATE * S5_GROUPS)) % 2); int b = (int)(i / (S5_STATE * S5_GROUPS * 2));
    long ldg = ((long)l * 2 + dir) * S5_GROUPS + g;
    float2 lt = p.lampow()[(ldg * (S5_T + 1) + S5_T) * S5_STATE + pp];
    float hr = 0.f, hi = 0.f;
    long base = (((long)b * 2 + dir) * S5_GROUPS + g) * NCH;
#ifndef CPU_TEST
    static_assert(NCH % 12 == 0, "carry batching");
    for (int c0 = 0; c0 < NCH; c0 += 12) {
      float2 sv[12];
#pragma unroll
      for (int k = 0; k < 12; ++k) sv[k] = p.sc()[(base + c0 + k) * S5_STATE + pp];
#pragma unroll
      for (int k = 0; k < 12; ++k) {
        p.hcbf()[(base + c0 + k) * 2 * S5_STATE + pp] = f2bf16(hr); p.hcbf()[(base + c0 + k) * 2 * S5_STATE + S5_STATE + pp] = f2bf16(hi);
        const float nr = lt.x * hr - lt.y * hi + sv[k].x, ni = lt.x * hi + lt.y * hr + sv[k].y;
        hr = nr; hi = ni;
      }
    }
#else
    for (int c = 0; c < NCH; ++c) {
      p.hc()[(base + c) * S5_STATE + pp] = make_float2(hr, hi);
      float2 s = p.sc()[(base + c) * S5_STATE + pp];
      float nr = lt.x * hr - lt.y * hi + s.x, ni = lt.x * hi + lt.y * hr + s.y;
      hr = nr; hi = ni;
    }
#endif
  }
#endif
}
DEV void ph_s5out(const P& p, int l, long gtid, long gsize) {
  FOR_ITEMS(i, (long)NR * S5_W) {
    int chn = (int)(i % S5_W); long r = i / S5_W; int g = chn / S5_GROUP, ii = chn % S5_GROUP;
    int b, tl; bool isctx = r >= NL;
    if (isctx) { b = (int)((r - NL) / CTX_LEN); tl = (int)((r - NL) % CTX_LEN); } else { b = (int)(r / SEQ); tl = (int)(r % SEQ); }
    float y = p.s5_d[l * S5_W + chn] * p.proj()[r * IN_W + S5_OFF + chn];
    for (int dir = 0; dir < 2; ++dir) {
      int n = isctx ? (dir ? CTX_LEN - 1 - tl : tl) : CTX_LEN + (dir ? SEQ - 1 - tl : tl);
      int c = n / S5_T, tau = n % S5_T;
      long ldg = ((long)l * 2 + dir) * S5_GROUPS + g;
      long hb = ((((long)b * 2 + dir) * S5_GROUPS + g) * NCH + c) * S5_STATE;
      for (int pp = 0; pp < S5_STATE; ++pp) {
        float cr = p.s5_c_re[(ldg * S5_GROUP + ii) * S5_STATE + pp], ci = p.s5_c_im[(ldg * S5_GROUP + ii) * S5_STATE + pp];
        float2 lp = p.lampow()[(ldg * (S5_T + 1) + tau + 1) * S5_STATE + pp]; float2 h = p.hc()[hb + pp];
        float tr = lp.x * h.x - lp.y * h.y, ti = lp.x * h.y + lp.y * h.x;
        y += cr * tr - ci * ti;
      }
      for (int s = 0; s <= tau; ++s) {
        const float* u = p.proj() + s5_row(b, dir, c * S5_T + s) * IN_W + S5_OFF + g * S5_GROUP;
        const float* kk = p.kc() + ((ldg * S5_T + (tau - s)) * S5_GROUP + ii) * S5_GROUP;
#pragma unroll
        for (int j = 0; j < S5_GROUP; ++j) y += kk[j] * u[j];
      }
    }
    float gy = gelu_tanhf(y); p.ybuf()[i] = gy; p.ybf()[i] = f2bf16(gy);
  }
}
struct EpiGlu { const float* g; float* mixb; DEVM void operator()(long r, int n, float v) const { mixb[r * MIX_W + ATTN_W + HYENA_W + n] = g[r * S5_W + n] * sigmoidf_(v); } };
DEV void ph_glu(const P& p, int l, long gtid, long gsize) {
  EpiGlu e{p.ybuf(), p.mixb()};
  gemm_naive(p.ybuf(), S5_W, p.s5_w_glu + (long)l * S5_W * S5_W, S5_W, NR, S5_W, S5_W, e, gtid, gsize);
}
DEV void ph_rms(const P& p, int l, long gtid, long gsize) {
  FOR_ITEMS(i, (long)NR * 3) {
    int grp = (int)(i % 3); long r = i / 3;
    int off = grp == 0 ? 0 : (grp == 1 ? ATTN_W : ATTN_W + HYENA_W); int w = grp == 0 ? ATTN_W : (grp == 1 ? HYENA_W : S5_W);
    float* v = p.mixb() + r * MIX_W + off; float ss = 0.f;
    for (int k = 0; k < w; ++k) ss += v[k] * v[k];
    float rs = 1.0f / sqrtf(ss / (float)w + LN_EPS);
    for (int k = 0; k < w; ++k) { float nv = v[k] * rs * p.mix_g[l * MIX_W + off + k]; v[k] = nv; p.mixbf()[r * MIX_W + off + k] = f2bf16(nv); }
  }
}
struct EpiRes { const float* xcur; const float* mod; int l; int goff; float* tmp;
  DEVM void operator()(long r, int n, float v) const { const float* m = mod + ((long)l * (BATCH + 1) + modrow(r)) * 6 * D_MODEL + goff; tmp[r * D_MODEL + n] = DN_ALPHA * xcur[r * D_MODEL + n] + m[n] * v; } };
DEV void ph_outproj(const P& p, int l, long gtid, long gsize) {
  EpiRes e{p.xcur(), p.mod(), l, 2 * D_MODEL, p.tmp()};
  gemm_naive(p.mixb(), MIX_W, p.w_out + (long)l * MIX_W * D_MODEL, D_MODEL, NR, D_MODEL, MIX_W, e, gtid, gsize);
}
DEV void ph_ln(const P& p, int l, int which, long gtid, long gsize) {
  const float* gw = (which == 0 ? p.ln1_g : p.ln2_g) + l * D_MODEL; const float* bw = (which == 0 ? p.ln1_b : p.ln2_b) + l * D_MODEL;
  FOR_ITEMS(r, (long)NR) {
    const float* v = p.tmp() + r * D_MODEL; float mu = 0.f;
#pragma unroll 4
    for (int k = 0; k < D_MODEL; ++k) mu += v[k];
    mu /= (float)D_MODEL; float var = 0.f;
#pragma unroll 4
    for (int k = 0; k < D_MODEL; ++k) { float d = v[k] - mu; var += d * d; }
    float rs = 1.0f / sqrtf(var / (float)D_MODEL + LN_EPS);
    const float* m = p.mod() + ((long)l * (BATCH + 1) + modrow(r)) * 6 * D_MODEL + 3 * D_MODEL;
#pragma unroll 2
    for (int k = 0; k < D_MODEL; ++k) {
      float y = (v[k] - mu) * rs * gw[k] + bw[k];
      p.xcur()[r * D_MODEL + k] = y;
      if (which == 0) { float uv = y * (1.0f + m[D_MODEL + k]) + m[k]; p.ubuf()[r * D_MODEL + k] = uv; p.ubf()[r * D_MODEL + k] = f2bf16(uv); }
      if (which == 1 && l == DEPTH - 1 && r < NL) p.out[r * D_MODEL + k] = y;
    }
  }
}
DEV void ph_router(const P& p, int l, long gtid, long gsize) {
  EpiStore e{p.rl(), N_EXPERTS};
  gemm_naive(p.ubuf(), D_MODEL, p.w_router + (long)l * D_MODEL * N_EXPERTS, N_EXPERTS, NR, N_EXPERTS, D_MODEL, e, gtid, gsize);
}
DEV bool better(float v, int i, float bv, int bi) { return v > bv || (v == bv && i < bi); }
DEV void ph_select(const P& p, int l, long gtid, long gsize) {
  FOR_ITEMS(r, (long)NR) {
    const float* lg = p.rl() + r * N_EXPERTS; const float* rb = p.router_bias + l * N_EXPERTS;
    float gs[N_EXPERT_GROUPS];
#pragma unroll
    for (int g = 0; g < N_EXPERT_GROUPS; ++g) {
      float m1 = -1e30f, m2 = -1e30f;
      for (int e = 0; e < EPG; ++e) { float v = sigmoidf_(lg[g * EPG + e]) + rb[g * EPG + e]; if (v > m1) { m2 = m1; m1 = v; } else if (v > m2) m2 = v; }
      gs[g] = m1 + m2;
    }
    unsigned keep = 0;
#pragma unroll
    for (int it = 0; it < TOPK_GROUPS; ++it) {
      float bv = -1e30f; int bi = -1;
#pragma unroll
      for (int g = 0; g < N_EXPERT_GROUPS; ++g) if (!((keep >> g) & 1u) && (bi < 0 || gs[g] > bv)) { bv = gs[g]; bi = g; }
      keep |= 1u << bi;
    }
    float lastv = 1e30f; int lasti = -1; float gsum = 0.f;
    for (int it = 0; it < TOP_K; ++it) {
      float bv = -1e30f; int bi = -1;
      for (int e = 0; e < N_EXPERTS; ++e) {
        if (!((keep >> (e / EPG)) & 1u)) continue;
        float v = sigmoidf_(lg[e]) + rb[e];
        if (!better(lastv, lasti, v, e)) continue;
        if (bi < 0 || better(v, e, bv, bi)) { bv = v; bi = e; }
      }
      lastv = bv; lasti = bi;
      float sc = sigmoidf_(lg[bi]); gsum += sc;
      p.top_e()[r * TOP_K + it] = bi; p.gate()[r * TOP_K + it] = sc;
      p.posb()[r * TOP_K + it] = atomicAdd(&p.cnt()[l * N_EXPERTS + bi], 1);
    }
    float inv = ROUTED_SCALE / gsum;
    for (int it = 0; it < TOP_K; ++it) p.gate()[r * TOP_K + it] *= inv;
  }
}
DEV void ph_sortrows(const P& p, int l, long gtid, long gsize) {
  FOR_ITEMS(i, (long)NR * TOP_K) {
    int e = p.top_e()[i]; int off = 0;
    for (int j = 0; j < e; ++j) off += p.cnt()[l * N_EXPERTS + j];
    p.srow()[off + p.posb()[i]] = (int)i;
  }
}
DEV void ph_expert_up(const P& p, int l, long gtid, long gsize) {
  FOR_ITEMS(i, (long)NR * TOP_K * EXPERT_FF) {
    int cidx = (int)(i % EXPERT_FF); int a = p.srow()[i / EXPERT_FF]; int e = p.top_e()[a]; long r = a / TOP_K;
    const float* xg = p.ubuf() + r * D_MODEL;
    const float* wg = p.w_exp_gate + ((long)l * N_EXPERTS + e) * D_MODEL * EXPERT_FF; const float* wu = p.w_exp_up + ((long)l * N_EXPERTS + e) * D_MODEL * EXPERT_FF;
    float g = 0.f, u = 0.f;
    for (int k = 0; k < D_MODEL; ++k) { float xv = xg[k]; g += xv * wg[(long)k * EXPERT_FF + cidx]; u += xv * wu[(long)k * EXPERT_FF + cidx]; }
    p.hbuf()[(long)a * EXPERT_FF + cidx] = siluf(g) * u;
  }
  FOR_ITEMS(i, (long)NR * SHARED_FF) {
    int cidx = (int)(i % SHARED_FF); long r = i / SHARED_FF;
    const float* xg = p.ubuf() + r * D_MODEL;
    const float* wg = p.w_sh_gate + (long)l * D_MODEL * SHARED_FF; const float* wu = p.w_sh_up + (long)l * D_MODEL * SHARED_FF;
    float g = 0.f, u = 0.f;
    for (int k = 0; k < D_MODEL; ++k) { float xv = xg[k]; g += xv * wg[(long)k * SHARED_FF + cidx]; u += xv * wu[(long)k * SHARED_FF + cidx]; }
    p.hsb()[i] = siluf(g) * u;
  }
}
DEV void ph_expert_down(const P& p, int l, long gtid, long gsize) {
  FOR_ITEMS(i, (long)NR * TOP_K * D_MODEL) {
    int d = (int)(i % D_MODEL); long a = i / D_MODEL;
    int e = p.top_e()[a]; const float* wd = p.w_exp_down + ((long)l * N_EXPERTS + e) * EXPERT_FF * D_MODEL;
    const float* h = p.hbuf() + a * EXPERT_FF; float acc = 0.f;
    for (int cidx = 0; cidx < EXPERT_FF; ++cidx) acc += h[cidx] * wd[(long)cidx * D_MODEL + d];
    p.yk()[i] = acc * p.gate()[a];
  }
  FOR_ITEMS(i, (long)NR * D_MODEL) {
    int d = (int)(i % D_MODEL); long r = i / D_MODEL;
    const float* wsd = p.w_sh_down + (long)l * SHARED_FF * D_MODEL; const float* hs = p.hsb() + r * SHARED_FF;
    float acc = 0.f;
    for (int cidx = 0; cidx < SHARED_FF; ++cidx) acc += hs[cidx] * wsd[(long)cidx * D_MODEL + d];
    p.ysh()[i] = acc;
  }
}
DEV void ph_combine(const P& p, int l, long gtid, long gsize) {
#pragma unroll 1
  FOR_ITEMS(i, (long)NR * D_MODEL) {
    int d = (int)(i % D_MODEL); long r = i / D_MODEL;
    float f = p.ysh()[i];
#pragma unroll
    for (int k = 0; k < TOP_K; ++k) f += p.yk()[(r * TOP_K + k) * D_MODEL + d];
    const float* m = p.mod() + ((long)l * (BATCH + 1) + modrow(r)) * 6 * D_MODEL + 5 * D_MODEL;
    p.tmp()[i] = DN_ALPHA * p.xcur()[i] + m[d] * f;
  }
}
#define NLP 16


#ifndef CPU_TEST
typedef __attribute__((ext_vector_type(8))) short bf16x8;
typedef __attribute__((ext_vector_type(4))) float f32x4;
typedef __attribute__((ext_vector_type(4))) unsigned u32x4;
typedef __attribute__((ext_vector_type(2))) unsigned u32x2;
static_assert(N_EXPERTS == 256 && D_MODEL % 128 == 0 && NR % 128 == 0, "shape assumptions");
#define SM_XB 0
#define NT 512
#define SM_A 256
#define SM_B (256 + 16384)
#define SM_MISC (256 + 114688)
#define SMEM_BYTES (256 + 114688 + 4096)

DEV int otid() { int t = threadIdx.x; asm volatile("" : "+v"(t)); return t; }
typedef __bf16 bf16x2_t __attribute__((ext_vector_type(2)));
typedef float f32x2_t __attribute__((ext_vector_type(2)));
DEV unsigned pack2(float a, float b) { f32x2_t v = {a, b}; return __builtin_bit_cast(unsigned, __builtin_convertvector(v, bf16x2_t)); }
DEV unsigned f2bf(float f) { return pack2(f, 0.f) & 0xffffu; }
DEV int tile_off(int row, int chunk) { return row * 128 + ((chunk ^ ((row >> 1) & 7)) << 4); }

DEV float bflo(float x) { return x - __uint_as_float(f2bf(x) << 16); }
DEV void wt_convert(const float* W, unsigned short* WT, int K, int N, bool lo, long gtid, long gsize) {
  FOR_ITEMS4(i, (long)N * (K / 8)) {
    const int n = (int)(i % N); const int k8 = (int)(i / N) * 8;
    float v[8];
#pragma unroll
    for (int j = 0; j < 8; ++j) { const float x = W[(long)(k8 + j) * N + n]; v[j] = lo ? bflo(x) : x; }
    u32x4 o; o[0] = pack2(v[0], v[1]); o[1] = pack2(v[2], v[3]); o[2] = pack2(v[4], v[5]); o[3] = pack2(v[6], v[7]);
    *(u32x4*)(WT + (long)n * K + k8) = o;
  }
}
DEV void wt_convert_all(const P& p, long gtid, long gsize) {
  for (int l = 0; l < DEPTH; ++l) {
    wt_convert(p.w_in + (long)l * D_MODEL * IN_W, p.wt_in() + (long)l * IN_W * D_MODEL, D_MODEL, IN_W, false, gtid, gsize);
    wt_convert(p.w_out + (long)l * MIX_W * D_MODEL, p.wt_out() + (long)l * D_MODEL * MIX_W, MIX_W, D_MODEL, false, gtid, gsize);
    wt_convert(p.s5_w_glu + (long)l * S5_W * S5_W, p.wt_glu() + (long)l * S5_W * S5_W, S5_W, S5_W, false, gtid, gsize);
    wt_convert(p.w_sh_gate + (long)l * D_MODEL * SHARED_FF, p.wt_shg() + (long)l * SHARED_FF * D_MODEL, D_MODEL, SHARED_FF, false, gtid, gsize);
    wt_convert(p.w_sh_up + (long)l * D_MODEL * SHARED_FF, p.wt_shu() + (long)l * SHARED_FF * D_MODEL, D_MODEL, SHARED_FF, false, gtid, gsize);
    wt_convert(p.w_sh_down + (long)l * SHARED_FF * D_MODEL, p.wt_shd() + (long)l * D_MODEL * SHARED_FF, SHARED_FF, D_MODEL, false, gtid, gsize);
    wt_convert(p.w_router + (long)l * D_MODEL * N_EXPERTS, p.wt_rh() + (long)l * N_EXPERTS * D_MODEL, D_MODEL, N_EXPERTS, false, gtid, gsize);
    wt_convert(p.w_router + (long)l * D_MODEL * N_EXPERTS, p.wt_rl() + (long)l * N_EXPERTS * D_MODEL, D_MODEL, N_EXPERTS, true, gtid, gsize);
  }
}
struct ALRows { const char* base; unsigned off[2]; DEVM const unsigned short* a(int i, int kt) const { return (const unsigned short*)(base + (off[i] + (unsigned)kt * 128u)); } };
struct BLStd { static constexpr bool TR = false; const char* base; unsigned voff; int ldb4; bool valid;
  DEVM void load(float4 (&rb)[8], int kt) const {
#pragma unroll
    for (int i = 0; i < 8; ++i) rb[i] = valid ? *(const float4*)(base + (unsigned)((unsigned)(kt * 64 + i) * (unsigned)ldb4 + voff)) : make_float4(0.f, 0.f, 0.f, 0.f); } };
DEV unsigned bl_voff(int ldb4, int tid) { return (unsigned)((tid & 7) * 8) * (unsigned)ldb4 + (unsigned)((tid >> 3) * 16); }
DEV BLStd mk_bl(const float* B  , int ldb, int tid) {
  BLStd b; b.base = (const char*)B; b.ldb4 = ldb * 4; b.voff = bl_voff(ldb * 4, tid); b.valid = true; return b; }
#define SM_TILE 49152
template <int V = 0, class AL, class BL>
DEV void gemm_t(const AL& al, const BL& bl, int nk, f32x4 (&acc)[4][4], char* smem) {
  const int tid = otid(), lane = tid & 63, wid = tid >> 6, wr = wid >> 2, wc = wid & 3;
  const int l15 = lane & 15, q = lane >> 4, x = l15 >> 1;
  const char* ard0 = smem + SM_A + (wr * 64 + l15) * 128 + ((q ^ x) << 4);
  const char* ard1 = smem + SM_A + (wr * 64 + l15) * 128 + (((4 + q) ^ x) << 4);
  const char* brd0 = smem + SM_B + (wc * 64 + l15) * 128 + ((q ^ x) << 4);
  const char* brd1 = smem + SM_B + (wc * 64 + l15) * 128 + (((4 + q) ^ x) << 4);
  const int kq = tid & 7, nq = tid >> 3;
  char* awr = smem + SM_A + nq * 128 + ((kq ^ ((nq >> 1) & 7)) << 4);
  char* bwr0 = smem + SM_B + (nq * 4) * 128 + ((kq ^ ((2 * nq) & 7)) << 4);
  char* bwr1 = smem + SM_B + (nq * 4 + 2) * 128 + ((kq ^ ((2 * nq + 1) & 7)) << 4);
  if (nk <= 0) return;
  u32x4 ra[2]; float4 rb0[8];
#define GEMM_LOADA(KT) do { _Pragma("unroll") for (int i = 0; i < 2; ++i) ra[i] = *(const u32x4*)(al.a(i, (KT))); } while (0)
#define GEMM_WRITE(rb, PO) do { \
    *(u32x4*)(awr + (PO)) = ra[0]; *(u32x4*)(awr + (PO) + 8192) = ra[1]; \
    if (BL::TR) { u32x4 v; \
      v[0] = pack2(rb[0].x, rb[0].y); v[1] = pack2(rb[0].z, rb[0].w); v[2] = pack2(rb[1].x, rb[1].y); v[3] = pack2(rb[1].z, rb[1].w); *(u32x4*)(bwr0 + (PO)) = v; \
      v[0] = pack2(rb[2].x, rb[2].y); v[1] = pack2(rb[2].z, rb[2].w); v[2] = pack2(rb[3].x, rb[3].y); v[3] = pack2(rb[3].z, rb[3].w); *(u32x4*)(bwr0 + (PO) + 128) = v; \
      v[0] = pack2(rb[4].x, rb[4].y); v[1] = pack2(rb[4].z, rb[4].w); v[2] = pack2(rb[5].x, rb[5].y); v[3] = pack2(rb[5].z, rb[5].w); *(u32x4*)(bwr1 + (PO)) = v; \
      v[0] = pack2(rb[6].x, rb[6].y); v[1] = pack2(rb[6].z, rb[6].w); v[2] = pack2(rb[7].x, rb[7].y); v[3] = pack2(rb[7].z, rb[7].w); *(u32x4*)(bwr1 + (PO) + 128) = v; \
    } else { u32x4 v; \
      v[0] = pack2(rb[0].x, rb[1].x); v[1] = pack2(rb[2].x, rb[3].x); v[2] = pack2(rb[4].x, rb[5].x); v[3] = pack2(rb[6].x, rb[7].x); *(u32x4*)(bwr0 + (PO)) = v; \
      v[0] = pack2(rb[0].y, rb[1].y); v[1] = pack2(rb[2].y, rb[3].y); v[2] = pack2(rb[4].y, rb[5].y); v[3] = pack2(rb[6].y, rb[7].y); *(u32x4*)(bwr0 + (PO) + 128) = v; \
      v[0] = pack2(rb[0].z, rb[1].z); v[1] = pack2(rb[2].z, rb[3].z); v[2] = pack2(rb[4].z, rb[5].z); v[3] = pack2(rb[6].z, rb[7].z); *(u32x4*)(bwr1 + (PO)) = v; \
      v[0] = pack2(rb[0].w, rb[1].w); v[1] = pack2(rb[2].w, rb[3].w); v[2] = pack2(rb[4].w, rb[5].w); v[3] = pack2(rb[6].w, rb[7].w); *(u32x4*)(bwr1 + (PO) + 128) = v; \
    } } while (0)
  GEMM_LOADA(0);
  bl.load(rb0, 0);
  __syncthreads();
  GEMM_WRITE(rb0, 0);
  if (V != 3) { if (nk > 1) { GEMM_LOADA(1); bl.load(rb0, 1); } }
  __syncthreads();
#define GEMM_STEP(rbn, KT) do { \
    const int po = ((KT) & 1) * SM_TILE; \
    bf16x8 fa0[4], fb0[4], fa1[4], fb1[4]; \
    _Pragma("unroll") for (int n = 0; n < 4; ++n) fb0[n] = *(const bf16x8*)(brd0 + po + n * 2048); \
    _Pragma("unroll") for (int m = 0; m < 4; ++m) fa0[m] = *(const bf16x8*)(ard0 + po + m * 2048); \
    _Pragma("unroll") for (int n = 0; n < 4; ++n) fb1[n] = *(const bf16x8*)(brd1 + po + n * 2048); \
    _Pragma("unroll") for (int m = 0; m < 4; ++m) fa1[m] = *(const bf16x8*)(ard1 + po + m * 2048); \
    __builtin_amdgcn_sched_barrier(0);     \
    if ((KT) + 1 < nk) { \
      GEMM_WRITE(rbn, SM_TILE - po); \
      if (V != 3) { if ((KT) + 2 < nk) { GEMM_LOADA((KT) + 2); bl.load(rbn, (KT) + 2); } } \
    } \
    __builtin_amdgcn_sched_barrier(0); \
    if (V != 2) { \
      _Pragma("unroll") for (int m = 0; m < 4; ++m) _Pragma("unroll") for (int n = 0; n < 4; ++n) acc[m][n] = __builtin_amdgcn_mfma_f32_16x16x32_bf16(fa0[m], fb0[n], acc[m][n], 0, 0, 0); \
      _Pragma("unroll") for (int m = 0; m < 4; ++m) _Pragma("unroll") for (int n = 0; n < 4; ++n) acc[m][n] = __builtin_amdgcn_mfma_f32_16x16x32_bf16(fa1[m], fb1[n], acc[m][n], 0, 0, 0); \
    } else { _Pragma("unroll") for (int m = 0; m < 4; ++m) asm volatile("" :: "v"(fa0[m]), "v"(fb0[m]), "v"(fa1[m]), "v"(fb1[m])); } \
    __syncthreads(); \
  } while (0)
  int kt = 0;
#pragma unroll 1
  for (; kt < nk; ++kt) { GEMM_STEP(rb0, kt); }
#undef GEMM_STEP
#undef GEMM_WRITE
#undef GEMM_LOADA
}

struct BLT { const char* base; unsigned voff; unsigned rowb;
  DEVM void load(u32x4 (&rb)[4], int kt) const {
#pragma unroll
    for (int c = 0; c < 4; ++c) rb[c] = *(const u32x4*)(base + (voff + (unsigned)c * rowb + (unsigned)kt * 128u)); } };
DEV BLT mk_blt(const unsigned short* BT  , int K, int tid) {
  BLT b; b.base = (const char*)BT; b.rowb = (unsigned)K * 2u; b.voff = (unsigned)((tid >> 3) * 4) * b.rowb + (unsigned)((tid & 7) * 16); return b; }
template <class AL, class BL>
DEV void gemm_tb(const AL& al, const BL& bl, int nk, f32x4 (&acc)[4][4], char* smem) {
  const int tid = otid(), lane = tid & 63, wid = tid >> 6, wr = wid >> 2, wc = wid & 3;
  const int l15 = lane & 15, q = lane >> 4, x = l15 >> 1;
  const char* ard0 = smem + SM_A + (wr * 64 + l15) * 128 + ((q ^ x) << 4);
  const char* ard1 = smem + SM_A + (wr * 64 + l15) * 128 + (((4 + q) ^ x) << 4);
  const char* brd0 = smem + SM_B + (wc * 64 + l15) * 128 + ((q ^ x) << 4);
  const char* brd1 = smem + SM_B + (wc * 64 + l15) * 128 + (((4 + q) ^ x) << 4);
  const int kq = tid & 7, nq = tid >> 3;
  char* awr = smem + SM_A + nq * 128 + ((kq ^ ((nq >> 1) & 7)) << 4);
  char* bwr0 = smem + SM_B + (nq * 4) * 128 + ((kq ^ ((2 * nq) & 7)) << 4);
  char* bwr1 = smem + SM_B + (nq * 4 + 2) * 128 + ((kq ^ ((2 * nq + 1) & 7)) << 4);
  if (nk <= 0) return;
  u32x4 ra[2]; u32x4 rb0[4], rb1[4];
#define TB_LOADA(KT) do { _Pragma("unroll") for (int i = 0; i < 2; ++i) ra[i] = *(const u32x4*)(al.a(i, (KT))); } while (0)
#define TB_WRITE(rb, PO) do { \
    *(u32x4*)(awr + (PO)) = ra[0]; *(u32x4*)(awr + (PO) + 8192) = ra[1]; \
    *(u32x4*)(bwr0 + (PO)) = rb[0]; *(u32x4*)(bwr0 + (PO) + 128) = rb[1]; *(u32x4*)(bwr1 + (PO)) = rb[2]; *(u32x4*)(bwr1 + (PO) + 128) = rb[3]; } while (0)
  TB_LOADA(0);
  bl.load(rb0, 0);
  if (nk > 1) bl.load(rb1, 1);
  __syncthreads();
  TB_WRITE(rb0, 0);
  if (nk > 1) TB_LOADA(1);
  if (nk > 2) bl.load(rb0, 2);
  __syncthreads();
#define TB_STEP(rbn, KT) do { \
    const int po = ((KT) & 1) * SM_TILE; \
    bf16x8 fa0[4], fb0[4], fa1[4], fb1[4]; \
    _Pragma("unroll") for (int n = 0; n < 4; ++n) fb0[n] = *(const bf16x8*)(brd0 + po + n * 2048); \
    _Pragma("unroll") for (int m = 0; m < 4; ++m) fa0[m] = *(const bf16x8*)(ard0 + po + m * 2048); \
    _Pragma("unroll") for (int n = 0; n < 4; ++n) fb1[n] = *(const bf16x8*)(brd1 + po + n * 2048); \
    _Pragma("unroll") for (int m = 0; m < 4; ++m) fa1[m] = *(const bf16x8*)(ard1 + po + m * 2048); \
    __builtin_amdgcn_sched_barrier(0); \
    if ((KT) + 1 < nk) { \
      TB_WRITE(rbn, SM_TILE - po); \
      if ((KT) + 2 < nk) TB_LOADA((KT) + 2); \
      if ((KT) + 3 < nk) bl.load(rbn, (KT) + 3); \
    } \
    __builtin_amdgcn_sched_barrier(0); \
    _Pragma("unroll") for (int m = 0; m < 4; ++m) _Pragma("unroll") for (int n = 0; n < 4; ++n) acc[m][n] = __builtin_amdgcn_mfma_f32_16x16x32_bf16(fa0[m], fb0[n], acc[m][n], 0, 0, 0); \
    _Pragma("unroll") for (int m = 0; m < 4; ++m) _Pragma("unroll") for (int n = 0; n < 4; ++n) acc[m][n] = __builtin_amdgcn_mfma_f32_16x16x32_bf16(fa1[m], fb1[n], acc[m][n], 0, 0, 0); \
    __syncthreads(); \
  } while (0)
  int kt = 0;
#pragma unroll 1
  for (; kt + 1 < nk; kt += 2) { TB_STEP(rb1, kt); TB_STEP(rb0, kt + 1); }
  if (kt < nk) TB_STEP(rb1, kt);
#undef TB_STEP
#undef TB_WRITE
#undef TB_LOADA
}
DEV void acc_zero(f32x4 (&acc)[4][4]) {
#pragma unroll
  for (int m = 0; m < 4; ++m)
#pragma unroll
    for (int n = 0; n < 4; ++n) acc[m][n] = (f32x4){0.f, 0.f, 0.f, 0.f};
}
#define EPI_BEGIN const int etid = otid();
#define EPI_ROW(m, j) (((etid >> 8) & 1) * 64 + (m) * 16 + ((etid & 63) >> 4) * 4 + (j))
#define EPI_COL(n) (((etid >> 6) & 3) * 64 + (n) * 16 + (etid & 15))

template <class Epi>
DEV void gemm_phase_dense(const unsigned short* A, int lda, const unsigned short* BT, int N, int K, Epi epi, char* smem) {
  const int tid = otid(); const int nct = N >> 8; const int nitems = (NR >> 7) * nct;
  for (int it = blockIdx.x; it < nitems; it += gridDim.x) {
    const int rt = it / nct, ct = it - rt * nct;
    ALRows al; al.base = (const char*)(A + (long)rt * 128 * lda);
#pragma unroll
    for (int i = 0; i < 2; ++i) al.off[i] = (unsigned)(((tid >> 3) + 64 * i) * lda + (tid & 7) * 8) * 2u;
    const BLT bl = mk_blt(BT + (long)ct * 256 * K, K, tid);
    f32x4 acc[4][4]; acc_zero(acc);
    gemm_tb(al, bl, K >> 6, acc, smem);
    EPI_BEGIN
#pragma unroll
    for (int m = 0; m < 4; ++m)
#pragma unroll
      for (int n = 0; n < 4; ++n)
#pragma unroll
        for (int j = 0; j < 4; ++j) epi((long)rt * 128 + EPI_ROW(m, j), ct * 256 + EPI_COL(n), acc[m][n][j]);
  }
}
DEV void ph_proj_mfma(const P& p, int l, char* smem) {
  const int tid = otid(); const int nct = IN_W >> 8; const int nitems = (NR >> 7) * nct;
  const float* B = p.w_in + (long)l * D_MODEL * IN_W;
  for (int it = blockIdx.x; it < nitems; it += gridDim.x) {
    const int rt = it / nct, ct = it - rt * nct;
    ALRows al; al.base = (const char*)(p.ubf() + (long)rt * 128 * D_MODEL);
#pragma unroll
    for (int i = 0; i < 2; ++i) al.off[i] = (unsigned)(((tid >> 3) + 64 * i) * D_MODEL + (tid & 7) * 8) * 2u;
    const BLT bl = mk_blt(p.wt_in() + ((long)l * IN_W + ct * 256) * D_MODEL, D_MODEL, tid);
    f32x4 acc[4][4]; acc_zero(acc);
    gemm_tb(al, bl, D_MODEL >> 6, acc, smem);
    EPI_BEGIN
    if (ct >= HY_OFF / 256 && ct < S5_OFF / 256) {
      const bool isctx = rt >= NL / 128;
      const int rloc = (isctx ? (rt - NL / 128) : rt) * 128;
      const int Ls = isctx ? CTX_LEN : SEQ; const int b = rloc / Ls; const int t0 = rloc - b * Ls;
      float* zb = p.zT() + (isctx ? (size_t)BATCH * 3 * HYENA_W * SEQ : (size_t)0) + (size_t)b * 3 * HYENA_W * Ls;
#pragma unroll
      for (int m = 0; m < 4; ++m)
#pragma unroll
        for (int n = 0; n < 4; ++n) {
          const int c = ct * 256 + EPI_COL(n) - HY_OFF; const int t = t0 + EPI_ROW(m, 0);
          *(float4*)(zb + (size_t)c * Ls + t) = make_float4(acc[m][n][0], acc[m][n][1], acc[m][n][2], acc[m][n][3]);
        }
    } else if (ct == S5_OFF / 256) {
#pragma unroll
      for (int m = 0; m < 4; ++m)
#pragma unroll
        for (int n = 0; n < 4; ++n)
#pragma unroll
          for (int j = 0; j < 4; ++j) p.s5u()[((long)rt * 128 + EPI_ROW(m, j)) * S5_W + EPI_COL(n)] = (unsigned short)f2bf(acc[m][n][j]);
    } else {
      const int head = ct * 4 + ((etid >> 6) & 3);
      const bool isq = head < N_Q_HEADS, dorope = head < N_Q_HEADS + N_KV_HEADS && rt < NL / 128;
      const float qs = isq ? 0.125f * 1.4426950408889634f : 1.0f;
      const int c16 = etid & 15;
#pragma unroll
      for (int m = 0; m < 4; ++m)
#pragma unroll
        for (int j = 0; j < 4; ++j) {
          const long row = (long)rt * 128 + EPI_ROW(m, j);
          float v0 = acc[m][0][j], v1 = acc[m][1][j], v2 = acc[m][2][j], v3 = acc[m][3][j];
          if (dorope) {
            const int t = (int)(row % SEQ);
            const float2 cr = p.ropet()[(t / GRID_W) * ROPE_HALF + c16], cc = p.ropet()[(t % GRID_W) * ROPE_HALF + c16];
            const float a0 = v0 * cr.x - v1 * cr.y, a1 = v0 * cr.y + v1 * cr.x, a2 = v2 * cc.x - v3 * cc.y, a3 = v2 * cc.y + v3 * cc.x;
            v0 = a0; v1 = a1; v2 = a2; v3 = a3;
          }
          unsigned short* dst = p.qkvb() + row * HY_OFF + head * HEAD_DIM + c16;
          dst[0] = (unsigned short)f2bf(v0 * qs); dst[16] = (unsigned short)f2bf(v1 * qs); dst[32] = (unsigned short)f2bf(v2 * qs); dst[48] = (unsigned short)f2bf(v3 * qs);
        }
    }
  }
}
DEV void ph_hyena_pre_gpu(const P& p, int l, long gtid, long gsize) {
  const float* sw = p.hy_short_w + l * 3 * 3 * HYENA_W; const float* sb = p.hy_short_b + l * 3 * HYENA_W;
  FOR_ITEMS4(i, (long)BATCH * HYENA_W * (SEQ + CTX_LEN)) {
    const bool isctx = i >= (long)BATCH * HYENA_W * SEQ; const long ii = isctx ? i - (long)BATCH * HYENA_W * SEQ : i;
    const int Ls = isctx ? CTX_LEN : SEQ; const int t = (int)(ii % Ls); const int ch = (int)((ii / Ls) % HYENA_W); const int b = (int)(ii / ((long)Ls * HYENA_W));
    const float* zb = p.zT() + (isctx ? (size_t)BATCH * 3 * HYENA_W * SEQ : (size_t)0) + (size_t)b * 3 * HYENA_W * Ls;
    float z[3];
#pragma unroll
    for (int part = 0; part < 3; ++part) {
      const int cc = part * HYENA_W + ch; const float* zr = zb + (size_t)cc * Ls; float acc = sb[cc];
      if (t > 0) acc += zr[t - 1] * sw[cc];
      acc += zr[t] * sw[3 * HYENA_W + cc];
      if (t + 1 < Ls) acc += zr[t + 1] * sw[2 * 3 * HYENA_W + cc];
      z[part] = acc;
    }
    const long o = isctx ? ((long)NL + b * CTX_LEN + t) * HYENA_W + ch : ((long)b * HYENA_W + ch) * SEQ + t;
    p.hu()[o] = z[0] * z[1]; p.hx0()[o] = z[2];
  }
}
DEV void rms_rows(const P& p, int l, long r0, long r1, int w0, int nw);
DEV void ph_glu_mfma(const P& p, int l, char* smem) {
  const int tid = otid();
  for (int rt = blockIdx.x; rt < (NR >> 7); rt += gridDim.x) {
    ALRows al; al.base = (const char*)(p.ybf() + (long)rt * 128 * S5_W);
#pragma unroll
    for (int i = 0; i < 2; ++i) al.off[i] = (unsigned)(((tid >> 3) + 64 * i) * S5_W + (tid & 7) * 8) * 2u;
    const BLT bl = mk_blt(p.wt_glu() + (long)l * S5_W * S5_W, S5_W, tid);
    f32x4 acc[4][4]; acc_zero(acc);
    gemm_tb(al, bl, S5_W >> 6, acc, smem);
    EPI_BEGIN
#pragma unroll
    for (int m = 0; m < 4; ++m)
#pragma unroll
      for (int n = 0; n < 4; ++n)
#pragma unroll
        for (int j = 0; j < 4; ++j) {
          const long r = (long)rt * 128 + EPI_ROW(m, j); const int c = EPI_COL(n);
          p.mixb()[r * MIX_W + ATTN_W + HYENA_W + c] = __uint_as_float((unsigned)p.ybf()[r * S5_W + c] << 16) * sigmoidf_(acc[m][n][j]);
        }
    asm volatile("s_waitcnt vmcnt(0)" ::: "memory");
    __syncthreads();
    rms_rows(p, l, (long)rt * 128, (long)rt * 128 + 128, otid() >> 6, NT / 64);
  }
}
DEV void ph_outproj_mfma(const P& p, int l, char* smem) {
  EpiRes e{p.xcur(), p.mod(), l, 2 * D_MODEL, p.tmp()};
  gemm_phase_dense(p.mixbf(), MIX_W, p.wt_out() + (long)l * D_MODEL * MIX_W, D_MODEL, MIX_W, e, smem);
}

#define M3_ROWS 320
struct ALRows5 { const char* base; unsigned off[5]; DEVM const unsigned short* a(int i, int kt) const { return (const unsigned short*)(base + (off[i] + (unsigned)kt * 128u)); } };
struct BLStd4 { const char* base; unsigned voff; int ldb4;
  DEVM void load(float4 (&rb)[4], int kt) const {
    unsigned vo = voff; asm volatile("" : "+v"(vo));
#pragma unroll
    for (int i = 0; i < 4; ++i) rb[i] = *(const float4*)(base + (unsigned)((unsigned)(kt * 64 + i) * (unsigned)ldb4 + vo)); } };
#define SM_B3 (SM_A + 40960)
#define SM_TILE3 57344
template <class AL, class BL>
DEV void gemm_m3(const AL& al, const BL& bl, int nk, int nrows, f32x4 (&acc)[5][4], char* smem) {
  const int tid = otid(), lane = tid & 63, wid = tid >> 6, wr = wid >> 1, wc = wid & 1;
  const int l15 = lane & 15, q = lane >> 4, x = l15 >> 1;
  const bool has5 = __builtin_amdgcn_readfirstlane((int)(nrows > 256 + 16 * wr)) != 0;
  const char* ard0 = smem + SM_A + (wr * 16 + l15) * 128 + ((q ^ x) << 4);
  const char* ard1 = smem + SM_A + (wr * 16 + l15) * 128 + (((4 + q) ^ x) << 4);
  const char* brd0 = smem + SM_B3 + (wc * 64 + l15) * 128 + ((q ^ x) << 4);
  const char* brd1 = smem + SM_B3 + (wc * 64 + l15) * 128 + (((4 + q) ^ x) << 4);
  const int kq = tid & 7, ar = tid >> 3, nq = (tid >> 3) & 31, kh = tid >> 8;
  char* awr = smem + SM_A + ar * 128 + ((kq ^ ((ar >> 1) & 7)) << 4);
  char* bwr0 = smem + SM_B3 + (nq * 4) * 128 + ((kq ^ ((2 * nq) & 7)) << 4) + kh * 8;
  char* bwr1 = smem + SM_B3 + (nq * 4 + 2) * 128 + ((kq ^ ((2 * nq + 1) & 7)) << 4) + kh * 8;
  u32x4 ra[5]; float4 rb0[4];
#define M3_LOADA(KT) do { _Pragma("unroll") for (int i = 0; i < 5; ++i) ra[i] = *(const u32x4*)(al.a(i, (KT))); } while (0)
#define M3_WRITE(rb, PO) do { \
    _Pragma("unroll") for (int i = 0; i < 5; ++i) *(u32x4*)(awr + (PO) + 8192 * i) = ra[i]; \
    { u32x2 v; \
      v[0] = pack2(rb[0].x, rb[1].x); v[1] = pack2(rb[2].x, rb[3].x); *(u32x2*)(bwr0 + (PO)) = v; \
      v[0] = pack2(rb[0].y, rb[1].y); v[1] = pack2(rb[2].y, rb[3].y); *(u32x2*)(bwr0 + (PO) + 128) = v; \
      v[0] = pack2(rb[0].z, rb[1].z); v[1] = pack2(rb[2].z, rb[3].z); *(u32x2*)(bwr1 + (PO)) = v; \
      v[0] = pack2(rb[0].w, rb[1].w); v[1] = pack2(rb[2].w, rb[3].w); *(u32x2*)(bwr1 + (PO) + 128) = v; } } while (0)
  M3_LOADA(0);
  bl.load(rb0, 0);
  __syncthreads();
  M3_WRITE(rb0, 0);
  if (nk > 1) { M3_LOADA(1); bl.load(rb0, 1); }
  __builtin_amdgcn_sched_barrier(0);
#pragma unroll
  for (int m = 0; m < 5; ++m)
#pragma unroll
    for (int n = 0; n < 4; ++n) acc[m][n] = f32x4{0.f, 0.f, 0.f, 0.f};
  __syncthreads();
#define M3_MMA(fa, fb) do { \
    _Pragma("unroll") for (int m = 0; m < 4; ++m) _Pragma("unroll") for (int n = 0; n < 4; ++n) acc[m][n] = __builtin_amdgcn_mfma_f32_16x16x32_bf16(fa[m], fb[n], acc[m][n], 0, 0, 0); \
    if (has5) { _Pragma("unroll") for (int n = 0; n < 4; ++n) acc[4][n] = __builtin_amdgcn_mfma_f32_16x16x32_bf16(fa[4], fb[n], acc[4][n], 0, 0, 0); } } while (0)
#define M3_STEP(rbn, KT) do { \
    const int po = ((KT) & 1) * SM_TILE3; \
    bf16x8 fa0[5], fb0[4], fa1[5], fb1[4]; \
    _Pragma("unroll") for (int n = 0; n < 4; ++n) fb0[n] = *(const bf16x8*)(brd0 + po + n * 2048); \
    _Pragma("unroll") for (int m = 0; m < 5; ++m) fa0[m] = *(const bf16x8*)(ard0 + po + m * 8192); \
    __builtin_amdgcn_sched_barrier(0); \
    if ((KT) + 1 < nk) { \
      M3_WRITE(rbn, SM_TILE3 - po); \
      if ((KT) + 2 < nk) { M3_LOADA((KT) + 2); bl.load(rbn, (KT) + 2); } \
    } \
    __builtin_amdgcn_sched_barrier(0); \
    _Pragma("unroll") for (int n = 0; n < 4; ++n) fb1[n] = *(const bf16x8*)(brd1 + po + n * 2048); \
    _Pragma("unroll") for (int m = 0; m < 5; ++m) fa1[m] = *(const bf16x8*)(ard1 + po + m * 8192); \
    M3_MMA(fa0, fb0); \
    M3_MMA(fa1, fb1); \
    __syncthreads(); \
  } while (0)
  int kt = 0;
#pragma unroll 1
  for (; kt + 1 < nk; kt += 2) { M3_STEP(rb0, kt); M3_STEP(rb0, kt + 1); }
  if (kt < nk) M3_STEP(rb0, kt);
#undef M3_STEP
#undef M3_MMA
#undef M3_WRITE
#undef M3_LOADA
}
#define EPI3_ROW(m, j) ((((etid >> 7) & 3) + 4 * (m)) * 16 + ((etid & 63) >> 4) * 4 + (j))
#define EPI2_COL(n) (((etid >> 6) & 1) * 64 + (n) * 16 + (etid & 15))
#define EXP_ITEM(tile) \
    const int e = __builtin_amdgcn_readfirstlane(exp_find(toff, (tile))); const int tle_ = toff[e + 1] - toff[e]; \
    const int rpt_ = (((roff[e] + tle_ - 1) / tle_) + 15) & ~15; const int j0 = ((tile) - toff[e]) * rpt_; \
    const int nrows = min(rpt_, roff[e] - j0); \
    if (nrows <= 0) continue;
DEV void exp_prefix(const P& p, int l, int* toff, int* roff, int* rowo) {
  const int tid = otid(), lane = tid & 63, w = tid >> 6;
  __syncthreads();
  int c = 0, tl = 0, incl = 0, rinc = 0;
  int* wsum = roff + N_EXPERTS + 8;
  if (tid < N_EXPERTS) {
    c = p.cnt()[l * N_EXPERTS + tid];
    tl = (c + M3_ROWS - 1) / M3_ROWS; incl = tl; rinc = c;
#pragma unroll
    for (int o = 1; o < 64; o <<= 1) { const int v = __shfl_up(incl, o), v2 = __shfl_up(rinc, o); if (lane >= o) { incl += v; rinc += v2; } }
    if (lane == 63) { wsum[w] = incl; wsum[4 + w] = rinc; }
    roff[tid] = c;
  }
  __syncthreads();
  if (tid < N_EXPERTS) {
    int base = 0, rb = 0;
#pragma unroll
    for (int k = 0; k < 4; ++k) if (k < w) { base += wsum[k]; rb += wsum[4 + k]; }
    toff[tid] = base + incl - tl;
    rowo[tid] = rb + rinc - c;
    if (tid == N_EXPERTS - 1) toff[N_EXPERTS] = base + incl;
  }
  __syncthreads();
}
#define EXP_TABLES int* toff = (int*)(smem + SM_MISC); int* roff = toff + N_EXPERTS + 1; int* rowo = roff + N_EXPERTS + 16;
DEV int exp_find(const int* toff, int tile) {
  int lo = 0, hi = N_EXPERTS - 1;
  while (lo < hi) { int mid = (lo + hi + 1) >> 1; if (toff[mid] <= tile) lo = mid; else hi = mid - 1; }
  return lo;
}
template <int V = 0>
DEV void upgate_tile(const ALRows& al, const float* wg, const float* wu, int cq, f32x4 (&acc)[4][4], char* smem, int tid) {
  const int nq = tid >> 3; const int wsel = __builtin_amdgcn_readfirstlane(tid >> 6) & 1;
  BLStd bl; bl.base = (const char*)((wsel ? wu : wg) + cq * 128); bl.ldb4 = EXPERT_FF * 4; bl.valid = true;
  bl.voff = (unsigned)((tid & 7) * 8) * (unsigned)(EXPERT_FF * 4) + (unsigned)(((nq >> 4) * 32 + (nq & 7) * 4) * 4);
  acc_zero(acc);
  gemm_t<V>(al, bl, D_MODEL >> 6, acc, smem);
}
static_assert(EXPERT_FF == 256 && SHARED_FF == 256, "ff tiling");
template <int V = 0>
DEV void ph_expert_up_mfma(const P& p, int l, char* smem) {
  const int tid = otid();
  EXP_TABLES
  exp_prefix(p, l, toff, roff, rowo);
  const int n_tiles = toff[N_EXPERTS];
  const int n_items = ((n_tiles + 15) >> 4) * 64;
  for (int it = blockIdx.x; it < n_items; it += gridDim.x) {
    const int r8 = it & 7, s8 = it >> 3, tile = 2 * (8 * (s8 >> 3) + r8) + ((s8 >> 2) & 1), cq = s8 & 3;
    if (tile >= n_tiles) continue;
    EXP_ITEM(tile)
    const int tid = otid();
    const int rbase = e * NR + j0, crow0 = rowo[e] + j0;
    const float* wg = p.w_exp_gate + ((long)l * N_EXPERTS + e) * D_MODEL * EXPERT_FF; const float* wu = p.w_exp_up + ((long)l * N_EXPERTS + e) * D_MODEL * EXPERT_FF;
    ALRows5 al; al.base = (const char*)p.ubf();
#pragma unroll
    for (int i = 0; i < 5; ++i) { const int rl = min((tid >> 3) + 64 * i, nrows - 1); al.off[i] = ((unsigned)(p.elist()[rbase + rl] / TOP_K) * D_MODEL + (tid & 7) * 8) * 2u; }
    const int nq = (tid >> 3) & 31; const int wsel = __builtin_amdgcn_readfirstlane(tid >> 6) & 1;
    BLStd4 bl; bl.base = (const char*)((wsel ? wu : wg) + cq * 64); bl.ldb4 = EXPERT_FF * 4;
    bl.voff = (unsigned)((tid & 7) * 8 + (tid >> 8) * 4) * (unsigned)(EXPERT_FF * 4) + (unsigned)(((nq >> 4) * 32 + (nq & 7) * 4) * 4);
    f32x4 acc[5][4];
    gemm_m3(al, bl, D_MODEL >> 6, nrows, acc, smem);
    EPI_BEGIN
    const int ewc = (etid >> 6) & 1, ec = etid & 15;
#pragma unroll
    for (int m = 0; m < 5; ++m)
#pragma unroll
      for (int j = 0; j < 4; ++j) {
        const int rl = EPI3_ROW(m, j);
        if (rl < nrows) {
          const float gsc = p.egate()[rbase + rl];
          unsigned short* dst = p.hbf() + (long)(crow0 + rl) * EXPERT_FF + cq * 64 + ewc * 32 + ec;
          dst[0] = (unsigned short)f2bf(siluq(acc[m][0][j]) * acc[m][2][j] * gsc); dst[16] = (unsigned short)f2bf(siluq(acc[m][1][j]) * acc[m][3][j] * gsc);
        }
      }
  }
}
DEV void ph_expert_down_mfma(const P& p, int l, char* smem) {
  const int tid = otid();
  EXP_TABLES
  exp_prefix(p, l, toff, roff, rowo);
  const int NC8 = D_MODEL / 128;
  const int n_tiles = toff[N_EXPERTS];
  const int n_exp_items = ((n_tiles + 15) >> 4) * 128;
  for (int it = blockIdx.x; it < n_exp_items; it += gridDim.x) {
    const int r8 = it & 7, s8 = it >> 3, tile = 2 * (8 * (s8 >> 4) + r8) + ((s8 >> 3) & 1), ct = s8 & 7;
    if (tile >= n_tiles) continue;
    EXP_ITEM(tile)
    const int tid = otid();
    const int crow0 = rowo[e] + j0;
    const float* wd = p.w_exp_down + ((long)l * N_EXPERTS + e) * EXPERT_FF * D_MODEL;
    ALRows5 al; al.base = (const char*)p.hbf();
#pragma unroll
    for (int i = 0; i < 5; ++i) { const int rl = min((tid >> 3) + 64 * i, nrows - 1); al.off[i] = ((unsigned)(crow0 + rl) * EXPERT_FF + (tid & 7) * 8) * 2u; }
    BLStd4 bl; bl.base = (const char*)(wd + ct * 128); bl.ldb4 = D_MODEL * 4;
    bl.voff = (unsigned)((tid & 7) * 8 + (tid >> 8) * 4) * (unsigned)(D_MODEL * 4) + (unsigned)(((tid >> 3) & 31) * 16);
    f32x4 acc[5][4];
    gemm_m3(al, bl, EXPERT_FF >> 6, nrows, acc, smem);
    EPI_BEGIN
#pragma unroll
    for (int m = 0; m < 5; ++m)
#pragma unroll
      for (int j = 0; j < 4; ++j) {
        const int rl = EPI3_ROW(m, j);
        if (rl < nrows) {
          unsigned short* dst = p.ykb() + (long)(crow0 + rl) * D_MODEL + ct * 128;
#pragma unroll
          for (int n = 0; n < 4; ++n) dst[EPI2_COL(n)] = (unsigned short)f2bf(acc[m][n][j]);
        }
      }
  }
  const int NCT = D_MODEL / 256;
  const int n_sh_items = (NR >> 7) * NCT;
  for (int it = (int)gridDim.x - 1 - (int)blockIdx.x; it < n_sh_items; it += gridDim.x) {
    const int rt = it / NCT, ct = it - rt * NCT;
    ALRows al; al.base = (const char*)(p.hsbf() + (long)rt * 128 * SHARED_FF);
#pragma unroll
    for (int i = 0; i < 2; ++i) al.off[i] = (unsigned)(((tid >> 3) + 64 * i) * SHARED_FF + (tid & 7) * 8) * 2u;
    const BLT bl = mk_blt(p.wt_shd() + ((long)l * D_MODEL + ct * 256) * SHARED_FF, SHARED_FF, tid);
    f32x4 acc[4][4]; acc_zero(acc);
    gemm_tb(al, bl, SHARED_FF >> 6, acc, smem);
    EPI_BEGIN
#pragma unroll
    for (int m = 0; m < 4; ++m)
#pragma unroll
      for (int n = 0; n < 4; ++n)
#pragma unroll
        for (int j = 0; j < 4; ++j) p.ysh()[((long)rt * 128 + EPI_ROW(m, j)) * D_MODEL + ct * 256 + EPI_COL(n)] = acc[m][n][j];
  }
}

typedef __attribute__((ext_vector_type(16))) float f32x16;
#define SM_HR 256
#define UB_STRIDE 8272
#define SM_HU (256 + 32768)
#define SMEM_HY (256 + 32768 + 2 * UB_STRIDE * 2)
static_assert(SEQ == 8192 && HYENA_W == 256, "hyena mfma shape");
DEV void ph_hyena_mfma(const P& p, int l, char* smem) {
  const int tid = otid(), lane = tid & 63, w = tid >> 6;
  unsigned short* R = (unsigned short*)(smem + SM_HR); unsigned short* U = (unsigned short*)(smem + SM_HU);
  for (int ch = blockIdx.x; ch < HYENA_W; ch += gridDim.x) {
    __syncthreads();
    const float* kf = p.kraw() + ((long)l * 2 * HYENA_W + ch) * SEQ; const float* kb = p.kraw() + ((long)l * 2 * HYENA_W + HYENA_W + ch) * SEQ;
    {
      float4 fa[2][2]; float fx[2]; float4 ba[2][2];
#pragma unroll
      for (int i = 0; i < 2; ++i) {
        const int base = 8 * (1024 - (tid + 512 * i));
        fa[i][0] = *(const float4*)(kf + base - 8); fa[i][1] = *(const float4*)(kf + base - 4); fx[i] = base < SEQ ? kf[base] : 0.f;
      }
#pragma unroll
      for (int i = 0; i < 2; ++i) {
        const int o = 8 * (tid + 512 * i);
        ba[i][0] = *(const float4*)(kb + o); ba[i][1] = *(const float4*)(kb + o + 4);
      }
      const float kf0 = kf[0];
#pragma unroll
      for (int i = 0; i < 2; ++i) {
        const int C = tid + 512 * i; u32x4 v;
        v[0] = pack2(fx[i], fa[i][1].w); v[1] = pack2(fa[i][1].z, fa[i][1].y); v[2] = pack2(fa[i][1].x, fa[i][0].w); v[3] = pack2(fa[i][0].z, fa[i][0].y);
        *(u32x4*)((char*)R + ((C ^ ((C >> 4) & 1)) << 4)) = v;
      }
#pragma unroll
      for (int i = 0; i < 2; ++i) {
        const int C = 1024 + tid + 512 * i; u32x4 v;
        v[0] = pack2((i == 0 && tid == 0) ? kf0 : ba[i][0].x, ba[i][0].y); v[1] = pack2(ba[i][0].z, ba[i][0].w); v[2] = pack2(ba[i][1].x, ba[i][1].y); v[3] = pack2(ba[i][1].z, ba[i][1].w);
        *(u32x4*)((char*)R + ((C ^ ((C >> 4) & 1)) << 4)) = v;
      }
      __builtin_amdgcn_sched_barrier(0);
      float4 ua[5][2];
#pragma unroll
      for (int i = 0; i < 5; ++i) {
        const int cc = tid + 512 * i; const int b = cc >= (UB_STRIDE / 8) ? 1 : 0; const int c = cc - b * (UB_STRIDE / 8);
        const bool ok = cc < 2 * (UB_STRIDE / 8) && c >= 2 && c < 2 + SEQ / 8;
        const float* src = p.hu() + ((long)b * HYENA_W + ch) * SEQ + (ok ? 8 * c - 16 : 0);
        ua[i][0] = ok ? *(const float4*)src : make_float4(0.f, 0.f, 0.f, 0.f); ua[i][1] = ok ? *(const float4*)(src + 4) : make_float4(0.f, 0.f, 0.f, 0.f);
      }
#pragma unroll
      for (int i = 0; i < 5; ++i) {
        const int cc = tid + 512 * i;
        if (cc < 2 * (UB_STRIDE / 8)) {
          u32x4 v; v[0] = pack2(ua[i][0].x, ua[i][0].y); v[1] = pack2(ua[i][0].z, ua[i][0].w); v[2] = pack2(ua[i][1].x, ua[i][1].y); v[3] = pack2(ua[i][1].z, ua[i][1].w);
          *(u32x4*)((char*)U + cc * 16) = v;
        }
      }
    }
    __syncthreads();
    f32x16 acc[2];
#pragma unroll
    for (int mi = 0; mi < 2; ++mi)
#pragma unroll
      for (int k = 0; k < 16; ++k) acc[mi][k] = 0.f;
    const int r = lane & 31, h = lane >> 5, sig = lane & 15, bb = (lane >> 4) & 1;
    const unsigned* Ud = (const unsigned*)U + bb * (UB_STRIDE / 2);
    const int ub0 = 8 * h + sig;
    const int cbase = 1022 - 64 * (2 * w) - 2 * r + h;
    const bool odd = sig & 1;
#define HY_LOAD(AF, D, Q) do { const int qq_ = (Q); \
      _Pragma("unroll") for (int mi = 0; mi < 2; ++mi) { const int C = cbase - 64 * mi + 2 * qq_; AF[mi] = *(const bf16x8*)((const char*)R + ((C ^ ((C >> 4) & 1)) << 4)); } \
      const int di_ = (16 * qq_ + ub0) >> 1; \
      _Pragma("unroll") for (int i = 0; i < 5; ++i) D[i] = Ud[di_ + i]; } while (0)
#define HY_MMA(AF, D) do { u32x4 bw_; \
      _Pragma("unroll") for (int i = 0; i < 4; ++i) bw_[i] = odd ? __builtin_amdgcn_alignbit(D[i + 1], D[i], 16) : D[i]; \
      const bf16x8 bfr_ = __builtin_bit_cast(bf16x8, bw_); \
      _Pragma("unroll") for (int mi = 0; mi < 2; ++mi) acc[mi] = __builtin_amdgcn_mfma_f32_32x32x16_bf16(AF[mi], bfr_, acc[mi], 0, 0, 0); } while (0)
    bf16x8 a0[2], a1[2], a2[2], a3[2]; unsigned d0[5], d1[5], d2[5], d3[5];
    HY_LOAD(a0, d0, 0); HY_LOAD(a1, d1, 1); HY_LOAD(a2, d2, 2); HY_LOAD(a3, d3, 3);
    static_assert((SEQ / 16) % 4 == 0, "hyena k-tiles");
#pragma unroll 1
    for (int q = 0; q < SEQ / 16; q += 4) {
      HY_MMA(a0, d0); HY_LOAD(a0, d0, min(q + 4, SEQ / 16));
      HY_MMA(a1, d1); HY_LOAD(a1, d1, min(q + 5, SEQ / 16));
      HY_MMA(a2, d2); HY_LOAD(a2, d2, min(q + 6, SEQ / 16));
      HY_MMA(a3, d3); HY_LOAD(a3, d3, min(q + 7, SEQ / 16));
    }
    HY_MMA(a0, d0);
#undef HY_LOAD
#undef HY_MMA
    __syncthreads();
    {
      float* Y = (float*)(smem + SM_HR);
      float* yl = Y + bb * SEQ + 16 * (32 * (2 * w) + 4 * h) + sig;
#pragma unroll
      for (int mi = 0; mi < 2; ++mi)
#pragma unroll
        for (int k = 0; k < 16; ++k) yl[16 * (32 * mi + (k & 3) + 8 * (k >> 2))] = acc[mi][k];
    }
    __syncthreads();
    {
      const float* Y = (const float*)(smem + SM_HR);
      const float kn = p.knorm()[l * HYENA_W + ch], dsk = p.hy_d[l * HYENA_W + ch];
      static_assert(BATCH * SEQ == NT * 32, "hyena epilogue shape");
#pragma unroll 1
      for (int hh = 0; hh < 2; ++hh) {
        float4 uu[4], xx[4], yy[4];
#pragma unroll
        for (int i = 0; i < 4; ++i) {
          const int idx = 4 * (tid + NT * (4 * hh + i)); const int b = idx / SEQ, t = idx - b * SEQ;
          const long o = ((long)b * HYENA_W + ch) * SEQ + t;
          uu[i] = *(const float4*)(p.hu() + o); xx[i] = *(const float4*)(p.hx0() + o); yy[i] = *(const float4*)(Y + idx);
        }
#pragma unroll
        for (int i = 0; i < 4; ++i) {
          const int idx = 4 * (tid + NT * (4 * hh + i));
          float* dst = p.mixb() + (long)idx * MIX_W + ATTN_W + ch;
          dst[0] = (yy[i].x * kn + uu[i].x * dsk) * xx[i].x; dst[MIX_W] = (yy[i].y * kn + uu[i].y * dsk) * xx[i].y;
          dst[2 * MIX_W] = (yy[i].z * kn + uu[i].z * dsk) * xx[i].z; dst[3 * MIX_W] = (yy[i].w * kn + uu[i].w * dsk) * xx[i].w;
        }
      }
    }
  }
}
#define SM_K 256
#define SM_V (256 + 8192)
static_assert(HEAD_DIM == 64 && WINDOW == 128 && CTX_LEN == 256 && Q_GROUP == 4, "attention shape");
DEV void ph_attn_mfma(const P& p, int l, char* smem) {
  const int tid = otid(), lane = tid & 63, w = (tid >> 6) & 3, hsel = tid >> 8, h = lane >> 5, ql = lane & 31;
  char* Ks = smem + SM_K; char* Vs = smem + SM_V;
  const int n_lat = BATCH * (SEQ / 128) * N_KV_HEADS * (Q_GROUP / 2);
  const int n_ctx = (l == 0) ? BATCH * (CTX_LEN / 128) * N_KV_HEADS * (Q_GROUP / 2) : 0;
  const float QS = 0.125f * 1.4426950408889634f;
  for (int it = blockIdx.x; it < n_lat + n_ctx; it += gridDim.x) {
    const bool isctx = it >= n_lat;
    int b, qb, kvh, g;
    { int x = isctx ? it - n_lat : it; g = (x & 1) * 2 + hsel; kvh = (x >> 1) & 1; x >>= 2; if (isctx) { qb = x & 1; b = x >> 1; } else { qb = x & 63; b = x >> 6; } }
    const int hq = kvh * Q_GROUP + g;
    const int tq0 = qb * 128 + 32 * w;
    const long qrow = (isctx ? (long)NL + b * CTX_LEN : (long)b * SEQ) + tq0 + ql;
    bf16x8 qf[4];
    {
      const unsigned short* qp = p.qkvb() + qrow * HY_OFF + Q_OFF + hq * HEAD_DIM + 8 * h;
#pragma unroll
      for (int ks = 0; ks < 4; ++ks) qf[ks] = *(const bf16x8*)(qp + 16 * ks);
    }
    f32x16 o0, o1;
#pragma unroll
    for (int k = 0; k < 16; ++k) { o0[k] = 0.f; o1[k] = 0.f; }
    float m = -1e30f, lsum = 0.f;
    const int nsteps = isctx ? 4 : 10;
    u32x4 rk[1], rv[1];
    auto key_row = [&](int step, int key) -> long {
      if (step < 4) return (long)NL + b * CTX_LEN + step * 64 + key;
      const int tk = qb * 128 - 128 + (step - 4) * 64 + key;
      return (tk < 0 || tk >= SEQ) ? -1 : (long)b * SEQ + tk;
    };
    auto step_valid = [&](int step) -> bool { if (step < 4) return true; const int t0 = qb * 128 - 128 + (step - 4) * 64; return t0 >= 0 && t0 < SEQ; };
    auto load_tile = [&](int step) {
#pragma unroll
      for (int i = 0; i < 1; ++i) {
        const int key = (tid >> 3); const long kr = key_row(step, key);
        const unsigned short* kp = p.qkvb() + kr * HY_OFF + K_OFF + kvh * HEAD_DIM + (tid & 7) * 8; const unsigned short* vp = p.qkvb() + kr * HY_OFF + V_OFF + kvh * HEAD_DIM + (tid & 7) * 8;
        rk[i] = *(const u32x4*)kp; rv[i] = *(const u32x4*)vp;
      }
    };
    int step = 0;
    load_tile(0);
    while (step < nsteps) {
      __syncthreads();
#pragma unroll
      for (int i = 0; i < 1; ++i) {
        const int key = (tid >> 3), ch = tid & 7;
        *(u32x4*)(Ks + tile_off(key, ch)) = rk[i];
        *(u32x4*)(Vs + key * 128 + ((ch * 16) ^ (64 * ((key >> 1) & 1)))) = rv[i];
      }
      __syncthreads();
      const int cur = step;
      int nxt = step + 1;
      while (nxt < nsteps && !step_valid(nxt)) ++nxt;
      if (nxt < nsteps) load_tile(nxt);
      step = nxt;
#pragma unroll
      for (int sub = 0; sub < 2; ++sub) {
        const bool win = cur >= 4;
        const int ks0 = win ? qb * 128 - 128 + (cur - 4) * 64 + sub * 32 : 0;
        if (win && (ks0 > tq0 + 31 + WINDOW || ks0 + 31 < tq0 - WINDOW)) continue;
        f32x16 sacc;
#pragma unroll
        for (int k = 0; k < 16; ++k) sacc[k] = 0.f;
#pragma unroll
        for (int ks = 0; ks < 4; ++ks) {
          const bf16x8 kf = *(const bf16x8*)(Ks + tile_off(sub * 32 + ql, 2 * ks + h));
          sacc = __builtin_amdgcn_mfma_f32_32x32x16_bf16(kf, qf[ks], sacc, 0, 0, 0);
        }
        if (win && (ks0 + 31 - tq0 > WINDOW || tq0 + 31 - ks0 > WINDOW)) {
          const int tq = tq0 + ql;
#pragma unroll
          for (int k = 0; k < 16; ++k) { const int d = ks0 + (k & 3) + 8 * (k >> 2) + 4 * h - tq; if (d > WINDOW || d < -WINDOW) sacc[k] = -1e30f; }
        }
        float mx = sacc[0];
#pragma unroll
        for (int k = 1; k < 16; ++k) mx = fmaxf(mx, sacc[k]);
        mx = fmaxf(mx, __shfl_xor(mx, 32));
        const float mn = fmaxf(m, mx); const float alpha = __builtin_amdgcn_exp2f(m - mn); m = mn;
        float ps = 0.f;
#pragma unroll
        for (int k = 0; k < 16; ++k) { sacc[k] = __builtin_amdgcn_exp2f(sacc[k] - mn); ps += sacc[k]; }
        lsum = lsum * alpha + ps;
#pragma unroll
        for (int k = 0; k < 16; ++k) { o0[k] *= alpha; o1[k] *= alpha; }
        u32x2 v00, v01, v02, v03, v10, v11, v12, v13;
        {
          const int q4 = (lane & 15) >> 2, p4 = lane & 3, blk = (lane >> 4) & 1, sq = (q4 >> 1) & 1;
          const unsigned lb = (unsigned)(size_t)((__attribute__((address_space(3))) char*)Vs) + (unsigned)((sub * 32 + 4 * h + q4) * 128 + 32 * blk + 8 * p4);
          const unsigned base0 = lb + 64 * sq, base1 = lb + 64 * (1 - sq);
          asm volatile(
              "ds_read_b64_tr_b16 %0, %8\n\t"
              "ds_read_b64_tr_b16 %1, %8 offset:1024\n\t"
              "ds_read_b64_tr_b16 %2, %8 offset:2048\n\t"
              "ds_read_b64_tr_b16 %3, %8 offset:3072\n\t"
              "ds_read_b64_tr_b16 %4, %9\n\t"
              "ds_read_b64_tr_b16 %5, %9 offset:1024\n\t"
              "ds_read_b64_tr_b16 %6, %9 offset:2048\n\t"
              "ds_read_b64_tr_b16 %7, %9 offset:3072\n\t"
              "s_waitcnt lgkmcnt(0)"
              : "=&v"(v00), "=&v"(v01), "=&v"(v02), "=&v"(v03), "=&v"(v10), "=&v"(v11), "=&v"(v12), "=&v"(v13)
              : "v"(base0), "v"(base1) : "memory");
        }
#pragma unroll
        for (int ks2 = 0; ks2 < 2; ++ks2) {
          u32x4 pw;
#pragma unroll
          for (int i = 0; i < 4; ++i) pw[i] = pack2(sacc[8 * ks2 + 2 * i], sacc[8 * ks2 + 2 * i + 1]);
          const bf16x8 pf = __builtin_bit_cast(bf16x8, pw);
          u32x4 a0, a1;
          if (ks2 == 0) { a0[0] = v00[0]; a0[1] = v00[1]; a0[2] = v01[0]; a0[3] = v01[1]; a1[0] = v10[0]; a1[1] = v10[1]; a1[2] = v11[0]; a1[3] = v11[1]; }
          else          { a0[0] = v02[0]; a0[1] = v02[1]; a0[2] = v03[0]; a0[3] = v03[1]; a1[0] = v12[0]; a1[1] = v12[1]; a1[2] = v13[0]; a1[3] = v13[1]; }
          o0 = __builtin_amdgcn_mfma_f32_32x32x16_bf16(__builtin_bit_cast(bf16x8, a0), pf, o0, 0, 0, 0);
          o1 = __builtin_amdgcn_mfma_f32_32x32x16_bf16(__builtin_bit_cast(bf16x8, a1), pf, o1, 0, 0, 0);
        }
      }
    }
    lsum += __shfl_xor(lsum, 32);
    const float sk = p.sink[l * N_Q_HEADS + hq] * 1.4426950408889634f;
    const float mf = fmaxf(m, sk); const float sc = __builtin_amdgcn_exp2f(m - mf); const float inv = sc / (lsum * sc + __builtin_amdgcn_exp2f(sk - mf));
    float* op = p.mixb() + qrow * MIX_W + hq * HEAD_DIM + 4 * h;
#pragma unroll
    for (int gq = 0; gq < 4; ++gq) {
      *(float4*)(op + 8 * gq) = make_float4(o0[4 * gq] * inv, o0[4 * gq + 1] * inv, o0[4 * gq + 2] * inv, o0[4 * gq + 3] * inv);
      *(float4*)(op + 32 + 8 * gq) = make_float4(o1[4 * gq] * inv, o1[4 * gq + 1] * inv, o1[4 * gq + 2] * inv, o1[4 * gq + 3] * inv);
    }
  }
}


static_assert(S5_T == 64 && S5_STATE == 64 && S5_GROUP == 16 && S5_GROUPS == 16 && NCH == 132, "s5 mfma shape");
#define S5_COLS (BATCH * NCH)
#define S5_RT 88
DEV void ph_s5tables_gpu(const P& p, long gtid, long gsize) {
  FOR_ITEMS4(i, (long)DEPTH * 2 * S5_GROUPS * 128 * 1024) {
    const int k = (int)(i & 1023), n = (int)((i >> 10) & 127); const long ldg = i >> 17;
    const int ri = n >> 6, pp = n & 63, sidx = k >> 4, j = k & 15;
    const float2 lp = p.lampow()[(ldg * (S5_T + 1) + (S5_T - 1 - sidx)) * S5_STATE + pp]; const float2 bb = p.bbar()[(ldg * S5_STATE + pp) * S5_GROUP + j];
    p.bmtb()[i] = (unsigned short)f2bf(ri ? lp.x * bb.y + lp.y * bb.x : lp.x * bb.x - lp.y * bb.y);
  }
  FOR_ITEMS4(i, (long)DEPTH * 2 * S5_GROUPS * 128 * 1024) {
    const int k = (int)(i & 127), n = (int)((i >> 7) & 1023); const long ldg = i >> 17; const int dir = (int)((ldg >> 4) & 1);
    const int ri = k >> 6, pp = k & 63, tl = n >> 4, ii = n & 15; const int tau = dir ? 63 - tl : tl;
    const float cr = p.s5_c_re[(ldg * S5_GROUP + ii) * S5_STATE + pp], ci = p.s5_c_im[(ldg * S5_GROUP + ii) * S5_STATE + pp];
    const float2 lp = p.lampow()[(ldg * (S5_T + 1) + tau + 1) * S5_STATE + pp];
    p.cmtb()[i] = (unsigned short)f2bf(ri ? -(cr * lp.y + ci * lp.x) : cr * lp.x - ci * lp.y);
  }
}
DEV void ph_kcb_gpu(const P& p, long gtid, long gsize) {
  FOR_ITEMS4(i, (long)DEPTH * 2 * S5_GROUPS * S5_T * 256) p.kcb()[i] = (unsigned short)f2bf(p.kc()[i]);
}
struct ALS5U { const char* base; unsigned off0[2]; int stepb; const char* hbase; unsigned hoff[2]; int nki;
  DEVM void set(int i, int b, int dir, int chunk, int sl, unsigned joff) { off0[i] = (unsigned)s5_row(b, dir, chunk * S5_T + sl) * (unsigned)(S5_W * 2) + joff; }
  DEVM const unsigned short* a(int i, int kt) const {
    if (kt >= nki) return (const unsigned short*)(hbase + (hoff[i] + (unsigned)(kt - nki) * 128u));
    return (const unsigned short*)(base + (off0[i] + (unsigned)(kt * stepb))); } };
struct BLKc { const char* kc; const char* cm; int tl, i0, sj, ss, dir, nki; unsigned cmoff;
  DEVM void load(u32x4 (&rb)[4], int kt) const {
    if (kt >= nki) {
#pragma unroll
      for (int c = 0; c < 4; ++c) rb[c] = *(const u32x4*)(cm + (cmoff + (unsigned)(c * 128 + (kt - nki) * 64) * 2u));
      return;
    }
    const int d = (dir ? 63 - tl : tl) - (4 * kt + ss);
    if (d < 0) {
#pragma unroll
      for (int c = 0; c < 4; ++c) rb[c] = (u32x4){0u, 0u, 0u, 0u};
    } else {
#pragma unroll
      for (int c = 0; c < 4; ++c) rb[c] = *(const u32x4*)(kc + (unsigned)(((d * 16 + i0 + c) * 16 + sj) * 2));
    }
  } };
DEV void ph_s5_sgemm(const P& p, int l, char* smem) {
  const int tid = otid();
  const int nitems = 2 * S5_GROUPS * 3;
  for (int it = blockIdx.x; it < nitems; it += gridDim.x) {
    const int rt = it % 3, g = (it / 3) % S5_GROUPS, dir = it / (3 * S5_GROUPS);
    ALS5U al; al.base = (const char*)(p.s5u() + g * S5_GROUP); al.stepb = (dir ? -4 : 4) * S5_W * 2; al.nki = 1 << 20; al.hbase = al.base; al.hoff[0] = al.hoff[1] = 0;
#pragma unroll
    for (int i = 0; i < 2; ++i) { const int col = rt * S5_RT + min((tid >> 3) + 64 * i, S5_RT - 1); al.set(i, col / NCH, dir, col % NCH, (tid & 7) >> 1, (tid & 1) * 16); }
    BLT bl; bl.base = (const char*)(p.bmtb() + (((long)l * 2 + dir) * S5_GROUPS + g) * 128 * 1024); bl.rowb = 1024 * 2;
    bl.voff = (unsigned)((((tid >> 3) & 31) * 4)) * bl.rowb + (unsigned)((tid & 7) * 16);
    f32x4 acc[4][4]; acc_zero(acc);
    gemm_tb(al, bl, 16, acc, smem);
    EPI_BEGIN
    if (((etid >> 6) & 3) < 2) {
#pragma unroll
      for (int m = 0; m < 4; ++m)
#pragma unroll
        for (int j = 0; j < 4; ++j) {
          const int rl = EPI_ROW(m, j);
          if (rl < S5_RT) {
            const int col = rt * S5_RT + rl; const int b = col / NCH, c = col % NCH;
            float* dst = (float*)(p.sc() + ((((long)b * 2 + dir) * S5_GROUPS + g) * NCH + c) * S5_STATE);
#pragma unroll
            for (int n = 0; n < 4; ++n) { const int nn = EPI_COL(n); dst[(nn & 63) * 2 + (nn >> 6)] = acc[m][n][j]; }
          }
        }
    }
  }
}

static_assert(NCH == 132, "carry scan grouping");
DEV void ph_s5_carry_gpu(const P& p, int l, char* smem) {
  const int tid = otid();
  float2* E = (float2*)(smem + SM_MISC);
  const int nchains = BATCH * 2 * S5_GROUPS * S5_STATE;
  for (int cb = blockIdx.x * 16; cb < nchains; cb += gridDim.x * 16) {
    const int cl = tid & 15, grp = tid >> 4; const bool act = tid < 176;
    const int chain = cb + cl;
    const int pp = chain % S5_STATE, g = (chain / S5_STATE) % S5_GROUPS, dir = (chain / (S5_STATE * S5_GROUPS)) % 2, b = chain / (S5_STATE * S5_GROUPS * 2);
    const long ldg = ((long)l * 2 + dir) * S5_GROUPS + g;
    const long base = (((long)b * 2 + dir) * S5_GROUPS + g) * NCH + grp * 12;
    float2 lt = make_float2(0.f, 0.f); float2 L[12]; float hr = 0.f, hi = 0.f;
    __syncthreads();
    if (act) {
      lt = p.lampow()[(ldg * (S5_T + 1) + S5_T) * S5_STATE + pp];
      float2 sv[12];
#pragma unroll
      for (int k = 0; k < 12; ++k) sv[k] = p.sc()[(base + k) * S5_STATE + pp];
#pragma unroll
      for (int k = 0; k < 12; ++k) { L[k] = make_float2(hr, hi); const float nr = lt.x * hr - lt.y * hi + sv[k].x, ni = lt.x * hi + lt.y * hr + sv[k].y; hr = nr; hi = ni; }
      E[grp * 16 + cl] = make_float2(hr, hi);
    }
    __syncthreads();
    if (act) {
      float pr = lt.x, pi = lt.y;
#pragma unroll
      for (int k = 1; k < 12; ++k) { const float nr = pr * lt.x - pi * lt.y, ni = pr * lt.y + pi * lt.x; pr = nr; pi = ni; }
      float gr = 0.f, gi = 0.f;
      for (int gp = 0; gp < grp; ++gp) { const float2 e = E[gp * 16 + cl]; const float nr = pr * gr - pi * gi + e.x, ni = pr * gi + pi * gr + e.y; gr = nr; gi = ni; }
#pragma unroll
      for (int k = 0; k < 12; ++k) {
        const float vr = L[k].x + gr, vi = L[k].y + gi;
        p.hcbf()[(base + k) * 2 * S5_STATE + pp] = f2bf16(vr); p.hcbf()[(base + k) * 2 * S5_STATE + S5_STATE + pp] = f2bf16(vi);
        const float nr = lt.x * gr - lt.y * gi, ni = lt.x * gi + lt.y * gr; gr = nr; gi = ni;
      }
    }
  }
}
DEV void ph_s5_ygemm(const P& p, int l, char* smem) {
  const int tid = otid();
  const int nitems = S5_GROUPS * 3 * 4;
  for (int it = blockIdx.x; it < nitems; it += gridDim.x) {
    const int nt = it & 3, rt = (it >> 2) % 3, g = it / 12;
    f32x4 acc[4][4]; acc_zero(acc);
#pragma unroll 1
    for (int dir = 0; dir < 2; ++dir) {
      const long ldg = ((long)l * 2 + dir) * S5_GROUPS + g;
      const int nki = dir ? 16 - 4 * nt : 4 * nt + 4;
      ALS5U al; al.base = (const char*)(p.s5u() + g * S5_GROUP); al.stepb = (dir ? -4 : 4) * S5_W * 2; al.nki = nki; al.hbase = (const char*)p.hcbf();
#pragma unroll
      for (int i = 0; i < 2; ++i) {
        const int col = rt * S5_RT + min((tid >> 3) + 64 * i, S5_RT - 1); const int b = col / NCH, blk = col % NCH;
        const int ch = dir ? (blk < 4 ? 3 - blk : 135 - blk) : blk;
        al.set(i, b, dir, ch, (tid & 7) >> 1, (tid & 1) * 16);
        al.hoff[i] = (unsigned)((((b * 2 + dir) * S5_GROUPS + g) * NCH + ch) * 128 + (tid & 7) * 8) * 2u;
      }
      BLKc bk; bk.kc = (const char*)(p.kcb() + ldg * S5_T * 256); bk.tl = 16 * nt + (tid >> 5); bk.i0 = ((tid >> 3) & 3) * 4; bk.sj = (tid & 1) * 8; bk.ss = (tid & 7) >> 1; bk.dir = dir; bk.nki = nki;
      bk.cm = (const char*)(p.cmtb() + ldg * 1024 * 128); bk.cmoff = (unsigned)(((16 * nt + (tid >> 5)) * 16 + ((tid >> 3) & 3) * 4) * 128 + (tid & 7) * 8) * 2u;
      gemm_tb(al, bk, nki + 2, acc, smem);
    }
    EPI_BEGIN
#pragma unroll
    for (int m = 0; m < 4; ++m)
#pragma unroll
      for (int j = 0; j < 4; ++j) {
        const int rl = EPI_ROW(m, j);
        if (rl < S5_RT) {
          const int col = rt * S5_RT + rl; const int b = col / NCH, blk = col % NCH;
#pragma unroll
          for (int n = 0; n < 4; ++n) {
            const int nn = nt * 256 + EPI_COL(n); const int tl = nn >> 4, chn = g * S5_GROUP + (nn & 15);
            const long row = blk < 4 ? (long)NL + b * CTX_LEN + blk * 64 + tl : (long)b * SEQ + (blk - 4) * 64 + tl;
            const float y = acc[m][n][j] + p.s5_d[l * S5_W + chn] * __uint_as_float((unsigned)p.s5u()[row * S5_W + chn] << 16);
            const float gy = gelu_tanhf(y);
            p.ybuf()[row * S5_W + chn] = gy; p.ybf()[row * S5_W + chn] = (unsigned short)f2bf(gy);
          }
        }
      }
  }
}

DEV float wave_sum(float v) {
#pragma unroll
  for (int o = 32; o > 0; o >>= 1) v += __shfl_xor(v, o);
  return v;
}
DEV void st_bf4(unsigned short* dst, float a, float b, float c, float d) { u32x2 v; v[0] = pack2(a, b); v[1] = pack2(c, d); *(u32x2*)dst = v; }
static_assert(BATCH == 2, "mod partial layout");
DEV void ph_modsum_gpu(const P& p, long gtid, long gsize) {
  FOR_ITEMS(i, (long)DEPTH * (BATCH + 1) * 6 * D_MODEL) {
    const int n = (int)(i % (6 * D_MODEL)); const int j = (int)((i / (6 * D_MODEL)) % (BATCH + 1)); const int l = (int)(i / (6 * D_MODEL * (BATCH + 1)));
    float acc = p.b_ada[l * 6 * D_MODEL + n];
#pragma unroll
    for (int sl = 0; sl < 16; ++sl) acc += p.modp()[((long)(l * 16 + sl) * (BATCH + 1) + j) * 6 * D_MODEL + n];
    p.mod()[i] = acc;
  }
}
DEV void ph_modu0_gpu(const P& p, long gtid, long gsize) {
  FOR_ITEMS4(i4, (long)NR * D_MODEL / 4) {
    const long i = i4 * 4; const int k = (int)(i % D_MODEL); const long r = i / D_MODEL;
    const float* m = p.mod() + (long)modrow(r) * 6 * D_MODEL;
    const float4 x = *(const float4*)(p.xcur() + i); const float4 sh = *(const float4*)(m + k); const float4 sc = *(const float4*)(m + D_MODEL + k);
    st_bf4(p.ubf() + i, x.x * (1.f + sc.x) + sh.x, x.y * (1.f + sc.y) + sh.y, x.z * (1.f + sc.z) + sh.z, x.w * (1.f + sc.w) + sh.w);
  }
}
DEV void rms_rows(const P& p, int l, long r0, long r1, int w0, int nw) {
  const int lane = otid() & 63;
  for (long r = r0 + w0; r < r1; r += nw) {
    const float* v = p.mixb() + r * MIX_W; float4 a[4]; float ss[4];
#pragma unroll
    for (int i = 0; i < 4; ++i) { a[i] = *(const float4*)(v + (i * 64 + lane) * 4); ss[i] = a[i].x * a[i].x + a[i].y * a[i].y + a[i].z * a[i].z + a[i].w * a[i].w; }
    const float s_att = wave_sum(ss[0] + ss[1]), s_hy = wave_sum(ss[2]), s_s5 = wave_sum(ss[3]);
    float rs[4]; rs[0] = rs[1] = 1.0f / sqrtf(s_att / (float)ATTN_W + LN_EPS); rs[2] = 1.0f / sqrtf(s_hy / (float)HYENA_W + LN_EPS); rs[3] = 1.0f / sqrtf(s_s5 / (float)S5_W + LN_EPS);
#pragma unroll
    for (int i = 0; i < 4; ++i) {
      const int k = (i * 64 + lane) * 4; const float4 g = *(const float4*)(p.mix_g + l * MIX_W + k);
      st_bf4(p.mixbf() + r * MIX_W + k, a[i].x * rs[i] * g.x, a[i].y * rs[i] * g.y, a[i].z * rs[i] * g.z, a[i].w * rs[i] * g.w);
    }
  }
}
DEV void ln_rows(float4 (&a)[4], const float* gw, const float* bw, int lane) {
  float s = 0.f;
#pragma unroll
  for (int i = 0; i < 4; ++i) s += a[i].x + a[i].y + a[i].z + a[i].w;
  const float mu = wave_sum(s) / (float)D_MODEL; float q = 0.f;
#pragma unroll
  for (int i = 0; i < 4; ++i) { a[i].x -= mu; a[i].y -= mu; a[i].z -= mu; a[i].w -= mu; q += a[i].x * a[i].x + a[i].y * a[i].y + a[i].z * a[i].z + a[i].w * a[i].w; }
  const float rs = 1.0f / sqrtf(wave_sum(q) / (float)D_MODEL + LN_EPS);
#pragma unroll
  for (int i = 0; i < 4; ++i) {
    const int k = (i * 64 + lane) * 4; const float4 g = *(const float4*)(gw + k), b = *(const float4*)(bw + k);
    a[i].x = a[i].x * rs * g.x + b.x; a[i].y = a[i].y * rs * g.y + b.y; a[i].z = a[i].z * rs * g.z + b.z; a[i].w = a[i].w * rs * g.w + b.w;
  }
}
DEV void ph_ln1_gpu(const P& p, int l) {
  const int tid_ = otid(); const int lane = tid_ & 63; const int gw = blockIdx.x * (NT / 64) + (tid_ >> 6), nw = gridDim.x * (NT / 64);
  for (long r = gw; r < NR; r += nw) {
    float4 a[4];
#pragma unroll
    for (int i = 0; i < 4; ++i) a[i] = *(const float4*)(p.tmp() + r * D_MODEL + (i * 64 + lane) * 4);
    ln_rows(a, p.ln1_g + l * D_MODEL, p.ln1_b + l * D_MODEL, lane);
    const float* m = p.mod() + ((long)l * (BATCH + 1) + modrow(r)) * 6 * D_MODEL + 3 * D_MODEL;
#pragma unroll
    for (int i = 0; i < 4; ++i) {
      const int k = (i * 64 + lane) * 4;
      *(float4*)(p.xcur() + r * D_MODEL + k) = a[i];
      const float4 sh = *(const float4*)(m + k), sc = *(const float4*)(m + D_MODEL + k);
      const float u0 = a[i].x * (1.f + sc.x) + sh.x, u1 = a[i].y * (1.f + sc.y) + sh.y, u2 = a[i].z * (1.f + sc.z) + sh.z, u3 = a[i].w * (1.f + sc.w) + sh.w;
      st_bf4(p.ubf() + r * D_MODEL + k, u0, u1, u2, u3);
      st_bf4(p.ubl() + r * D_MODEL + k, bflo(u0), bflo(u1), bflo(u2), bflo(u3));
    }
  }
}
DEV void exp_prefix(const P& p, int l, int* toff, int* roff, int* rowo);
DEV void ph_ln2_gpu(const P& p, int l, char* smem) {
  const int tid_ = otid(); const int lane = tid_ & 63; const int gw = blockIdx.x * (NT / 64) + (tid_ >> 6), nw = gridDim.x * (NT / 64);
  int* toff = (int*)(smem + SM_MISC); int* roff = toff + N_EXPERTS + 1; int* rowo = roff + N_EXPERTS + 16;
  exp_prefix(p, l, toff, roff, rowo);
  int e_n = 0, s_n = 0;
  if (gw < NR && lane < TOP_K) { e_n = p.top_e()[(long)gw * TOP_K + lane]; s_n = p.posb()[(long)gw * TOP_K + lane]; }
  for (long r = gw; r < NR; r += nw) {
    const int myrow = rowo[e_n] + s_n;
    if (r + nw < NR && lane < TOP_K) { e_n = p.top_e()[(r + nw) * TOP_K + lane]; s_n = p.posb()[(r + nw) * TOP_K + lane]; }
    float4 a[4];
    const float* m = p.mod() + ((long)l * (BATCH + 1) + modrow(r)) * 6 * D_MODEL + 5 * D_MODEL;
#pragma unroll
    for (int i = 0; i < 4; ++i) {
      const int k = (i * 64 + lane) * 4;
      float4 f = *(const float4*)(p.ysh() + r * D_MODEL + k);
#pragma unroll
      for (int kk = 0; kk < TOP_K; ++kk) { const u32x2 y = *(const u32x2*)(p.ykb() + (long)__builtin_amdgcn_readlane(myrow, kk) * D_MODEL + k); f.x += __uint_as_float(y[0] << 16); f.y += __uint_as_float(y[0] & 0xffff0000u); f.z += __uint_as_float(y[1] << 16); f.w += __uint_as_float(y[1] & 0xffff0000u); }
      const float4 x = *(const float4*)(p.xcur() + r * D_MODEL + k), g2 = *(const float4*)(m + k);
      a[i].x = DN_ALPHA * x.x + g2.x * f.x; a[i].y = DN_ALPHA * x.y + g2.y * f.y; a[i].z = DN_ALPHA * x.z + g2.z * f.z; a[i].w = DN_ALPHA * x.w + g2.w * f.w;
    }
    ln_rows(a, p.ln2_g + l * D_MODEL, p.ln2_b + l * D_MODEL, lane);
    const float* mn = p.mod() + ((long)(l + 1) * (BATCH + 1) + modrow(r)) * 6 * D_MODEL;
#pragma unroll
    for (int i = 0; i < 4; ++i) {
      const int k = (i * 64 + lane) * 4;
      *(float4*)(p.xcur() + r * D_MODEL + k) = a[i];
      if (l + 1 < DEPTH) {
        const float4 sh = *(const float4*)(mn + k), sc = *(const float4*)(mn + D_MODEL + k);
        st_bf4(p.ubf() + r * D_MODEL + k, a[i].x * (1.f + sc.x) + sh.x, a[i].y * (1.f + sc.y) + sh.y, a[i].z * (1.f + sc.z) + sh.z, a[i].w * (1.f + sc.w) + sh.w);
      } else if (r < NL) *(float4*)(p.out + r * D_MODEL + k) = a[i];
    }
  }
}
struct ALRouter { const char* hi; const char* lo_; unsigned off[2];
  DEVM const unsigned short* a(int i, int kt) const { return (const unsigned short*)((kt >= 32 ? lo_ : hi) + (off[i] + (unsigned)(kt & 15) * 128u)); } };
struct BLRouter { const char* base; const char* lob; unsigned voff; unsigned rowb;
  DEVM void load(u32x4 (&rb)[4], int kt) const {
    const char* bb = (kt >> 4) == 1 ? lob : base;
#pragma unroll
    for (int c = 0; c < 4; ++c) rb[c] = *(const u32x4*)(bb + (voff + (unsigned)c * rowb + (unsigned)(kt & 15) * 128u)); } };
DEV void ph_router_mfma(const P& p, int l, char* smem) {
  const int tid = otid();
  const int n_router = (NR >> 7), n_sh = (NR >> 7) * 2;
  const int nrb = (int)gridDim.x >= 64 ? (int)((gridDim.x * 3) / 5) : 0;
  const bool is_router = nrb == 0 ? false : (int)blockIdx.x < nrb;
  for (int pass = 0; pass < 2; ++pass) {
    const bool do_router = nrb == 0 ? pass == 0 : is_router;
    if (nrb != 0 && pass == 1) break;
    const int first = nrb == 0 ? (int)blockIdx.x : (do_router ? (int)blockIdx.x : (int)blockIdx.x - nrb);
    const int stride = nrb == 0 ? (int)gridDim.x : (do_router ? nrb : (int)gridDim.x - nrb);
    const int nit = do_router ? n_router : n_sh;
    for (int it = first; it < nit; it += stride) {
      const int rt = do_router ? it : (it >> 1), cq = do_router ? 0 : (it & 1);
      ALRouter ar; ar.hi = (const char*)(p.ubf() + (long)rt * 128 * D_MODEL); ar.lo_ = (const char*)(p.ubl() + (long)rt * 128 * D_MODEL);
#pragma unroll
      for (int i = 0; i < 2; ++i) ar.off[i] = (unsigned)(((tid >> 3) + 64 * i) * D_MODEL + (tid & 7) * 8) * 2u;
      BLRouter br; int nk;
      if (do_router) {
        br.base = (const char*)(p.wt_rh() + (long)l * N_EXPERTS * D_MODEL); br.lob = (const char*)(p.wt_rl() + (long)l * N_EXPERTS * D_MODEL); br.rowb = D_MODEL * 2;
        br.voff = (unsigned)((tid >> 3) * 4) * br.rowb + (unsigned)((tid & 7) * 16); nk = 3 * (D_MODEL >> 6);
      } else {
        const int nq = tid >> 3; const int wsel = __builtin_amdgcn_readfirstlane(tid >> 6) & 1;
        const unsigned short* wsrc = (wsel ? p.wt_shu() : p.wt_shg()) + (long)l * SHARED_FF * D_MODEL;
        br.base = (const char*)wsrc; br.lob = br.base; br.rowb = D_MODEL * 2;
        br.voff = (unsigned)(cq * 128 + (nq >> 4) * 32 + (nq & 7) * 4) * br.rowb + (unsigned)((tid & 7) * 16); nk = D_MODEL >> 6;
      }
      f32x4 acc[4][4]; acc_zero(acc);
      gemm_tb(ar, br, nk, acc, smem);
      EPI_BEGIN
      if (do_router) {
#pragma unroll
        for (int m = 0; m < 4; ++m)
#pragma unroll
          for (int n = 0; n < 4; ++n)
#pragma unroll
            for (int j = 0; j < 4; ++j) p.rl()[((long)rt * 128 + EPI_ROW(m, j)) * N_EXPERTS + EPI_COL(n)] = acc[m][n][j];
      } else {
        const int elane = etid & 63, ewc = (etid >> 6) & 3;
#pragma unroll
        for (int m = 0; m < 4; ++m)
#pragma unroll
          for (int j = 0; j < 4; ++j)
          { unsigned short* dst = p.hsbf() + ((long)rt * 128 + EPI_ROW(m, j)) * SHARED_FF + cq * 128 + ewc * 32 + (elane & 15);
            dst[0] = (unsigned short)f2bf(siluq(acc[m][0][j]) * acc[m][2][j]); dst[16] = (unsigned short)f2bf(siluq(acc[m][1][j]) * acc[m][3][j]); }
      }
    }
  }
}
static_assert(EPG == 32 && TOP_K == 8 && N_EXPERT_GROUPS == 8 && TOPK_GROUPS == 4, "select shape");
DEV void ph_select_gpu(const P& p, int l) {
  const int tid_ = otid(); const int lane = tid_ & 63; const int gw = blockIdx.x * (NT / 64) + (tid_ >> 6), nw = gridDim.x * (NT / 64);
  const float4 rb = *(const float4*)(p.router_bias + l * N_EXPERTS + 4 * lane);
  for (long r = gw; r < NR; r += nw) {
    const float4 lg = *(const float4*)(p.rl() + r * N_EXPERTS + 4 * lane);
    float sc[4] = {sigmoidf_(lg.x), sigmoidf_(lg.y), sigmoidf_(lg.z), sigmoidf_(lg.w)};
    float bz[4] = {sc[0] + rb.x, sc[1] + rb.y, sc[2] + rb.z, sc[3] + rb.w};
    float m1 = fmaxf(bz[0], bz[1]), m2 = fminf(bz[0], bz[1]);
#pragma unroll
    for (int c = 2; c < 4; ++c) { const float v = bz[c]; m2 = fmaxf(m2, fminf(m1, v)); m1 = fmaxf(m1, v); }
#pragma unroll
    for (int o = 1; o < 8; o <<= 1) { const float b1 = __shfl_xor(m1, o), b2 = __shfl_xor(m2, o); m2 = fmaxf(fminf(m1, b1), fmaxf(m2, b2)); m1 = fmaxf(m1, b1); }
    const float gs = m1 + m2; const int mg = lane >> 3; int rank = 0;
#pragma unroll
    for (int j = 0; j < 8; ++j) { const float gj = __shfl(gs, j * 8); rank += (gj > gs || (gj == gs && j < mg)) ? 1 : 0; }
    if (rank >= TOPK_GROUPS) { bz[0] = bz[1] = bz[2] = bz[3] = -1e30f; }
    int sel_e[TOP_K]; float sel_s[TOP_K]; float gsum = 0.f;
#pragma unroll
    for (int it = 0; it < TOP_K; ++it) {
      float bv = bz[0]; int bc = 0;
#pragma unroll
      for (int c = 1; c < 4; ++c) if (bz[c] > bv) { bv = bz[c]; bc = c; }
      int bi = 4 * lane + bc; float bs = sc[bc];
      const int myi = bi;
#pragma unroll
      for (int o = 1; o < 64; o <<= 1) {
        const float ov = __shfl_xor(bv, o); const int oi = __shfl_xor(bi, o); const float os = __shfl_xor(bs, o);
        if (ov > bv || (ov == bv && oi < bi)) { bv = ov; bi = oi; bs = os; }
      }
      sel_e[it] = bi; sel_s[it] = bs; gsum += bs;
      if (bi == myi) {
#pragma unroll
        for (int c = 0; c < 4; ++c) if (c == bc) bz[c] = -1e30f;
      }
    }
    const float inv = ROUTED_SCALE / gsum;
    int me = sel_e[0]; float ms = sel_s[0];
#pragma unroll
    for (int it = 1; it < TOP_K; ++it) if (lane == it) { me = sel_e[it]; ms = sel_s[it]; }
    if (lane < TOP_K) {
      const long a = r * TOP_K + lane;
      p.top_e()[a] = me; p.gate()[a] = ms * inv;
      const int pos = atomicAdd(&p.cnt()[l * N_EXPERTS + me], 1);
      p.elist()[(long)me * NR + pos] = (int)a; p.egate()[(long)me * NR + pos] = ms * inv; p.posb()[a] = pos;
    }
  }
}
#endif

#ifndef CPU_TEST
#define XB_TMO      128
#define XB_XCNT(j)  (256  + 64 * (j))
#define XB_XSUB(j)  (1280 + 64 * (j))
#define XB_XGEN(j)  (2304 + 64 * (j))
#define XB_TOP      3328
#define XB_TOPGEN   3392
#define XCD_BAR_WORDS 3456
#define XB_SPIN_CAP (1u << 18)
#define LAS __attribute__((address_space(3)))
__device__ __forceinline__ unsigned xb_ld(unsigned* p)              { return __hip_atomic_load(p, __ATOMIC_RELAXED, __HIP_MEMORY_SCOPE_AGENT); }
__device__ __forceinline__ unsigned xb_add(unsigned* p, unsigned v) { return __hip_atomic_fetch_add(p, v, __ATOMIC_RELAXED, __HIP_MEMORY_SCOPE_AGENT); }
__device__ __forceinline__ unsigned xb_xcc_id() { return (unsigned)__builtin_amdgcn_s_getreg((3 << 11) | 20) & 0xFu; }
#define XB_SPIN(cond, bar) do { unsigned _sp = 0; while (cond) { __builtin_amdgcn_s_sleep(1); \
    if ((++_sp & 255u) == 0u) { if (xb_ld(&(bar)[XB_TMO])) break; if (_sp > XB_SPIN_CAP) { atomicAdd(&(bar)[XB_TMO], 1u); break; } } } } while (0)
struct XcdBarrier { unsigned* bar; unsigned x; volatile LAS unsigned* st; };
__device__ __forceinline__ XcdBarrier xcd_barrier_post(unsigned* bar, volatile LAS unsigned* st) {
    XcdBarrier b; b.bar = bar; b.x = xb_xcc_id(); b.st = st;
    if (threadIdx.x == 0) (void)xb_add(&bar[XB_XCNT(b.x)], 1u);
    return b;
}
__device__ __forceinline__ void xcd_barrier_complete(unsigned* bar, unsigned x, unsigned& nloc, unsigned& nx) {
    const unsigned G = gridDim.x * gridDim.y * gridDim.z;
    unsigned sum, cnt, mine, sp = 0u;
    for (;;) {
        sum = 0u; cnt = 0u; mine = 0u;
#pragma unroll
        for (unsigned j = 0; j < 16; ++j) { const unsigned c = xb_ld(&bar[XB_XCNT(j)]); sum += c; cnt += (c > 0u) ? 1u : 0u; mine = (j == x) ? c : mine; }
        if (sum == G) break;
        __builtin_amdgcn_s_sleep(1);
        if ((++sp & 255u) == 0u) { if (xb_ld(&bar[XB_TMO])) break; if (sp > XB_SPIN_CAP) { atomicAdd(&bar[XB_TMO], 1u); break; } }
    }
    nloc = mine > 0u ? mine : 1u; nx = cnt > 0u ? cnt : 1u;
}
__device__ __forceinline__ void xcd_barrier(const XcdBarrier& b) {
    asm volatile("s_waitcnt vmcnt(0)" ::: "memory");
    __syncthreads();
    if (threadIdx.x == 0) {
        unsigned* bar = b.bar;
        unsigned bx = b.x; asm volatile("" : "+s"(bx));
        __builtin_amdgcn_s_waitcnt(0);
        unsigned nloc = b.st[0], nx = b.st[1];
        if (nloc == 0u) { xcd_barrier_complete(bar, bx, nloc, nx); b.st[0] = nloc; b.st[1] = nx; }
        const unsigned old = xb_add(&bar[XB_XSUB(bx)], 1u);
        const unsigned gen = old / nloc;
        if (old + 1u == (gen + 1u) * nloc) {
            __builtin_amdgcn_fence(__ATOMIC_RELEASE, "agent");
            asm volatile("s_waitcnt vmcnt(0)" ::: "memory");
            const unsigned og = xb_add(&bar[XB_TOP], 1u);
            const unsigned tg = og / nx;
            if (og + 1u == (tg + 1u) * nx) xb_add(&bar[XB_TOPGEN], 1u);
            else XB_SPIN(xb_ld(&bar[XB_TOPGEN]) == tg, bar);
            __builtin_amdgcn_fence(__ATOMIC_ACQUIRE, "agent");
            xb_add(&bar[XB_XGEN(bx)], 1u);
            asm volatile("s_waitcnt vmcnt(0)" ::: "memory");
        } else {
            XB_SPIN(xb_ld(&bar[XB_XGEN(bx)]) == gen, bar);
            __builtin_amdgcn_fence(__ATOMIC_ACQUIRE, "agent");
            asm volatile("s_waitcnt vmcnt(0)" ::: "memory");
        }
    }
    __syncthreads();
}
#define GRID_SYNC() xcd_barrier(xb)
#else
#define GRID_SYNC() do {} while (0)
#endif

#ifndef CPU_TEST
#define GPUSEL(a, b) a
#else
#define GPUSEL(a, b) b
#endif
#ifndef CPU_TEST
#define OPAQUE_S(v) asm volatile("" : "+s"(v))
#define OPAQUE_V(v) asm volatile("" : "+v"(v))
#else
#define OPAQUE_S(v) do {} while (0)
#define OPAQUE_V(v) do {} while (0)
#endif
#ifndef PROBE_MASK
#define PROBE_MASK 0
#endif
#define LPHASE(stmt) do { int l = lo; OPAQUE_S(l); if (SINGLE && ((PROBE_MASK >> (ph - NG - lo * NLP)) & 1)) { long gtid = gtid0; OPAQUE_V(gtid); stmt; GRID_SYNC(); } PHASE(stmt); } while (0)
#define PHASE(stmt) do { if (SINGLE || ph == only) { long gtid = gtid0; OPAQUE_V(gtid); stmt; } if (SINGLE) { GRID_SYNC(); } ++ph; } while (0)
#ifndef CPU_TEST
template <bool SINGLE> __device__ __forceinline__ void run_seq(const P& p, long gtid0, long gsize, int only, const XcdBarrier& xb, char* smem)
#else
template <bool SINGLE> static int run_seq(const P& p, long gtid0, long gsize, int only)
#endif
{
  int ph = 0;
  PHASE(ph_g0(p, gtid, gsize));
  PHASE(ph_g1(p, gtid, gsize));
  PHASE(ph_g2(p, gtid, gsize));
  PHASE(ph_g3(p, gtid, gsize));
  PHASE(ph_g4(p, gtid, gsize));
#pragma unroll 1
  for (int lo = 0; lo < DEPTH; ++lo) {
    LPHASE(ph_modu(p, l, 0, gtid, gsize));
    LPHASE(GPUSEL(ph_proj_mfma(p, l, smem), ph_proj(p, l, gtid, gsize)));
    LPHASE(ph_post_proj(p, l, gtid, gsize));
    LPHASE(ph_mix(p, l, gtid, gsize); GPUSEL((ph_attn_mfma(p, l, smem), ph_hyena_mfma(p, l, smem)), (void)0));
    LPHASE(ph_s5out(p, l, gtid, gsize));
    LPHASE(GPUSEL(ph_glu_mfma(p, l, smem), ph_glu(p, l, gtid, gsize)));
    LPHASE(ph_rms(p, l, gtid, gsize));
    LPHASE(GPUSEL(ph_outproj_mfma(p, l, smem), ph_outproj(p, l, gtid, gsize)));
    LPHASE(ph_ln(p, l, 0, gtid, gsize));
    LPHASE(ph_router(p, l, gtid, gsize));
    LPHASE(ph_select(p, l, gtid, gsize));
    LPHASE(ph_sortrows(p, l, gtid, gsize));
    LPHASE(GPUSEL(ph_expert_up_mfma(p, l, smem), ph_expert_up(p, l, gtid, gsize)));
    LPHASE(GPUSEL(ph_expert_down_mfma(p, l, smem), ph_expert_down(p, l, gtid, gsize)));
    LPHASE(ph_combine(p, l, gtid, gsize));
    LPHASE(ph_ln(p, l, 1, gtid, gsize));
  }
#ifdef CPU_TEST
  return ph;
#endif
}


#ifndef CPU_TEST
#define NG_GPU 4
#define NLP_GPU 12
#ifndef PROBE_MASK_G
#define PROBE_MASK_G 0
#endif
#define GPHASE(stmt) do { if (SINGLE || ph == only) { long gtid = (long)blockIdx.x * NT + otid(); long gsize = gsize0; asm volatile("" : "+s"(gsize)); stmt; } if (SINGLE) { GRID_SYNC(); } ++ph; } while (0)
#define GLPHASE(stmt) do { int l = lo; OPAQUE_S(l); if (SINGLE && ((PROBE_MASK_G >> (ph - NG_GPU - lo * NLP_GPU)) & 1)) { long gtid = (long)blockIdx.x * NT + otid(); stmt; GRID_SYNC(); } GPHASE(stmt); } while (0)
template <bool SINGLE> __device__ __forceinline__ void run_seq_gpu(const P& p, long gtid0, long gsize0, int only, const XcdBarrier& xb, char* smem) {
  int ph = 0;
  const long gsize = gsize0;
#ifdef PROBE_INIT
  if (SINGLE) { long gtid = (long)blockIdx.x * NT + otid(); ph_g0(p, gtid, gsize); GRID_SYNC(); ph_g1(p, gtid, gsize); ph_modsum_gpu(p, gtid, gsize); ph_s5tables_gpu(p, gtid, gsize); GRID_SYNC(); ph_g2(p, gtid, gsize); ph_modu0_gpu(p, gtid, gsize); GRID_SYNC(); ph_g3(p, gtid, gsize); GRID_SYNC(); ph_g4(p, gtid, gsize); GRID_SYNC(); }
#endif
  GPHASE(ph_g0(p, gtid, gsize); s5_lampow_gpu(p, gtid, gsize); rope_table_gpu(p, gtid, gsize));
  GPHASE(ph_g1(p, gtid, gsize); ph_modsum_gpu(p, gtid, gsize); ph_s5tables_gpu(p, gtid, gsize); wt_convert_all(p, gtid, gsize));
  GPHASE(ph_g2(p, gtid, gsize); ph_modu0_gpu(p, gtid, gsize); ph_kcb_gpu(p, gtid, gsize));
  GPHASE(ph_g3(p, gtid, gsize));
#pragma unroll 1
  for (int lo = 0; lo < DEPTH; ++lo) {
    GLPHASE(if (l == 0) ph_g4(p, gtid, gsize); ph_proj_mfma(p, l, smem));
    GLPHASE(ph_s5_sgemm(p, l, smem); ph_hyena_pre_gpu(p, l, gtid, gsize));
    GLPHASE(ph_mix(p, l, gtid, gsize); ph_s5_carry_gpu(p, l, smem); ph_attn_mfma(p, l, smem); ph_hyena_mfma(p, l, smem));
    GLPHASE(ph_s5_ygemm(p, l, smem));
    GLPHASE(ph_glu_mfma(p, l, smem));
    GLPHASE(ph_outproj_mfma(p, l, smem));
    GLPHASE(ph_ln1_gpu(p, l));
    GLPHASE(ph_router_mfma(p, l, smem));
    GLPHASE(ph_select_gpu(p, l));
#ifdef UPVAR
    if (SINGLE) { int l = lo; OPAQUE_S(l); ph_expert_up_mfma<UPVAR>(p, l, smem); GRID_SYNC(); }
#endif
    GLPHASE(ph_expert_up_mfma(p, l, smem));
    GLPHASE(ph_expert_down_mfma(p, l, smem));
    GLPHASE(ph_ln2_gpu(p, l, smem));
  }
}
#endif

static void carve(P& p, void* ws) { p.ws = (char*)ws; }
static void set_inputs(P& p, void* const* d_in) {
  const float** f = (const float**)&p.x;
  for (int i = 0; i < 40; ++i) f[i] = (const float*)d_in[i];
}

#ifndef CPU_TEST
#ifndef MK_SINGLE
#define MK_SINGLE 1
#endif
extern __shared__ __attribute__((aligned(16))) char dyn_smem[];
__global__ void __launch_bounds__(NT, 2) mk_single(P p) {
  uint4* xbw = (uint4*)(dyn_smem + SM_XB);
  if (threadIdx.x == 0) *xbw = make_uint4(0u, 0u, 0u, 0u);
  __syncthreads();
  XcdBarrier xb = xcd_barrier_post(p.bar(), (volatile LAS unsigned*)xbw);
  run_seq_gpu<true>(p, (long)blockIdx.x * blockDim.x + threadIdx.x, (long)gridDim.x * blockDim.x, -1, xb, dyn_smem);
}
#if !MK_SINGLE
__global__ void __launch_bounds__(NT, 2) mk_phase(P p, int only) {
  XcdBarrier xb; xb.bar = p.bar(); xb.x = 0; xb.st = nullptr;
#ifdef DBG_ONLY
  only = DBG_ONLY;
#endif
  run_seq_gpu<false>(p, (long)blockIdx.x * blockDim.x + threadIdx.x, (long)gridDim.x * blockDim.x, only, xb, dyn_smem);
}
#endif
extern "C" void kernel_launch(void* const* d_in, const int* in_sizes, int n_in, void* d_out, int out_size, void* d_ws, size_t ws_size, hipStream_t stream) {
  P p; memset(&p, 0, sizeof(p));
  set_inputs(p, d_in); p.out = (float*)d_out; carve(p, d_ws);
  (void)hipMemsetAsync(p.bar(), 0, 4096 * sizeof(unsigned) + ((DEPTH * N_EXPERTS * sizeof(int) + 255) / 256) * 256, stream);
#if MK_SINGLE
  static int grid = 0;
  if (!grid) {
    int dev = 0, cus = 0, per_cu = 0; (void)hipGetDevice(&dev);
    (void)hipDeviceGetAttribute(&cus, hipDeviceAttributeMultiprocessorCount, dev);
    (void)hipFuncSetAttribute((const void*)mk_single, hipFuncAttributeMaxDynamicSharedMemorySize, SMEM_BYTES);
    (void)hipOccupancyMaxActiveBlocksPerMultiprocessor(&per_cu, mk_single, NT, SMEM_BYTES);
    grid = cus * (per_cu < 1 ? per_cu : 1);
  }
  mk_single<<<grid, NT, SMEM_BYTES, stream>>>(p);
#else
  for (int ph = 0; ph < NG_GPU + DEPTH * NLP_GPU; ++ph) mk_phase<<<256, NT, SMEM_BYTES, stream>>>(p, ph);
#endif
}
#endif
```
